# Optimizing an MI355X kernel written in HIP

```python
import jax, jax.numpy as jnp
from jax import lax
import numpy as np

D_MODEL = 1024
BATCH = 32
SEQ = 2048
DEPTH = 1

GRID_W = 64
WIN_R = 8
WIN_C = 16
NA_HEADS = 8
NA_HEAD_DIM = 64
NA_WIDTH = NA_HEADS * NA_HEAD_DIM
RET_HEADS = 4
RET_HEAD_DIM = 128
RET_WIDTH = RET_HEADS * RET_HEAD_DIM
RET_CHUNK = 128
ROPE_BASE = 10000.0
D_MIX = NA_WIDTH + RET_WIDTH
D_IN_PROJ = 3 * NA_WIDTH + 4 * RET_WIDTH
N_EXPERTS = 256
TOP_K = 8
N_GROUPS = 8
TOPK_GROUPS = 4
D_EXPERT = 256
D_SHARED = 256
ROUTED_SCALE = 2.5
EXPERT_BLOCK = 128
BLOCKS_PER_STEP = 32
LN_EPS = 1e-5
GN_EPS = 1e-6
DEEPNORM_ALPHA = (2.0 * DEPTH) ** 0.25
DEEPNORM_BETA = (8.0 * DEPTH) ** -0.25

kernel_name = 'hybrid_natten_retnet_moe_block'


def _layer_norm(x, g, b):
    xf = x.astype(jnp.float32)
    mu = jnp.mean(xf, -1, keepdims=True)
    var = jnp.mean(jnp.square(xf - mu), -1, keepdims=True)
    y = (xf - mu) * lax.rsqrt(var + LN_EPS) * g.astype(jnp.float32) + b.astype(jnp.float32)
    return y.astype(x.dtype)


def _rope(t, cos, sin):
    half = t.shape[-1] // 2
    t1, t2 = t[..., :half], t[..., half:]
    return jnp.concatenate([t1 * cos - t2 * sin, t2 * cos + t1 * sin], axis=-1).astype(t.dtype)


def _neighbourhood_attention(q, k, v, rpb, rows):
    b, s, _ = q.shape
    w, h, d = GRID_W, NA_HEADS, NA_HEAD_DIM
    kr = min(WIN_R, rows)
    grid = lambda t: t.reshape(b, rows, w, h, d)
    q_rows = grid(q * d ** -0.5).transpose(1, 0, 3, 2, 4)
    k_grid = grid(k).transpose(0, 3, 1, 2, 4)
    v_grid = grid(v).transpose(0, 3, 1, 2, 4)
    cq = jnp.arange(w)
    cs = jnp.clip(cq - WIN_C // 2, 0, w - WIN_C)
    ck = jnp.arange(w)
    col_in = (ck[None, :] >= cs[:, None]) & (ck[None, :] < cs[:, None] + WIN_C)
    dc_idx = jnp.clip(ck[None, :] - cq[:, None] + WIN_C - 1, 0, 2 * WIN_C - 2)
    rpb_cols = rpb[:, :, dc_idx]

    def row_block(args):
        r, q_row = args
        rs = jnp.clip(r - kr // 2, 0, rows - kr)
        k_blk = lax.dynamic_slice_in_dim(k_grid, rs, kr, axis=2)
        v_blk = lax.dynamic_slice_in_dim(v_grid, rs, kr, axis=2)
        dr_idx = rs + jnp.arange(kr) - r + WIN_R - 1
        bias = rpb_cols[:, dr_idx].transpose(0, 2, 1, 3)
        sc = jnp.einsum('bhqd,bhrkd->bhqrk', q_row, k_blk).astype(jnp.float32)
        sc = sc + bias.astype(jnp.float32)[None]
        sc = jnp.where(col_in[:, None, :], sc, -jnp.inf)
        p = jax.nn.softmax(sc, axis=(-2, -1)).astype(v_blk.dtype)
        return jnp.einsum('bhqrk,bhrkd->bhqd', p, v_blk)

    out = lax.map(row_block, (jnp.arange(rows, dtype=jnp.int32), q_rows))
    return out.transpose(1, 0, 3, 2, 4).reshape(b, s, h * d)


def _retention_chunkwise(q, k, v, log_gamma, strict):
    b, h, s, dh = q.shape
    n = s // RET_CHUNK
    qc = q.reshape(b, h, n, RET_CHUNK, dh)
    kc = k.reshape(b, h, n, RET_CHUNK, dh)
    vc = v.reshape(b, h, n, RET_CHUNK, dh)
    lg = log_gamma.astype(jnp.float32)[:, None]
    i = jnp.arange(RET_CHUNK, dtype=jnp.float32)
    diff = i[:, None] - i[None, :]
    mask = (diff > 0) if strict else (diff >= 0)
    decay_in = jnp.where(mask, jnp.exp(jnp.maximum(diff, 0.0) * lg[:, :, None]), 0.0)
    sc = jnp.einsum('bhncd,bhnmd->bhncm', qc, kc) * decay_in[None, :, None]
    intra = jnp.einsum('bhncm,bhnme->bhnce', sc, vc)
    k_decay = jnp.exp((RET_CHUNK - 1 - i)[None, :] * lg)
    q_decay = jnp.exp((i + 1)[None, :] * lg)
    kv = jnp.einsum('bhncd,bhnce->nbhde', kc * k_decay[None, :, None, :, None], vc)
    chunk_decay = jnp.exp(RET_CHUNK * lg)[None, :, :, None]

    def step(state, kv_n):
        return chunk_decay * state + kv_n, state

    _, r_prev = lax.scan(step, jnp.zeros_like(kv[0]), kv)
    cross = jnp.einsum('bhncd,nbhde->bhnce', qc * q_decay[None, :, None, :, None], r_prev)
    return (intra + cross).reshape(b, h, s, dh)


def _bidirectional_retention(q, k, v, g, log_decay, gn_g, cos, sin):
    b, s, _ = q.shape
    h, dh = RET_HEADS, RET_HEAD_DIM
    qh = _rope(q.reshape(b, s, h, dh), cos, sin).transpose(0, 2, 1, 3)
    kh = (_rope(k.reshape(b, s, h, dh), cos, sin) * dh ** -0.5).transpose(0, 2, 1, 3)
    vh = v.reshape(b, s, h, dh).transpose(0, 2, 1, 3)
    y_fwd = _retention_chunkwise(qh, kh, vh, log_decay[0], False)
    y_bwd = jnp.flip(_retention_chunkwise(jnp.flip(qh, 2), jnp.flip(kh, 2), jnp.flip(vh, 2),
                                          log_decay[1], True), 2)
    y = (y_fwd + y_bwd).astype(jnp.float32)
    mu = jnp.mean(y, -1, keepdims=True)
    var = jnp.mean(jnp.square(y - mu), -1, keepdims=True)
    yn = ((y - mu) * lax.rsqrt(var + GN_EPS)).transpose(0, 2, 1, 3).reshape(b, s, h * dh)
    yn = yn * gn_g.astype(jnp.float32)
    return (jax.nn.silu(g.astype(jnp.float32)) * yn).astype(g.dtype)


def _token_mixer(h, w_in, w_out, rpb, log_decay, gn_g, cos, sin, rows):
    proj = jnp.einsum('bsd,de->bse', h, w_in)
    cuts = [NA_WIDTH, 2 * NA_WIDTH, 3 * NA_WIDTH, 3 * NA_WIDTH + RET_WIDTH,
            3 * NA_WIDTH + 2 * RET_WIDTH, 3 * NA_WIDTH + 3 * RET_WIDTH]
    q_na, k_na, v_na, q_r, k_r, v_r, g_r = jnp.split(proj, cuts, axis=-1)
    y_na = _neighbourhood_attention(q_na, k_na, v_na, rpb, rows)
    y_r = _bidirectional_retention(q_r, k_r, v_r, g_r, log_decay, gn_g, cos, sin)
    return jnp.einsum('bse,ed->bsd', jnp.concatenate([y_na, y_r], axis=-1), w_out)


def _route(xf, w_router, router_bias):
    n = xf.shape[0]
    scores = jax.nn.sigmoid(jnp.einsum('nd,de->ne', xf, w_router).astype(jnp.float32))
    sel = scores + router_bias.astype(jnp.float32)[None]
    grp = sel.reshape(n, N_GROUPS, N_EXPERTS // N_GROUPS)
    group_score = lax.top_k(grp, 2)[0].sum(-1)
    _, gidx = lax.top_k(group_score, TOPK_GROUPS)
    gmask = jax.nn.one_hot(gidx, N_GROUPS, dtype=jnp.float32).sum(1) > 0
    masked = jnp.where(gmask[:, :, None], grp, -jnp.inf).reshape(n, N_EXPERTS)
    _, topk_idx = lax.top_k(masked, TOP_K)
    w = jnp.take_along_axis(scores, topk_idx, axis=1)
    w = w / jnp.sum(w, -1, keepdims=True) * ROUTED_SCALE
    return topk_idx.astype(jnp.int32), w


def _routed_experts(xf, topk_idx, topk_w, w_gate, w_up, w_down):
    n, d = xf.shape
    a = n * TOP_K
    flat_e = topk_idx.reshape(a)
    flat_w = topk_w.reshape(a)
    flat_tok = jnp.arange(a, dtype=jnp.int32) // TOP_K
    order = jnp.argsort(flat_e)
    e_sorted = flat_e[order]
    counts = jnp.bincount(flat_e, length=N_EXPERTS).astype(jnp.int32)
    starts = jnp.cumsum(counts) - counts
    padded = (counts + EXPERT_BLOCK - 1) // EXPERT_BLOCK * EXPERT_BLOCK
    pends = jnp.cumsum(padded)
    pstarts = pends - padded
    dest = pstarts[e_sorted] + (jnp.arange(a, dtype=jnp.int32) - starts[e_sorted])
    n_blocks = -(-(a + N_EXPERTS * (EXPERT_BLOCK - 1)) // EXPERT_BLOCK)
    n_blocks = -(-n_blocks // BLOCKS_PER_STEP) * BLOCKS_PER_STEP
    p = n_blocks * EXPERT_BLOCK
    slot_tok = jnp.full((p,), n, jnp.int32).at[dest].set(flat_tok[order])
    slot_w = jnp.zeros((p,), flat_w.dtype).at[dest].set(flat_w[order])
    block_e = jnp.searchsorted(pends, jnp.arange(n_blocks, dtype=jnp.int32) * EXPERT_BLOCK, side='right')
    block_e = jnp.minimum(block_e, N_EXPERTS - 1).astype(jnp.int32)
    n_steps = n_blocks // BLOCKS_PER_STEP
    slot_tok = slot_tok.reshape(n_steps, BLOCKS_PER_STEP, EXPERT_BLOCK)
    slot_w = slot_w.reshape(n_steps, BLOCKS_PER_STEP, EXPERT_BLOCK)
    block_e = block_e.reshape(n_steps, BLOCKS_PER_STEP)
    x_pad = jnp.concatenate([xf, jnp.zeros((1, d), xf.dtype)], axis=0)

    def step(acc, inp):
        tok, wt, e = inp
        xb = x_pad[tok]
        hg = jnp.einsum('sbd,sdf->sbf', xb, w_gate[e])
        hu = jnp.einsum('sbd,sdf->sbf', xb, w_up[e])
        y = jnp.einsum('sbf,sfd->sbd', jax.nn.silu(hg) * hu, w_down[e]) * wt[..., None]
        acc = acc.at[tok.reshape(-1)].add(y.reshape(-1, d).astype(acc.dtype))
        return acc, None

    acc, _ = lax.scan(step, jnp.zeros((n + 1, d), xf.dtype), (slot_tok, slot_w, block_e))
    return acc[:n]


def _moe_ffn(xf, w_router, router_bias, w_gate, w_up, w_down, ws_gate, ws_up, ws_down):
    shared = jnp.einsum('nf,fd->nd', jax.nn.silu(xf @ ws_gate) * (xf @ ws_up), ws_down)
    topk_idx, topk_w = _route(xf, w_router, router_bias)
    return shared + _routed_experts(xf, topk_idx, topk_w, w_gate, w_up, w_down)


def setup_inputs(seed: int = 0) -> dict:
    key = jax.random.key(seed)
    ks = jax.random.split(key, 24)
    L, D, E = DEPTH, D_MODEL, N_EXPERTS
    nrm = lambda k, shape, scale: jax.random.normal(k, shape, jnp.float32) * scale
    beta = DEEPNORM_BETA
    col_scale = np.concatenate([np.ones(2 * NA_WIDTH), np.full(NA_WIDTH, beta), np.ones(2 * RET_WIDTH),
                                np.full(RET_WIDTH, beta), np.ones(RET_WIDTH)]).astype(np.float32)
    base_decay = np.log(1.0 - 2.0 ** (-5.0 - np.arange(RET_HEADS))).astype(np.float32)
    ret_log_decay = jnp.asarray(base_decay)[None, None, :] * jnp.exp(nrm(ks[7], (L, 2, RET_HEADS), 0.1))
    return {
        'x': nrm(ks[0], (BATCH, SEQ, D), 1.0),
        'c': nrm(ks[1], (BATCH, D), 1.0),
        'w_ada': nrm(ks[2], (L, D, 6 * D), D ** -0.5),
        'b_ada': nrm(ks[3], (L, 6 * D), 0.02),
        'w_in': nrm(ks[4], (L, D, D_IN_PROJ), D ** -0.5) * jnp.asarray(col_scale),
        'w_out': nrm(ks[5], (L, D_MIX, D), beta * D_MIX ** -0.5),
        'na_rpb': nrm(ks[6], (L, NA_HEADS, 2 * WIN_R - 1, 2 * WIN_C - 1), 0.1),
        'ret_log_decay': ret_log_decay,
        'ret_gn_g': 1.0 + nrm(ks[8], (L, RET_WIDTH), 0.02),
        'ln1_g': 1.0 + nrm(ks[9], (L, D), 0.02),
        'ln1_b': nrm(ks[10], (L, D), 0.02),
        'ln2_g': 1.0 + nrm(ks[11], (L, D), 0.02),
        'ln2_b': nrm(ks[12], (L, D), 0.02),
        'w_router': nrm(ks[13], (L, D, E), D ** -0.5),
        'router_bias': nrm(ks[14], (L, E), 0.01),
        'w_gate': nrm(ks[15], (L, E, D, D_EXPERT), beta * D ** -0.5),
        'w_up': nrm(ks[16], (L, E, D, D_EXPERT), beta * D ** -0.5),
        'w_down': nrm(ks[17], (L, E, D_EXPERT, D), beta * D_EXPERT ** -0.5),
        'ws_gate': nrm(ks[18], (L, D, D_SHARED), beta * D ** -0.5),
        'ws_up': nrm(ks[19], (L, D, D_SHARED), beta * D ** -0.5),
        'ws_down': nrm(ks[20], (L, D_SHARED, D), beta * D_SHARED ** -0.5),
    }


def reference(x, c, w_ada, b_ada, w_in, w_out, na_rpb, ret_log_decay, ret_gn_g, ln1_g, ln1_b,
              ln2_g, ln2_b, w_router, router_bias, w_gate, w_up, w_down, ws_gate, ws_up, ws_down):
    b, s, d = x.shape
    rows = s // GRID_W
    t = jnp.arange(s, dtype=jnp.float32)
    inv_freq = ROPE_BASE ** (-jnp.arange(0, RET_HEAD_DIM, 2, dtype=jnp.float32) / RET_HEAD_DIM)
    ang = t[:, None] * inv_freq[None, :]
    cos, sin = jnp.cos(ang)[:, None, :], jnp.sin(ang)[:, None, :]
    cond = jax.nn.silu(c)
    for l in range(DEPTH):
        mod = jnp.einsum('bd,de->be', cond, w_ada[l]) + b_ada[l]
        shift_a, scale_a, gate_a, shift_f, scale_f, gate_f = [m[:, None, :] for m in jnp.split(mod, 6, axis=-1)]
        h = x * (1.0 + scale_a) + shift_a
        mix = _token_mixer(h, w_in[l], w_out[l], na_rpb[l], ret_log_decay[l], ret_gn_g[l], cos, sin, rows)
        x = _layer_norm(DEEPNORM_ALPHA * x + gate_a * mix, ln1_g[l], ln1_b[l])
        hf = (x * (1.0 + scale_f) + shift_f).reshape(b * s, d)
        ffn = _moe_ffn(hf, w_router[l], router_bias[l], w_gate[l], w_up[l], w_down[l],
                       ws_gate[l], ws_up[l], ws_down[l]).reshape(b, s, d)
        x = _layer_norm(DEEPNORM_ALPHA * x + gate_f * ffn, ln2_g[l], ln2_b[l])
    return x
```

```cpp
#include <hip/hip_runtime.h>
#include <cstdio>
#include <cstdint>

typedef unsigned short bf16_t;
typedef short bf16x8 __attribute__((ext_vector_type(8)));
typedef float f32x4 __attribute__((ext_vector_type(4)));
typedef float f32x2 __attribute__((ext_vector_type(2)));
typedef unsigned u32x4 __attribute__((ext_vector_type(4)));
typedef unsigned u32x2 __attribute__((ext_vector_type(2)));

constexpr int D = 1024, BATCH = 32, SEQ = 2048, M = BATCH * SEQ;
constexpr int DIN = 3584;
constexpr int OFF_QNA = 0, OFF_KNA = 512, OFF_VNA = 1024, OFF_QR = 1536, OFF_KR = 2048, OFF_VR = 2560, OFF_GR = 3072;
constexpr int NE = 256, TOPK = 8, DE = 256;
constexpr int NSLOT = M * TOPK;
constexpr float LN_EPS = 1e-5f, GN_EPS = 1e-6f;
constexpr float ALPHA = 1.189207115002721f;
constexpr float YSCALE = 64.f, YINV = 1.f / 64.f;
constexpr int MOD_SHIFT_A = 0, MOD_SCALE_A = 1024, MOD_GATE_A = 2048, MOD_SHIFT_F = 3072, MOD_SCALE_F = 4096, MOD_GATE_F = 5120;

constexpr size_t MiB = 1u << 20;
constexpr size_t WS_CTL = 0;
constexpr size_t WS_MOD = 1 * MiB;
constexpr size_t WS_ROPE = 2 * MiB;
constexpr size_t WS_WIN_T = 4 * MiB;
constexpr size_t WS_WOUT_T = 11 * MiB;
constexpr size_t WS_WR_T = 13 * MiB;
constexpr size_t WS_WSGU_T = 14 * MiB;
constexpr size_t WS_WSD_T = 15 * MiB;
constexpr size_t WS_SLOT_ENT = 16 * MiB;
constexpr size_t WS_SLOT_W = 18 * MiB;
constexpr size_t WS_TOPK_E = 20 * MiB;
constexpr size_t WS_TOPK_W = 22 * MiB;
constexpr size_t WS_MODP = 24 * MiB;
constexpr size_t WS_WD_T = 32 * MiB;
constexpr size_t WS_WGU_T = 160 * MiB;
constexpr size_t WS_YMIX = 416 * MiB;
constexpr size_t WS_PROJ = 544 * MiB;
constexpr size_t WS_LOGITS = WS_YMIX, WS_SHH = WS_YMIX + 64 * MiB;
constexpr size_t WS_HF = WS_PROJ, WS_ACT = WS_PROJ + 128 * MiB;
constexpr size_t WS_YBUF = WS_WGU_T;
constexpr size_t WS_END = 992 * MiB;
constexpr int CW_COUNT = 1024, CW_CURSOR = 1536, CW_OFFS = 2048  , CW_TILE128 = 2560  , CW_TILE256 = 3072  ;

__device__ __forceinline__ unsigned f2bf(float f) { unsigned u = __float_as_uint(f); return (u + 0x7fffu + ((u >> 16) & 1u)) >> 16; }
__device__ __forceinline__ float bf2f(unsigned short h) { return __uint_as_float(((unsigned)h) << 16); }
__device__ __forceinline__ unsigned pk2(float lo, float hi) { return f2bf(lo) | (f2bf(hi) << 16); }
__device__ __forceinline__ float silu_f(float v) { return v / (1.f + __expf(-v)); }
__device__ __forceinline__ float wave_sum(float v) {
#pragma unroll
    for (int o = 1; o < 64; o <<= 1) v += __shfl_xor(v, o);
    return v;
}
__device__ __forceinline__ unsigned char f2fp8(float v) {
    v = fminf(fmaxf(v, -440.f), 440.f);
    return (unsigned char)(__builtin_amdgcn_cvt_pk_fp8_f32(v, v, 0, false) & 0xff);
}

__global__ __launch_bounds__(256) void k_convert_t(const float* __restrict__ src, bf16_t* __restrict__ dst, int K, int N, int G, int which, int row_off,
                                                   size_t src_estride, size_t dst_estride) {
    __shared__ float tile[64][65];
    const int e = blockIdx.z;
    src += (size_t)e * src_estride; dst += (size_t)e * dst_estride;
    const int n0 = blockIdx.x * 64, k0 = blockIdx.y * 64, tid = threadIdx.x;
#pragma unroll
    for (int i = 0; i < 16; ++i) { const int k = i * 4 + (tid >> 6), n = tid & 63; tile[k][n] = src[(size_t)(k0 + k) * N + n0 + n]; }
    __syncthreads();
#pragma unroll
    for (int i = 0; i < 2; ++i) {
        const int q = tid + 256 * i, n = q >> 3, kc = q & 7;
        const int ng = n0 + n;
        const int drow = (G == 0) ? (row_off + ng) : ((ng / G) * 2 * G + which * G + (ng % G));
        u32x4 o;
        o.x = pk2(tile[kc * 8 + 0][n], tile[kc * 8 + 1][n]); o.y = pk2(tile[kc * 8 + 2][n], tile[kc * 8 + 3][n]);
        o.z = pk2(tile[kc * 8 + 4][n], tile[kc * 8 + 5][n]); o.w = pk2(tile[kc * 8 + 6][n], tile[kc * 8 + 7][n]);
        *(u32x4*)(dst + (size_t)drow * K + k0 + kc * 8) = o;
    }
}

__global__ void k_rope(float* __restrict__ tab) {
    const int idx = blockIdx.x * 256 + threadIdx.x; if (idx >= SEQ * 64) return;
    const int t = idx >> 6, i = idx & 63;
    const float inv_freq = powf(10000.f, -(float)(2 * i) / 128.f);
    const float ang = (float)t * inv_freq;
    const double a = (double)ang;
    const double two_pi = 6.283185307179586476925286766559;
    const double kf = rint(a / two_pi); double r = a - kf * two_pi;
    double sgn = 1.0; if (r > 1.5707963267948966) { r = 3.141592653589793 - r; sgn = -1.0; } else if (r < -1.5707963267948966) { r = -3.141592653589793 - r; sgn = -1.0; }
    const double r2 = r * r;
    double s = r * (1.0 + r2 * (-1.0 / 6 + r2 * (1.0 / 120 + r2 * (-1.0 / 5040 + r2 * (1.0 / 362880 + r2 * (-1.0 / 39916800 + r2 * (1.0 / 6227020800.0 + r2 * (-1.0 / 1307674368000.0))))))));
    double c = 1.0 + r2 * (-0.5 + r2 * (1.0 / 24 + r2 * (-1.0 / 720 + r2 * (1.0 / 40320 + r2 * (-1.0 / 3628800 + r2 * (1.0 / 479001600.0 + r2 * (-1.0 / 87178291200.0 + r2 * (1.0 / 20922789888000.0))))))));
    tab[idx] = (float)(sgn * c); tab[SEQ * 64 + idx] = (float)s;
}

__global__ __launch_bounds__(256) void k_mod(const float* __restrict__ c, const float* __restrict__ w_ada, const float* __restrict__ b_ada, float* __restrict__ mod) {
    __shared__ float sc[32][33];
    const int j = blockIdx.x * 256 + threadIdx.x, tid = threadIdx.x;
    float acc[32];
#pragma unroll
    for (int b = 0; b < 32; ++b) acc[b] = 0.f;
    for (int k0 = 0; k0 < D; k0 += 32) {
        __syncthreads();
#pragma unroll
        for (int i = 0; i < 4; ++i) { const int q = tid + 256 * i, b = q >> 5, kk = q & 31; sc[b][kk] = silu_f(c[b * D + k0 + kk]); }
        __syncthreads();
#pragma unroll 4
        for (int kk = 0; kk < 32; ++kk) {
            const float w = w_ada[(size_t)(k0 + kk) * 6144 + j];
#pragma unroll
            for (int b = 0; b < 32; ++b) acc[b] += sc[b][kk] * w;
        }
    }
    const float bb = b_ada[j];
#pragma unroll
    for (int b = 0; b < 32; ++b) mod[b * 6144 + j] = acc[b] + bb;
}

__global__ __launch_bounds__(256) void k_modx(const float* __restrict__ x, const float* __restrict__ mod, bf16_t* __restrict__ h) {
    const size_t i4 = (size_t)blockIdx.x * 256 + threadIdx.x;
    const size_t e = i4 * 4; const int row = (int)(e >> 10), col = (int)(e & 1023), b = row >> 11;
    const f32x4 v = *(const f32x4*)(x + e);
    const f32x4 sc = *(const f32x4*)(mod + b * 6144 + MOD_SCALE_A + col), sh = *(const f32x4*)(mod + b * 6144 + MOD_SHIFT_A + col);
    u32x2 o; o.x = pk2(v.x * (1.f + sc.x) + sh.x, v.y * (1.f + sc.y) + sh.y); o.y = pk2(v.z * (1.f + sc.z) + sh.z, v.w * (1.f + sc.w) + sh.w);
    *(u32x2*)(h + e) = o;
}

template <class P> __global__ __launch_bounds__(256, 2) void k_gemm128(P p) {
    __shared__ __attribute__((aligned(16))) bf16_t shm[2 * 128 * 32];
    if (!p.setup(blockIdx.x)) return;
    const int tid = threadIdx.x, wid = tid >> 6, lane = tid & 63, wr = wid >> 1, wc = wid & 1, fr = lane & 15, fq = lane >> 4;
    bf16_t* SA = shm; bf16_t* SB = shm + 128 * 32;
    const int r0 = tid >> 2, cc = (tid & 3) * 8;
    const bf16_t* a0 = p.arow(r0) + cc; const bf16_t* a1 = p.arow(r0 + 64) + cc;
    const bf16_t* b0 = p.brow(r0) + cc; const bf16_t* b1 = p.brow(r0 + 64) + cc;
    const int K = p.K();
    f32x4 acc[4][4];
#pragma unroll
    for (int m = 0; m < 4; ++m)
#pragma unroll
        for (int n = 0; n < 4; ++n) acc[m][n] = (f32x4){0.f, 0.f, 0.f, 0.f};
    for (int t = 0; t < K; t += 32) {
        const u32x4 va0 = *(const u32x4*)(a0 + t), va1 = *(const u32x4*)(a1 + t), vb0 = *(const u32x4*)(b0 + t), vb1 = *(const u32x4*)(b1 + t);
        __syncthreads();
        *(u32x4*)(SA + r0 * 32 + cc) = va0; *(u32x4*)(SA + (r0 + 64) * 32 + cc) = va1;
        *(u32x4*)(SB + r0 * 32 + cc) = vb0; *(u32x4*)(SB + (r0 + 64) * 32 + cc) = vb1;
        __syncthreads();
        bf16x8 At[4], Bt[4];
#pragma unroll
        for (int m = 0; m < 4; ++m) { At[m] = *(const bf16x8*)(SA + (wr * 64 + m * 16 + fr) * 32 + fq * 8); Bt[m] = *(const bf16x8*)(SB + (wc * 64 + m * 16 + fr) * 32 + fq * 8); }
#pragma unroll
        for (int m = 0; m < 4; ++m)
#pragma unroll
            for (int n = 0; n < 4; ++n) acc[m][n] = __builtin_amdgcn_mfma_f32_16x16x32_bf16(At[m], Bt[n], acc[m][n], 0, 0, 0);
    }
    p.epi(acc, wr, wc, fr, fq);
}

struct PInProj {
    const bf16_t* A; const bf16_t* Bt; bf16_t* out; int pm, pn;
    __device__ bool setup(int blk) { pn = blk % (DIN / 128); pm = blk / (DIN / 128); return true; }
    __device__ const bf16_t* arow(int r) const { return A + (size_t)(pm * 128 + r) * D; }
    __device__ const bf16_t* brow(int r) const { return Bt + (size_t)(pn * 128 + r) * D; }
    __device__ int K() const { return D; }
    __device__ void epi(const f32x4 (&acc)[4][4], int wr, int wc, int fr, int fq) const {
#pragma unroll
        for (int m = 0; m < 4; ++m)
#pragma unroll
            for (int n = 0; n < 4; ++n) {
                const int col = pn * 128 + wc * 64 + n * 16 + fr;
                const float s = (col < 512) ? 0.125f : ((col >= OFF_KR && col < OFF_VR) ? 0.08838834764831845f : 1.f);
#pragma unroll
                for (int j = 0; j < 4; ++j) { const int row = pm * 128 + wr * 64 + m * 16 + fq * 4 + j; out[(size_t)row * DIN + col] = (bf16_t)f2bf(acc[m][n][j] * s); }
            }
    }
};
struct POutProj {
    const bf16_t* A; const bf16_t* Bt; const float* x; const float* mod; float* out; int pm, pn;
    __device__ bool setup(int blk) { pn = blk % 8; pm = blk / 8; return true; }
    __device__ const bf16_t* arow(int r) const { return A + (size_t)(pm * 128 + r) * D; }
    __device__ const bf16_t* brow(int r) const { return Bt + (size_t)(pn * 128 + r) * D; }
    __device__ int K() const { return D; }
    __device__ void epi(const f32x4 (&acc)[4][4], int wr, int wc, int fr, int fq) const {
        const int b = (pm * 128) >> 11;
#pragma unroll
        for (int m = 0; m < 4; ++m)
#pragma unroll
            for (int n = 0; n < 4; ++n) {
                const int col = pn * 128 + wc * 64 + n * 16 + fr; const float g = mod[b * 6144 + MOD_GATE_A + col];
#pragma unroll
                for (int j = 0; j < 4; ++j) { const size_t o = (size_t)(pm * 128 + wr * 64 + m * 16 + fq * 4 + j) * D + col; out[o] = ALPHA * x[o] + g * acc[m][n][j]; }
            }
    }
};
struct PRouter {
    const bf16_t* A; const bf16_t* Bt; float* out; int pm, pn;
    __device__ bool setup(int blk) { pn = blk % 2; pm = blk / 2; return true; }
    __device__ const bf16_t* arow(int r) const { return A + (size_t)(pm * 128 + r) * D; }
    __device__ const bf16_t* brow(int r) const { return Bt + (size_t)(pn * 128 + r) * D; }
    __device__ int K() const { return D; }
    __device__ void epi(const f32x4 (&acc)[4][4], int wr, int wc, int fr, int fq) const {
#pragma unroll
        for (int m = 0; m < 4; ++m)
#pragma unroll
            for (int n = 0; n < 4; ++n)
#pragma unroll
                for (int j = 0; j < 4; ++j) out[(size_t)(pm * 128 + wr * 64 + m * 16 + fq * 4 + j) * NE + pn * 128 + wc * 64 + n * 16 + fr] = acc[m][n][j];
    }
};
struct PSharedGU {
    const bf16_t* A; const bf16_t* Bt; bf16_t* out; int pm, pn;
    __device__ bool setup(int blk) { pn = blk % 4; pm = blk / 4; return true; }
    __device__ const bf16_t* arow(int r) const { return A + (size_t)(pm * 128 + r) * D; }
    __device__ const bf16_t* brow(int r) const { return Bt + (size_t)(pn * 128 + r) * D; }
    __device__ int K() const { return D; }
    __device__ void epi(const f32x4 (&acc)[4][4], int wr, int wc, int fr, int fq) const {
#pragma unroll
        for (int m = 0; m < 4; ++m)
#pragma unroll
            for (int n = 0; n < 2; ++n)
#pragma unroll
                for (int j = 0; j < 4; ++j) {
                    const int row = pm * 128 + wr * 64 + m * 16 + fq * 4 + j, hc = pn * 64 + wc * 32 + n * 16 + fr;
                    out[(size_t)row * DE + hc] = (bf16_t)f2bf(silu_f(acc[m][n][j]) * acc[m][n + 2][j]);
                }
    }
};
struct PSharedDown {
    const bf16_t* A; const bf16_t* Bt; const float* mod; float* out; int pm, pn;
    __device__ bool setup(int blk) { pn = blk % 8; pm = blk / 8; return true; }
    __device__ const bf16_t* arow(int r) const { return A + (size_t)(pm * 128 + r) * DE; }
    __device__ const bf16_t* brow(int r) const { return Bt + (size_t)(pn * 128 + r) * DE; }
    __device__ int K() const { return DE; }
    __device__ void epi(const f32x4 (&acc)[4][4], int wr, int wc, int fr, int fq) const {
        const int b = (pm * 128) >> 11;
#pragma unroll
        for (int m = 0; m < 4; ++m)
#pragma unroll
            for (int n = 0; n < 4; ++n) {
                const int col = pn * 128 + wc * 64 + n * 16 + fr; const float g = mod[b * 6144 + MOD_GATE_F + col];
#pragma unroll
                for (int j = 0; j < 4; ++j) { const size_t o = (size_t)(pm * 128 + wr * 64 + m * 16 + fq * 4 + j) * D + col; out[o] = ALPHA * out[o] + g * acc[m][n][j]; }
            }
    }
};
__device__ __forceinline__ bool find_tile(const unsigned* ctl, int base, int tile, int& e, int& t) {
    if (tile >= (int)ctl[base + NE]) return false;
    int lo = 0, hi = NE - 1;
    while (lo < hi) { const int mid = (lo + hi + 1) >> 1; if ((int)ctl[base + mid] <= tile) lo = mid; else hi = mid - 1; }
    e = lo; t = tile - (int)ctl[base + lo]; return true;
}
struct PExpGU {
    const bf16_t* hf; const bf16_t* Wgu; const unsigned* ctl; const int* slot_ent; const float* slot_w; bf16_t* act;
    int e, t, pn, cnt, off, pad;
    __device__ bool setup(int blk) { pn = blk % 4; if (!find_tile(ctl, CW_TILE128, blk / 4, e, t)) return false; cnt = (int)ctl[CW_COUNT + e]; off = (int)ctl[CW_OFFS + e]; return true; }
    __device__ const bf16_t* arow(int r) const { int i = t * 128 + r; if (i >= cnt) i = cnt - 1; const int tok = slot_ent[off + i] >> 3; return hf + (size_t)tok * D; }
    __device__ const bf16_t* brow(int r) const { return Wgu + ((size_t)e * 512 + pn * 128 + r) * D; }
    __device__ int K() const { return D; }
    __device__ void epi(const f32x4 (&acc)[4][4], int wr, int wc, int fr, int fq) const {
#pragma unroll
        for (int m = 0; m < 4; ++m)
#pragma unroll
            for (int j = 0; j < 4; ++j) {
                const int i = t * 128 + wr * 64 + m * 16 + fq * 4 + j; if (i >= cnt) continue;
                const float w = slot_w[off + i];
#pragma unroll
                for (int n = 0; n < 2; ++n) { const int hc = pn * 64 + wc * 32 + n * 16 + fr; act[(size_t)(off + i) * DE + hc] = (bf16_t)f2bf(w * silu_f(acc[m][n][j]) * acc[m][n + 2][j]); }
            }
    }
};
struct PExpDown {
    const bf16_t* act; const bf16_t* Wd; const unsigned* ctl; const int* slot_ent; unsigned char* ybuf;
    int e, t, pn, cnt, off, pad;
    __device__ bool setup(int blk) { pn = blk % 8; if (!find_tile(ctl, CW_TILE128, blk / 8, e, t)) return false; cnt = (int)ctl[CW_COUNT + e]; off = (int)ctl[CW_OFFS + e]; return true; }
    __device__ const bf16_t* arow(int r) const { return act + (size_t)(off + t * 128 + r) * DE; }
    __device__ const bf16_t* brow(int r) const { return Wd + ((size_t)e * D + pn * 128 + r) * DE; }
    __device__ int K() const { return DE; }
    __device__ void epi(const f32x4 (&acc)[4][4], int wr, int wc, int fr, int fq) const {
#pragma unroll
        for (int m = 0; m < 4; ++m)
#pragma unroll
            for (int j = 0; j < 4; ++j) {
                const int i = t * 128 + wr * 64 + m * 16 + fq * 4 + j; if (i >= cnt) continue;
                const size_t dst = (size_t)slot_ent[off + i] * D;
#pragma unroll
                for (int n = 0; n < 4; ++n) ybuf[dst + pn * 128 + wc * 64 + n * 16 + fr] = f2fp8(acc[m][n][j] * YSCALE);
            }
    }
};

__global__ __launch_bounds__(256) void k_na(const bf16_t* __restrict__ proj, const float* __restrict__ rpb, bf16_t* __restrict__ ymix) {
    const int gid = blockIdx.x * 256 + threadIdx.x; const int h = gid & 7, tok = gid >> 3;
    const int b = tok >> 11, s = tok & 2047, r = s >> 6, c = s & 63;
    const int rs = min(max(r - 4, 0), 24), cs = min(max(c - 8, 0), 48);
    float q[64], acc[64];
    { const bf16_t* qp = proj + (size_t)tok * DIN + OFF_QNA + h * 64;
#pragma unroll
      for (int i = 0; i < 8; ++i) { const u32x4 v = *(const u32x4*)(qp + i * 8);
          q[i * 8 + 0] = __uint_as_float(v.x << 16); q[i * 8 + 1] = __uint_as_float(v.x & 0xffff0000u); q[i * 8 + 2] = __uint_as_float(v.y << 16); q[i * 8 + 3] = __uint_as_float(v.y & 0xffff0000u);
          q[i * 8 + 4] = __uint_as_float(v.z << 16); q[i * 8 + 5] = __uint_as_float(v.z & 0xffff0000u); q[i * 8 + 6] = __uint_as_float(v.w << 16); q[i * 8 + 7] = __uint_as_float(v.w & 0xffff0000u); } }
#pragma unroll
    for (int i = 0; i < 64; ++i) acc[i] = 0.f;
    float mx = -3.0e38f, l = 0.f;
    for (int kr = 0; kr < 8; ++kr) {
        for (int kc = 0; kc < 16; ++kc) {
            const int krow = rs + kr, kcol = cs + kc;
            const size_t kt = ((size_t)b << 11) + krow * 64 + kcol;
            const bf16_t* kp = proj + kt * DIN + OFF_KNA + h * 64; const bf16_t* vp = proj + kt * DIN + OFF_VNA + h * 64;
            float sc = 0.f;
#pragma unroll
            for (int i = 0; i < 8; ++i) { const u32x4 v = *(const u32x4*)(kp + i * 8);
                sc += q[i * 8 + 0] * __uint_as_float(v.x << 16) + q[i * 8 + 1] * __uint_as_float(v.x & 0xffff0000u) + q[i * 8 + 2] * __uint_as_float(v.y << 16) + q[i * 8 + 3] * __uint_as_float(v.y & 0xffff0000u)
                    + q[i * 8 + 4] * __uint_as_float(v.z << 16) + q[i * 8 + 5] * __uint_as_float(v.z & 0xffff0000u) + q[i * 8 + 6] * __uint_as_float(v.w << 16) + q[i * 8 + 7] * __uint_as_float(v.w & 0xffff0000u); }
            const int dr = krow - r + 7, dc = min(max(kcol - c + 15, 0), 30);
            sc += rpb[h * 465 + dr * 31 + dc];
            const float mn = fmaxf(mx, sc), corr = __expf(mx - mn), pe = __expf(sc - mn);
            l = l * corr + pe; mx = mn;
#pragma unroll
            for (int i = 0; i < 8; ++i) { const u32x4 v = *(const u32x4*)(vp + i * 8);
                acc[i * 8 + 0] = acc[i * 8 + 0] * corr + pe * __uint_as_float(v.x << 16); acc[i * 8 + 1] = acc[i * 8 + 1] * corr + pe * __uint_as_float(v.x & 0xffff0000u);
                acc[i * 8 + 2] = acc[i * 8 + 2] * corr + pe * __uint_as_float(v.y << 16); acc[i * 8 + 3] = acc[i * 8 + 3] * corr + pe * __uint_as_float(v.y & 0xffff0000u);
                acc[i * 8 + 4] = acc[i * 8 + 4] * corr + pe * __uint_as_float(v.z << 16); acc[i * 8 + 5] = acc[i * 8 + 5] * corr + pe * __uint_as_float(v.z & 0xffff0000u);
                acc[i * 8 + 6] = acc[i * 8 + 6] * corr + pe * __uint_as_float(v.w << 16); acc[i * 8 + 7] = acc[i * 8 + 7] * corr + pe * __uint_as_float(v.w & 0xffff0000u); }
        }
    }
    const float inv = 1.f / l;
    bf16_t* op = ymix + (size_t)tok * D + h * 64;
#pragma unroll
    for (int i = 0; i < 8; ++i) { u32x4 o; o.x = pk2(acc[i * 8 + 0] * inv, acc[i * 8 + 1] * inv); o.y = pk2(acc[i * 8 + 2] * inv, acc[i * 8 + 3] * inv);
        o.z = pk2(acc[i * 8 + 4] * inv, acc[i * 8 + 5] * inv); o.w = pk2(acc[i * 8 + 6] * inv, acc[i * 8 + 7] * inv); *(u32x4*)(op + i * 8) = o; }
}

__global__ __launch_bounds__(256) void k_ret(const bf16_t* __restrict__ proj, const float* __restrict__ rope, const float* __restrict__ log_decay, float* __restrict__ ybuf  ) {
    __shared__ float sq[16][128], sk[16][128], sv[16][128], sy[16][2][128];
    const int blk = blockIdx.x, dir = blk & 1, h = (blk >> 1) & 3, b = blk >> 3, tid = threadIdx.x;
    const int dv = tid & 127, half = tid >> 7;
    const float g = __expf(log_decay[dir * 4 + h]);
    float S[64];
#pragma unroll
    for (int i = 0; i < 64; ++i) S[i] = 0.f;
    float* yo = ybuf + (size_t)dir * M * 512;
    for (int t0 = 0; t0 < SEQ; t0 += 16) {
        __syncthreads();
#pragma unroll
        for (int i = 0; i < 8; ++i) {
            const int q = tid + 256 * i;
            const int u = q >> 7, which = (q >> 6) & 1, pr = q & 63;
            const int t = dir ? (SEQ - 1 - (t0 + u)) : (t0 + u);
            const bf16_t* rowp = proj + ((size_t)(b * SEQ + t)) * DIN + (which ? OFF_KR : OFF_QR) + h * 128;
            const float a1 = bf2f(rowp[pr]), a2 = bf2f(rowp[pr + 64]);
            const float cs = rope[t * 64 + pr], sn = rope[SEQ * 64 + t * 64 + pr];
            float* dst = which ? sk[u] : sq[u];
            dst[pr] = a1 * cs - a2 * sn; dst[pr + 64] = a2 * cs + a1 * sn;
        }
#pragma unroll
        for (int i = 0; i < 8; ++i) { const int q = tid + 256 * i; const int u = q >> 7, d = q & 127; const int t = dir ? (SEQ - 1 - (t0 + u)) : (t0 + u);
            sv[u][d] = bf2f(proj[((size_t)(b * SEQ + t)) * DIN + OFF_VR + h * 128 + d]); }
        __syncthreads();
        for (int u = 0; u < 16; ++u) {
            const float v = sv[u][dv]; float y = 0.f;
            if (dir == 0) {
#pragma unroll
                for (int i = 0; i < 64; ++i) { S[i] = g * S[i] + sk[u][half * 64 + i] * v; y += sq[u][half * 64 + i] * S[i]; }
            } else {
#pragma unroll
                for (int i = 0; i < 64; ++i) { y += sq[u][half * 64 + i] * S[i]; S[i] = g * (S[i] + sk[u][half * 64 + i] * v); }
            }
            sy[u][half][dv] = y;
        }
        __syncthreads();
#pragma unroll
        for (int i = 0; i < 8; ++i) { const int q = tid + 256 * i; const int u = q >> 7, d = q & 127; const int t = dir ? (SEQ - 1 - (t0 + u)) : (t0 + u);
            yo[((size_t)(b * SEQ + t)) * 512 + h * 128 + d] = sy[u][0][d] + sy[u][1][d]; }
    }
}
__global__ __launch_bounds__(256) void k_ret_fin(const float* __restrict__ ybuf, const bf16_t* __restrict__ proj, const float* __restrict__ gn_g, bf16_t* __restrict__ ymix) {
    const int w = (blockIdx.x * 256 + threadIdx.x) >> 6, lane = threadIdx.x & 63; const int tok = w >> 2, h = w & 3;
    const size_t o = (size_t)tok * 512 + h * 128 + lane * 2;
    const f32x2 a = *(const f32x2*)(ybuf + o), bb = *(const f32x2*)(ybuf + (size_t)M * 512 + o);
    const float y0 = a.x + bb.x, y1 = a.y + bb.y;
    const float mu = wave_sum(y0 + y1) * (1.f / 128.f); const float d0 = y0 - mu, d1 = y1 - mu;
    const float var = wave_sum(d0 * d0 + d1 * d1) * (1.f / 128.f); const float rs = 1.f / sqrtf(var + GN_EPS);
    const bf16_t* gp = proj + (size_t)tok * DIN + OFF_GR + h * 128 + lane * 2;
    const float g0 = bf2f(gp[0]), g1 = bf2f(gp[1]);
    const float o0 = silu_f(g0) * (d0 * rs * gn_g[h * 128 + lane * 2]), o1 = silu_f(g1) * (d1 * rs * gn_g[h * 128 + lane * 2 + 1]);
    *(unsigned*)(ymix + (size_t)tok * D + 512 + h * 128 + lane * 2) = pk2(o0, o1);
}

__global__ __launch_bounds__(256) void k_ln1(float* __restrict__ io, const float* __restrict__ g, const float* __restrict__ bb, const float* __restrict__ mod, bf16_t* __restrict__ hf) {
    const int row = (blockIdx.x * 256 + threadIdx.x) >> 6, lane = threadIdx.x & 63, b = row >> 11;
    f32x4 v[4]; float s = 0.f;
#pragma unroll
    for (int j = 0; j < 4; ++j) { v[j] = *(const f32x4*)(io + (size_t)row * D + j * 256 + lane * 4); s += (v[j].x + v[j].y) + (v[j].z + v[j].w); }
    const float mean = wave_sum(s) * (1.f / D); float s2 = 0.f;
#pragma unroll
    for (int j = 0; j < 4; ++j) { v[j] = v[j] - mean; s2 += (v[j].x * v[j].x + v[j].y * v[j].y) + (v[j].z * v[j].z + v[j].w * v[j].w); }
    const float rstd = 1.f / sqrtf(wave_sum(s2) * (1.f / D) + LN_EPS);
#pragma unroll
    for (int j = 0; j < 4; ++j) { const int col = j * 256 + lane * 4;
        const f32x4 gg = *(const f32x4*)(g + col), bv = *(const f32x4*)(bb + col);
        const f32x4 x1 = v[j] * rstd * gg + bv;
        *(f32x4*)(io + (size_t)row * D + col) = x1;
        const f32x4 sc = *(const f32x4*)(mod + b * 6144 + MOD_SCALE_F + col), sh = *(const f32x4*)(mod + b * 6144 + MOD_SHIFT_F + col);
        u32x2 o; o.x = pk2(x1.x * (1.f + sc.x) + sh.x, x1.y * (1.f + sc.y) + sh.y); o.y = pk2(x1.z * (1.f + sc.z) + sh.z, x1.w * (1.f + sc.w) + sh.w);
        *(u32x2*)(hf + (size_t)row * D + col) = o; }
}

__device__ __forceinline__ void top2_merge(float& a1, float& a2, float b1, float b2) { const float n1 = fmaxf(a1, b1); const float n2 = fmaxf(fminf(a1, b1), fmaxf(a2, b2)); a1 = n1; a2 = n2; }
__global__ __launch_bounds__(256) void k_route(const float* __restrict__ logits, const float* __restrict__ rbias, int* __restrict__ topk_e, float* __restrict__ topk_w, unsigned* __restrict__ ctl) {
    __shared__ unsigned hist[NE];
    const int tid = threadIdx.x, lane = tid & 63, wv = tid >> 6;
    hist[tid] = 0u; __syncthreads();
    const f32x4 bias = *(const f32x4*)(rbias + lane * 4);
    for (int it = 0; it < 16; ++it) {
        const int tok = blockIdx.x * 64 + wv * 16 + it;
        const f32x4 lg = *(const f32x4*)(logits + (size_t)tok * NE + lane * 4);
        float sc0 = 1.f / (1.f + __expf(-lg.x)), sc1 = 1.f / (1.f + __expf(-lg.y)), sc2 = 1.f / (1.f + __expf(-lg.z)), sc3 = 1.f / (1.f + __expf(-lg.w));
        float s0 = sc0 + bias.x, s1 = sc1 + bias.y, s2 = sc2 + bias.z, s3 = sc3 + bias.w;
        float m1 = fmaxf(s0, s1), m2 = fminf(s0, s1); top2_merge(m1, m2, fmaxf(s2, s3), fminf(s2, s3));
#pragma unroll
        for (int o = 1; o < 8; o <<= 1) { const float b1 = __shfl_xor(m1, o), b2 = __shfl_xor(m2, o); top2_merge(m1, m2, b1, b2); }
        const float gs = m1 + m2; const int grp = lane >> 3;
        int rank = 0;
#pragma unroll
        for (int gq = 0; gq < 8; ++gq) { const float og = __shfl(gs, gq * 8); rank += (og > gs || (og == gs && gq < grp)) ? 1 : 0; }
        const bool sel = rank < 4;
        const float NEG = -3.0e38f;
        if (!sel) { s0 = NEG; s1 = NEG; s2 = NEG; s3 = NEG; }
        float wsum = 0.f; float myw = 0.f; int mye = 0;
#pragma unroll
        for (int k = 0; k < TOPK; ++k) {
            float bv = s0; int bi = 0;
            if (s1 > bv) { bv = s1; bi = 1; } if (s2 > bv) { bv = s2; bi = 2; } if (s3 > bv) { bv = s3; bi = 3; }
            int be = lane * 4 + bi;
#pragma unroll
            for (int o = 1; o < 64; o <<= 1) { const float ov = __shfl_xor(bv, o); const int oe = __shfl_xor(be, o); if (ov > bv || (ov == bv && oe < be)) { bv = ov; be = oe; } }
            const int ol = be >> 2, oj = be & 3;
            const float mysc = oj == 0 ? sc0 : (oj == 1 ? sc1 : (oj == 2 ? sc2 : sc3));
            const float wsel = __shfl(mysc, ol);
            if (lane == ol) { if (oj == 0) s0 = NEG; else if (oj == 1) s1 = NEG; else if (oj == 2) s2 = NEG; else s3 = NEG; }
            wsum += wsel;
            if (lane == k) { myw = wsel; mye = be; }
        }
        if (lane < TOPK) { topk_e[tok * TOPK + lane] = mye; topk_w[tok * TOPK + lane] = myw / wsum * 2.5f; atomicAdd(&hist[mye], 1u); }
    }
    __syncthreads();
    if (hist[tid]) atomicAdd(&ctl[CW_COUNT + tid], hist[tid]);
}
__global__ __launch_bounds__(256) void k_offsets(unsigned* __restrict__ ctl) {
    __shared__ unsigned c[NE];
    const int tid = threadIdx.x; c[tid] = ctl[CW_COUNT + tid]; __syncthreads();
    unsigned off = 0, t128 = 0, t256 = 0;
    for (int i = 0; i < tid; ++i) { off += c[i]; t128 += (c[i] + 127u) >> 7; t256 += (c[i] + 255u) >> 8; }
    ctl[CW_OFFS + tid] = off; ctl[CW_TILE128 + tid] = t128; ctl[CW_TILE256 + tid] = t256;
    if (tid == NE - 1) { ctl[CW_OFFS + NE] = off + c[tid]; ctl[CW_TILE128 + NE] = t128 + ((c[tid] + 127u) >> 7); ctl[CW_TILE256 + NE] = t256 + ((c[tid] + 255u) >> 8); }
}
__global__ __launch_bounds__(256) void k_fill(const int* __restrict__ topk_e, const float* __restrict__ topk_w, unsigned* __restrict__ ctl, int* __restrict__ slot_ent, float* __restrict__ slot_w) {
    __shared__ unsigned hist[NE], base[NE];
    const int tid = threadIdx.x; hist[tid] = 0u; __syncthreads();
    int e[4]; unsigned loc[4];
#pragma unroll
    for (int i = 0; i < 4; ++i) { const int idx = blockIdx.x * 1024 + i * 256 + tid; e[i] = topk_e[idx]; loc[i] = atomicAdd(&hist[e[i]], 1u); }
    __syncthreads();
    if (hist[tid]) base[tid] = atomicAdd(&ctl[CW_CURSOR + tid], hist[tid]);
    __syncthreads();
#pragma unroll
    for (int i = 0; i < 4; ++i) { const int idx = blockIdx.x * 1024 + i * 256 + tid; const unsigned pos = ctl[CW_OFFS + e[i]] + base[e[i]] + loc[i]; slot_ent[pos] = idx; slot_w[pos] = topk_w[idx]; }
}

__global__ __launch_bounds__(256) void k_final(float* __restrict__ io, const unsigned char* __restrict__ ybuf, const float* __restrict__ g, const float* __restrict__ bb, const float* __restrict__ mod) {
    const int row = (blockIdx.x * 256 + threadIdx.x) >> 6, lane = threadIdx.x & 63, b = row >> 11;
    f32x4 v[4]; float s = 0.f;
#pragma unroll
    for (int j = 0; j < 4; ++j) {
        const int col = j * 256 + lane * 4;
        f32x4 a = (f32x4){0.f, 0.f, 0.f, 0.f};
#pragma unroll
        for (int k = 0; k < TOPK; ++k) {
            const unsigned pk = *(const unsigned*)(ybuf + ((size_t)row * TOPK + k) * D + col);
            const f32x2 lo = __builtin_amdgcn_cvt_pk_f32_fp8((int)pk, false), hi = __builtin_amdgcn_cvt_pk_f32_fp8((int)pk, true);
            a.x += lo.x; a.y += lo.y; a.z += hi.x; a.w += hi.y;
        }
        const f32x4 gt = *(const f32x4*)(mod + b * 6144 + MOD_GATE_F + col);
        v[j] = *(const f32x4*)(io + (size_t)row * D + col) + gt * a * YINV;
        s += (v[j].x + v[j].y) + (v[j].z + v[j].w);
    }
    const float mean = wave_sum(s) * (1.f / D); float s2 = 0.f;
#pragma unroll
    for (int j = 0; j < 4; ++j) { v[j] = v[j] - mean; s2 += (v[j].x * v[j].x + v[j].y * v[j].y) + (v[j].z * v[j].z + v[j].w * v[j].w); }
    const float rstd = 1.f / sqrtf(wave_sum(s2) * (1.f / D) + LN_EPS);
#pragma unroll
    for (int j = 0; j < 4; ++j) { const int col = j * 256 + lane * 4; const f32x4 gg = *(const f32x4*)(g + col), bv = *(const f32x4*)(bb + col);
        *(f32x4*)(io + (size_t)row * D + col) = v[j] * rstd * gg + bv; }
}

extern "C" void kernel_launch(void* const* d_in, const int* in_sizes, int n_in, void* d_out, int out_size, void* d_ws, size_t ws_size, hipStream_t stream) {
    if (n_in != 21 || in_sizes[0] != M * D || out_size != M * D || ws_size < WS_END) { fprintf(stderr, "kernel_launch: unexpected shapes (n_in %d, ws %zu)\n", n_in, ws_size); return; }
    const float* x = (const float*)d_in[0]; const float* c = (const float*)d_in[1]; const float* w_ada = (const float*)d_in[2]; const float* b_ada = (const float*)d_in[3];
    const float* w_in = (const float*)d_in[4]; const float* w_out = (const float*)d_in[5]; const float* na_rpb = (const float*)d_in[6]; const float* ret_ld = (const float*)d_in[7];
    const float* ret_gn = (const float*)d_in[8]; const float* ln1_g = (const float*)d_in[9]; const float* ln1_b = (const float*)d_in[10]; const float* ln2_g = (const float*)d_in[11];
    const float* ln2_b = (const float*)d_in[12]; const float* w_router = (const float*)d_in[13]; const float* rbias = (const float*)d_in[14]; const float* w_gate = (const float*)d_in[15];
    const float* w_up = (const float*)d_in[16]; const float* w_down = (const float*)d_in[17]; const float* ws_gate = (const float*)d_in[18]; const float* ws_up = (const float*)d_in[19];
    const float* ws_down = (const float*)d_in[20];
    unsigned char* ws = (unsigned char*)d_ws; float* out = (float*)d_out;
    unsigned* ctl = (unsigned*)(ws + WS_CTL); float* mod = (float*)(ws + WS_MOD); float* rope = (float*)(ws + WS_ROPE);
    bf16_t* win_t = (bf16_t*)(ws + WS_WIN_T); bf16_t* wout_t = (bf16_t*)(ws + WS_WOUT_T); bf16_t* wr_t = (bf16_t*)(ws + WS_WR_T);
    bf16_t* wsgu_t = (bf16_t*)(ws + WS_WSGU_T); bf16_t* wsd_t = (bf16_t*)(ws + WS_WSD_T); bf16_t* wd_t = (bf16_t*)(ws + WS_WD_T); bf16_t* wgu_t = (bf16_t*)(ws + WS_WGU_T);
    int* slot_ent = (int*)(ws + WS_SLOT_ENT); float* slot_w = (float*)(ws + WS_SLOT_W); int* topk_e = (int*)(ws + WS_TOPK_E); float* topk_w = (float*)(ws + WS_TOPK_W);
    bf16_t* ymix = (bf16_t*)(ws + WS_YMIX); bf16_t* proj = (bf16_t*)(ws + WS_PROJ); bf16_t* hbuf = (bf16_t*)(ws + WS_YMIX);
    float* logits = (float*)(ws + WS_LOGITS); bf16_t* shh = (bf16_t*)(ws + WS_SHH); bf16_t* hf = (bf16_t*)(ws + WS_HF); bf16_t* act = (bf16_t*)(ws + WS_ACT);
    unsigned char* ybuf = ws + WS_YBUF;

    hipMemsetAsync(ws + WS_CTL, 0, 1 * MiB, stream);
    k_convert_t<<<dim3(DIN / 64, D / 64, 1), 256, 0, stream>>>(w_in, win_t, D, DIN, 0, 0, 0, 0, 0);
    k_convert_t<<<dim3(D / 64, D / 64, 1), 256, 0, stream>>>(w_out, wout_t, D, D, 0, 0, 0, 0, 0);
    k_convert_t<<<dim3(NE / 64, D / 64, 1), 256, 0, stream>>>(w_router, wr_t, D, NE, 0, 0, 0, 0, 0);
    k_convert_t<<<dim3(DE / 64, D / 64, 1), 256, 0, stream>>>(ws_gate, wsgu_t, D, DE, 32, 0, 0, 0, 0);
    k_convert_t<<<dim3(DE / 64, D / 64, 1), 256, 0, stream>>>(ws_up, wsgu_t, D, DE, 32, 1, 0, 0, 0);
    k_convert_t<<<dim3(D / 64, DE / 64, 1), 256, 0, stream>>>(ws_down, wsd_t, DE, D, 0, 0, 0, 0, 0);
    k_convert_t<<<dim3(DE / 64, D / 64, NE), 256, 0, stream>>>(w_gate, wgu_t, D, DE, 32, 0, 0, (size_t)D * DE, (size_t)512 * D);
    k_convert_t<<<dim3(DE / 64, D / 64, NE), 256, 0, stream>>>(w_up, wgu_t, D, DE, 32, 1, 0, (size_t)D * DE, (size_t)512 * D);
    k_convert_t<<<dim3(D / 64, DE / 64, NE), 256, 0, stream>>>(w_down, wd_t, DE, D, 0, 0, 0, (size_t)DE * D, (size_t)D * DE);
    k_rope<<<SEQ * 64 / 256, 256, 0, stream>>>(rope);
    k_mod<<<6144 / 256, 256, 0, stream>>>(c, w_ada, b_ada, mod);
    k_modx<<<M * D / 4 / 256, 256, 0, stream>>>(x, mod, hbuf);
    { PInProj p{hbuf, win_t, proj, 0, 0}; k_gemm128<PInProj><<<(M / 128) * (DIN / 128), 256, 0, stream>>>(p); }
    k_na<<<M * 8 / 256, 256, 0, stream>>>(proj, na_rpb, ymix);
    k_ret<<<BATCH * 4 * 2, 256, 0, stream>>>(proj, rope, ret_ld, out  );
    k_ret_fin<<<M * 4 * 64 / 256, 256, 0, stream>>>(out, proj, ret_gn, ymix);
    { POutProj p{ymix, wout_t, x, mod, out, 0, 0}; k_gemm128<POutProj><<<(M / 128) * 8, 256, 0, stream>>>(p); }
    k_ln1<<<M * 64 / 256, 256, 0, stream>>>(out, ln1_g, ln1_b, mod, hf);
    { PRouter p{hf, wr_t, logits, 0, 0}; k_gemm128<PRouter><<<(M / 128) * 2, 256, 0, stream>>>(p); }
    { PSharedGU p{hf, wsgu_t, shh, 0, 0}; k_gemm128<PSharedGU><<<(M / 128) * 4, 256, 0, stream>>>(p); }
    k_route<<<M / 64, 256, 0, stream>>>(logits, rbias, topk_e, topk_w, ctl);
    k_offsets<<<1, 256, 0, stream>>>(ctl);
    k_fill<<<NSLOT / 1024, 256, 0, stream>>>(topk_e, topk_w, ctl, slot_ent, slot_w);
    constexpr int MAXT128 = NSLOT / 128 + NE;
    { PExpGU p{hf, wgu_t, ctl, slot_ent, slot_w, act, 0, 0, 0, 0, 0, 0}; k_gemm128<PExpGU><<<MAXT128 * 4, 256, 0, stream>>>(p); }
    { PSharedDown p{shh, wsd_t, mod, out, 0, 0}; k_gemm128<PSharedDown><<<(M / 128) * 8, 256, 0, stream>>>(p); }
    { PExpDown p{act, wd_t, ctl, slot_ent, ybuf, 0, 0, 0, 0, 0, 0}; k_gemm128<PExpDown><<<MAXT128 * 8, 256, 0, stream>>>(p); }
    k_final<<<M * 64 / 256, 256, 0, stream>>>(out, ybuf, ln2_g, ln2_b, mod);
}
```

```cpp
#include <hip/hip_runtime.h>
#include <cstdio>
#include <cstdint>

typedef unsigned short bf16_t;
typedef short bf16x8 __attribute__((ext_vector_type(8)));
typedef float f32x4 __attribute__((ext_vector_type(4)));
typedef float f32x2 __attribute__((ext_vector_type(2)));
typedef unsigned u32x4 __attribute__((ext_vector_type(4)));
typedef unsigned u32x2 __attribute__((ext_vector_type(2)));
#define LAS __attribute__((address_space(3)))

constexpr int D = 1024, BATCH = 32, SEQ = 2048, M = BATCH * SEQ;
constexpr int DIN = 3584;
constexpr int OFF_QNA = 0, OFF_KNA = 512, OFF_VNA = 1024, OFF_QR = 1536, OFF_KR = 2048, OFF_VR = 2560, OFF_GR = 3072;
constexpr int NE = 256, TOPK = 8, DE = 256;
constexpr int NSLOT = M * TOPK;
constexpr float LN_EPS = 1e-5f, GN_EPS = 1e-6f;
constexpr float ALPHA = 1.189207115002721f;
constexpr float YSCALE = 64.f, YINV = 1.f / 64.f;
constexpr int MOD_SHIFT_A = 0, MOD_SCALE_A = 1024, MOD_GATE_A = 2048, MOD_SHIFT_F = 3072, MOD_SCALE_F = 4096, MOD_GATE_F = 5120;

constexpr size_t MiB = 1u << 20;
constexpr size_t WS_CTL = 0;
constexpr size_t WS_MOD = 1 * MiB;
constexpr size_t WS_ROPE = 2 * MiB;
constexpr size_t WS_WIN_T = 4 * MiB;
constexpr size_t WS_WOUT_T = 11 * MiB;
constexpr size_t WS_WR_T = 13 * MiB;
constexpr size_t WS_WSGU_T = 14 * MiB;
constexpr size_t WS_WSD_T = 15 * MiB;
constexpr size_t WS_SLOT_ENT = 16 * MiB;
constexpr size_t WS_SLOT_W = 18 * MiB;
constexpr size_t WS_TOPK_E = 20 * MiB;
constexpr size_t WS_TOPK_W = 22 * MiB;
constexpr size_t WS_WD_T = 32 * MiB;
constexpr size_t WS_WGU_T = 160 * MiB;
constexpr size_t WS_YMIX = 416 * MiB;
constexpr size_t WS_PROJ = 544 * MiB;
constexpr size_t WS_LOGITS = WS_YMIX, WS_SHH = WS_YMIX + 64 * MiB;
constexpr size_t WS_HF = WS_PROJ, WS_ACT = WS_PROJ + 128 * MiB;
constexpr size_t WS_YBUF = WS_WGU_T;
constexpr size_t WS_END = 992 * MiB;
constexpr int CW_COUNT = 1024, CW_CURSOR = 1536, CW_BAR = 8192;

constexpr int RING_BYTES = 131072;
constexpr int TAB_OFF = RING_BYTES;
constexpr int T_OFF = 0, T_TILE = 260, T_CNT = 520, T_HIST = 776, T_BASE = 1032, TAB_WORDS = 1288;
constexpr int MISC_OFF = TAB_OFF + 6144;
constexpr int VN_OFF = MISC_OFF + 256;
constexpr int LDS_BYTES = 147456;
static_assert(TAB_WORDS * 4 <= 6144 && VN_OFF + 8192 <= LDS_BYTES, "LDS map");

__device__ __forceinline__ unsigned f2bf(float f) { unsigned u = __float_as_uint(f); return (u + 0x7fffu + ((u >> 16) & 1u)) >> 16; }
__device__ __forceinline__ float bf2f(unsigned short h) { return __uint_as_float(((unsigned)h) << 16); }
__device__ __forceinline__ unsigned pk2(float lo, float hi) { return f2bf(lo) | (f2bf(hi) << 16); }
__device__ __forceinline__ unsigned cvt_pk_bf16(float lo, float hi) { unsigned r; asm volatile("v_cvt_pk_bf16_f32 %0, %1, %2" : "=v"(r) : "v"(lo), "v"(hi)); return r; }
__device__ __forceinline__ float silu_f(float v) { return v / (1.f + __expf(-v)); }
__device__ __forceinline__ float wave_sum(float v) {
#pragma unroll
    for (int o = 1; o < 64; o <<= 1) v += __shfl_xor(v, o);
    return v;
}
__device__ __forceinline__ float clamp8(float v) { return fminf(fmaxf(v, -440.f), 440.f); }
#define LDS_WAIT() asm volatile("s_waitcnt lgkmcnt(0)" ::: "memory")

#define XB_TMO      128
#define XB_XCNT(j)  (256  + 64 * (j))
#define XB_XSUB(j)  (1280 + 64 * (j))
#define XB_XGEN(j)  (2304 + 64 * (j))
#define XB_TOP      3328
#define XB_TOPGEN   3392
#define XCD_BAR_WORDS 3456
#define XB_SPIN_CAP (1u << 23)
__device__ __forceinline__ unsigned xb_ld(unsigned* p)              { return __hip_atomic_load(p, __ATOMIC_RELAXED, __HIP_MEMORY_SCOPE_AGENT); }
__device__ __forceinline__ unsigned xb_add(unsigned* p, unsigned v) { return __hip_atomic_fetch_add(p, v, __ATOMIC_RELAXED, __HIP_MEMORY_SCOPE_AGENT); }
__device__ __forceinline__ unsigned xb_xcc_id() { return (unsigned)__builtin_amdgcn_s_getreg((3 << 11) | 20) & 0xFu; }
#define XB_SPIN(cond, bar) do { unsigned _sp = 0; while (cond) { __builtin_amdgcn_s_sleep(1); \
    if ((++_sp & 255u) == 0u) { if (xb_ld(&(bar)[XB_TMO])) break; if (_sp > XB_SPIN_CAP) { atomicAdd(&(bar)[XB_TMO], 1u); break; } } } } while (0)
struct XcdBarrier { unsigned* bar; unsigned x; volatile LAS unsigned* st; };
__device__ __forceinline__ XcdBarrier xcd_barrier_post(unsigned* bar, volatile LAS unsigned* st) {
    XcdBarrier b; b.bar = bar; b.x = xb_xcc_id(); b.st = st;
    if (threadIdx.x == 0) (void)xb_add(&bar[XB_XCNT(b.x)], 1u);
    return b;
}
__device__ __forceinline__ void xcd_barrier_complete(unsigned* bar, unsigned x, unsigned& nloc, unsigned& nx) {
    const unsigned G = gridDim.x * gridDim.y * gridDim.z;
    unsigned sum, cnt, mine, sp = 0u;
    for (;;) {
        sum = 0u; cnt = 0u; mine = 0u;
#pragma unroll
        for (unsigned j = 0; j < 16; ++j) { const unsigned c = xb_ld(&bar[XB_XCNT(j)]); sum += c; cnt += (c > 0u) ? 1u : 0u; mine = (j == x) ? c : mine; }
        if (sum == G) break;
        __builtin_amdgcn_s_sleep(1);
        if ((++sp & 255u) == 0u) { if (xb_ld(&bar[XB_TMO])) break; if (sp > XB_SPIN_CAP) { atomicAdd(&bar[XB_TMO], 1u); break; } }
    }
    nloc = mine > 0u ? mine : 1u; nx = cnt > 0u ? cnt : 1u;
}
__device__ __forceinline__ void xcd_barrier(const XcdBarrier& b) {
    asm volatile("s_waitcnt vmcnt(0)" ::: "memory");
    __syncthreads();
    if (threadIdx.x == 0) {
        unsigned* bar = b.bar;
        __builtin_amdgcn_s_waitcnt(0);
        unsigned nloc = b.st[0], nx = b.st[1];
        if (nloc == 0u) { xcd_barrier_complete(bar, b.x, nloc, nx); b.st[0] = nloc; b.st[1] = nx; }
        const unsigned old = xb_add(&bar[XB_XSUB(b.x)], 1u);
        const unsigned gen = old / nloc;
        if (old + 1u == (gen + 1u) * nloc) {
            __builtin_amdgcn_fence(__ATOMIC_RELEASE, "agent");
            asm volatile("s_waitcnt vmcnt(0)" ::: "memory");
            const unsigned og = xb_add(&bar[XB_TOP], 1u);
            const unsigned tg = og / nx;
            if (og + 1u == (tg + 1u) * nx) xb_add(&bar[XB_TOPGEN], 1u);
            else XB_SPIN(xb_ld(&bar[XB_TOPGEN]) == tg, bar);
            __builtin_amdgcn_fence(__ATOMIC_ACQUIRE, "agent");
            xb_add(&bar[XB_XGEN(b.x)], 1u);
            asm volatile("s_waitcnt vmcnt(0)" ::: "memory");
        } else {
            XB_SPIN(xb_ld(&bar[XB_XGEN(b.x)]) == gen, bar);
            __builtin_amdgcn_fence(__ATOMIC_ACQUIRE, "agent");
            asm volatile("s_waitcnt vmcnt(0)" ::: "memory");
        }
    }
    __syncthreads();
}

namespace pg8 {
constexpr int BM = 256, BK = 64, HALF = 128, HTB = HALF * BK * 2, STAGE_BYTES = 8 * HTB;
__device__ __forceinline__ int lds_byte(int r, int c) { const int st = (r >> 4) * 2 + (c >> 5), rr = r & 15, cc = c & 31, ob = rr * 64 + cc * 2; return st * 1024 + (ob ^ (((ob >> 9) & 1) << 5)); }
__device__ __forceinline__ void stage_rc(int b, int& R, int& C) { const int st = b / 1024, sb = b % 1024, swz = sb ^ (((sb >> 9) & 1) << 5); R = (st >> 1) * 16 + swz / 64; C = (st & 1) * 32 + (swz % 64) / 2; }
__device__ __forceinline__ int perm32(int rho) { const int n = rho >> 4, i = rho & 15; return 8 * (i >> 2) + 4 * n + (i & 3); }

struct Unit { int pm, pn; const char* B; int e, cnt, off; };

template <class Epi, class Sched>
__device__ __forceinline__ void gemm_phase(LAS unsigned char* lds, const char* Abase, const int K, const Sched& S, const Epi& E) {
    int tid_ = threadIdx.x; asm volatile("" : "+v"(tid_));
    const int tid = tid_, wid = __builtin_amdgcn_readfirstlane(tid >> 6), lane = tid & 63, wr = wid >> 2, wc = wid & 3, fr = lane & 15, fq = lane >> 4;
    const int nt = K / BK;
    int Rr[2], Cc[2]; unsigned voffB[2], voffA[2];
#pragma unroll
    for (int i = 0; i < 2; ++i) { int R, C; stage_rc(tid * 16 + i * 8192, R, C); Rr[i] = R; Cc[i] = C; const int Rb = Epi::PERM ? ((R & ~31) + perm32(R & 31)) : R; voffB[i] = (unsigned)(Rb * K + C) * 2u; voffA[i] = (unsigned)(R * K + C) * 2u; }
    constexpr bool GATHER = Sched::GATHER;
    const size_t kstep = (size_t)(BK * 2);
    const size_t hstep = (size_t)HALF * K * 2;
    const unsigned ldsw = (unsigned)wid * 1024u;
    const int aoff = lds_byte(wr * 64 + fr, fq * 8), boff = lds_byte(wc * 32 + fr, fq * 8);
#define PG8_SA(b, h) (((b) * 2 + (h)) * HTB)
#define PG8_SB(b, h) ((4 + (b) * 2 + (h)) * HTB)
#define PG8_STAGE(bufoff, gbase, voff) do { _Pragma("unroll") for (int _i = 0; _i < 2; ++_i) \
        __builtin_amdgcn_global_load_lds((const unsigned*)((const char*)(gbase) + (voff)[_i]), (LAS unsigned*)(lds + (bufoff) + ldsw + _i * 8192), 16, 0, 0); } while (0)
#define PG8_STAGEA(bufoff, uptr, koff, NEXT, h) do { if constexpr (GATHER) { if (NEXT) { const u32x2 _t = *(const LAS u32x2*)(vnslot + 2 * (h)); unsigned _v[2] = {_t.x, _t.y}; PG8_STAGE(bufoff, Abase + (koff), _v); } else { PG8_STAGE(bufoff, Abase + (koff), vc[h]); } } \
        else { PG8_STAGE(bufoff, (uptr) + (size_t)(h) * hstep + (koff), voffA); } } while (0)
#define PG8_LDA(dst, b, h) do { _Pragma("unroll") for (int m = 0; m < 4; ++m) _Pragma("unroll") for (int k = 0; k < 2; ++k) dst[m][k] = *(const LAS bf16x8*)(lds + PG8_SA(b, h) + aoff + m * 2048 + k * 1024); } while (0)
#define PG8_LDB(dst, b, h) do { _Pragma("unroll") for (int n = 0; n < 2; ++n) _Pragma("unroll") for (int k = 0; k < 2; ++k) dst[n][k] = *(const LAS bf16x8*)(lds + PG8_SB(b, h) + boff + n * 2048 + k * 1024); } while (0)
#define PG8_MMA(ai, bj, At, Bt) do { __builtin_amdgcn_s_setprio(1); _Pragma("unroll") for (int m = 0; m < 4; ++m) _Pragma("unroll") for (int n = 0; n < 2; ++n) _Pragma("unroll") for (int k = 0; k < 2; ++k) \
        acc[ai][bj][m][n] = __builtin_amdgcn_mfma_f32_16x16x32_bf16(Bt[n][k], At[m][k], acc[ai][bj][m][n], 0, 0, 0); __builtin_amdgcn_s_setprio(0); } while (0)
#define PG8_WAIT_V(n) asm volatile("s_waitcnt vmcnt(" #n ")" ::: "memory")
#define PG8_WAIT_L(n) asm volatile("s_waitcnt lgkmcnt(" #n ")" ::: "memory")
#define PG8_BAR __builtin_amdgcn_s_barrier()
#define PG8_SCHED __builtin_amdgcn_sched_barrier(0)
    Unit cur, nxt; int ui = 0;
    if (!S.next(0, cur)) return;
    f32x4 acc[2][2][4][2];
#pragma unroll
    for (int a = 0; a < 2; ++a)
#pragma unroll
        for (int b = 0; b < 2; ++b)
#pragma unroll
            for (int m = 0; m < 4; ++m)
#pragma unroll
                for (int n = 0; n < 2; ++n) acc[a][b][m][n] = (f32x4){0.f, 0.f, 0.f, 0.f};
    bf16x8 At[4][2], B0[2][2], B1[2][2];
    unsigned vc[2][2];
    LAS unsigned* vnslot = (LAS unsigned*)(lds + (VN_OFF - 0)) + tid * 4;
    if constexpr (GATHER) S.avoff(cur, Rr, Cc, vc);
    const char* cB = cur.B; const char* cA = Abase + S.aoff(cur);
    PG8_STAGE(PG8_SB(0, 0), cB, voffB); PG8_STAGE(PG8_SB(0, 1), cB + hstep, voffB); PG8_STAGEA(PG8_SA(0, 0), cA, 0, false, 0); PG8_STAGEA(PG8_SA(0, 1), cA, 0, false, 1);
    if (wr == 1) PG8_BAR;
    PG8_WAIT_V(2); PG8_BAR;
    PG8_STAGE(PG8_SB(1, 0), cB + kstep, voffB); PG8_STAGEA(PG8_SA(1, 0), cA, kstep, false, 0); PG8_STAGE(PG8_SB(1, 1), cB + hstep + kstep, voffB);
    PG8_WAIT_V(6); PG8_BAR;
    for (;;) {
        const bool has_next = S.next(ui + 1, nxt);
        if constexpr (GATHER) {
            unsigned vn[2][2];
            if (has_next) S.avoff(nxt, Rr, Cc, vn);
            else {
#pragma unroll
                for (int h = 0; h < 2; ++h)
#pragma unroll
                    for (int i = 0; i < 2; ++i) vn[h][i] = vc[h][i];
            }
            *(LAS u32x4*)vnslot = (u32x4){vn[0][0], vn[0][1], vn[1][0], vn[1][1]};
        }
        const char* nB = has_next ? nxt.B : cB; const char* nA = has_next ? Abase + S.aoff(nxt) : cA;
        for (int t = 0; t < nt; t += 2) {
            const bool last = (t == nt - 2);
            const size_t k1 = (size_t)(t + 1) * kstep;
            const size_t k2 = last ? (size_t)0 : (size_t)(t + 2) * kstep, k3 = k2 + kstep;
            const char* u2 = last ? nA : cA; const char* b2 = last ? nB : cB + (size_t)(t + 2) * kstep;
            const char* b3 = b2 + kstep;
            PG8_LDB(B0, 0, 0); PG8_LDB(B1, 0, 1); PG8_SCHED; PG8_LDA(At, 0, 0); PG8_STAGEA(PG8_SA(1, 1), cA, k1, false, 1);
            PG8_WAIT_V(8); PG8_WAIT_L(0); PG8_BAR; PG8_MMA(0, 0, At, B0); PG8_MMA(0, 1, At, B1); PG8_BAR; PG8_SCHED;
            PG8_LDA(At, 0, 1); PG8_STAGE(PG8_SB(0, 0), b2, voffB); PG8_STAGE(PG8_SB(0, 1), b2 + hstep, voffB); PG8_STAGEA(PG8_SA(0, 0), u2, k2, last, 0);
            PG8_WAIT_V(8); PG8_WAIT_L(0); PG8_BAR; PG8_MMA(1, 0, At, B0); PG8_MMA(1, 1, At, B1); PG8_BAR; PG8_SCHED;
            PG8_LDB(B0, 1, 0); PG8_LDB(B1, 1, 1); PG8_SCHED; PG8_LDA(At, 1, 0); PG8_STAGEA(PG8_SA(0, 1), u2, k2, last, 1);
            PG8_WAIT_V(8); PG8_WAIT_L(0); PG8_BAR; PG8_MMA(0, 0, At, B0); PG8_MMA(0, 1, At, B1); PG8_BAR; PG8_SCHED;
            PG8_LDA(At, 1, 1); PG8_STAGE(PG8_SB(1, 0), b3, voffB); PG8_STAGE(PG8_SB(1, 1), b3 + hstep, voffB); PG8_STAGEA(PG8_SA(1, 0), u2, k3, last, 0);
            PG8_WAIT_V(8); PG8_WAIT_L(0); PG8_BAR; PG8_MMA(1, 0, At, B0); PG8_MMA(1, 1, At, B1); PG8_BAR; PG8_SCHED;
        }
        if (wr == 0) PG8_BAR;
        E(acc, cur, wr, wc, fr, fq);
        if (!has_next) break;
#pragma unroll
        for (int a = 0; a < 2; ++a)
#pragma unroll
            for (int b = 0; b < 2; ++b)
#pragma unroll
                for (int m = 0; m < 4; ++m)
#pragma unroll
                    for (int n = 0; n < 2; ++n) acc[a][b][m][n] = (f32x4){0.f, 0.f, 0.f, 0.f};
        cur = nxt; cB = nB; cA = nA; ++ui;
        if constexpr (GATHER) { const u32x4 _t = *(const LAS u32x4*)vnslot; vc[0][0] = _t.x; vc[0][1] = _t.y; vc[1][0] = _t.z; vc[1][1] = _t.w; }
        if (wr == 1) PG8_BAR;
    }
    PG8_WAIT_V(0);
    PG8_BAR;
#undef PG8_SA
#undef PG8_SB
#undef PG8_STAGE
#undef PG8_STAGEA
#undef PG8_LDA
#undef PG8_LDB
#undef PG8_MMA
#undef PG8_WAIT_V
#undef PG8_WAIT_L
#undef PG8_BAR
#undef PG8_SCHED
}

struct DenseOrder {
    int nM, nN, nwg, G, c, K; const char* Bt;
    __device__ void init(int Mrows, int N, int K_, const void* Bt_, int G_, int c_) { nM = Mrows / BM; nN = N / BM; nwg = nM * nN; G = G_; c = c_; K = K_; Bt = (const char*)Bt_; }
    __device__ __forceinline__ bool next(int i, Unit& u) const {
        const long L = (long)i * G + c; if (L >= nwg) return false;
        int wgid = (int)L; { const int q = nwg / 8, r = nwg % 8, xcd = wgid % 8, off = wgid / 8; wgid = (xcd < r ? xcd * (q + 1) : r * (q + 1) + (xcd - r) * q) + off; }
        const int nig = 8 * nN, gid = wgid / nig, fm = gid * 8, gsz = (nM - fm) < 8 ? (nM - fm) : 8;
        u.pm = fm + ((wgid % nig) % gsz); u.pn = (wgid % nig) / gsz; u.B = Bt + (size_t)u.pn * BM * K * 2; u.e = 0; u.cnt = 0; u.off = 0; return true;
    }
    static constexpr bool GATHER = false;
    __device__ __forceinline__ size_t aoff(const Unit& u) const { return (size_t)u.pm * BM * K * 2; }
    __device__ __forceinline__ void avoff(const Unit&, const int (&)[2], const int (&)[2], unsigned (&)[2][2]) const {}
};
template <int NCOL, bool TOKROWS> struct ExpertOrder {
    static constexpr bool GATHER = true;
    __device__ __forceinline__ size_t aoff(const Unit&) const { return 0; }
    const LAS unsigned* tab; int per, c, K; const char* W; size_t wstride; const int* slot_ent;
    __device__ void init(const LAS unsigned* tab_, int K_, const void* W_, size_t wstride_, const int* slot_ent_, int G, int c_) {
        tab = tab_; K = K_; W = (const char*)W_; wstride = wstride_; slot_ent = slot_ent_; c = c_;
        const int U = (int)tab[T_TILE + NE] * NCOL; per = (U + G - 1) / G;
    }
    __device__ __forceinline__ bool next(int i, Unit& u) const {
        const int U = (int)tab[T_TILE + NE] * NCOL; const int L = c * per + i;
        if (i >= per || L >= U) return false;
        const int tile = L / NCOL; u.pn = L % NCOL;
        int lo = 0, hi = NE - 1;
        while (lo < hi) { const int mid = (lo + hi + 1) >> 1; if ((int)tab[T_TILE + mid] <= tile) lo = mid; else hi = mid - 1; }
        u.e = lo; u.pm = tile - (int)tab[T_TILE + lo]; u.cnt = (int)tab[T_CNT + lo]; u.off = (int)tab[T_OFF + lo];
        u.B = W + (size_t)lo * wstride + (size_t)u.pn * BM * K * 2; return true;
    }
    __device__ __forceinline__ void avoff(const Unit& u, const int (&)[2], const int (&)[2], unsigned (&v)[2][2]) const {
        int R[2], C[2]; int tidq = threadIdx.x; asm volatile("" : "+v"(tidq));
#pragma unroll
        for (int i = 0; i < 2; ++i) stage_rc(tidq * 16 + i * 8192, R[i], C[i]);
#pragma unroll
        for (int h = 0; h < 2; ++h)
#pragma unroll
            for (int i = 0; i < 2; ++i) {
                int r = u.pm * BM + h * HALF + R[i]; if (r >= u.cnt) r = u.cnt - 1;
                const int slot = u.off + r;
                const int row = TOKROWS ? (slot_ent[slot] >> 3) : slot;
                v[h][i] = (unsigned)(row * K + C[i]) * 2u;
            }
    }
};

struct EpiInProj {
    static constexpr bool PERM = true; bf16_t* O;
    __device__ __forceinline__ void operator()(const f32x4 (&acc)[2][2][4][2], const Unit& u, int wr, int wc, int fr, int fq) const {
        const float sc = (u.pn < 2) ? 0.125f : ((u.pn == 8 || u.pn == 9) ? 0.08838834764831845f : 1.f);
        const int row0 = u.pm * BM + wr * 64 + fr, col0 = u.pn * BM + wc * 32 + 8 * fq;
#pragma unroll
        for (int ai = 0; ai < 2; ++ai)
#pragma unroll
            for (int m = 0; m < 4; ++m) { bf16_t* rowp = O + (size_t)(row0 + ai * HALF + m * 16) * DIN + col0;
#pragma unroll
                for (int bj = 0; bj < 2; ++bj) { const f32x4 v0 = acc[ai][bj][m][0] * sc, v1 = acc[ai][bj][m][1] * sc;
                    u32x4 w; w.x = cvt_pk_bf16(v0[0], v0[1]); w.y = cvt_pk_bf16(v0[2], v0[3]); w.z = cvt_pk_bf16(v1[0], v1[1]); w.w = cvt_pk_bf16(v1[2], v1[3]);
                    *(u32x4*)(rowp + bj * HALF) = w; } }
    }
};
struct EpiOutProj {
    static constexpr bool PERM = false; const float* x; const float* mod; float* out;
    __device__ __forceinline__ void operator()(const f32x4 (&acc)[2][2][4][2], const Unit& u, int wr, int wc, int fr, int fq) const {
        const int b = (u.pm * BM) >> 11; const int col0 = u.pn * BM + wc * 32 + 4 * fq;
#pragma unroll
        for (int bj = 0; bj < 2; ++bj)
#pragma unroll
            for (int n = 0; n < 2; ++n) { const int col = col0 + bj * HALF + n * 16; const f32x4 g = *(const f32x4*)(mod + b * 6144 + MOD_GATE_A + col);
#pragma unroll
                for (int ai = 0; ai < 2; ++ai)
#pragma unroll
                    for (int m = 0; m < 4; ++m) { const size_t o = (size_t)(u.pm * BM + ai * HALF + wr * 64 + m * 16 + fr) * D + col;
                        const f32x4 xv = *(const f32x4*)(x + o); *(f32x4*)(out + o) = xv * ALPHA + g * acc[ai][bj][m][n]; } }
    }
};
struct EpiRouter {
    static constexpr bool PERM = false; float* out;
    __device__ __forceinline__ void operator()(const f32x4 (&acc)[2][2][4][2], const Unit& u, int wr, int wc, int fr, int fq) const {
        const int col0 = wc * 32 + 4 * fq;
#pragma unroll
        for (int ai = 0; ai < 2; ++ai)
#pragma unroll
            for (int m = 0; m < 4; ++m) { float* rowp = out + (size_t)(u.pm * BM + ai * HALF + wr * 64 + m * 16 + fr) * NE + col0;
#pragma unroll
                for (int bj = 0; bj < 2; ++bj)
#pragma unroll
                    for (int n = 0; n < 2; ++n) *(f32x4*)(rowp + bj * HALF + n * 16) = acc[ai][bj][m][n]; }
    }
};
template <bool EXPERT> struct EpiGU {
    static constexpr bool PERM = true; bf16_t* O; const float* slot_w;
    __device__ __forceinline__ void operator()(const f32x4 (&acc)[2][2][4][2], const Unit& u, int wr, int wc, int fr, int fq) const {
        const int h0 = u.pn * HALF + wc * 32 + 8 * fq;
#pragma unroll
        for (int ai = 0; ai < 2; ++ai)
#pragma unroll
            for (int m = 0; m < 4; ++m) {
                const int rt = u.pm * BM + ai * HALF + wr * 64 + m * 16 + fr;
                float w = 1.f; size_t orow = (size_t)rt;
                if (EXPERT) { if (rt >= u.cnt) continue; w = slot_w[u.off + rt]; orow = (size_t)(u.off + rt); }
                const f32x4 g0 = acc[ai][0][m][0], g1 = acc[ai][0][m][1], u0 = acc[ai][1][m][0], u1 = acc[ai][1][m][1];
                u32x4 o;
                o.x = cvt_pk_bf16(w * silu_f(g0[0]) * u0[0], w * silu_f(g0[1]) * u0[1]); o.y = cvt_pk_bf16(w * silu_f(g0[2]) * u0[2], w * silu_f(g0[3]) * u0[3]);
                o.z = cvt_pk_bf16(w * silu_f(g1[0]) * u1[0], w * silu_f(g1[1]) * u1[1]); o.w = cvt_pk_bf16(w * silu_f(g1[2]) * u1[2], w * silu_f(g1[3]) * u1[3]);
                *(u32x4*)(O + orow * DE + h0) = o;
            }
    }
};
struct EpiSharedDown {
    static constexpr bool PERM = false; const float* mod; float* out;
    __device__ __forceinline__ void operator()(const f32x4 (&acc)[2][2][4][2], const Unit& u, int wr, int wc, int fr, int fq) const {
        const int b = (u.pm * BM) >> 11; const int col0 = u.pn * BM + wc * 32 + 4 * fq;
#pragma unroll
        for (int bj = 0; bj < 2; ++bj)
#pragma unroll
            for (int n = 0; n < 2; ++n) { const int col = col0 + bj * HALF + n * 16; const f32x4 g = *(const f32x4*)(mod + b * 6144 + MOD_GATE_F + col);
#pragma unroll
                for (int ai = 0; ai < 2; ++ai)
#pragma unroll
                    for (int m = 0; m < 4; ++m) { const size_t o = (size_t)(u.pm * BM + ai * HALF + wr * 64 + m * 16 + fr) * D + col;
                        const f32x4 xv = *(const f32x4*)(out + o); *(f32x4*)(out + o) = xv * ALPHA + g * acc[ai][bj][m][n]; } }
    }
};
struct EpiExpDown {
    static constexpr bool PERM = true; unsigned char* ybuf; const int* slot_ent;
    __device__ __forceinline__ void operator()(const f32x4 (&acc)[2][2][4][2], const Unit& u, int wr, int wc, int fr, int fq) const {
        const int col0 = u.pn * BM + wc * 32 + 8 * fq;
#pragma unroll
        for (int ai = 0; ai < 2; ++ai)
#pragma unroll
            for (int m = 0; m < 4; ++m) {
                const int rt = u.pm * BM + ai * HALF + wr * 64 + m * 16 + fr; if (rt >= u.cnt) continue;
                unsigned char* rowp = ybuf + (size_t)slot_ent[u.off + rt] * D + col0;
#pragma unroll
                for (int bj = 0; bj < 2; ++bj) { const f32x4 v0 = acc[ai][bj][m][0] * YSCALE, v1 = acc[ai][bj][m][1] * YSCALE;
                    int w0 = __builtin_amdgcn_cvt_pk_fp8_f32(clamp8(v0[0]), clamp8(v0[1]), 0, false); w0 = __builtin_amdgcn_cvt_pk_fp8_f32(clamp8(v0[2]), clamp8(v0[3]), w0, true);
                    int w1 = __builtin_amdgcn_cvt_pk_fp8_f32(clamp8(v1[0]), clamp8(v1[1]), 0, false); w1 = __builtin_amdgcn_cvt_pk_fp8_f32(clamp8(v1[2]), clamp8(v1[3]), w1, true);
                    u32x2 o; o.x = (unsigned)w0; o.y = (unsigned)w1; *(u32x2*)(rowp + bj * HALF) = o; }
            }
    }
};
}

struct Ctx {
    const float *x, *c, *w_ada, *b_ada, *w_in, *w_out, *na_rpb, *ret_ld, *ret_gn, *ln1_g, *ln1_b, *ln2_g, *ln2_b, *w_router, *rbias, *w_gate, *w_up, *w_down, *ws_gate, *ws_up, *ws_down;
    float* out; unsigned char* ws;
};
constexpr int NW = 8;

__device__ __forceinline__ void transpose_item(const float* W, int K, int N, bf16_t* WT, int G, int which, LAS float* scr, int item, int lane) {
    const int nblk = N / 32, kb = item / nblk, nb = item % nblk, k0 = 64 * kb, n0 = 32 * nb;
#pragma unroll 8
    for (int i = 0; i < 32; ++i) { const int kk = 2 * i + (lane >> 5); scr[kk * 33 + (lane & 31)] = W[(size_t)(k0 + kk) * N + n0 + (lane & 31)]; }
    LDS_WAIT(); asm volatile("" ::: "memory");
    const int c = lane & 7;
#pragma unroll
    for (int j = 0; j < 4; ++j) { const int n = (lane >> 3) + 8 * j; const LAS float* s = scr + (8 * c) * 33 + n;
        u32x4 o; o.x = pk2(s[0 * 33], s[1 * 33]); o.y = pk2(s[2 * 33], s[3 * 33]); o.z = pk2(s[4 * 33], s[5 * 33]); o.w = pk2(s[6 * 33], s[7 * 33]);
        const int ng = n0 + n; const int drow = (G == 0) ? ng : ((ng / G) * 2 * G + which * G + (ng % G));
        *(u32x4*)(WT + (size_t)drow * K + k0 + 8 * c) = o; }
    LDS_WAIT(); asm volatile("" ::: "memory");
}
__device__ __forceinline__ void rope_entry(float* tab, int idx) {
    const int t = idx >> 6, i = idx & 63;
    const float inv_freq = powf(10000.f, -(float)(2 * i) / 128.f);
    const float ang = (float)t * inv_freq;
    const double a = (double)ang; const double two_pi = 6.283185307179586476925286766559;
    const double kf = rint(a / two_pi); double r = a - kf * two_pi;
    double sgn = 1.0; if (r > 1.5707963267948966) { r = 3.141592653589793 - r; sgn = -1.0; } else if (r < -1.5707963267948966) { r = -3.141592653589793 - r; sgn = -1.0; }
    const double r2 = r * r;
    const double s = r * (1.0 + r2 * (-1.0 / 6 + r2 * (1.0 / 120 + r2 * (-1.0 / 5040 + r2 * (1.0 / 362880 + r2 * (-1.0 / 39916800 + r2 * (1.0 / 6227020800.0 + r2 * (-1.0 / 1307674368000.0))))))));
    const double c = 1.0 + r2 * (-0.5 + r2 * (1.0 / 24 + r2 * (-1.0 / 720 + r2 * (1.0 / 40320 + r2 * (-1.0 / 3628800 + r2 * (1.0 / 479001600.0 + r2 * (-1.0 / 87178291200.0 + r2 * (1.0 / 20922789888000.0))))))));
    tab[idx] = (float)(sgn * c); tab[SEQ * 64 + idx] = (float)s;
}
__device__ __forceinline__ void mod_task(const float* __restrict__ cin, const float* __restrict__ w_ada, const float* __restrict__ b_ada, float* mod, int task, int lane) {
    const int j = task * 64 + lane;
    float acc[32];
#pragma unroll
    for (int b = 0; b < 32; ++b) acc[b] = 0.f;
    for (int k0 = 0; k0 < D; k0 += 64) {
        float cv[32];
#pragma unroll
        for (int b = 0; b < 32; ++b) cv[b] = silu_f(cin[b * D + k0 + lane]);
        for (int kk = 0; kk < 64; ++kk) {
            const float w = w_ada[(size_t)(k0 + kk) * 6144 + j];
#pragma unroll
            for (int b = 0; b < 32; ++b) acc[b] += __builtin_bit_cast(float, __builtin_amdgcn_readlane(__builtin_bit_cast(int, cv[b]), kk)) * w;
        }
    }
    const float bb = b_ada[j];
#pragma unroll
    for (int b = 0; b < 32; ++b) mod[b * 6144 + j] = acc[b] + bb;
}

__device__ __forceinline__ void na_item(const bf16_t* __restrict__ proj, const float* __restrict__ rpb, bf16_t* __restrict__ ymix, int gid) {
    const int h = gid & 7, tok = gid >> 3;
    const int b = tok >> 11, s = tok & 2047, r = s >> 6, c = s & 63;
    const int rs = min(max(r - 4, 0), 24), cs = min(max(c - 8, 0), 48);
    float q[64], acc[64];
    { const bf16_t* qp = proj + (size_t)tok * DIN + OFF_QNA + h * 64;
#pragma unroll
      for (int i = 0; i < 8; ++i) { const u32x4 v = *(const u32x4*)(qp + i * 8);
          q[i * 8 + 0] = __uint_as_float(v.x << 16); q[i * 8 + 1] = __uint_as_float(v.x & 0xffff0000u); q[i * 8 + 2] = __uint_as_float(v.y << 16); q[i * 8 + 3] = __uint_as_float(v.y & 0xffff0000u);
          q[i * 8 + 4] = __uint_as_float(v.z << 16); q[i * 8 + 5] = __uint_as_float(v.z & 0xffff0000u); q[i * 8 + 6] = __uint_as_float(v.w << 16); q[i * 8 + 7] = __uint_as_float(v.w & 0xffff0000u); } }
#pragma unroll
    for (int i = 0; i < 64; ++i) acc[i] = 0.f;
    float mx = -3.0e38f, l = 0.f;
    for (int kr = 0; kr < 8; ++kr) {
        for (int kc = 0; kc < 16; ++kc) {
            const int krow = rs + kr, kcol = cs + kc;
            const size_t kt = ((size_t)b << 11) + krow * 64 + kcol;
            const bf16_t* kp = proj + kt * DIN + OFF_KNA + h * 64; const bf16_t* vp = proj + kt * DIN + OFF_VNA + h * 64;
            float sc = 0.f;
#pragma unroll
            for (int i = 0; i < 8; ++i) { const u32x4 v = *(const u32x4*)(kp + i * 8);
                sc += q[i * 8 + 0] * __uint_as_float(v.x << 16) + q[i * 8 + 1] * __uint_as_float(v.x & 0xffff0000u) + q[i * 8 + 2] * __uint_as_float(v.y << 16) + q[i * 8 + 3] * __uint_as_float(v.y & 0xffff0000u)
                    + q[i * 8 + 4] * __uint_as_float(v.z << 16) + q[i * 8 + 5] * __uint_as_float(v.z & 0xffff0000u) + q[i * 8 + 6] * __uint_as_float(v.w << 16) + q[i * 8 + 7] * __uint_as_float(v.w & 0xffff0000u); }
            const int dr = krow - r + 7, dc = min(max(kcol - c + 15, 0), 30);
            sc += rpb[h * 465 + dr * 31 + dc];
            const float mn = fmaxf(mx, sc), corr = __expf(mx - mn), pe = __expf(sc - mn);
            l = l * corr + pe; mx = mn;
#pragma unroll
            for (int i = 0; i < 8; ++i) { const u32x4 v = *(const u32x4*)(vp + i * 8);
                acc[i * 8 + 0] = acc[i * 8 + 0] * corr + pe * __uint_as_float(v.x << 16); acc[i * 8 + 1] = acc[i * 8 + 1] * corr + pe * __uint_as_float(v.x & 0xffff0000u);
                acc[i * 8 + 2] = acc[i * 8 + 2] * corr + pe * __uint_as_float(v.y << 16); acc[i * 8 + 3] = acc[i * 8 + 3] * corr + pe * __uint_as_float(v.y & 0xffff0000u);
                acc[i * 8 + 4] = acc[i * 8 + 4] * corr + pe * __uint_as_float(v.z << 16); acc[i * 8 + 5] = acc[i * 8 + 5] * corr + pe * __uint_as_float(v.z & 0xffff0000u);
                acc[i * 8 + 6] = acc[i * 8 + 6] * corr + pe * __uint_as_float(v.w << 16); acc[i * 8 + 7] = acc[i * 8 + 7] * corr + pe * __uint_as_float(v.w & 0xffff0000u); }
        }
    }
    const float inv = 1.f / l;
    bf16_t* op = ymix + (size_t)tok * D + h * 64;
#pragma unroll
    for (int i = 0; i < 8; ++i) { u32x4 o; o.x = pk2(acc[i * 8 + 0] * inv, acc[i * 8 + 1] * inv); o.y = pk2(acc[i * 8 + 2] * inv, acc[i * 8 + 3] * inv);
        o.z = pk2(acc[i * 8 + 4] * inv, acc[i * 8 + 5] * inv); o.w = pk2(acc[i * 8 + 6] * inv, acc[i * 8 + 7] * inv); *(u32x4*)(op + i * 8) = o; }
}

__device__ __forceinline__ void ret_unit(const bf16_t* __restrict__ proj, const float* __restrict__ rope, const float* __restrict__ log_decay, float* __restrict__ ybuf, LAS unsigned char* lds, int unit) {
    LAS float* sq = (LAS float*)lds; LAS float* sk = sq + 16 * 128; LAS float* sv = sk + 16 * 128; LAS float* sy = sv + 16 * 128;
    const int dir = unit & 1, h = (unit >> 1) & 3, b = unit >> 3, tid = threadIdx.x;
    const int dv = tid & 127, qt = tid >> 7;
    const float g = __expf(log_decay[dir * 4 + h]);
    float S[32];
#pragma unroll
    for (int i = 0; i < 32; ++i) S[i] = 0.f;
    float* yo = ybuf + (size_t)dir * M * 512;
    for (int t0 = 0; t0 < SEQ; t0 += 16) {
        __syncthreads();
#pragma unroll
        for (int i = 0; i < 4; ++i) {
            const int q = tid + 512 * i;
            const int u = q >> 7, which = (q >> 6) & 1, pr = q & 63;
            const int t = dir ? (SEQ - 1 - (t0 + u)) : (t0 + u);
            const bf16_t* rowp = proj + ((size_t)(b * SEQ + t)) * DIN + (which ? OFF_KR : OFF_QR) + h * 128;
            const float a1 = bf2f(rowp[pr]), a2 = bf2f(rowp[pr + 64]);
            const float cs = rope[t * 64 + pr], sn = rope[SEQ * 64 + t * 64 + pr];
            LAS float* dst = (which ? sk : sq) + u * 128;
            dst[pr] = a1 * cs - a2 * sn; dst[pr + 64] = a2 * cs + a1 * sn;
        }
#pragma unroll
        for (int i = 0; i < 4; ++i) { const int q = tid + 512 * i; const int u = q >> 7, d = q & 127; const int t = dir ? (SEQ - 1 - (t0 + u)) : (t0 + u);
            sv[u * 128 + d] = bf2f(proj[((size_t)(b * SEQ + t)) * DIN + OFF_VR + h * 128 + d]); }
        __syncthreads();
        for (int u = 0; u < 16; ++u) {
            const float v = sv[u * 128 + dv]; float y = 0.f;
            if (dir == 0) {
#pragma unroll
                for (int i = 0; i < 32; ++i) { S[i] = g * S[i] + sk[u * 128 + qt * 32 + i] * v; y += sq[u * 128 + qt * 32 + i] * S[i]; }
            } else {
#pragma unroll
                for (int i = 0; i < 32; ++i) { y += sq[u * 128 + qt * 32 + i] * S[i]; S[i] = g * (S[i] + sk[u * 128 + qt * 32 + i] * v); }
            }
            sy[(u * 4 + qt) * 128 + dv] = y;
        }
        __syncthreads();
#pragma unroll
        for (int i = 0; i < 4; ++i) { const int q = tid + 512 * i; const int u = q >> 7, d = q & 127; const int t = dir ? (SEQ - 1 - (t0 + u)) : (t0 + u);
            yo[((size_t)(b * SEQ + t)) * 512 + h * 128 + d] = (sy[(u * 4 + 0) * 128 + d] + sy[(u * 4 + 1) * 128 + d]) + (sy[(u * 4 + 2) * 128 + d] + sy[(u * 4 + 3) * 128 + d]); }
    }
    __syncthreads();
}
__device__ __forceinline__ void ret_fin_item(const float* __restrict__ ybuf, const bf16_t* __restrict__ proj, const float* __restrict__ gn_g, bf16_t* __restrict__ ymix, int w, int lane) {
    const int tok = w >> 2, h = w & 3;
    const size_t o = (size_t)tok * 512 + h * 128 + lane * 2;
    const f32x2 a = *(const f32x2*)(ybuf + o), bb = *(const f32x2*)(ybuf + (size_t)M * 512 + o);
    const float y0 = a.x + bb.x, y1 = a.y + bb.y;
    const float mu = wave_sum(y0 + y1) * (1.f / 128.f); const float d0 = y0 - mu, d1 = y1 - mu;
    const float var = wave_sum(d0 * d0 + d1 * d1) * (1.f / 128.f); const float rs = 1.f / sqrtf(var + GN_EPS);
    const bf16_t* gp = proj + (size_t)tok * DIN + OFF_GR + h * 128 + lane * 2;
    const float g0 = bf2f(gp[0]), g1 = bf2f(gp[1]);
    const float o0 = silu_f(g0) * (d0 * rs * gn_g[h * 128 + lane * 2]), o1 = silu_f(g1) * (d1 * rs * gn_g[h * 128 + lane * 2 + 1]);
    *(unsigned*)(ymix + (size_t)tok * D + 512 + h * 128 + lane * 2) = pk2(o0, o1);
}
__device__ __forceinline__ void ln1_row(float* __restrict__ io, const float* __restrict__ g, const float* __restrict__ bb, const float* __restrict__ mod, bf16_t* __restrict__ hf, int row, int lane) {
    const int b = row >> 11;
    f32x4 v[4]; float s = 0.f;
#pragma unroll
    for (int j = 0; j < 4; ++j) { v[j] = *(const f32x4*)(io + (size_t)row * D + j * 256 + lane * 4); s += (v[j].x + v[j].y) + (v[j].z + v[j].w); }
    const float mean = wave_sum(s) * (1.f / D); float s2 = 0.f;
#pragma unroll
    for (int j = 0; j < 4; ++j) { v[j] = v[j] - mean; s2 += (v[j].x * v[j].x + v[j].y * v[j].y) + (v[j].z * v[j].z + v[j].w * v[j].w); }
    const float rstd = 1.f / sqrtf(wave_sum(s2) * (1.f / D) + LN_EPS);
#pragma unroll
    for (int j = 0; j < 4; ++j) { const int col = j * 256 + lane * 4;
        const f32x4 gg = *(const f32x4*)(g + col), bv = *(const f32x4*)(bb + col);
        const f32x4 x1 = v[j] * rstd * gg + bv;
        *(f32x4*)(io + (size_t)row * D + col) = x1;
        const f32x4 sc = *(const f32x4*)(mod + b * 6144 + MOD_SCALE_F + col), sh = *(const f32x4*)(mod + b * 6144 + MOD_SHIFT_F + col);
        u32x2 o; o.x = pk2(x1.x * (1.f + sc.x) + sh.x, x1.y * (1.f + sc.y) + sh.y); o.y = pk2(x1.z * (1.f + sc.z) + sh.z, x1.w * (1.f + sc.w) + sh.w);
        *(u32x2*)(hf + (size_t)row * D + col) = o; }
}
__device__ __forceinline__ void top2_merge(float& a1, float& a2, float b1, float b2) { const float n1 = fmaxf(a1, b1); const float n2 = fmaxf(fminf(a1, b1), fmaxf(a2, b2)); a1 = n1; a2 = n2; }
__device__ __forceinline__ void route_token(const float* __restrict__ logits, const f32x4 bias, int* __restrict__ topk_e, float* __restrict__ topk_w, LAS unsigned* hist, int tok, int lane) {
    const f32x4 lg = *(const f32x4*)(logits + (size_t)tok * NE + lane * 4);
    const float sc0 = 1.f / (1.f + __expf(-lg.x)), sc1 = 1.f / (1.f + __expf(-lg.y)), sc2 = 1.f / (1.f + __expf(-lg.z)), sc3 = 1.f / (1.f + __expf(-lg.w));
    float s0 = sc0 + bias.x, s1 = sc1 + bias.y, s2 = sc2 + bias.z, s3 = sc3 + bias.w;
    float m1 = fmaxf(s0, s1), m2 = fminf(s0, s1); top2_merge(m1, m2, fmaxf(s2, s3), fminf(s2, s3));
#pragma unroll
    for (int o = 1; o < 8; o <<= 1) { const float b1 = __shfl_xor(m1, o), b2 = __shfl_xor(m2, o); top2_merge(m1, m2, b1, b2); }
    const float gs = m1 + m2; const int grp = lane >> 3;
    int rank = 0;
#pragma unroll
    for (int gq = 0; gq < 8; ++gq) { const float og = __shfl(gs, gq * 8); rank += (og > gs || (og == gs && gq < grp)) ? 1 : 0; }
    const float NEG = -3.0e38f;
    if (rank >= 4) { s0 = NEG; s1 = NEG; s2 = NEG; s3 = NEG; }
    float wsum = 0.f; float myw = 0.f; int mye = 0;
#pragma unroll
    for (int k = 0; k < TOPK; ++k) {
        float bv = s0; int bi = 0;
        if (s1 > bv) { bv = s1; bi = 1; }
        if (s2 > bv) { bv = s2; bi = 2; }
        if (s3 > bv) { bv = s3; bi = 3; }
        int be = lane * 4 + bi;
#pragma unroll
        for (int o = 1; o < 64; o <<= 1) { const float ov = __shfl_xor(bv, o); const int oe = __shfl_xor(be, o); if (ov > bv || (ov == bv && oe < be)) { bv = ov; be = oe; } }
        const int ol = be >> 2, oj = be & 3;
        const float mysc = oj == 0 ? sc0 : (oj == 1 ? sc1 : (oj == 2 ? sc2 : sc3));
        const float wsel = __shfl(mysc, ol);
        if (lane == ol) { if (oj == 0) s0 = NEG; else if (oj == 1) s1 = NEG; else if (oj == 2) s2 = NEG; else s3 = NEG; }
        wsum += wsel;
        if (lane == k) { myw = wsel; mye = be; }
    }
    if (lane < TOPK) { topk_e[tok * TOPK + lane] = mye; topk_w[tok * TOPK + lane] = myw / wsum * 2.5f; __hip_atomic_fetch_add(&hist[mye], 1u, __ATOMIC_RELAXED, __HIP_MEMORY_SCOPE_WORKGROUP); }
}
__device__ __forceinline__ void build_tables(const unsigned* ctl, LAS unsigned* tab) {
    if (threadIdx.x < 64) {
        const int lane = threadIdx.x;
        unsigned c[4], so = 0, st = 0;
#pragma unroll
        for (int j = 0; j < 4; ++j) { c[j] = __hip_atomic_load(ctl + CW_COUNT + lane * 4 + j, __ATOMIC_RELAXED, __HIP_MEMORY_SCOPE_AGENT); so += c[j]; st += (c[j] + 255u) >> 8; }
        unsigned io = so, it = st;
#pragma unroll
        for (int o = 1; o < 64; o <<= 1) { const unsigned a = __shfl_up(io, o), b = __shfl_up(it, o); if (lane >= o) { io += a; it += b; } }
        unsigned eo = io - so, et = it - st;
#pragma unroll
        for (int j = 0; j < 4; ++j) { tab[T_CNT + lane * 4 + j] = c[j]; tab[T_OFF + lane * 4 + j] = eo; tab[T_TILE + lane * 4 + j] = et; eo += c[j]; et += (c[j] + 255u) >> 8; }
        if (lane == 63) { tab[T_OFF + NE] = eo; tab[T_TILE + NE] = et; }
    }
    __syncthreads();
}
__device__ __forceinline__ void final_row(float* __restrict__ io, const unsigned char* __restrict__ ybuf, const float* __restrict__ g, const float* __restrict__ bb, const float* __restrict__ mod, int row, int lane) {
    const int b = row >> 11;
    f32x4 v[4]; float s = 0.f;
#pragma unroll
    for (int j = 0; j < 4; ++j) {
        const int col = j * 256 + lane * 4;
        f32x4 a = (f32x4){0.f, 0.f, 0.f, 0.f};
#pragma unroll
        for (int k = 0; k < TOPK; ++k) {
            const unsigned pk = *(const unsigned*)(ybuf + ((size_t)row * TOPK + k) * D + col);
            const f32x2 lo = __builtin_amdgcn_cvt_pk_f32_fp8((int)pk, false), hi = __builtin_amdgcn_cvt_pk_f32_fp8((int)pk, true);
            a.x += lo.x; a.y += lo.y; a.z += hi.x; a.w += hi.y;
        }
        const f32x4 gt = *(const f32x4*)(mod + b * 6144 + MOD_GATE_F + col);
        v[j] = *(const f32x4*)(io + (size_t)row * D + col) + gt * a * YINV;
        s += (v[j].x + v[j].y) + (v[j].z + v[j].w);
    }
    const float mean = wave_sum(s) * (1.f / D); float s2 = 0.f;
#pragma unroll
    for (int j = 0; j < 4; ++j) { v[j] = v[j] - mean; s2 += (v[j].x * v[j].x + v[j].y * v[j].y) + (v[j].z * v[j].z + v[j].w * v[j].w); }
    const float rstd = 1.f / sqrtf(wave_sum(s2) * (1.f / D) + LN_EPS);
#pragma unroll
    for (int j = 0; j < 4; ++j) { const int col = j * 256 + lane * 4; const f32x4 gg = *(const f32x4*)(g + col), bv = *(const f32x4*)(bb + col);
        *(f32x4*)(io + (size_t)row * D + col) = v[j] * rstd * gg + bv; }
}

#ifndef MK_PER_PHASE
#define MK_PER_PHASE 0
#endif
constexpr int N_PHASES = 13;
struct Args { Ctx X; int ph_lo, ph_hi; };
typedef __attribute__((address_space(4))) const Ctx* CtxCP;
__device__ __forceinline__ CtxCP ctx_ptr() { CtxCP p = (CtxCP)__builtin_amdgcn_kernarg_segment_ptr(); asm volatile("" : "+s"(p)); return p; }

__global__ void __launch_bounds__(NW * 64, 2) mk_fwd(Args args) {
    extern __shared__ __attribute__((aligned(16))) unsigned char lds_raw[];
    LAS unsigned char* lds = (LAS unsigned char*)lds_raw;
    LAS unsigned* tab = (LAS unsigned*)(lds + TAB_OFF);
    volatile LAS unsigned* MISC = (volatile LAS unsigned*)(lds + MISC_OFF);
#define PH_BEGIN \
    const __attribute__((address_space(4))) Ctx& X = *ctx_ptr(); unsigned char* ws = X.ws; (void)ws; \
    const int tid = threadIdx.x, lane = tid & 63, wave = __builtin_amdgcn_readfirstlane(tid >> 6); (void)lane; (void)wave; \
    const int G = gridDim.x, bx = blockIdx.x; (void)G; (void)bx; \
    const int gw = bx * NW + wave, NGW = G * NW; (void)gw; (void)NGW; \
    const int gt = bx * (NW * 64) + tid, NGT = G * NW * 64; (void)gt; (void)NGT; \
    unsigned* ctl = (unsigned*)(ws + WS_CTL); float* mod = (float*)(ws + WS_MOD); float* rope = (float*)(ws + WS_ROPE); (void)ctl; (void)mod; (void)rope; \
    bf16_t* win_t = (bf16_t*)(ws + WS_WIN_T); bf16_t* wout_t = (bf16_t*)(ws + WS_WOUT_T); bf16_t* wr_t = (bf16_t*)(ws + WS_WR_T); (void)win_t; (void)wout_t; (void)wr_t; \
    bf16_t* wsgu_t = (bf16_t*)(ws + WS_WSGU_T); bf16_t* wsd_t = (bf16_t*)(ws + WS_WSD_T); bf16_t* wd_t = (bf16_t*)(ws + WS_WD_T); bf16_t* wgu_t = (bf16_t*)(ws + WS_WGU_T); (void)wsgu_t; (void)wsd_t; (void)wd_t; (void)wgu_t; \
    int* slot_ent = (int*)(ws + WS_SLOT_ENT); float* slot_w = (float*)(ws + WS_SLOT_W); int* topk_e = (int*)(ws + WS_TOPK_E); float* topk_w = (float*)(ws + WS_TOPK_W); (void)slot_ent; (void)slot_w; (void)topk_e; (void)topk_w; \
    bf16_t* ymix = (bf16_t*)(ws + WS_YMIX); bf16_t* proj = (bf16_t*)(ws + WS_PROJ); bf16_t* hbuf = (bf16_t*)(ws + WS_YMIX); (void)ymix; (void)proj; (void)hbuf; \
    float* logits = (float*)(ws + WS_LOGITS); bf16_t* shh = (bf16_t*)(ws + WS_SHH); bf16_t* hf = (bf16_t*)(ws + WS_HF); bf16_t* act = (bf16_t*)(ws + WS_ACT); (void)logits; (void)shh; (void)hf; (void)act; \
    unsigned char* ybuf = ws + WS_YBUF; float* out = X.out; (void)ybuf; (void)out;

    for (int u = threadIdx.x; u < (LDS_BYTES - TAB_OFF) / 4; u += NW * 64) ((LAS unsigned*)(lds + TAB_OFF))[u] = 0u;
    __syncthreads();
    if (!MK_PER_PHASE) { unsigned* ctl0 = (unsigned*)(args.X.ws + WS_CTL); (void)xcd_barrier_post(ctl0 + CW_BAR, MISC + 8); }
    const int lo = args.ph_lo, hi = args.ph_hi;
#ifdef MK_ONLY
#define IN(k) ((k) == MK_ONLY)
#else
#define IN(k) (lo <= (k) && (k) < hi)
#endif
#define SEAM(k) do { if (IN(k) && IN((k) + 1)) { XcdBarrier _b; _b.bar = (unsigned*)(ctx_ptr()->ws + WS_CTL) + CW_BAR; _b.x = xb_xcc_id(); _b.st = (volatile LAS unsigned*)(lds + MISC_OFF) + 8; xcd_barrier(_b); } } while (0)

    if (IN(0)) { PH_BEGIN
        LAS float* scr = (LAS float*)(lds + wave * 16384);
        if (gw < 96) mod_task(X.c, X.w_ada, X.b_ada, mod, gw, lane);
        constexpr int I_IN = (D / 64) * (DIN / 32), I_OUT = (D / 64) * (D / 32), I_R = (D / 64) * (NE / 32), I_SG = (D / 64) * (DE / 32), I_SD = (DE / 64) * (D / 32);
        constexpr int I_EG = I_SG, I_ED = I_SD;
        constexpr int N_SMALL = I_IN + I_OUT + I_R + 2 * I_SG + I_SD;
        constexpr int N_ITEMS = N_SMALL + NE * (2 * I_EG + I_ED);
        for (int it = gw; it < N_ITEMS; it += NGW) {
            int r = it;
            if (r < I_IN) { transpose_item(X.w_in, D, DIN, win_t, 0, 0, scr, r, lane); continue; } r -= I_IN;
            if (r < I_OUT) { transpose_item(X.w_out, D, D, wout_t, 0, 0, scr, r, lane); continue; } r -= I_OUT;
            if (r < I_R) { transpose_item(X.w_router, D, NE, wr_t, 0, 0, scr, r, lane); continue; } r -= I_R;
            if (r < I_SG) { transpose_item(X.ws_gate, D, DE, wsgu_t, 128, 0, scr, r, lane); continue; } r -= I_SG;
            if (r < I_SG) { transpose_item(X.ws_up, D, DE, wsgu_t, 128, 1, scr, r, lane); continue; } r -= I_SG;
            if (r < I_SD) { transpose_item(X.ws_down, DE, D, wsd_t, 0, 0, scr, r, lane); continue; } r -= I_SD;
            const int e = r / (2 * I_EG + I_ED); r -= e * (2 * I_EG + I_ED);
            if (r < I_EG) { transpose_item(X.w_gate + (size_t)e * D * DE, D, DE, wgu_t + (size_t)e * 512 * D, 128, 0, scr, r, lane); continue; } r -= I_EG;
            if (r < I_EG) { transpose_item(X.w_up + (size_t)e * D * DE, D, DE, wgu_t + (size_t)e * 512 * D, 128, 1, scr, r, lane); continue; } r -= I_EG;
            transpose_item(X.w_down + (size_t)e * DE * D, DE, D, wd_t + (size_t)e * D * DE, 0, 0, scr, r, lane);
        }
        for (int i = gt; i < SEQ * 64; i += NGT) rope_entry(rope, i);
    }
    SEAM(0);
    if (IN(1)) { PH_BEGIN
        for (size_t i4 = gt; i4 < (size_t)M * D / 4; i4 += NGT) {
            const size_t e = i4 * 4; const int row = (int)(e >> 10), col = (int)(e & 1023), b = row >> 11;
            const f32x4 v = *(const f32x4*)(X.x + e);
            const f32x4 sc = *(const f32x4*)(mod + b * 6144 + MOD_SCALE_A + col), sh = *(const f32x4*)(mod + b * 6144 + MOD_SHIFT_A + col);
            u32x2 o; o.x = pk2(v.x * (1.f + sc.x) + sh.x, v.y * (1.f + sc.y) + sh.y); o.y = pk2(v.z * (1.f + sc.z) + sh.z, v.w * (1.f + sc.w) + sh.w);
            *(u32x2*)(hbuf + e) = o;
        }
    }
    SEAM(1);
    if (IN(2)) { PH_BEGIN
        pg8::DenseOrder S; S.init(M, DIN, D, win_t, G, bx);
        pg8::EpiInProj E{proj};
        pg8::gemm_phase(lds, (const char*)hbuf, D, S, E);
    }
    SEAM(2);
    if (IN(3)) { PH_BEGIN
        for (int u = bx; u < BATCH * 4 * 2; u += G) ret_unit(proj, rope, X.ret_ld, out, lds, u);
        for (int i = gt; i < M * 8; i += NGT) na_item(proj, X.na_rpb, ymix, i);
    }
    SEAM(3);
    if (IN(4)) { PH_BEGIN for (int w = gw; w < M * 4; w += NGW) ret_fin_item(out, proj, X.ret_gn, ymix, w, lane); }
    SEAM(4);
    if (IN(5)) { PH_BEGIN
        pg8::DenseOrder S; S.init(M, D, D, wout_t, G, bx);
        pg8::EpiOutProj E{X.x, mod, out};
        pg8::gemm_phase(lds, (const char*)ymix, D, S, E);
    }
    SEAM(5);
    if (IN(6)) { PH_BEGIN for (int r = gw; r < M; r += NGW) ln1_row(out, X.ln1_g, X.ln1_b, mod, hf, r, lane); }
    SEAM(6);
    if (IN(7)) { PH_BEGIN
        { pg8::DenseOrder S; S.init(M, NE, D, wr_t, G, bx); pg8::EpiRouter E{logits}; pg8::gemm_phase(lds, (const char*)hf, D, S, E); }
        { pg8::DenseOrder S; S.init(M, 2 * DE, D, wsgu_t, G, bx); pg8::EpiGU<false> E{shh, nullptr}; pg8::gemm_phase(lds, (const char*)hf, D, S, E); }
    }
    SEAM(7);
    if (IN(8)) { PH_BEGIN
        LAS unsigned* hist = tab + T_HIST;
        if (tid < NE) hist[tid] = 0u;
        __syncthreads();
        const f32x4 bias = *(const f32x4*)(X.rbias + lane * 4);
        for (int tok = gw; tok < M; tok += NGW) route_token(logits, bias, topk_e, topk_w, hist, tok, lane);
        __syncthreads();
        if (tid < NE && hist[tid]) atomicAdd(&ctl[CW_COUNT + tid], hist[tid]);
    }
    SEAM(8);
    if (IN(9)) { PH_BEGIN
        build_tables(ctl, tab);
        LAS unsigned* hist = tab + T_HIST; LAS unsigned* base = tab + T_BASE;
        for (int c0 = bx * 2048; c0 < NSLOT; c0 += G * 2048) {
            __syncthreads();
            if (tid < NE) hist[tid] = 0u;
            __syncthreads();
            int e[4]; unsigned loc[4];
#pragma unroll
            for (int i = 0; i < 4; ++i) { const int idx = c0 + i * 512 + tid; e[i] = topk_e[idx]; loc[i] = __hip_atomic_fetch_add(&hist[e[i]], 1u, __ATOMIC_RELAXED, __HIP_MEMORY_SCOPE_WORKGROUP); }
            __syncthreads();
            if (tid < NE && hist[tid]) base[tid] = atomicAdd(&ctl[CW_CURSOR + tid], hist[tid]);
            __syncthreads();
#pragma unroll
            for (int i = 0; i < 4; ++i) { const int idx = c0 + i * 512 + tid; const unsigned pos = tab[T_OFF + e[i]] + base[e[i]] + loc[i]; slot_ent[pos] = idx; slot_w[pos] = topk_w[idx]; }
        }
    }
    SEAM(9);
    if (IN(10)) { PH_BEGIN
        build_tables(ctl, tab);
        { pg8::ExpertOrder<2, true> S; S.init(tab, D, wgu_t, (size_t)512 * D * 2, slot_ent, G, bx); pg8::EpiGU<true> E{act, slot_w}; pg8::gemm_phase(lds, (const char*)hf, D, S, E); }
        { pg8::DenseOrder S; S.init(M, D, DE, wsd_t, G, bx); pg8::EpiSharedDown E{mod, out}; pg8::gemm_phase(lds, (const char*)shh, DE, S, E); }
    }
    SEAM(10);
    if (IN(11)) { PH_BEGIN
        build_tables(ctl, tab);
        pg8::ExpertOrder<4, false> S; S.init(tab, DE, wd_t, (size_t)D * DE * 2, slot_ent, G, bx); pg8::EpiExpDown E{ybuf, slot_ent}; pg8::gemm_phase(lds, (const char*)act, DE, S, E);
    }
    SEAM(11);
    if (IN(12)) { PH_BEGIN for (int r = gw; r < M; r += NGW) final_row(out, ybuf, X.ln2_g, X.ln2_b, mod, r, lane); }
#undef IN
#undef SEAM
}

extern "C" void kernel_launch(void* const* d_in, const int* in_sizes, int n_in, void* d_out, int out_size, void* d_ws, size_t ws_size, hipStream_t stream) {
    static int grid = 0;
    if (grid == 0) {
        if (n_in != 21 || in_sizes[0] != M * D || out_size != M * D || ws_size < WS_END) { fprintf(stderr, "kernel_launch: unexpected shapes (n_in %d, ws %zu)\n", n_in, ws_size); grid = -1; return; }
        int dev = 0, cus = 0, per_cu = 0;
        if (hipGetDevice(&dev) != hipSuccess || hipDeviceGetAttribute(&cus, hipDeviceAttributeMultiprocessorCount, dev) != hipSuccess) { grid = -1; return; }
        if (hipFuncSetAttribute((const void*)mk_fwd, hipFuncAttributeMaxDynamicSharedMemorySize, LDS_BYTES) != hipSuccess) { fprintf(stderr, "kernel_launch: hipFuncSetAttribute failed\n"); grid = -1; return; }
        if (hipOccupancyMaxActiveBlocksPerMultiprocessor(&per_cu, (const void*)mk_fwd, NW * 64, LDS_BYTES) != hipSuccess || per_cu < 1) { fprintf(stderr, "kernel_launch: occupancy query says %d\n", per_cu); }
        (void)hipGetLastError();
        grid = cus;
    }
    if (grid < 0) return;
    (void)hipMemsetAsync((char*)d_ws + WS_CTL, 0, 1 * MiB, stream);
    Args a{};
    const float** p = (const float**)&a.X;
    for (int i = 0; i < 21; ++i) p[i] = (const float*)d_in[i];
    a.X.out = (float*)d_out; a.X.ws = (unsigned char*)d_ws;
#if MK_PER_PHASE
    for (int ph = 0; ph < N_PHASES; ++ph) { a.ph_lo = ph; a.ph_hi = ph + 1; hipLaunchKernelGGL(mk_fwd, dim3(grid), dim3(NW * 64), LDS_BYTES, stream, a); }
#else
    a.ph_lo = 0; a.ph_hi = N_PHASES;
    hipLaunchKernelGGL(mk_fwd, dim3(grid), dim3(NW * 64), LDS_BYTES, stream, a);
#endif
}
```

```cpp
#include <hip/hip_runtime.h>
#include <cstdio>
#include <cstdint>

typedef unsigned short bf16_t;
typedef short bf16x8 __attribute__((ext_vector_type(8)));
typedef float f32x4 __attribute__((ext_vector_type(4)));
typedef float f32x2 __attribute__((ext_vector_type(2)));
typedef unsigned u32x4 __attribute__((ext_vector_type(4)));
typedef unsigned u32x2 __attribute__((ext_vector_type(2)));
#define LAS __attribute__((address_space(3)))

constexpr int D = 1024, BATCH = 32, SEQ = 2048, M = BATCH * SEQ;
constexpr int DIN = 3584;
constexpr int OFF_QNA = 0, OFF_KNA = 512, OFF_VNA = 1024, OFF_QR = 1536, OFF_KR = 2048, OFF_VR = 2560, OFF_GR = 3072;
constexpr int NE = 256, TOPK = 8, DE = 256;
constexpr int NSLOT = M * TOPK;
constexpr float LN_EPS = 1e-5f, GN_EPS = 1e-6f;
constexpr float ALPHA = 1.189207115002721f;
constexpr float YSCALE = 64.f, YINV = 1.f / 64.f;
constexpr int MOD_SHIFT_A = 0, MOD_SCALE_A = 1024, MOD_GATE_A = 2048, MOD_SHIFT_F = 3072, MOD_SCALE_F = 4096, MOD_GATE_F = 5120;

constexpr size_t MiB = 1u << 20;
constexpr size_t WS_CTL = 0;
constexpr size_t WS_MOD = 1 * MiB;
constexpr size_t WS_ROPE = 2 * MiB;
constexpr size_t WS_WIN_T = 4 * MiB;
constexpr size_t WS_WOUT_T = 11 * MiB;
constexpr size_t WS_WR_T = 13 * MiB;
constexpr size_t WS_WSGU_T = 14 * MiB;
constexpr size_t WS_WSD_T = 15 * MiB;
constexpr size_t WS_SLOT_ENT = 16 * MiB;
constexpr size_t WS_SLOT_W = 18 * MiB;
constexpr size_t WS_TOPK_E = 20 * MiB;
constexpr size_t WS_TOPK_W = 22 * MiB;
constexpr size_t WS_WD_T = 32 * MiB;
constexpr size_t WS_WGU_T = 160 * MiB;
constexpr size_t WS_YMIX = 416 * MiB;
constexpr size_t WS_PROJ = 544 * MiB;
constexpr size_t WS_LOGITS = WS_YMIX, WS_SHH = WS_YMIX + 64 * MiB;
constexpr size_t WS_HF = WS_PROJ, WS_ACT = WS_PROJ + 128 * MiB;
constexpr size_t WS_YBUF = WS_WGU_T;
constexpr size_t WS_END = 992 * MiB;
constexpr int CW_COUNT = 1024, CW_CURSOR = 1536, CW_BAR = 8192;

constexpr int RING_BYTES = 131072;
constexpr int TAB_OFF = RING_BYTES;
constexpr int T_OFF = 0, T_TILE = 260, T_CNT = 520, T_HIST = 776, T_BASE = 1032, TAB_WORDS = 1288;
constexpr int VN_OFF = TAB_OFF + 6144;
constexpr int PHASE_BYTES = 155648;
constexpr int MISC_OFF = PHASE_BYTES;
constexpr int LDS_BYTES = PHASE_BYTES + 256;
static_assert(TAB_WORDS * 4 <= 6144 && VN_OFF + 8192 <= PHASE_BYTES && LDS_BYTES <= 163840, "LDS map");

__device__ __forceinline__ unsigned f2bf(float f) { unsigned u = __float_as_uint(f); return (u + 0x7fffu + ((u >> 16) & 1u)) >> 16; }
__device__ __forceinline__ float bf2f(unsigned short h) { return __uint_as_float(((unsigned)h) << 16); }
__device__ __forceinline__ unsigned pk2(float lo, float hi) { return f2bf(lo) | (f2bf(hi) << 16); }
__device__ __forceinline__ unsigned cvt_pk_bf16(float lo, float hi) { unsigned r; asm volatile("v_cvt_pk_bf16_f32 %0, %1, %2" : "=v"(r) : "v"(lo), "v"(hi)); return r; }
__device__ __forceinline__ float silu_f(float v) { return v / (1.f + __expf(-v)); }
__device__ __forceinline__ float wave_sum(float v) {
#pragma unroll
    for (int o = 1; o < 64; o <<= 1) v += __shfl_xor(v, o);
    return v;
}
__device__ __forceinline__ float clamp8(float v) { return fminf(fmaxf(v, -440.f), 440.f); }
#define LDS_WAIT() asm volatile("s_waitcnt lgkmcnt(0)" ::: "memory")

#define XB_TMO      128
#define XB_XCNT(j)  (256  + 64 * (j))
#define XB_XSUB(j)  (1280 + 64 * (j))
#define XB_XGEN(j)  (2304 + 64 * (j))
#define XB_TOP      3328
#define XB_TOPGEN   3392
#define XCD_BAR_WORDS 3456
#define XB_SPIN_CAP (1u << 23)
__device__ __forceinline__ unsigned xb_ld(unsigned* p)              { return __hip_atomic_load(p, __ATOMIC_RELAXED, __HIP_MEMORY_SCOPE_AGENT); }
__device__ __forceinline__ unsigned xb_add(unsigned* p, unsigned v) { return __hip_atomic_fetch_add(p, v, __ATOMIC_RELAXED, __HIP_MEMORY_SCOPE_AGENT); }
__device__ __forceinline__ unsigned xb_xcc_id() { return (unsigned)__builtin_amdgcn_s_getreg((3 << 11) | 20) & 0xFu; }
#define XB_SPIN(cond, bar) do { unsigned _sp = 0; while (cond) { __builtin_amdgcn_s_sleep(1); \
    if ((++_sp & 255u) == 0u) { if (xb_ld(&(bar)[XB_TMO])) break; if (_sp > XB_SPIN_CAP) { atomicAdd(&(bar)[XB_TMO], 1u); break; } } } } while (0)
struct XcdBarrier { unsigned* bar; unsigned x; volatile LAS unsigned* st; };
__device__ __forceinline__ XcdBarrier xcd_barrier_post(unsigned* bar, volatile LAS unsigned* st) {
    XcdBarrier b; b.bar = bar; b.x = xb_xcc_id(); b.st = st;
    if (threadIdx.x == 0) (void)xb_add(&bar[XB_XCNT(b.x)], 1u);
    return b;
}
__device__ __forceinline__ void xcd_barrier_complete(unsigned* bar, unsigned x, unsigned& nloc, unsigned& nx) {
    const unsigned G = gridDim.x * gridDim.y * gridDim.z;
    unsigned sum, cnt, mine, sp = 0u;
    for (;;) {
        sum = 0u; cnt = 0u; mine = 0u;
#pragma unroll
        for (unsigned j = 0; j < 16; ++j) { const unsigned c = xb_ld(&bar[XB_XCNT(j)]); sum += c; cnt += (c > 0u) ? 1u : 0u; mine = (j == x) ? c : mine; }
        if (sum == G) break;
        __builtin_amdgcn_s_sleep(1);
        if ((++sp & 255u) == 0u) { if (xb_ld(&bar[XB_TMO])) break; if (sp > XB_SPIN_CAP) { atomicAdd(&bar[XB_TMO], 1u); break; } }
    }
    nloc = mine > 0u ? mine : 1u; nx = cnt > 0u ? cnt : 1u;
}
__device__ __forceinline__ void xcd_barrier(const XcdBarrier& b) {
    asm volatile("s_waitcnt vmcnt(0)" ::: "memory");
    __syncthreads();
    if (threadIdx.x == 0) {
        unsigned* bar = b.bar;
        __builtin_amdgcn_s_waitcnt(0);
        unsigned nloc = b.st[0], nx = b.st[1];
        if (nloc == 0u) { xcd_barrier_complete(bar, b.x, nloc, nx); b.st[0] = nloc; b.st[1] = nx; }
        const unsigned old = xb_add(&bar[XB_XSUB(b.x)], 1u);
        const unsigned gen = old / nloc;
        if (old + 1u == (gen + 1u) * nloc) {
            __builtin_amdgcn_fence(__ATOMIC_RELEASE, "agent");
            asm volatile("s_waitcnt vmcnt(0)" ::: "memory");
            const unsigned og = xb_add(&bar[XB_TOP], 1u);
            const unsigned tg = og / nx;
            if (og + 1u == (tg + 1u) * nx) xb_add(&bar[XB_TOPGEN], 1u);
            else XB_SPIN(xb_ld(&bar[XB_TOPGEN]) == tg, bar);
            __builtin_amdgcn_fence(__ATOMIC_ACQUIRE, "agent");
            xb_add(&bar[XB_XGEN(b.x)], 1u);
            asm volatile("s_waitcnt vmcnt(0)" ::: "memory");
        } else {
            XB_SPIN(xb_ld(&bar[XB_XGEN(b.x)]) == gen, bar);
            __builtin_amdgcn_fence(__ATOMIC_ACQUIRE, "agent");
            asm volatile("s_waitcnt vmcnt(0)" ::: "memory");
        }
    }
    __syncthreads();
}

namespace pg8 {
constexpr int BM = 256, BK = 64, HALF = 128, HTB = HALF * BK * 2, STAGE_BYTES = 8 * HTB;
__device__ __forceinline__ int lds_byte(int r, int c) { const int st = (r >> 4) * 2 + (c >> 5), rr = r & 15, cc = c & 31, ob = rr * 64 + cc * 2; return st * 1024 + (ob ^ (((ob >> 9) & 1) << 5)); }
__device__ __forceinline__ void stage_rc(int b, int& R, int& C) { const int st = b / 1024, sb = b % 1024, swz = sb ^ (((sb >> 9) & 1) << 5); R = (st >> 1) * 16 + swz / 64; C = (st & 1) * 32 + (swz % 64) / 2; }
__device__ __forceinline__ int perm32(int rho) { const int n = rho >> 4, i = rho & 15; return 8 * (i >> 2) + 4 * n + (i & 3); }

struct Unit { int pm, pn; const char* B; int e, cnt, off; };

template <class Epi, class Sched>
__device__ __forceinline__ void gemm_phase(LAS unsigned char* lds, const char* Abase, const int K, const Sched& S, const Epi& E) {
    int tid_ = threadIdx.x; asm volatile("" : "+v"(tid_));
    const int tid = tid_, wid = __builtin_amdgcn_readfirstlane(tid >> 6), lane = tid & 63, wr = wid >> 2, wc = wid & 3, fr = lane & 15, fq = lane >> 4;
    const int nt = K / BK;
    int Rr[2], Cc[2]; unsigned voffB[2], voffA[2];
#pragma unroll
    for (int i = 0; i < 2; ++i) { int R, C; stage_rc(tid * 16 + i * 8192, R, C); Rr[i] = R; Cc[i] = C; const int Rb = Epi::PERM ? ((R & ~31) + perm32(R & 31)) : R; voffB[i] = (unsigned)(Rb * K + C) * 2u; voffA[i] = (unsigned)(R * K + C) * 2u; }
    constexpr bool GATHER = Sched::GATHER;
    const size_t kstep = (size_t)(BK * 2);
    const size_t hstep = (size_t)HALF * K * 2;
    const unsigned ldsw = (unsigned)wid * 1024u;
    const int aoff = lds_byte(wr * 64 + fr, fq * 8), boff = lds_byte(wc * 32 + fr, fq * 8);
#define PG8_SA(b, h) (((b) * 2 + (h)) * HTB)
#define PG8_SB(b, h) ((4 + (b) * 2 + (h)) * HTB)
#define PG8_STAGE(bufoff, gbase, voff) do { _Pragma("unroll") for (int _i = 0; _i < 2; ++_i) \
        __builtin_amdgcn_global_load_lds((const unsigned*)((const char*)(gbase) + (voff)[_i]), (LAS unsigned*)(lds + (bufoff) + ldsw + _i * 8192), 16, 0, 0); } while (0)
#define PG8_STAGEA(bufoff, uptr, koff, NEXT, h) do { if constexpr (GATHER) { if (NEXT) { const u32x2 _t = *(const LAS u32x2*)(vnslot + 2 * (h)); unsigned _v[2] = {_t.x, _t.y}; PG8_STAGE(bufoff, Abase + (koff), _v); } else { PG8_STAGE(bufoff, Abase + (koff), vc[h]); } } \
        else { PG8_STAGE(bufoff, (uptr) + (size_t)(h) * hstep + (koff), voffA); } } while (0)
#define PG8_LDA(dst, b, h) do { _Pragma("unroll") for (int m = 0; m < 4; ++m) _Pragma("unroll") for (int k = 0; k < 2; ++k) dst[m][k] = *(const LAS bf16x8*)(lds + PG8_SA(b, h) + aoff + m * 2048 + k * 1024); } while (0)
#define PG8_LDB(dst, b, h) do { _Pragma("unroll") for (int n = 0; n < 2; ++n) _Pragma("unroll") for (int k = 0; k < 2; ++k) dst[n][k] = *(const LAS bf16x8*)(lds + PG8_SB(b, h) + boff + n * 2048 + k * 1024); } while (0)
#define PG8_MMA(ai, bj, At, Bt) do { __builtin_amdgcn_s_setprio(1); _Pragma("unroll") for (int m = 0; m < 4; ++m) _Pragma("unroll") for (int n = 0; n < 2; ++n) _Pragma("unroll") for (int k = 0; k < 2; ++k) \
        acc[ai][bj][m][n] = __builtin_amdgcn_mfma_f32_16x16x32_bf16(Bt[n][k], At[m][k], acc[ai][bj][m][n], 0, 0, 0); __builtin_amdgcn_s_setprio(0); } while (0)
#define PG8_WAIT_V(n) asm volatile("s_waitcnt vmcnt(" #n ")" ::: "memory")
#define PG8_WAIT_L(n) asm volatile("s_waitcnt lgkmcnt(" #n ")" ::: "memory")
#define PG8_BAR __builtin_amdgcn_s_barrier()
#define PG8_SCHED __builtin_amdgcn_sched_barrier(0)
    Unit cur, nxt; int ui = 0;
    if (!S.next(0, cur)) return;
    f32x4 acc[2][2][4][2];
#pragma unroll
    for (int a = 0; a < 2; ++a)
#pragma unroll
        for (int b = 0; b < 2; ++b)
#pragma unroll
            for (int m = 0; m < 4; ++m)
#pragma unroll
                for (int n = 0; n < 2; ++n) acc[a][b][m][n] = (f32x4){0.f, 0.f, 0.f, 0.f};
    bf16x8 At[4][2], B0[2][2], B1[2][2];
    unsigned vc[2][2];
    LAS unsigned* vnslot = (LAS unsigned*)(lds + (VN_OFF - 0)) + tid * 4;
    if constexpr (GATHER) S.avoff(cur, Rr, Cc, vc);
    const char* cB = cur.B; const char* cA = Abase + S.aoff(cur);
    PG8_STAGE(PG8_SB(0, 0), cB, voffB); PG8_STAGE(PG8_SB(0, 1), cB + hstep, voffB); PG8_STAGEA(PG8_SA(0, 0), cA, 0, false, 0); PG8_STAGEA(PG8_SA(0, 1), cA, 0, false, 1);
    if (wr == 1) PG8_BAR;
    PG8_WAIT_V(2); PG8_BAR;
    PG8_STAGE(PG8_SB(1, 0), cB + kstep, voffB); PG8_STAGEA(PG8_SA(1, 0), cA, kstep, false, 0); PG8_STAGE(PG8_SB(1, 1), cB + hstep + kstep, voffB);
    PG8_WAIT_V(6); PG8_BAR;
    for (;;) {
        const bool has_next = S.next(ui + 1, nxt);
        if constexpr (GATHER) {
            unsigned vn[2][2];
            if (has_next) S.avoff(nxt, Rr, Cc, vn);
            else {
#pragma unroll
                for (int h = 0; h < 2; ++h)
#pragma unroll
                    for (int i = 0; i < 2; ++i) vn[h][i] = vc[h][i];
            }
            *(LAS u32x4*)vnslot = (u32x4){vn[0][0], vn[0][1], vn[1][0], vn[1][1]};
        }
        const char* nB = has_next ? nxt.B : cB; const char* nA = has_next ? Abase + S.aoff(nxt) : cA;
        for (int t = 0; t < nt; t += 2) {
            const bool last = (t == nt - 2);
            const size_t k1 = (size_t)(t + 1) * kstep;
            const size_t k2 = last ? (size_t)0 : (size_t)(t + 2) * kstep, k3 = k2 + kstep;
            const char* u2 = last ? nA : cA; const char* b2 = last ? nB : cB + (size_t)(t + 2) * kstep;
            const char* b3 = b2 + kstep;
            PG8_LDB(B0, 0, 0); PG8_LDB(B1, 0, 1); PG8_SCHED; PG8_LDA(At, 0, 0); PG8_STAGEA(PG8_SA(1, 1), cA, k1, false, 1);
            PG8_WAIT_V(8); PG8_WAIT_L(0); PG8_BAR; PG8_MMA(0, 0, At, B0); PG8_MMA(0, 1, At, B1); PG8_BAR; PG8_SCHED;
            PG8_LDA(At, 0, 1); PG8_STAGE(PG8_SB(0, 0), b2, voffB); PG8_STAGE(PG8_SB(0, 1), b2 + hstep, voffB); PG8_STAGEA(PG8_SA(0, 0), u2, k2, last, 0);
            PG8_WAIT_V(8); PG8_WAIT_L(0); PG8_BAR; PG8_MMA(1, 0, At, B0); PG8_MMA(1, 1, At, B1); PG8_BAR; PG8_SCHED;
            PG8_LDB(B0, 1, 0); PG8_LDB(B1, 1, 1); PG8_SCHED; PG8_LDA(At, 1, 0); PG8_STAGEA(PG8_SA(0, 1), u2, k2, last, 1);
            PG8_WAIT_V(8); PG8_WAIT_L(0); PG8_BAR; PG8_MMA(0, 0, At, B0); PG8_MMA(0, 1, At, B1); PG8_BAR; PG8_SCHED;
            PG8_LDA(At, 1, 1); PG8_STAGE(PG8_SB(1, 0), b3, voffB); PG8_STAGE(PG8_SB(1, 1), b3 + hstep, voffB); PG8_STAGEA(PG8_SA(1, 0), u2, k3, last, 0);
            PG8_WAIT_V(8); PG8_WAIT_L(0); PG8_BAR; PG8_MMA(1, 0, At, B0); PG8_MMA(1, 1, At, B1); PG8_BAR; PG8_SCHED;
        }
        if (wr == 0) PG8_BAR;
        E(acc, cur, wr, wc, fr, fq);
        if (!has_next) break;
#pragma unroll
        for (int a = 0; a < 2; ++a)
#pragma unroll
            for (int b = 0; b < 2; ++b)
#pragma unroll
                for (int m = 0; m < 4; ++m)
#pragma unroll
                    for (int n = 0; n < 2; ++n) acc[a][b][m][n] = (f32x4){0.f, 0.f, 0.f, 0.f};
        cur = nxt; cB = nB; cA = nA; ++ui;
        if constexpr (GATHER) { const u32x4 _t = *(const LAS u32x4*)vnslot; vc[0][0] = _t.x; vc[0][1] = _t.y; vc[1][0] = _t.z; vc[1][1] = _t.w; }
        if (wr == 1) PG8_BAR;
    }
    PG8_WAIT_V(0);
    PG8_BAR;
#undef PG8_SA
#undef PG8_SB
#undef PG8_STAGE
#undef PG8_STAGEA
#undef PG8_LDA
#undef PG8_LDB
#undef PG8_MMA
#undef PG8_WAIT_V
#undef PG8_WAIT_L
#undef PG8_BAR
#undef PG8_SCHED
}

struct DenseOrder {
    int nM, nN, nwg, G, c, K; const char* Bt;
    __device__ void init(int Mrows, int N, int K_, const void* Bt_, int G_, int c_) { nM = Mrows / BM; nN = N / BM; nwg = nM * nN; G = G_; c = c_; K = K_; Bt = (const char*)Bt_; }
    __device__ __forceinline__ bool next(int i, Unit& u) const {
        const long L = (long)i * G + c; if (L >= nwg) return false;
        int wgid = (int)L; { const int q = nwg / 8, r = nwg % 8, xcd = wgid % 8, off = wgid / 8; wgid = (xcd < r ? xcd * (q + 1) : r * (q + 1) + (xcd - r) * q) + off; }
        const int nig = 8 * nN, gid = wgid / nig, fm = gid * 8, gsz = (nM - fm) < 8 ? (nM - fm) : 8;
        u.pm = fm + ((wgid % nig) % gsz); u.pn = (wgid % nig) / gsz; u.B = Bt + (size_t)u.pn * BM * K * 2; u.e = 0; u.cnt = 0; u.off = 0; return true;
    }
    static constexpr bool GATHER = false;
    __device__ __forceinline__ size_t aoff(const Unit& u) const { return (size_t)u.pm * BM * K * 2; }
    __device__ __forceinline__ void avoff(const Unit&, const int (&)[2], const int (&)[2], unsigned (&)[2][2]) const {}
};
template <int NCOL, bool TOKROWS> struct ExpertOrder {
    static constexpr bool GATHER = true;
    __device__ __forceinline__ size_t aoff(const Unit&) const { return 0; }
    const LAS unsigned* tab; int per, c, K; const char* W; size_t wstride; const int* slot_ent;
    __device__ void init(const LAS unsigned* tab_, int K_, const void* W_, size_t wstride_, const int* slot_ent_, int G, int c_) {
        tab = tab_; K = K_; W = (const char*)W_; wstride = wstride_; slot_ent = slot_ent_; c = c_;
        const int U = (int)tab[T_TILE + NE] * NCOL; per = (U + G - 1) / G;
    }
    __device__ __forceinline__ bool next(int i, Unit& u) const {
        const int U = (int)tab[T_TILE + NE] * NCOL; const int L = c * per + i;
        if (i >= per || L >= U) return false;
        const int tile = L / NCOL; u.pn = L % NCOL;
        int lo = 0, hi = NE - 1;
        while (lo < hi) { const int mid = (lo + hi + 1) >> 1; if ((int)tab[T_TILE + mid] <= tile) lo = mid; else hi = mid - 1; }
        u.e = lo; u.pm = tile - (int)tab[T_TILE + lo]; u.cnt = (int)tab[T_CNT + lo]; u.off = (int)tab[T_OFF + lo];
        u.B = W + (size_t)lo * wstride + (size_t)u.pn * BM * K * 2; return true;
    }
    __device__ __forceinline__ void avoff(const Unit& u, const int (&)[2], const int (&)[2], unsigned (&v)[2][2]) const {
        int R[2], C[2]; int tidq = threadIdx.x; asm volatile("" : "+v"(tidq));
#pragma unroll
        for (int i = 0; i < 2; ++i) stage_rc(tidq * 16 + i * 8192, R[i], C[i]);
#pragma unroll
        for (int h = 0; h < 2; ++h)
#pragma unroll
            for (int i = 0; i < 2; ++i) {
                int r = u.pm * BM + h * HALF + R[i]; if (r >= u.cnt) r = u.cnt - 1;
                const int slot = u.off + r;
                const int row = TOKROWS ? (slot_ent[slot] >> 3) : slot;
                v[h][i] = (unsigned)(row * K + C[i]) * 2u;
            }
    }
};

struct EpiInProj {
    static constexpr bool PERM = true; bf16_t* O;
    __device__ __forceinline__ void operator()(const f32x4 (&acc)[2][2][4][2], const Unit& u, int wr, int wc, int fr, int fq) const {
        const float sc = (u.pn < 2) ? 0.125f : ((u.pn == 8 || u.pn == 9) ? 0.08838834764831845f : 1.f);
        const int row0 = u.pm * BM + wr * 64 + fr, col0 = u.pn * BM + wc * 32 + 8 * fq;
#pragma unroll
        for (int ai = 0; ai < 2; ++ai)
#pragma unroll
            for (int m = 0; m < 4; ++m) { bf16_t* rowp = O + (size_t)(row0 + ai * HALF + m * 16) * DIN + col0;
#pragma unroll
                for (int bj = 0; bj < 2; ++bj) { const f32x4 v0 = acc[ai][bj][m][0] * sc, v1 = acc[ai][bj][m][1] * sc;
                    u32x4 w; w.x = cvt_pk_bf16(v0[0], v0[1]); w.y = cvt_pk_bf16(v0[2], v0[3]); w.z = cvt_pk_bf16(v1[0], v1[1]); w.w = cvt_pk_bf16(v1[2], v1[3]);
                    *(u32x4*)(rowp + bj * HALF) = w; } }
    }
};
struct EpiOutProj {
    static constexpr bool PERM = false; const float* x; const float* mod; float* out;
    __device__ __forceinline__ void operator()(const f32x4 (&acc)[2][2][4][2], const Unit& u, int wr, int wc, int fr, int fq) const {
        const int b = (u.pm * BM) >> 11; const int col0 = u.pn * BM + wc * 32 + 4 * fq;
#pragma unroll
        for (int bj = 0; bj < 2; ++bj)
#pragma unroll
            for (int n = 0; n < 2; ++n) { const int col = col0 + bj * HALF + n * 16; const f32x4 g = *(const f32x4*)(mod + b * 6144 + MOD_GATE_A + col);
#pragma unroll
                for (int ai = 0; ai < 2; ++ai)
#pragma unroll
                    for (int m = 0; m < 4; ++m) { const size_t o = (size_t)(u.pm * BM + ai * HALF + wr * 64 + m * 16 + fr) * D + col;
                        const f32x4 xv = *(const f32x4*)(x + o); *(f32x4*)(out + o) = xv * ALPHA + g * acc[ai][bj][m][n]; } }
    }
};
struct EpiRouter {
    static constexpr bool PERM = false; float* out;
    __device__ __forceinline__ void operator()(const f32x4 (&acc)[2][2][4][2], const Unit& u, int wr, int wc, int fr, int fq) const {
        const int col0 = wc * 32 + 4 * fq;
#pragma unroll
        for (int ai = 0; ai < 2; ++ai)
#pragma unroll
            for (int m = 0; m < 4; ++m) { float* rowp = out + (size_t)(u.pm * BM + ai * HALF + wr * 64 + m * 16 + fr) * NE + col0;
#pragma unroll
                for (int bj = 0; bj < 2; ++bj)
#pragma unroll
                    for (int n = 0; n < 2; ++n) *(f32x4*)(rowp + bj * HALF + n * 16) = acc[ai][bj][m][n]; }
    }
};
template <bool EXPERT> struct EpiGU {
    static constexpr bool PERM = true; bf16_t* O; const float* slot_w;
    __device__ __forceinline__ void operator()(const f32x4 (&acc)[2][2][4][2], const Unit& u, int wr, int wc, int fr, int fq) const {
        const int h0 = u.pn * HALF + wc * 32 + 8 * fq;
#pragma unroll
        for (int ai = 0; ai < 2; ++ai)
#pragma unroll
            for (int m = 0; m < 4; ++m) {
                const int rt = u.pm * BM + ai * HALF + wr * 64 + m * 16 + fr;
                float w = 1.f; size_t orow = (size_t)rt;
                if (EXPERT) { if (rt >= u.cnt) continue; w = slot_w[u.off + rt]; orow = (size_t)(u.off + rt); }
                const f32x4 g0 = acc[ai][0][m][0], g1 = acc[ai][0][m][1], u0 = acc[ai][1][m][0], u1 = acc[ai][1][m][1];
                u32x4 o;
                o.x = cvt_pk_bf16(w * silu_f(g0[0]) * u0[0], w * silu_f(g0[1]) * u0[1]); o.y = cvt_pk_bf16(w * silu_f(g0[2]) * u0[2], w * silu_f(g0[3]) * u0[3]);
                o.z = cvt_pk_bf16(w * silu_f(g1[0]) * u1[0], w * silu_f(g1[1]) * u1[1]); o.w = cvt_pk_bf16(w * silu_f(g1[2]) * u1[2], w * silu_f(g1[3]) * u1[3]);
                *(u32x4*)(O + orow * DE + h0) = o;
            }
    }
};
struct EpiSharedDown {
    static constexpr bool PERM = false; const float* mod; float* out;
    __device__ __forceinline__ void operator()(const f32x4 (&acc)[2][2][4][2], const Unit& u, int wr, int wc, int fr, int fq) const {
        const int b = (u.pm * BM) >> 11; const int col0 = u.pn * BM + wc * 32 + 4 * fq;
#pragma unroll
        for (int bj = 0; bj < 2; ++bj)
#pragma unroll
            for (int n = 0; n < 2; ++n) { const int col = col0 + bj * HALF + n * 16; const f32x4 g = *(const f32x4*)(mod + b * 6144 + MOD_GATE_F + col);
#pragma unroll
                for (int ai = 0; ai < 2; ++ai)
#pragma unroll
                    for (int m = 0; m < 4; ++m) { const size_t o = (size_t)(u.pm * BM + ai * HALF + wr * 64 + m * 16 + fr) * D + col;
                        const f32x4 xv = *(const f32x4*)(out + o); *(f32x4*)(out + o) = xv * ALPHA + g * acc[ai][bj][m][n]; } }
    }
};
struct EpiExpDown {
    static constexpr bool PERM = true; unsigned char* ybuf; const int* slot_ent;
    __device__ __forceinline__ void operator()(const f32x4 (&acc)[2][2][4][2], const Unit& u, int wr, int wc, int fr, int fq) const {
        const int col0 = u.pn * BM + wc * 32 + 8 * fq;
#pragma unroll
        for (int ai = 0; ai < 2; ++ai)
#pragma unroll
            for (int m = 0; m < 4; ++m) {
                const int rt = u.pm * BM + ai * HALF + wr * 64 + m * 16 + fr; if (rt >= u.cnt) continue;
                unsigned char* rowp = ybuf + (size_t)slot_ent[u.off + rt] * D + col0;
#pragma unroll
                for (int bj = 0; bj < 2; ++bj) { const f32x4 v0 = acc[ai][bj][m][0] * YSCALE, v1 = acc[ai][bj][m][1] * YSCALE;
                    int w0 = __builtin_amdgcn_cvt_pk_fp8_f32(clamp8(v0[0]), clamp8(v0[1]), 0, false); w0 = __builtin_amdgcn_cvt_pk_fp8_f32(clamp8(v0[2]), clamp8(v0[3]), w0, true);
                    int w1 = __builtin_amdgcn_cvt_pk_fp8_f32(clamp8(v1[0]), clamp8(v1[1]), 0, false); w1 = __builtin_amdgcn_cvt_pk_fp8_f32(clamp8(v1[2]), clamp8(v1[3]), w1, true);
                    u32x2 o; o.x = (unsigned)w0; o.y = (unsigned)w1; *(u32x2*)(rowp + bj * HALF) = o; }
            }
    }
};
}

struct Ctx {
    const float *x, *c, *w_ada, *b_ada, *w_in, *w_out, *na_rpb, *ret_ld, *ret_gn, *ln1_g, *ln1_b, *ln2_g, *ln2_b, *w_router, *rbias, *w_gate, *w_up, *w_down, *ws_gate, *ws_up, *ws_down;
    float* out; unsigned char* ws;
};
constexpr int NW = 8;

__device__ __forceinline__ void transpose_item(const float* W, int K, int N, bf16_t* WT, int G, int which, LAS float* scr, int item, int lane) {
    const int nblk = N / 32, kb = item / nblk, nb = item % nblk, k0 = 64 * kb, n0 = 32 * nb;
#pragma unroll 8
    for (int i = 0; i < 32; ++i) { const int kk = 2 * i + (lane >> 5); scr[kk * 33 + (lane & 31)] = W[(size_t)(k0 + kk) * N + n0 + (lane & 31)]; }
    LDS_WAIT(); asm volatile("" ::: "memory");
    const int c = lane & 7;
#pragma unroll
    for (int j = 0; j < 4; ++j) { const int n = (lane >> 3) + 8 * j; const LAS float* s = scr + (8 * c) * 33 + n;
        u32x4 o; o.x = pk2(s[0 * 33], s[1 * 33]); o.y = pk2(s[2 * 33], s[3 * 33]); o.z = pk2(s[4 * 33], s[5 * 33]); o.w = pk2(s[6 * 33], s[7 * 33]);
        const int ng = n0 + n; const int drow = (G == 0) ? ng : ((ng / G) * 2 * G + which * G + (ng % G));
        *(u32x4*)(WT + (size_t)drow * K + k0 + 8 * c) = o; }
    LDS_WAIT(); asm volatile("" ::: "memory");
}
__device__ __forceinline__ void rope_entry(float* tab, int idx) {
    const int t = idx >> 6, i = idx & 63;
    const float inv_freq = powf(10000.f, -(float)(2 * i) / 128.f);
    const float ang = (float)t * inv_freq;
    const double a = (double)ang; const double two_pi = 6.283185307179586476925286766559;
    const double kf = rint(a / two_pi); double r = a - kf * two_pi;
    double sgn = 1.0; if (r > 1.5707963267948966) { r = 3.141592653589793 - r; sgn = -1.0; } else if (r < -1.5707963267948966) { r = -3.141592653589793 - r; sgn = -1.0; }
    const double r2 = r * r;
    const double s = r * (1.0 + r2 * (-1.0 / 6 + r2 * (1.0 / 120 + r2 * (-1.0 / 5040 + r2 * (1.0 / 362880 + r2 * (-1.0 / 39916800 + r2 * (1.0 / 6227020800.0 + r2 * (-1.0 / 1307674368000.0))))))));
    const double c = 1.0 + r2 * (-0.5 + r2 * (1.0 / 24 + r2 * (-1.0 / 720 + r2 * (1.0 / 40320 + r2 * (-1.0 / 3628800 + r2 * (1.0 / 479001600.0 + r2 * (-1.0 / 87178291200.0 + r2 * (1.0 / 20922789888000.0))))))));
    tab[idx] = (float)(sgn * c); tab[SEQ * 64 + idx] = (float)s;
}
__device__ __forceinline__ void mod_task(const float* __restrict__ cin, const float* __restrict__ w_ada, const float* __restrict__ b_ada, float* mod, int task, int lane) {
    const int j = task * 64 + lane;
    float acc[32];
#pragma unroll
    for (int b = 0; b < 32; ++b) acc[b] = 0.f;
    for (int k0 = 0; k0 < D; k0 += 64) {
        float cv[32];
#pragma unroll
        for (int b = 0; b < 32; ++b) cv[b] = silu_f(cin[b * D + k0 + lane]);
        for (int kk = 0; kk < 64; ++kk) {
            const float w = w_ada[(size_t)(k0 + kk) * 6144 + j];
#pragma unroll
            for (int b = 0; b < 32; ++b) acc[b] += __builtin_bit_cast(float, __builtin_amdgcn_readlane(__builtin_bit_cast(int, cv[b]), kk)) * w;
        }
    }
    const float bb = b_ada[j];
#pragma unroll
    for (int b = 0; b < 32; ++b) mod[b * 6144 + j] = acc[b] + bb;
}

__device__ __forceinline__ void na_item(const bf16_t* __restrict__ proj, const float* __restrict__ rpb, bf16_t* __restrict__ ymix, int gid) {
    const int h = gid & 7, tok = gid >> 3;
    const int b = tok >> 11, s = tok & 2047, r = s >> 6, c = s & 63;
    const int rs = min(max(r - 4, 0), 24), cs = min(max(c - 8, 0), 48);
    float q[64], acc[64];
    { const bf16_t* qp = proj + (size_t)tok * DIN + OFF_QNA + h * 64;
#pragma unroll
      for (int i = 0; i < 8; ++i) { const u32x4 v = *(const u32x4*)(qp + i * 8);
          q[i * 8 + 0] = __uint_as_float(v.x << 16); q[i * 8 + 1] = __uint_as_float(v.x & 0xffff0000u); q[i * 8 + 2] = __uint_as_float(v.y << 16); q[i * 8 + 3] = __uint_as_float(v.y & 0xffff0000u);
          q[i * 8 + 4] = __uint_as_float(v.z << 16); q[i * 8 + 5] = __uint_as_float(v.z & 0xffff0000u); q[i * 8 + 6] = __uint_as_float(v.w << 16); q[i * 8 + 7] = __uint_as_float(v.w & 0xffff0000u); } }
#pragma unroll
    for (int i = 0; i < 64; ++i) acc[i] = 0.f;
    float mx = -3.0e38f, l = 0.f;
    for (int kr = 0; kr < 8; ++kr) {
        for (int kc = 0; kc < 16; ++kc) {
            const int krow = rs + kr, kcol = cs + kc;
            const size_t kt = ((size_t)b << 11) + krow * 64 + kcol;
            const bf16_t* kp = proj + kt * DIN + OFF_KNA + h * 64; const bf16_t* vp = proj + kt * DIN + OFF_VNA + h * 64;
            float sc = 0.f;
#pragma unroll
            for (int i = 0; i < 8; ++i) { const u32x4 v = *(const u32x4*)(kp + i * 8);
                sc += q[i * 8 + 0] * __uint_as_float(v.x << 16) + q[i * 8 + 1] * __uint_as_float(v.x & 0xffff0000u) + q[i * 8 + 2] * __uint_as_float(v.y << 16) + q[i * 8 + 3] * __uint_as_float(v.y & 0xffff0000u)
                    + q[i * 8 + 4] * __uint_as_float(v.z << 16) + q[i * 8 + 5] * __uint_as_float(v.z & 0xffff0000u) + q[i * 8 + 6] * __uint_as_float(v.w << 16) + q[i * 8 + 7] * __uint_as_float(v.w & 0xffff0000u); }
            const int dr = krow - r + 7, dc = min(max(kcol - c + 15, 0), 30);
            sc += rpb[h * 465 + dr * 31 + dc];
            const float mn = fmaxf(mx, sc), corr = __expf(mx - mn), pe = __expf(sc - mn);
            l = l * corr + pe; mx = mn;
#pragma unroll
            for (int i = 0; i < 8; ++i) { const u32x4 v = *(const u32x4*)(vp + i * 8);
                acc[i * 8 + 0] = acc[i * 8 + 0] * corr + pe * __uint_as_float(v.x << 16); acc[i * 8 + 1] = acc[i * 8 + 1] * corr + pe * __uint_as_float(v.x & 0xffff0000u);
                acc[i * 8 + 2] = acc[i * 8 + 2] * corr + pe * __uint_as_float(v.y << 16); acc[i * 8 + 3] = acc[i * 8 + 3] * corr + pe * __uint_as_float(v.y & 0xffff0000u);
                acc[i * 8 + 4] = acc[i * 8 + 4] * corr + pe * __uint_as_float(v.z << 16); acc[i * 8 + 5] = acc[i * 8 + 5] * corr + pe * __uint_as_float(v.z & 0xffff0000u);
                acc[i * 8 + 6] = acc[i * 8 + 6] * corr + pe * __uint_as_float(v.w << 16); acc[i * 8 + 7] = acc[i * 8 + 7] * corr + pe * __uint_as_float(v.w & 0xffff0000u); }
        }
    }
    const float inv = 1.f / l;
    bf16_t* op = ymix + (size_t)tok * D + h * 64;
#pragma unroll
    for (int i = 0; i < 8; ++i) { u32x4 o; o.x = pk2(acc[i * 8 + 0] * inv, acc[i * 8 + 1] * inv); o.y = pk2(acc[i * 8 + 2] * inv, acc[i * 8 + 3] * inv);
        o.z = pk2(acc[i * 8 + 4] * inv, acc[i * 8 + 5] * inv); o.w = pk2(acc[i * 8 + 6] * inv, acc[i * 8 + 7] * inv); *(u32x4*)(op + i * 8) = o; }
}

__device__ __forceinline__ void ret_unit(const bf16_t* __restrict__ proj, const float* __restrict__ rope, const float* __restrict__ log_decay, float* __restrict__ ybuf, LAS unsigned char* lds, int unit) {
    LAS float* sq = (LAS float*)lds; LAS float* sk = sq + 16 * 128; LAS float* sv = sk + 16 * 128; LAS float* sy = sv + 16 * 128;
    const int dir = unit & 1, h = (unit >> 1) & 3, b = unit >> 3, tid = threadIdx.x;
    const int dv = tid & 127, qt = tid >> 7;
    const float g = __expf(log_decay[dir * 4 + h]);
    float S[32];
#pragma unroll
    for (int i = 0; i < 32; ++i) S[i] = 0.f;
    float* yo = ybuf + (size_t)dir * M * 512;
    for (int t0 = 0; t0 < SEQ; t0 += 16) {
        __syncthreads();
#pragma unroll
        for (int i = 0; i < 4; ++i) {
            const int q = tid + 512 * i;
            const int u = q >> 7, which = (q >> 6) & 1, pr = q & 63;
            const int t = dir ? (SEQ - 1 - (t0 + u)) : (t0 + u);
            const bf16_t* rowp = proj + ((size_t)(b * SEQ + t)) * DIN + (which ? OFF_KR : OFF_QR) + h * 128;
            const float a1 = bf2f(rowp[pr]), a2 = bf2f(rowp[pr + 64]);
            const float cs = rope[t * 64 + pr], sn = rope[SEQ * 64 + t * 64 + pr];
            LAS float* dst = (which ? sk : sq) + u * 128;
            dst[pr] = a1 * cs - a2 * sn; dst[pr + 64] = a2 * cs + a1 * sn;
        }
#pragma unroll
        for (int i = 0; i < 4; ++i) { const int q = tid + 512 * i; const int u = q >> 7, d = q & 127; const int t = dir ? (SEQ - 1 - (t0 + u)) : (t0 + u);
            sv[u * 128 + d] = bf2f(proj[((size_t)(b * SEQ + t)) * DIN + OFF_VR + h * 128 + d]); }
        __syncthreads();
        for (int u = 0; u < 16; ++u) {
            const float v = sv[u * 128 + dv]; float y = 0.f;
            if (dir == 0) {
#pragma unroll
                for (int i = 0; i < 32; ++i) { S[i] = g * S[i] + sk[u * 128 + qt * 32 + i] * v; y += sq[u * 128 + qt * 32 + i] * S[i]; }
            } else {
#pragma unroll
                for (int i = 0; i < 32; ++i) { y += sq[u * 128 + qt * 32 + i] * S[i]; S[i] = g * (S[i] + sk[u * 128 + qt * 32 + i] * v); }
            }
            sy[(u * 4 + qt) * 128 + dv] = y;
        }
        __syncthreads();
#pragma unroll
        for (int i = 0; i < 4; ++i) { const int q = tid + 512 * i; const int u = q >> 7, d = q & 127; const int t = dir ? (SEQ - 1 - (t0 + u)) : (t0 + u);
            yo[((size_t)(b * SEQ + t)) * 512 + h * 128 + d] = (sy[(u * 4 + 0) * 128 + d] + sy[(u * 4 + 1) * 128 + d]) + (sy[(u * 4 + 2) * 128 + d] + sy[(u * 4 + 3) * 128 + d]); }
    }
    __syncthreads();
}

namespace ret {
typedef short s16x4 __attribute__((ext_vector_type(4)));
typedef __bf16 bfx2 __attribute__((ext_vector_type(2)));
constexpr unsigned RS = 288, TILE = 128 * RS, LK = 0, LV = TILE, LRF = 2 * TILE, LRB = 3 * TILE;
constexpr float LOG2E = 1.4426950408889634f;
__device__ __forceinline__ unsigned offb(unsigned row, unsigned ch) { return RS * row + 16u * ch; }
__device__ __forceinline__ unsigned cvtpk(float lo, float hi) { const f32x2 v = {lo, hi}; return __builtin_bit_cast(unsigned, __builtin_convertvector(v, bfx2)); }
__device__ __forceinline__ bf16x8 pack8(const float (&f)[8]) { u32x4 u; u.x = cvtpk(f[0], f[1]); u.y = cvtpk(f[2], f[3]); u.z = cvtpk(f[4], f[5]); u.w = cvtpk(f[6], f[7]); return __builtin_bit_cast(bf16x8, u); }
__device__ __forceinline__ void unpack8(const bf16x8 v, float (&f)[8]) { const u32x4 u = __builtin_bit_cast(u32x4, v);
    f[0] = __uint_as_float(u.x << 16); f[1] = __uint_as_float(u.x & 0xffff0000u); f[2] = __uint_as_float(u.y << 16); f[3] = __uint_as_float(u.y & 0xffff0000u);
    f[4] = __uint_as_float(u.z << 16); f[5] = __uint_as_float(u.z & 0xffff0000u); f[6] = __uint_as_float(u.w << 16); f[7] = __uint_as_float(u.w & 0xffff0000u); }
__device__ __forceinline__ bf16x8 trfrag(LAS unsigned char* base, unsigned row0, unsigned row1, unsigned cblk, unsigned qp, unsigned p) {
    const unsigned ch = 2u * cblk + (p >> 1), bo = 8u * (p & 1u);
    const s16x4 lo = __builtin_amdgcn_ds_read_tr16_b64_v4i16((LAS s16x4*)(base + offb(row0 + qp, ch) + bo));
    const s16x4 hi = __builtin_amdgcn_ds_read_tr16_b64_v4i16((LAS s16x4*)(base + offb(row1 + qp, ch) + bo));
    return __builtin_shufflevector(lo, hi, 0, 1, 2, 3, 4, 5, 6, 7);
}
__device__ __forceinline__ void stage_kv(LAS unsigned char* lds, const bf16_t* __restrict__ proj, const float* __restrict__ rope, int b, int h, int n, int tid) {
#pragma unroll
    for (int i = 0; i < 2; ++i) {
        const int q2 = tid + 512 * i, row = q2 >> 3, pc = q2 & 7, t = n * 128 + row;
        const bf16_t* rp = proj + (size_t)(b * SEQ + t) * DIN + OFF_KR + h * 128;
        float fa[8], fb[8], o1[8], o2[8];
        unpack8(*(const bf16x8*)(rp + pc * 8), fa); unpack8(*(const bf16x8*)(rp + 64 + pc * 8), fb);
        const f32x4 c0 = *(const f32x4*)(rope + t * 64 + pc * 8), c1 = *(const f32x4*)(rope + t * 64 + pc * 8 + 4);
        const f32x4 s0 = *(const f32x4*)(rope + SEQ * 64 + t * 64 + pc * 8), s1 = *(const f32x4*)(rope + SEQ * 64 + t * 64 + pc * 8 + 4);
        const float cs[8] = {c0.x, c0.y, c0.z, c0.w, c1.x, c1.y, c1.z, c1.w}, sn[8] = {s0.x, s0.y, s0.z, s0.w, s1.x, s1.y, s1.z, s1.w};
#pragma unroll
        for (int e = 0; e < 8; ++e) { o1[e] = fa[e] * cs[e] - fb[e] * sn[e]; o2[e] = fb[e] * cs[e] + fa[e] * sn[e]; }
        *(LAS bf16x8*)(lds + LK + offb(row, pc)) = pack8(o1); *(LAS bf16x8*)(lds + LK + offb(row, pc + 8)) = pack8(o2);
    }
#pragma unroll
    for (int i = 0; i < 4; ++i) {
        const int q4 = tid + 512 * i, row = q4 >> 4, ch = q4 & 15, t = n * 128 + row;
        *(LAS bf16x8*)(lds + LV + offb(row, ch)) = *(const bf16x8*)(proj + (size_t)(b * SEQ + t) * DIN + OFF_VR + h * 128 + ch * 8);
    }
}
template <bool FWD> __device__ __forceinline__ void state_update(LAS unsigned char* lds, f32x4 (&racc)[8], float l2, int w, int g, unsigned qp, unsigned p) {
    const float dec = __builtin_amdgcn_exp2f(128.f * l2);
    bf16x8 vs[4];
#pragma unroll
    for (int ks = 0; ks < 4; ++ks) {
        float f[8]; unpack8(trfrag(lds + LV, 32 * ks + 8 * g, 32 * ks + 8 * g + 4, w, qp, p), f);
#pragma unroll
        for (int e = 0; e < 8; ++e) { const int key = 32 * ks + 8 * g + e; f[e] *= __builtin_amdgcn_exp2f((FWD ? (float)(127 - key) : (float)key) * l2); }
        vs[ks] = pack8(f);
    }
#pragma unroll
    for (int nb = 0; nb < 8; ++nb) {
        racc[nb] = racc[nb] * dec;
#pragma unroll
        for (int ks = 0; ks < 4; ++ks) racc[nb] = __builtin_amdgcn_mfma_f32_16x16x32_bf16(vs[ks], trfrag(lds + LK, 32 * ks + 8 * g, 32 * ks + 8 * g + 4, nb, qp, p), racc[nb], 0, 0, 0);
    }
}
__device__ __forceinline__ void unit(const bf16_t* __restrict__ proj, const float* __restrict__ rope, const float* __restrict__ log_decay, const float* __restrict__ gn_g, bf16_t* __restrict__ ymix,
                                     unsigned char* __restrict__ scratch  , LAS unsigned char* lds, int u) {
    const int b = u >> 2, h = u & 3;
    int tid_ = threadIdx.x; asm volatile("" : "+v"(tid_));
    const int tid0 = tid_, w = __builtin_amdgcn_readfirstlane(tid0 >> 6);
#define RET_LANE int tid = tid0; asm volatile("" : "+v"(tid)); const int lane = tid & 63, r = lane & 15, g = lane >> 4; const unsigned qp = (unsigned)r >> 2, p = (unsigned)lane & 3u;
    const float lf2_ = log_decay[h] * LOG2E, lb2_ = log_decay[4 + h] * LOG2E;
    f32x4 racc[8];
#pragma unroll
    for (int nb = 0; nb < 8; ++nb) racc[nb] = (f32x4){0.f, 0.f, 0.f, 0.f};
    for (int n = 15; n >= 0; --n) {
        RET_LANE
        unsigned char* img = scratch + (size_t)n * TILE;
#pragma unroll
        for (int nb = 0; nb < 8; ++nb) { u32x2 o; o.x = cvtpk(racc[nb][0], racc[nb][1]); o.y = cvtpk(racc[nb][2], racc[nb][3]);
            *(u32x2*)(img + offb(16 * nb + r, 2 * w + (g >> 1)) + 8 * (g & 1)) = o; }
        if (n == 0) break;
        float lb2 = lb2_; asm volatile("" : "+v"(lb2));
        __syncthreads();
        stage_kv(lds, proj, rope, b, h, n, tid);
        __syncthreads();
        state_update<false>(lds, racc, lb2, w, g, qp, p);
    }
    asm volatile("s_waitcnt vmcnt(0)" ::: "memory");
    __syncthreads();
    __builtin_amdgcn_fence(__ATOMIC_ACQUIRE, "agent");
    asm volatile("s_waitcnt vmcnt(0)" ::: "memory");
#pragma unroll
    for (int nb = 0; nb < 8; ++nb) racc[nb] = (f32x4){0.f, 0.f, 0.f, 0.f};
    for (int n = 0; n < 16; ++n) {
        RET_LANE
        float lf2 = lf2_, lb2 = lb2_; asm volatile("" : "+v"(lf2), "+v"(lb2));
        const float* gnp = gn_g; asm volatile("" : "+s"(gnp));
        __syncthreads();
        stage_kv(lds, proj, rope, b, h, n, tid);
        { const unsigned char* img = scratch + (size_t)n * TILE;
#pragma unroll
          for (int i = 0; i < 5; ++i) { const int q4 = tid + 512 * i; if (q4 < (int)TILE / 16) *(LAS u32x4*)(lds + LRB + q4 * 16) = *(const u32x4*)(img + q4 * 16); } }
#pragma unroll
        for (int nb = 0; nb < 8; ++nb) { u32x2 o; o.x = cvtpk(racc[nb][0], racc[nb][1]); o.y = cvtpk(racc[nb][2], racc[nb][3]);
            *(LAS u32x2*)(lds + LRF + offb(16 * nb + r, 2 * w + (g >> 1)) + 8 * (g & 1)) = o; }
        const int cq = 16 * w + r, tq = n * 128 + cq;
        bf16x8 qn[4], qf[4], qb[4];
        { const bf16_t* rp = proj + (size_t)(b * SEQ + tq) * DIN + OFF_QR + h * 128 + 8 * g;
          const float sf = __builtin_amdgcn_exp2f((float)(cq + 1) * lf2), sb = __builtin_amdgcn_exp2f((float)(128 - cq) * lb2);
#pragma unroll
          for (int ks = 0; ks < 2; ++ks) {
              float fa[8], fb[8], o1[8], o2[8], t1[8], t2[8];
              unpack8(*(const bf16x8*)(rp + 32 * ks), fa); unpack8(*(const bf16x8*)(rp + 32 * ks + 64), fb);
              const float* cp = rope + tq * 64 + 32 * ks + 8 * g; const float* sp = cp + SEQ * 64;
              const f32x4 c0 = *(const f32x4*)cp, c1 = *(const f32x4*)(cp + 4), s0 = *(const f32x4*)sp, s1 = *(const f32x4*)(sp + 4);
              const float cs[8] = {c0.x, c0.y, c0.z, c0.w, c1.x, c1.y, c1.z, c1.w}, sn[8] = {s0.x, s0.y, s0.z, s0.w, s1.x, s1.y, s1.z, s1.w};
#pragma unroll
              for (int e = 0; e < 8; ++e) { o1[e] = fa[e] * cs[e] - fb[e] * sn[e]; o2[e] = fb[e] * cs[e] + fa[e] * sn[e]; }
              qn[ks] = pack8(o1); qn[ks + 2] = pack8(o2);
#pragma unroll
              for (int e = 0; e < 8; ++e) { t1[e] = o1[e] * sf; t2[e] = o2[e] * sf; }
              qf[ks] = pack8(t1); qf[ks + 2] = pack8(t2);
#pragma unroll
              for (int e = 0; e < 8; ++e) { t1[e] = o1[e] * sb; t2[e] = o2[e] * sb; }
              qb[ks] = pack8(t1); qb[ks + 2] = pack8(t2);
          } }
        __syncthreads();
        bf16x8 pt[4];
#pragma unroll
        for (int ks2 = 0; ks2 < 4; ++ks2) {
            float pv[8];
#pragma unroll
            for (int hb = 0; hb < 2; ++hb) {
                const int mb = 2 * ks2 + hb;
                f32x4 st = (f32x4){0.f, 0.f, 0.f, 0.f};
#pragma unroll
                for (int ks = 0; ks < 4; ++ks) st = __builtin_amdgcn_mfma_f32_16x16x32_bf16(*(const LAS bf16x8*)(lds + LK + offb(16 * mb + r, 4 * ks + g)), qn[ks], st, 0, 0, 0);
#pragma unroll
                for (int j = 0; j < 4; ++j) { const int diff = cq - (16 * mb + 4 * g + j); pv[4 * hb + j] = st[j] * __builtin_amdgcn_exp2f(diff >= 0 ? (float)diff * lf2 : (float)(-diff) * lb2); }
            }
            pt[ks2] = pack8(pv);
        }
        f32x4 yacc[8];
#pragma unroll
        for (int mbv = 0; mbv < 8; ++mbv) {
            f32x4 y = (f32x4){0.f, 0.f, 0.f, 0.f};
#pragma unroll
            for (int ks2 = 0; ks2 < 4; ++ks2) y = __builtin_amdgcn_mfma_f32_16x16x32_bf16(trfrag(lds + LV, 32 * ks2 + 4 * g, 32 * ks2 + 16 + 4 * g, mbv, qp, p), pt[ks2], y, 0, 0, 0);
#pragma unroll
            for (int ks = 0; ks < 4; ++ks) {
                y = __builtin_amdgcn_mfma_f32_16x16x32_bf16(trfrag(lds + LRF, 32 * ks + 8 * g, 32 * ks + 8 * g + 4, mbv, qp, p), qf[ks], y, 0, 0, 0);
                y = __builtin_amdgcn_mfma_f32_16x16x32_bf16(trfrag(lds + LRB, 32 * ks + 8 * g, 32 * ks + 8 * g + 4, mbv, qp, p), qb[ks], y, 0, 0, 0);
            }
            yacc[mbv] = y;
        }
        { float s = 0.f;
#pragma unroll
          for (int mbv = 0; mbv < 8; ++mbv) s += (yacc[mbv][0] + yacc[mbv][1]) + (yacc[mbv][2] + yacc[mbv][3]);
          s += __shfl_xor(s, 16); s += __shfl_xor(s, 32);
          const float mu = s * (1.f / 128.f); float s2 = 0.f;
#pragma unroll
          for (int mbv = 0; mbv < 8; ++mbv) { yacc[mbv] = yacc[mbv] - mu; s2 += (yacc[mbv][0] * yacc[mbv][0] + yacc[mbv][1] * yacc[mbv][1]) + (yacc[mbv][2] * yacc[mbv][2] + yacc[mbv][3] * yacc[mbv][3]); }
          s2 += __shfl_xor(s2, 16); s2 += __shfl_xor(s2, 32);
          const float rstd = 1.f / sqrtf(s2 * (1.f / 128.f) + GN_EPS);
          const bf16_t* gp = proj + (size_t)(b * SEQ + tq) * DIN + OFF_GR + h * 128 + 4 * g;
          bf16_t* op = ymix + (size_t)(b * SEQ + tq) * D + 512 + h * 128 + 4 * g;
#pragma unroll
          for (int mbv = 0; mbv < 8; ++mbv) {
              const u32x2 gv = *(const u32x2*)(gp + 16 * mbv); const f32x4 gn = *(const f32x4*)(gnp + h * 128 + 16 * mbv + 4 * g);
              const float g0 = __uint_as_float(gv.x << 16), g1 = __uint_as_float(gv.x & 0xffff0000u), g2 = __uint_as_float(gv.y << 16), g3 = __uint_as_float(gv.y & 0xffff0000u);
              u32x2 o; o.x = cvtpk(silu_f(g0) * (yacc[mbv][0] * rstd * gn.x), silu_f(g1) * (yacc[mbv][1] * rstd * gn.y));
              o.y = cvtpk(silu_f(g2) * (yacc[mbv][2] * rstd * gn.z), silu_f(g3) * (yacc[mbv][3] * rstd * gn.w));
              *(u32x2*)(op + 16 * mbv) = o;
          } }
        state_update<true>(lds, racc, lf2, w, g, qp, p);
    }
    __syncthreads();
#undef RET_LANE
}
}


namespace na {
constexpr unsigned LKR = 0, LVR = 73728, LRPB = 147456;
__device__ __forceinline__ void load_row(LAS unsigned char* lds, const bf16_t* __restrict__ proj, int b, int head, int krow, int tid) {
    const int key = tid >> 3, ch = tid & 7, slot = krow % 9;
    const bf16_t* rp = proj + (size_t)(b * SEQ + krow * 64 + key) * DIN + head * 64 + ch * 8;
    const unsigned o = (unsigned)slot * 8192u + 128u * key + 16u * (ch ^ (key & 7));
    *(LAS u32x4*)(lds + LKR + o) = *(const u32x4*)(rp + OFF_KNA);
    *(LAS u32x4*)(lds + LVR + o) = *(const u32x4*)(rp + OFF_VNA);
}
__device__ __forceinline__ void unit(const bf16_t* __restrict__ proj, const float* __restrict__ rpb, bf16_t* __restrict__ ymix, LAS unsigned char* lds, int u) {
    const int b = u >> 3, head = u & 7;
    int tid_ = threadIdx.x; asm volatile("" : "+v"(tid_));
    const int tid0 = tid_, w = __builtin_amdgcn_readfirstlane(tid0 >> 6);
    __syncthreads();
    if (tid0 < 465) ((LAS float*)(lds + LRPB))[tid0] = rpb[head * 465 + tid0];
    const int ct = w & 3, cb = (ct == 0) ? 0 : (ct == 1 ? 8 : (ct == 2 ? 24 : 32));
    int loaded_hi = -1;
    for (int st = 0; st < 16; ++st) {
        int tid = tid0; asm volatile("" : "+v"(tid));
        const int lane = tid & 63, qi = lane & 15, g = lane >> 4; const unsigned qp = (unsigned)qi >> 2, p = (unsigned)lane & 3u;
        const int r = 2 * st + (w >> 2);
        const int rs = min(max(r - 4, 0), 24);
        const int need_hi = min(max(2 * st + 1 - 4, 0), 24) + 7;
        __syncthreads();
        for (int kr = loaded_hi + 1; kr <= need_hi; ++kr) load_row(lds, proj, b, head, kr, tid);
        loaded_hi = need_hi;
        const int cq = 16 * ct + qi, tq = b * SEQ + r * 64 + cq;
        bf16x8 qn[2];
        { const bf16_t* qptr = proj + (size_t)tq * DIN + OFF_QNA + head * 64 + 8 * g; qn[0] = *(const bf16x8*)qptr; qn[1] = *(const bf16x8*)(qptr + 32); }
        __syncthreads();
        const int cs = min(max(cq - 8, 0), 48);
        const unsigned kb0 = 128u * qi + 16u * ((unsigned)g ^ ((unsigned)qi & 7u)), kb1 = 128u * qi + 16u * ((4u + (unsigned)g) ^ ((unsigned)qi & 7u));
        const LAS float* bias = (const LAS float*)(lds + LRPB);
        f32x4 sc[16]; float mx = -3.0e38f;
#pragma unroll
        for (int kr = 0; kr < 8; ++kr) {
            const int krow = rs + kr; const unsigned so = (unsigned)(krow % 9) * 8192u + 128u * (unsigned)cb;
            const int dr = krow - r + 7;
#pragma unroll
            for (int h2 = 0; h2 < 2; ++h2) {
                f32x4 a = (f32x4){0.f, 0.f, 0.f, 0.f};
                a = __builtin_amdgcn_mfma_f32_16x16x32_bf16(*(const LAS bf16x8*)(lds + LKR + so + 2048u * h2 + kb0), qn[0], a, 0, 0, 0);
                a = __builtin_amdgcn_mfma_f32_16x16x32_bf16(*(const LAS bf16x8*)(lds + LKR + so + 2048u * h2 + kb1), qn[1], a, 0, 0, 0);
#pragma unroll
                for (int j = 0; j < 4; ++j) {
                    const int kcol = cb + 16 * h2 + 4 * g + j;
                    const int dc = min(max(kcol - cq + 15, 0), 30);
                    const float v = a[j] + bias[dr * 31 + dc];
                    const bool in = (kcol >= cs) && (kcol < cs + 16);
                    a[j] = in ? v : -3.0e38f; mx = fmaxf(mx, a[j]);
                }
                sc[2 * kr + h2] = a;
            }
        }
        mx = fmaxf(mx, __shfl_xor(mx, 16)); mx = fmaxf(mx, __shfl_xor(mx, 32));
        float sum = 0.f; bf16x8 pt[8];
#pragma unroll
        for (int kk = 0; kk < 8; ++kk) {
            float pv[8];
#pragma unroll
            for (int h2 = 0; h2 < 2; ++h2)
#pragma unroll
                for (int j = 0; j < 4; ++j) { const float e = __builtin_amdgcn_exp2f((sc[2 * kk + h2][j] - mx) * 1.4426950408889634f); pv[4 * h2 + j] = e; sum += e; }
            pt[kk] = ret::pack8(pv);
        }
        sum += __shfl_xor(sum, 16); sum += __shfl_xor(sum, 32);
        const float inv = 1.f / sum;
        const unsigned sl = (((unsigned)g & 1u) << 2) | qp;
        bf16_t* op = ymix + (size_t)tq * D + head * 64 + 4 * g;
#pragma unroll
        for (int db = 0; db < 4; ++db) {
            const unsigned vb = 128u * (4u * (unsigned)g + qp) + 16u * ((2u * db + (p >> 1)) ^ sl) + 8u * (p & 1u);
            f32x4 y = (f32x4){0.f, 0.f, 0.f, 0.f};
#pragma unroll
            for (int kk = 0; kk < 8; ++kk) {
                const unsigned so = (unsigned)((rs + kk) % 9) * 8192u + 128u * (unsigned)cb;
                const ret::s16x4 lo = __builtin_amdgcn_ds_read_tr16_b64_v4i16((LAS ret::s16x4*)(lds + LVR + so + vb));
                const ret::s16x4 hi = __builtin_amdgcn_ds_read_tr16_b64_v4i16((LAS ret::s16x4*)(lds + LVR + so + 2048u + vb));
                y = __builtin_amdgcn_mfma_f32_16x16x32_bf16(__builtin_shufflevector(lo, hi, 0, 1, 2, 3, 4, 5, 6, 7), pt[kk], y, 0, 0, 0);
            }
            u32x2 o; o.x = ret::cvtpk(y[0] * inv, y[1] * inv); o.y = ret::cvtpk(y[2] * inv, y[3] * inv);
            *(u32x2*)(op + 16 * db) = o;
        }
    }
    __syncthreads();
}
}

__device__ __forceinline__ void ret_fin_item(const float* __restrict__ ybuf, const bf16_t* __restrict__ proj, const float* __restrict__ gn_g, bf16_t* __restrict__ ymix, int w, int lane) {
    const int tok = w >> 2, h = w & 3;
    const size_t o = (size_t)tok * 512 + h * 128 + lane * 2;
    const f32x2 a = *(const f32x2*)(ybuf + o), bb = *(const f32x2*)(ybuf + (size_t)M * 512 + o);
    const float y0 = a.x + bb.x, y1 = a.y + bb.y;
    const float mu = wave_sum(y0 + y1) * (1.f / 128.f); const float d0 = y0 - mu, d1 = y1 - mu;
    const float var = wave_sum(d0 * d0 + d1 * d1) * (1.f / 128.f); const float rs = 1.f / sqrtf(var + GN_EPS);
    const bf16_t* gp = proj + (size_t)tok * DIN + OFF_GR + h * 128 + lane * 2;
    const float g0 = bf2f(gp[0]), g1 = bf2f(gp[1]);
    const float o0 = silu_f(g0) * (d0 * rs * gn_g[h * 128 + lane * 2]), o1 = silu_f(g1) * (d1 * rs * gn_g[h * 128 + lane * 2 + 1]);
    *(unsigned*)(ymix + (size_t)tok * D + 512 + h * 128 + lane * 2) = pk2(o0, o1);
}
__device__ __forceinline__ void ln1_row(float* __restrict__ io, const float* __restrict__ g, const float* __restrict__ bb, const float* __restrict__ mod, bf16_t* __restrict__ hf, int row, int lane) {
    const int b = row >> 11;
    f32x4 v[4]; float s = 0.f;
#pragma unroll
    for (int j = 0; j < 4; ++j) { v[j] = *(const f32x4*)(io + (size_t)row * D + j * 256 + lane * 4); s += (v[j].x + v[j].y) + (v[j].z + v[j].w); }
    const float mean = wave_sum(s) * (1.f / D); float s2 = 0.f;
#pragma unroll
    for (int j = 0; j < 4; ++j) { v[j] = v[j] - mean; s2 += (v[j].x * v[j].x + v[j].y * v[j].y) + (v[j].z * v[j].z + v[j].w * v[j].w); }
    const float rstd = 1.f / sqrtf(wave_sum(s2) * (1.f / D) + LN_EPS);
#pragma unroll
    for (int j = 0; j < 4; ++j) { const int col = j * 256 + lane * 4;
        const f32x4 gg = *(const f32x4*)(g + col), bv = *(const f32x4*)(bb + col);
        const f32x4 x1 = v[j] * rstd * gg + bv;
        *(f32x4*)(io + (size_t)row * D + col) = x1;
        const f32x4 sc = *(const f32x4*)(mod + b * 6144 + MOD_SCALE_F + col), sh = *(const f32x4*)(mod + b * 6144 + MOD_SHIFT_F + col);
        u32x2 o; o.x = pk2(x1.x * (1.f + sc.x) + sh.x, x1.y * (1.f + sc.y) + sh.y); o.y = pk2(x1.z * (1.f + sc.z) + sh.z, x1.w * (1.f + sc.w) + sh.w);
        *(u32x2*)(hf + (size_t)row * D + col) = o; }
}
__device__ __forceinline__ void top2_merge(float& a1, float& a2, float b1, float b2) { const float n1 = fmaxf(a1, b1); const float n2 = fmaxf(fminf(a1, b1), fmaxf(a2, b2)); a1 = n1; a2 = n2; }
__device__ __forceinline__ void route_token(const float* __restrict__ logits, const f32x4 bias, int* __restrict__ topk_e, float* __restrict__ topk_w, LAS unsigned* hist, int tok, int lane) {
    const f32x4 lg = *(const f32x4*)(logits + (size_t)tok * NE + lane * 4);
    const float sc0 = 1.f / (1.f + __expf(-lg.x)), sc1 = 1.f / (1.f + __expf(-lg.y)), sc2 = 1.f / (1.f + __expf(-lg.z)), sc3 = 1.f / (1.f + __expf(-lg.w));
    float s0 = sc0 + bias.x, s1 = sc1 + bias.y, s2 = sc2 + bias.z, s3 = sc3 + bias.w;
    float m1 = fmaxf(s0, s1), m2 = fminf(s0, s1); top2_merge(m1, m2, fmaxf(s2, s3), fminf(s2, s3));
#pragma unroll
    for (int o = 1; o < 8; o <<= 1) { const float b1 = __shfl_xor(m1, o), b2 = __shfl_xor(m2, o); top2_merge(m1, m2, b1, b2); }
    const float gs = m1 + m2; const int grp = lane >> 3;
    int rank = 0;
#pragma unroll
    for (int gq = 0; gq < 8; ++gq) { const float og = __shfl(gs, gq * 8); rank += (og > gs || (og == gs && gq < grp)) ? 1 : 0; }
    const float NEG = -3.0e38f;
    if (rank >= 4) { s0 = NEG; s1 = NEG; s2 = NEG; s3 = NEG; }
    float wsum = 0.f; float myw = 0.f; int mye = 0;
#pragma unroll
    for (int k = 0; k < TOPK; ++k) {
        float bv = s0; int bi = 0;
        if (s1 > bv) { bv = s1; bi = 1; }
        if (s2 > bv) { bv = s2; bi = 2; }
        if (s3 > bv) { bv = s3; bi = 3; }
        int be = lane * 4 + bi;
#pragma unroll
        for (int o = 1; o < 64; o <<= 1) { const float ov = __shfl_xor(bv, o); const int oe = __shfl_xor(be, o); if (ov > bv || (ov == bv && oe < be)) { bv = ov; be = oe; } }
        const int ol = be >> 2, oj = be & 3;
        const float mysc = oj == 0 ? sc0 : (oj == 1 ? sc1 : (oj == 2 ? sc2 : sc3));
        const float wsel = __shfl(mysc, ol);
        if (lane == ol) { if (oj == 0) s0 = NEG; else if (oj == 1) s1 = NEG; else if (oj == 2) s2 = NEG; else s3 = NEG; }
        wsum += wsel;
        if (lane == k) { myw = wsel; mye = be; }
    }
    if (lane < TOPK) { topk_e[tok * TOPK + lane] = mye; topk_w[tok * TOPK + lane] = myw / wsum * 2.5f; __hip_atomic_fetch_add(&hist[mye], 1u, __ATOMIC_RELAXED, __HIP_MEMORY_SCOPE_WORKGROUP); }
}
__device__ __forceinline__ void build_tables(const unsigned* ctl, LAS unsigned* tab) {
    if (threadIdx.x < 64) {
        const int lane = threadIdx.x;
        unsigned c[4], so = 0, st = 0;
#pragma unroll
        for (int j = 0; j < 4; ++j) { c[j] = __hip_atomic_load(ctl + CW_COUNT + lane * 4 + j, __ATOMIC_RELAXED, __HIP_MEMORY_SCOPE_AGENT); so += c[j]; st += (c[j] + 255u) >> 8; }
        unsigned io = so, it = st;
#pragma unroll
        for (int o = 1; o < 64; o <<= 1) { const unsigned a = __shfl_up(io, o), b = __shfl_up(it, o); if (lane >= o) { io += a; it += b; } }
        unsigned eo = io - so, et = it - st;
#pragma unroll
        for (int j = 0; j < 4; ++j) { tab[T_CNT + lane * 4 + j] = c[j]; tab[T_OFF + lane * 4 + j] = eo; tab[T_TILE + lane * 4 + j] = et; eo += c[j]; et += (c[j] + 255u) >> 8; }
        if (lane == 63) { tab[T_OFF + NE] = eo; tab[T_TILE + NE] = et; }
    }
    __syncthreads();
}
__device__ __forceinline__ void final_row(float* __restrict__ io, const unsigned char* __restrict__ ybuf, const float* __restrict__ g, const float* __restrict__ bb, const float* __restrict__ mod, int row, int lane) {
    const int b = row >> 11;
    f32x4 v[4]; float s = 0.f;
#pragma unroll
    for (int j = 0; j < 4; ++j) {
        const int col = j * 256 + lane * 4;
        f32x4 a = (f32x4){0.f, 0.f, 0.f, 0.f};
#pragma unroll
        for (int k = 0; k < TOPK; ++k) {
            const unsigned pk = *(const unsigned*)(ybuf + ((size_t)row * TOPK + k) * D + col);
            const f32x2 lo = __builtin_amdgcn_cvt_pk_f32_fp8((int)pk, false), hi = __builtin_amdgcn_cvt_pk_f32_fp8((int)pk, true);
            a.x += lo.x; a.y += lo.y; a.z += hi.x; a.w += hi.y;
        }
        const f32x4 gt = *(const f32x4*)(mod + b * 6144 + MOD_GATE_F + col);
        v[j] = *(const f32x4*)(io + (size_t)row * D + col) + gt * a * YINV;
        s += (v[j].x + v[j].y) + (v[j].z + v[j].w);
    }
    const float mean = wave_sum(s) * (1.f / D); float s2 = 0.f;
#pragma unroll
    for (int j = 0; j < 4; ++j) { v[j] = v[j] - mean; s2 += (v[j].x * v[j].x + v[j].y * v[j].y) + (v[j].z * v[j].z + v[j].w * v[j].w); }
    const float rstd = 1.f / sqrtf(wave_sum(s2) * (1.f / D) + LN_EPS);
#pragma unroll
    for (int j = 0; j < 4; ++j) { const int col = j * 256 + lane * 4; const f32x4 gg = *(const f32x4*)(g + col), bv = *(const f32x4*)(bb + col);
        *(f32x4*)(io + (size_t)row * D + col) = v[j] * rstd * gg + bv; }
}

#ifndef MK_PER_PHASE
#define MK_PER_PHASE 0
#endif
constexpr int N_PHASES = 13;
struct Args { Ctx X; int ph_lo, ph_hi; };
typedef __attribute__((address_space(4))) const Ctx* CtxCP;
__device__ __forceinline__ CtxCP ctx_ptr() { CtxCP p = (CtxCP)__builtin_amdgcn_kernarg_segment_ptr(); asm volatile("" : "+s"(p)); return p; }

__global__ void __launch_bounds__(NW * 64, 2) mk_fwd(Args args) {
    extern __shared__ __attribute__((aligned(16))) unsigned char lds_raw[];
    LAS unsigned char* lds = (LAS unsigned char*)lds_raw;
    LAS unsigned* tab = (LAS unsigned*)(lds + TAB_OFF);
    volatile LAS unsigned* MISC = (volatile LAS unsigned*)(lds + MISC_OFF);
#define PH_BEGIN \
    const __attribute__((address_space(4))) Ctx& X = *ctx_ptr(); unsigned char* ws = X.ws; (void)ws; \
    const int tid = threadIdx.x, lane = tid & 63, wave = __builtin_amdgcn_readfirstlane(tid >> 6); (void)lane; (void)wave; \
    const int G = gridDim.x, bx = blockIdx.x; (void)G; (void)bx; \
    const int gw = bx * NW + wave, NGW = G * NW; (void)gw; (void)NGW; \
    const int gt = bx * (NW * 64) + tid, NGT = G * NW * 64; (void)gt; (void)NGT; \
    unsigned* ctl = (unsigned*)(ws + WS_CTL); float* mod = (float*)(ws + WS_MOD); float* rope = (float*)(ws + WS_ROPE); (void)ctl; (void)mod; (void)rope; \
    bf16_t* win_t = (bf16_t*)(ws + WS_WIN_T); bf16_t* wout_t = (bf16_t*)(ws + WS_WOUT_T); bf16_t* wr_t = (bf16_t*)(ws + WS_WR_T); (void)win_t; (void)wout_t; (void)wr_t; \
    bf16_t* wsgu_t = (bf16_t*)(ws + WS_WSGU_T); bf16_t* wsd_t = (bf16_t*)(ws + WS_WSD_T); bf16_t* wd_t = (bf16_t*)(ws + WS_WD_T); bf16_t* wgu_t = (bf16_t*)(ws + WS_WGU_T); (void)wsgu_t; (void)wsd_t; (void)wd_t; (void)wgu_t; \
    int* slot_ent = (int*)(ws + WS_SLOT_ENT); float* slot_w = (float*)(ws + WS_SLOT_W); int* topk_e = (int*)(ws + WS_TOPK_E); float* topk_w = (float*)(ws + WS_TOPK_W); (void)slot_ent; (void)slot_w; (void)topk_e; (void)topk_w; \
    bf16_t* ymix = (bf16_t*)(ws + WS_YMIX); bf16_t* proj = (bf16_t*)(ws + WS_PROJ); bf16_t* hbuf = (bf16_t*)(ws + WS_YMIX); (void)ymix; (void)proj; (void)hbuf; \
    float* logits = (float*)(ws + WS_LOGITS); bf16_t* shh = (bf16_t*)(ws + WS_SHH); bf16_t* hf = (bf16_t*)(ws + WS_HF); bf16_t* act = (bf16_t*)(ws + WS_ACT); (void)logits; (void)shh; (void)hf; (void)act; \
    unsigned char* ybuf = ws + WS_YBUF; float* out = X.out; (void)ybuf; (void)out;

    for (int u = threadIdx.x; u < (LDS_BYTES - MISC_OFF) / 4; u += NW * 64) ((LAS unsigned*)(lds + MISC_OFF))[u] = 0u;
    __syncthreads();
    if (!MK_PER_PHASE) { unsigned* ctl0 = (unsigned*)(args.X.ws + WS_CTL); (void)xcd_barrier_post(ctl0 + CW_BAR, MISC + 8); }
    const int lo = args.ph_lo, hi = args.ph_hi;
#ifdef MK_ONLY
#define IN(k) ((k) == MK_ONLY)
#else
#define IN(k) (lo <= (k) && (k) < hi)
#endif
#define SEAM(k) SEAM2(k, (k) + 1)
#define SEAM2(k, k2) do { if (IN(k) && IN(k2)) { XcdBarrier _b; _b.bar = (unsigned*)(ctx_ptr()->ws + WS_CTL) + CW_BAR; _b.x = xb_xcc_id(); _b.st = (volatile LAS unsigned*)(lds + MISC_OFF) + 8; xcd_barrier(_b); } } while (0)

    if (IN(0)) { PH_BEGIN
        LAS float* scr = (LAS float*)(lds + wave * 16384);
        if (gw < 96) mod_task(X.c, X.w_ada, X.b_ada, mod, gw, lane);
        constexpr int I_IN = (D / 64) * (DIN / 32), I_OUT = (D / 64) * (D / 32), I_R = (D / 64) * (NE / 32), I_SG = (D / 64) * (DE / 32), I_SD = (DE / 64) * (D / 32);
        constexpr int I_EG = I_SG, I_ED = I_SD;
        constexpr int N_SMALL = I_IN + I_OUT + I_R + 2 * I_SG + I_SD;
        constexpr int N_ITEMS = N_SMALL + NE * (2 * I_EG + I_ED);
        for (int it = gw; it < N_ITEMS; it += NGW) {
            int r = it;
            if (r < I_IN) { transpose_item(X.w_in, D, DIN, win_t, 0, 0, scr, r, lane); continue; } r -= I_IN;
            if (r < I_OUT) { transpose_item(X.w_out, D, D, wout_t, 0, 0, scr, r, lane); continue; } r -= I_OUT;
            if (r < I_R) { transpose_item(X.w_router, D, NE, wr_t, 0, 0, scr, r, lane); continue; } r -= I_R;
            if (r < I_SG) { transpose_item(X.ws_gate, D, DE, wsgu_t, 128, 0, scr, r, lane); continue; } r -= I_SG;
            if (r < I_SG) { transpose_item(X.ws_up, D, DE, wsgu_t, 128, 1, scr, r, lane); continue; } r -= I_SG;
            if (r < I_SD) { transpose_item(X.ws_down, DE, D, wsd_t, 0, 0, scr, r, lane); continue; } r -= I_SD;
            const int e = r / (2 * I_EG + I_ED); r -= e * (2 * I_EG + I_ED);
            if (r < I_EG) { transpose_item(X.w_gate + (size_t)e * D * DE, D, DE, wgu_t + (size_t)e * 512 * D, 128, 0, scr, r, lane); continue; } r -= I_EG;
            if (r < I_EG) { transpose_item(X.w_up + (size_t)e * D * DE, D, DE, wgu_t + (size_t)e * 512 * D, 128, 1, scr, r, lane); continue; } r -= I_EG;
            transpose_item(X.w_down + (size_t)e * DE * D, DE, D, wd_t + (size_t)e * D * DE, 0, 0, scr, r, lane);
        }
        for (int i = gt; i < SEQ * 64; i += NGT) rope_entry(rope, i);
    }
    SEAM(0);
    if (IN(1)) { PH_BEGIN
        for (size_t i4 = gt; i4 < (size_t)M * D / 4; i4 += NGT) {
            const size_t e = i4 * 4; const int row = (int)(e >> 10), col = (int)(e & 1023), b = row >> 11;
            const f32x4 v = *(const f32x4*)(X.x + e);
            const f32x4 sc = *(const f32x4*)(mod + b * 6144 + MOD_SCALE_A + col), sh = *(const f32x4*)(mod + b * 6144 + MOD_SHIFT_A + col);
            u32x2 o; o.x = pk2(v.x * (1.f + sc.x) + sh.x, v.y * (1.f + sc.y) + sh.y); o.y = pk2(v.z * (1.f + sc.z) + sh.z, v.w * (1.f + sc.w) + sh.w);
            *(u32x2*)(hbuf + e) = o;
        }
    }
    SEAM(1);
    if (IN(2)) { PH_BEGIN
        pg8::DenseOrder S; S.init(M, DIN, D, win_t, G, bx);
        pg8::EpiInProj E{proj};
        pg8::gemm_phase(lds, (const char*)hbuf, D, S, E);
    }
    SEAM(2);
    if (IN(3)) { PH_BEGIN
        const int R = (G >= 2) ? G / 2 : G;
        if (bx < R) for (int u = bx; u < BATCH * 4; u += R) ret::unit(proj, rope, X.ret_ld, X.ret_gn, ymix, (unsigned char*)out + (size_t)u * (16 * ret::TILE), lds, u);
        if (bx >= R || G < 2) for (int u = (G >= 2 ? bx - R : 0); u < BATCH * 8; u += (G >= 2 ? G - R : 1)) na::unit(proj, X.na_rpb, ymix, lds, u);
    }
    SEAM2(3, 5);
    if (IN(5)) { PH_BEGIN
        pg8::DenseOrder S; S.init(M, D, D, wout_t, G, bx);
        pg8::EpiOutProj E{X.x, mod, out};
        pg8::gemm_phase(lds, (const char*)ymix, D, S, E);
    }
    SEAM(5);
    if (IN(6)) { PH_BEGIN for (int r = gw; r < M; r += NGW) ln1_row(out, X.ln1_g, X.ln1_b, mod, hf, r, lane); }
    SEAM(6);
    if (IN(7)) { PH_BEGIN
        { pg8::DenseOrder S; S.init(M, NE, D, wr_t, G, bx); pg8::EpiRouter E{logits}; pg8::gemm_phase(lds, (const char*)hf, D, S, E); }
        { pg8::DenseOrder S; S.init(M, 2 * DE, D, wsgu_t, G, bx); pg8::EpiGU<false> E{shh, nullptr}; pg8::gemm_phase(lds, (const char*)hf, D, S, E); }
    }
    SEAM(7);
    if (IN(8)) { PH_BEGIN
        LAS unsigned* hist = tab + T_HIST;
        if (tid < NE) hist[tid] = 0u;
        __syncthreads();
        const f32x4 bias = *(const f32x4*)(X.rbias + lane * 4);
        for (int tok = gw; tok < M; tok += NGW) route_token(logits, bias, topk_e, topk_w, hist, tok, lane);
        __syncthreads();
        if (tid < NE && hist[tid]) atomicAdd(&ctl[CW_COUNT + tid], hist[tid]);
    }
    SEAM(8);
    if (IN(9)) { PH_BEGIN
        build_tables(ctl, tab);
        LAS unsigned* hist = tab + T_HIST; LAS unsigned* base = tab + T_BASE;
        for (int c0 = bx * 2048; c0 < NSLOT; c0 += G * 2048) {
            __syncthreads();
            if (tid < NE) hist[tid] = 0u;
            __syncthreads();
            int e[4]; unsigned loc[4];
#pragma unroll
            for (int i = 0; i < 4; ++i) { const int idx = c0 + i * 512 + tid; e[i] = topk_e[idx]; loc[i] = __hip_atomic_fetch_add(&hist[e[i]], 1u, __ATOMIC_RELAXED, __HIP_MEMORY_SCOPE_WORKGROUP); }
            __syncthreads();
            if (tid < NE && hist[tid]) base[tid] = atomicAdd(&ctl[CW_CURSOR + tid], hist[tid]);
            __syncthreads();
#pragma unroll
            for (int i = 0; i < 4; ++i) { const int idx = c0 + i * 512 + tid; const unsigned pos = tab[T_OFF + e[i]] + base[e[i]] + loc[i]; slot_ent[pos] = idx; slot_w[pos] = topk_w[idx]; }
        }
    }
    SEAM(9);
    if (IN(10)) { PH_BEGIN
        build_tables(ctl, tab);
        { pg8::ExpertOrder<2, true> S; S.init(tab, D, wgu_t, (size_t)512 * D * 2, slot_ent, G, bx); pg8::EpiGU<true> E{act, slot_w}; pg8::gemm_phase(lds, (const char*)hf, D, S, E); }
        { pg8::DenseOrder S; S.init(M, D, DE, wsd_t, G, bx); pg8::EpiSharedDown E{mod, out}; pg8::gemm_phase(lds, (const char*)shh, DE, S, E); }
    }
    SEAM(10);
    if (IN(11)) { PH_BEGIN
        build_tables(ctl, tab);
        pg8::ExpertOrder<4, false> S; S.init(tab, DE, wd_t, (size_t)D * DE * 2, slot_ent, G, bx); pg8::EpiExpDown E{ybuf, slot_ent}; pg8::gemm_phase(lds, (const char*)act, DE, S, E);
    }
    SEAM(11);
    if (IN(12)) { PH_BEGIN for (int r = gw; r < M; r += NGW) final_row(out, ybuf, X.ln2_g, X.ln2_b, mod, r, lane); }
#undef IN
#undef SEAM
}

extern "C" void kernel_launch(void* const* d_in, const int* in_sizes, int n_in, void* d_out, int out_size, void* d_ws, size_t ws_size, hipStream_t stream) {
    static int grid = 0;
    if (grid == 0) {
        if (n_in != 21 || in_sizes[0] != M * D || out_size != M * D || ws_size < WS_END) { fprintf(stderr, "kernel_launch: unexpected shapes (n_in %d, ws %zu)\n", n_in, ws_size); grid = -1; return; }
        int dev = 0, cus = 0, per_cu = 0;
        if (hipGetDevice(&dev) != hipSuccess || hipDeviceGetAttribute(&cus, hipDeviceAttributeMultiprocessorCount, dev) != hipSuccess) { grid = -1; return; }
        if (hipFuncSetAttribute((const void*)mk_fwd, hipFuncAttributeMaxDynamicSharedMemorySize, LDS_BYTES) != hipSuccess) { fprintf(stderr, "kernel_launch: hipFuncSetAttribute failed\n"); grid = -1; return; }
        if (hipOccupancyMaxActiveBlocksPerMultiprocessor(&per_cu, (const void*)mk_fwd, NW * 64, LDS_BYTES) != hipSuccess || per_cu < 1) { fprintf(stderr, "kernel_launch: occupancy query says %d\n", per_cu); }
        (void)hipGetLastError();
        grid = cus;
    }
    if (grid < 0) return;
    (void)hipMemsetAsync((char*)d_ws + WS_CTL, 0, 1 * MiB, stream);
    Args a{};
    const float** p = (const float**)&a.X;
    for (int i = 0; i < 21; ++i) p[i] = (const float*)d_in[i];
    a.X.out = (float*)d_out; a.X.ws = (unsigned char*)d_ws;
#if MK_PER_PHASE
    for (int ph = 0; ph < N_PHASES; ++ph) { a.ph_lo = ph; a.ph_hi = ph + 1; hipLaunchKernelGGL(mk_fwd, dim3(grid), dim3(NW * 64), LDS_BYTES, stream, a); }
#else
    a.ph_lo = 0; a.ph_hi = N_PHASES;
    hipLaunchKernelGGL(mk_fwd, dim3(grid), dim3(NW * 64), LDS_BYTES, stream, a);
#endif
}
```

```cpp
#include <hip/hip_runtime.h>
#include <cstdio>
#include <cstdint>

typedef unsigned short bf16_t;
typedef short bf16x8 __attribute__((ext_vector_type(8)));
typedef float f32x4 __attribute__((ext_vector_type(4)));
typedef float f32x2 __attribute__((ext_vector_type(2)));
typedef unsigned u32x4 __attribute__((ext_vector_type(4)));
typedef unsigned u32x2 __attribute__((ext_vector_type(2)));
#define LAS __attribute__((address_space(3)))

constexpr int D = 1024, BATCH = 32, SEQ = 2048, M = BATCH * SEQ;
constexpr int DIN = 3584;
constexpr int OFF_QNA = 0, OFF_KNA = 512, OFF_VNA = 1024, OFF_QR = 1536, OFF_KR = 2048, OFF_VR = 2560, OFF_GR = 3072;
constexpr int NE = 256, TOPK = 8, DE = 256;
constexpr int NSLOT = M * TOPK;
constexpr float LN_EPS = 1e-5f, GN_EPS = 1e-6f;
constexpr float ALPHA = 1.189207115002721f;
constexpr float YSCALE = 64.f, YINV = 1.f / 64.f;
constexpr int MOD_SHIFT_A = 0, MOD_SCALE_A = 1024, MOD_GATE_A = 2048, MOD_SHIFT_F = 3072, MOD_SCALE_F = 4096, MOD_GATE_F = 5120;

constexpr size_t MiB = 1u << 20;
constexpr size_t WS_CTL = 0;
constexpr size_t WS_MOD = 1 * MiB;
constexpr size_t WS_ROPE = 2 * MiB;
constexpr size_t WS_WIN_T = 4 * MiB;
constexpr size_t WS_WOUT_T = 11 * MiB;
constexpr size_t WS_WR_T = 13 * MiB;
constexpr size_t WS_WSGU_T = 14 * MiB;
constexpr size_t WS_WSD_T = 15 * MiB;
constexpr size_t WS_SLOT_ENT = 16 * MiB;
constexpr size_t WS_SLOT_W = 18 * MiB;
constexpr size_t WS_TOPK_E = 20 * MiB;
constexpr size_t WS_TOPK_W = 22 * MiB;
constexpr size_t WS_WD_T = 32 * MiB;
constexpr size_t WS_WGU_T = 160 * MiB;
constexpr size_t WS_YMIX = 416 * MiB;
constexpr size_t WS_PROJ = 544 * MiB;
constexpr size_t WS_LOGITS = WS_YMIX, WS_SHH = WS_YMIX + 64 * MiB;
constexpr size_t WS_HF = WS_PROJ, WS_ACT = WS_PROJ + 128 * MiB;
constexpr size_t WS_YBUF = WS_WGU_T;
constexpr size_t WS_END = 992 * MiB;
constexpr int CW_COUNT = 1024, CW_CURSOR = 1536, CW_BAR = 8192;

constexpr int RING_BYTES = 131072;
constexpr int TAB_OFF = RING_BYTES;
constexpr int T_OFF = 0, T_TILE = 260, T_CNT = 520, T_HIST = 776, T_BASE = 1032, TAB_WORDS = 1288;
constexpr int VN_OFF = TAB_OFF + 6144;
constexpr int PHASE_BYTES = 155648;
constexpr int MISC_OFF = PHASE_BYTES;
constexpr int LDS_BYTES = PHASE_BYTES + 256;
static_assert(TAB_WORDS * 4 <= 6144 && VN_OFF + 8192 <= PHASE_BYTES && LDS_BYTES <= 163840, "LDS map");

__device__ __forceinline__ unsigned f2bf(float f) { unsigned u = __float_as_uint(f); return (u + 0x7fffu + ((u >> 16) & 1u)) >> 16; }
__device__ __forceinline__ float bf2f(unsigned short h) { return __uint_as_float(((unsigned)h) << 16); }
__device__ __forceinline__ unsigned pk2(float lo, float hi) { return f2bf(lo) | (f2bf(hi) << 16); }
__device__ __forceinline__ unsigned cvt_pk_bf16(float lo, float hi) { unsigned r; asm volatile("v_cvt_pk_bf16_f32 %0, %1, %2" : "=v"(r) : "v"(lo), "v"(hi)); return r; }
__device__ __forceinline__ float silu_f(float v) { return v / (1.f + __expf(-v)); }
__device__ __forceinline__ float wave_sum(float v) {
#pragma unroll
    for (int o = 1; o < 64; o <<= 1) v += __shfl_xor(v, o);
    return v;
}
__device__ __forceinline__ float clamp8(float v) { return fminf(fmaxf(v, -440.f), 440.f); }
#define LDS_WAIT() asm volatile("s_waitcnt lgkmcnt(0)" ::: "memory")

#define XB_TMO      128
#define XB_XCNT(j)  (256  + 64 * (j))
#define XB_XSUB(j)  (1280 + 64 * (j))
#define XB_XGEN(j)  (2304 + 64 * (j))
#define XB_TOP      3328
#define XB_TOPGEN   3392
#define XCD_BAR_WORDS 3456
#define XB_SPIN_CAP (1u << 23)
__device__ __forceinline__ unsigned xb_ld(unsigned* p)              { return __hip_atomic_load(p, __ATOMIC_RELAXED, __HIP_MEMORY_SCOPE_AGENT); }
__device__ __forceinline__ unsigned xb_add(unsigned* p, unsigned v) { return __hip_atomic_fetch_add(p, v, __ATOMIC_RELAXED, __HIP_MEMORY_SCOPE_AGENT); }
__device__ __forceinline__ unsigned xb_xcc_id() { return (unsigned)__builtin_amdgcn_s_getreg((3 << 11) | 20) & 0xFu; }
#define XB_SPIN(cond, bar) do { unsigned _sp = 0; while (cond) { __builtin_amdgcn_s_sleep(1); \
    if ((++_sp & 255u) == 0u) { if (xb_ld(&(bar)[XB_TMO])) break; if (_sp > XB_SPIN_CAP) { atomicAdd(&(bar)[XB_TMO], 1u); break; } } } } while (0)
struct XcdBarrier { unsigned* bar; unsigned x; volatile LAS unsigned* st; };
__device__ __forceinline__ XcdBarrier xcd_barrier_post(unsigned* bar, volatile LAS unsigned* st) {
    XcdBarrier b; b.bar = bar; b.x = xb_xcc_id(); b.st = st;
    if (threadIdx.x == 0) (void)xb_add(&bar[XB_XCNT(b.x)], 1u);
    return b;
}
__device__ __forceinline__ void xcd_barrier_complete(unsigned* bar, unsigned x, unsigned& nloc, unsigned& nx) {
    const unsigned G = gridDim.x * gridDim.y * gridDim.z;
    unsigned sum, cnt, mine, sp = 0u;
    for (;;) {
        sum = 0u; cnt = 0u; mine = 0u;
#pragma unroll
        for (unsigned j = 0; j < 16; ++j) { const unsigned c = xb_ld(&bar[XB_XCNT(j)]); sum += c; cnt += (c > 0u) ? 1u : 0u; mine = (j == x) ? c : mine; }
        if (sum == G) break;
        __builtin_amdgcn_s_sleep(1);
        if ((++sp & 255u) == 0u) { if (xb_ld(&bar[XB_TMO])) break; if (sp > XB_SPIN_CAP) { atomicAdd(&bar[XB_TMO], 1u); break; } }
    }
    nloc = mine > 0u ? mine : 1u; nx = cnt > 0u ? cnt : 1u;
}
__device__ __forceinline__ void xcd_barrier(const XcdBarrier& b) {
    asm volatile("s_waitcnt vmcnt(0)" ::: "memory");
    __syncthreads();
    if (threadIdx.x == 0) {
        unsigned* bar = b.bar;
        __builtin_amdgcn_s_waitcnt(0);
        unsigned nloc = b.st[0], nx = b.st[1];
        if (nloc == 0u) { xcd_barrier_complete(bar, b.x, nloc, nx); b.st[0] = nloc; b.st[1] = nx; }
        const unsigned old = xb_add(&bar[XB_XSUB(b.x)], 1u);
        const unsigned gen = old / nloc;
        if (old + 1u == (gen + 1u) * nloc) {
            __builtin_amdgcn_fence(__ATOMIC_RELEASE, "agent");
            asm volatile("s_waitcnt vmcnt(0)" ::: "memory");
            const unsigned og = xb_add(&bar[XB_TOP], 1u);
            const unsigned tg = og / nx;
            if (og + 1u == (tg + 1u) * nx) xb_add(&bar[XB_TOPGEN], 1u);
            else XB_SPIN(xb_ld(&bar[XB_TOPGEN]) == tg, bar);
            __builtin_amdgcn_fence(__ATOMIC_ACQUIRE, "agent");
            xb_add(&bar[XB_XGEN(b.x)], 1u);
            asm volatile("s_waitcnt vmcnt(0)" ::: "memory");
        } else {
            XB_SPIN(xb_ld(&bar[XB_XGEN(b.x)]) == gen, bar);
            __builtin_amdgcn_fence(__ATOMIC_ACQUIRE, "agent");
            asm volatile("s_waitcnt vmcnt(0)" ::: "memory");
        }
    }
    __syncthreads();
}

namespace pg8 {
constexpr int BM = 256, BK = 64, HALF = 128, HTB = HALF * BK * 2, STAGE_BYTES = 8 * HTB;
__device__ __forceinline__ int lds_byte(int r, int c) { const int st = (r >> 4) * 2 + (c >> 5), rr = r & 15, cc = c & 31, ob = rr * 64 + cc * 2; return st * 1024 + (ob ^ (((ob >> 9) & 1) << 5)); }
__device__ __forceinline__ void stage_rc(int b, int& R, int& C) { const int st = b / 1024, sb = b % 1024, swz = sb ^ (((sb >> 9) & 1) << 5); R = (st >> 1) * 16 + swz / 64; C = (st & 1) * 32 + (swz % 64) / 2; }
__device__ __forceinline__ int perm32(int rho) { const int n = rho >> 4, i = rho & 15; return 8 * (i >> 2) + 4 * n + (i & 3); }

struct Unit { int pm, pn; const char* B; int e, cnt, off; };

template <class Epi, class Sched>
__device__ __forceinline__ void gemm_phase(LAS unsigned char* lds, const char* Abase, const int K, const Sched& S, const Epi& E) {
    int tid_ = threadIdx.x; asm volatile("" : "+v"(tid_));
    const int tid = tid_, wid = __builtin_amdgcn_readfirstlane(tid >> 6), lane = tid & 63, wr = wid >> 2, wc = wid & 3, fr = lane & 15, fq = lane >> 4;
    const int nt = K / BK;
    int Rr[2], Cc[2]; unsigned voffB[2], voffA[2];
#pragma unroll
    for (int i = 0; i < 2; ++i) { int R, C; stage_rc(tid * 16 + i * 8192, R, C); Rr[i] = R; Cc[i] = C; const int Rb = Epi::PERM ? ((R & ~31) + perm32(R & 31)) : R; voffB[i] = (unsigned)(Rb * K + C) * 2u; voffA[i] = (unsigned)(R * K + C) * 2u; }
    constexpr bool GATHER = Sched::GATHER;
    const size_t kstep = (size_t)(BK * 2);
    const size_t hstep = (size_t)HALF * K * 2;
    const unsigned ldsw = (unsigned)wid * 1024u;
    const int aoff = lds_byte(wr * 64 + fr, fq * 8), boff = lds_byte(wc * 32 + fr, fq * 8);
#define PG8_SA(b, h) (((b) * 2 + (h)) * HTB)
#define PG8_SB(b, h) ((4 + (b) * 2 + (h)) * HTB)
#define PG8_STAGE(bufoff, gbase, voff) do { _Pragma("unroll") for (int _i = 0; _i < 2; ++_i) \
        __builtin_amdgcn_global_load_lds((const unsigned*)((const char*)(gbase) + (voff)[_i]), (LAS unsigned*)(lds + (bufoff) + ldsw + _i * 8192), 16, 0, 0); } while (0)
#define PG8_STAGEA(bufoff, uptr, koff, NEXT, h) do { if constexpr (GATHER) { if (NEXT) { const u32x2 _t = *(const LAS u32x2*)(vnslot + 2 * (h)); unsigned _v[2] = {_t.x, _t.y}; PG8_STAGE(bufoff, Abase + (koff), _v); } else { PG8_STAGE(bufoff, Abase + (koff), vc[h]); } } \
        else { PG8_STAGE(bufoff, (uptr) + (size_t)(h) * hstep + (koff), voffA); } } while (0)
#define PG8_LDA(dst, b, h) do { _Pragma("unroll") for (int m = 0; m < 4; ++m) _Pragma("unroll") for (int k = 0; k < 2; ++k) dst[m][k] = *(const LAS bf16x8*)(lds + PG8_SA(b, h) + aoff + m * 2048 + k * 1024); } while (0)
#define PG8_LDB(dst, b, h) do { _Pragma("unroll") for (int n = 0; n < 2; ++n) _Pragma("unroll") for (int k = 0; k < 2; ++k) dst[n][k] = *(const LAS bf16x8*)(lds + PG8_SB(b, h) + boff + n * 2048 + k * 1024); } while (0)
#define PG8_MMA(ai, bj, At, Bt) do { __builtin_amdgcn_s_setprio(1); _Pragma("unroll") for (int m = 0; m < 4; ++m) _Pragma("unroll") for (int n = 0; n < 2; ++n) _Pragma("unroll") for (int k = 0; k < 2; ++k) \
        acc[ai][bj][m][n] = __builtin_amdgcn_mfma_f32_16x16x32_bf16(Bt[n][k], At[m][k], acc[ai][bj][m][n], 0, 0, 0); __builtin_amdgcn_s_setprio(0); } while (0)
#define PG8_WAIT_V(n) asm volatile("s_waitcnt vmcnt(" #n ")" ::: "memory")
#define PG8_WAIT_L(n) asm volatile("s_waitcnt lgkmcnt(" #n ")" ::: "memory")
#define PG8_BAR __builtin_amdgcn_s_barrier()
#define PG8_SCHED __builtin_amdgcn_sched_barrier(0)
    Unit cur, nxt; int ui = 0;
    if (!S.next(0, cur)) return;
    f32x4 acc[2][2][4][2];
#pragma unroll
    for (int a = 0; a < 2; ++a)
#pragma unroll
        for (int b = 0; b < 2; ++b)
#pragma unroll
            for (int m = 0; m < 4; ++m)
#pragma unroll
                for (int n = 0; n < 2; ++n) acc[a][b][m][n] = (f32x4){0.f, 0.f, 0.f, 0.f};
    bf16x8 At[4][2], B0[2][2], B1[2][2];
    unsigned vc[2][2];
    LAS unsigned* vnslot = (LAS unsigned*)(lds + (VN_OFF - 0)) + tid * 4;
    if constexpr (GATHER) S.avoff(cur, Rr, Cc, vc);
    const char* cB = cur.B; const char* cA = Abase + S.aoff(cur);
    PG8_STAGE(PG8_SB(0, 0), cB, voffB); PG8_STAGE(PG8_SB(0, 1), cB + hstep, voffB); PG8_STAGEA(PG8_SA(0, 0), cA, 0, false, 0); PG8_STAGEA(PG8_SA(0, 1), cA, 0, false, 1);
    if (wr == 1) PG8_BAR;
    PG8_WAIT_V(2); PG8_BAR;
    PG8_STAGE(PG8_SB(1, 0), cB + kstep, voffB); PG8_STAGEA(PG8_SA(1, 0), cA, kstep, false, 0); PG8_STAGE(PG8_SB(1, 1), cB + hstep + kstep, voffB);
    PG8_WAIT_V(6); PG8_BAR;
    for (;;) {
        const bool has_next = S.next(ui + 1, nxt);
        if constexpr (GATHER) {
            unsigned vn[2][2];
            if (has_next) S.avoff(nxt, Rr, Cc, vn);
            else {
#pragma unroll
                for (int h = 0; h < 2; ++h)
#pragma unroll
                    for (int i = 0; i < 2; ++i) vn[h][i] = vc[h][i];
            }
            *(LAS u32x4*)vnslot = (u32x4){vn[0][0], vn[0][1], vn[1][0], vn[1][1]};
        }
        const char* nB = has_next ? nxt.B : cB; const char* nA = has_next ? Abase + S.aoff(nxt) : cA;
        for (int t = 0; t < nt; t += 2) {
            const bool last = (t == nt - 2);
            const size_t k1 = (size_t)(t + 1) * kstep;
            const size_t k2 = last ? (size_t)0 : (size_t)(t + 2) * kstep, k3 = k2 + kstep;
            const char* u2 = last ? nA : cA; const char* b2 = last ? nB : cB + (size_t)(t + 2) * kstep;
            const char* b3 = b2 + kstep;
            PG8_LDB(B0, 0, 0); PG8_LDB(B1, 0, 1); PG8_SCHED; PG8_LDA(At, 0, 0); PG8_STAGEA(PG8_SA(1, 1), cA, k1, false, 1);
            PG8_WAIT_V(8); PG8_WAIT_L(0); PG8_BAR; PG8_MMA(0, 0, At, B0); PG8_MMA(0, 1, At, B1); PG8_BAR; PG8_SCHED;
            PG8_LDA(At, 0, 1); PG8_STAGE(PG8_SB(0, 0), b2, voffB); PG8_STAGE(PG8_SB(0, 1), b2 + hstep, voffB); PG8_STAGEA(PG8_SA(0, 0), u2, k2, last, 0);
            PG8_WAIT_V(8); PG8_WAIT_L(0); PG8_BAR; PG8_MMA(1, 0, At, B0); PG8_MMA(1, 1, At, B1); PG8_BAR; PG8_SCHED;
            PG8_LDB(B0, 1, 0); PG8_LDB(B1, 1, 1); PG8_SCHED; PG8_LDA(At, 1, 0); PG8_STAGEA(PG8_SA(0, 1), u2, k2, last, 1);
            PG8_WAIT_V(8); PG8_WAIT_L(0); PG8_BAR; PG8_MMA(0, 0, At, B0); PG8_MMA(0, 1, At, B1); PG8_BAR; PG8_SCHED;
            PG8_LDA(At, 1, 1); PG8_STAGE(PG8_SB(1, 0), b3, voffB); PG8_STAGE(PG8_SB(1, 1), b3 + hstep, voffB); PG8_STAGEA(PG8_SA(1, 0), u2, k3, last, 0);
            PG8_WAIT_V(8); PG8_WAIT_L(0); PG8_BAR; PG8_MMA(1, 0, At, B0); PG8_MMA(1, 1, At, B1); PG8_BAR; PG8_SCHED;
        }
        if (wr == 0) PG8_BAR;
        E(acc, cur, wr, wc, fr, fq);
        if (!has_next) break;
#pragma unroll
        for (int a = 0; a < 2; ++a)
#pragma unroll
            for (int b = 0; b < 2; ++b)
#pragma unroll
                for (int m = 0; m < 4; ++m)
#pragma unroll
                    for (int n = 0; n < 2; ++n) acc[a][b][m][n] = (f32x4){0.f, 0.f, 0.f, 0.f};
        cur = nxt; cB = nB; cA = nA; ++ui;
        if constexpr (GATHER) { const u32x4 _t = *(const LAS u32x4*)vnslot; vc[0][0] = _t.x; vc[0][1] = _t.y; vc[1][0] = _t.z; vc[1][1] = _t.w; }
        if (wr == 1) PG8_BAR;
    }
    PG8_WAIT_V(0);
    PG8_BAR;
#undef PG8_SA
#undef PG8_SB
#undef PG8_STAGE
#undef PG8_STAGEA
#undef PG8_LDA
#undef PG8_LDB
#undef PG8_MMA
#undef PG8_WAIT_V
#undef PG8_WAIT_L
#undef PG8_BAR
#undef PG8_SCHED
}

struct DenseOrder {
    int nM, nN, nwg, G, c, K; const char* Bt;
    __device__ void init(int Mrows, int N, int K_, const void* Bt_, int G_, int c_) { nM = Mrows / BM; nN = N / BM; nwg = nM * nN; G = G_; c = c_; K = K_; Bt = (const char*)Bt_; }
    __device__ __forceinline__ bool next(int i, Unit& u) const {
        const long L = (long)i * G + c; if (L >= nwg) return false;
        int wgid = (int)L; { const int q = nwg / 8, r = nwg % 8, xcd = wgid % 8, off = wgid / 8; wgid = (xcd < r ? xcd * (q + 1) : r * (q + 1) + (xcd - r) * q) + off; }
        const int nig = 8 * nN, gid = wgid / nig, fm = gid * 8, gsz = (nM - fm) < 8 ? (nM - fm) : 8;
        u.pm = fm + ((wgid % nig) % gsz); u.pn = (wgid % nig) / gsz; u.B = Bt + (size_t)u.pn * BM * K * 2; u.e = 0; u.cnt = 0; u.off = 0; return true;
    }
    static constexpr bool GATHER = false;
    __device__ __forceinline__ size_t aoff(const Unit& u) const { return (size_t)u.pm * BM * K * 2; }
    __device__ __forceinline__ void avoff(const Unit&, const int (&)[2], const int (&)[2], unsigned (&)[2][2]) const {}
};
template <int NCOL, bool TOKROWS> struct ExpertOrder {
    static constexpr bool GATHER = true;
    __device__ __forceinline__ size_t aoff(const Unit&) const { return 0; }
    const LAS unsigned* tab; int per, c, K; const char* W; size_t wstride; const int* slot_ent;
    int xbase, xend, xstride, xlb;
    __device__ void init(const LAS unsigned* tab_, int K_, const void* W_, size_t wstride_, const int* slot_ent_, int G, int c_) {
        tab = tab_; K = K_; W = (const char*)W_; wstride = wstride_; slot_ent = slot_ent_; c = c_;
        const int U = (int)tab[T_TILE + NE] * NCOL; per = (U + G - 1) / G;
        if (G % 8 == 0) { const int x = c_ % 8; const int q = U / 8, r = U % 8; xbase = x * q + (x < r ? x : r); xend = xbase + q + (x < r ? 1 : 0); xstride = G / 8; xlb = c_ / 8; }
        else { xbase = 0; xend = U; xstride = G; xlb = c_; }
    }
    __device__ __forceinline__ bool next(int i, Unit& u) const {
        const int L = xbase + i * xstride + xlb;
        if (L >= xend) return false;
        const int tile = L / NCOL; u.pn = L % NCOL;
        int lo = 0, hi = NE - 1;
        while (lo < hi) { const int mid = (lo + hi + 1) >> 1; if ((int)tab[T_TILE + mid] <= tile) lo = mid; else hi = mid - 1; }
        u.e = lo; u.pm = tile - (int)tab[T_TILE + lo]; u.cnt = (int)tab[T_CNT + lo]; u.off = (int)tab[T_OFF + lo];
        u.B = W + (size_t)lo * wstride + (size_t)u.pn * BM * K * 2; return true;
    }
    __device__ __forceinline__ void avoff(const Unit& u, const int (&)[2], const int (&)[2], unsigned (&v)[2][2]) const {
        int R[2], C[2]; int tidq = threadIdx.x; asm volatile("" : "+v"(tidq));
#pragma unroll
        for (int i = 0; i < 2; ++i) stage_rc(tidq * 16 + i * 8192, R[i], C[i]);
#pragma unroll
        for (int h = 0; h < 2; ++h)
#pragma unroll
            for (int i = 0; i < 2; ++i) {
                int r = u.pm * BM + h * HALF + R[i]; if (r >= u.cnt) r = u.cnt - 1;
                const int slot = u.off + r;
                const int row = TOKROWS ? (slot_ent[slot] >> 3) : slot;
                v[h][i] = (unsigned)(row * K + C[i]) * 2u;
            }
    }
};

struct EpiInProj {
    static constexpr bool PERM = true; bf16_t* O;
    __device__ __forceinline__ void operator()(const f32x4 (&acc)[2][2][4][2], const Unit& u, int wr, int wc, int fr, int fq) const {
        const float sc = (u.pn < 2) ? 0.125f : ((u.pn == 8 || u.pn == 9) ? 0.08838834764831845f : 1.f);
        const int row0 = u.pm * BM + wr * 64 + fr, col0 = u.pn * BM + wc * 32 + 8 * fq;
#pragma unroll
        for (int ai = 0; ai < 2; ++ai)
#pragma unroll
            for (int m = 0; m < 4; ++m) { bf16_t* rowp = O + (size_t)(row0 + ai * HALF + m * 16) * DIN + col0;
#pragma unroll
                for (int bj = 0; bj < 2; ++bj) { const f32x4 v0 = acc[ai][bj][m][0] * sc, v1 = acc[ai][bj][m][1] * sc;
                    u32x4 w; w.x = cvt_pk_bf16(v0[0], v0[1]); w.y = cvt_pk_bf16(v0[2], v0[3]); w.z = cvt_pk_bf16(v1[0], v1[1]); w.w = cvt_pk_bf16(v1[2], v1[3]);
                    *(u32x4*)(rowp + bj * HALF) = w; } }
    }
};
struct EpiOutProj {
    static constexpr bool PERM = false; const float* x; const float* mod; float* out;
    __device__ __forceinline__ void operator()(const f32x4 (&acc)[2][2][4][2], const Unit& u, int wr, int wc, int fr, int fq) const {
        const int b = (u.pm * BM) >> 11; const int col0 = u.pn * BM + wc * 32 + 4 * fq;
#pragma unroll
        for (int bj = 0; bj < 2; ++bj)
#pragma unroll
            for (int n = 0; n < 2; ++n) { const int col = col0 + bj * HALF + n * 16; const f32x4 g = *(const f32x4*)(mod + b * 6144 + MOD_GATE_A + col);
#pragma unroll
                for (int ai = 0; ai < 2; ++ai)
#pragma unroll
                    for (int m = 0; m < 4; ++m) { const size_t o = (size_t)(u.pm * BM + ai * HALF + wr * 64 + m * 16 + fr) * D + col;
                        const f32x4 xv = *(const f32x4*)(x + o); *(f32x4*)(out + o) = xv * ALPHA + g * acc[ai][bj][m][n]; } }
    }
};
struct EpiRouter {
    static constexpr bool PERM = false; float* out;
    __device__ __forceinline__ void operator()(const f32x4 (&acc)[2][2][4][2], const Unit& u, int wr, int wc, int fr, int fq) const {
        const int col0 = wc * 32 + 4 * fq;
#pragma unroll
        for (int ai = 0; ai < 2; ++ai)
#pragma unroll
            for (int m = 0; m < 4; ++m) { float* rowp = out + (size_t)(u.pm * BM + ai * HALF + wr * 64 + m * 16 + fr) * NE + col0;
#pragma unroll
                for (int bj = 0; bj < 2; ++bj)
#pragma unroll
                    for (int n = 0; n < 2; ++n) *(f32x4*)(rowp + bj * HALF + n * 16) = acc[ai][bj][m][n]; }
    }
};
template <bool EXPERT> struct EpiGU {
    static constexpr bool PERM = true; bf16_t* O; const float* slot_w;
    __device__ __forceinline__ void operator()(const f32x4 (&acc)[2][2][4][2], const Unit& u, int wr, int wc, int fr, int fq) const {
        const int h0 = u.pn * HALF + wc * 32 + 8 * fq;
#pragma unroll
        for (int ai = 0; ai < 2; ++ai)
#pragma unroll
            for (int m = 0; m < 4; ++m) {
                const int rt = u.pm * BM + ai * HALF + wr * 64 + m * 16 + fr;
                float w = 1.f; size_t orow = (size_t)rt;
                if (EXPERT) { if (rt >= u.cnt) continue; w = slot_w[u.off + rt]; orow = (size_t)(u.off + rt); }
                const f32x4 g0 = acc[ai][0][m][0], g1 = acc[ai][0][m][1], u0 = acc[ai][1][m][0], u1 = acc[ai][1][m][1];
                u32x4 o;
                o.x = cvt_pk_bf16(w * silu_f(g0[0]) * u0[0], w * silu_f(g0[1]) * u0[1]); o.y = cvt_pk_bf16(w * silu_f(g0[2]) * u0[2], w * silu_f(g0[3]) * u0[3]);
                o.z = cvt_pk_bf16(w * silu_f(g1[0]) * u1[0], w * silu_f(g1[1]) * u1[1]); o.w = cvt_pk_bf16(w * silu_f(g1[2]) * u1[2], w * silu_f(g1[3]) * u1[3]);
                *(u32x4*)(O + orow * DE + h0) = o;
            }
    }
};
struct EpiSharedDown {
    static constexpr bool PERM = false; const float* mod; float* out;
    __device__ __forceinline__ void operator()(const f32x4 (&acc)[2][2][4][2], const Unit& u, int wr, int wc, int fr, int fq) const {
        const int b = (u.pm * BM) >> 11; const int col0 = u.pn * BM + wc * 32 + 4 * fq;
#pragma unroll
        for (int bj = 0; bj < 2; ++bj)
#pragma unroll
            for (int n = 0; n < 2; ++n) { const int col = col0 + bj * HALF + n * 16; const f32x4 g = *(const f32x4*)(mod + b * 6144 + MOD_GATE_F + col);
#pragma unroll
                for (int ai = 0; ai < 2; ++ai)
#pragma unroll
                    for (int m = 0; m < 4; ++m) { const size_t o = (size_t)(u.pm * BM + ai * HALF + wr * 64 + m * 16 + fr) * D + col;
                        const f32x4 xv = *(const f32x4*)(out + o); *(f32x4*)(out + o) = xv * ALPHA + g * acc[ai][bj][m][n]; } }
    }
};
struct EpiExpDown {
    static constexpr bool PERM = true; unsigned char* ybuf; const int* slot_ent;
    __device__ __forceinline__ void operator()(const f32x4 (&acc)[2][2][4][2], const Unit& u, int wr, int wc, int fr, int fq) const {
        const int col0 = u.pn * BM + wc * 32 + 8 * fq;
#pragma unroll
        for (int ai = 0; ai < 2; ++ai)
#pragma unroll
            for (int m = 0; m < 4; ++m) {
                const int rt = u.pm * BM + ai * HALF + wr * 64 + m * 16 + fr; if (rt >= u.cnt) continue;
                unsigned char* rowp = ybuf + (size_t)slot_ent[u.off + rt] * D + col0;
#pragma unroll
                for (int bj = 0; bj < 2; ++bj) { const f32x4 v0 = acc[ai][bj][m][0] * YSCALE, v1 = acc[ai][bj][m][1] * YSCALE;
                    int w0 = __builtin_amdgcn_cvt_pk_fp8_f32(clamp8(v0[0]), clamp8(v0[1]), 0, false); w0 = __builtin_amdgcn_cvt_pk_fp8_f32(clamp8(v0[2]), clamp8(v0[3]), w0, true);
                    int w1 = __builtin_amdgcn_cvt_pk_fp8_f32(clamp8(v1[0]), clamp8(v1[1]), 0, false); w1 = __builtin_amdgcn_cvt_pk_fp8_f32(clamp8(v1[2]), clamp8(v1[3]), w1, true);
                    u32x2 o; o.x = (unsigned)w0; o.y = (unsigned)w1; *(u32x2*)(rowp + bj * HALF) = o; }
            }
    }
};
}

struct Ctx {
    const float *x, *c, *w_ada, *b_ada, *w_in, *w_out, *na_rpb, *ret_ld, *ret_gn, *ln1_g, *ln1_b, *ln2_g, *ln2_b, *w_router, *rbias, *w_gate, *w_up, *w_down, *ws_gate, *ws_up, *ws_down;
    float* out; unsigned char* ws;
};
constexpr int NW = 8;

__device__ __forceinline__ void transpose_item(const float* W, int K, int N, bf16_t* WT, int G, int which, LAS float* scr, int item, int lane) {
    const int nblk = N / 32, kb = item / nblk, nb = item % nblk, k0 = 64 * kb, n0 = 32 * nb;
    float v[32];
#pragma unroll
    for (int i = 0; i < 32; ++i) { const int kk = 2 * i + (lane >> 5); v[i] = __builtin_nontemporal_load(W + (size_t)(k0 + kk) * N + n0 + (lane & 31)); }
#pragma unroll
    for (int i = 0; i < 32; ++i) { const int kk = 2 * i + (lane >> 5); scr[kk * 33 + (lane & 31)] = v[i]; }
    LDS_WAIT(); asm volatile("" ::: "memory");
    const int c = lane & 7;
#pragma unroll
    for (int j = 0; j < 4; ++j) { const int n = (lane >> 3) + 8 * j; const LAS float* s = scr + (8 * c) * 33 + n;
        u32x4 o; o.x = pk2(s[0 * 33], s[1 * 33]); o.y = pk2(s[2 * 33], s[3 * 33]); o.z = pk2(s[4 * 33], s[5 * 33]); o.w = pk2(s[6 * 33], s[7 * 33]);
        const int ng = n0 + n; const int drow = (G == 0) ? ng : ((ng / G) * 2 * G + which * G + (ng % G));
        *(u32x4*)(WT + (size_t)drow * K + k0 + 8 * c) = o; }
    LDS_WAIT(); asm volatile("" ::: "memory");
}
__device__ __forceinline__ void rope_entry(float* tab, int idx) {
    const int t = idx >> 6, i = idx & 63;
    const float inv_freq = powf(10000.f, -(float)(2 * i) / 128.f);
    const float ang = (float)t * inv_freq;
    const double a = (double)ang; const double two_pi = 6.283185307179586476925286766559;
    const double kf = rint(a / two_pi); double r = a - kf * two_pi;
    double sgn = 1.0; if (r > 1.5707963267948966) { r = 3.141592653589793 - r; sgn = -1.0; } else if (r < -1.5707963267948966) { r = -3.141592653589793 - r; sgn = -1.0; }
    const double r2 = r * r;
    const double s = r * (1.0 + r2 * (-1.0 / 6 + r2 * (1.0 / 120 + r2 * (-1.0 / 5040 + r2 * (1.0 / 362880 + r2 * (-1.0 / 39916800 + r2 * (1.0 / 6227020800.0 + r2 * (-1.0 / 1307674368000.0))))))));
    const double c = 1.0 + r2 * (-0.5 + r2 * (1.0 / 24 + r2 * (-1.0 / 720 + r2 * (1.0 / 40320 + r2 * (-1.0 / 3628800 + r2 * (1.0 / 479001600.0 + r2 * (-1.0 / 87178291200.0 + r2 * (1.0 / 20922789888000.0))))))));
    tab[idx] = (float)(sgn * c); tab[SEQ * 64 + idx] = (float)s;
}
__device__ __forceinline__ void mod_task(const float* __restrict__ cin, const float* __restrict__ w_ada, float* __restrict__ modp, int task, int lane) {
    const int cbk = task % 96, kc = task / 96, j = cbk * 64 + lane, k0 = kc * 64;
    float acc[32], cv[32];
#pragma unroll
    for (int b = 0; b < 32; ++b) { acc[b] = 0.f; cv[b] = silu_f(cin[b * D + k0 + lane]); }
#pragma unroll
    for (int kb = 0; kb < 4; ++kb) {
        float w[16];
#pragma unroll
        for (int i = 0; i < 16; ++i) w[i] = w_ada[(size_t)(k0 + kb * 16 + i) * 6144 + j];
#pragma unroll
        for (int i = 0; i < 16; ++i)
#pragma unroll
            for (int b = 0; b < 32; ++b) acc[b] += __builtin_bit_cast(float, __builtin_amdgcn_readlane(__builtin_bit_cast(int, cv[b]), kb * 16 + i)) * w[i];
    }
#pragma unroll
    for (int b = 0; b < 32; ++b) modp[((size_t)kc * 32 + b) * 6144 + j] = acc[b];
}
__device__ __forceinline__ float mod_sum(const float* __restrict__ modp, const float* __restrict__ b_ada, int b, int j) {
    float s = 0.f;
#pragma unroll
    for (int kc = 0; kc < 16; ++kc) s += modp[((size_t)kc * 32 + b) * 6144 + j];
    return s + b_ada[j];
}

__device__ __forceinline__ void na_item(const bf16_t* __restrict__ proj, const float* __restrict__ rpb, bf16_t* __restrict__ ymix, int gid) {
    const int h = gid & 7, tok = gid >> 3;
    const int b = tok >> 11, s = tok & 2047, r = s >> 6, c = s & 63;
    const int rs = min(max(r - 4, 0), 24), cs = min(max(c - 8, 0), 48);
    float q[64], acc[64];
    { const bf16_t* qp = proj + (size_t)tok * DIN + OFF_QNA + h * 64;
#pragma unroll
      for (int i = 0; i < 8; ++i) { const u32x4 v = *(const u32x4*)(qp + i * 8);
          q[i * 8 + 0] = __uint_as_float(v.x << 16); q[i * 8 + 1] = __uint_as_float(v.x & 0xffff0000u); q[i * 8 + 2] = __uint_as_float(v.y << 16); q[i * 8 + 3] = __uint_as_float(v.y & 0xffff0000u);
          q[i * 8 + 4] = __uint_as_float(v.z << 16); q[i * 8 + 5] = __uint_as_float(v.z & 0xffff0000u); q[i * 8 + 6] = __uint_as_float(v.w << 16); q[i * 8 + 7] = __uint_as_float(v.w & 0xffff0000u); } }
#pragma unroll
    for (int i = 0; i < 64; ++i) acc[i] = 0.f;
    float mx = -3.0e38f, l = 0.f;
    for (int kr = 0; kr < 8; ++kr) {
        for (int kc = 0; kc < 16; ++kc) {
            const int krow = rs + kr, kcol = cs + kc;
            const size_t kt = ((size_t)b << 11) + krow * 64 + kcol;
            const bf16_t* kp = proj + kt * DIN + OFF_KNA + h * 64; const bf16_t* vp = proj + kt * DIN + OFF_VNA + h * 64;
            float sc = 0.f;
#pragma unroll
            for (int i = 0; i < 8; ++i) { const u32x4 v = *(const u32x4*)(kp + i * 8);
                sc += q[i * 8 + 0] * __uint_as_float(v.x << 16) + q[i * 8 + 1] * __uint_as_float(v.x & 0xffff0000u) + q[i * 8 + 2] * __uint_as_float(v.y << 16) + q[i * 8 + 3] * __uint_as_float(v.y & 0xffff0000u)
                    + q[i * 8 + 4] * __uint_as_float(v.z << 16) + q[i * 8 + 5] * __uint_as_float(v.z & 0xffff0000u) + q[i * 8 + 6] * __uint_as_float(v.w << 16) + q[i * 8 + 7] * __uint_as_float(v.w & 0xffff0000u); }
            const int dr = krow - r + 7, dc = min(max(kcol - c + 15, 0), 30);
            sc += rpb[h * 465 + dr * 31 + dc];
            const float mn = fmaxf(mx, sc), corr = __expf(mx - mn), pe = __expf(sc - mn);
            l = l * corr + pe; mx = mn;
#pragma unroll
            for (int i = 0; i < 8; ++i) { const u32x4 v = *(const u32x4*)(vp + i * 8);
                acc[i * 8 + 0] = acc[i * 8 + 0] * corr + pe * __uint_as_float(v.x << 16); acc[i * 8 + 1] = acc[i * 8 + 1] * corr + pe * __uint_as_float(v.x & 0xffff0000u);
                acc[i * 8 + 2] = acc[i * 8 + 2] * corr + pe * __uint_as_float(v.y << 16); acc[i * 8 + 3] = acc[i * 8 + 3] * corr + pe * __uint_as_float(v.y & 0xffff0000u);
                acc[i * 8 + 4] = acc[i * 8 + 4] * corr + pe * __uint_as_float(v.z << 16); acc[i * 8 + 5] = acc[i * 8 + 5] * corr + pe * __uint_as_float(v.z & 0xffff0000u);
                acc[i * 8 + 6] = acc[i * 8 + 6] * corr + pe * __uint_as_float(v.w << 16); acc[i * 8 + 7] = acc[i * 8 + 7] * corr + pe * __uint_as_float(v.w & 0xffff0000u); }
        }
    }
    const float inv = 1.f / l;
    bf16_t* op = ymix + (size_t)tok * D + h * 64;
#pragma unroll
    for (int i = 0; i < 8; ++i) { u32x4 o; o.x = pk2(acc[i * 8 + 0] * inv, acc[i * 8 + 1] * inv); o.y = pk2(acc[i * 8 + 2] * inv, acc[i * 8 + 3] * inv);
        o.z = pk2(acc[i * 8 + 4] * inv, acc[i * 8 + 5] * inv); o.w = pk2(acc[i * 8 + 6] * inv, acc[i * 8 + 7] * inv); *(u32x4*)(op + i * 8) = o; }
}

__device__ __forceinline__ void ret_unit(const bf16_t* __restrict__ proj, const float* __restrict__ rope, const float* __restrict__ log_decay, float* __restrict__ ybuf, LAS unsigned char* lds, int unit) {
    LAS float* sq = (LAS float*)lds; LAS float* sk = sq + 16 * 128; LAS float* sv = sk + 16 * 128; LAS float* sy = sv + 16 * 128;
    const int dir = unit & 1, h = (unit >> 1) & 3, b = unit >> 3, tid = threadIdx.x;
    const int dv = tid & 127, qt = tid >> 7;
    const float g = __expf(log_decay[dir * 4 + h]);
    float S[32];
#pragma unroll
    for (int i = 0; i < 32; ++i) S[i] = 0.f;
    float* yo = ybuf + (size_t)dir * M * 512;
    for (int t0 = 0; t0 < SEQ; t0 += 16) {
        __syncthreads();
#pragma unroll
        for (int i = 0; i < 4; ++i) {
            const int q = tid + 512 * i;
            const int u = q >> 7, which = (q >> 6) & 1, pr = q & 63;
            const int t = dir ? (SEQ - 1 - (t0 + u)) : (t0 + u);
            const bf16_t* rowp = proj + ((size_t)(b * SEQ + t)) * DIN + (which ? OFF_KR : OFF_QR) + h * 128;
            const float a1 = bf2f(rowp[pr]), a2 = bf2f(rowp[pr + 64]);
            const float cs = rope[t * 64 + pr], sn = rope[SEQ * 64 + t * 64 + pr];
            LAS float* dst = (which ? sk : sq) + u * 128;
            dst[pr] = a1 * cs - a2 * sn; dst[pr + 64] = a2 * cs + a1 * sn;
        }
#pragma unroll
        for (int i = 0; i < 4; ++i) { const int q = tid + 512 * i; const int u = q >> 7, d = q & 127; const int t = dir ? (SEQ - 1 - (t0 + u)) : (t0 + u);
            sv[u * 128 + d] = bf2f(proj[((size_t)(b * SEQ + t)) * DIN + OFF_VR + h * 128 + d]); }
        __syncthreads();
        for (int u = 0; u < 16; ++u) {
            const float v = sv[u * 128 + dv]; float y = 0.f;
            if (dir == 0) {
#pragma unroll
                for (int i = 0; i < 32; ++i) { S[i] = g * S[i] + sk[u * 128 + qt * 32 + i] * v; y += sq[u * 128 + qt * 32 + i] * S[i]; }
            } else {
#pragma unroll
                for (int i = 0; i < 32; ++i) { y += sq[u * 128 + qt * 32 + i] * S[i]; S[i] = g * (S[i] + sk[u * 128 + qt * 32 + i] * v); }
            }
            sy[(u * 4 + qt) * 128 + dv] = y;
        }
        __syncthreads();
#pragma unroll
        for (int i = 0; i < 4; ++i) { const int q = tid + 512 * i; const int u = q >> 7, d = q & 127; const int t = dir ? (SEQ - 1 - (t0 + u)) : (t0 + u);
            yo[((size_t)(b * SEQ + t)) * 512 + h * 128 + d] = (sy[(u * 4 + 0) * 128 + d] + sy[(u * 4 + 1) * 128 + d]) + (sy[(u * 4 + 2) * 128 + d] + sy[(u * 4 + 3) * 128 + d]); }
    }
    __syncthreads();
}

namespace ret {
typedef short s16x4 __attribute__((ext_vector_type(4)));
typedef __bf16 bfx2 __attribute__((ext_vector_type(2)));
constexpr unsigned RS = 288, TILE = 128 * RS, LK = 0, LV = TILE, LRF = 2 * TILE, LRB = 3 * TILE;
constexpr float LOG2E = 1.4426950408889634f;
__device__ __forceinline__ unsigned offb(unsigned row, unsigned ch) { return RS * row + 16u * ch; }
__device__ __forceinline__ unsigned cvtpk(float lo, float hi) { const f32x2 v = {lo, hi}; return __builtin_bit_cast(unsigned, __builtin_convertvector(v, bfx2)); }
__device__ __forceinline__ bf16x8 pack8(const float (&f)[8]) { u32x4 u; u.x = cvtpk(f[0], f[1]); u.y = cvtpk(f[2], f[3]); u.z = cvtpk(f[4], f[5]); u.w = cvtpk(f[6], f[7]); return __builtin_bit_cast(bf16x8, u); }
__device__ __forceinline__ void unpack8(const bf16x8 v, float (&f)[8]) { const u32x4 u = __builtin_bit_cast(u32x4, v);
    f[0] = __uint_as_float(u.x << 16); f[1] = __uint_as_float(u.x & 0xffff0000u); f[2] = __uint_as_float(u.y << 16); f[3] = __uint_as_float(u.y & 0xffff0000u);
    f[4] = __uint_as_float(u.z << 16); f[5] = __uint_as_float(u.z & 0xffff0000u); f[6] = __uint_as_float(u.w << 16); f[7] = __uint_as_float(u.w & 0xffff0000u); }
__device__ __forceinline__ bf16x8 trfrag(LAS unsigned char* base, unsigned row0, unsigned row1, unsigned cblk, unsigned qp, unsigned p) {
    const unsigned ch = 2u * cblk + (p >> 1), bo = 8u * (p & 1u);
    const s16x4 lo = __builtin_amdgcn_ds_read_tr16_b64_v4i16((LAS s16x4*)(base + offb(row0 + qp, ch) + bo));
    const s16x4 hi = __builtin_amdgcn_ds_read_tr16_b64_v4i16((LAS s16x4*)(base + offb(row1 + qp, ch) + bo));
    return __builtin_shufflevector(lo, hi, 0, 1, 2, 3, 4, 5, 6, 7);
}
struct KVRaw { bf16x8 ka[2], kb[2], v[4]; f32x4 c0[2], c1[2], s0[2], s1[2]; };
__device__ __forceinline__ void kv_load(KVRaw& R, const bf16_t* __restrict__ proj, const float* __restrict__ rope, int b, int h, int n, int tid) {
#pragma unroll
    for (int i = 0; i < 2; ++i) {
        const int q2 = tid + 512 * i, row = q2 >> 3, pc = q2 & 7, t = n * 128 + row;
        const bf16_t* rp = proj + (size_t)(b * SEQ + t) * DIN + OFF_KR + h * 128;
        R.ka[i] = *(const bf16x8*)(rp + pc * 8); R.kb[i] = *(const bf16x8*)(rp + 64 + pc * 8);
        R.c0[i] = *(const f32x4*)(rope + t * 64 + pc * 8); R.c1[i] = *(const f32x4*)(rope + t * 64 + pc * 8 + 4);
        R.s0[i] = *(const f32x4*)(rope + SEQ * 64 + t * 64 + pc * 8); R.s1[i] = *(const f32x4*)(rope + SEQ * 64 + t * 64 + pc * 8 + 4);
    }
#pragma unroll
    for (int i = 0; i < 4; ++i) { const int q4 = tid + 512 * i, row = q4 >> 4, ch = q4 & 15, t = n * 128 + row;
        R.v[i] = *(const bf16x8*)(proj + (size_t)(b * SEQ + t) * DIN + OFF_VR + h * 128 + ch * 8); }
}
__device__ __forceinline__ void kv_store(LAS unsigned char* lds, const KVRaw& R, int tid) {
#pragma unroll
    for (int i = 0; i < 2; ++i) {
        const int q2 = tid + 512 * i, row = q2 >> 3, pc = q2 & 7;
        float fa[8], fb[8], o1[8], o2[8];
        unpack8(R.ka[i], fa); unpack8(R.kb[i], fb);
        const float cs[8] = {R.c0[i].x, R.c0[i].y, R.c0[i].z, R.c0[i].w, R.c1[i].x, R.c1[i].y, R.c1[i].z, R.c1[i].w}, sn[8] = {R.s0[i].x, R.s0[i].y, R.s0[i].z, R.s0[i].w, R.s1[i].x, R.s1[i].y, R.s1[i].z, R.s1[i].w};
#pragma unroll
        for (int e = 0; e < 8; ++e) { o1[e] = fa[e] * cs[e] - fb[e] * sn[e]; o2[e] = fb[e] * cs[e] + fa[e] * sn[e]; }
        *(LAS bf16x8*)(lds + LK + offb(row, pc)) = pack8(o1); *(LAS bf16x8*)(lds + LK + offb(row, pc + 8)) = pack8(o2);
    }
#pragma unroll
    for (int i = 0; i < 4; ++i) { const int q4 = tid + 512 * i, row = q4 >> 4, ch = q4 & 15; *(LAS bf16x8*)(lds + LV + offb(row, ch)) = R.v[i]; }
}
__device__ __forceinline__ void rb_dma(LAS unsigned char* lds, const unsigned char* img, int w, int lane) {
#pragma unroll
    for (int i = 0; i < 5; ++i) { const int o = w + 8 * i; if (o < (int)TILE / 1024)
        __builtin_amdgcn_global_load_lds((const unsigned*)(img + o * 1024 + lane * 16), (LAS unsigned*)(lds + LRB + o * 1024), 16, 0, 0); }
}
template <bool FWD> __device__ __forceinline__ void state_update(LAS unsigned char* lds, f32x4 (&racc)[8], float l2, int w, int g, unsigned qp, unsigned p) {
    const float dec = __builtin_amdgcn_exp2f(128.f * l2);
    bf16x8 vs[4];
#pragma unroll
    for (int ks = 0; ks < 4; ++ks) {
        float f[8]; unpack8(trfrag(lds + LV, 32 * ks + 8 * g, 32 * ks + 8 * g + 4, w, qp, p), f);
#pragma unroll
        for (int e = 0; e < 8; ++e) { const int key = 32 * ks + 8 * g + e; f[e] *= __builtin_amdgcn_exp2f((FWD ? (float)(127 - key) : (float)key) * l2); }
        vs[ks] = pack8(f);
    }
#pragma unroll
    for (int nb = 0; nb < 8; ++nb) {
        racc[nb] = racc[nb] * dec;
#pragma unroll
        for (int ks = 0; ks < 4; ++ks) racc[nb] = __builtin_amdgcn_mfma_f32_16x16x32_bf16(vs[ks], trfrag(lds + LK, 32 * ks + 8 * g, 32 * ks + 8 * g + 4, nb, qp, p), racc[nb], 0, 0, 0);
    }
}
__device__ __forceinline__ void unit(const bf16_t* __restrict__ proj, const float* __restrict__ rope, const float* __restrict__ log_decay, const float* __restrict__ gn_g, bf16_t* __restrict__ ymix,
                                     unsigned char* __restrict__ scratch  , LAS unsigned char* lds, int u) {
    const int b = u >> 2, h = u & 3;
    int tid_ = threadIdx.x; asm volatile("" : "+v"(tid_));
    const int tid0 = tid_, w = __builtin_amdgcn_readfirstlane(tid0 >> 6);
#define RET_LANE int tid = tid0; asm volatile("" : "+v"(tid)); const int lane = tid & 63, r = lane & 15, g = lane >> 4; const unsigned qp = (unsigned)r >> 2, p = (unsigned)lane & 3u;
    const float lf2_ = log_decay[h] * LOG2E, lb2_ = log_decay[4 + h] * LOG2E;
    f32x4 racc[8];
#pragma unroll
    for (int nb = 0; nb < 8; ++nb) racc[nb] = (f32x4){0.f, 0.f, 0.f, 0.f};
    KVRaw raw;
    kv_load(raw, proj, rope, b, h, 15, tid0);
    for (int n = 15; n >= 0; --n) {
        RET_LANE
        unsigned char* img = scratch + (size_t)n * TILE;
#pragma unroll
        for (int nb = 0; nb < 8; ++nb) { u32x2 o; o.x = cvtpk(racc[nb][0], racc[nb][1]); o.y = cvtpk(racc[nb][2], racc[nb][3]);
            *(u32x2*)(img + offb(16 * nb + r, 2 * w + (g >> 1)) + 8 * (g & 1)) = o; }
        if (n == 0) break;
        float lb2 = lb2_; asm volatile("" : "+v"(lb2));
        __syncthreads();
        kv_store(lds, raw, tid);
        __syncthreads();
        kv_load(raw, proj, rope, b, h, n > 1 ? n - 1 : 0, tid);
        state_update<false>(lds, racc, lb2, w, g, qp, p);
    }
    asm volatile("s_waitcnt vmcnt(0)" ::: "memory");
    __syncthreads();
    __builtin_amdgcn_fence(__ATOMIC_ACQUIRE, "agent");
    asm volatile("s_waitcnt vmcnt(0)" ::: "memory");
#pragma unroll
    for (int nb = 0; nb < 8; ++nb) racc[nb] = (f32x4){0.f, 0.f, 0.f, 0.f};
    rb_dma(lds, scratch, w, tid0 & 63);
    for (int n = 0; n < 16; ++n) {
        RET_LANE
        float lf2 = lf2_, lb2 = lb2_; asm volatile("" : "+v"(lf2), "+v"(lb2));
        const float* gnp = gn_g; asm volatile("" : "+s"(gnp));
        __syncthreads();
        kv_store(lds, raw, tid);
#pragma unroll
        for (int nb = 0; nb < 8; ++nb) { u32x2 o; o.x = cvtpk(racc[nb][0], racc[nb][1]); o.y = cvtpk(racc[nb][2], racc[nb][3]);
            *(LAS u32x2*)(lds + LRF + offb(16 * nb + r, 2 * w + (g >> 1)) + 8 * (g & 1)) = o; }
        const int cq = 16 * w + r, tq = n * 128 + cq;
        bf16x8 qn[4], qf[4], qb[4];
        { const bf16_t* rp = proj + (size_t)(b * SEQ + tq) * DIN + OFF_QR + h * 128 + 8 * g;
          const float sf = __builtin_amdgcn_exp2f((float)(cq + 1) * lf2), sb = __builtin_amdgcn_exp2f((float)(128 - cq) * lb2);
#pragma unroll
          for (int ks = 0; ks < 2; ++ks) {
              float fa[8], fb[8], o1[8], o2[8], t1[8], t2[8];
              unpack8(*(const bf16x8*)(rp + 32 * ks), fa); unpack8(*(const bf16x8*)(rp + 32 * ks + 64), fb);
              const float* cp = rope + tq * 64 + 32 * ks + 8 * g; const float* sp = cp + SEQ * 64;
              const f32x4 c0 = *(const f32x4*)cp, c1 = *(const f32x4*)(cp + 4), s0 = *(const f32x4*)sp, s1 = *(const f32x4*)(sp + 4);
              const float cs[8] = {c0.x, c0.y, c0.z, c0.w, c1.x, c1.y, c1.z, c1.w}, sn[8] = {s0.x, s0.y, s0.z, s0.w, s1.x, s1.y, s1.z, s1.w};
#pragma unroll
              for (int e = 0; e < 8; ++e) { o1[e] = fa[e] * cs[e] - fb[e] * sn[e]; o2[e] = fb[e] * cs[e] + fa[e] * sn[e]; }
              qn[ks] = pack8(o1); qn[ks + 2] = pack8(o2);
#pragma unroll
              for (int e = 0; e < 8; ++e) { t1[e] = o1[e] * sf; t2[e] = o2[e] * sf; }
              qf[ks] = pack8(t1); qf[ks + 2] = pack8(t2);
#pragma unroll
              for (int e = 0; e < 8; ++e) { t1[e] = o1[e] * sb; t2[e] = o2[e] * sb; }
              qb[ks] = pack8(t1); qb[ks + 2] = pack8(t2);
          } }
        asm volatile("s_waitcnt vmcnt(0)" ::: "memory");
        __syncthreads();
        kv_load(raw, proj, rope, b, h, n < 15 ? n + 1 : 15, tid);
        u32x2 gv[8];
        { const bf16_t* gp = proj + (size_t)(b * SEQ + tq) * DIN + OFF_GR + h * 128 + 4 * g;
#pragma unroll
          for (int mbv = 0; mbv < 8; ++mbv) gv[mbv] = *(const u32x2*)(gp + 16 * mbv); }
        bf16x8 pt[4];
#pragma unroll
        for (int ks2 = 0; ks2 < 4; ++ks2) {
            float pv[8];
#pragma unroll
            for (int hb = 0; hb < 2; ++hb) {
                const int mb = 2 * ks2 + hb;
                f32x4 st = (f32x4){0.f, 0.f, 0.f, 0.f};
#pragma unroll
                for (int ks = 0; ks < 4; ++ks) st = __builtin_amdgcn_mfma_f32_16x16x32_bf16(*(const LAS bf16x8*)(lds + LK + offb(16 * mb + r, 4 * ks + g)), qn[ks], st, 0, 0, 0);
#pragma unroll
                for (int j = 0; j < 4; ++j) { const int diff = cq - (16 * mb + 4 * g + j); pv[4 * hb + j] = st[j] * __builtin_amdgcn_exp2f(diff >= 0 ? (float)diff * lf2 : (float)(-diff) * lb2); }
            }
            pt[ks2] = pack8(pv);
        }
        f32x4 yacc[8];
#pragma unroll
        for (int mbv = 0; mbv < 8; ++mbv) {
            f32x4 y = (f32x4){0.f, 0.f, 0.f, 0.f};
#pragma unroll
            for (int ks2 = 0; ks2 < 4; ++ks2) y = __builtin_amdgcn_mfma_f32_16x16x32_bf16(trfrag(lds + LV, 32 * ks2 + 4 * g, 32 * ks2 + 16 + 4 * g, mbv, qp, p), pt[ks2], y, 0, 0, 0);
#pragma unroll
            for (int ks = 0; ks < 4; ++ks) {
                y = __builtin_amdgcn_mfma_f32_16x16x32_bf16(trfrag(lds + LRF, 32 * ks + 8 * g, 32 * ks + 8 * g + 4, mbv, qp, p), qf[ks], y, 0, 0, 0);
                y = __builtin_amdgcn_mfma_f32_16x16x32_bf16(trfrag(lds + LRB, 32 * ks + 8 * g, 32 * ks + 8 * g + 4, mbv, qp, p), qb[ks], y, 0, 0, 0);
            }
            yacc[mbv] = y;
        }
        __syncthreads();
        if (n < 15) rb_dma(lds, scratch + (size_t)(n + 1) * TILE, w, lane);
        { float s = 0.f;
#pragma unroll
          for (int mbv = 0; mbv < 8; ++mbv) s += (yacc[mbv][0] + yacc[mbv][1]) + (yacc[mbv][2] + yacc[mbv][3]);
          s += __shfl_xor(s, 16); s += __shfl_xor(s, 32);
          const float mu = s * (1.f / 128.f); float s2 = 0.f;
#pragma unroll
          for (int mbv = 0; mbv < 8; ++mbv) { yacc[mbv] = yacc[mbv] - mu; s2 += (yacc[mbv][0] * yacc[mbv][0] + yacc[mbv][1] * yacc[mbv][1]) + (yacc[mbv][2] * yacc[mbv][2] + yacc[mbv][3] * yacc[mbv][3]); }
          s2 += __shfl_xor(s2, 16); s2 += __shfl_xor(s2, 32);
          const float rstd = 1.f / sqrtf(s2 * (1.f / 128.f) + GN_EPS);
          bf16_t* op = ymix + (size_t)(b * SEQ + tq) * D + 512 + h * 128 + 4 * g;
#pragma unroll
          for (int mbv = 0; mbv < 8; ++mbv) {
              const f32x4 gn = *(const f32x4*)(gnp + h * 128 + 16 * mbv + 4 * g);
              const float g0 = __uint_as_float(gv[mbv].x << 16), g1 = __uint_as_float(gv[mbv].x & 0xffff0000u), g2 = __uint_as_float(gv[mbv].y << 16), g3 = __uint_as_float(gv[mbv].y & 0xffff0000u);
              u32x2 o; o.x = cvtpk(silu_f(g0) * (yacc[mbv][0] * rstd * gn.x), silu_f(g1) * (yacc[mbv][1] * rstd * gn.y));
              o.y = cvtpk(silu_f(g2) * (yacc[mbv][2] * rstd * gn.z), silu_f(g3) * (yacc[mbv][3] * rstd * gn.w));
              *(u32x2*)(op + 16 * mbv) = o;
          } }
        state_update<true>(lds, racc, lf2, w, g, qp, p);
    }
    __syncthreads();
#undef RET_LANE
}
}


namespace na {
constexpr unsigned LKR = 0, LVR = 73728, LRPB = 147456;
__device__ __forceinline__ void load_row(LAS unsigned char* lds, const bf16_t* __restrict__ proj, int b, int head, int krow, int tid) {
    const int key = tid >> 3, ch = tid & 7, slot = krow % 9;
    const bf16_t* rp = proj + (size_t)(b * SEQ + krow * 64 + key) * DIN + head * 64 + ch * 8;
    const unsigned o = (unsigned)slot * 8192u + 128u * key + 16u * (ch ^ (key & 7));
    *(LAS u32x4*)(lds + LKR + o) = *(const u32x4*)(rp + OFF_KNA);
    *(LAS u32x4*)(lds + LVR + o) = *(const u32x4*)(rp + OFF_VNA);
}
__device__ __forceinline__ void unit(const bf16_t* __restrict__ proj, const float* __restrict__ rpb, bf16_t* __restrict__ ymix, LAS unsigned char* lds, int u) {
    const int b = u >> 3, head = u & 7;
    int tid_ = threadIdx.x; asm volatile("" : "+v"(tid_));
    const int tid0 = tid_, w = __builtin_amdgcn_readfirstlane(tid0 >> 6);
    __syncthreads();
    if (tid0 < 465) ((LAS float*)(lds + LRPB))[tid0] = rpb[head * 465 + tid0];
    const int ct = w & 3, cb = (ct == 0) ? 0 : (ct == 1 ? 8 : (ct == 2 ? 24 : 32));
    u32x4 pk[2], pv2[2]; int pre_lo = 0, pre_n = 0;
    for (int st = 0; st < 16; ++st) {
        int tid = tid0; asm volatile("" : "+v"(tid));
        const int lane = tid & 63, qi = lane & 15, g = lane >> 4; const unsigned qp = (unsigned)qi >> 2, p = (unsigned)lane & 3u;
        const int r = 2 * st + (w >> 2);
        const int rs = min(max(r - 4, 0), 24);
        const int need_hi = min(max(2 * st + 1 - 4, 0), 24) + 7;
        __syncthreads();
        if (st == 0) { for (int kr = 0; kr <= need_hi; ++kr) load_row(lds, proj, b, head, kr, tid); }
        else {
#pragma unroll
            for (int i = 0; i < 2; ++i) if (i < pre_n) { const int key = tid >> 3, ch = tid & 7; const unsigned o = (unsigned)((pre_lo + i) % 9) * 8192u + 128u * key + 16u * (ch ^ (key & 7));
                *(LAS u32x4*)(lds + LKR + o) = pk[i]; *(LAS u32x4*)(lds + LVR + o) = pv2[i]; }
        }
        const int cq = 16 * ct + qi, tq = b * SEQ + r * 64 + cq;
        bf16x8 qn[2];
        { const bf16_t* qptr = proj + (size_t)tq * DIN + OFF_QNA + head * 64 + 8 * g; qn[0] = *(const bf16x8*)qptr; qn[1] = *(const bf16x8*)(qptr + 32); }
        __syncthreads();
        { const int nh = (st < 15) ? min(max(2 * st + 3 - 4, 0), 24) + 7 : need_hi; pre_lo = need_hi + 1; pre_n = nh - need_hi;
#pragma unroll
          for (int i = 0; i < 2; ++i) if (i < pre_n) { const int key = tid >> 3, ch = tid & 7; const bf16_t* rp = proj + (size_t)(b * SEQ + (pre_lo + i) * 64 + key) * DIN + head * 64 + ch * 8;
              pk[i] = *(const u32x4*)(rp + OFF_KNA); pv2[i] = *(const u32x4*)(rp + OFF_VNA); } }
        const int cs = min(max(cq - 8, 0), 48);
        const unsigned kb0 = 128u * qi + 16u * ((unsigned)g ^ ((unsigned)qi & 7u)), kb1 = 128u * qi + 16u * ((4u + (unsigned)g) ^ ((unsigned)qi & 7u));
        const LAS float* bias = (const LAS float*)(lds + LRPB);
        f32x4 sc[16]; float mx = -3.0e38f;
#pragma unroll
        for (int kr = 0; kr < 8; ++kr) {
            const int krow = rs + kr; const unsigned so = (unsigned)(krow % 9) * 8192u + 128u * (unsigned)cb;
            const int dr = krow - r + 7;
#pragma unroll
            for (int h2 = 0; h2 < 2; ++h2) {
                f32x4 a = (f32x4){0.f, 0.f, 0.f, 0.f};
                a = __builtin_amdgcn_mfma_f32_16x16x32_bf16(*(const LAS bf16x8*)(lds + LKR + so + 2048u * h2 + kb0), qn[0], a, 0, 0, 0);
                a = __builtin_amdgcn_mfma_f32_16x16x32_bf16(*(const LAS bf16x8*)(lds + LKR + so + 2048u * h2 + kb1), qn[1], a, 0, 0, 0);
#pragma unroll
                for (int j = 0; j < 4; ++j) {
                    const int kcol = cb + 16 * h2 + 4 * g + j;
                    const int dc = min(max(kcol - cq + 15, 0), 30);
                    const float v = a[j] + bias[dr * 31 + dc];
                    const bool in = (kcol >= cs) && (kcol < cs + 16);
                    a[j] = in ? v : -3.0e38f; mx = fmaxf(mx, a[j]);
                }
                sc[2 * kr + h2] = a;
            }
        }
        mx = fmaxf(mx, __shfl_xor(mx, 16)); mx = fmaxf(mx, __shfl_xor(mx, 32));
        float sum = 0.f; bf16x8 pt[8];
#pragma unroll
        for (int kk = 0; kk < 8; ++kk) {
            float pv[8];
#pragma unroll
            for (int h2 = 0; h2 < 2; ++h2)
#pragma unroll
                for (int j = 0; j < 4; ++j) { const float e = __builtin_amdgcn_exp2f((sc[2 * kk + h2][j] - mx) * 1.4426950408889634f); pv[4 * h2 + j] = e; sum += e; }
            pt[kk] = ret::pack8(pv);
        }
        sum += __shfl_xor(sum, 16); sum += __shfl_xor(sum, 32);
        const float inv = 1.f / sum;
        const unsigned sl = (((unsigned)g & 1u) << 2) | qp;
        bf16_t* op = ymix + (size_t)tq * D + head * 64 + 4 * g;
#pragma unroll
        for (int db = 0; db < 4; ++db) {
            const unsigned vb = 128u * (4u * (unsigned)g + qp) + 16u * ((2u * db + (p >> 1)) ^ sl) + 8u * (p & 1u);
            f32x4 y = (f32x4){0.f, 0.f, 0.f, 0.f};
#pragma unroll
            for (int kk = 0; kk < 8; ++kk) {
                const unsigned so = (unsigned)((rs + kk) % 9) * 8192u + 128u * (unsigned)cb;
                const ret::s16x4 lo = __builtin_amdgcn_ds_read_tr16_b64_v4i16((LAS ret::s16x4*)(lds + LVR + so + vb));
                const ret::s16x4 hi = __builtin_amdgcn_ds_read_tr16_b64_v4i16((LAS ret::s16x4*)(lds + LVR + so + 2048u + vb));
                y = __builtin_amdgcn_mfma_f32_16x16x32_bf16(__builtin_shufflevector(lo, hi, 0, 1, 2, 3, 4, 5, 6, 7), pt[kk], y, 0, 0, 0);
            }
            u32x2 o; o.x = ret::cvtpk(y[0] * inv, y[1] * inv); o.y = ret::cvtpk(y[2] * inv, y[3] * inv);
            *(u32x2*)(op + 16 * db) = o;
        }
    }
    __syncthreads();
}
}

__device__ __forceinline__ void ret_fin_item(const float* __restrict__ ybuf, const bf16_t* __restrict__ proj, const float* __restrict__ gn_g, bf16_t* __restrict__ ymix, int w, int lane) {
    const int tok = w >> 2, h = w & 3;
    const size_t o = (size_t)tok * 512 + h * 128 + lane * 2;
    const f32x2 a = *(const f32x2*)(ybuf + o), bb = *(const f32x2*)(ybuf + (size_t)M * 512 + o);
    const float y0 = a.x + bb.x, y1 = a.y + bb.y;
    const float mu = wave_sum(y0 + y1) * (1.f / 128.f); const float d0 = y0 - mu, d1 = y1 - mu;
    const float var = wave_sum(d0 * d0 + d1 * d1) * (1.f / 128.f); const float rs = 1.f / sqrtf(var + GN_EPS);
    const bf16_t* gp = proj + (size_t)tok * DIN + OFF_GR + h * 128 + lane * 2;
    const float g0 = bf2f(gp[0]), g1 = bf2f(gp[1]);
    const float o0 = silu_f(g0) * (d0 * rs * gn_g[h * 128 + lane * 2]), o1 = silu_f(g1) * (d1 * rs * gn_g[h * 128 + lane * 2 + 1]);
    *(unsigned*)(ymix + (size_t)tok * D + 512 + h * 128 + lane * 2) = pk2(o0, o1);
}
__device__ __forceinline__ void ln1_row(float* __restrict__ io, const float* __restrict__ g, const float* __restrict__ bb, const float* __restrict__ mod, bf16_t* __restrict__ hf, int row, int lane) {
    const int b = row >> 11;
    f32x4 v[4]; float s = 0.f;
#pragma unroll
    for (int j = 0; j < 4; ++j) { v[j] = *(const f32x4*)(io + (size_t)row * D + j * 256 + lane * 4); s += (v[j].x + v[j].y) + (v[j].z + v[j].w); }
    const float mean = wave_sum(s) * (1.f / D); float s2 = 0.f;
#pragma unroll
    for (int j = 0; j < 4; ++j) { v[j] = v[j] - mean; s2 += (v[j].x * v[j].x + v[j].y * v[j].y) + (v[j].z * v[j].z + v[j].w * v[j].w); }
    const float rstd = 1.f / sqrtf(wave_sum(s2) * (1.f / D) + LN_EPS);
#pragma unroll
    for (int j = 0; j < 4; ++j) { const int col = j * 256 + lane * 4;
        const f32x4 gg = *(const f32x4*)(g + col), bv = *(const f32x4*)(bb + col);
        const f32x4 x1 = v[j] * rstd * gg + bv;
        *(f32x4*)(io + (size_t)row * D + col) = x1;
        const f32x4 sc = *(const f32x4*)(mod + b * 6144 + MOD_SCALE_F + col), sh = *(const f32x4*)(mod + b * 6144 + MOD_SHIFT_F + col);
        u32x2 o; o.x = pk2(x1.x * (1.f + sc.x) + sh.x, x1.y * (1.f + sc.y) + sh.y); o.y = pk2(x1.z * (1.f + sc.z) + sh.z, x1.w * (1.f + sc.w) + sh.w);
        *(u32x2*)(hf + (size_t)row * D + col) = o; }
}
__device__ __forceinline__ void top2_merge(float& a1, float& a2, float b1, float b2) { const float n1 = fmaxf(a1, b1); const float n2 = fmaxf(fminf(a1, b1), fmaxf(a2, b2)); a1 = n1; a2 = n2; }
__device__ __forceinline__ void route_token(const float* __restrict__ logits, const f32x4 bias, int* __restrict__ topk_e, float* __restrict__ topk_w, LAS unsigned* hist, int tok, int lane) {
    const f32x4 lg = *(const f32x4*)(logits + (size_t)tok * NE + lane * 4);
    const float sc0 = 1.f / (1.f + __expf(-lg.x)), sc1 = 1.f / (1.f + __expf(-lg.y)), sc2 = 1.f / (1.f + __expf(-lg.z)), sc3 = 1.f / (1.f + __expf(-lg.w));
    float s0 = sc0 + bias.x, s1 = sc1 + bias.y, s2 = sc2 + bias.z, s3 = sc3 + bias.w;
    float m1 = fmaxf(s0, s1), m2 = fminf(s0, s1); top2_merge(m1, m2, fmaxf(s2, s3), fminf(s2, s3));
#pragma unroll
    for (int o = 1; o < 8; o <<= 1) { const float b1 = __shfl_xor(m1, o), b2 = __shfl_xor(m2, o); top2_merge(m1, m2, b1, b2); }
    const float gs = m1 + m2; const int grp = lane >> 3;
    int rank = 0;
#pragma unroll
    for (int gq = 0; gq < 8; ++gq) { const float og = __shfl(gs, gq * 8); rank += (og > gs || (og == gs && gq < grp)) ? 1 : 0; }
    const float NEG = -3.0e38f;
    if (rank >= 4) { s0 = NEG; s1 = NEG; s2 = NEG; s3 = NEG; }
    float wsum = 0.f; float myw = 0.f; int mye = 0;
#pragma unroll
    for (int k = 0; k < TOPK; ++k) {
        float bv = s0; int bi = 0;
        if (s1 > bv) { bv = s1; bi = 1; }
        if (s2 > bv) { bv = s2; bi = 2; }
        if (s3 > bv) { bv = s3; bi = 3; }
        int be = lane * 4 + bi;
#pragma unroll
        for (int o = 1; o < 64; o <<= 1) { const float ov = __shfl_xor(bv, o); const int oe = __shfl_xor(be, o); if (ov > bv || (ov == bv && oe < be)) { bv = ov; be = oe; } }
        const int ol = be >> 2, oj = be & 3;
        const float mysc = oj == 0 ? sc0 : (oj == 1 ? sc1 : (oj == 2 ? sc2 : sc3));
        const float wsel = __shfl(mysc, ol);
        if (lane == ol) { if (oj == 0) s0 = NEG; else if (oj == 1) s1 = NEG; else if (oj == 2) s2 = NEG; else s3 = NEG; }
        wsum += wsel;
        if (lane == k) { myw = wsel; mye = be; }
    }
    if (lane < TOPK) { topk_e[tok * TOPK + lane] = mye; topk_w[tok * TOPK + lane] = myw / wsum * 2.5f; __hip_atomic_fetch_add(&hist[mye], 1u, __ATOMIC_RELAXED, __HIP_MEMORY_SCOPE_WORKGROUP); }
}
__device__ __forceinline__ void build_tables(const unsigned* ctl, LAS unsigned* tab) {
    if (threadIdx.x < 64) {
        const int lane = threadIdx.x;
        unsigned c[4], so = 0, st = 0;
#pragma unroll
        for (int j = 0; j < 4; ++j) { c[j] = __hip_atomic_load(ctl + CW_COUNT + lane * 4 + j, __ATOMIC_RELAXED, __HIP_MEMORY_SCOPE_AGENT); so += c[j]; st += (c[j] + 255u) >> 8; }
        unsigned io = so, it = st;
#pragma unroll
        for (int o = 1; o < 64; o <<= 1) { const unsigned a = __shfl_up(io, o), b = __shfl_up(it, o); if (lane >= o) { io += a; it += b; } }
        unsigned eo = io - so, et = it - st;
#pragma unroll
        for (int j = 0; j < 4; ++j) { tab[T_CNT + lane * 4 + j] = c[j]; tab[T_OFF + lane * 4 + j] = eo; tab[T_TILE + lane * 4 + j] = et; eo += c[j]; et += (c[j] + 255u) >> 8; }
        if (lane == 63) { tab[T_OFF + NE] = eo; tab[T_TILE + NE] = et; }
    }
    __syncthreads();
}
__device__ __forceinline__ void final_row(float* __restrict__ io, const unsigned char* __restrict__ ybuf, const float* __restrict__ g, const float* __restrict__ bb, const float* __restrict__ mod, int row, int lane) {
    const int b = row >> 11;
    f32x4 v[4]; float s = 0.f;
#pragma unroll
    for (int j = 0; j < 4; ++j) {
        const int col = j * 256 + lane * 4;
        f32x4 a = (f32x4){0.f, 0.f, 0.f, 0.f};
#pragma unroll
        for (int k = 0; k < TOPK; ++k) {
            const unsigned pk = *(const unsigned*)(ybuf + ((size_t)row * TOPK + k) * D + col);
            const f32x2 lo = __builtin_amdgcn_cvt_pk_f32_fp8((int)pk, false), hi = __builtin_amdgcn_cvt_pk_f32_fp8((int)pk, true);
            a.x += lo.x; a.y += lo.y; a.z += hi.x; a.w += hi.y;
        }
        const f32x4 gt = *(const f32x4*)(mod + b * 6144 + MOD_GATE_F + col);
        v[j] = *(const f32x4*)(io + (size_t)row * D + col) + gt * a * YINV;
        s += (v[j].x + v[j].y) + (v[j].z + v[j].w);
    }
    const float mean = wave_sum(s) * (1.f / D); float s2 = 0.f;
#pragma unroll
    for (int j = 0; j < 4; ++j) { v[j] = v[j] - mean; s2 += (v[j].x * v[j].x + v[j].y * v[j].y) + (v[j].z * v[j].z + v[j].w * v[j].w); }
    const float rstd = 1.f / sqrtf(wave_sum(s2) * (1.f / D) + LN_EPS);
#pragma unroll
    for (int j = 0; j < 4; ++j) { const int col = j * 256 + lane * 4; const f32x4 gg = *(const f32x4*)(g + col), bv = *(const f32x4*)(bb + col);
        *(f32x4*)(io + (size_t)row * D + col) = v[j] * rstd * gg + bv; }
}

#ifndef MK_PER_PHASE
#define MK_PER_PHASE 0
#endif
constexpr int N_PHASES = 13;
struct Args { Ctx X; int ph_lo, ph_hi; };
typedef __attribute__((address_space(4))) const Ctx* CtxCP;
__device__ __forceinline__ CtxCP ctx_ptr() { CtxCP p = (CtxCP)__builtin_amdgcn_kernarg_segment_ptr(); asm volatile("" : "+s"(p)); return p; }

__global__ void __launch_bounds__(NW * 64, 2) mk_fwd(Args args) {
    extern __shared__ __attribute__((aligned(16))) unsigned char lds_raw[];
    LAS unsigned char* lds = (LAS unsigned char*)lds_raw;
    LAS unsigned* tab = (LAS unsigned*)(lds + TAB_OFF);
    volatile LAS unsigned* MISC = (volatile LAS unsigned*)(lds + MISC_OFF);
#define PH_BEGIN \
    const __attribute__((address_space(4))) Ctx& X = *ctx_ptr(); unsigned char* ws = X.ws; (void)ws; \
    const int tid = threadIdx.x, lane = tid & 63, wave = __builtin_amdgcn_readfirstlane(tid >> 6); (void)lane; (void)wave; \
    const int G = gridDim.x, bx = blockIdx.x; (void)G; (void)bx; \
    const int gw = bx * NW + wave, NGW = G * NW; (void)gw; (void)NGW; \
    const int gt = bx * (NW * 64) + tid, NGT = G * NW * 64; (void)gt; (void)NGT; \
    unsigned* ctl = (unsigned*)(ws + WS_CTL); float* mod = (float*)(ws + WS_MOD); float* rope = (float*)(ws + WS_ROPE); (void)ctl; (void)mod; (void)rope; \
    bf16_t* win_t = (bf16_t*)(ws + WS_WIN_T); bf16_t* wout_t = (bf16_t*)(ws + WS_WOUT_T); bf16_t* wr_t = (bf16_t*)(ws + WS_WR_T); (void)win_t; (void)wout_t; (void)wr_t; \
    bf16_t* wsgu_t = (bf16_t*)(ws + WS_WSGU_T); bf16_t* wsd_t = (bf16_t*)(ws + WS_WSD_T); bf16_t* wd_t = (bf16_t*)(ws + WS_WD_T); bf16_t* wgu_t = (bf16_t*)(ws + WS_WGU_T); (void)wsgu_t; (void)wsd_t; (void)wd_t; (void)wgu_t; \
    int* slot_ent = (int*)(ws + WS_SLOT_ENT); float* slot_w = (float*)(ws + WS_SLOT_W); int* topk_e = (int*)(ws + WS_TOPK_E); float* topk_w = (float*)(ws + WS_TOPK_W); (void)slot_ent; (void)slot_w; (void)topk_e; (void)topk_w; \
    bf16_t* ymix = (bf16_t*)(ws + WS_YMIX); bf16_t* proj = (bf16_t*)(ws + WS_PROJ); bf16_t* hbuf = (bf16_t*)(ws + WS_YMIX); (void)ymix; (void)proj; (void)hbuf; \
    float* logits = (float*)(ws + WS_LOGITS); bf16_t* shh = (bf16_t*)(ws + WS_SHH); bf16_t* hf = (bf16_t*)(ws + WS_HF); bf16_t* act = (bf16_t*)(ws + WS_ACT); (void)logits; (void)shh; (void)hf; (void)act; \
    unsigned char* ybuf = ws + WS_YBUF; float* out = X.out; (void)ybuf; (void)out;

    for (int u = threadIdx.x; u < (LDS_BYTES - MISC_OFF) / 4; u += NW * 64) ((LAS unsigned*)(lds + MISC_OFF))[u] = 0u;
    __syncthreads();
    if (!MK_PER_PHASE) { unsigned* ctl0 = (unsigned*)(args.X.ws + WS_CTL); (void)xcd_barrier_post(ctl0 + CW_BAR, MISC + 8); }
    const int lo = args.ph_lo, hi = args.ph_hi;
#ifndef MK_DUP
#define MK_DUP -1
#endif
#define REPS(k) for (int _rep = 0; _rep < ((MK_DUP == (k)) ? 2 : 1); ++_rep)
#ifdef MK_ONLY
#define IN(k) ((k) == MK_ONLY)
#else
#define IN(k) (lo <= (k) && (k) < hi)
#endif
#define SEAM(k) SEAM2(k, (k) + 1)
#define SEAM2(k, k2) do { if (IN(k) && IN(k2)) { XcdBarrier _b; _b.bar = (unsigned*)(ctx_ptr()->ws + WS_CTL) + CW_BAR; _b.x = xb_xcc_id(); _b.st = (volatile LAS unsigned*)(lds + MISC_OFF) + 8; xcd_barrier(_b); } } while (0)

    REPS(0) if (IN(0)) { PH_BEGIN
        LAS float* scr = (LAS float*)(lds + wave * 16384);
        float* modp = (float*)(ws + WS_PROJ);
        for (int t = gw; t < 96 * 16; t += NGW) mod_task(X.c, X.w_ada, modp, t, lane);
        constexpr int I_IN = (D / 64) * (DIN / 32), I_OUT = (D / 64) * (D / 32), I_R = (D / 64) * (NE / 32), I_SG = (D / 64) * (DE / 32), I_SD = (DE / 64) * (D / 32);
        constexpr int I_EG = I_SG, I_ED = I_SD;
        constexpr int N_SMALL = I_IN + I_OUT + I_R + 2 * I_SG + I_SD;
        constexpr int N_ITEMS = N_SMALL + NE * (2 * I_EG + I_ED);
        for (int it = gw; it < N_ITEMS; it += NGW) {
            int r = it;
            if (r < I_IN) { transpose_item(X.w_in, D, DIN, win_t, 0, 0, scr, r, lane); continue; } r -= I_IN;
            if (r < I_OUT) { transpose_item(X.w_out, D, D, wout_t, 0, 0, scr, r, lane); continue; } r -= I_OUT;
            if (r < I_R) { transpose_item(X.w_router, D, NE, wr_t, 0, 0, scr, r, lane); continue; } r -= I_R;
            if (r < I_SG) { transpose_item(X.ws_gate, D, DE, wsgu_t, 128, 0, scr, r, lane); continue; } r -= I_SG;
            if (r < I_SG) { transpose_item(X.ws_up, D, DE, wsgu_t, 128, 1, scr, r, lane); continue; } r -= I_SG;
            if (r < I_SD) { transpose_item(X.ws_down, DE, D, wsd_t, 0, 0, scr, r, lane); continue; } r -= I_SD;
            const int e = r / (2 * I_EG + I_ED); r -= e * (2 * I_EG + I_ED);
            if (r < I_EG) { transpose_item(X.w_gate + (size_t)e * D * DE, D, DE, wgu_t + (size_t)e * 512 * D, 128, 0, scr, r, lane); continue; } r -= I_EG;
            if (r < I_EG) { transpose_item(X.w_up + (size_t)e * D * DE, D, DE, wgu_t + (size_t)e * 512 * D, 128, 1, scr, r, lane); continue; } r -= I_EG;
            transpose_item(X.w_down + (size_t)e * DE * D, DE, D, wd_t + (size_t)e * D * DE, 0, 0, scr, r, lane);
        }
        for (int i = gt; i < SEQ * 64; i += NGT) rope_entry(rope, i);
    }
    SEAM(0);
    REPS(1) if (IN(1)) { PH_BEGIN
        const float* modp = (const float*)(ws + WS_PROJ);
        for (int i = gt; i < 32 * 6144; i += NGT) mod[i] = mod_sum(modp, X.b_ada, i / 6144, i % 6144);
        LAS float* ssc = (LAS float*)lds; LAS float* ssh = ssc + 1024;
        int curb = -1;
        for (int c = bx; c < M / 256; c += G) {
            const int b = c >> 3;
            if (b != curb) {
                __syncthreads();
                for (int i = tid; i < 1024; i += NW * 64) { ssc[i] = 1.f + mod_sum(modp, X.b_ada, b, MOD_SCALE_A + i); ssh[i] = mod_sum(modp, X.b_ada, b, MOD_SHIFT_A + i); }
                __syncthreads();
                curb = b;
            }
            const f32x4 sc = *(const LAS f32x4*)(ssc + (tid & 255) * 4), sh = *(const LAS f32x4*)(ssh + (tid & 255) * 4);
            const float* xp = X.x + (size_t)c * 256 * D + (size_t)(tid >> 8) * D + (tid & 255) * 4;
            bf16_t* hp = hbuf + (size_t)c * 256 * D + (size_t)(tid >> 8) * D + (tid & 255) * 4;
            for (int i0 = 0; i0 < 128; i0 += 8) {
                f32x4 v[8];
#pragma unroll
                for (int i = 0; i < 8; ++i) v[i] = __builtin_nontemporal_load((const f32x4*)(xp + (size_t)(i0 + i) * 2 * D));
#pragma unroll
                for (int i = 0; i < 8; ++i) { u32x2 o; o.x = pk2(v[i].x * sc.x + sh.x, v[i].y * sc.y + sh.y); o.y = pk2(v[i].z * sc.z + sh.z, v[i].w * sc.w + sh.w); *(u32x2*)(hp + (size_t)(i0 + i) * 2 * D) = o; }
            }
        }
        __syncthreads();
    }
    SEAM(1);
    REPS(2) if (IN(2)) { PH_BEGIN
        pg8::DenseOrder S; S.init(M, DIN, D, win_t, G, bx);
        pg8::EpiInProj E{proj};
        pg8::gemm_phase(lds, (const char*)hbuf, D, S, E);
    }
    SEAM(2);
    REPS(3) if (IN(3)) { PH_BEGIN
        const int R = (G >= 2) ? G / 2 : G;
        REPS(31) if (bx < R) for (int u = bx; u < BATCH * 4; u += R) ret::unit(proj, rope, X.ret_ld, X.ret_gn, ymix, (unsigned char*)out + (size_t)u * (16 * ret::TILE), lds, u);
        REPS(32) if (bx >= R || G < 2) for (int u = (G >= 2 ? bx - R : 0); u < BATCH * 8; u += (G >= 2 ? G - R : 1)) na::unit(proj, X.na_rpb, ymix, lds, u);
    }
    SEAM2(3, 5);
    REPS(5) if (IN(5)) { PH_BEGIN
        pg8::DenseOrder S; S.init(M, D, D, wout_t, G, bx);
        pg8::EpiOutProj E{X.x, mod, out};
        pg8::gemm_phase(lds, (const char*)ymix, D, S, E);
    }
    SEAM(5);
    if (IN(6)) { PH_BEGIN for (int r = gw; r < M; r += NGW) ln1_row(out, X.ln1_g, X.ln1_b, mod, hf, r, lane); }
    SEAM(6);
    REPS(7) if (IN(7)) { PH_BEGIN
        { pg8::DenseOrder S; S.init(M, NE, D, wr_t, G, bx); pg8::EpiRouter E{logits}; pg8::gemm_phase(lds, (const char*)hf, D, S, E); }
        { pg8::DenseOrder S; S.init(M, 2 * DE, D, wsgu_t, G, bx); pg8::EpiGU<false> E{shh, nullptr}; pg8::gemm_phase(lds, (const char*)hf, D, S, E); }
    }
    SEAM(7);
    if (IN(8)) { PH_BEGIN
        LAS unsigned* hist = tab + T_HIST;
        if (tid < NE) hist[tid] = 0u;
        __syncthreads();
        const f32x4 bias = *(const f32x4*)(X.rbias + lane * 4);
        for (int tok = gw; tok < M; tok += NGW) route_token(logits, bias, topk_e, topk_w, hist, tok, lane);
        __syncthreads();
        if (tid < NE && hist[tid]) atomicAdd(&ctl[CW_COUNT + tid], hist[tid]);
    }
    SEAM(8);
    if (IN(9)) { PH_BEGIN
        build_tables(ctl, tab);
        LAS unsigned* hist = tab + T_HIST; LAS unsigned* base = tab + T_BASE;
        for (int c0 = bx * 2048; c0 < NSLOT; c0 += G * 2048) {
            __syncthreads();
            if (tid < NE) hist[tid] = 0u;
            __syncthreads();
            int e[4]; unsigned loc[4];
#pragma unroll
            for (int i = 0; i < 4; ++i) { const int idx = c0 + i * 512 + tid; e[i] = topk_e[idx]; loc[i] = __hip_atomic_fetch_add(&hist[e[i]], 1u, __ATOMIC_RELAXED, __HIP_MEMORY_SCOPE_WORKGROUP); }
            __syncthreads();
            if (tid < NE && hist[tid]) base[tid] = atomicAdd(&ctl[CW_CURSOR + tid], hist[tid]);
            __syncthreads();
#pragma unroll
            for (int i = 0; i < 4; ++i) { const int idx = c0 + i * 512 + tid; const unsigned pos = tab[T_OFF + e[i]] + base[e[i]] + loc[i]; slot_ent[pos] = idx; slot_w[pos] = topk_w[idx]; }
        }
    }
    SEAM(9);
    if (IN(10)) { PH_BEGIN
        build_tables(ctl, tab);
        REPS(10) { pg8::ExpertOrder<2, true> S; S.init(tab, D, wgu_t, (size_t)512 * D * 2, slot_ent, G, bx); pg8::EpiGU<true> E{act, slot_w}; pg8::gemm_phase(lds, (const char*)hf, D, S, E); }
        { pg8::DenseOrder S; S.init(M, D, DE, wsd_t, G, bx); pg8::EpiSharedDown E{mod, out}; pg8::gemm_phase(lds, (const char*)shh, DE, S, E); }
    }
    SEAM(10);
    REPS(11) if (IN(11)) { PH_BEGIN
        build_tables(ctl, tab);
        pg8::ExpertOrder<4, false> S; S.init(tab, DE, wd_t, (size_t)D * DE * 2, slot_ent, G, bx); pg8::EpiExpDown E{ybuf, slot_ent}; pg8::gemm_phase(lds, (const char*)act, DE, S, E);
    }
    SEAM(11);
    if (IN(12)) { PH_BEGIN for (int r = gw; r < M; r += NGW) final_row(out, ybuf, X.ln2_g, X.ln2_b, mod, r, lane); }
#undef IN
#undef SEAM
}

extern "C" void kernel_launch(void* const* d_in, const int* in_sizes, int n_in, void* d_out, int out_size, void* d_ws, size_t ws_size, hipStream_t stream) {
    static int grid = 0;
    if (grid == 0) {
        if (n_in != 21 || in_sizes[0] != M * D || out_size != M * D || ws_size < WS_END) { fprintf(stderr, "kernel_launch: unexpected shapes (n_in %d, ws %zu)\n", n_in, ws_size); grid = -1; return; }
        int dev = 0, cus = 0, per_cu = 0;
        if (hipGetDevice(&dev) != hipSuccess || hipDeviceGetAttribute(&cus, hipDeviceAttributeMultiprocessorCount, dev) != hipSuccess) { grid = -1; return; }
        if (hipFuncSetAttribute((const void*)mk_fwd, hipFuncAttributeMaxDynamicSharedMemorySize, LDS_BYTES) != hipSuccess) { fprintf(stderr, "kernel_launch: hipFuncSetAttribute failed\n"); grid = -1; return; }
        if (hipOccupancyMaxActiveBlocksPerMultiprocessor(&per_cu, (const void*)mk_fwd, NW * 64, LDS_BYTES) != hipSuccess || per_cu < 1) { fprintf(stderr, "kernel_launch: occupancy query says %d\n", per_cu); }
        (void)hipGetLastError();
        grid = cus;
    }
    if (grid < 0) return;
    (void)hipMemsetAsync((char*)d_ws + WS_CTL, 0, 1 * MiB, stream);
    Args a{};
    const float** p = (const float**)&a.X;
    for (int i = 0; i < 21; ++i) p[i] = (const float*)d_in[i];
    a.X.out = (float*)d_out; a.X.ws = (unsigned char*)d_ws;
#if MK_PER_PHASE
    for (int ph = 0; ph < N_PHASES; ++ph) { a.ph_lo = ph; a.ph_hi = ph + 1; hipLaunchKernelGGL(mk_fwd, dim3(grid), dim3(NW * 64), LDS_BYTES, stream, a); }
#else
    a.ph_lo = 0; a.ph_hi = N_PHASES;
    hipLaunchKernelGGL(mk_fwd, dim3(grid), dim3(NW * 64), LDS_BYTES, stream, a);
#endif
}
```

```cpp
#include <hip/hip_runtime.h>
#include <cstdio>
#include <cstdint>

typedef unsigned short bf16_t;
typedef short bf16x8 __attribute__((ext_vector_type(8)));
typedef float f32x4 __attribute__((ext_vector_type(4)));
typedef float f32x2 __attribute__((ext_vector_type(2)));
typedef unsigned u32x4 __attribute__((ext_vector_type(4)));
typedef unsigned u32x2 __attribute__((ext_vector_type(2)));
#define LAS __attribute__((address_space(3)))

constexpr int D = 1024, BATCH = 32, SEQ = 2048, M = BATCH * SEQ;
constexpr int DIN = 3584;
constexpr int OFF_QNA = 0, OFF_KNA = 512, OFF_VNA = 1024, OFF_QR = 1536, OFF_KR = 2048, OFF_VR = 2560, OFF_GR = 3072;
constexpr int NE = 256, TOPK = 8, DE = 256;
constexpr int NSLOT = M * TOPK;
constexpr float LN_EPS = 1e-5f, GN_EPS = 1e-6f;
constexpr float ALPHA = 1.189207115002721f;
constexpr float YSCALE = 64.f, YINV = 1.f / 64.f;
constexpr int MOD_SHIFT_A = 0, MOD_SCALE_A = 1024, MOD_GATE_A = 2048, MOD_SHIFT_F = 3072, MOD_SCALE_F = 4096, MOD_GATE_F = 5120;

constexpr size_t MiB = 1u << 20;
constexpr size_t WS_CTL = 0;
constexpr size_t WS_MOD = 1 * MiB;
constexpr size_t WS_ROPE = 2 * MiB;
constexpr size_t WS_WIN_T = 4 * MiB;
constexpr size_t WS_WOUT_T = 11 * MiB;
constexpr size_t WS_WR_T = 13 * MiB;
constexpr size_t WS_WSGU_T = 14 * MiB;
constexpr size_t WS_WSD_T = 15 * MiB;
constexpr size_t WS_SLOT_ENT = 16 * MiB;
constexpr size_t WS_SLOT_W = 18 * MiB;
constexpr size_t WS_TOPK_E = 20 * MiB;
constexpr size_t WS_TOPK_W = 22 * MiB;
constexpr size_t WS_WD_T = 32 * MiB;
constexpr size_t WS_WGU_T = 160 * MiB;
constexpr size_t WS_YMIX = 416 * MiB;
constexpr size_t WS_PROJ = 544 * MiB;
constexpr size_t WS_LOGITS = WS_YMIX, WS_SHH = WS_YMIX + 64 * MiB;
constexpr size_t WS_HF = WS_PROJ, WS_ACT = WS_PROJ + 128 * MiB;
constexpr size_t WS_YBUF = WS_WGU_T;
constexpr size_t WS_YSH = WS_PROJ + 384 * MiB;
constexpr size_t WS_END = 992 * MiB;
constexpr int CW_COUNT = 1024, CW_CURSOR = 1536, CW_BAR = 8192;

constexpr int RING_BYTES = 131072;
constexpr int TAB_OFF = RING_BYTES;
constexpr int T_OFF = 0, T_TILE = 260, T_CNT = 520, T_HIST = 776, T_BASE = 1032, TAB_WORDS = 1288;
constexpr int VN_OFF = TAB_OFF + 6144;
constexpr int ROWTAB_OFF = VN_OFF + 8192;
constexpr int PHASE_BYTES = 155648;
constexpr int MISC_OFF = PHASE_BYTES;
constexpr int LDS_BYTES = PHASE_BYTES + 256;
static_assert(TAB_WORDS * 4 <= 6144 && ROWTAB_OFF + 6144 <= PHASE_BYTES && LDS_BYTES <= 163840, "LDS map");

__device__ __forceinline__ unsigned f2bf(float f) { unsigned u = __float_as_uint(f); return (u + 0x7fffu + ((u >> 16) & 1u)) >> 16; }
__device__ __forceinline__ float bf2f(unsigned short h) { return __uint_as_float(((unsigned)h) << 16); }
__device__ __forceinline__ unsigned pk2(float lo, float hi) { return f2bf(lo) | (f2bf(hi) << 16); }
__device__ __forceinline__ unsigned cvt_pk_bf16(float lo, float hi) { unsigned r; asm volatile("v_cvt_pk_bf16_f32 %0, %1, %2" : "=v"(r) : "v"(lo), "v"(hi)); return r; }
__device__ __forceinline__ float silu_f(float v) { return v * __builtin_amdgcn_rcpf(1.f + __expf(-v)); }
__device__ __forceinline__ float wave_sum(float v) {
#pragma unroll
    for (int o = 1; o < 64; o <<= 1) v += __shfl_xor(v, o);
    return v;
}
__device__ __forceinline__ float clamp8(float v) { return fminf(fmaxf(v, -440.f), 440.f); }
#define LDS_WAIT() asm volatile("s_waitcnt lgkmcnt(0)" ::: "memory")
__device__ __forceinline__ int lane_id() { return (int)__builtin_amdgcn_mbcnt_hi(~0u, __builtin_amdgcn_mbcnt_lo(~0u, 0u)); }

#define XB_TMO      128
#define XB_XCNT(j)  (256  + 64 * (j))
#define XB_XSUB(j)  (1280 + 64 * (j))
#define XB_XGEN(j)  (2304 + 64 * (j))
#define XB_TOP      3328
#define XB_TOPGEN   3392
#define XCD_BAR_WORDS 3456
#define XB_SPIN_CAP (1u << 23)
__device__ __forceinline__ unsigned xb_ld(unsigned* p)              { return __hip_atomic_load(p, __ATOMIC_RELAXED, __HIP_MEMORY_SCOPE_AGENT); }
__device__ __forceinline__ unsigned xb_add(unsigned* p, unsigned v) { return __hip_atomic_fetch_add(p, v, __ATOMIC_RELAXED, __HIP_MEMORY_SCOPE_AGENT); }
__device__ __forceinline__ unsigned xb_xcc_id() { return (unsigned)__builtin_amdgcn_s_getreg((3 << 11) | 20) & 0xFu; }
#define XB_SPIN(cond, bar) do { unsigned _sp = 0; while (cond) { __builtin_amdgcn_s_sleep(1); \
    if ((++_sp & 255u) == 0u) { if (xb_ld(&(bar)[XB_TMO])) break; if (_sp > XB_SPIN_CAP) { atomicAdd(&(bar)[XB_TMO], 1u); break; } } } } while (0)
struct XcdBarrier { unsigned* bar; unsigned x; volatile LAS unsigned* st; };
__device__ __forceinline__ XcdBarrier xcd_barrier_post(unsigned* bar, volatile LAS unsigned* st, bool leader) {
    XcdBarrier b; b.bar = bar; b.x = xb_xcc_id(); b.st = st;
    if (leader) (void)xb_add(&bar[XB_XCNT(b.x)], 1u);
    return b;
}
__device__ __forceinline__ void xcd_barrier_complete(unsigned* bar, unsigned x, unsigned& nloc, unsigned& nx) {
    const unsigned G = gridDim.x * gridDim.y * gridDim.z;
    unsigned sum, cnt, mine, sp = 0u;
    for (;;) {
        sum = 0u; cnt = 0u; mine = 0u;
#pragma unroll
        for (unsigned j = 0; j < 16; ++j) { const unsigned c = xb_ld(&bar[XB_XCNT(j)]); sum += c; cnt += (c > 0u) ? 1u : 0u; mine = (j == x) ? c : mine; }
        if (sum == G) break;
        __builtin_amdgcn_s_sleep(1);
        if ((++sp & 255u) == 0u) { if (xb_ld(&bar[XB_TMO])) break; if (sp > XB_SPIN_CAP) { atomicAdd(&bar[XB_TMO], 1u); break; } }
    }
    nloc = mine > 0u ? mine : 1u; nx = cnt > 0u ? cnt : 1u;
}
__device__ __forceinline__ void xcd_barrier(const XcdBarrier& b, bool leader) {
    asm volatile("s_waitcnt vmcnt(0)" ::: "memory");
    __syncthreads();
    if (leader) {
        unsigned* bar = b.bar;
        __builtin_amdgcn_s_waitcnt(0);
        unsigned nloc = b.st[0], nx = b.st[1];
        if (nloc == 0u) { xcd_barrier_complete(bar, b.x, nloc, nx); b.st[0] = nloc; b.st[1] = nx; }
        const unsigned old = xb_add(&bar[XB_XSUB(b.x)], 1u);
        const unsigned gen = old / nloc;
        if (old + 1u == (gen + 1u) * nloc) {
            __builtin_amdgcn_fence(__ATOMIC_RELEASE, "agent");
            asm volatile("s_waitcnt vmcnt(0)" ::: "memory");
            const unsigned og = xb_add(&bar[XB_TOP], 1u);
            const unsigned tg = og / nx;
            if (og + 1u == (tg + 1u) * nx) xb_add(&bar[XB_TOPGEN], 1u);
            else XB_SPIN(xb_ld(&bar[XB_TOPGEN]) == tg, bar);
            __builtin_amdgcn_fence(__ATOMIC_ACQUIRE, "agent");
            xb_add(&bar[XB_XGEN(b.x)], 1u);
            asm volatile("s_waitcnt vmcnt(0)" ::: "memory");
        } else {
            XB_SPIN(xb_ld(&bar[XB_XGEN(b.x)]) == gen, bar);
            __builtin_amdgcn_fence(__ATOMIC_ACQUIRE, "agent");
            asm volatile("s_waitcnt vmcnt(0)" ::: "memory");
        }
    }
    __syncthreads();
}

namespace pg8 {
constexpr int BM = 256, BK = 64, HALF = 128, HTB = HALF * BK * 2, STAGE_BYTES = 8 * HTB;
__device__ __forceinline__ int lds_byte(int r, int c) { const int st = (r >> 4) * 2 + (c >> 5), rr = r & 15, cc = c & 31, ob = rr * 64 + cc * 2; return st * 1024 + (ob ^ (((ob >> 9) & 1) << 5)); }
__device__ __forceinline__ void stage_rc(int b, int& R, int& C) { const int st = b / 1024, sb = b % 1024, swz = sb ^ (((sb >> 9) & 1) << 5); R = (st >> 1) * 16 + swz / 64; C = (st & 1) * 32 + (swz % 64) / 2; }
__device__ __forceinline__ int perm32(int rho) { const int n = rho >> 4, i = rho & 15; return 8 * (i >> 2) + 4 * n + (i & 3); }

struct Unit { int pm, pn; const char* B; int e, cnt, off; };

template <class Epi, class Sched>
__device__ __forceinline__ void gemm_phase(LAS unsigned char* lds, const char* Abase, const int K, const Sched& S, const Epi& E, const int tid_in) {
    int tid_ = tid_in; asm volatile("" : "+v"(tid_));
    const int tid = tid_, wid = __builtin_amdgcn_readfirstlane(tid >> 6), lane = tid & 63, wr = wid >> 2, wc = wid & 3, fr = lane & 15, fq = lane >> 4;
    const int nt = K / BK;
    int Rr[2], Cc[2]; unsigned voffB[2], voffA[2];
#pragma unroll
    for (int i = 0; i < 2; ++i) { int R, C; stage_rc(tid * 16 + i * 8192, R, C); Rr[i] = R; Cc[i] = C; const int Rb = Epi::PERM ? ((R & ~31) + perm32(R & 31)) : R; voffB[i] = (unsigned)(Rb * K + C) * 2u; voffA[i] = (unsigned)(R * K + C) * 2u; }
    constexpr bool GATHER = Sched::GATHER;
    const size_t kstep = (size_t)(BK * 2);
    const size_t hstep = (size_t)HALF * K * 2;
    const unsigned ldsw = (unsigned)wid * 1024u;
    const int aoff = lds_byte(wr * 64 + fr, fq * 8), boff = lds_byte(wc * 32 + fr, fq * 8);
#define PG8_SA(b, h) (((b) * 2 + (h)) * HTB)
#define PG8_SB(b, h) ((4 + (b) * 2 + (h)) * HTB)
#define PG8_STAGE(bufoff, gbase, voff) do { _Pragma("unroll") for (int _i = 0; _i < 2; ++_i) \
        __builtin_amdgcn_global_load_lds((const unsigned*)((const char*)(gbase) + (voff)[_i]), (LAS unsigned*)(lds + (bufoff) + ldsw + _i * 8192), 16, 0, 0); } while (0)
#define PG8_STAGEA(bufoff, uptr, koff, NEXT, h) do { if constexpr (GATHER) { if (NEXT) { const u32x2 _t = *(const LAS u32x2*)(vnslot + 2 * (h)); unsigned _v[2] = {_t.x, _t.y}; PG8_STAGE(bufoff, Abase + (koff), _v); } else { PG8_STAGE(bufoff, Abase + (koff), vc[h]); } } \
        else { PG8_STAGE(bufoff, (uptr) + (size_t)(h) * hstep + (koff), voffA); } } while (0)
#define PG8_LDA(dst, b, h) do { _Pragma("unroll") for (int m = 0; m < 4; ++m) _Pragma("unroll") for (int k = 0; k < 2; ++k) dst[m][k] = *(const LAS bf16x8*)(lds + PG8_SA(b, h) + aoff + m * 2048 + k * 1024); } while (0)
#define PG8_LDB(dst, b, h) do { _Pragma("unroll") for (int n = 0; n < 2; ++n) _Pragma("unroll") for (int k = 0; k < 2; ++k) dst[n][k] = *(const LAS bf16x8*)(lds + PG8_SB(b, h) + boff + n * 2048 + k * 1024); } while (0)
#define PG8_MMA(ai, bj, At, Bt) do { __builtin_amdgcn_s_setprio(1); _Pragma("unroll") for (int m = 0; m < 4; ++m) _Pragma("unroll") for (int n = 0; n < 2; ++n) _Pragma("unroll") for (int k = 0; k < 2; ++k) \
        acc[ai][bj][m][n] = __builtin_amdgcn_mfma_f32_16x16x32_bf16(Bt[n][k], At[m][k], acc[ai][bj][m][n], 0, 0, 0); __builtin_amdgcn_s_setprio(0); } while (0)
#define PG8_WAIT_V(n) asm volatile("s_waitcnt vmcnt(" #n ")" ::: "memory")
#define PG8_WAIT_L(n) asm volatile("s_waitcnt lgkmcnt(" #n ")" ::: "memory")
#define PG8_BAR __builtin_amdgcn_s_barrier()
#define PG8_SCHED __builtin_amdgcn_sched_barrier(0)
    Unit cur, nxt; int ui = 0;
    if (!S.next(0, cur)) return;
    f32x4 acc[2][2][4][2];
#pragma unroll
    for (int a = 0; a < 2; ++a)
#pragma unroll
        for (int b = 0; b < 2; ++b)
#pragma unroll
            for (int m = 0; m < 4; ++m)
#pragma unroll
                for (int n = 0; n < 2; ++n) acc[a][b][m][n] = (f32x4){0.f, 0.f, 0.f, 0.f};
    bf16x8 At[4][2], B0[2][2], B1[2][2];
    unsigned vc[2][2];
    LAS unsigned* vnslot = (LAS unsigned*)(lds + (VN_OFF - 0)) + tid * 4;
    if constexpr (GATHER) S.avoff(cur, Rr, Cc, vc, tid);
    LAS unsigned* rowtab = (LAS unsigned*)(lds + ROWTAB_OFF);
    if constexpr (GATHER) S.rowtab(cur, rowtab, tid);
    const char* cB = cur.B; const char* cA = Abase + S.aoff(cur);
    PG8_STAGE(PG8_SB(0, 0), cB, voffB); PG8_STAGE(PG8_SB(0, 1), cB + hstep, voffB); PG8_STAGEA(PG8_SA(0, 0), cA, 0, false, 0); PG8_STAGEA(PG8_SA(0, 1), cA, 0, false, 1);
    if (wr == 1) PG8_BAR;
    PG8_WAIT_V(2); PG8_BAR;
    PG8_STAGE(PG8_SB(1, 0), cB + kstep, voffB); PG8_STAGEA(PG8_SA(1, 0), cA, kstep, false, 0); PG8_STAGE(PG8_SB(1, 1), cB + hstep + kstep, voffB);
    PG8_WAIT_V(6); PG8_BAR;
    for (;;) {
        const bool has_next = S.next(ui + 1, nxt);
        if constexpr (GATHER) {
            unsigned vn[2][2];
            if (has_next) S.avoff(nxt, Rr, Cc, vn, tid);
            else {
#pragma unroll
                for (int h = 0; h < 2; ++h)
#pragma unroll
                    for (int i = 0; i < 2; ++i) vn[h][i] = vc[h][i];
            }
            *(LAS u32x4*)vnslot = (u32x4){vn[0][0], vn[0][1], vn[1][0], vn[1][1]};
            if (has_next) S.rowtab(nxt, rowtab + 512 * ((ui + 1) % 3), tid);
        }
        const char* nB = has_next ? nxt.B : cB; const char* nA = has_next ? Abase + S.aoff(nxt) : cA;
        for (int t = 0; t < nt; t += 2) {
            const bool last = (t == nt - 2);
            const size_t k1 = (size_t)(t + 1) * kstep;
            const size_t k2 = last ? (size_t)0 : (size_t)(t + 2) * kstep, k3 = k2 + kstep;
            const char* u2 = last ? nA : cA; const char* b2 = last ? nB : cB + (size_t)(t + 2) * kstep;
            const char* b3 = b2 + kstep;
            PG8_LDB(B0, 0, 0); PG8_LDB(B1, 0, 1); PG8_SCHED; PG8_LDA(At, 0, 0); PG8_STAGEA(PG8_SA(1, 1), cA, k1, false, 1);
            PG8_WAIT_V(8); PG8_WAIT_L(0); PG8_BAR; PG8_MMA(0, 0, At, B0); PG8_MMA(0, 1, At, B1); PG8_BAR; PG8_SCHED;
            PG8_LDA(At, 0, 1); PG8_STAGE(PG8_SB(0, 0), b2, voffB); PG8_STAGE(PG8_SB(0, 1), b2 + hstep, voffB); PG8_STAGEA(PG8_SA(0, 0), u2, k2, last, 0);
            PG8_WAIT_V(8); PG8_WAIT_L(0); PG8_BAR; PG8_MMA(1, 0, At, B0); PG8_MMA(1, 1, At, B1); PG8_BAR; PG8_SCHED;
            PG8_LDB(B0, 1, 0); PG8_LDB(B1, 1, 1); PG8_SCHED; PG8_LDA(At, 1, 0); PG8_STAGEA(PG8_SA(0, 1), u2, k2, last, 1);
            PG8_WAIT_V(8); PG8_WAIT_L(0); PG8_BAR; PG8_MMA(0, 0, At, B0); PG8_MMA(0, 1, At, B1); PG8_BAR; PG8_SCHED;
            PG8_LDA(At, 1, 1); PG8_STAGE(PG8_SB(1, 0), b3, voffB); PG8_STAGE(PG8_SB(1, 1), b3 + hstep, voffB); PG8_STAGEA(PG8_SA(1, 0), u2, k3, last, 0);
            PG8_WAIT_V(8); PG8_WAIT_L(0); PG8_BAR; PG8_MMA(1, 0, At, B0); PG8_MMA(1, 1, At, B1); PG8_BAR; PG8_SCHED;
        }
        if (wr == 0) PG8_BAR;
        E(acc, cur, wr, wc, fr, fq, rowtab + 512 * (ui % 3));
        if (!has_next) break;
#pragma unroll
        for (int a = 0; a < 2; ++a)
#pragma unroll
            for (int b = 0; b < 2; ++b)
#pragma unroll
                for (int m = 0; m < 4; ++m)
#pragma unroll
                    for (int n = 0; n < 2; ++n) acc[a][b][m][n] = (f32x4){0.f, 0.f, 0.f, 0.f};
        cur = nxt; cB = nB; cA = nA; ++ui;
        if constexpr (GATHER) { const u32x4 _t = *(const LAS u32x4*)vnslot; vc[0][0] = _t.x; vc[0][1] = _t.y; vc[1][0] = _t.z; vc[1][1] = _t.w; }
        if (wr == 1) PG8_BAR;
    }
    PG8_WAIT_V(0);
    PG8_BAR;
#undef PG8_SA
#undef PG8_SB
#undef PG8_STAGE
#undef PG8_STAGEA
#undef PG8_LDA
#undef PG8_LDB
#undef PG8_MMA
#undef PG8_WAIT_V
#undef PG8_WAIT_L
#undef PG8_BAR
#undef PG8_SCHED
}

struct DenseOrder {
    int nM, nN, nwg, G, c, K; const char* Bt;
    __device__ void init(int Mrows, int N, int K_, const void* Bt_, int G_, int c_) { nM = Mrows / BM; nN = N / BM; nwg = nM * nN; G = G_; c = c_; K = K_; Bt = (const char*)Bt_; }
    __device__ __forceinline__ bool next(int i, Unit& u) const {
        const long L = (long)i * G + c; if (L >= nwg) return false;
        int wgid = (int)L; { const int q = nwg / 8, r = nwg % 8, xcd = wgid % 8, off = wgid / 8; wgid = (xcd < r ? xcd * (q + 1) : r * (q + 1) + (xcd - r) * q) + off; }
        const int nig = 8 * nN, gid = wgid / nig, fm = gid * 8, gsz = (nM - fm) < 8 ? (nM - fm) : 8;
        u.pm = fm + ((wgid % nig) % gsz); u.pn = (wgid % nig) / gsz; u.B = Bt + (size_t)u.pn * BM * K * 2; u.e = 0; u.cnt = 0; u.off = 0; return true;
    }
    static constexpr bool GATHER = false;
    __device__ __forceinline__ size_t aoff(const Unit& u) const { return (size_t)u.pm * BM * K * 2; }
    __device__ __forceinline__ void avoff(const Unit&, const int (&)[2], const int (&)[2], unsigned (&)[2][2], int) const {}
};
template <int NCOL, bool TOKROWS> struct ExpertOrder {
    static constexpr bool GATHER = true;
    __device__ __forceinline__ size_t aoff(const Unit&) const { return 0; }
    const LAS unsigned* tab; int per, c, K; const char* W; size_t wstride; const int* slot_ent; const float* slot_w;
    int xbase, xend, xstride, xlb;
    __device__ void init(const LAS unsigned* tab_, int K_, const void* W_, size_t wstride_, const int* slot_ent_, const float* slot_w_, int G, int c_) {
        tab = tab_; K = K_; W = (const char*)W_; wstride = wstride_; slot_ent = slot_ent_; slot_w = slot_w_; c = c_;
        const int U = (int)tab[T_TILE + NE] * NCOL; per = (U + G - 1) / G;
        if (G % 8 == 0) { const int x = c_ % 8; const int q = U / 8, r = U % 8; xbase = x * q + (x < r ? x : r); xend = xbase + q + (x < r ? 1 : 0); xstride = G / 8; xlb = c_ / 8; }
        else { xbase = 0; xend = U; xstride = G; xlb = c_; }
    }
    __device__ __forceinline__ bool next(int i, Unit& u) const {
        const int L = xbase + i * xstride + xlb;
        if (L >= xend) return false;
        const int tile = L / NCOL; u.pn = L % NCOL;
        int lo = 0, hi = NE - 1;
        while (lo < hi) { const int mid = (lo + hi + 1) >> 1; if ((int)tab[T_TILE + mid] <= tile) lo = mid; else hi = mid - 1; }
        u.e = lo; u.pm = tile - (int)tab[T_TILE + lo]; u.cnt = (int)tab[T_CNT + lo]; u.off = (int)tab[T_OFF + lo];
        u.B = W + (size_t)lo * wstride + (size_t)u.pn * BM * K * 2; return true;
    }
    __device__ __forceinline__ void rowtab(const Unit& u, LAS unsigned* t, int tid) const {
        if (tid < BM) { int r = u.pm * BM + tid; if (r >= u.cnt) r = u.cnt - 1; t[tid] = (unsigned)slot_ent[u.off + r]; t[BM + tid] = __float_as_uint(slot_w[u.off + r]); }
    }
    __device__ __forceinline__ void avoff(const Unit& u, const int (&)[2], const int (&)[2], unsigned (&v)[2][2], int tidq) const {
        int R[2], C[2]; asm volatile("" : "+v"(tidq));
#pragma unroll
        for (int i = 0; i < 2; ++i) stage_rc(tidq * 16 + i * 8192, R[i], C[i]);
#pragma unroll
        for (int h = 0; h < 2; ++h)
#pragma unroll
            for (int i = 0; i < 2; ++i) {
                int r = u.pm * BM + h * HALF + R[i]; if (r >= u.cnt) r = u.cnt - 1;
                const int slot = u.off + r;
                const int row = TOKROWS ? (slot_ent[slot] >> 3) : slot;
                v[h][i] = (unsigned)(row * K + C[i]) * 2u;
            }
    }
};

struct EpiInProj {
    static constexpr bool PERM = true; bf16_t* O;
    __device__ __forceinline__ void operator()(const f32x4 (&acc)[2][2][4][2], const Unit& u, int wr, int wc, int fr, int fq, const LAS unsigned* rt) const {
        const float sc = (u.pn < 2) ? 0.125f : ((u.pn == 8 || u.pn == 9) ? 0.08838834764831845f : 1.f);
        const int row0 = u.pm * BM + wr * 64 + fr, col0 = u.pn * BM + wc * 32 + 8 * fq;
#pragma unroll
        for (int ai = 0; ai < 2; ++ai)
#pragma unroll
            for (int m = 0; m < 4; ++m) { bf16_t* rowp = O + (size_t)(row0 + ai * HALF + m * 16) * DIN + col0;
#pragma unroll
                for (int bj = 0; bj < 2; ++bj) { const f32x4 v0 = acc[ai][bj][m][0] * sc, v1 = acc[ai][bj][m][1] * sc;
                    u32x4 w; w.x = cvt_pk_bf16(v0[0], v0[1]); w.y = cvt_pk_bf16(v0[2], v0[3]); w.z = cvt_pk_bf16(v1[0], v1[1]); w.w = cvt_pk_bf16(v1[2], v1[3]);
                    *(u32x4*)(rowp + bj * HALF) = w; } }
    }
};
struct EpiOutProj {
    static constexpr bool PERM = false; const float* x; const float* mod; float* out;
    __device__ __forceinline__ void operator()(const f32x4 (&acc)[2][2][4][2], const Unit& u, int wr, int wc, int fr, int fq, const LAS unsigned* rt) const {
        const int b = (u.pm * BM) >> 11; const int col0 = u.pn * BM + wc * 32 + 4 * fq;
#pragma unroll
        for (int bj = 0; bj < 2; ++bj)
#pragma unroll
            for (int n = 0; n < 2; ++n) { const int col = col0 + bj * HALF + n * 16; const f32x4 g = *(const f32x4*)(mod + b * 6144 + MOD_GATE_A + col);
#pragma unroll
                for (int ai = 0; ai < 2; ++ai)
#pragma unroll
                    for (int m = 0; m < 4; ++m) { const size_t o = (size_t)(u.pm * BM + ai * HALF + wr * 64 + m * 16 + fr) * D + col;
                        const f32x4 xv = *(const f32x4*)(x + o); *(f32x4*)(out + o) = xv * ALPHA + g * acc[ai][bj][m][n]; } }
    }
};
struct EpiRouter {
    static constexpr bool PERM = false; float* out;
    __device__ __forceinline__ void operator()(const f32x4 (&acc)[2][2][4][2], const Unit& u, int wr, int wc, int fr, int fq, const LAS unsigned* rt) const {
        const int col0 = wc * 32 + 4 * fq;
#pragma unroll
        for (int ai = 0; ai < 2; ++ai)
#pragma unroll
            for (int m = 0; m < 4; ++m) { float* rowp = out + (size_t)(u.pm * BM + ai * HALF + wr * 64 + m * 16 + fr) * NE + col0;
#pragma unroll
                for (int bj = 0; bj < 2; ++bj)
#pragma unroll
                    for (int n = 0; n < 2; ++n) *(f32x4*)(rowp + bj * HALF + n * 16) = acc[ai][bj][m][n]; }
    }
};
template <bool EXPERT> struct EpiGU {
    static constexpr bool PERM = true; bf16_t* O; const float* slot_w;
    __device__ __forceinline__ void operator()(const f32x4 (&acc)[2][2][4][2], const Unit& u, int wr, int wc, int fr, int fq, const LAS unsigned* rt) const {
        const int h0 = u.pn * HALF + wc * 32 + 8 * fq;
#pragma unroll
        for (int ai = 0; ai < 2; ++ai)
#pragma unroll
            for (int m = 0; m < 4; ++m) {
                const int rtw = u.pm * BM + ai * HALF + wr * 64 + m * 16 + fr;
                float w = 1.f; size_t orow = (size_t)rtw;
                if (EXPERT) { if (rtw >= u.cnt) continue; w = __uint_as_float(rt[BM + ai * HALF + wr * 64 + m * 16 + fr]); orow = (size_t)(u.off + rtw); }
                const f32x4 g0 = acc[ai][0][m][0], g1 = acc[ai][0][m][1], u0 = acc[ai][1][m][0], u1 = acc[ai][1][m][1];
                u32x4 o;
                o.x = cvt_pk_bf16(w * silu_f(g0[0]) * u0[0], w * silu_f(g0[1]) * u0[1]); o.y = cvt_pk_bf16(w * silu_f(g0[2]) * u0[2], w * silu_f(g0[3]) * u0[3]);
                o.z = cvt_pk_bf16(w * silu_f(g1[0]) * u1[0], w * silu_f(g1[1]) * u1[1]); o.w = cvt_pk_bf16(w * silu_f(g1[2]) * u1[2], w * silu_f(g1[3]) * u1[3]);
                *(u32x4*)(O + orow * DE + h0) = o;
            }
    }
};
struct EpiSharedDown {
    static constexpr bool PERM = true; unsigned char* ysh;
    __device__ __forceinline__ void operator()(const f32x4 (&acc)[2][2][4][2], const Unit& u, int wr, int wc, int fr, int fq, const LAS unsigned* rt) const {
        const int col0 = u.pn * BM + wc * 32 + 8 * fq;
#pragma unroll
        for (int ai = 0; ai < 2; ++ai)
#pragma unroll
            for (int m = 0; m < 4; ++m) {
                unsigned char* rowp = ysh + (size_t)(u.pm * BM + ai * HALF + wr * 64 + m * 16 + fr) * D + col0;
#pragma unroll
                for (int bj = 0; bj < 2; ++bj) { const f32x4 v0 = acc[ai][bj][m][0] * YSCALE, v1 = acc[ai][bj][m][1] * YSCALE;
                    int w0 = __builtin_amdgcn_cvt_pk_fp8_f32(clamp8(v0[0]), clamp8(v0[1]), 0, false); w0 = __builtin_amdgcn_cvt_pk_fp8_f32(clamp8(v0[2]), clamp8(v0[3]), w0, true);
                    int w1 = __builtin_amdgcn_cvt_pk_fp8_f32(clamp8(v1[0]), clamp8(v1[1]), 0, false); w1 = __builtin_amdgcn_cvt_pk_fp8_f32(clamp8(v1[2]), clamp8(v1[3]), w1, true);
                    u32x2 o; o.x = (unsigned)w0; o.y = (unsigned)w1; *(u32x2*)(rowp + bj * HALF) = o; }
            }
    }
};
struct EpiExpDown {
    static constexpr bool PERM = true; unsigned char* ybuf; const int* slot_ent;
    __device__ __forceinline__ void operator()(const f32x4 (&acc)[2][2][4][2], const Unit& u, int wr, int wc, int fr, int fq, const LAS unsigned* rt) const {
        const int col0 = u.pn * BM + wc * 32 + 8 * fq;
#pragma unroll
        for (int ai = 0; ai < 2; ++ai)
#pragma unroll
            for (int m = 0; m < 4; ++m) {
                const int rtw = u.pm * BM + ai * HALF + wr * 64 + m * 16 + fr; if (rtw >= u.cnt) continue;
                unsigned char* rowp = ybuf + (size_t)rt[ai * HALF + wr * 64 + m * 16 + fr] * D + col0;
#pragma unroll
                for (int bj = 0; bj < 2; ++bj) { const f32x4 v0 = acc[ai][bj][m][0] * YSCALE, v1 = acc[ai][bj][m][1] * YSCALE;
                    int w0 = __builtin_amdgcn_cvt_pk_fp8_f32(clamp8(v0[0]), clamp8(v0[1]), 0, false); w0 = __builtin_amdgcn_cvt_pk_fp8_f32(clamp8(v0[2]), clamp8(v0[3]), w0, true);
                    int w1 = __builtin_amdgcn_cvt_pk_fp8_f32(clamp8(v1[0]), clamp8(v1[1]), 0, false); w1 = __builtin_amdgcn_cvt_pk_fp8_f32(clamp8(v1[2]), clamp8(v1[3]), w1, true);
                    u32x2 o; o.x = (unsigned)w0; o.y = (unsigned)w1; *(u32x2*)(rowp + bj * HALF) = o; }
            }
    }
};
}

struct Ctx {
    const float *x, *c, *w_ada, *b_ada, *w_in, *w_out, *na_rpb, *ret_ld, *ret_gn, *ln1_g, *ln1_b, *ln2_g, *ln2_b, *w_router, *rbias, *w_gate, *w_up, *w_down, *ws_gate, *ws_up, *ws_down;
    float* out; unsigned char* ws;
};
constexpr int NW = 8;

__device__ __forceinline__ void transpose_item(const float* W, int K, int N, bf16_t* WT, int G, int which, LAS float* scr, int item, int lane) {
    const int nblk = N / 32, kb = item / nblk, nb = item % nblk, k0 = 64 * kb, n0 = 32 * nb;
    float v[32];
#pragma unroll
    for (int i = 0; i < 32; ++i) { const int kk = 2 * i + (lane >> 5); v[i] = __builtin_nontemporal_load(W + (size_t)(k0 + kk) * N + n0 + (lane & 31)); }
#pragma unroll
    for (int i = 0; i < 32; ++i) { const int kk = 2 * i + (lane >> 5); scr[kk * 33 + (lane & 31)] = v[i]; }
    LDS_WAIT(); asm volatile("" ::: "memory");
    const int c = lane & 7;
#pragma unroll
    for (int j = 0; j < 4; ++j) { const int n = (lane >> 3) + 8 * j; const LAS float* s = scr + (8 * c) * 33 + n;
        u32x4 o; o.x = pk2(s[0 * 33], s[1 * 33]); o.y = pk2(s[2 * 33], s[3 * 33]); o.z = pk2(s[4 * 33], s[5 * 33]); o.w = pk2(s[6 * 33], s[7 * 33]);
        const int ng = n0 + n; const int drow = (G == 0) ? ng : ((ng / G) * 2 * G + which * G + (ng % G));
        *(u32x4*)(WT + (size_t)drow * K + k0 + 8 * c) = o; }
    LDS_WAIT(); asm volatile("" ::: "memory");
}
__device__ __forceinline__ void rope_entry(float* tab, int idx) {
    const int t = idx >> 6, i = idx & 63;
    const float inv_freq = powf(10000.f, -(float)(2 * i) / 128.f);
    const float ang = (float)t * inv_freq;
    const double a = (double)ang; const double two_pi = 6.283185307179586476925286766559;
    const double kf = rint(a / two_pi); double r = a - kf * two_pi;
    double sgn = 1.0; if (r > 1.5707963267948966) { r = 3.141592653589793 - r; sgn = -1.0; } else if (r < -1.5707963267948966) { r = -3.141592653589793 - r; sgn = -1.0; }
    const double r2 = r * r;
    const double s = r * (1.0 + r2 * (-1.0 / 6 + r2 * (1.0 / 120 + r2 * (-1.0 / 5040 + r2 * (1.0 / 362880 + r2 * (-1.0 / 39916800 + r2 * (1.0 / 6227020800.0 + r2 * (-1.0 / 1307674368000.0))))))));
    const double c = 1.0 + r2 * (-0.5 + r2 * (1.0 / 24 + r2 * (-1.0 / 720 + r2 * (1.0 / 40320 + r2 * (-1.0 / 3628800 + r2 * (1.0 / 479001600.0 + r2 * (-1.0 / 87178291200.0 + r2 * (1.0 / 20922789888000.0))))))));
    tab[idx] = (float)(sgn * c); tab[SEQ * 64 + idx] = (float)s;
}
__device__ __forceinline__ void mod_task(const float* __restrict__ cin, const float* __restrict__ w_ada, float* __restrict__ modp, int task, int lane) {
    const int cbk = task % 96, kc = task / 96, j = cbk * 64 + lane, k0 = kc * 64;
    float acc[32], cv[32];
#pragma unroll
    for (int b = 0; b < 32; ++b) { acc[b] = 0.f; cv[b] = silu_f(cin[b * D + k0 + lane]); }
#pragma unroll
    for (int kb = 0; kb < 4; ++kb) {
        float w[16];
#pragma unroll
        for (int i = 0; i < 16; ++i) w[i] = w_ada[(size_t)(k0 + kb * 16 + i) * 6144 + j];
#pragma unroll
        for (int i = 0; i < 16; ++i)
#pragma unroll
            for (int b = 0; b < 32; ++b) acc[b] += __builtin_bit_cast(float, __builtin_amdgcn_readlane(__builtin_bit_cast(int, cv[b]), kb * 16 + i)) * w[i];
    }
#pragma unroll
    for (int b = 0; b < 32; ++b) modp[((size_t)kc * 32 + b) * 6144 + j] = acc[b];
}
__device__ __forceinline__ float mod_sum(const float* __restrict__ modp, const float* __restrict__ b_ada, int b, int j) {
    float s = 0.f;
#pragma unroll
    for (int kc = 0; kc < 16; ++kc) s += modp[((size_t)kc * 32 + b) * 6144 + j];
    return s + b_ada[j];
}

namespace ret {
typedef short s16x4 __attribute__((ext_vector_type(4)));
typedef __bf16 bfx2 __attribute__((ext_vector_type(2)));
constexpr unsigned RS = 288, TILE = 128 * RS, LK = 0, LV = TILE, LRF = 2 * TILE, LRB = 3 * TILE;
constexpr float LOG2E = 1.4426950408889634f;
__device__ __forceinline__ unsigned offb(unsigned row, unsigned ch) { return RS * row + 16u * ch; }
__device__ __forceinline__ unsigned cvtpk(float lo, float hi) { const f32x2 v = {lo, hi}; return __builtin_bit_cast(unsigned, __builtin_convertvector(v, bfx2)); }
__device__ __forceinline__ bf16x8 pack8(const float (&f)[8]) { u32x4 u; u.x = cvtpk(f[0], f[1]); u.y = cvtpk(f[2], f[3]); u.z = cvtpk(f[4], f[5]); u.w = cvtpk(f[6], f[7]); return __builtin_bit_cast(bf16x8, u); }
__device__ __forceinline__ void unpack8(const bf16x8 v, float (&f)[8]) { const u32x4 u = __builtin_bit_cast(u32x4, v);
    f[0] = __uint_as_float(u.x << 16); f[1] = __uint_as_float(u.x & 0xffff0000u); f[2] = __uint_as_float(u.y << 16); f[3] = __uint_as_float(u.y & 0xffff0000u);
    f[4] = __uint_as_float(u.z << 16); f[5] = __uint_as_float(u.z & 0xffff0000u); f[6] = __uint_as_float(u.w << 16); f[7] = __uint_as_float(u.w & 0xffff0000u); }
__device__ __forceinline__ bf16x8 trfrag(LAS unsigned char* base, unsigned row0, unsigned row1, unsigned cblk, unsigned qp, unsigned p) {
    const unsigned ch = 2u * cblk + (p >> 1), bo = 8u * (p & 1u);
    const s16x4 lo = __builtin_amdgcn_ds_read_tr16_b64_v4i16((LAS s16x4*)(base + offb(row0 + qp, ch) + bo));
    const s16x4 hi = __builtin_amdgcn_ds_read_tr16_b64_v4i16((LAS s16x4*)(base + offb(row1 + qp, ch) + bo));
    return __builtin_shufflevector(lo, hi, 0, 1, 2, 3, 4, 5, 6, 7);
}
struct KVRaw { bf16x8 ka[2], kb[2], v[4]; f32x4 c0[2], c1[2], s0[2], s1[2]; };
__device__ __forceinline__ void kv_load(KVRaw& R, const bf16_t* __restrict__ proj, const float* __restrict__ rope, int b, int h, int n, int tid) {
#pragma unroll
    for (int i = 0; i < 2; ++i) {
        const int q2 = tid + 512 * i, row = q2 >> 3, pc = q2 & 7, t = n * 128 + row;
        const bf16_t* rp = proj + (size_t)(b * SEQ + t) * DIN + OFF_KR + h * 128;
        R.ka[i] = *(const bf16x8*)(rp + pc * 8); R.kb[i] = *(const bf16x8*)(rp + 64 + pc * 8);
        R.c0[i] = *(const f32x4*)(rope + t * 64 + pc * 8); R.c1[i] = *(const f32x4*)(rope + t * 64 + pc * 8 + 4);
        R.s0[i] = *(const f32x4*)(rope + SEQ * 64 + t * 64 + pc * 8); R.s1[i] = *(const f32x4*)(rope + SEQ * 64 + t * 64 + pc * 8 + 4);
    }
#pragma unroll
    for (int i = 0; i < 4; ++i) { const int q4 = tid + 512 * i, row = q4 >> 4, ch = q4 & 15, t = n * 128 + row;
        R.v[i] = *(const bf16x8*)(proj + (size_t)(b * SEQ + t) * DIN + OFF_VR + h * 128 + ch * 8); }
}
__device__ __forceinline__ void kv_store(LAS unsigned char* lds, const KVRaw& R, int tid) {
#pragma unroll
    for (int i = 0; i < 2; ++i) {
        const int q2 = tid + 512 * i, row = q2 >> 3, pc = q2 & 7;
        float fa[8], fb[8], o1[8], o2[8];
        unpack8(R.ka[i], fa); unpack8(R.kb[i], fb);
        const float cs[8] = {R.c0[i].x, R.c0[i].y, R.c0[i].z, R.c0[i].w, R.c1[i].x, R.c1[i].y, R.c1[i].z, R.c1[i].w}, sn[8] = {R.s0[i].x, R.s0[i].y, R.s0[i].z, R.s0[i].w, R.s1[i].x, R.s1[i].y, R.s1[i].z, R.s1[i].w};
#pragma unroll
        for (int e = 0; e < 8; ++e) { o1[e] = fa[e] * cs[e] - fb[e] * sn[e]; o2[e] = fb[e] * cs[e] + fa[e] * sn[e]; }
        *(LAS bf16x8*)(lds + LK + offb(row, pc)) = pack8(o1); *(LAS bf16x8*)(lds + LK + offb(row, pc + 8)) = pack8(o2);
    }
#pragma unroll
    for (int i = 0; i < 4; ++i) { const int q4 = tid + 512 * i, row = q4 >> 4, ch = q4 & 15; *(LAS bf16x8*)(lds + LV + offb(row, ch)) = R.v[i]; }
}
__device__ __forceinline__ void rb_dma(LAS unsigned char* lds, const unsigned char* img, int w, int lane) {
#pragma unroll
    for (int i = 0; i < 5; ++i) { const int o = w + 8 * i; if (o < (int)TILE / 1024)
        __builtin_amdgcn_global_load_lds((const unsigned*)(img + o * 1024 + lane * 16), (LAS unsigned*)(lds + LRB + o * 1024), 16, 0, 0); }
}
template <bool FWD> __device__ __forceinline__ void state_update(LAS unsigned char* lds, f32x4 (&racc)[8], float l2, int w, int g, unsigned qp, unsigned p) {
    const float dec = __builtin_amdgcn_exp2f(128.f * l2);
    bf16x8 vs[4];
#pragma unroll
    for (int ks = 0; ks < 4; ++ks) {
        float f[8]; unpack8(trfrag(lds + LV, 32 * ks + 4 * g, 32 * ks + 16 + 4 * g, w, qp, p), f);
#pragma unroll
        for (int e = 0; e < 8; ++e) { const int key = 32 * ks + 16 * (e >> 2) + 4 * g + (e & 3); f[e] *= __builtin_amdgcn_exp2f((FWD ? (float)(127 - key) : (float)key) * l2); }
        vs[ks] = pack8(f);
    }
#pragma unroll
    for (int nb = 0; nb < 8; ++nb) {
        racc[nb] = racc[nb] * dec;
#pragma unroll
        for (int ks = 0; ks < 4; ++ks) racc[nb] = __builtin_amdgcn_mfma_f32_16x16x32_bf16(vs[ks], trfrag(lds + LK, 32 * ks + 4 * g, 32 * ks + 16 + 4 * g, nb, qp, p), racc[nb], 0, 0, 0);
    }
}
__device__ __forceinline__ void unit(const bf16_t* __restrict__ proj, const float* __restrict__ rope, const float* __restrict__ log_decay, const float* __restrict__ gn_g, bf16_t* __restrict__ ymix,
                                     unsigned char* __restrict__ scratch  , LAS unsigned char* lds, int hu, const int tid_in) {
    const int u = hu >> 1, n0 = (hu & 1) * 8, n1 = n0 + 8;
    const int b = u >> 2, h = u & 3;
    int tid_ = tid_in; asm volatile("" : "+v"(tid_));
    const int tid0 = tid_, w = __builtin_amdgcn_readfirstlane(tid0 >> 6);
#define RET_LANE int tid = tid0; asm volatile("" : "+v"(tid)); const int lane = tid & 63, r = lane & 15, g = lane >> 4; const unsigned qp = (unsigned)r >> 2, p = (unsigned)lane & 3u;
    const float lf2_ = log_decay[h] * LOG2E, lb2_ = log_decay[4 + h] * LOG2E;
    f32x4 racc[8];
#pragma unroll
    for (int nb = 0; nb < 8; ++nb) racc[nb] = (f32x4){0.f, 0.f, 0.f, 0.f};
    KVRaw raw;
    kv_load(raw, proj, rope, b, h, 15, tid0);
    for (int n = 15; n >= n0; --n) {
        RET_LANE
        if (n < n1) {
            unsigned char* img = scratch + (size_t)(n - n0) * TILE;
#pragma unroll
            for (int nb = 0; nb < 8; ++nb) { u32x2 o; o.x = cvtpk(racc[nb][0], racc[nb][1]); o.y = cvtpk(racc[nb][2], racc[nb][3]);
                *(u32x2*)(img + offb(16 * nb + r, 2 * w + (g >> 1)) + 8 * (g & 1)) = o; }
        }
        if (n == n0) break;
        float lb2 = lb2_; asm volatile("" : "+v"(lb2));
        __syncthreads();
        kv_store(lds, raw, tid);
        __syncthreads();
        kv_load(raw, proj, rope, b, h, n - 1 > n0 ? n - 1 : 0, tid);
        state_update<false>(lds, racc, lb2, w, g, qp, p);
    }
    asm volatile("s_waitcnt vmcnt(0)" ::: "memory");
    __syncthreads();
    __builtin_amdgcn_fence(__ATOMIC_ACQUIRE, "agent");
    asm volatile("s_waitcnt vmcnt(0)" ::: "memory");
#pragma unroll
    for (int nb = 0; nb < 8; ++nb) racc[nb] = (f32x4){0.f, 0.f, 0.f, 0.f};
    for (int n = 0; n < n0; ++n) {
        RET_LANE
        float lf2 = lf2_; asm volatile("" : "+v"(lf2));
        __syncthreads();
        kv_store(lds, raw, tid);
        __syncthreads();
        kv_load(raw, proj, rope, b, h, n + 1, tid);
        state_update<true>(lds, racc, lf2, w, g, qp, p);
    }
    rb_dma(lds, scratch, w, tid0 & 63);
    for (int n = n0; n < n1; ++n) {
        RET_LANE
        float lf2 = lf2_, lb2 = lb2_; asm volatile("" : "+v"(lf2), "+v"(lb2));
        const float* gnp = gn_g; asm volatile("" : "+s"(gnp));
        __syncthreads();
        kv_store(lds, raw, tid);
#pragma unroll
        for (int nb = 0; nb < 8; ++nb) { u32x2 o; o.x = cvtpk(racc[nb][0], racc[nb][1]); o.y = cvtpk(racc[nb][2], racc[nb][3]);
            *(LAS u32x2*)(lds + LRF + offb(16 * nb + r, 2 * w + (g >> 1)) + 8 * (g & 1)) = o; }
        const int cq = 16 * w + r, tq = n * 128 + cq;
        bf16x8 qn[4], qf[4], qb[4];
        { const bf16_t* rp = proj + (size_t)(b * SEQ + tq) * DIN + OFF_QR + h * 128 + 4 * g;
          const float sf = __builtin_amdgcn_exp2f((float)(cq + 1) * lf2), sb = __builtin_amdgcn_exp2f((float)(128 - cq) * lb2);
#pragma unroll
          for (int ks = 0; ks < 2; ++ks) {
              float fa[8], fb[8], o1[8], o2[8], t1[8], t2[8];
              { const u32x2 a0 = *(const u32x2*)(rp + 32 * ks), a1 = *(const u32x2*)(rp + 32 * ks + 16), b0 = *(const u32x2*)(rp + 32 * ks + 64), b1 = *(const u32x2*)(rp + 32 * ks + 80);
                unpack8(__builtin_bit_cast(bf16x8, (u32x4){a0.x, a0.y, a1.x, a1.y}), fa); unpack8(__builtin_bit_cast(bf16x8, (u32x4){b0.x, b0.y, b1.x, b1.y}), fb); }
              const float* cp = rope + tq * 64 + 32 * ks + 4 * g; const float* sp = cp + SEQ * 64;
              const f32x4 c0 = *(const f32x4*)cp, c1 = *(const f32x4*)(cp + 16), s0 = *(const f32x4*)sp, s1 = *(const f32x4*)(sp + 16);
              const float cs[8] = {c0.x, c0.y, c0.z, c0.w, c1.x, c1.y, c1.z, c1.w}, sn[8] = {s0.x, s0.y, s0.z, s0.w, s1.x, s1.y, s1.z, s1.w};
#pragma unroll
              for (int e = 0; e < 8; ++e) { o1[e] = fa[e] * cs[e] - fb[e] * sn[e]; o2[e] = fb[e] * cs[e] + fa[e] * sn[e]; }
              qn[ks] = pack8(o1); qn[ks + 2] = pack8(o2);
#pragma unroll
              for (int e = 0; e < 8; ++e) { t1[e] = o1[e] * sf; t2[e] = o2[e] * sf; }
              qf[ks] = pack8(t1); qf[ks + 2] = pack8(t2);
#pragma unroll
              for (int e = 0; e < 8; ++e) { t1[e] = o1[e] * sb; t2[e] = o2[e] * sb; }
              qb[ks] = pack8(t1); qb[ks + 2] = pack8(t2);
          } }
        asm volatile("s_waitcnt vmcnt(0)" ::: "memory");
        __syncthreads();
        kv_load(raw, proj, rope, b, h, n + 1 < n1 ? n + 1 : n, tid);
        u32x2 gv[8];
        { const bf16_t* gp = proj + (size_t)(b * SEQ + tq) * DIN + OFF_GR + h * 128 + 4 * g;
#pragma unroll
          for (int mbv = 0; mbv < 8; ++mbv) gv[mbv] = *(const u32x2*)(gp + 16 * mbv); }
        bf16x8 pt[4];
#pragma unroll
        for (int ks2 = 0; ks2 < 4; ++ks2) {
            float pv[8];
#pragma unroll
            for (int hb = 0; hb < 2; ++hb) {
                const int mb = 2 * ks2 + hb;
                f32x4 st = (f32x4){0.f, 0.f, 0.f, 0.f};
#pragma unroll
                for (int ks = 0; ks < 4; ++ks) { const LAS unsigned char* kp = lds + LK + RS * (16 * mb + r) + 64 * ks + 8 * g; const u32x2 k0 = *(const LAS u32x2*)kp, k1 = *(const LAS u32x2*)(kp + 32);
                    st = __builtin_amdgcn_mfma_f32_16x16x32_bf16(__builtin_bit_cast(bf16x8, (u32x4){k0.x, k0.y, k1.x, k1.y}), qn[ks], st, 0, 0, 0); }
#pragma unroll
                for (int j = 0; j < 4; ++j) { const int diff = cq - (16 * mb + 4 * g + j); pv[4 * hb + j] = st[j] * __builtin_amdgcn_exp2f(diff >= 0 ? (float)diff * lf2 : (float)(-diff) * lb2); }
            }
            pt[ks2] = pack8(pv);
        }
        f32x4 yacc[8];
#pragma unroll
        for (int mbv = 0; mbv < 8; ++mbv) {
            f32x4 y = (f32x4){0.f, 0.f, 0.f, 0.f};
#pragma unroll
            for (int ks2 = 0; ks2 < 4; ++ks2) y = __builtin_amdgcn_mfma_f32_16x16x32_bf16(trfrag(lds + LV, 32 * ks2 + 4 * g, 32 * ks2 + 16 + 4 * g, mbv, qp, p), pt[ks2], y, 0, 0, 0);
#pragma unroll
            for (int ks = 0; ks < 4; ++ks) {
                y = __builtin_amdgcn_mfma_f32_16x16x32_bf16(trfrag(lds + LRF, 32 * ks + 4 * g, 32 * ks + 16 + 4 * g, mbv, qp, p), qf[ks], y, 0, 0, 0);
                y = __builtin_amdgcn_mfma_f32_16x16x32_bf16(trfrag(lds + LRB, 32 * ks + 4 * g, 32 * ks + 16 + 4 * g, mbv, qp, p), qb[ks], y, 0, 0, 0);
            }
            yacc[mbv] = y;
        }
        __syncthreads();
        if (n + 1 < n1) rb_dma(lds, scratch + (size_t)(n + 1 - n0) * TILE, w, lane);
        { float s = 0.f;
#pragma unroll
          for (int mbv = 0; mbv < 8; ++mbv) s += (yacc[mbv][0] + yacc[mbv][1]) + (yacc[mbv][2] + yacc[mbv][3]);
          s += __shfl_xor(s, 16); s += __shfl_xor(s, 32);
          const float mu = s * (1.f / 128.f); float s2 = 0.f;
#pragma unroll
          for (int mbv = 0; mbv < 8; ++mbv) { yacc[mbv] = yacc[mbv] - mu; s2 += (yacc[mbv][0] * yacc[mbv][0] + yacc[mbv][1] * yacc[mbv][1]) + (yacc[mbv][2] * yacc[mbv][2] + yacc[mbv][3] * yacc[mbv][3]); }
          s2 += __shfl_xor(s2, 16); s2 += __shfl_xor(s2, 32);
          const float rstd = 1.f / sqrtf(s2 * (1.f / 128.f) + GN_EPS);
          bf16_t* op = ymix + (size_t)(b * SEQ + tq) * D + 512 + h * 128 + 4 * g;
#pragma unroll
          for (int mbv = 0; mbv < 8; ++mbv) {
              const f32x4 gn = *(const f32x4*)(gnp + h * 128 + 16 * mbv + 4 * g);
              const float g0 = __uint_as_float(gv[mbv].x << 16), g1 = __uint_as_float(gv[mbv].x & 0xffff0000u), g2 = __uint_as_float(gv[mbv].y << 16), g3 = __uint_as_float(gv[mbv].y & 0xffff0000u);
              u32x2 o; o.x = cvtpk(silu_f(g0) * (yacc[mbv][0] * rstd * gn.x), silu_f(g1) * (yacc[mbv][1] * rstd * gn.y));
              o.y = cvtpk(silu_f(g2) * (yacc[mbv][2] * rstd * gn.z), silu_f(g3) * (yacc[mbv][3] * rstd * gn.w));
              *(u32x2*)(op + 16 * mbv) = o;
          } }
        state_update<true>(lds, racc, lf2, w, g, qp, p);
    }
    __syncthreads();
#undef RET_LANE
}
}


namespace na {
constexpr unsigned LKR = 0, LVR = 73728, LRPB = 147456;
__device__ __forceinline__ void load_row(LAS unsigned char* lds, const bf16_t* __restrict__ proj, int b, int head, int krow, int tid) {
    const int key = tid >> 3, ch = tid & 7, slot = krow % 9;
    const bf16_t* rp = proj + (size_t)(b * SEQ + krow * 64 + key) * DIN + head * 64 + ch * 8;
    const unsigned o = (unsigned)slot * 8192u + 128u * key + 16u * (ch ^ (key & 7));
    *(LAS u32x4*)(lds + LKR + o) = *(const u32x4*)(rp + OFF_KNA);
    *(LAS u32x4*)(lds + LVR + o) = *(const u32x4*)(rp + OFF_VNA);
}
__device__ __forceinline__ void unit(const bf16_t* __restrict__ proj, const float* __restrict__ rpb, bf16_t* __restrict__ ymix, LAS unsigned char* lds, int u, const int tid_in) {
    const int b = u >> 3, head = u & 7;
    int tid_ = tid_in; asm volatile("" : "+v"(tid_));
    const int tid0 = tid_, w = __builtin_amdgcn_readfirstlane(tid0 >> 6);
    __syncthreads();
    if (tid0 < 465) ((LAS float*)(lds + LRPB))[tid0] = rpb[head * 465 + tid0];
    const int ct = w & 3, cb = (ct == 0) ? 0 : (ct == 1 ? 8 : (ct == 2 ? 24 : 32));
    u32x4 pk[2], pv2[2]; int pre_lo = 0, pre_n = 0;
    for (int st = 0; st < 16; ++st) {
        int tid = tid0; asm volatile("" : "+v"(tid));
        const int lane = tid & 63, qi = lane & 15, g = lane >> 4; const unsigned qp = (unsigned)qi >> 2, p = (unsigned)lane & 3u;
        const int r = 2 * st + (w >> 2);
        const int rs = min(max(r - 4, 0), 24);
        const int need_hi = min(max(2 * st + 1 - 4, 0), 24) + 7;
        __syncthreads();
        if (st == 0) { for (int kr = 0; kr <= need_hi; ++kr) load_row(lds, proj, b, head, kr, tid); }
        else {
#pragma unroll
            for (int i = 0; i < 2; ++i) if (i < pre_n) { const int key = tid >> 3, ch = tid & 7; const unsigned o = (unsigned)((pre_lo + i) % 9) * 8192u + 128u * key + 16u * (ch ^ (key & 7));
                *(LAS u32x4*)(lds + LKR + o) = pk[i]; *(LAS u32x4*)(lds + LVR + o) = pv2[i]; }
        }
        const int cq = 16 * ct + qi, tq = b * SEQ + r * 64 + cq;
        bf16x8 qn[2];
        { const bf16_t* qptr = proj + (size_t)tq * DIN + OFF_QNA + head * 64 + 8 * g; qn[0] = *(const bf16x8*)qptr; qn[1] = *(const bf16x8*)(qptr + 32); }
        __syncthreads();
        { const int nh = (st < 15) ? min(max(2 * st + 3 - 4, 0), 24) + 7 : need_hi; pre_lo = need_hi + 1; pre_n = nh - need_hi;
#pragma unroll
          for (int i = 0; i < 2; ++i) if (i < pre_n) { const int key = tid >> 3, ch = tid & 7; const bf16_t* rp = proj + (size_t)(b * SEQ + (pre_lo + i) * 64 + key) * DIN + head * 64 + ch * 8;
              pk[i] = *(const u32x4*)(rp + OFF_KNA); pv2[i] = *(const u32x4*)(rp + OFF_VNA); } }
        const int cs = min(max(cq - 8, 0), 48);
        const unsigned kb0 = 128u * qi + 16u * ((unsigned)g ^ ((unsigned)qi & 7u)), kb1 = 128u * qi + 16u * ((4u + (unsigned)g) ^ ((unsigned)qi & 7u));
        const LAS float* bias = (const LAS float*)(lds + LRPB);
        f32x4 sc[16]; float mx = -3.0e38f;
#pragma unroll
        for (int kr = 0; kr < 8; ++kr) {
            const int krow = rs + kr; const unsigned so = (unsigned)(krow % 9) * 8192u + 128u * (unsigned)cb;
            const int dr = krow - r + 7;
#pragma unroll
            for (int h2 = 0; h2 < 2; ++h2) {
                f32x4 a = (f32x4){0.f, 0.f, 0.f, 0.f};
                a = __builtin_amdgcn_mfma_f32_16x16x32_bf16(*(const LAS bf16x8*)(lds + LKR + so + 2048u * h2 + kb0), qn[0], a, 0, 0, 0);
                a = __builtin_amdgcn_mfma_f32_16x16x32_bf16(*(const LAS bf16x8*)(lds + LKR + so + 2048u * h2 + kb1), qn[1], a, 0, 0, 0);
#pragma unroll
                for (int j = 0; j < 4; ++j) {
                    const int kcol = cb + 16 * h2 + 4 * g + j;
                    const int dc = min(max(kcol - cq + 15, 0), 30);
                    const float v = a[j] + bias[dr * 31 + dc];
                    const bool in = (kcol >= cs) && (kcol < cs + 16);
                    a[j] = in ? v : -3.0e38f; mx = fmaxf(mx, a[j]);
                }
                sc[2 * kr + h2] = a;
            }
        }
        mx = fmaxf(mx, __shfl_xor(mx, 16)); mx = fmaxf(mx, __shfl_xor(mx, 32));
        float sum = 0.f; bf16x8 pt[8];
#pragma unroll
        for (int kk = 0; kk < 8; ++kk) {
            float pv[8];
#pragma unroll
            for (int h2 = 0; h2 < 2; ++h2)
#pragma unroll
                for (int j = 0; j < 4; ++j) { const float e = __builtin_amdgcn_exp2f((sc[2 * kk + h2][j] - mx) * 1.4426950408889634f); pv[4 * h2 + j] = e; sum += e; }
            pt[kk] = ret::pack8(pv);
        }
        sum += __shfl_xor(sum, 16); sum += __shfl_xor(sum, 32);
        const float inv = 1.f / sum;
        const unsigned sl = (((unsigned)g & 1u) << 2) | qp;
        bf16_t* op = ymix + (size_t)tq * D + head * 64 + 4 * g;
#pragma unroll
        for (int db = 0; db < 4; ++db) {
            const unsigned vb = 128u * (4u * (unsigned)g + qp) + 16u * ((2u * db + (p >> 1)) ^ sl) + 8u * (p & 1u);
            f32x4 y = (f32x4){0.f, 0.f, 0.f, 0.f};
#pragma unroll
            for (int kk = 0; kk < 8; ++kk) {
                const unsigned so = (unsigned)((rs + kk) % 9) * 8192u + 128u * (unsigned)cb;
                const ret::s16x4 lo = __builtin_amdgcn_ds_read_tr16_b64_v4i16((LAS ret::s16x4*)(lds + LVR + so + vb));
                const ret::s16x4 hi = __builtin_amdgcn_ds_read_tr16_b64_v4i16((LAS ret::s16x4*)(lds + LVR + so + 2048u + vb));
                y = __builtin_amdgcn_mfma_f32_16x16x32_bf16(__builtin_shufflevector(lo, hi, 0, 1, 2, 3, 4, 5, 6, 7), pt[kk], y, 0, 0, 0);
            }
            u32x2 o; o.x = ret::cvtpk(y[0] * inv, y[1] * inv); o.y = ret::cvtpk(y[2] * inv, y[3] * inv);
            *(u32x2*)(op + 16 * db) = o;
        }
    }
    __syncthreads();
}
}

__device__ __forceinline__ void ln1_row(float* __restrict__ io, const float* __restrict__ g, const float* __restrict__ bb, const float* __restrict__ mod, bf16_t* __restrict__ hf, int row, int lane) {
    const int b = row >> 11;
    f32x4 v[4]; float s = 0.f;
#pragma unroll
    for (int j = 0; j < 4; ++j) { v[j] = *(const f32x4*)(io + (size_t)row * D + j * 256 + lane * 4); s += (v[j].x + v[j].y) + (v[j].z + v[j].w); }
    const float mean = wave_sum(s) * (1.f / D); float s2 = 0.f;
#pragma unroll
    for (int j = 0; j < 4; ++j) { v[j] = v[j] - mean; s2 += (v[j].x * v[j].x + v[j].y * v[j].y) + (v[j].z * v[j].z + v[j].w * v[j].w); }
    const float rstd = 1.f / sqrtf(wave_sum(s2) * (1.f / D) + LN_EPS);
#pragma unroll
    for (int j = 0; j < 4; ++j) { const int col = j * 256 + lane * 4;
        const f32x4 gg = *(const f32x4*)(g + col), bv = *(const f32x4*)(bb + col);
        const f32x4 x1 = v[j] * rstd * gg + bv;
        *(f32x4*)(io + (size_t)row * D + col) = x1;
        const f32x4 sc = *(const f32x4*)(mod + b * 6144 + MOD_SCALE_F + col), sh = *(const f32x4*)(mod + b * 6144 + MOD_SHIFT_F + col);
        u32x2 o; o.x = pk2(x1.x * (1.f + sc.x) + sh.x, x1.y * (1.f + sc.y) + sh.y); o.y = pk2(x1.z * (1.f + sc.z) + sh.z, x1.w * (1.f + sc.w) + sh.w);
        *(u32x2*)(hf + (size_t)row * D + col) = o; }
}
__device__ __forceinline__ void top2_merge(float& a1, float& a2, float b1, float b2) { const float n1 = fmaxf(a1, b1); const float n2 = fmaxf(fminf(a1, b1), fmaxf(a2, b2)); a1 = n1; a2 = n2; }
__device__ __forceinline__ void route_token(const float* __restrict__ logits, const f32x4 bias, int* __restrict__ topk_e, float* __restrict__ topk_w, LAS unsigned* hist, int tok, int lane) {
    const f32x4 lg = *(const f32x4*)(logits + (size_t)tok * NE + lane * 4);
    const float sc0 = 1.f / (1.f + __expf(-lg.x)), sc1 = 1.f / (1.f + __expf(-lg.y)), sc2 = 1.f / (1.f + __expf(-lg.z)), sc3 = 1.f / (1.f + __expf(-lg.w));
    float s0 = sc0 + bias.x, s1 = sc1 + bias.y, s2 = sc2 + bias.z, s3 = sc3 + bias.w;
    float m1 = fmaxf(s0, s1), m2 = fminf(s0, s1); top2_merge(m1, m2, fmaxf(s2, s3), fminf(s2, s3));
#pragma unroll
    for (int o = 1; o < 8; o <<= 1) { const float b1 = __shfl_xor(m1, o), b2 = __shfl_xor(m2, o); top2_merge(m1, m2, b1, b2); }
    const float gs = m1 + m2; const int grp = lane >> 3;
    int rank = 0;
#pragma unroll
    for (int gq = 0; gq < 8; ++gq) { const float og = __shfl(gs, gq * 8); rank += (og > gs || (og == gs && gq < grp)) ? 1 : 0; }
    const float NEG = -3.0e38f;
    if (rank >= 4) { s0 = NEG; s1 = NEG; s2 = NEG; s3 = NEG; }
    float wsum = 0.f; float myw = 0.f; int mye = 0;
#pragma unroll
    for (int k = 0; k < TOPK; ++k) {
        float bv = s0; int bi = 0;
        if (s1 > bv) { bv = s1; bi = 1; }
        if (s2 > bv) { bv = s2; bi = 2; }
        if (s3 > bv) { bv = s3; bi = 3; }
        int be = lane * 4 + bi;
#pragma unroll
        for (int o = 1; o < 64; o <<= 1) { const float ov = __shfl_xor(bv, o); const int oe = __shfl_xor(be, o); if (ov > bv || (ov == bv && oe < be)) { bv = ov; be = oe; } }
        const int ol = be >> 2, oj = be & 3;
        const float mysc = oj == 0 ? sc0 : (oj == 1 ? sc1 : (oj == 2 ? sc2 : sc3));
        const float wsel = __shfl(mysc, ol);
        if (lane == ol) { if (oj == 0) s0 = NEG; else if (oj == 1) s1 = NEG; else if (oj == 2) s2 = NEG; else s3 = NEG; }
        wsum += wsel;
        if (lane == k) { myw = wsel; mye = be; }
    }
    if (lane < TOPK) { topk_e[tok * TOPK + lane] = mye; topk_w[tok * TOPK + lane] = myw / wsum * 2.5f; __hip_atomic_fetch_add(&hist[mye], 1u, __ATOMIC_RELAXED, __HIP_MEMORY_SCOPE_WORKGROUP); }
}
__device__ __forceinline__ void build_tables(const unsigned* ctl, LAS unsigned* tab, const int tid) {
    if (tid < 64) {
        const int lane = tid;
        unsigned c[4], so = 0, st = 0;
#pragma unroll
        for (int j = 0; j < 4; ++j) { c[j] = __hip_atomic_load(ctl + CW_COUNT + lane * 4 + j, __ATOMIC_RELAXED, __HIP_MEMORY_SCOPE_AGENT); so += c[j]; st += (c[j] + 255u) >> 8; }
        unsigned io = so, it = st;
#pragma unroll
        for (int o = 1; o < 64; o <<= 1) { const unsigned a = __shfl_up(io, o), b = __shfl_up(it, o); if (lane >= o) { io += a; it += b; } }
        unsigned eo = io - so, et = it - st;
#pragma unroll
        for (int j = 0; j < 4; ++j) { tab[T_CNT + lane * 4 + j] = c[j]; tab[T_OFF + lane * 4 + j] = eo; tab[T_TILE + lane * 4 + j] = et; eo += c[j]; et += (c[j] + 255u) >> 8; }
        if (lane == 63) { tab[T_OFF + NE] = eo; tab[T_TILE + NE] = et; }
    }
    __syncthreads();
}
__device__ __forceinline__ void final_row(float* __restrict__ io, const unsigned char* __restrict__ ybuf, const unsigned char* __restrict__ ysh, const float* __restrict__ g, const float* __restrict__ bb, const float* __restrict__ mod, int row, int lane) {
    const int b = row >> 11;
    f32x4 v[4]; float s = 0.f;
#pragma unroll
    for (int j = 0; j < 4; ++j) {
        const int col = j * 256 + lane * 4;
        f32x4 a = (f32x4){0.f, 0.f, 0.f, 0.f};
#pragma unroll
        for (int k = 0; k < TOPK; ++k) {
            const unsigned pk = *(const unsigned*)(ybuf + ((size_t)row * TOPK + k) * D + col);
            const f32x2 lo = __builtin_amdgcn_cvt_pk_f32_fp8((int)pk, false), hi = __builtin_amdgcn_cvt_pk_f32_fp8((int)pk, true);
            a.x += lo.x; a.y += lo.y; a.z += hi.x; a.w += hi.y;
        }
        { const unsigned pk = *(const unsigned*)(ysh + (size_t)row * D + col);
          const f32x2 lo = __builtin_amdgcn_cvt_pk_f32_fp8((int)pk, false), hi = __builtin_amdgcn_cvt_pk_f32_fp8((int)pk, true);
          a.x += lo.x; a.y += lo.y; a.z += hi.x; a.w += hi.y; }
        const f32x4 gt = *(const f32x4*)(mod + b * 6144 + MOD_GATE_F + col);
        v[j] = *(const f32x4*)(io + (size_t)row * D + col) * ALPHA + gt * a * YINV;
        s += (v[j].x + v[j].y) + (v[j].z + v[j].w);
    }
    const float mean = wave_sum(s) * (1.f / D); float s2 = 0.f;
#pragma unroll
    for (int j = 0; j < 4; ++j) { v[j] = v[j] - mean; s2 += (v[j].x * v[j].x + v[j].y * v[j].y) + (v[j].z * v[j].z + v[j].w * v[j].w); }
    const float rstd = 1.f / sqrtf(wave_sum(s2) * (1.f / D) + LN_EPS);
#pragma unroll
    for (int j = 0; j < 4; ++j) { const int col = j * 256 + lane * 4; const f32x4 gg = *(const f32x4*)(g + col), bv = *(const f32x4*)(bb + col);
        *(f32x4*)(io + (size_t)row * D + col) = v[j] * rstd * gg + bv; }
}

#ifndef MK_PER_PHASE
#define MK_PER_PHASE 0
#endif
constexpr int N_PHASES = 13;
struct Args { Ctx X; int ph_lo, ph_hi; };
typedef __attribute__((address_space(4))) const Ctx* CtxCP;
__device__ __forceinline__ CtxCP ctx_ptr() { CtxCP p = (CtxCP)__builtin_amdgcn_kernarg_segment_ptr(); asm volatile("" : "+s"(p)); return p; }

__global__ void __launch_bounds__(NW * 64, 2) mk_fwd(Args args) {
    extern __shared__ __attribute__((aligned(16))) unsigned char lds_raw[];
    LAS unsigned char* lds = (LAS unsigned char*)lds_raw;
    LAS unsigned* tab = (LAS unsigned*)(lds + TAB_OFF);
    volatile LAS unsigned* MISC = (volatile LAS unsigned*)(lds + MISC_OFF);
#define PH_BEGIN \
    const __attribute__((address_space(4))) Ctx& X = *ctx_ptr(); unsigned char* ws = X.ws; (void)ws; \
    const int lane = lane_id(), wave = wave0, tid = wave0 * 64 + lane; (void)lane; (void)wave; (void)tid; \
    const int G = gridDim.x, bx = blockIdx.x; (void)G; (void)bx; \
    const int gw = bx * NW + wave, NGW = G * NW; (void)gw; (void)NGW; \
    const int gt = bx * (NW * 64) + tid, NGT = G * NW * 64; (void)gt; (void)NGT; \
    unsigned* ctl = (unsigned*)(ws + WS_CTL); float* mod = (float*)(ws + WS_MOD); float* rope = (float*)(ws + WS_ROPE); (void)ctl; (void)mod; (void)rope; \
    bf16_t* win_t = (bf16_t*)(ws + WS_WIN_T); bf16_t* wout_t = (bf16_t*)(ws + WS_WOUT_T); bf16_t* wr_t = (bf16_t*)(ws + WS_WR_T); (void)win_t; (void)wout_t; (void)wr_t; \
    bf16_t* wsgu_t = (bf16_t*)(ws + WS_WSGU_T); bf16_t* wsd_t = (bf16_t*)(ws + WS_WSD_T); bf16_t* wd_t = (bf16_t*)(ws + WS_WD_T); bf16_t* wgu_t = (bf16_t*)(ws + WS_WGU_T); (void)wsgu_t; (void)wsd_t; (void)wd_t; (void)wgu_t; \
    int* slot_ent = (int*)(ws + WS_SLOT_ENT); float* slot_w = (float*)(ws + WS_SLOT_W); int* topk_e = (int*)(ws + WS_TOPK_E); float* topk_w = (float*)(ws + WS_TOPK_W); (void)slot_ent; (void)slot_w; (void)topk_e; (void)topk_w; \
    bf16_t* ymix = (bf16_t*)(ws + WS_YMIX); bf16_t* proj = (bf16_t*)(ws + WS_PROJ); bf16_t* hbuf = (bf16_t*)(ws + WS_YMIX); (void)ymix; (void)proj; (void)hbuf; \
    float* logits = (float*)(ws + WS_LOGITS); bf16_t* shh = (bf16_t*)(ws + WS_SHH); bf16_t* hf = (bf16_t*)(ws + WS_HF); bf16_t* act = (bf16_t*)(ws + WS_ACT); (void)logits; (void)shh; (void)hf; (void)act; \
    unsigned char* ybuf = ws + WS_YBUF; float* out = X.out; (void)ybuf; (void)out;

    const int wave0 = __builtin_amdgcn_readfirstlane((int)threadIdx.x >> 6);
    for (int u = threadIdx.x; u < (LDS_BYTES - MISC_OFF) / 4; u += NW * 64) ((LAS unsigned*)(lds + MISC_OFF))[u] = 0u;
    __syncthreads();
    if (!MK_PER_PHASE) { unsigned* ctl0 = (unsigned*)(args.X.ws + WS_CTL); (void)xcd_barrier_post(ctl0 + CW_BAR, MISC + 8, wave0 == 0 && lane_id() == 0); }
    const int lo = args.ph_lo, hi = args.ph_hi;
#ifndef MK_DUP
#define MK_DUP -1
#endif
#define REPS(k) for (int _rep = 0; _rep < ((MK_DUP == (k)) ? 2 : 1); ++_rep)
#ifdef MK_ONLY
#define IN(k) ((k) == MK_ONLY)
#else
#define IN(k) (lo <= (k) && (k) < hi)
#endif
#define SEAM(k) SEAM2(k, (k) + 1)
#define SEAM2(k, k2) do { if (IN(k) && IN(k2)) { XcdBarrier _b; _b.bar = (unsigned*)(ctx_ptr()->ws + WS_CTL) + CW_BAR; _b.x = xb_xcc_id(); _b.st = (volatile LAS unsigned*)(lds + MISC_OFF) + 8; xcd_barrier(_b, wave0 == 0 && lane_id() == 0); } } while (0)

    REPS(0) if (IN(0)) { PH_BEGIN
        LAS float* scr = (LAS float*)(lds + wave * 16384);
        float* modp = (float*)(ws + WS_PROJ);
        for (int t = gw; t < 96 * 16; t += NGW) mod_task(X.c, X.w_ada, modp, t, lane);
        constexpr int I_IN = (D / 64) * (DIN / 32), I_OUT = (D / 64) * (D / 32), I_R = (D / 64) * (NE / 32), I_SG = (D / 64) * (DE / 32), I_SD = (DE / 64) * (D / 32);
        constexpr int I_EG = I_SG, I_ED = I_SD;
        constexpr int N_SMALL = I_IN + I_OUT + I_R + 2 * I_SG + I_SD;
        constexpr int N_ITEMS = N_SMALL + NE * (2 * I_EG + I_ED);
        for (int it = gw; it < N_ITEMS; it += NGW) {
            int r = it;
            if (r < I_IN) { transpose_item(X.w_in, D, DIN, win_t, 0, 0, scr, r, lane); continue; } r -= I_IN;
            if (r < I_OUT) { transpose_item(X.w_out, D, D, wout_t, 0, 0, scr, r, lane); continue; } r -= I_OUT;
            if (r < I_R) { transpose_item(X.w_router, D, NE, wr_t, 0, 0, scr, r, lane); continue; } r -= I_R;
            if (r < I_SG) { transpose_item(X.ws_gate, D, DE, wsgu_t, 128, 0, scr, r, lane); continue; } r -= I_SG;
            if (r < I_SG) { transpose_item(X.ws_up, D, DE, wsgu_t, 128, 1, scr, r, lane); continue; } r -= I_SG;
            if (r < I_SD) { transpose_item(X.ws_down, DE, D, wsd_t, 0, 0, scr, r, lane); continue; } r -= I_SD;
            const int e = r / (2 * I_EG + I_ED); r -= e * (2 * I_EG + I_ED);
            if (r < I_EG) { transpose_item(X.w_gate + (size_t)e * D * DE, D, DE, wgu_t + (size_t)e * 512 * D, 128, 0, scr, r, lane); continue; } r -= I_EG;
            if (r < I_EG) { transpose_item(X.w_up + (size_t)e * D * DE, D, DE, wgu_t + (size_t)e * 512 * D, 128, 1, scr, r, lane); continue; } r -= I_EG;
            transpose_item(X.w_down + (size_t)e * DE * D, DE, D, wd_t + (size_t)e * D * DE, 0, 0, scr, r, lane);
        }
        for (int i = gt; i < SEQ * 64; i += NGT) rope_entry(rope, i);
    }
    SEAM(0);
    REPS(1) if (IN(1)) { PH_BEGIN
        const float* modp = (const float*)(ws + WS_PROJ);
        for (int i = gt; i < 32 * 6144; i += NGT) mod[i] = mod_sum(modp, X.b_ada, i / 6144, i % 6144);
        LAS float* ssc = (LAS float*)lds; LAS float* ssh = ssc + 1024;
        int curb = -1;
        for (int c = bx; c < M / 256; c += G) {
            const int b = c >> 3;
            if (b != curb) {
                __syncthreads();
                for (int i = tid; i < 1024; i += NW * 64) { ssc[i] = 1.f + mod_sum(modp, X.b_ada, b, MOD_SCALE_A + i); ssh[i] = mod_sum(modp, X.b_ada, b, MOD_SHIFT_A + i); }
                __syncthreads();
                curb = b;
            }
            const f32x4 sc = *(const LAS f32x4*)(ssc + (tid & 255) * 4), sh = *(const LAS f32x4*)(ssh + (tid & 255) * 4);
            const float* xp = X.x + (size_t)c * 256 * D + (size_t)(tid >> 8) * D + (tid & 255) * 4;
            bf16_t* hp = hbuf + (size_t)c * 256 * D + (size_t)(tid >> 8) * D + (tid & 255) * 4;
            for (int i0 = 0; i0 < 128; i0 += 8) {
                f32x4 v[8];
#pragma unroll
                for (int i = 0; i < 8; ++i) v[i] = __builtin_nontemporal_load((const f32x4*)(xp + (size_t)(i0 + i) * 2 * D));
#pragma unroll
                for (int i = 0; i < 8; ++i) { u32x2 o; o.x = pk2(v[i].x * sc.x + sh.x, v[i].y * sc.y + sh.y); o.y = pk2(v[i].z * sc.z + sh.z, v[i].w * sc.w + sh.w); *(u32x2*)(hp + (size_t)(i0 + i) * 2 * D) = o; }
            }
        }
        __syncthreads();
    }
    SEAM(1);
    REPS(2) if (IN(2)) { PH_BEGIN
        pg8::DenseOrder S; S.init(M, DIN, D, win_t, G, bx);
        pg8::EpiInProj E{proj};
        pg8::gemm_phase(lds, (const char*)hbuf, D, S, E, tid);
    }
    SEAM(2);
    REPS(3) if (IN(3)) { PH_BEGIN
        REPS(31) for (int hu = bx; hu < BATCH * 4 * 2; hu += G) ret::unit(proj, rope, X.ret_ld, X.ret_gn, ymix, (unsigned char*)out + (size_t)hu * (8 * ret::TILE), lds, hu, tid);
        REPS(32) for (int u = bx; u < BATCH * 8; u += G) na::unit(proj, X.na_rpb, ymix, lds, u, tid);
    }
    SEAM2(3, 5);
    REPS(5) if (IN(5)) { PH_BEGIN
        pg8::DenseOrder S; S.init(M, D, D, wout_t, G, bx);
        pg8::EpiOutProj E{X.x, mod, out};
        pg8::gemm_phase(lds, (const char*)ymix, D, S, E, tid);
    }
    SEAM(5);
    if (IN(6)) { PH_BEGIN for (int r = gw; r < M; r += NGW) ln1_row(out, X.ln1_g, X.ln1_b, mod, hf, r, lane); }
    SEAM(6);
    REPS(7) if (IN(7)) { PH_BEGIN
        { pg8::DenseOrder S; S.init(M, NE, D, wr_t, G, bx); pg8::EpiRouter E{logits}; pg8::gemm_phase(lds, (const char*)hf, D, S, E, tid); }
        { pg8::DenseOrder S; S.init(M, 2 * DE, D, wsgu_t, G, bx); pg8::EpiGU<false> E{shh, nullptr}; pg8::gemm_phase(lds, (const char*)hf, D, S, E, tid); }
    }
    SEAM(7);
    if (IN(8)) { PH_BEGIN
        LAS unsigned* hist = tab + T_HIST;
        if (tid < NE) hist[tid] = 0u;
        __syncthreads();
        const f32x4 bias = *(const f32x4*)(X.rbias + lane * 4);
        for (int tok = gw; tok < M; tok += NGW) route_token(logits, bias, topk_e, topk_w, hist, tok, lane);
        __syncthreads();
        if (tid < NE && hist[tid]) atomicAdd(&ctl[CW_COUNT + tid], hist[tid]);
    }
    SEAM(8);
    if (IN(9)) { PH_BEGIN
        build_tables(ctl, tab, tid);
        LAS unsigned* hist = tab + T_HIST; LAS unsigned* base = tab + T_BASE;
        for (int c0 = bx * 2048; c0 < NSLOT; c0 += G * 2048) {
            __syncthreads();
            if (tid < NE) hist[tid] = 0u;
            __syncthreads();
            int e[4]; unsigned loc[4];
#pragma unroll
            for (int i = 0; i < 4; ++i) { const int idx = c0 + i * 512 + tid; e[i] = topk_e[idx]; loc[i] = __hip_atomic_fetch_add(&hist[e[i]], 1u, __ATOMIC_RELAXED, __HIP_MEMORY_SCOPE_WORKGROUP); }
            __syncthreads();
            if (tid < NE && hist[tid]) base[tid] = atomicAdd(&ctl[CW_CURSOR + tid], hist[tid]);
            __syncthreads();
#pragma unroll
            for (int i = 0; i < 4; ++i) { const int idx = c0 + i * 512 + tid; const unsigned pos = tab[T_OFF + e[i]] + base[e[i]] + loc[i]; slot_ent[pos] = idx; slot_w[pos] = topk_w[idx]; }
        }
    }
    SEAM(9);
    if (IN(10)) { PH_BEGIN
        build_tables(ctl, tab, tid);
        REPS(10) { pg8::ExpertOrder<2, true> S; S.init(tab, D, wgu_t, (size_t)512 * D * 2, slot_ent, slot_w, G, bx); pg8::EpiGU<true> E{act, slot_w}; pg8::gemm_phase(lds, (const char*)hf, D, S, E, tid); }
        { pg8::DenseOrder S; S.init(M, D, DE, wsd_t, G, bx); pg8::EpiSharedDown E{ws + WS_YSH}; pg8::gemm_phase(lds, (const char*)shh, DE, S, E, tid); }
    }
    SEAM(10);
    REPS(11) if (IN(11)) { PH_BEGIN
        build_tables(ctl, tab, tid);
        pg8::ExpertOrder<4, false> S; S.init(tab, DE, wd_t, (size_t)D * DE * 2, slot_ent, slot_w, G, bx); pg8::EpiExpDown E{ybuf, slot_ent}; pg8::gemm_phase(lds, (const char*)act, DE, S, E, tid);
    }
    SEAM(11);
    if (IN(12)) { PH_BEGIN for (int r = gw; r < M; r += NGW) final_row(out, ybuf, ws + WS_YSH, X.ln2_g, X.ln2_b, mod, r, lane); }
#undef IN
#undef SEAM
}

extern "C" void kernel_launch(void* const* d_in, const int* in_sizes, int n_in, void* d_out, int out_size, void* d_ws, size_t ws_size, hipStream_t stream) {
    static int grid = 0;
    if (grid == 0) {
        if (n_in != 21 || in_sizes[0] != M * D || out_size != M * D || ws_size < WS_END) { fprintf(stderr, "kernel_launch: unexpected shapes (n_in %d, ws %zu)\n", n_in, ws_size); grid = -1; return; }
        int dev = 0, cus = 0, per_cu = 0;
        if (hipGetDevice(&dev) != hipSuccess || hipDeviceGetAttribute(&cus, hipDeviceAttributeMultiprocessorCount, dev) != hipSuccess) { grid = -1; return; }
        if (hipFuncSetAttribute((const void*)mk_fwd, hipFuncAttributeMaxDynamicSharedMemorySize, LDS_BYTES) != hipSuccess) { fprintf(stderr, "kernel_launch: hipFuncSetAttribute failed\n"); grid = -1; return; }
        if (hipOccupancyMaxActiveBlocksPerMultiprocessor(&per_cu, (const void*)mk_fwd, NW * 64, LDS_BYTES) != hipSuccess || per_cu < 1) { fprintf(stderr, "kernel_launch: occupancy query says %d\n", per_cu); }
        (void)hipGetLastError();
        grid = cus;
    }
    if (grid < 0) return;
    (void)hipMemsetAsync((char*)d_ws + WS_CTL, 0, 1 * MiB, stream);
    Args a{};
    const float** p = (const float**)&a.X;
    for (int i = 0; i < 21; ++i) p[i] = (const float*)d_in[i];
    a.X.out = (float*)d_out; a.X.ws = (unsigned char*)d_ws;
#if MK_PER_PHASE
    for (int ph = 0; ph < N_PHASES; ++ph) { a.ph_lo = ph; a.ph_hi = ph + 1; hipLaunchKernelGGL(mk_fwd, dim3(grid), dim3(NW * 64), LDS_BYTES, stream, a); }
#else
    a.ph_lo = 0; a.ph_hi = N_PHASES;
    hipLaunchKernelGGL(mk_fwd, dim3(grid), dim3(NW * 64), LDS_BYTES, stream, a);
#endif
}
```

```cpp
#include <hip/hip_runtime.h>
#include <cstdio>
#include <cstdint>

typedef unsigned short bf16_t;
typedef short bf16x8 __attribute__((ext_vector_type(8)));
typedef float f32x4 __attribute__((ext_vector_type(4)));
typedef float f32x2 __attribute__((ext_vector_type(2)));
typedef unsigned u32x4 __attribute__((ext_vector_type(4)));
typedef unsigned u32x2 __attribute__((ext_vector_type(2)));
#define LAS __attribute__((address_space(3)))

constexpr int D = 1024, BATCH = 32, SEQ = 2048, M = BATCH * SEQ;
constexpr int DIN = 3584;
constexpr int OFF_QNA = 0, OFF_KNA = 512, OFF_VNA = 1024, OFF_QR = 1536, OFF_KR = 2048, OFF_VR = 2560, OFF_GR = 3072;
constexpr int NE = 256, TOPK = 8, DE = 256;
constexpr int NSLOT = M * TOPK;
constexpr float LN_EPS = 1e-5f, GN_EPS = 1e-6f;
constexpr float ALPHA = 1.189207115002721f;
constexpr float YSCALE = 64.f, YINV = 1.f / 64.f;
constexpr float S_HF8 = 16.f, S_WGU8 = 256.f, S_ACT8 = 32.f, S_WD8 = 128.f;
constexpr float INV_GU8 = 1.f / (16.f * 256.f), INV_DN8 = 1.f / (32.f * 128.f);
constexpr int MOD_SHIFT_A = 0, MOD_SCALE_A = 1024, MOD_GATE_A = 2048, MOD_SHIFT_F = 3072, MOD_SCALE_F = 4096, MOD_GATE_F = 5120;

constexpr size_t MiB = 1u << 20;
constexpr size_t WS_CTL = 0;
constexpr size_t WS_MOD = 1 * MiB;
constexpr size_t WS_ROPE = 2 * MiB;
constexpr size_t WS_WIN_T = 4 * MiB;
constexpr size_t WS_WOUT_T = 11 * MiB;
constexpr size_t WS_WR_T = 13 * MiB;
constexpr size_t WS_WSGU_T = 14 * MiB;
constexpr size_t WS_WSD_T = 15 * MiB;
constexpr size_t WS_SLOT_ENT = 16 * MiB;
constexpr size_t WS_SLOT_W = 18 * MiB;
constexpr size_t WS_TOPK_E = 20 * MiB;
constexpr size_t WS_TOPK_W = 22 * MiB;
constexpr size_t WS_STATS = 24 * MiB;
constexpr size_t WS_WD_T = 32 * MiB;
constexpr size_t WS_WGU_T = 160 * MiB;
constexpr size_t WS_HF8 = 288 * MiB;
constexpr size_t WS_YMIX = 416 * MiB;
constexpr size_t WS_PROJ = 544 * MiB;
constexpr size_t WS_LOGITS = WS_YMIX, WS_SHH = WS_YMIX + 64 * MiB;
constexpr size_t WS_HF = WS_PROJ, WS_ACT = WS_PROJ + 128 * MiB;
constexpr size_t WS_YBUF = WS_WGU_T;
constexpr size_t WS_YSH = WS_PROJ + 384 * MiB;
constexpr size_t WS_END = 992 * MiB;
constexpr int CW_COUNT = 1024, CW_CURSOR = 1536, CW_BAR = 8192;

constexpr int RING_BYTES = 131072;
constexpr int TAB_OFF = RING_BYTES;
constexpr int T_OFF = 0, T_TILE = 260, T_CNT = 520, T_HIST = 776, T_BASE = 1032, TAB_WORDS = 1288;
constexpr int VN_OFF = TAB_OFF + 6144;
constexpr int ROWTAB_OFF = VN_OFF + 8192;
constexpr int PHASE_BYTES = 155648;
constexpr int MISC_OFF = PHASE_BYTES;
constexpr int LDS_BYTES = PHASE_BYTES + 256;
static_assert(TAB_WORDS * 4 <= 6144 && ROWTAB_OFF + 6144 <= PHASE_BYTES && LDS_BYTES <= 163840, "LDS map");

__device__ __forceinline__ unsigned f2bf(float f) { unsigned u = __float_as_uint(f); return (u + 0x7fffu + ((u >> 16) & 1u)) >> 16; }
__device__ __forceinline__ float bf2f(unsigned short h) { return __uint_as_float(((unsigned)h) << 16); }
__device__ __forceinline__ unsigned pk2(float lo, float hi) { return f2bf(lo) | (f2bf(hi) << 16); }
__device__ __forceinline__ unsigned cvt_pk_bf16(float lo, float hi) { unsigned r; asm volatile("v_cvt_pk_bf16_f32 %0, %1, %2" : "=v"(r) : "v"(lo), "v"(hi)); return r; }
__device__ __forceinline__ float silu_f(float v) { return v * __builtin_amdgcn_rcpf(1.f + __expf(-v)); }
__device__ __forceinline__ float wave_sum(float v) {
#pragma unroll
    for (int o = 1; o < 64; o <<= 1) v += __shfl_xor(v, o);
    return v;
}
__device__ __forceinline__ float clamp8(float v) { return fminf(fmaxf(v, -440.f), 440.f); }
#define LDS_WAIT() asm volatile("s_waitcnt lgkmcnt(0)" ::: "memory")
__device__ __forceinline__ int lane_id() { return (int)__builtin_amdgcn_mbcnt_hi(~0u, __builtin_amdgcn_mbcnt_lo(~0u, 0u)); }

#define XB_TMO      128
#define XB_XCNT(j)  (256  + 64 * (j))
#define XB_XSUB(j)  (1280 + 64 * (j))
#define XB_XGEN(j)  (2304 + 64 * (j))
#define XB_TOP      3328
#define XB_TOPGEN   3392
#define XCD_BAR_WORDS 3456
#define XB_SPIN_CAP (1u << 23)
__device__ __forceinline__ unsigned xb_ld(unsigned* p)              { return __hip_atomic_load(p, __ATOMIC_RELAXED, __HIP_MEMORY_SCOPE_AGENT); }
__device__ __forceinline__ unsigned xb_add(unsigned* p, unsigned v) { return __hip_atomic_fetch_add(p, v, __ATOMIC_RELAXED, __HIP_MEMORY_SCOPE_AGENT); }
__device__ __forceinline__ unsigned xb_xcc_id() { return (unsigned)__builtin_amdgcn_s_getreg((3 << 11) | 20) & 0xFu; }
#define XB_SPIN(cond, bar) do { unsigned _sp = 0; while (cond) { __builtin_amdgcn_s_sleep(1); \
    if ((++_sp & 255u) == 0u) { if (xb_ld(&(bar)[XB_TMO])) break; if (_sp > XB_SPIN_CAP) { atomicAdd(&(bar)[XB_TMO], 1u); break; } } } } while (0)
struct XcdBarrier { unsigned* bar; unsigned x; volatile LAS unsigned* st; };
__device__ __forceinline__ XcdBarrier xcd_barrier_post(unsigned* bar, volatile LAS unsigned* st, bool leader) {
    XcdBarrier b; b.bar = bar; b.x = xb_xcc_id(); b.st = st;
    if (leader) (void)xb_add(&bar[XB_XCNT(b.x)], 1u);
    return b;
}
__device__ __forceinline__ void xcd_barrier_complete(unsigned* bar, unsigned x, unsigned& nloc, unsigned& nx) {
    const unsigned G = gridDim.x * gridDim.y * gridDim.z;
    unsigned sum, cnt, mine, sp = 0u;
    for (;;) {
        sum = 0u; cnt = 0u; mine = 0u;
#pragma unroll
        for (unsigned j = 0; j < 16; ++j) { const unsigned c = xb_ld(&bar[XB_XCNT(j)]); sum += c; cnt += (c > 0u) ? 1u : 0u; mine = (j == x) ? c : mine; }
        if (sum == G) break;
        __builtin_amdgcn_s_sleep(1);
        if ((++sp & 255u) == 0u) { if (xb_ld(&bar[XB_TMO])) break; if (sp > XB_SPIN_CAP) { atomicAdd(&bar[XB_TMO], 1u); break; } }
    }
    nloc = mine > 0u ? mine : 1u; nx = cnt > 0u ? cnt : 1u;
}
__device__ __forceinline__ void xcd_barrier(const XcdBarrier& b, bool leader) {
    asm volatile("s_waitcnt vmcnt(0)" ::: "memory");
    __syncthreads();
    if (leader) {
        unsigned* bar = b.bar;
        __builtin_amdgcn_s_waitcnt(0);
        unsigned nloc = b.st[0], nx = b.st[1];
        if (nloc == 0u) { xcd_barrier_complete(bar, b.x, nloc, nx); b.st[0] = nloc; b.st[1] = nx; }
        const unsigned old = xb_add(&bar[XB_XSUB(b.x)], 1u);
        const unsigned gen = old / nloc;
        if (old + 1u == (gen + 1u) * nloc) {
            __builtin_amdgcn_fence(__ATOMIC_RELEASE, "agent");
            asm volatile("s_waitcnt vmcnt(0)" ::: "memory");
            const unsigned og = xb_add(&bar[XB_TOP], 1u);
            const unsigned tg = og / nx;
            if (og + 1u == (tg + 1u) * nx) xb_add(&bar[XB_TOPGEN], 1u);
            else XB_SPIN(xb_ld(&bar[XB_TOPGEN]) == tg, bar);
            __builtin_amdgcn_fence(__ATOMIC_ACQUIRE, "agent");
            xb_add(&bar[XB_XGEN(b.x)], 1u);
            asm volatile("s_waitcnt vmcnt(0)" ::: "memory");
        } else {
            XB_SPIN(xb_ld(&bar[XB_XGEN(b.x)]) == gen, bar);
            __builtin_amdgcn_fence(__ATOMIC_ACQUIRE, "agent");
            asm volatile("s_waitcnt vmcnt(0)" ::: "memory");
        }
    }
    __syncthreads();
}

namespace pg8 {
constexpr int BM = 256, BK = 64, HALF = 128, HTB = HALF * BK * 2, STAGE_BYTES = 8 * HTB;
__device__ __forceinline__ int lds_byte(int r, int c) { const int st = (r >> 4) * 2 + (c >> 5), rr = r & 15, cc = c & 31, ob = rr * 64 + cc * 2; return st * 1024 + (ob ^ (((ob >> 9) & 1) << 5)); }
__device__ __forceinline__ void stage_rc(int b, int& R, int& C) { const int st = b / 1024, sb = b % 1024, swz = sb ^ (((sb >> 9) & 1) << 5); R = (st >> 1) * 16 + swz / 64; C = (st & 1) * 32 + (swz % 64) / 2; }
__device__ __forceinline__ int perm32(int rho) { const int n = rho >> 4, i = rho & 15; return 8 * (i >> 2) + 4 * n + (i & 3); }

typedef int i32x8 __attribute__((ext_vector_type(8)));
__device__ __forceinline__ i32x8 cat8(const bf16x8 lo, const bf16x8 hi) { const u32x4 a = __builtin_bit_cast(u32x4, lo), b = __builtin_bit_cast(u32x4, hi); return (i32x8){(int)a.x, (int)a.y, (int)a.z, (int)a.w, (int)b.x, (int)b.y, (int)b.z, (int)b.w}; }
struct Unit { int pm, pn; const char* B; int e, cnt, off; };

template <int ESZ = 2, class Epi, class Sched>
__device__ __forceinline__ void gemm_phase(LAS unsigned char* lds, const char* Abase, const int K, const Sched& S, const Epi& E, const int tid_in) {
    int tid_ = tid_in; asm volatile("" : "+v"(tid_));
    const int tid = tid_, wid = __builtin_amdgcn_readfirstlane(tid >> 6), lane = tid & 63, wr = wid >> 2, wc = wid & 3, fr = lane & 15, fq = lane >> 4;
    const int rowbytes = K * ESZ, nt = rowbytes / 128;
    int Rr[2], Cc[2]; unsigned voffB[2], voffA[2];
#pragma unroll
    for (int i = 0; i < 2; ++i) { int R, C; stage_rc(tid * 16 + i * 8192, R, C); Rr[i] = R; Cc[i] = C; const int Rb = Epi::PERM ? ((R & ~31) + perm32(R & 31)) : R; voffB[i] = (unsigned)(Rb * rowbytes + C * 2); voffA[i] = (unsigned)(R * rowbytes + C * 2); }
    constexpr bool GATHER = Sched::GATHER;
    const size_t kstep = (size_t)128;
    const size_t hstep = (size_t)HALF * rowbytes;
    const unsigned ldsw = (unsigned)wid * 1024u;
    const int aoff = (ESZ == 2) ? lds_byte(wr * 64 + fr, fq * 8) : lds_byte(wr * 64 + fr, 16 * (fq & 1)) + 1024 * (fq >> 1);
    const int boff = (ESZ == 2) ? lds_byte(wc * 32 + fr, fq * 8) : lds_byte(wc * 32 + fr, 16 * (fq & 1)) + 1024 * (fq >> 1);
#define PG8_SA(b, h) (((b) * 2 + (h)) * HTB)
#define PG8_SB(b, h) ((4 + (b) * 2 + (h)) * HTB)
#define PG8_STAGE(bufoff, gbase, voff) do { _Pragma("unroll") for (int _i = 0; _i < 2; ++_i) \
        __builtin_amdgcn_global_load_lds((const unsigned*)((const char*)(gbase) + (voff)[_i]), (LAS unsigned*)(lds + (bufoff) + ldsw + _i * 8192), 16, 0, 0); } while (0)
#define PG8_STAGEA(bufoff, uptr, koff, NEXT, h) do { if constexpr (GATHER) { if (NEXT) { const u32x2 _t = *(const LAS u32x2*)(vnslot + 2 * (h)); unsigned _v[2] = {_t.x, _t.y}; PG8_STAGE(bufoff, Abase + (koff), _v); } else { PG8_STAGE(bufoff, Abase + (koff), vc[h]); } } \
        else { PG8_STAGE(bufoff, (uptr) + (size_t)(h) * hstep + (koff), voffA); } } while (0)
#define PG8_LDA(dst, b, h) do { _Pragma("unroll") for (int m = 0; m < 4; ++m) { if constexpr (ESZ == 2) { _Pragma("unroll") for (int k = 0; k < 2; ++k) dst[m].q[k] = *(const LAS bf16x8*)(lds + PG8_SA(b, h) + aoff + m * 2048 + k * 1024); } \
        else dst[m].w = cat8(*(const LAS bf16x8*)(lds + PG8_SA(b, h) + aoff + m * 2048), *(const LAS bf16x8*)(lds + PG8_SA(b, h) + aoff + m * 2048 + 16)); } } while (0)
#define PG8_LDB(dst, b, h) do { _Pragma("unroll") for (int n = 0; n < 2; ++n) { if constexpr (ESZ == 2) { _Pragma("unroll") for (int k = 0; k < 2; ++k) dst[n].q[k] = *(const LAS bf16x8*)(lds + PG8_SB(b, h) + boff + n * 2048 + k * 1024); } \
        else dst[n].w = cat8(*(const LAS bf16x8*)(lds + PG8_SB(b, h) + boff + n * 2048), *(const LAS bf16x8*)(lds + PG8_SB(b, h) + boff + n * 2048 + 16)); } } while (0)
#define PG8_MMA(ai, bj, At, Bt) do { __builtin_amdgcn_s_setprio(1); _Pragma("unroll") for (int m = 0; m < 4; ++m) _Pragma("unroll") for (int n = 0; n < 2; ++n) { \
        if constexpr (ESZ == 2) { _Pragma("unroll") for (int k = 0; k < 2; ++k) acc[ai][bj][m][n] = __builtin_amdgcn_mfma_f32_16x16x32_bf16(Bt[n].q[k], At[m].q[k], acc[ai][bj][m][n], 0, 0, 0); } \
        else { asm volatile("v_mfma_f32_16x16x128_f8f6f4 %0, %1, %2, %0" : "+v"(acc[ai][bj][m][n]) : "v"(Bt[n].w), "v"(At[m].w)); } } \
        __builtin_amdgcn_s_setprio(0); } while (0)
#define PG8_WAIT_V(n) asm volatile("s_waitcnt vmcnt(" #n ")" ::: "memory")
#define PG8_WAIT_L(n) asm volatile("s_waitcnt lgkmcnt(" #n ")" ::: "memory")
#define PG8_BAR __builtin_amdgcn_s_barrier()
#define PG8_SCHED __builtin_amdgcn_sched_barrier(0)
    Unit cur, nxt; int ui = 0;
    if (!S.next(0, cur)) return;
    f32x4 acc[2][2][4][2];
    union Frag { bf16x8 q[2]; i32x8 w; };
    Frag At[4], B0[2], B1[2];
    unsigned vc[2][2];
    LAS unsigned* vnslot = (LAS unsigned*)(lds + (VN_OFF - 0)) + tid * 4;
    if constexpr (GATHER) S.avoff(cur, Rr, Cc, vc, tid);
    LAS unsigned* rowtab = (LAS unsigned*)(lds + ROWTAB_OFF);
    if constexpr (GATHER) S.rowtab(cur, rowtab, tid);
    const char* cB = cur.B; const char* cA = Abase + S.aoff(cur);
    PG8_STAGE(PG8_SB(0, 0), cB, voffB); PG8_STAGE(PG8_SB(0, 1), cB + hstep, voffB); PG8_STAGEA(PG8_SA(0, 0), cA, 0, false, 0); PG8_STAGEA(PG8_SA(0, 1), cA, 0, false, 1);
    if (wr == 1) PG8_BAR;
    PG8_WAIT_V(2); PG8_BAR;
    PG8_STAGE(PG8_SB(1, 0), cB + kstep, voffB); PG8_STAGEA(PG8_SA(1, 0), cA, kstep, false, 0); PG8_STAGE(PG8_SB(1, 1), cB + hstep + kstep, voffB);
    PG8_WAIT_V(6); PG8_BAR;
    asm volatile("" ::: "memory");
#pragma unroll
    for (int a = 0; a < 2; ++a)
#pragma unroll
        for (int b = 0; b < 2; ++b)
#pragma unroll
            for (int m = 0; m < 4; ++m)
#pragma unroll
                for (int n = 0; n < 2; ++n) { acc[a][b][m][n] = (f32x4){0.f, 0.f, 0.f, 0.f}; asm volatile("" : "+v"(acc[a][b][m][n])); }
    asm volatile("s_nop 4" ::: "memory");
    for (;;) {
        const bool has_next = S.next(ui + 1, nxt);
        if constexpr (GATHER) {
            unsigned vn[2][2];
            if (has_next) S.avoff(nxt, Rr, Cc, vn, tid);
            else {
#pragma unroll
                for (int h = 0; h < 2; ++h)
#pragma unroll
                    for (int i = 0; i < 2; ++i) vn[h][i] = vc[h][i];
            }
            *(LAS u32x4*)vnslot = (u32x4){vn[0][0], vn[0][1], vn[1][0], vn[1][1]};
            if (has_next) S.rowtab(nxt, rowtab + 512 * ((ui + 1) % 3), tid);
        }
        const char* nB = has_next ? nxt.B : cB; const char* nA = has_next ? Abase + S.aoff(nxt) : cA;
        for (int t = 0; t < nt; t += 2) {
            const bool last = (t == nt - 2);
            const size_t k1 = (size_t)(t + 1) * kstep;
            const size_t k2 = last ? (size_t)0 : (size_t)(t + 2) * kstep, k3 = k2 + kstep;
            const char* u2 = last ? nA : cA; const char* b2 = last ? nB : cB + (size_t)(t + 2) * kstep;
            const char* b3 = b2 + kstep;
            PG8_LDB(B0, 0, 0); PG8_LDB(B1, 0, 1); PG8_SCHED; PG8_LDA(At, 0, 0); PG8_STAGEA(PG8_SA(1, 1), cA, k1, false, 1);
            PG8_WAIT_V(8); PG8_WAIT_L(0); PG8_BAR; PG8_MMA(0, 0, At, B0); PG8_MMA(0, 1, At, B1); PG8_BAR; PG8_SCHED;
            PG8_LDA(At, 0, 1); PG8_STAGE(PG8_SB(0, 0), b2, voffB); PG8_STAGE(PG8_SB(0, 1), b2 + hstep, voffB); PG8_STAGEA(PG8_SA(0, 0), u2, k2, last, 0);
            PG8_WAIT_V(8); PG8_WAIT_L(0); PG8_BAR; PG8_MMA(1, 0, At, B0); PG8_MMA(1, 1, At, B1); PG8_BAR; PG8_SCHED;
            PG8_LDB(B0, 1, 0); PG8_LDB(B1, 1, 1); PG8_SCHED; PG8_LDA(At, 1, 0); PG8_STAGEA(PG8_SA(0, 1), u2, k2, last, 1);
            PG8_WAIT_V(8); PG8_WAIT_L(0); PG8_BAR; PG8_MMA(0, 0, At, B0); PG8_MMA(0, 1, At, B1); PG8_BAR; PG8_SCHED;
            PG8_LDA(At, 1, 1); PG8_STAGE(PG8_SB(1, 0), b3, voffB); PG8_STAGE(PG8_SB(1, 1), b3 + hstep, voffB); PG8_STAGEA(PG8_SA(1, 0), u2, k3, last, 0);
            PG8_WAIT_V(8); PG8_WAIT_L(0); PG8_BAR; PG8_MMA(1, 0, At, B0); PG8_MMA(1, 1, At, B1); PG8_BAR; PG8_SCHED;
        }
        if (wr == 0) PG8_BAR;
        if constexpr (ESZ == 1) {
            asm volatile("s_nop 15\n\ts_nop 15" ::: "memory");
#pragma unroll
            for (int a = 0; a < 2; ++a)
#pragma unroll
                for (int b = 0; b < 2; ++b)
#pragma unroll
                    for (int m = 0; m < 4; ++m) asm volatile("" : "+v"(acc[a][b][m][0]), "+v"(acc[a][b][m][1]));
        }
        { const int l2 = lane_id(); E(acc, cur, wr, wc, l2 & 15, l2 >> 4, rowtab + 512 * (ui % 3)); }
        if (!has_next) break;
#pragma unroll
        for (int a = 0; a < 2; ++a)
#pragma unroll
            for (int b = 0; b < 2; ++b)
#pragma unroll
                for (int m = 0; m < 4; ++m)
#pragma unroll
                    for (int n = 0; n < 2; ++n) acc[a][b][m][n] = (f32x4){0.f, 0.f, 0.f, 0.f};
        cur = nxt; cB = nB; cA = nA; ++ui;
        if constexpr (GATHER) { const u32x4 _t = *(const LAS u32x4*)vnslot; vc[0][0] = _t.x; vc[0][1] = _t.y; vc[1][0] = _t.z; vc[1][1] = _t.w; }
        if (wr == 1) PG8_BAR;
    }
    PG8_WAIT_V(0);
    PG8_BAR;
#undef PG8_SA
#undef PG8_SB
#undef PG8_STAGE
#undef PG8_STAGEA
#undef PG8_LDA
#undef PG8_LDB
#undef PG8_MMA
#undef PG8_WAIT_V
#undef PG8_WAIT_L
#undef PG8_BAR
#undef PG8_SCHED
}

struct DenseOrder {
    int nM, nN, nwg, G, c, K; const char* Bt;
    __device__ void init(int Mrows, int N, int K_, const void* Bt_, int G_, int c_) { nM = Mrows / BM; nN = N / BM; nwg = nM * nN; G = G_; c = c_; K = K_; Bt = (const char*)Bt_; }
    __device__ __forceinline__ bool next(int i, Unit& u) const {
        const long L = (long)i * G + c; if (L >= nwg) return false;
        int wgid = (int)L; { const int q = nwg / 8, r = nwg % 8, xcd = wgid % 8, off = wgid / 8; wgid = (xcd < r ? xcd * (q + 1) : r * (q + 1) + (xcd - r) * q) + off; }
        const int nig = 8 * nN, gid = wgid / nig, fm = gid * 8, gsz = (nM - fm) < 8 ? (nM - fm) : 8;
        u.pm = fm + ((wgid % nig) % gsz); u.pn = (wgid % nig) / gsz; u.B = Bt + (size_t)u.pn * BM * K * 2; u.e = 0; u.cnt = 0; u.off = 0; return true;
    }
    static constexpr bool GATHER = false;
    __device__ __forceinline__ size_t aoff(const Unit& u) const { return (size_t)u.pm * BM * K * 2; }
    __device__ __forceinline__ void avoff(const Unit&, const int (&)[2], const int (&)[2], unsigned (&)[2][2], int) const {}
};
template <int NCOL, bool TOKROWS> struct ExpertOrder {
    static constexpr bool GATHER = true;
    __device__ __forceinline__ size_t aoff(const Unit&) const { return 0; }
    const LAS unsigned* tab; int per, c, K  ; const char* W; size_t wstride; const int* slot_ent; const float* slot_w;
    int xbase, xend, xstride, xlb;
    __device__ void init(const LAS unsigned* tab_, int K_, const void* W_, size_t wstride_, const int* slot_ent_, const float* slot_w_, int G, int c_) {
        tab = tab_; K = K_; W = (const char*)W_; wstride = wstride_; slot_ent = slot_ent_; slot_w = slot_w_; c = c_;
        const int U = (int)tab[T_TILE + NE] * NCOL; per = (U + G - 1) / G;
        if (G % 8 == 0) { const int x = c_ % 8; const int q = U / 8, r = U % 8; xbase = x * q + (x < r ? x : r); xend = xbase + q + (x < r ? 1 : 0); xstride = G / 8; xlb = c_ / 8; }
        else { xbase = 0; xend = U; xstride = G; xlb = c_; }
    }
    __device__ __forceinline__ bool next(int i, Unit& u) const {
        const int L = xbase + i * xstride + xlb;
        if (L >= xend) return false;
        const int tile = L / NCOL; u.pn = L % NCOL;
        int lo = 0, hi = NE - 1;
        while (lo < hi) { const int mid = (lo + hi + 1) >> 1; if ((int)tab[T_TILE + mid] <= tile) lo = mid; else hi = mid - 1; }
        u.e = lo; u.pm = tile - (int)tab[T_TILE + lo]; u.cnt = (int)tab[T_CNT + lo]; u.off = (int)tab[T_OFF + lo];
        u.B = W + (size_t)lo * wstride + (size_t)u.pn * BM * K; return true;
    }
    __device__ __forceinline__ void rowtab(const Unit& u, LAS unsigned* t, int tid) const {
        if (tid < BM) { int r = u.pm * BM + tid; if (r >= u.cnt) r = u.cnt - 1; t[tid] = (unsigned)slot_ent[u.off + r]; t[BM + tid] = __float_as_uint(slot_w[u.off + r]); }
    }
    __device__ __forceinline__ void avoff(const Unit& u, const int (&)[2], const int (&)[2], unsigned (&v)[2][2], int tidq) const {
        int R[2], C[2]; asm volatile("" : "+v"(tidq));
#pragma unroll
        for (int i = 0; i < 2; ++i) stage_rc(tidq * 16 + i * 8192, R[i], C[i]);
#pragma unroll
        for (int h = 0; h < 2; ++h)
#pragma unroll
            for (int i = 0; i < 2; ++i) {
                int r = u.pm * BM + h * HALF + R[i]; if (r >= u.cnt) r = u.cnt - 1;
                const int slot = u.off + r;
                const int row = TOKROWS ? (slot_ent[slot] >> 3) : slot;
                v[h][i] = (unsigned)(row * K + C[i] * 2);
            }
    }
};

struct EpiInProj {
    static constexpr bool PERM = true; bf16_t* O;
    __device__ __forceinline__ void operator()(const f32x4 (&acc)[2][2][4][2], const Unit& u, int wr, int wc, int fr, int fq, const LAS unsigned* rt) const {
        const float sc = (u.pn < 2) ? 0.125f : ((u.pn == 8 || u.pn == 9) ? 0.08838834764831845f : 1.f);
        const int row0 = u.pm * BM + wr * 64 + fr, col0 = u.pn * BM + wc * 32 + 8 * fq;
#pragma unroll
        for (int ai = 0; ai < 2; ++ai)
#pragma unroll
            for (int m = 0; m < 4; ++m) { bf16_t* rowp = O + (size_t)(row0 + ai * HALF + m * 16) * DIN + col0;
#pragma unroll
                for (int bj = 0; bj < 2; ++bj) { const f32x4 v0 = acc[ai][bj][m][0] * sc, v1 = acc[ai][bj][m][1] * sc;
                    u32x4 w; w.x = cvt_pk_bf16(v0[0], v0[1]); w.y = cvt_pk_bf16(v0[2], v0[3]); w.z = cvt_pk_bf16(v1[0], v1[1]); w.w = cvt_pk_bf16(v1[2], v1[3]);
                    *(u32x4*)(rowp + bj * HALF) = w; } }
    }
};
struct EpiOutProj {
    static constexpr bool PERM = false; const float* x; const float* mod; float* out;
    __device__ __forceinline__ void operator()(const f32x4 (&acc)[2][2][4][2], const Unit& u, int wr, int wc, int fr, int fq, const LAS unsigned* rt) const {
        const int b = (u.pm * BM) >> 11; const int col0 = u.pn * BM + wc * 32 + 4 * fq;
#pragma unroll
        for (int bj = 0; bj < 2; ++bj)
#pragma unroll
            for (int n = 0; n < 2; ++n) { const int col = col0 + bj * HALF + n * 16; const f32x4 g = *(const f32x4*)(mod + b * 6144 + MOD_GATE_A + col);
#pragma unroll
                for (int ai = 0; ai < 2; ++ai)
#pragma unroll
                    for (int m = 0; m < 4; ++m) { const size_t o = (size_t)(u.pm * BM + ai * HALF + wr * 64 + m * 16 + fr) * D + col;
                        const f32x4 xv = *(const f32x4*)(x + o); *(f32x4*)(out + o) = xv * ALPHA + g * acc[ai][bj][m][n]; } }
    }
};
struct EpiRouter {
    static constexpr bool PERM = false; float* out;
    __device__ __forceinline__ void operator()(const f32x4 (&acc)[2][2][4][2], const Unit& u, int wr, int wc, int fr, int fq, const LAS unsigned* rt) const {
        const int col0 = wc * 32 + 4 * fq;
#pragma unroll
        for (int ai = 0; ai < 2; ++ai)
#pragma unroll
            for (int m = 0; m < 4; ++m) { float* rowp = out + (size_t)(u.pm * BM + ai * HALF + wr * 64 + m * 16 + fr) * NE + col0;
#pragma unroll
                for (int bj = 0; bj < 2; ++bj)
#pragma unroll
                    for (int n = 0; n < 2; ++n) *(f32x4*)(rowp + bj * HALF + n * 16) = acc[ai][bj][m][n]; }
    }
};
template <bool EXPERT> struct EpiGU {
    static constexpr bool PERM = true; void* Ov;
    __device__ __forceinline__ void operator()(const f32x4 (&acc)[2][2][4][2], const Unit& u, int wr, int wc, int fr, int fq, const LAS unsigned* rt) const {
        const int h0 = u.pn * HALF + wc * 32 + 8 * fq;
#pragma unroll
        for (int ai = 0; ai < 2; ++ai)
#pragma unroll
            for (int m = 0; m < 4; ++m) {
                const int rtw = u.pm * BM + ai * HALF + wr * 64 + m * 16 + fr;
                if (EXPERT) { if (rtw >= u.cnt) continue; }
                const float w = EXPERT ? __uint_as_float(rt[BM + ai * HALF + wr * 64 + m * 16 + fr]) * (S_ACT8 * INV_GU8) : 1.f;
                const float gs = EXPERT ? INV_GU8 : 1.f;
                const f32x4 g0 = acc[ai][0][m][0] * gs, g1 = acc[ai][0][m][1] * gs, u0 = acc[ai][1][m][0], u1 = acc[ai][1][m][1];
                const float h[8] = {w * silu_f(g0[0]) * u0[0], w * silu_f(g0[1]) * u0[1], w * silu_f(g0[2]) * u0[2], w * silu_f(g0[3]) * u0[3],
                                    w * silu_f(g1[0]) * u1[0], w * silu_f(g1[1]) * u1[1], w * silu_f(g1[2]) * u1[2], w * silu_f(g1[3]) * u1[3]};
                if (EXPERT) {
                    int w0 = __builtin_amdgcn_cvt_pk_fp8_f32(clamp8(h[0]), clamp8(h[1]), 0, false); w0 = __builtin_amdgcn_cvt_pk_fp8_f32(clamp8(h[2]), clamp8(h[3]), w0, true);
                    int w1 = __builtin_amdgcn_cvt_pk_fp8_f32(clamp8(h[4]), clamp8(h[5]), 0, false); w1 = __builtin_amdgcn_cvt_pk_fp8_f32(clamp8(h[6]), clamp8(h[7]), w1, true);
                    u32x2 o; o.x = (unsigned)w0; o.y = (unsigned)w1; *(u32x2*)((unsigned char*)Ov + (size_t)(u.off + rtw) * DE + h0) = o;
                    asm volatile("" ::: "memory");
                } else {
                    u32x4 o; o.x = cvt_pk_bf16(h[0], h[1]); o.y = cvt_pk_bf16(h[2], h[3]); o.z = cvt_pk_bf16(h[4], h[5]); o.w = cvt_pk_bf16(h[6], h[7]);
                    *(u32x4*)((bf16_t*)Ov + (size_t)rtw * DE + h0) = o;
                }
            }
    }
};
struct EpiSharedDown {
    static constexpr bool PERM = true; unsigned char* ysh;
    __device__ __forceinline__ void operator()(const f32x4 (&acc)[2][2][4][2], const Unit& u, int wr, int wc, int fr, int fq, const LAS unsigned* rt) const {
        const int col0 = u.pn * BM + wc * 32 + 8 * fq;
#pragma unroll
        for (int ai = 0; ai < 2; ++ai)
#pragma unroll
            for (int m = 0; m < 4; ++m) {
                unsigned char* rowp = ysh + (size_t)(u.pm * BM + ai * HALF + wr * 64 + m * 16 + fr) * D + col0;
#pragma unroll
                for (int bj = 0; bj < 2; ++bj) { const f32x4 v0 = acc[ai][bj][m][0] * YSCALE, v1 = acc[ai][bj][m][1] * YSCALE;
                    int w0 = __builtin_amdgcn_cvt_pk_fp8_f32(clamp8(v0[0]), clamp8(v0[1]), 0, false); w0 = __builtin_amdgcn_cvt_pk_fp8_f32(clamp8(v0[2]), clamp8(v0[3]), w0, true);
                    int w1 = __builtin_amdgcn_cvt_pk_fp8_f32(clamp8(v1[0]), clamp8(v1[1]), 0, false); w1 = __builtin_amdgcn_cvt_pk_fp8_f32(clamp8(v1[2]), clamp8(v1[3]), w1, true);
                    u32x2 o; o.x = (unsigned)w0; o.y = (unsigned)w1; *(u32x2*)(rowp + bj * HALF) = o; }
            }
    }
};
struct EpiExpDown {
    static constexpr bool PERM = true; unsigned char* ybuf; const int* slot_ent;
    __device__ __forceinline__ void operator()(const f32x4 (&acc)[2][2][4][2], const Unit& u, int wr, int wc, int fr, int fq, const LAS unsigned* rt) const {
        const int col0 = u.pn * BM + wc * 32 + 8 * fq;
#pragma unroll
        for (int ai = 0; ai < 2; ++ai)
#pragma unroll
            for (int m = 0; m < 4; ++m) {
                const int rtw = u.pm * BM + ai * HALF + wr * 64 + m * 16 + fr; if (rtw >= u.cnt) continue;
                unsigned char* rowp = ybuf + (size_t)rt[ai * HALF + wr * 64 + m * 16 + fr] * D + col0;
#pragma unroll
                for (int bj = 0; bj < 2; ++bj) { const f32x4 v0 = acc[ai][bj][m][0] * (YSCALE * INV_DN8), v1 = acc[ai][bj][m][1] * (YSCALE * INV_DN8);
                    int w0 = __builtin_amdgcn_cvt_pk_fp8_f32(clamp8(v0[0]), clamp8(v0[1]), 0, false); w0 = __builtin_amdgcn_cvt_pk_fp8_f32(clamp8(v0[2]), clamp8(v0[3]), w0, true);
                    int w1 = __builtin_amdgcn_cvt_pk_fp8_f32(clamp8(v1[0]), clamp8(v1[1]), 0, false); w1 = __builtin_amdgcn_cvt_pk_fp8_f32(clamp8(v1[2]), clamp8(v1[3]), w1, true);
                    u32x2 o; o.x = (unsigned)w0; o.y = (unsigned)w1; *(u32x2*)(rowp + bj * HALF) = o; }
                asm volatile("" ::: "memory");
            }
    }
};
}

struct Ctx {
    const float *x, *c, *w_ada, *b_ada, *w_in, *w_out, *na_rpb, *ret_ld, *ret_gn, *ln1_g, *ln1_b, *ln2_g, *ln2_b, *w_router, *rbias, *w_gate, *w_up, *w_down, *ws_gate, *ws_up, *ws_down;
    float* out; unsigned char* ws;
};
constexpr int NW = 8;

__device__ __forceinline__ void transpose_item(const float* W, int K, int N, bf16_t* WT, int G, int which, LAS float* scr, int item, int lane) {
    const int nblk = N / 32, kb = item / nblk, nb = item % nblk, k0 = 64 * kb, n0 = 32 * nb;
    float v[32];
#pragma unroll
    for (int i = 0; i < 32; ++i) { const int kk = 2 * i + (lane >> 5); v[i] = __builtin_nontemporal_load(W + (size_t)(k0 + kk) * N + n0 + (lane & 31)); }
#pragma unroll
    for (int i = 0; i < 32; ++i) { const int kk = 2 * i + (lane >> 5); scr[kk * 33 + (lane & 31)] = v[i]; }
    LDS_WAIT(); asm volatile("" ::: "memory");
    const int c = lane & 7;
#pragma unroll
    for (int j = 0; j < 4; ++j) { const int n = (lane >> 3) + 8 * j; const LAS float* s = scr + (8 * c) * 33 + n;
        u32x4 o; o.x = pk2(s[0 * 33], s[1 * 33]); o.y = pk2(s[2 * 33], s[3 * 33]); o.z = pk2(s[4 * 33], s[5 * 33]); o.w = pk2(s[6 * 33], s[7 * 33]);
        const int ng = n0 + n; const int drow = (G == 0) ? ng : ((ng / G) * 2 * G + which * G + (ng % G));
        *(u32x4*)(WT + (size_t)drow * K + k0 + 8 * c) = o; }
    LDS_WAIT(); asm volatile("" ::: "memory");
}
__device__ __forceinline__ void transpose_item_fp8(const float* W, int K, int N, unsigned char* WT, int G, int which, float scale, LAS float* scr, int item, int lane) {
    const int nblk = N / 32, kb = item / nblk, nb = item % nblk, k0 = 64 * kb, n0 = 32 * nb;
    float v[32];
#pragma unroll
    for (int i = 0; i < 32; ++i) { const int kk = 2 * i + (lane >> 5); v[i] = __builtin_nontemporal_load(W + (size_t)(k0 + kk) * N + n0 + (lane & 31)); }
#pragma unroll
    for (int i = 0; i < 32; ++i) { const int kk = 2 * i + (lane >> 5); scr[kk * 33 + (lane & 31)] = v[i] * scale; }
    LDS_WAIT(); asm volatile("" ::: "memory");
    const int c = lane & 7;
#pragma unroll
    for (int j = 0; j < 4; ++j) { const int n = (lane >> 3) + 8 * j; const LAS float* sp = scr + (8 * c) * 33 + n;
        int w0 = __builtin_amdgcn_cvt_pk_fp8_f32(clamp8(sp[0 * 33]), clamp8(sp[1 * 33]), 0, false); w0 = __builtin_amdgcn_cvt_pk_fp8_f32(clamp8(sp[2 * 33]), clamp8(sp[3 * 33]), w0, true);
        int w1 = __builtin_amdgcn_cvt_pk_fp8_f32(clamp8(sp[4 * 33]), clamp8(sp[5 * 33]), 0, false); w1 = __builtin_amdgcn_cvt_pk_fp8_f32(clamp8(sp[6 * 33]), clamp8(sp[7 * 33]), w1, true);
        const int ng = n0 + n; const int drow = (G == 0) ? ng : ((ng / G) * 2 * G + which * G + (ng % G));
        u32x2 o; o.x = (unsigned)w0; o.y = (unsigned)w1; *(u32x2*)(WT + (size_t)drow * K + k0 + 8 * c) = o; }
    LDS_WAIT(); asm volatile("" ::: "memory");
}
__device__ __forceinline__ void rope_entry(float* tab, int idx) {
    const int t = idx >> 6, i = idx & 63;
    const float inv_freq = powf(10000.f, -(float)(2 * i) / 128.f);
    const float ang = (float)t * inv_freq;
    const double a = (double)ang; const double two_pi = 6.283185307179586476925286766559;
    const double kf = rint(a / two_pi); double r = a - kf * two_pi;
    double sgn = 1.0; if (r > 1.5707963267948966) { r = 3.141592653589793 - r; sgn = -1.0; } else if (r < -1.5707963267948966) { r = -3.141592653589793 - r; sgn = -1.0; }
    const double r2 = r * r;
    const double s = r * (1.0 + r2 * (-1.0 / 6 + r2 * (1.0 / 120 + r2 * (-1.0 / 5040 + r2 * (1.0 / 362880 + r2 * (-1.0 / 39916800 + r2 * (1.0 / 6227020800.0 + r2 * (-1.0 / 1307674368000.0))))))));
    const double c = 1.0 + r2 * (-0.5 + r2 * (1.0 / 24 + r2 * (-1.0 / 720 + r2 * (1.0 / 40320 + r2 * (-1.0 / 3628800 + r2 * (1.0 / 479001600.0 + r2 * (-1.0 / 87178291200.0 + r2 * (1.0 / 20922789888000.0))))))));
    tab[idx] = (float)(sgn * c); tab[SEQ * 64 + idx] = (float)s;
}
__device__ __forceinline__ void mod_task(const float* __restrict__ cin, const float* __restrict__ w_ada, float* __restrict__ modp, int task, int lane) {
    const int cbk = task % 96, kc = task / 96, j = cbk * 64 + lane, k0 = kc * 64;
    float acc[32], cv[32];
#pragma unroll
    for (int b = 0; b < 32; ++b) { acc[b] = 0.f; cv[b] = silu_f(cin[b * D + k0 + lane]); }
#pragma unroll
    for (int kb = 0; kb < 4; ++kb) {
        float w[16];
#pragma unroll
        for (int i = 0; i < 16; ++i) w[i] = w_ada[(size_t)(k0 + kb * 16 + i) * 6144 + j];
#pragma unroll
        for (int i = 0; i < 16; ++i)
#pragma unroll
            for (int b = 0; b < 32; ++b) acc[b] += __builtin_bit_cast(float, __builtin_amdgcn_readlane(__builtin_bit_cast(int, cv[b]), kb * 16 + i)) * w[i];
    }
#pragma unroll
    for (int b = 0; b < 32; ++b) modp[((size_t)kc * 32 + b) * 6144 + j] = acc[b];
}
__device__ __forceinline__ float mod_sum(const float* __restrict__ modp, const float* __restrict__ b_ada, int b, int j) {
    float s = 0.f;
#pragma unroll
    for (int kc = 0; kc < 16; ++kc) s += modp[((size_t)kc * 32 + b) * 6144 + j];
    return s + b_ada[j];
}

namespace ret {
typedef short s16x4 __attribute__((ext_vector_type(4)));
typedef __bf16 bfx2 __attribute__((ext_vector_type(2)));
constexpr unsigned RS = 288, TILE = 128 * RS, LK = 0, LV = TILE, LRF = 2 * TILE, LRB = 3 * TILE;
constexpr float LOG2E = 1.4426950408889634f;
__device__ __forceinline__ unsigned offb(unsigned row, unsigned ch) { return RS * row + 16u * ch; }
__device__ __forceinline__ unsigned cvtpk(float lo, float hi) { const f32x2 v = {lo, hi}; return __builtin_bit_cast(unsigned, __builtin_convertvector(v, bfx2)); }
__device__ __forceinline__ bf16x8 pack8(const float (&f)[8]) { u32x4 u; u.x = cvtpk(f[0], f[1]); u.y = cvtpk(f[2], f[3]); u.z = cvtpk(f[4], f[5]); u.w = cvtpk(f[6], f[7]); return __builtin_bit_cast(bf16x8, u); }
__device__ __forceinline__ void unpack8(const bf16x8 v, float (&f)[8]) { const u32x4 u = __builtin_bit_cast(u32x4, v);
    f[0] = __uint_as_float(u.x << 16); f[1] = __uint_as_float(u.x & 0xffff0000u); f[2] = __uint_as_float(u.y << 16); f[3] = __uint_as_float(u.y & 0xffff0000u);
    f[4] = __uint_as_float(u.z << 16); f[5] = __uint_as_float(u.z & 0xffff0000u); f[6] = __uint_as_float(u.w << 16); f[7] = __uint_as_float(u.w & 0xffff0000u); }
__device__ __forceinline__ bf16x8 trfrag(LAS unsigned char* base, unsigned row0, unsigned row1, unsigned cblk, unsigned qp, unsigned p) {
    const unsigned ch = 2u * cblk + (p >> 1), bo = 8u * (p & 1u);
    const s16x4 lo = __builtin_amdgcn_ds_read_tr16_b64_v4i16((LAS s16x4*)(base + offb(row0 + qp, ch) + bo));
    const s16x4 hi = __builtin_amdgcn_ds_read_tr16_b64_v4i16((LAS s16x4*)(base + offb(row1 + qp, ch) + bo));
    return __builtin_shufflevector(lo, hi, 0, 1, 2, 3, 4, 5, 6, 7);
}
struct KVRaw { bf16x8 ka[2], kb[2], v[4]; f32x4 c0[2], c1[2], s0[2], s1[2]; };
__device__ __forceinline__ void kv_load(KVRaw& R, const bf16_t* __restrict__ proj, const float* __restrict__ rope, int b, int h, int n, int tid) {
#pragma unroll
    for (int i = 0; i < 2; ++i) {
        const int q2 = tid + 512 * i, row = q2 >> 3, pc = q2 & 7, t = n * 128 + row;
        const bf16_t* rp = proj + (size_t)(b * SEQ + t) * DIN + OFF_KR + h * 128;
        R.ka[i] = *(const bf16x8*)(rp + pc * 8); R.kb[i] = *(const bf16x8*)(rp + 64 + pc * 8);
        R.c0[i] = *(const f32x4*)(rope + t * 64 + pc * 8); R.c1[i] = *(const f32x4*)(rope + t * 64 + pc * 8 + 4);
        R.s0[i] = *(const f32x4*)(rope + SEQ * 64 + t * 64 + pc * 8); R.s1[i] = *(const f32x4*)(rope + SEQ * 64 + t * 64 + pc * 8 + 4);
    }
#pragma unroll
    for (int i = 0; i < 4; ++i) { const int q4 = tid + 512 * i, row = q4 >> 4, ch = q4 & 15, t = n * 128 + row;
        R.v[i] = *(const bf16x8*)(proj + (size_t)(b * SEQ + t) * DIN + OFF_VR + h * 128 + ch * 8); }
}
__device__ __forceinline__ void kv_store(LAS unsigned char* lds, const KVRaw& R, int tid) {
#pragma unroll
    for (int i = 0; i < 2; ++i) {
        const int q2 = tid + 512 * i, row = q2 >> 3, pc = q2 & 7;
        float fa[8], fb[8], o1[8], o2[8];
        unpack8(R.ka[i], fa); unpack8(R.kb[i], fb);
        const float cs[8] = {R.c0[i].x, R.c0[i].y, R.c0[i].z, R.c0[i].w, R.c1[i].x, R.c1[i].y, R.c1[i].z, R.c1[i].w}, sn[8] = {R.s0[i].x, R.s0[i].y, R.s0[i].z, R.s0[i].w, R.s1[i].x, R.s1[i].y, R.s1[i].z, R.s1[i].w};
#pragma unroll
        for (int e = 0; e < 8; ++e) { o1[e] = fa[e] * cs[e] - fb[e] * sn[e]; o2[e] = fb[e] * cs[e] + fa[e] * sn[e]; }
        *(LAS bf16x8*)(lds + LK + offb(row, pc)) = pack8(o1); *(LAS bf16x8*)(lds + LK + offb(row, pc + 8)) = pack8(o2);
    }
#pragma unroll
    for (int i = 0; i < 4; ++i) { const int q4 = tid + 512 * i, row = q4 >> 4, ch = q4 & 15; *(LAS bf16x8*)(lds + LV + offb(row, ch)) = R.v[i]; }
}
__device__ __forceinline__ void rb_dma(LAS unsigned char* lds, const unsigned char* img, int w, int lane) {
#pragma unroll
    for (int i = 0; i < 5; ++i) { const int o = w + 8 * i; if (o < (int)TILE / 1024)
        __builtin_amdgcn_global_load_lds((const unsigned*)(img + o * 1024 + lane * 16), (LAS unsigned*)(lds + LRB + o * 1024), 16, 0, 0); }
}
template <bool FWD> __device__ __forceinline__ void state_update(LAS unsigned char* lds, f32x4 (&racc)[8], float l2, int w, int g, unsigned qp, unsigned p) {
    const float dec = __builtin_amdgcn_exp2f(128.f * l2);
    bf16x8 vs[4];
#pragma unroll
    for (int ks = 0; ks < 4; ++ks) {
        float f[8]; unpack8(trfrag(lds + LV, 32 * ks + 4 * g, 32 * ks + 16 + 4 * g, w, qp, p), f);
#pragma unroll
        for (int e = 0; e < 8; ++e) { const int key = 32 * ks + 16 * (e >> 2) + 4 * g + (e & 3); f[e] *= __builtin_amdgcn_exp2f((FWD ? (float)(127 - key) : (float)key) * l2); }
        vs[ks] = pack8(f);
    }
#pragma unroll
    for (int nb = 0; nb < 8; ++nb) {
        racc[nb] = racc[nb] * dec;
#pragma unroll
        for (int ks = 0; ks < 4; ++ks) racc[nb] = __builtin_amdgcn_mfma_f32_16x16x32_bf16(vs[ks], trfrag(lds + LK, 32 * ks + 4 * g, 32 * ks + 16 + 4 * g, nb, qp, p), racc[nb], 0, 0, 0);
    }
}
__device__ __forceinline__ void unit(const bf16_t* __restrict__ proj, const float* __restrict__ rope, const float* __restrict__ log_decay, const float* __restrict__ gn_g, bf16_t* __restrict__ ymix,
                                     unsigned char* __restrict__ scratch  , LAS unsigned char* lds, int hu, const int tid_in) {
    const int u = hu >> 1, n0 = (hu & 1) * 8, n1 = n0 + 8;
    const int b = u >> 2, h = u & 3;
    int tid_ = tid_in; asm volatile("" : "+v"(tid_));
    const int tid0 = tid_, w = __builtin_amdgcn_readfirstlane(tid0 >> 6);
#define RET_LANE int tid = tid0; asm volatile("" : "+v"(tid)); const int lane = tid & 63, r = lane & 15, g = lane >> 4; const unsigned qp = (unsigned)r >> 2, p = (unsigned)lane & 3u;
    const float lf2_ = log_decay[h] * LOG2E, lb2_ = log_decay[4 + h] * LOG2E;
    f32x4 racc[8];
#pragma unroll
    for (int nb = 0; nb < 8; ++nb) racc[nb] = (f32x4){0.f, 0.f, 0.f, 0.f};
    KVRaw raw;
    kv_load(raw, proj, rope, b, h, 15, tid0);
    for (int n = 15; n >= n0; --n) {
        RET_LANE
        if (n < n1) {
            unsigned char* img = scratch + (size_t)(n - n0) * TILE;
#pragma unroll
            for (int nb = 0; nb < 8; ++nb) { u32x2 o; o.x = cvtpk(racc[nb][0], racc[nb][1]); o.y = cvtpk(racc[nb][2], racc[nb][3]);
                *(u32x2*)(img + offb(16 * nb + r, 2 * w + (g >> 1)) + 8 * (g & 1)) = o; }
        }
        if (n == n0) break;
        float lb2 = lb2_; asm volatile("" : "+v"(lb2));
        __syncthreads();
        kv_store(lds, raw, tid);
        __syncthreads();
        kv_load(raw, proj, rope, b, h, n - 1 > n0 ? n - 1 : 0, tid);
        state_update<false>(lds, racc, lb2, w, g, qp, p);
    }
    asm volatile("s_waitcnt vmcnt(0)" ::: "memory");
    __syncthreads();
    __builtin_amdgcn_fence(__ATOMIC_ACQUIRE, "agent");
    asm volatile("s_waitcnt vmcnt(0)" ::: "memory");
#pragma unroll
    for (int nb = 0; nb < 8; ++nb) racc[nb] = (f32x4){0.f, 0.f, 0.f, 0.f};
    for (int n = 0; n < n0; ++n) {
        RET_LANE
        float lf2 = lf2_; asm volatile("" : "+v"(lf2));
        __syncthreads();
        kv_store(lds, raw, tid);
        __syncthreads();
        kv_load(raw, proj, rope, b, h, n + 1, tid);
        state_update<true>(lds, racc, lf2, w, g, qp, p);
    }
    rb_dma(lds, scratch, w, tid0 & 63);
    for (int n = n0; n < n1; ++n) {
        RET_LANE
        float lf2 = lf2_, lb2 = lb2_; asm volatile("" : "+v"(lf2), "+v"(lb2));
        const float* gnp = gn_g; asm volatile("" : "+s"(gnp));
        __syncthreads();
        kv_store(lds, raw, tid);
#pragma unroll
        for (int nb = 0; nb < 8; ++nb) { u32x2 o; o.x = cvtpk(racc[nb][0], racc[nb][1]); o.y = cvtpk(racc[nb][2], racc[nb][3]);
            *(LAS u32x2*)(lds + LRF + offb(16 * nb + r, 2 * w + (g >> 1)) + 8 * (g & 1)) = o; }
        const int cq = 16 * w + r, tq = n * 128 + cq;
        bf16x8 qn[4], qf[4], qb[4];
        { const bf16_t* rp = proj + (size_t)(b * SEQ + tq) * DIN + OFF_QR + h * 128 + 4 * g;
          const float sf = __builtin_amdgcn_exp2f((float)(cq + 1) * lf2), sb = __builtin_amdgcn_exp2f((float)(128 - cq) * lb2);
#pragma unroll
          for (int ks = 0; ks < 2; ++ks) {
              float fa[8], fb[8], o1[8], o2[8], t1[8], t2[8];
              { const u32x2 a0 = *(const u32x2*)(rp + 32 * ks), a1 = *(const u32x2*)(rp + 32 * ks + 16), b0 = *(const u32x2*)(rp + 32 * ks + 64), b1 = *(const u32x2*)(rp + 32 * ks + 80);
                unpack8(__builtin_bit_cast(bf16x8, (u32x4){a0.x, a0.y, a1.x, a1.y}), fa); unpack8(__builtin_bit_cast(bf16x8, (u32x4){b0.x, b0.y, b1.x, b1.y}), fb); }
              const float* cp = rope + tq * 64 + 32 * ks + 4 * g; const float* sp = cp + SEQ * 64;
              const f32x4 c0 = *(const f32x4*)cp, c1 = *(const f32x4*)(cp + 16), s0 = *(const f32x4*)sp, s1 = *(const f32x4*)(sp + 16);
              const float cs[8] = {c0.x, c0.y, c0.z, c0.w, c1.x, c1.y, c1.z, c1.w}, sn[8] = {s0.x, s0.y, s0.z, s0.w, s1.x, s1.y, s1.z, s1.w};
#pragma unroll
              for (int e = 0; e < 8; ++e) { o1[e] = fa[e] * cs[e] - fb[e] * sn[e]; o2[e] = fb[e] * cs[e] + fa[e] * sn[e]; }
              qn[ks] = pack8(o1); qn[ks + 2] = pack8(o2);
#pragma unroll
              for (int e = 0; e < 8; ++e) { t1[e] = o1[e] * sf; t2[e] = o2[e] * sf; }
              qf[ks] = pack8(t1); qf[ks + 2] = pack8(t2);
#pragma unroll
              for (int e = 0; e < 8; ++e) { t1[e] = o1[e] * sb; t2[e] = o2[e] * sb; }
              qb[ks] = pack8(t1); qb[ks + 2] = pack8(t2);
          } }
        asm volatile("s_waitcnt vmcnt(0)" ::: "memory");
        __syncthreads();
        kv_load(raw, proj, rope, b, h, n + 1 < n1 ? n + 1 : n, tid);
        u32x2 gv[8];
        { const bf16_t* gp = proj + (size_t)(b * SEQ + tq) * DIN + OFF_GR + h * 128 + 4 * g;
#pragma unroll
          for (int mbv = 0; mbv < 8; ++mbv) gv[mbv] = *(const u32x2*)(gp + 16 * mbv); }
        bf16x8 pt[4];
#pragma unroll
        for (int ks2 = 0; ks2 < 4; ++ks2) {
            float pv[8];
#pragma unroll
            for (int hb = 0; hb < 2; ++hb) {
                const int mb = 2 * ks2 + hb;
                f32x4 st = (f32x4){0.f, 0.f, 0.f, 0.f};
#pragma unroll
                for (int ks = 0; ks < 4; ++ks) { const LAS unsigned char* kp = lds + LK + RS * (16 * mb + r) + 64 * ks + 8 * g; const u32x2 k0 = *(const LAS u32x2*)kp, k1 = *(const LAS u32x2*)(kp + 32);
                    st = __builtin_amdgcn_mfma_f32_16x16x32_bf16(__builtin_bit_cast(bf16x8, (u32x4){k0.x, k0.y, k1.x, k1.y}), qn[ks], st, 0, 0, 0); }
#pragma unroll
                for (int j = 0; j < 4; ++j) { const int diff = cq - (16 * mb + 4 * g + j); pv[4 * hb + j] = st[j] * __builtin_amdgcn_exp2f(diff >= 0 ? (float)diff * lf2 : (float)(-diff) * lb2); }
            }
            pt[ks2] = pack8(pv);
        }
        f32x4 yacc[8];
#pragma unroll
        for (int mbv = 0; mbv < 8; ++mbv) {
            f32x4 y = (f32x4){0.f, 0.f, 0.f, 0.f};
#pragma unroll
            for (int ks2 = 0; ks2 < 4; ++ks2) y = __builtin_amdgcn_mfma_f32_16x16x32_bf16(trfrag(lds + LV, 32 * ks2 + 4 * g, 32 * ks2 + 16 + 4 * g, mbv, qp, p), pt[ks2], y, 0, 0, 0);
#pragma unroll
            for (int ks = 0; ks < 4; ++ks) {
                y = __builtin_amdgcn_mfma_f32_16x16x32_bf16(trfrag(lds + LRF, 32 * ks + 4 * g, 32 * ks + 16 + 4 * g, mbv, qp, p), qf[ks], y, 0, 0, 0);
                y = __builtin_amdgcn_mfma_f32_16x16x32_bf16(trfrag(lds + LRB, 32 * ks + 4 * g, 32 * ks + 16 + 4 * g, mbv, qp, p), qb[ks], y, 0, 0, 0);
            }
            yacc[mbv] = y;
        }
        __syncthreads();
        if (n + 1 < n1) rb_dma(lds, scratch + (size_t)(n + 1 - n0) * TILE, w, lane);
        { float s = 0.f;
#pragma unroll
          for (int mbv = 0; mbv < 8; ++mbv) s += (yacc[mbv][0] + yacc[mbv][1]) + (yacc[mbv][2] + yacc[mbv][3]);
          s += __shfl_xor(s, 16); s += __shfl_xor(s, 32);
          const float mu = s * (1.f / 128.f); float s2 = 0.f;
#pragma unroll
          for (int mbv = 0; mbv < 8; ++mbv) { yacc[mbv] = yacc[mbv] - mu; s2 += (yacc[mbv][0] * yacc[mbv][0] + yacc[mbv][1] * yacc[mbv][1]) + (yacc[mbv][2] * yacc[mbv][2] + yacc[mbv][3] * yacc[mbv][3]); }
          s2 += __shfl_xor(s2, 16); s2 += __shfl_xor(s2, 32);
          const float rstd = 1.f / sqrtf(s2 * (1.f / 128.f) + GN_EPS);
          bf16_t* op = ymix + (size_t)(b * SEQ + tq) * D + 512 + h * 128 + 4 * g;
#pragma unroll
          for (int mbv = 0; mbv < 8; ++mbv) {
              const f32x4 gn = *(const f32x4*)(gnp + h * 128 + 16 * mbv + 4 * g);
              const float g0 = __uint_as_float(gv[mbv].x << 16), g1 = __uint_as_float(gv[mbv].x & 0xffff0000u), g2 = __uint_as_float(gv[mbv].y << 16), g3 = __uint_as_float(gv[mbv].y & 0xffff0000u);
              u32x2 o; o.x = cvtpk(silu_f(g0) * (yacc[mbv][0] * rstd * gn.x), silu_f(g1) * (yacc[mbv][1] * rstd * gn.y));
              o.y = cvtpk(silu_f(g2) * (yacc[mbv][2] * rstd * gn.z), silu_f(g3) * (yacc[mbv][3] * rstd * gn.w));
              *(u32x2*)(op + 16 * mbv) = o;
          } }
        state_update<true>(lds, racc, lf2, w, g, qp, p);
    }
    __syncthreads();
#undef RET_LANE
}
}


namespace na {
constexpr unsigned LKR = 0, LVR = 73728, LRPB = 147456;
__device__ __forceinline__ void load_row(LAS unsigned char* lds, const bf16_t* __restrict__ proj, int b, int head, int krow, int tid) {
    const int key = tid >> 3, ch = tid & 7, slot = krow % 9;
    const bf16_t* rp = proj + (size_t)(b * SEQ + krow * 64 + key) * DIN + head * 64 + ch * 8;
    const unsigned o = (unsigned)slot * 8192u + 128u * key + 16u * (ch ^ (key & 7));
    *(LAS u32x4*)(lds + LKR + o) = *(const u32x4*)(rp + OFF_KNA);
    *(LAS u32x4*)(lds + LVR + o) = *(const u32x4*)(rp + OFF_VNA);
}
__device__ __forceinline__ void unit(const bf16_t* __restrict__ proj, const float* __restrict__ rpb, bf16_t* __restrict__ ymix, LAS unsigned char* lds, int u, const int tid_in) {
    const int b = u >> 3, head = u & 7;
    int tid_ = tid_in; asm volatile("" : "+v"(tid_));
    const int tid0 = tid_, w = __builtin_amdgcn_readfirstlane(tid0 >> 6);
    __syncthreads();
    if (tid0 < 465) ((LAS float*)(lds + LRPB))[tid0] = rpb[head * 465 + tid0];
    const int ct = w & 3, cb = (ct == 0) ? 0 : (ct == 1 ? 8 : (ct == 2 ? 24 : 32));
    u32x4 pk[2], pv2[2]; int pre_lo = 0, pre_n = 0;
    for (int st = 0; st < 16; ++st) {
        int tid = tid0; asm volatile("" : "+v"(tid));
        const int lane = tid & 63, qi = lane & 15, g = lane >> 4; const unsigned qp = (unsigned)qi >> 2, p = (unsigned)lane & 3u;
        const int r = 2 * st + (w >> 2);
        const int rs = min(max(r - 4, 0), 24);
        const int need_hi = min(max(2 * st + 1 - 4, 0), 24) + 7;
        __syncthreads();
        if (st == 0) { for (int kr = 0; kr <= need_hi; ++kr) load_row(lds, proj, b, head, kr, tid); }
        else {
#pragma unroll
            for (int i = 0; i < 2; ++i) if (i < pre_n) { const int key = tid >> 3, ch = tid & 7; const unsigned o = (unsigned)((pre_lo + i) % 9) * 8192u + 128u * key + 16u * (ch ^ (key & 7));
                *(LAS u32x4*)(lds + LKR + o) = pk[i]; *(LAS u32x4*)(lds + LVR + o) = pv2[i]; }
        }
        const int cq = 16 * ct + qi, tq = b * SEQ + r * 64 + cq;
        bf16x8 qn[2];
        { const bf16_t* qptr = proj + (size_t)tq * DIN + OFF_QNA + head * 64 + 8 * g; qn[0] = *(const bf16x8*)qptr; qn[1] = *(const bf16x8*)(qptr + 32); }
        __syncthreads();
        { const int nh = (st < 15) ? min(max(2 * st + 3 - 4, 0), 24) + 7 : need_hi; pre_lo = need_hi + 1; pre_n = nh - need_hi;
#pragma unroll
          for (int i = 0; i < 2; ++i) if (i < pre_n) { const int key = tid >> 3, ch = tid & 7; const bf16_t* rp = proj + (size_t)(b * SEQ + (pre_lo + i) * 64 + key) * DIN + head * 64 + ch * 8;
              pk[i] = *(const u32x4*)(rp + OFF_KNA); pv2[i] = *(const u32x4*)(rp + OFF_VNA); } }
        const int cs = min(max(cq - 8, 0), 48);
        const unsigned kb0 = 128u * qi + 16u * ((unsigned)g ^ ((unsigned)qi & 7u)), kb1 = 128u * qi + 16u * ((4u + (unsigned)g) ^ ((unsigned)qi & 7u));
        const LAS float* bias = (const LAS float*)(lds + LRPB);
        f32x4 sc[16]; float mx = -3.0e38f;
#pragma unroll
        for (int kr = 0; kr < 8; ++kr) {
            const int krow = rs + kr; const unsigned so = (unsigned)(krow % 9) * 8192u + 128u * (unsigned)cb;
            const int dr = krow - r + 7;
#pragma unroll
            for (int h2 = 0; h2 < 2; ++h2) {
                f32x4 a = (f32x4){0.f, 0.f, 0.f, 0.f};
                a = __builtin_amdgcn_mfma_f32_16x16x32_bf16(*(const LAS bf16x8*)(lds + LKR + so + 2048u * h2 + kb0), qn[0], a, 0, 0, 0);
                a = __builtin_amdgcn_mfma_f32_16x16x32_bf16(*(const LAS bf16x8*)(lds + LKR + so + 2048u * h2 + kb1), qn[1], a, 0, 0, 0);
#pragma unroll
                for (int j = 0; j < 4; ++j) {
                    const int kcol = cb + 16 * h2 + 4 * g + j;
                    const int dc = min(max(kcol - cq + 15, 0), 30);
                    const float v = a[j] + bias[dr * 31 + dc];
                    const bool in = (kcol >= cs) && (kcol < cs + 16);
                    a[j] = in ? v : -3.0e38f; mx = fmaxf(mx, a[j]);
                }
                sc[2 * kr + h2] = a;
            }
        }
        mx = fmaxf(mx, __shfl_xor(mx, 16)); mx = fmaxf(mx, __shfl_xor(mx, 32));
        float sum = 0.f; bf16x8 pt[8];
#pragma unroll
        for (int kk = 0; kk < 8; ++kk) {
            float pv[8];
#pragma unroll
            for (int h2 = 0; h2 < 2; ++h2)
#pragma unroll
                for (int j = 0; j < 4; ++j) { const float e = __builtin_amdgcn_exp2f((sc[2 * kk + h2][j] - mx) * 1.4426950408889634f); pv[4 * h2 + j] = e; sum += e; }
            pt[kk] = ret::pack8(pv);
        }
        sum += __shfl_xor(sum, 16); sum += __shfl_xor(sum, 32);
        const float inv = 1.f / sum;
        const unsigned sl = (((unsigned)g & 1u) << 2) | qp;
        bf16_t* op = ymix + (size_t)tq * D + head * 64 + 4 * g;
#pragma unroll
        for (int db = 0; db < 4; ++db) {
            const unsigned vb = 128u * (4u * (unsigned)g + qp) + 16u * ((2u * db + (p >> 1)) ^ sl) + 8u * (p & 1u);
            f32x4 y = (f32x4){0.f, 0.f, 0.f, 0.f};
#pragma unroll
            for (int kk = 0; kk < 8; ++kk) {
                const unsigned so = (unsigned)((rs + kk) % 9) * 8192u + 128u * (unsigned)cb;
                const ret::s16x4 lo = __builtin_amdgcn_ds_read_tr16_b64_v4i16((LAS ret::s16x4*)(lds + LVR + so + vb));
                const ret::s16x4 hi = __builtin_amdgcn_ds_read_tr16_b64_v4i16((LAS ret::s16x4*)(lds + LVR + so + 2048u + vb));
                y = __builtin_amdgcn_mfma_f32_16x16x32_bf16(__builtin_shufflevector(lo, hi, 0, 1, 2, 3, 4, 5, 6, 7), pt[kk], y, 0, 0, 0);
            }
            u32x2 o; o.x = ret::cvtpk(y[0] * inv, y[1] * inv); o.y = ret::cvtpk(y[2] * inv, y[3] * inv);
            *(u32x2*)(op + 16 * db) = o;
        }
    }
    __syncthreads();
}
}

__device__ __forceinline__ void ln1_row(const float* __restrict__ io, const float* __restrict__ g, const float* __restrict__ bb, const float* __restrict__ mod, bf16_t* __restrict__ hf, unsigned char* __restrict__ hf8, float* __restrict__ stats, int row, int lane) {
    const int b = row >> 11;
    f32x4 v[4]; float s = 0.f;
#pragma unroll
    for (int j = 0; j < 4; ++j) { v[j] = *(const f32x4*)(io + (size_t)row * D + j * 256 + lane * 4); s += (v[j].x + v[j].y) + (v[j].z + v[j].w); }
    const float mean = wave_sum(s) * (1.f / D); float s2 = 0.f;
#pragma unroll
    for (int j = 0; j < 4; ++j) { v[j] = v[j] - mean; s2 += (v[j].x * v[j].x + v[j].y * v[j].y) + (v[j].z * v[j].z + v[j].w * v[j].w); }
    const float rstd = 1.f / sqrtf(wave_sum(s2) * (1.f / D) + LN_EPS);
    if (lane == 0) *(f32x2*)(stats + 2 * (size_t)row) = (f32x2){mean, rstd};
#pragma unroll
    for (int j = 0; j < 4; ++j) { const int col = j * 256 + lane * 4;
        const f32x4 gg = *(const f32x4*)(g + col), bv = *(const f32x4*)(bb + col);
        const f32x4 x1 = v[j] * rstd * gg + bv;
        const f32x4 sc = *(const f32x4*)(mod + b * 6144 + MOD_SCALE_F + col), sh = *(const f32x4*)(mod + b * 6144 + MOD_SHIFT_F + col);
        u32x2 o; o.x = pk2(x1.x * (1.f + sc.x) + sh.x, x1.y * (1.f + sc.y) + sh.y); o.y = pk2(x1.z * (1.f + sc.z) + sh.z, x1.w * (1.f + sc.w) + sh.w);
        *(u32x2*)(hf + (size_t)row * D + col) = o;
        const f32x4 h4 = (x1 * (sc + 1.f) + sh) * S_HF8;
        int w0 = __builtin_amdgcn_cvt_pk_fp8_f32(clamp8(h4.x), clamp8(h4.y), 0, false); w0 = __builtin_amdgcn_cvt_pk_fp8_f32(clamp8(h4.z), clamp8(h4.w), w0, true);
        *(unsigned*)(hf8 + (size_t)row * D + col) = (unsigned)w0; }
}
__device__ __forceinline__ void top2_merge(float& a1, float& a2, float b1, float b2) { const float n1 = fmaxf(a1, b1); const float n2 = fmaxf(fminf(a1, b1), fmaxf(a2, b2)); a1 = n1; a2 = n2; }
__device__ __forceinline__ void route_token(const float* __restrict__ logits, const f32x4 bias, int* __restrict__ topk_e, float* __restrict__ topk_w, LAS unsigned* hist, int tok, int lane) {
    const f32x4 lg = *(const f32x4*)(logits + (size_t)tok * NE + lane * 4);
    const float sc0 = 1.f / (1.f + __expf(-lg.x)), sc1 = 1.f / (1.f + __expf(-lg.y)), sc2 = 1.f / (1.f + __expf(-lg.z)), sc3 = 1.f / (1.f + __expf(-lg.w));
    float s0 = sc0 + bias.x, s1 = sc1 + bias.y, s2 = sc2 + bias.z, s3 = sc3 + bias.w;
    float m1 = fmaxf(s0, s1), m2 = fminf(s0, s1); top2_merge(m1, m2, fmaxf(s2, s3), fminf(s2, s3));
#pragma unroll
    for (int o = 1; o < 8; o <<= 1) { const float b1 = __shfl_xor(m1, o), b2 = __shfl_xor(m2, o); top2_merge(m1, m2, b1, b2); }
    const float gs = m1 + m2; const int grp = lane >> 3;
    int rank = 0;
#pragma unroll
    for (int gq = 0; gq < 8; ++gq) { const float og = __shfl(gs, gq * 8); rank += (og > gs || (og == gs && gq < grp)) ? 1 : 0; }
    const float NEG = -3.0e38f;
    if (rank >= 4) { s0 = NEG; s1 = NEG; s2 = NEG; s3 = NEG; }
    float wsum = 0.f; float myw = 0.f; int mye = 0;
#pragma unroll
    for (int k = 0; k < TOPK; ++k) {
        float bv = s0; int bi = 0;
        if (s1 > bv) { bv = s1; bi = 1; }
        if (s2 > bv) { bv = s2; bi = 2; }
        if (s3 > bv) { bv = s3; bi = 3; }
        int be = lane * 4 + bi;
#pragma unroll
        for (int o = 1; o < 64; o <<= 1) { const float ov = __shfl_xor(bv, o); const int oe = __shfl_xor(be, o); if (ov > bv || (ov == bv && oe < be)) { bv = ov; be = oe; } }
        const int ol = be >> 2, oj = be & 3;
        const float mysc = oj == 0 ? sc0 : (oj == 1 ? sc1 : (oj == 2 ? sc2 : sc3));
        const float wsel = __shfl(mysc, ol);
        if (lane == ol) { if (oj == 0) s0 = NEG; else if (oj == 1) s1 = NEG; else if (oj == 2) s2 = NEG; else s3 = NEG; }
        wsum += wsel;
        if (lane == k) { myw = wsel; mye = be; }
    }
    if (lane < TOPK) { topk_e[tok * TOPK + lane] = mye; topk_w[tok * TOPK + lane] = myw / wsum * 2.5f; __hip_atomic_fetch_add(&hist[mye], 1u, __ATOMIC_RELAXED, __HIP_MEMORY_SCOPE_WORKGROUP); }
}
__device__ __forceinline__ void build_tables(const unsigned* ctl, LAS unsigned* tab, const int tid) {
    if (tid < 64) {
        const int lane = tid;
        unsigned c[4], so = 0, st = 0;
#pragma unroll
        for (int j = 0; j < 4; ++j) { c[j] = __hip_atomic_load(ctl + CW_COUNT + lane * 4 + j, __ATOMIC_RELAXED, __HIP_MEMORY_SCOPE_AGENT); so += c[j]; st += (c[j] + 255u) >> 8; }
        unsigned io = so, it = st;
#pragma unroll
        for (int o = 1; o < 64; o <<= 1) { const unsigned a = __shfl_up(io, o), b = __shfl_up(it, o); if (lane >= o) { io += a; it += b; } }
        unsigned eo = io - so, et = it - st;
#pragma unroll
        for (int j = 0; j < 4; ++j) { tab[T_CNT + lane * 4 + j] = c[j]; tab[T_OFF + lane * 4 + j] = eo; tab[T_TILE + lane * 4 + j] = et; eo += c[j]; et += (c[j] + 255u) >> 8; }
        if (lane == 63) { tab[T_OFF + NE] = eo; tab[T_TILE + NE] = et; }
    }
    __syncthreads();
}
__device__ __forceinline__ void final_row(float* __restrict__ io, const unsigned char* __restrict__ ybuf, const unsigned char* __restrict__ ysh, const float* __restrict__ g, const float* __restrict__ bb, const float* __restrict__ mod,
                                          const float* __restrict__ g1, const float* __restrict__ b1, const float* __restrict__ stats, int row, int lane) {
    const int b = row >> 11; const f32x2 st1 = *(const f32x2*)(stats + 2 * (size_t)row);
    f32x4 v[4]; float s = 0.f;
#pragma unroll
    for (int j = 0; j < 4; ++j) {
        const int col = j * 256 + lane * 4;
        f32x4 a = (f32x4){0.f, 0.f, 0.f, 0.f};
#pragma unroll
        for (int k = 0; k < TOPK; ++k) {
            const unsigned pk = *(const unsigned*)(ybuf + ((size_t)row * TOPK + k) * D + col);
            const f32x2 lo = __builtin_amdgcn_cvt_pk_f32_fp8((int)pk, false), hi = __builtin_amdgcn_cvt_pk_f32_fp8((int)pk, true);
            a.x += lo.x; a.y += lo.y; a.z += hi.x; a.w += hi.y;
        }
        { const unsigned pk = *(const unsigned*)(ysh + (size_t)row * D + col);
          const f32x2 lo = __builtin_amdgcn_cvt_pk_f32_fp8((int)pk, false), hi = __builtin_amdgcn_cvt_pk_f32_fp8((int)pk, true);
          a.x += lo.x; a.y += lo.y; a.z += hi.x; a.w += hi.y; }
        const f32x4 gt = *(const f32x4*)(mod + b * 6144 + MOD_GATE_F + col);
        const f32x4 x1 = (*(const f32x4*)(io + (size_t)row * D + col) - st1.x) * st1.y * *(const f32x4*)(g1 + col) + *(const f32x4*)(b1 + col);
        v[j] = x1 * ALPHA + gt * a * YINV;
        s += (v[j].x + v[j].y) + (v[j].z + v[j].w);
    }
    const float mean = wave_sum(s) * (1.f / D); float s2 = 0.f;
#pragma unroll
    for (int j = 0; j < 4; ++j) { v[j] = v[j] - mean; s2 += (v[j].x * v[j].x + v[j].y * v[j].y) + (v[j].z * v[j].z + v[j].w * v[j].w); }
    const float rstd = 1.f / sqrtf(wave_sum(s2) * (1.f / D) + LN_EPS);
#pragma unroll
    for (int j = 0; j < 4; ++j) { const int col = j * 256 + lane * 4; const f32x4 gg = *(const f32x4*)(g + col), bv = *(const f32x4*)(bb + col);
        *(f32x4*)(io + (size_t)row * D + col) = v[j] * rstd * gg + bv; }
}

#ifndef MK_PER_PHASE
#define MK_PER_PHASE 0
#endif
constexpr int N_PHASES = 13;
struct Args { Ctx X; int ph_lo, ph_hi; };
typedef __attribute__((address_space(4))) const Ctx* CtxCP;
__device__ __forceinline__ CtxCP ctx_ptr() { CtxCP p = (CtxCP)__builtin_amdgcn_kernarg_segment_ptr(); asm volatile("" : "+s"(p)); return p; }

__global__ void __launch_bounds__(NW * 64, 2) mk_fwd(Args args) {
    extern __shared__ __attribute__((aligned(16))) unsigned char lds_raw[];
    LAS unsigned char* lds = (LAS unsigned char*)lds_raw;
    LAS unsigned* tab = (LAS unsigned*)(lds + TAB_OFF);
    volatile LAS unsigned* MISC = (volatile LAS unsigned*)(lds + MISC_OFF);
#define PH_BEGIN \
    const __attribute__((address_space(4))) Ctx& X = *ctx_ptr(); unsigned char* ws = X.ws; (void)ws; \
    const int lane = lane_id(), wave = wave0, tid = wave0 * 64 + lane; (void)lane; (void)wave; (void)tid; \
    const int G = gridDim.x, bx = blockIdx.x; (void)G; (void)bx; \
    const int gw = bx * NW + wave, NGW = G * NW; (void)gw; (void)NGW; \
    const int gt = bx * (NW * 64) + tid, NGT = G * NW * 64; (void)gt; (void)NGT; \
    unsigned* ctl = (unsigned*)(ws + WS_CTL); float* mod = (float*)(ws + WS_MOD); float* rope = (float*)(ws + WS_ROPE); (void)ctl; (void)mod; (void)rope; \
    bf16_t* win_t = (bf16_t*)(ws + WS_WIN_T); bf16_t* wout_t = (bf16_t*)(ws + WS_WOUT_T); bf16_t* wr_t = (bf16_t*)(ws + WS_WR_T); (void)win_t; (void)wout_t; (void)wr_t; \
    bf16_t* wsgu_t = (bf16_t*)(ws + WS_WSGU_T); bf16_t* wsd_t = (bf16_t*)(ws + WS_WSD_T); bf16_t* wd_t = (bf16_t*)(ws + WS_WD_T); bf16_t* wgu_t = (bf16_t*)(ws + WS_WGU_T); (void)wsgu_t; (void)wsd_t; (void)wd_t; (void)wgu_t; \
    int* slot_ent = (int*)(ws + WS_SLOT_ENT); float* slot_w = (float*)(ws + WS_SLOT_W); int* topk_e = (int*)(ws + WS_TOPK_E); float* topk_w = (float*)(ws + WS_TOPK_W); (void)slot_ent; (void)slot_w; (void)topk_e; (void)topk_w; \
    bf16_t* ymix = (bf16_t*)(ws + WS_YMIX); bf16_t* proj = (bf16_t*)(ws + WS_PROJ); bf16_t* hbuf = (bf16_t*)(ws + WS_YMIX); (void)ymix; (void)proj; (void)hbuf; \
    float* logits = (float*)(ws + WS_LOGITS); bf16_t* shh = (bf16_t*)(ws + WS_SHH); bf16_t* hf = (bf16_t*)(ws + WS_HF); bf16_t* act = (bf16_t*)(ws + WS_ACT); (void)logits; (void)shh; (void)hf; (void)act; \
    unsigned char* ybuf = ws + WS_YBUF; float* out = X.out; (void)ybuf; (void)out;

    const int wave0 = __builtin_amdgcn_readfirstlane((int)threadIdx.x >> 6);
    for (int u = threadIdx.x; u < (LDS_BYTES - MISC_OFF) / 4; u += NW * 64) ((LAS unsigned*)(lds + MISC_OFF))[u] = 0u;
    __syncthreads();
    if (!MK_PER_PHASE) { unsigned* ctl0 = (unsigned*)(args.X.ws + WS_CTL); (void)xcd_barrier_post(ctl0 + CW_BAR, MISC + 8, wave0 == 0 && lane_id() == 0); }
    const int lo = args.ph_lo, hi = args.ph_hi;
#ifndef MK_DUP
#define MK_DUP -1
#endif
#define REPS(k) for (int _rep = 0; _rep < ((MK_DUP == (k)) ? 2 : 1); ++_rep)
#ifdef MK_ONLY
#define IN(k) ((k) == MK_ONLY)
#else
#define IN(k) (lo <= (k) && (k) < hi)
#endif
#define SEAM(k) SEAM2(k, (k) + 1)
#define SEAM2(k, k2) do { if (IN(k) && IN(k2)) { XcdBarrier _b; _b.bar = (unsigned*)(ctx_ptr()->ws + WS_CTL) + CW_BAR; _b.x = xb_xcc_id(); _b.st = (volatile LAS unsigned*)(lds + MISC_OFF) + 8; xcd_barrier(_b, wave0 == 0 && lane_id() == 0); } } while (0)

    REPS(0) if (IN(0)) { PH_BEGIN
        LAS float* scr = (LAS float*)(lds + wave * 16384);
        float* modp = (float*)(ws + WS_PROJ);
        for (int t = gw; t < 96 * 16; t += NGW) mod_task(X.c, X.w_ada, modp, t, lane);
        constexpr int I_IN = (D / 64) * (DIN / 32), I_OUT = (D / 64) * (D / 32), I_R = (D / 64) * (NE / 32), I_SG = (D / 64) * (DE / 32), I_SD = (DE / 64) * (D / 32);
        constexpr int I_EG = I_SG, I_ED = I_SD;
        constexpr int N_SMALL = I_IN + I_OUT + I_R + 2 * I_SG + I_SD;
        constexpr int N_ITEMS = N_SMALL + NE * (2 * I_EG + I_ED);
        for (int it = gw; it < N_ITEMS; it += NGW) {
            int r = it;
            if (r < I_IN) { transpose_item(X.w_in, D, DIN, win_t, 0, 0, scr, r, lane); continue; } r -= I_IN;
            if (r < I_OUT) { transpose_item(X.w_out, D, D, wout_t, 0, 0, scr, r, lane); continue; } r -= I_OUT;
            if (r < I_R) { transpose_item(X.w_router, D, NE, wr_t, 0, 0, scr, r, lane); continue; } r -= I_R;
            if (r < I_SG) { transpose_item(X.ws_gate, D, DE, wsgu_t, 128, 0, scr, r, lane); continue; } r -= I_SG;
            if (r < I_SG) { transpose_item(X.ws_up, D, DE, wsgu_t, 128, 1, scr, r, lane); continue; } r -= I_SG;
            if (r < I_SD) { transpose_item(X.ws_down, DE, D, wsd_t, 0, 0, scr, r, lane); continue; } r -= I_SD;
            const int e = r / (2 * I_EG + I_ED); r -= e * (2 * I_EG + I_ED);
            if (r < I_EG) { transpose_item_fp8(X.w_gate + (size_t)e * D * DE, D, DE, (unsigned char*)wgu_t + (size_t)e * 512 * D, 128, 0, S_WGU8, scr, r, lane); continue; } r -= I_EG;
            if (r < I_EG) { transpose_item_fp8(X.w_up + (size_t)e * D * DE, D, DE, (unsigned char*)wgu_t + (size_t)e * 512 * D, 128, 1, S_WGU8, scr, r, lane); continue; } r -= I_EG;
            transpose_item_fp8(X.w_down + (size_t)e * DE * D, DE, D, (unsigned char*)wd_t + (size_t)e * D * DE, 0, 0, S_WD8, scr, r, lane);
        }
        for (int i = gt; i < SEQ * 64; i += NGT) rope_entry(rope, i);
    }
    SEAM(0);
    REPS(1) if (IN(1)) { PH_BEGIN
        const float* modp = (const float*)(ws + WS_PROJ);
        for (int i = gt; i < 32 * 6144; i += NGT) mod[i] = mod_sum(modp, X.b_ada, i / 6144, i % 6144);
        LAS float* ssc = (LAS float*)lds; LAS float* ssh = ssc + 1024;
        int curb = -1;
        for (int c = bx; c < M / 256; c += G) {
            const int b = c >> 3;
            if (b != curb) {
                __syncthreads();
                for (int i = tid; i < 1024; i += NW * 64) { ssc[i] = 1.f + mod_sum(modp, X.b_ada, b, MOD_SCALE_A + i); ssh[i] = mod_sum(modp, X.b_ada, b, MOD_SHIFT_A + i); }
                __syncthreads();
                curb = b;
            }
            const f32x4 sc = *(const LAS f32x4*)(ssc + (tid & 255) * 4), sh = *(const LAS f32x4*)(ssh + (tid & 255) * 4);
            const float* xp = X.x + (size_t)c * 256 * D + (size_t)(tid >> 8) * D + (tid & 255) * 4;
            bf16_t* hp = hbuf + (size_t)c * 256 * D + (size_t)(tid >> 8) * D + (tid & 255) * 4;
            for (int i0 = 0; i0 < 128; i0 += 8) {
                f32x4 v[8];
#pragma unroll
                for (int i = 0; i < 8; ++i) v[i] = __builtin_nontemporal_load((const f32x4*)(xp + (size_t)(i0 + i) * 2 * D));
#pragma unroll
                for (int i = 0; i < 8; ++i) { u32x2 o; o.x = pk2(v[i].x * sc.x + sh.x, v[i].y * sc.y + sh.y); o.y = pk2(v[i].z * sc.z + sh.z, v[i].w * sc.w + sh.w); *(u32x2*)(hp + (size_t)(i0 + i) * 2 * D) = o; }
            }
        }
        __syncthreads();
    }
    SEAM(1);
    REPS(2) if (IN(2)) { PH_BEGIN
        pg8::DenseOrder S; S.init(M, DIN, D, win_t, G, bx);
        pg8::EpiInProj E{proj};
        pg8::gemm_phase(lds, (const char*)hbuf, D, S, E, tid);
    }
    SEAM(2);
    REPS(3) if (IN(3)) { PH_BEGIN
        REPS(31) for (int hu = bx; hu < BATCH * 4 * 2; hu += G) ret::unit(proj, rope, X.ret_ld, X.ret_gn, ymix, (unsigned char*)out + (size_t)hu * (8 * ret::TILE), lds, hu, tid);
        REPS(32) for (int u = bx; u < BATCH * 8; u += G) na::unit(proj, X.na_rpb, ymix, lds, u, tid);
    }
    SEAM2(3, 5);
    REPS(5) if (IN(5)) { PH_BEGIN
        pg8::DenseOrder S; S.init(M, D, D, wout_t, G, bx);
        pg8::EpiOutProj E{X.x, mod, out};
        pg8::gemm_phase(lds, (const char*)ymix, D, S, E, tid);
    }
    SEAM(5);
    REPS(6) if (IN(6)) { PH_BEGIN for (int r = gw; r < M; r += NGW) ln1_row(out, X.ln1_g, X.ln1_b, mod, hf, ws + WS_HF8, (float*)(ws + WS_STATS), r, lane); }
    SEAM(6);
    REPS(7) if (IN(7)) { PH_BEGIN
        { pg8::DenseOrder S; S.init(M, NE, D, wr_t, G, bx); pg8::EpiRouter E{logits}; pg8::gemm_phase(lds, (const char*)hf, D, S, E, tid); }
        { pg8::DenseOrder S; S.init(M, 2 * DE, D, wsgu_t, G, bx); pg8::EpiGU<false> E{(void*)shh}; pg8::gemm_phase(lds, (const char*)hf, D, S, E, tid); }
    }
    SEAM(7);
    if (IN(8)) { PH_BEGIN
        LAS unsigned* hist = tab + T_HIST;
        if (tid < NE) hist[tid] = 0u;
        __syncthreads();
        const f32x4 bias = *(const f32x4*)(X.rbias + lane * 4);
        for (int tok = gw; tok < M; tok += NGW) route_token(logits, bias, topk_e, topk_w, hist, tok, lane);
        __syncthreads();
        if (tid < NE && hist[tid]) atomicAdd(&ctl[CW_COUNT + tid], hist[tid]);
    }
    SEAM(8);
    if (IN(9)) { PH_BEGIN
        build_tables(ctl, tab, tid);
        LAS unsigned* hist = tab + T_HIST; LAS unsigned* base = tab + T_BASE;
        for (int c0 = bx * 2048; c0 < NSLOT; c0 += G * 2048) {
            __syncthreads();
            if (tid < NE) hist[tid] = 0u;
            __syncthreads();
            int e[4]; unsigned loc[4];
#pragma unroll
            for (int i = 0; i < 4; ++i) { const int idx = c0 + i * 512 + tid; e[i] = topk_e[idx]; loc[i] = __hip_atomic_fetch_add(&hist[e[i]], 1u, __ATOMIC_RELAXED, __HIP_MEMORY_SCOPE_WORKGROUP); }
            __syncthreads();
            if (tid < NE && hist[tid]) base[tid] = atomicAdd(&ctl[CW_CURSOR + tid], hist[tid]);
            __syncthreads();
#pragma unroll
            for (int i = 0; i < 4; ++i) { const int idx = c0 + i * 512 + tid; const unsigned pos = tab[T_OFF + e[i]] + base[e[i]] + loc[i]; slot_ent[pos] = idx; slot_w[pos] = topk_w[idx]; }
        }
    }
    SEAM(9);
    if (IN(10)) { PH_BEGIN
        build_tables(ctl, tab, tid);
        REPS(10) { pg8::ExpertOrder<2, true> S; S.init(tab, D, wgu_t, (size_t)512 * D, slot_ent, slot_w, G, bx); pg8::EpiGU<true> E{(void*)act}; pg8::gemm_phase<1>(lds, (const char*)(ws + WS_HF8), D, S, E, tid); }
        { pg8::DenseOrder S; S.init(M, D, DE, wsd_t, G, bx); pg8::EpiSharedDown E{ws + WS_YSH}; pg8::gemm_phase(lds, (const char*)shh, DE, S, E, tid); }
    }
    SEAM(10);
    REPS(11) if (IN(11)) { PH_BEGIN
        build_tables(ctl, tab, tid);
        pg8::ExpertOrder<4, false> S; S.init(tab, DE, wd_t, (size_t)D * DE, slot_ent, slot_w, G, bx); pg8::EpiExpDown E{ybuf, slot_ent}; pg8::gemm_phase<1>(lds, (const char*)act, DE, S, E, tid);
    }
    SEAM(11);
    if (IN(12)) { PH_BEGIN for (int r = gw; r < M; r += NGW) final_row(out, ybuf, ws + WS_YSH, X.ln2_g, X.ln2_b, mod, X.ln1_g, X.ln1_b, (const float*)(ws + WS_STATS), r, lane); }
#undef IN
#undef SEAM
}

extern "C" void kernel_launch(void* const* d_in, const int* in_sizes, int n_in, void* d_out, int out_size, void* d_ws, size_t ws_size, hipStream_t stream) {
    static int grid = 0;
    if (grid == 0) {
        if (n_in != 21 || in_sizes[0] != M * D || out_size != M * D || ws_size < WS_END) { fprintf(stderr, "kernel_launch: unexpected shapes (n_in %d, ws %zu)\n", n_in, ws_size); grid = -1; return; }
        int dev = 0, cus = 0, per_cu = 0;
        if (hipGetDevice(&dev) != hipSuccess || hipDeviceGetAttribute(&cus, hipDeviceAttributeMultiprocessorCount, dev) != hipSuccess) { grid = -1; return; }
        if (hipFuncSetAttribute((const void*)mk_fwd, hipFuncAttributeMaxDynamicSharedMemorySize, LDS_BYTES) != hipSuccess) { fprintf(stderr, "kernel_launch: hipFuncSetAttribute failed\n"); grid = -1; return; }
        if (hipOccupancyMaxActiveBlocksPerMultiprocessor(&per_cu, (const void*)mk_fwd, NW * 64, LDS_BYTES) != hipSuccess || per_cu < 1) { fprintf(stderr, "kernel_launch: occupancy query says %d\n", per_cu); }
        (void)hipGetLastError();
        grid = cus;
    }
    if (grid < 0) return;
    (void)hipMemsetAsync((char*)d_ws + WS_CTL, 0, 1 * MiB, stream);
    Args a{};
    const float** p = (const float**)&a.X;
    for (int i = 0; i < 21; ++i) p[i] = (const float*)d_in[i];
    a.X.out = (float*)d_out; a.X.ws = (unsigned char*)d_ws;
#if MK_PER_PHASE
    for (int ph = 0; ph < N_PHASES; ++ph) { a.ph_lo = ph; a.ph_hi = ph + 1; hipLaunchKernelGGL(mk_fwd, dim3(grid), dim3(NW * 64), LDS_BYTES, stream, a); }
#else
    a.ph_lo = 0; a.ph_hi = N_PHASES;
    hipLaunchKernelGGL(mk_fwd, dim3(grid), dim3(NW * 64), LDS_BYTES, stream, a);
#endif
}
```

```cpp
#include <hip/hip_runtime.h>
#include <cstdio>
#include <cstdint>

typedef unsigned short bf16_t;
typedef short bf16x8 __attribute__((ext_vector_type(8)));
typedef float f32x4 __attribute__((ext_vector_type(4)));
typedef float f32x2 __attribute__((ext_vector_type(2)));
typedef unsigned u32x4 __attribute__((ext_vector_type(4)));
typedef unsigned u32x2 __attribute__((ext_vector_type(2)));
#define LAS __attribute__((address_space(3)))

constexpr int D = 1024, BATCH = 32, SEQ = 2048, M = BATCH * SEQ;
constexpr int DIN = 3584;
constexpr int OFF_QNA = 0, OFF_KNA = 512, OFF_VNA = 1024, OFF_QR = 1536, OFF_KR = 2048, OFF_VR = 2560, OFF_GR = 3072;
constexpr int NE = 256, TOPK = 8, DE = 256;
constexpr int NSLOT = M * TOPK;
constexpr float LN_EPS = 1e-5f, GN_EPS = 1e-6f;
constexpr float ALPHA = 1.189207115002721f;
constexpr float YSCALE = 64.f, YINV = 1.f / 64.f;
constexpr float S_HF8 = 16.f, S_WGU8 = 256.f, S_ACT8 = 32.f, S_WD8 = 128.f;
constexpr float INV_GU8 = 1.f / (16.f * 256.f), INV_DN8 = 1.f / (32.f * 128.f);
constexpr int MOD_SHIFT_A = 0, MOD_SCALE_A = 1024, MOD_GATE_A = 2048, MOD_SHIFT_F = 3072, MOD_SCALE_F = 4096, MOD_GATE_F = 5120;

constexpr size_t MiB = 1u << 20;
constexpr size_t WS_CTL = 0;
constexpr size_t WS_MOD = 1 * MiB;
constexpr size_t WS_ROPE = 2 * MiB;
constexpr size_t WS_WIN_T = 4 * MiB;
constexpr size_t WS_WOUT_T = 11 * MiB;
constexpr size_t WS_WR_T = 13 * MiB;
constexpr size_t WS_WSGU_T = 14 * MiB;
constexpr size_t WS_WSD_T = 15 * MiB;
constexpr size_t WS_SLOT_ENT = 16 * MiB;
constexpr size_t WS_SLOT_W = 18 * MiB;
constexpr size_t WS_TOPK_E = 20 * MiB;
constexpr size_t WS_TOPK_W = 22 * MiB;
constexpr size_t WS_STATS = 24 * MiB;
constexpr size_t WS_WD_T = 32 * MiB;
constexpr size_t WS_WGU_T = 160 * MiB;
constexpr size_t WS_HF8 = 288 * MiB;
constexpr size_t WS_YMIX = 416 * MiB;
constexpr size_t WS_PROJ = 544 * MiB;
constexpr size_t WS_LOGITS = WS_YMIX, WS_SHH = WS_YMIX + 64 * MiB;
constexpr size_t WS_HF = WS_PROJ, WS_ACT = WS_PROJ + 128 * MiB;
constexpr size_t WS_YBUF = WS_WGU_T;
constexpr size_t WS_YSH = WS_PROJ + 384 * MiB;
constexpr size_t WS_END = 992 * MiB;
constexpr int CW_COUNT = 1024, CW_CURSOR = 1536, CW_BAR = 8192;

constexpr int RING_BYTES = 131072;
constexpr int TAB_OFF = RING_BYTES;
constexpr int T_OFF = 0, T_TILE = 260, T_CNT = 520, T_HIST = 776, T_BASE = 1032, TAB_WORDS = 1288;
constexpr int VN_OFF = TAB_OFF + 6144;
constexpr int ROWTAB_OFF = VN_OFF + 8192;
constexpr int PHASE_BYTES = 155648;
constexpr int MISC_OFF = PHASE_BYTES;
constexpr int LDS_BYTES = PHASE_BYTES + 256;
static_assert(TAB_WORDS * 4 <= 6144 && ROWTAB_OFF + 6144 <= PHASE_BYTES && LDS_BYTES <= 163840, "LDS map");

__device__ __forceinline__ unsigned f2bf(float f) { unsigned u = __float_as_uint(f); return (u + 0x7fffu + ((u >> 16) & 1u)) >> 16; }
__device__ __forceinline__ float bf2f(unsigned short h) { return __uint_as_float(((unsigned)h) << 16); }
__device__ __forceinline__ unsigned pk2(float lo, float hi) { return f2bf(lo) | (f2bf(hi) << 16); }
__device__ __forceinline__ unsigned cvt_pk_bf16(float lo, float hi) { unsigned r; asm volatile("v_cvt_pk_bf16_f32 %0, %1, %2" : "=v"(r) : "v"(lo), "v"(hi)); return r; }
__device__ __forceinline__ float silu_f(float v) { return v * __builtin_amdgcn_rcpf(1.f + __expf(-v)); }
__device__ __forceinline__ float wave_sum(float v) {
#pragma unroll
    for (int o = 1; o < 64; o <<= 1) v += __shfl_xor(v, o);
    return v;
}
__device__ __forceinline__ float clamp8(float v) { return __builtin_amdgcn_fmed3f(v, -440.f, 440.f); }
#define LDS_WAIT() asm volatile("s_waitcnt lgkmcnt(0)" ::: "memory")
__device__ __forceinline__ int lane_id() { return (int)__builtin_amdgcn_mbcnt_hi(~0u, __builtin_amdgcn_mbcnt_lo(~0u, 0u)); }

#define XB_TMO      128
#define XB_XCNT(j)  (256  + 64 * (j))
#define XB_XSUB(j)  (1280 + 64 * (j))
#define XB_XGEN(j)  (2304 + 64 * (j))
#define XB_TOP      3328
#define XB_TOPGEN   3392
#define XCD_BAR_WORDS 3456
#define XB_SPIN_CAP (1u << 23)
__device__ __forceinline__ unsigned xb_ld(unsigned* p)              { return __hip_atomic_load(p, __ATOMIC_RELAXED, __HIP_MEMORY_SCOPE_AGENT); }
__device__ __forceinline__ unsigned xb_add(unsigned* p, unsigned v) { return __hip_atomic_fetch_add(p, v, __ATOMIC_RELAXED, __HIP_MEMORY_SCOPE_AGENT); }
__device__ __forceinline__ unsigned xb_xcc_id() { return (unsigned)__builtin_amdgcn_s_getreg((3 << 11) | 20) & 0xFu; }
#define XB_SPIN(cond, bar) do { unsigned _sp = 0; while (cond) { __builtin_amdgcn_s_sleep(1); \
    if ((++_sp & 255u) == 0u) { if (xb_ld(&(bar)[XB_TMO])) break; if (_sp > XB_SPIN_CAP) { atomicAdd(&(bar)[XB_TMO], 1u); break; } } } } while (0)
struct XcdBarrier { unsigned* bar; unsigned x; volatile LAS unsigned* st; };
__device__ __forceinline__ XcdBarrier xcd_barrier_post(unsigned* bar, volatile LAS unsigned* st, bool leader) {
    XcdBarrier b; b.bar = bar; b.x = xb_xcc_id(); b.st = st;
    if (leader) (void)xb_add(&bar[XB_XCNT(b.x)], 1u);
    return b;
}
__device__ __forceinline__ void xcd_barrier_complete(unsigned* bar, unsigned x, unsigned& nloc, unsigned& nx) {
    const unsigned G = gridDim.x * gridDim.y * gridDim.z;
    unsigned sum, cnt, mine, sp = 0u;
    for (;;) {
        sum = 0u; cnt = 0u; mine = 0u;
#pragma unroll
        for (unsigned j = 0; j < 16; ++j) { const unsigned c = xb_ld(&bar[XB_XCNT(j)]); sum += c; cnt += (c > 0u) ? 1u : 0u; mine = (j == x) ? c : mine; }
        if (sum == G) break;
        __builtin_amdgcn_s_sleep(1);
        if ((++sp & 255u) == 0u) { if (xb_ld(&bar[XB_TMO])) break; if (sp > XB_SPIN_CAP) { atomicAdd(&bar[XB_TMO], 1u); break; } }
    }
    nloc = mine > 0u ? mine : 1u; nx = cnt > 0u ? cnt : 1u;
}
__device__ __forceinline__ void xcd_barrier(const XcdBarrier& b, bool leader) {
    asm volatile("s_waitcnt vmcnt(0)" ::: "memory");
    __syncthreads();
    if (leader) {
        unsigned* bar = b.bar;
        __builtin_amdgcn_s_waitcnt(0);
        unsigned nloc = b.st[0], nx = b.st[1];
        if (nloc == 0u) { xcd_barrier_complete(bar, b.x, nloc, nx); b.st[0] = nloc; b.st[1] = nx; }
        const unsigned old = xb_add(&bar[XB_XSUB(b.x)], 1u);
        const unsigned gen = old / nloc;
        if (old + 1u == (gen + 1u) * nloc) {
            __builtin_amdgcn_fence(__ATOMIC_RELEASE, "agent");
            asm volatile("s_waitcnt vmcnt(0)" ::: "memory");
            const unsigned og = xb_add(&bar[XB_TOP], 1u);
            const unsigned tg = og / nx;
            if (og + 1u == (tg + 1u) * nx) xb_add(&bar[XB_TOPGEN], 1u);
            else XB_SPIN(xb_ld(&bar[XB_TOPGEN]) == tg, bar);
            __builtin_amdgcn_fence(__ATOMIC_ACQUIRE, "agent");
            xb_add(&bar[XB_XGEN(b.x)], 1u);
            asm volatile("s_waitcnt vmcnt(0)" ::: "memory");
        } else {
            XB_SPIN(xb_ld(&bar[XB_XGEN(b.x)]) == gen, bar);
            __builtin_amdgcn_fence(__ATOMIC_ACQUIRE, "agent");
            asm volatile("s_waitcnt vmcnt(0)" ::: "memory");
        }
    }
    __syncthreads();
}

namespace pg8 {
constexpr int BM = 256, BK = 64, HALF = 128, HTB = HALF * BK * 2, STAGE_BYTES = 8 * HTB;
__device__ __forceinline__ int lds_byte(int r, int c) { const int st = (r >> 4) * 2 + (c >> 5), rr = r & 15, cc = c & 31, ob = rr * 64 + cc * 2; return st * 1024 + (ob ^ (((ob >> 9) & 1) << 5)); }
__device__ __forceinline__ void stage_rc(int b, int& R, int& C) { const int st = b / 1024, sb = b % 1024, swz = sb ^ (((sb >> 9) & 1) << 5); R = (st >> 1) * 16 + swz / 64; C = (st & 1) * 32 + (swz % 64) / 2; }
__device__ __forceinline__ int perm32(int rho) { const int n = rho >> 4, i = rho & 15; return 8 * (i >> 2) + 4 * n + (i & 3); }

typedef int i32x8 __attribute__((ext_vector_type(8)));
__device__ __forceinline__ i32x8 cat8(const bf16x8 lo, const bf16x8 hi) { const u32x4 a = __builtin_bit_cast(u32x4, lo), b = __builtin_bit_cast(u32x4, hi); return (i32x8){(int)a.x, (int)a.y, (int)a.z, (int)a.w, (int)b.x, (int)b.y, (int)b.z, (int)b.w}; }
struct Unit { int pm, pn; const char* B; int e, cnt, off; };

template <int ESZ = 2, class Epi, class Sched>
__device__ __forceinline__ void gemm_phase(LAS unsigned char* lds, const char* Abase, const int K, const Sched& S, const Epi& E, const int tid_in) {
    int tid_ = tid_in; asm volatile("" : "+v"(tid_));
    const int tid = tid_, wid = __builtin_amdgcn_readfirstlane(tid >> 6), lane = tid & 63, wr = wid >> 2, wc = wid & 3, fr = lane & 15, fq = lane >> 4;
    const int rowbytes = K * ESZ, nt = rowbytes / 128;
    int Rr[2], Cc[2]; unsigned voffB[2], voffA[2];
#pragma unroll
    for (int i = 0; i < 2; ++i) { int R, C; stage_rc(tid * 16 + i * 8192, R, C); Rr[i] = R; Cc[i] = C; const int Rb = Epi::PERM ? (64 * (R >> 5) + 16 * ((R >> 2) & 3) + 4 * ((R >> 4) & 1) + (R & 3)) : R; voffB[i] = (unsigned)(Rb * rowbytes + C * 2); voffA[i] = (unsigned)(R * rowbytes + C * 2); }
    constexpr bool GATHER = Sched::GATHER;
    const size_t kstep = (size_t)128;
    const size_t hstep = (size_t)HALF * rowbytes;
    const size_t bhstep = (size_t)(Epi::PERM ? 8 : HALF) * rowbytes;
    const unsigned ldsw = (unsigned)wid * 1024u;
    const int aoff = (ESZ == 2) ? lds_byte(wr * 64 + fr, fq * 8) : lds_byte(wr * 64 + fr, 16 * (fq & 1)) + 1024 * (fq >> 1);
    const int boff = (ESZ == 2) ? lds_byte(wc * 32 + fr, fq * 8) : lds_byte(wc * 32 + fr, 16 * (fq & 1)) + 1024 * (fq >> 1);
#define PG8_SA(b, h) (((b) * 2 + (h)) * HTB)
#define PG8_SB(b, h) ((4 + (b) * 2 + (h)) * HTB)
#define PG8_STAGE(bufoff, gbase, voff) do { _Pragma("unroll") for (int _i = 0; _i < 2; ++_i) \
        __builtin_amdgcn_global_load_lds((const unsigned*)((const char*)(gbase) + (voff)[_i]), (LAS unsigned*)(lds + (bufoff) + ldsw + _i * 8192), 16, 0, 0); } while (0)
#define PG8_STAGEA(bufoff, uptr, koff, NEXT, h) do { if constexpr (GATHER) { if (NEXT) { const u32x2 _t = *(const LAS u32x2*)(vnslot + 2 * (h)); unsigned _v[2] = {_t.x, _t.y}; PG8_STAGE(bufoff, Abase + (koff), _v); } else { PG8_STAGE(bufoff, Abase + (koff), vc[h]); } } \
        else { PG8_STAGE(bufoff, (uptr) + (size_t)(h) * hstep + (koff), voffA); } } while (0)
#define PG8_LDA(dst, b, h) do { _Pragma("unroll") for (int m = 0; m < 4; ++m) { if constexpr (ESZ == 2) { _Pragma("unroll") for (int k = 0; k < 2; ++k) dst[m].q[k] = *(const LAS bf16x8*)(lds + PG8_SA(b, h) + aoff + m * 2048 + k * 1024); } \
        else dst[m].w = cat8(*(const LAS bf16x8*)(lds + PG8_SA(b, h) + aoff + m * 2048), *(const LAS bf16x8*)(lds + PG8_SA(b, h) + aoff + m * 2048 + 16)); } } while (0)
#define PG8_LDB(dst, b, h) do { _Pragma("unroll") for (int n = 0; n < 2; ++n) { if constexpr (ESZ == 2) { _Pragma("unroll") for (int k = 0; k < 2; ++k) dst[n].q[k] = *(const LAS bf16x8*)(lds + PG8_SB(b, h) + boff + n * 2048 + k * 1024); } \
        else dst[n].w = cat8(*(const LAS bf16x8*)(lds + PG8_SB(b, h) + boff + n * 2048), *(const LAS bf16x8*)(lds + PG8_SB(b, h) + boff + n * 2048 + 16)); } } while (0)
#define PG8_MMA(ai, bj, At, Bt) do { __builtin_amdgcn_s_setprio(1); _Pragma("unroll") for (int m = 0; m < 4; ++m) _Pragma("unroll") for (int n = 0; n < 2; ++n) { \
        if constexpr (ESZ == 2) { _Pragma("unroll") for (int k = 0; k < 2; ++k) acc[ai][bj][m][n] = __builtin_amdgcn_mfma_f32_16x16x32_bf16(Bt[n].q[k], At[m].q[k], acc[ai][bj][m][n], 0, 0, 0); } \
        else { asm volatile("v_mfma_f32_16x16x128_f8f6f4 %0, %1, %2, %0" : "+v"(acc[ai][bj][m][n]) : "v"(Bt[n].w), "v"(At[m].w)); } } \
        __builtin_amdgcn_s_setprio(0); } while (0)
#define PG8_WAIT_V(n) asm volatile("s_waitcnt vmcnt(" #n ")" ::: "memory")
#define PG8_WAIT_L(n) asm volatile("s_waitcnt lgkmcnt(" #n ")" ::: "memory")
#define PG8_BAR __builtin_amdgcn_s_barrier()
#define PG8_SCHED __builtin_amdgcn_sched_barrier(0)
    Unit cur, nxt; int ui = 0;
    if (!S.next(0, cur)) return;
    f32x4 acc[2][2][4][2];
    union Frag { bf16x8 q[2]; i32x8 w; };
    Frag At[4], B0[2], B1[2];
    unsigned vc[2][2];
    LAS unsigned* vnslot = (LAS unsigned*)(lds + (VN_OFF - 0)) + tid * 4;
    if constexpr (GATHER) S.avoff(cur, Rr, Cc, vc, tid);
    LAS unsigned* rowtab = (LAS unsigned*)(lds + ROWTAB_OFF);
    if constexpr (GATHER) S.rowtab(cur, rowtab, tid);
    const char* cB = cur.B; const char* cA = Abase + S.aoff(cur);
    PG8_STAGE(PG8_SB(0, 0), cB, voffB); PG8_STAGE(PG8_SB(0, 1), cB + bhstep, voffB); PG8_STAGEA(PG8_SA(0, 0), cA, 0, false, 0); PG8_STAGEA(PG8_SA(0, 1), cA, 0, false, 1);
    if (wr == 1) PG8_BAR;
    PG8_WAIT_V(2); PG8_BAR;
    PG8_STAGE(PG8_SB(1, 0), cB + kstep, voffB); PG8_STAGEA(PG8_SA(1, 0), cA, kstep, false, 0); PG8_STAGE(PG8_SB(1, 1), cB + bhstep + kstep, voffB);
    PG8_WAIT_V(6); PG8_BAR;
    asm volatile("" ::: "memory");
#pragma unroll
    for (int a = 0; a < 2; ++a)
#pragma unroll
        for (int b = 0; b < 2; ++b)
#pragma unroll
            for (int m = 0; m < 4; ++m)
#pragma unroll
                for (int n = 0; n < 2; ++n) { acc[a][b][m][n] = (f32x4){0.f, 0.f, 0.f, 0.f}; asm volatile("" : "+v"(acc[a][b][m][n])); }
    asm volatile("s_nop 4" ::: "memory");
    for (;;) {
        const bool has_next = S.next(ui + 1, nxt);
        if constexpr (GATHER) {
            unsigned vn[2][2];
            if (has_next) S.avoff(nxt, Rr, Cc, vn, tid);
            else {
#pragma unroll
                for (int h = 0; h < 2; ++h)
#pragma unroll
                    for (int i = 0; i < 2; ++i) vn[h][i] = vc[h][i];
            }
            *(LAS u32x4*)vnslot = (u32x4){vn[0][0], vn[0][1], vn[1][0], vn[1][1]};
            if (has_next) S.rowtab(nxt, rowtab + 512 * ((ui + 1) % 3), tid);
        }
        const char* nB = has_next ? nxt.B : cB; const char* nA = has_next ? Abase + S.aoff(nxt) : cA;
        for (int t = 0; t < nt; t += 2) {
            const bool last = (t == nt - 2);
            const size_t k1 = (size_t)(t + 1) * kstep;
            const size_t k2 = last ? (size_t)0 : (size_t)(t + 2) * kstep, k3 = k2 + kstep;
            const char* u2 = last ? nA : cA; const char* b2 = last ? nB : cB + (size_t)(t + 2) * kstep;
            const char* b3 = b2 + kstep;
            PG8_LDB(B0, 0, 0); PG8_LDB(B1, 0, 1); PG8_SCHED; PG8_LDA(At, 0, 0); PG8_STAGEA(PG8_SA(1, 1), cA, k1, false, 1);
            PG8_WAIT_V(8); PG8_WAIT_L(0); PG8_BAR; PG8_MMA(0, 0, At, B0); PG8_MMA(0, 1, At, B1); PG8_BAR; PG8_SCHED;
            PG8_LDA(At, 0, 1); PG8_STAGE(PG8_SB(0, 0), b2, voffB); PG8_STAGE(PG8_SB(0, 1), b2 + bhstep, voffB); PG8_STAGEA(PG8_SA(0, 0), u2, k2, last, 0);
            PG8_WAIT_V(8); PG8_WAIT_L(0); PG8_BAR; PG8_MMA(1, 0, At, B0); PG8_MMA(1, 1, At, B1); PG8_BAR; PG8_SCHED;
            PG8_LDB(B0, 1, 0); PG8_LDB(B1, 1, 1); PG8_SCHED; PG8_LDA(At, 1, 0); PG8_STAGEA(PG8_SA(0, 1), u2, k2, last, 1);
            PG8_WAIT_V(8); PG8_WAIT_L(0); PG8_BAR; PG8_MMA(0, 0, At, B0); PG8_MMA(0, 1, At, B1); PG8_BAR; PG8_SCHED;
            PG8_LDA(At, 1, 1); PG8_STAGE(PG8_SB(1, 0), b3, voffB); PG8_STAGE(PG8_SB(1, 1), b3 + bhstep, voffB); PG8_STAGEA(PG8_SA(1, 0), u2, k3, last, 0);
            PG8_WAIT_V(8); PG8_WAIT_L(0); PG8_BAR; PG8_MMA(1, 0, At, B0); PG8_MMA(1, 1, At, B1); PG8_BAR; PG8_SCHED;
        }
        if (wr == 0) PG8_BAR;
        if constexpr (ESZ == 1) {
            asm volatile("s_nop 15\n\ts_nop 15" ::: "memory");
#pragma unroll
            for (int a = 0; a < 2; ++a)
#pragma unroll
                for (int b = 0; b < 2; ++b)
#pragma unroll
                    for (int m = 0; m < 4; ++m) asm volatile("" : "+v"(acc[a][b][m][0]), "+v"(acc[a][b][m][1]));
        }
        { const int l2 = lane_id(); E(acc, cur, wr, wc, l2 & 15, l2 >> 4, rowtab + 512 * (ui % 3)); }
        if (!has_next) break;
#pragma unroll
        for (int a = 0; a < 2; ++a)
#pragma unroll
            for (int b = 0; b < 2; ++b)
#pragma unroll
                for (int m = 0; m < 4; ++m)
#pragma unroll
                    for (int n = 0; n < 2; ++n) acc[a][b][m][n] = (f32x4){0.f, 0.f, 0.f, 0.f};
        cur = nxt; cB = nB; cA = nA; ++ui;
        if constexpr (GATHER) { const u32x4 _t = *(const LAS u32x4*)vnslot; vc[0][0] = _t.x; vc[0][1] = _t.y; vc[1][0] = _t.z; vc[1][1] = _t.w; }
        if (wr == 1) PG8_BAR;
    }
    PG8_WAIT_V(0);
    PG8_BAR;
#undef PG8_SA
#undef PG8_SB
#undef PG8_STAGE
#undef PG8_STAGEA
#undef PG8_LDA
#undef PG8_LDB
#undef PG8_MMA
#undef PG8_WAIT_V
#undef PG8_WAIT_L
#undef PG8_BAR
#undef PG8_SCHED
}

struct DenseOrder {
    int nM, nN, nwg, G, c, K; const char* Bt;
    __device__ void init(int Mrows, int N, int K_, const void* Bt_, int G_, int c_) { nM = Mrows / BM; nN = N / BM; nwg = nM * nN; G = G_; c = c_; K = K_; Bt = (const char*)Bt_; }
    __device__ __forceinline__ bool next(int i, Unit& u) const {
        const long L = (long)i * G + c; if (L >= nwg) return false;
        int wgid = (int)L; { const int q = nwg / 8, r = nwg % 8, xcd = wgid % 8, off = wgid / 8; wgid = (xcd < r ? xcd * (q + 1) : r * (q + 1) + (xcd - r) * q) + off; }
        const int nig = 8 * nN, gid = wgid / nig, fm = gid * 8, gsz = (nM - fm) < 8 ? (nM - fm) : 8;
        u.pm = fm + ((wgid % nig) % gsz); u.pn = (wgid % nig) / gsz; u.B = Bt + (size_t)u.pn * BM * K * 2; u.e = 0; u.cnt = 0; u.off = 0; return true;
    }
    static constexpr bool GATHER = false;
    __device__ __forceinline__ size_t aoff(const Unit& u) const { return (size_t)u.pm * BM * K * 2; }
    __device__ __forceinline__ void avoff(const Unit&, const int (&)[2], const int (&)[2], unsigned (&)[2][2], int) const {}
};
template <int NCOL, bool TOKROWS> struct ExpertOrder {
    static constexpr bool GATHER = true;
    __device__ __forceinline__ size_t aoff(const Unit&) const { return 0; }
    const LAS unsigned* tab; int per, c, K  ; const char* W; size_t wstride; const int* slot_ent; const float* slot_w;
    mutable int ehint = 0;
    int xbase, xend, xstride, xlb;
    __device__ void init(const LAS unsigned* tab_, int K_, const void* W_, size_t wstride_, const int* slot_ent_, const float* slot_w_, int G, int c_) {
        tab = tab_; K = K_; W = (const char*)W_; wstride = wstride_; slot_ent = slot_ent_; slot_w = slot_w_; c = c_;
        const int U = (int)tab[T_TILE + NE] * NCOL; per = (U + G - 1) / G;
        if (G % 8 == 0) { const int x = c_ % 8; const int q = U / 8, r = U % 8; xbase = x * q + (x < r ? x : r); xend = xbase + q + (x < r ? 1 : 0); xstride = G / 8; xlb = c_ / 8; }
        else { xbase = 0; xend = U; xstride = G; xlb = c_; }
    }
    __device__ __forceinline__ bool next(int i, Unit& u) const {
        const int L = xbase + i * xstride + xlb;
        if (L >= xend) return false;
        const int tile = L / NCOL; u.pn = L % NCOL;
        int lo = ehint;
        if (i == 0) { lo = 0; int hi = NE - 1; while (lo < hi) { const int mid = (lo + hi + 1) >> 1; if ((int)tab[T_TILE + mid] <= tile) lo = mid; else hi = mid - 1; } }
        else { while (lo < NE - 1 && (int)tab[T_TILE + lo + 1] <= tile) ++lo; }
        ehint = lo;
        u.e = lo; u.pm = tile - (int)tab[T_TILE + lo]; u.cnt = (int)tab[T_CNT + lo]; u.off = (int)tab[T_OFF + lo];
        u.B = W + (size_t)lo * wstride + (size_t)u.pn * BM * K; return true;
    }
    __device__ __forceinline__ void rowtab(const Unit& u, LAS unsigned* t, int tid) const {
        if (tid < BM) { int r = u.pm * BM + tid; if (r >= u.cnt) r = u.cnt - 1; t[tid] = (unsigned)slot_ent[u.off + r]; t[BM + tid] = __float_as_uint(slot_w[u.off + r]); }
    }
    __device__ __forceinline__ void avoff(const Unit& u, const int (&)[2], const int (&)[2], unsigned (&v)[2][2], int tidq) const {
        int R[2], C[2]; asm volatile("" : "+v"(tidq));
#pragma unroll
        for (int i = 0; i < 2; ++i) stage_rc(tidq * 16 + i * 8192, R[i], C[i]);
#pragma unroll
        for (int h = 0; h < 2; ++h)
#pragma unroll
            for (int i = 0; i < 2; ++i) {
                int r = u.pm * BM + h * HALF + R[i]; if (r >= u.cnt) r = u.cnt - 1;
                const int slot = u.off + r;
                const int row = TOKROWS ? (slot_ent[slot] >> 3) : slot;
                v[h][i] = (unsigned)(row * K + C[i] * 2);
            }
    }
};

struct EpiInProj {
    static constexpr bool PERM = true; bf16_t* O;
    __device__ __forceinline__ void operator()(const f32x4 (&acc)[2][2][4][2], const Unit& u, int wr, int wc, int fr, int fq, const LAS unsigned* rt) const {
        const float sc = (u.pn < 2) ? 0.125f : ((u.pn == 8 || u.pn == 9) ? 0.08838834764831845f : 1.f);
        const int row0 = u.pm * BM + wr * 64 + fr, col0 = u.pn * BM + wc * 64 + 16 * fq;
#pragma unroll
        for (int ai = 0; ai < 2; ++ai)
#pragma unroll
            for (int m = 0; m < 4; ++m) { bf16_t* rowp = O + (size_t)(row0 + ai * HALF + m * 16) * DIN + col0;
#pragma unroll
                for (int bj = 0; bj < 2; ++bj) { const f32x4 v0 = acc[ai][bj][m][0] * sc, v1 = acc[ai][bj][m][1] * sc;
                    u32x4 w; w.x = cvt_pk_bf16(v0[0], v0[1]); w.y = cvt_pk_bf16(v0[2], v0[3]); w.z = cvt_pk_bf16(v1[0], v1[1]); w.w = cvt_pk_bf16(v1[2], v1[3]);
                    *(u32x4*)(rowp + 8 * bj) = w; } }
    }
};
struct EpiOutProj {
    static constexpr bool PERM = false; const float* x; const float* mod; float* out;
    __device__ __forceinline__ void operator()(const f32x4 (&acc)[2][2][4][2], const Unit& u, int wr, int wc, int fr, int fq, const LAS unsigned* rt) const {
        const int b = (u.pm * BM) >> 11; const int col0 = u.pn * BM + wc * 32 + 4 * fq;
#pragma unroll
        for (int bj = 0; bj < 2; ++bj)
#pragma unroll
            for (int n = 0; n < 2; ++n) { const int col = col0 + bj * HALF + n * 16; const f32x4 g = *(const f32x4*)(mod + b * 6144 + MOD_GATE_A + col);
#pragma unroll
                for (int ai = 0; ai < 2; ++ai)
#pragma unroll
                    for (int m = 0; m < 4; ++m) { const size_t o = (size_t)(u.pm * BM + ai * HALF + wr * 64 + m * 16 + fr) * D + col;
                        const f32x4 xv = *(const f32x4*)(x + o); *(f32x4*)(out + o) = xv * ALPHA + g * acc[ai][bj][m][n]; } }
    }
};
struct EpiRouter {
    static constexpr bool PERM = false; float* out;
    __device__ __forceinline__ void operator()(const f32x4 (&acc)[2][2][4][2], const Unit& u, int wr, int wc, int fr, int fq, const LAS unsigned* rt) const {
        const int col0 = wc * 32 + 4 * fq;
#pragma unroll
        for (int ai = 0; ai < 2; ++ai)
#pragma unroll
            for (int m = 0; m < 4; ++m) { float* rowp = out + (size_t)(u.pm * BM + ai * HALF + wr * 64 + m * 16 + fr) * NE + col0;
#pragma unroll
                for (int bj = 0; bj < 2; ++bj)
#pragma unroll
                    for (int n = 0; n < 2; ++n) *(f32x4*)(rowp + bj * HALF + n * 16) = acc[ai][bj][m][n]; }
    }
};
template <bool EXPERT> struct EpiGU {
    static constexpr bool PERM = true; void* Ov;
    __device__ __forceinline__ void operator()(const f32x4 (&acc)[2][2][4][2], const Unit& u, int wr, int wc, int fr, int fq, const LAS unsigned* rt) const {
        const int h0 = u.pn * HALF + wc * 32 + 8 * fq;
#pragma unroll
        for (int ai = 0; ai < 2; ++ai)
#pragma unroll
            for (int m = 0; m < 4; ++m) {
                const int rtw = u.pm * BM + ai * HALF + wr * 64 + m * 16 + fr;
                if (EXPERT) { if (rtw >= u.cnt) continue; }
                const float w = EXPERT ? __uint_as_float(rt[BM + ai * HALF + wr * 64 + m * 16 + fr]) * (S_ACT8 * INV_GU8) : 1.f;
                const float gs = EXPERT ? INV_GU8 : 1.f;
                const f32x4 g0 = acc[ai][0][m][0] * gs, g1 = acc[ai][0][m][1] * gs, u0 = acc[ai][1][m][0], u1 = acc[ai][1][m][1];
                const float h[8] = {w * silu_f(g0[0]) * u0[0], w * silu_f(g0[1]) * u0[1], w * silu_f(g0[2]) * u0[2], w * silu_f(g0[3]) * u0[3],
                                    w * silu_f(g1[0]) * u1[0], w * silu_f(g1[1]) * u1[1], w * silu_f(g1[2]) * u1[2], w * silu_f(g1[3]) * u1[3]};
                if (EXPERT) {
                    int w0 = __builtin_amdgcn_cvt_pk_fp8_f32(clamp8(h[0]), clamp8(h[1]), 0, false); w0 = __builtin_amdgcn_cvt_pk_fp8_f32(clamp8(h[2]), clamp8(h[3]), w0, true);
                    int w1 = __builtin_amdgcn_cvt_pk_fp8_f32(clamp8(h[4]), clamp8(h[5]), 0, false); w1 = __builtin_amdgcn_cvt_pk_fp8_f32(clamp8(h[6]), clamp8(h[7]), w1, true);
                    u32x2 o; o.x = (unsigned)w0; o.y = (unsigned)w1; *(u32x2*)((unsigned char*)Ov + (size_t)(u.off + rtw) * DE + h0) = o;
                    asm volatile("" ::: "memory");
                } else {
                    u32x4 o; o.x = cvt_pk_bf16(h[0], h[1]); o.y = cvt_pk_bf16(h[2], h[3]); o.z = cvt_pk_bf16(h[4], h[5]); o.w = cvt_pk_bf16(h[6], h[7]);
                    *(u32x4*)((bf16_t*)Ov + (size_t)rtw * DE + h0) = o;
                }
            }
    }
};
struct EpiSharedDown {
    static constexpr bool PERM = true; unsigned char* ysh;
    __device__ __forceinline__ void operator()(const f32x4 (&acc)[2][2][4][2], const Unit& u, int wr, int wc, int fr, int fq, const LAS unsigned* rt) const {
        const int col0 = u.pn * BM + wc * 64 + 16 * fq;
#pragma unroll
        for (int ai = 0; ai < 2; ++ai)
#pragma unroll
            for (int m = 0; m < 4; ++m) {
                u32x4 o;
#pragma unroll
                for (int bj = 0; bj < 2; ++bj) { const f32x4 v0 = acc[ai][bj][m][0] * YSCALE, v1 = acc[ai][bj][m][1] * YSCALE;
                    int w0 = __builtin_amdgcn_cvt_pk_fp8_f32(clamp8(v0[0]), clamp8(v0[1]), 0, false); w0 = __builtin_amdgcn_cvt_pk_fp8_f32(clamp8(v0[2]), clamp8(v0[3]), w0, true);
                    int w1 = __builtin_amdgcn_cvt_pk_fp8_f32(clamp8(v1[0]), clamp8(v1[1]), 0, false); w1 = __builtin_amdgcn_cvt_pk_fp8_f32(clamp8(v1[2]), clamp8(v1[3]), w1, true);
                    if (bj == 0) { o.x = (unsigned)w0; o.y = (unsigned)w1; } else { o.z = (unsigned)w0; o.w = (unsigned)w1; } }
                *(u32x4*)(ysh + (size_t)(u.pm * BM + ai * HALF + wr * 64 + m * 16 + fr) * D + col0) = o;
            }
    }
};
struct EpiExpDown {
    static constexpr bool PERM = true; unsigned char* ybuf; const int* slot_ent;
    __device__ __forceinline__ void operator()(const f32x4 (&acc)[2][2][4][2], const Unit& u, int wr, int wc, int fr, int fq, const LAS unsigned* rt) const {
        const int col0 = u.pn * BM + wc * 64 + 16 * fq;
#pragma unroll
        for (int ai = 0; ai < 2; ++ai)
#pragma unroll
            for (int m = 0; m < 4; ++m) {
                const int rtw = u.pm * BM + ai * HALF + wr * 64 + m * 16 + fr; if (rtw >= u.cnt) continue;
                u32x4 o;
#pragma unroll
                for (int bj = 0; bj < 2; ++bj) { const f32x4 v0 = acc[ai][bj][m][0] * (YSCALE * INV_DN8), v1 = acc[ai][bj][m][1] * (YSCALE * INV_DN8);
                    int w0 = __builtin_amdgcn_cvt_pk_fp8_f32(clamp8(v0[0]), clamp8(v0[1]), 0, false); w0 = __builtin_amdgcn_cvt_pk_fp8_f32(clamp8(v0[2]), clamp8(v0[3]), w0, true);
                    int w1 = __builtin_amdgcn_cvt_pk_fp8_f32(clamp8(v1[0]), clamp8(v1[1]), 0, false); w1 = __builtin_amdgcn_cvt_pk_fp8_f32(clamp8(v1[2]), clamp8(v1[3]), w1, true);
                    if (bj == 0) { o.x = (unsigned)w0; o.y = (unsigned)w1; } else { o.z = (unsigned)w0; o.w = (unsigned)w1; } }
                *(u32x4*)(ybuf + (size_t)rt[ai * HALF + wr * 64 + m * 16 + fr] * D + col0) = o;
                asm volatile("" ::: "memory");
            }
    }
};
}

struct Ctx {
    const float *x, *c, *w_ada, *b_ada, *w_in, *w_out, *na_rpb, *ret_ld, *ret_gn, *ln1_g, *ln1_b, *ln2_g, *ln2_b, *w_router, *rbias, *w_gate, *w_up, *w_down, *ws_gate, *ws_up, *ws_down;
    float* out; unsigned char* ws;
};
constexpr int NW = 8;

__device__ __forceinline__ void transpose_item(const float* W, int K, int N, bf16_t* WT, int G, int which, LAS float* scr, int item, int lane) {
    const int nblk = N / 32, kb = item / nblk, nb = item % nblk, k0 = 64 * kb, n0 = 32 * nb;
    float v[32];
#pragma unroll
    for (int i = 0; i < 32; ++i) { const int kk = 2 * i + (lane >> 5); v[i] = __builtin_nontemporal_load(W + (size_t)(k0 + kk) * N + n0 + (lane & 31)); }
#pragma unroll
    for (int i = 0; i < 32; ++i) { const int kk = 2 * i + (lane >> 5); scr[kk * 33 + (lane & 31)] = v[i]; }
    LDS_WAIT(); asm volatile("" ::: "memory");
    const int c = lane & 7;
#pragma unroll
    for (int j = 0; j < 4; ++j) { const int n = (lane >> 3) + 8 * j; const LAS float* s = scr + (8 * c) * 33 + n;
        u32x4 o; o.x = pk2(s[0 * 33], s[1 * 33]); o.y = pk2(s[2 * 33], s[3 * 33]); o.z = pk2(s[4 * 33], s[5 * 33]); o.w = pk2(s[6 * 33], s[7 * 33]);
        const int ng = n0 + n; const int drow = (G == 0) ? ng : ((ng / G) * 2 * G + which * G + (ng % G));
        *(u32x4*)(WT + (size_t)drow * K + k0 + 8 * c) = o; }
    LDS_WAIT(); asm volatile("" ::: "memory");
}
__device__ __forceinline__ void transpose_item_fp8(const float* W, int K, int N, unsigned char* WT, int G, int which, float scale, LAS float* scr, int item, int lane) {
    const int nblk = N / 32, kb = item / nblk, nb = item % nblk, k0 = 64 * kb, n0 = 32 * nb;
    float v[32];
#pragma unroll
    for (int i = 0; i < 32; ++i) { const int kk = 2 * i + (lane >> 5); v[i] = __builtin_nontemporal_load(W + (size_t)(k0 + kk) * N + n0 + (lane & 31)); }
#pragma unroll
    for (int i = 0; i < 32; ++i) { const int kk = 2 * i + (lane >> 5); scr[kk * 33 + (lane & 31)] = v[i] * scale; }
    LDS_WAIT(); asm volatile("" ::: "memory");
    const int c = lane & 7;
#pragma unroll
    for (int j = 0; j < 4; ++j) { const int n = (lane >> 3) + 8 * j; const LAS float* sp = scr + (8 * c) * 33 + n;
        int w0 = __builtin_amdgcn_cvt_pk_fp8_f32(clamp8(sp[0 * 33]), clamp8(sp[1 * 33]), 0, false); w0 = __builtin_amdgcn_cvt_pk_fp8_f32(clamp8(sp[2 * 33]), clamp8(sp[3 * 33]), w0, true);
        int w1 = __builtin_amdgcn_cvt_pk_fp8_f32(clamp8(sp[4 * 33]), clamp8(sp[5 * 33]), 0, false); w1 = __builtin_amdgcn_cvt_pk_fp8_f32(clamp8(sp[6 * 33]), clamp8(sp[7 * 33]), w1, true);
        const int ng = n0 + n; const int drow = (G == 0) ? ng : ((ng / G) * 2 * G + which * G + (ng % G));
        u32x2 o; o.x = (unsigned)w0; o.y = (unsigned)w1; *(u32x2*)(WT + (size_t)drow * K + k0 + 8 * c) = o; }
    LDS_WAIT(); asm volatile("" ::: "memory");
}
__device__ __forceinline__ void rope_entry(float* tab, int idx) {
    const int t = idx >> 6, i = idx & 63;
    const float inv_freq = powf(10000.f, -(float)(2 * i) / 128.f);
    const float ang = (float)t * inv_freq;
    const double a = (double)ang; const double two_pi = 6.283185307179586476925286766559;
    const double kf = rint(a / two_pi); double r = a - kf * two_pi;
    double sgn = 1.0; if (r > 1.5707963267948966) { r = 3.141592653589793 - r; sgn = -1.0; } else if (r < -1.5707963267948966) { r = -3.141592653589793 - r; sgn = -1.0; }
    const double r2 = r * r;
    const double s = r * (1.0 + r2 * (-1.0 / 6 + r2 * (1.0 / 120 + r2 * (-1.0 / 5040 + r2 * (1.0 / 362880 + r2 * (-1.0 / 39916800 + r2 * (1.0 / 6227020800.0 + r2 * (-1.0 / 1307674368000.0))))))));
    const double c = 1.0 + r2 * (-0.5 + r2 * (1.0 / 24 + r2 * (-1.0 / 720 + r2 * (1.0 / 40320 + r2 * (-1.0 / 3628800 + r2 * (1.0 / 479001600.0 + r2 * (-1.0 / 87178291200.0 + r2 * (1.0 / 20922789888000.0))))))));
    tab[idx] = (float)(sgn * c); tab[SEQ * 64 + idx] = (float)s;
}
__device__ __forceinline__ void mod_task(const float* __restrict__ cin, const float* __restrict__ w_ada, float* __restrict__ modp, int task, int lane) {
    const int cbk = task % 96, kc = task / 96, j = cbk * 64 + lane, k0 = kc * 64;
    float acc[32], cv[32];
#pragma unroll
    for (int b = 0; b < 32; ++b) { acc[b] = 0.f; cv[b] = silu_f(cin[b * D + k0 + lane]); }
#pragma unroll
    for (int kb = 0; kb < 4; ++kb) {
        float w[16];
#pragma unroll
        for (int i = 0; i < 16; ++i) w[i] = w_ada[(size_t)(k0 + kb * 16 + i) * 6144 + j];
#pragma unroll
        for (int i = 0; i < 16; ++i)
#pragma unroll
            for (int b = 0; b < 32; ++b) acc[b] += __builtin_bit_cast(float, __builtin_amdgcn_readlane(__builtin_bit_cast(int, cv[b]), kb * 16 + i)) * w[i];
    }
#pragma unroll
    for (int b = 0; b < 32; ++b) modp[((size_t)kc * 32 + b) * 6144 + j] = acc[b];
}
__device__ __forceinline__ float mod_sum(const float* __restrict__ modp, const float* __restrict__ b_ada, int b, int j) {
    float s = 0.f;
#pragma unroll
    for (int kc = 0; kc < 16; ++kc) s += modp[((size_t)kc * 32 + b) * 6144 + j];
    return s + b_ada[j];
}

namespace ret {
typedef short s16x4 __attribute__((ext_vector_type(4)));
typedef __bf16 bfx2 __attribute__((ext_vector_type(2)));
constexpr unsigned RS = 288, TILE = 128 * RS, LK = 0, LV = TILE, LRF = 2 * TILE, LRB = 3 * TILE;
constexpr float LOG2E = 1.4426950408889634f;
__device__ __forceinline__ unsigned offb(unsigned row, unsigned ch) { return RS * row + 16u * ch; }
__device__ __forceinline__ unsigned cvtpk(float lo, float hi) { const f32x2 v = {lo, hi}; return __builtin_bit_cast(unsigned, __builtin_convertvector(v, bfx2)); }
__device__ __forceinline__ bf16x8 pack8(const float (&f)[8]) { u32x4 u; u.x = cvtpk(f[0], f[1]); u.y = cvtpk(f[2], f[3]); u.z = cvtpk(f[4], f[5]); u.w = cvtpk(f[6], f[7]); return __builtin_bit_cast(bf16x8, u); }
__device__ __forceinline__ void unpack8(const bf16x8 v, float (&f)[8]) { const u32x4 u = __builtin_bit_cast(u32x4, v);
    f[0] = __uint_as_float(u.x << 16); f[1] = __uint_as_float(u.x & 0xffff0000u); f[2] = __uint_as_float(u.y << 16); f[3] = __uint_as_float(u.y & 0xffff0000u);
    f[4] = __uint_as_float(u.z << 16); f[5] = __uint_as_float(u.z & 0xffff0000u); f[6] = __uint_as_float(u.w << 16); f[7] = __uint_as_float(u.w & 0xffff0000u); }
__device__ __forceinline__ bf16x8 trfrag(LAS unsigned char* base, unsigned row0, unsigned row1, unsigned cblk, unsigned qp, unsigned p) {
    const unsigned ch = 2u * cblk + (p >> 1), bo = 8u * (p & 1u);
    const s16x4 lo = __builtin_amdgcn_ds_read_tr16_b64_v4i16((LAS s16x4*)(base + offb(row0 + qp, ch) + bo));
    const s16x4 hi = __builtin_amdgcn_ds_read_tr16_b64_v4i16((LAS s16x4*)(base + offb(row1 + qp, ch) + bo));
    return __builtin_shufflevector(lo, hi, 0, 1, 2, 3, 4, 5, 6, 7);
}
struct KVRaw { bf16x8 ka[2], kb[2], v[4]; f32x4 c0[2], c1[2], s0[2], s1[2]; };
__device__ __forceinline__ void kv_load(KVRaw& R, const bf16_t* __restrict__ proj, const float* __restrict__ rope, int b, int h, int n, int tid) {
#pragma unroll
    for (int i = 0; i < 2; ++i) {
        const int q2 = tid + 512 * i, row = q2 >> 3, pc = q2 & 7, t = n * 128 + row;
        const bf16_t* rp = proj + (size_t)(b * SEQ + t) * DIN + OFF_KR + h * 128;
        R.ka[i] = *(const bf16x8*)(rp + pc * 8); R.kb[i] = *(const bf16x8*)(rp + 64 + pc * 8);
        R.c0[i] = *(const f32x4*)(rope + t * 64 + pc * 8); R.c1[i] = *(const f32x4*)(rope + t * 64 + pc * 8 + 4);
        R.s0[i] = *(const f32x4*)(rope + SEQ * 64 + t * 64 + pc * 8); R.s1[i] = *(const f32x4*)(rope + SEQ * 64 + t * 64 + pc * 8 + 4);
    }
#pragma unroll
    for (int i = 0; i < 4; ++i) { const int q4 = tid + 512 * i, row = q4 >> 4, ch = q4 & 15, t = n * 128 + row;
        R.v[i] = *(const bf16x8*)(proj + (size_t)(b * SEQ + t) * DIN + OFF_VR + h * 128 + ch * 8); }
}
__device__ __forceinline__ void kv_store(LAS unsigned char* lds, const KVRaw& R, int tid) {
#pragma unroll
    for (int i = 0; i < 2; ++i) {
        const int q2 = tid + 512 * i, row = q2 >> 3, pc = q2 & 7;
        float fa[8], fb[8], o1[8], o2[8];
        unpack8(R.ka[i], fa); unpack8(R.kb[i], fb);
        const float cs[8] = {R.c0[i].x, R.c0[i].y, R.c0[i].z, R.c0[i].w, R.c1[i].x, R.c1[i].y, R.c1[i].z, R.c1[i].w}, sn[8] = {R.s0[i].x, R.s0[i].y, R.s0[i].z, R.s0[i].w, R.s1[i].x, R.s1[i].y, R.s1[i].z, R.s1[i].w};
#pragma unroll
        for (int e = 0; e < 8; ++e) { o1[e] = fa[e] * cs[e] - fb[e] * sn[e]; o2[e] = fb[e] * cs[e] + fa[e] * sn[e]; }
        *(LAS bf16x8*)(lds + LK + offb(row, pc)) = pack8(o1); *(LAS bf16x8*)(lds + LK + offb(row, pc + 8)) = pack8(o2);
    }
#pragma unroll
    for (int i = 0; i < 4; ++i) { const int q4 = tid + 512 * i, row = q4 >> 4, ch = q4 & 15; *(LAS bf16x8*)(lds + LV + offb(row, ch)) = R.v[i]; }
}
__device__ __forceinline__ void rb_dma(LAS unsigned char* lds, const unsigned char* img, int w, int lane) {
#pragma unroll
    for (int i = 0; i < 5; ++i) { const int o = w + 8 * i; if (o < (int)TILE / 1024)
        __builtin_amdgcn_global_load_lds((const unsigned*)(img + o * 1024 + lane * 16), (LAS unsigned*)(lds + LRB + o * 1024), 16, 0, 0); }
}
template <bool FWD> __device__ __forceinline__ void state_update(LAS unsigned char* lds, f32x4 (&racc)[8], float l2, int w, int g, unsigned qp, unsigned p) {
    const float dec = __builtin_amdgcn_exp2f(128.f * l2);
    bf16x8 vs[4];
#pragma unroll
    for (int ks = 0; ks < 4; ++ks) {
        float f[8]; unpack8(trfrag(lds + LV, 32 * ks + 4 * g, 32 * ks + 16 + 4 * g, w, qp, p), f);
#pragma unroll
        for (int e = 0; e < 8; ++e) { const int key = 32 * ks + 16 * (e >> 2) + 4 * g + (e & 3); f[e] *= __builtin_amdgcn_exp2f((FWD ? (float)(127 - key) : (float)key) * l2); }
        vs[ks] = pack8(f);
    }
#pragma unroll
    for (int nb = 0; nb < 8; ++nb) {
        racc[nb] = racc[nb] * dec;
#pragma unroll
        for (int ks = 0; ks < 4; ++ks) racc[nb] = __builtin_amdgcn_mfma_f32_16x16x32_bf16(vs[ks], trfrag(lds + LK, 32 * ks + 4 * g, 32 * ks + 16 + 4 * g, nb, qp, p), racc[nb], 0, 0, 0);
    }
}
__device__ __forceinline__ void unit(const bf16_t* __restrict__ proj, const float* __restrict__ rope, const float* __restrict__ log_decay, const float* __restrict__ gn_g, bf16_t* __restrict__ ymix,
                                     unsigned char* __restrict__ scratch  , LAS unsigned char* lds, int hu, const int tid_in) {
    const int u = hu >> 1, n0 = (hu & 1) * 8, n1 = n0 + 8;
    const int b = u >> 2, h = u & 3;
    int tid_ = tid_in; asm volatile("" : "+v"(tid_));
    const int tid0 = tid_, w = __builtin_amdgcn_readfirstlane(tid0 >> 6);
#define RET_LANE int tid = tid0; asm volatile("" : "+v"(tid)); const int lane = tid & 63, r = lane & 15, g = lane >> 4; const unsigned qp = (unsigned)r >> 2, p = (unsigned)lane & 3u;
    const float lf2_ = log_decay[h] * LOG2E, lb2_ = log_decay[4 + h] * LOG2E;
    f32x4 racc[8];
#pragma unroll
    for (int nb = 0; nb < 8; ++nb) racc[nb] = (f32x4){0.f, 0.f, 0.f, 0.f};
    KVRaw raw;
    kv_load(raw, proj, rope, b, h, 15, tid0);
    for (int n = 15; n >= n0; --n) {
        RET_LANE
        if (n < n1) {
            unsigned char* img = scratch + (size_t)(n - n0) * TILE;
#pragma unroll
            for (int nb = 0; nb < 8; ++nb) { u32x2 o; o.x = cvtpk(racc[nb][0], racc[nb][1]); o.y = cvtpk(racc[nb][2], racc[nb][3]);
                *(u32x2*)(img + offb(16 * nb + r, 2 * w + (g >> 1)) + 8 * (g & 1)) = o; }
        }
        if (n == n0) break;
        float lb2 = lb2_; asm volatile("" : "+v"(lb2));
        __syncthreads();
        kv_store(lds, raw, tid);
        __syncthreads();
        kv_load(raw, proj, rope, b, h, n - 1 > n0 ? n - 1 : 0, tid);
        state_update<false>(lds, racc, lb2, w, g, qp, p);
    }
    asm volatile("s_waitcnt vmcnt(0)" ::: "memory");
    __syncthreads();
    __builtin_amdgcn_fence(__ATOMIC_ACQUIRE, "agent");
    asm volatile("s_waitcnt vmcnt(0)" ::: "memory");
#pragma unroll
    for (int nb = 0; nb < 8; ++nb) racc[nb] = (f32x4){0.f, 0.f, 0.f, 0.f};
    for (int n = 0; n < n0; ++n) {
        RET_LANE
        float lf2 = lf2_; asm volatile("" : "+v"(lf2));
        __syncthreads();
        kv_store(lds, raw, tid);
        __syncthreads();
        kv_load(raw, proj, rope, b, h, n + 1, tid);
        state_update<true>(lds, racc, lf2, w, g, qp, p);
    }
    rb_dma(lds, scratch, w, tid0 & 63);
    for (int n = n0; n < n1; ++n) {
        RET_LANE
        float lf2 = lf2_, lb2 = lb2_; asm volatile("" : "+v"(lf2), "+v"(lb2));
        const __attribute__((address_space(1))) float* gnp = (const __attribute__((address_space(1))) float*)gn_g; asm volatile("" : "+s"(gnp));
        __syncthreads();
        kv_store(lds, raw, tid);
#pragma unroll
        for (int nb = 0; nb < 8; ++nb) { u32x2 o; o.x = cvtpk(racc[nb][0], racc[nb][1]); o.y = cvtpk(racc[nb][2], racc[nb][3]);
            *(LAS u32x2*)(lds + LRF + offb(16 * nb + r, 2 * w + (g >> 1)) + 8 * (g & 1)) = o; }
        const int cq = 16 * w + r, tq = n * 128 + cq;
        bf16x8 qn[4], qf[4], qb[4];
        { const bf16_t* rp = proj + (size_t)(b * SEQ + tq) * DIN + OFF_QR + h * 128 + 4 * g;
          const float sf = __builtin_amdgcn_exp2f((float)(cq + 1) * lf2), sb = __builtin_amdgcn_exp2f((float)(128 - cq) * lb2);
#pragma unroll
          for (int ks = 0; ks < 2; ++ks) {
              float fa[8], fb[8], o1[8], o2[8], t1[8], t2[8];
              { const u32x2 a0 = *(const u32x2*)(rp + 32 * ks), a1 = *(const u32x2*)(rp + 32 * ks + 16), b0 = *(const u32x2*)(rp + 32 * ks + 64), b1 = *(const u32x2*)(rp + 32 * ks + 80);
                unpack8(__builtin_bit_cast(bf16x8, (u32x4){a0.x, a0.y, a1.x, a1.y}), fa); unpack8(__builtin_bit_cast(bf16x8, (u32x4){b0.x, b0.y, b1.x, b1.y}), fb); }
              const float* cp = rope + tq * 64 + 32 * ks + 4 * g; const float* sp = cp + SEQ * 64;
              const f32x4 c0 = *(const f32x4*)cp, c1 = *(const f32x4*)(cp + 16), s0 = *(const f32x4*)sp, s1 = *(const f32x4*)(sp + 16);
              const float cs[8] = {c0.x, c0.y, c0.z, c0.w, c1.x, c1.y, c1.z, c1.w}, sn[8] = {s0.x, s0.y, s0.z, s0.w, s1.x, s1.y, s1.z, s1.w};
#pragma unroll
              for (int e = 0; e < 8; ++e) { o1[e] = fa[e] * cs[e] - fb[e] * sn[e]; o2[e] = fb[e] * cs[e] + fa[e] * sn[e]; }
              qn[ks] = pack8(o1); qn[ks + 2] = pack8(o2);
#pragma unroll
              for (int e = 0; e < 8; ++e) { t1[e] = o1[e] * sf; t2[e] = o2[e] * sf; }
              qf[ks] = pack8(t1); qf[ks + 2] = pack8(t2);
#pragma unroll
              for (int e = 0; e < 8; ++e) { t1[e] = o1[e] * sb; t2[e] = o2[e] * sb; }
              qb[ks] = pack8(t1); qb[ks + 2] = pack8(t2);
          } }
        asm volatile("s_waitcnt vmcnt(0)" ::: "memory");
        __syncthreads();
        kv_load(raw, proj, rope, b, h, n + 1 < n1 ? n + 1 : n, tid);
        u32x2 gv[8];
        { const bf16_t* gp = proj + (size_t)(b * SEQ + tq) * DIN + OFF_GR + h * 128 + 4 * g;
#pragma unroll
          for (int mbv = 0; mbv < 8; ++mbv) gv[mbv] = *(const u32x2*)(gp + 16 * mbv); }
        bf16x8 pt[4];
#pragma unroll
        for (int ks2 = 0; ks2 < 4; ++ks2) {
            float pv[8];
#pragma unroll
            for (int hb = 0; hb < 2; ++hb) {
                const int mb = 2 * ks2 + hb;
                f32x4 st = (f32x4){0.f, 0.f, 0.f, 0.f};
#pragma unroll
                for (int ks = 0; ks < 4; ++ks) { const LAS unsigned char* kp = lds + LK + RS * (16 * mb + r) + 64 * ks + 8 * g; const u32x2 k0 = *(const LAS u32x2*)kp, k1 = *(const LAS u32x2*)(kp + 32);
                    st = __builtin_amdgcn_mfma_f32_16x16x32_bf16(__builtin_bit_cast(bf16x8, (u32x4){k0.x, k0.y, k1.x, k1.y}), qn[ks], st, 0, 0, 0); }
#pragma unroll
                for (int j = 0; j < 4; ++j) { const int diff = cq - (16 * mb + 4 * g + j); pv[4 * hb + j] = st[j] * __builtin_amdgcn_exp2f(diff >= 0 ? (float)diff * lf2 : (float)(-diff) * lb2); }
            }
            pt[ks2] = pack8(pv);
        }
        f32x4 yacc[8];
#pragma unroll
        for (int mbv = 0; mbv < 8; ++mbv) {
            f32x4 y = (f32x4){0.f, 0.f, 0.f, 0.f};
#pragma unroll
            for (int ks2 = 0; ks2 < 4; ++ks2) y = __builtin_amdgcn_mfma_f32_16x16x32_bf16(trfrag(lds + LV, 32 * ks2 + 4 * g, 32 * ks2 + 16 + 4 * g, mbv, qp, p), pt[ks2], y, 0, 0, 0);
#pragma unroll
            for (int ks = 0; ks < 4; ++ks) {
                y = __builtin_amdgcn_mfma_f32_16x16x32_bf16(trfrag(lds + LRF, 32 * ks + 4 * g, 32 * ks + 16 + 4 * g, mbv, qp, p), qf[ks], y, 0, 0, 0);
                y = __builtin_amdgcn_mfma_f32_16x16x32_bf16(trfrag(lds + LRB, 32 * ks + 4 * g, 32 * ks + 16 + 4 * g, mbv, qp, p), qb[ks], y, 0, 0, 0);
            }
            yacc[mbv] = y;
        }
        __syncthreads();
        if (n + 1 < n1) rb_dma(lds, scratch + (size_t)(n + 1 - n0) * TILE, w, lane);
        { float s = 0.f;
#pragma unroll
          for (int mbv = 0; mbv < 8; ++mbv) s += (yacc[mbv][0] + yacc[mbv][1]) + (yacc[mbv][2] + yacc[mbv][3]);
          s += __shfl_xor(s, 16); s += __shfl_xor(s, 32);
          const float mu = s * (1.f / 128.f); float s2 = 0.f;
#pragma unroll
          for (int mbv = 0; mbv < 8; ++mbv) { yacc[mbv] = yacc[mbv] - mu; s2 += (yacc[mbv][0] * yacc[mbv][0] + yacc[mbv][1] * yacc[mbv][1]) + (yacc[mbv][2] * yacc[mbv][2] + yacc[mbv][3] * yacc[mbv][3]); }
          s2 += __shfl_xor(s2, 16); s2 += __shfl_xor(s2, 32);
          const float rstd = 1.f / sqrtf(s2 * (1.f / 128.f) + GN_EPS);
          bf16_t* op = ymix + (size_t)(b * SEQ + tq) * D + 512 + h * 128 + 4 * g;
#pragma unroll
          for (int mbv = 0; mbv < 8; ++mbv) {
              const f32x4 gn = *(const __attribute__((address_space(1))) f32x4*)(gnp + h * 128 + 16 * mbv + 4 * g);
              const float g0 = __uint_as_float(gv[mbv].x << 16), g1 = __uint_as_float(gv[mbv].x & 0xffff0000u), g2 = __uint_as_float(gv[mbv].y << 16), g3 = __uint_as_float(gv[mbv].y & 0xffff0000u);
              u32x2 o; o.x = cvtpk(silu_f(g0) * (yacc[mbv][0] * rstd * gn.x), silu_f(g1) * (yacc[mbv][1] * rstd * gn.y));
              o.y = cvtpk(silu_f(g2) * (yacc[mbv][2] * rstd * gn.z), silu_f(g3) * (yacc[mbv][3] * rstd * gn.w));
              *(u32x2*)(op + 16 * mbv) = o;
          } }
        state_update<true>(lds, racc, lf2, w, g, qp, p);
    }
    __syncthreads();
#undef RET_LANE
}
}


namespace na {
constexpr unsigned LKR = 0, LVR = 73728, LRPB = 147456;
__device__ __forceinline__ void load_row(LAS unsigned char* lds, const bf16_t* __restrict__ proj, int b, int head, int krow, int tid) {
    const int key = tid >> 3, ch = tid & 7, slot = krow % 9;
    const bf16_t* rp = proj + (size_t)(b * SEQ + krow * 64 + key) * DIN + head * 64 + ch * 8;
    const unsigned o = (unsigned)slot * 8192u + 128u * key + 16u * (ch ^ (key & 7));
    *(LAS u32x4*)(lds + LKR + o) = *(const u32x4*)(rp + OFF_KNA);
    *(LAS u32x4*)(lds + LVR + o) = *(const u32x4*)(rp + OFF_VNA);
}
__device__ __forceinline__ void unit(const bf16_t* __restrict__ proj, const float* __restrict__ rpb, bf16_t* __restrict__ ymix, LAS unsigned char* lds, int u, const int tid_in) {
    const int b = u >> 3, head = u & 7;
    int tid_ = tid_in; asm volatile("" : "+v"(tid_));
    const int tid0 = tid_, w = __builtin_amdgcn_readfirstlane(tid0 >> 6);
    __syncthreads();
    if (tid0 < 465) ((LAS float*)(lds + LRPB))[tid0] = rpb[head * 465 + tid0];
    const int ct = w & 3, cb = (ct == 0) ? 0 : (ct == 1 ? 8 : (ct == 2 ? 24 : 32));
    u32x4 pk[2], pv2[2]; int pre_lo = 0, pre_n = 0;
    for (int st = 0; st < 16; ++st) {
        int tid = tid0; asm volatile("" : "+v"(tid));
        const int lane = tid & 63, qi = lane & 15, g = lane >> 4; const unsigned qp = (unsigned)qi >> 2, p = (unsigned)lane & 3u;
        const int r = 2 * st + (w >> 2);
        const int rs = min(max(r - 4, 0), 24);
        const int need_hi = min(max(2 * st + 1 - 4, 0), 24) + 7;
        __syncthreads();
        if (st == 0) { for (int kr = 0; kr <= need_hi; ++kr) load_row(lds, proj, b, head, kr, tid); }
        else {
#pragma unroll
            for (int i = 0; i < 2; ++i) if (i < pre_n) { const int key = tid >> 3, ch = tid & 7; const unsigned o = (unsigned)((pre_lo + i) % 9) * 8192u + 128u * key + 16u * (ch ^ (key & 7));
                *(LAS u32x4*)(lds + LKR + o) = pk[i]; *(LAS u32x4*)(lds + LVR + o) = pv2[i]; }
        }
        const int cq = 16 * ct + qi, tq = b * SEQ + r * 64 + cq;
        bf16x8 qn[2];
        { const bf16_t* qptr = proj + (size_t)tq * DIN + OFF_QNA + head * 64 + 8 * g; qn[0] = *(const bf16x8*)qptr; qn[1] = *(const bf16x8*)(qptr + 32); }
        __syncthreads();
        { const int nh = (st < 15) ? min(max(2 * st + 3 - 4, 0), 24) + 7 : need_hi; pre_lo = need_hi + 1; pre_n = nh - need_hi;
#pragma unroll
          for (int i = 0; i < 2; ++i) if (i < pre_n) { const int key = tid >> 3, ch = tid & 7; const bf16_t* rp = proj + (size_t)(b * SEQ + (pre_lo + i) * 64 + key) * DIN + head * 64 + ch * 8;
              pk[i] = *(const u32x4*)(rp + OFF_KNA); pv2[i] = *(const u32x4*)(rp + OFF_VNA); } }
        const int cs = min(max(cq - 8, 0), 48);
        const unsigned kb0 = 128u * qi + 16u * ((unsigned)g ^ ((unsigned)qi & 7u)), kb1 = 128u * qi + 16u * ((4u + (unsigned)g) ^ ((unsigned)qi & 7u));
        const LAS float* bias = (const LAS float*)(lds + LRPB);
        f32x4 sc[16]; float mx = -3.0e38f;
#pragma unroll
        for (int kr = 0; kr < 8; ++kr) {
            const int krow = rs + kr; const unsigned so = (unsigned)(krow % 9) * 8192u + 128u * (unsigned)cb;
            const int dr = krow - r + 7;
#pragma unroll
            for (int h2 = 0; h2 < 2; ++h2) {
                f32x4 a = (f32x4){0.f, 0.f, 0.f, 0.f};
                a = __builtin_amdgcn_mfma_f32_16x16x32_bf16(*(const LAS bf16x8*)(lds + LKR + so + 2048u * h2 + kb0), qn[0], a, 0, 0, 0);
                a = __builtin_amdgcn_mfma_f32_16x16x32_bf16(*(const LAS bf16x8*)(lds + LKR + so + 2048u * h2 + kb1), qn[1], a, 0, 0, 0);
#pragma unroll
                for (int j = 0; j < 4; ++j) {
                    const int kcol = cb + 16 * h2 + 4 * g + j;
                    const int dc = min(max(kcol - cq + 15, 0), 30);
                    const float v = a[j] + bias[dr * 31 + dc];
                    const bool in = (kcol >= cs) && (kcol < cs + 16);
                    a[j] = in ? v : -3.0e38f; mx = fmaxf(mx, a[j]);
                }
                sc[2 * kr + h2] = a;
            }
        }
        mx = fmaxf(mx, __shfl_xor(mx, 16)); mx = fmaxf(mx, __shfl_xor(mx, 32));
        float sum = 0.f; bf16x8 pt[8];
#pragma unroll
        for (int kk = 0; kk < 8; ++kk) {
            float pv[8];
#pragma unroll
            for (int h2 = 0; h2 < 2; ++h2)
#pragma unroll
                for (int j = 0; j < 4; ++j) { const float e = __builtin_amdgcn_exp2f((sc[2 * kk + h2][j] - mx) * 1.4426950408889634f); pv[4 * h2 + j] = e; sum += e; }
            pt[kk] = ret::pack8(pv);
        }
        sum += __shfl_xor(sum, 16); sum += __shfl_xor(sum, 32);
        const float inv = 1.f / sum;
        const unsigned sl = (((unsigned)g & 1u) << 2) | qp;
        bf16_t* op = ymix + (size_t)tq * D + head * 64 + 4 * g;
#pragma unroll
        for (int db = 0; db < 4; ++db) {
            const unsigned vb = 128u * (4u * (unsigned)g + qp) + 16u * ((2u * db + (p >> 1)) ^ sl) + 8u * (p & 1u);
            f32x4 y = (f32x4){0.f, 0.f, 0.f, 0.f};
#pragma unroll
            for (int kk = 0; kk < 8; ++kk) {
                const unsigned so = (unsigned)((rs + kk) % 9) * 8192u + 128u * (unsigned)cb;
                const ret::s16x4 lo = __builtin_amdgcn_ds_read_tr16_b64_v4i16((LAS ret::s16x4*)(lds + LVR + so + vb));
                const ret::s16x4 hi = __builtin_amdgcn_ds_read_tr16_b64_v4i16((LAS ret::s16x4*)(lds + LVR + so + 2048u + vb));
                y = __builtin_amdgcn_mfma_f32_16x16x32_bf16(__builtin_shufflevector(lo, hi, 0, 1, 2, 3, 4, 5, 6, 7), pt[kk], y, 0, 0, 0);
            }
            u32x2 o; o.x = ret::cvtpk(y[0] * inv, y[1] * inv); o.y = ret::cvtpk(y[2] * inv, y[3] * inv);
            *(u32x2*)(op + 16 * db) = o;
        }
    }
    __syncthreads();
}
}

__device__ __forceinline__ void ln1_row(const float* __restrict__ io, const float* __restrict__ g, const float* __restrict__ bb, const float* __restrict__ mod, bf16_t* __restrict__ hf, unsigned char* __restrict__ hf8, float* __restrict__ stats, int row, int lane) {
    const int b = row >> 11;
    f32x4 v[4]; float s = 0.f;
#pragma unroll
    for (int j = 0; j < 4; ++j) { v[j] = *(const f32x4*)(io + (size_t)row * D + j * 256 + lane * 4); s += (v[j].x + v[j].y) + (v[j].z + v[j].w); }
    const float mean = wave_sum(s) * (1.f / D); float s2 = 0.f;
#pragma unroll
    for (int j = 0; j < 4; ++j) { v[j] = v[j] - mean; s2 += (v[j].x * v[j].x + v[j].y * v[j].y) + (v[j].z * v[j].z + v[j].w * v[j].w); }
    const float rstd = 1.f / sqrtf(wave_sum(s2) * (1.f / D) + LN_EPS);
    if (lane == 0) *(f32x2*)(stats + 2 * (size_t)row) = (f32x2){mean, rstd};
#pragma unroll
    for (int j = 0; j < 4; ++j) { const int col = j * 256 + lane * 4;
        const f32x4 gg = *(const f32x4*)(g + col), bv = *(const f32x4*)(bb + col);
        const f32x4 x1 = v[j] * rstd * gg + bv;
        const f32x4 sc = *(const f32x4*)(mod + b * 6144 + MOD_SCALE_F + col), sh = *(const f32x4*)(mod + b * 6144 + MOD_SHIFT_F + col);
        u32x2 o; o.x = pk2(x1.x * (1.f + sc.x) + sh.x, x1.y * (1.f + sc.y) + sh.y); o.y = pk2(x1.z * (1.f + sc.z) + sh.z, x1.w * (1.f + sc.w) + sh.w);
        *(u32x2*)(hf + (size_t)row * D + col) = o;
        const f32x4 h4 = (x1 * (sc + 1.f) + sh) * S_HF8;
        int w0 = __builtin_amdgcn_cvt_pk_fp8_f32(clamp8(h4.x), clamp8(h4.y), 0, false); w0 = __builtin_amdgcn_cvt_pk_fp8_f32(clamp8(h4.z), clamp8(h4.w), w0, true);
        *(unsigned*)(hf8 + (size_t)row * D + col) = (unsigned)w0; }
}
__device__ __forceinline__ void top2_merge(float& a1, float& a2, float b1, float b2) { const float n1 = fmaxf(a1, b1); const float n2 = fmaxf(fminf(a1, b1), fmaxf(a2, b2)); a1 = n1; a2 = n2; }
__device__ __forceinline__ void route_token(const float* __restrict__ logits, const f32x4 bias, int* __restrict__ topk_e, float* __restrict__ topk_w, LAS unsigned* hist, int tok, int lane) {
    const f32x4 lg = *(const f32x4*)(logits + (size_t)tok * NE + lane * 4);
    const float sc0 = 1.f / (1.f + __expf(-lg.x)), sc1 = 1.f / (1.f + __expf(-lg.y)), sc2 = 1.f / (1.f + __expf(-lg.z)), sc3 = 1.f / (1.f + __expf(-lg.w));
    float s0 = sc0 + bias.x, s1 = sc1 + bias.y, s2 = sc2 + bias.z, s3 = sc3 + bias.w;
    float m1 = fmaxf(s0, s1), m2 = fminf(s0, s1); top2_merge(m1, m2, fmaxf(s2, s3), fminf(s2, s3));
#pragma unroll
    for (int o = 1; o < 8; o <<= 1) { const float b1 = __shfl_xor(m1, o), b2 = __shfl_xor(m2, o); top2_merge(m1, m2, b1, b2); }
    const float gs = m1 + m2; const int grp = lane >> 3;
    int rank = 0;
#pragma unroll
    for (int gq = 0; gq < 8; ++gq) { const float og = __shfl(gs, gq * 8); rank += (og > gs || (og == gs && gq < grp)) ? 1 : 0; }
    const float NEG = -3.0e38f;
    if (rank >= 4) { s0 = NEG; s1 = NEG; s2 = NEG; s3 = NEG; }
    float wsum = 0.f; float myw = 0.f; int mye = 0;
#pragma unroll
    for (int k = 0; k < TOPK; ++k) {
        float bv = s0; int bi = 0;
        if (s1 > bv) { bv = s1; bi = 1; }
        if (s2 > bv) { bv = s2; bi = 2; }
        if (s3 > bv) { bv = s3; bi = 3; }
        int be = lane * 4 + bi;
#pragma unroll
        for (int o = 1; o < 64; o <<= 1) { const float ov = __shfl_xor(bv, o); const int oe = __shfl_xor(be, o); if (ov > bv || (ov == bv && oe < be)) { bv = ov; be = oe; } }
        const int ol = be >> 2, oj = be & 3;
        const float mysc = oj == 0 ? sc0 : (oj == 1 ? sc1 : (oj == 2 ? sc2 : sc3));
        const float wsel = __shfl(mysc, ol);
        if (lane == ol) { if (oj == 0) s0 = NEG; else if (oj == 1) s1 = NEG; else if (oj == 2) s2 = NEG; else s3 = NEG; }
        wsum += wsel;
        if (lane == k) { myw = wsel; mye = be; }
    }
    if (lane < TOPK) { topk_e[tok * TOPK + lane] = mye; topk_w[tok * TOPK + lane] = myw / wsum * 2.5f; __hip_atomic_fetch_add(&hist[mye], 1u, __ATOMIC_RELAXED, __HIP_MEMORY_SCOPE_WORKGROUP); }
}
__device__ __forceinline__ void build_tables(const unsigned* ctl, LAS unsigned* tab, const int tid) {
    if (tid < 64) {
        const int lane = tid;
        unsigned c[4], so = 0, st = 0;
#pragma unroll
        for (int j = 0; j < 4; ++j) { c[j] = __hip_atomic_load(ctl + CW_COUNT + lane * 4 + j, __ATOMIC_RELAXED, __HIP_MEMORY_SCOPE_AGENT); so += c[j]; st += (c[j] + 255u) >> 8; }
        unsigned io = so, it = st;
#pragma unroll
        for (int o = 1; o < 64; o <<= 1) { const unsigned a = __shfl_up(io, o), b = __shfl_up(it, o); if (lane >= o) { io += a; it += b; } }
        unsigned eo = io - so, et = it - st;
#pragma unroll
        for (int j = 0; j < 4; ++j) { tab[T_CNT + lane * 4 + j] = c[j]; tab[T_OFF + lane * 4 + j] = eo; tab[T_TILE + lane * 4 + j] = et; eo += c[j]; et += (c[j] + 255u) >> 8; }
        if (lane == 63) { tab[T_OFF + NE] = eo; tab[T_TILE + NE] = et; }
    }
    __syncthreads();
}
__device__ __forceinline__ void final_row(float* __restrict__ io, const unsigned char* __restrict__ ybuf, const unsigned char* __restrict__ ysh, const float* __restrict__ g, const float* __restrict__ bb, const float* __restrict__ mod,
                                          const float* __restrict__ g1, const float* __restrict__ b1, const float* __restrict__ stats, int row, int lane) {
    const int b = row >> 11; const f32x2 st1 = *(const f32x2*)(stats + 2 * (size_t)row);
    f32x4 v[4]; float s = 0.f;
#pragma unroll
    for (int j = 0; j < 4; ++j) {
        const int col = j * 256 + lane * 4;
        f32x4 a = (f32x4){0.f, 0.f, 0.f, 0.f};
#pragma unroll
        for (int k = 0; k < TOPK; ++k) {
            const unsigned pk = *(const unsigned*)(ybuf + ((size_t)row * TOPK + k) * D + col);
            const f32x2 lo = __builtin_amdgcn_cvt_pk_f32_fp8((int)pk, false), hi = __builtin_amdgcn_cvt_pk_f32_fp8((int)pk, true);
            a.x += lo.x; a.y += lo.y; a.z += hi.x; a.w += hi.y;
        }
        { const unsigned pk = *(const unsigned*)(ysh + (size_t)row * D + col);
          const f32x2 lo = __builtin_amdgcn_cvt_pk_f32_fp8((int)pk, false), hi = __builtin_amdgcn_cvt_pk_f32_fp8((int)pk, true);
          a.x += lo.x; a.y += lo.y; a.z += hi.x; a.w += hi.y; }
        const f32x4 gt = *(const f32x4*)(mod + b * 6144 + MOD_GATE_F + col);
        const f32x4 x1 = (*(const f32x4*)(io + (size_t)row * D + col) - st1.x) * st1.y * *(const f32x4*)(g1 + col) + *(const f32x4*)(b1 + col);
        v[j] = x1 * ALPHA + gt * a * YINV;
        s += (v[j].x + v[j].y) + (v[j].z + v[j].w);
    }
    const float mean = wave_sum(s) * (1.f / D); float s2 = 0.f;
#pragma unroll
    for (int j = 0; j < 4; ++j) { v[j] = v[j] - mean; s2 += (v[j].x * v[j].x + v[j].y * v[j].y) + (v[j].z * v[j].z + v[j].w * v[j].w); }
    const float rstd = 1.f / sqrtf(wave_sum(s2) * (1.f / D) + LN_EPS);
#pragma unroll
    for (int j = 0; j < 4; ++j) { const int col = j * 256 + lane * 4; const f32x4 gg = *(const f32x4*)(g + col), bv = *(const f32x4*)(bb + col);
        *(f32x4*)(io + (size_t)row * D + col) = v[j] * rstd * gg + bv; }
}

#ifndef MK_PER_PHASE
#define MK_PER_PHASE 0
#endif
constexpr int N_PHASES = 13;
struct Args { Ctx X; int ph_lo, ph_hi; };
typedef __attribute__((address_space(4))) const Ctx* CtxCP;
__device__ __forceinline__ CtxCP ctx_ptr() { CtxCP p = (CtxCP)__builtin_amdgcn_kernarg_segment_ptr(); asm volatile("" : "+s"(p)); return p; }

__global__ void __launch_bounds__(NW * 64, 2) mk_fwd(Args args) {
    extern __shared__ __attribute__((aligned(16))) unsigned char lds_raw[];
    LAS unsigned char* lds = (LAS unsigned char*)lds_raw;
    LAS unsigned* tab = (LAS unsigned*)(lds + TAB_OFF);
    volatile LAS unsigned* MISC = (volatile LAS unsigned*)(lds + MISC_OFF);
#define PH_BEGIN \
    const __attribute__((address_space(4))) Ctx& X = *ctx_ptr(); unsigned char* ws = X.ws; (void)ws; \
    const int lane = lane_id(), wave = wave0, tid = wave0 * 64 + lane; (void)lane; (void)wave; (void)tid; \
    const int G = gridDim.x, bx = blockIdx.x; (void)G; (void)bx; \
    const int gw = bx * NW + wave, NGW = G * NW; (void)gw; (void)NGW; \
    const int gt = bx * (NW * 64) + tid, NGT = G * NW * 64; (void)gt; (void)NGT; \
    unsigned* ctl = (unsigned*)(ws + WS_CTL); float* mod = (float*)(ws + WS_MOD); float* rope = (float*)(ws + WS_ROPE); (void)ctl; (void)mod; (void)rope; \
    bf16_t* win_t = (bf16_t*)(ws + WS_WIN_T); bf16_t* wout_t = (bf16_t*)(ws + WS_WOUT_T); bf16_t* wr_t = (bf16_t*)(ws + WS_WR_T); (void)win_t; (void)wout_t; (void)wr_t; \
    bf16_t* wsgu_t = (bf16_t*)(ws + WS_WSGU_T); bf16_t* wsd_t = (bf16_t*)(ws + WS_WSD_T); bf16_t* wd_t = (bf16_t*)(ws + WS_WD_T); bf16_t* wgu_t = (bf16_t*)(ws + WS_WGU_T); (void)wsgu_t; (void)wsd_t; (void)wd_t; (void)wgu_t; \
    int* slot_ent = (int*)(ws + WS_SLOT_ENT); float* slot_w = (float*)(ws + WS_SLOT_W); int* topk_e = (int*)(ws + WS_TOPK_E); float* topk_w = (float*)(ws + WS_TOPK_W); (void)slot_ent; (void)slot_w; (void)topk_e; (void)topk_w; \
    bf16_t* ymix = (bf16_t*)(ws + WS_YMIX); bf16_t* proj = (bf16_t*)(ws + WS_PROJ); bf16_t* hbuf = (bf16_t*)(ws + WS_YMIX); (void)ymix; (void)proj; (void)hbuf; \
    float* logits = (float*)(ws + WS_LOGITS); bf16_t* shh = (bf16_t*)(ws + WS_SHH); bf16_t* hf = (bf16_t*)(ws + WS_HF); bf16_t* act = (bf16_t*)(ws + WS_ACT); (void)logits; (void)shh; (void)hf; (void)act; \
    unsigned char* ybuf = ws + WS_YBUF; float* out = X.out; (void)ybuf; (void)out;

    const int wave0 = __builtin_amdgcn_readfirstlane((int)threadIdx.x >> 6);
    for (int u = threadIdx.x; u < (LDS_BYTES - MISC_OFF) / 4; u += NW * 64) ((LAS unsigned*)(lds + MISC_OFF))[u] = 0u;
    __syncthreads();
    if (!MK_PER_PHASE) { unsigned* ctl0 = (unsigned*)(args.X.ws + WS_CTL); (void)xcd_barrier_post(ctl0 + CW_BAR, MISC + 8, wave0 == 0 && lane_id() == 0); }
    const int lo = args.ph_lo, hi = args.ph_hi;
#ifndef MK_DUP
#define MK_DUP -1
#endif
#define REPS(k) for (int _rep = 0; _rep < ((MK_DUP == (k)) ? 2 : 1); ++_rep)
#ifdef MK_ONLY
#define IN(k) ((k) == MK_ONLY)
#else
#define IN(k) (lo <= (k) && (k) < hi)
#endif
#define SEAM(k) SEAM2(k, (k) + 1)
#define SEAM2(k, k2) do { if (IN(k) && IN(k2)) { XcdBarrier _b; _b.bar = (unsigned*)(ctx_ptr()->ws + WS_CTL) + CW_BAR; _b.x = xb_xcc_id(); _b.st = (volatile LAS unsigned*)(lds + MISC_OFF) + 8; xcd_barrier(_b, wave0 == 0 && lane_id() == 0); } } while (0)

    REPS(0) if (IN(0)) { PH_BEGIN
        LAS float* scr = (LAS float*)(lds + wave * 16384);
        float* modp = (float*)(ws + WS_PROJ);
        for (int t = gw; t < 96 * 16; t += NGW) mod_task(X.c, X.w_ada, modp, t, lane);
        constexpr int I_IN = (D / 64) * (DIN / 32), I_OUT = (D / 64) * (D / 32), I_R = (D / 64) * (NE / 32), I_SG = (D / 64) * (DE / 32), I_SD = (DE / 64) * (D / 32);
        constexpr int I_EG = I_SG, I_ED = I_SD;
        constexpr int N_SMALL = I_IN + I_OUT + I_R + 2 * I_SG + I_SD;
        constexpr int N_ITEMS = N_SMALL + NE * (2 * I_EG + I_ED);
        for (int it = gw; it < N_ITEMS; it += NGW) {
            int r = it;
            if (r < I_IN) { transpose_item(X.w_in, D, DIN, win_t, 0, 0, scr, r, lane); continue; } r -= I_IN;
            if (r < I_OUT) { transpose_item(X.w_out, D, D, wout_t, 0, 0, scr, r, lane); continue; } r -= I_OUT;
            if (r < I_R) { transpose_item(X.w_router, D, NE, wr_t, 0, 0, scr, r, lane); continue; } r -= I_R;
            if (r < I_SG) { transpose_item(X.ws_gate, D, DE, wsgu_t, 8, 0, scr, r, lane); continue; } r -= I_SG;
            if (r < I_SG) { transpose_item(X.ws_up, D, DE, wsgu_t, 8, 1, scr, r, lane); continue; } r -= I_SG;
            if (r < I_SD) { transpose_item(X.ws_down, DE, D, wsd_t, 0, 0, scr, r, lane); continue; } r -= I_SD;
            const int e = r / (2 * I_EG + I_ED); r -= e * (2 * I_EG + I_ED);
            if (r < I_EG) { transpose_item_fp8(X.w_gate + (size_t)e * D * DE, D, DE, (unsigned char*)wgu_t + (size_t)e * 512 * D, 8, 0, S_WGU8, scr, r, lane); continue; } r -= I_EG;
            if (r < I_EG) { transpose_item_fp8(X.w_up + (size_t)e * D * DE, D, DE, (unsigned char*)wgu_t + (size_t)e * 512 * D, 8, 1, S_WGU8, scr, r, lane); continue; } r -= I_EG;
            transpose_item_fp8(X.w_down + (size_t)e * DE * D, DE, D, (unsigned char*)wd_t + (size_t)e * D * DE, 0, 0, S_WD8, scr, r, lane);
        }
        for (int i = gt; i < SEQ * 64; i += NGT) rope_entry(rope, i);
    }
    SEAM(0);
    REPS(1) if (IN(1)) { PH_BEGIN
        const float* modp = (const float*)(ws + WS_PROJ);
        for (int i = gt; i < 32 * 6144; i += NGT) mod[i] = mod_sum(modp, X.b_ada, i / 6144, i % 6144);
        LAS float* ssc = (LAS float*)lds; LAS float* ssh = ssc + 1024;
        int curb = -1;
        for (int c = bx; c < M / 256; c += G) {
            const int b = c >> 3;
            if (b != curb) {
                __syncthreads();
                for (int i = tid; i < 1024; i += NW * 64) { ssc[i] = 1.f + mod_sum(modp, X.b_ada, b, MOD_SCALE_A + i); ssh[i] = mod_sum(modp, X.b_ada, b, MOD_SHIFT_A + i); }
                __syncthreads();
                curb = b;
            }
            const f32x4 sc = *(const LAS f32x4*)(ssc + (tid & 255) * 4), sh = *(const LAS f32x4*)(ssh + (tid & 255) * 4);
            const float* xp = X.x + (size_t)c * 256 * D + (size_t)(tid >> 8) * D + (tid & 255) * 4;
            bf16_t* hp = hbuf + (size_t)c * 256 * D + (size_t)(tid >> 8) * D + (tid & 255) * 4;
            for (int i0 = 0; i0 < 128; i0 += 8) {
                f32x4 v[8];
#pragma unroll
                for (int i = 0; i < 8; ++i) v[i] = __builtin_nontemporal_load((const f32x4*)(xp + (size_t)(i0 + i) * 2 * D));
#pragma unroll
                for (int i = 0; i < 8; ++i) { u32x2 o; o.x = pk2(v[i].x * sc.x + sh.x, v[i].y * sc.y + sh.y); o.y = pk2(v[i].z * sc.z + sh.z, v[i].w * sc.w + sh.w); *(u32x2*)(hp + (size_t)(i0 + i) * 2 * D) = o; }
            }
        }
        __syncthreads();
    }
    SEAM(1);
    REPS(2) if (IN(2)) { PH_BEGIN
        pg8::DenseOrder S; S.init(M, DIN, D, win_t, G, bx);
        pg8::EpiInProj E{proj};
        pg8::gemm_phase(lds, (const char*)hbuf, D, S, E, tid);
    }
    SEAM(2);
    REPS(3) if (IN(3)) { PH_BEGIN
        REPS(31) for (int hu = bx; hu < BATCH * 4 * 2; hu += G) ret::unit(proj, rope, X.ret_ld, X.ret_gn, ymix, (unsigned char*)out + (size_t)hu * (8 * ret::TILE), lds, hu, tid);
        REPS(32) for (int u = bx; u < BATCH * 8; u += G) na::unit(proj, X.na_rpb, ymix, lds, u, tid);
    }
    SEAM2(3, 5);
    REPS(5) if (IN(5)) { PH_BEGIN
        pg8::DenseOrder S; S.init(M, D, D, wout_t, G, bx);
        pg8::EpiOutProj E{X.x, mod, out};
        pg8::gemm_phase(lds, (const char*)ymix, D, S, E, tid);
    }
    SEAM(5);
    REPS(6) if (IN(6)) { PH_BEGIN for (int r = gw; r < M; r += NGW) ln1_row(out, X.ln1_g, X.ln1_b, mod, hf, ws + WS_HF8, (float*)(ws + WS_STATS), r, lane); }
    SEAM(6);
    REPS(7) if (IN(7)) { PH_BEGIN
        { pg8::DenseOrder S; S.init(M, NE, D, wr_t, G, bx); pg8::EpiRouter E{logits}; pg8::gemm_phase(lds, (const char*)hf, D, S, E, tid); }
        { pg8::DenseOrder S; S.init(M, 2 * DE, D, wsgu_t, G, bx); pg8::EpiGU<false> E{(void*)shh}; pg8::gemm_phase(lds, (const char*)hf, D, S, E, tid); }
    }
    SEAM(7);
    if (IN(8)) { PH_BEGIN
        LAS unsigned* hist = tab + T_HIST;
        if (tid < NE) hist[tid] = 0u;
        __syncthreads();
        const f32x4 bias = *(const f32x4*)(X.rbias + lane * 4);
        for (int tok = gw; tok < M; tok += NGW) route_token(logits, bias, topk_e, topk_w, hist, tok, lane);
        __syncthreads();
        if (tid < NE && hist[tid]) atomicAdd(&ctl[CW_COUNT + tid], hist[tid]);
    }
    SEAM(8);
    if (IN(9)) { PH_BEGIN
        build_tables(ctl, tab, tid);
        LAS unsigned* hist = tab + T_HIST; LAS unsigned* base = tab + T_BASE;
        for (int c0 = bx * 2048; c0 < NSLOT; c0 += G * 2048) {
            __syncthreads();
            if (tid < NE) hist[tid] = 0u;
            __syncthreads();
            int e[4]; unsigned loc[4];
#pragma unroll
            for (int i = 0; i < 4; ++i) { const int idx = c0 + i * 512 + tid; e[i] = topk_e[idx]; loc[i] = __hip_atomic_fetch_add(&hist[e[i]], 1u, __ATOMIC_RELAXED, __HIP_MEMORY_SCOPE_WORKGROUP); }
            __syncthreads();
            if (tid < NE && hist[tid]) base[tid] = atomicAdd(&ctl[CW_CURSOR + tid], hist[tid]);
            __syncthreads();
#pragma unroll
            for (int i = 0; i < 4; ++i) { const int idx = c0 + i * 512 + tid; const unsigned pos = tab[T_OFF + e[i]] + base[e[i]] + loc[i]; slot_ent[pos] = idx; slot_w[pos] = topk_w[idx]; }
        }
    }
    SEAM(9);
    if (IN(10)) { PH_BEGIN
        build_tables(ctl, tab, tid);
        REPS(10) { pg8::ExpertOrder<2, true> S; S.init(tab, D, wgu_t, (size_t)512 * D, slot_ent, slot_w, G, bx); pg8::EpiGU<true> E{(void*)act}; pg8::gemm_phase<1>(lds, (const char*)(ws + WS_HF8), D, S, E, tid); }
        { pg8::DenseOrder S; S.init(M, D, DE, wsd_t, G, bx); pg8::EpiSharedDown E{ws + WS_YSH}; pg8::gemm_phase(lds, (const char*)shh, DE, S, E, tid); }
    }
    SEAM(10);
    REPS(11) if (IN(11)) { PH_BEGIN
        build_tables(ctl, tab, tid);
        pg8::ExpertOrder<4, false> S; S.init(tab, DE, wd_t, (size_t)D * DE, slot_ent, slot_w, G, bx); pg8::EpiExpDown E{ybuf, slot_ent}; pg8::gemm_phase<1>(lds, (const char*)act, DE, S, E, tid);
    }
    SEAM(11);
    if (IN(12)) { PH_BEGIN for (int r = gw; r < M; r += NGW) final_row(out, ybuf, ws + WS_YSH, X.ln2_g, X.ln2_b, mod, X.ln1_g, X.ln1_b, (const float*)(ws + WS_STATS), r, lane); }
#undef IN
#undef SEAM
}

extern "C" void kernel_launch(void* const* d_in, const int* in_sizes, int n_in, void* d_out, int out_size, void* d_ws, size_t ws_size, hipStream_t stream) {
    static int grid = 0;
    if (grid == 0) {
        if (n_in != 21 || in_sizes[0] != M * D || out_size != M * D || ws_size < WS_END) { fprintf(stderr, "kernel_launch: unexpected shapes (n_in %d, ws %zu)\n", n_in, ws_size); grid = -1; return; }
        int dev = 0, cus = 0, per_cu = 0;
        if (hipGetDevice(&dev) != hipSuccess || hipDeviceGetAttribute(&cus, hipDeviceAttributeMultiprocessorCount, dev) != hipSuccess) { grid = -1; return; }
        if (hipFuncSetAttribute((const void*)mk_fwd, hipFuncAttributeMaxDynamicSharedMemorySize, LDS_BYTES) != hipSuccess) { fprintf(stderr, "kernel_launch: hipFuncSetAttribute failed\n"); grid = -1; return; }
        if (hipOccupancyMaxActiveBlocksPerMultiprocessor(&per_cu, (const void*)mk_fwd, NW * 64, LDS_BYTES) != hipSuccess || per_cu < 1) { fprintf(stderr, "kernel_launch: occupancy query says %d\n", per_cu); }
        (void)hipGetLastError();
        grid = cus;
    }
    if (grid < 0) return;
    (void)hipMemsetAsync((char*)d_ws + WS_CTL, 0, 1 * MiB, stream);
    Args a{};
    const float** p = (const float**)&a.X;
    for (int i = 0; i < 21; ++i) p[i] = (const float*)d_in[i];
    a.X.out = (float*)d_out; a.X.ws = (unsigned char*)d_ws;
#if MK_PER_PHASE
    for (int ph = 0; ph < N_PHASES; ++ph) { a.ph_lo = ph; a.ph_hi = ph + 1; hipLaunchKernelGGL(mk_fwd, dim3(grid), dim3(NW * 64), LDS_BYTES, stream, a); }
#else
    a.ph_lo = 0; a.ph_hi = N_PHASES;
    hipLaunchKernelGGL(mk_fwd, dim3(grid), dim3(NW * 64), LDS_BYTES, stream, a);
#endif
}
```

```cpp
#include <hip/hip_runtime.h>
#include <cstdio>
#include <cstdint>

typedef unsigned short bf16_t;
typedef short bf16x8 __attribute__((ext_vector_type(8)));
typedef float f32x4 __attribute__((ext_vector_type(4)));
typedef float f32x2 __attribute__((ext_vector_type(2)));
typedef unsigned u32x4 __attribute__((ext_vector_type(4)));
typedef unsigned u32x2 __attribute__((ext_vector_type(2)));
#define LAS __attribute__((address_space(3)))

constexpr int D = 1024, BATCH = 32, SEQ = 2048, M = BATCH * SEQ;
constexpr int DIN = 3584;
constexpr int OFF_QNA = 0, OFF_KNA = 512, OFF_VNA = 1024, OFF_QR = 1536, OFF_KR = 2048, OFF_VR = 2560, OFF_GR = 3072;
constexpr int NE = 256, TOPK = 8, DE = 256;
constexpr int NSLOT = M * TOPK;
constexpr float LN_EPS = 1e-5f, GN_EPS = 1e-6f;
constexpr float ALPHA = 1.189207115002721f;
constexpr float YSCALE = 64.f, YINV = 1.f / 64.f;
constexpr float S_HF8 = 16.f, S_WGU8 = 256.f, S_ACT8 = 32.f, S_WD8 = 128.f;
constexpr float INV_GU8 = 1.f / (16.f * 256.f), INV_DN8 = 1.f / (32.f * 128.f);
constexpr int MOD_SHIFT_A = 0, MOD_SCALE_A = 1024, MOD_GATE_A = 2048, MOD_SHIFT_F = 3072, MOD_SCALE_F = 4096, MOD_GATE_F = 5120;

constexpr size_t MiB = 1u << 20;
constexpr size_t WS_CTL = 0;
constexpr size_t WS_MOD = 1 * MiB;
constexpr size_t WS_ROPE = 2 * MiB;
constexpr size_t WS_WIN_T = 4 * MiB;
constexpr size_t WS_WOUT_T = 11 * MiB;
constexpr size_t WS_WR_T = 13 * MiB;
constexpr size_t WS_WSGU_T = 14 * MiB;
constexpr size_t WS_WSD_T = 15 * MiB;
constexpr size_t WS_SLOT_ENT = 16 * MiB;
constexpr size_t WS_SLOT_W = 18 * MiB;
constexpr size_t WS_TOPK_E = 20 * MiB;
constexpr size_t WS_TOPK_W = 22 * MiB;
constexpr size_t WS_STATS = 24 * MiB;
constexpr size_t WS_WD_T = 32 * MiB;
constexpr size_t WS_WGU_T = 160 * MiB;
constexpr size_t WS_HF8 = 288 * MiB;
constexpr size_t WS_YMIX = 416 * MiB;
constexpr size_t WS_PROJ = 544 * MiB;
constexpr size_t WS_LOGITS = WS_YMIX, WS_SHH = WS_YMIX + 64 * MiB;
constexpr size_t WS_HF = WS_PROJ, WS_ACT = WS_PROJ + 128 * MiB;
constexpr size_t WS_YBUF = WS_WGU_T;
constexpr size_t WS_TB = WS_PROJ + 256 * MiB;
constexpr size_t WS_YSH = WS_PROJ + 384 * MiB;
constexpr size_t WS_END = 992 * MiB;
constexpr int CW_COUNT = 1024, CW_CURSOR = 1536, CW_BAR = 8192;

constexpr int RING_BYTES = 131072;
constexpr int TAB_OFF = RING_BYTES;
constexpr int T_OFF = 0, T_TILE = 260, T_CNT = 520, T_HIST = 776, T_BASE = 1032, TAB_WORDS = 1288;
constexpr int VN_OFF = TAB_OFF + 6144;
constexpr int ROWTAB_OFF = VN_OFF + 8192;
constexpr int PHASE_BYTES = 155648;
constexpr int MISC_OFF = PHASE_BYTES;
constexpr int LDS_BYTES = PHASE_BYTES + 256;
static_assert(TAB_WORDS * 4 <= 6144 && ROWTAB_OFF + 6144 <= PHASE_BYTES && LDS_BYTES <= 163840, "LDS map");

__device__ __forceinline__ unsigned f2bf(float f) { unsigned u = __float_as_uint(f); return (u + 0x7fffu + ((u >> 16) & 1u)) >> 16; }
__device__ __forceinline__ float bf2f(unsigned short h) { return __uint_as_float(((unsigned)h) << 16); }
__device__ __forceinline__ unsigned pk2(float lo, float hi) { return f2bf(lo) | (f2bf(hi) << 16); }
__device__ __forceinline__ unsigned cvt_pk_bf16(float lo, float hi) { unsigned r; asm volatile("v_cvt_pk_bf16_f32 %0, %1, %2" : "=v"(r) : "v"(lo), "v"(hi)); return r; }
__device__ __forceinline__ float silu_f(float v) { return v * __builtin_amdgcn_rcpf(1.f + __expf(-v)); }
__device__ __forceinline__ float wave_sum(float v) {
#pragma unroll
    for (int o = 1; o < 64; o <<= 1) v += __shfl_xor(v, o);
    return v;
}
__device__ __forceinline__ float clamp8(float v) { return __builtin_amdgcn_fmed3f(v, -440.f, 440.f); }
#define LDS_WAIT() asm volatile("s_waitcnt lgkmcnt(0)" ::: "memory")
__device__ __forceinline__ int lane_id() { return (int)__builtin_amdgcn_mbcnt_hi(~0u, __builtin_amdgcn_mbcnt_lo(~0u, 0u)); }

#define XB_TMO      128
#define XB_XCNT(j)  (256  + 64 * (j))
#define XB_XSUB(j)  (1280 + 64 * (j))
#define XB_XGEN(j)  (2304 + 64 * (j))
#define XB_TOP      3328
#define XB_TOPGEN   3392
#define XCD_BAR_WORDS 3456
#define XB_SPIN_CAP (1u << 23)
__device__ __forceinline__ unsigned xb_ld(unsigned* p)              { return __hip_atomic_load(p, __ATOMIC_RELAXED, __HIP_MEMORY_SCOPE_AGENT); }
__device__ __forceinline__ unsigned xb_add(unsigned* p, unsigned v) { return __hip_atomic_fetch_add(p, v, __ATOMIC_RELAXED, __HIP_MEMORY_SCOPE_AGENT); }
__device__ __forceinline__ unsigned xb_xcc_id() { return (unsigned)__builtin_amdgcn_s_getreg((3 << 11) | 20) & 0xFu; }
#define XB_SPIN(cond, bar) do { unsigned _sp = 0; while (cond) { __builtin_amdgcn_s_sleep(1); \
    if ((++_sp & 255u) == 0u) { if (xb_ld(&(bar)[XB_TMO])) break; if (_sp > XB_SPIN_CAP) { atomicAdd(&(bar)[XB_TMO], 1u); break; } } } } while (0)
struct XcdBarrier { unsigned* bar; unsigned x; volatile LAS unsigned* st; };
__device__ __forceinline__ XcdBarrier xcd_barrier_post(unsigned* bar, volatile LAS unsigned* st, bool leader) {
    XcdBarrier b; b.bar = bar; b.x = xb_xcc_id(); b.st = st;
    if (leader) (void)xb_add(&bar[XB_XCNT(b.x)], 1u);
    return b;
}
__device__ __forceinline__ void xcd_barrier_complete(unsigned* bar, unsigned x, unsigned& nloc, unsigned& nx) {
    const unsigned G = gridDim.x * gridDim.y * gridDim.z;
    unsigned sum, cnt, mine, sp = 0u;
    for (;;) {
        sum = 0u; cnt = 0u; mine = 0u;
#pragma unroll
        for (unsigned j = 0; j < 16; ++j) { const unsigned c = xb_ld(&bar[XB_XCNT(j)]); sum += c; cnt += (c > 0u) ? 1u : 0u; mine = (j == x) ? c : mine; }
        if (sum == G) break;
        __builtin_amdgcn_s_sleep(1);
        if ((++sp & 255u) == 0u) { if (xb_ld(&bar[XB_TMO])) break; if (sp > XB_SPIN_CAP) { atomicAdd(&bar[XB_TMO], 1u); break; } }
    }
    nloc = mine > 0u ? mine : 1u; nx = cnt > 0u ? cnt : 1u;
}
__device__ __forceinline__ void xcd_barrier(const XcdBarrier& b, bool leader) {
    asm volatile("s_waitcnt vmcnt(0)" ::: "memory");
    __syncthreads();
    if (leader) {
        unsigned* bar = b.bar;
        __builtin_amdgcn_s_waitcnt(0);
        unsigned nloc = b.st[0], nx = b.st[1];
        if (nloc == 0u) { xcd_barrier_complete(bar, b.x, nloc, nx); b.st[0] = nloc; b.st[1] = nx; }
        const unsigned old = xb_add(&bar[XB_XSUB(b.x)], 1u);
        const unsigned gen = old / nloc;
        if (old + 1u == (gen + 1u) * nloc) {
            __builtin_amdgcn_fence(__ATOMIC_RELEASE, "agent");
            asm volatile("s_waitcnt vmcnt(0)" ::: "memory");
            const unsigned og = xb_add(&bar[XB_TOP], 1u);
            const unsigned tg = og / nx;
            if (og + 1u == (tg + 1u) * nx) xb_add(&bar[XB_TOPGEN], 1u);
            else XB_SPIN(xb_ld(&bar[XB_TOPGEN]) == tg, bar);
            __builtin_amdgcn_fence(__ATOMIC_ACQUIRE, "agent");
            xb_add(&bar[XB_XGEN(b.x)], 1u);
            asm volatile("s_waitcnt vmcnt(0)" ::: "memory");
        } else {
            XB_SPIN(xb_ld(&bar[XB_XGEN(b.x)]) == gen, bar);
            __builtin_amdgcn_fence(__ATOMIC_ACQUIRE, "agent");
            asm volatile("s_waitcnt vmcnt(0)" ::: "memory");
        }
    }
    __syncthreads();
}

namespace pg8 {
constexpr int BM = 256, BK = 64, HALF = 128, HTB = HALF * BK * 2, STAGE_BYTES = 8 * HTB;
__device__ __forceinline__ int lds_byte(int r, int c) { const int st = (r >> 4) * 2 + (c >> 5), rr = r & 15, cc = c & 31, ob = rr * 64 + cc * 2; return st * 1024 + (ob ^ (((ob >> 9) & 1) << 5)); }
__device__ __forceinline__ void stage_rc(int b, int& R, int& C) { const int st = b / 1024, sb = b % 1024, swz = sb ^ (((sb >> 9) & 1) << 5); R = (st >> 1) * 16 + swz / 64; C = (st & 1) * 32 + (swz % 64) / 2; }
__device__ __forceinline__ int perm32(int rho) { const int n = rho >> 4, i = rho & 15; return 8 * (i >> 2) + 4 * n + (i & 3); }

typedef int i32x8 __attribute__((ext_vector_type(8)));
__device__ __forceinline__ i32x8 cat8(const bf16x8 lo, const bf16x8 hi) { const u32x4 a = __builtin_bit_cast(u32x4, lo), b = __builtin_bit_cast(u32x4, hi); return (i32x8){(int)a.x, (int)a.y, (int)a.z, (int)a.w, (int)b.x, (int)b.y, (int)b.z, (int)b.w}; }
struct Unit { int pm, pn; const char* B; int e, cnt, off; };

template <int ESZ = 2, class Epi, class Sched>
__device__ __forceinline__ void gemm_phase(LAS unsigned char* lds, const char* Abase, const int K, const Sched& S, const Epi& E, const int tid_in) {
    int tid_ = tid_in; asm volatile("" : "+v"(tid_));
    const int tid = tid_, wid = __builtin_amdgcn_readfirstlane(tid >> 6), lane = tid & 63, wr = wid >> 2, wc = wid & 3, fr = lane & 15, fq = lane >> 4;
    const int rowbytes = K * ESZ, nt = rowbytes / 128;
    int Rr[2], Cc[2]; unsigned voffB[2], voffA[2];
#pragma unroll
    for (int i = 0; i < 2; ++i) { int R, C; stage_rc(tid * 16 + i * 8192, R, C); Rr[i] = R; Cc[i] = C; const int Rb = Epi::PERM ? (64 * (R >> 5) + 16 * ((R >> 2) & 3) + 4 * ((R >> 4) & 1) + (R & 3)) : R; voffB[i] = (unsigned)(Rb * rowbytes + C * 2); voffA[i] = (unsigned)(R * rowbytes + C * 2); }
    constexpr bool GATHER = Sched::GATHER;
    const size_t kstep = (size_t)128;
    const size_t hstep = (size_t)HALF * rowbytes;
    const size_t bhstep = (size_t)(Epi::PERM ? 8 : HALF) * rowbytes;
    const unsigned ldsw = (unsigned)wid * 1024u;
    const int aoff = (ESZ == 2) ? lds_byte(wr * 64 + fr, fq * 8) : lds_byte(wr * 64 + fr, 16 * (fq & 1)) + 1024 * (fq >> 1);
    const int boff = (ESZ == 2) ? lds_byte(wc * 32 + fr, fq * 8) : lds_byte(wc * 32 + fr, 16 * (fq & 1)) + 1024 * (fq >> 1);
#define PG8_SA(b, h) (((b) * 2 + (h)) * HTB)
#define PG8_SB(b, h) ((4 + (b) * 2 + (h)) * HTB)
#define PG8_STAGE(bufoff, gbase, voff) do { _Pragma("unroll") for (int _i = 0; _i < 2; ++_i) \
        __builtin_amdgcn_global_load_lds((const unsigned*)((const char*)(gbase) + (voff)[_i]), (LAS unsigned*)(lds + (bufoff) + ldsw + _i * 8192), 16, 0, 0); } while (0)
#define PG8_STAGEA(bufoff, uptr, koff, NEXT, h) do { if constexpr (GATHER) { if (NEXT) { const u32x2 _t = *(const LAS u32x2*)(vnslot + 2 * (h)); unsigned _v[2] = {_t.x, _t.y}; PG8_STAGE(bufoff, Abase + (koff), _v); } else { PG8_STAGE(bufoff, Abase + (koff), vc[h]); } } \
        else { PG8_STAGE(bufoff, (uptr) + (size_t)(h) * hstep + (koff), voffA); } } while (0)
#define PG8_LDA(dst, b, h) do { _Pragma("unroll") for (int m = 0; m < 4; ++m) { if constexpr (ESZ == 2) { _Pragma("unroll") for (int k = 0; k < 2; ++k) dst[m].q[k] = *(const LAS bf16x8*)(lds + PG8_SA(b, h) + aoff + m * 2048 + k * 1024); } \
        else dst[m].w = cat8(*(const LAS bf16x8*)(lds + PG8_SA(b, h) + aoff + m * 2048), *(const LAS bf16x8*)(lds + PG8_SA(b, h) + aoff + m * 2048 + 16)); } } while (0)
#define PG8_LDB(dst, b, h) do { _Pragma("unroll") for (int n = 0; n < 2; ++n) { if constexpr (ESZ == 2) { _Pragma("unroll") for (int k = 0; k < 2; ++k) dst[n].q[k] = *(const LAS bf16x8*)(lds + PG8_SB(b, h) + boff + n * 2048 + k * 1024); } \
        else dst[n].w = cat8(*(const LAS bf16x8*)(lds + PG8_SB(b, h) + boff + n * 2048), *(const LAS bf16x8*)(lds + PG8_SB(b, h) + boff + n * 2048 + 16)); } } while (0)
#define PG8_MMA(ai, bj, At, Bt) do { __builtin_amdgcn_s_setprio(1); _Pragma("unroll") for (int m = 0; m < 4; ++m) _Pragma("unroll") for (int n = 0; n < 2; ++n) { \
        if constexpr (ESZ == 2) { _Pragma("unroll") for (int k = 0; k < 2; ++k) acc[ai][bj][m][n] = __builtin_amdgcn_mfma_f32_16x16x32_bf16(Bt[n].q[k], At[m].q[k], acc[ai][bj][m][n], 0, 0, 0); } \
        else { asm volatile("v_mfma_f32_16x16x128_f8f6f4 %0, %1, %2, %0" : "+v"(acc[ai][bj][m][n]) : "v"(Bt[n].w), "v"(At[m].w)); } } \
        __builtin_amdgcn_s_setprio(0); } while (0)
#define PG8_WAIT_V(n) asm volatile("s_waitcnt vmcnt(" #n ")" ::: "memory")
#define PG8_WAIT_L(n) asm volatile("s_waitcnt lgkmcnt(" #n ")" ::: "memory")
#define PG8_BAR __builtin_amdgcn_s_barrier()
#define PG8_SCHED __builtin_amdgcn_sched_barrier(0)
    Unit cur, nxt; int ui = 0;
    if (!S.next(0, cur)) return;
    f32x4 acc[2][2][4][2];
    union Frag { bf16x8 q[2]; i32x8 w; };
    Frag At[4], B0[2], B1[2];
    unsigned vc[2][2];
    LAS unsigned* vnslot = (LAS unsigned*)(lds + (VN_OFF - 0)) + tid * 4;
    if constexpr (GATHER) S.avoff(cur, Rr, Cc, vc, tid);
    LAS unsigned* rowtab = (LAS unsigned*)(lds + ROWTAB_OFF);
    if constexpr (GATHER) S.rowtab(cur, rowtab, tid);
    const char* cB = cur.B; const char* cA = Abase + S.aoff(cur);
    PG8_STAGE(PG8_SB(0, 0), cB, voffB); PG8_STAGE(PG8_SB(0, 1), cB + bhstep, voffB); PG8_STAGEA(PG8_SA(0, 0), cA, 0, false, 0); PG8_STAGEA(PG8_SA(0, 1), cA, 0, false, 1);
    if (wr == 1) PG8_BAR;
    PG8_WAIT_V(2); PG8_BAR;
    PG8_STAGE(PG8_SB(1, 0), cB + kstep, voffB); PG8_STAGEA(PG8_SA(1, 0), cA, kstep, false, 0); PG8_STAGE(PG8_SB(1, 1), cB + bhstep + kstep, voffB);
    PG8_WAIT_V(6); PG8_BAR;
    asm volatile("" ::: "memory");
#pragma unroll
    for (int a = 0; a < 2; ++a)
#pragma unroll
        for (int b = 0; b < 2; ++b)
#pragma unroll
            for (int m = 0; m < 4; ++m)
#pragma unroll
                for (int n = 0; n < 2; ++n) { acc[a][b][m][n] = (f32x4){0.f, 0.f, 0.f, 0.f}; asm volatile("" : "+v"(acc[a][b][m][n])); }
    asm volatile("s_nop 4" ::: "memory");
    for (;;) {
        const bool has_next = S.next(ui + 1, nxt);
        if constexpr (GATHER) {
            unsigned vn[2][2];
            if (has_next) S.avoff(nxt, Rr, Cc, vn, tid);
            else {
#pragma unroll
                for (int h = 0; h < 2; ++h)
#pragma unroll
                    for (int i = 0; i < 2; ++i) vn[h][i] = vc[h][i];
            }
            *(LAS u32x4*)vnslot = (u32x4){vn[0][0], vn[0][1], vn[1][0], vn[1][1]};
            if (has_next) S.rowtab(nxt, rowtab + 512 * ((ui + 1) % 3), tid);
        }
        const char* nB = has_next ? nxt.B : cB; const char* nA = has_next ? Abase + S.aoff(nxt) : cA;
        for (int t = 0; t < nt; t += 2) {
            const bool last = (t == nt - 2);
            const size_t k1 = (size_t)(t + 1) * kstep;
            const size_t k2 = last ? (size_t)0 : (size_t)(t + 2) * kstep, k3 = k2 + kstep;
            const char* u2 = last ? nA : cA; const char* b2 = last ? nB : cB + (size_t)(t + 2) * kstep;
            const char* b3 = b2 + kstep;
            PG8_LDB(B0, 0, 0); PG8_LDB(B1, 0, 1); PG8_SCHED; PG8_LDA(At, 0, 0); PG8_STAGEA(PG8_SA(1, 1), cA, k1, false, 1);
            PG8_WAIT_V(8); PG8_WAIT_L(0); PG8_BAR; PG8_MMA(0, 0, At, B0); PG8_MMA(0, 1, At, B1); PG8_BAR; PG8_SCHED;
            PG8_LDA(At, 0, 1); PG8_STAGE(PG8_SB(0, 0), b2, voffB); PG8_STAGE(PG8_SB(0, 1), b2 + bhstep, voffB); PG8_STAGEA(PG8_SA(0, 0), u2, k2, last, 0);
            PG8_WAIT_V(8); PG8_WAIT_L(0); PG8_BAR; PG8_MMA(1, 0, At, B0); PG8_MMA(1, 1, At, B1); PG8_BAR; PG8_SCHED;
            PG8_LDB(B0, 1, 0); PG8_LDB(B1, 1, 1); PG8_SCHED; PG8_LDA(At, 1, 0); PG8_STAGEA(PG8_SA(0, 1), u2, k2, last, 1);
            PG8_WAIT_V(8); PG8_WAIT_L(0); PG8_BAR; PG8_MMA(0, 0, At, B0); PG8_MMA(0, 1, At, B1); PG8_BAR; PG8_SCHED;
            PG8_LDA(At, 1, 1); PG8_STAGE(PG8_SB(1, 0), b3, voffB); PG8_STAGE(PG8_SB(1, 1), b3 + bhstep, voffB); PG8_STAGEA(PG8_SA(1, 0), u2, k3, last, 0);
            PG8_WAIT_V(8); PG8_WAIT_L(0); PG8_BAR; PG8_MMA(1, 0, At, B0); PG8_MMA(1, 1, At, B1); PG8_BAR; PG8_SCHED;
        }
        if (wr == 0) PG8_BAR;
        if constexpr (ESZ == 1) {
            asm volatile("s_nop 15\n\ts_nop 15" ::: "memory");
#pragma unroll
            for (int a = 0; a < 2; ++a)
#pragma unroll
                for (int b = 0; b < 2; ++b)
#pragma unroll
                    for (int m = 0; m < 4; ++m) asm volatile("" : "+v"(acc[a][b][m][0]), "+v"(acc[a][b][m][1]));
        }
        { const int l2 = lane_id(); E(acc, cur, wr, wc, l2 & 15, l2 >> 4, rowtab + 512 * (ui % 3)); }
        if (!has_next) break;
#pragma unroll
        for (int a = 0; a < 2; ++a)
#pragma unroll
            for (int b = 0; b < 2; ++b)
#pragma unroll
                for (int m = 0; m < 4; ++m)
#pragma unroll
                    for (int n = 0; n < 2; ++n) acc[a][b][m][n] = (f32x4){0.f, 0.f, 0.f, 0.f};
        cur = nxt; cB = nB; cA = nA; ++ui;
        if constexpr (GATHER) { const u32x4 _t = *(const LAS u32x4*)vnslot; vc[0][0] = _t.x; vc[0][1] = _t.y; vc[1][0] = _t.z; vc[1][1] = _t.w; }
        if (wr == 1) PG8_BAR;
    }
    PG8_WAIT_V(0);
    PG8_BAR;
#undef PG8_SA
#undef PG8_SB
#undef PG8_STAGE
#undef PG8_STAGEA
#undef PG8_LDA
#undef PG8_LDB
#undef PG8_MMA
#undef PG8_WAIT_V
#undef PG8_WAIT_L
#undef PG8_BAR
#undef PG8_SCHED
}

struct DenseOrder {
    int nM, nN, nwg, G, c, K; const char* Bt;
    __device__ void init(int Mrows, int N, int K_, const void* Bt_, int G_, int c_) { nM = Mrows / BM; nN = N / BM; nwg = nM * nN; G = G_; c = c_; K = K_; Bt = (const char*)Bt_; }
    __device__ __forceinline__ bool next(int i, Unit& u) const {
        const long L = (long)i * G + c; if (L >= nwg) return false;
        int wgid = (int)L; { const int q = nwg / 8, r = nwg % 8, xcd = wgid % 8, off = wgid / 8; wgid = (xcd < r ? xcd * (q + 1) : r * (q + 1) + (xcd - r) * q) + off; }
        const int nig = 8 * nN, gid = wgid / nig, fm = gid * 8, gsz = (nM - fm) < 8 ? (nM - fm) : 8;
        u.pm = fm + ((wgid % nig) % gsz); u.pn = (wgid % nig) / gsz; u.B = Bt + (size_t)u.pn * BM * K * 2; u.e = 0; u.cnt = 0; u.off = 0; return true;
    }
    static constexpr bool GATHER = false;
    __device__ __forceinline__ size_t aoff(const Unit& u) const { return (size_t)u.pm * BM * K * 2; }
    __device__ __forceinline__ void avoff(const Unit&, const int (&)[2], const int (&)[2], unsigned (&)[2][2], int) const {}
};
template <int NCOL, bool TOKROWS> struct ExpertOrder {
    static constexpr bool GATHER = true;
    __device__ __forceinline__ size_t aoff(const Unit&) const { return 0; }
    const LAS unsigned* tab; int per, c, K  ; const char* W; size_t wstride; const int* slot_ent; const float* slot_w;
    mutable int ehint = 0;
    int xbase, xend, xstride, xlb;
    __device__ void init(const LAS unsigned* tab_, int K_, const void* W_, size_t wstride_, const int* slot_ent_, const float* slot_w_, int G, int c_) {
        tab = tab_; K = K_; W = (const char*)W_; wstride = wstride_; slot_ent = slot_ent_; slot_w = slot_w_; c = c_;
        const int U = (int)tab[T_TILE + NE] * NCOL; per = (U + G - 1) / G;
        if (G % 8 == 0) { const int x = c_ % 8; const int q = U / 8, r = U % 8; xbase = x * q + (x < r ? x : r); xend = xbase + q + (x < r ? 1 : 0); xstride = G / 8; xlb = c_ / 8; }
        else { xbase = 0; xend = U; xstride = G; xlb = c_; }
    }
    __device__ __forceinline__ bool next(int i, Unit& u) const {
        const int L = xbase + i * xstride + xlb;
        if (L >= xend) return false;
        const int tile = L / NCOL; u.pn = L % NCOL;
        int lo = ehint;
        if (i == 0) { lo = 0; int hi = NE - 1; while (lo < hi) { const int mid = (lo + hi + 1) >> 1; if ((int)tab[T_TILE + mid] <= tile) lo = mid; else hi = mid - 1; } }
        else { while (lo < NE - 1 && (int)tab[T_TILE + lo + 1] <= tile) ++lo; }
        ehint = lo;
        u.e = lo; u.pm = tile - (int)tab[T_TILE + lo]; u.cnt = (int)tab[T_CNT + lo]; u.off = (int)tab[T_OFF + lo];
        u.B = W + (size_t)lo * wstride + (size_t)u.pn * BM * K; return true;
    }
    __device__ __forceinline__ void rowtab(const Unit& u, LAS unsigned* t, int tid) const {
        if (tid < BM) { int r = u.pm * BM + tid; if (r >= u.cnt) r = u.cnt - 1; t[tid] = (unsigned)slot_ent[u.off + r]; t[BM + tid] = __float_as_uint(slot_w[u.off + r]); }
    }
    __device__ __forceinline__ void avoff(const Unit& u, const int (&)[2], const int (&)[2], unsigned (&v)[2][2], int tidq) const {
        int R[2], C[2]; asm volatile("" : "+v"(tidq));
#pragma unroll
        for (int i = 0; i < 2; ++i) stage_rc(tidq * 16 + i * 8192, R[i], C[i]);
#pragma unroll
        for (int h = 0; h < 2; ++h)
#pragma unroll
            for (int i = 0; i < 2; ++i) {
                int r = u.pm * BM + h * HALF + R[i]; if (r >= u.cnt) r = u.cnt - 1;
                const int slot = u.off + r;
                const int row = TOKROWS ? (slot_ent[slot] >> 3) : slot;
                v[h][i] = (unsigned)(row * K + C[i] * 2);
            }
    }
};

struct EpiInProj {
    static constexpr bool PERM = true; bf16_t* O;
    __device__ __forceinline__ void operator()(const f32x4 (&acc)[2][2][4][2], const Unit& u, int wr, int wc, int fr, int fq, const LAS unsigned* rt) const {
        const float sc = (u.pn < 2) ? 0.125f : ((u.pn == 8 || u.pn == 9) ? 0.08838834764831845f : 1.f);
        const int row0 = u.pm * BM + wr * 64 + fr, col0 = u.pn * BM + wc * 64 + 16 * fq;
#pragma unroll
        for (int ai = 0; ai < 2; ++ai)
#pragma unroll
            for (int m = 0; m < 4; ++m) { bf16_t* rowp = O + (size_t)(row0 + ai * HALF + m * 16) * DIN + col0;
#pragma unroll
                for (int bj = 0; bj < 2; ++bj) { const f32x4 v0 = acc[ai][bj][m][0] * sc, v1 = acc[ai][bj][m][1] * sc;
                    u32x4 w; w.x = cvt_pk_bf16(v0[0], v0[1]); w.y = cvt_pk_bf16(v0[2], v0[3]); w.z = cvt_pk_bf16(v1[0], v1[1]); w.w = cvt_pk_bf16(v1[2], v1[3]);
                    *(u32x4*)(rowp + 8 * bj) = w; } }
    }
};
struct EpiOutProj {
    static constexpr bool PERM = true; const float* x; const float* mod; bf16_t* tb;
    __device__ __forceinline__ void operator()(const f32x4 (&acc)[2][2][4][2], const Unit& u, int wr, int wc, int fr, int fq, const LAS unsigned* rt) const {
        const int b = (u.pm * BM) >> 11; const int col0 = u.pn * BM + wc * 64 + 16 * fq;
        f32x4 g[2][2];
#pragma unroll
        for (int bj = 0; bj < 2; ++bj)
#pragma unroll
            for (int n = 0; n < 2; ++n) g[bj][n] = *(const f32x4*)(mod + b * 6144 + MOD_GATE_A + col0 + 8 * bj + 4 * n);
#pragma unroll
        for (int ai = 0; ai < 2; ++ai)
#pragma unroll
            for (int m = 0; m < 4; ++m) { const size_t o = (size_t)(u.pm * BM + ai * HALF + wr * 64 + m * 16 + fr) * D + col0;
#pragma unroll
                for (int bj = 0; bj < 2; ++bj) {
                    const f32x4 t0 = *(const f32x4*)(x + o + 8 * bj) * ALPHA + g[bj][0] * acc[ai][bj][m][0], t1 = *(const f32x4*)(x + o + 8 * bj + 4) * ALPHA + g[bj][1] * acc[ai][bj][m][1];
                    u32x4 w; w.x = cvt_pk_bf16(t0[0], t0[1]); w.y = cvt_pk_bf16(t0[2], t0[3]); w.z = cvt_pk_bf16(t1[0], t1[1]); w.w = cvt_pk_bf16(t1[2], t1[3]);
                    *(u32x4*)(tb + o + 8 * bj) = w; } }
    }
};
struct EpiRouter {
    static constexpr bool PERM = false; float* out;
    __device__ __forceinline__ void operator()(const f32x4 (&acc)[2][2][4][2], const Unit& u, int wr, int wc, int fr, int fq, const LAS unsigned* rt) const {
        const int col0 = wc * 32 + 4 * fq;
#pragma unroll
        for (int ai = 0; ai < 2; ++ai)
#pragma unroll
            for (int m = 0; m < 4; ++m) { float* rowp = out + (size_t)(u.pm * BM + ai * HALF + wr * 64 + m * 16 + fr) * NE + col0;
#pragma unroll
                for (int bj = 0; bj < 2; ++bj)
#pragma unroll
                    for (int n = 0; n < 2; ++n) *(f32x4*)(rowp + bj * HALF + n * 16) = acc[ai][bj][m][n]; }
    }
};
template <bool EXPERT> struct EpiGU {
    static constexpr bool PERM = true; void* Ov;
    __device__ __forceinline__ void operator()(const f32x4 (&acc)[2][2][4][2], const Unit& u, int wr, int wc, int fr, int fq, const LAS unsigned* rt) const {
        const int h0 = u.pn * HALF + wc * 32 + 8 * fq;
#pragma unroll
        for (int ai = 0; ai < 2; ++ai)
#pragma unroll
            for (int m = 0; m < 4; ++m) {
                const int rtw = u.pm * BM + ai * HALF + wr * 64 + m * 16 + fr;
                if (EXPERT) { if (rtw >= u.cnt) continue; }
                const float w = EXPERT ? __uint_as_float(rt[BM + ai * HALF + wr * 64 + m * 16 + fr]) * (S_ACT8 * INV_GU8) : 1.f;
                const float gs = EXPERT ? INV_GU8 : 1.f;
                const f32x4 g0 = acc[ai][0][m][0] * gs, g1 = acc[ai][0][m][1] * gs, u0 = acc[ai][1][m][0], u1 = acc[ai][1][m][1];
                const float h[8] = {w * silu_f(g0[0]) * u0[0], w * silu_f(g0[1]) * u0[1], w * silu_f(g0[2]) * u0[2], w * silu_f(g0[3]) * u0[3],
                                    w * silu_f(g1[0]) * u1[0], w * silu_f(g1[1]) * u1[1], w * silu_f(g1[2]) * u1[2], w * silu_f(g1[3]) * u1[3]};
                if (EXPERT) {
                    int w0 = __builtin_amdgcn_cvt_pk_fp8_f32(clamp8(h[0]), clamp8(h[1]), 0, false); w0 = __builtin_amdgcn_cvt_pk_fp8_f32(clamp8(h[2]), clamp8(h[3]), w0, true);
                    int w1 = __builtin_amdgcn_cvt_pk_fp8_f32(clamp8(h[4]), clamp8(h[5]), 0, false); w1 = __builtin_amdgcn_cvt_pk_fp8_f32(clamp8(h[6]), clamp8(h[7]), w1, true);
                    u32x2 o; o.x = (unsigned)w0; o.y = (unsigned)w1; *(u32x2*)((unsigned char*)Ov + (size_t)(u.off + rtw) * DE + h0) = o;
                    asm volatile("" ::: "memory");
                } else {
                    u32x4 o; o.x = cvt_pk_bf16(h[0], h[1]); o.y = cvt_pk_bf16(h[2], h[3]); o.z = cvt_pk_bf16(h[4], h[5]); o.w = cvt_pk_bf16(h[6], h[7]);
                    *(u32x4*)((bf16_t*)Ov + (size_t)rtw * DE + h0) = o;
                }
            }
    }
};
struct EpiSharedDown {
    static constexpr bool PERM = true; unsigned char* ysh;
    __device__ __forceinline__ void operator()(const f32x4 (&acc)[2][2][4][2], const Unit& u, int wr, int wc, int fr, int fq, const LAS unsigned* rt) const {
        const int col0 = u.pn * BM + wc * 64 + 16 * fq;
#pragma unroll
        for (int ai = 0; ai < 2; ++ai)
#pragma unroll
            for (int m = 0; m < 4; ++m) {
                u32x4 o;
#pragma unroll
                for (int bj = 0; bj < 2; ++bj) { const f32x4 v0 = acc[ai][bj][m][0] * YSCALE, v1 = acc[ai][bj][m][1] * YSCALE;
                    int w0 = __builtin_amdgcn_cvt_pk_fp8_f32(clamp8(v0[0]), clamp8(v0[1]), 0, false); w0 = __builtin_amdgcn_cvt_pk_fp8_f32(clamp8(v0[2]), clamp8(v0[3]), w0, true);
                    int w1 = __builtin_amdgcn_cvt_pk_fp8_f32(clamp8(v1[0]), clamp8(v1[1]), 0, false); w1 = __builtin_amdgcn_cvt_pk_fp8_f32(clamp8(v1[2]), clamp8(v1[3]), w1, true);
                    if (bj == 0) { o.x = (unsigned)w0; o.y = (unsigned)w1; } else { o.z = (unsigned)w0; o.w = (unsigned)w1; } }
                *(u32x4*)(ysh + (size_t)(u.pm * BM + ai * HALF + wr * 64 + m * 16 + fr) * D + col0) = o;
            }
    }
};
struct EpiExpDown {
    static constexpr bool PERM = true; unsigned char* ybuf; const int* slot_ent;
    __device__ __forceinline__ void operator()(const f32x4 (&acc)[2][2][4][2], const Unit& u, int wr, int wc, int fr, int fq, const LAS unsigned* rt) const {
        const int col0 = u.pn * BM + wc * 64 + 16 * fq;
#pragma unroll
        for (int ai = 0; ai < 2; ++ai)
#pragma unroll
            for (int m = 0; m < 4; ++m) {
                const int rtw = u.pm * BM + ai * HALF + wr * 64 + m * 16 + fr; if (rtw >= u.cnt) continue;
                u32x4 o;
#pragma unroll
                for (int bj = 0; bj < 2; ++bj) { const f32x4 v0 = acc[ai][bj][m][0] * (YSCALE * INV_DN8), v1 = acc[ai][bj][m][1] * (YSCALE * INV_DN8);
                    int w0 = __builtin_amdgcn_cvt_pk_fp8_f32(clamp8(v0[0]), clamp8(v0[1]), 0, false); w0 = __builtin_amdgcn_cvt_pk_fp8_f32(clamp8(v0[2]), clamp8(v0[3]), w0, true);
                    int w1 = __builtin_amdgcn_cvt_pk_fp8_f32(clamp8(v1[0]), clamp8(v1[1]), 0, false); w1 = __builtin_amdgcn_cvt_pk_fp8_f32(clamp8(v1[2]), clamp8(v1[3]), w1, true);
                    if (bj == 0) { o.x = (unsigned)w0; o.y = (unsigned)w1; } else { o.z = (unsigned)w0; o.w = (unsigned)w1; } }
                *(u32x4*)(ybuf + (size_t)rt[ai * HALF + wr * 64 + m * 16 + fr] * D + col0) = o;
                asm volatile("" ::: "memory");
            }
    }
};
struct EpiProbeSum {
    static constexpr bool PERM = true; float* o;
    __device__ __forceinline__ void operator()(const f32x4 (&acc)[2][2][4][2], const Unit& u, int wr, int wc, int fr, int fq, const LAS unsigned* rt) const {
        f32x4 s = (f32x4){0.f, 0.f, 0.f, 0.f};
#pragma unroll
        for (int a = 0; a < 2; ++a)
#pragma unroll
            for (int b = 0; b < 2; ++b)
#pragma unroll
                for (int m = 0; m < 4; ++m) s += acc[a][b][m][0] + acc[a][b][m][1];
        if (s.x == 123.456f) *(f32x4*)(o + (size_t)(blockIdx.x * 512 + wr * 256 + wc * 64 + fq * 16 + fr) * 4) = s;
    }
};
}

struct Ctx {
    const float *x, *c, *w_ada, *b_ada, *w_in, *w_out, *na_rpb, *ret_ld, *ret_gn, *ln1_g, *ln1_b, *ln2_g, *ln2_b, *w_router, *rbias, *w_gate, *w_up, *w_down, *ws_gate, *ws_up, *ws_down;
    float* out; unsigned char* ws;
};
constexpr int NW = 8;

__device__ __forceinline__ void transpose_item(const float* W, int K, int N, bf16_t* WT, int G, int which, LAS float* scr, int item, int lane) {
    const int nblk = N / 32, kb = item / nblk, nb = item % nblk, k0 = 64 * kb, n0 = 32 * nb;
    float v[32];
#pragma unroll
    for (int i = 0; i < 32; ++i) { const int kk = 2 * i + (lane >> 5); v[i] = __builtin_nontemporal_load(W + (size_t)(k0 + kk) * N + n0 + (lane & 31)); }
#pragma unroll
    for (int i = 0; i < 32; ++i) { const int kk = 2 * i + (lane >> 5); scr[kk * 33 + (lane & 31)] = v[i]; }
    LDS_WAIT(); asm volatile("" ::: "memory");
    const int c = lane & 7;
#pragma unroll
    for (int j = 0; j < 4; ++j) { const int n = (lane >> 3) + 8 * j; const LAS float* s = scr + (8 * c) * 33 + n;
        u32x4 o; o.x = pk2(s[0 * 33], s[1 * 33]); o.y = pk2(s[2 * 33], s[3 * 33]); o.z = pk2(s[4 * 33], s[5 * 33]); o.w = pk2(s[6 * 33], s[7 * 33]);
        const int ng = n0 + n; const int drow = (G == 0) ? ng : ((ng / G) * 2 * G + which * G + (ng % G));
        *(u32x4*)(WT + (size_t)drow * K + k0 + 8 * c) = o; }
    LDS_WAIT(); asm volatile("" ::: "memory");
}
__device__ __forceinline__ void transpose_item_fp8(const float* W, int K, int N, unsigned char* WT, int G, int which, float scale, LAS float* scr, int item, int lane) {
    const int nblk = N / 32, kb = item / nblk, nb = item % nblk, k0 = 64 * kb, n0 = 32 * nb;
    float v[32];
#pragma unroll
    for (int i = 0; i < 32; ++i) { const int kk = 2 * i + (lane >> 5); v[i] = __builtin_nontemporal_load(W + (size_t)(k0 + kk) * N + n0 + (lane & 31)); }
#pragma unroll
    for (int i = 0; i < 32; ++i) { const int kk = 2 * i + (lane >> 5); scr[kk * 33 + (lane & 31)] = v[i] * scale; }
    LDS_WAIT(); asm volatile("" ::: "memory");
    const int c = lane & 7;
#pragma unroll
    for (int j = 0; j < 4; ++j) { const int n = (lane >> 3) + 8 * j; const LAS float* sp = scr + (8 * c) * 33 + n;
        int w0 = __builtin_amdgcn_cvt_pk_fp8_f32(clamp8(sp[0 * 33]), clamp8(sp[1 * 33]), 0, false); w0 = __builtin_amdgcn_cvt_pk_fp8_f32(clamp8(sp[2 * 33]), clamp8(sp[3 * 33]), w0, true);
        int w1 = __builtin_amdgcn_cvt_pk_fp8_f32(clamp8(sp[4 * 33]), clamp8(sp[5 * 33]), 0, false); w1 = __builtin_amdgcn_cvt_pk_fp8_f32(clamp8(sp[6 * 33]), clamp8(sp[7 * 33]), w1, true);
        const int ng = n0 + n; const int drow = (G == 0) ? ng : ((ng / G) * 2 * G + which * G + (ng % G));
        u32x2 o; o.x = (unsigned)w0; o.y = (unsigned)w1; *(u32x2*)(WT + (size_t)drow * K + k0 + 8 * c) = o; }
    LDS_WAIT(); asm volatile("" ::: "memory");
}
__device__ __forceinline__ void rope_entry(float* tab, int idx) {
    const int t = idx >> 6, i = idx & 63;
    const float inv_freq = powf(10000.f, -(float)(2 * i) / 128.f);
    const float ang = (float)t * inv_freq;
    const double a = (double)ang; const double two_pi = 6.283185307179586476925286766559;
    const double kf = rint(a / two_pi); double r = a - kf * two_pi;
    double sgn = 1.0; if (r > 1.5707963267948966) { r = 3.141592653589793 - r; sgn = -1.0; } else if (r < -1.5707963267948966) { r = -3.141592653589793 - r; sgn = -1.0; }
    const double r2 = r * r;
    const double s = r * (1.0 + r2 * (-1.0 / 6 + r2 * (1.0 / 120 + r2 * (-1.0 / 5040 + r2 * (1.0 / 362880 + r2 * (-1.0 / 39916800 + r2 * (1.0 / 6227020800.0 + r2 * (-1.0 / 1307674368000.0))))))));
    const double c = 1.0 + r2 * (-0.5 + r2 * (1.0 / 24 + r2 * (-1.0 / 720 + r2 * (1.0 / 40320 + r2 * (-1.0 / 3628800 + r2 * (1.0 / 479001600.0 + r2 * (-1.0 / 87178291200.0 + r2 * (1.0 / 20922789888000.0))))))));
    tab[idx] = (float)(sgn * c); tab[SEQ * 64 + idx] = (float)s;
}
__device__ __forceinline__ void mod_task(const float* __restrict__ cin, const float* __restrict__ w_ada, float* __restrict__ modp, int task, int lane) {
    const int cbk = task % 96, kc = task / 96, j = cbk * 64 + lane, k0 = kc * 64;
    float acc[32], cv[32];
#pragma unroll
    for (int b = 0; b < 32; ++b) { acc[b] = 0.f; cv[b] = silu_f(cin[b * D + k0 + lane]); }
#pragma unroll
    for (int kb = 0; kb < 4; ++kb) {
        float w[16];
#pragma unroll
        for (int i = 0; i < 16; ++i) w[i] = w_ada[(size_t)(k0 + kb * 16 + i) * 6144 + j];
#pragma unroll
        for (int i = 0; i < 16; ++i)
#pragma unroll
            for (int b = 0; b < 32; ++b) acc[b] += __builtin_bit_cast(float, __builtin_amdgcn_readlane(__builtin_bit_cast(int, cv[b]), kb * 16 + i)) * w[i];
    }
#pragma unroll
    for (int b = 0; b < 32; ++b) modp[((size_t)kc * 32 + b) * 6144 + j] = acc[b];
}
__device__ __forceinline__ float mod_sum(const float* __restrict__ modp, const float* __restrict__ b_ada, int b, int j) {
    float s = 0.f;
#pragma unroll
    for (int kc = 0; kc < 16; ++kc) s += modp[((size_t)kc * 32 + b) * 6144 + j];
    return s + b_ada[j];
}

namespace ret {
typedef short s16x4 __attribute__((ext_vector_type(4)));
typedef __bf16 bfx2 __attribute__((ext_vector_type(2)));
constexpr unsigned RS = 288, TILE = 128 * RS, LK = 0, LV = TILE, LRF = 2 * TILE, LRB = 3 * TILE;
constexpr float LOG2E = 1.4426950408889634f;
__device__ __forceinline__ unsigned offb(unsigned row, unsigned ch) { return RS * row + 16u * ch; }
__device__ __forceinline__ unsigned cvtpk(float lo, float hi) { const f32x2 v = {lo, hi}; return __builtin_bit_cast(unsigned, __builtin_convertvector(v, bfx2)); }
__device__ __forceinline__ bf16x8 pack8(const float (&f)[8]) { u32x4 u; u.x = cvtpk(f[0], f[1]); u.y = cvtpk(f[2], f[3]); u.z = cvtpk(f[4], f[5]); u.w = cvtpk(f[6], f[7]); return __builtin_bit_cast(bf16x8, u); }
__device__ __forceinline__ void unpack8(const bf16x8 v, float (&f)[8]) { const u32x4 u = __builtin_bit_cast(u32x4, v);
    f[0] = __uint_as_float(u.x << 16); f[1] = __uint_as_float(u.x & 0xffff0000u); f[2] = __uint_as_float(u.y << 16); f[3] = __uint_as_float(u.y & 0xffff0000u);
    f[4] = __uint_as_float(u.z << 16); f[5] = __uint_as_float(u.z & 0xffff0000u); f[6] = __uint_as_float(u.w << 16); f[7] = __uint_as_float(u.w & 0xffff0000u); }
__device__ __forceinline__ bf16x8 trfrag(LAS unsigned char* base, unsigned row0, unsigned row1, unsigned cblk, unsigned qp, unsigned p) {
    const unsigned ch = 2u * cblk + (p >> 1), bo = 8u * (p & 1u);
    const s16x4 lo = __builtin_amdgcn_ds_read_tr16_b64_v4i16((LAS s16x4*)(base + offb(row0 + qp, ch) + bo));
    const s16x4 hi = __builtin_amdgcn_ds_read_tr16_b64_v4i16((LAS s16x4*)(base + offb(row1 + qp, ch) + bo));
    return __builtin_shufflevector(lo, hi, 0, 1, 2, 3, 4, 5, 6, 7);
}
struct KVRaw { bf16x8 ka[2], kb[2], v[4]; f32x4 c0[2], c1[2], s0[2], s1[2]; };
__device__ __forceinline__ void kv_load(KVRaw& R, const bf16_t* __restrict__ proj, const float* __restrict__ rope, int b, int h, int n, int tid) {
#pragma unroll
    for (int i = 0; i < 2; ++i) {
        const int q2 = tid + 512 * i, row = q2 >> 3, pc = q2 & 7, t = n * 128 + row;
        const bf16_t* rp = proj + (size_t)(b * SEQ + t) * DIN + OFF_KR + h * 128;
        R.ka[i] = *(const bf16x8*)(rp + pc * 8); R.kb[i] = *(const bf16x8*)(rp + 64 + pc * 8);
        R.c0[i] = *(const f32x4*)(rope + t * 64 + pc * 8); R.c1[i] = *(const f32x4*)(rope + t * 64 + pc * 8 + 4);
        R.s0[i] = *(const f32x4*)(rope + SEQ * 64 + t * 64 + pc * 8); R.s1[i] = *(const f32x4*)(rope + SEQ * 64 + t * 64 + pc * 8 + 4);
    }
#pragma unroll
    for (int i = 0; i < 4; ++i) { const int q4 = tid + 512 * i, row = q4 >> 4, ch = q4 & 15, t = n * 128 + row;
        R.v[i] = *(const bf16x8*)(proj + (size_t)(b * SEQ + t) * DIN + OFF_VR + h * 128 + ch * 8); }
}
__device__ __forceinline__ void kv_store(LAS unsigned char* lds, const KVRaw& R, int tid) {
#pragma unroll
    for (int i = 0; i < 2; ++i) {
        const int q2 = tid + 512 * i, row = q2 >> 3, pc = q2 & 7;
        float fa[8], fb[8], o1[8], o2[8];
        unpack8(R.ka[i], fa); unpack8(R.kb[i], fb);
        const float cs[8] = {R.c0[i].x, R.c0[i].y, R.c0[i].z, R.c0[i].w, R.c1[i].x, R.c1[i].y, R.c1[i].z, R.c1[i].w}, sn[8] = {R.s0[i].x, R.s0[i].y, R.s0[i].z, R.s0[i].w, R.s1[i].x, R.s1[i].y, R.s1[i].z, R.s1[i].w};
#pragma unroll
        for (int e = 0; e < 8; ++e) { o1[e] = fa[e] * cs[e] - fb[e] * sn[e]; o2[e] = fb[e] * cs[e] + fa[e] * sn[e]; }
        *(LAS bf16x8*)(lds + LK + offb(row, pc)) = pack8(o1); *(LAS bf16x8*)(lds + LK + offb(row, pc + 8)) = pack8(o2);
    }
#pragma unroll
    for (int i = 0; i < 4; ++i) { const int q4 = tid + 512 * i, row = q4 >> 4, ch = q4 & 15; *(LAS bf16x8*)(lds + LV + offb(row, ch)) = R.v[i]; }
}
__device__ __forceinline__ void rb_dma(LAS unsigned char* lds, const unsigned char* img, int w, int lane) {
#pragma unroll
    for (int i = 0; i < 5; ++i) { const int o = w + 8 * i; if (o < (int)TILE / 1024)
        __builtin_amdgcn_global_load_lds((const unsigned*)(img + o * 1024 + lane * 16), (LAS unsigned*)(lds + LRB + o * 1024), 16, 0, 0); }
}
template <bool FWD> __device__ __forceinline__ void state_update(LAS unsigned char* lds, f32x4 (&racc)[8], float l2, int w, int g, unsigned qp, unsigned p) {
    const float dec = __builtin_amdgcn_exp2f(128.f * l2);
    bf16x8 vs[4];
#pragma unroll
    for (int ks = 0; ks < 4; ++ks) {
        float f[8]; unpack8(trfrag(lds + LV, 32 * ks + 4 * g, 32 * ks + 16 + 4 * g, w, qp, p), f);
#pragma unroll
        for (int e = 0; e < 8; ++e) { const int key = 32 * ks + 16 * (e >> 2) + 4 * g + (e & 3); f[e] *= __builtin_amdgcn_exp2f((FWD ? (float)(127 - key) : (float)key) * l2); }
        vs[ks] = pack8(f);
    }
#pragma unroll
    for (int nb = 0; nb < 8; ++nb) {
        racc[nb] = racc[nb] * dec;
#pragma unroll
        for (int ks = 0; ks < 4; ++ks) racc[nb] = __builtin_amdgcn_mfma_f32_16x16x32_bf16(vs[ks], trfrag(lds + LK, 32 * ks + 4 * g, 32 * ks + 16 + 4 * g, nb, qp, p), racc[nb], 0, 0, 0);
    }
}
__device__ __forceinline__ void unit(const bf16_t* __restrict__ proj, const float* __restrict__ rope, const float* __restrict__ log_decay, const float* __restrict__ gn_g, bf16_t* __restrict__ ymix,
                                     unsigned char* __restrict__ scratch  , LAS unsigned char* lds, int hu, const int tid_in) {
    const int u = hu >> 1, n0 = (hu & 1) * 8, n1 = n0 + 8;
    const int b = u >> 2, h = u & 3;
    int tid_ = tid_in; asm volatile("" : "+v"(tid_));
    const int tid0 = tid_, w = __builtin_amdgcn_readfirstlane(tid0 >> 6);
#define RET_LANE int tid = tid0; asm volatile("" : "+v"(tid)); const int lane = tid & 63, r = lane & 15, g = lane >> 4; const unsigned qp = (unsigned)r >> 2, p = (unsigned)lane & 3u;
    const float lf2_ = log_decay[h] * LOG2E, lb2_ = log_decay[4 + h] * LOG2E;
    f32x4 racc[8];
#pragma unroll
    for (int nb = 0; nb < 8; ++nb) racc[nb] = (f32x4){0.f, 0.f, 0.f, 0.f};
    KVRaw raw;
    kv_load(raw, proj, rope, b, h, 15, tid0);
    for (int n = 15; n >= n0; --n) {
        RET_LANE
        if (n < n1) {
            unsigned char* img = scratch + (size_t)(n - n0) * TILE;
#pragma unroll
            for (int nb = 0; nb < 8; ++nb) { u32x2 o; o.x = cvtpk(racc[nb][0], racc[nb][1]); o.y = cvtpk(racc[nb][2], racc[nb][3]);
                *(u32x2*)(img + offb(16 * nb + r, 2 * w + (g >> 1)) + 8 * (g & 1)) = o; }
        }
        if (n == n0) break;
        float lb2 = lb2_; asm volatile("" : "+v"(lb2));
        __syncthreads();
        kv_store(lds, raw, tid);
        __syncthreads();
        kv_load(raw, proj, rope, b, h, n - 1 > n0 ? n - 1 : 0, tid);
        state_update<false>(lds, racc, lb2, w, g, qp, p);
    }
    asm volatile("s_waitcnt vmcnt(0)" ::: "memory");
    __syncthreads();
    __builtin_amdgcn_fence(__ATOMIC_ACQUIRE, "agent");
    asm volatile("s_waitcnt vmcnt(0)" ::: "memory");
#pragma unroll
    for (int nb = 0; nb < 8; ++nb) racc[nb] = (f32x4){0.f, 0.f, 0.f, 0.f};
    for (int n = 0; n < n0; ++n) {
        RET_LANE
        float lf2 = lf2_; asm volatile("" : "+v"(lf2));
        __syncthreads();
        kv_store(lds, raw, tid);
        __syncthreads();
        kv_load(raw, proj, rope, b, h, n + 1, tid);
        state_update<true>(lds, racc, lf2, w, g, qp, p);
    }
    rb_dma(lds, scratch, w, tid0 & 63);
    for (int n = n0; n < n1; ++n) {
        RET_LANE
        float lf2 = lf2_, lb2 = lb2_; asm volatile("" : "+v"(lf2), "+v"(lb2));
        const __attribute__((address_space(1))) float* gnp = (const __attribute__((address_space(1))) float*)gn_g; asm volatile("" : "+s"(gnp));
        __syncthreads();
        kv_store(lds, raw, tid);
#pragma unroll
        for (int nb = 0; nb < 8; ++nb) { u32x2 o; o.x = cvtpk(racc[nb][0], racc[nb][1]); o.y = cvtpk(racc[nb][2], racc[nb][3]);
            *(LAS u32x2*)(lds + LRF + offb(16 * nb + r, 2 * w + (g >> 1)) + 8 * (g & 1)) = o; }
        const int cq = 16 * w + r, tq = n * 128 + cq;
        bf16x8 qn[4], qf[4], qb[4];
        { const bf16_t* rp = proj + (size_t)(b * SEQ + tq) * DIN + OFF_QR + h * 128 + 4 * g;
          const float sf = __builtin_amdgcn_exp2f((float)(cq + 1) * lf2), sb = __builtin_amdgcn_exp2f((float)(128 - cq) * lb2);
#pragma unroll
          for (int ks = 0; ks < 2; ++ks) {
              float fa[8], fb[8], o1[8], o2[8], t1[8], t2[8];
              { const u32x2 a0 = *(const u32x2*)(rp + 32 * ks), a1 = *(const u32x2*)(rp + 32 * ks + 16), b0 = *(const u32x2*)(rp + 32 * ks + 64), b1 = *(const u32x2*)(rp + 32 * ks + 80);
                unpack8(__builtin_bit_cast(bf16x8, (u32x4){a0.x, a0.y, a1.x, a1.y}), fa); unpack8(__builtin_bit_cast(bf16x8, (u32x4){b0.x, b0.y, b1.x, b1.y}), fb); }
              const float* cp = rope + tq * 64 + 32 * ks + 4 * g; const float* sp = cp + SEQ * 64;
              const f32x4 c0 = *(const f32x4*)cp, c1 = *(const f32x4*)(cp + 16), s0 = *(const f32x4*)sp, s1 = *(const f32x4*)(sp + 16);
              const float cs[8] = {c0.x, c0.y, c0.z, c0.w, c1.x, c1.y, c1.z, c1.w}, sn[8] = {s0.x, s0.y, s0.z, s0.w, s1.x, s1.y, s1.z, s1.w};
#pragma unroll
              for (int e = 0; e < 8; ++e) { o1[e] = fa[e] * cs[e] - fb[e] * sn[e]; o2[e] = fb[e] * cs[e] + fa[e] * sn[e]; }
              qn[ks] = pack8(o1); qn[ks + 2] = pack8(o2);
#pragma unroll
              for (int e = 0; e < 8; ++e) { t1[e] = o1[e] * sf; t2[e] = o2[e] * sf; }
              qf[ks] = pack8(t1); qf[ks + 2] = pack8(t2);
#pragma unroll
              for (int e = 0; e < 8; ++e) { t1[e] = o1[e] * sb; t2[e] = o2[e] * sb; }
              qb[ks] = pack8(t1); qb[ks + 2] = pack8(t2);
          } }
        asm volatile("s_waitcnt vmcnt(0)" ::: "memory");
        __syncthreads();
        kv_load(raw, proj, rope, b, h, n + 1 < n1 ? n + 1 : n, tid);
        u32x2 gv[8];
        { const bf16_t* gp = proj + (size_t)(b * SEQ + tq) * DIN + OFF_GR + h * 128 + 4 * g;
#pragma unroll
          for (int mbv = 0; mbv < 8; ++mbv) gv[mbv] = *(const u32x2*)(gp + 16 * mbv); }
        bf16x8 pt[4];
#pragma unroll
        for (int ks2 = 0; ks2 < 4; ++ks2) {
            float pv[8];
#pragma unroll
            for (int hb = 0; hb < 2; ++hb) {
                const int mb = 2 * ks2 + hb;
                f32x4 st = (f32x4){0.f, 0.f, 0.f, 0.f};
#pragma unroll
                for (int ks = 0; ks < 4; ++ks) { const LAS unsigned char* kp = lds + LK + RS * (16 * mb + r) + 64 * ks + 8 * g; const u32x2 k0 = *(const LAS u32x2*)kp, k1 = *(const LAS u32x2*)(kp + 32);
                    st = __builtin_amdgcn_mfma_f32_16x16x32_bf16(__builtin_bit_cast(bf16x8, (u32x4){k0.x, k0.y, k1.x, k1.y}), qn[ks], st, 0, 0, 0); }
#pragma unroll
                for (int j = 0; j < 4; ++j) { const int diff = cq - (16 * mb + 4 * g + j); pv[4 * hb + j] = st[j] * __builtin_amdgcn_exp2f(diff >= 0 ? (float)diff * lf2 : (float)(-diff) * lb2); }
            }
            pt[ks2] = pack8(pv);
        }
        f32x4 yacc[8];
#pragma unroll
        for (int mbv = 0; mbv < 8; ++mbv) {
            f32x4 y = (f32x4){0.f, 0.f, 0.f, 0.f};
#pragma unroll
            for (int ks2 = 0; ks2 < 4; ++ks2) y = __builtin_amdgcn_mfma_f32_16x16x32_bf16(trfrag(lds + LV, 32 * ks2 + 4 * g, 32 * ks2 + 16 + 4 * g, mbv, qp, p), pt[ks2], y, 0, 0, 0);
#pragma unroll
            for (int ks = 0; ks < 4; ++ks) {
                y = __builtin_amdgcn_mfma_f32_16x16x32_bf16(trfrag(lds + LRF, 32 * ks + 4 * g, 32 * ks + 16 + 4 * g, mbv, qp, p), qf[ks], y, 0, 0, 0);
                y = __builtin_amdgcn_mfma_f32_16x16x32_bf16(trfrag(lds + LRB, 32 * ks + 4 * g, 32 * ks + 16 + 4 * g, mbv, qp, p), qb[ks], y, 0, 0, 0);
            }
            yacc[mbv] = y;
        }
        __syncthreads();
        if (n + 1 < n1) rb_dma(lds, scratch + (size_t)(n + 1 - n0) * TILE, w, lane);
        { float s = 0.f;
#pragma unroll
          for (int mbv = 0; mbv < 8; ++mbv) s += (yacc[mbv][0] + yacc[mbv][1]) + (yacc[mbv][2] + yacc[mbv][3]);
          s += __shfl_xor(s, 16); s += __shfl_xor(s, 32);
          const float mu = s * (1.f / 128.f); float s2 = 0.f;
#pragma unroll
          for (int mbv = 0; mbv < 8; ++mbv) { yacc[mbv] = yacc[mbv] - mu; s2 += (yacc[mbv][0] * yacc[mbv][0] + yacc[mbv][1] * yacc[mbv][1]) + (yacc[mbv][2] * yacc[mbv][2] + yacc[mbv][3] * yacc[mbv][3]); }
          s2 += __shfl_xor(s2, 16); s2 += __shfl_xor(s2, 32);
          const float rstd = 1.f / sqrtf(s2 * (1.f / 128.f) + GN_EPS);
          bf16_t* op = ymix + (size_t)(b * SEQ + tq) * D + 512 + h * 128 + 4 * g;
#pragma unroll
          for (int mbv = 0; mbv < 8; ++mbv) {
              const f32x4 gn = *(const __attribute__((address_space(1))) f32x4*)(gnp + h * 128 + 16 * mbv + 4 * g);
              const float g0 = __uint_as_float(gv[mbv].x << 16), g1 = __uint_as_float(gv[mbv].x & 0xffff0000u), g2 = __uint_as_float(gv[mbv].y << 16), g3 = __uint_as_float(gv[mbv].y & 0xffff0000u);
              u32x2 o; o.x = cvtpk(silu_f(g0) * (yacc[mbv][0] * rstd * gn.x), silu_f(g1) * (yacc[mbv][1] * rstd * gn.y));
              o.y = cvtpk(silu_f(g2) * (yacc[mbv][2] * rstd * gn.z), silu_f(g3) * (yacc[mbv][3] * rstd * gn.w));
              *(u32x2*)(op + 16 * mbv) = o;
          } }
        state_update<true>(lds, racc, lf2, w, g, qp, p);
    }
    __syncthreads();
#undef RET_LANE
}
}


namespace na {
constexpr unsigned LKR = 0, LVR = 73728, LRPB = 147456;
__device__ __forceinline__ void load_row(LAS unsigned char* lds, const bf16_t* __restrict__ proj, int b, int head, int krow, int tid) {
    const int key = tid >> 3, ch = tid & 7, slot = krow % 9;
    const bf16_t* rp = proj + (size_t)(b * SEQ + krow * 64 + key) * DIN + head * 64 + ch * 8;
    const unsigned o = (unsigned)slot * 8192u + 128u * key + 16u * (ch ^ (key & 7));
    *(LAS u32x4*)(lds + LKR + o) = *(const u32x4*)(rp + OFF_KNA);
    *(LAS u32x4*)(lds + LVR + o) = *(const u32x4*)(rp + OFF_VNA);
}
__device__ __forceinline__ void unit(const bf16_t* __restrict__ proj, const float* __restrict__ rpb, bf16_t* __restrict__ ymix, LAS unsigned char* lds, int u, const int tid_in) {
    const int b = u >> 3, head = u & 7;
    int tid_ = tid_in; asm volatile("" : "+v"(tid_));
    const int tid0 = tid_, w = __builtin_amdgcn_readfirstlane(tid0 >> 6);
    __syncthreads();
    if (tid0 < 465) ((LAS float*)(lds + LRPB))[tid0] = rpb[head * 465 + tid0];
    const int ct = w & 3, cb = (ct == 0) ? 0 : (ct == 1 ? 8 : (ct == 2 ? 24 : 32));
    u32x4 pk[2], pv2[2]; int pre_lo = 0, pre_n = 0;
    for (int st = 0; st < 16; ++st) {
        int tid = tid0; asm volatile("" : "+v"(tid));
        const int lane = tid & 63, qi = lane & 15, g = lane >> 4; const unsigned qp = (unsigned)qi >> 2, p = (unsigned)lane & 3u;
        const int r = 2 * st + (w >> 2);
        const int rs = min(max(r - 4, 0), 24);
        const int need_hi = min(max(2 * st + 1 - 4, 0), 24) + 7;
        __syncthreads();
        if (st == 0) { for (int kr = 0; kr <= need_hi; ++kr) load_row(lds, proj, b, head, kr, tid); }
        else {
#pragma unroll
            for (int i = 0; i < 2; ++i) if (i < pre_n) { const int key = tid >> 3, ch = tid & 7; const unsigned o = (unsigned)((pre_lo + i) % 9) * 8192u + 128u * key + 16u * (ch ^ (key & 7));
                *(LAS u32x4*)(lds + LKR + o) = pk[i]; *(LAS u32x4*)(lds + LVR + o) = pv2[i]; }
        }
        const int cq = 16 * ct + qi, tq = b * SEQ + r * 64 + cq;
        bf16x8 qn[2];
        { const bf16_t* qptr = proj + (size_t)tq * DIN + OFF_QNA + head * 64 + 8 * g; qn[0] = *(const bf16x8*)qptr; qn[1] = *(const bf16x8*)(qptr + 32); }
        __syncthreads();
        { const int nh = (st < 15) ? min(max(2 * st + 3 - 4, 0), 24) + 7 : need_hi; pre_lo = need_hi + 1; pre_n = nh - need_hi;
#pragma unroll
          for (int i = 0; i < 2; ++i) if (i < pre_n) { const int key = tid >> 3, ch = tid & 7; const bf16_t* rp = proj + (size_t)(b * SEQ + (pre_lo + i) * 64 + key) * DIN + head * 64 + ch * 8;
              pk[i] = *(const u32x4*)(rp + OFF_KNA); pv2[i] = *(const u32x4*)(rp + OFF_VNA); } }
        const int cs = min(max(cq - 8, 0), 48);
        const unsigned kb0 = 128u * qi + 16u * ((unsigned)g ^ ((unsigned)qi & 7u)), kb1 = 128u * qi + 16u * ((4u + (unsigned)g) ^ ((unsigned)qi & 7u));
        const LAS float* bias = (const LAS float*)(lds + LRPB);
        f32x4 sc[16]; float mx = -3.0e38f;
#pragma unroll
        for (int kr = 0; kr < 8; ++kr) {
            const int krow = rs + kr; const unsigned so = (unsigned)(krow % 9) * 8192u + 128u * (unsigned)cb;
            const int dr = krow - r + 7;
#pragma unroll
            for (int h2 = 0; h2 < 2; ++h2) {
                f32x4 a = (f32x4){0.f, 0.f, 0.f, 0.f};
                a = __builtin_amdgcn_mfma_f32_16x16x32_bf16(*(const LAS bf16x8*)(lds + LKR + so + 2048u * h2 + kb0), qn[0], a, 0, 0, 0);
                a = __builtin_amdgcn_mfma_f32_16x16x32_bf16(*(const LAS bf16x8*)(lds + LKR + so + 2048u * h2 + kb1), qn[1], a, 0, 0, 0);
#pragma unroll
                for (int j = 0; j < 4; ++j) {
                    const int kcol = cb + 16 * h2 + 4 * g + j;
                    const int dc = min(max(kcol - cq + 15, 0), 30);
                    const float v = a[j] + bias[dr * 31 + dc];
                    const bool in = (kcol >= cs) && (kcol < cs + 16);
                    a[j] = in ? v : -3.0e38f; mx = fmaxf(mx, a[j]);
                }
                sc[2 * kr + h2] = a;
            }
        }
        mx = fmaxf(mx, __shfl_xor(mx, 16)); mx = fmaxf(mx, __shfl_xor(mx, 32));
        float sum = 0.f; bf16x8 pt[8];
#pragma unroll
        for (int kk = 0; kk < 8; ++kk) {
            float pv[8];
#pragma unroll
            for (int h2 = 0; h2 < 2; ++h2)
#pragma unroll
                for (int j = 0; j < 4; ++j) { const float e = __builtin_amdgcn_exp2f((sc[2 * kk + h2][j] - mx) * 1.4426950408889634f); pv[4 * h2 + j] = e; sum += e; }
            pt[kk] = ret::pack8(pv);
        }
        sum += __shfl_xor(sum, 16); sum += __shfl_xor(sum, 32);
        const float inv = 1.f / sum;
        const unsigned sl = (((unsigned)g & 1u) << 2) | qp;
        bf16_t* op = ymix + (size_t)tq * D + head * 64 + 4 * g;
#pragma unroll
        for (int db = 0; db < 4; ++db) {
            const unsigned vb = 128u * (4u * (unsigned)g + qp) + 16u * ((2u * db + (p >> 1)) ^ sl) + 8u * (p & 1u);
            f32x4 y = (f32x4){0.f, 0.f, 0.f, 0.f};
#pragma unroll
            for (int kk = 0; kk < 8; ++kk) {
                const unsigned so = (unsigned)((rs + kk) % 9) * 8192u + 128u * (unsigned)cb;
                const ret::s16x4 lo = __builtin_amdgcn_ds_read_tr16_b64_v4i16((LAS ret::s16x4*)(lds + LVR + so + vb));
                const ret::s16x4 hi = __builtin_amdgcn_ds_read_tr16_b64_v4i16((LAS ret::s16x4*)(lds + LVR + so + 2048u + vb));
                y = __builtin_amdgcn_mfma_f32_16x16x32_bf16(__builtin_shufflevector(lo, hi, 0, 1, 2, 3, 4, 5, 6, 7), pt[kk], y, 0, 0, 0);
            }
            u32x2 o; o.x = ret::cvtpk(y[0] * inv, y[1] * inv); o.y = ret::cvtpk(y[2] * inv, y[3] * inv);
            *(u32x2*)(op + 16 * db) = o;
        }
    }
    __syncthreads();
}
}

__device__ __forceinline__ void unpack_t16r(const u32x4 a, const u32x4 b, f32x4 (&v)[4]) {
    v[0] = (f32x4){__uint_as_float(a.x << 16), __uint_as_float(a.x & 0xffff0000u), __uint_as_float(a.y << 16), __uint_as_float(a.y & 0xffff0000u)};
    v[1] = (f32x4){__uint_as_float(a.z << 16), __uint_as_float(a.z & 0xffff0000u), __uint_as_float(a.w << 16), __uint_as_float(a.w & 0xffff0000u)};
    v[2] = (f32x4){__uint_as_float(b.x << 16), __uint_as_float(b.x & 0xffff0000u), __uint_as_float(b.y << 16), __uint_as_float(b.y & 0xffff0000u)};
    v[3] = (f32x4){__uint_as_float(b.z << 16), __uint_as_float(b.z & 0xffff0000u), __uint_as_float(b.w << 16), __uint_as_float(b.w & 0xffff0000u)};
}
__device__ __forceinline__ void ln1_row(const u32x4 ra, const u32x4 rb, const LAS float* cv  , bf16_t* __restrict__ hf, unsigned char* __restrict__ hf8, float* __restrict__ stats, int row, int lane) {
    asm volatile("" : "+v"(cv));
    const int c0 = lane * 16;
    f32x4 v[4]; float s = 0.f;
    unpack_t16r(ra, rb, v);
#pragma unroll
    for (int j = 0; j < 4; ++j) s += (v[j].x + v[j].y) + (v[j].z + v[j].w);
    const float mean = wave_sum(s) * (1.f / D); float s2 = 0.f;
#pragma unroll
    for (int j = 0; j < 4; ++j) { v[j] = v[j] - mean; s2 += (v[j].x * v[j].x + v[j].y * v[j].y) + (v[j].z * v[j].z + v[j].w * v[j].w); }
    const float rstd = 1.f / sqrtf(wave_sum(s2) * (1.f / D) + LN_EPS);
    if (lane == 0) *(f32x2*)(stats + 2 * (size_t)row) = (f32x2){mean, rstd};
    u32x4 ob[2], o8;
#pragma unroll
    for (int j = 0; j < 4; ++j) { const int col = c0 + 4 * j;
        const f32x4 gg = *(const LAS f32x4*)(cv + col), bv = *(const LAS f32x4*)(cv + 1024 + col), sc1 = *(const LAS f32x4*)(cv + 2048 + col), sh = *(const LAS f32x4*)(cv + 3072 + col);
        const f32x4 h4 = (v[j] * rstd * gg + bv) * sc1 + sh;
        const unsigned p0 = pk2(h4.x, h4.y), p1 = pk2(h4.z, h4.w);
        if (j == 0) { ob[0].x = p0; ob[0].y = p1; } else if (j == 1) { ob[0].z = p0; ob[0].w = p1; } else if (j == 2) { ob[1].x = p0; ob[1].y = p1; } else { ob[1].z = p0; ob[1].w = p1; }
        const f32x4 h8 = h4 * S_HF8;
        int w0 = __builtin_amdgcn_cvt_pk_fp8_f32(clamp8(h8.x), clamp8(h8.y), 0, false); w0 = __builtin_amdgcn_cvt_pk_fp8_f32(clamp8(h8.z), clamp8(h8.w), w0, true);
        if (j == 0) o8.x = (unsigned)w0; else if (j == 1) o8.y = (unsigned)w0; else if (j == 2) o8.z = (unsigned)w0; else o8.w = (unsigned)w0; }
    *(u32x4*)(hf + (size_t)row * D + c0) = ob[0]; *(u32x4*)(hf + (size_t)row * D + c0 + 8) = ob[1];
    *(u32x4*)(hf8 + (size_t)row * D + c0) = o8;
}
__device__ __forceinline__ void top2_merge(float& a1, float& a2, float b1, float b2) { const float n1 = fmaxf(a1, b1); const float n2 = fmaxf(fminf(a1, b1), fmaxf(a2, b2)); a1 = n1; a2 = n2; }
__device__ __forceinline__ void route_token(const float* __restrict__ logits, const f32x4 bias, int* __restrict__ topk_e, float* __restrict__ topk_w, LAS unsigned* hist, int tok, int lane) {
    const f32x4 lg = *(const f32x4*)(logits + (size_t)tok * NE + lane * 4);
    const float sc0 = 1.f / (1.f + __expf(-lg.x)), sc1 = 1.f / (1.f + __expf(-lg.y)), sc2 = 1.f / (1.f + __expf(-lg.z)), sc3 = 1.f / (1.f + __expf(-lg.w));
    float s0 = sc0 + bias.x, s1 = sc1 + bias.y, s2 = sc2 + bias.z, s3 = sc3 + bias.w;
    float m1 = fmaxf(s0, s1), m2 = fminf(s0, s1); top2_merge(m1, m2, fmaxf(s2, s3), fminf(s2, s3));
#pragma unroll
    for (int o = 1; o < 8; o <<= 1) { const float b1 = __shfl_xor(m1, o), b2 = __shfl_xor(m2, o); top2_merge(m1, m2, b1, b2); }
    const float gs = m1 + m2; const int grp = lane >> 3;
    int rank = 0;
#pragma unroll
    for (int gq = 0; gq < 8; ++gq) { const float og = __shfl(gs, gq * 8); rank += (og > gs || (og == gs && gq < grp)) ? 1 : 0; }
    const float NEG = -3.0e38f;
    if (rank >= 4) { s0 = NEG; s1 = NEG; s2 = NEG; s3 = NEG; }
    float wsum = 0.f; float myw = 0.f; int mye = 0;
#pragma unroll
    for (int k = 0; k < TOPK; ++k) {
        float bv = s0; int bi = 0;
        if (s1 > bv) { bv = s1; bi = 1; }
        if (s2 > bv) { bv = s2; bi = 2; }
        if (s3 > bv) { bv = s3; bi = 3; }
        int be = lane * 4 + bi;
#pragma unroll
        for (int o = 1; o < 64; o <<= 1) { const float ov = __shfl_xor(bv, o); const int oe = __shfl_xor(be, o); if (ov > bv || (ov == bv && oe < be)) { bv = ov; be = oe; } }
        const int ol = be >> 2, oj = be & 3;
        const float mysc = oj == 0 ? sc0 : (oj == 1 ? sc1 : (oj == 2 ? sc2 : sc3));
        const float wsel = __shfl(mysc, ol);
        if (lane == ol) { if (oj == 0) s0 = NEG; else if (oj == 1) s1 = NEG; else if (oj == 2) s2 = NEG; else s3 = NEG; }
        wsum += wsel;
        if (lane == k) { myw = wsel; mye = be; }
    }
    if (lane < TOPK) { topk_e[tok * TOPK + lane] = mye; topk_w[tok * TOPK + lane] = myw / wsum * 2.5f; __hip_atomic_fetch_add(&hist[mye], 1u, __ATOMIC_RELAXED, __HIP_MEMORY_SCOPE_WORKGROUP); }
}
__device__ __forceinline__ void build_tables(const unsigned* ctl, LAS unsigned* tab, const int tid) {
    if (tid < 64) {
        const int lane = tid;
        unsigned c[4], so = 0, st = 0;
#pragma unroll
        for (int j = 0; j < 4; ++j) { c[j] = __hip_atomic_load(ctl + CW_COUNT + lane * 4 + j, __ATOMIC_RELAXED, __HIP_MEMORY_SCOPE_AGENT); so += c[j]; st += (c[j] + 255u) >> 8; }
        unsigned io = so, it = st;
#pragma unroll
        for (int o = 1; o < 64; o <<= 1) { const unsigned a = __shfl_up(io, o), b = __shfl_up(it, o); if (lane >= o) { io += a; it += b; } }
        unsigned eo = io - so, et = it - st;
#pragma unroll
        for (int j = 0; j < 4; ++j) { tab[T_CNT + lane * 4 + j] = c[j]; tab[T_OFF + lane * 4 + j] = eo; tab[T_TILE + lane * 4 + j] = et; eo += c[j]; et += (c[j] + 255u) >> 8; }
        if (lane == 63) { tab[T_OFF + NE] = eo; tab[T_TILE + NE] = et; }
    }
    __syncthreads();
}
struct RowRaw { u32x4 y[9]; u32x4 t[2]; f32x2 st; };
__device__ __forceinline__ void final_load(RowRaw& R, const bf16_t* __restrict__ tb, const unsigned char* __restrict__ ybuf, const unsigned char* __restrict__ ysh, const float* __restrict__ stats, int row, int lane) {
    const int c0 = lane * 16;
#pragma unroll
    for (int k = 0; k < TOPK; ++k) R.y[k] = *(const u32x4*)(ybuf + ((size_t)row * TOPK + k) * D + c0);
    R.y[8] = *(const u32x4*)(ysh + (size_t)row * D + c0);
    R.t[0] = *(const u32x4*)(tb + (size_t)row * D + c0); R.t[1] = *(const u32x4*)(tb + (size_t)row * D + c0 + 8);
    R.st = *(const f32x2*)(stats + 2 * (size_t)row);
}
__device__ __forceinline__ void final_row(float* __restrict__ out, const RowRaw& R, const LAS float* cv  , int row, int lane) {
    asm volatile("" : "+v"(cv));
    const int c0 = lane * 16;
    f32x4 a[4], t[4], v[4]; float s = 0.f;
#pragma unroll
    for (int j = 0; j < 4; ++j) a[j] = (f32x4){0.f, 0.f, 0.f, 0.f};
#pragma unroll
    for (int k = 0; k < 9; ++k) { const unsigned w[4] = {R.y[k].x, R.y[k].y, R.y[k].z, R.y[k].w};
#pragma unroll
        for (int j = 0; j < 4; ++j) { const f32x2 lo = __builtin_amdgcn_cvt_pk_f32_fp8((int)w[j], false), hi = __builtin_amdgcn_cvt_pk_f32_fp8((int)w[j], true); a[j].x += lo.x; a[j].y += lo.y; a[j].z += hi.x; a[j].w += hi.y; } }
    unpack_t16r(R.t[0], R.t[1], t);
#pragma unroll
    for (int j = 0; j < 4; ++j) { const int col = c0 + 4 * j;
        const f32x4 x1 = (t[j] - R.st.x) * R.st.y * *(const LAS f32x4*)(cv + col) + *(const LAS f32x4*)(cv + 1024 + col);
        v[j] = x1 * ALPHA + *(const LAS f32x4*)(cv + 4096 + col) * a[j] * YINV;
        s += (v[j].x + v[j].y) + (v[j].z + v[j].w); }
    const float mean = wave_sum(s) * (1.f / D); float s2 = 0.f;
#pragma unroll
    for (int j = 0; j < 4; ++j) { v[j] = v[j] - mean; s2 += (v[j].x * v[j].x + v[j].y * v[j].y) + (v[j].z * v[j].z + v[j].w * v[j].w); }
    const float rstd = 1.f / sqrtf(wave_sum(s2) * (1.f / D) + LN_EPS);
#pragma unroll
    for (int j = 0; j < 4; ++j) { const int col = c0 + 4 * j;
        *(f32x4*)(out + (size_t)row * D + col) = v[j] * rstd * *(const LAS f32x4*)(cv + 2048 + col) + *(const LAS f32x4*)(cv + 3072 + col); }
}

#ifndef MK_PER_PHASE
#define MK_PER_PHASE 0
#endif
constexpr int N_PHASES = 13;
struct Args { Ctx X; int ph_lo, ph_hi; };
typedef __attribute__((address_space(4))) const Ctx* CtxCP;
__device__ __forceinline__ CtxCP ctx_ptr() { CtxCP p = (CtxCP)__builtin_amdgcn_kernarg_segment_ptr(); asm volatile("" : "+s"(p)); return p; }

__global__ void __launch_bounds__(NW * 64, 2) mk_fwd(Args args) {
    extern __shared__ __attribute__((aligned(16))) unsigned char lds_raw[];
    LAS unsigned char* lds = (LAS unsigned char*)lds_raw;
    LAS unsigned* tab = (LAS unsigned*)(lds + TAB_OFF);
    volatile LAS unsigned* MISC = (volatile LAS unsigned*)(lds + MISC_OFF);
#define PH_BEGIN \
    const __attribute__((address_space(4))) Ctx& X = *ctx_ptr(); unsigned char* ws = X.ws; (void)ws; \
    const int lane = lane_id(), wave = wave0, tid = wave0 * 64 + lane; (void)lane; (void)wave; (void)tid; \
    const int G = gridDim.x, bx = blockIdx.x; (void)G; (void)bx; \
    const int gw = bx * NW + wave, NGW = G * NW; (void)gw; (void)NGW; \
    const int gt = bx * (NW * 64) + tid, NGT = G * NW * 64; (void)gt; (void)NGT; \
    unsigned* ctl = (unsigned*)(ws + WS_CTL); float* mod = (float*)(ws + WS_MOD); float* rope = (float*)(ws + WS_ROPE); (void)ctl; (void)mod; (void)rope; \
    bf16_t* win_t = (bf16_t*)(ws + WS_WIN_T); bf16_t* wout_t = (bf16_t*)(ws + WS_WOUT_T); bf16_t* wr_t = (bf16_t*)(ws + WS_WR_T); (void)win_t; (void)wout_t; (void)wr_t; \
    bf16_t* wsgu_t = (bf16_t*)(ws + WS_WSGU_T); bf16_t* wsd_t = (bf16_t*)(ws + WS_WSD_T); bf16_t* wd_t = (bf16_t*)(ws + WS_WD_T); bf16_t* wgu_t = (bf16_t*)(ws + WS_WGU_T); (void)wsgu_t; (void)wsd_t; (void)wd_t; (void)wgu_t; \
    int* slot_ent = (int*)(ws + WS_SLOT_ENT); float* slot_w = (float*)(ws + WS_SLOT_W); int* topk_e = (int*)(ws + WS_TOPK_E); float* topk_w = (float*)(ws + WS_TOPK_W); (void)slot_ent; (void)slot_w; (void)topk_e; (void)topk_w; \
    bf16_t* ymix = (bf16_t*)(ws + WS_YMIX); bf16_t* proj = (bf16_t*)(ws + WS_PROJ); bf16_t* hbuf = (bf16_t*)(ws + WS_YMIX); (void)ymix; (void)proj; (void)hbuf; \
    float* logits = (float*)(ws + WS_LOGITS); bf16_t* shh = (bf16_t*)(ws + WS_SHH); bf16_t* hf = (bf16_t*)(ws + WS_HF); bf16_t* act = (bf16_t*)(ws + WS_ACT); (void)logits; (void)shh; (void)hf; (void)act; \
    unsigned char* ybuf = ws + WS_YBUF; float* out = X.out; (void)ybuf; (void)out;

    const int wave0 = __builtin_amdgcn_readfirstlane((int)threadIdx.x >> 6);
    for (int u = threadIdx.x; u < (LDS_BYTES - MISC_OFF) / 4; u += NW * 64) ((LAS unsigned*)(lds + MISC_OFF))[u] = 0u;
    __syncthreads();
    if (!MK_PER_PHASE) { unsigned* ctl0 = (unsigned*)(args.X.ws + WS_CTL); (void)xcd_barrier_post(ctl0 + CW_BAR, MISC + 8, wave0 == 0 && lane_id() == 0); }
    const int lo = args.ph_lo, hi = args.ph_hi;
#ifndef MK_DUP
#define MK_DUP -1
#endif
#define REPS(k) for (int _rep = 0; _rep < ((MK_DUP == (k)) ? 2 : 1); ++_rep)
#ifdef MK_ONLY
#define IN(k) ((k) == MK_ONLY)
#else
#define IN(k) (lo <= (k) && (k) < hi)
#endif
#define SEAM(k) SEAM2(k, (k) + 1)
#define SEAM2(k, k2) do { if (IN(k) && IN(k2)) { XcdBarrier _b; _b.bar = (unsigned*)(ctx_ptr()->ws + WS_CTL) + CW_BAR; _b.x = xb_xcc_id(); _b.st = (volatile LAS unsigned*)(lds + MISC_OFF) + 8; xcd_barrier(_b, wave0 == 0 && lane_id() == 0); } } while (0)

    REPS(0) if (IN(0)) { PH_BEGIN
        LAS float* scr = (LAS float*)(lds + wave * 16384);
        float* modp = (float*)(ws + WS_PROJ);
        for (int t = gw; t < 96 * 16; t += NGW) mod_task(X.c, X.w_ada, modp, t, lane);
        constexpr int I_IN = (D / 64) * (DIN / 32), I_OUT = (D / 64) * (D / 32), I_R = (D / 64) * (NE / 32), I_SG = (D / 64) * (DE / 32), I_SD = (DE / 64) * (D / 32);
        constexpr int I_EG = I_SG, I_ED = I_SD;
        constexpr int N_SMALL = I_IN + I_OUT + I_R + 2 * I_SG + I_SD;
        constexpr int N_ITEMS = N_SMALL + NE * (2 * I_EG + I_ED);
        for (int it = gw; it < N_ITEMS; it += NGW) {
            int r = it;
            if (r < I_IN) { transpose_item(X.w_in, D, DIN, win_t, 0, 0, scr, r, lane); continue; } r -= I_IN;
            if (r < I_OUT) { transpose_item(X.w_out, D, D, wout_t, 0, 0, scr, r, lane); continue; } r -= I_OUT;
            if (r < I_R) { transpose_item(X.w_router, D, NE, wr_t, 0, 0, scr, r, lane); continue; } r -= I_R;
            if (r < I_SG) { transpose_item(X.ws_gate, D, DE, wsgu_t, 8, 0, scr, r, lane); continue; } r -= I_SG;
            if (r < I_SG) { transpose_item(X.ws_up, D, DE, wsgu_t, 8, 1, scr, r, lane); continue; } r -= I_SG;
            if (r < I_SD) { transpose_item(X.ws_down, DE, D, wsd_t, 0, 0, scr, r, lane); continue; } r -= I_SD;
            const int e = r / (2 * I_EG + I_ED); r -= e * (2 * I_EG + I_ED);
            if (r < I_EG) { transpose_item_fp8(X.w_gate + (size_t)e * D * DE, D, DE, (unsigned char*)wgu_t + (size_t)e * 512 * D, 8, 0, S_WGU8, scr, r, lane); continue; } r -= I_EG;
            if (r < I_EG) { transpose_item_fp8(X.w_up + (size_t)e * D * DE, D, DE, (unsigned char*)wgu_t + (size_t)e * 512 * D, 8, 1, S_WGU8, scr, r, lane); continue; } r -= I_EG;
            transpose_item_fp8(X.w_down + (size_t)e * DE * D, DE, D, (unsigned char*)wd_t + (size_t)e * D * DE, 0, 0, S_WD8, scr, r, lane);
        }
        for (int i = gt; i < SEQ * 64; i += NGT) rope_entry(rope, i);
    }
    SEAM(0);
    REPS(1) if (IN(1)) { PH_BEGIN
        const float* modp = (const float*)(ws + WS_PROJ);
        for (int i = gt; i < 32 * 6144; i += NGT) mod[i] = mod_sum(modp, X.b_ada, i / 6144, i % 6144);
        LAS float* ssc = (LAS float*)lds; LAS float* ssh = ssc + 1024;
        int curb = -1;
        for (int c = bx; c < M / 256; c += G) {
            const int b = c >> 3;
            if (b != curb) {
                __syncthreads();
                for (int i = tid; i < 1024; i += NW * 64) { ssc[i] = 1.f + mod_sum(modp, X.b_ada, b, MOD_SCALE_A + i); ssh[i] = mod_sum(modp, X.b_ada, b, MOD_SHIFT_A + i); }
                __syncthreads();
                curb = b;
            }
            const f32x4 sc = *(const LAS f32x4*)(ssc + (tid & 255) * 4), sh = *(const LAS f32x4*)(ssh + (tid & 255) * 4);
            const float* xp = X.x + (size_t)c * 256 * D + (size_t)(tid >> 8) * D + (tid & 255) * 4;
            bf16_t* hp = hbuf + (size_t)c * 256 * D + (size_t)(tid >> 8) * D + (tid & 255) * 4;
            for (int i0 = 0; i0 < 128; i0 += 8) {
                f32x4 v[8];
#pragma unroll
                for (int i = 0; i < 8; ++i) v[i] = __builtin_nontemporal_load((const f32x4*)(xp + (size_t)(i0 + i) * 2 * D));
#pragma unroll
                for (int i = 0; i < 8; ++i) { u32x2 o; o.x = pk2(v[i].x * sc.x + sh.x, v[i].y * sc.y + sh.y); o.y = pk2(v[i].z * sc.z + sh.z, v[i].w * sc.w + sh.w); *(u32x2*)(hp + (size_t)(i0 + i) * 2 * D) = o; }
            }
        }
        __syncthreads();
    }
    SEAM(1);
    REPS(2) if (IN(2)) { PH_BEGIN
        pg8::DenseOrder S; S.init(M, DIN, D, win_t, G, bx);
        pg8::EpiInProj E{proj};
        pg8::gemm_phase(lds, (const char*)hbuf, D, S, E, tid);
    }
    SEAM(2);
    REPS(3) if (IN(3)) { PH_BEGIN
        REPS(31) for (int hu = bx; hu < BATCH * 4 * 2; hu += G) ret::unit(proj, rope, X.ret_ld, X.ret_gn, ymix, (unsigned char*)out + (size_t)hu * (8 * ret::TILE), lds, hu, tid);
        REPS(32) for (int u = bx; u < BATCH * 8; u += G) na::unit(proj, X.na_rpb, ymix, lds, u, tid);
    }
    SEAM2(3, 5);
    REPS(5) if (IN(5)) { PH_BEGIN
        pg8::DenseOrder S; S.init(M, D, D, wout_t, G, bx);
        pg8::EpiOutProj E{X.x, mod, (bf16_t*)(ws + WS_TB)};
        pg8::gemm_phase(lds, (const char*)ymix, D, S, E, tid);
    }
    SEAM(5);
    REPS(6) if (IN(6)) { PH_BEGIN
        LAS float* cv = (LAS float*)lds; int curb = -1;
        for (int c = bx; c < M / 256; c += G) {
            const int b = c >> 3;
            if (b != curb) {
                __syncthreads();
                if (tid < 256) { const int i = tid * 4; *(LAS f32x4*)(cv + i) = *(const f32x4*)(X.ln1_g + i); *(LAS f32x4*)(cv + 1024 + i) = *(const f32x4*)(X.ln1_b + i);
                    *(LAS f32x4*)(cv + 2048 + i) = *(const f32x4*)(mod + b * 6144 + MOD_SCALE_F + i) + 1.f; *(LAS f32x4*)(cv + 3072 + i) = *(const f32x4*)(mod + b * 6144 + MOD_SHIFT_F + i); }
                __syncthreads(); curb = b;
            }
            const bf16_t* tp = (const bf16_t*)(ws + WS_TB) + (size_t)(c * 256 + wave * 32) * D + lane * 16;
            u32x4 ra = *(const u32x4*)tp, rb = *(const u32x4*)(tp + 8);
#pragma unroll 1
            for (int i = 0; i < 32; ++i) {
                const u32x4 ca = ra, cb = rb; const int nx = i < 31 ? i + 1 : i;
                ra = *(const u32x4*)(tp + (size_t)nx * D); rb = *(const u32x4*)(tp + (size_t)nx * D + 8);
                ln1_row(ca, cb, cv, hf, ws + WS_HF8, (float*)(ws + WS_STATS), c * 256 + wave * 32 + i, lane);
            }
        }
        __syncthreads();
    }
    SEAM(6);
    REPS(7) if (IN(7)) { PH_BEGIN
        { pg8::DenseOrder S; S.init(M, NE, D, wr_t, G, bx); pg8::EpiRouter E{logits}; pg8::gemm_phase(lds, (const char*)hf, D, S, E, tid); }
        { pg8::DenseOrder S; S.init(M, 2 * DE, D, wsgu_t, G, bx); pg8::EpiGU<false> E{(void*)shh}; pg8::gemm_phase(lds, (const char*)hf, D, S, E, tid); }
    }
    SEAM(7);
    if (IN(8)) { PH_BEGIN
        LAS unsigned* hist = tab + T_HIST;
        if (tid < NE) hist[tid] = 0u;
        __syncthreads();
        const f32x4 bias = *(const f32x4*)(X.rbias + lane * 4);
        for (int tok = gw; tok < M; tok += NGW) route_token(logits, bias, topk_e, topk_w, hist, tok, lane);
        __syncthreads();
        if (tid < NE && hist[tid]) atomicAdd(&ctl[CW_COUNT + tid], hist[tid]);
    }
    SEAM(8);
    if (IN(9)) { PH_BEGIN
        build_tables(ctl, tab, tid);
        LAS unsigned* hist = tab + T_HIST; LAS unsigned* base = tab + T_BASE;
        for (int c0 = bx * 2048; c0 < NSLOT; c0 += G * 2048) {
            __syncthreads();
            if (tid < NE) hist[tid] = 0u;
            __syncthreads();
            int e[4]; unsigned loc[4];
#pragma unroll
            for (int i = 0; i < 4; ++i) { const int idx = c0 + i * 512 + tid; e[i] = topk_e[idx]; loc[i] = __hip_atomic_fetch_add(&hist[e[i]], 1u, __ATOMIC_RELAXED, __HIP_MEMORY_SCOPE_WORKGROUP); }
            __syncthreads();
            if (tid < NE && hist[tid]) base[tid] = atomicAdd(&ctl[CW_CURSOR + tid], hist[tid]);
            __syncthreads();
#pragma unroll
            for (int i = 0; i < 4; ++i) { const int idx = c0 + i * 512 + tid; const unsigned pos = tab[T_OFF + e[i]] + base[e[i]] + loc[i]; slot_ent[pos] = idx; slot_w[pos] = topk_w[idx]; }
        }
    }
    SEAM(9);
    if (IN(10)) { PH_BEGIN
        build_tables(ctl, tab, tid);
        REPS(10) { pg8::ExpertOrder<2, true> S; S.init(tab, D, wgu_t, (size_t)512 * D, slot_ent, slot_w, G, bx); pg8::EpiGU<true> E{(void*)act}; pg8::gemm_phase<1>(lds, (const char*)(ws + WS_HF8), D, S, E, tid); }
        { pg8::DenseOrder S; S.init(M, D, DE, wsd_t, G, bx); pg8::EpiSharedDown E{ws + WS_YSH}; pg8::gemm_phase(lds, (const char*)shh, DE, S, E, tid); }
    }
    SEAM(10);
    REPS(11) if (IN(11)) { PH_BEGIN
        build_tables(ctl, tab, tid);
        pg8::ExpertOrder<4, false> S; S.init(tab, DE, wd_t, (size_t)D * DE, slot_ent, slot_w, G, bx); pg8::EpiExpDown E{ybuf, slot_ent}; pg8::gemm_phase<1>(lds, (const char*)act, DE, S, E, tid);
#if MK_DUP == 111
        { pg8::ExpertOrder<4, false> S2; S2.init(tab, DE, wd_t, (size_t)D * DE, slot_ent, slot_w, G, bx); pg8::EpiProbeSum E2{(float*)(ws + WS_STATS)}; pg8::gemm_phase<1>(lds, (const char*)act, DE, S2, E2, tid); }
#endif
    }
    SEAM(11);
    REPS(12) if (IN(12)) { PH_BEGIN
        LAS float* cv = (LAS float*)lds; int curb = -1;
        for (int c = bx; c < M / 256; c += G) {
            const int b = c >> 3;
            if (b != curb) {
                __syncthreads();
                if (tid < 256) { const int i = tid * 4; *(LAS f32x4*)(cv + i) = *(const f32x4*)(X.ln1_g + i); *(LAS f32x4*)(cv + 1024 + i) = *(const f32x4*)(X.ln1_b + i);
                    *(LAS f32x4*)(cv + 2048 + i) = *(const f32x4*)(X.ln2_g + i); *(LAS f32x4*)(cv + 3072 + i) = *(const f32x4*)(X.ln2_b + i); *(LAS f32x4*)(cv + 4096 + i) = *(const f32x4*)(mod + b * 6144 + MOD_GATE_F + i); }
                __syncthreads(); curb = b;
            }
            const int r0 = c * 256 + wave * 32;
            RowRaw nx; final_load(nx, (const bf16_t*)(ws + WS_TB), ybuf, ws + WS_YSH, (const float*)(ws + WS_STATS), r0, lane);
#pragma unroll 1
            for (int i = 0; i < 32; ++i) {
                const RowRaw cur = nx;
                final_load(nx, (const bf16_t*)(ws + WS_TB), ybuf, ws + WS_YSH, (const float*)(ws + WS_STATS), r0 + (i < 31 ? i + 1 : i), lane);
                final_row(out, cur, cv, r0 + i, lane);
            }
        }
    }
#undef IN
#undef SEAM
}

extern "C" void kernel_launch(void* const* d_in, const int* in_sizes, int n_in, void* d_out, int out_size, void* d_ws, size_t ws_size, hipStream_t stream) {
    static int grid = 0;
    if (grid == 0) {
        if (n_in != 21 || in_sizes[0] != M * D || out_size != M * D || ws_size < WS_END) { fprintf(stderr, "kernel_launch: unexpected shapes (n_in %d, ws %zu)\n", n_in, ws_size); grid = -1; return; }
        int dev = 0, cus = 0, per_cu = 0;
        if (hipGetDevice(&dev) != hipSuccess || hipDeviceGetAttribute(&cus, hipDeviceAttributeMultiprocessorCount, dev) != hipSuccess) { grid = -1; return; }
        if (hipFuncSetAttribute((const void*)mk_fwd, hipFuncAttributeMaxDynamicSharedMemorySize, LDS_BYTES) != hipSuccess) { fprintf(stderr, "kernel_launch: hipFuncSetAttribute failed\n"); grid = -1; return; }
        if (hipOccupancyMaxActiveBlocksPerMultiprocessor(&per_cu, (const void*)mk_fwd, NW * 64, LDS_BYTES) != hipSuccess || per_cu < 1) { fprintf(stderr, "kernel_launch: occupancy query says %d\n", per_cu); }
        (void)hipGetLastError();
        grid = cus;
    }
    if (grid < 0) return;
    (void)hipMemsetAsync((char*)d_ws + WS_CTL, 0, 1 * MiB, stream);
    Args a{};
    const float** p = (const float**)&a.X;
    for (int i = 0; i < 21; ++i) p[i] = (const float*)d_in[i];
    a.X.out = (float*)d_out; a.X.ws = (unsigned char*)d_ws;
#if MK_PER_PHASE
    for (int ph = 0; ph < N_PHASES; ++ph) { a.ph_lo = ph; a.ph_hi = ph + 1; hipLaunchKernelGGL(mk_fwd, dim3(grid), dim3(NW * 64), LDS_BYTES, stream, a); }
#else
    a.ph_lo = 0; a.ph_hi = N_PHASES;
    hipLaunchKernelGGL(mk_fwd, dim3(grid), dim3(NW * 64), LDS_BYTES, stream, a);
#endif
}
```

```cpp
#include <hip/hip_runtime.h>
#include <cstdio>
#include <cstdint>

typedef unsigned short bf16_t;
typedef short bf16x8 __attribute__((ext_vector_type(8)));
typedef float f32x4 __attribute__((ext_vector_type(4)));
typedef float f32x2 __attribute__((ext_vector_type(2)));
typedef unsigned u32x4 __attribute__((ext_vector_type(4)));
typedef unsigned u32x2 __attribute__((ext_vector_type(2)));
#define LAS __attribute__((address_space(3)))

constexpr int D = 1024, BATCH = 32, SEQ = 2048, M = BATCH * SEQ;
constexpr int DIN = 3584;
constexpr int OFF_QNA = 0, OFF_KNA = 512, OFF_VNA = 1024, OFF_QR = 1536, OFF_KR = 2048, OFF_VR = 2560, OFF_GR = 3072;
constexpr int NE = 256, TOPK = 8, DE = 256;
constexpr int NSLOT = M * TOPK;
constexpr float LN_EPS = 1e-5f, GN_EPS = 1e-6f;
constexpr float ALPHA = 1.189207115002721f;
constexpr float YSCALE = 64.f, YINV = 1.f / 64.f;
constexpr float S_HF8 = 16.f, S_WGU8 = 256.f, S_ACT8 = 32.f, S_WD8 = 128.f;
constexpr float INV_GU8 = 1.f / (16.f * 256.f), INV_DN8 = 1.f / (32.f * 128.f);
constexpr int MOD_SHIFT_A = 0, MOD_SCALE_A = 1024, MOD_GATE_A = 2048, MOD_SHIFT_F = 3072, MOD_SCALE_F = 4096, MOD_GATE_F = 5120;

constexpr size_t MiB = 1u << 20;
constexpr size_t WS_CTL = 0;
constexpr size_t WS_MOD = 1 * MiB;
constexpr size_t WS_ROPE = 2 * MiB;
constexpr size_t WS_WIN_T = 4 * MiB;
constexpr size_t WS_WOUT_T = 11 * MiB;
constexpr size_t WS_WR_T = 13 * MiB;
constexpr size_t WS_WSGU_T = 14 * MiB;
constexpr size_t WS_WSD_T = 15 * MiB;
constexpr size_t WS_SLOT_ENT = 16 * MiB;
constexpr size_t WS_SLOT_W = 18 * MiB;
constexpr size_t WS_TOPK_E = 20 * MiB;
constexpr size_t WS_TOPK_W = 22 * MiB;
constexpr size_t WS_STATS = 24 * MiB;
constexpr size_t WS_WD_T = 32 * MiB;
constexpr size_t WS_WGU_T = 160 * MiB;
constexpr size_t WS_HF8 = 288 * MiB;
constexpr size_t WS_YMIX = 416 * MiB;
constexpr size_t WS_PROJ = 544 * MiB;
constexpr size_t WS_LOGITS = WS_YMIX, WS_SHH = WS_YMIX + 64 * MiB;
constexpr size_t WS_HF = WS_PROJ, WS_ACT = WS_PROJ + 128 * MiB;
constexpr size_t WS_YBUF = WS_WGU_T;
constexpr size_t WS_TB = WS_PROJ + 256 * MiB;
constexpr size_t WS_YSH = WS_PROJ + 384 * MiB;
constexpr size_t WS_END = 992 * MiB;
constexpr int CW_COUNT = 1024, CW_CURSOR = 1536, CW_BAR = 8192;

constexpr int RING_BYTES = 131072;
constexpr int TAB_OFF = RING_BYTES;
constexpr int T_OFF = 0, T_TILE = 260, T_CNT = 520, T_HIST = 776, T_BASE = 1032, TAB_WORDS = 1288;
constexpr int VN_OFF = TAB_OFF + 6144;
constexpr int ROWTAB_OFF = VN_OFF + 8192;
constexpr int PHASE_BYTES = 155648;
constexpr int MISC_OFF = PHASE_BYTES;
constexpr int LDS_BYTES = PHASE_BYTES + 256;
static_assert(TAB_WORDS * 4 <= 6144 && ROWTAB_OFF + 6144 <= PHASE_BYTES && LDS_BYTES <= 163840, "LDS map");

__device__ __forceinline__ unsigned f2bf(float f) { unsigned u = __float_as_uint(f); return (u + 0x7fffu + ((u >> 16) & 1u)) >> 16; }
__device__ __forceinline__ float bf2f(unsigned short h) { return __uint_as_float(((unsigned)h) << 16); }
__device__ __forceinline__ unsigned pk2(float lo, float hi) { return f2bf(lo) | (f2bf(hi) << 16); }
__device__ __forceinline__ unsigned cvt_pk_bf16(float lo, float hi) { unsigned r; asm volatile("v_cvt_pk_bf16_f32 %0, %1, %2" : "=v"(r) : "v"(lo), "v"(hi)); return r; }
__device__ __forceinline__ float silu_f(float v) { return v * __builtin_amdgcn_rcpf(1.f + __expf(-v)); }
__device__ __forceinline__ float wave_sum(float v) {
#pragma unroll
    for (int o = 1; o < 64; o <<= 1) v += __shfl_xor(v, o);
    return v;
}
__device__ __forceinline__ float clamp8(float v) { return __builtin_amdgcn_fmed3f(v, -440.f, 440.f); }
#define LDS_WAIT() asm volatile("s_waitcnt lgkmcnt(0)" ::: "memory")
__device__ __forceinline__ int lane_id() { return (int)__builtin_amdgcn_mbcnt_hi(~0u, __builtin_amdgcn_mbcnt_lo(~0u, 0u)); }

#define XB_TMO      128
#define XB_XCNT(j)  (256  + 64 * (j))
#define XB_XSUB(j)  (1280 + 64 * (j))
#define XB_XGEN(j)  (2304 + 64 * (j))
#define XB_TOP      3328
#define XB_TOPGEN   3392
#define XCD_BAR_WORDS 3456
#define XB_SPIN_CAP (1u << 23)
__device__ __forceinline__ unsigned xb_ld(unsigned* p)              { return __hip_atomic_load(p, __ATOMIC_RELAXED, __HIP_MEMORY_SCOPE_AGENT); }
__device__ __forceinline__ unsigned xb_add(unsigned* p, unsigned v) { return __hip_atomic_fetch_add(p, v, __ATOMIC_RELAXED, __HIP_MEMORY_SCOPE_AGENT); }
__device__ __forceinline__ unsigned xb_xcc_id() { return (unsigned)__builtin_amdgcn_s_getreg((3 << 11) | 20) & 0xFu; }
#define XB_SPIN(cond, bar) do { unsigned _sp = 0; while (cond) { __builtin_amdgcn_s_sleep(1); \
    if ((++_sp & 255u) == 0u) { if (xb_ld(&(bar)[XB_TMO])) break; if (_sp > XB_SPIN_CAP) { atomicAdd(&(bar)[XB_TMO], 1u); break; } } } } while (0)
struct XcdBarrier { unsigned* bar; unsigned x; volatile LAS unsigned* st; };
__device__ __forceinline__ XcdBarrier xcd_barrier_post(unsigned* bar, volatile LAS unsigned* st, bool leader) {
    XcdBarrier b; b.bar = bar; b.x = xb_xcc_id(); b.st = st;
    if (leader) (void)xb_add(&bar[XB_XCNT(b.x)], 1u);
    return b;
}
__device__ __forceinline__ void xcd_barrier_complete(unsigned* bar, unsigned x, unsigned& nloc, unsigned& nx) {
    const unsigned G = gridDim.x * gridDim.y * gridDim.z;
    unsigned sum, cnt, mine, sp = 0u;
    for (;;) {
        sum = 0u; cnt = 0u; mine = 0u;
#pragma unroll
        for (unsigned j = 0; j < 16; ++j) { const unsigned c = xb_ld(&bar[XB_XCNT(j)]); sum += c; cnt += (c > 0u) ? 1u : 0u; mine = (j == x) ? c : mine; }
        if (sum == G) break;
        __builtin_amdgcn_s_sleep(1);
        if ((++sp & 255u) == 0u) { if (xb_ld(&bar[XB_TMO])) break; if (sp > XB_SPIN_CAP) { atomicAdd(&bar[XB_TMO], 1u); break; } }
    }
    nloc = mine > 0u ? mine : 1u; nx = cnt > 0u ? cnt : 1u;
}
__device__ __forceinline__ void xcd_barrier(const XcdBarrier& b, bool leader) {
    asm volatile("s_waitcnt vmcnt(0)" ::: "memory");
    __syncthreads();
    if (leader) {
        unsigned* bar = b.bar;
        __builtin_amdgcn_s_waitcnt(0);
        unsigned nloc = b.st[0], nx = b.st[1];
        if (nloc == 0u) { xcd_barrier_complete(bar, b.x, nloc, nx); b.st[0] = nloc; b.st[1] = nx; }
        const unsigned old = xb_add(&bar[XB_XSUB(b.x)], 1u);
        const unsigned gen = old / nloc;
        if (old + 1u == (gen + 1u) * nloc) {
            __builtin_amdgcn_fence(__ATOMIC_RELEASE, "agent");
            asm volatile("s_waitcnt vmcnt(0)" ::: "memory");
            const unsigned og = xb_add(&bar[XB_TOP], 1u);
            const unsigned tg = og / nx;
            if (og + 1u == (tg + 1u) * nx) xb_add(&bar[XB_TOPGEN], 1u);
            else XB_SPIN(xb_ld(&bar[XB_TOPGEN]) == tg, bar);
            __builtin_amdgcn_fence(__ATOMIC_ACQUIRE, "agent");
            xb_add(&bar[XB_XGEN(b.x)], 1u);
            asm volatile("s_waitcnt vmcnt(0)" ::: "memory");
        } else {
            XB_SPIN(xb_ld(&bar[XB_XGEN(b.x)]) == gen, bar);
            __builtin_amdgcn_fence(__ATOMIC_ACQUIRE, "agent");
            asm volatile("s_waitcnt vmcnt(0)" ::: "memory");
        }
    }
    __syncthreads();
}

namespace pg8 {
constexpr int BM = 256, BK = 64, HALF = 128, HTB = HALF * BK * 2, STAGE_BYTES = 8 * HTB;
__device__ __forceinline__ int lds_byte(int r, int c) { const int st = (r >> 4) * 2 + (c >> 5), rr = r & 15, cc = c & 31, ob = rr * 64 + cc * 2; return st * 1024 + (ob ^ (((ob >> 9) & 1) << 5)); }
__device__ __forceinline__ void stage_rc(int b, int& R, int& C) { const int st = b / 1024, sb = b % 1024, swz = sb ^ (((sb >> 9) & 1) << 5); R = (st >> 1) * 16 + swz / 64; C = (st & 1) * 32 + (swz % 64) / 2; }
__device__ __forceinline__ int perm32(int rho) { const int n = rho >> 4, i = rho & 15; return 8 * (i >> 2) + 4 * n + (i & 3); }

typedef int i32x8 __attribute__((ext_vector_type(8)));
__device__ __forceinline__ i32x8 cat8(const bf16x8 lo, const bf16x8 hi) { const u32x4 a = __builtin_bit_cast(u32x4, lo), b = __builtin_bit_cast(u32x4, hi); return (i32x8){(int)a.x, (int)a.y, (int)a.z, (int)a.w, (int)b.x, (int)b.y, (int)b.z, (int)b.w}; }
struct Unit { int pm, pn; const char* B; int e, cnt, off; };

template <int ESZ = 2, class Epi, class Sched>
__device__ __forceinline__ void gemm_phase(LAS unsigned char* lds, const char* Abase, const int K, const Sched& S, const Epi& E, const int tid_in) {
    int tid_ = tid_in; asm volatile("" : "+v"(tid_));
    const int tid = tid_, wid = __builtin_amdgcn_readfirstlane(tid >> 6), lane = tid & 63, wr = wid >> 2, wc = wid & 3, fr = lane & 15, fq = lane >> 4;
    const int rowbytes = K * ESZ, nt = rowbytes / 128;
    int Rr[2], Cc[2]; unsigned voffB[2], voffA[2];
#pragma unroll
    for (int i = 0; i < 2; ++i) { int R, C; stage_rc(tid * 16 + i * 8192, R, C); Rr[i] = R; Cc[i] = C; const int Rb = Epi::PERM ? (64 * (R >> 5) + 16 * ((R >> 2) & 3) + 4 * ((R >> 4) & 1) + (R & 3)) : R; voffB[i] = (unsigned)(Rb * rowbytes + C * 2); voffA[i] = (unsigned)(R * rowbytes + C * 2); }
    constexpr bool GATHER = Sched::GATHER;
    const size_t kstep = (size_t)128;
    const size_t hstep = (size_t)HALF * rowbytes;
    const size_t bhstep = (size_t)(Epi::PERM ? 8 : HALF) * rowbytes;
    const unsigned ldsw = (unsigned)wid * 1024u;
    const int aoff = (ESZ == 2) ? lds_byte(wr * 64 + fr, fq * 8) : lds_byte(wr * 64 + fr, 16 * (fq & 1)) + 1024 * (fq >> 1);
    const int boff = (ESZ == 2) ? lds_byte(wc * 32 + fr, fq * 8) : lds_byte(wc * 32 + fr, 16 * (fq & 1)) + 1024 * (fq >> 1);
#define PG8_SA(b, h) (((b) * 2 + (h)) * HTB)
#define PG8_SB(b, h) ((4 + (b) * 2 + (h)) * HTB)
#define PG8_STAGE(bufoff, gbase, voff) do { _Pragma("unroll") for (int _i = 0; _i < 2; ++_i) \
        __builtin_amdgcn_global_load_lds((const unsigned*)((const char*)(gbase) + (voff)[_i]), (LAS unsigned*)(lds + (bufoff) + ldsw + _i * 8192), 16, 0, 0); } while (0)
#define PG8_STAGEA(bufoff, uptr, koff, NEXT, h) do { if constexpr (GATHER) { if (NEXT) { const u32x2 _t = *(const LAS u32x2*)(vnslot + 2 * (h)); unsigned _v[2] = {_t.x, _t.y}; PG8_STAGE(bufoff, Abase + (koff), _v); } else { PG8_STAGE(bufoff, Abase + (koff), vc[h]); } } \
        else { PG8_STAGE(bufoff, (uptr) + (size_t)(h) * hstep + (koff), voffA); } } while (0)
#define PG8_LDA(dst, b, h) do { _Pragma("unroll") for (int m = 0; m < 4; ++m) { if constexpr (ESZ == 2) { _Pragma("unroll") for (int k = 0; k < 2; ++k) dst[m].q[k] = *(const LAS bf16x8*)(lds + PG8_SA(b, h) + aoff + m * 2048 + k * 1024); } \
        else dst[m].w = cat8(*(const LAS bf16x8*)(lds + PG8_SA(b, h) + aoff + m * 2048), *(const LAS bf16x8*)(lds + PG8_SA(b, h) + aoff + m * 2048 + 16)); } } while (0)
#define PG8_LDB(dst, b, h) do { _Pragma("unroll") for (int n = 0; n < 2; ++n) { if constexpr (ESZ == 2) { _Pragma("unroll") for (int k = 0; k < 2; ++k) dst[n].q[k] = *(const LAS bf16x8*)(lds + PG8_SB(b, h) + boff + n * 2048 + k * 1024); } \
        else dst[n].w = cat8(*(const LAS bf16x8*)(lds + PG8_SB(b, h) + boff + n * 2048), *(const LAS bf16x8*)(lds + PG8_SB(b, h) + boff + n * 2048 + 16)); } } while (0)
#define PG8_MMA(ai, bj, At, Bt) do { __builtin_amdgcn_s_setprio(1); _Pragma("unroll") for (int m = 0; m < 4; ++m) _Pragma("unroll") for (int n = 0; n < 2; ++n) { \
        if constexpr (ESZ == 2) { _Pragma("unroll") for (int k = 0; k < 2; ++k) acc[ai][bj][m][n] = __builtin_amdgcn_mfma_f32_16x16x32_bf16(Bt[n].q[k], At[m].q[k], acc[ai][bj][m][n], 0, 0, 0); } \
        else { asm volatile("v_mfma_f32_16x16x128_f8f6f4 %0, %1, %2, %0" : "+v"(acc[ai][bj][m][n]) : "v"(Bt[n].w), "v"(At[m].w)); } } \
        __builtin_amdgcn_s_setprio(0); } while (0)
#define PG8_WAIT_V(n) asm volatile("s_waitcnt vmcnt(" #n ")" ::: "memory")
#define PG8_WAIT_L(n) asm volatile("s_waitcnt lgkmcnt(" #n ")" ::: "memory")
#define PG8_BAR __builtin_amdgcn_s_barrier()
#define PG8_SCHED __builtin_amdgcn_sched_barrier(0)
    Unit cur, nxt; int ui = 0;
    if (!S.next(0, cur)) return;
    f32x4 acc[2][2][4][2];
    union Frag { bf16x8 q[2]; i32x8 w; };
    Frag At[4], B0[2], B1[2];
    unsigned vc[2][2];
    LAS unsigned* vnslot = (LAS unsigned*)(lds + (VN_OFF - 0)) + tid * 4;
    if constexpr (GATHER) S.avoff(cur, Rr, Cc, vc, tid);
    LAS unsigned* rowtab = (LAS unsigned*)(lds + ROWTAB_OFF);
    if constexpr (GATHER) S.rowtab(cur, rowtab, tid);
    const char* cB = cur.B; const char* cA = Abase + S.aoff(cur);
    PG8_STAGE(PG8_SB(0, 0), cB, voffB); PG8_STAGE(PG8_SB(0, 1), cB + bhstep, voffB); PG8_STAGEA(PG8_SA(0, 0), cA, 0, false, 0); PG8_STAGEA(PG8_SA(0, 1), cA, 0, false, 1);
    if (wr == 1) PG8_BAR;
    PG8_WAIT_V(2); PG8_BAR;
    PG8_STAGE(PG8_SB(1, 0), cB + kstep, voffB); PG8_STAGEA(PG8_SA(1, 0), cA, kstep, false, 0); PG8_STAGE(PG8_SB(1, 1), cB + bhstep + kstep, voffB);
    PG8_WAIT_V(6); PG8_BAR;
    asm volatile("" ::: "memory");
#pragma unroll
    for (int a = 0; a < 2; ++a)
#pragma unroll
        for (int b = 0; b < 2; ++b)
#pragma unroll
            for (int m = 0; m < 4; ++m)
#pragma unroll
                for (int n = 0; n < 2; ++n) { acc[a][b][m][n] = (f32x4){0.f, 0.f, 0.f, 0.f}; asm volatile("" : "+v"(acc[a][b][m][n])); }
    asm volatile("s_nop 4" ::: "memory");
    for (;;) {
        const bool has_next = S.next(ui + 1, nxt);
        if constexpr (GATHER) {
            unsigned vn[2][2];
            if (has_next) S.avoff(nxt, Rr, Cc, vn, tid);
            else {
#pragma unroll
                for (int h = 0; h < 2; ++h)
#pragma unroll
                    for (int i = 0; i < 2; ++i) vn[h][i] = vc[h][i];
            }
            *(LAS u32x4*)vnslot = (u32x4){vn[0][0], vn[0][1], vn[1][0], vn[1][1]};
            if (has_next) S.rowtab(nxt, rowtab + 512 * ((ui + 1) % 3), tid);
        }
        const char* nB = has_next ? nxt.B : cB; const char* nA = has_next ? Abase + S.aoff(nxt) : cA;
        for (int t = 0; t < nt; t += 2) {
            const bool last = (t == nt - 2);
            const size_t k1 = (size_t)(t + 1) * kstep;
            const size_t k2 = last ? (size_t)0 : (size_t)(t + 2) * kstep, k3 = k2 + kstep;
            const char* u2 = last ? nA : cA; const char* b2 = last ? nB : cB + (size_t)(t + 2) * kstep;
            const char* b3 = b2 + kstep;
            PG8_LDB(B0, 0, 0); PG8_LDB(B1, 0, 1); PG8_SCHED; PG8_LDA(At, 0, 0); PG8_STAGEA(PG8_SA(1, 1), cA, k1, false, 1);
            PG8_WAIT_V(8); PG8_WAIT_L(0); PG8_BAR; PG8_MMA(0, 0, At, B0); PG8_MMA(0, 1, At, B1); PG8_BAR; PG8_SCHED;
            PG8_LDA(At, 0, 1); PG8_STAGE(PG8_SB(0, 0), b2, voffB); PG8_STAGE(PG8_SB(0, 1), b2 + bhstep, voffB); PG8_STAGEA(PG8_SA(0, 0), u2, k2, last, 0);
            PG8_WAIT_V(8); PG8_WAIT_L(0); PG8_BAR; PG8_MMA(1, 0, At, B0); PG8_MMA(1, 1, At, B1); PG8_BAR; PG8_SCHED;
            PG8_LDB(B0, 1, 0); PG8_LDB(B1, 1, 1); PG8_SCHED; PG8_LDA(At, 1, 0); PG8_STAGEA(PG8_SA(0, 1), u2, k2, last, 1);
            PG8_WAIT_V(8); PG8_WAIT_L(0); PG8_BAR; PG8_MMA(0, 0, At, B0); PG8_MMA(0, 1, At, B1); PG8_BAR; PG8_SCHED;
            PG8_LDA(At, 1, 1); PG8_STAGE(PG8_SB(1, 0), b3, voffB); PG8_STAGE(PG8_SB(1, 1), b3 + bhstep, voffB); PG8_STAGEA(PG8_SA(1, 0), u2, k3, last, 0);
            PG8_WAIT_V(8); PG8_WAIT_L(0); PG8_BAR; PG8_MMA(1, 0, At, B0); PG8_MMA(1, 1, At, B1); PG8_BAR; PG8_SCHED;
        }
        if (wr == 0) PG8_BAR;
        if constexpr (ESZ == 1) {
            asm volatile("s_nop 15\n\ts_nop 15" ::: "memory");
#pragma unroll
            for (int a = 0; a < 2; ++a)
#pragma unroll
                for (int b = 0; b < 2; ++b)
#pragma unroll
                    for (int m = 0; m < 4; ++m) asm volatile("" : "+v"(acc[a][b][m][0]), "+v"(acc[a][b][m][1]));
        }
        { const int l2 = lane_id(); E(acc, cur, wr, wc, l2 & 15, l2 >> 4, rowtab + 512 * (ui % 3)); }
        if (!has_next) break;
#pragma unroll
        for (int a = 0; a < 2; ++a)
#pragma unroll
            for (int b = 0; b < 2; ++b)
#pragma unroll
                for (int m = 0; m < 4; ++m)
#pragma unroll
                    for (int n = 0; n < 2; ++n) acc[a][b][m][n] = (f32x4){0.f, 0.f, 0.f, 0.f};
        cur = nxt; cB = nB; cA = nA; ++ui;
        if constexpr (GATHER) { const u32x4 _t = *(const LAS u32x4*)vnslot; vc[0][0] = _t.x; vc[0][1] = _t.y; vc[1][0] = _t.z; vc[1][1] = _t.w; }
        if (wr == 1) PG8_BAR;
    }
    PG8_WAIT_V(0);
    PG8_BAR;
#undef PG8_SA
#undef PG8_SB
#undef PG8_STAGE
#undef PG8_STAGEA
#undef PG8_LDA
#undef PG8_LDB
#undef PG8_MMA
#undef PG8_WAIT_V
#undef PG8_WAIT_L
#undef PG8_BAR
#undef PG8_SCHED
}

struct DenseOrder {
    int nM, nN, nwg, G, c, K; const char* Bt;
    __device__ __forceinline__ void init(int Mrows, int N, int K_, const void* Bt_, int G_, int c_) { nM = Mrows / BM; nN = N / BM; nwg = nM * nN; G = G_; c = c_; K = K_; Bt = (const char*)Bt_; }
    __device__ __forceinline__ bool next(int i, Unit& u) const {
        const long L = (long)i * G + c; if (L >= nwg) return false;
        int wgid = (int)L; { const int q = nwg / 8, r = nwg % 8, xcd = wgid % 8, off = wgid / 8; wgid = (xcd < r ? xcd * (q + 1) : r * (q + 1) + (xcd - r) * q) + off; }
        const int nig = 8 * nN, gid = wgid / nig, fm = gid * 8, gsz = (nM - fm) < 8 ? (nM - fm) : 8;
        u.pm = fm + ((wgid % nig) % gsz); u.pn = (wgid % nig) / gsz; u.B = Bt + (size_t)u.pn * BM * K * 2; u.e = 0; u.cnt = 0; u.off = 0; return true;
    }
    static constexpr bool GATHER = false;
    __device__ __forceinline__ size_t aoff(const Unit& u) const { return (size_t)u.pm * BM * K * 2; }
    __device__ __forceinline__ void avoff(const Unit&, const int (&)[2], const int (&)[2], unsigned (&)[2][2], int) const {}
};
template <int NCOL, bool TOKROWS> struct ExpertOrder {
    static constexpr bool GATHER = true;
    __device__ __forceinline__ size_t aoff(const Unit&) const { return 0; }
    const LAS unsigned* tab; int per, c, K  ; const char* W; size_t wstride; const int* slot_ent; const float* slot_w;
    mutable int ehint = 0;
    int xbase, xend, xstride, xlb;
    __device__ __forceinline__ void init(const LAS unsigned* tab_, int K_, const void* W_, size_t wstride_, const int* slot_ent_, const float* slot_w_, int G, int c_) {
        tab = tab_; K = K_; W = (const char*)W_; wstride = wstride_; slot_ent = slot_ent_; slot_w = slot_w_; c = c_;
        const int U = (int)tab[T_TILE + NE] * NCOL; per = (U + G - 1) / G;
        if (G % 8 == 0) { const int x = c_ % 8; const int q = U / 8, r = U % 8; xbase = x * q + (x < r ? x : r); xend = xbase + q + (x < r ? 1 : 0); xstride = G / 8; xlb = c_ / 8; }
        else { xbase = 0; xend = U; xstride = G; xlb = c_; }
    }
    __device__ __forceinline__ bool next(int i, Unit& u) const {
        const int L = xbase + i * xstride + xlb;
        if (L >= xend) return false;
        const int tile = L / NCOL; u.pn = L % NCOL;
        int lo = ehint;
        if (i == 0) { lo = 0; int hi = NE - 1; while (lo < hi) { const int mid = (lo + hi + 1) >> 1; if ((int)tab[T_TILE + mid] <= tile) lo = mid; else hi = mid - 1; } }
        else { while (lo < NE - 1 && (int)tab[T_TILE + lo + 1] <= tile) ++lo; }
        ehint = lo;
        u.e = lo; u.pm = tile - (int)tab[T_TILE + lo]; u.cnt = (int)tab[T_CNT + lo]; u.off = (int)tab[T_OFF + lo];
        u.B = W + (size_t)lo * wstride + (size_t)u.pn * BM * K; return true;
    }
    __device__ __forceinline__ void rowtab(const Unit& u, LAS unsigned* t, int tid) const {
        if (tid < BM) { int r = u.pm * BM + tid; if (r >= u.cnt) r = u.cnt - 1; t[tid] = (unsigned)slot_ent[u.off + r]; t[BM + tid] = __float_as_uint(slot_w[u.off + r]); }
    }
    __device__ __forceinline__ void avoff(const Unit& u, const int (&)[2], const int (&)[2], unsigned (&v)[2][2], int tidq) const {
        int R[2], C[2]; asm volatile("" : "+v"(tidq));
#pragma unroll
        for (int i = 0; i < 2; ++i) stage_rc(tidq * 16 + i * 8192, R[i], C[i]);
#pragma unroll
        for (int h = 0; h < 2; ++h)
#pragma unroll
            for (int i = 0; i < 2; ++i) {
                int r = u.pm * BM + h * HALF + R[i]; if (r >= u.cnt) r = u.cnt - 1;
                const int slot = u.off + r;
                const int row = TOKROWS ? (slot_ent[slot] >> 3) : slot;
                v[h][i] = (unsigned)(row * K + C[i] * 2);
            }
    }
};

struct EpiInProj {
    static constexpr bool PERM = true; bf16_t* O;
    __device__ __forceinline__ void operator()(const f32x4 (&acc)[2][2][4][2], const Unit& u, int wr, int wc, int fr, int fq, const LAS unsigned* rt) const {
        const float sc = (u.pn < 2) ? 0.125f : ((u.pn == 8 || u.pn == 9) ? 0.08838834764831845f : 1.f);
        const int row0 = u.pm * BM + wr * 64 + fr, col0 = u.pn * BM + wc * 64 + 16 * fq;
#pragma unroll
        for (int ai = 0; ai < 2; ++ai)
#pragma unroll
            for (int m = 0; m < 4; ++m) { bf16_t* rowp = O + (size_t)(row0 + ai * HALF + m * 16) * DIN + col0;
#pragma unroll
                for (int bj = 0; bj < 2; ++bj) { const f32x4 v0 = acc[ai][bj][m][0] * sc, v1 = acc[ai][bj][m][1] * sc;
                    u32x4 w; w.x = cvt_pk_bf16(v0[0], v0[1]); w.y = cvt_pk_bf16(v0[2], v0[3]); w.z = cvt_pk_bf16(v1[0], v1[1]); w.w = cvt_pk_bf16(v1[2], v1[3]);
                    *(u32x4*)(rowp + 8 * bj) = w; } }
    }
};
struct EpiOutProj {
    static constexpr bool PERM = true; const float* x; const float* mod; bf16_t* tb;
    __device__ __forceinline__ void operator()(const f32x4 (&acc)[2][2][4][2], const Unit& u, int wr, int wc, int fr, int fq, const LAS unsigned* rt) const {
        const int b = (u.pm * BM) >> 11; const int col0 = u.pn * BM + wc * 64 + 16 * fq;
        f32x4 g[2][2];
#pragma unroll
        for (int bj = 0; bj < 2; ++bj)
#pragma unroll
            for (int n = 0; n < 2; ++n) g[bj][n] = *(const f32x4*)(mod + b * 6144 + MOD_GATE_A + col0 + 8 * bj + 4 * n);
#pragma unroll
        for (int ai = 0; ai < 2; ++ai)
#pragma unroll
            for (int m = 0; m < 4; ++m) { const size_t o = (size_t)(u.pm * BM + ai * HALF + wr * 64 + m * 16 + fr) * D + col0;
#pragma unroll
                for (int bj = 0; bj < 2; ++bj) {
                    const f32x4 t0 = *(const f32x4*)(x + o + 8 * bj) * ALPHA + g[bj][0] * acc[ai][bj][m][0], t1 = *(const f32x4*)(x + o + 8 * bj + 4) * ALPHA + g[bj][1] * acc[ai][bj][m][1];
                    u32x4 w; w.x = cvt_pk_bf16(t0[0], t0[1]); w.y = cvt_pk_bf16(t0[2], t0[3]); w.z = cvt_pk_bf16(t1[0], t1[1]); w.w = cvt_pk_bf16(t1[2], t1[3]);
                    *(u32x4*)(tb + o + 8 * bj) = w; } }
    }
};
struct EpiRouter {
    static constexpr bool PERM = false; float* out;
    __device__ __forceinline__ void operator()(const f32x4 (&acc)[2][2][4][2], const Unit& u, int wr, int wc, int fr, int fq, const LAS unsigned* rt) const {
        const int col0 = wc * 32 + 4 * fq;
#pragma unroll
        for (int ai = 0; ai < 2; ++ai)
#pragma unroll
            for (int m = 0; m < 4; ++m) { float* rowp = out + (size_t)(u.pm * BM + ai * HALF + wr * 64 + m * 16 + fr) * NE + col0;
#pragma unroll
                for (int bj = 0; bj < 2; ++bj)
#pragma unroll
                    for (int n = 0; n < 2; ++n) *(f32x4*)(rowp + bj * HALF + n * 16) = acc[ai][bj][m][n]; }
    }
};
template <bool EXPERT> struct EpiGU {
    static constexpr bool PERM = true; void* Ov;
    __device__ __forceinline__ void operator()(const f32x4 (&acc)[2][2][4][2], const Unit& u, int wr, int wc, int fr, int fq, const LAS unsigned* rt) const {
        const int h0 = u.pn * HALF + wc * 32 + 8 * fq;
#pragma unroll
        for (int ai = 0; ai < 2; ++ai)
#pragma unroll
            for (int m = 0; m < 4; ++m) {
                const int rtw = u.pm * BM + ai * HALF + wr * 64 + m * 16 + fr;
                if (EXPERT) { if (rtw >= u.cnt) continue; }
                const float w = EXPERT ? __uint_as_float(rt[BM + ai * HALF + wr * 64 + m * 16 + fr]) * (S_ACT8 * INV_GU8) : 1.f;
                const float gs = EXPERT ? INV_GU8 : 1.f;
                const f32x4 g0 = acc[ai][0][m][0] * gs, g1 = acc[ai][0][m][1] * gs, u0 = acc[ai][1][m][0], u1 = acc[ai][1][m][1];
                const float h[8] = {w * silu_f(g0[0]) * u0[0], w * silu_f(g0[1]) * u0[1], w * silu_f(g0[2]) * u0[2], w * silu_f(g0[3]) * u0[3],
                                    w * silu_f(g1[0]) * u1[0], w * silu_f(g1[1]) * u1[1], w * silu_f(g1[2]) * u1[2], w * silu_f(g1[3]) * u1[3]};
                if (EXPERT) {
                    int w0 = __builtin_amdgcn_cvt_pk_fp8_f32(clamp8(h[0]), clamp8(h[1]), 0, false); w0 = __builtin_amdgcn_cvt_pk_fp8_f32(clamp8(h[2]), clamp8(h[3]), w0, true);
                    int w1 = __builtin_amdgcn_cvt_pk_fp8_f32(clamp8(h[4]), clamp8(h[5]), 0, false); w1 = __builtin_amdgcn_cvt_pk_fp8_f32(clamp8(h[6]), clamp8(h[7]), w1, true);
                    u32x2 o; o.x = (unsigned)w0; o.y = (unsigned)w1; *(u32x2*)((unsigned char*)Ov + (size_t)(u.off + rtw) * DE + h0) = o;
                    asm volatile("" ::: "memory");
                } else {
                    u32x4 o; o.x = cvt_pk_bf16(h[0], h[1]); o.y = cvt_pk_bf16(h[2], h[3]); o.z = cvt_pk_bf16(h[4], h[5]); o.w = cvt_pk_bf16(h[6], h[7]);
                    *(u32x4*)((bf16_t*)Ov + (size_t)rtw * DE + h0) = o;
                }
            }
    }
};
struct EpiSharedDown {
    static constexpr bool PERM = true; unsigned char* ysh;
    __device__ __forceinline__ void operator()(const f32x4 (&acc)[2][2][4][2], const Unit& u, int wr, int wc, int fr, int fq, const LAS unsigned* rt) const {
        const int col0 = u.pn * BM + wc * 64 + 16 * fq;
#pragma unroll
        for (int ai = 0; ai < 2; ++ai)
#pragma unroll
            for (int m = 0; m < 4; ++m) {
                u32x4 o;
#pragma unroll
                for (int bj = 0; bj < 2; ++bj) { const f32x4 v0 = acc[ai][bj][m][0] * YSCALE, v1 = acc[ai][bj][m][1] * YSCALE;
                    int w0 = __builtin_amdgcn_cvt_pk_fp8_f32(clamp8(v0[0]), clamp8(v0[1]), 0, false); w0 = __builtin_amdgcn_cvt_pk_fp8_f32(clamp8(v0[2]), clamp8(v0[3]), w0, true);
                    int w1 = __builtin_amdgcn_cvt_pk_fp8_f32(clamp8(v1[0]), clamp8(v1[1]), 0, false); w1 = __builtin_amdgcn_cvt_pk_fp8_f32(clamp8(v1[2]), clamp8(v1[3]), w1, true);
                    if (bj == 0) { o.x = (unsigned)w0; o.y = (unsigned)w1; } else { o.z = (unsigned)w0; o.w = (unsigned)w1; } }
                *(u32x4*)(ysh + (size_t)(u.pm * BM + ai * HALF + wr * 64 + m * 16 + fr) * D + col0) = o;
            }
    }
};
struct EpiExpDown {
    static constexpr bool PERM = true; unsigned char* ybuf; const int* slot_ent;
    __device__ __forceinline__ void operator()(const f32x4 (&acc)[2][2][4][2], const Unit& u, int wr, int wc, int fr, int fq, const LAS unsigned* rt) const {
        const int col0 = u.pn * BM + wc * 64 + 16 * fq;
#pragma unroll
        for (int ai = 0; ai < 2; ++ai)
#pragma unroll
            for (int m = 0; m < 4; ++m) {
                const int rtw = u.pm * BM + ai * HALF + wr * 64 + m * 16 + fr; if (rtw >= u.cnt) continue;
                u32x4 o;
#pragma unroll
                for (int bj = 0; bj < 2; ++bj) { const f32x4 v0 = acc[ai][bj][m][0] * (YSCALE * INV_DN8), v1 = acc[ai][bj][m][1] * (YSCALE * INV_DN8);
                    int w0 = __builtin_amdgcn_cvt_pk_fp8_f32(clamp8(v0[0]), clamp8(v0[1]), 0, false); w0 = __builtin_amdgcn_cvt_pk_fp8_f32(clamp8(v0[2]), clamp8(v0[3]), w0, true);
                    int w1 = __builtin_amdgcn_cvt_pk_fp8_f32(clamp8(v1[0]), clamp8(v1[1]), 0, false); w1 = __builtin_amdgcn_cvt_pk_fp8_f32(clamp8(v1[2]), clamp8(v1[3]), w1, true);
                    if (bj == 0) { o.x = (unsigned)w0; o.y = (unsigned)w1; } else { o.z = (unsigned)w0; o.w = (unsigned)w1; } }
                *(u32x4*)(ybuf + (size_t)rt[ai * HALF + wr * 64 + m * 16 + fr] * D + col0) = o;
                asm volatile("" ::: "memory");
            }
    }
};
struct EpiProbeSum {
    static constexpr bool PERM = true; float* o;
    __device__ __forceinline__ void operator()(const f32x4 (&acc)[2][2][4][2], const Unit& u, int wr, int wc, int fr, int fq, const LAS unsigned* rt) const {
        f32x4 s = (f32x4){0.f, 0.f, 0.f, 0.f};
#pragma unroll
        for (int a = 0; a < 2; ++a)
#pragma unroll
            for (int b = 0; b < 2; ++b)
#pragma unroll
                for (int m = 0; m < 4; ++m) s += acc[a][b][m][0] + acc[a][b][m][1];
        if (s.x == 123.456f) *(f32x4*)(o + (size_t)(blockIdx.x * 512 + wr * 256 + wc * 64 + fq * 16 + fr) * 4) = s;
    }
};
}

struct Ctx {
    const float *x, *c, *w_ada, *b_ada, *w_in, *w_out, *na_rpb, *ret_ld, *ret_gn, *ln1_g, *ln1_b, *ln2_g, *ln2_b, *w_router, *rbias, *w_gate, *w_up, *w_down, *ws_gate, *ws_up, *ws_down;
    float* out; unsigned char* ws;
};
constexpr int NW = 8;

__device__ __forceinline__ void transpose_item(const float* W, int K, int N, bf16_t* WT, int G, int which, LAS float* scr, int item, int lane) {
    const int nblk = N / 32, kb = item / nblk, nb = item % nblk, k0 = 64 * kb, n0 = 32 * nb;
    float v[32];
#pragma unroll
    for (int i = 0; i < 32; ++i) { const int kk = 2 * i + (lane >> 5); v[i] = __builtin_nontemporal_load(W + (size_t)(k0 + kk) * N + n0 + (lane & 31)); }
#pragma unroll
    for (int i = 0; i < 32; ++i) { const int kk = 2 * i + (lane >> 5); scr[kk * 33 + (lane & 31)] = v[i]; }
    LDS_WAIT(); asm volatile("" ::: "memory");
    const int c = lane & 7;
#pragma unroll
    for (int j = 0; j < 4; ++j) { const int n = (lane >> 3) + 8 * j; const LAS float* s = scr + (8 * c) * 33 + n;
        u32x4 o; o.x = pk2(s[0 * 33], s[1 * 33]); o.y = pk2(s[2 * 33], s[3 * 33]); o.z = pk2(s[4 * 33], s[5 * 33]); o.w = pk2(s[6 * 33], s[7 * 33]);
        const int ng = n0 + n; const int drow = (G == 0) ? ng : ((ng / G) * 2 * G + which * G + (ng % G));
        *(u32x4*)(WT + (size_t)drow * K + k0 + 8 * c) = o; }
    LDS_WAIT(); asm volatile("" ::: "memory");
}
__device__ __forceinline__ void transpose_item_fp8(const float* W, int K, int N, unsigned char* WT, int G, int which, float scale, LAS float* scr, int item, int lane) {
    const int nblk = N / 32, kb = item / nblk, nb = item % nblk, k0 = 64 * kb, n0 = 32 * nb;
    float v[32];
#pragma unroll
    for (int i = 0; i < 32; ++i) { const int kk = 2 * i + (lane >> 5); v[i] = __builtin_nontemporal_load(W + (size_t)(k0 + kk) * N + n0 + (lane & 31)); }
#pragma unroll
    for (int i = 0; i < 32; ++i) { const int kk = 2 * i + (lane >> 5); scr[kk * 33 + (lane & 31)] = v[i] * scale; }
    LDS_WAIT(); asm volatile("" ::: "memory");
    const int c = lane & 7;
#pragma unroll
    for (int j = 0; j < 4; ++j) { const int n = (lane >> 3) + 8 * j; const LAS float* sp = scr + (8 * c) * 33 + n;
        int w0 = __builtin_amdgcn_cvt_pk_fp8_f32(clamp8(sp[0 * 33]), clamp8(sp[1 * 33]), 0, false); w0 = __builtin_amdgcn_cvt_pk_fp8_f32(clamp8(sp[2 * 33]), clamp8(sp[3 * 33]), w0, true);
        int w1 = __builtin_amdgcn_cvt_pk_fp8_f32(clamp8(sp[4 * 33]), clamp8(sp[5 * 33]), 0, false); w1 = __builtin_amdgcn_cvt_pk_fp8_f32(clamp8(sp[6 * 33]), clamp8(sp[7 * 33]), w1, true);
        const int ng = n0 + n; const int drow = (G == 0) ? ng : ((ng / G) * 2 * G + which * G + (ng % G));
        u32x2 o; o.x = (unsigned)w0; o.y = (unsigned)w1; *(u32x2*)(WT + (size_t)drow * K + k0 + 8 * c) = o; }
    LDS_WAIT(); asm volatile("" ::: "memory");
}
__device__ __forceinline__ void rope_entry(float* tab, int idx) {
    const int t = idx >> 6, i = idx & 63;
    const float inv_freq = powf(10000.f, -(float)(2 * i) / 128.f);
    const float ang = (float)t * inv_freq;
    const double a = (double)ang; const double two_pi = 6.283185307179586476925286766559;
    const double kf = rint(a / two_pi); double r = a - kf * two_pi;
    double sgn = 1.0; if (r > 1.5707963267948966) { r = 3.141592653589793 - r; sgn = -1.0; } else if (r < -1.5707963267948966) { r = -3.141592653589793 - r; sgn = -1.0; }
    const double r2 = r * r;
    const double s = r * (1.0 + r2 * (-1.0 / 6 + r2 * (1.0 / 120 + r2 * (-1.0 / 5040 + r2 * (1.0 / 362880 + r2 * (-1.0 / 39916800 + r2 * (1.0 / 6227020800.0 + r2 * (-1.0 / 1307674368000.0))))))));
    const double c = 1.0 + r2 * (-0.5 + r2 * (1.0 / 24 + r2 * (-1.0 / 720 + r2 * (1.0 / 40320 + r2 * (-1.0 / 3628800 + r2 * (1.0 / 479001600.0 + r2 * (-1.0 / 87178291200.0 + r2 * (1.0 / 20922789888000.0))))))));
    tab[idx] = (float)(sgn * c); tab[SEQ * 64 + idx] = (float)s;
}
__device__ __forceinline__ void mod_task(const float* __restrict__ cin, const float* __restrict__ w_ada, float* __restrict__ modp, int task, int lane) {
    const int cbk = task % 96, kc = task / 96, j = cbk * 64 + lane, k0 = kc * 64;
    float acc[32], cv[32];
#pragma unroll
    for (int b = 0; b < 32; ++b) { acc[b] = 0.f; cv[b] = silu_f(cin[b * D + k0 + lane]); }
#pragma unroll
    for (int kb = 0; kb < 4; ++kb) {
        float w[16];
#pragma unroll
        for (int i = 0; i < 16; ++i) w[i] = w_ada[(size_t)(k0 + kb * 16 + i) * 6144 + j];
#pragma unroll
        for (int i = 0; i < 16; ++i)
#pragma unroll
            for (int b = 0; b < 32; ++b) acc[b] += __builtin_bit_cast(float, __builtin_amdgcn_readlane(__builtin_bit_cast(int, cv[b]), kb * 16 + i)) * w[i];
    }
#pragma unroll
    for (int b = 0; b < 32; ++b) modp[((size_t)kc * 32 + b) * 6144 + j] = acc[b];
}
__device__ __forceinline__ float mod_sum(const float* __restrict__ modp, const float* __restrict__ b_ada, int b, int j) {
    float s = 0.f;
#pragma unroll
    for (int kc = 0; kc < 16; ++kc) s += modp[((size_t)kc * 32 + b) * 6144 + j];
    return s + b_ada[j];
}

#ifndef RET_PROBE
#define RET_PROBE 0
#endif
namespace ret {
typedef short s16x4 __attribute__((ext_vector_type(4)));
typedef __bf16 bfx2 __attribute__((ext_vector_type(2)));
constexpr unsigned RS = 288, TILE = 128 * RS, LK = 0, LV = TILE, LRF = 2 * TILE, LRB = 3 * TILE;
constexpr float LOG2E = 1.4426950408889634f;
__device__ __forceinline__ unsigned offb(unsigned row, unsigned ch) { return RS * row + 16u * ch; }
__device__ __forceinline__ unsigned cvtpk(float lo, float hi) { const f32x2 v = {lo, hi}; return __builtin_bit_cast(unsigned, __builtin_convertvector(v, bfx2)); }
__device__ __forceinline__ bf16x8 pack8(const float (&f)[8]) { u32x4 u; u.x = cvtpk(f[0], f[1]); u.y = cvtpk(f[2], f[3]); u.z = cvtpk(f[4], f[5]); u.w = cvtpk(f[6], f[7]); return __builtin_bit_cast(bf16x8, u); }
__device__ __forceinline__ void unpack8(const bf16x8 v, float (&f)[8]) { const u32x4 u = __builtin_bit_cast(u32x4, v);
    f[0] = __uint_as_float(u.x << 16); f[1] = __uint_as_float(u.x & 0xffff0000u); f[2] = __uint_as_float(u.y << 16); f[3] = __uint_as_float(u.y & 0xffff0000u);
    f[4] = __uint_as_float(u.z << 16); f[5] = __uint_as_float(u.z & 0xffff0000u); f[6] = __uint_as_float(u.w << 16); f[7] = __uint_as_float(u.w & 0xffff0000u); }
__device__ __forceinline__ bf16x8 trfrag(LAS unsigned char* base, unsigned row0, unsigned row1, unsigned cblk, unsigned qp, unsigned p) {
    const unsigned ch = 2u * cblk + (p >> 1), bo = 8u * (p & 1u);
    const s16x4 lo = __builtin_amdgcn_ds_read_tr16_b64_v4i16((LAS s16x4*)(base + offb(row0 + qp, ch) + bo));
    const s16x4 hi = __builtin_amdgcn_ds_read_tr16_b64_v4i16((LAS s16x4*)(base + offb(row1 + qp, ch) + bo));
    return __builtin_shufflevector(lo, hi, 0, 1, 2, 3, 4, 5, 6, 7);
}
struct KVRaw { bf16x8 ka[2], kb[2], v[4]; f32x4 c0[2], c1[2], s0[2], s1[2]; };
__device__ __forceinline__ void kv_load(KVRaw& R, const bf16_t* __restrict__ proj, const float* __restrict__ rope, int b, int h, int n, int tid) {
#pragma unroll
    for (int i = 0; i < 2; ++i) {
        const int q2 = tid + 512 * i, row = q2 >> 3, pc = q2 & 7, t = n * 128 + row;
        const bf16_t* rp = proj + (size_t)(b * SEQ + t) * DIN + OFF_KR + h * 128;
        R.ka[i] = *(const bf16x8*)(rp + pc * 8); R.kb[i] = *(const bf16x8*)(rp + 64 + pc * 8);
        R.c0[i] = *(const f32x4*)(rope + t * 64 + pc * 8); R.c1[i] = *(const f32x4*)(rope + t * 64 + pc * 8 + 4);
        R.s0[i] = *(const f32x4*)(rope + SEQ * 64 + t * 64 + pc * 8); R.s1[i] = *(const f32x4*)(rope + SEQ * 64 + t * 64 + pc * 8 + 4);
    }
#pragma unroll
    for (int i = 0; i < 4; ++i) { const int q4 = tid + 512 * i, row = q4 >> 4, ch = q4 & 15, t = n * 128 + row;
        R.v[i] = *(const bf16x8*)(proj + (size_t)(b * SEQ + t) * DIN + OFF_VR + h * 128 + ch * 8); }
}
__device__ __forceinline__ void kv_store(LAS unsigned char* lds, const KVRaw& R, int tid) {
#pragma unroll
    for (int i = 0; i < 2; ++i) {
        const int q2 = tid + 512 * i, row = q2 >> 3, pc = q2 & 7;
        float fa[8], fb[8], o1[8], o2[8];
        unpack8(R.ka[i], fa); unpack8(R.kb[i], fb);
        const float cs[8] = {R.c0[i].x, R.c0[i].y, R.c0[i].z, R.c0[i].w, R.c1[i].x, R.c1[i].y, R.c1[i].z, R.c1[i].w}, sn[8] = {R.s0[i].x, R.s0[i].y, R.s0[i].z, R.s0[i].w, R.s1[i].x, R.s1[i].y, R.s1[i].z, R.s1[i].w};
#pragma unroll
        for (int e = 0; e < 8; ++e) { o1[e] = fa[e] * cs[e] - fb[e] * sn[e]; o2[e] = fb[e] * cs[e] + fa[e] * sn[e]; }
        *(LAS bf16x8*)(lds + LK + offb(row, pc)) = pack8(o1); *(LAS bf16x8*)(lds + LK + offb(row, pc + 8)) = pack8(o2);
    }
#pragma unroll
    for (int i = 0; i < 4; ++i) { const int q4 = tid + 512 * i, row = q4 >> 4, ch = q4 & 15; *(LAS bf16x8*)(lds + LV + offb(row, ch)) = R.v[i]; }
}
__device__ __forceinline__ void rb_dma(LAS unsigned char* lds, const unsigned char* img, int w, int lane) {
#pragma unroll
    for (int i = 0; i < 5; ++i) { const int o = w + 8 * i; if (o < (int)TILE / 1024)
        __builtin_amdgcn_global_load_lds((const unsigned*)(img + o * 1024 + lane * 16), (LAS unsigned*)(lds + LRB + o * 1024), 16, 0, 0); }
}
template <bool FWD> __device__ __forceinline__ void state_update_1(LAS unsigned char* lds, f32x4 (&racc)[8], float l2, int w, int g, unsigned qp, unsigned p);
template <bool FWD> __device__ __forceinline__ void state_update(LAS unsigned char* lds, f32x4 (&racc)[8], float l2, int w, int g, unsigned qp, unsigned p) {
    if (RET_PROBE == 2) {
        f32x4 r2[8];
#pragma unroll
        for (int i = 0; i < 8; ++i) r2[i] = racc[i];
        unsigned zo = 0; asm volatile("" : "+v"(zo));
        state_update_1<FWD>(lds + zo, r2, l2, w, g, qp, p);
        state_update_1<FWD>(lds, racc, l2, w, g, qp, p);
#pragma unroll
        for (int i = 0; i < 8; ++i) racc[i] = (racc[i] + r2[i]) * 0.5f;
    } else state_update_1<FWD>(lds, racc, l2, w, g, qp, p);
}
template <bool FWD> __device__ __forceinline__ void state_update_1(LAS unsigned char* lds, f32x4 (&racc)[8], float l2, int w, int g, unsigned qp, unsigned p) {
    const float dec = __builtin_amdgcn_exp2f(128.f * l2);
    bf16x8 vs[4];
#pragma unroll
    for (int ks = 0; ks < 4; ++ks) {
        float f[8]; unpack8(trfrag(lds + LV, 32 * ks + 4 * g, 32 * ks + 16 + 4 * g, w, qp, p), f);
#pragma unroll
        for (int e = 0; e < 8; ++e) { const int key = 32 * ks + 16 * (e >> 2) + 4 * g + (e & 3); f[e] *= __builtin_amdgcn_exp2f((FWD ? (float)(127 - key) : (float)key) * l2); }
        vs[ks] = pack8(f);
    }
#pragma unroll
    for (int nb = 0; nb < 8; ++nb) {
        racc[nb] = racc[nb] * dec;
#pragma unroll
        for (int ks = 0; ks < 4; ++ks) racc[nb] = __builtin_amdgcn_mfma_f32_16x16x32_bf16(vs[ks], trfrag(lds + LK, 32 * ks + 4 * g, 32 * ks + 16 + 4 * g, nb, qp, p), racc[nb], 0, 0, 0);
    }
}
__device__ __forceinline__ void unit(const bf16_t* __restrict__ proj, const float* __restrict__ rope, const float* __restrict__ log_decay, const float* __restrict__ gn_g, bf16_t* __restrict__ ymix,
                                     unsigned char* __restrict__ scratch  , LAS unsigned char* lds, int hu, const int tid_in) {
    const int u = hu >> 1, n0 = (hu & 1) * 8, n1 = n0 + 8;
    const int b = u >> 2, h = u & 3;
    int tid_ = tid_in; asm volatile("" : "+v"(tid_));
    const int tid0 = tid_, w = __builtin_amdgcn_readfirstlane(tid0 >> 6);
#define RET_LANE int tid = tid0; asm volatile("" : "+v"(tid)); const int lane = tid & 63, r = lane & 15, g = lane >> 4; const unsigned qp = (unsigned)r >> 2, p = (unsigned)lane & 3u;
    const float lf2_ = log_decay[h] * LOG2E, lb2_ = log_decay[4 + h] * LOG2E;
    f32x4 racc[8];
    KVRaw raw;
    for (int rep7 = 0; rep7 < (RET_PROBE == 7 ? 2 : 1); ++rep7) {
#pragma unroll
    for (int nb = 0; nb < 8; ++nb) racc[nb] = (f32x4){0.f, 0.f, 0.f, 0.f};
    kv_load(raw, proj, rope, b, h, 15, tid0);
    for (int n = 15; n >= n0; --n) {
        RET_LANE
        if (n < n1) {
            unsigned char* img = scratch + (size_t)(n - n0) * TILE;
#pragma unroll
            for (int nb = 0; nb < 8; ++nb) { u32x2 o; o.x = cvtpk(racc[nb][0], racc[nb][1]); o.y = cvtpk(racc[nb][2], racc[nb][3]);
                *(u32x2*)(img + offb(16 * nb + r, 2 * w + (g >> 1)) + 8 * (g & 1)) = o; }
        }
        if (n == n0) break;
        float lb2 = lb2_; asm volatile("" : "+v"(lb2));
        __syncthreads();
        kv_store(lds, raw, tid);
        __syncthreads();
        kv_load(raw, proj, rope, b, h, n - 1 > n0 ? n - 1 : 0, tid);
        state_update<false>(lds, racc, lb2, w, g, qp, p);
    }
    }
    asm volatile("s_waitcnt vmcnt(0)" ::: "memory");
    __syncthreads();
    __builtin_amdgcn_fence(__ATOMIC_ACQUIRE, "agent");
    asm volatile("s_waitcnt vmcnt(0)" ::: "memory");
    for (int rep8 = 0; rep8 < (RET_PROBE == 8 ? 2 : 1); ++rep8) {
    if (RET_PROBE == 8 && rep8 == 1) { __syncthreads(); kv_load(raw, proj, rope, b, h, 0, tid0); }
#pragma unroll
    for (int nb = 0; nb < 8; ++nb) racc[nb] = (f32x4){0.f, 0.f, 0.f, 0.f};
    for (int n = 0; n < n0; ++n) {
        RET_LANE
        float lf2 = lf2_; asm volatile("" : "+v"(lf2));
        __syncthreads();
        kv_store(lds, raw, tid);
        __syncthreads();
        kv_load(raw, proj, rope, b, h, n + 1, tid);
        state_update<true>(lds, racc, lf2, w, g, qp, p);
    }
    rb_dma(lds, scratch, w, tid0 & 63);
    for (int n = n0; n < n1; ++n) {
        RET_LANE
        float lf2 = lf2_, lb2 = lb2_; asm volatile("" : "+v"(lf2), "+v"(lb2));
        const __attribute__((address_space(1))) float* gnp = (const __attribute__((address_space(1))) float*)gn_g; asm volatile("" : "+s"(gnp));
        __syncthreads();
        kv_store(lds, raw, tid);
#pragma unroll
        for (int nb = 0; nb < 8; ++nb) { u32x2 o; o.x = cvtpk(racc[nb][0], racc[nb][1]); o.y = cvtpk(racc[nb][2], racc[nb][3]);
            *(LAS u32x2*)(lds + LRF + offb(16 * nb + r, 2 * w + (g >> 1)) + 8 * (g & 1)) = o; }
        const int cq = 16 * w + r, tq = n * 128 + cq;
        bf16x8 qn[4], qf[4], qb[4];
        { const bf16_t* rp = proj + (size_t)(b * SEQ + tq) * DIN + OFF_QR + h * 128 + 4 * g;
          const float sf = __builtin_amdgcn_exp2f((float)(cq + 1) * lf2), sb = __builtin_amdgcn_exp2f((float)(128 - cq) * lb2);
#pragma unroll
          for (int ks = 0; ks < 2; ++ks) {
              float fa[8], fb[8], o1[8], o2[8], t1[8], t2[8];
              { const u32x2 a0 = *(const u32x2*)(rp + 32 * ks), a1 = *(const u32x2*)(rp + 32 * ks + 16), b0 = *(const u32x2*)(rp + 32 * ks + 64), b1 = *(const u32x2*)(rp + 32 * ks + 80);
                unpack8(__builtin_bit_cast(bf16x8, (u32x4){a0.x, a0.y, a1.x, a1.y}), fa); unpack8(__builtin_bit_cast(bf16x8, (u32x4){b0.x, b0.y, b1.x, b1.y}), fb); }
              const float* cp = rope + tq * 64 + 32 * ks + 4 * g; const float* sp = cp + SEQ * 64;
              const f32x4 c0 = *(const f32x4*)cp, c1 = *(const f32x4*)(cp + 16), s0 = *(const f32x4*)sp, s1 = *(const f32x4*)(sp + 16);
              const float cs[8] = {c0.x, c0.y, c0.z, c0.w, c1.x, c1.y, c1.z, c1.w}, sn[8] = {s0.x, s0.y, s0.z, s0.w, s1.x, s1.y, s1.z, s1.w};
#pragma unroll
              for (int e = 0; e < 8; ++e) { o1[e] = fa[e] * cs[e] - fb[e] * sn[e]; o2[e] = fb[e] * cs[e] + fa[e] * sn[e]; }
              qn[ks] = pack8(o1); qn[ks + 2] = pack8(o2);
#pragma unroll
              for (int e = 0; e < 8; ++e) { t1[e] = o1[e] * sf; t2[e] = o2[e] * sf; }
              qf[ks] = pack8(t1); qf[ks + 2] = pack8(t2);
#pragma unroll
              for (int e = 0; e < 8; ++e) { t1[e] = o1[e] * sb; t2[e] = o2[e] * sb; }
              qb[ks] = pack8(t1); qb[ks + 2] = pack8(t2);
          } }
        asm volatile("s_waitcnt vmcnt(0)" ::: "memory");
        __syncthreads();
        kv_load(raw, proj, rope, b, h, n + 1 < n1 ? n + 1 : n, tid);
        u32x2 gv[8];
        { const bf16_t* gp = proj + (size_t)(b * SEQ + tq) * DIN + OFF_GR + h * 128 + 4 * g;
#pragma unroll
          for (int mbv = 0; mbv < 8; ++mbv) gv[mbv] = *(const u32x2*)(gp + 16 * mbv); }
        bf16x8 pt[4];
#pragma unroll
        for (int rep3 = 0; rep3 < (RET_PROBE == 3 ? 2 : 1); ++rep3) {
        unsigned zo3 = 0; if (RET_PROBE == 3) asm volatile("" : "+v"(zo3));
#pragma unroll
        for (int ks2 = 0; ks2 < 4; ++ks2) {
            float pv[8];
#pragma unroll
            for (int hb = 0; hb < 2; ++hb) {
                const int mb = 2 * ks2 + hb;
                f32x4 st = (f32x4){0.f, 0.f, 0.f, 0.f};
#pragma unroll
                for (int ks = 0; ks < 4; ++ks) { const LAS unsigned char* kp = lds + LK + zo3 + RS * (16 * mb + r) + 64 * ks + 8 * g; const u32x2 k0 = *(const LAS u32x2*)kp, k1 = *(const LAS u32x2*)(kp + 32);
                    st = __builtin_amdgcn_mfma_f32_16x16x32_bf16(__builtin_bit_cast(bf16x8, (u32x4){k0.x, k0.y, k1.x, k1.y}), qn[ks], st, 0, 0, 0); }
#pragma unroll
                for (int j = 0; j < 4; ++j) { const int diff = cq - (16 * mb + 4 * g + j); pv[4 * hb + j] = st[j] * __builtin_amdgcn_exp2f(diff >= 0 ? (float)diff * lf2 : (float)(-diff) * lb2); }
            }
            pt[ks2] = pack8(pv);
        }
        }
        f32x4 yacc[8];
#pragma unroll
        for (int mbv = 0; mbv < 8; ++mbv) {
            f32x4 y = (f32x4){0.f, 0.f, 0.f, 0.f};
#pragma unroll
            for (int rep = 0; rep < (RET_PROBE == 1 ? 2 : 1); ++rep) {
            unsigned zo = 0; if (RET_PROBE == 1) asm volatile("" : "+v"(zo));
#pragma unroll
            for (int ks2 = 0; ks2 < 4; ++ks2) y = __builtin_amdgcn_mfma_f32_16x16x32_bf16(trfrag(lds + LV + zo, 32 * ks2 + 4 * g, 32 * ks2 + 16 + 4 * g, mbv, qp, p), pt[ks2], y, 0, 0, 0);
#pragma unroll
            for (int ks = 0; ks < 4; ++ks) {
                y = __builtin_amdgcn_mfma_f32_16x16x32_bf16(trfrag(lds + LRF + zo, 32 * ks + 4 * g, 32 * ks + 16 + 4 * g, mbv, qp, p), qf[ks], y, 0, 0, 0);
                y = __builtin_amdgcn_mfma_f32_16x16x32_bf16(trfrag(lds + LRB + zo, 32 * ks + 4 * g, 32 * ks + 16 + 4 * g, mbv, qp, p), qb[ks], y, 0, 0, 0);
            }
            }
            yacc[mbv] = (RET_PROBE == 1) ? y * 0.5f : y;
        }
        __syncthreads();
        if (n + 1 < n1) rb_dma(lds, scratch + (size_t)(n + 1 - n0) * TILE, w, lane);
        { float s = 0.f;
#pragma unroll
          for (int mbv = 0; mbv < 8; ++mbv) s += (yacc[mbv][0] + yacc[mbv][1]) + (yacc[mbv][2] + yacc[mbv][3]);
          s += __shfl_xor(s, 16); s += __shfl_xor(s, 32);
          const float mu = s * (1.f / 128.f); float s2 = 0.f;
#pragma unroll
          for (int mbv = 0; mbv < 8; ++mbv) { yacc[mbv] = yacc[mbv] - mu; s2 += (yacc[mbv][0] * yacc[mbv][0] + yacc[mbv][1] * yacc[mbv][1]) + (yacc[mbv][2] * yacc[mbv][2] + yacc[mbv][3] * yacc[mbv][3]); }
          s2 += __shfl_xor(s2, 16); s2 += __shfl_xor(s2, 32);
          const float rstd = 1.f / sqrtf(s2 * (1.f / 128.f) + GN_EPS);
          bf16_t* op = ymix + (size_t)(b * SEQ + tq) * D + 512 + h * 128 + 4 * g;
#pragma unroll
          for (int rep4 = 0; rep4 < (RET_PROBE == 4 ? 2 : 1); ++rep4) {
          if (RET_PROBE == 4) { asm volatile("" : "+v"(op)); asm volatile("" : "+v"(gv[0]), "+v"(gv[1]), "+v"(gv[2]), "+v"(gv[3]), "+v"(gv[4]), "+v"(gv[5]), "+v"(gv[6]), "+v"(gv[7])); }
#pragma unroll
          for (int mbv = 0; mbv < 8; ++mbv) {
              const f32x4 gn = *(const __attribute__((address_space(1))) f32x4*)(gnp + h * 128 + 16 * mbv + 4 * g);
              const float g0 = __uint_as_float(gv[mbv].x << 16), g1 = __uint_as_float(gv[mbv].x & 0xffff0000u), g2 = __uint_as_float(gv[mbv].y << 16), g3 = __uint_as_float(gv[mbv].y & 0xffff0000u);
              u32x2 o; o.x = cvtpk(silu_f(g0) * (yacc[mbv][0] * rstd * gn.x), silu_f(g1) * (yacc[mbv][1] * rstd * gn.y));
              o.y = cvtpk(silu_f(g2) * (yacc[mbv][2] * rstd * gn.z), silu_f(g3) * (yacc[mbv][3] * rstd * gn.w));
              *(u32x2*)(op + 16 * mbv) = o;
          } } }
        state_update<true>(lds, racc, lf2, w, g, qp, p);
    }
    }
    __syncthreads();
#undef RET_LANE
}
}


namespace na {
constexpr unsigned LKR = 0, LVR = 73728, LRPB = 147456;
__device__ __forceinline__ void load_row(LAS unsigned char* lds, const bf16_t* __restrict__ proj, int b, int head, int krow, int tid) {
    const int key = tid >> 3, ch = tid & 7, slot = krow % 9;
    const bf16_t* rp = proj + (size_t)(b * SEQ + krow * 64 + key) * DIN + head * 64 + ch * 8;
    const unsigned o = (unsigned)slot * 8192u + 128u * key + 16u * (ch ^ (key & 7));
    *(LAS u32x4*)(lds + LKR + o) = *(const u32x4*)(rp + OFF_KNA);
    *(LAS u32x4*)(lds + LVR + o) = *(const u32x4*)(rp + OFF_VNA);
}
__device__ __forceinline__ void unit(const bf16_t* __restrict__ proj, const float* __restrict__ rpb, bf16_t* __restrict__ ymix, LAS unsigned char* lds, int u, const int tid_in) {
    const int b = u >> 3, head = u & 7;
    int tid_ = tid_in; asm volatile("" : "+v"(tid_));
    const int tid0 = tid_, w = __builtin_amdgcn_readfirstlane(tid0 >> 6);
    __syncthreads();
    if (tid0 < 465) ((LAS float*)(lds + LRPB))[tid0] = rpb[head * 465 + tid0];
    const int ct = w & 3, cb = (ct == 0) ? 0 : (ct == 1 ? 8 : (ct == 2 ? 24 : 32));
    u32x4 pk[2], pv2[2]; int pre_lo = 0, pre_n = 0;
    for (int st = 0; st < 16; ++st) {
        int tid = tid0; asm volatile("" : "+v"(tid));
        const int lane = tid & 63, qi = lane & 15, g = lane >> 4; const unsigned qp = (unsigned)qi >> 2, p = (unsigned)lane & 3u;
        const int r = 2 * st + (w >> 2);
        const int rs = min(max(r - 4, 0), 24);
        const int need_hi = min(max(2 * st + 1 - 4, 0), 24) + 7;
        __syncthreads();
        if (st == 0) { for (int kr = 0; kr <= need_hi; ++kr) load_row(lds, proj, b, head, kr, tid); }
        else {
#pragma unroll
            for (int i = 0; i < 2; ++i) if (i < pre_n) { const int key = tid >> 3, ch = tid & 7; const unsigned o = (unsigned)((pre_lo + i) % 9) * 8192u + 128u * key + 16u * (ch ^ (key & 7));
                *(LAS u32x4*)(lds + LKR + o) = pk[i]; *(LAS u32x4*)(lds + LVR + o) = pv2[i]; }
        }
        const int cq = 16 * ct + qi, tq = b * SEQ + r * 64 + cq;
        bf16x8 qn[2];
        { const bf16_t* qptr = proj + (size_t)tq * DIN + OFF_QNA + head * 64 + 8 * g; qn[0] = *(const bf16x8*)qptr; qn[1] = *(const bf16x8*)(qptr + 32); }
        __syncthreads();
        { const int nh = (st < 15) ? min(max(2 * st + 3 - 4, 0), 24) + 7 : need_hi; pre_lo = need_hi + 1; pre_n = nh - need_hi;
#pragma unroll
          for (int i = 0; i < 2; ++i) if (i < pre_n) { const int key = tid >> 3, ch = tid & 7; const bf16_t* rp = proj + (size_t)(b * SEQ + (pre_lo + i) * 64 + key) * DIN + head * 64 + ch * 8;
              pk[i] = *(const u32x4*)(rp + OFF_KNA); pv2[i] = *(const u32x4*)(rp + OFF_VNA); } }
        const int cs = min(max(cq - 8, 0), 48);
        const unsigned kb0 = 128u * qi + 16u * ((unsigned)g ^ ((unsigned)qi & 7u)), kb1 = 128u * qi + 16u * ((4u + (unsigned)g) ^ ((unsigned)qi & 7u));
        const LAS float* bias = (const LAS float*)(lds + LRPB);
        f32x4 sc[16]; float mx = -3.0e38f;
#pragma unroll
        for (int kr = 0; kr < 8; ++kr) {
            const int krow = rs + kr; const unsigned so = (unsigned)(krow % 9) * 8192u + 128u * (unsigned)cb;
            const int dr = krow - r + 7;
#pragma unroll
            for (int h2 = 0; h2 < 2; ++h2) {
                f32x4 a = (f32x4){0.f, 0.f, 0.f, 0.f};
                a = __builtin_amdgcn_mfma_f32_16x16x32_bf16(*(const LAS bf16x8*)(lds + LKR + so + 2048u * h2 + kb0), qn[0], a, 0, 0, 0);
                a = __builtin_amdgcn_mfma_f32_16x16x32_bf16(*(const LAS bf16x8*)(lds + LKR + so + 2048u * h2 + kb1), qn[1], a, 0, 0, 0);
#pragma unroll
                for (int j = 0; j < 4; ++j) {
                    const int kcol = cb + 16 * h2 + 4 * g + j;
                    const int dc = min(max(kcol - cq + 15, 0), 30);
                    const float v = a[j] + bias[dr * 31 + dc];
                    const bool in = (kcol >= cs) && (kcol < cs + 16);
                    a[j] = in ? v : -3.0e38f; mx = fmaxf(mx, a[j]);
                }
                sc[2 * kr + h2] = a;
            }
        }
        mx = fmaxf(mx, __shfl_xor(mx, 16)); mx = fmaxf(mx, __shfl_xor(mx, 32));
        float sum = 0.f; bf16x8 pt[8];
#pragma unroll
        for (int kk = 0; kk < 8; ++kk) {
            float pv[8];
#pragma unroll
            for (int h2 = 0; h2 < 2; ++h2)
#pragma unroll
                for (int j = 0; j < 4; ++j) { const float e = __builtin_amdgcn_exp2f((sc[2 * kk + h2][j] - mx) * 1.4426950408889634f); pv[4 * h2 + j] = e; sum += e; }
            pt[kk] = ret::pack8(pv);
        }
        sum += __shfl_xor(sum, 16); sum += __shfl_xor(sum, 32);
        const float inv = 1.f / sum;
        const unsigned sl = (((unsigned)g & 1u) << 2) | qp;
        bf16_t* op = ymix + (size_t)tq * D + head * 64 + 4 * g;
#pragma unroll
        for (int db = 0; db < 4; ++db) {
            const unsigned vb = 128u * (4u * (unsigned)g + qp) + 16u * ((2u * db + (p >> 1)) ^ sl) + 8u * (p & 1u);
            f32x4 y = (f32x4){0.f, 0.f, 0.f, 0.f};
#pragma unroll
            for (int kk = 0; kk < 8; ++kk) {
                const unsigned so = (unsigned)((rs + kk) % 9) * 8192u + 128u * (unsigned)cb;
                const ret::s16x4 lo = __builtin_amdgcn_ds_read_tr16_b64_v4i16((LAS ret::s16x4*)(lds + LVR + so + vb));
                const ret::s16x4 hi = __builtin_amdgcn_ds_read_tr16_b64_v4i16((LAS ret::s16x4*)(lds + LVR + so + 2048u + vb));
                y = __builtin_amdgcn_mfma_f32_16x16x32_bf16(__builtin_shufflevector(lo, hi, 0, 1, 2, 3, 4, 5, 6, 7), pt[kk], y, 0, 0, 0);
            }
            u32x2 o; o.x = ret::cvtpk(y[0] * inv, y[1] * inv); o.y = ret::cvtpk(y[2] * inv, y[3] * inv);
            *(u32x2*)(op + 16 * db) = o;
        }
    }
    __syncthreads();
}
}

__device__ __forceinline__ void unpack_t16r(const u32x4 a, const u32x4 b, f32x4 (&v)[4]) {
    v[0] = (f32x4){__uint_as_float(a.x << 16), __uint_as_float(a.x & 0xffff0000u), __uint_as_float(a.y << 16), __uint_as_float(a.y & 0xffff0000u)};
    v[1] = (f32x4){__uint_as_float(a.z << 16), __uint_as_float(a.z & 0xffff0000u), __uint_as_float(a.w << 16), __uint_as_float(a.w & 0xffff0000u)};
    v[2] = (f32x4){__uint_as_float(b.x << 16), __uint_as_float(b.x & 0xffff0000u), __uint_as_float(b.y << 16), __uint_as_float(b.y & 0xffff0000u)};
    v[3] = (f32x4){__uint_as_float(b.z << 16), __uint_as_float(b.z & 0xffff0000u), __uint_as_float(b.w << 16), __uint_as_float(b.w & 0xffff0000u)};
}
__device__ __forceinline__ void ln1_row(const u32x4 ra, const u32x4 rb, const LAS float* cv  , bf16_t* __restrict__ hf, unsigned char* __restrict__ hf8, float* __restrict__ stats, int row, int lane) {
    asm volatile("" : "+v"(cv));
    const int c0 = lane * 16;
    f32x4 v[4]; float s = 0.f;
    unpack_t16r(ra, rb, v);
#pragma unroll
    for (int j = 0; j < 4; ++j) s += (v[j].x + v[j].y) + (v[j].z + v[j].w);
    const float mean = wave_sum(s) * (1.f / D); float s2 = 0.f;
#pragma unroll
    for (int j = 0; j < 4; ++j) { v[j] = v[j] - mean; s2 += (v[j].x * v[j].x + v[j].y * v[j].y) + (v[j].z * v[j].z + v[j].w * v[j].w); }
    const float rstd = 1.f / sqrtf(wave_sum(s2) * (1.f / D) + LN_EPS);
    if (lane == 0) *(f32x2*)(stats + 2 * (size_t)row) = (f32x2){mean, rstd};
    u32x4 ob[2], o8;
#pragma unroll
    for (int j = 0; j < 4; ++j) { const int col = c0 + 4 * j;
        const f32x4 gg = *(const LAS f32x4*)(cv + col), bv = *(const LAS f32x4*)(cv + 1024 + col), sc1 = *(const LAS f32x4*)(cv + 2048 + col), sh = *(const LAS f32x4*)(cv + 3072 + col);
        const f32x4 h4 = (v[j] * rstd * gg + bv) * sc1 + sh;
        const unsigned p0 = pk2(h4.x, h4.y), p1 = pk2(h4.z, h4.w);
        if (j == 0) { ob[0].x = p0; ob[0].y = p1; } else if (j == 1) { ob[0].z = p0; ob[0].w = p1; } else if (j == 2) { ob[1].x = p0; ob[1].y = p1; } else { ob[1].z = p0; ob[1].w = p1; }
        const f32x4 h8 = h4 * S_HF8;
        int w0 = __builtin_amdgcn_cvt_pk_fp8_f32(clamp8(h8.x), clamp8(h8.y), 0, false); w0 = __builtin_amdgcn_cvt_pk_fp8_f32(clamp8(h8.z), clamp8(h8.w), w0, true);
        if (j == 0) o8.x = (unsigned)w0; else if (j == 1) o8.y = (unsigned)w0; else if (j == 2) o8.z = (unsigned)w0; else o8.w = (unsigned)w0; }
    *(u32x4*)(hf + (size_t)row * D + c0) = ob[0]; *(u32x4*)(hf + (size_t)row * D + c0 + 8) = ob[1];
    *(u32x4*)(hf8 + (size_t)row * D + c0) = o8;
}
__device__ __forceinline__ void top2_merge(float& a1, float& a2, float b1, float b2) { const float n1 = fmaxf(a1, b1); const float n2 = fmaxf(fminf(a1, b1), fmaxf(a2, b2)); a1 = n1; a2 = n2; }
template <int CTRL> __device__ __forceinline__ float dppf(float v) { return __builtin_bit_cast(float, __builtin_amdgcn_update_dpp(0, __builtin_bit_cast(int, v), CTRL, 0xf, 0xf, true)); }
__device__ __forceinline__ float rdlane(float v, int l) { return __builtin_bit_cast(float, __builtin_amdgcn_readlane(__builtin_bit_cast(int, v), l)); }
template <int T> __device__ __forceinline__ void route_tokens(const float* __restrict__ logits, const f32x4 bias, int* __restrict__ topk_e, float* __restrict__ topk_w, LAS unsigned* hist, int tok0, int tstride, int lane) {
    const float NEG = -3.0e38f;
    float sc[T][4], s[T][4];
#pragma unroll
    for (int t = 0; t < T; ++t) {
        const f32x4 lg = *(const f32x4*)(logits + (size_t)(tok0 + t * tstride) * NE + lane * 4);
        sc[t][0] = 1.f / (1.f + __expf(-lg.x)); sc[t][1] = 1.f / (1.f + __expf(-lg.y)); sc[t][2] = 1.f / (1.f + __expf(-lg.z)); sc[t][3] = 1.f / (1.f + __expf(-lg.w));
        s[t][0] = sc[t][0] + bias.x; s[t][1] = sc[t][1] + bias.y; s[t][2] = sc[t][2] + bias.z; s[t][3] = sc[t][3] + bias.w;
    }
    const int grp = lane >> 3;
#pragma unroll
    for (int t = 0; t < T; ++t) {
        float m1 = fmaxf(s[t][0], s[t][1]), m2 = fminf(s[t][0], s[t][1]); top2_merge(m1, m2, fmaxf(s[t][2], s[t][3]), fminf(s[t][2], s[t][3]));
        { const float b1 = dppf<0xB1>(m1), b2 = dppf<0xB1>(m2); top2_merge(m1, m2, b1, b2); }
        { const float b1 = dppf<0x4E>(m1), b2 = dppf<0x4E>(m2); top2_merge(m1, m2, b1, b2); }
        { const float b1 = dppf<0x141>(m1), b2 = dppf<0x141>(m2); top2_merge(m1, m2, b1, b2); }
        const float gs = m1 + m2; int rank = 0;
#pragma unroll
        for (int gq = 0; gq < 8; ++gq) { const float og = rdlane(gs, gq * 8); rank += (og > gs || (og == gs && gq < grp)) ? 1 : 0; }
        if (rank >= 4) { s[t][0] = NEG; s[t][1] = NEG; s[t][2] = NEG; s[t][3] = NEG; }
    }
    float wsum[T], myw[T]; int mye[T];
#pragma unroll
    for (int t = 0; t < T; ++t) { wsum[t] = 0.f; myw[t] = 0.f; mye[t] = 0; }
#pragma unroll
    for (int k = 0; k < TOPK; ++k) {
#pragma unroll
        for (int t = 0; t < T; ++t) {
            float bv = s[t][0]; int bi = 0;
            if (s[t][1] > bv) { bv = s[t][1]; bi = 1; }
            if (s[t][2] > bv) { bv = s[t][2]; bi = 2; }
            if (s[t][3] > bv) { bv = s[t][3]; bi = 3; }
            const float bsc = bi == 0 ? sc[t][0] : (bi == 1 ? sc[t][1] : (bi == 2 ? sc[t][2] : sc[t][3]));
            float m = fmaxf(bv, dppf<0xB1>(bv)); m = fmaxf(m, dppf<0x4E>(m)); m = fmaxf(m, dppf<0x141>(m)); m = fmaxf(m, dppf<0x140>(m));
            const float wm = fmaxf(fmaxf(rdlane(m, 0), rdlane(m, 16)), fmaxf(rdlane(m, 32), rdlane(m, 48)));
            const unsigned long long bal = __ballot(bv == wm);
            const int wl = __ffsll((long long)bal) - 1;
            const int be = wl * 4 + __builtin_amdgcn_readlane(bi, wl);
            const float wsel = rdlane(bsc, wl);
            if (lane == wl) { if (bi == 0) s[t][0] = NEG; else if (bi == 1) s[t][1] = NEG; else if (bi == 2) s[t][2] = NEG; else s[t][3] = NEG; }
            wsum[t] += wsel;
            if (lane == k) { myw[t] = wsel; mye[t] = be; }
        }
    }
#pragma unroll
    for (int t = 0; t < T; ++t) if (lane < TOPK) { const int tok = tok0 + t * tstride; topk_e[tok * TOPK + lane] = mye[t]; topk_w[tok * TOPK + lane] = myw[t] / wsum[t] * 2.5f; __hip_atomic_fetch_add(&hist[mye[t]], 1u, __ATOMIC_RELAXED, __HIP_MEMORY_SCOPE_WORKGROUP); }
}
__device__ __forceinline__ void build_tables(const unsigned* ctl, LAS unsigned* tab, const int tid) {
    if (tid < 64) {
        const int lane = tid;
        unsigned c[4], so = 0, st = 0;
#pragma unroll
        for (int j = 0; j < 4; ++j) { c[j] = __hip_atomic_load(ctl + CW_COUNT + lane * 4 + j, __ATOMIC_RELAXED, __HIP_MEMORY_SCOPE_AGENT); so += c[j]; st += (c[j] + 255u) >> 8; }
        unsigned io = so, it = st;
#pragma unroll
        for (int o = 1; o < 64; o <<= 1) { const unsigned a = __shfl_up(io, o), b = __shfl_up(it, o); if (lane >= o) { io += a; it += b; } }
        unsigned eo = io - so, et = it - st;
#pragma unroll
        for (int j = 0; j < 4; ++j) { tab[T_CNT + lane * 4 + j] = c[j]; tab[T_OFF + lane * 4 + j] = eo; tab[T_TILE + lane * 4 + j] = et; eo += c[j]; et += (c[j] + 255u) >> 8; }
        if (lane == 63) { tab[T_OFF + NE] = eo; tab[T_TILE + NE] = et; }
    }
    __syncthreads();
}
struct RowRaw { u32x4 y[9]; u32x4 t[2]; f32x2 st; };
__device__ __forceinline__ void final_load(RowRaw& R, const bf16_t* __restrict__ tb, const unsigned char* __restrict__ ybuf, const unsigned char* __restrict__ ysh, const float* __restrict__ stats, int row, int lane) {
    const int c0 = lane * 16;
#pragma unroll
    for (int k = 0; k < TOPK; ++k) R.y[k] = *(const u32x4*)(ybuf + ((size_t)row * TOPK + k) * D + c0);
    R.y[8] = *(const u32x4*)(ysh + (size_t)row * D + c0);
    R.t[0] = *(const u32x4*)(tb + (size_t)row * D + c0); R.t[1] = *(const u32x4*)(tb + (size_t)row * D + c0 + 8);
    R.st = *(const f32x2*)(stats + 2 * (size_t)row);
}
__device__ __forceinline__ void final_row(float* __restrict__ out, const RowRaw& R, const LAS float* cv  , int row, int lane) {
    asm volatile("" : "+v"(cv));
    const int c0 = lane * 16;
    f32x4 a[4], t[4], v[4]; float s = 0.f;
#pragma unroll
    for (int j = 0; j < 4; ++j) a[j] = (f32x4){0.f, 0.f, 0.f, 0.f};
#pragma unroll
    for (int k = 0; k < 9; ++k) { const unsigned w[4] = {R.y[k].x, R.y[k].y, R.y[k].z, R.y[k].w};
#pragma unroll
        for (int j = 0; j < 4; ++j) { const f32x2 lo = __builtin_amdgcn_cvt_pk_f32_fp8((int)w[j], false), hi = __builtin_amdgcn_cvt_pk_f32_fp8((int)w[j], true); a[j].x += lo.x; a[j].y += lo.y; a[j].z += hi.x; a[j].w += hi.y; } }
    unpack_t16r(R.t[0], R.t[1], t);
#pragma unroll
    for (int j = 0; j < 4; ++j) { const int col = c0 + 4 * j;
        const f32x4 x1 = (t[j] - R.st.x) * R.st.y * *(const LAS f32x4*)(cv + col) + *(const LAS f32x4*)(cv + 1024 + col);
        v[j] = x1 * ALPHA + *(const LAS f32x4*)(cv + 4096 + col) * a[j] * YINV;
        s += (v[j].x + v[j].y) + (v[j].z + v[j].w); }
    const float mean = wave_sum(s) * (1.f / D); float s2 = 0.f;
#pragma unroll
    for (int j = 0; j < 4; ++j) { v[j] = v[j] - mean; s2 += (v[j].x * v[j].x + v[j].y * v[j].y) + (v[j].z * v[j].z + v[j].w * v[j].w); }
    const float rstd = 1.f / sqrtf(wave_sum(s2) * (1.f / D) + LN_EPS);
#pragma unroll
    for (int j = 0; j < 4; ++j) { const int col = c0 + 4 * j;
        *(f32x4*)(out + (size_t)row * D + col) = v[j] * rstd * *(const LAS f32x4*)(cv + 2048 + col) + *(const LAS f32x4*)(cv + 3072 + col); }
}

#ifndef MK_PER_PHASE
#define MK_PER_PHASE 0
#endif
constexpr int N_PHASES = 13;
struct Args { Ctx X; int ph_lo, ph_hi; };
typedef __attribute__((address_space(4))) const Ctx* CtxCP;
__device__ __forceinline__ CtxCP ctx_ptr() { CtxCP p = (CtxCP)__builtin_amdgcn_kernarg_segment_ptr(); asm volatile("" : "+s"(p)); return p; }

__global__ void __launch_bounds__(NW * 64, 2) mk_fwd(Args args) {
    extern __shared__ __attribute__((aligned(16))) unsigned char lds_raw[];
    LAS unsigned char* lds = (LAS unsigned char*)lds_raw;
    LAS unsigned* tab = (LAS unsigned*)(lds + TAB_OFF);
    volatile LAS unsigned* MISC = (volatile LAS unsigned*)(lds + MISC_OFF);
#define PH_BEGIN \
    const __attribute__((address_space(4))) Ctx& X = *ctx_ptr(); unsigned char* ws = X.ws; (void)ws; \
    const int lane = lane_id(), wave = wave0, tid = wave0 * 64 + lane; (void)lane; (void)wave; (void)tid; \
    const int G = gridDim.x, bx = blockIdx.x; (void)G; (void)bx; \
    const int gw = bx * NW + wave, NGW = G * NW; (void)gw; (void)NGW; \
    const int gt = bx * (NW * 64) + tid, NGT = G * NW * 64; (void)gt; (void)NGT; \
    unsigned* ctl = (unsigned*)(ws + WS_CTL); float* mod = (float*)(ws + WS_MOD); float* rope = (float*)(ws + WS_ROPE); (void)ctl; (void)mod; (void)rope; \
    bf16_t* win_t = (bf16_t*)(ws + WS_WIN_T); bf16_t* wout_t = (bf16_t*)(ws + WS_WOUT_T); bf16_t* wr_t = (bf16_t*)(ws + WS_WR_T); (void)win_t; (void)wout_t; (void)wr_t; \
    bf16_t* wsgu_t = (bf16_t*)(ws + WS_WSGU_T); bf16_t* wsd_t = (bf16_t*)(ws + WS_WSD_T); bf16_t* wd_t = (bf16_t*)(ws + WS_WD_T); bf16_t* wgu_t = (bf16_t*)(ws + WS_WGU_T); (void)wsgu_t; (void)wsd_t; (void)wd_t; (void)wgu_t; \
    int* slot_ent = (int*)(ws + WS_SLOT_ENT); float* slot_w = (float*)(ws + WS_SLOT_W); int* topk_e = (int*)(ws + WS_TOPK_E); float* topk_w = (float*)(ws + WS_TOPK_W); (void)slot_ent; (void)slot_w; (void)topk_e; (void)topk_w; \
    bf16_t* ymix = (bf16_t*)(ws + WS_YMIX); bf16_t* proj = (bf16_t*)(ws + WS_PROJ); bf16_t* hbuf = (bf16_t*)(ws + WS_YMIX); (void)ymix; (void)proj; (void)hbuf; \
    float* logits = (float*)(ws + WS_LOGITS); bf16_t* shh = (bf16_t*)(ws + WS_SHH); bf16_t* hf = (bf16_t*)(ws + WS_HF); bf16_t* act = (bf16_t*)(ws + WS_ACT); (void)logits; (void)shh; (void)hf; (void)act; \
    unsigned char* ybuf = ws + WS_YBUF; float* out = X.out; (void)ybuf; (void)out;

    const int wave0 = __builtin_amdgcn_readfirstlane((int)threadIdx.x >> 6);
    for (int u = threadIdx.x; u < (LDS_BYTES - MISC_OFF) / 4; u += NW * 64) ((LAS unsigned*)(lds + MISC_OFF))[u] = 0u;
    __syncthreads();
    if (!MK_PER_PHASE) { unsigned* ctl0 = (unsigned*)(args.X.ws + WS_CTL); (void)xcd_barrier_post(ctl0 + CW_BAR, MISC + 8, wave0 == 0 && lane_id() == 0); }
    const int lo = args.ph_lo, hi = args.ph_hi;
#ifndef MK_DUP
#define MK_DUP -1
#endif
#define REPS(k) for (int _rep = 0; _rep < ((MK_DUP == (k)) ? 2 : 1); ++_rep)
#ifdef MK_ONLY
#define IN(k) ((k) == MK_ONLY)
#else
#define IN(k) (lo <= (k) && (k) < hi)
#endif
#define SEAM(k) SEAM2(k, (k) + 1)
#define SEAM2(k, k2) do { if (IN(k) && IN(k2)) { XcdBarrier _b; _b.bar = (unsigned*)(ctx_ptr()->ws + WS_CTL) + CW_BAR; _b.x = xb_xcc_id(); _b.st = (volatile LAS unsigned*)(lds + MISC_OFF) + 8; xcd_barrier(_b, wave0 == 0 && lane_id() == 0); } } while (0)

    REPS(0) if (IN(0)) { PH_BEGIN
        LAS float* scr = (LAS float*)(lds + wave * 16384);
        float* modp = (float*)(ws + WS_PROJ);
        for (int t = gw; t < 96 * 16; t += NGW) mod_task(X.c, X.w_ada, modp, t, lane);
        constexpr int I_IN = (D / 64) * (DIN / 32), I_OUT = (D / 64) * (D / 32), I_R = (D / 64) * (NE / 32), I_SG = (D / 64) * (DE / 32), I_SD = (DE / 64) * (D / 32);
        constexpr int I_EG = I_SG, I_ED = I_SD;
        constexpr int N_SMALL = I_IN + I_OUT + I_R + 2 * I_SG + I_SD;
        constexpr int N_ITEMS = N_SMALL + NE * (2 * I_EG + I_ED);
        for (int it = gw; it < N_ITEMS; it += NGW) {
            int r = it;
            if (r < I_IN) { transpose_item(X.w_in, D, DIN, win_t, 0, 0, scr, r, lane); continue; } r -= I_IN;
            if (r < I_OUT) { transpose_item(X.w_out, D, D, wout_t, 0, 0, scr, r, lane); continue; } r -= I_OUT;
            if (r < I_R) { transpose_item(X.w_router, D, NE, wr_t, 0, 0, scr, r, lane); continue; } r -= I_R;
            if (r < I_SG) { transpose_item(X.ws_gate, D, DE, wsgu_t, 8, 0, scr, r, lane); continue; } r -= I_SG;
            if (r < I_SG) { transpose_item(X.ws_up, D, DE, wsgu_t, 8, 1, scr, r, lane); continue; } r -= I_SG;
            if (r < I_SD) { transpose_item(X.ws_down, DE, D, wsd_t, 0, 0, scr, r, lane); continue; } r -= I_SD;
            const int e = r / (2 * I_EG + I_ED); r -= e * (2 * I_EG + I_ED);
            if (r < I_EG) { transpose_item_fp8(X.w_gate + (size_t)e * D * DE, D, DE, (unsigned char*)wgu_t + (size_t)e * 512 * D, 8, 0, S_WGU8, scr, r, lane); continue; } r -= I_EG;
            if (r < I_EG) { transpose_item_fp8(X.w_up + (size_t)e * D * DE, D, DE, (unsigned char*)wgu_t + (size_t)e * 512 * D, 8, 1, S_WGU8, scr, r, lane); continue; } r -= I_EG;
            transpose_item_fp8(X.w_down + (size_t)e * DE * D, DE, D, (unsigned char*)wd_t + (size_t)e * D * DE, 0, 0, S_WD8, scr, r, lane);
        }
        for (int i = gt; i < SEQ * 64; i += NGT) rope_entry(rope, i);
    }
    SEAM(0);
    REPS(1) if (IN(1)) { PH_BEGIN
        const float* modp = (const float*)(ws + WS_PROJ);
        for (int i = gt; i < 32 * 6144; i += NGT) mod[i] = mod_sum(modp, X.b_ada, i / 6144, i % 6144);
        LAS float* ssc = (LAS float*)lds; LAS float* ssh = ssc + 1024;
        int curb = -1;
        for (int c = bx; c < M / 256; c += G) {
            const int b = c >> 3;
            if (b != curb) {
                __syncthreads();
                for (int i = tid; i < 1024; i += NW * 64) { ssc[i] = 1.f + mod_sum(modp, X.b_ada, b, MOD_SCALE_A + i); ssh[i] = mod_sum(modp, X.b_ada, b, MOD_SHIFT_A + i); }
                __syncthreads();
                curb = b;
            }
            const f32x4 sc = *(const LAS f32x4*)(ssc + (tid & 255) * 4), sh = *(const LAS f32x4*)(ssh + (tid & 255) * 4);
            const float* xp = X.x + (size_t)c * 256 * D + (size_t)(tid >> 8) * D + (tid & 255) * 4;
            bf16_t* hp = hbuf + (size_t)c * 256 * D + (size_t)(tid >> 8) * D + (tid & 255) * 4;
            for (int i0 = 0; i0 < 128; i0 += 8) {
                f32x4 v[8];
#pragma unroll
                for (int i = 0; i < 8; ++i) v[i] = __builtin_nontemporal_load((const f32x4*)(xp + (size_t)(i0 + i) * 2 * D));
#pragma unroll
                for (int i = 0; i < 8; ++i) { u32x2 o; o.x = pk2(v[i].x * sc.x + sh.x, v[i].y * sc.y + sh.y); o.y = pk2(v[i].z * sc.z + sh.z, v[i].w * sc.w + sh.w); *(u32x2*)(hp + (size_t)(i0 + i) * 2 * D) = o; }
            }
        }
        __syncthreads();
    }
    SEAM(1);
    REPS(2) if (IN(2)) { PH_BEGIN
        pg8::DenseOrder S; S.init(M, DIN, D, win_t, G, bx);
        pg8::EpiInProj E{proj};
        pg8::gemm_phase(lds, (const char*)hbuf, D, S, E, tid);
    }
    SEAM(2);
    REPS(3) if (IN(3)) { PH_BEGIN
        REPS(31) for (int hu = bx; hu < BATCH * 4 * 2; hu += G) ret::unit(proj, rope, X.ret_ld, X.ret_gn, ymix, (unsigned char*)out + (size_t)hu * (8 * ret::TILE), lds, hu, tid);
        REPS(32) for (int u = bx; u < BATCH * 8; u += G) na::unit(proj, X.na_rpb, ymix, lds, u, tid);
    }
    SEAM2(3, 5);
    REPS(5) if (IN(5)) { PH_BEGIN
        pg8::DenseOrder S; S.init(M, D, D, wout_t, G, bx);
        pg8::EpiOutProj E{X.x, mod, (bf16_t*)(ws + WS_TB)};
        pg8::gemm_phase(lds, (const char*)ymix, D, S, E, tid);
    }
    SEAM(5);
    REPS(6) if (IN(6)) { PH_BEGIN
        LAS float* cv = (LAS float*)lds; int curb = -1;
        for (int c = bx; c < M / 256; c += G) {
            const int b = c >> 3;
            if (b != curb) {
                __syncthreads();
                if (tid < 256) { const int i = tid * 4; *(LAS f32x4*)(cv + i) = *(const f32x4*)(X.ln1_g + i); *(LAS f32x4*)(cv + 1024 + i) = *(const f32x4*)(X.ln1_b + i);
                    *(LAS f32x4*)(cv + 2048 + i) = *(const f32x4*)(mod + b * 6144 + MOD_SCALE_F + i) + 1.f; *(LAS f32x4*)(cv + 3072 + i) = *(const f32x4*)(mod + b * 6144 + MOD_SHIFT_F + i); }
                __syncthreads(); curb = b;
            }
            const bf16_t* tp = (const bf16_t*)(ws + WS_TB) + (size_t)(c * 256 + wave * 32) * D + lane * 16;
            u32x4 ra = *(const u32x4*)tp, rb = *(const u32x4*)(tp + 8);
#pragma unroll 1
            for (int i = 0; i < 32; ++i) {
                const u32x4 ca = ra, cb = rb; const int nx = i < 31 ? i + 1 : i;
                ra = *(const u32x4*)(tp + (size_t)nx * D); rb = *(const u32x4*)(tp + (size_t)nx * D + 8);
                ln1_row(ca, cb, cv, hf, ws + WS_HF8, (float*)(ws + WS_STATS), c * 256 + wave * 32 + i, lane);
            }
        }
        __syncthreads();
    }
    SEAM(6);
    REPS(7) if (IN(7)) { PH_BEGIN
        { pg8::DenseOrder S; S.init(M, NE, D, wr_t, G, bx); pg8::EpiRouter E{logits}; pg8::gemm_phase(lds, (const char*)hf, D, S, E, tid); }
        { pg8::DenseOrder S; S.init(M, 2 * DE, D, wsgu_t, G, bx); pg8::EpiGU<false> E{(void*)shh}; pg8::gemm_phase(lds, (const char*)hf, D, S, E, tid); }
    }
    SEAM(7);
    if (IN(8)) { PH_BEGIN
        LAS unsigned* hist = tab + T_HIST;
        if (tid < NE) hist[tid] = 0u;
        __syncthreads();
        const f32x4 bias = *(const f32x4*)(X.rbias + lane * 4);
        { int tok = gw;
          for (; tok + 3 * NGW < M; tok += 4 * NGW) route_tokens<4>(logits, bias, topk_e, topk_w, hist, tok, NGW, lane);
          for (; tok < M; tok += NGW) route_tokens<1>(logits, bias, topk_e, topk_w, hist, tok, NGW, lane); }
        __syncthreads();
        if (tid < NE && hist[tid]) atomicAdd(&ctl[CW_COUNT + tid], hist[tid]);
#if MK_DUP == 8
        __syncthreads();
        { int tok = gw;
          for (; tok + 3 * NGW < M; tok += 4 * NGW) route_tokens<4>(logits, bias, topk_e, topk_w, tab + T_BASE, tok, NGW, lane);
          for (; tok < M; tok += NGW) route_tokens<1>(logits, bias, topk_e, topk_w, tab + T_BASE, tok, NGW, lane); }
        __syncthreads();
#endif
    }
    SEAM(8);
    if (IN(9)) { PH_BEGIN
        build_tables(ctl, tab, tid);
        LAS unsigned* hist = tab + T_HIST; LAS unsigned* base = tab + T_BASE;
        for (int c0 = bx * 2048; c0 < NSLOT; c0 += G * 2048) {
            __syncthreads();
            if (tid < NE) hist[tid] = 0u;
            __syncthreads();
            int e[4]; unsigned loc[4];
#pragma unroll
            for (int i = 0; i < 4; ++i) { const int idx = c0 + i * 512 + tid; e[i] = topk_e[idx]; loc[i] = __hip_atomic_fetch_add(&hist[e[i]], 1u, __ATOMIC_RELAXED, __HIP_MEMORY_SCOPE_WORKGROUP); }
            __syncthreads();
            if (tid < NE && hist[tid]) base[tid] = atomicAdd(&ctl[CW_CURSOR + tid], hist[tid]);
            __syncthreads();
#pragma unroll
            for (int i = 0; i < 4; ++i) { const int idx = c0 + i * 512 + tid; const unsigned pos = tab[T_OFF + e[i]] + base[e[i]] + loc[i]; slot_ent[pos] = idx; slot_w[pos] = topk_w[idx]; }
        }
    }
    SEAM(9);
    if (IN(10)) { PH_BEGIN
        build_tables(ctl, tab, tid);
        REPS(10) { pg8::ExpertOrder<2, true> S; S.init(tab, D, wgu_t, (size_t)512 * D, slot_ent, slot_w, G, bx); pg8::EpiGU<true> E{(void*)act}; pg8::gemm_phase<1>(lds, (const char*)(ws + WS_HF8), D, S, E, tid); }
        { pg8::DenseOrder S; S.init(M, D, DE, wsd_t, G, bx); pg8::EpiSharedDown E{ws + WS_YSH}; pg8::gemm_phase(lds, (const char*)shh, DE, S, E, tid); }
    }
    SEAM(10);
    REPS(11) if (IN(11)) { PH_BEGIN
        build_tables(ctl, tab, tid);
        pg8::ExpertOrder<4, false> S; S.init(tab, DE, wd_t, (size_t)D * DE, slot_ent, slot_w, G, bx); pg8::EpiExpDown E{ybuf, slot_ent}; pg8::gemm_phase<1>(lds, (const char*)act, DE, S, E, tid);
#if MK_DUP == 111
        { pg8::ExpertOrder<4, false> S2; S2.init(tab, DE, wd_t, (size_t)D * DE, slot_ent, slot_w, G, bx); pg8::EpiProbeSum E2{(float*)(ws + WS_STATS)}; pg8::gemm_phase<1>(lds, (const char*)act, DE, S2, E2, tid); }
#endif
    }
    SEAM(11);
    REPS(12) if (IN(12)) { PH_BEGIN
        LAS float* cv = (LAS float*)lds; int curb = -1;
        for (int c = bx; c < M / 256; c += G) {
            const int b = c >> 3;
            if (b != curb) {
                __syncthreads();
                if (tid < 256) { const int i = tid * 4; *(LAS f32x4*)(cv + i) = *(const f32x4*)(X.ln1_g + i); *(LAS f32x4*)(cv + 1024 + i) = *(const f32x4*)(X.ln1_b + i);
                    *(LAS f32x4*)(cv + 2048 + i) = *(const f32x4*)(X.ln2_g + i); *(LAS f32x4*)(cv + 3072 + i) = *(const f32x4*)(X.ln2_b + i); *(LAS f32x4*)(cv + 4096 + i) = *(const f32x4*)(mod + b * 6144 + MOD_GATE_F + i); }
                __syncthreads(); curb = b;
            }
            const int r0 = c * 256 + wave * 32;
            RowRaw nx; final_load(nx, (const bf16_t*)(ws + WS_TB), ybuf, ws + WS_YSH, (const float*)(ws + WS_STATS), r0, lane);
#pragma unroll 1
            for (int i = 0; i < 32; ++i) {
                const RowRaw cur = nx;
                final_load(nx, (const bf16_t*)(ws + WS_TB), ybuf, ws + WS_YSH, (const float*)(ws + WS_STATS), r0 + (i < 31 ? i + 1 : i), lane);
                final_row(out, cur, cv, r0 + i, lane);
            }
        }
    }
#undef IN
#undef SEAM
}

extern "C" void kernel_launch(void* const* d_in, const int* in_sizes, int n_in, void* d_out, int out_size, void* d_ws, size_t ws_size, hipStream_t stream) {
    static int grid = 0;
    if (grid == 0) {
        if (n_in != 21 || in_sizes[0] != M * D || out_size != M * D || ws_size < WS_END) { fprintf(stderr, "kernel_launch: unexpected shapes (n_in %d, ws %zu)\n", n_in, ws_size); grid = -1; return; }
        int dev = 0, cus = 0, per_cu = 0;
        if (hipGetDevice(&dev) != hipSuccess || hipDeviceGetAttribute(&cus, hipDeviceAttributeMultiprocessorCount, dev) != hipSuccess) { grid = -1; return; }
        if (hipFuncSetAttribute((const void*)mk_fwd, hipFuncAttributeMaxDynamicSharedMemorySize, LDS_BYTES) != hipSuccess) { fprintf(stderr, "kernel_launch: hipFuncSetAttribute failed\n"); grid = -1; return; }
        if (hipOccupancyMaxActiveBlocksPerMultiprocessor(&per_cu, (const void*)mk_fwd, NW * 64, LDS_BYTES) != hipSuccess || per_cu < 1) { fprintf(stderr, "kernel_launch: occupancy query says %d\n", per_cu); }
        (void)hipGetLastError();
        grid = cus;
    }
    if (grid < 0) return;
    (void)hipMemsetAsync((char*)d_ws + WS_CTL, 0, 1 * MiB, stream);
    Args a{};
    const float** p = (const float**)&a.X;
    for (int i = 0; i < 21; ++i) p[i] = (const float*)d_in[i];
    a.X.out = (float*)d_out; a.X.ws = (unsigned char*)d_ws;
#if MK_PER_PHASE
    for (int ph = 0; ph < N_PHASES; ++ph) { a.ph_lo = ph; a.ph_hi = ph + 1; hipLaunchKernelGGL(mk_fwd, dim3(grid), dim3(NW * 64), LDS_BYTES, stream, a); }
#else
    a.ph_lo = 0; a.ph_hi = N_PHASES;
    hipLaunchKernelGGL(mk_fwd, dim3(grid), dim3(NW * 64), LDS_BYTES, stream, a);
#endif
}
```

```cpp
#include <hip/hip_runtime.h>
#include <cstdio>
#include <cstdint>

typedef unsigned short bf16_t;
typedef short bf16x8 __attribute__((ext_vector_type(8)));
typedef float f32x4 __attribute__((ext_vector_type(4)));
typedef float f32x2 __attribute__((ext_vector_type(2)));
typedef unsigned u32x4 __attribute__((ext_vector_type(4)));
typedef unsigned u32x2 __attribute__((ext_vector_type(2)));
#define LAS __attribute__((address_space(3)))

constexpr int D = 1024, BATCH = 32, SEQ = 2048, M = BATCH * SEQ;
constexpr int DIN = 3584;
constexpr int OFF_QNA = 0, OFF_KNA = 512, OFF_VNA = 1024, OFF_QR = 1536, OFF_KR = 2048, OFF_VR = 2560, OFF_GR = 3072;
constexpr int NE = 256, TOPK = 8, DE = 256;
constexpr int NSLOT = M * TOPK;
constexpr float LN_EPS = 1e-5f, GN_EPS = 1e-6f;
constexpr float ALPHA = 1.189207115002721f;
constexpr float YSCALE = 64.f, YINV = 1.f / 64.f;
constexpr float S_HF8 = 16.f, S_WGU8 = 256.f, S_ACT8 = 32.f, S_WD8 = 128.f;
constexpr float INV_GU8 = 1.f / (16.f * 256.f), INV_DN8 = 1.f / (32.f * 128.f);
constexpr int MOD_SHIFT_A = 0, MOD_SCALE_A = 1024, MOD_GATE_A = 2048, MOD_SHIFT_F = 3072, MOD_SCALE_F = 4096, MOD_GATE_F = 5120;

constexpr size_t MiB = 1u << 20;
constexpr size_t WS_CTL = 0;
constexpr size_t WS_MOD = 1 * MiB;
constexpr size_t WS_ROPE = 2 * MiB;
constexpr size_t WS_WIN_T = 4 * MiB;
constexpr size_t WS_WOUT_T = 11 * MiB;
constexpr size_t WS_WR_T = 13 * MiB;
constexpr size_t WS_WSGU_T = 14 * MiB;
constexpr size_t WS_WSD_T = 15 * MiB;
constexpr size_t WS_SLOT_ENT = 16 * MiB;
constexpr size_t WS_SLOT_W = 18 * MiB;
constexpr size_t WS_TOPK_E = 20 * MiB;
constexpr size_t WS_TOPK_W = 22 * MiB;
constexpr size_t WS_STATS = 24 * MiB;
constexpr size_t WS_WD_T = 32 * MiB;
constexpr size_t WS_WGU_T = 160 * MiB;
constexpr size_t WS_HF8 = 288 * MiB;
constexpr size_t WS_YMIX = 416 * MiB;
constexpr size_t WS_PROJ = 544 * MiB;
constexpr size_t WS_LOGITS = WS_YMIX, WS_SHH = WS_YMIX + 64 * MiB;
constexpr size_t WS_HF = WS_PROJ, WS_ACT = WS_PROJ + 128 * MiB;
constexpr size_t WS_YBUF = WS_WGU_T;
constexpr size_t WS_TB = WS_PROJ + 256 * MiB;
constexpr size_t WS_YSH = WS_PROJ + 384 * MiB;
constexpr size_t WS_END = 992 * MiB;
constexpr int CW_COUNT = 1024, CW_CURSOR = 1536, CW_BAR = 8192;

constexpr int RING_BYTES = 131072;
constexpr int TAB_OFF = RING_BYTES;
constexpr int T_OFF = 0, T_TILE = 260, T_CNT = 520, T_HIST = 776, T_BASE = 1032, TAB_WORDS = 1288;
constexpr int VN_OFF = TAB_OFF + 6144;
constexpr int ROWTAB_OFF = VN_OFF + 8192;
constexpr int PHASE_BYTES = 155648;
constexpr int MISC_OFF = PHASE_BYTES;
constexpr int LDS_BYTES = PHASE_BYTES + 256;
static_assert(TAB_WORDS * 4 <= 6144 && ROWTAB_OFF + 6144 <= PHASE_BYTES && LDS_BYTES <= 163840, "LDS map");

__device__ __forceinline__ unsigned f2bf(float f) { unsigned u = __float_as_uint(f); return (u + 0x7fffu + ((u >> 16) & 1u)) >> 16; }
__device__ __forceinline__ float bf2f(unsigned short h) { return __uint_as_float(((unsigned)h) << 16); }
__device__ __forceinline__ unsigned pk2(float lo, float hi) { return f2bf(lo) | (f2bf(hi) << 16); }
__device__ __forceinline__ unsigned cvt_pk_bf16(float lo, float hi) { unsigned r; asm volatile("v_cvt_pk_bf16_f32 %0, %1, %2" : "=v"(r) : "v"(lo), "v"(hi)); return r; }
__device__ __forceinline__ float silu_f(float v) { return v * __builtin_amdgcn_rcpf(1.f + __expf(-v)); }
__device__ __forceinline__ float wave_sum(float v) {
    v += __builtin_bit_cast(float, __builtin_amdgcn_update_dpp(0, __builtin_bit_cast(int, v), 0xB1, 0xf, 0xf, true));
    v += __builtin_bit_cast(float, __builtin_amdgcn_update_dpp(0, __builtin_bit_cast(int, v), 0x4E, 0xf, 0xf, true));
    v += __builtin_bit_cast(float, __builtin_amdgcn_update_dpp(0, __builtin_bit_cast(int, v), 0x141, 0xf, 0xf, true));
    v += __builtin_bit_cast(float, __builtin_amdgcn_update_dpp(0, __builtin_bit_cast(int, v), 0x140, 0xf, 0xf, true));
    const int b = __builtin_bit_cast(int, v);
    return (__builtin_bit_cast(float, __builtin_amdgcn_readlane(b, 0)) + __builtin_bit_cast(float, __builtin_amdgcn_readlane(b, 16))) + (__builtin_bit_cast(float, __builtin_amdgcn_readlane(b, 32)) + __builtin_bit_cast(float, __builtin_amdgcn_readlane(b, 48)));
}
__device__ __forceinline__ float clamp8(float v) { return __builtin_amdgcn_fmed3f(v, -440.f, 440.f); }
#define LDS_WAIT() asm volatile("s_waitcnt lgkmcnt(0)" ::: "memory")
__device__ __forceinline__ int lane_id() { return (int)__builtin_amdgcn_mbcnt_hi(~0u, __builtin_amdgcn_mbcnt_lo(~0u, 0u)); }

#define XB_TMO      128
#define XB_XCNT(j)  (256  + 64 * (j))
#define XB_XSUB(j)  (1280 + 64 * (j))
#define XB_XGEN(j)  (2304 + 64 * (j))
#define XB_TOP      3328
#define XB_TOPGEN   3392
#define XCD_BAR_WORDS 3456
#define XB_SPIN_CAP (1u << 23)
__device__ __forceinline__ unsigned xb_ld(unsigned* p)              { return __hip_atomic_load(p, __ATOMIC_RELAXED, __HIP_MEMORY_SCOPE_AGENT); }
__device__ __forceinline__ unsigned xb_add(unsigned* p, unsigned v) { return __hip_atomic_fetch_add(p, v, __ATOMIC_RELAXED, __HIP_MEMORY_SCOPE_AGENT); }
__device__ __forceinline__ unsigned xb_xcc_id() { return (unsigned)__builtin_amdgcn_s_getreg((3 << 11) | 20) & 0xFu; }
#define XB_SPIN(cond, bar) do { unsigned _sp = 0; while (cond) { __builtin_amdgcn_s_sleep(1); \
    if ((++_sp & 255u) == 0u) { if (xb_ld(&(bar)[XB_TMO])) break; if (_sp > XB_SPIN_CAP) { atomicAdd(&(bar)[XB_TMO], 1u); break; } } } } while (0)
struct XcdBarrier { unsigned* bar; unsigned x; volatile LAS unsigned* st; };
__device__ __forceinline__ XcdBarrier xcd_barrier_post(unsigned* bar, volatile LAS unsigned* st, bool leader) {
    XcdBarrier b; b.bar = bar; b.x = xb_xcc_id(); b.st = st;
    if (leader) (void)xb_add(&bar[XB_XCNT(b.x)], 1u);
    return b;
}
__device__ __forceinline__ void xcd_barrier_complete(unsigned* bar, unsigned x, unsigned& nloc, unsigned& nx) {
    const unsigned G = gridDim.x * gridDim.y * gridDim.z;
    unsigned sum, cnt, mine, sp = 0u;
    for (;;) {
        sum = 0u; cnt = 0u; mine = 0u;
#pragma unroll
        for (unsigned j = 0; j < 16; ++j) { const unsigned c = xb_ld(&bar[XB_XCNT(j)]); sum += c; cnt += (c > 0u) ? 1u : 0u; mine = (j == x) ? c : mine; }
        if (sum == G) break;
        __builtin_amdgcn_s_sleep(1);
        if ((++sp & 255u) == 0u) { if (xb_ld(&bar[XB_TMO])) break; if (sp > XB_SPIN_CAP) { atomicAdd(&bar[XB_TMO], 1u); break; } }
    }
    nloc = mine > 0u ? mine : 1u; nx = cnt > 0u ? cnt : 1u;
}
__device__ __forceinline__ void xcd_barrier(const XcdBarrier& b, bool leader) {
    asm volatile("s_waitcnt vmcnt(0)" ::: "memory");
    __syncthreads();
    if (leader) {
        unsigned* bar = b.bar;
        __builtin_amdgcn_s_waitcnt(0);
        unsigned nloc = b.st[0], nx = b.st[1];
        if (nloc == 0u) { xcd_barrier_complete(bar, b.x, nloc, nx); b.st[0] = nloc; b.st[1] = nx; }
        const unsigned old = xb_add(&bar[XB_XSUB(b.x)], 1u);
        const unsigned gen = old / nloc;
        if (old + 1u == (gen + 1u) * nloc) {
            __builtin_amdgcn_fence(__ATOMIC_RELEASE, "agent");
            asm volatile("s_waitcnt vmcnt(0)" ::: "memory");
            const unsigned og = xb_add(&bar[XB_TOP], 1u);
            const unsigned tg = og / nx;
            if (og + 1u == (tg + 1u) * nx) xb_add(&bar[XB_TOPGEN], 1u);
            else XB_SPIN(xb_ld(&bar[XB_TOPGEN]) == tg, bar);
            __builtin_amdgcn_fence(__ATOMIC_ACQUIRE, "agent");
            xb_add(&bar[XB_XGEN(b.x)], 1u);
            asm volatile("s_waitcnt vmcnt(0)" ::: "memory");
        } else {
            XB_SPIN(xb_ld(&bar[XB_XGEN(b.x)]) == gen, bar);
            __builtin_amdgcn_fence(__ATOMIC_ACQUIRE, "agent");
            asm volatile("s_waitcnt vmcnt(0)" ::: "memory");
        }
    }
    __syncthreads();
}

namespace pg8 {
constexpr int BM = 256, BK = 64, HALF = 128, HTB = HALF * BK * 2, STAGE_BYTES = 8 * HTB;
__device__ __forceinline__ int lds_byte(int r, int c) { const int st = (r >> 4) * 2 + (c >> 5), rr = r & 15, cc = c & 31, ob = rr * 64 + cc * 2; return st * 1024 + (ob ^ (((ob >> 9) & 1) << 5)); }
__device__ __forceinline__ void stage_rc(int b, int& R, int& C) { const int st = b / 1024, sb = b % 1024, swz = sb ^ (((sb >> 9) & 1) << 5); R = (st >> 1) * 16 + swz / 64; C = (st & 1) * 32 + (swz % 64) / 2; }
__device__ __forceinline__ int perm32(int rho) { const int n = rho >> 4, i = rho & 15; return 8 * (i >> 2) + 4 * n + (i & 3); }

typedef int i32x8 __attribute__((ext_vector_type(8)));
__device__ __forceinline__ i32x8 cat8(const bf16x8 lo, const bf16x8 hi) { const u32x4 a = __builtin_bit_cast(u32x4, lo), b = __builtin_bit_cast(u32x4, hi); return (i32x8){(int)a.x, (int)a.y, (int)a.z, (int)a.w, (int)b.x, (int)b.y, (int)b.z, (int)b.w}; }
struct Unit { int pm, pn; const char* B; int e, cnt, off; };

template <int ESZ = 2, class Epi, class Sched>
__device__ __forceinline__ void gemm_phase(LAS unsigned char* lds, const char* Abase, const int K, const Sched& S, const Epi& E, const int tid_in) {
    int tid_ = tid_in; asm volatile("" : "+v"(tid_));
    const int tid = tid_, wid = __builtin_amdgcn_readfirstlane(tid >> 6), lane = tid & 63, wr = wid >> 2, wc = wid & 3, fr = lane & 15, fq = lane >> 4;
    const int rowbytes = K * ESZ, nt = rowbytes / 128;
    int Rr[2], Cc[2]; unsigned voffB[2], voffA[2];
#pragma unroll
    for (int i = 0; i < 2; ++i) { int R, C; stage_rc(tid * 16 + i * 8192, R, C); Rr[i] = R; Cc[i] = C; const int Rb = Epi::PERM ? (64 * (R >> 5) + 16 * ((R >> 2) & 3) + 4 * ((R >> 4) & 1) + (R & 3)) : R; voffB[i] = (unsigned)(Rb * rowbytes + C * 2); voffA[i] = (unsigned)(R * rowbytes + C * 2); }
    constexpr bool GATHER = Sched::GATHER;
    const size_t kstep = (size_t)128;
    const size_t hstep = (size_t)HALF * rowbytes;
    const size_t bhstep = (size_t)(Epi::PERM ? 8 : HALF) * rowbytes;
    const unsigned ldsw = (unsigned)wid * 1024u;
    const int aoff = (ESZ == 2) ? lds_byte(wr * 64 + fr, fq * 8) : lds_byte(wr * 64 + fr, 16 * (fq & 1)) + 1024 * (fq >> 1);
    const int boff = (ESZ == 2) ? lds_byte(wc * 32 + fr, fq * 8) : lds_byte(wc * 32 + fr, 16 * (fq & 1)) + 1024 * (fq >> 1);
#define PG8_SA(b, h) (((b) * 2 + (h)) * HTB)
#define PG8_SB(b, h) ((4 + (b) * 2 + (h)) * HTB)
#define PG8_STAGE(bufoff, gbase, voff) do { _Pragma("unroll") for (int _i = 0; _i < 2; ++_i) \
        __builtin_amdgcn_global_load_lds((const unsigned*)((const char*)(gbase) + (voff)[_i]), (LAS unsigned*)(lds + (bufoff) + ldsw + _i * 8192), 16, 0, 0); } while (0)
#define PG8_STAGEA(bufoff, uptr, koff, NEXT, h) do { if constexpr (GATHER) { if (NEXT) { const u32x2 _t = *(const LAS u32x2*)(vnslot + 2 * (h)); unsigned _v[2] = {_t.x, _t.y}; PG8_STAGE(bufoff, Abase + (koff), _v); } else { PG8_STAGE(bufoff, Abase + (koff), vc[h]); } } \
        else { PG8_STAGE(bufoff, (uptr) + (size_t)(h) * hstep + (koff), voffA); } } while (0)
#define PG8_LDA(dst, b, h) do { _Pragma("unroll") for (int m = 0; m < 4; ++m) { if constexpr (ESZ == 2) { _Pragma("unroll") for (int k = 0; k < 2; ++k) dst[m].q[k] = *(const LAS bf16x8*)(lds + PG8_SA(b, h) + aoff + m * 2048 + k * 1024); } \
        else dst[m].w = cat8(*(const LAS bf16x8*)(lds + PG8_SA(b, h) + aoff + m * 2048), *(const LAS bf16x8*)(lds + PG8_SA(b, h) + aoff + m * 2048 + 16)); } } while (0)
#define PG8_LDB(dst, b, h) do { _Pragma("unroll") for (int n = 0; n < 2; ++n) { if constexpr (ESZ == 2) { _Pragma("unroll") for (int k = 0; k < 2; ++k) dst[n].q[k] = *(const LAS bf16x8*)(lds + PG8_SB(b, h) + boff + n * 2048 + k * 1024); } \
        else dst[n].w = cat8(*(const LAS bf16x8*)(lds + PG8_SB(b, h) + boff + n * 2048), *(const LAS bf16x8*)(lds + PG8_SB(b, h) + boff + n * 2048 + 16)); } } while (0)
#define PG8_MMA(ai, bj, At, Bt) do { __builtin_amdgcn_s_setprio(1); _Pragma("unroll") for (int m = 0; m < 4; ++m) _Pragma("unroll") for (int n = 0; n < 2; ++n) { \
        if constexpr (ESZ == 2) { _Pragma("unroll") for (int k = 0; k < 2; ++k) acc[ai][bj][m][n] = __builtin_amdgcn_mfma_f32_16x16x32_bf16(Bt[n].q[k], At[m].q[k], acc[ai][bj][m][n], 0, 0, 0); } \
        else { asm volatile("v_mfma_f32_16x16x128_f8f6f4 %0, %1, %2, %0" : "+v"(acc[ai][bj][m][n]) : "v"(Bt[n].w), "v"(At[m].w)); } } \
        __builtin_amdgcn_s_setprio(0); } while (0)
#define PG8_WAIT_V(n) asm volatile("s_waitcnt vmcnt(" #n ")" ::: "memory")
#define PG8_WAIT_L(n) asm volatile("s_waitcnt lgkmcnt(" #n ")" ::: "memory")
#define PG8_BAR __builtin_amdgcn_s_barrier()
#define PG8_SCHED __builtin_amdgcn_sched_barrier(0)
    Unit cur, nxt; int ui = 0;
    if (!S.next(0, cur)) return;
    f32x4 acc[2][2][4][2];
    union Frag { bf16x8 q[2]; i32x8 w; };
    Frag At[4], B0[2], B1[2];
    unsigned vc[2][2];
    LAS unsigned* vnslot = (LAS unsigned*)(lds + (VN_OFF - 0)) + tid * 4;
    if constexpr (GATHER) S.avoff(cur, Rr, Cc, vc, tid);
    LAS unsigned* rowtab = (LAS unsigned*)(lds + ROWTAB_OFF);
    if constexpr (GATHER) S.rowtab(cur, rowtab, tid);
    const char* cB = cur.B; const char* cA = Abase + S.aoff(cur);
    PG8_STAGE(PG8_SB(0, 0), cB, voffB); PG8_STAGE(PG8_SB(0, 1), cB + bhstep, voffB); PG8_STAGEA(PG8_SA(0, 0), cA, 0, false, 0); PG8_STAGEA(PG8_SA(0, 1), cA, 0, false, 1);
    if (wr == 1) PG8_BAR;
    PG8_WAIT_V(2); PG8_BAR;
    PG8_STAGE(PG8_SB(1, 0), cB + kstep, voffB); PG8_STAGEA(PG8_SA(1, 0), cA, kstep, false, 0); PG8_STAGE(PG8_SB(1, 1), cB + bhstep + kstep, voffB);
    PG8_WAIT_V(6); PG8_BAR;
    asm volatile("" ::: "memory");
#pragma unroll
    for (int a = 0; a < 2; ++a)
#pragma unroll
        for (int b = 0; b < 2; ++b)
#pragma unroll
            for (int m = 0; m < 4; ++m)
#pragma unroll
                for (int n = 0; n < 2; ++n) { acc[a][b][m][n] = (f32x4){0.f, 0.f, 0.f, 0.f}; asm volatile("" : "+v"(acc[a][b][m][n])); }
    asm volatile("s_nop 4" ::: "memory");
    for (;;) {
        const bool has_next = S.next(ui + 1, nxt);
        if constexpr (GATHER) {
            unsigned vn[2][2];
            if (has_next) S.avoff(nxt, Rr, Cc, vn, tid);
            else {
#pragma unroll
                for (int h = 0; h < 2; ++h)
#pragma unroll
                    for (int i = 0; i < 2; ++i) vn[h][i] = vc[h][i];
            }
            *(LAS u32x4*)vnslot = (u32x4){vn[0][0], vn[0][1], vn[1][0], vn[1][1]};
            if (has_next) S.rowtab(nxt, rowtab + 512 * ((ui + 1) % 3), tid);
        }
        const char* nB = has_next ? nxt.B : cB; const char* nA = has_next ? Abase + S.aoff(nxt) : cA;
        for (int t = 0; t < nt; t += 2) {
            const bool last = (t == nt - 2);
            const size_t k1 = (size_t)(t + 1) * kstep;
            const size_t k2 = last ? (size_t)0 : (size_t)(t + 2) * kstep, k3 = k2 + kstep;
            const char* u2 = last ? nA : cA; const char* b2 = last ? nB : cB + (size_t)(t + 2) * kstep;
            const char* b3 = b2 + kstep;
            PG8_LDB(B0, 0, 0); PG8_LDB(B1, 0, 1); PG8_SCHED; PG8_LDA(At, 0, 0); PG8_STAGEA(PG8_SA(1, 1), cA, k1, false, 1);
            PG8_WAIT_V(8); PG8_WAIT_L(0); PG8_BAR; PG8_MMA(0, 0, At, B0); PG8_MMA(0, 1, At, B1); PG8_BAR; PG8_SCHED;
            PG8_LDA(At, 0, 1); PG8_STAGE(PG8_SB(0, 0), b2, voffB); PG8_STAGE(PG8_SB(0, 1), b2 + bhstep, voffB); PG8_STAGEA(PG8_SA(0, 0), u2, k2, last, 0);
            PG8_WAIT_V(8); PG8_WAIT_L(0); PG8_BAR; PG8_MMA(1, 0, At, B0); PG8_MMA(1, 1, At, B1); PG8_BAR; PG8_SCHED;
            PG8_LDB(B0, 1, 0); PG8_LDB(B1, 1, 1); PG8_SCHED; PG8_LDA(At, 1, 0); PG8_STAGEA(PG8_SA(0, 1), u2, k2, last, 1);
            PG8_WAIT_V(8); PG8_WAIT_L(0); PG8_BAR; PG8_MMA(0, 0, At, B0); PG8_MMA(0, 1, At, B1); PG8_BAR; PG8_SCHED;
            PG8_LDA(At, 1, 1); PG8_STAGE(PG8_SB(1, 0), b3, voffB); PG8_STAGE(PG8_SB(1, 1), b3 + bhstep, voffB); PG8_STAGEA(PG8_SA(1, 0), u2, k3, last, 0);
            PG8_WAIT_V(8); PG8_WAIT_L(0); PG8_BAR; PG8_MMA(1, 0, At, B0); PG8_MMA(1, 1, At, B1); PG8_BAR; PG8_SCHED;
        }
        if (wr == 0) PG8_BAR;
        if constexpr (ESZ == 1) {
            asm volatile("s_nop 15\n\ts_nop 15" ::: "memory");
#pragma unroll
            for (int a = 0; a < 2; ++a)
#pragma unroll
                for (int b = 0; b < 2; ++b)
#pragma unroll
                    for (int m = 0; m < 4; ++m) asm volatile("" : "+v"(acc[a][b][m][0]), "+v"(acc[a][b][m][1]));
        }
        { const int l2 = lane_id(); E(acc, cur, wr, wc, l2 & 15, l2 >> 4, rowtab + 512 * (ui % 3)); }
        if (!has_next) break;
#pragma unroll
        for (int a = 0; a < 2; ++a)
#pragma unroll
            for (int b = 0; b < 2; ++b)
#pragma unroll
                for (int m = 0; m < 4; ++m)
#pragma unroll
                    for (int n = 0; n < 2; ++n) acc[a][b][m][n] = (f32x4){0.f, 0.f, 0.f, 0.f};
        cur = nxt; cB = nB; cA = nA; ++ui;
        if constexpr (GATHER) { const u32x4 _t = *(const LAS u32x4*)vnslot; vc[0][0] = _t.x; vc[0][1] = _t.y; vc[1][0] = _t.z; vc[1][1] = _t.w; }
        if (wr == 1) PG8_BAR;
    }
    PG8_WAIT_V(0);
    PG8_BAR;
#undef PG8_SA
#undef PG8_SB
#undef PG8_STAGE
#undef PG8_STAGEA
#undef PG8_LDA
#undef PG8_LDB
#undef PG8_MMA
#undef PG8_WAIT_V
#undef PG8_WAIT_L
#undef PG8_BAR
#undef PG8_SCHED
}

struct DenseOrder {
    int nM, nN, nwg, G, c, K; const char* Bt;
    __device__ __forceinline__ void init(int Mrows, int N, int K_, const void* Bt_, int G_, int c_) { nM = Mrows / BM; nN = N / BM; nwg = nM * nN; G = G_; c = c_; K = K_; Bt = (const char*)Bt_; }
    __device__ __forceinline__ bool next(int i, Unit& u) const {
        const long L = (long)i * G + c; if (L >= nwg) return false;
        int wgid = (int)L; { const int q = nwg / 8, r = nwg % 8, xcd = wgid % 8, off = wgid / 8; wgid = (xcd < r ? xcd * (q + 1) : r * (q + 1) + (xcd - r) * q) + off; }
        const int nig = 8 * nN, gid = wgid / nig, fm = gid * 8, gsz = (nM - fm) < 8 ? (nM - fm) : 8;
        u.pm = fm + ((wgid % nig) % gsz); u.pn = (wgid % nig) / gsz; u.B = Bt + (size_t)u.pn * BM * K * 2; u.e = 0; u.cnt = 0; u.off = 0; return true;
    }
    static constexpr bool GATHER = false;
    __device__ __forceinline__ size_t aoff(const Unit& u) const { return (size_t)u.pm * BM * K * 2; }
    __device__ __forceinline__ void avoff(const Unit&, const int (&)[2], const int (&)[2], unsigned (&)[2][2], int) const {}
};
template <int NCOL, bool TOKROWS> struct ExpertOrder {
    static constexpr bool GATHER = true;
    __device__ __forceinline__ size_t aoff(const Unit&) const { return 0; }
    const LAS unsigned* tab; int per, c, K  ; const char* W; size_t wstride; const int* slot_ent; const float* slot_w;
    mutable int ehint = 0;
    int xbase, xend, xstride, xlb;
    __device__ __forceinline__ void init(const LAS unsigned* tab_, int K_, const void* W_, size_t wstride_, const int* slot_ent_, const float* slot_w_, int G, int c_) {
        tab = tab_; K = K_; W = (const char*)W_; wstride = wstride_; slot_ent = slot_ent_; slot_w = slot_w_; c = c_;
        const int U = (int)tab[T_TILE + NE] * NCOL; per = (U + G - 1) / G;
        if (G % 8 == 0) { const int x = c_ % 8; const int q = U / 8, r = U % 8; xbase = x * q + (x < r ? x : r); xend = xbase + q + (x < r ? 1 : 0); xstride = G / 8; xlb = c_ / 8; }
        else { xbase = 0; xend = U; xstride = G; xlb = c_; }
    }
    __device__ __forceinline__ bool next(int i, Unit& u) const {
        const int L = xbase + i * xstride + xlb;
        if (L >= xend) return false;
        const int tile = L / NCOL; u.pn = L % NCOL;
        int lo = ehint;
        if (i == 0) { lo = 0; int hi = NE - 1; while (lo < hi) { const int mid = (lo + hi + 1) >> 1; if ((int)tab[T_TILE + mid] <= tile) lo = mid; else hi = mid - 1; } }
        else { while (lo < NE - 1 && (int)tab[T_TILE + lo + 1] <= tile) ++lo; }
        ehint = lo;
        u.e = lo; u.pm = tile - (int)tab[T_TILE + lo]; u.cnt = (int)tab[T_CNT + lo]; u.off = (int)tab[T_OFF + lo];
        u.B = W + (size_t)lo * wstride + (size_t)u.pn * BM * K; return true;
    }
    __device__ __forceinline__ void rowtab(const Unit& u, LAS unsigned* t, int tid) const {
        if (tid < BM) { int r = u.pm * BM + tid; if (r >= u.cnt) r = u.cnt - 1; t[tid] = (unsigned)slot_ent[u.off + r]; t[BM + tid] = __float_as_uint(slot_w[u.off + r]); }
    }
    __device__ __forceinline__ void avoff(const Unit& u, const int (&)[2], const int (&)[2], unsigned (&v)[2][2], int tidq) const {
        int R[2], C[2]; asm volatile("" : "+v"(tidq));
#pragma unroll
        for (int i = 0; i < 2; ++i) stage_rc(tidq * 16 + i * 8192, R[i], C[i]);
#pragma unroll
        for (int h = 0; h < 2; ++h)
#pragma unroll
            for (int i = 0; i < 2; ++i) {
                int r = u.pm * BM + h * HALF + R[i]; if (r >= u.cnt) r = u.cnt - 1;
                const int slot = u.off + r;
                const int row = TOKROWS ? (slot_ent[slot] >> 3) : slot;
                v[h][i] = (unsigned)(row * K + C[i] * 2);
            }
    }
};

struct EpiInProj {
    static constexpr bool PERM = true; bf16_t* O;
    __device__ __forceinline__ void operator()(const f32x4 (&acc)[2][2][4][2], const Unit& u, int wr, int wc, int fr, int fq, const LAS unsigned* rt) const {
        const float sc = (u.pn < 2) ? 0.125f : ((u.pn == 8 || u.pn == 9) ? 0.08838834764831845f : 1.f);
        const int row0 = u.pm * BM + wr * 64 + fr, col0 = u.pn * BM + wc * 64 + 16 * fq;
#pragma unroll
        for (int ai = 0; ai < 2; ++ai)
#pragma unroll
            for (int m = 0; m < 4; ++m) { bf16_t* rowp = O + (size_t)(row0 + ai * HALF + m * 16) * DIN + col0;
#pragma unroll
                for (int bj = 0; bj < 2; ++bj) { const f32x4 v0 = acc[ai][bj][m][0] * sc, v1 = acc[ai][bj][m][1] * sc;
                    u32x4 w; w.x = cvt_pk_bf16(v0[0], v0[1]); w.y = cvt_pk_bf16(v0[2], v0[3]); w.z = cvt_pk_bf16(v1[0], v1[1]); w.w = cvt_pk_bf16(v1[2], v1[3]);
                    *(u32x4*)(rowp + 8 * bj) = w; } }
    }
};
struct EpiOutProj {
    static constexpr bool PERM = true; const float* x; const float* mod; bf16_t* tb;
    __device__ __forceinline__ void operator()(const f32x4 (&acc)[2][2][4][2], const Unit& u, int wr, int wc, int fr, int fq, const LAS unsigned* rt) const {
        const int b = (u.pm * BM) >> 11; const int col0 = u.pn * BM + wc * 64 + 16 * fq;
        f32x4 g[2][2];
#pragma unroll
        for (int bj = 0; bj < 2; ++bj)
#pragma unroll
            for (int n = 0; n < 2; ++n) g[bj][n] = *(const f32x4*)(mod + b * 6144 + MOD_GATE_A + col0 + 8 * bj + 4 * n);
#pragma unroll
        for (int ai = 0; ai < 2; ++ai)
#pragma unroll
            for (int m = 0; m < 4; ++m) { const size_t o = (size_t)(u.pm * BM + ai * HALF + wr * 64 + m * 16 + fr) * D + col0;
#pragma unroll
                for (int bj = 0; bj < 2; ++bj) {
                    const f32x4 t0 = *(const f32x4*)(x + o + 8 * bj) * ALPHA + g[bj][0] * acc[ai][bj][m][0], t1 = *(const f32x4*)(x + o + 8 * bj + 4) * ALPHA + g[bj][1] * acc[ai][bj][m][1];
                    u32x4 w; w.x = cvt_pk_bf16(t0[0], t0[1]); w.y = cvt_pk_bf16(t0[2], t0[3]); w.z = cvt_pk_bf16(t1[0], t1[1]); w.w = cvt_pk_bf16(t1[2], t1[3]);
                    *(u32x4*)(tb + o + 8 * bj) = w; } }
    }
};
struct EpiRouter {
    static constexpr bool PERM = false; float* out;
    __device__ __forceinline__ void operator()(const f32x4 (&acc)[2][2][4][2], const Unit& u, int wr, int wc, int fr, int fq, const LAS unsigned* rt) const {
        const int col0 = wc * 32 + 4 * fq;
#pragma unroll
        for (int ai = 0; ai < 2; ++ai)
#pragma unroll
            for (int m = 0; m < 4; ++m) { float* rowp = out + (size_t)(u.pm * BM + ai * HALF + wr * 64 + m * 16 + fr) * NE + col0;
#pragma unroll
                for (int bj = 0; bj < 2; ++bj)
#pragma unroll
                    for (int n = 0; n < 2; ++n) *(f32x4*)(rowp + bj * HALF + n * 16) = acc[ai][bj][m][n]; }
    }
};
template <bool EXPERT> struct EpiGU {
    static constexpr bool PERM = true; void* Ov;
    __device__ __forceinline__ void operator()(const f32x4 (&acc)[2][2][4][2], const Unit& u, int wr, int wc, int fr, int fq, const LAS unsigned* rt) const {
        const int h0 = u.pn * HALF + wc * 32 + 8 * fq;
#pragma unroll
        for (int ai = 0; ai < 2; ++ai)
#pragma unroll
            for (int m = 0; m < 4; ++m) {
                const int rtw = u.pm * BM + ai * HALF + wr * 64 + m * 16 + fr;
                if (EXPERT) { if (rtw >= u.cnt) continue; }
                const float w = EXPERT ? __uint_as_float(rt[BM + ai * HALF + wr * 64 + m * 16 + fr]) * (S_ACT8 * INV_GU8) : 1.f;
                const float gs = EXPERT ? INV_GU8 : 1.f;
                const f32x4 g0 = acc[ai][0][m][0] * gs, g1 = acc[ai][0][m][1] * gs, u0 = acc[ai][1][m][0], u1 = acc[ai][1][m][1];
                const float h[8] = {w * silu_f(g0[0]) * u0[0], w * silu_f(g0[1]) * u0[1], w * silu_f(g0[2]) * u0[2], w * silu_f(g0[3]) * u0[3],
                                    w * silu_f(g1[0]) * u1[0], w * silu_f(g1[1]) * u1[1], w * silu_f(g1[2]) * u1[2], w * silu_f(g1[3]) * u1[3]};
                if (EXPERT) {
                    int w0 = __builtin_amdgcn_cvt_pk_fp8_f32(clamp8(h[0]), clamp8(h[1]), 0, false); w0 = __builtin_amdgcn_cvt_pk_fp8_f32(clamp8(h[2]), clamp8(h[3]), w0, true);
                    int w1 = __builtin_amdgcn_cvt_pk_fp8_f32(clamp8(h[4]), clamp8(h[5]), 0, false); w1 = __builtin_amdgcn_cvt_pk_fp8_f32(clamp8(h[6]), clamp8(h[7]), w1, true);
                    u32x2 o; o.x = (unsigned)w0; o.y = (unsigned)w1; *(u32x2*)((unsigned char*)Ov + (size_t)(u.off + rtw) * DE + h0) = o;
                    asm volatile("" ::: "memory");
                } else {
                    u32x4 o; o.x = cvt_pk_bf16(h[0], h[1]); o.y = cvt_pk_bf16(h[2], h[3]); o.z = cvt_pk_bf16(h[4], h[5]); o.w = cvt_pk_bf16(h[6], h[7]);
                    *(u32x4*)((bf16_t*)Ov + (size_t)rtw * DE + h0) = o;
                }
            }
    }
};
struct EpiSharedDown {
    static constexpr bool PERM = true; unsigned char* ysh;
    __device__ __forceinline__ void operator()(const f32x4 (&acc)[2][2][4][2], const Unit& u, int wr, int wc, int fr, int fq, const LAS unsigned* rt) const {
        const int col0 = u.pn * BM + wc * 64 + 16 * fq;
#pragma unroll
        for (int ai = 0; ai < 2; ++ai)
#pragma unroll
            for (int m = 0; m < 4; ++m) {
                u32x4 o;
#pragma unroll
                for (int bj = 0; bj < 2; ++bj) { const f32x4 v0 = acc[ai][bj][m][0] * YSCALE, v1 = acc[ai][bj][m][1] * YSCALE;
                    int w0 = __builtin_amdgcn_cvt_pk_fp8_f32(clamp8(v0[0]), clamp8(v0[1]), 0, false); w0 = __builtin_amdgcn_cvt_pk_fp8_f32(clamp8(v0[2]), clamp8(v0[3]), w0, true);
                    int w1 = __builtin_amdgcn_cvt_pk_fp8_f32(clamp8(v1[0]), clamp8(v1[1]), 0, false); w1 = __builtin_amdgcn_cvt_pk_fp8_f32(clamp8(v1[2]), clamp8(v1[3]), w1, true);
                    if (bj == 0) { o.x = (unsigned)w0; o.y = (unsigned)w1; } else { o.z = (unsigned)w0; o.w = (unsigned)w1; } }
                *(u32x4*)(ysh + (size_t)(u.pm * BM + ai * HALF + wr * 64 + m * 16 + fr) * D + col0) = o;
            }
    }
};
struct EpiExpDown {
    static constexpr bool PERM = true; unsigned char* ybuf; const int* slot_ent;
    __device__ __forceinline__ void operator()(const f32x4 (&acc)[2][2][4][2], const Unit& u, int wr, int wc, int fr, int fq, const LAS unsigned* rt) const {
        const int col0 = u.pn * BM + wc * 64 + 16 * fq;
#pragma unroll
        for (int ai = 0; ai < 2; ++ai)
#pragma unroll
            for (int m = 0; m < 4; ++m) {
                const int rtw = u.pm * BM + ai * HALF + wr * 64 + m * 16 + fr; if (rtw >= u.cnt) continue;
                u32x4 o;
#pragma unroll
                for (int bj = 0; bj < 2; ++bj) { const f32x4 v0 = acc[ai][bj][m][0] * (YSCALE * INV_DN8), v1 = acc[ai][bj][m][1] * (YSCALE * INV_DN8);
                    int w0 = __builtin_amdgcn_cvt_pk_fp8_f32(clamp8(v0[0]), clamp8(v0[1]), 0, false); w0 = __builtin_amdgcn_cvt_pk_fp8_f32(clamp8(v0[2]), clamp8(v0[3]), w0, true);
                    int w1 = __builtin_amdgcn_cvt_pk_fp8_f32(clamp8(v1[0]), clamp8(v1[1]), 0, false); w1 = __builtin_amdgcn_cvt_pk_fp8_f32(clamp8(v1[2]), clamp8(v1[3]), w1, true);
                    if (bj == 0) { o.x = (unsigned)w0; o.y = (unsigned)w1; } else { o.z = (unsigned)w0; o.w = (unsigned)w1; } }
                *(u32x4*)(ybuf + (size_t)rt[ai * HALF + wr * 64 + m * 16 + fr] * D + col0) = o;
                asm volatile("" ::: "memory");
            }
    }
};
struct EpiProbeSum {
    static constexpr bool PERM = true; float* o;
    __device__ __forceinline__ void operator()(const f32x4 (&acc)[2][2][4][2], const Unit& u, int wr, int wc, int fr, int fq, const LAS unsigned* rt) const {
        f32x4 s = (f32x4){0.f, 0.f, 0.f, 0.f};
#pragma unroll
        for (int a = 0; a < 2; ++a)
#pragma unroll
            for (int b = 0; b < 2; ++b)
#pragma unroll
                for (int m = 0; m < 4; ++m) s += acc[a][b][m][0] + acc[a][b][m][1];
        if (s.x == 123.456f) *(f32x4*)(o + (size_t)(blockIdx.x * 512 + wr * 256 + wc * 64 + fq * 16 + fr) * 4) = s;
    }
};
}

struct Ctx {
    const float *x, *c, *w_ada, *b_ada, *w_in, *w_out, *na_rpb, *ret_ld, *ret_gn, *ln1_g, *ln1_b, *ln2_g, *ln2_b, *w_router, *rbias, *w_gate, *w_up, *w_down, *ws_gate, *ws_up, *ws_down;
    float* out; unsigned char* ws;
};
constexpr int NW = 8;

__device__ __forceinline__ void transpose_item(const float* W, int K, int N, bf16_t* WT, int G, int which, LAS float* scr, int item, int lane) {
    const int nblk = N / 32, kb = item / nblk, nb = item % nblk, k0 = 64 * kb, n0 = 32 * nb;
    float v[32];
#pragma unroll
    for (int i = 0; i < 32; ++i) { const int kk = 2 * i + (lane >> 5); v[i] = __builtin_nontemporal_load(W + (size_t)(k0 + kk) * N + n0 + (lane & 31)); }
#pragma unroll
    for (int i = 0; i < 32; ++i) { const int kk = 2 * i + (lane >> 5); scr[kk * 33 + (lane & 31)] = v[i]; }
    LDS_WAIT(); asm volatile("" ::: "memory");
    const int c = lane & 7;
#pragma unroll
    for (int j = 0; j < 4; ++j) { const int n = (lane >> 3) + 8 * j; const LAS float* s = scr + (8 * c) * 33 + n;
        u32x4 o; o.x = pk2(s[0 * 33], s[1 * 33]); o.y = pk2(s[2 * 33], s[3 * 33]); o.z = pk2(s[4 * 33], s[5 * 33]); o.w = pk2(s[6 * 33], s[7 * 33]);
        const int ng = n0 + n; const int drow = (G == 0) ? ng : ((ng / G) * 2 * G + which * G + (ng % G));
        *(u32x4*)(WT + (size_t)drow * K + k0 + 8 * c) = o; }
    LDS_WAIT(); asm volatile("" ::: "memory");
}
__device__ __forceinline__ void transpose_item_fp8(const float* W, int K, int N, unsigned char* WT, int G, int which, float scale, LAS float* scr, int item, int lane) {
    const int nblk = N / 32, kb = item / nblk, nb = item % nblk, k0 = 64 * kb, n0 = 32 * nb;
    float v[32];
#pragma unroll
    for (int i = 0; i < 32; ++i) { const int kk = 2 * i + (lane >> 5); v[i] = __builtin_nontemporal_load(W + (size_t)(k0 + kk) * N + n0 + (lane & 31)); }
#pragma unroll
    for (int i = 0; i < 32; ++i) { const int kk = 2 * i + (lane >> 5); scr[kk * 33 + (lane & 31)] = v[i] * scale; }
    LDS_WAIT(); asm volatile("" ::: "memory");
    const int c = lane & 7;
#pragma unroll
    for (int j = 0; j < 4; ++j) { const int n = (lane >> 3) + 8 * j; const LAS float* sp = scr + (8 * c) * 33 + n;
        int w0 = __builtin_amdgcn_cvt_pk_fp8_f32(clamp8(sp[0 * 33]), clamp8(sp[1 * 33]), 0, false); w0 = __builtin_amdgcn_cvt_pk_fp8_f32(clamp8(sp[2 * 33]), clamp8(sp[3 * 33]), w0, true);
        int w1 = __builtin_amdgcn_cvt_pk_fp8_f32(clamp8(sp[4 * 33]), clamp8(sp[5 * 33]), 0, false); w1 = __builtin_amdgcn_cvt_pk_fp8_f32(clamp8(sp[6 * 33]), clamp8(sp[7 * 33]), w1, true);
        const int ng = n0 + n; const int drow = (G == 0) ? ng : ((ng / G) * 2 * G + which * G + (ng % G));
        u32x2 o; o.x = (unsigned)w0; o.y = (unsigned)w1; *(u32x2*)(WT + (size_t)drow * K + k0 + 8 * c) = o; }
    LDS_WAIT(); asm volatile("" ::: "memory");
}
__device__ __forceinline__ void rope_entry(float* tab, int idx) {
    const int t = idx >> 6, i = idx & 63;
    const float inv_freq = powf(10000.f, -(float)(2 * i) / 128.f);
    const float ang = (float)t * inv_freq;
    const double a = (double)ang; const double two_pi = 6.283185307179586476925286766559;
    const double kf = rint(a / two_pi); double r = a - kf * two_pi;
    double sgn = 1.0; if (r > 1.5707963267948966) { r = 3.141592653589793 - r; sgn = -1.0; } else if (r < -1.5707963267948966) { r = -3.141592653589793 - r; sgn = -1.0; }
    const double r2 = r * r;
    const double s = r * (1.0 + r2 * (-1.0 / 6 + r2 * (1.0 / 120 + r2 * (-1.0 / 5040 + r2 * (1.0 / 362880 + r2 * (-1.0 / 39916800 + r2 * (1.0 / 6227020800.0 + r2 * (-1.0 / 1307674368000.0))))))));
    const double c = 1.0 + r2 * (-0.5 + r2 * (1.0 / 24 + r2 * (-1.0 / 720 + r2 * (1.0 / 40320 + r2 * (-1.0 / 3628800 + r2 * (1.0 / 479001600.0 + r2 * (-1.0 / 87178291200.0 + r2 * (1.0 / 20922789888000.0))))))));
    tab[idx] = (float)(sgn * c); tab[SEQ * 64 + idx] = (float)s;
}
__device__ __forceinline__ void mod_task(const float* __restrict__ cin, const float* __restrict__ w_ada, float* __restrict__ modp, int task, int lane) {
    const int cbk = task % 96, kc = task / 96, j = cbk * 64 + lane, k0 = kc * 64;
    float acc[32], cv[32];
#pragma unroll
    for (int b = 0; b < 32; ++b) { acc[b] = 0.f; cv[b] = silu_f(cin[b * D + k0 + lane]); }
#pragma unroll
    for (int kb = 0; kb < 4; ++kb) {
        float w[16];
#pragma unroll
        for (int i = 0; i < 16; ++i) w[i] = w_ada[(size_t)(k0 + kb * 16 + i) * 6144 + j];
#pragma unroll
        for (int i = 0; i < 16; ++i)
#pragma unroll
            for (int b = 0; b < 32; ++b) acc[b] += __builtin_bit_cast(float, __builtin_amdgcn_readlane(__builtin_bit_cast(int, cv[b]), kb * 16 + i)) * w[i];
    }
#pragma unroll
    for (int b = 0; b < 32; ++b) modp[((size_t)kc * 32 + b) * 6144 + j] = acc[b];
}
__device__ __forceinline__ float mod_sum(const float* __restrict__ modp, const float* __restrict__ b_ada, int b, int j) {
    float s = 0.f;
#pragma unroll
    for (int kc = 0; kc < 16; ++kc) s += modp[((size_t)kc * 32 + b) * 6144 + j];
    return s + b_ada[j];
}

#ifndef RET_PROBE
#define RET_PROBE 0
#endif
namespace ret {
typedef short s16x4 __attribute__((ext_vector_type(4)));
typedef __bf16 bfx2 __attribute__((ext_vector_type(2)));
constexpr unsigned RS = 288, TILE = 128 * RS, LK = 0, LV = TILE, LRF = 2 * TILE, LRB = 3 * TILE;
constexpr float LOG2E = 1.4426950408889634f;
__device__ __forceinline__ unsigned offb(unsigned row, unsigned ch) { return RS * row + 16u * ch; }
__device__ __forceinline__ unsigned cvtpk(float lo, float hi) { const f32x2 v = {lo, hi}; return __builtin_bit_cast(unsigned, __builtin_convertvector(v, bfx2)); }
__device__ __forceinline__ bf16x8 pack8(const float (&f)[8]) { u32x4 u; u.x = cvtpk(f[0], f[1]); u.y = cvtpk(f[2], f[3]); u.z = cvtpk(f[4], f[5]); u.w = cvtpk(f[6], f[7]); return __builtin_bit_cast(bf16x8, u); }
__device__ __forceinline__ void unpack8(const bf16x8 v, float (&f)[8]) { const u32x4 u = __builtin_bit_cast(u32x4, v);
    f[0] = __uint_as_float(u.x << 16); f[1] = __uint_as_float(u.x & 0xffff0000u); f[2] = __uint_as_float(u.y << 16); f[3] = __uint_as_float(u.y & 0xffff0000u);
    f[4] = __uint_as_float(u.z << 16); f[5] = __uint_as_float(u.z & 0xffff0000u); f[6] = __uint_as_float(u.w << 16); f[7] = __uint_as_float(u.w & 0xffff0000u); }
__device__ __forceinline__ bf16x8 trfrag(LAS unsigned char* base, unsigned row0, unsigned row1, unsigned cblk, unsigned qp, unsigned p) {
    const unsigned ch = 2u * cblk + (p >> 1), bo = 8u * (p & 1u);
    const s16x4 lo = __builtin_amdgcn_ds_read_tr16_b64_v4i16((LAS s16x4*)(base + offb(row0 + qp, ch) + bo));
    const s16x4 hi = __builtin_amdgcn_ds_read_tr16_b64_v4i16((LAS s16x4*)(base + offb(row1 + qp, ch) + bo));
    return __builtin_shufflevector(lo, hi, 0, 1, 2, 3, 4, 5, 6, 7);
}
struct KVRaw { bf16x8 ka[2], kb[2], v[4]; f32x4 c0[2], c1[2], s0[2], s1[2]; };
__device__ __forceinline__ void kv_load(KVRaw& R, const bf16_t* __restrict__ proj, const float* __restrict__ rope, int b, int h, int n, int tid) {
#pragma unroll
    for (int i = 0; i < 2; ++i) {
        const int q2 = tid + 512 * i, row = q2 >> 3, pc = q2 & 7, t = n * 128 + row;
        const bf16_t* rp = proj + (size_t)(b * SEQ + t) * DIN + OFF_KR + h * 128;
        R.ka[i] = *(const bf16x8*)(rp + pc * 8); R.kb[i] = *(const bf16x8*)(rp + 64 + pc * 8);
        R.c0[i] = *(const f32x4*)(rope + t * 64 + pc * 8); R.c1[i] = *(const f32x4*)(rope + t * 64 + pc * 8 + 4);
        R.s0[i] = *(const f32x4*)(rope + SEQ * 64 + t * 64 + pc * 8); R.s1[i] = *(const f32x4*)(rope + SEQ * 64 + t * 64 + pc * 8 + 4);
    }
#pragma unroll
    for (int i = 0; i < 4; ++i) { const int q4 = tid + 512 * i, row = q4 >> 4, ch = q4 & 15, t = n * 128 + row;
        R.v[i] = *(const bf16x8*)(proj + (size_t)(b * SEQ + t) * DIN + OFF_VR + h * 128 + ch * 8); }
}
__device__ __forceinline__ void kv_store(LAS unsigned char* lds, const KVRaw& R, int tid) {
#pragma unroll
    for (int i = 0; i < 2; ++i) {
        const int q2 = tid + 512 * i, row = q2 >> 3, pc = q2 & 7;
        float fa[8], fb[8], o1[8], o2[8];
        unpack8(R.ka[i], fa); unpack8(R.kb[i], fb);
        const float cs[8] = {R.c0[i].x, R.c0[i].y, R.c0[i].z, R.c0[i].w, R.c1[i].x, R.c1[i].y, R.c1[i].z, R.c1[i].w}, sn[8] = {R.s0[i].x, R.s0[i].y, R.s0[i].z, R.s0[i].w, R.s1[i].x, R.s1[i].y, R.s1[i].z, R.s1[i].w};
#pragma unroll
        for (int e = 0; e < 8; ++e) { o1[e] = fa[e] * cs[e] - fb[e] * sn[e]; o2[e] = fb[e] * cs[e] + fa[e] * sn[e]; }
        *(LAS bf16x8*)(lds + LK + offb(row, pc)) = pack8(o1); *(LAS bf16x8*)(lds + LK + offb(row, pc + 8)) = pack8(o2);
    }
#pragma unroll
    for (int i = 0; i < 4; ++i) { const int q4 = tid + 512 * i, row = q4 >> 4, ch = q4 & 15; *(LAS bf16x8*)(lds + LV + offb(row, ch)) = R.v[i]; }
}
__device__ __forceinline__ void rb_dma(LAS unsigned char* lds, const unsigned char* img, int w, int lane) {
#pragma unroll
    for (int i = 0; i < 5; ++i) { const int o = w + 8 * i; if (o < (int)TILE / 1024)
        __builtin_amdgcn_global_load_lds((const unsigned*)(img + o * 1024 + lane * 16), (LAS unsigned*)(lds + LRB + o * 1024), 16, 0, 0); }
}
template <bool FWD> __device__ __forceinline__ void state_update_1(LAS unsigned char* lds, f32x4 (&racc)[8], float l2, int w, int g, unsigned qp, unsigned p);
template <bool FWD> __device__ __forceinline__ void state_update(LAS unsigned char* lds, f32x4 (&racc)[8], float l2, int w, int g, unsigned qp, unsigned p) {
    if (RET_PROBE == 2) {
        f32x4 r2[8];
#pragma unroll
        for (int i = 0; i < 8; ++i) r2[i] = racc[i];
        unsigned zo = 0; asm volatile("" : "+v"(zo));
        state_update_1<FWD>(lds + zo, r2, l2, w, g, qp, p);
        state_update_1<FWD>(lds, racc, l2, w, g, qp, p);
#pragma unroll
        for (int i = 0; i < 8; ++i) racc[i] = (racc[i] + r2[i]) * 0.5f;
    } else state_update_1<FWD>(lds, racc, l2, w, g, qp, p);
}
template <bool FWD> __device__ __forceinline__ void state_update_1(LAS unsigned char* lds, f32x4 (&racc)[8], float l2, int w, int g, unsigned qp, unsigned p) {
    const float dec = __builtin_amdgcn_exp2f(128.f * l2);
    bf16x8 vs[4];
#pragma unroll
    for (int ks = 0; ks < 4; ++ks) {
        float f[8]; unpack8(trfrag(lds + LV, 32 * ks + 4 * g, 32 * ks + 16 + 4 * g, w, qp, p), f);
#pragma unroll
        for (int e = 0; e < 8; ++e) { const int key = 32 * ks + 16 * (e >> 2) + 4 * g + (e & 3); f[e] *= __builtin_amdgcn_exp2f((FWD ? (float)(127 - key) : (float)key) * l2); }
        vs[ks] = pack8(f);
    }
#pragma unroll
    for (int nb = 0; nb < 8; ++nb) {
        racc[nb] = racc[nb] * dec;
#pragma unroll
        for (int ks = 0; ks < 4; ++ks) racc[nb] = __builtin_amdgcn_mfma_f32_16x16x32_bf16(vs[ks], trfrag(lds + LK, 32 * ks + 4 * g, 32 * ks + 16 + 4 * g, nb, qp, p), racc[nb], 0, 0, 0);
    }
}
__device__ __forceinline__ void unit(const bf16_t* __restrict__ proj, const float* __restrict__ rope, const float* __restrict__ log_decay, const float* __restrict__ gn_g, bf16_t* __restrict__ ymix,
                                     unsigned char* __restrict__ scratch  , LAS unsigned char* lds, int hu, const int tid_in) {
    const int u = hu >> 1, n0 = (hu & 1) * 8, n1 = n0 + 8;
    const int b = u >> 2, h = u & 3;
    int tid_ = tid_in; asm volatile("" : "+v"(tid_));
    const int tid0 = tid_, w = __builtin_amdgcn_readfirstlane(tid0 >> 6);
#define RET_LANE int tid = tid0; asm volatile("" : "+v"(tid)); const int lane = tid & 63, r = lane & 15, g = lane >> 4; const unsigned qp = (unsigned)r >> 2, p = (unsigned)lane & 3u;
    const float lf2_ = log_decay[h] * LOG2E, lb2_ = log_decay[4 + h] * LOG2E;
    f32x4 racc[8];
    KVRaw raw;
    for (int rep7 = 0; rep7 < (RET_PROBE == 7 ? 2 : 1); ++rep7) {
#pragma unroll
    for (int nb = 0; nb < 8; ++nb) racc[nb] = (f32x4){0.f, 0.f, 0.f, 0.f};
    kv_load(raw, proj, rope, b, h, 15, tid0);
    for (int n = 15; n >= n0; --n) {
        RET_LANE
        if (n < n1) {
            unsigned char* img = scratch + (size_t)(n - n0) * TILE;
#pragma unroll
            for (int nb = 0; nb < 8; ++nb) { u32x2 o; o.x = cvtpk(racc[nb][0], racc[nb][1]); o.y = cvtpk(racc[nb][2], racc[nb][3]);
                *(u32x2*)(img + offb(16 * nb + r, 2 * w + (g >> 1)) + 8 * (g & 1)) = o; }
        }
        if (n == n0) break;
        float lb2 = lb2_; asm volatile("" : "+v"(lb2));
        __syncthreads();
        kv_store(lds, raw, tid);
        __syncthreads();
        kv_load(raw, proj, rope, b, h, n - 1 > n0 ? n - 1 : 0, tid);
        state_update<false>(lds, racc, lb2, w, g, qp, p);
    }
    }
    asm volatile("s_waitcnt vmcnt(0)" ::: "memory");
    __syncthreads();
    __builtin_amdgcn_fence(__ATOMIC_ACQUIRE, "agent");
    asm volatile("s_waitcnt vmcnt(0)" ::: "memory");
    for (int rep8 = 0; rep8 < (RET_PROBE == 8 ? 2 : 1); ++rep8) {
    if (RET_PROBE == 8 && rep8 == 1) { __syncthreads(); kv_load(raw, proj, rope, b, h, 0, tid0); }
#pragma unroll
    for (int nb = 0; nb < 8; ++nb) racc[nb] = (f32x4){0.f, 0.f, 0.f, 0.f};
    for (int n = 0; n < n0; ++n) {
        RET_LANE
        float lf2 = lf2_; asm volatile("" : "+v"(lf2));
        __syncthreads();
        kv_store(lds, raw, tid);
        __syncthreads();
        kv_load(raw, proj, rope, b, h, n + 1, tid);
        state_update<true>(lds, racc, lf2, w, g, qp, p);
    }
    rb_dma(lds, scratch, w, tid0 & 63);
    for (int n = n0; n < n1; ++n) {
        RET_LANE
        float lf2 = lf2_, lb2 = lb2_; asm volatile("" : "+v"(lf2), "+v"(lb2));
        const __attribute__((address_space(1))) float* gnp = (const __attribute__((address_space(1))) float*)gn_g; asm volatile("" : "+s"(gnp));
        __syncthreads();
        kv_store(lds, raw, tid);
#pragma unroll
        for (int nb = 0; nb < 8; ++nb) { u32x2 o; o.x = cvtpk(racc[nb][0], racc[nb][1]); o.y = cvtpk(racc[nb][2], racc[nb][3]);
            *(LAS u32x2*)(lds + LRF + offb(16 * nb + r, 2 * w + (g >> 1)) + 8 * (g & 1)) = o; }
        const int cq = 16 * w + r, tq = n * 128 + cq;
        bf16x8 qn[4], qf[4], qb[4];
        { const bf16_t* rp = proj + (size_t)(b * SEQ + tq) * DIN + OFF_QR + h * 128 + 4 * g;
          const float sf = __builtin_amdgcn_exp2f((float)(cq + 1) * lf2), sb = __builtin_amdgcn_exp2f((float)(128 - cq) * lb2);
#pragma unroll
          for (int ks = 0; ks < 2; ++ks) {
              float fa[8], fb[8], o1[8], o2[8], t1[8], t2[8];
              { const u32x2 a0 = *(const u32x2*)(rp + 32 * ks), a1 = *(const u32x2*)(rp + 32 * ks + 16), b0 = *(const u32x2*)(rp + 32 * ks + 64), b1 = *(const u32x2*)(rp + 32 * ks + 80);
                unpack8(__builtin_bit_cast(bf16x8, (u32x4){a0.x, a0.y, a1.x, a1.y}), fa); unpack8(__builtin_bit_cast(bf16x8, (u32x4){b0.x, b0.y, b1.x, b1.y}), fb); }
              const float* cp = rope + tq * 64 + 32 * ks + 4 * g; const float* sp = cp + SEQ * 64;
              const f32x4 c0 = *(const f32x4*)cp, c1 = *(const f32x4*)(cp + 16), s0 = *(const f32x4*)sp, s1 = *(const f32x4*)(sp + 16);
              const float cs[8] = {c0.x, c0.y, c0.z, c0.w, c1.x, c1.y, c1.z, c1.w}, sn[8] = {s0.x, s0.y, s0.z, s0.w, s1.x, s1.y, s1.z, s1.w};
#pragma unroll
              for (int e = 0; e < 8; ++e) { o1[e] = fa[e] * cs[e] - fb[e] * sn[e]; o2[e] = fb[e] * cs[e] + fa[e] * sn[e]; }
              qn[ks] = pack8(o1); qn[ks + 2] = pack8(o2);
#pragma unroll
              for (int e = 0; e < 8; ++e) { t1[e] = o1[e] * sf; t2[e] = o2[e] * sf; }
              qf[ks] = pack8(t1); qf[ks + 2] = pack8(t2);
#pragma unroll
              for (int e = 0; e < 8; ++e) { t1[e] = o1[e] * sb; t2[e] = o2[e] * sb; }
              qb[ks] = pack8(t1); qb[ks + 2] = pack8(t2);
          } }
        asm volatile("s_waitcnt vmcnt(0)" ::: "memory");
        __syncthreads();
        kv_load(raw, proj, rope, b, h, n + 1 < n1 ? n + 1 : n, tid);
        u32x2 gv[8];
        { const bf16_t* gp = proj + (size_t)(b * SEQ + tq) * DIN + OFF_GR + h * 128 + 4 * g;
#pragma unroll
          for (int mbv = 0; mbv < 8; ++mbv) gv[mbv] = *(const u32x2*)(gp + 16 * mbv); }
        bf16x8 pt[4];
#pragma unroll
        for (int rep3 = 0; rep3 < (RET_PROBE == 3 ? 2 : 1); ++rep3) {
        unsigned zo3 = 0; if (RET_PROBE == 3) asm volatile("" : "+v"(zo3));
#pragma unroll
        for (int ks2 = 0; ks2 < 4; ++ks2) {
            float pv[8];
#pragma unroll
            for (int hb = 0; hb < 2; ++hb) {
                const int mb = 2 * ks2 + hb;
                f32x4 st = (f32x4){0.f, 0.f, 0.f, 0.f};
#pragma unroll
                for (int ks = 0; ks < 4; ++ks) { const LAS unsigned char* kp = lds + LK + zo3 + RS * (16 * mb + r) + 64 * ks + 8 * g; const u32x2 k0 = *(const LAS u32x2*)kp, k1 = *(const LAS u32x2*)(kp + 32);
                    st = __builtin_amdgcn_mfma_f32_16x16x32_bf16(__builtin_bit_cast(bf16x8, (u32x4){k0.x, k0.y, k1.x, k1.y}), qn[ks], st, 0, 0, 0); }
#pragma unroll
                for (int j = 0; j < 4; ++j) { const int diff = cq - (16 * mb + 4 * g + j); pv[4 * hb + j] = st[j] * __builtin_amdgcn_exp2f(diff >= 0 ? (float)diff * lf2 : (float)(-diff) * lb2); }
            }
            pt[ks2] = pack8(pv);
        }
        }
        f32x4 yacc[8];
#pragma unroll
        for (int mbv = 0; mbv < 8; ++mbv) {
            f32x4 y = (f32x4){0.f, 0.f, 0.f, 0.f};
#pragma unroll
            for (int rep = 0; rep < (RET_PROBE == 1 ? 2 : 1); ++rep) {
            unsigned zo = 0; if (RET_PROBE == 1) asm volatile("" : "+v"(zo));
#pragma unroll
            for (int ks2 = 0; ks2 < 4; ++ks2) y = __builtin_amdgcn_mfma_f32_16x16x32_bf16(trfrag(lds + LV + zo, 32 * ks2 + 4 * g, 32 * ks2 + 16 + 4 * g, mbv, qp, p), pt[ks2], y, 0, 0, 0);
#pragma unroll
            for (int ks = 0; ks < 4; ++ks) {
                y = __builtin_amdgcn_mfma_f32_16x16x32_bf16(trfrag(lds + LRF + zo, 32 * ks + 4 * g, 32 * ks + 16 + 4 * g, mbv, qp, p), qf[ks], y, 0, 0, 0);
                y = __builtin_amdgcn_mfma_f32_16x16x32_bf16(trfrag(lds + LRB + zo, 32 * ks + 4 * g, 32 * ks + 16 + 4 * g, mbv, qp, p), qb[ks], y, 0, 0, 0);
            }
            }
            yacc[mbv] = (RET_PROBE == 1) ? y * 0.5f : y;
        }
        __syncthreads();
        if (n + 1 < n1) rb_dma(lds, scratch + (size_t)(n + 1 - n0) * TILE, w, lane);
        { float s = 0.f;
#pragma unroll
          for (int mbv = 0; mbv < 8; ++mbv) s += (yacc[mbv][0] + yacc[mbv][1]) + (yacc[mbv][2] + yacc[mbv][3]);
          s += __shfl_xor(s, 16); s += __shfl_xor(s, 32);
          const float mu = s * (1.f / 128.f); float s2 = 0.f;
#pragma unroll
          for (int mbv = 0; mbv < 8; ++mbv) { yacc[mbv] = yacc[mbv] - mu; s2 += (yacc[mbv][0] * yacc[mbv][0] + yacc[mbv][1] * yacc[mbv][1]) + (yacc[mbv][2] * yacc[mbv][2] + yacc[mbv][3] * yacc[mbv][3]); }
          s2 += __shfl_xor(s2, 16); s2 += __shfl_xor(s2, 32);
          const float rstd = 1.f / sqrtf(s2 * (1.f / 128.f) + GN_EPS);
          bf16_t* op = ymix + (size_t)(b * SEQ + tq) * D + 512 + h * 128 + 4 * g;
#pragma unroll
          for (int rep4 = 0; rep4 < (RET_PROBE == 4 ? 2 : 1); ++rep4) {
          if (RET_PROBE == 4) { asm volatile("" : "+v"(op)); asm volatile("" : "+v"(gv[0]), "+v"(gv[1]), "+v"(gv[2]), "+v"(gv[3]), "+v"(gv[4]), "+v"(gv[5]), "+v"(gv[6]), "+v"(gv[7])); }
#pragma unroll
          for (int mbv = 0; mbv < 8; ++mbv) {
              const f32x4 gn = *(const __attribute__((address_space(1))) f32x4*)(gnp + h * 128 + 16 * mbv + 4 * g);
              const float g0 = __uint_as_float(gv[mbv].x << 16), g1 = __uint_as_float(gv[mbv].x & 0xffff0000u), g2 = __uint_as_float(gv[mbv].y << 16), g3 = __uint_as_float(gv[mbv].y & 0xffff0000u);
              u32x2 o; o.x = cvtpk(silu_f(g0) * (yacc[mbv][0] * rstd * gn.x), silu_f(g1) * (yacc[mbv][1] * rstd * gn.y));
              o.y = cvtpk(silu_f(g2) * (yacc[mbv][2] * rstd * gn.z), silu_f(g3) * (yacc[mbv][3] * rstd * gn.w));
              *(u32x2*)(op + 16 * mbv) = o;
          } } }
        state_update<true>(lds, racc, lf2, w, g, qp, p);
    }
    }
    __syncthreads();
#undef RET_LANE
}
}


namespace na {
constexpr unsigned LKR = 0, LVR = 73728, LRPB = 147456;
__device__ __forceinline__ void load_row(LAS unsigned char* lds, const bf16_t* __restrict__ proj, int b, int head, int krow, int tid) {
    const int key = tid >> 3, ch = tid & 7, slot = krow % 9;
    const bf16_t* rp = proj + (size_t)(b * SEQ + krow * 64 + key) * DIN + head * 64 + ch * 8;
    const unsigned o = (unsigned)slot * 8192u + 128u * key + 16u * (ch ^ (key & 7));
    *(LAS u32x4*)(lds + LKR + o) = *(const u32x4*)(rp + OFF_KNA);
    *(LAS u32x4*)(lds + LVR + o) = *(const u32x4*)(rp + OFF_VNA);
}
__device__ __forceinline__ void unit(const bf16_t* __restrict__ proj, const float* __restrict__ rpb, bf16_t* __restrict__ ymix, LAS unsigned char* lds, int u, const int tid_in) {
    const int b = u >> 3, head = u & 7;
    int tid_ = tid_in; asm volatile("" : "+v"(tid_));
    const int tid0 = tid_, w = __builtin_amdgcn_readfirstlane(tid0 >> 6);
    __syncthreads();
    if (tid0 < 465) ((LAS float*)(lds + LRPB))[tid0] = rpb[head * 465 + tid0];
    const int ct = w & 3, cb = (ct == 0) ? 0 : (ct == 1 ? 8 : (ct == 2 ? 24 : 32));
    u32x4 pk[2], pv2[2]; int pre_lo = 0, pre_n = 0;
    for (int st = 0; st < 16; ++st) {
        int tid = tid0; asm volatile("" : "+v"(tid));
        const int lane = tid & 63, qi = lane & 15, g = lane >> 4; const unsigned qp = (unsigned)qi >> 2, p = (unsigned)lane & 3u;
        const int r = 2 * st + (w >> 2);
        const int rs = min(max(r - 4, 0), 24);
        const int need_hi = min(max(2 * st + 1 - 4, 0), 24) + 7;
        __syncthreads();
        if (st == 0) { for (int kr = 0; kr <= need_hi; ++kr) load_row(lds, proj, b, head, kr, tid); }
        else {
#pragma unroll
            for (int i = 0; i < 2; ++i) if (i < pre_n) { const int key = tid >> 3, ch = tid & 7; const unsigned o = (unsigned)((pre_lo + i) % 9) * 8192u + 128u * key + 16u * (ch ^ (key & 7));
                *(LAS u32x4*)(lds + LKR + o) = pk[i]; *(LAS u32x4*)(lds + LVR + o) = pv2[i]; }
        }
        const int cq = 16 * ct + qi, tq = b * SEQ + r * 64 + cq;
        bf16x8 qn[2];
        { const bf16_t* qptr = proj + (size_t)tq * DIN + OFF_QNA + head * 64 + 8 * g; qn[0] = *(const bf16x8*)qptr; qn[1] = *(const bf16x8*)(qptr + 32); }
        __syncthreads();
        { const int nh = (st < 15) ? min(max(2 * st + 3 - 4, 0), 24) + 7 : need_hi; pre_lo = need_hi + 1; pre_n = nh - need_hi;
#pragma unroll
          for (int i = 0; i < 2; ++i) if (i < pre_n) { const int key = tid >> 3, ch = tid & 7; const bf16_t* rp = proj + (size_t)(b * SEQ + (pre_lo + i) * 64 + key) * DIN + head * 64 + ch * 8;
              pk[i] = *(const u32x4*)(rp + OFF_KNA); pv2[i] = *(const u32x4*)(rp + OFF_VNA); } }
        const int cs = min(max(cq - 8, 0), 48);
        const unsigned kb0 = 128u * qi + 16u * ((unsigned)g ^ ((unsigned)qi & 7u)), kb1 = 128u * qi + 16u * ((4u + (unsigned)g) ^ ((unsigned)qi & 7u));
        const LAS float* bias = (const LAS float*)(lds + LRPB);
        f32x4 sc[16]; float mx = -3.0e38f;
#pragma unroll
        for (int kr = 0; kr < 8; ++kr) {
            const int krow = rs + kr; const unsigned so = (unsigned)(krow % 9) * 8192u + 128u * (unsigned)cb;
            const int dr = krow - r + 7;
#pragma unroll
            for (int h2 = 0; h2 < 2; ++h2) {
                f32x4 a = (f32x4){0.f, 0.f, 0.f, 0.f};
                a = __builtin_amdgcn_mfma_f32_16x16x32_bf16(*(const LAS bf16x8*)(lds + LKR + so + 2048u * h2 + kb0), qn[0], a, 0, 0, 0);
                a = __builtin_amdgcn_mfma_f32_16x16x32_bf16(*(const LAS bf16x8*)(lds + LKR + so + 2048u * h2 + kb1), qn[1], a, 0, 0, 0);
#pragma unroll
                for (int j = 0; j < 4; ++j) {
                    const int kcol = cb + 16 * h2 + 4 * g + j;
                    const int dc = min(max(kcol - cq + 15, 0), 30);
                    const float v = a[j] + bias[dr * 31 + dc];
                    const bool in = (kcol >= cs) && (kcol < cs + 16);
                    a[j] = in ? v : -3.0e38f; mx = fmaxf(mx, a[j]);
                }
                sc[2 * kr + h2] = a;
            }
        }
        mx = fmaxf(mx, __shfl_xor(mx, 16)); mx = fmaxf(mx, __shfl_xor(mx, 32));
        float sum = 0.f; bf16x8 pt[8];
#pragma unroll
        for (int kk = 0; kk < 8; ++kk) {
            float pv[8];
#pragma unroll
            for (int h2 = 0; h2 < 2; ++h2)
#pragma unroll
                for (int j = 0; j < 4; ++j) { const float e = __builtin_amdgcn_exp2f((sc[2 * kk + h2][j] - mx) * 1.4426950408889634f); pv[4 * h2 + j] = e; sum += e; }
            pt[kk] = ret::pack8(pv);
        }
        sum += __shfl_xor(sum, 16); sum += __shfl_xor(sum, 32);
        const float inv = 1.f / sum;
        const unsigned sl = (((unsigned)g & 1u) << 2) | qp;
        bf16_t* op = ymix + (size_t)tq * D + head * 64 + 4 * g;
#pragma unroll
        for (int db = 0; db < 4; ++db) {
            const unsigned vb = 128u * (4u * (unsigned)g + qp) + 16u * ((2u * db + (p >> 1)) ^ sl) + 8u * (p & 1u);
            f32x4 y = (f32x4){0.f, 0.f, 0.f, 0.f};
#pragma unroll
            for (int kk = 0; kk < 8; ++kk) {
                const unsigned so = (unsigned)((rs + kk) % 9) * 8192u + 128u * (unsigned)cb;
                const ret::s16x4 lo = __builtin_amdgcn_ds_read_tr16_b64_v4i16((LAS ret::s16x4*)(lds + LVR + so + vb));
                const ret::s16x4 hi = __builtin_amdgcn_ds_read_tr16_b64_v4i16((LAS ret::s16x4*)(lds + LVR + so + 2048u + vb));
                y = __builtin_amdgcn_mfma_f32_16x16x32_bf16(__builtin_shufflevector(lo, hi, 0, 1, 2, 3, 4, 5, 6, 7), pt[kk], y, 0, 0, 0);
            }
            u32x2 o; o.x = ret::cvtpk(y[0] * inv, y[1] * inv); o.y = ret::cvtpk(y[2] * inv, y[3] * inv);
            *(u32x2*)(op + 16 * db) = o;
        }
    }
    __syncthreads();
}
}

__device__ __forceinline__ void unpack_t16r(const u32x4 a, const u32x4 b, f32x4 (&v)[4]) {
    v[0] = (f32x4){__uint_as_float(a.x << 16), __uint_as_float(a.x & 0xffff0000u), __uint_as_float(a.y << 16), __uint_as_float(a.y & 0xffff0000u)};
    v[1] = (f32x4){__uint_as_float(a.z << 16), __uint_as_float(a.z & 0xffff0000u), __uint_as_float(a.w << 16), __uint_as_float(a.w & 0xffff0000u)};
    v[2] = (f32x4){__uint_as_float(b.x << 16), __uint_as_float(b.x & 0xffff0000u), __uint_as_float(b.y << 16), __uint_as_float(b.y & 0xffff0000u)};
    v[3] = (f32x4){__uint_as_float(b.z << 16), __uint_as_float(b.z & 0xffff0000u), __uint_as_float(b.w << 16), __uint_as_float(b.w & 0xffff0000u)};
}
__device__ __forceinline__ void ln1_row(const u32x4 ra, const u32x4 rb, const LAS float* cv  , bf16_t* __restrict__ hf, unsigned char* __restrict__ hf8, float* __restrict__ stats, int row, int lane) {
    asm volatile("" : "+v"(cv));
    const int c0 = lane * 16;
    f32x4 v[4]; float s = 0.f;
    unpack_t16r(ra, rb, v);
#pragma unroll
    for (int j = 0; j < 4; ++j) s += (v[j].x + v[j].y) + (v[j].z + v[j].w);
    const float mean = wave_sum(s) * (1.f / D); float s2 = 0.f;
#pragma unroll
    for (int j = 0; j < 4; ++j) { v[j] = v[j] - mean; s2 += (v[j].x * v[j].x + v[j].y * v[j].y) + (v[j].z * v[j].z + v[j].w * v[j].w); }
    const float rstd = 1.f / sqrtf(wave_sum(s2) * (1.f / D) + LN_EPS);
    if (lane == 0) *(f32x2*)(stats + 2 * (size_t)row) = (f32x2){mean, rstd};
    u32x4 ob[2], o8;
#pragma unroll
    for (int j = 0; j < 4; ++j) { const int col = c0 + 4 * j;
        const f32x4 gg = *(const LAS f32x4*)(cv + col), bv = *(const LAS f32x4*)(cv + 1024 + col), sc1 = *(const LAS f32x4*)(cv + 2048 + col), sh = *(const LAS f32x4*)(cv + 3072 + col);
        const f32x4 h4 = (v[j] * rstd * gg + bv) * sc1 + sh;
        const unsigned p0 = pk2(h4.x, h4.y), p1 = pk2(h4.z, h4.w);
        if (j == 0) { ob[0].x = p0; ob[0].y = p1; } else if (j == 1) { ob[0].z = p0; ob[0].w = p1; } else if (j == 2) { ob[1].x = p0; ob[1].y = p1; } else { ob[1].z = p0; ob[1].w = p1; }
        const f32x4 h8 = h4 * S_HF8;
        int w0 = __builtin_amdgcn_cvt_pk_fp8_f32(clamp8(h8.x), clamp8(h8.y), 0, false); w0 = __builtin_amdgcn_cvt_pk_fp8_f32(clamp8(h8.z), clamp8(h8.w), w0, true);
        if (j == 0) o8.x = (unsigned)w0; else if (j == 1) o8.y = (unsigned)w0; else if (j == 2) o8.z = (unsigned)w0; else o8.w = (unsigned)w0; }
    *(u32x4*)(hf + (size_t)row * D + c0) = ob[0]; *(u32x4*)(hf + (size_t)row * D + c0 + 8) = ob[1];
    *(u32x4*)(hf8 + (size_t)row * D + c0) = o8;
}
__device__ __forceinline__ void top2_merge(float& a1, float& a2, float b1, float b2) { const float n1 = fmaxf(a1, b1); const float n2 = fmaxf(fminf(a1, b1), fmaxf(a2, b2)); a1 = n1; a2 = n2; }
template <int CTRL> __device__ __forceinline__ float dppf(float v) { return __builtin_bit_cast(float, __builtin_amdgcn_update_dpp(0, __builtin_bit_cast(int, v), CTRL, 0xf, 0xf, true)); }
__device__ __forceinline__ float rdlane(float v, int l) { return __builtin_bit_cast(float, __builtin_amdgcn_readlane(__builtin_bit_cast(int, v), l)); }
template <int T> __device__ __forceinline__ void route_tokens(const float* __restrict__ logits, const f32x4 bias, int* __restrict__ topk_e, float* __restrict__ topk_w, LAS unsigned* hist, int tok0, int tstride, int lane) {
    const float NEG = -3.0e38f;
    float sc[T][4], s[T][4];
#pragma unroll
    for (int t = 0; t < T; ++t) {
        const f32x4 lg = *(const f32x4*)(logits + (size_t)(tok0 + t * tstride) * NE + lane * 4);
        sc[t][0] = 1.f / (1.f + __expf(-lg.x)); sc[t][1] = 1.f / (1.f + __expf(-lg.y)); sc[t][2] = 1.f / (1.f + __expf(-lg.z)); sc[t][3] = 1.f / (1.f + __expf(-lg.w));
        s[t][0] = sc[t][0] + bias.x; s[t][1] = sc[t][1] + bias.y; s[t][2] = sc[t][2] + bias.z; s[t][3] = sc[t][3] + bias.w;
    }
    const int grp = lane >> 3;
#pragma unroll
    for (int t = 0; t < T; ++t) {
        float m1 = fmaxf(s[t][0], s[t][1]), m2 = fminf(s[t][0], s[t][1]); top2_merge(m1, m2, fmaxf(s[t][2], s[t][3]), fminf(s[t][2], s[t][3]));
        { const float b1 = dppf<0xB1>(m1), b2 = dppf<0xB1>(m2); top2_merge(m1, m2, b1, b2); }
        { const float b1 = dppf<0x4E>(m1), b2 = dppf<0x4E>(m2); top2_merge(m1, m2, b1, b2); }
        { const float b1 = dppf<0x141>(m1), b2 = dppf<0x141>(m2); top2_merge(m1, m2, b1, b2); }
        const float gs = m1 + m2; int rank = 0;
#pragma unroll
        for (int gq = 0; gq < 8; ++gq) { const float og = rdlane(gs, gq * 8); rank += (og > gs || (og == gs && gq < grp)) ? 1 : 0; }
        const bool out = rank >= 4;
        s[t][0] = out ? NEG : s[t][0]; s[t][1] = out ? NEG : s[t][1]; s[t][2] = out ? NEG : s[t][2]; s[t][3] = out ? NEG : s[t][3];
    }
    float wsum[T], myw[T]; int mye[T];
#pragma unroll
    for (int t = 0; t < T; ++t) { wsum[t] = 0.f; myw[t] = 0.f; mye[t] = 0; }
#pragma unroll
    for (int k = 0; k < TOPK; ++k) {
#pragma unroll
        for (int t = 0; t < T; ++t) {
            float bv = s[t][0]; int bi = 0;
            { const bool c1 = s[t][1] > bv; bi = c1 ? 1 : bi; bv = c1 ? s[t][1] : bv; const bool c2 = s[t][2] > bv; bi = c2 ? 2 : bi; bv = c2 ? s[t][2] : bv; const bool c3 = s[t][3] > bv; bi = c3 ? 3 : bi; bv = c3 ? s[t][3] : bv; }
            const float bsc = bi == 0 ? sc[t][0] : (bi == 1 ? sc[t][1] : (bi == 2 ? sc[t][2] : sc[t][3]));
            float m = fmaxf(bv, dppf<0xB1>(bv)); m = fmaxf(m, dppf<0x4E>(m)); m = fmaxf(m, dppf<0x141>(m)); m = fmaxf(m, dppf<0x140>(m));
            const float wm = fmaxf(fmaxf(rdlane(m, 0), rdlane(m, 16)), fmaxf(rdlane(m, 32), rdlane(m, 48)));
            const unsigned long long bal = __ballot(bv == wm);
            const int wl = __ffsll((long long)bal) - 1;
            const int be = wl * 4 + __builtin_amdgcn_readlane(bi, wl);
            const float wsel = rdlane(bsc, wl);
            const bool mine = (lane == wl);
            s[t][0] = (mine && bi == 0) ? NEG : s[t][0]; s[t][1] = (mine && bi == 1) ? NEG : s[t][1]; s[t][2] = (mine && bi == 2) ? NEG : s[t][2]; s[t][3] = (mine && bi == 3) ? NEG : s[t][3];
            wsum[t] += wsel;
            myw[t] = (lane == k) ? wsel : myw[t]; mye[t] = (lane == k) ? be : mye[t];
        }
    }
#pragma unroll
    for (int t = 0; t < T; ++t) if (lane < TOPK) { const int tok = tok0 + t * tstride; topk_e[tok * TOPK + lane] = mye[t]; topk_w[tok * TOPK + lane] = myw[t] / wsum[t] * 2.5f; __hip_atomic_fetch_add(&hist[mye[t]], 1u, __ATOMIC_RELAXED, __HIP_MEMORY_SCOPE_WORKGROUP); }
}
__device__ __forceinline__ void build_tables(const unsigned* ctl, LAS unsigned* tab, const int tid) {
    if (tid < 64) {
        const int lane = tid;
        unsigned c[4], so = 0, st = 0;
#pragma unroll
        for (int j = 0; j < 4; ++j) { c[j] = __hip_atomic_load(ctl + CW_COUNT + lane * 4 + j, __ATOMIC_RELAXED, __HIP_MEMORY_SCOPE_AGENT); so += c[j]; st += (c[j] + 255u) >> 8; }
        unsigned io = so, it = st;
#pragma unroll
        for (int o = 1; o < 64; o <<= 1) { const unsigned a = __shfl_up(io, o), b = __shfl_up(it, o); if (lane >= o) { io += a; it += b; } }
        unsigned eo = io - so, et = it - st;
#pragma unroll
        for (int j = 0; j < 4; ++j) { tab[T_CNT + lane * 4 + j] = c[j]; tab[T_OFF + lane * 4 + j] = eo; tab[T_TILE + lane * 4 + j] = et; eo += c[j]; et += (c[j] + 255u) >> 8; }
        if (lane == 63) { tab[T_OFF + NE] = eo; tab[T_TILE + NE] = et; }
    }
    __syncthreads();
}
struct RowRaw { u32x4 y[9]; u32x4 t[2]; f32x2 st; };
__device__ __forceinline__ void final_load(RowRaw& R, const bf16_t* __restrict__ tb, const unsigned char* __restrict__ ybuf, const unsigned char* __restrict__ ysh, const float* __restrict__ stats, int row, int lane) {
    const int c0 = lane * 16;
#pragma unroll
    for (int k = 0; k < TOPK; ++k) R.y[k] = *(const u32x4*)(ybuf + ((size_t)row * TOPK + k) * D + c0);
    R.y[8] = *(const u32x4*)(ysh + (size_t)row * D + c0);
    R.t[0] = *(const u32x4*)(tb + (size_t)row * D + c0); R.t[1] = *(const u32x4*)(tb + (size_t)row * D + c0 + 8);
    R.st = *(const f32x2*)(stats + 2 * (size_t)row);
}
__device__ __forceinline__ void final_row(float* __restrict__ out, const RowRaw& R, const LAS float* cv  , int row, int lane) {
    asm volatile("" : "+v"(cv));
    const int c0 = lane * 16;
    f32x4 a[4], t[4], v[4]; float s = 0.f;
#pragma unroll
    for (int j = 0; j < 4; ++j) a[j] = (f32x4){0.f, 0.f, 0.f, 0.f};
#pragma unroll
    for (int k = 0; k < 9; ++k) { const unsigned w[4] = {R.y[k].x, R.y[k].y, R.y[k].z, R.y[k].w};
#pragma unroll
        for (int j = 0; j < 4; ++j) { const f32x2 lo = __builtin_amdgcn_cvt_pk_f32_fp8((int)w[j], false), hi = __builtin_amdgcn_cvt_pk_f32_fp8((int)w[j], true); a[j].x += lo.x; a[j].y += lo.y; a[j].z += hi.x; a[j].w += hi.y; } }
    unpack_t16r(R.t[0], R.t[1], t);
#pragma unroll
    for (int j = 0; j < 4; ++j) { const int col = c0 + 4 * j;
        const f32x4 x1 = (t[j] - R.st.x) * R.st.y * *(const LAS f32x4*)(cv + col) + *(const LAS f32x4*)(cv + 1024 + col);
        v[j] = x1 * ALPHA + *(const LAS f32x4*)(cv + 4096 + col) * a[j] * YINV;
        s += (v[j].x + v[j].y) + (v[j].z + v[j].w); }
    const float mean = wave_sum(s) * (1.f / D); float s2 = 0.f;
#pragma unroll
    for (int j = 0; j < 4; ++j) { v[j] = v[j] - mean; s2 += (v[j].x * v[j].x + v[j].y * v[j].y) + (v[j].z * v[j].z + v[j].w * v[j].w); }
    const float rstd = 1.f / sqrtf(wave_sum(s2) * (1.f / D) + LN_EPS);
#pragma unroll
    for (int j = 0; j < 4; ++j) { const int col = c0 + 4 * j;
        *(f32x4*)(out + (size_t)row * D + col) = v[j] * rstd * *(const LAS f32x4*)(cv + 2048 + col) + *(const LAS f32x4*)(cv + 3072 + col); }
}

#ifndef MK_PER_PHASE
#define MK_PER_PHASE 0
#endif
constexpr int N_PHASES = 13;
struct Args { Ctx X; int ph_lo, ph_hi; };
typedef __attribute__((address_space(4))) const Ctx* CtxCP;
__device__ __forceinline__ CtxCP ctx_ptr() { CtxCP p = (CtxCP)__builtin_amdgcn_kernarg_segment_ptr(); asm volatile("" : "+s"(p)); return p; }

__global__ void __launch_bounds__(NW * 64, 2) mk_fwd(Args args) {
    extern __shared__ __attribute__((aligned(16))) unsigned char lds_raw[];
    LAS unsigned char* lds = (LAS unsigned char*)lds_raw;
    LAS unsigned* tab = (LAS unsigned*)(lds + TAB_OFF);
    volatile LAS unsigned* MISC = (volatile LAS unsigned*)(lds + MISC_OFF);
#define PH_BEGIN \
    const __attribute__((address_space(4))) Ctx& X = *ctx_ptr(); unsigned char* ws = X.ws; (void)ws; \
    const int lane = lane_id(), wave = wave0, tid = wave0 * 64 + lane; (void)lane; (void)wave; (void)tid; \
    const int G = gridDim.x, bx = blockIdx.x; (void)G; (void)bx; \
    const int gw = bx * NW + wave, NGW = G * NW; (void)gw; (void)NGW; \
    const int gt = bx * (NW * 64) + tid, NGT = G * NW * 64; (void)gt; (void)NGT; \
    unsigned* ctl = (unsigned*)(ws + WS_CTL); float* mod = (float*)(ws + WS_MOD); float* rope = (float*)(ws + WS_ROPE); (void)ctl; (void)mod; (void)rope; \
    bf16_t* win_t = (bf16_t*)(ws + WS_WIN_T); bf16_t* wout_t = (bf16_t*)(ws + WS_WOUT_T); bf16_t* wr_t = (bf16_t*)(ws + WS_WR_T); (void)win_t; (void)wout_t; (void)wr_t; \
    bf16_t* wsgu_t = (bf16_t*)(ws + WS_WSGU_T); bf16_t* wsd_t = (bf16_t*)(ws + WS_WSD_T); bf16_t* wd_t = (bf16_t*)(ws + WS_WD_T); bf16_t* wgu_t = (bf16_t*)(ws + WS_WGU_T); (void)wsgu_t; (void)wsd_t; (void)wd_t; (void)wgu_t; \
    int* slot_ent = (int*)(ws + WS_SLOT_ENT); float* slot_w = (float*)(ws + WS_SLOT_W); int* topk_e = (int*)(ws + WS_TOPK_E); float* topk_w = (float*)(ws + WS_TOPK_W); (void)slot_ent; (void)slot_w; (void)topk_e; (void)topk_w; \
    bf16_t* ymix = (bf16_t*)(ws + WS_YMIX); bf16_t* proj = (bf16_t*)(ws + WS_PROJ); bf16_t* hbuf = (bf16_t*)(ws + WS_YMIX); (void)ymix; (void)proj; (void)hbuf; \
    float* logits = (float*)(ws + WS_LOGITS); bf16_t* shh = (bf16_t*)(ws + WS_SHH); bf16_t* hf = (bf16_t*)(ws + WS_HF); bf16_t* act = (bf16_t*)(ws + WS_ACT); (void)logits; (void)shh; (void)hf; (void)act; \
    unsigned char* ybuf = ws + WS_YBUF; float* out = X.out; (void)ybuf; (void)out;

    const int wave0 = __builtin_amdgcn_readfirstlane((int)threadIdx.x >> 6);
    for (int u = threadIdx.x; u < (LDS_BYTES - MISC_OFF) / 4; u += NW * 64) ((LAS unsigned*)(lds + MISC_OFF))[u] = 0u;
    __syncthreads();
    if (!MK_PER_PHASE) { unsigned* ctl0 = (unsigned*)(args.X.ws + WS_CTL); (void)xcd_barrier_post(ctl0 + CW_BAR, MISC + 8, wave0 == 0 && lane_id() == 0); }
    const int lo = args.ph_lo, hi = args.ph_hi;
#ifndef MK_DUP
#define MK_DUP -1
#endif
#define REPS(k) for (int _rep = 0; _rep < ((MK_DUP == (k)) ? 2 : 1); ++_rep)
#ifdef MK_ONLY
#define IN(k) ((k) == MK_ONLY)
#else
#define IN(k) (lo <= (k) && (k) < hi)
#endif
#define SEAM(k) SEAM2(k, (k) + 1)
#define SEAM2(k, k2) do { if (IN(k) && IN(k2)) { XcdBarrier _b; _b.bar = (unsigned*)(ctx_ptr()->ws + WS_CTL) + CW_BAR; _b.x = xb_xcc_id(); _b.st = (volatile LAS unsigned*)(lds + MISC_OFF) + 8; xcd_barrier(_b, wave0 == 0 && lane_id() == 0); } } while (0)

    REPS(0) if (IN(0)) { PH_BEGIN
        LAS float* scr = (LAS float*)(lds + wave * 16384);
        float* modp = (float*)(ws + WS_PROJ);
        for (int t = gw; t < 96 * 16; t += NGW) mod_task(X.c, X.w_ada, modp, t, lane);
        constexpr int I_IN = (D / 64) * (DIN / 32), I_OUT = (D / 64) * (D / 32), I_R = (D / 64) * (NE / 32), I_SG = (D / 64) * (DE / 32), I_SD = (DE / 64) * (D / 32);
        constexpr int I_EG = I_SG, I_ED = I_SD;
        constexpr int N_SMALL = I_IN + I_OUT + I_R + 2 * I_SG + I_SD;
        constexpr int N_ITEMS = N_SMALL + NE * (2 * I_EG + I_ED);
        for (int it = gw; it < N_ITEMS; it += NGW) {
            int r = it;
            if (r < I_IN) { transpose_item(X.w_in, D, DIN, win_t, 0, 0, scr, r, lane); continue; } r -= I_IN;
            if (r < I_OUT) { transpose_item(X.w_out, D, D, wout_t, 0, 0, scr, r, lane); continue; } r -= I_OUT;
            if (r < I_R) { transpose_item(X.w_router, D, NE, wr_t, 0, 0, scr, r, lane); continue; } r -= I_R;
            if (r < I_SG) { transpose_item(X.ws_gate, D, DE, wsgu_t, 8, 0, scr, r, lane); continue; } r -= I_SG;
            if (r < I_SG) { transpose_item(X.ws_up, D, DE, wsgu_t, 8, 1, scr, r, lane); continue; } r -= I_SG;
            if (r < I_SD) { transpose_item(X.ws_down, DE, D, wsd_t, 0, 0, scr, r, lane); continue; } r -= I_SD;
            const int e = r / (2 * I_EG + I_ED); r -= e * (2 * I_EG + I_ED);
            if (r < I_EG) { transpose_item_fp8(X.w_gate + (size_t)e * D * DE, D, DE, (unsigned char*)wgu_t + (size_t)e * 512 * D, 8, 0, S_WGU8, scr, r, lane); continue; } r -= I_EG;
            if (r < I_EG) { transpose_item_fp8(X.w_up + (size_t)e * D * DE, D, DE, (unsigned char*)wgu_t + (size_t)e * 512 * D, 8, 1, S_WGU8, scr, r, lane); continue; } r -= I_EG;
            transpose_item_fp8(X.w_down + (size_t)e * DE * D, DE, D, (unsigned char*)wd_t + (size_t)e * D * DE, 0, 0, S_WD8, scr, r, lane);
        }
        for (int i = gt; i < SEQ * 64; i += NGT) rope_entry(rope, i);
    }
    SEAM(0);
    REPS(1) if (IN(1)) { PH_BEGIN
        const float* modp = (const float*)(ws + WS_PROJ);
        for (int i = gt; i < 32 * 6144; i += NGT) mod[i] = mod_sum(modp, X.b_ada, i / 6144, i % 6144);
        LAS float* ssc = (LAS float*)lds; LAS float* ssh = ssc + 1024;
        int curb = -1;
        for (int c = bx; c < M / 256; c += G) {
            const int b = c >> 3;
            if (b != curb) {
                __syncthreads();
                for (int i = tid; i < 1024; i += NW * 64) { ssc[i] = 1.f + mod_sum(modp, X.b_ada, b, MOD_SCALE_A + i); ssh[i] = mod_sum(modp, X.b_ada, b, MOD_SHIFT_A + i); }
                __syncthreads();
                curb = b;
            }
            const f32x4 sc = *(const LAS f32x4*)(ssc + (tid & 255) * 4), sh = *(const LAS f32x4*)(ssh + (tid & 255) * 4);
            const float* xp = X.x + (size_t)c * 256 * D + (size_t)(tid >> 8) * D + (tid & 255) * 4;
            bf16_t* hp = hbuf + (size_t)c * 256 * D + (size_t)(tid >> 8) * D + (tid & 255) * 4;
            for (int i0 = 0; i0 < 128; i0 += 8) {
                f32x4 v[8];
#pragma unroll
                for (int i = 0; i < 8; ++i) v[i] = __builtin_nontemporal_load((const f32x4*)(xp + (size_t)(i0 + i) * 2 * D));
#pragma unroll
                for (int i = 0; i < 8; ++i) { u32x2 o; o.x = pk2(v[i].x * sc.x + sh.x, v[i].y * sc.y + sh.y); o.y = pk2(v[i].z * sc.z + sh.z, v[i].w * sc.w + sh.w); *(u32x2*)(hp + (size_t)(i0 + i) * 2 * D) = o; }
            }
        }
        __syncthreads();
    }
    SEAM(1);
    REPS(2) if (IN(2)) { PH_BEGIN
        pg8::DenseOrder S; S.init(M, DIN, D, win_t, G, bx);
        pg8::EpiInProj E{proj};
        pg8::gemm_phase(lds, (const char*)hbuf, D, S, E, tid);
    }
    SEAM(2);
    REPS(3) if (IN(3)) { PH_BEGIN
        REPS(31) for (int hu = bx; hu < BATCH * 4 * 2; hu += G) ret::unit(proj, rope, X.ret_ld, X.ret_gn, ymix, (unsigned char*)out + (size_t)hu * (8 * ret::TILE), lds, hu, tid);
        REPS(32) for (int u = bx; u < BATCH * 8; u += G) na::unit(proj, X.na_rpb, ymix, lds, u, tid);
    }
    SEAM2(3, 5);
    REPS(5) if (IN(5)) { PH_BEGIN
        pg8::DenseOrder S; S.init(M, D, D, wout_t, G, bx);
        pg8::EpiOutProj E{X.x, mod, (bf16_t*)(ws + WS_TB)};
        pg8::gemm_phase(lds, (const char*)ymix, D, S, E, tid);
    }
    SEAM(5);
    REPS(6) if (IN(6)) { PH_BEGIN
        LAS float* cv = (LAS float*)lds; int curb = -1;
        for (int c = bx; c < M / 256; c += G) {
            const int b = c >> 3;
            if (b != curb) {
                __syncthreads();
                if (tid < 256) { const int i = tid * 4; *(LAS f32x4*)(cv + i) = *(const f32x4*)(X.ln1_g + i); *(LAS f32x4*)(cv + 1024 + i) = *(const f32x4*)(X.ln1_b + i);
                    *(LAS f32x4*)(cv + 2048 + i) = *(const f32x4*)(mod + b * 6144 + MOD_SCALE_F + i) + 1.f; *(LAS f32x4*)(cv + 3072 + i) = *(const f32x4*)(mod + b * 6144 + MOD_SHIFT_F + i); }
                __syncthreads(); curb = b;
            }
            const bf16_t* tp = (const bf16_t*)(ws + WS_TB) + (size_t)(c * 256 + wave * 32) * D + lane * 16;
            u32x4 ra = *(const u32x4*)tp, rb = *(const u32x4*)(tp + 8);
#pragma unroll 1
            for (int i = 0; i < 32; ++i) {
                const u32x4 ca = ra, cb = rb; const int nx = i < 31 ? i + 1 : i;
                ra = *(const u32x4*)(tp + (size_t)nx * D); rb = *(const u32x4*)(tp + (size_t)nx * D + 8);
                ln1_row(ca, cb, cv, hf, ws + WS_HF8, (float*)(ws + WS_STATS), c * 256 + wave * 32 + i, lane);
            }
        }
        __syncthreads();
    }
    SEAM(6);
    REPS(7) if (IN(7)) { PH_BEGIN
        { pg8::DenseOrder S; S.init(M, NE, D, wr_t, G, bx); pg8::EpiRouter E{logits}; pg8::gemm_phase(lds, (const char*)hf, D, S, E, tid); }
        { pg8::DenseOrder S; S.init(M, 2 * DE, D, wsgu_t, G, bx); pg8::EpiGU<false> E{(void*)shh}; pg8::gemm_phase(lds, (const char*)hf, D, S, E, tid); }
    }
    SEAM(7);
    if (IN(8)) { PH_BEGIN
        LAS unsigned* hist = tab + T_HIST;
        if (tid < NE) hist[tid] = 0u;
        __syncthreads();
        const f32x4 bias = *(const f32x4*)(X.rbias + lane * 4);
        { int tok = gw;
          for (; tok + 3 * NGW < M; tok += 4 * NGW) route_tokens<4>(logits, bias, topk_e, topk_w, hist, tok, NGW, lane);
          for (; tok < M; tok += NGW) route_tokens<1>(logits, bias, topk_e, topk_w, hist, tok, NGW, lane); }
        __syncthreads();
        if (tid < NE && hist[tid]) atomicAdd(&ctl[CW_COUNT + tid], hist[tid]);
#if MK_DUP == 8
        __syncthreads();
        { int tok = gw;
          for (; tok + 3 * NGW < M; tok += 4 * NGW) route_tokens<4>(logits, bias, topk_e, topk_w, tab + T_BASE, tok, NGW, lane);
          for (; tok < M; tok += NGW) route_tokens<1>(logits, bias, topk_e, topk_w, tab + T_BASE, tok, NGW, lane); }
        __syncthreads();
#endif
    }
    SEAM(8);
    if (IN(9)) { PH_BEGIN
        build_tables(ctl, tab, tid);
        LAS unsigned* hist = tab + T_HIST; LAS unsigned* base = tab + T_BASE;
        for (int c0 = bx * 2048; c0 < NSLOT; c0 += G * 2048) {
            __syncthreads();
            if (tid < NE) hist[tid] = 0u;
            __syncthreads();
            int e[4]; unsigned loc[4];
#pragma unroll
            for (int i = 0; i < 4; ++i) { const int idx = c0 + i * 512 + tid; e[i] = topk_e[idx]; loc[i] = __hip_atomic_fetch_add(&hist[e[i]], 1u, __ATOMIC_RELAXED, __HIP_MEMORY_SCOPE_WORKGROUP); }
            __syncthreads();
            if (tid < NE && hist[tid]) base[tid] = atomicAdd(&ctl[CW_CURSOR + tid], hist[tid]);
            __syncthreads();
#pragma unroll
            for (int i = 0; i < 4; ++i) { const int idx = c0 + i * 512 + tid; const unsigned pos = tab[T_OFF + e[i]] + base[e[i]] + loc[i]; slot_ent[pos] = idx; slot_w[pos] = topk_w[idx]; }
        }
    }
    SEAM(9);
    if (IN(10)) { PH_BEGIN
        build_tables(ctl, tab, tid);
        REPS(10) { pg8::ExpertOrder<2, true> S; S.init(tab, D, wgu_t, (size_t)512 * D, slot_ent, slot_w, G, bx); pg8::EpiGU<true> E{(void*)act}; pg8::gemm_phase<1>(lds, (const char*)(ws + WS_HF8), D, S, E, tid); }
        { pg8::DenseOrder S; S.init(M, D, DE, wsd_t, G, bx); pg8::EpiSharedDown E{ws + WS_YSH}; pg8::gemm_phase(lds, (const char*)shh, DE, S, E, tid); }
    }
    SEAM(10);
    REPS(11) if (IN(11)) { PH_BEGIN
        build_tables(ctl, tab, tid);
        pg8::ExpertOrder<4, false> S; S.init(tab, DE, wd_t, (size_t)D * DE, slot_ent, slot_w, G, bx); pg8::EpiExpDown E{ybuf, slot_ent}; pg8::gemm_phase<1>(lds, (const char*)act, DE, S, E, tid);
#if MK_DUP == 111
        { pg8::ExpertOrder<4, false> S2; S2.init(tab, DE, wd_t, (size_t)D * DE, slot_ent, slot_w, G, bx); pg8::EpiProbeSum E2{(float*)(ws + WS_STATS)}; pg8::gemm_phase<1>(lds, (const char*)act, DE, S2, E2, tid); }
#endif
    }
    SEAM(11);
    REPS(12) if (IN(12)) { PH_BEGIN
        LAS float* cv = (LAS float*)lds; int curb = -1;
        for (int c = bx; c < M / 256; c += G) {
            const int b = c >> 3;
            if (b != curb) {
                __syncthreads();
                if (tid < 256) { const int i = tid * 4; *(LAS f32x4*)(cv + i) = *(const f32x4*)(X.ln1_g + i); *(LAS f32x4*)(cv + 1024 + i) = *(const f32x4*)(X.ln1_b + i);
                    *(LAS f32x4*)(cv + 2048 + i) = *(const f32x4*)(X.ln2_g + i); *(LAS f32x4*)(cv + 3072 + i) = *(const f32x4*)(X.ln2_b + i); *(LAS f32x4*)(cv + 4096 + i) = *(const f32x4*)(mod + b * 6144 + MOD_GATE_F + i); }
                __syncthreads(); curb = b;
            }
            const int r0 = c * 256 + wave * 32;
            RowRaw nx; final_load(nx, (const bf16_t*)(ws + WS_TB), ybuf, ws + WS_YSH, (const float*)(ws + WS_STATS), r0, lane);
#pragma unroll 1
            for (int i = 0; i < 32; ++i) {
                const RowRaw cur = nx;
                final_load(nx, (const bf16_t*)(ws + WS_TB), ybuf, ws + WS_YSH, (const float*)(ws + WS_STATS), r0 + (i < 31 ? i + 1 : i), lane);
                final_row(out, cur, cv, r0 + i, lane);
            }
        }
    }
#undef IN
#undef SEAM
}

extern "C" void kernel_launch(void* const* d_in, const int* in_sizes, int n_in, void* d_out, int out_size, void* d_ws, size_t ws_size, hipStream_t stream) {
    static int grid = 0;
    if (grid == 0) {
        if (n_in != 21 || in_sizes[0] != M * D || out_size != M * D || ws_size < WS_END) { fprintf(stderr, "kernel_launch: unexpected shapes (n_in %d, ws %zu)\n", n_in, ws_size); grid = -1; return; }
        int dev = 0, cus = 0, per_cu = 0;
        if (hipGetDevice(&dev) != hipSuccess || hipDeviceGetAttribute(&cus, hipDeviceAttributeMultiprocessorCount, dev) != hipSuccess) { grid = -1; return; }
        if (hipFuncSetAttribute((const void*)mk_fwd, hipFuncAttributeMaxDynamicSharedMemorySize, LDS_BYTES) != hipSuccess) { fprintf(stderr, "kernel_launch: hipFuncSetAttribute failed\n"); grid = -1; return; }
        if (hipOccupancyMaxActiveBlocksPerMultiprocessor(&per_cu, (const void*)mk_fwd, NW * 64, LDS_BYTES) != hipSuccess || per_cu < 1) { fprintf(stderr, "kernel_launch: occupancy query says %d\n", per_cu); }
        (void)hipGetLastError();
        grid = cus;
    }
    if (grid < 0) return;
    (void)hipMemsetAsync((char*)d_ws + WS_CTL, 0, 1 * MiB, stream);
    Args a{};
    const float** p = (const float**)&a.X;
    for (int i = 0; i < 21; ++i) p[i] = (const float*)d_in[i];
    a.X.out = (float*)d_out; a.X.ws = (unsigned char*)d_ws;
#if MK_PER_PHASE
    for (int ph = 0; ph < N_PHASES; ++ph) { a.ph_lo = ph; a.ph_hi = ph + 1; hipLaunchKernelGGL(mk_fwd, dim3(grid), dim3(NW * 64), LDS_BYTES, stream, a); }
#else
    a.ph_lo = 0; a.ph_hi = N_PHASES;
    hipLaunchKernelGGL(mk_fwd, dim3(grid), dim3(NW * 64), LDS_BYTES, stream, a);
#endif
}
```

```cpp
#include <hip/hip_runtime.h>
#include <cstdio>
#include <cstdint>

typedef unsigned short bf16_t;
typedef short bf16x8 __attribute__((ext_vector_type(8)));
typedef float f32x4 __attribute__((ext_vector_type(4)));
typedef float f32x2 __attribute__((ext_vector_type(2)));
typedef unsigned u32x4 __attribute__((ext_vector_type(4)));
typedef unsigned u32x2 __attribute__((ext_vector_type(2)));
#define LAS __attribute__((address_space(3)))

constexpr int D = 1024, BATCH = 32, SEQ = 2048, M = BATCH * SEQ;
constexpr int DIN = 3584;
constexpr int OFF_QNA = 0, OFF_KNA = 512, OFF_VNA = 1024, OFF_QR = 1536, OFF_KR = 2048, OFF_VR = 2560, OFF_GR = 3072;
constexpr int NE = 256, TOPK = 8, DE = 256;
constexpr int NSLOT = M * TOPK;
constexpr float LN_EPS = 1e-5f, GN_EPS = 1e-6f;
constexpr float ALPHA = 1.189207115002721f;
constexpr float YSCALE = 64.f, YINV = 1.f / 64.f;
constexpr float S_HF8 = 16.f, S_WGU8 = 256.f, S_ACT8 = 32.f, S_WD8 = 128.f;
constexpr float INV_GU8 = 1.f / (16.f * 256.f), INV_DN8 = 1.f / (32.f * 128.f);
constexpr int MOD_SHIFT_A = 0, MOD_SCALE_A = 1024, MOD_GATE_A = 2048, MOD_SHIFT_F = 3072, MOD_SCALE_F = 4096, MOD_GATE_F = 5120;

constexpr size_t MiB = 1u << 20;
constexpr size_t WS_CTL = 0;
constexpr size_t WS_MOD = 1 * MiB;
constexpr size_t WS_ROPE = 2 * MiB;
constexpr size_t WS_WIN_T = 4 * MiB;
constexpr size_t WS_WOUT_T = 11 * MiB;
constexpr size_t WS_WR_T = 13 * MiB;
constexpr size_t WS_WSGU_T = 14 * MiB;
constexpr size_t WS_WSD_T = 15 * MiB;
constexpr size_t WS_SLOT_ENT = 16 * MiB;
constexpr size_t WS_SLOT_W = 18 * MiB;
constexpr size_t WS_TOPK_E = 20 * MiB;
constexpr size_t WS_TOPK_W = 22 * MiB;
constexpr size_t WS_STATS = 24 * MiB;
constexpr size_t WS_WD_T = 32 * MiB;
constexpr size_t WS_WGU_T = 160 * MiB;
constexpr size_t WS_HF8 = 288 * MiB;
constexpr size_t WS_YMIX = 416 * MiB;
constexpr size_t WS_PROJ = 544 * MiB;
constexpr size_t WS_LOGITS = WS_YMIX, WS_SHH = WS_YMIX + 64 * MiB;
constexpr size_t WS_HF = WS_PROJ, WS_ACT = WS_PROJ + 128 * MiB;
constexpr size_t WS_YBUF = WS_WGU_T;
constexpr size_t WS_TB = WS_PROJ + 256 * MiB;
constexpr size_t WS_YSH = WS_PROJ + 384 * MiB;
constexpr size_t WS_END = 992 * MiB;
constexpr int CW_COUNT = 1024, CW_CURSOR = 1536, CW_BAR = 8192;

constexpr int RING_BYTES = 131072;
constexpr int TAB_OFF = RING_BYTES;
constexpr int T_OFF = 0, T_TILE = 260, T_CNT = 520, T_HIST = 776, T_BASE = 1032, TAB_WORDS = 1288;
constexpr int VN_OFF = TAB_OFF + 6144;
constexpr int ROWTAB_OFF = VN_OFF + 8192;
constexpr int PHASE_BYTES = 155648;
constexpr int MISC_OFF = PHASE_BYTES;
constexpr int LDS_BYTES = PHASE_BYTES + 256;
static_assert(TAB_WORDS * 4 <= 6144 && ROWTAB_OFF + 6144 <= PHASE_BYTES && LDS_BYTES <= 163840, "LDS map");

__device__ __forceinline__ unsigned f2bf(float f) { unsigned u = __float_as_uint(f); return (u + 0x7fffu + ((u >> 16) & 1u)) >> 16; }
__device__ __forceinline__ float bf2f(unsigned short h) { return __uint_as_float(((unsigned)h) << 16); }
__device__ __forceinline__ unsigned pk2(float lo, float hi) { return f2bf(lo) | (f2bf(hi) << 16); }
__device__ __forceinline__ unsigned cvt_pk_bf16(float lo, float hi) { unsigned r; asm volatile("v_cvt_pk_bf16_f32 %0, %1, %2" : "=v"(r) : "v"(lo), "v"(hi)); return r; }
__device__ __forceinline__ float silu_f(float v) { return v * __builtin_amdgcn_rcpf(1.f + __expf(-v)); }
__device__ __forceinline__ float wave_sum(float v) {
    v += __builtin_bit_cast(float, __builtin_amdgcn_update_dpp(0, __builtin_bit_cast(int, v), 0xB1, 0xf, 0xf, true));
    v += __builtin_bit_cast(float, __builtin_amdgcn_update_dpp(0, __builtin_bit_cast(int, v), 0x4E, 0xf, 0xf, true));
    v += __builtin_bit_cast(float, __builtin_amdgcn_update_dpp(0, __builtin_bit_cast(int, v), 0x141, 0xf, 0xf, true));
    v += __builtin_bit_cast(float, __builtin_amdgcn_update_dpp(0, __builtin_bit_cast(int, v), 0x140, 0xf, 0xf, true));
    const int b = __builtin_bit_cast(int, v);
    return (__builtin_bit_cast(float, __builtin_amdgcn_readlane(b, 0)) + __builtin_bit_cast(float, __builtin_amdgcn_readlane(b, 16))) + (__builtin_bit_cast(float, __builtin_amdgcn_readlane(b, 32)) + __builtin_bit_cast(float, __builtin_amdgcn_readlane(b, 48)));
}
__device__ __forceinline__ float clamp8(float v) { return __builtin_amdgcn_fmed3f(v, -440.f, 440.f); }
#define LDS_WAIT() asm volatile("s_waitcnt lgkmcnt(0)" ::: "memory")
__device__ __forceinline__ int lane_id() { return (int)__builtin_amdgcn_mbcnt_hi(~0u, __builtin_amdgcn_mbcnt_lo(~0u, 0u)); }

#define XB_TMO      128
#define XB_XCNT(j)  (256  + 64 * (j))
#define XB_XSUB(j)  (1280 + 64 * (j))
#define XB_XGEN(j)  (2304 + 64 * (j))
#define XB_TOP      3328
#define XB_TOPGEN   3392
#define XCD_BAR_WORDS 3456
#define XB_SPIN_CAP (1u << 23)
__device__ __forceinline__ unsigned xb_ld(unsigned* p)              { return __hip_atomic_load(p, __ATOMIC_RELAXED, __HIP_MEMORY_SCOPE_AGENT); }
__device__ __forceinline__ unsigned xb_add(unsigned* p, unsigned v) { return __hip_atomic_fetch_add(p, v, __ATOMIC_RELAXED, __HIP_MEMORY_SCOPE_AGENT); }
__device__ __forceinline__ unsigned xb_xcc_id() { return (unsigned)__builtin_amdgcn_s_getreg((3 << 11) | 20) & 0xFu; }
#define XB_SPIN(cond, bar) do { unsigned _sp = 0; while (cond) { __builtin_amdgcn_s_sleep(1); \
    if ((++_sp & 255u) == 0u) { if (xb_ld(&(bar)[XB_TMO])) break; if (_sp > XB_SPIN_CAP) { atomicAdd(&(bar)[XB_TMO], 1u); break; } } } } while (0)
struct XcdBarrier { unsigned* bar; unsigned x; volatile LAS unsigned* st; };
__device__ __forceinline__ XcdBarrier xcd_barrier_post(unsigned* bar, volatile LAS unsigned* st, bool leader) {
    XcdBarrier b; b.bar = bar; b.x = xb_xcc_id(); b.st = st;
    if (leader) (void)xb_add(&bar[XB_XCNT(b.x)], 1u);
    return b;
}
__device__ __forceinline__ void xcd_barrier_complete(unsigned* bar, unsigned x, unsigned& nloc, unsigned& nx) {
    const unsigned G = gridDim.x * gridDim.y * gridDim.z;
    unsigned sum, cnt, mine, sp = 0u;
    for (;;) {
        sum = 0u; cnt = 0u; mine = 0u;
#pragma unroll
        for (unsigned j = 0; j < 16; ++j) { const unsigned c = xb_ld(&bar[XB_XCNT(j)]); sum += c; cnt += (c > 0u) ? 1u : 0u; mine = (j == x) ? c : mine; }
        if (sum == G) break;
        __builtin_amdgcn_s_sleep(1);
        if ((++sp & 255u) == 0u) { if (xb_ld(&bar[XB_TMO])) break; if (sp > XB_SPIN_CAP) { atomicAdd(&bar[XB_TMO], 1u); break; } }
    }
    nloc = mine > 0u ? mine : 1u; nx = cnt > 0u ? cnt : 1u;
}
__device__ __forceinline__ void xcd_barrier(const XcdBarrier& b, bool leader) {
    asm volatile("s_waitcnt vmcnt(0)" ::: "memory");
    __syncthreads();
    if (leader) {
        unsigned* bar = b.bar;
        __builtin_amdgcn_s_waitcnt(0);
        unsigned nloc = b.st[0], nx = b.st[1];
        if (nloc == 0u) { xcd_barrier_complete(bar, b.x, nloc, nx); b.st[0] = nloc; b.st[1] = nx; }
        const unsigned old = xb_add(&bar[XB_XSUB(b.x)], 1u);
        const unsigned gen = old / nloc;
        if (old + 1u == (gen + 1u) * nloc) {
            __builtin_amdgcn_fence(__ATOMIC_RELEASE, "agent");
            asm volatile("s_waitcnt vmcnt(0)" ::: "memory");
            const unsigned og = xb_add(&bar[XB_TOP], 1u);
            const unsigned tg = og / nx;
            if (og + 1u == (tg + 1u) * nx) xb_add(&bar[XB_TOPGEN], 1u);
            else XB_SPIN(xb_ld(&bar[XB_TOPGEN]) == tg, bar);
            __builtin_amdgcn_fence(__ATOMIC_ACQUIRE, "agent");
            xb_add(&bar[XB_XGEN(b.x)], 1u);
            asm volatile("s_waitcnt vmcnt(0)" ::: "memory");
        } else {
            XB_SPIN(xb_ld(&bar[XB_XGEN(b.x)]) == gen, bar);
            __builtin_amdgcn_fence(__ATOMIC_ACQUIRE, "agent");
            asm volatile("s_waitcnt vmcnt(0)" ::: "memory");
        }
    }
    __syncthreads();
}

namespace pg8 {
constexpr int BM = 256, BK = 64, HALF = 128, HTB = HALF * BK * 2, STAGE_BYTES = 8 * HTB;
__device__ __forceinline__ int lds_byte(int r, int c) { const int st = (r >> 4) * 2 + (c >> 5), rr = r & 15, cc = c & 31, ob = rr * 64 + cc * 2; return st * 1024 + (ob ^ (((ob >> 9) & 1) << 5)); }
__device__ __forceinline__ void stage_rc(int b, int& R, int& C) { const int st = b / 1024, sb = b % 1024, swz = sb ^ (((sb >> 9) & 1) << 5); R = (st >> 1) * 16 + swz / 64; C = (st & 1) * 32 + (swz % 64) / 2; }
__device__ __forceinline__ int perm32(int rho) { const int n = rho >> 4, i = rho & 15; return 8 * (i >> 2) + 4 * n + (i & 3); }

typedef int i32x8 __attribute__((ext_vector_type(8)));
__device__ __forceinline__ i32x8 cat8(const bf16x8 lo, const bf16x8 hi) { const u32x4 a = __builtin_bit_cast(u32x4, lo), b = __builtin_bit_cast(u32x4, hi); return (i32x8){(int)a.x, (int)a.y, (int)a.z, (int)a.w, (int)b.x, (int)b.y, (int)b.z, (int)b.w}; }
struct Unit { int pm, pn; const char* B; int e, cnt, off; };

template <int ESZ = 2, class Epi, class Sched>
__device__ __forceinline__ void gemm_phase(LAS unsigned char* lds, const char* Abase, const int K, const Sched& S, const Epi& E, const int tid_in) {
    int tid_ = tid_in; asm volatile("" : "+v"(tid_));
    const int tid = tid_, wid = __builtin_amdgcn_readfirstlane(tid >> 6), lane = tid & 63, wr = wid >> 2, wc = wid & 3, fr = lane & 15, fq = lane >> 4;
    const int rowbytes = K * ESZ, nt = rowbytes / 128;
    int Rr[2], Cc[2]; unsigned voffB[2], voffA[2];
#pragma unroll
    for (int i = 0; i < 2; ++i) { int R, C; stage_rc(tid * 16 + i * 8192, R, C); Rr[i] = R; Cc[i] = C; const int Rb = Epi::PERM ? (64 * (R >> 5) + 16 * ((R >> 2) & 3) + 4 * ((R >> 4) & 1) + (R & 3)) : R; voffB[i] = (unsigned)(Rb * rowbytes + C * 2); voffA[i] = (unsigned)(R * rowbytes + C * 2); }
    constexpr bool GATHER = Sched::GATHER;
    const size_t kstep = (size_t)128;
    const size_t hstep = (size_t)HALF * rowbytes;
    const size_t bhstep = (size_t)(Epi::PERM ? 8 : HALF) * rowbytes;
    const unsigned ldsw = (unsigned)wid * 1024u;
    const int aoff = (ESZ == 2) ? lds_byte(wr * 64 + fr, fq * 8) : lds_byte(wr * 64 + fr, 16 * (fq & 1)) + 1024 * (fq >> 1);
    const int boff = (ESZ == 2) ? lds_byte(wc * 32 + fr, fq * 8) : lds_byte(wc * 32 + fr, 16 * (fq & 1)) + 1024 * (fq >> 1);
#define PG8_SA(b, h) (((b) * 2 + (h)) * HTB)
#define PG8_SB(b, h) ((4 + (b) * 2 + (h)) * HTB)
#define PG8_STAGE(bufoff, gbase, voff) do { _Pragma("unroll") for (int _i = 0; _i < 2; ++_i) \
        __builtin_amdgcn_global_load_lds((const unsigned*)((const char*)(gbase) + (voff)[_i]), (LAS unsigned*)(lds + (bufoff) + ldsw + _i * 8192), 16, 0, 0); } while (0)
#define PG8_STAGEA(bufoff, uptr, koff, NEXT, h) do { if constexpr (GATHER) { if (NEXT) { const u32x2 _t = *(const LAS u32x2*)(vnslot + 2 * (h)); unsigned _v[2] = {_t.x, _t.y}; PG8_STAGE(bufoff, Abase + (koff), _v); } else { PG8_STAGE(bufoff, Abase + (koff), vc[h]); } } \
        else { PG8_STAGE(bufoff, (uptr) + (size_t)(h) * hstep + (koff), voffA); } } while (0)
#define PG8_LDA(dst, b, h) do { _Pragma("unroll") for (int m = 0; m < 4; ++m) { if constexpr (ESZ == 2) { _Pragma("unroll") for (int k = 0; k < 2; ++k) dst[m].q[k] = *(const LAS bf16x8*)(lds + PG8_SA(b, h) + aoff + m * 2048 + k * 1024); } \
        else dst[m].w = cat8(*(const LAS bf16x8*)(lds + PG8_SA(b, h) + aoff + m * 2048), *(const LAS bf16x8*)(lds + PG8_SA(b, h) + aoff + m * 2048 + 16)); } } while (0)
#define PG8_LDB(dst, b, h) do { _Pragma("unroll") for (int n = 0; n < 2; ++n) { if constexpr (ESZ == 2) { _Pragma("unroll") for (int k = 0; k < 2; ++k) dst[n].q[k] = *(const LAS bf16x8*)(lds + PG8_SB(b, h) + boff + n * 2048 + k * 1024); } \
        else dst[n].w = cat8(*(const LAS bf16x8*)(lds + PG8_SB(b, h) + boff + n * 2048), *(const LAS bf16x8*)(lds + PG8_SB(b, h) + boff + n * 2048 + 16)); } } while (0)
#define PG8_MMA(ai, bj, At, Bt) do { __builtin_amdgcn_s_setprio(1); _Pragma("unroll") for (int m = 0; m < 4; ++m) _Pragma("unroll") for (int n = 0; n < 2; ++n) { \
        if constexpr (ESZ == 2) { _Pragma("unroll") for (int k = 0; k < 2; ++k) acc[ai][bj][m][n] = __builtin_amdgcn_mfma_f32_16x16x32_bf16(Bt[n].q[k], At[m].q[k], acc[ai][bj][m][n], 0, 0, 0); } \
        else { asm volatile("v_mfma_f32_16x16x128_f8f6f4 %0, %1, %2, %0" : "+v"(acc[ai][bj][m][n]) : "v"(Bt[n].w), "v"(At[m].w)); } } \
        __builtin_amdgcn_s_setprio(0); } while (0)
#define PG8_WAIT_V(n) asm volatile("s_waitcnt vmcnt(" #n ")" ::: "memory")
#define PG8_WAIT_L(n) asm volatile("s_waitcnt lgkmcnt(" #n ")" ::: "memory")
#define PG8_BAR __builtin_amdgcn_s_barrier()
#define PG8_SCHED __builtin_amdgcn_sched_barrier(0)
    Unit cur, nxt; int ui = 0;
    if (!S.next(0, cur)) return;
    f32x4 acc[2][2][4][2];
    union Frag { bf16x8 q[2]; i32x8 w; };
    Frag At[4], B0[2], B1[2];
    unsigned vc[2][2];
    LAS unsigned* vnslot = (LAS unsigned*)(lds + (VN_OFF - 0)) + tid * 4;
    if constexpr (GATHER) S.avoff(cur, Rr, Cc, vc, tid);
    LAS unsigned* rowtab = (LAS unsigned*)(lds + ROWTAB_OFF);
    if constexpr (GATHER) S.rowtab(cur, rowtab, tid);
    const char* cB = cur.B; const char* cA = Abase + S.aoff(cur);
    PG8_STAGE(PG8_SB(0, 0), cB, voffB); PG8_STAGE(PG8_SB(0, 1), cB + bhstep, voffB); PG8_STAGEA(PG8_SA(0, 0), cA, 0, false, 0); PG8_STAGEA(PG8_SA(0, 1), cA, 0, false, 1);
    if (wr == 1) PG8_BAR;
    PG8_WAIT_V(2); PG8_BAR;
    PG8_STAGE(PG8_SB(1, 0), cB + kstep, voffB); PG8_STAGEA(PG8_SA(1, 0), cA, kstep, false, 0); PG8_STAGE(PG8_SB(1, 1), cB + bhstep + kstep, voffB);
    PG8_WAIT_V(6); PG8_BAR;
    asm volatile("" ::: "memory");
#pragma unroll
    for (int a = 0; a < 2; ++a)
#pragma unroll
        for (int b = 0; b < 2; ++b)
#pragma unroll
            for (int m = 0; m < 4; ++m)
#pragma unroll
                for (int n = 0; n < 2; ++n) { acc[a][b][m][n] = (f32x4){0.f, 0.f, 0.f, 0.f}; asm volatile("" : "+v"(acc[a][b][m][n])); }
    asm volatile("s_nop 4" ::: "memory");
    for (;;) {
        const bool has_next = S.next(ui + 1, nxt);
        if constexpr (GATHER) {
            unsigned vn[2][2];
            if (has_next) S.avoff(nxt, Rr, Cc, vn, tid);
            else {
#pragma unroll
                for (int h = 0; h < 2; ++h)
#pragma unroll
                    for (int i = 0; i < 2; ++i) vn[h][i] = vc[h][i];
            }
            *(LAS u32x4*)vnslot = (u32x4){vn[0][0], vn[0][1], vn[1][0], vn[1][1]};
            if (has_next) S.rowtab(nxt, rowtab + 512 * ((ui + 1) % 3), tid);
        }
        const char* nB = has_next ? nxt.B : cB; const char* nA = has_next ? Abase + S.aoff(nxt) : cA;
        for (int t = 0; t < nt; t += 2) {
            const bool last = (t == nt - 2);
            const size_t k1 = (size_t)(t + 1) * kstep;
            const size_t k2 = last ? (size_t)0 : (size_t)(t + 2) * kstep, k3 = k2 + kstep;
            const char* u2 = last ? nA : cA; const char* b2 = last ? nB : cB + (size_t)(t + 2) * kstep;
            const char* b3 = b2 + kstep;
            PG8_LDB(B0, 0, 0); PG8_LDB(B1, 0, 1); PG8_SCHED; PG8_LDA(At, 0, 0); PG8_STAGEA(PG8_SA(1, 1), cA, k1, false, 1);
            PG8_WAIT_V(8); PG8_WAIT_L(0); PG8_BAR; PG8_MMA(0, 0, At, B0); PG8_MMA(0, 1, At, B1); PG8_BAR; PG8_SCHED;
            PG8_LDA(At, 0, 1); PG8_STAGE(PG8_SB(0, 0), b2, voffB); PG8_STAGE(PG8_SB(0, 1), b2 + bhstep, voffB); PG8_STAGEA(PG8_SA(0, 0), u2, k2, last, 0);
            PG8_WAIT_V(8); PG8_WAIT_L(0); PG8_BAR; PG8_MMA(1, 0, At, B0); PG8_MMA(1, 1, At, B1); PG8_BAR; PG8_SCHED;
            PG8_LDB(B0, 1, 0); PG8_LDB(B1, 1, 1); PG8_SCHED; PG8_LDA(At, 1, 0); PG8_STAGEA(PG8_SA(0, 1), u2, k2, last, 1);
            PG8_WAIT_V(8); PG8_WAIT_L(0); PG8_BAR; PG8_MMA(0, 0, At, B0); PG8_MMA(0, 1, At, B1); PG8_BAR; PG8_SCHED;
            PG8_LDA(At, 1, 1); PG8_STAGE(PG8_SB(1, 0), b3, voffB); PG8_STAGE(PG8_SB(1, 1), b3 + bhstep, voffB); PG8_STAGEA(PG8_SA(1, 0), u2, k3, last, 0);
            PG8_WAIT_V(8); PG8_WAIT_L(0); PG8_BAR; PG8_MMA(1, 0, At, B0); PG8_MMA(1, 1, At, B1); PG8_BAR; PG8_SCHED;
        }
        if (wr == 0) PG8_BAR;
        if constexpr (ESZ == 1) {
            asm volatile("s_nop 15\n\ts_nop 15" ::: "memory");
#pragma unroll
            for (int a = 0; a < 2; ++a)
#pragma unroll
                for (int b = 0; b < 2; ++b)
#pragma unroll
                    for (int m = 0; m < 4; ++m) asm volatile("" : "+v"(acc[a][b][m][0]), "+v"(acc[a][b][m][1]));
        }
        { const int l2 = lane_id(); E(acc, cur, wr, wc, l2 & 15, l2 >> 4, rowtab + 512 * (ui % 3)); }
        if (!has_next) break;
#pragma unroll
        for (int a = 0; a < 2; ++a)
#pragma unroll
            for (int b = 0; b < 2; ++b)
#pragma unroll
                for (int m = 0; m < 4; ++m)
#pragma unroll
                    for (int n = 0; n < 2; ++n) acc[a][b][m][n] = (f32x4){0.f, 0.f, 0.f, 0.f};
        cur = nxt; cB = nB; cA = nA; ++ui;
        if constexpr (GATHER) { const u32x4 _t = *(const LAS u32x4*)vnslot; vc[0][0] = _t.x; vc[0][1] = _t.y; vc[1][0] = _t.z; vc[1][1] = _t.w; }
        if (wr == 1) PG8_BAR;
    }
    PG8_WAIT_V(0);
    PG8_BAR;
#undef PG8_SA
#undef PG8_SB
#undef PG8_STAGE
#undef PG8_STAGEA
#undef PG8_LDA
#undef PG8_LDB
#undef PG8_MMA
#undef PG8_WAIT_V
#undef PG8_WAIT_L
#undef PG8_BAR
#undef PG8_SCHED
}

struct DenseOrder {
    int nM, nN, nwg, G, c, K; const char* Bt;
    __device__ __forceinline__ void init(int Mrows, int N, int K_, const void* Bt_, int G_, int c_) { nM = Mrows / BM; nN = N / BM; nwg = nM * nN; G = G_; c = c_; K = K_; Bt = (const char*)Bt_; }
    __device__ __forceinline__ bool next(int i, Unit& u) const {
        const long L = (long)i * G + c; if (L >= nwg) return false;
        int wgid = (int)L; { const int q = nwg / 8, r = nwg % 8, xcd = wgid % 8, off = wgid / 8; wgid = (xcd < r ? xcd * (q + 1) : r * (q + 1) + (xcd - r) * q) + off; }
        const int nig = 8 * nN, gid = wgid / nig, fm = gid * 8, gsz = (nM - fm) < 8 ? (nM - fm) : 8;
        u.pm = fm + ((wgid % nig) % gsz); u.pn = (wgid % nig) / gsz; u.B = Bt + (size_t)u.pn * BM * K * 2; u.e = 0; u.cnt = 0; u.off = 0; return true;
    }
    static constexpr bool GATHER = false;
    __device__ __forceinline__ size_t aoff(const Unit& u) const { return (size_t)u.pm * BM * K * 2; }
    __device__ __forceinline__ void avoff(const Unit&, const int (&)[2], const int (&)[2], unsigned (&)[2][2], int) const {}
};
template <int NCOL, bool TOKROWS> struct ExpertOrder {
    static constexpr bool GATHER = true;
    __device__ __forceinline__ size_t aoff(const Unit&) const { return 0; }
    const LAS unsigned* tab; int per, c, K  ; const char* W; size_t wstride; const int* slot_ent; const float* slot_w;
    mutable int ehint = 0;
    int xbase, xend, xstride, xlb;
    __device__ __forceinline__ void init(const LAS unsigned* tab_, int K_, const void* W_, size_t wstride_, const int* slot_ent_, const float* slot_w_, int G, int c_) {
        tab = tab_; K = K_; W = (const char*)W_; wstride = wstride_; slot_ent = slot_ent_; slot_w = slot_w_; c = c_;
        const int U = (int)tab[T_TILE + NE] * NCOL; per = (U + G - 1) / G;
        if (G % 8 == 0) { const int x = c_ % 8; const int q = U / 8, r = U % 8; xbase = x * q + (x < r ? x : r); xend = xbase + q + (x < r ? 1 : 0); xstride = G / 8; xlb = c_ / 8; }
        else { xbase = 0; xend = U; xstride = G; xlb = c_; }
    }
    __device__ __forceinline__ bool next(int i, Unit& u) const {
        const int L = xbase + i * xstride + xlb;
        if (L >= xend) return false;
        const int tile = L / NCOL; u.pn = L % NCOL;
        int lo = ehint;
        if (i == 0) { lo = 0; int hi = NE - 1; while (lo < hi) { const int mid = (lo + hi + 1) >> 1; if ((int)tab[T_TILE + mid] <= tile) lo = mid; else hi = mid - 1; } }
        else { while (lo < NE - 1 && (int)tab[T_TILE + lo + 1] <= tile) ++lo; }
        ehint = lo;
        u.e = lo; u.pm = tile - (int)tab[T_TILE + lo]; u.cnt = (int)tab[T_CNT + lo]; u.off = (int)tab[T_OFF + lo];
        u.B = W + (size_t)lo * wstride + (size_t)u.pn * BM * K; return true;
    }
    __device__ __forceinline__ void rowtab(const Unit& u, LAS unsigned* t, int tid) const {
        if (tid < BM) { int r = u.pm * BM + tid; if (r >= u.cnt) r = u.cnt - 1; t[tid] = (unsigned)slot_ent[u.off + r]; t[BM + tid] = __float_as_uint(slot_w[u.off + r]); }
    }
    __device__ __forceinline__ void avoff(const Unit& u, const int (&)[2], const int (&)[2], unsigned (&v)[2][2], int tidq) const {
        int R[2], C[2]; asm volatile("" : "+v"(tidq));
#pragma unroll
        for (int i = 0; i < 2; ++i) stage_rc(tidq * 16 + i * 8192, R[i], C[i]);
#pragma unroll
        for (int h = 0; h < 2; ++h)
#pragma unroll
            for (int i = 0; i < 2; ++i) {
                int r = u.pm * BM + h * HALF + R[i]; if (r >= u.cnt) r = u.cnt - 1;
                const int slot = u.off + r;
                const int row = TOKROWS ? (slot_ent[slot] >> 3) : slot;
                v[h][i] = (unsigned)(row * K + C[i] * 2);
            }
    }
};

struct EpiInProj {
    static constexpr bool PERM = true; bf16_t* O;
    __device__ __forceinline__ void operator()(const f32x4 (&acc)[2][2][4][2], const Unit& u, int wr, int wc, int fr, int fq, const LAS unsigned* rt) const {
        const float sc = (u.pn < 2) ? 0.125f : ((u.pn == 8 || u.pn == 9) ? 0.08838834764831845f : 1.f);
        const int row0 = u.pm * BM + wr * 64 + fr, col0 = u.pn * BM + wc * 64 + 16 * fq;
#pragma unroll
        for (int ai = 0; ai < 2; ++ai)
#pragma unroll
            for (int m = 0; m < 4; ++m) { bf16_t* rowp = O + (size_t)(row0 + ai * HALF + m * 16) * DIN + col0;
#pragma unroll
                for (int bj = 0; bj < 2; ++bj) { const f32x4 v0 = acc[ai][bj][m][0] * sc, v1 = acc[ai][bj][m][1] * sc;
                    u32x4 w; w.x = cvt_pk_bf16(v0[0], v0[1]); w.y = cvt_pk_bf16(v0[2], v0[3]); w.z = cvt_pk_bf16(v1[0], v1[1]); w.w = cvt_pk_bf16(v1[2], v1[3]);
                    *(u32x4*)(rowp + 8 * bj) = w; } }
    }
};
struct EpiOutProj {
    static constexpr bool PERM = true; const float* x; const float* mod; bf16_t* tb;
    __device__ __forceinline__ void operator()(const f32x4 (&acc)[2][2][4][2], const Unit& u, int wr, int wc, int fr, int fq, const LAS unsigned* rt) const {
        const int b = (u.pm * BM) >> 11; const int col0 = u.pn * BM + wc * 64 + 16 * fq;
        f32x4 g[2][2];
#pragma unroll
        for (int bj = 0; bj < 2; ++bj)
#pragma unroll
            for (int n = 0; n < 2; ++n) g[bj][n] = *(const f32x4*)(mod + b * 6144 + MOD_GATE_A + col0 + 8 * bj + 4 * n);
#pragma unroll
        for (int ai = 0; ai < 2; ++ai)
#pragma unroll
            for (int m = 0; m < 4; ++m) { const size_t o = (size_t)(u.pm * BM + ai * HALF + wr * 64 + m * 16 + fr) * D + col0;
#pragma unroll
                for (int bj = 0; bj < 2; ++bj) {
                    const f32x4 t0 = *(const f32x4*)(x + o + 8 * bj) * ALPHA + g[bj][0] * acc[ai][bj][m][0], t1 = *(const f32x4*)(x + o + 8 * bj + 4) * ALPHA + g[bj][1] * acc[ai][bj][m][1];
                    u32x4 w; w.x = cvt_pk_bf16(t0[0], t0[1]); w.y = cvt_pk_bf16(t0[2], t0[3]); w.z = cvt_pk_bf16(t1[0], t1[1]); w.w = cvt_pk_bf16(t1[2], t1[3]);
                    *(u32x4*)(tb + o + 8 * bj) = w; } }
    }
};
struct EpiRouter {
    static constexpr bool PERM = false; float* out;
    __device__ __forceinline__ void operator()(const f32x4 (&acc)[2][2][4][2], const Unit& u, int wr, int wc, int fr, int fq, const LAS unsigned* rt) const {
        const int col0 = wc * 32 + 4 * fq;
#pragma unroll
        for (int ai = 0; ai < 2; ++ai)
#pragma unroll
            for (int m = 0; m < 4; ++m) { float* rowp = out + (size_t)(u.pm * BM + ai * HALF + wr * 64 + m * 16 + fr) * NE + col0;
#pragma unroll
                for (int bj = 0; bj < 2; ++bj)
#pragma unroll
                    for (int n = 0; n < 2; ++n) *(f32x4*)(rowp + bj * HALF + n * 16) = acc[ai][bj][m][n]; }
    }
};
template <bool EXPERT> struct EpiGU {
    static constexpr bool PERM = true; void* Ov;
    __device__ __forceinline__ void operator()(const f32x4 (&acc)[2][2][4][2], const Unit& u, int wr, int wc, int fr, int fq, const LAS unsigned* rt) const {
        const int h0 = u.pn * HALF + wc * 32 + 8 * fq;
#pragma unroll
        for (int ai = 0; ai < 2; ++ai)
#pragma unroll
            for (int m = 0; m < 4; ++m) {
                const int rtw = u.pm * BM + ai * HALF + wr * 64 + m * 16 + fr;
                if (EXPERT) { if (rtw >= u.cnt) continue; }
                const float w = EXPERT ? __uint_as_float(rt[BM + ai * HALF + wr * 64 + m * 16 + fr]) * (S_ACT8 * INV_GU8) : 1.f;
                const float gs = EXPERT ? INV_GU8 : 1.f;
                const f32x4 g0 = acc[ai][0][m][0] * gs, g1 = acc[ai][0][m][1] * gs, u0 = acc[ai][1][m][0], u1 = acc[ai][1][m][1];
                const float h[8] = {w * silu_f(g0[0]) * u0[0], w * silu_f(g0[1]) * u0[1], w * silu_f(g0[2]) * u0[2], w * silu_f(g0[3]) * u0[3],
                                    w * silu_f(g1[0]) * u1[0], w * silu_f(g1[1]) * u1[1], w * silu_f(g1[2]) * u1[2], w * silu_f(g1[3]) * u1[3]};
                if (EXPERT) {
                    int w0 = __builtin_amdgcn_cvt_pk_fp8_f32(clamp8(h[0]), clamp8(h[1]), 0, false); w0 = __builtin_amdgcn_cvt_pk_fp8_f32(clamp8(h[2]), clamp8(h[3]), w0, true);
                    int w1 = __builtin_amdgcn_cvt_pk_fp8_f32(clamp8(h[4]), clamp8(h[5]), 0, false); w1 = __builtin_amdgcn_cvt_pk_fp8_f32(clamp8(h[6]), clamp8(h[7]), w1, true);
                    u32x2 o; o.x = (unsigned)w0; o.y = (unsigned)w1; *(u32x2*)((unsigned char*)Ov + (size_t)(u.off + rtw) * DE + h0) = o;
                    asm volatile("" ::: "memory");
                } else {
                    u32x4 o; o.x = cvt_pk_bf16(h[0], h[1]); o.y = cvt_pk_bf16(h[2], h[3]); o.z = cvt_pk_bf16(h[4], h[5]); o.w = cvt_pk_bf16(h[6], h[7]);
                    *(u32x4*)((bf16_t*)Ov + (size_t)rtw * DE + h0) = o;
                }
            }
    }
};
struct EpiSharedDown {
    static constexpr bool PERM = true; unsigned char* ysh;
    __device__ __forceinline__ void operator()(const f32x4 (&acc)[2][2][4][2], const Unit& u, int wr, int wc, int fr, int fq, const LAS unsigned* rt) const {
        const int col0 = u.pn * BM + wc * 64 + 16 * fq;
#pragma unroll
        for (int ai = 0; ai < 2; ++ai)
#pragma unroll
            for (int m = 0; m < 4; ++m) {
                u32x4 o;
#pragma unroll
                for (int bj = 0; bj < 2; ++bj) { const f32x4 v0 = acc[ai][bj][m][0] * YSCALE, v1 = acc[ai][bj][m][1] * YSCALE;
                    int w0 = __builtin_amdgcn_cvt_pk_fp8_f32(clamp8(v0[0]), clamp8(v0[1]), 0, false); w0 = __builtin_amdgcn_cvt_pk_fp8_f32(clamp8(v0[2]), clamp8(v0[3]), w0, true);
                    int w1 = __builtin_amdgcn_cvt_pk_fp8_f32(clamp8(v1[0]), clamp8(v1[1]), 0, false); w1 = __builtin_amdgcn_cvt_pk_fp8_f32(clamp8(v1[2]), clamp8(v1[3]), w1, true);
                    if (bj == 0) { o.x = (unsigned)w0; o.y = (unsigned)w1; } else { o.z = (unsigned)w0; o.w = (unsigned)w1; } }
                *(u32x4*)(ysh + (size_t)(u.pm * BM + ai * HALF + wr * 64 + m * 16 + fr) * D + col0) = o;
            }
    }
};
struct EpiExpDown {
    static constexpr bool PERM = true; unsigned char* ybuf; const int* slot_ent;
    __device__ __forceinline__ void operator()(const f32x4 (&acc)[2][2][4][2], const Unit& u, int wr, int wc, int fr, int fq, const LAS unsigned* rt) const {
        const int col0 = u.pn * BM + wc * 64 + 16 * fq;
#pragma unroll
        for (int ai = 0; ai < 2; ++ai)
#pragma unroll
            for (int m = 0; m < 4; ++m) {
                const int rtw = u.pm * BM + ai * HALF + wr * 64 + m * 16 + fr; if (rtw >= u.cnt) continue;
                u32x4 o;
#pragma unroll
                for (int bj = 0; bj < 2; ++bj) { const f32x4 v0 = acc[ai][bj][m][0] * (YSCALE * INV_DN8), v1 = acc[ai][bj][m][1] * (YSCALE * INV_DN8);
                    int w0 = __builtin_amdgcn_cvt_pk_fp8_f32(clamp8(v0[0]), clamp8(v0[1]), 0, false); w0 = __builtin_amdgcn_cvt_pk_fp8_f32(clamp8(v0[2]), clamp8(v0[3]), w0, true);
                    int w1 = __builtin_amdgcn_cvt_pk_fp8_f32(clamp8(v1[0]), clamp8(v1[1]), 0, false); w1 = __builtin_amdgcn_cvt_pk_fp8_f32(clamp8(v1[2]), clamp8(v1[3]), w1, true);
                    if (bj == 0) { o.x = (unsigned)w0; o.y = (unsigned)w1; } else { o.z = (unsigned)w0; o.w = (unsigned)w1; } }
                *(u32x4*)(ybuf + (size_t)rt[ai * HALF + wr * 64 + m * 16 + fr] * D + col0) = o;
                asm volatile("" ::: "memory");
            }
    }
};
struct EpiProbeSum {
    static constexpr bool PERM = true; float* o;
    __device__ __forceinline__ void operator()(const f32x4 (&acc)[2][2][4][2], const Unit& u, int wr, int wc, int fr, int fq, const LAS unsigned* rt) const {
        f32x4 s = (f32x4){0.f, 0.f, 0.f, 0.f};
#pragma unroll
        for (int a = 0; a < 2; ++a)
#pragma unroll
            for (int b = 0; b < 2; ++b)
#pragma unroll
                for (int m = 0; m < 4; ++m) s += acc[a][b][m][0] + acc[a][b][m][1];
        if (s.x == 123.456f) *(f32x4*)(o + (size_t)(blockIdx.x * 512 + wr * 256 + wc * 64 + fq * 16 + fr) * 4) = s;
    }
};
}

struct Ctx {
    const float *x, *c, *w_ada, *b_ada, *w_in, *w_out, *na_rpb, *ret_ld, *ret_gn, *ln1_g, *ln1_b, *ln2_g, *ln2_b, *w_router, *rbias, *w_gate, *w_up, *w_down, *ws_gate, *ws_up, *ws_down;
    float* out; unsigned char* ws;
};
constexpr int NW = 8;

__device__ __forceinline__ void transpose_item(const float* W, int K, int N, bf16_t* WT, int G, int which, LAS float* scr, int item, int lane) {
    const int nblk = N / 32, kb = item / nblk, nb = item % nblk, k0 = 64 * kb, n0 = 32 * nb;
    float v[32];
#pragma unroll
    for (int i = 0; i < 32; ++i) { const int kk = 2 * i + (lane >> 5); v[i] = __builtin_nontemporal_load(W + (size_t)(k0 + kk) * N + n0 + (lane & 31)); }
#pragma unroll
    for (int i = 0; i < 32; ++i) { const int kk = 2 * i + (lane >> 5); scr[kk * 33 + (lane & 31)] = v[i]; }
    LDS_WAIT(); asm volatile("" ::: "memory");
    const int c = lane & 7;
#pragma unroll
    for (int j = 0; j < 4; ++j) { const int n = (lane >> 3) + 8 * j; const LAS float* s = scr + (8 * c) * 33 + n;
        u32x4 o; o.x = pk2(s[0 * 33], s[1 * 33]); o.y = pk2(s[2 * 33], s[3 * 33]); o.z = pk2(s[4 * 33], s[5 * 33]); o.w = pk2(s[6 * 33], s[7 * 33]);
        const int ng = n0 + n; const int drow = (G == 0) ? ng : ((ng / G) * 2 * G + which * G + (ng % G));
        *(u32x4*)(WT + (size_t)drow * K + k0 + 8 * c) = o; }
    LDS_WAIT(); asm volatile("" ::: "memory");
}
__device__ __forceinline__ void transpose_item_fp8(const float* W, int K, int N, unsigned char* WT, int G, int which, float scale, LAS float* scr, int item, int lane) {
    const int nblk = N / 32, kb = item / nblk, nb = item % nblk, k0 = 64 * kb, n0 = 32 * nb;
    float v[32];
#pragma unroll
    for (int i = 0; i < 32; ++i) { const int kk = 2 * i + (lane >> 5); v[i] = __builtin_nontemporal_load(W + (size_t)(k0 + kk) * N + n0 + (lane & 31)); }
#pragma unroll
    for (int i = 0; i < 32; ++i) { const int kk = 2 * i + (lane >> 5); scr[kk * 33 + (lane & 31)] = v[i] * scale; }
    LDS_WAIT(); asm volatile("" ::: "memory");
    const int c = lane & 7;
#pragma unroll
    for (int j = 0; j < 4; ++j) { const int n = (lane >> 3) + 8 * j; const LAS float* sp = scr + (8 * c) * 33 + n;
        int w0 = __builtin_amdgcn_cvt_pk_fp8_f32(clamp8(sp[0 * 33]), clamp8(sp[1 * 33]), 0, false); w0 = __builtin_amdgcn_cvt_pk_fp8_f32(clamp8(sp[2 * 33]), clamp8(sp[3 * 33]), w0, true);
        int w1 = __builtin_amdgcn_cvt_pk_fp8_f32(clamp8(sp[4 * 33]), clamp8(sp[5 * 33]), 0, false); w1 = __builtin_amdgcn_cvt_pk_fp8_f32(clamp8(sp[6 * 33]), clamp8(sp[7 * 33]), w1, true);
        const int ng = n0 + n; const int drow = (G == 0) ? ng : ((ng / G) * 2 * G + which * G + (ng % G));
        u32x2 o; o.x = (unsigned)w0; o.y = (unsigned)w1; *(u32x2*)(WT + (size_t)drow * K + k0 + 8 * c) = o; }
    LDS_WAIT(); asm volatile("" ::: "memory");
}
__device__ __forceinline__ void rope_entry(float* tab, int idx) {
    const int t = idx >> 6, i = idx & 63;
    const float inv_freq = powf(10000.f, -(float)(2 * i) / 128.f);
    const float ang = (float)t * inv_freq;
    const double a = (double)ang; const double two_pi = 6.283185307179586476925286766559;
    const double kf = rint(a / two_pi); double r = a - kf * two_pi;
    double sgn = 1.0; if (r > 1.5707963267948966) { r = 3.141592653589793 - r; sgn = -1.0; } else if (r < -1.5707963267948966) { r = -3.141592653589793 - r; sgn = -1.0; }
    const double r2 = r * r;
    const double s = r * (1.0 + r2 * (-1.0 / 6 + r2 * (1.0 / 120 + r2 * (-1.0 / 5040 + r2 * (1.0 / 362880 + r2 * (-1.0 / 39916800 + r2 * (1.0 / 6227020800.0 + r2 * (-1.0 / 1307674368000.0))))))));
    const double c = 1.0 + r2 * (-0.5 + r2 * (1.0 / 24 + r2 * (-1.0 / 720 + r2 * (1.0 / 40320 + r2 * (-1.0 / 3628800 + r2 * (1.0 / 479001600.0 + r2 * (-1.0 / 87178291200.0 + r2 * (1.0 / 20922789888000.0))))))));
    tab[idx] = (float)(sgn * c); tab[SEQ * 64 + idx] = (float)s;
}
__device__ __forceinline__ void mod_task(const float* __restrict__ cin, const float* __restrict__ w_ada, float* __restrict__ modp, int task, int lane) {
    const int cbk = task % 96, kc = task / 96, j = cbk * 64 + lane, k0 = kc * 64;
    float acc[32], cv[32];
#pragma unroll
    for (int b = 0; b < 32; ++b) { acc[b] = 0.f; cv[b] = silu_f(cin[b * D + k0 + lane]); }
#pragma unroll
    for (int kb = 0; kb < 4; ++kb) {
        float w[16];
#pragma unroll
        for (int i = 0; i < 16; ++i) w[i] = w_ada[(size_t)(k0 + kb * 16 + i) * 6144 + j];
#pragma unroll
        for (int i = 0; i < 16; ++i)
#pragma unroll
            for (int b = 0; b < 32; ++b) acc[b] += __builtin_bit_cast(float, __builtin_amdgcn_readlane(__builtin_bit_cast(int, cv[b]), kb * 16 + i)) * w[i];
    }
#pragma unroll
    for (int b = 0; b < 32; ++b) modp[((size_t)kc * 32 + b) * 6144 + j] = acc[b];
}
__device__ __forceinline__ float mod_sum(const float* __restrict__ modp, const float* __restrict__ b_ada, int b, int j) {
    float s = 0.f;
#pragma unroll
    for (int kc = 0; kc < 16; ++kc) s += modp[((size_t)kc * 32 + b) * 6144 + j];
    return s + b_ada[j];
}

#ifndef RET_PROBE
#define RET_PROBE 0
#endif
namespace ret {
typedef short s16x4 __attribute__((ext_vector_type(4)));
typedef __bf16 bfx2 __attribute__((ext_vector_type(2)));
constexpr unsigned RS = 288, TILE = 128 * RS, LK = 0, LV = TILE, LRF = 2 * TILE, LRB = 3 * TILE;
constexpr float LOG2E = 1.4426950408889634f;
__device__ __forceinline__ unsigned offb(unsigned row, unsigned ch) { return RS * row + 16u * ch; }
__device__ __forceinline__ unsigned cvtpk(float lo, float hi) { const f32x2 v = {lo, hi}; return __builtin_bit_cast(unsigned, __builtin_convertvector(v, bfx2)); }
__device__ __forceinline__ bf16x8 pack8(const float (&f)[8]) { u32x4 u; u.x = cvtpk(f[0], f[1]); u.y = cvtpk(f[2], f[3]); u.z = cvtpk(f[4], f[5]); u.w = cvtpk(f[6], f[7]); return __builtin_bit_cast(bf16x8, u); }
__device__ __forceinline__ void unpack8(const bf16x8 v, float (&f)[8]) { const u32x4 u = __builtin_bit_cast(u32x4, v);
    f[0] = __uint_as_float(u.x << 16); f[1] = __uint_as_float(u.x & 0xffff0000u); f[2] = __uint_as_float(u.y << 16); f[3] = __uint_as_float(u.y & 0xffff0000u);
    f[4] = __uint_as_float(u.z << 16); f[5] = __uint_as_float(u.z & 0xffff0000u); f[6] = __uint_as_float(u.w << 16); f[7] = __uint_as_float(u.w & 0xffff0000u); }
__device__ __forceinline__ bf16x8 trfrag(LAS unsigned char* base, unsigned row0, unsigned row1, unsigned cblk, unsigned qp, unsigned p) {
    const unsigned ch = 2u * cblk + (p >> 1), bo = 8u * (p & 1u);
    const s16x4 lo = __builtin_amdgcn_ds_read_tr16_b64_v4i16((LAS s16x4*)(base + offb(row0 + qp, ch) + bo));
    const s16x4 hi = __builtin_amdgcn_ds_read_tr16_b64_v4i16((LAS s16x4*)(base + offb(row1 + qp, ch) + bo));
    return __builtin_shufflevector(lo, hi, 0, 1, 2, 3, 4, 5, 6, 7);
}
struct KVRaw { bf16x8 ka[2], kb[2], v[4]; f32x4 c0[2], c1[2], s0[2], s1[2]; };
__device__ __forceinline__ void kv_load(KVRaw& R, const bf16_t* __restrict__ proj, const float* __restrict__ rope, int b, int h, int n, int tid) {
#pragma unroll
    for (int i = 0; i < 2; ++i) {
        const int q2 = tid + 512 * i, row = q2 >> 3, pc = q2 & 7, t = n * 128 + row;
        const bf16_t* rp = proj + (size_t)(b * SEQ + t) * DIN + OFF_KR + h * 128;
        R.ka[i] = *(const bf16x8*)(rp + pc * 8); R.kb[i] = *(const bf16x8*)(rp + 64 + pc * 8);
        R.c0[i] = *(const f32x4*)(rope + t * 64 + pc * 8); R.c1[i] = *(const f32x4*)(rope + t * 64 + pc * 8 + 4);
        R.s0[i] = *(const f32x4*)(rope + SEQ * 64 + t * 64 + pc * 8); R.s1[i] = *(const f32x4*)(rope + SEQ * 64 + t * 64 + pc * 8 + 4);
    }
#pragma unroll
    for (int i = 0; i < 4; ++i) { const int q4 = tid + 512 * i, row = q4 >> 4, ch = q4 & 15, t = n * 128 + row;
        R.v[i] = *(const bf16x8*)(proj + (size_t)(b * SEQ + t) * DIN + OFF_VR + h * 128 + ch * 8); }
}
__device__ __forceinline__ void kv_store(LAS unsigned char* lds, const KVRaw& R, int tid) {
#pragma unroll
    for (int i = 0; i < 2; ++i) {
        const int q2 = tid + 512 * i, row = q2 >> 3, pc = q2 & 7;
        float fa[8], fb[8], o1[8], o2[8];
        unpack8(R.ka[i], fa); unpack8(R.kb[i], fb);
        const float cs[8] = {R.c0[i].x, R.c0[i].y, R.c0[i].z, R.c0[i].w, R.c1[i].x, R.c1[i].y, R.c1[i].z, R.c1[i].w}, sn[8] = {R.s0[i].x, R.s0[i].y, R.s0[i].z, R.s0[i].w, R.s1[i].x, R.s1[i].y, R.s1[i].z, R.s1[i].w};
#pragma unroll
        for (int e = 0; e < 8; ++e) { o1[e] = fa[e] * cs[e] - fb[e] * sn[e]; o2[e] = fb[e] * cs[e] + fa[e] * sn[e]; }
        *(LAS bf16x8*)(lds + LK + offb(row, pc)) = pack8(o1); *(LAS bf16x8*)(lds + LK + offb(row, pc + 8)) = pack8(o2);
    }
#pragma unroll
    for (int i = 0; i < 4; ++i) { const int q4 = tid + 512 * i, row = q4 >> 4, ch = q4 & 15; *(LAS bf16x8*)(lds + LV + offb(row, ch)) = R.v[i]; }
}
__device__ __forceinline__ void rb_dma(LAS unsigned char* lds, const unsigned char* img, int w, int lane) {
#pragma unroll
    for (int i = 0; i < 5; ++i) { const int o = w + 8 * i; if (o < (int)TILE / 1024)
        __builtin_amdgcn_global_load_lds((const unsigned*)(img + o * 1024 + lane * 16), (LAS unsigned*)(lds + LRB + o * 1024), 16, 0, 0); }
}
template <bool FWD> __device__ __forceinline__ void state_update_1(LAS unsigned char* lds, f32x4 (&racc)[8], float l2, int w, int g, unsigned qp, unsigned p);
template <bool FWD> __device__ __forceinline__ void state_update(LAS unsigned char* lds, f32x4 (&racc)[8], float l2, int w, int g, unsigned qp, unsigned p) {
    if (RET_PROBE == 2) {
        f32x4 r2[8];
#pragma unroll
        for (int i = 0; i < 8; ++i) r2[i] = racc[i];
        unsigned zo = 0; asm volatile("" : "+v"(zo));
        state_update_1<FWD>(lds + zo, r2, l2, w, g, qp, p);
        state_update_1<FWD>(lds, racc, l2, w, g, qp, p);
#pragma unroll
        for (int i = 0; i < 8; ++i) racc[i] = (racc[i] + r2[i]) * 0.5f;
    } else state_update_1<FWD>(lds, racc, l2, w, g, qp, p);
}
template <bool FWD> __device__ __forceinline__ void state_update_1(LAS unsigned char* lds, f32x4 (&racc)[8], float l2, int w, int g, unsigned qp, unsigned p) {
    const float dec = __builtin_amdgcn_exp2f(128.f * l2);
    bf16x8 vs[4];
#pragma unroll
    for (int ks = 0; ks < 4; ++ks) {
        float f[8]; unpack8(trfrag(lds + LV, 32 * ks + 4 * g, 32 * ks + 16 + 4 * g, w, qp, p), f);
#pragma unroll
        for (int e = 0; e < 8; ++e) { const int key = 32 * ks + 16 * (e >> 2) + 4 * g + (e & 3); f[e] *= __builtin_amdgcn_exp2f((FWD ? (float)(127 - key) : (float)key) * l2); }
        vs[ks] = pack8(f);
    }
#pragma unroll
    for (int nb = 0; nb < 8; ++nb) {
        racc[nb] = racc[nb] * dec;
#pragma unroll
        for (int ks = 0; ks < 4; ++ks) racc[nb] = __builtin_amdgcn_mfma_f32_16x16x32_bf16(vs[ks], trfrag(lds + LK, 32 * ks + 4 * g, 32 * ks + 16 + 4 * g, nb, qp, p), racc[nb], 0, 0, 0);
    }
}
__device__ __forceinline__ void unit(const bf16_t* __restrict__ proj, const float* __restrict__ rope, const float* __restrict__ log_decay, const float* __restrict__ gn_g, bf16_t* __restrict__ ymix,
                                     unsigned char* __restrict__ scratch  , LAS unsigned char* lds, int hu, const int tid_in) {
    const int u = hu >> 1, n0 = (hu & 1) * 8, n1 = n0 + 8;
    const int b = u >> 2, h = u & 3;
    int tid_ = tid_in; asm volatile("" : "+v"(tid_));
    const int tid0 = tid_, w = __builtin_amdgcn_readfirstlane(tid0 >> 6);
#define RET_LANE int tid = tid0; asm volatile("" : "+v"(tid)); const int lane = tid & 63, r = lane & 15, g = lane >> 4; const unsigned qp = (unsigned)r >> 2, p = (unsigned)lane & 3u;
    const float lf2_ = log_decay[h] * LOG2E, lb2_ = log_decay[4 + h] * LOG2E;
    f32x4 racc[8];
    KVRaw raw;
    for (int rep7 = 0; rep7 < (RET_PROBE == 7 ? 2 : 1); ++rep7) {
#pragma unroll
    for (int nb = 0; nb < 8; ++nb) racc[nb] = (f32x4){0.f, 0.f, 0.f, 0.f};
    kv_load(raw, proj, rope, b, h, 15, tid0);
    for (int n = 15; n >= n0; --n) {
        RET_LANE
        if (n < n1) {
            unsigned char* img = scratch + (size_t)(n - n0) * TILE;
#pragma unroll
            for (int nb = 0; nb < 8; ++nb) { u32x2 o; o.x = cvtpk(racc[nb][0], racc[nb][1]); o.y = cvtpk(racc[nb][2], racc[nb][3]);
                *(u32x2*)(img + offb(16 * nb + r, 2 * w + (g >> 1)) + 8 * (g & 1)) = o; }
        }
        if (n == n0) break;
        float lb2 = lb2_; asm volatile("" : "+v"(lb2));
        __syncthreads();
        kv_store(lds, raw, tid);
        __syncthreads();
        kv_load(raw, proj, rope, b, h, n - 1 > n0 ? n - 1 : 0, tid);
        state_update<false>(lds, racc, lb2, w, g, qp, p);
    }
    }
    asm volatile("s_waitcnt vmcnt(0)" ::: "memory");
    __syncthreads();
    __builtin_amdgcn_fence(__ATOMIC_ACQUIRE, "agent");
    asm volatile("s_waitcnt vmcnt(0)" ::: "memory");
    for (int rep8 = 0; rep8 < (RET_PROBE == 8 ? 2 : 1); ++rep8) {
    if (RET_PROBE == 8 && rep8 == 1) { __syncthreads(); kv_load(raw, proj, rope, b, h, 0, tid0); }
#pragma unroll
    for (int nb = 0; nb < 8; ++nb) racc[nb] = (f32x4){0.f, 0.f, 0.f, 0.f};
    for (int n = 0; n < n0; ++n) {
        RET_LANE
        float lf2 = lf2_; asm volatile("" : "+v"(lf2));
        __syncthreads();
        kv_store(lds, raw, tid);
        __syncthreads();
        kv_load(raw, proj, rope, b, h, n + 1, tid);
        state_update<true>(lds, racc, lf2, w, g, qp, p);
    }
    rb_dma(lds, scratch, w, tid0 & 63);
    for (int n = n0; n < n1; ++n) {
        RET_LANE
        float lf2 = lf2_, lb2 = lb2_; asm volatile("" : "+v"(lf2), "+v"(lb2));
        const __attribute__((address_space(1))) float* gnp = (const __attribute__((address_space(1))) float*)gn_g; asm volatile("" : "+s"(gnp));
        __syncthreads();
        kv_store(lds, raw, tid);
#pragma unroll
        for (int nb = 0; nb < 8; ++nb) { u32x2 o; o.x = cvtpk(racc[nb][0], racc[nb][1]); o.y = cvtpk(racc[nb][2], racc[nb][3]);
            *(LAS u32x2*)(lds + LRF + offb(16 * nb + r, 2 * w + (g >> 1)) + 8 * (g & 1)) = o; }
        const int cq = 16 * w + r, tq = n * 128 + cq;
        bf16x8 qn[4], qf[4], qb[4];
        { const bf16_t* rp = proj + (size_t)(b * SEQ + tq) * DIN + OFF_QR + h * 128 + 4 * g;
          const float sf = __builtin_amdgcn_exp2f((float)(cq + 1) * lf2), sb = __builtin_amdgcn_exp2f((float)(128 - cq) * lb2);
#pragma unroll
          for (int ks = 0; ks < 2; ++ks) {
              float fa[8], fb[8], o1[8], o2[8], t1[8], t2[8];
              { const u32x2 a0 = *(const u32x2*)(rp + 32 * ks), a1 = *(const u32x2*)(rp + 32 * ks + 16), b0 = *(const u32x2*)(rp + 32 * ks + 64), b1 = *(const u32x2*)(rp + 32 * ks + 80);
                unpack8(__builtin_bit_cast(bf16x8, (u32x4){a0.x, a0.y, a1.x, a1.y}), fa); unpack8(__builtin_bit_cast(bf16x8, (u32x4){b0.x, b0.y, b1.x, b1.y}), fb); }
              const float* cp = rope + tq * 64 + 32 * ks + 4 * g; const float* sp = cp + SEQ * 64;
              const f32x4 c0 = *(const f32x4*)cp, c1 = *(const f32x4*)(cp + 16), s0 = *(const f32x4*)sp, s1 = *(const f32x4*)(sp + 16);
              const float cs[8] = {c0.x, c0.y, c0.z, c0.w, c1.x, c1.y, c1.z, c1.w}, sn[8] = {s0.x, s0.y, s0.z, s0.w, s1.x, s1.y, s1.z, s1.w};
#pragma unroll
              for (int e = 0; e < 8; ++e) { o1[e] = fa[e] * cs[e] - fb[e] * sn[e]; o2[e] = fb[e] * cs[e] + fa[e] * sn[e]; }
              qn[ks] = pack8(o1); qn[ks + 2] = pack8(o2);
#pragma unroll
              for (int e = 0; e < 8; ++e) { t1[e] = o1[e] * sf; t2[e] = o2[e] * sf; }
              qf[ks] = pack8(t1); qf[ks + 2] = pack8(t2);
#pragma unroll
              for (int e = 0; e < 8; ++e) { t1[e] = o1[e] * sb; t2[e] = o2[e] * sb; }
              qb[ks] = pack8(t1); qb[ks + 2] = pack8(t2);
          } }
        asm volatile("s_waitcnt vmcnt(0)" ::: "memory");
        __syncthreads();
        kv_load(raw, proj, rope, b, h, n + 1 < n1 ? n + 1 : n, tid);
        u32x2 gv[8];
        { const bf16_t* gp = proj + (size_t)(b * SEQ + tq) * DIN + OFF_GR + h * 128 + 4 * g;
#pragma unroll
          for (int mbv = 0; mbv < 8; ++mbv) gv[mbv] = *(const u32x2*)(gp + 16 * mbv); }
        bf16x8 pt[4];
#pragma unroll
        for (int rep3 = 0; rep3 < (RET_PROBE == 3 ? 2 : 1); ++rep3) {
        unsigned zo3 = 0; if (RET_PROBE == 3) asm volatile("" : "+v"(zo3));
#pragma unroll
        for (int ks2 = 0; ks2 < 4; ++ks2) {
            float pv[8];
#pragma unroll
            for (int hb = 0; hb < 2; ++hb) {
                const int mb = 2 * ks2 + hb;
                f32x4 st = (f32x4){0.f, 0.f, 0.f, 0.f};
#pragma unroll
                for (int ks = 0; ks < 4; ++ks) { const LAS unsigned char* kp = lds + LK + zo3 + RS * (16 * mb + r) + 64 * ks + 8 * g; const u32x2 k0 = *(const LAS u32x2*)kp, k1 = *(const LAS u32x2*)(kp + 32);
                    st = __builtin_amdgcn_mfma_f32_16x16x32_bf16(__builtin_bit_cast(bf16x8, (u32x4){k0.x, k0.y, k1.x, k1.y}), qn[ks], st, 0, 0, 0); }
#pragma unroll
                for (int j = 0; j < 4; ++j) { const int diff = cq - (16 * mb + 4 * g + j); pv[4 * hb + j] = st[j] * __builtin_amdgcn_exp2f(diff >= 0 ? (float)diff * lf2 : (float)(-diff) * lb2); }
            }
            pt[ks2] = pack8(pv);
        }
        }
        f32x4 yacc[8];
#pragma unroll
        for (int mbv = 0; mbv < 8; ++mbv) {
            f32x4 y = (f32x4){0.f, 0.f, 0.f, 0.f};
#pragma unroll
            for (int rep = 0; rep < (RET_PROBE == 1 ? 2 : 1); ++rep) {
            unsigned zo = 0; if (RET_PROBE == 1) asm volatile("" : "+v"(zo));
#pragma unroll
            for (int ks2 = 0; ks2 < 4; ++ks2) y = __builtin_amdgcn_mfma_f32_16x16x32_bf16(trfrag(lds + LV + zo, 32 * ks2 + 4 * g, 32 * ks2 + 16 + 4 * g, mbv, qp, p), pt[ks2], y, 0, 0, 0);
#pragma unroll
            for (int ks = 0; ks < 4; ++ks) {
                y = __builtin_amdgcn_mfma_f32_16x16x32_bf16(trfrag(lds + LRF + zo, 32 * ks + 4 * g, 32 * ks + 16 + 4 * g, mbv, qp, p), qf[ks], y, 0, 0, 0);
                y = __builtin_amdgcn_mfma_f32_16x16x32_bf16(trfrag(lds + LRB + zo, 32 * ks + 4 * g, 32 * ks + 16 + 4 * g, mbv, qp, p), qb[ks], y, 0, 0, 0);
            }
            }
            yacc[mbv] = (RET_PROBE == 1) ? y * 0.5f : y;
        }
        __syncthreads();
        if (n + 1 < n1) rb_dma(lds, scratch + (size_t)(n + 1 - n0) * TILE, w, lane);
        { float s = 0.f;
#pragma unroll
          for (int mbv = 0; mbv < 8; ++mbv) s += (yacc[mbv][0] + yacc[mbv][1]) + (yacc[mbv][2] + yacc[mbv][3]);
          s += __shfl_xor(s, 16); s += __shfl_xor(s, 32);
          const float mu = s * (1.f / 128.f); float s2 = 0.f;
#pragma unroll
          for (int mbv = 0; mbv < 8; ++mbv) { yacc[mbv] = yacc[mbv] - mu; s2 += (yacc[mbv][0] * yacc[mbv][0] + yacc[mbv][1] * yacc[mbv][1]) + (yacc[mbv][2] * yacc[mbv][2] + yacc[mbv][3] * yacc[mbv][3]); }
          s2 += __shfl_xor(s2, 16); s2 += __shfl_xor(s2, 32);
          const float rstd = 1.f / sqrtf(s2 * (1.f / 128.f) + GN_EPS);
          bf16_t* op = ymix + (size_t)(b * SEQ + tq) * D + 512 + h * 128 + 4 * g;
#pragma unroll
          for (int rep4 = 0; rep4 < (RET_PROBE == 4 ? 2 : 1); ++rep4) {
          if (RET_PROBE == 4) { asm volatile("" : "+v"(op)); asm volatile("" : "+v"(gv[0]), "+v"(gv[1]), "+v"(gv[2]), "+v"(gv[3]), "+v"(gv[4]), "+v"(gv[5]), "+v"(gv[6]), "+v"(gv[7])); }
#pragma unroll
          for (int mbv = 0; mbv < 8; ++mbv) {
              const f32x4 gn = *(const __attribute__((address_space(1))) f32x4*)(gnp + h * 128 + 16 * mbv + 4 * g);
              const float g0 = __uint_as_float(gv[mbv].x << 16), g1 = __uint_as_float(gv[mbv].x & 0xffff0000u), g2 = __uint_as_float(gv[mbv].y << 16), g3 = __uint_as_float(gv[mbv].y & 0xffff0000u);
              u32x2 o; o.x = cvtpk(silu_f(g0) * (yacc[mbv][0] * rstd * gn.x), silu_f(g1) * (yacc[mbv][1] * rstd * gn.y));
              o.y = cvtpk(silu_f(g2) * (yacc[mbv][2] * rstd * gn.z), silu_f(g3) * (yacc[mbv][3] * rstd * gn.w));
              *(u32x2*)(op + 16 * mbv) = o;
          } } }
        state_update<true>(lds, racc, lf2, w, g, qp, p);
    }
    }
    __syncthreads();
#undef RET_LANE
}
}


namespace na {
constexpr unsigned LKR = 0, LVR = 73728, LRPB = 147456;
__device__ __forceinline__ void load_row(LAS unsigned char* lds, const bf16_t* __restrict__ proj, int b, int head, int krow, int tid) {
    const int key = tid >> 3, ch = tid & 7, slot = krow % 9;
    const bf16_t* rp = proj + (size_t)(b * SEQ + krow * 64 + key) * DIN + head * 64 + ch * 8;
    const unsigned o = (unsigned)slot * 8192u + 128u * key + 16u * (ch ^ (key & 7));
    *(LAS u32x4*)(lds + LKR + o) = *(const u32x4*)(rp + OFF_KNA);
    *(LAS u32x4*)(lds + LVR + o) = *(const u32x4*)(rp + OFF_VNA);
}
__device__ __forceinline__ void unit(const bf16_t* __restrict__ proj, const float* __restrict__ rpb, bf16_t* __restrict__ ymix, LAS unsigned char* lds, int u, const int tid_in) {
    const int b = u >> 3, head = u & 7;
    int tid_ = tid_in; asm volatile("" : "+v"(tid_));
    const int tid0 = tid_, w = __builtin_amdgcn_readfirstlane(tid0 >> 6);
    __syncthreads();
    if (tid0 < 465) ((LAS float*)(lds + LRPB))[tid0] = rpb[head * 465 + tid0];
    const int ct = w & 3, cb = (ct == 0) ? 0 : (ct == 1 ? 8 : (ct == 2 ? 24 : 32));
    u32x4 pk[2], pv2[2]; int pre_lo = 0, pre_n = 0;
    for (int st = 0; st < 16; ++st) {
        int tid = tid0; asm volatile("" : "+v"(tid));
        const int lane = tid & 63, qi = lane & 15, g = lane >> 4; const unsigned qp = (unsigned)qi >> 2, p = (unsigned)lane & 3u;
        const int r = 2 * st + (w >> 2);
        const int rs = min(max(r - 4, 0), 24);
        const int need_hi = min(max(2 * st + 1 - 4, 0), 24) + 7;
        __syncthreads();
        if (st == 0) { for (int kr = 0; kr <= need_hi; ++kr) load_row(lds, proj, b, head, kr, tid); }
        else {
#pragma unroll
            for (int i = 0; i < 2; ++i) if (i < pre_n) { const int key = tid >> 3, ch = tid & 7; const unsigned o = (unsigned)((pre_lo + i) % 9) * 8192u + 128u * key + 16u * (ch ^ (key & 7));
                *(LAS u32x4*)(lds + LKR + o) = pk[i]; *(LAS u32x4*)(lds + LVR + o) = pv2[i]; }
        }
        const int cq = 16 * ct + qi, tq = b * SEQ + r * 64 + cq;
        bf16x8 qn[2];
        { const bf16_t* qptr = proj + (size_t)tq * DIN + OFF_QNA + head * 64 + 8 * g; qn[0] = *(const bf16x8*)qptr; qn[1] = *(const bf16x8*)(qptr + 32); }
        __syncthreads();
        { const int nh = (st < 15) ? min(max(2 * st + 3 - 4, 0), 24) + 7 : need_hi; pre_lo = need_hi + 1; pre_n = nh - need_hi;
#pragma unroll
          for (int i = 0; i < 2; ++i) if (i < pre_n) { const int key = tid >> 3, ch = tid & 7; const bf16_t* rp = proj + (size_t)(b * SEQ + (pre_lo + i) * 64 + key) * DIN + head * 64 + ch * 8;
              pk[i] = *(const u32x4*)(rp + OFF_KNA); pv2[i] = *(const u32x4*)(rp + OFF_VNA); } }
        const int cs = min(max(cq - 8, 0), 48);
        const unsigned kb0 = 128u * qi + 16u * ((unsigned)g ^ ((unsigned)qi & 7u)), kb1 = 128u * qi + 16u * ((4u + (unsigned)g) ^ ((unsigned)qi & 7u));
        const LAS float* bias = (const LAS float*)(lds + LRPB);
        f32x4 sc[16]; float mx = -3.0e38f;
#pragma unroll
        for (int kr = 0; kr < 8; ++kr) {
            const int krow = rs + kr; const unsigned so = (unsigned)(krow % 9) * 8192u + 128u * (unsigned)cb;
            const int dr = krow - r + 7;
#pragma unroll
            for (int h2 = 0; h2 < 2; ++h2) {
                f32x4 a = (f32x4){0.f, 0.f, 0.f, 0.f};
                a = __builtin_amdgcn_mfma_f32_16x16x32_bf16(*(const LAS bf16x8*)(lds + LKR + so + 2048u * h2 + kb0), qn[0], a, 0, 0, 0);
                a = __builtin_amdgcn_mfma_f32_16x16x32_bf16(*(const LAS bf16x8*)(lds + LKR + so + 2048u * h2 + kb1), qn[1], a, 0, 0, 0);
#pragma unroll
                for (int j = 0; j < 4; ++j) {
                    const int kcol = cb + 16 * h2 + 4 * g + j;
                    const int dc = min(max(kcol - cq + 15, 0), 30);
                    const float v = a[j] + bias[dr * 31 + dc];
                    const bool in = (kcol >= cs) && (kcol < cs + 16);
                    a[j] = in ? v : -3.0e38f; mx = fmaxf(mx, a[j]);
                }
                sc[2 * kr + h2] = a;
            }
        }
        mx = fmaxf(mx, __shfl_xor(mx, 16)); mx = fmaxf(mx, __shfl_xor(mx, 32));
        float sum = 0.f; bf16x8 pt[8];
#pragma unroll
        for (int kk = 0; kk < 8; ++kk) {
            float pv[8];
#pragma unroll
            for (int h2 = 0; h2 < 2; ++h2)
#pragma unroll
                for (int j = 0; j < 4; ++j) { const float e = __builtin_amdgcn_exp2f((sc[2 * kk + h2][j] - mx) * 1.4426950408889634f); pv[4 * h2 + j] = e; sum += e; }
            pt[kk] = ret::pack8(pv);
        }
        sum += __shfl_xor(sum, 16); sum += __shfl_xor(sum, 32);
        const float inv = 1.f / sum;
        const unsigned sl = (((unsigned)g & 1u) << 2) | qp;
        bf16_t* op = ymix + (size_t)tq * D + head * 64 + 4 * g;
#pragma unroll
        for (int db = 0; db < 4; ++db) {
            const unsigned vb = 128u * (4u * (unsigned)g + qp) + 16u * ((2u * db + (p >> 1)) ^ sl) + 8u * (p & 1u);
            f32x4 y = (f32x4){0.f, 0.f, 0.f, 0.f};
#pragma unroll
            for (int kk = 0; kk < 8; ++kk) {
                const unsigned so = (unsigned)((rs + kk) % 9) * 8192u + 128u * (unsigned)cb;
                const ret::s16x4 lo = __builtin_amdgcn_ds_read_tr16_b64_v4i16((LAS ret::s16x4*)(lds + LVR + so + vb));
                const ret::s16x4 hi = __builtin_amdgcn_ds_read_tr16_b64_v4i16((LAS ret::s16x4*)(lds + LVR + so + 2048u + vb));
                y = __builtin_amdgcn_mfma_f32_16x16x32_bf16(__builtin_shufflevector(lo, hi, 0, 1, 2, 3, 4, 5, 6, 7), pt[kk], y, 0, 0, 0);
            }
            u32x2 o; o.x = ret::cvtpk(y[0] * inv, y[1] * inv); o.y = ret::cvtpk(y[2] * inv, y[3] * inv);
            *(u32x2*)(op + 16 * db) = o;
        }
    }
    __syncthreads();
}
}

__device__ __forceinline__ void unpack_t16r(const u32x4 a, const u32x4 b, f32x4 (&v)[4]) {
    v[0] = (f32x4){__uint_as_float(a.x << 16), __uint_as_float(a.x & 0xffff0000u), __uint_as_float(a.y << 16), __uint_as_float(a.y & 0xffff0000u)};
    v[1] = (f32x4){__uint_as_float(a.z << 16), __uint_as_float(a.z & 0xffff0000u), __uint_as_float(a.w << 16), __uint_as_float(a.w & 0xffff0000u)};
    v[2] = (f32x4){__uint_as_float(b.x << 16), __uint_as_float(b.x & 0xffff0000u), __uint_as_float(b.y << 16), __uint_as_float(b.y & 0xffff0000u)};
    v[3] = (f32x4){__uint_as_float(b.z << 16), __uint_as_float(b.z & 0xffff0000u), __uint_as_float(b.w << 16), __uint_as_float(b.w & 0xffff0000u)};
}
__device__ __forceinline__ void ln1_row(const u32x4 ra, const u32x4 rb, const LAS float* cv  , bf16_t* __restrict__ hf, unsigned char* __restrict__ hf8, float* __restrict__ stats, int row, int lane) {
    asm volatile("" : "+v"(cv));
    const int c0 = lane * 16;
    f32x4 v[4]; float s = 0.f;
    unpack_t16r(ra, rb, v);
#pragma unroll
    for (int j = 0; j < 4; ++j) s += (v[j].x + v[j].y) + (v[j].z + v[j].w);
    const float mean = wave_sum(s) * (1.f / D); float s2 = 0.f;
#pragma unroll
    for (int j = 0; j < 4; ++j) { v[j] = v[j] - mean; s2 += (v[j].x * v[j].x + v[j].y * v[j].y) + (v[j].z * v[j].z + v[j].w * v[j].w); }
    const float rstd = 1.f / sqrtf(wave_sum(s2) * (1.f / D) + LN_EPS);
    if (lane == 0) *(f32x2*)(stats + 2 * (size_t)row) = (f32x2){mean, rstd};
    u32x4 ob[2], o8;
#pragma unroll
    for (int j = 0; j < 4; ++j) { const int col = c0 + 4 * j;
        const f32x4 gg = *(const LAS f32x4*)(cv + col), bv = *(const LAS f32x4*)(cv + 1024 + col), sc1 = *(const LAS f32x4*)(cv + 2048 + col), sh = *(const LAS f32x4*)(cv + 3072 + col);
        const f32x4 h4 = (v[j] * rstd * gg + bv) * sc1 + sh;
        const unsigned p0 = pk2(h4.x, h4.y), p1 = pk2(h4.z, h4.w);
        if (j == 0) { ob[0].x = p0; ob[0].y = p1; } else if (j == 1) { ob[0].z = p0; ob[0].w = p1; } else if (j == 2) { ob[1].x = p0; ob[1].y = p1; } else { ob[1].z = p0; ob[1].w = p1; }
        const f32x4 h8 = h4 * S_HF8;
        int w0 = __builtin_amdgcn_cvt_pk_fp8_f32(clamp8(h8.x), clamp8(h8.y), 0, false); w0 = __builtin_amdgcn_cvt_pk_fp8_f32(clamp8(h8.z), clamp8(h8.w), w0, true);
        if (j == 0) o8.x = (unsigned)w0; else if (j == 1) o8.y = (unsigned)w0; else if (j == 2) o8.z = (unsigned)w0; else o8.w = (unsigned)w0; }
    *(u32x4*)(hf + (size_t)row * D + c0) = ob[0]; *(u32x4*)(hf + (size_t)row * D + c0 + 8) = ob[1];
    *(u32x4*)(hf8 + (size_t)row * D + c0) = o8;
}
__device__ __forceinline__ void top2_merge(float& a1, float& a2, float b1, float b2) { const float n1 = fmaxf(a1, b1); const float n2 = fmaxf(fminf(a1, b1), fmaxf(a2, b2)); a1 = n1; a2 = n2; }
__device__ __forceinline__ float sigm(float x) { return 1.f / (1.f + __expf(-x)); }
__device__ __forceinline__ void route_lane(const float* __restrict__ logits, const float* __restrict__ rbias, int* __restrict__ topk_e, float* __restrict__ topk_w, LAS unsigned* hist, int tok) {
    const float NEG = -3.0e38f;
    const float* row = logits + (size_t)tok * NE;
    float gs[8];
#pragma unroll
    for (int g = 0; g < 8; ++g) {
        float m1 = NEG, m2 = NEG;
#pragma unroll
        for (int q = 0; q < 8; ++q) {
            const f32x4 lg = *(const f32x4*)(row + g * 32 + q * 4), b4 = *(const f32x4*)(rbias + g * 32 + q * 4);
            const float v[4] = {sigm(lg.x) + b4.x, sigm(lg.y) + b4.y, sigm(lg.z) + b4.z, sigm(lg.w) + b4.w};
#pragma unroll
            for (int j = 0; j < 4; ++j) { m2 = fmaxf(m2, fminf(m1, v[j])); m1 = fmaxf(m1, v[j]); }
        }
        gs[g] = m1 + m2;
        if (g & 1) asm volatile("" ::: "memory");
    }
    int pc[8];
    { int run = 0;
#pragma unroll
      for (int g = 0; g < 8; ++g) { int rank = 0;
#pragma unroll
          for (int h = 0; h < 8; ++h) if (h != g) rank += (gs[h] > gs[g] || (gs[h] == gs[g] && h < g)) ? 1 : 0;
          run += (rank < 4) ? 1 : 0; pc[g] = run; } }
    float L[8]; int I[8];
#pragma unroll
    for (int i = 0; i < 8; ++i) { L[i] = NEG; I[i] = 0; }
#pragma unroll 1
    for (int k = 0; k < 4; ++k) {
        int gk = 0;
#pragma unroll
        for (int g = 0; g < 8; ++g) gk += (pc[g] <= k) ? 1 : 0;
        const int base = gk * 32;
#pragma unroll
        for (int q = 0; q < 8; ++q) {
            const f32x4 lg = *(const f32x4*)(row + base + q * 4), b4 = *(const f32x4*)(rbias + base + q * 4);
            const float cv[4] = {sigm(lg.x) + b4.x, sigm(lg.y) + b4.y, sigm(lg.z) + b4.z, sigm(lg.w) + b4.w};
#pragma unroll
            for (int j = 0; j < 4; ++j) { float v = cv[j]; int idx = base + q * 4 + j;
#pragma unroll
                for (int i = 0; i < 8; ++i) { const bool gt = v > L[i]; const float tv = gt ? L[i] : v; const int ti = gt ? I[i] : idx; L[i] = gt ? v : L[i]; I[i] = gt ? idx : I[i]; v = tv; idx = ti; } }
        }
    }
    float w[8], wsum = 0.f;
#pragma unroll
    for (int i = 0; i < 8; ++i) { w[i] = sigm(row[I[i]]); wsum += w[i]; }
    const float sc = 2.5f / wsum;
    *(u32x4*)(topk_e + tok * TOPK) = (u32x4){(unsigned)I[0], (unsigned)I[1], (unsigned)I[2], (unsigned)I[3]}; *(u32x4*)(topk_e + tok * TOPK + 4) = (u32x4){(unsigned)I[4], (unsigned)I[5], (unsigned)I[6], (unsigned)I[7]};
    *(f32x4*)(topk_w + tok * TOPK) = (f32x4){w[0] * sc, w[1] * sc, w[2] * sc, w[3] * sc}; *(f32x4*)(topk_w + tok * TOPK + 4) = (f32x4){w[4] * sc, w[5] * sc, w[6] * sc, w[7] * sc};
#pragma unroll
    for (int i = 0; i < 8; ++i) __hip_atomic_fetch_add(&hist[I[i]], 1u, __ATOMIC_RELAXED, __HIP_MEMORY_SCOPE_WORKGROUP);
}
__device__ __forceinline__ void build_tables(const unsigned* ctl, LAS unsigned* tab, const int tid) {
    if (tid < 64) {
        const int lane = tid;
        unsigned c[4], so = 0, st = 0;
#pragma unroll
        for (int j = 0; j < 4; ++j) { c[j] = __hip_atomic_load(ctl + CW_COUNT + lane * 4 + j, __ATOMIC_RELAXED, __HIP_MEMORY_SCOPE_AGENT); so += c[j]; st += (c[j] + 255u) >> 8; }
        unsigned io = so, it = st;
#pragma unroll
        for (int o = 1; o < 64; o <<= 1) { const unsigned a = __shfl_up(io, o), b = __shfl_up(it, o); if (lane >= o) { io += a; it += b; } }
        unsigned eo = io - so, et = it - st;
#pragma unroll
        for (int j = 0; j < 4; ++j) { tab[T_CNT + lane * 4 + j] = c[j]; tab[T_OFF + lane * 4 + j] = eo; tab[T_TILE + lane * 4 + j] = et; eo += c[j]; et += (c[j] + 255u) >> 8; }
        if (lane == 63) { tab[T_OFF + NE] = eo; tab[T_TILE + NE] = et; }
    }
    __syncthreads();
}
struct RowRaw { u32x4 y[9]; u32x4 t[2]; f32x2 st; };
__device__ __forceinline__ void final_load(RowRaw& R, const bf16_t* __restrict__ tb, const unsigned char* __restrict__ ybuf, const unsigned char* __restrict__ ysh, const float* __restrict__ stats, int row, int lane) {
    const int c0 = lane * 16;
#pragma unroll
    for (int k = 0; k < TOPK; ++k) R.y[k] = *(const u32x4*)(ybuf + ((size_t)row * TOPK + k) * D + c0);
    R.y[8] = *(const u32x4*)(ysh + (size_t)row * D + c0);
    R.t[0] = *(const u32x4*)(tb + (size_t)row * D + c0); R.t[1] = *(const u32x4*)(tb + (size_t)row * D + c0 + 8);
    R.st = *(const f32x2*)(stats + 2 * (size_t)row);
}
__device__ __forceinline__ void final_row(float* __restrict__ out, const RowRaw& R, const LAS float* cv  , int row, int lane) {
    asm volatile("" : "+v"(cv));
    const int c0 = lane * 16;
    f32x4 a[4], t[4], v[4]; float s = 0.f;
#pragma unroll
    for (int j = 0; j < 4; ++j) a[j] = (f32x4){0.f, 0.f, 0.f, 0.f};
#pragma unroll
    for (int k = 0; k < 9; ++k) { const unsigned w[4] = {R.y[k].x, R.y[k].y, R.y[k].z, R.y[k].w};
#pragma unroll
        for (int j = 0; j < 4; ++j) { const f32x2 lo = __builtin_amdgcn_cvt_pk_f32_fp8((int)w[j], false), hi = __builtin_amdgcn_cvt_pk_f32_fp8((int)w[j], true); a[j].x += lo.x; a[j].y += lo.y; a[j].z += hi.x; a[j].w += hi.y; } }
    unpack_t16r(R.t[0], R.t[1], t);
#pragma unroll
    for (int j = 0; j < 4; ++j) { const int col = c0 + 4 * j;
        const f32x4 x1 = (t[j] - R.st.x) * R.st.y * *(const LAS f32x4*)(cv + col) + *(const LAS f32x4*)(cv + 1024 + col);
        v[j] = x1 * ALPHA + *(const LAS f32x4*)(cv + 4096 + col) * a[j] * YINV;
        s += (v[j].x + v[j].y) + (v[j].z + v[j].w); }
    const float mean = wave_sum(s) * (1.f / D); float s2 = 0.f;
#pragma unroll
    for (int j = 0; j < 4; ++j) { v[j] = v[j] - mean; s2 += (v[j].x * v[j].x + v[j].y * v[j].y) + (v[j].z * v[j].z + v[j].w * v[j].w); }
    const float rstd = 1.f / sqrtf(wave_sum(s2) * (1.f / D) + LN_EPS);
#pragma unroll
    for (int j = 0; j < 4; ++j) { const int col = c0 + 4 * j;
        *(f32x4*)(out + (size_t)row * D + col) = v[j] * rstd * *(const LAS f32x4*)(cv + 2048 + col) + *(const LAS f32x4*)(cv + 3072 + col); }
}

#ifndef MK_PER_PHASE
#define MK_PER_PHASE 0
#endif
constexpr int N_PHASES = 13;
struct Args { Ctx X; int ph_lo, ph_hi; };
typedef __attribute__((address_space(4))) const Ctx* CtxCP;
__device__ __forceinline__ CtxCP ctx_ptr() { CtxCP p = (CtxCP)__builtin_amdgcn_kernarg_segment_ptr(); asm volatile("" : "+s"(p)); return p; }

__global__ void __launch_bounds__(NW * 64, 2) mk_fwd(Args args) {
    extern __shared__ __attribute__((aligned(16))) unsigned char lds_raw[];
    LAS unsigned char* lds = (LAS unsigned char*)lds_raw;
    LAS unsigned* tab = (LAS unsigned*)(lds + TAB_OFF);
    volatile LAS unsigned* MISC = (volatile LAS unsigned*)(lds + MISC_OFF);
#define PH_BEGIN \
    const __attribute__((address_space(4))) Ctx& X = *ctx_ptr(); unsigned char* ws = X.ws; (void)ws; \
    const int lane = lane_id(), wave = wave0, tid = wave0 * 64 + lane; (void)lane; (void)wave; (void)tid; \
    const int G = gridDim.x, bx = blockIdx.x; (void)G; (void)bx; \
    const int gw = bx * NW + wave, NGW = G * NW; (void)gw; (void)NGW; \
    const int gt = bx * (NW * 64) + tid, NGT = G * NW * 64; (void)gt; (void)NGT; \
    unsigned* ctl = (unsigned*)(ws + WS_CTL); float* mod = (float*)(ws + WS_MOD); float* rope = (float*)(ws + WS_ROPE); (void)ctl; (void)mod; (void)rope; \
    bf16_t* win_t = (bf16_t*)(ws + WS_WIN_T); bf16_t* wout_t = (bf16_t*)(ws + WS_WOUT_T); bf16_t* wr_t = (bf16_t*)(ws + WS_WR_T); (void)win_t; (void)wout_t; (void)wr_t; \
    bf16_t* wsgu_t = (bf16_t*)(ws + WS_WSGU_T); bf16_t* wsd_t = (bf16_t*)(ws + WS_WSD_T); bf16_t* wd_t = (bf16_t*)(ws + WS_WD_T); bf16_t* wgu_t = (bf16_t*)(ws + WS_WGU_T); (void)wsgu_t; (void)wsd_t; (void)wd_t; (void)wgu_t; \
    int* slot_ent = (int*)(ws + WS_SLOT_ENT); float* slot_w = (float*)(ws + WS_SLOT_W); int* topk_e = (int*)(ws + WS_TOPK_E); float* topk_w = (float*)(ws + WS_TOPK_W); (void)slot_ent; (void)slot_w; (void)topk_e; (void)topk_w; \
    bf16_t* ymix = (bf16_t*)(ws + WS_YMIX); bf16_t* proj = (bf16_t*)(ws + WS_PROJ); bf16_t* hbuf = (bf16_t*)(ws + WS_YMIX); (void)ymix; (void)proj; (void)hbuf; \
    float* logits = (float*)(ws + WS_LOGITS); bf16_t* shh = (bf16_t*)(ws + WS_SHH); bf16_t* hf = (bf16_t*)(ws + WS_HF); bf16_t* act = (bf16_t*)(ws + WS_ACT); (void)logits; (void)shh; (void)hf; (void)act; \
    unsigned char* ybuf = ws + WS_YBUF; float* out = X.out; (void)ybuf; (void)out;

    const int wave0 = __builtin_amdgcn_readfirstlane((int)threadIdx.x >> 6);
    for (int u = threadIdx.x; u < (LDS_BYTES - MISC_OFF) / 4; u += NW * 64) ((LAS unsigned*)(lds + MISC_OFF))[u] = 0u;
    __syncthreads();
    if (!MK_PER_PHASE) { unsigned* ctl0 = (unsigned*)(args.X.ws + WS_CTL); (void)xcd_barrier_post(ctl0 + CW_BAR, MISC + 8, wave0 == 0 && lane_id() == 0); }
    const int lo = args.ph_lo, hi = args.ph_hi;
#ifndef MK_DUP
#define MK_DUP -1
#endif
#define REPS(k) for (int _rep = 0; _rep < ((MK_DUP == (k)) ? 2 : 1); ++_rep)
#ifdef MK_ONLY
#define IN(k) ((k) == MK_ONLY)
#else
#define IN(k) (lo <= (k) && (k) < hi)
#endif
#define SEAM(k) SEAM2(k, (k) + 1)
#define SEAM2(k, k2) do { if (IN(k) && IN(k2)) { XcdBarrier _b; _b.bar = (unsigned*)(ctx_ptr()->ws + WS_CTL) + CW_BAR; _b.x = xb_xcc_id(); _b.st = (volatile LAS unsigned*)(lds + MISC_OFF) + 8; xcd_barrier(_b, wave0 == 0 && lane_id() == 0); } } while (0)

    REPS(0) if (IN(0)) { PH_BEGIN
        LAS float* scr = (LAS float*)(lds + wave * 16384);
        float* modp = (float*)(ws + WS_PROJ);
        for (int t = gw; t < 96 * 16; t += NGW) mod_task(X.c, X.w_ada, modp, t, lane);
        constexpr int I_IN = (D / 64) * (DIN / 32), I_OUT = (D / 64) * (D / 32), I_R = (D / 64) * (NE / 32), I_SG = (D / 64) * (DE / 32), I_SD = (DE / 64) * (D / 32);
        constexpr int I_EG = I_SG, I_ED = I_SD;
        constexpr int N_SMALL = I_IN + I_OUT + I_R + 2 * I_SG + I_SD;
        constexpr int N_ITEMS = N_SMALL + NE * (2 * I_EG + I_ED);
        for (int it = gw; it < N_ITEMS; it += NGW) {
            int r = it;
            if (r < I_IN) { transpose_item(X.w_in, D, DIN, win_t, 0, 0, scr, r, lane); continue; } r -= I_IN;
            if (r < I_OUT) { transpose_item(X.w_out, D, D, wout_t, 0, 0, scr, r, lane); continue; } r -= I_OUT;
            if (r < I_R) { transpose_item(X.w_router, D, NE, wr_t, 0, 0, scr, r, lane); continue; } r -= I_R;
            if (r < I_SG) { transpose_item(X.ws_gate, D, DE, wsgu_t, 8, 0, scr, r, lane); continue; } r -= I_SG;
            if (r < I_SG) { transpose_item(X.ws_up, D, DE, wsgu_t, 8, 1, scr, r, lane); continue; } r -= I_SG;
            if (r < I_SD) { transpose_item(X.ws_down, DE, D, wsd_t, 0, 0, scr, r, lane); continue; } r -= I_SD;
            const int e = r / (2 * I_EG + I_ED); r -= e * (2 * I_EG + I_ED);
            if (r < I_EG) { transpose_item_fp8(X.w_gate + (size_t)e * D * DE, D, DE, (unsigned char*)wgu_t + (size_t)e * 512 * D, 8, 0, S_WGU8, scr, r, lane); continue; } r -= I_EG;
            if (r < I_EG) { transpose_item_fp8(X.w_up + (size_t)e * D * DE, D, DE, (unsigned char*)wgu_t + (size_t)e * 512 * D, 8, 1, S_WGU8, scr, r, lane); continue; } r -= I_EG;
            transpose_item_fp8(X.w_down + (size_t)e * DE * D, DE, D, (unsigned char*)wd_t + (size_t)e * D * DE, 0, 0, S_WD8, scr, r, lane);
        }
        for (int i = gt; i < SEQ * 64; i += NGT) rope_entry(rope, i);
    }
    SEAM(0);
    REPS(1) if (IN(1)) { PH_BEGIN
        const float* modp = (const float*)(ws + WS_PROJ);
        for (int i = gt; i < 32 * 6144; i += NGT) mod[i] = mod_sum(modp, X.b_ada, i / 6144, i % 6144);
        LAS float* ssc = (LAS float*)lds; LAS float* ssh = ssc + 1024;
        int curb = -1;
        for (int c = bx; c < M / 256; c += G) {
            const int b = c >> 3;
            if (b != curb) {
                __syncthreads();
                for (int i = tid; i < 1024; i += NW * 64) { ssc[i] = 1.f + mod_sum(modp, X.b_ada, b, MOD_SCALE_A + i); ssh[i] = mod_sum(modp, X.b_ada, b, MOD_SHIFT_A + i); }
                __syncthreads();
                curb = b;
            }
            const f32x4 sc = *(const LAS f32x4*)(ssc + (tid & 255) * 4), sh = *(const LAS f32x4*)(ssh + (tid & 255) * 4);
            const float* xp = X.x + (size_t)c * 256 * D + (size_t)(tid >> 8) * D + (tid & 255) * 4;
            bf16_t* hp = hbuf + (size_t)c * 256 * D + (size_t)(tid >> 8) * D + (tid & 255) * 4;
            for (int i0 = 0; i0 < 128; i0 += 8) {
                f32x4 v[8];
#pragma unroll
                for (int i = 0; i < 8; ++i) v[i] = __builtin_nontemporal_load((const f32x4*)(xp + (size_t)(i0 + i) * 2 * D));
#pragma unroll
                for (int i = 0; i < 8; ++i) { u32x2 o; o.x = pk2(v[i].x * sc.x + sh.x, v[i].y * sc.y + sh.y); o.y = pk2(v[i].z * sc.z + sh.z, v[i].w * sc.w + sh.w); *(u32x2*)(hp + (size_t)(i0 + i) * 2 * D) = o; }
            }
        }
        __syncthreads();
    }
    SEAM(1);
    REPS(2) if (IN(2)) { PH_BEGIN
        pg8::DenseOrder S; S.init(M, DIN, D, win_t, G, bx);
        pg8::EpiInProj E{proj};
        pg8::gemm_phase(lds, (const char*)hbuf, D, S, E, tid);
    }
    SEAM(2);
    REPS(3) if (IN(3)) { PH_BEGIN
        REPS(31) for (int hu = bx; hu < BATCH * 4 * 2; hu += G) ret::unit(proj, rope, X.ret_ld, X.ret_gn, ymix, (unsigned char*)out + (size_t)hu * (8 * ret::TILE), lds, hu, tid);
        REPS(32) for (int u = bx; u < BATCH * 8; u += G) na::unit(proj, X.na_rpb, ymix, lds, u, tid);
    }
    SEAM2(3, 5);
    REPS(5) if (IN(5)) { PH_BEGIN
        pg8::DenseOrder S; S.init(M, D, D, wout_t, G, bx);
        pg8::EpiOutProj E{X.x, mod, (bf16_t*)(ws + WS_TB)};
        pg8::gemm_phase(lds, (const char*)ymix, D, S, E, tid);
    }
    SEAM(5);
    REPS(6) if (IN(6)) { PH_BEGIN
        LAS float* cv = (LAS float*)lds; int curb = -1;
        for (int c = bx; c < M / 256; c += G) {
            const int b = c >> 3;
            if (b != curb) {
                __syncthreads();
                if (tid < 256) { const int i = tid * 4; *(LAS f32x4*)(cv + i) = *(const f32x4*)(X.ln1_g + i); *(LAS f32x4*)(cv + 1024 + i) = *(const f32x4*)(X.ln1_b + i);
                    *(LAS f32x4*)(cv + 2048 + i) = *(const f32x4*)(mod + b * 6144 + MOD_SCALE_F + i) + 1.f; *(LAS f32x4*)(cv + 3072 + i) = *(const f32x4*)(mod + b * 6144 + MOD_SHIFT_F + i); }
                __syncthreads(); curb = b;
            }
            const bf16_t* tp = (const bf16_t*)(ws + WS_TB) + (size_t)(c * 256 + wave * 32) * D + lane * 16;
            u32x4 ra = *(const u32x4*)tp, rb = *(const u32x4*)(tp + 8);
#pragma unroll 1
            for (int i = 0; i < 32; ++i) {
                const u32x4 ca = ra, cb = rb; const int nx = i < 31 ? i + 1 : i;
                ra = *(const u32x4*)(tp + (size_t)nx * D); rb = *(const u32x4*)(tp + (size_t)nx * D + 8);
                ln1_row(ca, cb, cv, hf, ws + WS_HF8, (float*)(ws + WS_STATS), c * 256 + wave * 32 + i, lane);
            }
        }
        __syncthreads();
    }
    SEAM(6);
    REPS(7) if (IN(7)) { PH_BEGIN
        { pg8::DenseOrder S; S.init(M, NE, D, wr_t, G, bx); pg8::EpiRouter E{logits}; pg8::gemm_phase(lds, (const char*)hf, D, S, E, tid); }
        { pg8::DenseOrder S; S.init(M, 2 * DE, D, wsgu_t, G, bx); pg8::EpiGU<false> E{(void*)shh}; pg8::gemm_phase(lds, (const char*)hf, D, S, E, tid); }
    }
    SEAM(7);
    if (IN(8)) { PH_BEGIN
        LAS unsigned* hist = tab + T_HIST;
        if (tid < NE) hist[tid] = 0u;
        __syncthreads();
        for (int t0 = bx * 256; t0 < M; t0 += G * 256) { if (tid < 256) route_lane(logits, X.rbias, topk_e, topk_w, hist, t0 + tid); }
        __syncthreads();
        if (tid < NE && hist[tid]) atomicAdd(&ctl[CW_COUNT + tid], hist[tid]);
#if MK_DUP == 8
        __syncthreads();
        { int tok = gw;
          for (; tok + 3 * NGW < M; tok += 4 * NGW) route_tokens<4>(logits, bias, topk_e, topk_w, tab + T_BASE, tok, NGW, lane);
          for (; tok < M; tok += NGW) route_tokens<1>(logits, bias, topk_e, topk_w, tab + T_BASE, tok, NGW, lane); }
        __syncthreads();
#endif
    }
    SEAM(8);
    if (IN(9)) { PH_BEGIN
        build_tables(ctl, tab, tid);
        LAS unsigned* hist = tab + T_HIST; LAS unsigned* base = tab + T_BASE;
        for (int c0 = bx * 2048; c0 < NSLOT; c0 += G * 2048) {
            __syncthreads();
            if (tid < NE) hist[tid] = 0u;
            __syncthreads();
            int e[4]; unsigned loc[4];
#pragma unroll
            for (int i = 0; i < 4; ++i) { const int idx = c0 + i * 512 + tid; e[i] = topk_e[idx]; loc[i] = __hip_atomic_fetch_add(&hist[e[i]], 1u, __ATOMIC_RELAXED, __HIP_MEMORY_SCOPE_WORKGROUP); }
            __syncthreads();
            if (tid < NE && hist[tid]) base[tid] = atomicAdd(&ctl[CW_CURSOR + tid], hist[tid]);
            __syncthreads();
#pragma unroll
            for (int i = 0; i < 4; ++i) { const int idx = c0 + i * 512 + tid; const unsigned pos = tab[T_OFF + e[i]] + base[e[i]] + loc[i]; slot_ent[pos] = idx; slot_w[pos] = topk_w[idx]; }
        }
    }
    SEAM(9);
    if (IN(10)) { PH_BEGIN
        build_tables(ctl, tab, tid);
        REPS(10) { pg8::ExpertOrder<2, true> S; S.init(tab, D, wgu_t, (size_t)512 * D, slot_ent, slot_w, G, bx); pg8::EpiGU<true> E{(void*)act}; pg8::gemm_phase<1>(lds, (const char*)(ws + WS_HF8), D, S, E, tid); }
        { pg8::DenseOrder S; S.init(M, D, DE, wsd_t, G, bx); pg8::EpiSharedDown E{ws + WS_YSH}; pg8::gemm_phase(lds, (const char*)shh, DE, S, E, tid); }
    }
    SEAM(10);
    REPS(11) if (IN(11)) { PH_BEGIN
        build_tables(ctl, tab, tid);
        pg8::ExpertOrder<4, false> S; S.init(tab, DE, wd_t, (size_t)D * DE, slot_ent, slot_w, G, bx); pg8::EpiExpDown E{ybuf, slot_ent}; pg8::gemm_phase<1>(lds, (const char*)act, DE, S, E, tid);
#if MK_DUP == 111
        { pg8::ExpertOrder<4, false> S2; S2.init(tab, DE, wd_t, (size_t)D * DE, slot_ent, slot_w, G, bx); pg8::EpiProbeSum E2{(float*)(ws + WS_STATS)}; pg8::gemm_phase<1>(lds, (const char*)act, DE, S2, E2, tid); }
#endif
    }
    SEAM(11);
    REPS(12) if (IN(12)) { PH_BEGIN
        LAS float* cv = (LAS float*)lds; int curb = -1;
        for (int c = bx; c < M / 256; c += G) {
            const int b = c >> 3;
            if (b != curb) {
                __syncthreads();
                if (tid < 256) { const int i = tid * 4; *(LAS f32x4*)(cv + i) = *(const f32x4*)(X.ln1_g + i); *(LAS f32x4*)(cv + 1024 + i) = *(const f32x4*)(X.ln1_b + i);
                    *(LAS f32x4*)(cv + 2048 + i) = *(const f32x4*)(X.ln2_g + i); *(LAS f32x4*)(cv + 3072 + i) = *(const f32x4*)(X.ln2_b + i); *(LAS f32x4*)(cv + 4096 + i) = *(const f32x4*)(mod + b * 6144 + MOD_GATE_F + i); }
                __syncthreads(); curb = b;
            }
            const int r0 = c * 256 + wave * 32;
            RowRaw nx; final_load(nx, (const bf16_t*)(ws + WS_TB), ybuf, ws + WS_YSH, (const float*)(ws + WS_STATS), r0, lane);
#pragma unroll 1
            for (int i = 0; i < 32; ++i) {
                const RowRaw cur = nx;
                final_load(nx, (const bf16_t*)(ws + WS_TB), ybuf, ws + WS_YSH, (const float*)(ws + WS_STATS), r0 + (i < 31 ? i + 1 : i), lane);
                final_row(out, cur, cv, r0 + i, lane);
            }
        }
    }
#undef IN
#undef SEAM
}

extern "C" void kernel_launch(void* const* d_in, const int* in_sizes, int n_in, void* d_out, int out_size, void* d_ws, size_t ws_size, hipStream_t stream) {
    static int grid = 0;
    if (grid == 0) {
        if (n_in != 21 || in_sizes[0] != M * D || out_size != M * D || ws_size < WS_END) { fprintf(stderr, "kernel_launch: unexpected shapes (n_in %d, ws %zu)\n", n_in, ws_size); grid = -1; return; }
        int dev = 0, cus = 0, per_cu = 0;
        if (hipGetDevice(&dev) != hipSuccess || hipDeviceGetAttribute(&cus, hipDeviceAttributeMultiprocessorCount, dev) != hipSuccess) { grid = -1; return; }
        if (hipFuncSetAttribute((const void*)mk_fwd, hipFuncAttributeMaxDynamicSharedMemorySize, LDS_BYTES) != hipSuccess) { fprintf(stderr, "kernel_launch: hipFuncSetAttribute failed\n"); grid = -1; return; }
        if (hipOccupancyMaxActiveBlocksPerMultiprocessor(&per_cu, (const void*)mk_fwd, NW * 64, LDS_BYTES) != hipSuccess || per_cu < 1) { fprintf(stderr, "kernel_launch: occupancy query says %d\n", per_cu); }
        (void)hipGetLastError();
        grid = cus;
    }
    if (grid < 0) return;
    (void)hipMemsetAsync((char*)d_ws + WS_CTL, 0, 1 * MiB, stream);
    Args a{};
    const float** p = (const float**)&a.X;
    for (int i = 0; i < 21; ++i) p[i] = (const float*)d_in[i];
    a.X.out = (float*)d_out; a.X.ws = (unsigned char*)d_ws;
#if MK_PER_PHASE
    for (int ph = 0; ph < N_PHASES; ++ph) { a.ph_lo = ph; a.ph_hi = ph + 1; hipLaunchKernelGGL(mk_fwd, dim3(grid), dim3(NW * 64), LDS_BYTES, stream, a); }
#else
    a.ph_lo = 0; a.ph_hi = N_PHASES;
    hipLaunchKernelGGL(mk_fwd, dim3(grid), dim3(NW * 64), LDS_BYTES, stream, a);
#endif
}
```

```cpp
#include <hip/hip_runtime.h>
#include <cstdio>
#include <cstdint>

typedef unsigned short bf16_t;
typedef short bf16x8 __attribute__((ext_vector_type(8)));
typedef float f32x4 __attribute__((ext_vector_type(4)));
typedef float f32x2 __attribute__((ext_vector_type(2)));
typedef unsigned u32x4 __attribute__((ext_vector_type(4)));
typedef unsigned u32x2 __attribute__((ext_vector_type(2)));
#define LAS __attribute__((address_space(3)))

constexpr int D = 1024, BATCH = 32, SEQ = 2048, M = BATCH * SEQ;
constexpr int DIN = 3584;
constexpr int OFF_QNA = 0, OFF_KNA = 512, OFF_VNA = 1024, OFF_QR = 1536, OFF_KR = 2048, OFF_VR = 2560, OFF_GR = 3072;
constexpr int NE = 256, TOPK = 8, DE = 256;
constexpr int NSLOT = M * TOPK;
constexpr float LN_EPS = 1e-5f, GN_EPS = 1e-6f;
constexpr float ALPHA = 1.189207115002721f;
constexpr float YSCALE = 64.f, YINV = 1.f / 64.f;
constexpr float S_HF8 = 16.f, S_WGU8 = 256.f, S_ACT8 = 32.f, S_WD8 = 128.f;
constexpr float INV_GU8 = 1.f / (16.f * 256.f), INV_DN8 = 1.f / (32.f * 128.f);
constexpr int MOD_SHIFT_A = 0, MOD_SCALE_A = 1024, MOD_GATE_A = 2048, MOD_SHIFT_F = 3072, MOD_SCALE_F = 4096, MOD_GATE_F = 5120;

constexpr size_t MiB = 1u << 20;
constexpr size_t WS_CTL = 0;
constexpr size_t WS_MOD = 1 * MiB;
constexpr size_t WS_ROPE = 2 * MiB;
constexpr size_t WS_WIN_T = 4 * MiB;
constexpr size_t WS_WOUT_T = 11 * MiB;
constexpr size_t WS_WR_T = 13 * MiB;
constexpr size_t WS_WSGU_T = 14 * MiB;
constexpr size_t WS_WSD_T = 15 * MiB;
constexpr size_t WS_SLOT_ENT = 16 * MiB;
constexpr size_t WS_SLOT_W = 18 * MiB;
constexpr size_t WS_TOPK_E = 20 * MiB;
constexpr size_t WS_TOPK_W = 22 * MiB;
constexpr size_t WS_STATS = 24 * MiB;
constexpr size_t WS_WD_T = 32 * MiB;
constexpr size_t WS_WGU_T = 160 * MiB;
constexpr size_t WS_HF8 = 288 * MiB;
constexpr size_t WS_YMIX = 416 * MiB;
constexpr size_t WS_PROJ = 544 * MiB;
constexpr size_t WS_LOGITS = WS_PROJ + 384 * MiB;
constexpr size_t WS_SHH = 352 * MiB;
constexpr size_t WS_HF = WS_PROJ, WS_ACT = WS_PROJ + 128 * MiB;
constexpr size_t WS_YBUF = WS_WGU_T;
constexpr size_t WS_TB = WS_PROJ + 256 * MiB;
constexpr size_t WS_YSH = WS_PROJ + 384 * MiB;
constexpr size_t WS_END = 992 * MiB;
constexpr int CW_COUNT = 1024, CW_CURSOR = 1536, CW_BAR = 8192;

constexpr int RING_BYTES = 131072;
constexpr int TAB_OFF = RING_BYTES;
constexpr int T_OFF = 0, T_TILE = 260, T_CNT = 520, T_HIST = 776, T_BASE = 1032, TAB_WORDS = 1288;
constexpr int VN_OFF = TAB_OFF + 6144;
constexpr int ROWTAB_OFF = VN_OFF + 8192;
constexpr int PHASE_BYTES = 155648;
constexpr int MISC_OFF = PHASE_BYTES;
constexpr int LDS_BYTES = PHASE_BYTES + 256;
static_assert(TAB_WORDS * 4 <= 6144 && ROWTAB_OFF + 6144 <= PHASE_BYTES && LDS_BYTES <= 163840, "LDS map");

__device__ __forceinline__ unsigned f2bf(float f) { unsigned u = __float_as_uint(f); return (u + 0x7fffu + ((u >> 16) & 1u)) >> 16; }
__device__ __forceinline__ float bf2f(unsigned short h) { return __uint_as_float(((unsigned)h) << 16); }
__device__ __forceinline__ unsigned pk2(float lo, float hi) { return f2bf(lo) | (f2bf(hi) << 16); }
__device__ __forceinline__ unsigned cvt_pk_bf16(float lo, float hi) { unsigned r; asm volatile("v_cvt_pk_bf16_f32 %0, %1, %2" : "=v"(r) : "v"(lo), "v"(hi)); return r; }
__device__ __forceinline__ float silu_f(float v) { return v * __builtin_amdgcn_rcpf(1.f + __expf(-v)); }
__device__ __forceinline__ float wave_sum(float v) {
    v += __builtin_bit_cast(float, __builtin_amdgcn_update_dpp(0, __builtin_bit_cast(int, v), 0xB1, 0xf, 0xf, true));
    v += __builtin_bit_cast(float, __builtin_amdgcn_update_dpp(0, __builtin_bit_cast(int, v), 0x4E, 0xf, 0xf, true));
    v += __builtin_bit_cast(float, __builtin_amdgcn_update_dpp(0, __builtin_bit_cast(int, v), 0x141, 0xf, 0xf, true));
    v += __builtin_bit_cast(float, __builtin_amdgcn_update_dpp(0, __builtin_bit_cast(int, v), 0x140, 0xf, 0xf, true));
    const int b = __builtin_bit_cast(int, v);
    return (__builtin_bit_cast(float, __builtin_amdgcn_readlane(b, 0)) + __builtin_bit_cast(float, __builtin_amdgcn_readlane(b, 16))) + (__builtin_bit_cast(float, __builtin_amdgcn_readlane(b, 32)) + __builtin_bit_cast(float, __builtin_amdgcn_readlane(b, 48)));
}
__device__ __forceinline__ float clamp8(float v) { return __builtin_amdgcn_fmed3f(v, -440.f, 440.f); }
#define LDS_WAIT() asm volatile("s_waitcnt lgkmcnt(0)" ::: "memory")
__device__ __forceinline__ int lane_id() { return (int)__builtin_amdgcn_mbcnt_hi(~0u, __builtin_amdgcn_mbcnt_lo(~0u, 0u)); }

#define XB_TMO      128
#define XB_XCNT(j)  (256  + 64 * (j))
#define XB_XSUB(j)  (1280 + 64 * (j))
#define XB_XGEN(j)  (2304 + 64 * (j))
#define XB_TOP      3328
#define XB_TOPGEN   3392
#define XCD_BAR_WORDS 3456
#define XB_SPIN_CAP (1u << 23)
__device__ __forceinline__ unsigned xb_ld(unsigned* p)              { return __hip_atomic_load(p, __ATOMIC_RELAXED, __HIP_MEMORY_SCOPE_AGENT); }
__device__ __forceinline__ unsigned xb_add(unsigned* p, unsigned v) { return __hip_atomic_fetch_add(p, v, __ATOMIC_RELAXED, __HIP_MEMORY_SCOPE_AGENT); }
__device__ __forceinline__ unsigned xb_xcc_id() { return (unsigned)__builtin_amdgcn_s_getreg((3 << 11) | 20) & 0xFu; }
#define XB_SPIN(cond, bar) do { unsigned _sp = 0; while (cond) { __builtin_amdgcn_s_sleep(1); \
    if ((++_sp & 255u) == 0u) { if (xb_ld(&(bar)[XB_TMO])) break; if (_sp > XB_SPIN_CAP) { atomicAdd(&(bar)[XB_TMO], 1u); break; } } } } while (0)
struct XcdBarrier { unsigned* bar; unsigned x; volatile LAS unsigned* st; };
__device__ __forceinline__ XcdBarrier xcd_barrier_post(unsigned* bar, volatile LAS unsigned* st, bool leader) {
    XcdBarrier b; b.bar = bar; b.x = xb_xcc_id(); b.st = st;
    if (leader) (void)xb_add(&bar[XB_XCNT(b.x)], 1u);
    return b;
}
__device__ __forceinline__ void xcd_barrier_complete(unsigned* bar, unsigned x, unsigned& nloc, unsigned& nx) {
    const unsigned G = gridDim.x * gridDim.y * gridDim.z;
    unsigned sum, cnt, mine, sp = 0u;
    for (;;) {
        sum = 0u; cnt = 0u; mine = 0u;
#pragma unroll
        for (unsigned j = 0; j < 16; ++j) { const unsigned c = xb_ld(&bar[XB_XCNT(j)]); sum += c; cnt += (c > 0u) ? 1u : 0u; mine = (j == x) ? c : mine; }
        if (sum == G) break;
        __builtin_amdgcn_s_sleep(1);
        if ((++sp & 255u) == 0u) { if (xb_ld(&bar[XB_TMO])) break; if (sp > XB_SPIN_CAP) { atomicAdd(&bar[XB_TMO], 1u); break; } }
    }
    nloc = mine > 0u ? mine : 1u; nx = cnt > 0u ? cnt : 1u;
}
__device__ __forceinline__ void xcd_barrier(const XcdBarrier& b, bool leader) {
    asm volatile("s_waitcnt vmcnt(0)" ::: "memory");
    __syncthreads();
    if (leader) {
        unsigned* bar = b.bar;
        __builtin_amdgcn_s_waitcnt(0);
        unsigned nloc = b.st[0], nx = b.st[1];
        if (nloc == 0u) { xcd_barrier_complete(bar, b.x, nloc, nx); b.st[0] = nloc; b.st[1] = nx; }
        const unsigned old = xb_add(&bar[XB_XSUB(b.x)], 1u);
        const unsigned gen = old / nloc;
        if (old + 1u == (gen + 1u) * nloc) {
            __builtin_amdgcn_fence(__ATOMIC_RELEASE, "agent");
            asm volatile("s_waitcnt vmcnt(0)" ::: "memory");
            const unsigned og = xb_add(&bar[XB_TOP], 1u);
            const unsigned tg = og / nx;
            if (og + 1u == (tg + 1u) * nx) xb_add(&bar[XB_TOPGEN], 1u);
            else XB_SPIN(xb_ld(&bar[XB_TOPGEN]) == tg, bar);
            __builtin_amdgcn_fence(__ATOMIC_ACQUIRE, "agent");
            xb_add(&bar[XB_XGEN(b.x)], 1u);
            asm volatile("s_waitcnt vmcnt(0)" ::: "memory");
        } else {
            XB_SPIN(xb_ld(&bar[XB_XGEN(b.x)]) == gen, bar);
            __builtin_amdgcn_fence(__ATOMIC_ACQUIRE, "agent");
            asm volatile("s_waitcnt vmcnt(0)" ::: "memory");
        }
    }
    __syncthreads();
}

namespace pg8 {
constexpr int BM = 256, BK = 64, HALF = 128, HTB = HALF * BK * 2, STAGE_BYTES = 8 * HTB;
__device__ __forceinline__ int lds_byte(int r, int c) { const int st = (r >> 4) * 2 + (c >> 5), rr = r & 15, cc = c & 31, ob = rr * 64 + cc * 2; return st * 1024 + (ob ^ (((ob >> 9) & 1) << 5)); }
__device__ __forceinline__ void stage_rc(int b, int& R, int& C) { const int st = b / 1024, sb = b % 1024, swz = sb ^ (((sb >> 9) & 1) << 5); R = (st >> 1) * 16 + swz / 64; C = (st & 1) * 32 + (swz % 64) / 2; }
__device__ __forceinline__ int perm32(int rho) { const int n = rho >> 4, i = rho & 15; return 8 * (i >> 2) + 4 * n + (i & 3); }

typedef int i32x8 __attribute__((ext_vector_type(8)));
__device__ __forceinline__ i32x8 cat8(const bf16x8 lo, const bf16x8 hi) { const u32x4 a = __builtin_bit_cast(u32x4, lo), b = __builtin_bit_cast(u32x4, hi); return (i32x8){(int)a.x, (int)a.y, (int)a.z, (int)a.w, (int)b.x, (int)b.y, (int)b.z, (int)b.w}; }
struct Unit { int pm, pn; const char* B; int e, cnt, off; };

template <int ESZ = 2, class Epi, class Sched>
__device__ __forceinline__ void gemm_phase(LAS unsigned char* lds, const char* Abase, const int K, const Sched& S, const Epi& E, const int tid_in) {
    int tid_ = tid_in; asm volatile("" : "+v"(tid_));
    const int tid = tid_, wid = __builtin_amdgcn_readfirstlane(tid >> 6), lane = tid & 63, wr = wid >> 2, wc = wid & 3, fr = lane & 15, fq = lane >> 4;
    const int rowbytes = K * ESZ, nt = rowbytes / 128;
    int Rr[2], Cc[2]; unsigned voffB[2], voffA[2];
#pragma unroll
    for (int i = 0; i < 2; ++i) { int R, C; stage_rc(tid * 16 + i * 8192, R, C); Rr[i] = R; Cc[i] = C; const int Rb = Epi::PERM ? (64 * (R >> 5) + 16 * ((R >> 2) & 3) + 4 * ((R >> 4) & 1) + (R & 3)) : R; voffB[i] = (unsigned)(Rb * rowbytes + C * 2); voffA[i] = (unsigned)(R * rowbytes + C * 2); }
    constexpr bool GATHER = Sched::GATHER;
    const size_t kstep = (size_t)128;
    const size_t hstep = (size_t)HALF * rowbytes;
    const size_t bhstep = (size_t)(Epi::PERM ? 8 : HALF) * rowbytes;
    const unsigned ldsw = (unsigned)wid * 1024u;
    const int aoff = (ESZ == 2) ? lds_byte(wr * 64 + fr, fq * 8) : lds_byte(wr * 64 + fr, 16 * (fq & 1)) + 1024 * (fq >> 1);
    const int boff = (ESZ == 2) ? lds_byte(wc * 32 + fr, fq * 8) : lds_byte(wc * 32 + fr, 16 * (fq & 1)) + 1024 * (fq >> 1);
#define PG8_SA(b, h) (((b) * 2 + (h)) * HTB)
#define PG8_SB(b, h) ((4 + (b) * 2 + (h)) * HTB)
#define PG8_STAGE(bufoff, gbase, voff) do { _Pragma("unroll") for (int _i = 0; _i < 2; ++_i) \
        __builtin_amdgcn_global_load_lds((const unsigned*)((const char*)(gbase) + (voff)[_i]), (LAS unsigned*)(lds + (bufoff) + ldsw + _i * 8192), 16, 0, 0); } while (0)
#define PG8_STAGEA(bufoff, uptr, koff, NEXT, h) do { if constexpr (GATHER) { if (NEXT) { const u32x2 _t = *(const LAS u32x2*)(vnslot + 2 * (h)); unsigned _v[2] = {_t.x, _t.y}; PG8_STAGE(bufoff, Abase + (koff), _v); } else { PG8_STAGE(bufoff, Abase + (koff), vc[h]); } } \
        else { PG8_STAGE(bufoff, (uptr) + (size_t)(h) * hstep + (koff), voffA); } } while (0)
#define PG8_LDA(dst, b, h) do { _Pragma("unroll") for (int m = 0; m < 4; ++m) { if constexpr (ESZ == 2) { _Pragma("unroll") for (int k = 0; k < 2; ++k) dst[m].q[k] = *(const LAS bf16x8*)(lds + PG8_SA(b, h) + aoff + m * 2048 + k * 1024); } \
        else dst[m].w = cat8(*(const LAS bf16x8*)(lds + PG8_SA(b, h) + aoff + m * 2048), *(const LAS bf16x8*)(lds + PG8_SA(b, h) + aoff + m * 2048 + 16)); } } while (0)
#define PG8_LDB(dst, b, h) do { _Pragma("unroll") for (int n = 0; n < 2; ++n) { if constexpr (ESZ == 2) { _Pragma("unroll") for (int k = 0; k < 2; ++k) dst[n].q[k] = *(const LAS bf16x8*)(lds + PG8_SB(b, h) + boff + n * 2048 + k * 1024); } \
        else dst[n].w = cat8(*(const LAS bf16x8*)(lds + PG8_SB(b, h) + boff + n * 2048), *(const LAS bf16x8*)(lds + PG8_SB(b, h) + boff + n * 2048 + 16)); } } while (0)
#define PG8_MMA(ai, bj, At, Bt) do { __builtin_amdgcn_s_setprio(1); _Pragma("unroll") for (int m = 0; m < 4; ++m) _Pragma("unroll") for (int n = 0; n < 2; ++n) { \
        if constexpr (ESZ == 2) { _Pragma("unroll") for (int k = 0; k < 2; ++k) acc[ai][bj][m][n] = __builtin_amdgcn_mfma_f32_16x16x32_bf16(Bt[n].q[k], At[m].q[k], acc[ai][bj][m][n], 0, 0, 0); } \
        else { asm volatile("v_mfma_f32_16x16x128_f8f6f4 %0, %1, %2, %0" : "+v"(acc[ai][bj][m][n]) : "v"(Bt[n].w), "v"(At[m].w)); } } \
        __builtin_amdgcn_s_setprio(0); } while (0)
#define PG8_WAIT_V(n) asm volatile("s_waitcnt vmcnt(" #n ")" ::: "memory")
#define PG8_WAIT_L(n) asm volatile("s_waitcnt lgkmcnt(" #n ")" ::: "memory")
#define PG8_BAR __builtin_amdgcn_s_barrier()
#define PG8_SCHED __builtin_amdgcn_sched_barrier(0)
    Unit cur, nxt; int ui = 0;
    if (!S.next(0, cur)) return;
    f32x4 acc[2][2][4][2];
    union Frag { bf16x8 q[2]; i32x8 w; };
    Frag At[4], B0[2], B1[2];
    unsigned vc[2][2];
    LAS unsigned* vnslot = (LAS unsigned*)(lds + (VN_OFF - 0)) + tid * 4;
    if constexpr (GATHER) S.avoff(cur, Rr, Cc, vc, tid);
    LAS unsigned* rowtab = (LAS unsigned*)(lds + ROWTAB_OFF);
    if constexpr (GATHER) S.rowtab(cur, rowtab, tid);
    const char* cB = cur.B; const char* cA = Abase + S.aoff(cur);
    PG8_STAGE(PG8_SB(0, 0), cB, voffB); PG8_STAGE(PG8_SB(0, 1), cB + bhstep, voffB); PG8_STAGEA(PG8_SA(0, 0), cA, 0, false, 0); PG8_STAGEA(PG8_SA(0, 1), cA, 0, false, 1);
    if (wr == 1) PG8_BAR;
    PG8_WAIT_V(2); PG8_BAR;
    PG8_STAGE(PG8_SB(1, 0), cB + kstep, voffB); PG8_STAGEA(PG8_SA(1, 0), cA, kstep, false, 0); PG8_STAGE(PG8_SB(1, 1), cB + bhstep + kstep, voffB);
    PG8_WAIT_V(6); PG8_BAR;
    asm volatile("" ::: "memory");
#pragma unroll
    for (int a = 0; a < 2; ++a)
#pragma unroll
        for (int b = 0; b < 2; ++b)
#pragma unroll
            for (int m = 0; m < 4; ++m)
#pragma unroll
                for (int n = 0; n < 2; ++n) { acc[a][b][m][n] = (f32x4){0.f, 0.f, 0.f, 0.f}; asm volatile("" : "+v"(acc[a][b][m][n])); }
    asm volatile("s_nop 4" ::: "memory");
    for (;;) {
        const bool has_next = S.next(ui + 1, nxt);
        if constexpr (GATHER) {
            unsigned vn[2][2];
            if (has_next) S.avoff(nxt, Rr, Cc, vn, tid);
            else {
#pragma unroll
                for (int h = 0; h < 2; ++h)
#pragma unroll
                    for (int i = 0; i < 2; ++i) vn[h][i] = vc[h][i];
            }
            *(LAS u32x4*)vnslot = (u32x4){vn[0][0], vn[0][1], vn[1][0], vn[1][1]};
            if (has_next) S.rowtab(nxt, rowtab + 512 * ((ui + 1) % 3), tid);
        }
        const char* nB = has_next ? nxt.B : cB; const char* nA = has_next ? Abase + S.aoff(nxt) : cA;
        for (int t = 0; t < nt; t += 2) {
            const bool last = (t == nt - 2);
            const size_t k1 = (size_t)(t + 1) * kstep;
            const size_t k2 = last ? (size_t)0 : (size_t)(t + 2) * kstep, k3 = k2 + kstep;
            const char* u2 = last ? nA : cA; const char* b2 = last ? nB : cB + (size_t)(t + 2) * kstep;
            const char* b3 = b2 + kstep;
            PG8_LDB(B0, 0, 0); PG8_LDB(B1, 0, 1); PG8_SCHED; PG8_LDA(At, 0, 0); PG8_STAGEA(PG8_SA(1, 1), cA, k1, false, 1);
            PG8_WAIT_V(8); PG8_WAIT_L(0); PG8_BAR; PG8_MMA(0, 0, At, B0); PG8_MMA(0, 1, At, B1); PG8_BAR; PG8_SCHED;
            PG8_LDA(At, 0, 1); PG8_STAGE(PG8_SB(0, 0), b2, voffB); PG8_STAGE(PG8_SB(0, 1), b2 + bhstep, voffB); PG8_STAGEA(PG8_SA(0, 0), u2, k2, last, 0);
            PG8_WAIT_V(8); PG8_WAIT_L(0); PG8_BAR; PG8_MMA(1, 0, At, B0); PG8_MMA(1, 1, At, B1); PG8_BAR; PG8_SCHED;
            PG8_LDB(B0, 1, 0); PG8_LDB(B1, 1, 1); PG8_SCHED; PG8_LDA(At, 1, 0); PG8_STAGEA(PG8_SA(0, 1), u2, k2, last, 1);
            PG8_WAIT_V(8); PG8_WAIT_L(0); PG8_BAR; PG8_MMA(0, 0, At, B0); PG8_MMA(0, 1, At, B1); PG8_BAR; PG8_SCHED;
            PG8_LDA(At, 1, 1); PG8_STAGE(PG8_SB(1, 0), b3, voffB); PG8_STAGE(PG8_SB(1, 1), b3 + bhstep, voffB); PG8_STAGEA(PG8_SA(1, 0), u2, k3, last, 0);
            PG8_WAIT_V(8); PG8_WAIT_L(0); PG8_BAR; PG8_MMA(1, 0, At, B0); PG8_MMA(1, 1, At, B1); PG8_BAR; PG8_SCHED;
        }
        if (wr == 0) PG8_BAR;
        if constexpr (ESZ == 1) {
            asm volatile("s_nop 15\n\ts_nop 15" ::: "memory");
#pragma unroll
            for (int a = 0; a < 2; ++a)
#pragma unroll
                for (int b = 0; b < 2; ++b)
#pragma unroll
                    for (int m = 0; m < 4; ++m) asm volatile("" : "+v"(acc[a][b][m][0]), "+v"(acc[a][b][m][1]));
        }
        { const int l2 = lane_id(); E(acc, cur, wr, wc, l2 & 15, l2 >> 4, rowtab + 512 * (ui % 3)); }
        if (!has_next) break;
#pragma unroll
        for (int a = 0; a < 2; ++a)
#pragma unroll
            for (int b = 0; b < 2; ++b)
#pragma unroll
                for (int m = 0; m < 4; ++m)
#pragma unroll
                    for (int n = 0; n < 2; ++n) acc[a][b][m][n] = (f32x4){0.f, 0.f, 0.f, 0.f};
        cur = nxt; cB = nB; cA = nA; ++ui;
        if constexpr (GATHER) { const u32x4 _t = *(const LAS u32x4*)vnslot; vc[0][0] = _t.x; vc[0][1] = _t.y; vc[1][0] = _t.z; vc[1][1] = _t.w; }
        if (wr == 1) PG8_BAR;
    }
    PG8_WAIT_V(0);
    PG8_BAR;
#undef PG8_SA
#undef PG8_SB
#undef PG8_STAGE
#undef PG8_STAGEA
#undef PG8_LDA
#undef PG8_LDB
#undef PG8_MMA
#undef PG8_WAIT_V
#undef PG8_WAIT_L
#undef PG8_BAR
#undef PG8_SCHED
}

struct DenseOrder {
    int nM, nN, nwg, G, c, K; const char* Bt;
    __device__ __forceinline__ void init(int Mrows, int N, int K_, const void* Bt_, int G_, int c_) { nM = Mrows / BM; nN = N / BM; nwg = nM * nN; G = G_; c = c_; K = K_; Bt = (const char*)Bt_; }
    __device__ __forceinline__ bool next(int i, Unit& u) const {
        const long L = (long)i * G + c; if (L >= nwg) return false;
        int wgid = (int)L; { const int q = nwg / 8, r = nwg % 8, xcd = wgid % 8, off = wgid / 8; wgid = (xcd < r ? xcd * (q + 1) : r * (q + 1) + (xcd - r) * q) + off; }
        const int nig = 8 * nN, gid = wgid / nig, fm = gid * 8, gsz = (nM - fm) < 8 ? (nM - fm) : 8;
        u.pm = fm + ((wgid % nig) % gsz); u.pn = (wgid % nig) / gsz; u.B = Bt + (size_t)u.pn * BM * K * 2; u.e = 0; u.cnt = 0; u.off = 0; return true;
    }
    static constexpr bool GATHER = false;
    __device__ __forceinline__ size_t aoff(const Unit& u) const { return (size_t)u.pm * BM * K * 2; }
    __device__ __forceinline__ void avoff(const Unit&, const int (&)[2], const int (&)[2], unsigned (&)[2][2], int) const {}
};
struct RowOrder {
    int pm, ncol, K; const char* Bt;
    static constexpr bool GATHER = false;
    __device__ __forceinline__ bool next(int i, Unit& u) const { if (i >= ncol) return false; u.pm = pm; u.pn = i; u.B = Bt + (size_t)i * BM * K * 2; u.e = 0; u.cnt = 0; u.off = 0; return true; }
    __device__ __forceinline__ size_t aoff(const Unit& u) const { return (size_t)u.pm * BM * K * 2; }
    __device__ __forceinline__ void avoff(const Unit&, const int (&)[2], const int (&)[2], unsigned (&)[2][2], int) const {}
};
template <int NCOL, bool TOKROWS> struct ExpertOrder {
    static constexpr bool GATHER = true;
    __device__ __forceinline__ size_t aoff(const Unit&) const { return 0; }
    const LAS unsigned* tab; int per, c, K  ; const char* W; size_t wstride; const int* slot_ent; const float* slot_w;
    mutable int ehint = 0;
    int xbase, xend, xstride, xlb;
    __device__ __forceinline__ void init(const LAS unsigned* tab_, int K_, const void* W_, size_t wstride_, const int* slot_ent_, const float* slot_w_, int G, int c_) {
        tab = tab_; K = K_; W = (const char*)W_; wstride = wstride_; slot_ent = slot_ent_; slot_w = slot_w_; c = c_;
        const int U = (int)tab[T_TILE + NE] * NCOL; per = (U + G - 1) / G;
        if (G % 8 == 0) { const int x = c_ % 8; const int q = U / 8, r = U % 8; xbase = x * q + (x < r ? x : r); xend = xbase + q + (x < r ? 1 : 0); xstride = G / 8; xlb = c_ / 8; }
        else { xbase = 0; xend = U; xstride = G; xlb = c_; }
    }
    __device__ __forceinline__ bool next(int i, Unit& u) const {
        const int L = xbase + i * xstride + xlb;
        if (L >= xend) return false;
        const int tile = L / NCOL; u.pn = L % NCOL;
        int lo = ehint;
        if (i == 0) { lo = 0; int hi = NE - 1; while (lo < hi) { const int mid = (lo + hi + 1) >> 1; if ((int)tab[T_TILE + mid] <= tile) lo = mid; else hi = mid - 1; } }
        else { while (lo < NE - 1 && (int)tab[T_TILE + lo + 1] <= tile) ++lo; }
        ehint = lo;
        u.e = lo; u.pm = tile - (int)tab[T_TILE + lo]; u.cnt = (int)tab[T_CNT + lo]; u.off = (int)tab[T_OFF + lo];
        u.B = W + (size_t)lo * wstride + (size_t)u.pn * BM * K; return true;
    }
    __device__ __forceinline__ void rowtab(const Unit& u, LAS unsigned* t, int tid) const {
        if (tid < BM) { int r = u.pm * BM + tid; if (r >= u.cnt) r = u.cnt - 1; t[tid] = (unsigned)slot_ent[u.off + r]; t[BM + tid] = __float_as_uint(slot_w[u.off + r]); }
    }
    __device__ __forceinline__ void avoff(const Unit& u, const int (&)[2], const int (&)[2], unsigned (&v)[2][2], int tidq) const {
        int R[2], C[2]; asm volatile("" : "+v"(tidq));
#pragma unroll
        for (int i = 0; i < 2; ++i) stage_rc(tidq * 16 + i * 8192, R[i], C[i]);
#pragma unroll
        for (int h = 0; h < 2; ++h)
#pragma unroll
            for (int i = 0; i < 2; ++i) {
                int r = u.pm * BM + h * HALF + R[i]; if (r >= u.cnt) r = u.cnt - 1;
                const int slot = u.off + r;
                const int row = TOKROWS ? (slot_ent[slot] >> 3) : slot;
                v[h][i] = (unsigned)(row * K + C[i] * 2);
            }
    }
};

struct EpiInProj {
    static constexpr bool PERM = true; bf16_t* O;
    __device__ __forceinline__ void operator()(const f32x4 (&acc)[2][2][4][2], const Unit& u, int wr, int wc, int fr, int fq, const LAS unsigned* rt) const {
        const float sc = (u.pn < 2) ? 0.125f : ((u.pn == 8 || u.pn == 9) ? 0.08838834764831845f : 1.f);
        const int row0 = u.pm * BM + wr * 64 + fr, col0 = u.pn * BM + wc * 64 + 16 * fq;
#pragma unroll
        for (int ai = 0; ai < 2; ++ai)
#pragma unroll
            for (int m = 0; m < 4; ++m) { bf16_t* rowp = O + (size_t)(row0 + ai * HALF + m * 16) * DIN + col0;
#pragma unroll
                for (int bj = 0; bj < 2; ++bj) { const f32x4 v0 = acc[ai][bj][m][0] * sc, v1 = acc[ai][bj][m][1] * sc;
                    u32x4 w; w.x = cvt_pk_bf16(v0[0], v0[1]); w.y = cvt_pk_bf16(v0[2], v0[3]); w.z = cvt_pk_bf16(v1[0], v1[1]); w.w = cvt_pk_bf16(v1[2], v1[3]);
                    *(u32x4*)(rowp + 8 * bj) = w; } }
    }
};
struct EpiOutProj {
    static constexpr bool PERM = true; const float* x; const float* mod; bf16_t* tb;
    __device__ __forceinline__ void operator()(const f32x4 (&acc)[2][2][4][2], const Unit& u, int wr, int wc, int fr, int fq, const LAS unsigned* rt) const {
        const int b = (u.pm * BM) >> 11; const int col0 = u.pn * BM + wc * 64 + 16 * fq;
        f32x4 g[2][2];
#pragma unroll
        for (int bj = 0; bj < 2; ++bj)
#pragma unroll
            for (int n = 0; n < 2; ++n) g[bj][n] = *(const f32x4*)(mod + b * 6144 + MOD_GATE_A + col0 + 8 * bj + 4 * n);
#pragma unroll
        for (int ai = 0; ai < 2; ++ai)
#pragma unroll
            for (int m = 0; m < 4; ++m) { const size_t o = (size_t)(u.pm * BM + ai * HALF + wr * 64 + m * 16 + fr) * D + col0;
#pragma unroll
                for (int bj = 0; bj < 2; ++bj) {
                    const f32x4 t0 = *(const f32x4*)(x + o + 8 * bj) * ALPHA + g[bj][0] * acc[ai][bj][m][0], t1 = *(const f32x4*)(x + o + 8 * bj + 4) * ALPHA + g[bj][1] * acc[ai][bj][m][1];
                    u32x4 w; w.x = cvt_pk_bf16(t0[0], t0[1]); w.y = cvt_pk_bf16(t0[2], t0[3]); w.z = cvt_pk_bf16(t1[0], t1[1]); w.w = cvt_pk_bf16(t1[2], t1[3]);
                    *(u32x4*)(tb + o + 8 * bj) = w; } }
    }
};
struct EpiRouter {
    static constexpr bool PERM = false; float* out;
    __device__ __forceinline__ void operator()(const f32x4 (&acc)[2][2][4][2], const Unit& u, int wr, int wc, int fr, int fq, const LAS unsigned* rt) const {
        const int col0 = wc * 32 + 4 * fq;
#pragma unroll
        for (int ai = 0; ai < 2; ++ai)
#pragma unroll
            for (int m = 0; m < 4; ++m) { float* rowp = out + (size_t)(u.pm * BM + ai * HALF + wr * 64 + m * 16 + fr) * NE + col0;
#pragma unroll
                for (int bj = 0; bj < 2; ++bj)
#pragma unroll
                    for (int n = 0; n < 2; ++n) *(f32x4*)(rowp + bj * HALF + n * 16) = acc[ai][bj][m][n]; }
    }
};
template <bool EXPERT> struct EpiGU {
    static constexpr bool PERM = true; void* Ov;
    __device__ __forceinline__ void operator()(const f32x4 (&acc)[2][2][4][2], const Unit& u, int wr, int wc, int fr, int fq, const LAS unsigned* rt) const {
        const int h0 = u.pn * HALF + wc * 32 + 8 * fq;
#pragma unroll
        for (int ai = 0; ai < 2; ++ai)
#pragma unroll
            for (int m = 0; m < 4; ++m) {
                const int rtw = u.pm * BM + ai * HALF + wr * 64 + m * 16 + fr;
                if (EXPERT) { if (rtw >= u.cnt) continue; }
                const float w = EXPERT ? __uint_as_float(rt[BM + ai * HALF + wr * 64 + m * 16 + fr]) * (S_ACT8 * INV_GU8) : 1.f;
                const float gs = EXPERT ? INV_GU8 : 1.f;
                const f32x4 g0 = acc[ai][0][m][0] * gs, g1 = acc[ai][0][m][1] * gs, u0 = acc[ai][1][m][0], u1 = acc[ai][1][m][1];
                const float h[8] = {w * silu_f(g0[0]) * u0[0], w * silu_f(g0[1]) * u0[1], w * silu_f(g0[2]) * u0[2], w * silu_f(g0[3]) * u0[3],
                                    w * silu_f(g1[0]) * u1[0], w * silu_f(g1[1]) * u1[1], w * silu_f(g1[2]) * u1[2], w * silu_f(g1[3]) * u1[3]};
                if (EXPERT) {
                    int w0 = __builtin_amdgcn_cvt_pk_fp8_f32(clamp8(h[0]), clamp8(h[1]), 0, false); w0 = __builtin_amdgcn_cvt_pk_fp8_f32(clamp8(h[2]), clamp8(h[3]), w0, true);
                    int w1 = __builtin_amdgcn_cvt_pk_fp8_f32(clamp8(h[4]), clamp8(h[5]), 0, false); w1 = __builtin_amdgcn_cvt_pk_fp8_f32(clamp8(h[6]), clamp8(h[7]), w1, true);
                    u32x2 o; o.x = (unsigned)w0; o.y = (unsigned)w1; *(u32x2*)((unsigned char*)Ov + (size_t)(u.off + rtw) * DE + h0) = o;
                    asm volatile("" ::: "memory");
                } else {
                    u32x4 o; o.x = cvt_pk_bf16(h[0], h[1]); o.y = cvt_pk_bf16(h[2], h[3]); o.z = cvt_pk_bf16(h[4], h[5]); o.w = cvt_pk_bf16(h[6], h[7]);
                    *(u32x4*)((bf16_t*)Ov + (size_t)rtw * DE + h0) = o;
                }
            }
    }
};
struct EpiSharedDown {
    static constexpr bool PERM = true; unsigned char* ysh;
    __device__ __forceinline__ void operator()(const f32x4 (&acc)[2][2][4][2], const Unit& u, int wr, int wc, int fr, int fq, const LAS unsigned* rt) const {
        const int col0 = u.pn * BM + wc * 64 + 16 * fq;
#pragma unroll
        for (int ai = 0; ai < 2; ++ai)
#pragma unroll
            for (int m = 0; m < 4; ++m) {
                u32x4 o;
#pragma unroll
                for (int bj = 0; bj < 2; ++bj) { const f32x4 v0 = acc[ai][bj][m][0] * YSCALE, v1 = acc[ai][bj][m][1] * YSCALE;
                    int w0 = __builtin_amdgcn_cvt_pk_fp8_f32(clamp8(v0[0]), clamp8(v0[1]), 0, false); w0 = __builtin_amdgcn_cvt_pk_fp8_f32(clamp8(v0[2]), clamp8(v0[3]), w0, true);
                    int w1 = __builtin_amdgcn_cvt_pk_fp8_f32(clamp8(v1[0]), clamp8(v1[1]), 0, false); w1 = __builtin_amdgcn_cvt_pk_fp8_f32(clamp8(v1[2]), clamp8(v1[3]), w1, true);
                    if (bj == 0) { o.x = (unsigned)w0; o.y = (unsigned)w1; } else { o.z = (unsigned)w0; o.w = (unsigned)w1; } }
                *(u32x4*)(ysh + (size_t)(u.pm * BM + ai * HALF + wr * 64 + m * 16 + fr) * D + col0) = o;
            }
    }
};
struct EpiExpDown {
    static constexpr bool PERM = true; unsigned char* ybuf; const int* slot_ent;
    __device__ __forceinline__ void operator()(const f32x4 (&acc)[2][2][4][2], const Unit& u, int wr, int wc, int fr, int fq, const LAS unsigned* rt) const {
        const int col0 = u.pn * BM + wc * 64 + 16 * fq;
#pragma unroll
        for (int ai = 0; ai < 2; ++ai)
#pragma unroll
            for (int m = 0; m < 4; ++m) {
                const int rtw = u.pm * BM + ai * HALF + wr * 64 + m * 16 + fr; if (rtw >= u.cnt) continue;
                u32x4 o;
#pragma unroll
                for (int bj = 0; bj < 2; ++bj) { const f32x4 v0 = acc[ai][bj][m][0] * (YSCALE * INV_DN8), v1 = acc[ai][bj][m][1] * (YSCALE * INV_DN8);
                    int w0 = __builtin_amdgcn_cvt_pk_fp8_f32(clamp8(v0[0]), clamp8(v0[1]), 0, false); w0 = __builtin_amdgcn_cvt_pk_fp8_f32(clamp8(v0[2]), clamp8(v0[3]), w0, true);
                    int w1 = __builtin_amdgcn_cvt_pk_fp8_f32(clamp8(v1[0]), clamp8(v1[1]), 0, false); w1 = __builtin_amdgcn_cvt_pk_fp8_f32(clamp8(v1[2]), clamp8(v1[3]), w1, true);
                    if (bj == 0) { o.x = (unsigned)w0; o.y = (unsigned)w1; } else { o.z = (unsigned)w0; o.w = (unsigned)w1; } }
                *(u32x4*)(ybuf + (size_t)rt[ai * HALF + wr * 64 + m * 16 + fr] * D + col0) = o;
                asm volatile("" ::: "memory");
            }
    }
};
struct EpiProbeSum {
    static constexpr bool PERM = true; float* o;
    __device__ __forceinline__ void operator()(const f32x4 (&acc)[2][2][4][2], const Unit& u, int wr, int wc, int fr, int fq, const LAS unsigned* rt) const {
        f32x4 s = (f32x4){0.f, 0.f, 0.f, 0.f};
#pragma unroll
        for (int a = 0; a < 2; ++a)
#pragma unroll
            for (int b = 0; b < 2; ++b)
#pragma unroll
                for (int m = 0; m < 4; ++m) s += acc[a][b][m][0] + acc[a][b][m][1];
        if (s.x == 123.456f) *(f32x4*)(o + (size_t)(blockIdx.x * 512 + wr * 256 + wc * 64 + fq * 16 + fr) * 4) = s;
    }
};
}

struct Ctx {
    const float *x, *c, *w_ada, *b_ada, *w_in, *w_out, *na_rpb, *ret_ld, *ret_gn, *ln1_g, *ln1_b, *ln2_g, *ln2_b, *w_router, *rbias, *w_gate, *w_up, *w_down, *ws_gate, *ws_up, *ws_down;
    float* out; unsigned char* ws;
};
constexpr int NW = 8;

__device__ __forceinline__ void transpose_item(const float* W, int K, int N, bf16_t* WT, int G, int which, LAS float* scr, int item, int lane) {
    const int nblk = N / 32, kb = item / nblk, nb = item % nblk, k0 = 64 * kb, n0 = 32 * nb;
    float v[32];
#pragma unroll
    for (int i = 0; i < 32; ++i) { const int kk = 2 * i + (lane >> 5); v[i] = __builtin_nontemporal_load(W + (size_t)(k0 + kk) * N + n0 + (lane & 31)); }
#pragma unroll
    for (int i = 0; i < 32; ++i) { const int kk = 2 * i + (lane >> 5); scr[kk * 33 + (lane & 31)] = v[i]; }
    LDS_WAIT(); asm volatile("" ::: "memory");
    const int c = lane & 7;
#pragma unroll
    for (int j = 0; j < 4; ++j) { const int n = (lane >> 3) + 8 * j; const LAS float* s = scr + (8 * c) * 33 + n;
        u32x4 o; o.x = pk2(s[0 * 33], s[1 * 33]); o.y = pk2(s[2 * 33], s[3 * 33]); o.z = pk2(s[4 * 33], s[5 * 33]); o.w = pk2(s[6 * 33], s[7 * 33]);
        const int ng = n0 + n; const int drow = (G == 0) ? ng : ((ng / G) * 2 * G + which * G + (ng % G));
        *(u32x4*)(WT + (size_t)drow * K + k0 + 8 * c) = o; }
    LDS_WAIT(); asm volatile("" ::: "memory");
}
__device__ __forceinline__ void transpose_item_fp8(const float* W, int K, int N, unsigned char* WT, int G, int which, float scale, LAS float* scr, int item, int lane) {
    const int nblk = N / 32, kb = item / nblk, nb = item % nblk, k0 = 64 * kb, n0 = 32 * nb;
    float v[32];
#pragma unroll
    for (int i = 0; i < 32; ++i) { const int kk = 2 * i + (lane >> 5); v[i] = __builtin_nontemporal_load(W + (size_t)(k0 + kk) * N + n0 + (lane & 31)); }
#pragma unroll
    for (int i = 0; i < 32; ++i) { const int kk = 2 * i + (lane >> 5); scr[kk * 33 + (lane & 31)] = v[i] * scale; }
    LDS_WAIT(); asm volatile("" ::: "memory");
    const int c = lane & 7;
#pragma unroll
    for (int j = 0; j < 4; ++j) { const int n = (lane >> 3) + 8 * j; const LAS float* sp = scr + (8 * c) * 33 + n;
        int w0 = __builtin_amdgcn_cvt_pk_fp8_f32(clamp8(sp[0 * 33]), clamp8(sp[1 * 33]), 0, false); w0 = __builtin_amdgcn_cvt_pk_fp8_f32(clamp8(sp[2 * 33]), clamp8(sp[3 * 33]), w0, true);
        int w1 = __builtin_amdgcn_cvt_pk_fp8_f32(clamp8(sp[4 * 33]), clamp8(sp[5 * 33]), 0, false); w1 = __builtin_amdgcn_cvt_pk_fp8_f32(clamp8(sp[6 * 33]), clamp8(sp[7 * 33]), w1, true);
        const int ng = n0 + n; const int drow = (G == 0) ? ng : ((ng / G) * 2 * G + which * G + (ng % G));
        u32x2 o; o.x = (unsigned)w0; o.y = (unsigned)w1; *(u32x2*)(WT + (size_t)drow * K + k0 + 8 * c) = o; }
    LDS_WAIT(); asm volatile("" ::: "memory");
}
__device__ __forceinline__ void rope_entry(float* tab, int idx) {
    const int t = idx >> 6, i = idx & 63;
    const float inv_freq = powf(10000.f, -(float)(2 * i) / 128.f);
    const float ang = (float)t * inv_freq;
    const double a = (double)ang; const double two_pi = 6.283185307179586476925286766559;
    const double kf = rint(a / two_pi); double r = a - kf * two_pi;
    double sgn = 1.0; if (r > 1.5707963267948966) { r = 3.141592653589793 - r; sgn = -1.0; } else if (r < -1.5707963267948966) { r = -3.141592653589793 - r; sgn = -1.0; }
    const double r2 = r * r;
    const double s = r * (1.0 + r2 * (-1.0 / 6 + r2 * (1.0 / 120 + r2 * (-1.0 / 5040 + r2 * (1.0 / 362880 + r2 * (-1.0 / 39916800 + r2 * (1.0 / 6227020800.0 + r2 * (-1.0 / 1307674368000.0))))))));
    const double c = 1.0 + r2 * (-0.5 + r2 * (1.0 / 24 + r2 * (-1.0 / 720 + r2 * (1.0 / 40320 + r2 * (-1.0 / 3628800 + r2 * (1.0 / 479001600.0 + r2 * (-1.0 / 87178291200.0 + r2 * (1.0 / 20922789888000.0))))))));
    tab[idx] = (float)(sgn * c); tab[SEQ * 64 + idx] = (float)s;
}
__device__ __forceinline__ void mod_task(const float* __restrict__ cin, const float* __restrict__ w_ada, float* __restrict__ modp, int task, int lane) {
    const int cbk = task % 96, kc = task / 96, j = cbk * 64 + lane, k0 = kc * 64;
    float acc[32], cv[32];
#pragma unroll
    for (int b = 0; b < 32; ++b) { acc[b] = 0.f; cv[b] = silu_f(cin[b * D + k0 + lane]); }
#pragma unroll
    for (int kb = 0; kb < 4; ++kb) {
        float w[16];
#pragma unroll
        for (int i = 0; i < 16; ++i) w[i] = w_ada[(size_t)(k0 + kb * 16 + i) * 6144 + j];
#pragma unroll
        for (int i = 0; i < 16; ++i)
#pragma unroll
            for (int b = 0; b < 32; ++b) acc[b] += __builtin_bit_cast(float, __builtin_amdgcn_readlane(__builtin_bit_cast(int, cv[b]), kb * 16 + i)) * w[i];
    }
#pragma unroll
    for (int b = 0; b < 32; ++b) modp[((size_t)kc * 32 + b) * 6144 + j] = acc[b];
}
__device__ __forceinline__ float mod_sum(const float* __restrict__ modp, const float* __restrict__ b_ada, int b, int j) {
    float s = 0.f;
#pragma unroll
    for (int kc = 0; kc < 16; ++kc) s += modp[((size_t)kc * 32 + b) * 6144 + j];
    return s + b_ada[j];
}

#ifndef RET_PROBE
#define RET_PROBE 0
#endif
namespace ret {
typedef short s16x4 __attribute__((ext_vector_type(4)));
typedef __bf16 bfx2 __attribute__((ext_vector_type(2)));
constexpr unsigned RS = 288, TILE = 128 * RS, LK = 0, LV = TILE, LRF = 2 * TILE, LRB = 3 * TILE;
constexpr float LOG2E = 1.4426950408889634f;
__device__ __forceinline__ unsigned offb(unsigned row, unsigned ch) { return RS * row + 16u * ch; }
__device__ __forceinline__ unsigned cvtpk(float lo, float hi) { const f32x2 v = {lo, hi}; return __builtin_bit_cast(unsigned, __builtin_convertvector(v, bfx2)); }
__device__ __forceinline__ bf16x8 pack8(const float (&f)[8]) { u32x4 u; u.x = cvtpk(f[0], f[1]); u.y = cvtpk(f[2], f[3]); u.z = cvtpk(f[4], f[5]); u.w = cvtpk(f[6], f[7]); return __builtin_bit_cast(bf16x8, u); }
__device__ __forceinline__ void unpack8(const bf16x8 v, float (&f)[8]) { const u32x4 u = __builtin_bit_cast(u32x4, v);
    f[0] = __uint_as_float(u.x << 16); f[1] = __uint_as_float(u.x & 0xffff0000u); f[2] = __uint_as_float(u.y << 16); f[3] = __uint_as_float(u.y & 0xffff0000u);
    f[4] = __uint_as_float(u.z << 16); f[5] = __uint_as_float(u.z & 0xffff0000u); f[6] = __uint_as_float(u.w << 16); f[7] = __uint_as_float(u.w & 0xffff0000u); }
__device__ __forceinline__ bf16x8 trfrag(LAS unsigned char* base, unsigned row0, unsigned row1, unsigned cblk, unsigned qp, unsigned p) {
    const unsigned ch = 2u * cblk + (p >> 1), bo = 8u * (p & 1u);
    const s16x4 lo = __builtin_amdgcn_ds_read_tr16_b64_v4i16((LAS s16x4*)(base + offb(row0 + qp, ch) + bo));
    const s16x4 hi = __builtin_amdgcn_ds_read_tr16_b64_v4i16((LAS s16x4*)(base + offb(row1 + qp, ch) + bo));
    return __builtin_shufflevector(lo, hi, 0, 1, 2, 3, 4, 5, 6, 7);
}
struct KVRaw { bf16x8 ka[2], kb[2], v[4]; f32x4 c0[2], c1[2], s0[2], s1[2]; };
__device__ __forceinline__ void kv_load(KVRaw& R, const bf16_t* __restrict__ proj, const float* __restrict__ rope, int b, int h, int n, int tid) {
#pragma unroll
    for (int i = 0; i < 2; ++i) {
        const int q2 = tid + 512 * i, row = q2 >> 3, pc = q2 & 7, t = n * 128 + row;
        const bf16_t* rp = proj + (size_t)(b * SEQ + t) * DIN + OFF_KR + h * 128;
        R.ka[i] = *(const bf16x8*)(rp + pc * 8); R.kb[i] = *(const bf16x8*)(rp + 64 + pc * 8);
        R.c0[i] = *(const f32x4*)(rope + t * 64 + pc * 8); R.c1[i] = *(const f32x4*)(rope + t * 64 + pc * 8 + 4);
        R.s0[i] = *(const f32x4*)(rope + SEQ * 64 + t * 64 + pc * 8); R.s1[i] = *(const f32x4*)(rope + SEQ * 64 + t * 64 + pc * 8 + 4);
    }
#pragma unroll
    for (int i = 0; i < 4; ++i) { const int q4 = tid + 512 * i, row = q4 >> 4, ch = q4 & 15, t = n * 128 + row;
        R.v[i] = *(const bf16x8*)(proj + (size_t)(b * SEQ + t) * DIN + OFF_VR + h * 128 + ch * 8); }
}
__device__ __forceinline__ void kv_store(LAS unsigned char* lds, const KVRaw& R, int tid) {
#pragma unroll
    for (int i = 0; i < 2; ++i) {
        const int q2 = tid + 512 * i, row = q2 >> 3, pc = q2 & 7;
        float fa[8], fb[8], o1[8], o2[8];
        unpack8(R.ka[i], fa); unpack8(R.kb[i], fb);
        const float cs[8] = {R.c0[i].x, R.c0[i].y, R.c0[i].z, R.c0[i].w, R.c1[i].x, R.c1[i].y, R.c1[i].z, R.c1[i].w}, sn[8] = {R.s0[i].x, R.s0[i].y, R.s0[i].z, R.s0[i].w, R.s1[i].x, R.s1[i].y, R.s1[i].z, R.s1[i].w};
#pragma unroll
        for (int e = 0; e < 8; ++e) { o1[e] = fa[e] * cs[e] - fb[e] * sn[e]; o2[e] = fb[e] * cs[e] + fa[e] * sn[e]; }
        *(LAS bf16x8*)(lds + LK + offb(row, pc)) = pack8(o1); *(LAS bf16x8*)(lds + LK + offb(row, pc + 8)) = pack8(o2);
    }
#pragma unroll
    for (int i = 0; i < 4; ++i) { const int q4 = tid + 512 * i, row = q4 >> 4, ch = q4 & 15; *(LAS bf16x8*)(lds + LV + offb(row, ch)) = R.v[i]; }
}
__device__ __forceinline__ void rb_dma(LAS unsigned char* lds, const unsigned char* img, int w, int lane) {
#pragma unroll
    for (int i = 0; i < 5; ++i) { const int o = w + 8 * i; if (o < (int)TILE / 1024)
        __builtin_amdgcn_global_load_lds((const unsigned*)(img + o * 1024 + lane * 16), (LAS unsigned*)(lds + LRB + o * 1024), 16, 0, 0); }
}
template <bool FWD> __device__ __forceinline__ void state_update_1(LAS unsigned char* lds, f32x4 (&racc)[8], float l2, int w, int g, unsigned qp, unsigned p);
template <bool FWD> __device__ __forceinline__ void state_update(LAS unsigned char* lds, f32x4 (&racc)[8], float l2, int w, int g, unsigned qp, unsigned p) {
    if (RET_PROBE == 2) {
        f32x4 r2[8];
#pragma unroll
        for (int i = 0; i < 8; ++i) r2[i] = racc[i];
        unsigned zo = 0; asm volatile("" : "+v"(zo));
        state_update_1<FWD>(lds + zo, r2, l2, w, g, qp, p);
        state_update_1<FWD>(lds, racc, l2, w, g, qp, p);
#pragma unroll
        for (int i = 0; i < 8; ++i) racc[i] = (racc[i] + r2[i]) * 0.5f;
    } else state_update_1<FWD>(lds, racc, l2, w, g, qp, p);
}
template <bool FWD> __device__ __forceinline__ void state_update_1(LAS unsigned char* lds, f32x4 (&racc)[8], float l2, int w, int g, unsigned qp, unsigned p) {
    const float dec = __builtin_amdgcn_exp2f(128.f * l2);
    bf16x8 vs[4];
#pragma unroll
    for (int ks = 0; ks < 4; ++ks) {
        float f[8]; unpack8(trfrag(lds + LV, 32 * ks + 4 * g, 32 * ks + 16 + 4 * g, w, qp, p), f);
#pragma unroll
        for (int e = 0; e < 8; ++e) { const int key = 32 * ks + 16 * (e >> 2) + 4 * g + (e & 3); f[e] *= __builtin_amdgcn_exp2f((FWD ? (float)(127 - key) : (float)key) * l2); }
        vs[ks] = pack8(f);
    }
#pragma unroll
    for (int nb = 0; nb < 8; ++nb) {
        racc[nb] = racc[nb] * dec;
#pragma unroll
        for (int ks = 0; ks < 4; ++ks) racc[nb] = __builtin_amdgcn_mfma_f32_16x16x32_bf16(vs[ks], trfrag(lds + LK, 32 * ks + 4 * g, 32 * ks + 16 + 4 * g, nb, qp, p), racc[nb], 0, 0, 0);
    }
}
__device__ __forceinline__ void unit(const bf16_t* __restrict__ proj, const float* __restrict__ rope, const float* __restrict__ log_decay, const float* __restrict__ gn_g, bf16_t* __restrict__ ymix,
                                     unsigned char* __restrict__ scratch  , LAS unsigned char* lds, int hu, const int tid_in) {
    const int u = hu >> 1, n0 = (hu & 1) * 8, n1 = n0 + 8;
    const int b = u >> 2, h = u & 3;
    int tid_ = tid_in; asm volatile("" : "+v"(tid_));
    const int tid0 = tid_, w = __builtin_amdgcn_readfirstlane(tid0 >> 6);
#define RET_LANE int tid = tid0; asm volatile("" : "+v"(tid)); const int lane = tid & 63, r = lane & 15, g = lane >> 4; const unsigned qp = (unsigned)r >> 2, p = (unsigned)lane & 3u;
    const float lf2_ = log_decay[h] * LOG2E, lb2_ = log_decay[4 + h] * LOG2E;
    f32x4 racc[8];
    KVRaw raw;
    for (int rep7 = 0; rep7 < (RET_PROBE == 7 ? 2 : 1); ++rep7) {
#pragma unroll
    for (int nb = 0; nb < 8; ++nb) racc[nb] = (f32x4){0.f, 0.f, 0.f, 0.f};
    kv_load(raw, proj, rope, b, h, 15, tid0);
    for (int n = 15; n >= n0; --n) {
        RET_LANE
        if (n < n1) {
            unsigned char* img = scratch + (size_t)(n - n0) * TILE;
#pragma unroll
            for (int nb = 0; nb < 8; ++nb) { u32x2 o; o.x = cvtpk(racc[nb][0], racc[nb][1]); o.y = cvtpk(racc[nb][2], racc[nb][3]);
                *(u32x2*)(img + offb(16 * nb + r, 2 * w + (g >> 1)) + 8 * (g & 1)) = o; }
        }
        if (n == n0) break;
        float lb2 = lb2_; asm volatile("" : "+v"(lb2));
        __syncthreads();
        kv_store(lds, raw, tid);
        __syncthreads();
        kv_load(raw, proj, rope, b, h, n - 1 > n0 ? n - 1 : 0, tid);
        state_update<false>(lds, racc, lb2, w, g, qp, p);
    }
    }
    asm volatile("s_waitcnt vmcnt(0)" ::: "memory");
    __syncthreads();
    __builtin_amdgcn_fence(__ATOMIC_ACQUIRE, "agent");
    asm volatile("s_waitcnt vmcnt(0)" ::: "memory");
    for (int rep8 = 0; rep8 < (RET_PROBE == 8 ? 2 : 1); ++rep8) {
    if (RET_PROBE == 8 && rep8 == 1) { __syncthreads(); kv_load(raw, proj, rope, b, h, 0, tid0); }
#pragma unroll
    for (int nb = 0; nb < 8; ++nb) racc[nb] = (f32x4){0.f, 0.f, 0.f, 0.f};
    for (int n = 0; n < n0; ++n) {
        RET_LANE
        float lf2 = lf2_; asm volatile("" : "+v"(lf2));
        __syncthreads();
        kv_store(lds, raw, tid);
        __syncthreads();
        kv_load(raw, proj, rope, b, h, n + 1, tid);
        state_update<true>(lds, racc, lf2, w, g, qp, p);
    }
    rb_dma(lds, scratch, w, tid0 & 63);
    for (int n = n0; n < n1; ++n) {
        RET_LANE
        float lf2 = lf2_, lb2 = lb2_; asm volatile("" : "+v"(lf2), "+v"(lb2));
        const __attribute__((address_space(1))) float* gnp = (const __attribute__((address_space(1))) float*)gn_g; asm volatile("" : "+s"(gnp));
        __syncthreads();
        kv_store(lds, raw, tid);
#pragma unroll
        for (int nb = 0; nb < 8; ++nb) { u32x2 o; o.x = cvtpk(racc[nb][0], racc[nb][1]); o.y = cvtpk(racc[nb][2], racc[nb][3]);
            *(LAS u32x2*)(lds + LRF + offb(16 * nb + r, 2 * w + (g >> 1)) + 8 * (g & 1)) = o; }
        const int cq = 16 * w + r, tq = n * 128 + cq;
        bf16x8 qn[4], qf[4], qb[4];
        { const bf16_t* rp = proj + (size_t)(b * SEQ + tq) * DIN + OFF_QR + h * 128 + 4 * g;
          const float sf = __builtin_amdgcn_exp2f((float)(cq + 1) * lf2), sb = __builtin_amdgcn_exp2f((float)(128 - cq) * lb2);
#pragma unroll
          for (int ks = 0; ks < 2; ++ks) {
              float fa[8], fb[8], o1[8], o2[8], t1[8], t2[8];
              { const u32x2 a0 = *(const u32x2*)(rp + 32 * ks), a1 = *(const u32x2*)(rp + 32 * ks + 16), b0 = *(const u32x2*)(rp + 32 * ks + 64), b1 = *(const u32x2*)(rp + 32 * ks + 80);
                unpack8(__builtin_bit_cast(bf16x8, (u32x4){a0.x, a0.y, a1.x, a1.y}), fa); unpack8(__builtin_bit_cast(bf16x8, (u32x4){b0.x, b0.y, b1.x, b1.y}), fb); }
              const float* cp = rope + tq * 64 + 32 * ks + 4 * g; const float* sp = cp + SEQ * 64;
              const f32x4 c0 = *(const f32x4*)cp, c1 = *(const f32x4*)(cp + 16), s0 = *(const f32x4*)sp, s1 = *(const f32x4*)(sp + 16);
              const float cs[8] = {c0.x, c0.y, c0.z, c0.w, c1.x, c1.y, c1.z, c1.w}, sn[8] = {s0.x, s0.y, s0.z, s0.w, s1.x, s1.y, s1.z, s1.w};
#pragma unroll
              for (int e = 0; e < 8; ++e) { o1[e] = fa[e] * cs[e] - fb[e] * sn[e]; o2[e] = fb[e] * cs[e] + fa[e] * sn[e]; }
              qn[ks] = pack8(o1); qn[ks + 2] = pack8(o2);
#pragma unroll
              for (int e = 0; e < 8; ++e) { t1[e] = o1[e] * sf; t2[e] = o2[e] * sf; }
              qf[ks] = pack8(t1); qf[ks + 2] = pack8(t2);
#pragma unroll
              for (int e = 0; e < 8; ++e) { t1[e] = o1[e] * sb; t2[e] = o2[e] * sb; }
              qb[ks] = pack8(t1); qb[ks + 2] = pack8(t2);
          } }
        asm volatile("s_waitcnt vmcnt(0)" ::: "memory");
        __syncthreads();
        kv_load(raw, proj, rope, b, h, n + 1 < n1 ? n + 1 : n, tid);
        u32x2 gv[8];
        { const bf16_t* gp = proj + (size_t)(b * SEQ + tq) * DIN + OFF_GR + h * 128 + 4 * g;
#pragma unroll
          for (int mbv = 0; mbv < 8; ++mbv) gv[mbv] = *(const u32x2*)(gp + 16 * mbv); }
        bf16x8 pt[4];
#pragma unroll
        for (int rep3 = 0; rep3 < (RET_PROBE == 3 ? 2 : 1); ++rep3) {
        unsigned zo3 = 0; if (RET_PROBE == 3) asm volatile("" : "+v"(zo3));
#pragma unroll
        for (int ks2 = 0; ks2 < 4; ++ks2) {
            float pv[8];
#pragma unroll
            for (int hb = 0; hb < 2; ++hb) {
                const int mb = 2 * ks2 + hb;
                f32x4 st = (f32x4){0.f, 0.f, 0.f, 0.f};
#pragma unroll
                for (int ks = 0; ks < 4; ++ks) { const LAS unsigned char* kp = lds + LK + zo3 + RS * (16 * mb + r) + 64 * ks + 8 * g; const u32x2 k0 = *(const LAS u32x2*)kp, k1 = *(const LAS u32x2*)(kp + 32);
                    st = __builtin_amdgcn_mfma_f32_16x16x32_bf16(__builtin_bit_cast(bf16x8, (u32x4){k0.x, k0.y, k1.x, k1.y}), qn[ks], st, 0, 0, 0); }
#pragma unroll
                for (int j = 0; j < 4; ++j) { const int diff = cq - (16 * mb + 4 * g + j); pv[4 * hb + j] = st[j] * __builtin_amdgcn_exp2f(diff >= 0 ? (float)diff * lf2 : (float)(-diff) * lb2); }
            }
            pt[ks2] = pack8(pv);
        }
        }
        f32x4 yacc[8];
#pragma unroll
        for (int mbv = 0; mbv < 8; ++mbv) {
            f32x4 y = (f32x4){0.f, 0.f, 0.f, 0.f};
#pragma unroll
            for (int rep = 0; rep < (RET_PROBE == 1 ? 2 : 1); ++rep) {
            unsigned zo = 0; if (RET_PROBE == 1) asm volatile("" : "+v"(zo));
#pragma unroll
            for (int ks2 = 0; ks2 < 4; ++ks2) y = __builtin_amdgcn_mfma_f32_16x16x32_bf16(trfrag(lds + LV + zo, 32 * ks2 + 4 * g, 32 * ks2 + 16 + 4 * g, mbv, qp, p), pt[ks2], y, 0, 0, 0);
#pragma unroll
            for (int ks = 0; ks < 4; ++ks) {
                y = __builtin_amdgcn_mfma_f32_16x16x32_bf16(trfrag(lds + LRF + zo, 32 * ks + 4 * g, 32 * ks + 16 + 4 * g, mbv, qp, p), qf[ks], y, 0, 0, 0);
                y = __builtin_amdgcn_mfma_f32_16x16x32_bf16(trfrag(lds + LRB + zo, 32 * ks + 4 * g, 32 * ks + 16 + 4 * g, mbv, qp, p), qb[ks], y, 0, 0, 0);
            }
            }
            yacc[mbv] = (RET_PROBE == 1) ? y * 0.5f : y;
        }
        __syncthreads();
        if (n + 1 < n1) rb_dma(lds, scratch + (size_t)(n + 1 - n0) * TILE, w, lane);
        { float s = 0.f;
#pragma unroll
          for (int mbv = 0; mbv < 8; ++mbv) s += (yacc[mbv][0] + yacc[mbv][1]) + (yacc[mbv][2] + yacc[mbv][3]);
          s += __shfl_xor(s, 16); s += __shfl_xor(s, 32);
          const float mu = s * (1.f / 128.f); float s2 = 0.f;
#pragma unroll
          for (int mbv = 0; mbv < 8; ++mbv) { yacc[mbv] = yacc[mbv] - mu; s2 += (yacc[mbv][0] * yacc[mbv][0] + yacc[mbv][1] * yacc[mbv][1]) + (yacc[mbv][2] * yacc[mbv][2] + yacc[mbv][3] * yacc[mbv][3]); }
          s2 += __shfl_xor(s2, 16); s2 += __shfl_xor(s2, 32);
          const float rstd = 1.f / sqrtf(s2 * (1.f / 128.f) + GN_EPS);
          bf16_t* op = ymix + (size_t)(b * SEQ + tq) * D + 512 + h * 128 + 4 * g;
#pragma unroll
          for (int rep4 = 0; rep4 < (RET_PROBE == 4 ? 2 : 1); ++rep4) {
          if (RET_PROBE == 4) { asm volatile("" : "+v"(op)); asm volatile("" : "+v"(gv[0]), "+v"(gv[1]), "+v"(gv[2]), "+v"(gv[3]), "+v"(gv[4]), "+v"(gv[5]), "+v"(gv[6]), "+v"(gv[7])); }
#pragma unroll
          for (int mbv = 0; mbv < 8; ++mbv) {
              const f32x4 gn = *(const __attribute__((address_space(1))) f32x4*)(gnp + h * 128 + 16 * mbv + 4 * g);
              const float g0 = __uint_as_float(gv[mbv].x << 16), g1 = __uint_as_float(gv[mbv].x & 0xffff0000u), g2 = __uint_as_float(gv[mbv].y << 16), g3 = __uint_as_float(gv[mbv].y & 0xffff0000u);
              u32x2 o; o.x = cvtpk(silu_f(g0) * (yacc[mbv][0] * rstd * gn.x), silu_f(g1) * (yacc[mbv][1] * rstd * gn.y));
              o.y = cvtpk(silu_f(g2) * (yacc[mbv][2] * rstd * gn.z), silu_f(g3) * (yacc[mbv][3] * rstd * gn.w));
              *(u32x2*)(op + 16 * mbv) = o;
          } } }
        state_update<true>(lds, racc, lf2, w, g, qp, p);
    }
    }
    __syncthreads();
#undef RET_LANE
}
}


namespace na {
constexpr unsigned LKR = 0, LVR = 73728, LRPB = 147456;
__device__ __forceinline__ void load_row(LAS unsigned char* lds, const bf16_t* __restrict__ proj, int b, int head, int krow, int tid) {
    const int key = tid >> 3, ch = tid & 7, slot = krow % 9;
    const bf16_t* rp = proj + (size_t)(b * SEQ + krow * 64 + key) * DIN + head * 64 + ch * 8;
    const unsigned o = (unsigned)slot * 8192u + 128u * key + 16u * (ch ^ (key & 7));
    *(LAS u32x4*)(lds + LKR + o) = *(const u32x4*)(rp + OFF_KNA);
    *(LAS u32x4*)(lds + LVR + o) = *(const u32x4*)(rp + OFF_VNA);
}
__device__ __forceinline__ void unit(const bf16_t* __restrict__ proj, const float* __restrict__ rpb, bf16_t* __restrict__ ymix, LAS unsigned char* lds, int u, const int tid_in) {
    const int b = u >> 3, head = u & 7;
    int tid_ = tid_in; asm volatile("" : "+v"(tid_));
    const int tid0 = tid_, w = __builtin_amdgcn_readfirstlane(tid0 >> 6);
    __syncthreads();
    if (tid0 < 465) ((LAS float*)(lds + LRPB))[tid0] = rpb[head * 465 + tid0];
    const int ct = w & 3, cb = (ct == 0) ? 0 : (ct == 1 ? 8 : (ct == 2 ? 24 : 32));
    u32x4 pk[2], pv2[2]; int pre_lo = 0, pre_n = 0;
    for (int st = 0; st < 16; ++st) {
        int tid = tid0; asm volatile("" : "+v"(tid));
        const int lane = tid & 63, qi = lane & 15, g = lane >> 4; const unsigned qp = (unsigned)qi >> 2, p = (unsigned)lane & 3u;
        const int r = 2 * st + (w >> 2);
        const int rs = min(max(r - 4, 0), 24);
        const int need_hi = min(max(2 * st + 1 - 4, 0), 24) + 7;
        __syncthreads();
        if (st == 0) { for (int kr = 0; kr <= need_hi; ++kr) load_row(lds, proj, b, head, kr, tid); }
        else {
#pragma unroll
            for (int i = 0; i < 2; ++i) if (i < pre_n) { const int key = tid >> 3, ch = tid & 7; const unsigned o = (unsigned)((pre_lo + i) % 9) * 8192u + 128u * key + 16u * (ch ^ (key & 7));
                *(LAS u32x4*)(lds + LKR + o) = pk[i]; *(LAS u32x4*)(lds + LVR + o) = pv2[i]; }
        }
        const int cq = 16 * ct + qi, tq = b * SEQ + r * 64 + cq;
        bf16x8 qn[2];
        { const bf16_t* qptr = proj + (size_t)tq * DIN + OFF_QNA + head * 64 + 8 * g; qn[0] = *(const bf16x8*)qptr; qn[1] = *(const bf16x8*)(qptr + 32); }
        __syncthreads();
        { const int nh = (st < 15) ? min(max(2 * st + 3 - 4, 0), 24) + 7 : need_hi; pre_lo = need_hi + 1; pre_n = nh - need_hi;
#pragma unroll
          for (int i = 0; i < 2; ++i) if (i < pre_n) { const int key = tid >> 3, ch = tid & 7; const bf16_t* rp = proj + (size_t)(b * SEQ + (pre_lo + i) * 64 + key) * DIN + head * 64 + ch * 8;
              pk[i] = *(const u32x4*)(rp + OFF_KNA); pv2[i] = *(const u32x4*)(rp + OFF_VNA); } }
        const int cs = min(max(cq - 8, 0), 48);
        const unsigned kb0 = 128u * qi + 16u * ((unsigned)g ^ ((unsigned)qi & 7u)), kb1 = 128u * qi + 16u * ((4u + (unsigned)g) ^ ((unsigned)qi & 7u));
        const LAS float* bias = (const LAS float*)(lds + LRPB);
        f32x4 sc[16]; float mx = -3.0e38f;
#pragma unroll
        for (int kr = 0; kr < 8; ++kr) {
            const int krow = rs + kr; const unsigned so = (unsigned)(krow % 9) * 8192u + 128u * (unsigned)cb;
            const int dr = krow - r + 7;
#pragma unroll
            for (int h2 = 0; h2 < 2; ++h2) {
                f32x4 a = (f32x4){0.f, 0.f, 0.f, 0.f};
                a = __builtin_amdgcn_mfma_f32_16x16x32_bf16(*(const LAS bf16x8*)(lds + LKR + so + 2048u * h2 + kb0), qn[0], a, 0, 0, 0);
                a = __builtin_amdgcn_mfma_f32_16x16x32_bf16(*(const LAS bf16x8*)(lds + LKR + so + 2048u * h2 + kb1), qn[1], a, 0, 0, 0);
#pragma unroll
                for (int j = 0; j < 4; ++j) {
                    const int kcol = cb + 16 * h2 + 4 * g + j;
                    const int dc = min(max(kcol - cq + 15, 0), 30);
                    const float v = a[j] + bias[dr * 31 + dc];
                    const bool in = (kcol >= cs) && (kcol < cs + 16);
                    a[j] = in ? v : -3.0e38f; mx = fmaxf(mx, a[j]);
                }
                sc[2 * kr + h2] = a;
            }
        }
        mx = fmaxf(mx, __shfl_xor(mx, 16)); mx = fmaxf(mx, __shfl_xor(mx, 32));
        float sum = 0.f; bf16x8 pt[8];
#pragma unroll
        for (int kk = 0; kk < 8; ++kk) {
            float pv[8];
#pragma unroll
            for (int h2 = 0; h2 < 2; ++h2)
#pragma unroll
                for (int j = 0; j < 4; ++j) { const float e = __builtin_amdgcn_exp2f((sc[2 * kk + h2][j] - mx) * 1.4426950408889634f); pv[4 * h2 + j] = e; sum += e; }
            pt[kk] = ret::pack8(pv);
        }
        sum += __shfl_xor(sum, 16); sum += __shfl_xor(sum, 32);
        const float inv = 1.f / sum;
        const unsigned sl = (((unsigned)g & 1u) << 2) | qp;
        bf16_t* op = ymix + (size_t)tq * D + head * 64 + 4 * g;
#pragma unroll
        for (int db = 0; db < 4; ++db) {
            const unsigned vb = 128u * (4u * (unsigned)g + qp) + 16u * ((2u * db + (p >> 1)) ^ sl) + 8u * (p & 1u);
            f32x4 y = (f32x4){0.f, 0.f, 0.f, 0.f};
#pragma unroll
            for (int kk = 0; kk < 8; ++kk) {
                const unsigned so = (unsigned)((rs + kk) % 9) * 8192u + 128u * (unsigned)cb;
                const ret::s16x4 lo = __builtin_amdgcn_ds_read_tr16_b64_v4i16((LAS ret::s16x4*)(lds + LVR + so + vb));
                const ret::s16x4 hi = __builtin_amdgcn_ds_read_tr16_b64_v4i16((LAS ret::s16x4*)(lds + LVR + so + 2048u + vb));
                y = __builtin_amdgcn_mfma_f32_16x16x32_bf16(__builtin_shufflevector(lo, hi, 0, 1, 2, 3, 4, 5, 6, 7), pt[kk], y, 0, 0, 0);
            }
            u32x2 o; o.x = ret::cvtpk(y[0] * inv, y[1] * inv); o.y = ret::cvtpk(y[2] * inv, y[3] * inv);
            *(u32x2*)(op + 16 * db) = o;
        }
    }
    __syncthreads();
}
}

__device__ __forceinline__ void unpack_t16r(const u32x4 a, const u32x4 b, f32x4 (&v)[4]) {
    v[0] = (f32x4){__uint_as_float(a.x << 16), __uint_as_float(a.x & 0xffff0000u), __uint_as_float(a.y << 16), __uint_as_float(a.y & 0xffff0000u)};
    v[1] = (f32x4){__uint_as_float(a.z << 16), __uint_as_float(a.z & 0xffff0000u), __uint_as_float(a.w << 16), __uint_as_float(a.w & 0xffff0000u)};
    v[2] = (f32x4){__uint_as_float(b.x << 16), __uint_as_float(b.x & 0xffff0000u), __uint_as_float(b.y << 16), __uint_as_float(b.y & 0xffff0000u)};
    v[3] = (f32x4){__uint_as_float(b.z << 16), __uint_as_float(b.z & 0xffff0000u), __uint_as_float(b.w << 16), __uint_as_float(b.w & 0xffff0000u)};
}
__device__ __forceinline__ void ln1_row(const u32x4 ra, const u32x4 rb, const LAS float* cv  , bf16_t* __restrict__ hf, unsigned char* __restrict__ hf8, float* __restrict__ stats, int row, int lane) {
    asm volatile("" : "+v"(cv));
    const int c0 = lane * 16;
    f32x4 v[4]; float s = 0.f;
    unpack_t16r(ra, rb, v);
#pragma unroll
    for (int j = 0; j < 4; ++j) s += (v[j].x + v[j].y) + (v[j].z + v[j].w);
    const float mean = wave_sum(s) * (1.f / D); float s2 = 0.f;
#pragma unroll
    for (int j = 0; j < 4; ++j) { v[j] = v[j] - mean; s2 += (v[j].x * v[j].x + v[j].y * v[j].y) + (v[j].z * v[j].z + v[j].w * v[j].w); }
    const float rstd = 1.f / sqrtf(wave_sum(s2) * (1.f / D) + LN_EPS);
    if (lane == 0) *(f32x2*)(stats + 2 * (size_t)row) = (f32x2){mean, rstd};
    u32x4 ob[2], o8;
#pragma unroll
    for (int j = 0; j < 4; ++j) { const int col = c0 + 4 * j;
        const f32x4 gg = *(const LAS f32x4*)(cv + col), bv = *(const LAS f32x4*)(cv + 1024 + col), sc1 = *(const LAS f32x4*)(cv + 2048 + col), sh = *(const LAS f32x4*)(cv + 3072 + col);
        const f32x4 h4 = (v[j] * rstd * gg + bv) * sc1 + sh;
        const unsigned p0 = pk2(h4.x, h4.y), p1 = pk2(h4.z, h4.w);
        if (j == 0) { ob[0].x = p0; ob[0].y = p1; } else if (j == 1) { ob[0].z = p0; ob[0].w = p1; } else if (j == 2) { ob[1].x = p0; ob[1].y = p1; } else { ob[1].z = p0; ob[1].w = p1; }
        const f32x4 h8 = h4 * S_HF8;
        int w0 = __builtin_amdgcn_cvt_pk_fp8_f32(clamp8(h8.x), clamp8(h8.y), 0, false); w0 = __builtin_amdgcn_cvt_pk_fp8_f32(clamp8(h8.z), clamp8(h8.w), w0, true);
        if (j == 0) o8.x = (unsigned)w0; else if (j == 1) o8.y = (unsigned)w0; else if (j == 2) o8.z = (unsigned)w0; else o8.w = (unsigned)w0; }
    *(u32x4*)(hf + (size_t)row * D + c0) = ob[0]; *(u32x4*)(hf + (size_t)row * D + c0 + 8) = ob[1];
    *(u32x4*)(hf8 + (size_t)row * D + c0) = o8;
}
__device__ __forceinline__ void top2_merge(float& a1, float& a2, float b1, float b2) { const float n1 = fmaxf(a1, b1); const float n2 = fmaxf(fminf(a1, b1), fmaxf(a2, b2)); a1 = n1; a2 = n2; }
__device__ __forceinline__ float sigm(float x) { return 1.f / (1.f + __expf(-x)); }
__device__ __forceinline__ void route_lane(const float* __restrict__ logits, const float* __restrict__ rbias, int* __restrict__ topk_e, float* __restrict__ topk_w, LAS unsigned* hist, int tok) {
    const float NEG = -3.0e38f;
    const float* row = logits + (size_t)tok * NE;
    float gs[8];
#pragma unroll
    for (int g = 0; g < 8; ++g) {
        float m1 = NEG, m2 = NEG;
#pragma unroll
        for (int q = 0; q < 8; ++q) {
            const f32x4 lg = *(const f32x4*)(row + g * 32 + q * 4), b4 = *(const f32x4*)(rbias + g * 32 + q * 4);
            const float v[4] = {sigm(lg.x) + b4.x, sigm(lg.y) + b4.y, sigm(lg.z) + b4.z, sigm(lg.w) + b4.w};
#pragma unroll
            for (int j = 0; j < 4; ++j) { m2 = fmaxf(m2, fminf(m1, v[j])); m1 = fmaxf(m1, v[j]); }
        }
        gs[g] = m1 + m2;
        if (g & 1) asm volatile("" ::: "memory");
    }
    int pc[8];
    { int run = 0;
#pragma unroll
      for (int g = 0; g < 8; ++g) { int rank = 0;
#pragma unroll
          for (int h = 0; h < 8; ++h) if (h != g) rank += (gs[h] > gs[g] || (gs[h] == gs[g] && h < g)) ? 1 : 0;
          run += (rank < 4) ? 1 : 0; pc[g] = run; } }
    float L[8]; int I[8];
#pragma unroll
    for (int i = 0; i < 8; ++i) { L[i] = NEG; I[i] = 0; }
#pragma unroll 1
    for (int k = 0; k < 4; ++k) {
        int gk = 0;
#pragma unroll
        for (int g = 0; g < 8; ++g) gk += (pc[g] <= k) ? 1 : 0;
        const int base = gk * 32;
#pragma unroll
        for (int q = 0; q < 8; ++q) {
            const f32x4 lg = *(const f32x4*)(row + base + q * 4), b4 = *(const f32x4*)(rbias + base + q * 4);
            const float cv[4] = {sigm(lg.x) + b4.x, sigm(lg.y) + b4.y, sigm(lg.z) + b4.z, sigm(lg.w) + b4.w};
#pragma unroll
            for (int j = 0; j < 4; ++j) { float v = cv[j]; int idx = base + q * 4 + j;
#pragma unroll
                for (int i = 0; i < 8; ++i) { const bool gt = v > L[i]; const float tv = gt ? L[i] : v; const int ti = gt ? I[i] : idx; L[i] = gt ? v : L[i]; I[i] = gt ? idx : I[i]; v = tv; idx = ti; } }
        }
    }
    float w[8], wsum = 0.f;
#pragma unroll
    for (int i = 0; i < 8; ++i) { w[i] = sigm(row[I[i]]); wsum += w[i]; }
    const float sc = 2.5f / wsum;
    *(u32x4*)(topk_e + tok * TOPK) = (u32x4){(unsigned)I[0], (unsigned)I[1], (unsigned)I[2], (unsigned)I[3]}; *(u32x4*)(topk_e + tok * TOPK + 4) = (u32x4){(unsigned)I[4], (unsigned)I[5], (unsigned)I[6], (unsigned)I[7]};
    *(f32x4*)(topk_w + tok * TOPK) = (f32x4){w[0] * sc, w[1] * sc, w[2] * sc, w[3] * sc}; *(f32x4*)(topk_w + tok * TOPK + 4) = (f32x4){w[4] * sc, w[5] * sc, w[6] * sc, w[7] * sc};
#pragma unroll
    for (int i = 0; i < 8; ++i) __hip_atomic_fetch_add(&hist[I[i]], 1u, __ATOMIC_RELAXED, __HIP_MEMORY_SCOPE_WORKGROUP);
}
__device__ __forceinline__ void build_tables(const unsigned* ctl, LAS unsigned* tab, const int tid) {
    if (tid < 64) {
        const int lane = tid;
        unsigned c[4], so = 0, st = 0;
#pragma unroll
        for (int j = 0; j < 4; ++j) { c[j] = __hip_atomic_load(ctl + CW_COUNT + lane * 4 + j, __ATOMIC_RELAXED, __HIP_MEMORY_SCOPE_AGENT); so += c[j]; st += (c[j] + 255u) >> 8; }
        unsigned io = so, it = st;
#pragma unroll
        for (int o = 1; o < 64; o <<= 1) { const unsigned a = __shfl_up(io, o), b = __shfl_up(it, o); if (lane >= o) { io += a; it += b; } }
        unsigned eo = io - so, et = it - st;
#pragma unroll
        for (int j = 0; j < 4; ++j) { tab[T_CNT + lane * 4 + j] = c[j]; tab[T_OFF + lane * 4 + j] = eo; tab[T_TILE + lane * 4 + j] = et; eo += c[j]; et += (c[j] + 255u) >> 8; }
        if (lane == 63) { tab[T_OFF + NE] = eo; tab[T_TILE + NE] = et; }
    }
    __syncthreads();
}
struct RowRaw { u32x4 y[9]; u32x4 t[2]; f32x2 st; };
__device__ __forceinline__ void final_load(RowRaw& R, const bf16_t* __restrict__ tb, const unsigned char* __restrict__ ybuf, const unsigned char* __restrict__ ysh, const float* __restrict__ stats, int row, int lane) {
    const int c0 = lane * 16;
#pragma unroll
    for (int k = 0; k < TOPK; ++k) R.y[k] = *(const u32x4*)(ybuf + ((size_t)row * TOPK + k) * D + c0);
    R.y[8] = *(const u32x4*)(ysh + (size_t)row * D + c0);
    R.t[0] = *(const u32x4*)(tb + (size_t)row * D + c0); R.t[1] = *(const u32x4*)(tb + (size_t)row * D + c0 + 8);
    R.st = *(const f32x2*)(stats + 2 * (size_t)row);
}
__device__ __forceinline__ void final_row(float* __restrict__ out, const RowRaw& R, const LAS float* cv  , int row, int lane) {
    asm volatile("" : "+v"(cv));
    const int c0 = lane * 16;
    f32x4 a[4], t[4], v[4]; float s = 0.f;
#pragma unroll
    for (int j = 0; j < 4; ++j) a[j] = (f32x4){0.f, 0.f, 0.f, 0.f};
#pragma unroll
    for (int k = 0; k < 9; ++k) { const unsigned w[4] = {R.y[k].x, R.y[k].y, R.y[k].z, R.y[k].w};
#pragma unroll
        for (int j = 0; j < 4; ++j) { const f32x2 lo = __builtin_amdgcn_cvt_pk_f32_fp8((int)w[j], false), hi = __builtin_amdgcn_cvt_pk_f32_fp8((int)w[j], true); a[j].x += lo.x; a[j].y += lo.y; a[j].z += hi.x; a[j].w += hi.y; } }
    unpack_t16r(R.t[0], R.t[1], t);
#pragma unroll
    for (int j = 0; j < 4; ++j) { const int col = c0 + 4 * j;
        const f32x4 x1 = (t[j] - R.st.x) * R.st.y * *(const LAS f32x4*)(cv + col) + *(const LAS f32x4*)(cv + 1024 + col);
        v[j] = x1 * ALPHA + *(const LAS f32x4*)(cv + 4096 + col) * a[j] * YINV;
        s += (v[j].x + v[j].y) + (v[j].z + v[j].w); }
    const float mean = wave_sum(s) * (1.f / D); float s2 = 0.f;
#pragma unroll
    for (int j = 0; j < 4; ++j) { v[j] = v[j] - mean; s2 += (v[j].x * v[j].x + v[j].y * v[j].y) + (v[j].z * v[j].z + v[j].w * v[j].w); }
    const float rstd = 1.f / sqrtf(wave_sum(s2) * (1.f / D) + LN_EPS);
#pragma unroll
    for (int j = 0; j < 4; ++j) { const int col = c0 + 4 * j;
        *(f32x4*)(out + (size_t)row * D + col) = v[j] * rstd * *(const LAS f32x4*)(cv + 2048 + col) + *(const LAS f32x4*)(cv + 3072 + col); }
}

#ifndef MK_PER_PHASE
#define MK_PER_PHASE 0
#endif
constexpr int N_PHASES = 13;
struct Args { Ctx X; int ph_lo, ph_hi; };
typedef __attribute__((address_space(4))) const Ctx* CtxCP;
__device__ __forceinline__ CtxCP ctx_ptr() { CtxCP p = (CtxCP)__builtin_amdgcn_kernarg_segment_ptr(); asm volatile("" : "+s"(p)); return p; }

__global__ void __launch_bounds__(NW * 64, 2) mk_fwd(Args args) {
    extern __shared__ __attribute__((aligned(16))) unsigned char lds_raw[];
    LAS unsigned char* lds = (LAS unsigned char*)lds_raw;
    LAS unsigned* tab = (LAS unsigned*)(lds + TAB_OFF);
    volatile LAS unsigned* MISC = (volatile LAS unsigned*)(lds + MISC_OFF);
#define PH_BEGIN \
    const __attribute__((address_space(4))) Ctx& X = *ctx_ptr(); unsigned char* ws = X.ws; (void)ws; \
    const int lane = lane_id(), wave = wave0, tid = wave0 * 64 + lane; (void)lane; (void)wave; (void)tid; \
    const int G = gridDim.x, bx = blockIdx.x; (void)G; (void)bx; \
    const int gw = bx * NW + wave, NGW = G * NW; (void)gw; (void)NGW; \
    const int gt = bx * (NW * 64) + tid, NGT = G * NW * 64; (void)gt; (void)NGT; \
    unsigned* ctl = (unsigned*)(ws + WS_CTL); float* mod = (float*)(ws + WS_MOD); float* rope = (float*)(ws + WS_ROPE); (void)ctl; (void)mod; (void)rope; \
    bf16_t* win_t = (bf16_t*)(ws + WS_WIN_T); bf16_t* wout_t = (bf16_t*)(ws + WS_WOUT_T); bf16_t* wr_t = (bf16_t*)(ws + WS_WR_T); (void)win_t; (void)wout_t; (void)wr_t; \
    bf16_t* wsgu_t = (bf16_t*)(ws + WS_WSGU_T); bf16_t* wsd_t = (bf16_t*)(ws + WS_WSD_T); bf16_t* wd_t = (bf16_t*)(ws + WS_WD_T); bf16_t* wgu_t = (bf16_t*)(ws + WS_WGU_T); (void)wsgu_t; (void)wsd_t; (void)wd_t; (void)wgu_t; \
    int* slot_ent = (int*)(ws + WS_SLOT_ENT); float* slot_w = (float*)(ws + WS_SLOT_W); int* topk_e = (int*)(ws + WS_TOPK_E); float* topk_w = (float*)(ws + WS_TOPK_W); (void)slot_ent; (void)slot_w; (void)topk_e; (void)topk_w; \
    bf16_t* ymix = (bf16_t*)(ws + WS_YMIX); bf16_t* proj = (bf16_t*)(ws + WS_PROJ); bf16_t* hbuf = (bf16_t*)(ws + WS_YMIX); (void)ymix; (void)proj; (void)hbuf; \
    float* logits = (float*)(ws + WS_LOGITS); bf16_t* shh = (bf16_t*)(ws + WS_SHH); bf16_t* hf = (bf16_t*)(ws + WS_HF); bf16_t* act = (bf16_t*)(ws + WS_ACT); (void)logits; (void)shh; (void)hf; (void)act; \
    unsigned char* ybuf = ws + WS_YBUF; float* out = X.out; (void)ybuf; (void)out;

    const int wave0 = __builtin_amdgcn_readfirstlane((int)threadIdx.x >> 6);
    for (int u = threadIdx.x; u < (LDS_BYTES - MISC_OFF) / 4; u += NW * 64) ((LAS unsigned*)(lds + MISC_OFF))[u] = 0u;
    __syncthreads();
    if (!MK_PER_PHASE) { unsigned* ctl0 = (unsigned*)(args.X.ws + WS_CTL); (void)xcd_barrier_post(ctl0 + CW_BAR, MISC + 8, wave0 == 0 && lane_id() == 0); }
    const int lo = args.ph_lo, hi = args.ph_hi;
#ifndef MK_DUP
#define MK_DUP -1
#endif
#define REPS(k) for (int _rep = 0; _rep < ((MK_DUP == (k)) ? 2 : 1); ++_rep)
#ifdef MK_ONLY
#define IN(k) ((k) == MK_ONLY)
#else
#define IN(k) (lo <= (k) && (k) < hi)
#endif
#define SEAM(k) SEAM2(k, (k) + 1)
#define SEAM2(k, k2) do { if (IN(k) && IN(k2)) { XcdBarrier _b; _b.bar = (unsigned*)(ctx_ptr()->ws + WS_CTL) + CW_BAR; _b.x = xb_xcc_id(); _b.st = (volatile LAS unsigned*)(lds + MISC_OFF) + 8; xcd_barrier(_b, wave0 == 0 && lane_id() == 0); } } while (0)

    REPS(0) if (IN(0)) { PH_BEGIN
        LAS float* scr = (LAS float*)(lds + wave * 16384);
        float* modp = (float*)(ws + WS_PROJ);
        for (int t = gw; t < 96 * 16; t += NGW) mod_task(X.c, X.w_ada, modp, t, lane);
        constexpr int I_IN = (D / 64) * (DIN / 32), I_OUT = (D / 64) * (D / 32), I_R = (D / 64) * (NE / 32), I_SG = (D / 64) * (DE / 32), I_SD = (DE / 64) * (D / 32);
        constexpr int I_EG = I_SG, I_ED = I_SD;
        constexpr int N_SMALL = I_IN + I_OUT + I_R + 2 * I_SG + I_SD;
        constexpr int N_ITEMS = N_SMALL + NE * (2 * I_EG + I_ED);
        for (int it = gw; it < N_ITEMS; it += NGW) {
            int r = it;
            if (r < I_IN) { transpose_item(X.w_in, D, DIN, win_t, 0, 0, scr, r, lane); continue; } r -= I_IN;
            if (r < I_OUT) { transpose_item(X.w_out, D, D, wout_t, 0, 0, scr, r, lane); continue; } r -= I_OUT;
            if (r < I_R) { transpose_item(X.w_router, D, NE, wr_t, 0, 0, scr, r, lane); continue; } r -= I_R;
            if (r < I_SG) { transpose_item(X.ws_gate, D, DE, wsgu_t, 8, 0, scr, r, lane); continue; } r -= I_SG;
            if (r < I_SG) { transpose_item(X.ws_up, D, DE, wsgu_t, 8, 1, scr, r, lane); continue; } r -= I_SG;
            if (r < I_SD) { transpose_item(X.ws_down, DE, D, wsd_t, 0, 0, scr, r, lane); continue; } r -= I_SD;
            const int e = r / (2 * I_EG + I_ED); r -= e * (2 * I_EG + I_ED);
            if (r < I_EG) { transpose_item_fp8(X.w_gate + (size_t)e * D * DE, D, DE, (unsigned char*)wgu_t + (size_t)e * 512 * D, 8, 0, S_WGU8, scr, r, lane); continue; } r -= I_EG;
            if (r < I_EG) { transpose_item_fp8(X.w_up + (size_t)e * D * DE, D, DE, (unsigned char*)wgu_t + (size_t)e * 512 * D, 8, 1, S_WGU8, scr, r, lane); continue; } r -= I_EG;
            transpose_item_fp8(X.w_down + (size_t)e * DE * D, DE, D, (unsigned char*)wd_t + (size_t)e * D * DE, 0, 0, S_WD8, scr, r, lane);
        }
        for (int i = gt; i < SEQ * 64; i += NGT) rope_entry(rope, i);
    }
    SEAM(0);
    REPS(1) if (IN(1)) { PH_BEGIN
        const float* modp = (const float*)(ws + WS_PROJ);
        for (int i = gt; i < 32 * 6144; i += NGT) mod[i] = mod_sum(modp, X.b_ada, i / 6144, i % 6144);
        LAS float* ssc = (LAS float*)lds; LAS float* ssh = ssc + 1024;
        int curb = -1;
        for (int c = bx; c < M / 256; c += G) {
            const int b = c >> 3;
            if (b != curb) {
                __syncthreads();
                for (int i = tid; i < 1024; i += NW * 64) { ssc[i] = 1.f + mod_sum(modp, X.b_ada, b, MOD_SCALE_A + i); ssh[i] = mod_sum(modp, X.b_ada, b, MOD_SHIFT_A + i); }
                __syncthreads();
                curb = b;
            }
            const f32x4 sc = *(const LAS f32x4*)(ssc + (tid & 255) * 4), sh = *(const LAS f32x4*)(ssh + (tid & 255) * 4);
            const float* xp = X.x + (size_t)c * 256 * D + (size_t)(tid >> 8) * D + (tid & 255) * 4;
            bf16_t* hp = hbuf + (size_t)c * 256 * D + (size_t)(tid >> 8) * D + (tid & 255) * 4;
            for (int i0 = 0; i0 < 128; i0 += 8) {
                f32x4 v[8];
#pragma unroll
                for (int i = 0; i < 8; ++i) v[i] = __builtin_nontemporal_load((const f32x4*)(xp + (size_t)(i0 + i) * 2 * D));
#pragma unroll
                for (int i = 0; i < 8; ++i) { u32x2 o; o.x = pk2(v[i].x * sc.x + sh.x, v[i].y * sc.y + sh.y); o.y = pk2(v[i].z * sc.z + sh.z, v[i].w * sc.w + sh.w); *(u32x2*)(hp + (size_t)(i0 + i) * 2 * D) = o; }
            }
        }
        __syncthreads();
    }
    SEAM(1);
    REPS(2) if (IN(2)) { PH_BEGIN
        pg8::DenseOrder S; S.init(M, DIN, D, win_t, G, bx);
        pg8::EpiInProj E{proj};
        pg8::gemm_phase(lds, (const char*)hbuf, D, S, E, tid);
    }
    SEAM(2);
    REPS(3) if (IN(3)) { PH_BEGIN
        REPS(31) for (int hu = bx; hu < BATCH * 4 * 2; hu += G) ret::unit(proj, rope, X.ret_ld, X.ret_gn, ymix, (unsigned char*)out + (size_t)hu * (8 * ret::TILE), lds, hu, tid);
        REPS(32) for (int u = bx; u < BATCH * 8; u += G) na::unit(proj, X.na_rpb, ymix, lds, u, tid);
    }
    SEAM2(3, 5);
    if (IN(5)) { PH_BEGIN
        LAS float* cv = (LAS float*)lds; LAS unsigned* hist = tab + T_HIST;
        if (tid < NE) hist[tid] = 0u;
        __syncthreads();
        for (int c = bx; c < M / 256; c += G) {
            const int b = c >> 3;
            { pg8::RowOrder S{c, 4, D, (const char*)wout_t}; pg8::EpiOutProj E{X.x, mod, (bf16_t*)(ws + WS_TB)}; pg8::gemm_phase(lds, (const char*)ymix, D, S, E, tid); }
            asm volatile("s_waitcnt vmcnt(0)" ::: "memory"); __syncthreads();
            int lane2 = lane; asm volatile("" : "+v"(lane2));
            const int tid2 = wave * 64 + lane2;
            if (tid2 < 256) { const int i = tid2 * 4; *(LAS f32x4*)(cv + i) = *(const f32x4*)(X.ln1_g + i); *(LAS f32x4*)(cv + 1024 + i) = *(const f32x4*)(X.ln1_b + i);
                *(LAS f32x4*)(cv + 2048 + i) = *(const f32x4*)(mod + b * 6144 + MOD_SCALE_F + i) + 1.f; *(LAS f32x4*)(cv + 3072 + i) = *(const f32x4*)(mod + b * 6144 + MOD_SHIFT_F + i); }
            __syncthreads();
            { const bf16_t* tp = (const bf16_t*)(ws + WS_TB) + (size_t)(c * 256 + wave * 32) * D + lane2 * 16;
              u32x4 ra = *(const u32x4*)tp, rb = *(const u32x4*)(tp + 8);
#pragma unroll 1
              for (int i = 0; i < 32; ++i) {
                  const u32x4 ca = ra, cb = rb; const int nx = i < 31 ? i + 1 : i;
                  ra = *(const u32x4*)(tp + (size_t)nx * D); rb = *(const u32x4*)(tp + (size_t)nx * D + 8);
                  ln1_row(ca, cb, cv, hf, ws + WS_HF8, (float*)(ws + WS_STATS), c * 256 + wave * 32 + i, lane2);
              } }
            asm volatile("s_waitcnt vmcnt(0)" ::: "memory"); __syncthreads();
            { pg8::RowOrder S{c, 1, D, (const char*)wr_t}; pg8::EpiRouter E{logits}; pg8::gemm_phase(lds, (const char*)hf, D, S, E, tid); }
            { pg8::RowOrder S{c, 2, D, (const char*)wsgu_t}; pg8::EpiGU<false> E{(void*)shh}; pg8::gemm_phase(lds, (const char*)hf, D, S, E, tid); }
            asm volatile("s_waitcnt vmcnt(0)" ::: "memory"); __syncthreads();
            { int lane3 = lane; asm volatile("" : "+v"(lane3)); const int tid3 = wave * 64 + lane3;
              if (tid3 < 256) route_lane(logits, X.rbias, topk_e, topk_w, hist, c * 256 + tid3); }
        }
        __syncthreads();
        if (tid < NE && hist[tid]) atomicAdd(&ctl[CW_COUNT + tid], hist[tid]);
    }
    SEAM2(5, 9);
    if (IN(9)) { PH_BEGIN
        build_tables(ctl, tab, tid);
        LAS unsigned* hist = tab + T_HIST; LAS unsigned* base = tab + T_BASE;
        for (int c0 = bx * 2048; c0 < NSLOT; c0 += G * 2048) {
            __syncthreads();
            if (tid < NE) hist[tid] = 0u;
            __syncthreads();
            int e[4]; unsigned loc[4];
#pragma unroll
            for (int i = 0; i < 4; ++i) { const int idx = c0 + i * 512 + tid; e[i] = topk_e[idx]; loc[i] = __hip_atomic_fetch_add(&hist[e[i]], 1u, __ATOMIC_RELAXED, __HIP_MEMORY_SCOPE_WORKGROUP); }
            __syncthreads();
            if (tid < NE && hist[tid]) base[tid] = atomicAdd(&ctl[CW_CURSOR + tid], hist[tid]);
            __syncthreads();
#pragma unroll
            for (int i = 0; i < 4; ++i) { const int idx = c0 + i * 512 + tid; const unsigned pos = tab[T_OFF + e[i]] + base[e[i]] + loc[i]; slot_ent[pos] = idx; slot_w[pos] = topk_w[idx]; }
        }
    }
    SEAM(9);
    if (IN(10)) { PH_BEGIN
        build_tables(ctl, tab, tid);
        REPS(10) { pg8::ExpertOrder<2, true> S; S.init(tab, D, wgu_t, (size_t)512 * D, slot_ent, slot_w, G, bx); pg8::EpiGU<true> E{(void*)act}; pg8::gemm_phase<1>(lds, (const char*)(ws + WS_HF8), D, S, E, tid); }
        { pg8::DenseOrder S; S.init(M, D, DE, wsd_t, G, bx); pg8::EpiSharedDown E{ws + WS_YSH}; pg8::gemm_phase(lds, (const char*)shh, DE, S, E, tid); }
    }
    SEAM(10);
    REPS(11) if (IN(11)) { PH_BEGIN
        build_tables(ctl, tab, tid);
        pg8::ExpertOrder<4, false> S; S.init(tab, DE, wd_t, (size_t)D * DE, slot_ent, slot_w, G, bx); pg8::EpiExpDown E{ybuf, slot_ent}; pg8::gemm_phase<1>(lds, (const char*)act, DE, S, E, tid);
#if MK_DUP == 111
        { pg8::ExpertOrder<4, false> S2; S2.init(tab, DE, wd_t, (size_t)D * DE, slot_ent, slot_w, G, bx); pg8::EpiProbeSum E2{(float*)(ws + WS_STATS)}; pg8::gemm_phase<1>(lds, (const char*)act, DE, S2, E2, tid); }
#endif
    }
    SEAM(11);
    REPS(12) if (IN(12)) { PH_BEGIN
        LAS float* cv = (LAS float*)lds; int curb = -1;
        for (int c = bx; c < M / 256; c += G) {
            const int b = c >> 3;
            if (b != curb) {
                __syncthreads();
                if (tid < 256) { const int i = tid * 4; *(LAS f32x4*)(cv + i) = *(const f32x4*)(X.ln1_g + i); *(LAS f32x4*)(cv + 1024 + i) = *(const f32x4*)(X.ln1_b + i);
                    *(LAS f32x4*)(cv + 2048 + i) = *(const f32x4*)(X.ln2_g + i); *(LAS f32x4*)(cv + 3072 + i) = *(const f32x4*)(X.ln2_b + i); *(LAS f32x4*)(cv + 4096 + i) = *(const f32x4*)(mod + b * 6144 + MOD_GATE_F + i); }
                __syncthreads(); curb = b;
            }
            const int r0 = c * 256 + wave * 32;
            RowRaw nx; final_load(nx, (const bf16_t*)(ws + WS_TB), ybuf, ws + WS_YSH, (const float*)(ws + WS_STATS), r0, lane);
#pragma unroll 1
            for (int i = 0; i < 32; ++i) {
                const RowRaw cur = nx;
                final_load(nx, (const bf16_t*)(ws + WS_TB), ybuf, ws + WS_YSH, (const float*)(ws + WS_STATS), r0 + (i < 31 ? i + 1 : i), lane);
                final_row(out, cur, cv, r0 + i, lane);
            }
        }
    }
#undef IN
#undef SEAM
}

extern "C" void kernel_launch(void* const* d_in, const int* in_sizes, int n_in, void* d_out, int out_size, void* d_ws, size_t ws_size, hipStream_t stream) {
    static int grid = 0;
    if (grid == 0) {
        if (n_in != 21 || in_sizes[0] != M * D || out_size != M * D || ws_size < WS_END) { fprintf(stderr, "kernel_launch: unexpected shapes (n_in %d, ws %zu)\n", n_in, ws_size); grid = -1; return; }
        int dev = 0, cus = 0, per_cu = 0;
        if (hipGetDevice(&dev) != hipSuccess || hipDeviceGetAttribute(&cus, hipDeviceAttributeMultiprocessorCount, dev) != hipSuccess) { grid = -1; return; }
        if (hipFuncSetAttribute((const void*)mk_fwd, hipFuncAttributeMaxDynamicSharedMemorySize, LDS_BYTES) != hipSuccess) { fprintf(stderr, "kernel_launch: hipFuncSetAttribute failed\n"); grid = -1; return; }
        if (hipOccupancyMaxActiveBlocksPerMultiprocessor(&per_cu, (const void*)mk_fwd, NW * 64, LDS_BYTES) != hipSuccess || per_cu < 1) { fprintf(stderr, "kernel_launch: occupancy query says %d\n", per_cu); }
        (void)hipGetLastError();
        grid = cus;
    }
    if (grid < 0) return;
    (void)hipMemsetAsync((char*)d_ws + WS_CTL, 0, 1 * MiB, stream);
    Args a{};
    const float** p = (const float**)&a.X;
    for (int i = 0; i < 21; ++i) p[i] = (const float*)d_in[i];
    a.X.out = (float*)d_out; a.X.ws = (unsigned char*)d_ws;
#if MK_PER_PHASE
    for (int ph = 0; ph < N_PHASES; ++ph) { a.ph_lo = ph; a.ph_hi = ph + 1; hipLaunchKernelGGL(mk_fwd, dim3(grid), dim3(NW * 64), LDS_BYTES, stream, a); }
#else
    a.ph_lo = 0; a.ph_hi = N_PHASES;
    hipLaunchKernelGGL(mk_fwd, dim3(grid), dim3(NW * 64), LDS_BYTES, stream, a);
#endif
}
```

```cpp
#include <hip/hip_runtime.h>
#include <cstdio>
#include <cstdint>

typedef unsigned short bf16_t;
typedef short bf16x8 __attribute__((ext_vector_type(8)));
typedef float f32x4 __attribute__((ext_vector_type(4)));
typedef float f32x2 __attribute__((ext_vector_type(2)));
typedef unsigned u32x4 __attribute__((ext_vector_type(4)));
typedef unsigned u32x2 __attribute__((ext_vector_type(2)));
#define LAS __attribute__((address_space(3)))

constexpr int D = 1024, BATCH = 32, SEQ = 2048, M = BATCH * SEQ;
constexpr int DIN = 3584;
constexpr int OFF_QNA = 0, OFF_KNA = 512, OFF_VNA = 1024, OFF_QR = 1536, OFF_KR = 2048, OFF_VR = 2560, OFF_GR = 3072;
constexpr int NE = 256, TOPK = 8, DE = 256;
constexpr int NSLOT = M * TOPK;
constexpr float LN_EPS = 1e-5f, GN_EPS = 1e-6f;
constexpr float ALPHA = 1.189207115002721f;
constexpr float YSCALE = 64.f, YINV = 1.f / 64.f;
constexpr float S_HF8 = 16.f, S_WGU8 = 256.f, S_ACT8 = 32.f, S_WD8 = 128.f;
constexpr float INV_GU8 = 1.f / (16.f * 256.f), INV_DN8 = 1.f / (32.f * 128.f);
constexpr int MOD_SHIFT_A = 0, MOD_SCALE_A = 1024, MOD_GATE_A = 2048, MOD_SHIFT_F = 3072, MOD_SCALE_F = 4096, MOD_GATE_F = 5120;

constexpr size_t MiB = 1u << 20;
constexpr size_t WS_CTL = 0;
constexpr size_t WS_MOD = 1 * MiB;
constexpr size_t WS_ROPE = 2 * MiB;
constexpr size_t WS_WIN_T = 4 * MiB;
constexpr size_t WS_WOUT_T = 11 * MiB;
constexpr size_t WS_WR_T = 13 * MiB;
constexpr size_t WS_WSGU_T = 14 * MiB;
constexpr size_t WS_WSD_T = 15 * MiB;
constexpr size_t WS_SLOT_ENT = 16 * MiB;
constexpr size_t WS_SLOT_W = 18 * MiB;
constexpr size_t WS_TOPK_E = 20 * MiB;
constexpr size_t WS_TOPK_W = 22 * MiB;
constexpr size_t WS_STATS = 24 * MiB;
constexpr size_t WS_WD_T = 32 * MiB;
constexpr size_t WS_WGU_T = 160 * MiB;
constexpr size_t WS_HF8 = 288 * MiB;
constexpr size_t WS_YMIX = 416 * MiB;
constexpr size_t WS_PROJ = 544 * MiB;
constexpr size_t WS_LOGITS = WS_PROJ + 384 * MiB;
constexpr size_t WS_SHH = 352 * MiB;
constexpr size_t WS_HF = WS_PROJ, WS_ACT = WS_PROJ + 128 * MiB;
constexpr size_t WS_YBUF = WS_WGU_T;
constexpr size_t WS_TB = WS_PROJ + 256 * MiB;
constexpr size_t WS_YSH = WS_PROJ + 384 * MiB;
constexpr size_t WS_END = 992 * MiB;
constexpr int CW_COUNT = 1024, CW_CURSOR = 1536, CW_BAR = 8192;

constexpr int RING_BYTES = 131072;
constexpr int TAB_OFF = RING_BYTES;
constexpr int T_OFF = 0, T_TILE = 260, T_CNT = 520, T_HIST = 776, T_BASE = 1032, TAB_WORDS = 1288;
constexpr int VN_OFF = TAB_OFF + 6144;
constexpr int ROWTAB_OFF = VN_OFF + 8192;
constexpr int PHASE_BYTES = 155648;
constexpr int MISC_OFF = PHASE_BYTES;
constexpr int LDS_BYTES = PHASE_BYTES + 256;
static_assert(TAB_WORDS * 4 <= 6144 && ROWTAB_OFF + 6144 <= PHASE_BYTES && LDS_BYTES <= 163840, "LDS map");

__device__ __forceinline__ unsigned f2bf(float f) { unsigned u = __float_as_uint(f); return (u + 0x7fffu + ((u >> 16) & 1u)) >> 16; }
__device__ __forceinline__ float bf2f(unsigned short h) { return __uint_as_float(((unsigned)h) << 16); }
__device__ __forceinline__ unsigned pk2(float lo, float hi) { return f2bf(lo) | (f2bf(hi) << 16); }
__device__ __forceinline__ unsigned cvt_pk_bf16(float lo, float hi) { unsigned r; asm volatile("v_cvt_pk_bf16_f32 %0, %1, %2" : "=v"(r) : "v"(lo), "v"(hi)); return r; }
__device__ __forceinline__ float silu_f(float v) { return v * __builtin_amdgcn_rcpf(1.f + __expf(-v)); }
__device__ __forceinline__ float wave_sum(float v) {
    v += __builtin_bit_cast(float, __builtin_amdgcn_update_dpp(0, __builtin_bit_cast(int, v), 0xB1, 0xf, 0xf, true));
    v += __builtin_bit_cast(float, __builtin_amdgcn_update_dpp(0, __builtin_bit_cast(int, v), 0x4E, 0xf, 0xf, true));
    v += __builtin_bit_cast(float, __builtin_amdgcn_update_dpp(0, __builtin_bit_cast(int, v), 0x141, 0xf, 0xf, true));
    v += __builtin_bit_cast(float, __builtin_amdgcn_update_dpp(0, __builtin_bit_cast(int, v), 0x140, 0xf, 0xf, true));
    const int b = __builtin_bit_cast(int, v);
    return (__builtin_bit_cast(float, __builtin_amdgcn_readlane(b, 0)) + __builtin_bit_cast(float, __builtin_amdgcn_readlane(b, 16))) + (__builtin_bit_cast(float, __builtin_amdgcn_readlane(b, 32)) + __builtin_bit_cast(float, __builtin_amdgcn_readlane(b, 48)));
}
__device__ __forceinline__ float clamp8(float v) { return __builtin_amdgcn_fmed3f(v, -440.f, 440.f); }
#define LDS_WAIT() asm volatile("s_waitcnt lgkmcnt(0)" ::: "memory")
__device__ __forceinline__ int lane_id() { return (int)__builtin_amdgcn_mbcnt_hi(~0u, __builtin_amdgcn_mbcnt_lo(~0u, 0u)); }

#define XB_TMO      128
#define XB_XCNT(j)  (256  + 64 * (j))
#define XB_XSUB(j)  (1280 + 64 * (j))
#define XB_XGEN(j)  (2304 + 64 * (j))
#define XB_TOP      3328
#define XB_TOPGEN   3392
#define XCD_BAR_WORDS 3456
#define XB_SPIN_CAP (1u << 23)
__device__ __forceinline__ unsigned xb_ld(unsigned* p)              { return __hip_atomic_load(p, __ATOMIC_RELAXED, __HIP_MEMORY_SCOPE_AGENT); }
__device__ __forceinline__ unsigned xb_add(unsigned* p, unsigned v) { return __hip_atomic_fetch_add(p, v, __ATOMIC_RELAXED, __HIP_MEMORY_SCOPE_AGENT); }
__device__ __forceinline__ unsigned xb_xcc_id() { return (unsigned)__builtin_amdgcn_s_getreg((3 << 11) | 20) & 0xFu; }
#define XB_SPIN(cond, bar) do { unsigned _sp = 0; while (cond) { __builtin_amdgcn_s_sleep(1); \
    if ((++_sp & 255u) == 0u) { if (xb_ld(&(bar)[XB_TMO])) break; if (_sp > XB_SPIN_CAP) { atomicAdd(&(bar)[XB_TMO], 1u); break; } } } } while (0)
struct XcdBarrier { unsigned* bar; unsigned x; volatile LAS unsigned* st; };
__device__ __forceinline__ XcdBarrier xcd_barrier_post(unsigned* bar, volatile LAS unsigned* st, bool leader) {
    XcdBarrier b; b.bar = bar; b.x = xb_xcc_id(); b.st = st;
    if (leader) (void)xb_add(&bar[XB_XCNT(b.x)], 1u);
    return b;
}
__device__ __forceinline__ void xcd_barrier_complete(unsigned* bar, unsigned x, unsigned& nloc, unsigned& nx) {
    const unsigned G = gridDim.x * gridDim.y * gridDim.z;
    unsigned sum, cnt, mine, sp = 0u;
    for (;;) {
        sum = 0u; cnt = 0u; mine = 0u;
#pragma unroll
        for (unsigned j = 0; j < 16; ++j) { const unsigned c = xb_ld(&bar[XB_XCNT(j)]); sum += c; cnt += (c > 0u) ? 1u : 0u; mine = (j == x) ? c : mine; }
        if (sum == G) break;
        __builtin_amdgcn_s_sleep(1);
        if ((++sp & 255u) == 0u) { if (xb_ld(&bar[XB_TMO])) break; if (sp > XB_SPIN_CAP) { atomicAdd(&bar[XB_TMO], 1u); break; } }
    }
    nloc = mine > 0u ? mine : 1u; nx = cnt > 0u ? cnt : 1u;
}
__device__ __forceinline__ void xcd_barrier(const XcdBarrier& b, bool leader) {
    asm volatile("s_waitcnt vmcnt(0)" ::: "memory");
    __syncthreads();
    if (leader) {
        unsigned* bar = b.bar;
        __builtin_amdgcn_s_waitcnt(0);
        unsigned nloc = b.st[0], nx = b.st[1];
        if (nloc == 0u) { xcd_barrier_complete(bar, b.x, nloc, nx); b.st[0] = nloc; b.st[1] = nx; }
        const unsigned old = xb_add(&bar[XB_XSUB(b.x)], 1u);
        const unsigned gen = old / nloc;
        if (old + 1u == (gen + 1u) * nloc) {
            __builtin_amdgcn_fence(__ATOMIC_RELEASE, "agent");
            asm volatile("s_waitcnt vmcnt(0)" ::: "memory");
            const unsigned og = xb_add(&bar[XB_TOP], 1u);
            const unsigned tg = og / nx;
            if (og + 1u == (tg + 1u) * nx) xb_add(&bar[XB_TOPGEN], 1u);
            else XB_SPIN(xb_ld(&bar[XB_TOPGEN]) == tg, bar);
            __builtin_amdgcn_fence(__ATOMIC_ACQUIRE, "agent");
            xb_add(&bar[XB_XGEN(b.x)], 1u);
            asm volatile("s_waitcnt vmcnt(0)" ::: "memory");
        } else {
            XB_SPIN(xb_ld(&bar[XB_XGEN(b.x)]) == gen, bar);
            __builtin_amdgcn_fence(__ATOMIC_ACQUIRE, "agent");
            asm volatile("s_waitcnt vmcnt(0)" ::: "memory");
        }
    }
    __syncthreads();
}

namespace pg8 {
constexpr int BM = 256, BK = 64, HALF = 128, HTB = HALF * BK * 2, STAGE_BYTES = 8 * HTB;
__device__ __forceinline__ int lds_byte(int r, int c) { const int st = (r >> 4) * 2 + (c >> 5), rr = r & 15, cc = c & 31, ob = rr * 64 + cc * 2; return st * 1024 + (ob ^ (((ob >> 9) & 1) << 5)); }
__device__ __forceinline__ void stage_rc(int b, int& R, int& C) { const int st = b / 1024, sb = b % 1024, swz = sb ^ (((sb >> 9) & 1) << 5); R = (st >> 1) * 16 + swz / 64; C = (st & 1) * 32 + (swz % 64) / 2; }
__device__ __forceinline__ int perm32(int rho) { const int n = rho >> 4, i = rho & 15; return 8 * (i >> 2) + 4 * n + (i & 3); }

typedef int i32x8 __attribute__((ext_vector_type(8)));
__device__ __forceinline__ i32x8 cat8(const bf16x8 lo, const bf16x8 hi) { const u32x4 a = __builtin_bit_cast(u32x4, lo), b = __builtin_bit_cast(u32x4, hi); return (i32x8){(int)a.x, (int)a.y, (int)a.z, (int)a.w, (int)b.x, (int)b.y, (int)b.z, (int)b.w}; }
struct Unit { int pm, pn; const char* B; int e, cnt, off; };

template <int ESZ = 2, bool AREUSE = false, class Epi, class Sched>
__device__ __forceinline__ void gemm_phase(LAS unsigned char* lds, const char* Abase, const int K, const Sched& S, const Epi& E, const int tid_in) {
    int tid_ = tid_in; asm volatile("" : "+v"(tid_));
    const int tid = tid_, wid = __builtin_amdgcn_readfirstlane(tid >> 6), lane = tid & 63, wr = wid >> 2, wc = wid & 3, fr = lane & 15, fq = lane >> 4;
    const int rowbytes = K * ESZ, nt = rowbytes / 128;
    int Rr[2], Cc[2]; unsigned voffB[2], voffA[2];
#pragma unroll
    for (int i = 0; i < 2; ++i) { int R, C; stage_rc(tid * 16 + i * 8192, R, C); Rr[i] = R; Cc[i] = C; const int Rb = Epi::PERM ? (64 * (R >> 5) + 16 * ((R >> 2) & 3) + 4 * ((R >> 4) & 1) + (R & 3)) : R; voffB[i] = (unsigned)(Rb * rowbytes + C * 2); voffA[i] = (unsigned)(R * rowbytes + C * 2); }
    constexpr bool GATHER = Sched::GATHER;
    const size_t kstep = (size_t)128;
    const size_t hstep = (size_t)HALF * rowbytes;
    const size_t bhstep = (size_t)(Epi::PERM ? 8 : HALF) * rowbytes;
    const unsigned ldsw = (unsigned)wid * 1024u;
    const int aoff = lds_byte(wr * 64 + fr, fq * 8);
    const int boff = lds_byte(wc * 32 + fr, fq * 8);
#define PG8_SA(b, h) (((b) * 2 + (h)) * HTB)
#define PG8_SB(b, h) ((4 + (b) * 2 + (h)) * HTB)
#define PG8_STAGE(bufoff, gbase, voff) do { _Pragma("unroll") for (int _i = 0; _i < 2; ++_i) \
        __builtin_amdgcn_global_load_lds((const unsigned*)((const char*)(gbase) + (voff)[_i]), (LAS unsigned*)(lds + (bufoff) + ldsw + _i * 8192), 16, 0, 0); } while (0)
#define PG8_STAGEA(bufoff, uptr, koff, NEXT, h) do { if constexpr (GATHER) { if (NEXT) { const u32x2 _t = *(const LAS u32x2*)(vnslot + 2 * (h)); unsigned _v[2] = {_t.x, _t.y}; PG8_STAGE(bufoff, Abase + (koff), _v); } else { PG8_STAGE(bufoff, Abase + (koff), vc[h]); } } \
        else { PG8_STAGE(bufoff, (uptr) + (size_t)(h) * hstep + (koff), voffA); } } while (0)
#define PG8_LDA(dst, b, h) do { _Pragma("unroll") for (int m = 0; m < 4; ++m) { if constexpr (ESZ == 2) { _Pragma("unroll") for (int k = 0; k < 2; ++k) dst[m].q[k] = *(const LAS bf16x8*)(lds + PG8_SA(b, h) + aoff + m * 2048 + k * 1024); } \
        else dst[m].w = cat8(*(const LAS bf16x8*)(lds + PG8_SA(b, h) + aoff + m * 2048), *(const LAS bf16x8*)(lds + PG8_SA(b, h) + aoff + m * 2048 + 1024)); } } while (0)
#define PG8_LDB(dst, b, h) do { _Pragma("unroll") for (int n = 0; n < 2; ++n) { if constexpr (ESZ == 2) { _Pragma("unroll") for (int k = 0; k < 2; ++k) dst[n].q[k] = *(const LAS bf16x8*)(lds + PG8_SB(b, h) + boff + n * 2048 + k * 1024); } \
        else dst[n].w = cat8(*(const LAS bf16x8*)(lds + PG8_SB(b, h) + boff + n * 2048), *(const LAS bf16x8*)(lds + PG8_SB(b, h) + boff + n * 2048 + 1024)); } } while (0)
#define PG8_MMA(ai, bj, At, Bt) do { __builtin_amdgcn_s_setprio(1); _Pragma("unroll") for (int m = 0; m < 4; ++m) _Pragma("unroll") for (int n = 0; n < 2; ++n) { \
        if constexpr (ESZ == 2) { _Pragma("unroll") for (int k = 0; k < 2; ++k) acc[ai][bj][m][n] = __builtin_amdgcn_mfma_f32_16x16x32_bf16(Bt[n].q[k], At[m].q[k], acc[ai][bj][m][n], 0, 0, 0); } \
        else { asm volatile("v_mfma_f32_16x16x128_f8f6f4 %0, %1, %2, %0" : "+v"(acc[ai][bj][m][n]) : "v"(Bt[n].w), "v"(At[m].w)); } } \
        __builtin_amdgcn_s_setprio(0); } while (0)
#define PG8_WAIT_V(n) asm volatile("s_waitcnt vmcnt(" #n ")" ::: "memory")
#define PG8_WAIT_L(n) asm volatile("s_waitcnt lgkmcnt(" #n ")" ::: "memory")
#define PG8_BAR __builtin_amdgcn_s_barrier()
#define PG8_SCHED __builtin_amdgcn_sched_barrier(0)
    Unit cur, nxt; int ui = 0; bool fresh_cur = true;
    if (!S.next(0, cur)) return;
    f32x4 acc[2][2][4][2];
    union Frag { bf16x8 q[2]; i32x8 w; };
    Frag At[4], B0[2], B1[2];
    unsigned vc[2][2];
    LAS unsigned* vnslot = (LAS unsigned*)(lds + (VN_OFF - 0)) + tid * 4;
    if constexpr (GATHER) S.avoff(cur, Rr, Cc, vc, tid);
    LAS unsigned* rowtab = (LAS unsigned*)(lds + ROWTAB_OFF);
    if constexpr (GATHER) S.rowtab(cur, rowtab, tid);
    const char* cB = cur.B; const char* cA = Abase + S.aoff(cur);
    PG8_STAGE(PG8_SB(0, 0), cB, voffB); PG8_STAGE(PG8_SB(0, 1), cB + bhstep, voffB); PG8_STAGEA(PG8_SA(0, 0), cA, 0, false, 0); PG8_STAGEA(PG8_SA(0, 1), cA, 0, false, 1);
    if (wr == 1) PG8_BAR;
    PG8_WAIT_V(2); PG8_BAR;
    PG8_STAGE(PG8_SB(1, 0), cB + kstep, voffB); PG8_STAGEA(PG8_SA(1, 0), cA, kstep, false, 0); PG8_STAGE(PG8_SB(1, 1), cB + bhstep + kstep, voffB);
    PG8_WAIT_V(6); PG8_BAR;
    asm volatile("" ::: "memory");
#pragma unroll
    for (int a = 0; a < 2; ++a)
#pragma unroll
        for (int b = 0; b < 2; ++b)
#pragma unroll
            for (int m = 0; m < 4; ++m)
#pragma unroll
                for (int n = 0; n < 2; ++n) { acc[a][b][m][n] = (f32x4){0.f, 0.f, 0.f, 0.f}; asm volatile("" : "+v"(acc[a][b][m][n])); }
    asm volatile("s_nop 4" ::: "memory");
    for (;;) {
        const bool has_next = S.next(ui + 1, nxt);
        if constexpr (GATHER) {
            unsigned vn[2][2];
            if (has_next) S.avoff(nxt, Rr, Cc, vn, tid);
            else {
#pragma unroll
                for (int h = 0; h < 2; ++h)
#pragma unroll
                    for (int i = 0; i < 2; ++i) vn[h][i] = vc[h][i];
            }
            *(LAS u32x4*)vnslot = (u32x4){vn[0][0], vn[0][1], vn[1][0], vn[1][1]};
            if (has_next) S.rowtab(nxt, rowtab + 512 * ((ui + 1) % 3), tid);
        }
        const char* nB = has_next ? nxt.B : cB; const char* nA = has_next ? Abase + S.aoff(nxt) : cA;
        const bool fresh_nxt = !(AREUSE && has_next && nxt.e == cur.e && nxt.pm == cur.pm);
        const bool ff = fresh_cur && fresh_nxt;
#define PG8_WAITX do { if (!AREUSE || ff) PG8_WAIT_V(8); else PG8_WAIT_V(4); } while (0)
        for (int t = 0; t < nt; t += 2) {
            const bool last = (t == nt - 2);
            const size_t k1 = (size_t)(t + 1) * kstep;
            const size_t k2 = last ? (size_t)0 : (size_t)(t + 2) * kstep, k3 = k2 + kstep;
            const char* u2 = last ? nA : cA; const char* b2 = last ? nB : cB + (size_t)(t + 2) * kstep;
            const char* b3 = b2 + kstep;
            PG8_LDB(B0, 0, 0); PG8_LDB(B1, 0, 1); PG8_SCHED; PG8_LDA(At, 0, 0); if (!AREUSE || fresh_cur) PG8_STAGEA(PG8_SA(1, 1), cA, k1, false, 1);
            PG8_WAITX; PG8_WAIT_L(0); PG8_BAR; PG8_MMA(0, 0, At, B0); PG8_MMA(0, 1, At, B1); PG8_BAR; PG8_SCHED;
            PG8_LDA(At, 0, 1); PG8_STAGE(PG8_SB(0, 0), b2, voffB); PG8_STAGE(PG8_SB(0, 1), b2 + bhstep, voffB); if (!AREUSE || fresh_nxt) PG8_STAGEA(PG8_SA(0, 0), u2, k2, last, 0);
            PG8_WAITX; PG8_WAIT_L(0); PG8_BAR; PG8_MMA(1, 0, At, B0); PG8_MMA(1, 1, At, B1); PG8_BAR; PG8_SCHED;
            PG8_LDB(B0, 1, 0); PG8_LDB(B1, 1, 1); PG8_SCHED; PG8_LDA(At, 1, 0); if (!AREUSE || fresh_nxt) PG8_STAGEA(PG8_SA(0, 1), u2, k2, last, 1);
            PG8_WAITX; PG8_WAIT_L(0); PG8_BAR; PG8_MMA(0, 0, At, B0); PG8_MMA(0, 1, At, B1); PG8_BAR; PG8_SCHED;
            PG8_LDA(At, 1, 1); PG8_STAGE(PG8_SB(1, 0), b3, voffB); PG8_STAGE(PG8_SB(1, 1), b3 + bhstep, voffB); if (!AREUSE || fresh_nxt) PG8_STAGEA(PG8_SA(1, 0), u2, k3, last, 0);
            PG8_WAITX; PG8_WAIT_L(0); PG8_BAR; PG8_MMA(1, 0, At, B0); PG8_MMA(1, 1, At, B1); PG8_BAR; PG8_SCHED;
        }
#undef PG8_WAITX
        if (wr == 0) PG8_BAR;
        if constexpr (ESZ == 1) {
            asm volatile("s_nop 15\n\ts_nop 15" ::: "memory");
#pragma unroll
            for (int a = 0; a < 2; ++a)
#pragma unroll
                for (int b = 0; b < 2; ++b)
#pragma unroll
                    for (int m = 0; m < 4; ++m) asm volatile("" : "+v"(acc[a][b][m][0]), "+v"(acc[a][b][m][1]));
        }
        { const int l2 = lane_id(); E(acc, cur, wr, wc, l2 & 15, l2 >> 4, rowtab + 512 * (ui % 3)); }
        if (!has_next) break;
#pragma unroll
        for (int a = 0; a < 2; ++a)
#pragma unroll
            for (int b = 0; b < 2; ++b)
#pragma unroll
                for (int m = 0; m < 4; ++m)
#pragma unroll
                    for (int n = 0; n < 2; ++n) acc[a][b][m][n] = (f32x4){0.f, 0.f, 0.f, 0.f};
        cur = nxt; cB = nB; cA = nA; ++ui; fresh_cur = fresh_nxt;
        if constexpr (GATHER) { const u32x4 _t = *(const LAS u32x4*)vnslot; vc[0][0] = _t.x; vc[0][1] = _t.y; vc[1][0] = _t.z; vc[1][1] = _t.w; }
        if (wr == 1) PG8_BAR;
    }
    PG8_WAIT_V(0);
    PG8_BAR;
#undef PG8_SA
#undef PG8_SB
#undef PG8_STAGE
#undef PG8_STAGEA
#undef PG8_LDA
#undef PG8_LDB
#undef PG8_MMA
#undef PG8_WAIT_V
#undef PG8_WAIT_L
#undef PG8_BAR
#undef PG8_SCHED
}

struct DenseOrder {
    int nM, nN, nwg, G, c, K; const char* Bt;
    __device__ __forceinline__ void init(int Mrows, int N, int K_, const void* Bt_, int G_, int c_) { nM = Mrows / BM; nN = N / BM; nwg = nM * nN; G = G_; c = c_; K = K_; Bt = (const char*)Bt_; }
    __device__ __forceinline__ bool next(int i, Unit& u) const {
        const long L = (long)i * G + c; if (L >= nwg) return false;
        int wgid = (int)L; { const int q = nwg / 8, r = nwg % 8, xcd = wgid % 8, off = wgid / 8; wgid = (xcd < r ? xcd * (q + 1) : r * (q + 1) + (xcd - r) * q) + off; }
        const int nig = 8 * nN, gid = wgid / nig, fm = gid * 8, gsz = (nM - fm) < 8 ? (nM - fm) : 8;
        u.pm = fm + ((wgid % nig) % gsz); u.pn = (wgid % nig) / gsz; u.B = Bt + (size_t)u.pn * BM * K * 2; u.e = 0; u.cnt = 0; u.off = 0; return true;
    }
    static constexpr bool GATHER = false;
    __device__ __forceinline__ size_t aoff(const Unit& u) const { return (size_t)u.pm * BM * K * 2; }
    __device__ __forceinline__ void avoff(const Unit&, const int (&)[2], const int (&)[2], unsigned (&)[2][2], int) const {}
};
struct RowOrder {
    int pm, ncol, K; const char* Bt;
    static constexpr bool GATHER = false;
    __device__ __forceinline__ bool next(int i, Unit& u) const { if (i >= ncol) return false; u.pm = pm; u.pn = i; u.B = Bt + (size_t)i * BM * K * 2; u.e = 0; u.cnt = 0; u.off = 0; return true; }
    __device__ __forceinline__ size_t aoff(const Unit& u) const { return (size_t)u.pm * BM * K * 2; }
    __device__ __forceinline__ void avoff(const Unit&, const int (&)[2], const int (&)[2], unsigned (&)[2][2], int) const {}
};
template <int NCOL, bool TOKROWS, bool TILEMAJOR = false> struct ExpertOrder {
    static constexpr bool GATHER = true;
    __device__ __forceinline__ size_t aoff(const Unit&) const { return 0; }
    const LAS unsigned* tab; int per, c, K  ; const char* W; size_t wstride; const int* slot_ent; const float* slot_w;
    mutable int ehint = 0;
    int xbase, xend, xstride, xlb;
    __device__ __forceinline__ void init(const LAS unsigned* tab_, int K_, const void* W_, size_t wstride_, const int* slot_ent_, const float* slot_w_, int G, int c_) {
        tab = tab_; K = K_; W = (const char*)W_; wstride = wstride_; slot_ent = slot_ent_; slot_w = slot_w_; c = c_;
        const int U = (int)tab[T_TILE + NE] * (TILEMAJOR ? 1 : NCOL); per = (U + G - 1) / G;
        if (G % 8 == 0) { const int x = c_ % 8; const int q = U / 8, r = U % 8; xbase = x * q + (x < r ? x : r); xend = xbase + q + (x < r ? 1 : 0); xstride = G / 8; xlb = c_ / 8; }
        else { xbase = 0; xend = U; xstride = G; xlb = c_; }
    }
    __device__ __forceinline__ bool next(int i, Unit& u) const {
        const int L = TILEMAJOR ? xbase + (i / NCOL) * xstride + xlb : xbase + i * xstride + xlb;
        if (L >= xend) return false;
        const int tile = TILEMAJOR ? L : L / NCOL; u.pn = TILEMAJOR ? i % NCOL : L % NCOL;
        int lo = ehint;
        if (i == 0) { lo = 0; int hi = NE - 1; while (lo < hi) { const int mid = (lo + hi + 1) >> 1; if ((int)tab[T_TILE + mid] <= tile) lo = mid; else hi = mid - 1; } }
        else { while (lo < NE - 1 && (int)tab[T_TILE + lo + 1] <= tile) ++lo; }
        ehint = lo;
        u.e = lo; u.pm = tile - (int)tab[T_TILE + lo]; u.cnt = (int)tab[T_CNT + lo]; u.off = (int)tab[T_OFF + lo];
        u.B = W + (size_t)lo * wstride + (size_t)u.pn * BM * K; return true;
    }
    __device__ __forceinline__ void rowtab(const Unit& u, LAS unsigned* t, int tid) const {
        if (tid < BM) { int r = u.pm * BM + tid; if (r >= u.cnt) r = u.cnt - 1; t[tid] = (unsigned)slot_ent[u.off + r]; t[BM + tid] = __float_as_uint(slot_w[u.off + r]); }
    }
    __device__ __forceinline__ void avoff(const Unit& u, const int (&)[2], const int (&)[2], unsigned (&v)[2][2], int tidq) const {
        int R[2], C[2]; asm volatile("" : "+v"(tidq));
#pragma unroll
        for (int i = 0; i < 2; ++i) stage_rc(tidq * 16 + i * 8192, R[i], C[i]);
#pragma unroll
        for (int h = 0; h < 2; ++h)
#pragma unroll
            for (int i = 0; i < 2; ++i) {
                int r = u.pm * BM + h * HALF + R[i]; if (r >= u.cnt) r = u.cnt - 1;
                const int slot = u.off + r;
                const int row = TOKROWS ? (slot_ent[slot] >> 3) : slot;
                v[h][i] = (unsigned)(row * K + C[i] * 2);
            }
    }
};

struct EpiInProj {
    static constexpr bool PERM = true; bf16_t* O;
    __device__ __forceinline__ void operator()(const f32x4 (&acc)[2][2][4][2], const Unit& u, int wr, int wc, int fr, int fq, const LAS unsigned* rt) const {
        const float sc = (u.pn < 2) ? 0.125f : ((u.pn == 8 || u.pn == 9) ? 0.08838834764831845f : 1.f);
        const int row0 = u.pm * BM + wr * 64 + fr, col0 = u.pn * BM + wc * 64 + 16 * fq;
#pragma unroll
        for (int ai = 0; ai < 2; ++ai)
#pragma unroll
            for (int m = 0; m < 4; ++m) { bf16_t* rowp = O + (size_t)(row0 + ai * HALF + m * 16) * DIN + col0;
#pragma unroll
                for (int bj = 0; bj < 2; ++bj) { const f32x4 v0 = acc[ai][bj][m][0] * sc, v1 = acc[ai][bj][m][1] * sc;
                    u32x4 w; w.x = cvt_pk_bf16(v0[0], v0[1]); w.y = cvt_pk_bf16(v0[2], v0[3]); w.z = cvt_pk_bf16(v1[0], v1[1]); w.w = cvt_pk_bf16(v1[2], v1[3]);
                    *(u32x4*)(rowp + 8 * bj) = w; } }
    }
};
struct EpiOutProj {
    static constexpr bool PERM = true; const float* x; const float* mod; bf16_t* tb;
    __device__ __forceinline__ void operator()(const f32x4 (&acc)[2][2][4][2], const Unit& u, int wr, int wc, int fr, int fq, const LAS unsigned* rt) const {
        const int b = (u.pm * BM) >> 11; const int col0 = u.pn * BM + wc * 64 + 16 * fq;
        f32x4 g[2][2];
#pragma unroll
        for (int bj = 0; bj < 2; ++bj)
#pragma unroll
            for (int n = 0; n < 2; ++n) g[bj][n] = *(const f32x4*)(mod + b * 6144 + MOD_GATE_A + col0 + 8 * bj + 4 * n);
#pragma unroll
        for (int ai = 0; ai < 2; ++ai)
#pragma unroll
            for (int m = 0; m < 4; ++m) { const size_t o = (size_t)(u.pm * BM + ai * HALF + wr * 64 + m * 16 + fr) * D + col0;
#pragma unroll
                for (int bj = 0; bj < 2; ++bj) {
                    const f32x4 t0 = *(const f32x4*)(x + o + 8 * bj) * ALPHA + g[bj][0] * acc[ai][bj][m][0], t1 = *(const f32x4*)(x + o + 8 * bj + 4) * ALPHA + g[bj][1] * acc[ai][bj][m][1];
                    u32x4 w; w.x = cvt_pk_bf16(t0[0], t0[1]); w.y = cvt_pk_bf16(t0[2], t0[3]); w.z = cvt_pk_bf16(t1[0], t1[1]); w.w = cvt_pk_bf16(t1[2], t1[3]);
                    *(u32x4*)(tb + o + 8 * bj) = w; } }
    }
};
struct EpiRouter {
    static constexpr bool PERM = false; float* out;
    __device__ __forceinline__ void operator()(const f32x4 (&acc)[2][2][4][2], const Unit& u, int wr, int wc, int fr, int fq, const LAS unsigned* rt) const {
        const int col0 = wc * 32 + 4 * fq;
#pragma unroll
        for (int ai = 0; ai < 2; ++ai)
#pragma unroll
            for (int m = 0; m < 4; ++m) { float* rowp = out + (size_t)(u.pm * BM + ai * HALF + wr * 64 + m * 16 + fr) * NE + col0;
#pragma unroll
                for (int bj = 0; bj < 2; ++bj)
#pragma unroll
                    for (int n = 0; n < 2; ++n) *(f32x4*)(rowp + bj * HALF + n * 16) = acc[ai][bj][m][n]; }
    }
};
template <bool EXPERT> struct EpiGU {
    static constexpr bool PERM = true; void* Ov;
    __device__ __forceinline__ void operator()(const f32x4 (&acc)[2][2][4][2], const Unit& u, int wr, int wc, int fr, int fq, const LAS unsigned* rt) const {
        const int h0 = u.pn * HALF + wc * 32 + 8 * fq;
#pragma unroll
        for (int ai = 0; ai < 2; ++ai)
#pragma unroll
            for (int m = 0; m < 4; ++m) {
                const int rtw = u.pm * BM + ai * HALF + wr * 64 + m * 16 + fr;
                if (EXPERT) { if (rtw >= u.cnt) continue; }
                const float w = EXPERT ? __uint_as_float(rt[BM + ai * HALF + wr * 64 + m * 16 + fr]) * (S_ACT8 * INV_GU8) : 1.f;
                const float gs = EXPERT ? INV_GU8 : 1.f;
                const f32x4 g0 = acc[ai][0][m][0] * gs, g1 = acc[ai][0][m][1] * gs, u0 = acc[ai][1][m][0], u1 = acc[ai][1][m][1];
                const float h[8] = {w * silu_f(g0[0]) * u0[0], w * silu_f(g0[1]) * u0[1], w * silu_f(g0[2]) * u0[2], w * silu_f(g0[3]) * u0[3],
                                    w * silu_f(g1[0]) * u1[0], w * silu_f(g1[1]) * u1[1], w * silu_f(g1[2]) * u1[2], w * silu_f(g1[3]) * u1[3]};
                if (EXPERT) {
                    int w0 = __builtin_amdgcn_cvt_pk_fp8_f32(clamp8(h[0]), clamp8(h[1]), 0, false); w0 = __builtin_amdgcn_cvt_pk_fp8_f32(clamp8(h[2]), clamp8(h[3]), w0, true);
                    int w1 = __builtin_amdgcn_cvt_pk_fp8_f32(clamp8(h[4]), clamp8(h[5]), 0, false); w1 = __builtin_amdgcn_cvt_pk_fp8_f32(clamp8(h[6]), clamp8(h[7]), w1, true);
                    u32x2 o; o.x = (unsigned)w0; o.y = (unsigned)w1; *(u32x2*)((unsigned char*)Ov + (size_t)(u.off + rtw) * DE + h0) = o;
                    asm volatile("" ::: "memory");
                } else {
                    u32x4 o; o.x = cvt_pk_bf16(h[0], h[1]); o.y = cvt_pk_bf16(h[2], h[3]); o.z = cvt_pk_bf16(h[4], h[5]); o.w = cvt_pk_bf16(h[6], h[7]);
                    *(u32x4*)((bf16_t*)Ov + (size_t)rtw * DE + h0) = o;
                }
            }
    }
};
struct EpiSharedDown {
    static constexpr bool PERM = true; unsigned char* ysh;
    __device__ __forceinline__ void operator()(const f32x4 (&acc)[2][2][4][2], const Unit& u, int wr, int wc, int fr, int fq, const LAS unsigned* rt) const {
        const int col0 = u.pn * BM + wc * 64 + 16 * fq;
#pragma unroll
        for (int ai = 0; ai < 2; ++ai)
#pragma unroll
            for (int m = 0; m < 4; ++m) {
                u32x4 o;
#pragma unroll
                for (int bj = 0; bj < 2; ++bj) { const f32x4 v0 = acc[ai][bj][m][0] * YSCALE, v1 = acc[ai][bj][m][1] * YSCALE;
                    int w0 = __builtin_amdgcn_cvt_pk_fp8_f32(clamp8(v0[0]), clamp8(v0[1]), 0, false); w0 = __builtin_amdgcn_cvt_pk_fp8_f32(clamp8(v0[2]), clamp8(v0[3]), w0, true);
                    int w1 = __builtin_amdgcn_cvt_pk_fp8_f32(clamp8(v1[0]), clamp8(v1[1]), 0, false); w1 = __builtin_amdgcn_cvt_pk_fp8_f32(clamp8(v1[2]), clamp8(v1[3]), w1, true);
                    if (bj == 0) { o.x = (unsigned)w0; o.y = (unsigned)w1; } else { o.z = (unsigned)w0; o.w = (unsigned)w1; } }
                *(u32x4*)(ysh + (size_t)(u.pm * BM + ai * HALF + wr * 64 + m * 16 + fr) * D + col0) = o;
            }
    }
};
struct EpiExpDown {
    static constexpr bool PERM = true; unsigned char* ybuf; const int* slot_ent;
    __device__ __forceinline__ void operator()(const f32x4 (&acc)[2][2][4][2], const Unit& u, int wr, int wc, int fr, int fq, const LAS unsigned* rt) const {
        const int col0 = u.pn * BM + wc * 64 + 16 * fq;
#pragma unroll
        for (int ai = 0; ai < 2; ++ai)
#pragma unroll
            for (int m = 0; m < 4; ++m) {
                const int rtw = u.pm * BM + ai * HALF + wr * 64 + m * 16 + fr; if (rtw >= u.cnt) continue;
                u32x4 o;
#pragma unroll
                for (int bj = 0; bj < 2; ++bj) { const f32x4 v0 = acc[ai][bj][m][0] * (YSCALE * INV_DN8), v1 = acc[ai][bj][m][1] * (YSCALE * INV_DN8);
                    int w0 = __builtin_amdgcn_cvt_pk_fp8_f32(clamp8(v0[0]), clamp8(v0[1]), 0, false); w0 = __builtin_amdgcn_cvt_pk_fp8_f32(clamp8(v0[2]), clamp8(v0[3]), w0, true);
                    int w1 = __builtin_amdgcn_cvt_pk_fp8_f32(clamp8(v1[0]), clamp8(v1[1]), 0, false); w1 = __builtin_amdgcn_cvt_pk_fp8_f32(clamp8(v1[2]), clamp8(v1[3]), w1, true);
                    if (bj == 0) { o.x = (unsigned)w0; o.y = (unsigned)w1; } else { o.z = (unsigned)w0; o.w = (unsigned)w1; } }
                *(u32x4*)(ybuf + (size_t)rt[ai * HALF + wr * 64 + m * 16 + fr] * D + col0) = o;
                asm volatile("" ::: "memory");
            }
    }
};

template <int PMODE = 0, class Sched> __device__ __forceinline__ void down_phase(LAS unsigned char* lds, const char* act8, const Sched& S, unsigned char* ybuf, const int tid_in) {
    int tid_ = tid_in; asm volatile("" : "+v"(tid_));
    const int tid = tid_, wid = __builtin_amdgcn_readfirstlane(tid >> 6), lane = tid & 63, wr = wid >> 2, wc = wid & 3, fr = lane & 15, fq = lane >> 4;
    constexpr int RB = DE;
    int Rr[2]; unsigned voffB[2], cc2[2];
#pragma unroll
    for (int i = 0; i < 2; ++i) { int R, C; stage_rc(tid * 16 + i * 8192, R, C); Rr[i] = R; cc2[i] = (unsigned)(C * 2); const int Rb = (R & ~31) + perm32(R & 31); voffB[i] = (unsigned)(Rb * RB + C * 2); }
    const unsigned ldsw = (unsigned)wid * 1024u;
    const int aoff = lds_byte(wr * 64 + fr, fq * 8), boff = lds_byte(wc * 32 + fr, fq * 8);
#define DN_SA(k, h) (((k) * 2 + (h)) * HTB)
#define DN_SB(z, k) (65536 + ((z) * 2 + (k)) * HTB)
#define DN_STAGE(bufoff, gbase, voff) do { _Pragma("unroll") for (int _i = 0; _i < 2; ++_i) \
        __builtin_amdgcn_global_load_lds((const unsigned*)((const char*)(gbase) + (voff)[_i]), (LAS unsigned*)(lds + (bufoff) + ldsw + _i * 8192), 16, 0, 0); } while (0)
    LAS unsigned* rowtab = (LAS unsigned*)(lds + ROWTAB_OFF);
    Unit cur, nxt; int ti = 0;
    if (!S.next(0, cur)) return;
#define DN_STAGE_A(u) do { unsigned _va[2][2]; _Pragma("unroll") for (int _h = 0; _h < 2; ++_h) _Pragma("unroll") for (int _i = 0; _i < 2; ++_i) { int _r = (u).pm * BM + _h * HALF + Rr[_i]; if (_r >= (u).cnt) _r = (u).cnt - 1; _va[_h][_i] = (unsigned)(((u).off + _r) * RB) + cc2[_i]; } \
        _Pragma("unroll") for (int _k = 0; _k < 2; ++_k) _Pragma("unroll") for (int _h = 0; _h < 2; ++_h) DN_STAGE(DN_SA(_k, _h), act8 + _k * 128, _va[_h]); } while (0)
#define DN_STAGE_B(u, s_, z_) do { const char* _b = (u).B + (size_t)(s_) * (HALF * RB); _Pragma("unroll") for (int _k = 0; _k < 2; ++_k) DN_STAGE(DN_SB(z_, _k), _b + _k * 128, voffB); } while (0)
#define DN_ROWTAB(u, par) do { if (tid < BM) { int _r = (u).pm * BM + tid; if (_r >= (u).cnt) _r = (u).cnt - 1; rowtab[(par) * BM + tid] = (PMODE == 1) ? (unsigned)((u).off + _r) : (unsigned)S.slot_ent[(u).off + _r]; } } while (0)
    DN_STAGE_A(cur); DN_ROWTAB(cur, 0); DN_STAGE_B(cur, 0, 0);
    f32x4 acc[2][2][4][2];
    union Frag { bf16x8 q[2]; i32x8 w; };
    int gs = 0;
    Unit prev = cur; int prev_s = -1, prev_par = 0;
#define DN_EPILOGUE(set, u, s_, par) do { const int _col0 = (s_) * HALF + wc * 32 + 8 * fq; \
        _Pragma("unroll") for (int _ai = 0; _ai < 2; ++_ai) _Pragma("unroll") for (int _m = 0; _m < 4; ++_m) { const int _rt = _ai * HALF + wr * 64 + _m * 16 + fr; \
            { const f32x4 _v0 = acc[set][_ai][_m][0] * (YSCALE * INV_DN8), _v1 = acc[set][_ai][_m][1] * (YSCALE * INV_DN8);   \
                int _w0 = __builtin_amdgcn_cvt_pk_fp8_f32(clamp8(_v0[0]), clamp8(_v0[1]), 0, false); _w0 = __builtin_amdgcn_cvt_pk_fp8_f32(clamp8(_v0[2]), clamp8(_v0[3]), _w0, true); \
                int _w1 = __builtin_amdgcn_cvt_pk_fp8_f32(clamp8(_v1[0]), clamp8(_v1[1]), 0, false); _w1 = __builtin_amdgcn_cvt_pk_fp8_f32(clamp8(_v1[2]), clamp8(_v1[3]), _w1, true); \
                u32x2 _o; _o.x = (unsigned)_w0; _o.y = (unsigned)_w1; if (PMODE != 2 || (_w0 == 0x12345678 && _w1 == 0x31415926)) *(u32x2*)(ybuf + (size_t)rowtab[(par) * BM + _rt] * D + _col0) = _o; } } } while (0)
    for (;;) {
        const bool has_next = S.next(ti + 1, nxt);
        const int par = ti & 1;
#pragma unroll 1
        for (int s2 = 0; s2 < 8; s2 += 2) {
#pragma unroll
            for (int sb = 0; sb < 2; ++sb) {
                const int s = s2 + sb; const int z = sb;
                if (s == 0) asm volatile("s_waitcnt vmcnt(0)" ::: "memory");
                else if (PMODE == 2) asm volatile("s_waitcnt vmcnt(0)" ::: "memory");
                else asm volatile("s_waitcnt vmcnt(8)" ::: "memory");
                __builtin_amdgcn_s_barrier();
                asm volatile("" ::: "memory");
                if (s < 7) DN_STAGE_B(cur, s + 1, z ^ 1); else if (has_next) DN_STAGE_B(nxt, 0, z ^ 1);
                if (wr == 1 && prev_s >= 0) { asm volatile("s_nop 15" ::: "memory"); DN_EPILOGUE(sb ^ 1, prev, prev_s, prev_par); }
#pragma unroll
                for (int ai = 0; ai < 2; ++ai)
#pragma unroll
                    for (int m = 0; m < 4; ++m)
#pragma unroll
                        for (int n = 0; n < 2; ++n) acc[sb][ai][m][n] = (f32x4){0.f, 0.f, 0.f, 0.f};
                asm volatile("s_nop 4" ::: "memory");
#pragma unroll
                for (int k = 0; k < 2; ++k) {
                    Frag Bf[2];
#pragma unroll
                    for (int n = 0; n < 2; ++n) Bf[n].w = cat8(*(const LAS bf16x8*)(lds + DN_SB(z, k) + boff + n * 2048), *(const LAS bf16x8*)(lds + DN_SB(z, k) + boff + n * 2048 + 1024));
#pragma unroll
                    for (int ai = 0; ai < 2; ++ai) {
                        Frag Af[4];
#pragma unroll
                        for (int m = 0; m < 4; ++m) Af[m].w = cat8(*(const LAS bf16x8*)(lds + DN_SA(k, ai) + aoff + m * 2048), *(const LAS bf16x8*)(lds + DN_SA(k, ai) + aoff + m * 2048 + 1024));
#pragma unroll
                        for (int m = 0; m < 4; ++m)
#pragma unroll
                            for (int n = 0; n < 2; ++n) asm volatile("v_mfma_f32_16x16x128_f8f6f4 %0, %1, %2, %0" : "+v"(acc[sb][ai][m][n]) : "v"(Bf[n].w), "v"(Af[m].w));
                    }
                }
                if (wr == 0 && prev_s >= 0) DN_EPILOGUE(sb ^ 1, prev, prev_s, prev_par);
                prev = cur; prev_s = s; prev_par = par;
            }
        }
        if (!has_next) break;
        asm volatile("s_waitcnt lgkmcnt(0)" ::: "memory");
        __builtin_amdgcn_s_barrier();
        DN_STAGE_A(nxt); DN_ROWTAB(nxt, par ^ 1);
        cur = nxt; ++ti;
    }
    asm volatile("s_nop 15\n\ts_nop 15" ::: "memory");
    DN_EPILOGUE(1, prev, prev_s, prev_par);
    asm volatile("s_waitcnt vmcnt(0) lgkmcnt(0)" ::: "memory");
    __builtin_amdgcn_s_barrier();
#undef DN_SA
#undef DN_SB
#undef DN_STAGE
#undef DN_STAGE_A
#undef DN_STAGE_B
#undef DN_ROWTAB
#undef DN_EPILOGUE
}
constexpr int T_P64 = T_HIST;
template <int PMODE = 0> __device__ __forceinline__ void down2_phase(LAS unsigned char* lds, LAS unsigned* tab, const char* act8, const char* wd, const int* slot_ent, unsigned char* ybuf, const int G, const int bx, const int tid_in) {
    int tid_ = tid_in; asm volatile("" : "+v"(tid_));
    const int tid = tid_, wid = __builtin_amdgcn_readfirstlane(tid >> 6), lane = tid & 63, wr = wid >> 2, wc = wid & 3, fr = lane & 15, fq = lane >> 4;
    constexpr int NS = 8, PD = 7, PB = 16384;
    if (tid < 64) {
        unsigned c[4], sp = 0;
#pragma unroll
        for (int j = 0; j < 4; ++j) { c[j] = (tab[T_CNT + lane * 4 + j] + 63u) >> 6; sp += c[j]; }
        unsigned ip = sp;
#pragma unroll
        for (int o = 1; o < 64; o <<= 1) { const unsigned a = __shfl_up(ip, o); if (lane >= o) ip += a; }
        unsigned ep = ip - sp;
#pragma unroll
        for (int j = 0; j < 4; ++j) { tab[T_P64 + lane * 4 + j] = ep; ep += c[j]; }
        if (lane == 63) tab[T_P64 + NE] = ep;
    }
    __syncthreads();
    int g, q; const int NG = G >> 2;
    if (G % 32 == 0) { const int x = bx % 8, i = bx / 8; g = x * (G / 32) + (i >> 2); q = i & 3; } else { g = bx >> 2; q = bx & 3; }
    const int NP = (int)tab[T_P64 + NE];
    const int p_lo = g < NG ? (int)((long long)g * NP / NG) : 0, p_hi = g < NG ? (int)((long long)(g + 1) * NP / NG) : 0;
    if (p_lo < p_hi) {
    int R0, C0; stage_rc(tid * 16, R0, C0);
    const unsigned ldsw = (unsigned)wid * 1024u;
    const int aoff = lds_byte(wr * 32 + fr, fq * 8);
    LAS unsigned* rowtab = (LAS unsigned*)(lds + VN_OFF);
    int e0 = 0; { int hi = NE - 1; while (e0 < hi) { const int mid = (e0 + hi + 1) >> 1; if ((int)tab[T_P64 + mid] <= p_lo) e0 = mid; else hi = mid - 1; } }
    int e2 = e0, nb2 = (int)tab[T_P64 + e0 + 1];
    int e = -1, nb = p_lo;
#define D2_STAGE(pp_, it_) do { const int _pp = (pp_) < p_hi ? (pp_) : p_hi - 1; \
        while (_pp >= nb2) { ++e2; nb2 = (int)tab[T_P64 + e2 + 1]; } \
        const int _off = (int)tab[T_OFF + e2], _cnt = (int)tab[T_CNT + e2], _r0 = (_pp - (int)tab[T_P64 + e2]) * 64; \
        int _r = _r0 + R0; if (_r >= _cnt) _r = _cnt - 1; int _rr = _r0 + lane; if (_rr >= _cnt) _rr = _cnt - 1; \
        const char* _a = act8 + (size_t)(unsigned)((_off + _r) * DE + C0 * 2); const unsigned _zb = (unsigned)((it_) & (NS - 1)) * PB; \
        __builtin_amdgcn_global_load_lds((const unsigned*)_a, (LAS unsigned*)(lds + _zb + ldsw), 16, 0, 0); \
        __builtin_amdgcn_global_load_lds((const unsigned*)(_a + 128), (LAS unsigned*)(lds + _zb + 8192 + ldsw), 16, 0, 0); \
        __builtin_amdgcn_global_load_lds((const unsigned*)(slot_ent + _off + _rr), rowtab + ((it_) & 15) * 64, 4, 0, 0); } while (0)
    union Frag { bf16x8 q2[2]; i32x8 w; };
    Frag Bf[2][4], Af[2][2][2];
    f32x4 acc[2][2][4];
#define D2_CVT(v_) ({ const f32x4 _v = (v_) * (YSCALE * INV_DN8); int _w = __builtin_amdgcn_cvt_pk_fp8_f32(clamp8(_v[0]), clamp8(_v[1]), 0, false); (unsigned)__builtin_amdgcn_cvt_pk_fp8_f32(clamp8(_v[2]), clamp8(_v[3]), _w, true); })
#define D2_OUT(dst_, o_) do { if (PMODE == 0 || ((o_).x == 0x12345678u && (o_).y == 0x31415926u && (dst_) < (unsigned)NSLOT)) *(u32x4*)(ybuf + (size_t)(dst_) * D + (q * 256 + wc * 64 + 16 * fq)) = (o_); } while (0)
#define D2_EPILOGUE(set, ip_) do { _Pragma("unroll") for (int _m = 0; _m < 2; ++_m) { \
            const unsigned _dst = rowtab[((ip_) & 15) * 64 + wr * 32 + _m * 16 + fr]; u32x4 _o; \
            _Pragma("unroll") for (int _n = 0; _n < 4; ++_n) _o[_n] = D2_CVT(acc[set][_m][_n]); \
            D2_OUT(_dst, _o); } } while (0)
#define D2_READA(par, it_) do { const unsigned _zb = (unsigned)((it_) & (NS - 1)) * PB; _Pragma("unroll") for (int _k = 0; _k < 2; ++_k) _Pragma("unroll") for (int _m = 0; _m < 2; ++_m) \
        Af[par][_k][_m].w = cat8(*(const LAS bf16x8*)(lds + _zb + _k * 8192 + aoff + _m * 2048), *(const LAS bf16x8*)(lds + _zb + _k * 8192 + aoff + _m * 2048 + 1024)); } while (0)
#define D2_MFMA0(sb, m, n) asm volatile("v_mfma_f32_16x16x128_f8f6f4 %0, %1, %2, 0" : "=&v"(acc[sb][m][n]) : "v"(Bf[0][n].w), "v"(Af[sb][0][m].w))
#define D2_MFMA1(sb, m, n) asm volatile("v_mfma_f32_16x16x128_f8f6f4 %0, %1, %2, %0" : "+v"(acc[sb][m][n]) : "v"(Bf[1][n].w), "v"(Af[sb][1][m].w))
#define D2_PAIR(MF, sb, m, n0, EPI, om, on, ov) do { MF(sb, m, n0); MF(sb, m, n0 + 1); if (EPI) (ov)[on] = D2_CVT(acc[(sb) ^ 1][om][on]); __builtin_amdgcn_sched_barrier(0); } while (0)
#define D2_PIECE(sb, i_, EPI) do { const int _i = (i_); \
        if (_i < PD - 1 || PMODE != 0) asm volatile("s_waitcnt vmcnt(15)" ::: "memory");        \
        else asm volatile("s_waitcnt vmcnt(25)" ::: "memory");                                    \
        __builtin_amdgcn_s_barrier();                                      \
        asm volatile("" ::: "memory"); \
        if (PMODE != 3) D2_STAGE(p_lo + _i + PD, _i + PD);                 \
        if (p_lo + _i >= nb) {                                             \
            do { ++e; nb = (int)tab[T_P64 + e + 1]; } while (p_lo + _i >= nb); \
            const __attribute__((address_space(1))) char* wb = (const __attribute__((address_space(1))) char*)(wd + ((size_t)e * D + q * 256 + wc * 64 + 16 * (fr >> 2) + (fr & 3)) * DE + 16 * fq); \
            _Pragma("unroll") for (int _k = 0; _k < 2; ++_k) _Pragma("unroll") for (int _n = 0; _n < 4; ++_n) \
                Bf[_k][_n].w = cat8(*(const __attribute__((address_space(1))) bf16x8*)(wb + _n * 4 * DE + _k * 128), *(const __attribute__((address_space(1))) bf16x8*)(wb + _n * 4 * DE + _k * 128 + 64)); \
            _Pragma("unroll") for (int _k = 0; _k < 2; ++_k) _Pragma("unroll") for (int _n = 0; _n < 4; ++_n) asm volatile("" : "+v"(Bf[_k][_n].w));     \
        } \
        D2_READA((sb) ^ 1, _i + 1); \
        unsigned _d0 = 0, _d1 = 0; u32x4 _o0, _o1; \
        __builtin_amdgcn_sched_barrier(0); \
        D2_PAIR(D2_MFMA0, sb, 0, 0, EPI, 0, 0, _o0); D2_PAIR(D2_MFMA0, sb, 0, 2, EPI, 0, 1, _o0); \
        if (EPI) { _d0 = rowtab[((_i - 1) & 15) * 64 + wr * 32 + fr]; _d1 = rowtab[((_i - 1) & 15) * 64 + wr * 32 + 16 + fr]; }     \
        __builtin_amdgcn_sched_barrier(0); \
        D2_PAIR(D2_MFMA0, sb, 1, 0, EPI, 0, 2, _o0); D2_PAIR(D2_MFMA0, sb, 1, 2, EPI, 0, 3, _o0); \
        if (EPI) D2_OUT(_d0, _o0); \
        D2_PAIR(D2_MFMA1, sb, 0, 0, EPI, 1, 0, _o1); D2_PAIR(D2_MFMA1, sb, 0, 2, EPI, 1, 1, _o1); D2_PAIR(D2_MFMA1, sb, 1, 0, EPI, 1, 2, _o1); D2_PAIR(D2_MFMA1, sb, 1, 2, EPI, 1, 3, _o1); \
        if (EPI) D2_OUT(_d1, _o1); \
    } while (0)
#pragma unroll 1
    for (int j = 0; j < PD; ++j) D2_STAGE(p_lo + j, j);
    const int n_it = p_hi - p_lo;
    asm volatile("s_waitcnt vmcnt(18)" ::: "memory");
    __builtin_amdgcn_s_barrier();
    asm volatile("" ::: "memory");
    D2_READA(0, 0);
    D2_PIECE(0, 0, false);
#pragma unroll 1
    for (int i2 = 1; i2 < n_it; i2 += 2) {
        D2_PIECE(1, i2, true);
        if (i2 + 1 < n_it) D2_PIECE(0, i2 + 1, true);
    }
    asm volatile("s_nop 15\n\ts_nop 15" ::: "memory");
    if (n_it & 1) D2_EPILOGUE(0, n_it - 1); else D2_EPILOGUE(1, n_it - 1);
#undef D2_CVT
#undef D2_OUT
#undef D2_READA
#undef D2_MFMA0
#undef D2_MFMA1
#undef D2_PAIR
#undef D2_PIECE
#undef D2_STAGE
#undef D2_EPILOGUE
    }
    asm volatile("s_waitcnt vmcnt(0) lgkmcnt(0)" ::: "memory");
    __builtin_amdgcn_s_barrier();
}
struct EpiProbeSum {
    static constexpr bool PERM = true; float* o;
    __device__ __forceinline__ void operator()(const f32x4 (&acc)[2][2][4][2], const Unit& u, int wr, int wc, int fr, int fq, const LAS unsigned* rt) const {
        f32x4 s = (f32x4){0.f, 0.f, 0.f, 0.f};
#pragma unroll
        for (int a = 0; a < 2; ++a)
#pragma unroll
            for (int b = 0; b < 2; ++b)
#pragma unroll
                for (int m = 0; m < 4; ++m) s += acc[a][b][m][0] + acc[a][b][m][1];
        if (s.x == 123.456f) *(f32x4*)(o + (size_t)(blockIdx.x * 512 + wr * 256 + wc * 64 + fq * 16 + fr) * 4) = s;
    }
};
}

struct Ctx {
    const float *x, *c, *w_ada, *b_ada, *w_in, *w_out, *na_rpb, *ret_ld, *ret_gn, *ln1_g, *ln1_b, *ln2_g, *ln2_b, *w_router, *rbias, *w_gate, *w_up, *w_down, *ws_gate, *ws_up, *ws_down;
    float* out; unsigned char* ws;
};
constexpr int NW = 8;

__device__ __forceinline__ void transpose_item(const float* W, int K, int N, bf16_t* WT, int G, int which, LAS float* scr, int item, int lane) {
    const int nblk = N / 32, kb = item / nblk, nb = item % nblk, k0 = 64 * kb, n0 = 32 * nb;
    float v[32];
#pragma unroll
    for (int i = 0; i < 32; ++i) { const int kk = 2 * i + (lane >> 5); v[i] = __builtin_nontemporal_load(W + (size_t)(k0 + kk) * N + n0 + (lane & 31)); }
#pragma unroll
    for (int i = 0; i < 32; ++i) { const int kk = 2 * i + (lane >> 5); scr[kk * 33 + (lane & 31)] = v[i]; }
    LDS_WAIT(); asm volatile("" ::: "memory");
    const int c = lane & 7;
#pragma unroll
    for (int j = 0; j < 4; ++j) { const int n = (lane >> 3) + 8 * j; const LAS float* s = scr + (8 * c) * 33 + n;
        u32x4 o; o.x = pk2(s[0 * 33], s[1 * 33]); o.y = pk2(s[2 * 33], s[3 * 33]); o.z = pk2(s[4 * 33], s[5 * 33]); o.w = pk2(s[6 * 33], s[7 * 33]);
        const int ng = n0 + n; const int drow = (G == 0) ? ng : ((ng / G) * 2 * G + which * G + (ng % G));
        *(u32x4*)(WT + (size_t)drow * K + k0 + 8 * c) = o; }
    LDS_WAIT(); asm volatile("" ::: "memory");
}
__device__ __forceinline__ void transpose_item_fp8(const float* W, int K, int N, unsigned char* WT, int G, int which, float scale, LAS float* scr, int item, int lane) {
    const int nblk = N / 32, kb = item / nblk, nb = item % nblk, k0 = 64 * kb, n0 = 32 * nb;
    float v[32];
#pragma unroll
    for (int i = 0; i < 32; ++i) { const int kk = 2 * i + (lane >> 5); v[i] = __builtin_nontemporal_load(W + (size_t)(k0 + kk) * N + n0 + (lane & 31)); }
#pragma unroll
    for (int i = 0; i < 32; ++i) { const int kk = 2 * i + (lane >> 5); scr[kk * 33 + (lane & 31)] = v[i] * scale; }
    LDS_WAIT(); asm volatile("" ::: "memory");
    const int c = lane & 7;
#pragma unroll
    for (int j = 0; j < 4; ++j) { const int n = (lane >> 3) + 8 * j; const LAS float* sp = scr + (8 * c) * 33 + n;
        int w0 = __builtin_amdgcn_cvt_pk_fp8_f32(clamp8(sp[0 * 33]), clamp8(sp[1 * 33]), 0, false); w0 = __builtin_amdgcn_cvt_pk_fp8_f32(clamp8(sp[2 * 33]), clamp8(sp[3 * 33]), w0, true);
        int w1 = __builtin_amdgcn_cvt_pk_fp8_f32(clamp8(sp[4 * 33]), clamp8(sp[5 * 33]), 0, false); w1 = __builtin_amdgcn_cvt_pk_fp8_f32(clamp8(sp[6 * 33]), clamp8(sp[7 * 33]), w1, true);
        const int ng = n0 + n; const int drow = (G == 0) ? ng : ((ng / G) * 2 * G + which * G + (ng % G));
        u32x2 o; o.x = (unsigned)w0; o.y = (unsigned)w1; *(u32x2*)(WT + (size_t)drow * K + k0 + 8 * c) = o; }
    LDS_WAIT(); asm volatile("" ::: "memory");
}
__device__ __forceinline__ void rope_entry(float* tab, int idx) {
    const int t = idx >> 6, i = idx & 63;
    const float inv_freq = powf(10000.f, -(float)(2 * i) / 128.f);
    const float ang = (float)t * inv_freq;
    const double a = (double)ang; const double two_pi = 6.283185307179586476925286766559;
    const double kf = rint(a / two_pi); double r = a - kf * two_pi;
    double sgn = 1.0; if (r > 1.5707963267948966) { r = 3.141592653589793 - r; sgn = -1.0; } else if (r < -1.5707963267948966) { r = -3.141592653589793 - r; sgn = -1.0; }
    const double r2 = r * r;
    const double s = r * (1.0 + r2 * (-1.0 / 6 + r2 * (1.0 / 120 + r2 * (-1.0 / 5040 + r2 * (1.0 / 362880 + r2 * (-1.0 / 39916800 + r2 * (1.0 / 6227020800.0 + r2 * (-1.0 / 1307674368000.0))))))));
    const double c = 1.0 + r2 * (-0.5 + r2 * (1.0 / 24 + r2 * (-1.0 / 720 + r2 * (1.0 / 40320 + r2 * (-1.0 / 3628800 + r2 * (1.0 / 479001600.0 + r2 * (-1.0 / 87178291200.0 + r2 * (1.0 / 20922789888000.0))))))));
    tab[idx] = (float)(sgn * c); tab[SEQ * 64 + idx] = (float)s;
}
__device__ __forceinline__ void mod_task(const float* __restrict__ cin, const float* __restrict__ w_ada, float* __restrict__ modp, int task, int lane) {
    const int cbk = task % 96, kc = task / 96, j = cbk * 64 + lane, k0 = kc * 64;
    float acc[32], cv[32];
#pragma unroll
    for (int b = 0; b < 32; ++b) { acc[b] = 0.f; cv[b] = silu_f(cin[b * D + k0 + lane]); }
#pragma unroll
    for (int kb = 0; kb < 4; ++kb) {
        float w[16];
#pragma unroll
        for (int i = 0; i < 16; ++i) w[i] = w_ada[(size_t)(k0 + kb * 16 + i) * 6144 + j];
#pragma unroll
        for (int i = 0; i < 16; ++i)
#pragma unroll
            for (int b = 0; b < 32; ++b) acc[b] += __builtin_bit_cast(float, __builtin_amdgcn_readlane(__builtin_bit_cast(int, cv[b]), kb * 16 + i)) * w[i];
    }
#pragma unroll
    for (int b = 0; b < 32; ++b) modp[((size_t)kc * 32 + b) * 6144 + j] = acc[b];
}
__device__ __forceinline__ float mod_sum(const float* __restrict__ modp, const float* __restrict__ b_ada, int b, int j) {
    float s = 0.f;
#pragma unroll
    for (int kc = 0; kc < 16; ++kc) s += modp[((size_t)kc * 32 + b) * 6144 + j];
    return s + b_ada[j];
}

#ifndef RET_PROBE
#define RET_PROBE 0
#endif
namespace ret {
typedef short s16x4 __attribute__((ext_vector_type(4)));
typedef __bf16 bfx2 __attribute__((ext_vector_type(2)));
constexpr unsigned RS = 288, TILE = 128 * RS, LK = 0, LV = TILE, LRF = 2 * TILE, LRB = 3 * TILE;
constexpr float LOG2E = 1.4426950408889634f;
__device__ __forceinline__ unsigned offb(unsigned row, unsigned ch) { return RS * row + 16u * ch; }
__device__ __forceinline__ unsigned cvtpk(float lo, float hi) { const f32x2 v = {lo, hi}; return __builtin_bit_cast(unsigned, __builtin_convertvector(v, bfx2)); }
__device__ __forceinline__ bf16x8 pack8(const float (&f)[8]) { u32x4 u; u.x = cvtpk(f[0], f[1]); u.y = cvtpk(f[2], f[3]); u.z = cvtpk(f[4], f[5]); u.w = cvtpk(f[6], f[7]); return __builtin_bit_cast(bf16x8, u); }
__device__ __forceinline__ void unpack8(const bf16x8 v, float (&f)[8]) { const u32x4 u = __builtin_bit_cast(u32x4, v);
    f[0] = __uint_as_float(u.x << 16); f[1] = __uint_as_float(u.x & 0xffff0000u); f[2] = __uint_as_float(u.y << 16); f[3] = __uint_as_float(u.y & 0xffff0000u);
    f[4] = __uint_as_float(u.z << 16); f[5] = __uint_as_float(u.z & 0xffff0000u); f[6] = __uint_as_float(u.w << 16); f[7] = __uint_as_float(u.w & 0xffff0000u); }
__device__ __forceinline__ bf16x8 trfrag(LAS unsigned char* base, unsigned row0, unsigned row1, unsigned cblk, unsigned qp, unsigned p) {
    const unsigned ch = 2u * cblk + (p >> 1), bo = 8u * (p & 1u);
    const s16x4 lo = __builtin_amdgcn_ds_read_tr16_b64_v4i16((LAS s16x4*)(base + offb(row0 + qp, ch) + bo));
    const s16x4 hi = __builtin_amdgcn_ds_read_tr16_b64_v4i16((LAS s16x4*)(base + offb(row1 + qp, ch) + bo));
    return __builtin_shufflevector(lo, hi, 0, 1, 2, 3, 4, 5, 6, 7);
}
struct KVRaw { bf16x8 ka[2], kb[2], v[4]; f32x4 c0[2], c1[2], s0[2], s1[2]; };
__device__ __forceinline__ void kv_load(KVRaw& R, const bf16_t* __restrict__ proj, const float* __restrict__ rope, int b, int h, int n, int tid) {
#pragma unroll
    for (int i = 0; i < 2; ++i) {
        const int q2 = tid + 512 * i, row = q2 >> 3, pc = q2 & 7, t = n * 128 + row;
        const bf16_t* rp = proj + (size_t)(b * SEQ + t) * DIN + OFF_KR + h * 128;
        R.ka[i] = *(const bf16x8*)(rp + pc * 8); R.kb[i] = *(const bf16x8*)(rp + 64 + pc * 8);
        R.c0[i] = *(const f32x4*)(rope + t * 64 + pc * 8); R.c1[i] = *(const f32x4*)(rope + t * 64 + pc * 8 + 4);
        R.s0[i] = *(const f32x4*)(rope + SEQ * 64 + t * 64 + pc * 8); R.s1[i] = *(const f32x4*)(rope + SEQ * 64 + t * 64 + pc * 8 + 4);
    }
#pragma unroll
    for (int i = 0; i < 4; ++i) { const int q4 = tid + 512 * i, row = q4 >> 4, ch = q4 & 15, t = n * 128 + row;
        R.v[i] = *(const bf16x8*)(proj + (size_t)(b * SEQ + t) * DIN + OFF_VR + h * 128 + ch * 8); }
}
__device__ __forceinline__ void kv_store(LAS unsigned char* lds, const KVRaw& R, int tid) {
#pragma unroll
    for (int i = 0; i < 2; ++i) {
        const int q2 = tid + 512 * i, row = q2 >> 3, pc = q2 & 7;
        float fa[8], fb[8], o1[8], o2[8];
        unpack8(R.ka[i], fa); unpack8(R.kb[i], fb);
        const float cs[8] = {R.c0[i].x, R.c0[i].y, R.c0[i].z, R.c0[i].w, R.c1[i].x, R.c1[i].y, R.c1[i].z, R.c1[i].w}, sn[8] = {R.s0[i].x, R.s0[i].y, R.s0[i].z, R.s0[i].w, R.s1[i].x, R.s1[i].y, R.s1[i].z, R.s1[i].w};
#pragma unroll
        for (int e = 0; e < 8; ++e) { o1[e] = fa[e] * cs[e] - fb[e] * sn[e]; o2[e] = fb[e] * cs[e] + fa[e] * sn[e]; }
        *(LAS bf16x8*)(lds + LK + offb(row, pc)) = pack8(o1); *(LAS bf16x8*)(lds + LK + offb(row, pc + 8)) = pack8(o2);
    }
#pragma unroll
    for (int i = 0; i < 4; ++i) { const int q4 = tid + 512 * i, row = q4 >> 4, ch = q4 & 15; *(LAS bf16x8*)(lds + LV + offb(row, ch)) = R.v[i]; }
}
__device__ __forceinline__ void rb_dma(LAS unsigned char* lds, const unsigned char* img, int w, int lane) {
#pragma unroll
    for (int i = 0; i < 5; ++i) { const int o = w + 8 * i; if (o < (int)TILE / 1024)
        __builtin_amdgcn_global_load_lds((const unsigned*)(img + o * 1024 + lane * 16), (LAS unsigned*)(lds + LRB + o * 1024), 16, 0, 0); }
}
template <bool FWD> __device__ __forceinline__ void state_update_1(LAS unsigned char* lds, f32x4 (&racc)[8], float l2, int w, int g, unsigned qp, unsigned p);
template <bool FWD> __device__ __forceinline__ void state_update(LAS unsigned char* lds, f32x4 (&racc)[8], float l2, int w, int g, unsigned qp, unsigned p) {
    if (RET_PROBE == 2) {
        f32x4 r2[8];
#pragma unroll
        for (int i = 0; i < 8; ++i) r2[i] = racc[i];
        unsigned zo = 0; asm volatile("" : "+v"(zo));
        state_update_1<FWD>(lds + zo, r2, l2, w, g, qp, p);
        state_update_1<FWD>(lds, racc, l2, w, g, qp, p);
#pragma unroll
        for (int i = 0; i < 8; ++i) racc[i] = (racc[i] + r2[i]) * 0.5f;
    } else state_update_1<FWD>(lds, racc, l2, w, g, qp, p);
}
template <bool FWD> __device__ __forceinline__ void state_update_1(LAS unsigned char* lds, f32x4 (&racc)[8], float l2, int w, int g, unsigned qp, unsigned p) {
    const float dec = __builtin_amdgcn_exp2f(128.f * l2);
    bf16x8 vs[4];
#pragma unroll
    for (int ks = 0; ks < 4; ++ks) {
        float f[8]; unpack8(trfrag(lds + LV, 32 * ks + 4 * g, 32 * ks + 16 + 4 * g, w, qp, p), f);
#pragma unroll
        for (int e = 0; e < 8; ++e) { const int key = 32 * ks + 16 * (e >> 2) + 4 * g + (e & 3); f[e] *= __builtin_amdgcn_exp2f((FWD ? (float)(127 - key) : (float)key) * l2); }
        vs[ks] = pack8(f);
    }
#pragma unroll
    for (int nb = 0; nb < 8; ++nb) {
        racc[nb] = racc[nb] * dec;
#pragma unroll
        for (int ks = 0; ks < 4; ++ks) racc[nb] = __builtin_amdgcn_mfma_f32_16x16x32_bf16(vs[ks], trfrag(lds + LK, 32 * ks + 4 * g, 32 * ks + 16 + 4 * g, nb, qp, p), racc[nb], 0, 0, 0);
    }
}
__device__ __forceinline__ void unit(const bf16_t* __restrict__ proj, const float* __restrict__ rope, const float* __restrict__ log_decay, const float* __restrict__ gn_g, bf16_t* __restrict__ ymix,
                                     unsigned char* __restrict__ scratch  , LAS unsigned char* lds, int hu, const int tid_in) {
    const int u = hu >> 1, n0 = (hu & 1) * 8, n1 = n0 + 8;
    const int b = u >> 2, h = u & 3;
    int tid_ = tid_in; asm volatile("" : "+v"(tid_));
    const int tid0 = tid_, w = __builtin_amdgcn_readfirstlane(tid0 >> 6);
#define RET_LANE int tid = tid0; asm volatile("" : "+v"(tid)); const int lane = tid & 63, r = lane & 15, g = lane >> 4; const unsigned qp = (unsigned)r >> 2, p = (unsigned)lane & 3u;
    const float lf2_ = log_decay[h] * LOG2E, lb2_ = log_decay[4 + h] * LOG2E;
    f32x4 racc[8];
    KVRaw raw;
    for (int rep7 = 0; rep7 < (RET_PROBE == 7 ? 2 : 1); ++rep7) {
#pragma unroll
    for (int nb = 0; nb < 8; ++nb) racc[nb] = (f32x4){0.f, 0.f, 0.f, 0.f};
    kv_load(raw, proj, rope, b, h, 15, tid0);
    for (int n = 15; n >= n0; --n) {
        RET_LANE
        if (n < n1) {
            unsigned char* img = scratch + (size_t)(n - n0) * TILE;
#pragma unroll
            for (int nb = 0; nb < 8; ++nb) { u32x2 o; o.x = cvtpk(racc[nb][0], racc[nb][1]); o.y = cvtpk(racc[nb][2], racc[nb][3]);
                *(u32x2*)(img + offb(16 * nb + r, 2 * w + (g >> 1)) + 8 * (g & 1)) = o; }
        }
        if (n == n0) break;
        float lb2 = lb2_; asm volatile("" : "+v"(lb2));
        __syncthreads();
        kv_store(lds, raw, tid);
        __syncthreads();
        kv_load(raw, proj, rope, b, h, n - 1 > n0 ? n - 1 : 0, tid);
        state_update<false>(lds, racc, lb2, w, g, qp, p);
    }
    }
    asm volatile("s_waitcnt vmcnt(0)" ::: "memory");
    __syncthreads();
    __builtin_amdgcn_fence(__ATOMIC_ACQUIRE, "agent");
    asm volatile("s_waitcnt vmcnt(0)" ::: "memory");
    for (int rep8 = 0; rep8 < (RET_PROBE == 8 ? 2 : 1); ++rep8) {
    if (RET_PROBE == 8 && rep8 == 1) { __syncthreads(); kv_load(raw, proj, rope, b, h, 0, tid0); }
#pragma unroll
    for (int nb = 0; nb < 8; ++nb) racc[nb] = (f32x4){0.f, 0.f, 0.f, 0.f};
    for (int n = 0; n < n0; ++n) {
        RET_LANE
        float lf2 = lf2_; asm volatile("" : "+v"(lf2));
        __syncthreads();
        kv_store(lds, raw, tid);
        __syncthreads();
        kv_load(raw, proj, rope, b, h, n + 1, tid);
        state_update<true>(lds, racc, lf2, w, g, qp, p);
    }
    rb_dma(lds, scratch, w, tid0 & 63);
    for (int n = n0; n < n1; ++n) {
        RET_LANE
        float lf2 = lf2_, lb2 = lb2_; asm volatile("" : "+v"(lf2), "+v"(lb2));
        const __attribute__((address_space(1))) float* gnp = (const __attribute__((address_space(1))) float*)gn_g; asm volatile("" : "+s"(gnp));
        __syncthreads();
        kv_store(lds, raw, tid);
#pragma unroll
        for (int nb = 0; nb < 8; ++nb) { u32x2 o; o.x = cvtpk(racc[nb][0], racc[nb][1]); o.y = cvtpk(racc[nb][2], racc[nb][3]);
            *(LAS u32x2*)(lds + LRF + offb(16 * nb + r, 2 * w + (g >> 1)) + 8 * (g & 1)) = o; }
        const int cq = 16 * w + r, tq = n * 128 + cq;
        bf16x8 qn[4], qf[4], qb[4];
        { const bf16_t* rp = proj + (size_t)(b * SEQ + tq) * DIN + OFF_QR + h * 128 + 4 * g;
          const float sf = __builtin_amdgcn_exp2f((float)(cq + 1) * lf2), sb = __builtin_amdgcn_exp2f((float)(128 - cq) * lb2);
#pragma unroll
          for (int ks = 0; ks < 2; ++ks) {
              float fa[8], fb[8], o1[8], o2[8], t1[8], t2[8];
              { const u32x2 a0 = *(const u32x2*)(rp + 32 * ks), a1 = *(const u32x2*)(rp + 32 * ks + 16), b0 = *(const u32x2*)(rp + 32 * ks + 64), b1 = *(const u32x2*)(rp + 32 * ks + 80);
                unpack8(__builtin_bit_cast(bf16x8, (u32x4){a0.x, a0.y, a1.x, a1.y}), fa); unpack8(__builtin_bit_cast(bf16x8, (u32x4){b0.x, b0.y, b1.x, b1.y}), fb); }
              const float* cp = rope + tq * 64 + 32 * ks + 4 * g; const float* sp = cp + SEQ * 64;
              const f32x4 c0 = *(const f32x4*)cp, c1 = *(const f32x4*)(cp + 16), s0 = *(const f32x4*)sp, s1 = *(const f32x4*)(sp + 16);
              const float cs[8] = {c0.x, c0.y, c0.z, c0.w, c1.x, c1.y, c1.z, c1.w}, sn[8] = {s0.x, s0.y, s0.z, s0.w, s1.x, s1.y, s1.z, s1.w};
#pragma unroll
              for (int e = 0; e < 8; ++e) { o1[e] = fa[e] * cs[e] - fb[e] * sn[e]; o2[e] = fb[e] * cs[e] + fa[e] * sn[e]; }
              qn[ks] = pack8(o1); qn[ks + 2] = pack8(o2);
#pragma unroll
              for (int e = 0; e < 8; ++e) { t1[e] = o1[e] * sf; t2[e] = o2[e] * sf; }
              qf[ks] = pack8(t1); qf[ks + 2] = pack8(t2);
#pragma unroll
              for (int e = 0; e < 8; ++e) { t1[e] = o1[e] * sb; t2[e] = o2[e] * sb; }
              qb[ks] = pack8(t1); qb[ks + 2] = pack8(t2);
          } }
        asm volatile("s_waitcnt vmcnt(0)" ::: "memory");
        __syncthreads();
        kv_load(raw, proj, rope, b, h, n + 1 < n1 ? n + 1 : n, tid);
        u32x2 gv[8];
        { const bf16_t* gp = proj + (size_t)(b * SEQ + tq) * DIN + OFF_GR + h * 128 + 4 * g;
#pragma unroll
          for (int mbv = 0; mbv < 8; ++mbv) gv[mbv] = *(const u32x2*)(gp + 16 * mbv); }
        bf16x8 pt[4];
#pragma unroll
        for (int rep3 = 0; rep3 < (RET_PROBE == 3 ? 2 : 1); ++rep3) {
        unsigned zo3 = 0; if (RET_PROBE == 3) asm volatile("" : "+v"(zo3));
#pragma unroll
        for (int ks2 = 0; ks2 < 4; ++ks2) {
            float pv[8];
#pragma unroll
            for (int hb = 0; hb < 2; ++hb) {
                const int mb = 2 * ks2 + hb;
                f32x4 st = (f32x4){0.f, 0.f, 0.f, 0.f};
#pragma unroll
                for (int ks = 0; ks < 4; ++ks) { const LAS unsigned char* kp = lds + LK + zo3 + RS * (16 * mb + r) + 64 * ks + 8 * g; const u32x2 k0 = *(const LAS u32x2*)kp, k1 = *(const LAS u32x2*)(kp + 32);
                    st = __builtin_amdgcn_mfma_f32_16x16x32_bf16(__builtin_bit_cast(bf16x8, (u32x4){k0.x, k0.y, k1.x, k1.y}), qn[ks], st, 0, 0, 0); }
#pragma unroll
                for (int j = 0; j < 4; ++j) { const int diff = cq - (16 * mb + 4 * g + j); pv[4 * hb + j] = st[j] * __builtin_amdgcn_exp2f(diff >= 0 ? (float)diff * lf2 : (float)(-diff) * lb2); }
            }
            pt[ks2] = pack8(pv);
        }
        }
        f32x4 yacc[8];
#pragma unroll
        for (int mbv = 0; mbv < 8; ++mbv) {
            f32x4 y = (f32x4){0.f, 0.f, 0.f, 0.f};
#pragma unroll
            for (int rep = 0; rep < (RET_PROBE == 1 ? 2 : 1); ++rep) {
            unsigned zo = 0; if (RET_PROBE == 1) asm volatile("" : "+v"(zo));
#pragma unroll
            for (int ks2 = 0; ks2 < 4; ++ks2) y = __builtin_amdgcn_mfma_f32_16x16x32_bf16(trfrag(lds + LV + zo, 32 * ks2 + 4 * g, 32 * ks2 + 16 + 4 * g, mbv, qp, p), pt[ks2], y, 0, 0, 0);
#pragma unroll
            for (int ks = 0; ks < 4; ++ks) {
                y = __builtin_amdgcn_mfma_f32_16x16x32_bf16(trfrag(lds + LRF + zo, 32 * ks + 4 * g, 32 * ks + 16 + 4 * g, mbv, qp, p), qf[ks], y, 0, 0, 0);
                y = __builtin_amdgcn_mfma_f32_16x16x32_bf16(trfrag(lds + LRB + zo, 32 * ks + 4 * g, 32 * ks + 16 + 4 * g, mbv, qp, p), qb[ks], y, 0, 0, 0);
            }
            }
            yacc[mbv] = (RET_PROBE == 1) ? y * 0.5f : y;
        }
        __syncthreads();
        if (n + 1 < n1) rb_dma(lds, scratch + (size_t)(n + 1 - n0) * TILE, w, lane);
        { float s = 0.f;
#pragma unroll
          for (int mbv = 0; mbv < 8; ++mbv) s += (yacc[mbv][0] + yacc[mbv][1]) + (yacc[mbv][2] + yacc[mbv][3]);
          s += __shfl_xor(s, 16); s += __shfl_xor(s, 32);
          const float mu = s * (1.f / 128.f); float s2 = 0.f;
#pragma unroll
          for (int mbv = 0; mbv < 8; ++mbv) { yacc[mbv] = yacc[mbv] - mu; s2 += (yacc[mbv][0] * yacc[mbv][0] + yacc[mbv][1] * yacc[mbv][1]) + (yacc[mbv][2] * yacc[mbv][2] + yacc[mbv][3] * yacc[mbv][3]); }
          s2 += __shfl_xor(s2, 16); s2 += __shfl_xor(s2, 32);
          const float rstd = 1.f / sqrtf(s2 * (1.f / 128.f) + GN_EPS);
          bf16_t* op = ymix + (size_t)(b * SEQ + tq) * D + 512 + h * 128 + 4 * g;
#pragma unroll
          for (int rep4 = 0; rep4 < (RET_PROBE == 4 ? 2 : 1); ++rep4) {
          if (RET_PROBE == 4) { asm volatile("" : "+v"(op)); asm volatile("" : "+v"(gv[0]), "+v"(gv[1]), "+v"(gv[2]), "+v"(gv[3]), "+v"(gv[4]), "+v"(gv[5]), "+v"(gv[6]), "+v"(gv[7])); }
#pragma unroll
          for (int mbv = 0; mbv < 8; ++mbv) {
              const f32x4 gn = *(const __attribute__((address_space(1))) f32x4*)(gnp + h * 128 + 16 * mbv + 4 * g);
              const float g0 = __uint_as_float(gv[mbv].x << 16), g1 = __uint_as_float(gv[mbv].x & 0xffff0000u), g2 = __uint_as_float(gv[mbv].y << 16), g3 = __uint_as_float(gv[mbv].y & 0xffff0000u);
              u32x2 o; o.x = cvtpk(silu_f(g0) * (yacc[mbv][0] * rstd * gn.x), silu_f(g1) * (yacc[mbv][1] * rstd * gn.y));
              o.y = cvtpk(silu_f(g2) * (yacc[mbv][2] * rstd * gn.z), silu_f(g3) * (yacc[mbv][3] * rstd * gn.w));
              *(u32x2*)(op + 16 * mbv) = o;
          } } }
        state_update<true>(lds, racc, lf2, w, g, qp, p);
    }
    }
    __syncthreads();
#undef RET_LANE
}
}


namespace na {
constexpr unsigned LKR = 0, LVR = 73728, LRPB = 147456;
__device__ __forceinline__ void load_row(LAS unsigned char* lds, const bf16_t* __restrict__ proj, int b, int head, int krow, int tid) {
    const int key = tid >> 3, ch = tid & 7, slot = krow % 9;
    const bf16_t* rp = proj + (size_t)(b * SEQ + krow * 64 + key) * DIN + head * 64 + ch * 8;
    const unsigned o = (unsigned)slot * 8192u + 128u * key + 16u * (ch ^ (key & 7));
    *(LAS u32x4*)(lds + LKR + o) = *(const u32x4*)(rp + OFF_KNA);
    *(LAS u32x4*)(lds + LVR + o) = *(const u32x4*)(rp + OFF_VNA);
}
__device__ __forceinline__ void unit(const bf16_t* __restrict__ proj, const float* __restrict__ rpb, bf16_t* __restrict__ ymix, LAS unsigned char* lds, int u, const int tid_in) {
    const int b = u >> 3, head = u & 7;
    int tid_ = tid_in; asm volatile("" : "+v"(tid_));
    const int tid0 = tid_, w = __builtin_amdgcn_readfirstlane(tid0 >> 6);
    __syncthreads();
    if (tid0 < 465) ((LAS float*)(lds + LRPB))[tid0] = rpb[head * 465 + tid0];
    const int ct = w & 3, cb = (ct == 0) ? 0 : (ct == 1 ? 8 : (ct == 2 ? 24 : 32));
    u32x4 pk[2], pv2[2]; int pre_lo = 0, pre_n = 0;
    for (int st = 0; st < 16; ++st) {
        int tid = tid0; asm volatile("" : "+v"(tid));
        const int lane = tid & 63, qi = lane & 15, g = lane >> 4; const unsigned qp = (unsigned)qi >> 2, p = (unsigned)lane & 3u;
        const int r = 2 * st + (w >> 2);
        const int rs = min(max(r - 4, 0), 24);
        const int need_hi = min(max(2 * st + 1 - 4, 0), 24) + 7;
        __syncthreads();
        if (st == 0) { for (int kr = 0; kr <= need_hi; ++kr) load_row(lds, proj, b, head, kr, tid); }
        else {
#pragma unroll
            for (int i = 0; i < 2; ++i) if (i < pre_n) { const int key = tid >> 3, ch = tid & 7; const unsigned o = (unsigned)((pre_lo + i) % 9) * 8192u + 128u * key + 16u * (ch ^ (key & 7));
                *(LAS u32x4*)(lds + LKR + o) = pk[i]; *(LAS u32x4*)(lds + LVR + o) = pv2[i]; }
        }
        const int cq = 16 * ct + qi, tq = b * SEQ + r * 64 + cq;
        bf16x8 qn[2];
        { const bf16_t* qptr = proj + (size_t)tq * DIN + OFF_QNA + head * 64 + 8 * g; qn[0] = *(const bf16x8*)qptr; qn[1] = *(const bf16x8*)(qptr + 32); }
        __syncthreads();
        { const int nh = (st < 15) ? min(max(2 * st + 3 - 4, 0), 24) + 7 : need_hi; pre_lo = need_hi + 1; pre_n = nh - need_hi;
#pragma unroll
          for (int i = 0; i < 2; ++i) if (i < pre_n) { const int key = tid >> 3, ch = tid & 7; const bf16_t* rp = proj + (size_t)(b * SEQ + (pre_lo + i) * 64 + key) * DIN + head * 64 + ch * 8;
              pk[i] = *(const u32x4*)(rp + OFF_KNA); pv2[i] = *(const u32x4*)(rp + OFF_VNA); } }
        const int cs = min(max(cq - 8, 0), 48);
        const unsigned kb0 = 128u * qi + 16u * ((unsigned)g ^ ((unsigned)qi & 7u)), kb1 = 128u * qi + 16u * ((4u + (unsigned)g) ^ ((unsigned)qi & 7u));
        const LAS float* bias = (const LAS float*)(lds + LRPB);
        f32x4 sc[16]; float mx = -3.0e38f;
#pragma unroll
        for (int kr = 0; kr < 8; ++kr) {
            const int krow = rs + kr; const unsigned so = (unsigned)(krow % 9) * 8192u + 128u * (unsigned)cb;
            const int dr = krow - r + 7;
#pragma unroll
            for (int h2 = 0; h2 < 2; ++h2) {
                f32x4 a = (f32x4){0.f, 0.f, 0.f, 0.f};
                a = __builtin_amdgcn_mfma_f32_16x16x32_bf16(*(const LAS bf16x8*)(lds + LKR + so + 2048u * h2 + kb0), qn[0], a, 0, 0, 0);
                a = __builtin_amdgcn_mfma_f32_16x16x32_bf16(*(const LAS bf16x8*)(lds + LKR + so + 2048u * h2 + kb1), qn[1], a, 0, 0, 0);
#pragma unroll
                for (int j = 0; j < 4; ++j) {
                    const int kcol = cb + 16 * h2 + 4 * g + j;
                    const int dc = min(max(kcol - cq + 15, 0), 30);
                    const float v = a[j] + bias[dr * 31 + dc];
                    const bool in = (kcol >= cs) && (kcol < cs + 16);
                    a[j] = in ? v : -3.0e38f; mx = fmaxf(mx, a[j]);
                }
                sc[2 * kr + h2] = a;
            }
        }
        mx = fmaxf(mx, __shfl_xor(mx, 16)); mx = fmaxf(mx, __shfl_xor(mx, 32));
        float sum = 0.f; bf16x8 pt[8];
#pragma unroll
        for (int kk = 0; kk < 8; ++kk) {
            float pv[8];
#pragma unroll
            for (int h2 = 0; h2 < 2; ++h2)
#pragma unroll
                for (int j = 0; j < 4; ++j) { const float e = __builtin_amdgcn_exp2f((sc[2 * kk + h2][j] - mx) * 1.4426950408889634f); pv[4 * h2 + j] = e; sum += e; }
            pt[kk] = ret::pack8(pv);
        }
        sum += __shfl_xor(sum, 16); sum += __shfl_xor(sum, 32);
        const float inv = 1.f / sum;
        const unsigned sl = (((unsigned)g & 1u) << 2) | qp;
        bf16_t* op = ymix + (size_t)tq * D + head * 64 + 4 * g;
#pragma unroll
        for (int db = 0; db < 4; ++db) {
            const unsigned vb = 128u * (4u * (unsigned)g + qp) + 16u * ((2u * db + (p >> 1)) ^ sl) + 8u * (p & 1u);
            f32x4 y = (f32x4){0.f, 0.f, 0.f, 0.f};
#pragma unroll
            for (int kk = 0; kk < 8; ++kk) {
                const unsigned so = (unsigned)((rs + kk) % 9) * 8192u + 128u * (unsigned)cb;
                const ret::s16x4 lo = __builtin_amdgcn_ds_read_tr16_b64_v4i16((LAS ret::s16x4*)(lds + LVR + so + vb));
                const ret::s16x4 hi = __builtin_amdgcn_ds_read_tr16_b64_v4i16((LAS ret::s16x4*)(lds + LVR + so + 2048u + vb));
                y = __builtin_amdgcn_mfma_f32_16x16x32_bf16(__builtin_shufflevector(lo, hi, 0, 1, 2, 3, 4, 5, 6, 7), pt[kk], y, 0, 0, 0);
            }
            u32x2 o; o.x = ret::cvtpk(y[0] * inv, y[1] * inv); o.y = ret::cvtpk(y[2] * inv, y[3] * inv);
            *(u32x2*)(op + 16 * db) = o;
        }
    }
    __syncthreads();
}
}

__device__ __forceinline__ void unpack_t16r(const u32x4 a, const u32x4 b, f32x4 (&v)[4]) {
    v[0] = (f32x4){__uint_as_float(a.x << 16), __uint_as_float(a.x & 0xffff0000u), __uint_as_float(a.y << 16), __uint_as_float(a.y & 0xffff0000u)};
    v[1] = (f32x4){__uint_as_float(a.z << 16), __uint_as_float(a.z & 0xffff0000u), __uint_as_float(a.w << 16), __uint_as_float(a.w & 0xffff0000u)};
    v[2] = (f32x4){__uint_as_float(b.x << 16), __uint_as_float(b.x & 0xffff0000u), __uint_as_float(b.y << 16), __uint_as_float(b.y & 0xffff0000u)};
    v[3] = (f32x4){__uint_as_float(b.z << 16), __uint_as_float(b.z & 0xffff0000u), __uint_as_float(b.w << 16), __uint_as_float(b.w & 0xffff0000u)};
}
__device__ __forceinline__ void ln1_row(const u32x4 ra, const u32x4 rb, const LAS float* cv  , bf16_t* __restrict__ hf, unsigned char* __restrict__ hf8, float* __restrict__ stats, int row, int lane) {
    asm volatile("" : "+v"(cv));
    const int c0 = lane * 16;
    f32x4 v[4]; float s = 0.f;
    unpack_t16r(ra, rb, v);
#pragma unroll
    for (int j = 0; j < 4; ++j) s += (v[j].x + v[j].y) + (v[j].z + v[j].w);
    const float mean = wave_sum(s) * (1.f / D); float s2 = 0.f;
#pragma unroll
    for (int j = 0; j < 4; ++j) { v[j] = v[j] - mean; s2 += (v[j].x * v[j].x + v[j].y * v[j].y) + (v[j].z * v[j].z + v[j].w * v[j].w); }
    const float rstd = 1.f / sqrtf(wave_sum(s2) * (1.f / D) + LN_EPS);
    if (lane == 0) *(f32x2*)(stats + 2 * (size_t)row) = (f32x2){mean, rstd};
    u32x4 ob[2], o8;
#pragma unroll
    for (int j = 0; j < 4; ++j) { const int col = c0 + 4 * j;
        const f32x4 gg = *(const LAS f32x4*)(cv + col), bv = *(const LAS f32x4*)(cv + 1024 + col), sc1 = *(const LAS f32x4*)(cv + 2048 + col), sh = *(const LAS f32x4*)(cv + 3072 + col);
        const f32x4 h4 = (v[j] * rstd * gg + bv) * sc1 + sh;
        const unsigned p0 = pk2(h4.x, h4.y), p1 = pk2(h4.z, h4.w);
        if (j == 0) { ob[0].x = p0; ob[0].y = p1; } else if (j == 1) { ob[0].z = p0; ob[0].w = p1; } else if (j == 2) { ob[1].x = p0; ob[1].y = p1; } else { ob[1].z = p0; ob[1].w = p1; }
        const f32x4 h8 = h4 * S_HF8;
        int w0 = __builtin_amdgcn_cvt_pk_fp8_f32(clamp8(h8.x), clamp8(h8.y), 0, false); w0 = __builtin_amdgcn_cvt_pk_fp8_f32(clamp8(h8.z), clamp8(h8.w), w0, true);
        if (j == 0) o8.x = (unsigned)w0; else if (j == 1) o8.y = (unsigned)w0; else if (j == 2) o8.z = (unsigned)w0; else o8.w = (unsigned)w0; }
    *(u32x4*)(hf + (size_t)row * D + c0) = ob[0]; *(u32x4*)(hf + (size_t)row * D + c0 + 8) = ob[1];
    *(u32x4*)(hf8 + (size_t)row * D + c0) = o8;
}
__device__ __forceinline__ void top2_merge(float& a1, float& a2, float b1, float b2) { const float n1 = fmaxf(a1, b1); const float n2 = fmaxf(fminf(a1, b1), fmaxf(a2, b2)); a1 = n1; a2 = n2; }
__device__ __forceinline__ float sigm(float x) { return 1.f / (1.f + __expf(-x)); }
__device__ __forceinline__ void route_lane(const float* __restrict__ logits, const float* __restrict__ rbias, int* __restrict__ topk_e, float* __restrict__ topk_w, LAS unsigned* hist, int tok) {
    const float NEG = -3.0e38f;
    const float* row = logits + (size_t)tok * NE;
    float gs[8];
#pragma unroll
    for (int g = 0; g < 8; ++g) {
        float m1 = NEG, m2 = NEG;
#pragma unroll
        for (int q = 0; q < 8; ++q) {
            const f32x4 lg = *(const f32x4*)(row + g * 32 + q * 4), b4 = *(const f32x4*)(rbias + g * 32 + q * 4);
            const float v[4] = {sigm(lg.x) + b4.x, sigm(lg.y) + b4.y, sigm(lg.z) + b4.z, sigm(lg.w) + b4.w};
#pragma unroll
            for (int j = 0; j < 4; ++j) { m2 = fmaxf(m2, fminf(m1, v[j])); m1 = fmaxf(m1, v[j]); }
        }
        gs[g] = m1 + m2;
        if (g & 1) asm volatile("" ::: "memory");
    }
    int pc[8];
    { int run = 0;
#pragma unroll
      for (int g = 0; g < 8; ++g) { int rank = 0;
#pragma unroll
          for (int h = 0; h < 8; ++h) if (h != g) rank += (gs[h] > gs[g] || (gs[h] == gs[g] && h < g)) ? 1 : 0;
          run += (rank < 4) ? 1 : 0; pc[g] = run; } }
    float L[8]; int I[8];
#pragma unroll
    for (int i = 0; i < 8; ++i) { L[i] = NEG; I[i] = 0; }
#pragma unroll 1
    for (int k = 0; k < 4; ++k) {
        int gk = 0;
#pragma unroll
        for (int g = 0; g < 8; ++g) gk += (pc[g] <= k) ? 1 : 0;
        const int base = gk * 32;
#pragma unroll
        for (int q = 0; q < 8; ++q) {
            const f32x4 lg = *(const f32x4*)(row + base + q * 4), b4 = *(const f32x4*)(rbias + base + q * 4);
            const float cv[4] = {sigm(lg.x) + b4.x, sigm(lg.y) + b4.y, sigm(lg.z) + b4.z, sigm(lg.w) + b4.w};
#pragma unroll
            for (int j = 0; j < 4; ++j) { float v = cv[j]; int idx = base + q * 4 + j;
#pragma unroll
                for (int i = 0; i < 8; ++i) { const bool gt = v > L[i]; const float tv = gt ? L[i] : v; const int ti = gt ? I[i] : idx; L[i] = gt ? v : L[i]; I[i] = gt ? idx : I[i]; v = tv; idx = ti; } }
        }
    }
    float w[8], wsum = 0.f;
#pragma unroll
    for (int i = 0; i < 8; ++i) { w[i] = sigm(row[I[i]]); wsum += w[i]; }
    const float sc = 2.5f / wsum;
    *(u32x4*)(topk_e + tok * TOPK) = (u32x4){(unsigned)I[0], (unsigned)I[1], (unsigned)I[2], (unsigned)I[3]}; *(u32x4*)(topk_e + tok * TOPK + 4) = (u32x4){(unsigned)I[4], (unsigned)I[5], (unsigned)I[6], (unsigned)I[7]};
    *(f32x4*)(topk_w + tok * TOPK) = (f32x4){w[0] * sc, w[1] * sc, w[2] * sc, w[3] * sc}; *(f32x4*)(topk_w + tok * TOPK + 4) = (f32x4){w[4] * sc, w[5] * sc, w[6] * sc, w[7] * sc};
#pragma unroll
    for (int i = 0; i < 8; ++i) __hip_atomic_fetch_add(&hist[I[i]], 1u, __ATOMIC_RELAXED, __HIP_MEMORY_SCOPE_WORKGROUP);
}
__device__ __forceinline__ void build_tables(const unsigned* ctl, LAS unsigned* tab, const int tid) {
    if (tid < 64) {
        const int lane = tid;
        unsigned c[4], so = 0, st = 0;
#pragma unroll
        for (int j = 0; j < 4; ++j) { c[j] = __hip_atomic_load(ctl + CW_COUNT + lane * 4 + j, __ATOMIC_RELAXED, __HIP_MEMORY_SCOPE_AGENT); so += c[j]; st += (c[j] + 255u) >> 8; }
        unsigned io = so, it = st;
#pragma unroll
        for (int o = 1; o < 64; o <<= 1) { const unsigned a = __shfl_up(io, o), b = __shfl_up(it, o); if (lane >= o) { io += a; it += b; } }
        unsigned eo = io - so, et = it - st;
#pragma unroll
        for (int j = 0; j < 4; ++j) { tab[T_CNT + lane * 4 + j] = c[j]; tab[T_OFF + lane * 4 + j] = eo; tab[T_TILE + lane * 4 + j] = et; eo += c[j]; et += (c[j] + 255u) >> 8; }
        if (lane == 63) { tab[T_OFF + NE] = eo; tab[T_TILE + NE] = et; }
    }
    __syncthreads();
}
struct RowRaw { u32x4 y[9]; u32x4 t[2]; f32x2 st; };
__device__ __forceinline__ void final_load(RowRaw& R, const bf16_t* __restrict__ tb, const unsigned char* __restrict__ ybuf, const unsigned char* __restrict__ ysh, const float* __restrict__ stats, int row, int lane) {
    const int c0 = lane * 16;
#pragma unroll
    for (int k = 0; k < TOPK; ++k) R.y[k] = *(const u32x4*)(ybuf + ((size_t)row * TOPK + k) * D + c0);
    R.y[8] = *(const u32x4*)(ysh + (size_t)row * D + c0);
    R.t[0] = *(const u32x4*)(tb + (size_t)row * D + c0); R.t[1] = *(const u32x4*)(tb + (size_t)row * D + c0 + 8);
    R.st = *(const f32x2*)(stats + 2 * (size_t)row);
}
__device__ __forceinline__ void final_row(float* __restrict__ out, const RowRaw& R, const LAS float* cv  , int row, int lane) {
    asm volatile("" : "+v"(cv));
    const int c0 = lane * 16;
    f32x4 a[4], t[4], v[4]; float s = 0.f;
#pragma unroll
    for (int j = 0; j < 4; ++j) a[j] = (f32x4){0.f, 0.f, 0.f, 0.f};
#pragma unroll
    for (int k = 0; k < 9; ++k) { const unsigned w[4] = {R.y[k].x, R.y[k].y, R.y[k].z, R.y[k].w};
#pragma unroll
        for (int j = 0; j < 4; ++j) { const f32x2 lo = __builtin_amdgcn_cvt_pk_f32_fp8((int)w[j], false), hi = __builtin_amdgcn_cvt_pk_f32_fp8((int)w[j], true); a[j].x += lo.x; a[j].y += lo.y; a[j].z += hi.x; a[j].w += hi.y; } }
    unpack_t16r(R.t[0], R.t[1], t);
#pragma unroll
    for (int j = 0; j < 4; ++j) { const int col = c0 + 4 * j;
        const f32x4 x1 = (t[j] - R.st.x) * R.st.y * *(const LAS f32x4*)(cv + col) + *(const LAS f32x4*)(cv + 1024 + col);
        v[j] = x1 * ALPHA + *(const LAS f32x4*)(cv + 4096 + col) * a[j] * YINV;
        s += (v[j].x + v[j].y) + (v[j].z + v[j].w); }
    const float mean = wave_sum(s) * (1.f / D); float s2 = 0.f;
#pragma unroll
    for (int j = 0; j < 4; ++j) { v[j] = v[j] - mean; s2 += (v[j].x * v[j].x + v[j].y * v[j].y) + (v[j].z * v[j].z + v[j].w * v[j].w); }
    const float rstd = 1.f / sqrtf(wave_sum(s2) * (1.f / D) + LN_EPS);
#pragma unroll
    for (int j = 0; j < 4; ++j) { const int col = c0 + 4 * j;
        *(f32x4*)(out + (size_t)row * D + col) = v[j] * rstd * *(const LAS f32x4*)(cv + 2048 + col) + *(const LAS f32x4*)(cv + 3072 + col); }
}

#ifndef MK_PER_PHASE
#define MK_PER_PHASE 0
#endif
constexpr int N_PHASES = 13;
struct Args { Ctx X; int ph_lo, ph_hi; };
typedef __attribute__((address_space(4))) const Ctx* CtxCP;
__device__ __forceinline__ CtxCP ctx_ptr() { CtxCP p = (CtxCP)__builtin_amdgcn_kernarg_segment_ptr(); asm volatile("" : "+s"(p)); return p; }

__global__ void __launch_bounds__(NW * 64, 2) mk_fwd(Args args) {
    extern __shared__ __attribute__((aligned(16))) unsigned char lds_raw[];
    LAS unsigned char* lds = (LAS unsigned char*)lds_raw;
    LAS unsigned* tab = (LAS unsigned*)(lds + TAB_OFF);
    volatile LAS unsigned* MISC = (volatile LAS unsigned*)(lds + MISC_OFF);
#define PH_BEGIN \
    const __attribute__((address_space(4))) Ctx& X = *ctx_ptr(); unsigned char* ws = X.ws; (void)ws; \
    const int lane = lane_id(), wave = wave0, tid = wave0 * 64 + lane; (void)lane; (void)wave; (void)tid; \
    const int G = gridDim.x, bx = blockIdx.x; (void)G; (void)bx; \
    const int gw = bx * NW + wave, NGW = G * NW; (void)gw; (void)NGW; \
    const int gt = bx * (NW * 64) + tid, NGT = G * NW * 64; (void)gt; (void)NGT; \
    unsigned* ctl = (unsigned*)(ws + WS_CTL); float* mod = (float*)(ws + WS_MOD); float* rope = (float*)(ws + WS_ROPE); (void)ctl; (void)mod; (void)rope; \
    bf16_t* win_t = (bf16_t*)(ws + WS_WIN_T); bf16_t* wout_t = (bf16_t*)(ws + WS_WOUT_T); bf16_t* wr_t = (bf16_t*)(ws + WS_WR_T); (void)win_t; (void)wout_t; (void)wr_t; \
    bf16_t* wsgu_t = (bf16_t*)(ws + WS_WSGU_T); bf16_t* wsd_t = (bf16_t*)(ws + WS_WSD_T); bf16_t* wd_t = (bf16_t*)(ws + WS_WD_T); bf16_t* wgu_t = (bf16_t*)(ws + WS_WGU_T); (void)wsgu_t; (void)wsd_t; (void)wd_t; (void)wgu_t; \
    int* slot_ent = (int*)(ws + WS_SLOT_ENT); float* slot_w = (float*)(ws + WS_SLOT_W); int* topk_e = (int*)(ws + WS_TOPK_E); float* topk_w = (float*)(ws + WS_TOPK_W); (void)slot_ent; (void)slot_w; (void)topk_e; (void)topk_w; \
    bf16_t* ymix = (bf16_t*)(ws + WS_YMIX); bf16_t* proj = (bf16_t*)(ws + WS_PROJ); bf16_t* hbuf = (bf16_t*)(ws + WS_YMIX); (void)ymix; (void)proj; (void)hbuf; \
    float* logits = (float*)(ws + WS_LOGITS); bf16_t* shh = (bf16_t*)(ws + WS_SHH); bf16_t* hf = (bf16_t*)(ws + WS_HF); bf16_t* act = (bf16_t*)(ws + WS_ACT); (void)logits; (void)shh; (void)hf; (void)act; \
    unsigned char* ybuf = ws + WS_YBUF; float* out = X.out; (void)ybuf; (void)out;

    const int wave0 = __builtin_amdgcn_readfirstlane((int)threadIdx.x >> 6);
    for (int u = threadIdx.x; u < (LDS_BYTES - MISC_OFF) / 4; u += NW * 64) ((LAS unsigned*)(lds + MISC_OFF))[u] = 0u;
    __syncthreads();
    if (!MK_PER_PHASE) { unsigned* ctl0 = (unsigned*)(args.X.ws + WS_CTL); (void)xcd_barrier_post(ctl0 + CW_BAR, MISC + 8, wave0 == 0 && lane_id() == 0); }
    const int lo = args.ph_lo, hi = args.ph_hi;
#ifndef MK_DUP
#define MK_DUP -1
#endif
#define REPS(k) for (int _rep = 0; _rep < ((MK_DUP == (k)) ? 2 : 1); ++_rep)
#ifdef MK_ONLY
#define IN(k) ((k) == MK_ONLY)
#else
#define IN(k) (lo <= (k) && (k) < hi)
#endif
#define SEAM(k) SEAM2(k, (k) + 1)
#define SEAM2(k, k2) do { if (IN(k) && IN(k2)) { XcdBarrier _b; _b.bar = (unsigned*)(ctx_ptr()->ws + WS_CTL) + CW_BAR; _b.x = xb_xcc_id(); _b.st = (volatile LAS unsigned*)(lds + MISC_OFF) + 8; xcd_barrier(_b, wave0 == 0 && lane_id() == 0); } } while (0)

    REPS(0) if (IN(0)) { PH_BEGIN
        LAS float* scr = (LAS float*)(lds + wave * 16384);
        float* modp = (float*)(ws + WS_PROJ);
        for (int t = gw; t < 96 * 16; t += NGW) mod_task(X.c, X.w_ada, modp, t, lane);
        constexpr int I_IN = (D / 64) * (DIN / 32), I_OUT = (D / 64) * (D / 32), I_R = (D / 64) * (NE / 32), I_SG = (D / 64) * (DE / 32), I_SD = (DE / 64) * (D / 32);
        constexpr int I_EG = I_SG, I_ED = I_SD;
        constexpr int N_SMALL = I_IN + I_OUT + I_R + 2 * I_SG + I_SD;
        constexpr int N_ITEMS = N_SMALL + NE * (2 * I_EG + I_ED);
        for (int it = gw; it < N_ITEMS; it += NGW) {
            int r = it;
            if (r < I_IN) { transpose_item(X.w_in, D, DIN, win_t, 0, 0, scr, r, lane); continue; } r -= I_IN;
            if (r < I_OUT) { transpose_item(X.w_out, D, D, wout_t, 0, 0, scr, r, lane); continue; } r -= I_OUT;
            if (r < I_R) { transpose_item(X.w_router, D, NE, wr_t, 0, 0, scr, r, lane); continue; } r -= I_R;
            if (r < I_SG) { transpose_item(X.ws_gate, D, DE, wsgu_t, 8, 0, scr, r, lane); continue; } r -= I_SG;
            if (r < I_SG) { transpose_item(X.ws_up, D, DE, wsgu_t, 8, 1, scr, r, lane); continue; } r -= I_SG;
            if (r < I_SD) { transpose_item(X.ws_down, DE, D, wsd_t, 0, 0, scr, r, lane); continue; } r -= I_SD;
            const int e = r / (2 * I_EG + I_ED); r -= e * (2 * I_EG + I_ED);
            if (r < I_EG) { transpose_item_fp8(X.w_gate + (size_t)e * D * DE, D, DE, (unsigned char*)wgu_t + (size_t)e * 512 * D, 8, 0, S_WGU8, scr, r, lane); continue; } r -= I_EG;
            if (r < I_EG) { transpose_item_fp8(X.w_up + (size_t)e * D * DE, D, DE, (unsigned char*)wgu_t + (size_t)e * 512 * D, 8, 1, S_WGU8, scr, r, lane); continue; } r -= I_EG;
            transpose_item_fp8(X.w_down + (size_t)e * DE * D, DE, D, (unsigned char*)wd_t + (size_t)e * D * DE, 0, 0, S_WD8, scr, r, lane);
        }
        for (int i = gt; i < SEQ * 64; i += NGT) rope_entry(rope, i);
    }
    SEAM(0);
    REPS(1) if (IN(1)) { PH_BEGIN
        const float* modp = (const float*)(ws + WS_PROJ);
        for (int i = gt; i < 32 * 6144; i += NGT) mod[i] = mod_sum(modp, X.b_ada, i / 6144, i % 6144);
        LAS float* ssc = (LAS float*)lds; LAS float* ssh = ssc + 1024;
        int curb = -1;
        for (int c = bx; c < M / 256; c += G) {
            const int b = c >> 3;
            if (b != curb) {
                __syncthreads();
                for (int i = tid; i < 1024; i += NW * 64) { ssc[i] = 1.f + mod_sum(modp, X.b_ada, b, MOD_SCALE_A + i); ssh[i] = mod_sum(modp, X.b_ada, b, MOD_SHIFT_A + i); }
                __syncthreads();
                curb = b;
            }
            const f32x4 sc = *(const LAS f32x4*)(ssc + (tid & 255) * 4), sh = *(const LAS f32x4*)(ssh + (tid & 255) * 4);
            const float* xp = X.x + (size_t)c * 256 * D + (size_t)(tid >> 8) * D + (tid & 255) * 4;
            bf16_t* hp = hbuf + (size_t)c * 256 * D + (size_t)(tid >> 8) * D + (tid & 255) * 4;
            for (int i0 = 0; i0 < 128; i0 += 8) {
                f32x4 v[8];
#pragma unroll
                for (int i = 0; i < 8; ++i) v[i] = __builtin_nontemporal_load((const f32x4*)(xp + (size_t)(i0 + i) * 2 * D));
#pragma unroll
                for (int i = 0; i < 8; ++i) { u32x2 o; o.x = pk2(v[i].x * sc.x + sh.x, v[i].y * sc.y + sh.y); o.y = pk2(v[i].z * sc.z + sh.z, v[i].w * sc.w + sh.w); *(u32x2*)(hp + (size_t)(i0 + i) * 2 * D) = o; }
            }
        }
        __syncthreads();
    }
    SEAM(1);
    REPS(2) if (IN(2)) { PH_BEGIN
        pg8::DenseOrder S; S.init(M, DIN, D, win_t, G, bx);
        pg8::EpiInProj E{proj};
        pg8::gemm_phase(lds, (const char*)hbuf, D, S, E, tid);
    }
    SEAM(2);
    REPS(3) if (IN(3)) { PH_BEGIN
        REPS(31) for (int hu = bx; hu < BATCH * 4 * 2; hu += G) ret::unit(proj, rope, X.ret_ld, X.ret_gn, ymix, (unsigned char*)out + (size_t)hu * (8 * ret::TILE), lds, hu, tid);
        REPS(32) for (int u = bx; u < BATCH * 8; u += G) na::unit(proj, X.na_rpb, ymix, lds, u, tid);
    }
    SEAM2(3, 5);
    if (IN(5)) { PH_BEGIN
        LAS float* cv = (LAS float*)lds; LAS unsigned* hist = tab + T_HIST;
        if (tid < NE) hist[tid] = 0u;
        __syncthreads();
        for (int c = bx; c < M / 256; c += G) {
            const int b = c >> 3;
            { pg8::RowOrder S{c, 4, D, (const char*)wout_t}; pg8::EpiOutProj E{X.x, mod, (bf16_t*)(ws + WS_TB)}; pg8::gemm_phase(lds, (const char*)ymix, D, S, E, tid); }
            asm volatile("s_waitcnt vmcnt(0)" ::: "memory"); __syncthreads();
            int lane2 = lane; asm volatile("" : "+v"(lane2));
            const int tid2 = wave * 64 + lane2;
            if (tid2 < 256) { const int i = tid2 * 4; *(LAS f32x4*)(cv + i) = *(const f32x4*)(X.ln1_g + i); *(LAS f32x4*)(cv + 1024 + i) = *(const f32x4*)(X.ln1_b + i);
                *(LAS f32x4*)(cv + 2048 + i) = *(const f32x4*)(mod + b * 6144 + MOD_SCALE_F + i) + 1.f; *(LAS f32x4*)(cv + 3072 + i) = *(const f32x4*)(mod + b * 6144 + MOD_SHIFT_F + i); }
            __syncthreads();
            { const bf16_t* tp = (const bf16_t*)(ws + WS_TB) + (size_t)(c * 256 + wave * 32) * D + lane2 * 16;
              u32x4 ra = *(const u32x4*)tp, rb = *(const u32x4*)(tp + 8);
#pragma unroll 1
              for (int i = 0; i < 32; ++i) {
                  const u32x4 ca = ra, cb = rb; const int nx = i < 31 ? i + 1 : i;
                  ra = *(const u32x4*)(tp + (size_t)nx * D); rb = *(const u32x4*)(tp + (size_t)nx * D + 8);
                  ln1_row(ca, cb, cv, hf, ws + WS_HF8, (float*)(ws + WS_STATS), c * 256 + wave * 32 + i, lane2);
              } }
            asm volatile("s_waitcnt vmcnt(0)" ::: "memory"); __syncthreads();
            { pg8::RowOrder S{c, 1, D, (const char*)wr_t}; pg8::EpiRouter E{logits}; pg8::gemm_phase(lds, (const char*)hf, D, S, E, tid); }
            { pg8::RowOrder S{c, 2, D, (const char*)wsgu_t}; pg8::EpiGU<false> E{(void*)shh}; pg8::gemm_phase(lds, (const char*)hf, D, S, E, tid); }
            asm volatile("s_waitcnt vmcnt(0)" ::: "memory"); __syncthreads();
            { int lane3 = lane; asm volatile("" : "+v"(lane3)); const int tid3 = wave * 64 + lane3;
              if (tid3 < 256) route_lane(logits, X.rbias, topk_e, topk_w, hist, c * 256 + tid3); }
        }
        __syncthreads();
        if (tid < NE && hist[tid]) atomicAdd(&ctl[CW_COUNT + tid], hist[tid]);
    }
    SEAM2(5, 9);
    if (IN(9)) { PH_BEGIN
        build_tables(ctl, tab, tid);
        LAS unsigned* hist = tab + T_HIST; LAS unsigned* base = tab + T_BASE;
        for (int c0 = bx * 2048; c0 < NSLOT; c0 += G * 2048) {
            __syncthreads();
            if (tid < NE) hist[tid] = 0u;
            __syncthreads();
            int e[4]; unsigned loc[4];
#pragma unroll
            for (int i = 0; i < 4; ++i) { const int idx = c0 + i * 512 + tid; e[i] = topk_e[idx]; loc[i] = __hip_atomic_fetch_add(&hist[e[i]], 1u, __ATOMIC_RELAXED, __HIP_MEMORY_SCOPE_WORKGROUP); }
            __syncthreads();
            if (tid < NE && hist[tid]) base[tid] = atomicAdd(&ctl[CW_CURSOR + tid], hist[tid]);
            __syncthreads();
#pragma unroll
            for (int i = 0; i < 4; ++i) { const int idx = c0 + i * 512 + tid; const unsigned pos = tab[T_OFF + e[i]] + base[e[i]] + loc[i]; slot_ent[pos] = idx; slot_w[pos] = topk_w[idx]; }
        }
    }
    SEAM(9);
    if (IN(10)) { PH_BEGIN
        build_tables(ctl, tab, tid);
        REPS(10) { pg8::ExpertOrder<2, true> S; S.init(tab, D, wgu_t, (size_t)512 * D, slot_ent, slot_w, G, bx); pg8::EpiGU<true> E{(void*)act}; pg8::gemm_phase<1>(lds, (const char*)(ws + WS_HF8), D, S, E, tid); }
        { pg8::DenseOrder S; S.init(M, D, DE, wsd_t, G, bx); pg8::EpiSharedDown E{ws + WS_YSH}; pg8::gemm_phase(lds, (const char*)shh, DE, S, E, tid); }
    }
    SEAM(10);
    REPS(11) if (IN(11)) { PH_BEGIN
        build_tables(ctl, tab, tid);
#if MK_DUP >= 113 && MK_DUP <= 116
        pg8::down2_phase<MK_DUP - 112>(lds, tab, (const char*)act, (const char*)wd_t, slot_ent, ybuf, G, bx, tid);
#endif
        pg8::down2_phase(lds, tab, (const char*)act, (const char*)wd_t, slot_ent, ybuf, G, bx, tid);
#if MK_DUP == 111
        { pg8::ExpertOrder<4, false> S2; S2.init(tab, DE, wd_t, (size_t)D * DE, slot_ent, slot_w, G, bx); pg8::EpiProbeSum E2{(float*)(ws + WS_STATS)}; pg8::gemm_phase<1>(lds, (const char*)act, DE, S2, E2, tid); }
#endif
    }
    SEAM(11);
    REPS(12) if (IN(12)) { PH_BEGIN
        LAS float* cv = (LAS float*)lds; int curb = -1;
        for (int c = bx; c < M / 256; c += G) {
            const int b = c >> 3;
            if (b != curb) {
                __syncthreads();
                if (tid < 256) { const int i = tid * 4; *(LAS f32x4*)(cv + i) = *(const f32x4*)(X.ln1_g + i); *(LAS f32x4*)(cv + 1024 + i) = *(const f32x4*)(X.ln1_b + i);
                    *(LAS f32x4*)(cv + 2048 + i) = *(const f32x4*)(X.ln2_g + i); *(LAS f32x4*)(cv + 3072 + i) = *(const f32x4*)(X.ln2_b + i); *(LAS f32x4*)(cv + 4096 + i) = *(const f32x4*)(mod + b * 6144 + MOD_GATE_F + i); }
                __syncthreads(); curb = b;
            }
            const int r0 = c * 256 + wave * 32;
            RowRaw nx; final_load(nx, (const bf16_t*)(ws + WS_TB), ybuf, ws + WS_YSH, (const float*)(ws + WS_STATS), r0, lane);
#pragma unroll 1
            for (int i = 0; i < 32; ++i) {
                const RowRaw cur = nx;
                final_load(nx, (const bf16_t*)(ws + WS_TB), ybuf, ws + WS_YSH, (const float*)(ws + WS_STATS), r0 + (i < 31 ? i + 1 : i), lane);
                final_row(out, cur, cv, r0 + i, lane);
            }
        }
    }
#undef IN
#undef SEAM
}

extern "C" void kernel_launch(void* const* d_in, const int* in_sizes, int n_in, void* d_out, int out_size, void* d_ws, size_t ws_size, hipStream_t stream) {
    static int grid = 0;
    if (grid == 0) {
        if (n_in != 21 || in_sizes[0] != M * D || out_size != M * D || ws_size < WS_END) { fprintf(stderr, "kernel_launch: unexpected shapes (n_in %d, ws %zu)\n", n_in, ws_size); grid = -1; return; }
        int dev = 0, cus = 0, per_cu = 0;
        if (hipGetDevice(&dev) != hipSuccess || hipDeviceGetAttribute(&cus, hipDeviceAttributeMultiprocessorCount, dev) != hipSuccess) { grid = -1; return; }
        if (hipFuncSetAttribute((const void*)mk_fwd, hipFuncAttributeMaxDynamicSharedMemorySize, LDS_BYTES) != hipSuccess) { fprintf(stderr, "kernel_launch: hipFuncSetAttribute failed\n"); grid = -1; return; }
        if (hipOccupancyMaxActiveBlocksPerMultiprocessor(&per_cu, (const void*)mk_fwd, NW * 64, LDS_BYTES) != hipSuccess || per_cu < 1) { fprintf(stderr, "kernel_launch: occupancy query says %d\n", per_cu); }
        (void)hipGetLastError();
        grid = cus;
    }
    if (grid < 0) return;
    (void)hipMemsetAsync((char*)d_ws + WS_CTL, 0, 1 * MiB, stream);
    Args a{};
    const float** p = (const float**)&a.X;
    for (int i = 0; i < 21; ++i) p[i] = (const float*)d_in[i];
    a.X.out = (float*)d_out; a.X.ws = (unsigned char*)d_ws;
#if MK_PER_PHASE
    for (int ph = 0; ph < N_PHASES; ++ph) { a.ph_lo = ph; a.ph_hi = ph + 1; hipLaunchKernelGGL(mk_fwd, dim3(grid), dim3(NW * 64), LDS_BYTES, stream, a); }
#else
    a.ph_lo = 0; a.ph_hi = N_PHASES;
    hipLaunchKernelGGL(mk_fwd, dim3(grid), dim3(NW * 64), LDS_BYTES, stream, a);
#endif
}
```

```cpp
#include <hip/hip_runtime.h>
#include <cstdio>
#include <cstdint>

typedef unsigned short bf16_t;
typedef short bf16x8 __attribute__((ext_vector_type(8)));
typedef float f32x4 __attribute__((ext_vector_type(4)));
typedef float f32x2 __attribute__((ext_vector_type(2)));
typedef unsigned u32x4 __attribute__((ext_vector_type(4)));
typedef unsigned u32x2 __attribute__((ext_vector_type(2)));
#define LAS __attribute__((address_space(3)))

constexpr int D = 1024, BATCH = 32, SEQ = 2048, M = BATCH * SEQ;
constexpr int DIN = 3584;
constexpr int OFF_QNA = 0, OFF_KNA = 512, OFF_VNA = 1024, OFF_QR = 1536, OFF_KR = 2048, OFF_VR = 2560, OFF_GR = 3072;
constexpr int NE = 256, TOPK = 8, DE = 256;
constexpr int NSLOT = M * TOPK;
constexpr float LN_EPS = 1e-5f, GN_EPS = 1e-6f;
constexpr float ALPHA = 1.189207115002721f;
constexpr float YSCALE = 64.f, YINV = 1.f / 64.f;
constexpr float S_HF8 = 16.f, S_WGU8 = 256.f, S_ACT8 = 32.f, S_WD8 = 128.f;
constexpr float INV_GU8 = 1.f / (16.f * 256.f), INV_DN8 = 1.f / (32.f * 128.f);
constexpr float S_H8 = 16.f, S_WIN8 = 128.f, INV_IN8 = 1.f / (16.f * 128.f);
constexpr int MOD_SHIFT_A = 0, MOD_SCALE_A = 1024, MOD_GATE_A = 2048, MOD_SHIFT_F = 3072, MOD_SCALE_F = 4096, MOD_GATE_F = 5120;

constexpr size_t MiB = 1u << 20;
constexpr size_t WS_CTL = 0;
constexpr size_t WS_MOD = 1 * MiB;
constexpr size_t WS_ROPE = 2 * MiB;
constexpr size_t WS_WIN_T = 4 * MiB;
constexpr size_t WS_WOUT_T = 11 * MiB;
constexpr size_t WS_WR_T = 13 * MiB;
constexpr size_t WS_WSGU_T = 14 * MiB;
constexpr size_t WS_WSD_T = 15 * MiB;
constexpr size_t WS_SLOT_ENT = 16 * MiB;
constexpr size_t WS_SLOT_W = 18 * MiB;
constexpr size_t WS_TOPK_E = 20 * MiB;
constexpr size_t WS_TOPK_W = 22 * MiB;
constexpr size_t WS_STATS = 24 * MiB;
constexpr size_t WS_WD_T = 32 * MiB;
constexpr size_t WS_WGU_T = 160 * MiB;
constexpr size_t WS_HF8 = 288 * MiB;
constexpr size_t WS_YMIX = 416 * MiB;
constexpr size_t WS_PROJ = 544 * MiB;
constexpr size_t WS_LOGITS = WS_PROJ + 384 * MiB;
constexpr size_t WS_SHH = 352 * MiB;
constexpr size_t WS_HF = WS_PROJ, WS_ACT = WS_PROJ + 128 * MiB;
constexpr size_t WS_YBUF = WS_WGU_T;
constexpr size_t WS_TB = WS_PROJ + 256 * MiB;
constexpr size_t WS_YSH = WS_PROJ + 384 * MiB;
constexpr size_t WS_END = 992 * MiB;
constexpr int CW_COUNT = 1024, CW_CURSOR = 1536, CW_BAR = 8192;

constexpr int RING_BYTES = 131072;
constexpr int TAB_OFF = RING_BYTES;
constexpr int T_OFF = 0, T_TILE = 260, T_CNT = 520, T_HIST = 776, T_BASE = 1032, TAB_WORDS = 1288;
constexpr int VN_OFF = TAB_OFF + 6144;
constexpr int ROWTAB_OFF = VN_OFF + 8192;
constexpr int PHASE_BYTES = 155648;
constexpr int MISC_OFF = PHASE_BYTES;
constexpr int LDS_BYTES = PHASE_BYTES + 256;
static_assert(TAB_WORDS * 4 <= 6144 && ROWTAB_OFF + 6144 <= PHASE_BYTES && LDS_BYTES <= 163840, "LDS map");

__device__ __forceinline__ unsigned f2bf(float f) { unsigned u = __float_as_uint(f); return (u + 0x7fffu + ((u >> 16) & 1u)) >> 16; }
__device__ __forceinline__ float bf2f(unsigned short h) { return __uint_as_float(((unsigned)h) << 16); }
__device__ __forceinline__ unsigned pk2(float lo, float hi) { return f2bf(lo) | (f2bf(hi) << 16); }
__device__ __forceinline__ unsigned cvt_pk_bf16(float lo, float hi) { unsigned r; asm volatile("v_cvt_pk_bf16_f32 %0, %1, %2" : "=v"(r) : "v"(lo), "v"(hi)); return r; }
__device__ __forceinline__ float silu_f(float v) { return v * __builtin_amdgcn_rcpf(1.f + __expf(-v)); }
__device__ __forceinline__ float wave_sum(float v) {
    v += __builtin_bit_cast(float, __builtin_amdgcn_update_dpp(0, __builtin_bit_cast(int, v), 0xB1, 0xf, 0xf, true));
    v += __builtin_bit_cast(float, __builtin_amdgcn_update_dpp(0, __builtin_bit_cast(int, v), 0x4E, 0xf, 0xf, true));
    v += __builtin_bit_cast(float, __builtin_amdgcn_update_dpp(0, __builtin_bit_cast(int, v), 0x141, 0xf, 0xf, true));
    v += __builtin_bit_cast(float, __builtin_amdgcn_update_dpp(0, __builtin_bit_cast(int, v), 0x140, 0xf, 0xf, true));
    const int b = __builtin_bit_cast(int, v);
    return (__builtin_bit_cast(float, __builtin_amdgcn_readlane(b, 0)) + __builtin_bit_cast(float, __builtin_amdgcn_readlane(b, 16))) + (__builtin_bit_cast(float, __builtin_amdgcn_readlane(b, 32)) + __builtin_bit_cast(float, __builtin_amdgcn_readlane(b, 48)));
}
__device__ __forceinline__ float clamp8(float v) { return __builtin_amdgcn_fmed3f(v, -440.f, 440.f); }
#define LDS_WAIT() asm volatile("s_waitcnt lgkmcnt(0)" ::: "memory")
__device__ __forceinline__ int lane_id() { return (int)__builtin_amdgcn_mbcnt_hi(~0u, __builtin_amdgcn_mbcnt_lo(~0u, 0u)); }

#define XB_TMO      128
#define XB_XCNT(j)  (256  + 64 * (j))
#define XB_XSUB(j)  (1280 + 64 * (j))
#define XB_XGEN(j)  (2304 + 64 * (j))
#define XB_TOP      3328
#define XB_TOPGEN   3392
#define XCD_BAR_WORDS 3456
#define XB_SPIN_CAP (1u << 23)
__device__ __forceinline__ unsigned xb_ld(unsigned* p)              { return __hip_atomic_load(p, __ATOMIC_RELAXED, __HIP_MEMORY_SCOPE_AGENT); }
__device__ __forceinline__ unsigned xb_add(unsigned* p, unsigned v) { return __hip_atomic_fetch_add(p, v, __ATOMIC_RELAXED, __HIP_MEMORY_SCOPE_AGENT); }
__device__ __forceinline__ unsigned xb_xcc_id() { return (unsigned)__builtin_amdgcn_s_getreg((3 << 11) | 20) & 0xFu; }
#define XB_SPIN(cond, bar) do { unsigned _sp = 0; while (cond) { __builtin_amdgcn_s_sleep(1); \
    if ((++_sp & 255u) == 0u) { if (xb_ld(&(bar)[XB_TMO])) break; if (_sp > XB_SPIN_CAP) { atomicAdd(&(bar)[XB_TMO], 1u); break; } } } } while (0)
struct XcdBarrier { unsigned* bar; unsigned x; volatile LAS unsigned* st; };
__device__ __forceinline__ XcdBarrier xcd_barrier_post(unsigned* bar, volatile LAS unsigned* st, bool leader) {
    XcdBarrier b; b.bar = bar; b.x = xb_xcc_id(); b.st = st;
    if (leader) (void)xb_add(&bar[XB_XCNT(b.x)], 1u);
    return b;
}
__device__ __forceinline__ void xcd_barrier_complete(unsigned* bar, unsigned x, unsigned& nloc, unsigned& nx) {
    const unsigned G = gridDim.x * gridDim.y * gridDim.z;
    unsigned sum, cnt, mine, sp = 0u;
    for (;;) {
        sum = 0u; cnt = 0u; mine = 0u;
#pragma unroll
        for (unsigned j = 0; j < 16; ++j) { const unsigned c = xb_ld(&bar[XB_XCNT(j)]); sum += c; cnt += (c > 0u) ? 1u : 0u; mine = (j == x) ? c : mine; }
        if (sum == G) break;
        __builtin_amdgcn_s_sleep(1);
        if ((++sp & 255u) == 0u) { if (xb_ld(&bar[XB_TMO])) break; if (sp > XB_SPIN_CAP) { atomicAdd(&bar[XB_TMO], 1u); break; } }
    }
    nloc = mine > 0u ? mine : 1u; nx = cnt > 0u ? cnt : 1u;
}
__device__ __forceinline__ void xcd_barrier(const XcdBarrier& b, bool leader) {
    asm volatile("s_waitcnt vmcnt(0)" ::: "memory");
    __syncthreads();
    if (leader) {
        unsigned* bar = b.bar;
        __builtin_amdgcn_s_waitcnt(0);
        unsigned nloc = b.st[0], nx = b.st[1];
        if (nloc == 0u) { xcd_barrier_complete(bar, b.x, nloc, nx); b.st[0] = nloc; b.st[1] = nx; }
        const unsigned old = xb_add(&bar[XB_XSUB(b.x)], 1u);
        const unsigned gen = old / nloc;
        if (old + 1u == (gen + 1u) * nloc) {
            __builtin_amdgcn_fence(__ATOMIC_RELEASE, "agent");
            asm volatile("s_waitcnt vmcnt(0)" ::: "memory");
            const unsigned og = xb_add(&bar[XB_TOP], 1u);
            const unsigned tg = og / nx;
            if (og + 1u == (tg + 1u) * nx) xb_add(&bar[XB_TOPGEN], 1u);
            else XB_SPIN(xb_ld(&bar[XB_TOPGEN]) == tg, bar);
            __builtin_amdgcn_fence(__ATOMIC_ACQUIRE, "agent");
            xb_add(&bar[XB_XGEN(b.x)], 1u);
            asm volatile("s_waitcnt vmcnt(0)" ::: "memory");
        } else {
            XB_SPIN(xb_ld(&bar[XB_XGEN(b.x)]) == gen, bar);
            __builtin_amdgcn_fence(__ATOMIC_ACQUIRE, "agent");
            asm volatile("s_waitcnt vmcnt(0)" ::: "memory");
        }
    }
    __syncthreads();
}

namespace pg8 {
constexpr int BM = 256, BK = 64, HALF = 128, HTB = HALF * BK * 2, STAGE_BYTES = 8 * HTB;
__device__ __forceinline__ int lds_byte(int r, int c) { const int st = (r >> 4) * 2 + (c >> 5), rr = r & 15, cc = c & 31, ob = rr * 64 + cc * 2; return st * 1024 + (ob ^ (((ob >> 9) & 1) << 5)); }
__device__ __forceinline__ void stage_rc(int b, int& R, int& C) { const int st = b / 1024, sb = b % 1024, swz = sb ^ (((sb >> 9) & 1) << 5); R = (st >> 1) * 16 + swz / 64; C = (st & 1) * 32 + (swz % 64) / 2; }
__device__ __forceinline__ int perm32(int rho) { const int n = rho >> 4, i = rho & 15; return 8 * (i >> 2) + 4 * n + (i & 3); }

typedef int i32x8 __attribute__((ext_vector_type(8)));
__device__ __forceinline__ i32x8 cat8(const bf16x8 lo, const bf16x8 hi) { const u32x4 a = __builtin_bit_cast(u32x4, lo), b = __builtin_bit_cast(u32x4, hi); return (i32x8){(int)a.x, (int)a.y, (int)a.z, (int)a.w, (int)b.x, (int)b.y, (int)b.z, (int)b.w}; }
struct Unit { int pm, pn; const char* B; int e, cnt, off; };

template <int ESZ = 2, bool AREUSE = false, class Epi, class Sched>
__device__ __forceinline__ void gemm_phase(LAS unsigned char* lds, const char* Abase, const int K, const Sched& S, const Epi& E, const int tid_in) {
    int tid_ = tid_in; asm volatile("" : "+v"(tid_));
    const int tid = tid_, wid = __builtin_amdgcn_readfirstlane(tid >> 6), lane = tid & 63, wr = wid >> 2, wc = wid & 3, fr = lane & 15, fq = lane >> 4;
    const int rowbytes = K * ESZ, nt = rowbytes / 128;
    int Rr[2], Cc[2]; unsigned voffB[2], voffA[2];
#pragma unroll
    for (int i = 0; i < 2; ++i) { int R, C; stage_rc(tid * 16 + i * 8192, R, C); Rr[i] = R; Cc[i] = C; const int Rb = Epi::PERM ? (64 * (R >> 5) + 16 * ((R >> 2) & 3) + 4 * ((R >> 4) & 1) + (R & 3)) : R; voffB[i] = (unsigned)(Rb * rowbytes + C * 2); voffA[i] = (unsigned)(R * rowbytes + C * 2); }
    constexpr bool GATHER = Sched::GATHER;
    const size_t kstep = (size_t)128;
    const size_t hstep = (size_t)HALF * rowbytes;
    const size_t bhstep = (size_t)(Epi::PERM ? 8 : HALF) * rowbytes;
    const unsigned ldsw = (unsigned)wid * 1024u;
    const int aoff = lds_byte(wr * 64 + fr, fq * 8);
    const int boff = lds_byte(wc * 32 + fr, fq * 8);
#define PG8_SA(b, h) (((b) * 2 + (h)) * HTB)
#define PG8_SB(b, h) ((4 + (b) * 2 + (h)) * HTB)
#define PG8_STAGE(bufoff, gbase, voff) do { _Pragma("unroll") for (int _i = 0; _i < 2; ++_i) \
        __builtin_amdgcn_global_load_lds((const unsigned*)((const char*)(gbase) + (voff)[_i]), (LAS unsigned*)(lds + (bufoff) + ldsw + _i * 8192), 16, 0, 0); } while (0)
#define PG8_STAGEA(bufoff, uptr, koff, NEXT, h) do { if constexpr (GATHER) { if (NEXT) { const u32x2 _t = *(const LAS u32x2*)(vnslot + 2 * (h)); unsigned _v[2] = {_t.x, _t.y}; PG8_STAGE(bufoff, Abase + (koff), _v); } else { PG8_STAGE(bufoff, Abase + (koff), vc[h]); } } \
        else { PG8_STAGE(bufoff, (uptr) + (size_t)(h) * hstep + (koff), voffA); } } while (0)
#define PG8_LDA(dst, b, h) do { _Pragma("unroll") for (int m = 0; m < 4; ++m) { if constexpr (ESZ == 2) { _Pragma("unroll") for (int k = 0; k < 2; ++k) dst[m].q[k] = *(const LAS bf16x8*)(lds + PG8_SA(b, h) + aoff + m * 2048 + k * 1024); } \
        else dst[m].w = cat8(*(const LAS bf16x8*)(lds + PG8_SA(b, h) + aoff + m * 2048), *(const LAS bf16x8*)(lds + PG8_SA(b, h) + aoff + m * 2048 + 1024)); } } while (0)
#define PG8_LDB(dst, b, h) do { _Pragma("unroll") for (int n = 0; n < 2; ++n) { if constexpr (ESZ == 2) { _Pragma("unroll") for (int k = 0; k < 2; ++k) dst[n].q[k] = *(const LAS bf16x8*)(lds + PG8_SB(b, h) + boff + n * 2048 + k * 1024); } \
        else dst[n].w = cat8(*(const LAS bf16x8*)(lds + PG8_SB(b, h) + boff + n * 2048), *(const LAS bf16x8*)(lds + PG8_SB(b, h) + boff + n * 2048 + 1024)); } } while (0)
#define PG8_MMA(ai, bj, At, Bt) do { __builtin_amdgcn_s_setprio(1); _Pragma("unroll") for (int m = 0; m < 4; ++m) _Pragma("unroll") for (int n = 0; n < 2; ++n) { \
        if constexpr (ESZ == 2) { _Pragma("unroll") for (int k = 0; k < 2; ++k) acc[ai][bj][m][n] = __builtin_amdgcn_mfma_f32_16x16x32_bf16(Bt[n].q[k], At[m].q[k], acc[ai][bj][m][n], 0, 0, 0); } \
        else { asm volatile("v_mfma_f32_16x16x128_f8f6f4 %0, %1, %2, %0" : "+v"(acc[ai][bj][m][n]) : "v"(Bt[n].w), "v"(At[m].w)); } } \
        __builtin_amdgcn_s_setprio(0); } while (0)
#define PG8_WAIT_V(n) asm volatile("s_waitcnt vmcnt(" #n ")" ::: "memory")
#define PG8_WAIT_L(n) asm volatile("s_waitcnt lgkmcnt(" #n ")" ::: "memory")
#define PG8_BAR __builtin_amdgcn_s_barrier()
#define PG8_SCHED __builtin_amdgcn_sched_barrier(0)
    Unit cur, nxt; int ui = 0; bool fresh_cur = true;
    if (!S.next(0, cur)) return;
    f32x4 acc[2][2][4][2];
    union Frag { bf16x8 q[2]; i32x8 w; };
    Frag At[4], B0[2], B1[2];
    unsigned vc[2][2];
    LAS unsigned* vnslot = (LAS unsigned*)(lds + (VN_OFF - 0)) + tid * 4;
    if constexpr (GATHER) S.avoff(cur, Rr, Cc, vc, tid);
    LAS unsigned* rowtab = (LAS unsigned*)(lds + ROWTAB_OFF);
    if constexpr (GATHER) S.rowtab(cur, rowtab, tid);
    const char* cB = cur.B; const char* cA = Abase + S.aoff(cur);
    PG8_STAGE(PG8_SB(0, 0), cB, voffB); PG8_STAGE(PG8_SB(0, 1), cB + bhstep, voffB); PG8_STAGEA(PG8_SA(0, 0), cA, 0, false, 0); PG8_STAGEA(PG8_SA(0, 1), cA, 0, false, 1);
    if (wr == 1) PG8_BAR;
    PG8_WAIT_V(2); PG8_BAR;
    PG8_STAGE(PG8_SB(1, 0), cB + kstep, voffB); PG8_STAGEA(PG8_SA(1, 0), cA, kstep, false, 0); PG8_STAGE(PG8_SB(1, 1), cB + bhstep + kstep, voffB);
    PG8_WAIT_V(6); PG8_BAR;
    asm volatile("" ::: "memory");
#pragma unroll
    for (int a = 0; a < 2; ++a)
#pragma unroll
        for (int b = 0; b < 2; ++b)
#pragma unroll
            for (int m = 0; m < 4; ++m)
#pragma unroll
                for (int n = 0; n < 2; ++n) { acc[a][b][m][n] = (f32x4){0.f, 0.f, 0.f, 0.f}; asm volatile("" : "+v"(acc[a][b][m][n])); }
    asm volatile("s_nop 4" ::: "memory");
    for (;;) {
        const bool has_next = S.next(ui + 1, nxt);
        if constexpr (GATHER) {
            unsigned vn[2][2];
            if (has_next) S.avoff(nxt, Rr, Cc, vn, tid);
            else {
#pragma unroll
                for (int h = 0; h < 2; ++h)
#pragma unroll
                    for (int i = 0; i < 2; ++i) vn[h][i] = vc[h][i];
            }
            *(LAS u32x4*)vnslot = (u32x4){vn[0][0], vn[0][1], vn[1][0], vn[1][1]};
            if (has_next) S.rowtab(nxt, rowtab + 512 * ((ui + 1) % 3), tid);
        }
        const char* nB = has_next ? nxt.B : cB; const char* nA = has_next ? Abase + S.aoff(nxt) : cA;
        const bool fresh_nxt = !(AREUSE && has_next && nxt.e == cur.e && nxt.pm == cur.pm);
        const bool ff = fresh_cur && fresh_nxt;
#define PG8_WAITX do { if (!AREUSE || ff) PG8_WAIT_V(8); else PG8_WAIT_V(4); } while (0)
        for (int t = 0; t < nt; t += 2) {
            const bool last = (t == nt - 2);
            const size_t k1 = (size_t)(t + 1) * kstep;
            const size_t k2 = last ? (size_t)0 : (size_t)(t + 2) * kstep, k3 = k2 + kstep;
            const char* u2 = last ? nA : cA; const char* b2 = last ? nB : cB + (size_t)(t + 2) * kstep;
            const char* b3 = b2 + kstep;
            PG8_LDB(B0, 0, 0); PG8_LDB(B1, 0, 1); PG8_SCHED; PG8_LDA(At, 0, 0); if (!AREUSE || fresh_cur) PG8_STAGEA(PG8_SA(1, 1), cA, k1, false, 1);
            PG8_WAITX; PG8_WAIT_L(0); PG8_BAR; PG8_MMA(0, 0, At, B0); PG8_MMA(0, 1, At, B1); PG8_BAR; PG8_SCHED;
            PG8_LDA(At, 0, 1); PG8_STAGE(PG8_SB(0, 0), b2, voffB); PG8_STAGE(PG8_SB(0, 1), b2 + bhstep, voffB); if (!AREUSE || fresh_nxt) PG8_STAGEA(PG8_SA(0, 0), u2, k2, last, 0);
            PG8_WAITX; PG8_WAIT_L(0); PG8_BAR; PG8_MMA(1, 0, At, B0); PG8_MMA(1, 1, At, B1); PG8_BAR; PG8_SCHED;
            PG8_LDB(B0, 1, 0); PG8_LDB(B1, 1, 1); PG8_SCHED; PG8_LDA(At, 1, 0); if (!AREUSE || fresh_nxt) PG8_STAGEA(PG8_SA(0, 1), u2, k2, last, 1);
            PG8_WAITX; PG8_WAIT_L(0); PG8_BAR; PG8_MMA(0, 0, At, B0); PG8_MMA(0, 1, At, B1); PG8_BAR; PG8_SCHED;
            PG8_LDA(At, 1, 1); PG8_STAGE(PG8_SB(1, 0), b3, voffB); PG8_STAGE(PG8_SB(1, 1), b3 + bhstep, voffB); if (!AREUSE || fresh_nxt) PG8_STAGEA(PG8_SA(1, 0), u2, k3, last, 0);
            PG8_WAITX; PG8_WAIT_L(0); PG8_BAR; PG8_MMA(1, 0, At, B0); PG8_MMA(1, 1, At, B1); PG8_BAR; PG8_SCHED;
        }
#undef PG8_WAITX
        if (wr == 0) PG8_BAR;
        if constexpr (ESZ == 1) {
            asm volatile("s_nop 15\n\ts_nop 15" ::: "memory");
#pragma unroll
            for (int a = 0; a < 2; ++a)
#pragma unroll
                for (int b = 0; b < 2; ++b)
#pragma unroll
                    for (int m = 0; m < 4; ++m) asm volatile("" : "+v"(acc[a][b][m][0]), "+v"(acc[a][b][m][1]));
        }
        { const int l2 = lane_id(); E(acc, cur, wr, wc, l2 & 15, l2 >> 4, rowtab + 512 * (ui % 3)); }
        if (!has_next) break;
#pragma unroll
        for (int a = 0; a < 2; ++a)
#pragma unroll
            for (int b = 0; b < 2; ++b)
#pragma unroll
                for (int m = 0; m < 4; ++m)
#pragma unroll
                    for (int n = 0; n < 2; ++n) acc[a][b][m][n] = (f32x4){0.f, 0.f, 0.f, 0.f};
        cur = nxt; cB = nB; cA = nA; ++ui; fresh_cur = fresh_nxt;
        if constexpr (GATHER) { const u32x4 _t = *(const LAS u32x4*)vnslot; vc[0][0] = _t.x; vc[0][1] = _t.y; vc[1][0] = _t.z; vc[1][1] = _t.w; }
        if (wr == 1) PG8_BAR;
    }
    PG8_WAIT_V(0);
    PG8_BAR;
#undef PG8_SA
#undef PG8_SB
#undef PG8_STAGE
#undef PG8_STAGEA
#undef PG8_LDA
#undef PG8_LDB
#undef PG8_MMA
#undef PG8_WAIT_V
#undef PG8_WAIT_L
#undef PG8_BAR
#undef PG8_SCHED
}

struct DenseOrder {
    int nM, nN, nwg, G, c, K; const char* Bt;
    __device__ __forceinline__ void init(int Mrows, int N, int K_, const void* Bt_, int G_, int c_) { nM = Mrows / BM; nN = N / BM; nwg = nM * nN; G = G_; c = c_; K = K_; Bt = (const char*)Bt_; }
    __device__ __forceinline__ bool next(int i, Unit& u) const {
        const long L = (long)i * G + c; if (L >= nwg) return false;
        int wgid = (int)L; { const int q = nwg / 8, r = nwg % 8, xcd = wgid % 8, off = wgid / 8; wgid = (xcd < r ? xcd * (q + 1) : r * (q + 1) + (xcd - r) * q) + off; }
        const int nig = 8 * nN, gid = wgid / nig, fm = gid * 8, gsz = (nM - fm) < 8 ? (nM - fm) : 8;
        u.pm = fm + ((wgid % nig) % gsz); u.pn = (wgid % nig) / gsz; u.B = Bt + (size_t)u.pn * BM * K * 2; u.e = 0; u.cnt = 0; u.off = 0; return true;
    }
    static constexpr bool GATHER = false;
    __device__ __forceinline__ size_t aoff(const Unit& u) const { return (size_t)u.pm * BM * K * 2; }
    __device__ __forceinline__ void avoff(const Unit&, const int (&)[2], const int (&)[2], unsigned (&)[2][2], int) const {}
};
struct RowOrder {
    int pm, ncol, K; const char* Bt;
    static constexpr bool GATHER = false;
    __device__ __forceinline__ bool next(int i, Unit& u) const { if (i >= ncol) return false; u.pm = pm; u.pn = i; u.B = Bt + (size_t)i * BM * K * 2; u.e = 0; u.cnt = 0; u.off = 0; return true; }
    __device__ __forceinline__ size_t aoff(const Unit& u) const { return (size_t)u.pm * BM * K * 2; }
    __device__ __forceinline__ void avoff(const Unit&, const int (&)[2], const int (&)[2], unsigned (&)[2][2], int) const {}
};
template <int NCOL, bool TOKROWS, bool TILEMAJOR = false> struct ExpertOrder {
    static constexpr bool GATHER = true;
    __device__ __forceinline__ size_t aoff(const Unit&) const { return 0; }
    const LAS unsigned* tab; int per, c, K  ; const char* W; size_t wstride; const int* slot_ent; const float* slot_w;
    mutable int ehint = 0;
    int xbase, xend, xstride, xlb;
    __device__ __forceinline__ void init(const LAS unsigned* tab_, int K_, const void* W_, size_t wstride_, const int* slot_ent_, const float* slot_w_, int G, int c_) {
        tab = tab_; K = K_; W = (const char*)W_; wstride = wstride_; slot_ent = slot_ent_; slot_w = slot_w_; c = c_;
        const int U = (int)tab[T_TILE + NE] * (TILEMAJOR ? 1 : NCOL); per = (U + G - 1) / G;
        if (G % 8 == 0) { const int x = c_ % 8; const int q = U / 8, r = U % 8; xbase = x * q + (x < r ? x : r); xend = xbase + q + (x < r ? 1 : 0); xstride = G / 8; xlb = c_ / 8; }
        else { xbase = 0; xend = U; xstride = G; xlb = c_; }
    }
    __device__ __forceinline__ bool next(int i, Unit& u) const {
        const int L = TILEMAJOR ? xbase + (i / NCOL) * xstride + xlb : xbase + i * xstride + xlb;
        if (L >= xend) return false;
        const int tile = TILEMAJOR ? L : L / NCOL; u.pn = TILEMAJOR ? i % NCOL : L % NCOL;
        int lo = ehint;
        if (i == 0) { lo = 0; int hi = NE - 1; while (lo < hi) { const int mid = (lo + hi + 1) >> 1; if ((int)tab[T_TILE + mid] <= tile) lo = mid; else hi = mid - 1; } }
        else { while (lo < NE - 1 && (int)tab[T_TILE + lo + 1] <= tile) ++lo; }
        ehint = lo;
        u.e = lo; u.pm = tile - (int)tab[T_TILE + lo]; u.cnt = (int)tab[T_CNT + lo]; u.off = (int)tab[T_OFF + lo];
        u.B = W + (size_t)lo * wstride + (size_t)u.pn * BM * K; return true;
    }
    __device__ __forceinline__ void rowtab(const Unit& u, LAS unsigned* t, int tid) const {
        if (tid < BM) { int r = u.pm * BM + tid; if (r >= u.cnt) r = u.cnt - 1; t[tid] = (unsigned)slot_ent[u.off + r]; t[BM + tid] = __float_as_uint(slot_w[u.off + r]); }
    }
    __device__ __forceinline__ void avoff(const Unit& u, const int (&)[2], const int (&)[2], unsigned (&v)[2][2], int tidq) const {
        int R[2], C[2]; asm volatile("" : "+v"(tidq));
#pragma unroll
        for (int i = 0; i < 2; ++i) stage_rc(tidq * 16 + i * 8192, R[i], C[i]);
#pragma unroll
        for (int h = 0; h < 2; ++h)
#pragma unroll
            for (int i = 0; i < 2; ++i) {
                int r = u.pm * BM + h * HALF + R[i]; if (r >= u.cnt) r = u.cnt - 1;
                const int slot = u.off + r;
                const int row = TOKROWS ? (slot_ent[slot] >> 3) : slot;
                v[h][i] = (unsigned)(row * K + C[i] * 2);
            }
    }
};

struct EpiInProj {
    static constexpr bool PERM = true; bf16_t* O;
    __device__ __forceinline__ void operator()(const f32x4 (&acc)[2][2][4][2], const Unit& u, int wr, int wc, int fr, int fq, const LAS unsigned* rt) const {
        const float sc = INV_IN8 * ((u.pn < 2) ? 0.125f : ((u.pn == 8 || u.pn == 9) ? 0.08838834764831845f : 1.f));
        const int row0 = u.pm * BM + wr * 64 + fr, col0 = u.pn * BM + wc * 64 + 16 * fq;
#pragma unroll
        for (int ai = 0; ai < 2; ++ai)
#pragma unroll
            for (int m = 0; m < 4; ++m) { bf16_t* rowp = O + (size_t)(row0 + ai * HALF + m * 16) * DIN + col0;
#pragma unroll
                for (int bj = 0; bj < 2; ++bj) { const f32x4 v0 = acc[ai][bj][m][0] * sc, v1 = acc[ai][bj][m][1] * sc;
                    u32x4 w; w.x = cvt_pk_bf16(v0[0], v0[1]); w.y = cvt_pk_bf16(v0[2], v0[3]); w.z = cvt_pk_bf16(v1[0], v1[1]); w.w = cvt_pk_bf16(v1[2], v1[3]);
                    *(u32x4*)(rowp + 8 * bj) = w; } }
    }
};
struct EpiOutProj {
    static constexpr bool PERM = true; const float* x; const float* mod; bf16_t* tb;
    __device__ __forceinline__ void operator()(const f32x4 (&acc)[2][2][4][2], const Unit& u, int wr, int wc, int fr, int fq, const LAS unsigned* rt) const {
        const int b = (u.pm * BM) >> 11; const int col0 = u.pn * BM + wc * 64 + 16 * fq;
        f32x4 g[2][2];
#pragma unroll
        for (int bj = 0; bj < 2; ++bj)
#pragma unroll
            for (int n = 0; n < 2; ++n) g[bj][n] = *(const f32x4*)(mod + b * 6144 + MOD_GATE_A + col0 + 8 * bj + 4 * n);
#pragma unroll
        for (int ai = 0; ai < 2; ++ai)
#pragma unroll
            for (int m = 0; m < 4; ++m) { const size_t o = (size_t)(u.pm * BM + ai * HALF + wr * 64 + m * 16 + fr) * D + col0;
#pragma unroll
                for (int bj = 0; bj < 2; ++bj) {
                    const f32x4 t0 = *(const f32x4*)(x + o + 8 * bj) * ALPHA + g[bj][0] * acc[ai][bj][m][0], t1 = *(const f32x4*)(x + o + 8 * bj + 4) * ALPHA + g[bj][1] * acc[ai][bj][m][1];
                    u32x4 w; w.x = cvt_pk_bf16(t0[0], t0[1]); w.y = cvt_pk_bf16(t0[2], t0[3]); w.z = cvt_pk_bf16(t1[0], t1[1]); w.w = cvt_pk_bf16(t1[2], t1[3]);
                    *(u32x4*)(tb + o + 8 * bj) = w; } }
    }
};
struct EpiRouter {
    static constexpr bool PERM = false; float* out;
    __device__ __forceinline__ void operator()(const f32x4 (&acc)[2][2][4][2], const Unit& u, int wr, int wc, int fr, int fq, const LAS unsigned* rt) const {
        const int col0 = wc * 32 + 4 * fq;
#pragma unroll
        for (int ai = 0; ai < 2; ++ai)
#pragma unroll
            for (int m = 0; m < 4; ++m) { float* rowp = out + (size_t)(u.pm * BM + ai * HALF + wr * 64 + m * 16 + fr) * NE + col0;
#pragma unroll
                for (int bj = 0; bj < 2; ++bj)
#pragma unroll
                    for (int n = 0; n < 2; ++n) *(f32x4*)(rowp + bj * HALF + n * 16) = acc[ai][bj][m][n]; }
    }
};
template <bool EXPERT> struct EpiGU {
    static constexpr bool PERM = true; void* Ov;
    __device__ __forceinline__ void operator()(const f32x4 (&acc)[2][2][4][2], const Unit& u, int wr, int wc, int fr, int fq, const LAS unsigned* rt) const {
        const int h0 = u.pn * HALF + wc * 32 + 8 * fq;
#pragma unroll
        for (int ai = 0; ai < 2; ++ai)
#pragma unroll
            for (int m = 0; m < 4; ++m) {
                const int rtw = u.pm * BM + ai * HALF + wr * 64 + m * 16 + fr;
                if (EXPERT) { if (rtw >= u.cnt) continue; }
                const float w = EXPERT ? __uint_as_float(rt[BM + ai * HALF + wr * 64 + m * 16 + fr]) * (S_ACT8 * INV_GU8) : 1.f;
                const float gs = EXPERT ? INV_GU8 : 1.f;
                const f32x4 g0 = acc[ai][0][m][0] * gs, g1 = acc[ai][0][m][1] * gs, u0 = acc[ai][1][m][0], u1 = acc[ai][1][m][1];
                const float h[8] = {w * silu_f(g0[0]) * u0[0], w * silu_f(g0[1]) * u0[1], w * silu_f(g0[2]) * u0[2], w * silu_f(g0[3]) * u0[3],
                                    w * silu_f(g1[0]) * u1[0], w * silu_f(g1[1]) * u1[1], w * silu_f(g1[2]) * u1[2], w * silu_f(g1[3]) * u1[3]};
                if (EXPERT) {
                    int w0 = __builtin_amdgcn_cvt_pk_fp8_f32(clamp8(h[0]), clamp8(h[1]), 0, false); w0 = __builtin_amdgcn_cvt_pk_fp8_f32(clamp8(h[2]), clamp8(h[3]), w0, true);
                    int w1 = __builtin_amdgcn_cvt_pk_fp8_f32(clamp8(h[4]), clamp8(h[5]), 0, false); w1 = __builtin_amdgcn_cvt_pk_fp8_f32(clamp8(h[6]), clamp8(h[7]), w1, true);
                    u32x2 o; o.x = (unsigned)w0; o.y = (unsigned)w1; *(u32x2*)((unsigned char*)Ov + (size_t)(u.off + rtw) * DE + h0) = o;
                    asm volatile("" ::: "memory");
                } else {
                    u32x4 o; o.x = cvt_pk_bf16(h[0], h[1]); o.y = cvt_pk_bf16(h[2], h[3]); o.z = cvt_pk_bf16(h[4], h[5]); o.w = cvt_pk_bf16(h[6], h[7]);
                    *(u32x4*)((bf16_t*)Ov + (size_t)rtw * DE + h0) = o;
                }
            }
    }
};
struct EpiSharedDown {
    static constexpr bool PERM = true; unsigned char* ysh;
    __device__ __forceinline__ void operator()(const f32x4 (&acc)[2][2][4][2], const Unit& u, int wr, int wc, int fr, int fq, const LAS unsigned* rt) const {
        const int col0 = u.pn * BM + wc * 64 + 16 * fq;
#pragma unroll
        for (int ai = 0; ai < 2; ++ai)
#pragma unroll
            for (int m = 0; m < 4; ++m) {
                u32x4 o;
#pragma unroll
                for (int bj = 0; bj < 2; ++bj) { const f32x4 v0 = acc[ai][bj][m][0] * YSCALE, v1 = acc[ai][bj][m][1] * YSCALE;
                    int w0 = __builtin_amdgcn_cvt_pk_fp8_f32(clamp8(v0[0]), clamp8(v0[1]), 0, false); w0 = __builtin_amdgcn_cvt_pk_fp8_f32(clamp8(v0[2]), clamp8(v0[3]), w0, true);
                    int w1 = __builtin_amdgcn_cvt_pk_fp8_f32(clamp8(v1[0]), clamp8(v1[1]), 0, false); w1 = __builtin_amdgcn_cvt_pk_fp8_f32(clamp8(v1[2]), clamp8(v1[3]), w1, true);
                    if (bj == 0) { o.x = (unsigned)w0; o.y = (unsigned)w1; } else { o.z = (unsigned)w0; o.w = (unsigned)w1; } }
                *(u32x4*)(ysh + (size_t)(u.pm * BM + ai * HALF + wr * 64 + m * 16 + fr) * D + col0) = o;
            }
    }
};
struct EpiExpDown {
    static constexpr bool PERM = true; unsigned char* ybuf; const int* slot_ent;
    __device__ __forceinline__ void operator()(const f32x4 (&acc)[2][2][4][2], const Unit& u, int wr, int wc, int fr, int fq, const LAS unsigned* rt) const {
        const int col0 = u.pn * BM + wc * 64 + 16 * fq;
#pragma unroll
        for (int ai = 0; ai < 2; ++ai)
#pragma unroll
            for (int m = 0; m < 4; ++m) {
                const int rtw = u.pm * BM + ai * HALF + wr * 64 + m * 16 + fr; if (rtw >= u.cnt) continue;
                u32x4 o;
#pragma unroll
                for (int bj = 0; bj < 2; ++bj) { const f32x4 v0 = acc[ai][bj][m][0] * (YSCALE * INV_DN8), v1 = acc[ai][bj][m][1] * (YSCALE * INV_DN8);
                    int w0 = __builtin_amdgcn_cvt_pk_fp8_f32(clamp8(v0[0]), clamp8(v0[1]), 0, false); w0 = __builtin_amdgcn_cvt_pk_fp8_f32(clamp8(v0[2]), clamp8(v0[3]), w0, true);
                    int w1 = __builtin_amdgcn_cvt_pk_fp8_f32(clamp8(v1[0]), clamp8(v1[1]), 0, false); w1 = __builtin_amdgcn_cvt_pk_fp8_f32(clamp8(v1[2]), clamp8(v1[3]), w1, true);
                    if (bj == 0) { o.x = (unsigned)w0; o.y = (unsigned)w1; } else { o.z = (unsigned)w0; o.w = (unsigned)w1; } }
                *(u32x4*)(ybuf + (size_t)rt[ai * HALF + wr * 64 + m * 16 + fr] * D + col0) = o;
                asm volatile("" ::: "memory");
            }
    }
};

template <int PMODE = 0, class Sched> __device__ __forceinline__ void down_phase(LAS unsigned char* lds, const char* act8, const Sched& S, unsigned char* ybuf, const int tid_in) {
    int tid_ = tid_in; asm volatile("" : "+v"(tid_));
    const int tid = tid_, wid = __builtin_amdgcn_readfirstlane(tid >> 6), lane = tid & 63, wr = wid >> 2, wc = wid & 3, fr = lane & 15, fq = lane >> 4;
    constexpr int RB = DE;
    int Rr[2]; unsigned voffB[2], cc2[2];
#pragma unroll
    for (int i = 0; i < 2; ++i) { int R, C; stage_rc(tid * 16 + i * 8192, R, C); Rr[i] = R; cc2[i] = (unsigned)(C * 2); const int Rb = (R & ~31) + perm32(R & 31); voffB[i] = (unsigned)(Rb * RB + C * 2); }
    const unsigned ldsw = (unsigned)wid * 1024u;
    const int aoff = lds_byte(wr * 64 + fr, fq * 8), boff = lds_byte(wc * 32 + fr, fq * 8);
#define DN_SA(k, h) (((k) * 2 + (h)) * HTB)
#define DN_SB(z, k) (65536 + ((z) * 2 + (k)) * HTB)
#define DN_STAGE(bufoff, gbase, voff) do { _Pragma("unroll") for (int _i = 0; _i < 2; ++_i) \
        __builtin_amdgcn_global_load_lds((const unsigned*)((const char*)(gbase) + (voff)[_i]), (LAS unsigned*)(lds + (bufoff) + ldsw + _i * 8192), 16, 0, 0); } while (0)
    LAS unsigned* rowtab = (LAS unsigned*)(lds + ROWTAB_OFF);
    Unit cur, nxt; int ti = 0;
    if (!S.next(0, cur)) return;
#define DN_STAGE_A(u) do { unsigned _va[2][2]; _Pragma("unroll") for (int _h = 0; _h < 2; ++_h) _Pragma("unroll") for (int _i = 0; _i < 2; ++_i) { int _r = (u).pm * BM + _h * HALF + Rr[_i]; if (_r >= (u).cnt) _r = (u).cnt - 1; _va[_h][_i] = (unsigned)(((u).off + _r) * RB) + cc2[_i]; } \
        _Pragma("unroll") for (int _k = 0; _k < 2; ++_k) _Pragma("unroll") for (int _h = 0; _h < 2; ++_h) DN_STAGE(DN_SA(_k, _h), act8 + _k * 128, _va[_h]); } while (0)
#define DN_STAGE_B(u, s_, z_) do { const char* _b = (u).B + (size_t)(s_) * (HALF * RB); _Pragma("unroll") for (int _k = 0; _k < 2; ++_k) DN_STAGE(DN_SB(z_, _k), _b + _k * 128, voffB); } while (0)
#define DN_ROWTAB(u, par) do { if (tid < BM) { int _r = (u).pm * BM + tid; if (_r >= (u).cnt) _r = (u).cnt - 1; rowtab[(par) * BM + tid] = (PMODE == 1) ? (unsigned)((u).off + _r) : (unsigned)S.slot_ent[(u).off + _r]; } } while (0)
    DN_STAGE_A(cur); DN_ROWTAB(cur, 0); DN_STAGE_B(cur, 0, 0);
    f32x4 acc[2][2][4][2];
    union Frag { bf16x8 q[2]; i32x8 w; };
    int gs = 0;
    Unit prev = cur; int prev_s = -1, prev_par = 0;
#define DN_EPILOGUE(set, u, s_, par) do { const int _col0 = (s_) * HALF + wc * 32 + 8 * fq; \
        _Pragma("unroll") for (int _ai = 0; _ai < 2; ++_ai) _Pragma("unroll") for (int _m = 0; _m < 4; ++_m) { const int _rt = _ai * HALF + wr * 64 + _m * 16 + fr; \
            { const f32x4 _v0 = acc[set][_ai][_m][0] * (YSCALE * INV_DN8), _v1 = acc[set][_ai][_m][1] * (YSCALE * INV_DN8);   \
                int _w0 = __builtin_amdgcn_cvt_pk_fp8_f32(clamp8(_v0[0]), clamp8(_v0[1]), 0, false); _w0 = __builtin_amdgcn_cvt_pk_fp8_f32(clamp8(_v0[2]), clamp8(_v0[3]), _w0, true); \
                int _w1 = __builtin_amdgcn_cvt_pk_fp8_f32(clamp8(_v1[0]), clamp8(_v1[1]), 0, false); _w1 = __builtin_amdgcn_cvt_pk_fp8_f32(clamp8(_v1[2]), clamp8(_v1[3]), _w1, true); \
                u32x2 _o; _o.x = (unsigned)_w0; _o.y = (unsigned)_w1; if (PMODE != 2 || (_w0 == 0x12345678 && _w1 == 0x31415926)) *(u32x2*)(ybuf + (size_t)rowtab[(par) * BM + _rt] * D + _col0) = _o; } } } while (0)
    for (;;) {
        const bool has_next = S.next(ti + 1, nxt);
        const int par = ti & 1;
#pragma unroll 1
        for (int s2 = 0; s2 < 8; s2 += 2) {
#pragma unroll
            for (int sb = 0; sb < 2; ++sb) {
                const int s = s2 + sb; const int z = sb;
                if (s == 0) asm volatile("s_waitcnt vmcnt(0)" ::: "memory");
                else if (PMODE == 2) asm volatile("s_waitcnt vmcnt(0)" ::: "memory");
                else asm volatile("s_waitcnt vmcnt(8)" ::: "memory");
                __builtin_amdgcn_s_barrier();
                asm volatile("" ::: "memory");
                if (s < 7) DN_STAGE_B(cur, s + 1, z ^ 1); else if (has_next) DN_STAGE_B(nxt, 0, z ^ 1);
                if (wr == 1 && prev_s >= 0) { asm volatile("s_nop 15" ::: "memory"); DN_EPILOGUE(sb ^ 1, prev, prev_s, prev_par); }
#pragma unroll
                for (int ai = 0; ai < 2; ++ai)
#pragma unroll
                    for (int m = 0; m < 4; ++m)
#pragma unroll
                        for (int n = 0; n < 2; ++n) acc[sb][ai][m][n] = (f32x4){0.f, 0.f, 0.f, 0.f};
                asm volatile("s_nop 4" ::: "memory");
#pragma unroll
                for (int k = 0; k < 2; ++k) {
                    Frag Bf[2];
#pragma unroll
                    for (int n = 0; n < 2; ++n) Bf[n].w = cat8(*(const LAS bf16x8*)(lds + DN_SB(z, k) + boff + n * 2048), *(const LAS bf16x8*)(lds + DN_SB(z, k) + boff + n * 2048 + 1024));
#pragma unroll
                    for (int ai = 0; ai < 2; ++ai) {
                        Frag Af[4];
#pragma unroll
                        for (int m = 0; m < 4; ++m) Af[m].w = cat8(*(const LAS bf16x8*)(lds + DN_SA(k, ai) + aoff + m * 2048), *(const LAS bf16x8*)(lds + DN_SA(k, ai) + aoff + m * 2048 + 1024));
#pragma unroll
                        for (int m = 0; m < 4; ++m)
#pragma unroll
                            for (int n = 0; n < 2; ++n) asm volatile("v_mfma_f32_16x16x128_f8f6f4 %0, %1, %2, %0" : "+v"(acc[sb][ai][m][n]) : "v"(Bf[n].w), "v"(Af[m].w));
                    }
                }
                if (wr == 0 && prev_s >= 0) DN_EPILOGUE(sb ^ 1, prev, prev_s, prev_par);
                prev = cur; prev_s = s; prev_par = par;
            }
        }
        if (!has_next) break;
        asm volatile("s_waitcnt lgkmcnt(0)" ::: "memory");
        __builtin_amdgcn_s_barrier();
        DN_STAGE_A(nxt); DN_ROWTAB(nxt, par ^ 1);
        cur = nxt; ++ti;
    }
    asm volatile("s_nop 15\n\ts_nop 15" ::: "memory");
    DN_EPILOGUE(1, prev, prev_s, prev_par);
    asm volatile("s_waitcnt vmcnt(0) lgkmcnt(0)" ::: "memory");
    __builtin_amdgcn_s_barrier();
#undef DN_SA
#undef DN_SB
#undef DN_STAGE
#undef DN_STAGE_A
#undef DN_STAGE_B
#undef DN_ROWTAB
#undef DN_EPILOGUE
}
constexpr int T_P64 = T_HIST;
template <int PMODE = 0> __device__ __forceinline__ void down2_phase(LAS unsigned char* lds, LAS unsigned* tab, const char* act8, const char* wd, const int* slot_ent, unsigned char* ybuf, const int G, const int bx, const int tid_in) {
    int tid_ = tid_in; asm volatile("" : "+v"(tid_));
    const int tid = tid_, wid = __builtin_amdgcn_readfirstlane(tid >> 6), lane = tid & 63, wr = wid >> 2, wc = wid & 3, fr = lane & 15, fq = lane >> 4;
    constexpr int NS = 8, PD = 7, PB = 16384;
    if (tid < 64) {
        unsigned c[4], sp = 0;
#pragma unroll
        for (int j = 0; j < 4; ++j) { c[j] = (tab[T_CNT + lane * 4 + j] + 63u) >> 6; sp += c[j]; }
        unsigned ip = sp;
#pragma unroll
        for (int o = 1; o < 64; o <<= 1) { const unsigned a = __shfl_up(ip, o); if (lane >= o) ip += a; }
        unsigned ep = ip - sp;
#pragma unroll
        for (int j = 0; j < 4; ++j) { tab[T_P64 + lane * 4 + j] = ep; ep += c[j]; }
        if (lane == 63) tab[T_P64 + NE] = ep;
    }
    __syncthreads();
    int g, q; const int NG = G >> 2;
    if (G % 32 == 0) { const int x = bx % 8, i = bx / 8; g = x * (G / 32) + (i >> 2); q = i & 3; } else { g = bx >> 2; q = bx & 3; }
    const int NP = (int)tab[T_P64 + NE];
    const int p_lo = g < NG ? (int)((long long)g * NP / NG) : 0, p_hi = g < NG ? (int)((long long)(g + 1) * NP / NG) : 0;
    if (p_lo < p_hi) {
    int R0, C0; stage_rc(tid * 16, R0, C0);
    const unsigned ldsw = (unsigned)wid * 1024u;
    const int aoff = lds_byte(wr * 32 + fr, fq * 8);
    LAS unsigned* rowtab = (LAS unsigned*)(lds + VN_OFF);
    int e0 = 0; { int hi = NE - 1; while (e0 < hi) { const int mid = (e0 + hi + 1) >> 1; if ((int)tab[T_P64 + mid] <= p_lo) e0 = mid; else hi = mid - 1; } }
    int e2 = e0, nb2 = (int)tab[T_P64 + e0 + 1];
    int e = -1, nb = p_lo;
#define D2_STAGE(pp_, it_) do { const int _pp = (pp_) < p_hi ? (pp_) : p_hi - 1; \
        while (_pp >= nb2) { ++e2; nb2 = (int)tab[T_P64 + e2 + 1]; } \
        const int _off = (int)tab[T_OFF + e2], _cnt = (int)tab[T_CNT + e2], _r0 = (_pp - (int)tab[T_P64 + e2]) * 64; \
        int _r = _r0 + R0; if (_r >= _cnt) _r = _cnt - 1; int _rr = _r0 + lane; if (_rr >= _cnt) _rr = _cnt - 1; \
        const char* _a = act8 + (size_t)(unsigned)((_off + _r) * DE + C0 * 2); const unsigned _zb = (unsigned)((it_) & (NS - 1)) * PB; \
        __builtin_amdgcn_global_load_lds((const unsigned*)_a, (LAS unsigned*)(lds + _zb + ldsw), 16, 0, 0); \
        __builtin_amdgcn_global_load_lds((const unsigned*)(_a + 128), (LAS unsigned*)(lds + _zb + 8192 + ldsw), 16, 0, 0); \
        __builtin_amdgcn_global_load_lds((const unsigned*)(slot_ent + _off + _rr), rowtab + ((it_) & 15) * 64, 4, 0, 0); } while (0)
    union Frag { bf16x8 q2[2]; i32x8 w; };
    Frag Bf[2][4], Af[2][2][2];
    f32x4 acc[2][2][4];
#define D2_CVT(v_) ({ const f32x4 _v = (v_) * (YSCALE * INV_DN8); int _w = __builtin_amdgcn_cvt_pk_fp8_f32(clamp8(_v[0]), clamp8(_v[1]), 0, false); (unsigned)__builtin_amdgcn_cvt_pk_fp8_f32(clamp8(_v[2]), clamp8(_v[3]), _w, true); })
#define D2_OUT(dst_, o_) do { if (PMODE == 0 || ((o_).x == 0x12345678u && (o_).y == 0x31415926u && (dst_) < (unsigned)NSLOT)) *(u32x4*)(ybuf + (size_t)(dst_) * D + (q * 256 + wc * 64 + 16 * fq)) = (o_); } while (0)
#define D2_EPILOGUE(set, ip_) do { _Pragma("unroll") for (int _m = 0; _m < 2; ++_m) { \
            const unsigned _dst = rowtab[((ip_) & 15) * 64 + wr * 32 + _m * 16 + fr]; u32x4 _o; \
            _Pragma("unroll") for (int _n = 0; _n < 4; ++_n) _o[_n] = D2_CVT(acc[set][_m][_n]); \
            D2_OUT(_dst, _o); } } while (0)
#define D2_READA(par, it_) do { const unsigned _zb = (unsigned)((it_) & (NS - 1)) * PB; _Pragma("unroll") for (int _k = 0; _k < 2; ++_k) _Pragma("unroll") for (int _m = 0; _m < 2; ++_m) \
        Af[par][_k][_m].w = cat8(*(const LAS bf16x8*)(lds + _zb + _k * 8192 + aoff + _m * 2048), *(const LAS bf16x8*)(lds + _zb + _k * 8192 + aoff + _m * 2048 + 1024)); } while (0)
#define D2_MFMA0(sb, m, n) asm volatile("v_mfma_f32_16x16x128_f8f6f4 %0, %1, %2, 0" : "=&v"(acc[sb][m][n]) : "v"(Bf[0][n].w), "v"(Af[sb][0][m].w))
#define D2_MFMA1(sb, m, n) asm volatile("v_mfma_f32_16x16x128_f8f6f4 %0, %1, %2, %0" : "+v"(acc[sb][m][n]) : "v"(Bf[1][n].w), "v"(Af[sb][1][m].w))
#define D2_PAIR(MF, sb, m, n0, EPI, om, on, ov) do { MF(sb, m, n0); MF(sb, m, n0 + 1); if (EPI && PMODE < 5) (ov)[on] = D2_CVT(acc[(sb) ^ 1][om][on]); __builtin_amdgcn_sched_barrier(0); } while (0)
#define D2_PIECE(sb, i_, EPI) do { const int _i = (i_); \
        if (_i < PD - 1 || PMODE != 0) asm volatile("s_waitcnt vmcnt(15)" ::: "memory");        \
        else asm volatile("s_waitcnt vmcnt(25)" ::: "memory");                                    \
        if (PMODE != 5) __builtin_amdgcn_s_barrier();                      \
        asm volatile("" ::: "memory"); \
        if (PMODE != 3 && PMODE != 5 && PMODE != 6) D2_STAGE(p_lo + _i + PD, _i + PD);                 \
        if (p_lo + _i >= nb) {                                             \
            do { ++e; nb = (int)tab[T_P64 + e + 1]; } while (p_lo + _i >= nb); \
            const __attribute__((address_space(1))) char* wb = (const __attribute__((address_space(1))) char*)(wd + ((size_t)e * D + q * 256 + wc * 64 + 16 * (fr >> 2) + (fr & 3)) * DE + 16 * fq); \
            _Pragma("unroll") for (int _k = 0; _k < 2; ++_k) _Pragma("unroll") for (int _n = 0; _n < 4; ++_n) \
                Bf[_k][_n].w = cat8(*(const __attribute__((address_space(1))) bf16x8*)(wb + _n * 4 * DE + _k * 128), *(const __attribute__((address_space(1))) bf16x8*)(wb + _n * 4 * DE + _k * 128 + 64)); \
            _Pragma("unroll") for (int _k = 0; _k < 2; ++_k) _Pragma("unroll") for (int _n = 0; _n < 4; ++_n) asm volatile("" : "+v"(Bf[_k][_n].w));     \
        } \
        if (PMODE != 5) D2_READA((sb) ^ 1, _i + 1); \
        unsigned _d0 = 0, _d1 = 0; u32x4 _o0, _o1; \
        __builtin_amdgcn_sched_barrier(0); \
        D2_PAIR(D2_MFMA0, sb, 0, 0, EPI, 0, 0, _o0); D2_PAIR(D2_MFMA0, sb, 0, 2, EPI, 0, 1, _o0); \
        if (EPI && PMODE < 5) { _d0 = rowtab[((_i - 1) & 15) * 64 + wr * 32 + fr]; _d1 = rowtab[((_i - 1) & 15) * 64 + wr * 32 + 16 + fr]; }     \
        __builtin_amdgcn_sched_barrier(0); \
        D2_PAIR(D2_MFMA0, sb, 1, 0, EPI, 0, 2, _o0); D2_PAIR(D2_MFMA0, sb, 1, 2, EPI, 0, 3, _o0); \
        if (EPI && PMODE < 5) D2_OUT(_d0, _o0); \
        D2_PAIR(D2_MFMA1, sb, 0, 0, EPI, 1, 0, _o1); D2_PAIR(D2_MFMA1, sb, 0, 2, EPI, 1, 1, _o1); D2_PAIR(D2_MFMA1, sb, 1, 0, EPI, 1, 2, _o1); D2_PAIR(D2_MFMA1, sb, 1, 2, EPI, 1, 3, _o1); \
        if (EPI && PMODE < 5) D2_OUT(_d1, _o1); \
    } while (0)
#pragma unroll 1
    for (int j = 0; j < PD; ++j) D2_STAGE(p_lo + j, j);
    const int n_it = p_hi - p_lo;
    asm volatile("s_waitcnt vmcnt(18)" ::: "memory");
    __builtin_amdgcn_s_barrier();
    asm volatile("" ::: "memory");
    D2_READA(0, 0);
    D2_PIECE(0, 0, false);
#pragma unroll 1
    for (int i2 = 1; i2 < n_it; i2 += 2) {
        D2_PIECE(1, i2, true);
        if (i2 + 1 < n_it) D2_PIECE(0, i2 + 1, true);
    }
    asm volatile("s_nop 15\n\ts_nop 15" ::: "memory");
    if (n_it & 1) D2_EPILOGUE(0, n_it - 1); else D2_EPILOGUE(1, n_it - 1);
#undef D2_CVT
#undef D2_OUT
#undef D2_READA
#undef D2_MFMA0
#undef D2_MFMA1
#undef D2_PAIR
#undef D2_PIECE
#undef D2_STAGE
#undef D2_EPILOGUE
    }
    asm volatile("s_waitcnt vmcnt(0) lgkmcnt(0)" ::: "memory");
    __builtin_amdgcn_s_barrier();
}
struct EpiProbeSum {
    static constexpr bool PERM = true; float* o;
    __device__ __forceinline__ void operator()(const f32x4 (&acc)[2][2][4][2], const Unit& u, int wr, int wc, int fr, int fq, const LAS unsigned* rt) const {
        f32x4 s = (f32x4){0.f, 0.f, 0.f, 0.f};
#pragma unroll
        for (int a = 0; a < 2; ++a)
#pragma unroll
            for (int b = 0; b < 2; ++b)
#pragma unroll
                for (int m = 0; m < 4; ++m) s += acc[a][b][m][0] + acc[a][b][m][1];
        if (s.x == 123.456f) *(f32x4*)(o + (size_t)(blockIdx.x * 512 + wr * 256 + wc * 64 + fq * 16 + fr) * 4) = s;
    }
};
}

struct Ctx {
    const float *x, *c, *w_ada, *b_ada, *w_in, *w_out, *na_rpb, *ret_ld, *ret_gn, *ln1_g, *ln1_b, *ln2_g, *ln2_b, *w_router, *rbias, *w_gate, *w_up, *w_down, *ws_gate, *ws_up, *ws_down;
    float* out; unsigned char* ws;
};
constexpr int NW = 8;

__device__ __forceinline__ void transpose_item(const float* W, int K, int N, bf16_t* WT, int G, int which, LAS float* scr, int item, int lane) {
    const int nblk = N / 32, kb = item / nblk, nb = item % nblk, k0 = 64 * kb, n0 = 32 * nb;
    float v[32];
#pragma unroll
    for (int i = 0; i < 32; ++i) { const int kk = 2 * i + (lane >> 5); v[i] = __builtin_nontemporal_load(W + (size_t)(k0 + kk) * N + n0 + (lane & 31)); }
#pragma unroll
    for (int i = 0; i < 32; ++i) { const int kk = 2 * i + (lane >> 5); scr[kk * 33 + (lane & 31)] = v[i]; }
    LDS_WAIT(); asm volatile("" ::: "memory");
    const int c = lane & 7;
#pragma unroll
    for (int j = 0; j < 4; ++j) { const int n = (lane >> 3) + 8 * j; const LAS float* s = scr + (8 * c) * 33 + n;
        u32x4 o; o.x = pk2(s[0 * 33], s[1 * 33]); o.y = pk2(s[2 * 33], s[3 * 33]); o.z = pk2(s[4 * 33], s[5 * 33]); o.w = pk2(s[6 * 33], s[7 * 33]);
        const int ng = n0 + n; const int drow = (G == 0) ? ng : ((ng / G) * 2 * G + which * G + (ng % G));
        *(u32x4*)(WT + (size_t)drow * K + k0 + 8 * c) = o; }
    LDS_WAIT(); asm volatile("" ::: "memory");
}
__device__ __forceinline__ void transpose_item_fp8(const float* W, int K, int N, unsigned char* WT, int G, int which, float scale, LAS float* scr, int item, int lane) {
    const int nblk = N / 32, kb = item / nblk, nb = item % nblk, k0 = 64 * kb, n0 = 32 * nb;
    float v[32];
#pragma unroll
    for (int i = 0; i < 32; ++i) { const int kk = 2 * i + (lane >> 5); v[i] = __builtin_nontemporal_load(W + (size_t)(k0 + kk) * N + n0 + (lane & 31)); }
#pragma unroll
    for (int i = 0; i < 32; ++i) { const int kk = 2 * i + (lane >> 5); scr[kk * 33 + (lane & 31)] = v[i] * scale; }
    LDS_WAIT(); asm volatile("" ::: "memory");
    const int c = lane & 7;
#pragma unroll
    for (int j = 0; j < 4; ++j) { const int n = (lane >> 3) + 8 * j; const LAS float* sp = scr + (8 * c) * 33 + n;
        int w0 = __builtin_amdgcn_cvt_pk_fp8_f32(clamp8(sp[0 * 33]), clamp8(sp[1 * 33]), 0, false); w0 = __builtin_amdgcn_cvt_pk_fp8_f32(clamp8(sp[2 * 33]), clamp8(sp[3 * 33]), w0, true);
        int w1 = __builtin_amdgcn_cvt_pk_fp8_f32(clamp8(sp[4 * 33]), clamp8(sp[5 * 33]), 0, false); w1 = __builtin_amdgcn_cvt_pk_fp8_f32(clamp8(sp[6 * 33]), clamp8(sp[7 * 33]), w1, true);
        const int ng = n0 + n; const int drow = (G == 0) ? ng : ((ng / G) * 2 * G + which * G + (ng % G));
        u32x2 o; o.x = (unsigned)w0; o.y = (unsigned)w1; *(u32x2*)(WT + (size_t)drow * K + k0 + 8 * c) = o; }
    LDS_WAIT(); asm volatile("" ::: "memory");
}
__device__ __forceinline__ void rope_entry(float* tab, int idx) {
    const int t = idx >> 6, i = idx & 63;
    const float inv_freq = powf(10000.f, -(float)(2 * i) / 128.f);
    const float ang = (float)t * inv_freq;
    const double a = (double)ang; const double two_pi = 6.283185307179586476925286766559;
    const double kf = rint(a / two_pi); double r = a - kf * two_pi;
    double sgn = 1.0; if (r > 1.5707963267948966) { r = 3.141592653589793 - r; sgn = -1.0; } else if (r < -1.5707963267948966) { r = -3.141592653589793 - r; sgn = -1.0; }
    const double r2 = r * r;
    const double s = r * (1.0 + r2 * (-1.0 / 6 + r2 * (1.0 / 120 + r2 * (-1.0 / 5040 + r2 * (1.0 / 362880 + r2 * (-1.0 / 39916800 + r2 * (1.0 / 6227020800.0 + r2 * (-1.0 / 1307674368000.0))))))));
    const double c = 1.0 + r2 * (-0.5 + r2 * (1.0 / 24 + r2 * (-1.0 / 720 + r2 * (1.0 / 40320 + r2 * (-1.0 / 3628800 + r2 * (1.0 / 479001600.0 + r2 * (-1.0 / 87178291200.0 + r2 * (1.0 / 20922789888000.0))))))));
    tab[idx] = (float)(sgn * c); tab[SEQ * 64 + idx] = (float)s;
}
__device__ __forceinline__ void mod_task(const float* __restrict__ cin, const float* __restrict__ w_ada, float* __restrict__ modp, int task, int lane) {
    const int cbk = task % 96, kc = task / 96, j = cbk * 64 + lane, k0 = kc * 64;
    float acc[32], cv[32];
#pragma unroll
    for (int b = 0; b < 32; ++b) { acc[b] = 0.f; cv[b] = silu_f(cin[b * D + k0 + lane]); }
#pragma unroll
    for (int kb = 0; kb < 4; ++kb) {
        float w[16];
#pragma unroll
        for (int i = 0; i < 16; ++i) w[i] = w_ada[(size_t)(k0 + kb * 16 + i) * 6144 + j];
#pragma unroll
        for (int i = 0; i < 16; ++i)
#pragma unroll
            for (int b = 0; b < 32; ++b) acc[b] += __builtin_bit_cast(float, __builtin_amdgcn_readlane(__builtin_bit_cast(int, cv[b]), kb * 16 + i)) * w[i];
    }
#pragma unroll
    for (int b = 0; b < 32; ++b) modp[((size_t)kc * 32 + b) * 6144 + j] = acc[b];
}
__device__ __forceinline__ float mod_sum(const float* __restrict__ modp, const float* __restrict__ b_ada, int b, int j) {
    float s = 0.f;
#pragma unroll
    for (int kc = 0; kc < 16; ++kc) s += modp[((size_t)kc * 32 + b) * 6144 + j];
    return s + b_ada[j];
}

#ifndef RET_PROBE
#define RET_PROBE 0
#endif
namespace ret {
typedef short s16x4 __attribute__((ext_vector_type(4)));
typedef __bf16 bfx2 __attribute__((ext_vector_type(2)));
constexpr unsigned RS = 288, TILE = 128 * RS, LK = 0, LV = TILE, LRF = 2 * TILE, LRB = 3 * TILE;
constexpr float LOG2E = 1.4426950408889634f;
__device__ __forceinline__ unsigned offb(unsigned row, unsigned ch) { return RS * row + 16u * ch; }
__device__ __forceinline__ unsigned cvtpk(float lo, float hi) { const f32x2 v = {lo, hi}; return __builtin_bit_cast(unsigned, __builtin_convertvector(v, bfx2)); }
__device__ __forceinline__ bf16x8 pack8(const float (&f)[8]) { u32x4 u; u.x = cvtpk(f[0], f[1]); u.y = cvtpk(f[2], f[3]); u.z = cvtpk(f[4], f[5]); u.w = cvtpk(f[6], f[7]); return __builtin_bit_cast(bf16x8, u); }
__device__ __forceinline__ void unpack8(const bf16x8 v, float (&f)[8]) { const u32x4 u = __builtin_bit_cast(u32x4, v);
    f[0] = __uint_as_float(u.x << 16); f[1] = __uint_as_float(u.x & 0xffff0000u); f[2] = __uint_as_float(u.y << 16); f[3] = __uint_as_float(u.y & 0xffff0000u);
    f[4] = __uint_as_float(u.z << 16); f[5] = __uint_as_float(u.z & 0xffff0000u); f[6] = __uint_as_float(u.w << 16); f[7] = __uint_as_float(u.w & 0xffff0000u); }
__device__ __forceinline__ bf16x8 trfrag(LAS unsigned char* base, unsigned row0, unsigned row1, unsigned cblk, unsigned qp, unsigned p) {
    const unsigned ch = 2u * cblk + (p >> 1), bo = 8u * (p & 1u);
    const s16x4 lo = __builtin_amdgcn_ds_read_tr16_b64_v4i16((LAS s16x4*)(base + offb(row0 + qp, ch) + bo));
    const s16x4 hi = __builtin_amdgcn_ds_read_tr16_b64_v4i16((LAS s16x4*)(base + offb(row1 + qp, ch) + bo));
    return __builtin_shufflevector(lo, hi, 0, 1, 2, 3, 4, 5, 6, 7);
}
struct KVRaw { bf16x8 ka[2], kb[2], v[4]; f32x4 c0[2], c1[2], s0[2], s1[2]; };
__device__ __forceinline__ void kv_load(KVRaw& R, const bf16_t* __restrict__ proj, const float* __restrict__ rope, int b, int h, int n, int tid) {
#pragma unroll
    for (int i = 0; i < 2; ++i) {
        const int q2 = tid + 512 * i, row = q2 >> 3, pc = q2 & 7, t = n * 128 + row;
        const bf16_t* rp = proj + (size_t)(b * SEQ + t) * DIN + OFF_KR + h * 128;
        R.ka[i] = *(const bf16x8*)(rp + pc * 8); R.kb[i] = *(const bf16x8*)(rp + 64 + pc * 8);
        R.c0[i] = *(const f32x4*)(rope + t * 64 + pc * 8); R.c1[i] = *(const f32x4*)(rope + t * 64 + pc * 8 + 4);
        R.s0[i] = *(const f32x4*)(rope + SEQ * 64 + t * 64 + pc * 8); R.s1[i] = *(const f32x4*)(rope + SEQ * 64 + t * 64 + pc * 8 + 4);
    }
#pragma unroll
    for (int i = 0; i < 4; ++i) { const int q4 = tid + 512 * i, row = q4 >> 4, ch = q4 & 15, t = n * 128 + row;
        R.v[i] = *(const bf16x8*)(proj + (size_t)(b * SEQ + t) * DIN + OFF_VR + h * 128 + ch * 8); }
}
__device__ __forceinline__ void kv_store(LAS unsigned char* lds, const KVRaw& R, int tid) {
#pragma unroll
    for (int i = 0; i < 2; ++i) {
        const int q2 = tid + 512 * i, row = q2 >> 3, pc = q2 & 7;
        float fa[8], fb[8], o1[8], o2[8];
        unpack8(R.ka[i], fa); unpack8(R.kb[i], fb);
        const float cs[8] = {R.c0[i].x, R.c0[i].y, R.c0[i].z, R.c0[i].w, R.c1[i].x, R.c1[i].y, R.c1[i].z, R.c1[i].w}, sn[8] = {R.s0[i].x, R.s0[i].y, R.s0[i].z, R.s0[i].w, R.s1[i].x, R.s1[i].y, R.s1[i].z, R.s1[i].w};
#pragma unroll
        for (int e = 0; e < 8; ++e) { o1[e] = fa[e] * cs[e] - fb[e] * sn[e]; o2[e] = fb[e] * cs[e] + fa[e] * sn[e]; }
        *(LAS bf16x8*)(lds + LK + offb(row, pc)) = pack8(o1); *(LAS bf16x8*)(lds + LK + offb(row, pc + 8)) = pack8(o2);
    }
#pragma unroll
    for (int i = 0; i < 4; ++i) { const int q4 = tid + 512 * i, row = q4 >> 4, ch = q4 & 15; *(LAS bf16x8*)(lds + LV + offb(row, ch)) = R.v[i]; }
}
__device__ __forceinline__ void rb_dma(LAS unsigned char* lds, const unsigned char* img, int w, int lane) {
#pragma unroll
    for (int i = 0; i < 5; ++i) { const int o = w + 8 * i; if (o < (int)TILE / 1024)
        __builtin_amdgcn_global_load_lds((const unsigned*)(img + o * 1024 + lane * 16), (LAS unsigned*)(lds + LRB + o * 1024), 16, 0, 0); }
}
template <bool FWD> __device__ __forceinline__ void state_update_1(LAS unsigned char* lds, f32x4 (&racc)[8], float l2, int w, int g, unsigned qp, unsigned p);
template <bool FWD> __device__ __forceinline__ void state_update(LAS unsigned char* lds, f32x4 (&racc)[8], float l2, int w, int g, unsigned qp, unsigned p) {
    if (RET_PROBE == 2) {
        f32x4 r2[8];
#pragma unroll
        for (int i = 0; i < 8; ++i) r2[i] = racc[i];
        unsigned zo = 0; asm volatile("" : "+v"(zo));
        state_update_1<FWD>(lds + zo, r2, l2, w, g, qp, p);
        state_update_1<FWD>(lds, racc, l2, w, g, qp, p);
#pragma unroll
        for (int i = 0; i < 8; ++i) racc[i] = (racc[i] + r2[i]) * 0.5f;
    } else state_update_1<FWD>(lds, racc, l2, w, g, qp, p);
}
template <bool FWD> __device__ __forceinline__ void state_update_1(LAS unsigned char* lds, f32x4 (&racc)[8], float l2, int w, int g, unsigned qp, unsigned p) {
    const float dec = __builtin_amdgcn_exp2f(128.f * l2);
    bf16x8 vs[4];
#pragma unroll
    for (int ks = 0; ks < 4; ++ks) {
        float f[8]; unpack8(trfrag(lds + LV, 32 * ks + 4 * g, 32 * ks + 16 + 4 * g, w, qp, p), f);
#pragma unroll
        for (int e = 0; e < 8; ++e) { const int key = 32 * ks + 16 * (e >> 2) + 4 * g + (e & 3); f[e] *= __builtin_amdgcn_exp2f((FWD ? (float)(127 - key) : (float)key) * l2); }
        vs[ks] = pack8(f);
    }
#pragma unroll
    for (int nb = 0; nb < 8; ++nb) {
        racc[nb] = racc[nb] * dec;
#pragma unroll
        for (int ks = 0; ks < 4; ++ks) racc[nb] = __builtin_amdgcn_mfma_f32_16x16x32_bf16(vs[ks], trfrag(lds + LK, 32 * ks + 4 * g, 32 * ks + 16 + 4 * g, nb, qp, p), racc[nb], 0, 0, 0);
    }
}
__device__ __forceinline__ void unit(const bf16_t* __restrict__ proj, const float* __restrict__ rope, const float* __restrict__ log_decay, const float* __restrict__ gn_g, bf16_t* __restrict__ ymix,
                                     unsigned char* __restrict__ scratch  , LAS unsigned char* lds, int hu, const int tid_in) {
    const int u = hu >> 1, n0 = (hu & 1) * 8, n1 = n0 + 8;
    const int b = u >> 2, h = u & 3;
    int tid_ = tid_in; asm volatile("" : "+v"(tid_));
    const int tid0 = tid_, w = __builtin_amdgcn_readfirstlane(tid0 >> 6);
#define RET_LANE int tid = tid0; asm volatile("" : "+v"(tid)); const int lane = tid & 63, r = lane & 15, g = lane >> 4; const unsigned qp = (unsigned)r >> 2, p = (unsigned)lane & 3u;
    const float lf2_ = log_decay[h] * LOG2E, lb2_ = log_decay[4 + h] * LOG2E;
    f32x4 racc[8];
    KVRaw raw;
    for (int rep7 = 0; rep7 < (RET_PROBE == 7 ? 2 : 1); ++rep7) {
#pragma unroll
    for (int nb = 0; nb < 8; ++nb) racc[nb] = (f32x4){0.f, 0.f, 0.f, 0.f};
    kv_load(raw, proj, rope, b, h, 15, tid0);
    for (int n = 15; n >= n0; --n) {
        RET_LANE
        if (n < n1) {
            unsigned char* img = scratch + (size_t)(n - n0) * TILE;
#pragma unroll
            for (int nb = 0; nb < 8; ++nb) { u32x2 o; o.x = cvtpk(racc[nb][0], racc[nb][1]); o.y = cvtpk(racc[nb][2], racc[nb][3]);
                *(u32x2*)(img + offb(16 * nb + r, 2 * w + (g >> 1)) + 8 * (g & 1)) = o; }
        }
        if (n == n0) break;
        float lb2 = lb2_; asm volatile("" : "+v"(lb2));
        __syncthreads();
        kv_store(lds, raw, tid);
        __syncthreads();
        kv_load(raw, proj, rope, b, h, n - 1 > n0 ? n - 1 : 0, tid);
        state_update<false>(lds, racc, lb2, w, g, qp, p);
    }
    }
    asm volatile("s_waitcnt vmcnt(0)" ::: "memory");
    __syncthreads();
    __builtin_amdgcn_fence(__ATOMIC_ACQUIRE, "agent");
    asm volatile("s_waitcnt vmcnt(0)" ::: "memory");
    for (int rep8 = 0; rep8 < (RET_PROBE == 8 ? 2 : 1); ++rep8) {
    if (RET_PROBE == 8 && rep8 == 1) { __syncthreads(); kv_load(raw, proj, rope, b, h, 0, tid0); }
#pragma unroll
    for (int nb = 0; nb < 8; ++nb) racc[nb] = (f32x4){0.f, 0.f, 0.f, 0.f};
    for (int n = 0; n < n0; ++n) {
        RET_LANE
        float lf2 = lf2_; asm volatile("" : "+v"(lf2));
        __syncthreads();
        kv_store(lds, raw, tid);
        __syncthreads();
        kv_load(raw, proj, rope, b, h, n + 1, tid);
        state_update<true>(lds, racc, lf2, w, g, qp, p);
    }
    rb_dma(lds, scratch, w, tid0 & 63);
    for (int n = n0; n < n1; ++n) {
        RET_LANE
        float lf2 = lf2_, lb2 = lb2_; asm volatile("" : "+v"(lf2), "+v"(lb2));
        const __attribute__((address_space(1))) float* gnp = (const __attribute__((address_space(1))) float*)gn_g; asm volatile("" : "+s"(gnp));
        __syncthreads();
        kv_store(lds, raw, tid);
#pragma unroll
        for (int nb = 0; nb < 8; ++nb) { u32x2 o; o.x = cvtpk(racc[nb][0], racc[nb][1]); o.y = cvtpk(racc[nb][2], racc[nb][3]);
            *(LAS u32x2*)(lds + LRF + offb(16 * nb + r, 2 * w + (g >> 1)) + 8 * (g & 1)) = o; }
        const int cq = 16 * w + r, tq = n * 128 + cq;
        bf16x8 qn[4], qf[4], qb[4];
        { const bf16_t* rp = proj + (size_t)(b * SEQ + tq) * DIN + OFF_QR + h * 128 + 4 * g;
          const float sf = __builtin_amdgcn_exp2f((float)(cq + 1) * lf2), sb = __builtin_amdgcn_exp2f((float)(128 - cq) * lb2);
#pragma unroll
          for (int ks = 0; ks < 2; ++ks) {
              float fa[8], fb[8], o1[8], o2[8], t1[8], t2[8];
              { const u32x2 a0 = *(const u32x2*)(rp + 32 * ks), a1 = *(const u32x2*)(rp + 32 * ks + 16), b0 = *(const u32x2*)(rp + 32 * ks + 64), b1 = *(const u32x2*)(rp + 32 * ks + 80);
                unpack8(__builtin_bit_cast(bf16x8, (u32x4){a0.x, a0.y, a1.x, a1.y}), fa); unpack8(__builtin_bit_cast(bf16x8, (u32x4){b0.x, b0.y, b1.x, b1.y}), fb); }
              const float* cp = rope + tq * 64 + 32 * ks + 4 * g; const float* sp = cp + SEQ * 64;
              const f32x4 c0 = *(const f32x4*)cp, c1 = *(const f32x4*)(cp + 16), s0 = *(const f32x4*)sp, s1 = *(const f32x4*)(sp + 16);
              const float cs[8] = {c0.x, c0.y, c0.z, c0.w, c1.x, c1.y, c1.z, c1.w}, sn[8] = {s0.x, s0.y, s0.z, s0.w, s1.x, s1.y, s1.z, s1.w};
#pragma unroll
              for (int e = 0; e < 8; ++e) { o1[e] = fa[e] * cs[e] - fb[e] * sn[e]; o2[e] = fb[e] * cs[e] + fa[e] * sn[e]; }
              qn[ks] = pack8(o1); qn[ks + 2] = pack8(o2);
#pragma unroll
              for (int e = 0; e < 8; ++e) { t1[e] = o1[e] * sf; t2[e] = o2[e] * sf; }
              qf[ks] = pack8(t1); qf[ks + 2] = pack8(t2);
#pragma unroll
              for (int e = 0; e < 8; ++e) { t1[e] = o1[e] * sb; t2[e] = o2[e] * sb; }
              qb[ks] = pack8(t1); qb[ks + 2] = pack8(t2);
          } }
        asm volatile("s_waitcnt vmcnt(0)" ::: "memory");
        __syncthreads();
        kv_load(raw, proj, rope, b, h, n + 1 < n1 ? n + 1 : n, tid);
        u32x2 gv[8];
        { const bf16_t* gp = proj + (size_t)(b * SEQ + tq) * DIN + OFF_GR + h * 128 + 4 * g;
#pragma unroll
          for (int mbv = 0; mbv < 8; ++mbv) gv[mbv] = *(const u32x2*)(gp + 16 * mbv); }
        bf16x8 pt[4];
#pragma unroll
        for (int rep3 = 0; rep3 < (RET_PROBE == 3 ? 2 : 1); ++rep3) {
        unsigned zo3 = 0; if (RET_PROBE == 3) asm volatile("" : "+v"(zo3));
#pragma unroll
        for (int ks2 = 0; ks2 < 4; ++ks2) {
            float pv[8];
#pragma unroll
            for (int hb = 0; hb < 2; ++hb) {
                const int mb = 2 * ks2 + hb;
                f32x4 st = (f32x4){0.f, 0.f, 0.f, 0.f};
#pragma unroll
                for (int ks = 0; ks < 4; ++ks) { const LAS unsigned char* kp = lds + LK + zo3 + RS * (16 * mb + r) + 64 * ks + 8 * g; const u32x2 k0 = *(const LAS u32x2*)kp, k1 = *(const LAS u32x2*)(kp + 32);
                    st = __builtin_amdgcn_mfma_f32_16x16x32_bf16(__builtin_bit_cast(bf16x8, (u32x4){k0.x, k0.y, k1.x, k1.y}), qn[ks], st, 0, 0, 0); }
#pragma unroll
                for (int j = 0; j < 4; ++j) { const int diff = cq - (16 * mb + 4 * g + j); pv[4 * hb + j] = st[j] * __builtin_amdgcn_exp2f(diff >= 0 ? (float)diff * lf2 : (float)(-diff) * lb2); }
            }
            pt[ks2] = pack8(pv);
        }
        }
        f32x4 yacc[8];
#pragma unroll
        for (int mbv = 0; mbv < 8; ++mbv) {
            f32x4 y = (f32x4){0.f, 0.f, 0.f, 0.f};
#pragma unroll
            for (int rep = 0; rep < (RET_PROBE == 1 ? 2 : 1); ++rep) {
            unsigned zo = 0; if (RET_PROBE == 1) asm volatile("" : "+v"(zo));
#pragma unroll
            for (int ks2 = 0; ks2 < 4; ++ks2) y = __builtin_amdgcn_mfma_f32_16x16x32_bf16(trfrag(lds + LV + zo, 32 * ks2 + 4 * g, 32 * ks2 + 16 + 4 * g, mbv, qp, p), pt[ks2], y, 0, 0, 0);
#pragma unroll
            for (int ks = 0; ks < 4; ++ks) {
                y = __builtin_amdgcn_mfma_f32_16x16x32_bf16(trfrag(lds + LRF + zo, 32 * ks + 4 * g, 32 * ks + 16 + 4 * g, mbv, qp, p), qf[ks], y, 0, 0, 0);
                y = __builtin_amdgcn_mfma_f32_16x16x32_bf16(trfrag(lds + LRB + zo, 32 * ks + 4 * g, 32 * ks + 16 + 4 * g, mbv, qp, p), qb[ks], y, 0, 0, 0);
            }
            }
            yacc[mbv] = (RET_PROBE == 1) ? y * 0.5f : y;
        }
        __syncthreads();
        if (n + 1 < n1) rb_dma(lds, scratch + (size_t)(n + 1 - n0) * TILE, w, lane);
        { float s = 0.f;
#pragma unroll
          for (int mbv = 0; mbv < 8; ++mbv) s += (yacc[mbv][0] + yacc[mbv][1]) + (yacc[mbv][2] + yacc[mbv][3]);
          s += __shfl_xor(s, 16); s += __shfl_xor(s, 32);
          const float mu = s * (1.f / 128.f); float s2 = 0.f;
#pragma unroll
          for (int mbv = 0; mbv < 8; ++mbv) { yacc[mbv] = yacc[mbv] - mu; s2 += (yacc[mbv][0] * yacc[mbv][0] + yacc[mbv][1] * yacc[mbv][1]) + (yacc[mbv][2] * yacc[mbv][2] + yacc[mbv][3] * yacc[mbv][3]); }
          s2 += __shfl_xor(s2, 16); s2 += __shfl_xor(s2, 32);
          const float rstd = 1.f / sqrtf(s2 * (1.f / 128.f) + GN_EPS);
          bf16_t* op = ymix + (size_t)(b * SEQ + tq) * D + 512 + h * 128 + 4 * g;
#pragma unroll
          for (int rep4 = 0; rep4 < (RET_PROBE == 4 ? 2 : 1); ++rep4) {
          if (RET_PROBE == 4) { asm volatile("" : "+v"(op)); asm volatile("" : "+v"(gv[0]), "+v"(gv[1]), "+v"(gv[2]), "+v"(gv[3]), "+v"(gv[4]), "+v"(gv[5]), "+v"(gv[6]), "+v"(gv[7])); }
#pragma unroll
          for (int mbv = 0; mbv < 8; ++mbv) {
              const f32x4 gn = *(const __attribute__((address_space(1))) f32x4*)(gnp + h * 128 + 16 * mbv + 4 * g);
              const float g0 = __uint_as_float(gv[mbv].x << 16), g1 = __uint_as_float(gv[mbv].x & 0xffff0000u), g2 = __uint_as_float(gv[mbv].y << 16), g3 = __uint_as_float(gv[mbv].y & 0xffff0000u);
              u32x2 o; o.x = cvtpk(silu_f(g0) * (yacc[mbv][0] * rstd * gn.x), silu_f(g1) * (yacc[mbv][1] * rstd * gn.y));
              o.y = cvtpk(silu_f(g2) * (yacc[mbv][2] * rstd * gn.z), silu_f(g3) * (yacc[mbv][3] * rstd * gn.w));
              *(u32x2*)(op + 16 * mbv) = o;
          } } }
        state_update<true>(lds, racc, lf2, w, g, qp, p);
    }
    }
    __syncthreads();
#undef RET_LANE
}
}


namespace na {
constexpr unsigned LKR = 0, LVR = 73728, LRPB = 147456;
__device__ __forceinline__ void load_row(LAS unsigned char* lds, const bf16_t* __restrict__ proj, int b, int head, int krow, int tid) {
    const int key = tid >> 3, ch = tid & 7, slot = krow % 9;
    const bf16_t* rp = proj + (size_t)(b * SEQ + krow * 64 + key) * DIN + head * 64 + ch * 8;
    const unsigned o = (unsigned)slot * 8192u + 128u * key + 16u * (ch ^ (key & 7));
    *(LAS u32x4*)(lds + LKR + o) = *(const u32x4*)(rp + OFF_KNA);
    *(LAS u32x4*)(lds + LVR + o) = *(const u32x4*)(rp + OFF_VNA);
}
__device__ __forceinline__ void unit(const bf16_t* __restrict__ proj, const float* __restrict__ rpb, bf16_t* __restrict__ ymix, LAS unsigned char* lds, int u, const int tid_in) {
    const int b = u >> 3, head = u & 7;
    int tid_ = tid_in; asm volatile("" : "+v"(tid_));
    const int tid0 = tid_, w = __builtin_amdgcn_readfirstlane(tid0 >> 6);
    __syncthreads();
    if (tid0 < 465) ((LAS float*)(lds + LRPB))[tid0] = rpb[head * 465 + tid0];
    const int ct = w & 3, cb = (ct == 0) ? 0 : (ct == 1 ? 8 : (ct == 2 ? 24 : 32));
    u32x4 pk[2], pv2[2]; int pre_lo = 0, pre_n = 0;
    for (int st = 0; st < 16; ++st) {
        int tid = tid0; asm volatile("" : "+v"(tid));
        const int lane = tid & 63, qi = lane & 15, g = lane >> 4; const unsigned qp = (unsigned)qi >> 2, p = (unsigned)lane & 3u;
        const int r = 2 * st + (w >> 2);
        const int rs = min(max(r - 4, 0), 24);
        const int need_hi = min(max(2 * st + 1 - 4, 0), 24) + 7;
        __syncthreads();
        if (st == 0) { for (int kr = 0; kr <= need_hi; ++kr) load_row(lds, proj, b, head, kr, tid); }
        else {
#pragma unroll
            for (int i = 0; i < 2; ++i) if (i < pre_n) { const int key = tid >> 3, ch = tid & 7; const unsigned o = (unsigned)((pre_lo + i) % 9) * 8192u + 128u * key + 16u * (ch ^ (key & 7));
                *(LAS u32x4*)(lds + LKR + o) = pk[i]; *(LAS u32x4*)(lds + LVR + o) = pv2[i]; }
        }
        const int cq = 16 * ct + qi, tq = b * SEQ + r * 64 + cq;
        bf16x8 qn[2];
        { const bf16_t* qptr = proj + (size_t)tq * DIN + OFF_QNA + head * 64 + 8 * g; qn[0] = *(const bf16x8*)qptr; qn[1] = *(const bf16x8*)(qptr + 32); }
        __syncthreads();
        { const int nh = (st < 15) ? min(max(2 * st + 3 - 4, 0), 24) + 7 : need_hi; pre_lo = need_hi + 1; pre_n = nh - need_hi;
#pragma unroll
          for (int i = 0; i < 2; ++i) if (i < pre_n) { const int key = tid >> 3, ch = tid & 7; const bf16_t* rp = proj + (size_t)(b * SEQ + (pre_lo + i) * 64 + key) * DIN + head * 64 + ch * 8;
              pk[i] = *(const u32x4*)(rp + OFF_KNA); pv2[i] = *(const u32x4*)(rp + OFF_VNA); } }
        const int cs = min(max(cq - 8, 0), 48);
        const unsigned kb0 = 128u * qi + 16u * ((unsigned)g ^ ((unsigned)qi & 7u)), kb1 = 128u * qi + 16u * ((4u + (unsigned)g) ^ ((unsigned)qi & 7u));
        const LAS float* bias = (const LAS float*)(lds + LRPB);
        f32x4 sc[16]; float mx = -3.0e38f;
#pragma unroll
        for (int kr = 0; kr < 8; ++kr) {
            const int krow = rs + kr; const unsigned so = (unsigned)(krow % 9) * 8192u + 128u * (unsigned)cb;
            const int dr = krow - r + 7;
#pragma unroll
            for (int h2 = 0; h2 < 2; ++h2) {
                f32x4 a = (f32x4){0.f, 0.f, 0.f, 0.f};
                a = __builtin_amdgcn_mfma_f32_16x16x32_bf16(*(const LAS bf16x8*)(lds + LKR + so + 2048u * h2 + kb0), qn[0], a, 0, 0, 0);
                a = __builtin_amdgcn_mfma_f32_16x16x32_bf16(*(const LAS bf16x8*)(lds + LKR + so + 2048u * h2 + kb1), qn[1], a, 0, 0, 0);
#pragma unroll
                for (int j = 0; j < 4; ++j) {
                    const int kcol = cb + 16 * h2 + 4 * g + j;
                    const int dc = min(max(kcol - cq + 15, 0), 30);
                    const float v = a[j] + bias[dr * 31 + dc];
                    const bool in = (kcol >= cs) && (kcol < cs + 16);
                    a[j] = in ? v : -3.0e38f; mx = fmaxf(mx, a[j]);
                }
                sc[2 * kr + h2] = a;
            }
        }
        mx = fmaxf(mx, __shfl_xor(mx, 16)); mx = fmaxf(mx, __shfl_xor(mx, 32));
        float sum = 0.f; bf16x8 pt[8];
#pragma unroll
        for (int kk = 0; kk < 8; ++kk) {
            float pv[8];
#pragma unroll
            for (int h2 = 0; h2 < 2; ++h2)
#pragma unroll
                for (int j = 0; j < 4; ++j) { const float e = __builtin_amdgcn_exp2f((sc[2 * kk + h2][j] - mx) * 1.4426950408889634f); pv[4 * h2 + j] = e; sum += e; }
            pt[kk] = ret::pack8(pv);
        }
        sum += __shfl_xor(sum, 16); sum += __shfl_xor(sum, 32);
        const float inv = 1.f / sum;
        const unsigned sl = (((unsigned)g & 1u) << 2) | qp;
        bf16_t* op = ymix + (size_t)tq * D + head * 64 + 4 * g;
#pragma unroll
        for (int db = 0; db < 4; ++db) {
            const unsigned vb = 128u * (4u * (unsigned)g + qp) + 16u * ((2u * db + (p >> 1)) ^ sl) + 8u * (p & 1u);
            f32x4 y = (f32x4){0.f, 0.f, 0.f, 0.f};
#pragma unroll
            for (int kk = 0; kk < 8; ++kk) {
                const unsigned so = (unsigned)((rs + kk) % 9) * 8192u + 128u * (unsigned)cb;
                const ret::s16x4 lo = __builtin_amdgcn_ds_read_tr16_b64_v4i16((LAS ret::s16x4*)(lds + LVR + so + vb));
                const ret::s16x4 hi = __builtin_amdgcn_ds_read_tr16_b64_v4i16((LAS ret::s16x4*)(lds + LVR + so + 2048u + vb));
                y = __builtin_amdgcn_mfma_f32_16x16x32_bf16(__builtin_shufflevector(lo, hi, 0, 1, 2, 3, 4, 5, 6, 7), pt[kk], y, 0, 0, 0);
            }
            u32x2 o; o.x = ret::cvtpk(y[0] * inv, y[1] * inv); o.y = ret::cvtpk(y[2] * inv, y[3] * inv);
            *(u32x2*)(op + 16 * db) = o;
        }
    }
    __syncthreads();
}
}

__device__ __forceinline__ void unpack_t16r(const u32x4 a, const u32x4 b, f32x4 (&v)[4]) {
    v[0] = (f32x4){__uint_as_float(a.x << 16), __uint_as_float(a.x & 0xffff0000u), __uint_as_float(a.y << 16), __uint_as_float(a.y & 0xffff0000u)};
    v[1] = (f32x4){__uint_as_float(a.z << 16), __uint_as_float(a.z & 0xffff0000u), __uint_as_float(a.w << 16), __uint_as_float(a.w & 0xffff0000u)};
    v[2] = (f32x4){__uint_as_float(b.x << 16), __uint_as_float(b.x & 0xffff0000u), __uint_as_float(b.y << 16), __uint_as_float(b.y & 0xffff0000u)};
    v[3] = (f32x4){__uint_as_float(b.z << 16), __uint_as_float(b.z & 0xffff0000u), __uint_as_float(b.w << 16), __uint_as_float(b.w & 0xffff0000u)};
}
__device__ __forceinline__ void ln1_row(const u32x4 ra, const u32x4 rb, const LAS float* cv  , bf16_t* __restrict__ hf, unsigned char* __restrict__ hf8, float* __restrict__ stats, int row, int lane) {
    asm volatile("" : "+v"(cv));
    const int c0 = lane * 16;
    f32x4 v[4]; float s = 0.f;
    unpack_t16r(ra, rb, v);
#pragma unroll
    for (int j = 0; j < 4; ++j) s += (v[j].x + v[j].y) + (v[j].z + v[j].w);
    const float mean = wave_sum(s) * (1.f / D); float s2 = 0.f;
#pragma unroll
    for (int j = 0; j < 4; ++j) { v[j] = v[j] - mean; s2 += (v[j].x * v[j].x + v[j].y * v[j].y) + (v[j].z * v[j].z + v[j].w * v[j].w); }
    const float rstd = 1.f / sqrtf(wave_sum(s2) * (1.f / D) + LN_EPS);
    if (lane == 0) *(f32x2*)(stats + 2 * (size_t)row) = (f32x2){mean, rstd};
    u32x4 ob[2], o8;
#pragma unroll
    for (int j = 0; j < 4; ++j) { const int col = c0 + 4 * j;
        const f32x4 gg = *(const LAS f32x4*)(cv + col), bv = *(const LAS f32x4*)(cv + 1024 + col), sc1 = *(const LAS f32x4*)(cv + 2048 + col), sh = *(const LAS f32x4*)(cv + 3072 + col);
        const f32x4 h4 = (v[j] * rstd * gg + bv) * sc1 + sh;
        const unsigned p0 = pk2(h4.x, h4.y), p1 = pk2(h4.z, h4.w);
        if (j == 0) { ob[0].x = p0; ob[0].y = p1; } else if (j == 1) { ob[0].z = p0; ob[0].w = p1; } else if (j == 2) { ob[1].x = p0; ob[1].y = p1; } else { ob[1].z = p0; ob[1].w = p1; }
        const f32x4 h8 = h4 * S_HF8;
        int w0 = __builtin_amdgcn_cvt_pk_fp8_f32(clamp8(h8.x), clamp8(h8.y), 0, false); w0 = __builtin_amdgcn_cvt_pk_fp8_f32(clamp8(h8.z), clamp8(h8.w), w0, true);
        if (j == 0) o8.x = (unsigned)w0; else if (j == 1) o8.y = (unsigned)w0; else if (j == 2) o8.z = (unsigned)w0; else o8.w = (unsigned)w0; }
    *(u32x4*)(hf + (size_t)row * D + c0) = ob[0]; *(u32x4*)(hf + (size_t)row * D + c0 + 8) = ob[1];
    *(u32x4*)(hf8 + (size_t)row * D + c0) = o8;
}
__device__ __forceinline__ void top2_merge(float& a1, float& a2, float b1, float b2) { const float n1 = fmaxf(a1, b1); const float n2 = fmaxf(fminf(a1, b1), fmaxf(a2, b2)); a1 = n1; a2 = n2; }
__device__ __forceinline__ float sigm(float x) { return 1.f / (1.f + __expf(-x)); }
__device__ __forceinline__ void route_lane(const float* __restrict__ logits, const float* __restrict__ rbias, int* __restrict__ topk_e, float* __restrict__ topk_w, LAS unsigned* hist, int tok) {
    const float NEG = -3.0e38f;
    const float* row = logits + (size_t)tok * NE;
    float gs[8];
#pragma unroll
    for (int g = 0; g < 8; ++g) {
        float m1 = NEG, m2 = NEG;
#pragma unroll
        for (int q = 0; q < 8; ++q) {
            const f32x4 lg = *(const f32x4*)(row + g * 32 + q * 4), b4 = *(const f32x4*)(rbias + g * 32 + q * 4);
            const float v[4] = {sigm(lg.x) + b4.x, sigm(lg.y) + b4.y, sigm(lg.z) + b4.z, sigm(lg.w) + b4.w};
#pragma unroll
            for (int j = 0; j < 4; ++j) { m2 = fmaxf(m2, fminf(m1, v[j])); m1 = fmaxf(m1, v[j]); }
        }
        gs[g] = m1 + m2;
        if (g & 1) asm volatile("" ::: "memory");
    }
    int pc[8];
    { int run = 0;
#pragma unroll
      for (int g = 0; g < 8; ++g) { int rank = 0;
#pragma unroll
          for (int h = 0; h < 8; ++h) if (h != g) rank += (gs[h] > gs[g] || (gs[h] == gs[g] && h < g)) ? 1 : 0;
          run += (rank < 4) ? 1 : 0; pc[g] = run; } }
    float L[8]; int I[8];
#pragma unroll
    for (int i = 0; i < 8; ++i) { L[i] = NEG; I[i] = 0; }
#pragma unroll 1
    for (int k = 0; k < 4; ++k) {
        int gk = 0;
#pragma unroll
        for (int g = 0; g < 8; ++g) gk += (pc[g] <= k) ? 1 : 0;
        const int base = gk * 32;
#pragma unroll
        for (int q = 0; q < 8; ++q) {
            const f32x4 lg = *(const f32x4*)(row + base + q * 4), b4 = *(const f32x4*)(rbias + base + q * 4);
            const float cv[4] = {sigm(lg.x) + b4.x, sigm(lg.y) + b4.y, sigm(lg.z) + b4.z, sigm(lg.w) + b4.w};
#pragma unroll
            for (int j = 0; j < 4; ++j) { float v = cv[j]; int idx = base + q * 4 + j;
#pragma unroll
                for (int i = 0; i < 8; ++i) { const bool gt = v > L[i]; const float tv = gt ? L[i] : v; const int ti = gt ? I[i] : idx; L[i] = gt ? v : L[i]; I[i] = gt ? idx : I[i]; v = tv; idx = ti; } }
        }
    }
    float w[8], wsum = 0.f;
#pragma unroll
    for (int i = 0; i < 8; ++i) { w[i] = sigm(row[I[i]]); wsum += w[i]; }
    const float sc = 2.5f / wsum;
    *(u32x4*)(topk_e + tok * TOPK) = (u32x4){(unsigned)I[0], (unsigned)I[1], (unsigned)I[2], (unsigned)I[3]}; *(u32x4*)(topk_e + tok * TOPK + 4) = (u32x4){(unsigned)I[4], (unsigned)I[5], (unsigned)I[6], (unsigned)I[7]};
    *(f32x4*)(topk_w + tok * TOPK) = (f32x4){w[0] * sc, w[1] * sc, w[2] * sc, w[3] * sc}; *(f32x4*)(topk_w + tok * TOPK + 4) = (f32x4){w[4] * sc, w[5] * sc, w[6] * sc, w[7] * sc};
#pragma unroll
    for (int i = 0; i < 8; ++i) __hip_atomic_fetch_add(&hist[I[i]], 1u, __ATOMIC_RELAXED, __HIP_MEMORY_SCOPE_WORKGROUP);
}
__device__ __forceinline__ void build_tables(const unsigned* ctl, LAS unsigned* tab, const int tid) {
    if (tid < 64) {
        const int lane = tid;
        unsigned c[4], so = 0, st = 0;
#pragma unroll
        for (int j = 0; j < 4; ++j) { c[j] = __hip_atomic_load(ctl + CW_COUNT + lane * 4 + j, __ATOMIC_RELAXED, __HIP_MEMORY_SCOPE_AGENT); so += c[j]; st += (c[j] + 255u) >> 8; }
        unsigned io = so, it = st;
#pragma unroll
        for (int o = 1; o < 64; o <<= 1) { const unsigned a = __shfl_up(io, o), b = __shfl_up(it, o); if (lane >= o) { io += a; it += b; } }
        unsigned eo = io - so, et = it - st;
#pragma unroll
        for (int j = 0; j < 4; ++j) { tab[T_CNT + lane * 4 + j] = c[j]; tab[T_OFF + lane * 4 + j] = eo; tab[T_TILE + lane * 4 + j] = et; eo += c[j]; et += (c[j] + 255u) >> 8; }
        if (lane == 63) { tab[T_OFF + NE] = eo; tab[T_TILE + NE] = et; }
    }
    __syncthreads();
}
struct RowRaw { u32x4 y[9]; u32x4 t[2]; f32x2 st; };
__device__ __forceinline__ void final_load(RowRaw& R, const bf16_t* __restrict__ tb, const unsigned char* __restrict__ ybuf, const unsigned char* __restrict__ ysh, const float* __restrict__ stats, int row, int lane) {
    const int c0 = lane * 16;
#pragma unroll
    for (int k = 0; k < TOPK; ++k) R.y[k] = *(const u32x4*)(ybuf + ((size_t)row * TOPK + k) * D + c0);
    R.y[8] = *(const u32x4*)(ysh + (size_t)row * D + c0);
    R.t[0] = *(const u32x4*)(tb + (size_t)row * D + c0); R.t[1] = *(const u32x4*)(tb + (size_t)row * D + c0 + 8);
    R.st = *(const f32x2*)(stats + 2 * (size_t)row);
}
__device__ __forceinline__ void final_row(float* __restrict__ out, const RowRaw& R, const LAS float* cv  , int row, int lane) {
    asm volatile("" : "+v"(cv));
    const int c0 = lane * 16;
    f32x4 a[4], t[4], v[4]; float s = 0.f;
#pragma unroll
    for (int j = 0; j < 4; ++j) a[j] = (f32x4){0.f, 0.f, 0.f, 0.f};
#pragma unroll
    for (int k = 0; k < 9; ++k) { const unsigned w[4] = {R.y[k].x, R.y[k].y, R.y[k].z, R.y[k].w};
#pragma unroll
        for (int j = 0; j < 4; ++j) { const f32x2 lo = __builtin_amdgcn_cvt_pk_f32_fp8((int)w[j], false), hi = __builtin_amdgcn_cvt_pk_f32_fp8((int)w[j], true); a[j].x += lo.x; a[j].y += lo.y; a[j].z += hi.x; a[j].w += hi.y; } }
    unpack_t16r(R.t[0], R.t[1], t);
#pragma unroll
    for (int j = 0; j < 4; ++j) { const int col = c0 + 4 * j;
        const f32x4 x1 = (t[j] - R.st.x) * R.st.y * *(const LAS f32x4*)(cv + col) + *(const LAS f32x4*)(cv + 1024 + col);
        v[j] = x1 * ALPHA + *(const LAS f32x4*)(cv + 4096 + col) * a[j] * YINV;
        s += (v[j].x + v[j].y) + (v[j].z + v[j].w); }
    const float mean = wave_sum(s) * (1.f / D); float s2 = 0.f;
#pragma unroll
    for (int j = 0; j < 4; ++j) { v[j] = v[j] - mean; s2 += (v[j].x * v[j].x + v[j].y * v[j].y) + (v[j].z * v[j].z + v[j].w * v[j].w); }
    const float rstd = 1.f / sqrtf(wave_sum(s2) * (1.f / D) + LN_EPS);
#pragma unroll
    for (int j = 0; j < 4; ++j) { const int col = c0 + 4 * j;
        *(f32x4*)(out + (size_t)row * D + col) = v[j] * rstd * *(const LAS f32x4*)(cv + 2048 + col) + *(const LAS f32x4*)(cv + 3072 + col); }
}

#ifndef MK_PER_PHASE
#define MK_PER_PHASE 0
#endif
constexpr int N_PHASES = 13;
struct Args { Ctx X; int ph_lo, ph_hi; };
typedef __attribute__((address_space(4))) const Ctx* CtxCP;
__device__ __forceinline__ CtxCP ctx_ptr() { CtxCP p = (CtxCP)__builtin_amdgcn_kernarg_segment_ptr(); asm volatile("" : "+s"(p)); return p; }

__global__ void __launch_bounds__(NW * 64, 2) mk_fwd(Args args) {
    extern __shared__ __attribute__((aligned(16))) unsigned char lds_raw[];
    LAS unsigned char* lds = (LAS unsigned char*)lds_raw;
    LAS unsigned* tab = (LAS unsigned*)(lds + TAB_OFF);
    volatile LAS unsigned* MISC = (volatile LAS unsigned*)(lds + MISC_OFF);
#define PH_BEGIN \
    const __attribute__((address_space(4))) Ctx& X = *ctx_ptr(); unsigned char* ws = X.ws; (void)ws; \
    const int lane = lane_id(), wave = wave0, tid = wave0 * 64 + lane; (void)lane; (void)wave; (void)tid; \
    const int G = gridDim.x, bx = blockIdx.x; (void)G; (void)bx; \
    const int gw = bx * NW + wave, NGW = G * NW; (void)gw; (void)NGW; \
    const int gt = bx * (NW * 64) + tid, NGT = G * NW * 64; (void)gt; (void)NGT; \
    unsigned* ctl = (unsigned*)(ws + WS_CTL); float* mod = (float*)(ws + WS_MOD); float* rope = (float*)(ws + WS_ROPE); (void)ctl; (void)mod; (void)rope; \
    bf16_t* win_t = (bf16_t*)(ws + WS_WIN_T); bf16_t* wout_t = (bf16_t*)(ws + WS_WOUT_T); bf16_t* wr_t = (bf16_t*)(ws + WS_WR_T); (void)win_t; (void)wout_t; (void)wr_t; \
    bf16_t* wsgu_t = (bf16_t*)(ws + WS_WSGU_T); bf16_t* wsd_t = (bf16_t*)(ws + WS_WSD_T); bf16_t* wd_t = (bf16_t*)(ws + WS_WD_T); bf16_t* wgu_t = (bf16_t*)(ws + WS_WGU_T); (void)wsgu_t; (void)wsd_t; (void)wd_t; (void)wgu_t; \
    int* slot_ent = (int*)(ws + WS_SLOT_ENT); float* slot_w = (float*)(ws + WS_SLOT_W); int* topk_e = (int*)(ws + WS_TOPK_E); float* topk_w = (float*)(ws + WS_TOPK_W); (void)slot_ent; (void)slot_w; (void)topk_e; (void)topk_w; \
    bf16_t* ymix = (bf16_t*)(ws + WS_YMIX); bf16_t* proj = (bf16_t*)(ws + WS_PROJ); bf16_t* hbuf = (bf16_t*)(ws + WS_YMIX); (void)ymix; (void)proj; (void)hbuf; \
    float* logits = (float*)(ws + WS_LOGITS); bf16_t* shh = (bf16_t*)(ws + WS_SHH); bf16_t* hf = (bf16_t*)(ws + WS_HF); bf16_t* act = (bf16_t*)(ws + WS_ACT); (void)logits; (void)shh; (void)hf; (void)act; \
    unsigned char* ybuf = ws + WS_YBUF; float* out = X.out; (void)ybuf; (void)out;

    const int wave0 = __builtin_amdgcn_readfirstlane((int)threadIdx.x >> 6);
    for (int u = threadIdx.x; u < (LDS_BYTES - MISC_OFF) / 4; u += NW * 64) ((LAS unsigned*)(lds + MISC_OFF))[u] = 0u;
    __syncthreads();
    if (!MK_PER_PHASE) { unsigned* ctl0 = (unsigned*)(args.X.ws + WS_CTL); (void)xcd_barrier_post(ctl0 + CW_BAR, MISC + 8, wave0 == 0 && lane_id() == 0); }
    const int lo = args.ph_lo, hi = args.ph_hi;
#ifndef MK_DUP
#define MK_DUP -1
#endif
#define REPS(k) for (int _rep = 0; _rep < ((MK_DUP == (k)) ? 2 : 1); ++_rep)
#ifdef MK_ONLY
#define IN(k) ((k) == MK_ONLY)
#else
#define IN(k) (lo <= (k) && (k) < hi)
#endif
#define SEAM(k) SEAM2(k, (k) + 1)
#define SEAM2(k, k2) do { if (IN(k) && IN(k2)) { XcdBarrier _b; _b.bar = (unsigned*)(ctx_ptr()->ws + WS_CTL) + CW_BAR; _b.x = xb_xcc_id(); _b.st = (volatile LAS unsigned*)(lds + MISC_OFF) + 8; xcd_barrier(_b, wave0 == 0 && lane_id() == 0); } } while (0)

    REPS(0) if (IN(0)) { PH_BEGIN
        LAS float* scr = (LAS float*)(lds + wave * 16384);
        float* modp = (float*)(ws + WS_PROJ);
        for (int t = gw; t < 96 * 16; t += NGW) mod_task(X.c, X.w_ada, modp, t, lane);
        constexpr int I_IN = (D / 64) * (DIN / 32), I_OUT = (D / 64) * (D / 32), I_R = (D / 64) * (NE / 32), I_SG = (D / 64) * (DE / 32), I_SD = (DE / 64) * (D / 32);
        constexpr int I_EG = I_SG, I_ED = I_SD;
        constexpr int N_SMALL = I_IN + I_OUT + I_R + 2 * I_SG + I_SD;
        constexpr int N_ITEMS = N_SMALL + NE * (2 * I_EG + I_ED);
        for (int it = gw; it < N_ITEMS; it += NGW) {
            int r = it;
            if (r < I_IN) { transpose_item_fp8(X.w_in, D, DIN, (unsigned char*)win_t, 0, 0, S_WIN8, scr, r, lane); continue; } r -= I_IN;
            if (r < I_OUT) { transpose_item(X.w_out, D, D, wout_t, 0, 0, scr, r, lane); continue; } r -= I_OUT;
            if (r < I_R) { transpose_item(X.w_router, D, NE, wr_t, 0, 0, scr, r, lane); continue; } r -= I_R;
            if (r < I_SG) { transpose_item(X.ws_gate, D, DE, wsgu_t, 8, 0, scr, r, lane); continue; } r -= I_SG;
            if (r < I_SG) { transpose_item(X.ws_up, D, DE, wsgu_t, 8, 1, scr, r, lane); continue; } r -= I_SG;
            if (r < I_SD) { transpose_item(X.ws_down, DE, D, wsd_t, 0, 0, scr, r, lane); continue; } r -= I_SD;
            const int e = r / (2 * I_EG + I_ED); r -= e * (2 * I_EG + I_ED);
            if (r < I_EG) { transpose_item_fp8(X.w_gate + (size_t)e * D * DE, D, DE, (unsigned char*)wgu_t + (size_t)e * 512 * D, 8, 0, S_WGU8, scr, r, lane); continue; } r -= I_EG;
            if (r < I_EG) { transpose_item_fp8(X.w_up + (size_t)e * D * DE, D, DE, (unsigned char*)wgu_t + (size_t)e * 512 * D, 8, 1, S_WGU8, scr, r, lane); continue; } r -= I_EG;
            transpose_item_fp8(X.w_down + (size_t)e * DE * D, DE, D, (unsigned char*)wd_t + (size_t)e * D * DE, 0, 0, S_WD8, scr, r, lane);
        }
        for (int i = gt; i < SEQ * 64; i += NGT) rope_entry(rope, i);
    }
    SEAM(0);
    REPS(1) if (IN(1)) { PH_BEGIN
        const float* modp = (const float*)(ws + WS_PROJ);
        for (int i = gt; i < 32 * 6144; i += NGT) mod[i] = mod_sum(modp, X.b_ada, i / 6144, i % 6144);
        LAS float* ssc = (LAS float*)lds; LAS float* ssh = ssc + 1024;
        int curb = -1;
        for (int c = bx; c < M / 256; c += G) {
            const int b = c >> 3;
            if (b != curb) {
                __syncthreads();
                for (int i = tid; i < 1024; i += NW * 64) { ssc[i] = 1.f + mod_sum(modp, X.b_ada, b, MOD_SCALE_A + i); ssh[i] = mod_sum(modp, X.b_ada, b, MOD_SHIFT_A + i); }
                __syncthreads();
                curb = b;
            }
            const f32x4 sc = *(const LAS f32x4*)(ssc + (tid & 255) * 4), sh = *(const LAS f32x4*)(ssh + (tid & 255) * 4);
            const float* xp = X.x + (size_t)c * 256 * D + (size_t)(tid >> 8) * D + (tid & 255) * 4;
            unsigned char* hp = (unsigned char*)hbuf + (size_t)c * 256 * D + (size_t)(tid >> 8) * D + (tid & 255) * 4;
            for (int i0 = 0; i0 < 128; i0 += 8) {
                f32x4 v[8];
#pragma unroll
                for (int i = 0; i < 8; ++i) v[i] = __builtin_nontemporal_load((const f32x4*)(xp + (size_t)(i0 + i) * 2 * D));
#pragma unroll
                for (int i = 0; i < 8; ++i) { int w = __builtin_amdgcn_cvt_pk_fp8_f32(clamp8((v[i].x * sc.x + sh.x) * S_H8), clamp8((v[i].y * sc.y + sh.y) * S_H8), 0, false);
                    w = __builtin_amdgcn_cvt_pk_fp8_f32(clamp8((v[i].z * sc.z + sh.z) * S_H8), clamp8((v[i].w * sc.w + sh.w) * S_H8), w, true); *(unsigned*)(hp + (size_t)(i0 + i) * 2 * D) = (unsigned)w; }
            }
        }
        __syncthreads();
    }
    SEAM(1);
    REPS(2) if (IN(2)) { PH_BEGIN
        pg8::DenseOrder S; S.init(M, DIN, D / 2, win_t, G, bx);
        pg8::EpiInProj E{proj};
        pg8::gemm_phase<1>(lds, (const char*)hbuf, D, S, E, tid);
    }
    SEAM(2);
    REPS(3) if (IN(3)) { PH_BEGIN
        REPS(31) for (int hu = bx; hu < BATCH * 4 * 2; hu += G) ret::unit(proj, rope, X.ret_ld, X.ret_gn, ymix, (unsigned char*)out + (size_t)hu * (8 * ret::TILE), lds, hu, tid);
        REPS(32) for (int u = bx; u < BATCH * 8; u += G) na::unit(proj, X.na_rpb, ymix, lds, u, tid);
    }
    SEAM2(3, 5);
    if (IN(5)) { PH_BEGIN
        LAS float* cv = (LAS float*)lds; LAS unsigned* hist = tab + T_HIST;
        if (tid < NE) hist[tid] = 0u;
        __syncthreads();
        for (int c = bx; c < M / 256; c += G) {
            const int b = c >> 3;
            { pg8::RowOrder S{c, 4, D, (const char*)wout_t}; pg8::EpiOutProj E{X.x, mod, (bf16_t*)(ws + WS_TB)}; pg8::gemm_phase(lds, (const char*)ymix, D, S, E, tid); }
            asm volatile("s_waitcnt vmcnt(0)" ::: "memory"); __syncthreads();
            int lane2 = lane; asm volatile("" : "+v"(lane2));
            const int tid2 = wave * 64 + lane2;
            if (tid2 < 256) { const int i = tid2 * 4; *(LAS f32x4*)(cv + i) = *(const f32x4*)(X.ln1_g + i); *(LAS f32x4*)(cv + 1024 + i) = *(const f32x4*)(X.ln1_b + i);
                *(LAS f32x4*)(cv + 2048 + i) = *(const f32x4*)(mod + b * 6144 + MOD_SCALE_F + i) + 1.f; *(LAS f32x4*)(cv + 3072 + i) = *(const f32x4*)(mod + b * 6144 + MOD_SHIFT_F + i); }
            __syncthreads();
            { const bf16_t* tp = (const bf16_t*)(ws + WS_TB) + (size_t)(c * 256 + wave * 32) * D + lane2 * 16;
              u32x4 ra = *(const u32x4*)tp, rb = *(const u32x4*)(tp + 8);
#pragma unroll 1
              for (int i = 0; i < 32; ++i) {
                  const u32x4 ca = ra, cb = rb; const int nx = i < 31 ? i + 1 : i;
                  ra = *(const u32x4*)(tp + (size_t)nx * D); rb = *(const u32x4*)(tp + (size_t)nx * D + 8);
                  ln1_row(ca, cb, cv, hf, ws + WS_HF8, (float*)(ws + WS_STATS), c * 256 + wave * 32 + i, lane2);
              } }
            asm volatile("s_waitcnt vmcnt(0)" ::: "memory"); __syncthreads();
            { pg8::RowOrder S{c, 1, D, (const char*)wr_t}; pg8::EpiRouter E{logits}; pg8::gemm_phase(lds, (const char*)hf, D, S, E, tid); }
            { pg8::RowOrder S{c, 2, D, (const char*)wsgu_t}; pg8::EpiGU<false> E{(void*)shh}; pg8::gemm_phase(lds, (const char*)hf, D, S, E, tid); }
            asm volatile("s_waitcnt vmcnt(0)" ::: "memory"); __syncthreads();
            { int lane3 = lane; asm volatile("" : "+v"(lane3)); const int tid3 = wave * 64 + lane3;
              if (tid3 < 256) route_lane(logits, X.rbias, topk_e, topk_w, hist, c * 256 + tid3); }
        }
        __syncthreads();
        if (tid < NE && hist[tid]) atomicAdd(&ctl[CW_COUNT + tid], hist[tid]);
    }
    SEAM2(5, 9);
    if (IN(9)) { PH_BEGIN
        build_tables(ctl, tab, tid);
        LAS unsigned* hist = tab + T_HIST; LAS unsigned* base = tab + T_BASE;
        for (int c0 = bx * 2048; c0 < NSLOT; c0 += G * 2048) {
            __syncthreads();
            if (tid < NE) hist[tid] = 0u;
            __syncthreads();
            int e[4]; unsigned loc[4];
#pragma unroll
            for (int i = 0; i < 4; ++i) { const int idx = c0 + i * 512 + tid; e[i] = topk_e[idx]; loc[i] = __hip_atomic_fetch_add(&hist[e[i]], 1u, __ATOMIC_RELAXED, __HIP_MEMORY_SCOPE_WORKGROUP); }
            __syncthreads();
            if (tid < NE && hist[tid]) base[tid] = atomicAdd(&ctl[CW_CURSOR + tid], hist[tid]);
            __syncthreads();
#pragma unroll
            for (int i = 0; i < 4; ++i) { const int idx = c0 + i * 512 + tid; const unsigned pos = tab[T_OFF + e[i]] + base[e[i]] + loc[i]; slot_ent[pos] = idx; slot_w[pos] = topk_w[idx]; }
        }
    }
    SEAM(9);
    if (IN(10)) { PH_BEGIN
        build_tables(ctl, tab, tid);
        REPS(10) { pg8::ExpertOrder<2, true> S; S.init(tab, D, wgu_t, (size_t)512 * D, slot_ent, slot_w, G, bx); pg8::EpiGU<true> E{(void*)act}; pg8::gemm_phase<1>(lds, (const char*)(ws + WS_HF8), D, S, E, tid); }
        { pg8::DenseOrder S; S.init(M, D, DE, wsd_t, G, bx); pg8::EpiSharedDown E{ws + WS_YSH}; pg8::gemm_phase(lds, (const char*)shh, DE, S, E, tid); }
    }
    SEAM(10);
    REPS(11) if (IN(11)) { PH_BEGIN
        build_tables(ctl, tab, tid);
#if MK_DUP >= 113 && MK_DUP <= 118
        pg8::down2_phase<MK_DUP - 112>(lds, tab, (const char*)act, (const char*)wd_t, slot_ent, ybuf, G, bx, tid);
#endif
        pg8::down2_phase(lds, tab, (const char*)act, (const char*)wd_t, slot_ent, ybuf, G, bx, tid);
#if MK_DUP == 111
        { pg8::ExpertOrder<4, false> S2; S2.init(tab, DE, wd_t, (size_t)D * DE, slot_ent, slot_w, G, bx); pg8::EpiProbeSum E2{(float*)(ws + WS_STATS)}; pg8::gemm_phase<1>(lds, (const char*)act, DE, S2, E2, tid); }
#endif
    }
    SEAM(11);
    REPS(12) if (IN(12)) { PH_BEGIN
        LAS float* cv = (LAS float*)lds; int curb = -1;
        for (int c = bx; c < M / 256; c += G) {
            const int b = c >> 3;
            if (b != curb) {
                __syncthreads();
                if (tid < 256) { const int i = tid * 4; *(LAS f32x4*)(cv + i) = *(const f32x4*)(X.ln1_g + i); *(LAS f32x4*)(cv + 1024 + i) = *(const f32x4*)(X.ln1_b + i);
                    *(LAS f32x4*)(cv + 2048 + i) = *(const f32x4*)(X.ln2_g + i); *(LAS f32x4*)(cv + 3072 + i) = *(const f32x4*)(X.ln2_b + i); *(LAS f32x4*)(cv + 4096 + i) = *(const f32x4*)(mod + b * 6144 + MOD_GATE_F + i); }
                __syncthreads(); curb = b;
            }
            const int r0 = c * 256 + wave * 32;
            RowRaw nx; final_load(nx, (const bf16_t*)(ws + WS_TB), ybuf, ws + WS_YSH, (const float*)(ws + WS_STATS), r0, lane);
#pragma unroll 1
            for (int i = 0; i < 32; ++i) {
                const RowRaw cur = nx;
                final_load(nx, (const bf16_t*)(ws + WS_TB), ybuf, ws + WS_YSH, (const float*)(ws + WS_STATS), r0 + (i < 31 ? i + 1 : i), lane);
                final_row(out, cur, cv, r0 + i, lane);
            }
        }
    }
#undef IN
#undef SEAM
}

extern "C" void kernel_launch(void* const* d_in, const int* in_sizes, int n_in, void* d_out, int out_size, void* d_ws, size_t ws_size, hipStream_t stream) {
    static int grid = 0;
    if (grid == 0) {
        if (n_in != 21 || in_sizes[0] != M * D || out_size != M * D || ws_size < WS_END) { fprintf(stderr, "kernel_launch: unexpected shapes (n_in %d, ws %zu)\n", n_in, ws_size); grid = -1; return; }
        int dev = 0, cus = 0, per_cu = 0;
        if (hipGetDevice(&dev) != hipSuccess || hipDeviceGetAttribute(&cus, hipDeviceAttributeMultiprocessorCount, dev) != hipSuccess) { grid = -1; return; }
        if (hipFuncSetAttribute((const void*)mk_fwd, hipFuncAttributeMaxDynamicSharedMemorySize, LDS_BYTES) != hipSuccess) { fprintf(stderr, "kernel_launch: hipFuncSetAttribute failed\n"); grid = -1; return; }
        if (hipOccupancyMaxActiveBlocksPerMultiprocessor(&per_cu, (const void*)mk_fwd, NW * 64, LDS_BYTES) != hipSuccess || per_cu < 1) { fprintf(stderr, "kernel_launch: occupancy query says %d\n", per_cu); }
        (void)hipGetLastError();
        grid = cus;
    }
    if (grid < 0) return;
    (void)hipMemsetAsync((char*)d_ws + WS_CTL, 0, 1 * MiB, stream);
    Args a{};
    const float** p = (const float**)&a.X;
    for (int i = 0; i < 21; ++i) p[i] = (const float*)d_in[i];
    a.X.out = (float*)d_out; a.X.ws = (unsigned char*)d_ws;
#if MK_PER_PHASE
    for (int ph = 0; ph < N_PHASES; ++ph) { a.ph_lo = ph; a.ph_hi = ph + 1; hipLaunchKernelGGL(mk_fwd, dim3(grid), dim3(NW * 64), LDS_BYTES, stream, a); }
#else
    a.ph_lo = 0; a.ph_hi = N_PHASES;
    hipLaunchKernelGGL(mk_fwd, dim3(grid), dim3(NW * 64), LDS_BYTES, stream, a);
#endif
}
```

```cpp
#include <hip/hip_runtime.h>
#include <cstdio>
#include <cstdint>

typedef unsigned short bf16_t;
typedef short bf16x8 __attribute__((ext_vector_type(8)));
typedef float f32x4 __attribute__((ext_vector_type(4)));
typedef float f32x2 __attribute__((ext_vector_type(2)));
typedef unsigned u32x4 __attribute__((ext_vector_type(4)));
typedef unsigned u32x2 __attribute__((ext_vector_type(2)));
#define LAS __attribute__((address_space(3)))

constexpr int D = 1024, BATCH = 32, SEQ = 2048, M = BATCH * SEQ;
constexpr int DIN = 3584;
constexpr int OFF_QNA = 0, OFF_KNA = 512, OFF_VNA = 1024, OFF_QR = 1536, OFF_KR = 2048, OFF_VR = 2560, OFF_GR = 3072;
constexpr int NE = 256, TOPK = 8, DE = 256;
constexpr int NSLOT = M * TOPK;
constexpr float LN_EPS = 1e-5f, GN_EPS = 1e-6f;
constexpr float ALPHA = 1.189207115002721f;
constexpr float YSCALE = 64.f, YINV = 1.f / 64.f;
constexpr float S_HF8 = 16.f, S_WGU8 = 256.f, S_ACT8 = 32.f, S_WD8 = 128.f;
constexpr float INV_GU8 = 1.f / (16.f * 256.f), INV_DN8 = 1.f / (32.f * 128.f);
constexpr float S_H8 = 16.f, S_WIN8 = 128.f, INV_IN8 = 1.f / (16.f * 128.f);
constexpr int MOD_SHIFT_A = 0, MOD_SCALE_A = 1024, MOD_GATE_A = 2048, MOD_SHIFT_F = 3072, MOD_SCALE_F = 4096, MOD_GATE_F = 5120;

constexpr size_t MiB = 1u << 20;
constexpr size_t WS_CTL = 0;
constexpr size_t WS_MOD = 1 * MiB;
constexpr size_t WS_ROPE = 2 * MiB;
constexpr size_t WS_WIN_T = 4 * MiB;
constexpr size_t WS_WOUT_T = 11 * MiB;
constexpr size_t WS_WR_T = 13 * MiB;
constexpr size_t WS_WSGU_T = 14 * MiB;
constexpr size_t WS_WSD_T = 15 * MiB;
constexpr size_t WS_SLOT_ENT = 16 * MiB;
constexpr size_t WS_SLOT_W = 18 * MiB;
constexpr size_t WS_TOPK_E = 20 * MiB;
constexpr size_t WS_TOPK_W = 22 * MiB;
constexpr size_t WS_STATS = 24 * MiB;
constexpr size_t WS_WD_T = 32 * MiB;
constexpr size_t WS_WGU_T = 160 * MiB;
constexpr size_t WS_HF8 = 288 * MiB;
constexpr size_t WS_YMIX = 416 * MiB;
constexpr size_t WS_PROJ = 544 * MiB;
constexpr size_t WS_LOGITS = WS_PROJ + 384 * MiB;
constexpr size_t WS_SHH = 352 * MiB;
constexpr size_t WS_HF = WS_PROJ, WS_ACT = WS_PROJ + 128 * MiB;
constexpr size_t WS_YBUF = WS_WGU_T;
constexpr size_t WS_TB = WS_PROJ + 256 * MiB;
constexpr size_t WS_YSH = WS_PROJ + 384 * MiB;
constexpr size_t WS_END = 992 * MiB;
constexpr int CW_COUNT = 1024, CW_CURSOR = 1536, CW_BAR = 8192;

constexpr int RING_BYTES = 131072;
constexpr int TAB_OFF = RING_BYTES;
constexpr int T_OFF = 0, T_TILE = 260, T_CNT = 520, T_HIST = 776, T_BASE = 1032, TAB_WORDS = 1288;
constexpr int VN_OFF = TAB_OFF + 6144;
constexpr int ROWTAB_OFF = VN_OFF + 8192;
constexpr int PHASE_BYTES = 155648;
constexpr int MISC_OFF = PHASE_BYTES;
constexpr int LDS_BYTES = PHASE_BYTES + 256;
static_assert(TAB_WORDS * 4 <= 6144 && ROWTAB_OFF + 6144 <= PHASE_BYTES && LDS_BYTES <= 163840, "LDS map");

__device__ __forceinline__ unsigned f2bf(float f) { unsigned u = __float_as_uint(f); return (u + 0x7fffu + ((u >> 16) & 1u)) >> 16; }
__device__ __forceinline__ float bf2f(unsigned short h) { return __uint_as_float(((unsigned)h) << 16); }
__device__ __forceinline__ unsigned pk2(float lo, float hi) { return f2bf(lo) | (f2bf(hi) << 16); }
__device__ __forceinline__ unsigned cvt_pk_bf16(float lo, float hi) { unsigned r; asm volatile("v_cvt_pk_bf16_f32 %0, %1, %2" : "=v"(r) : "v"(lo), "v"(hi)); return r; }
__device__ __forceinline__ float silu_f(float v) { return v * __builtin_amdgcn_rcpf(1.f + __expf(-v)); }
__device__ __forceinline__ float wave_sum(float v) {
    v += __builtin_bit_cast(float, __builtin_amdgcn_update_dpp(0, __builtin_bit_cast(int, v), 0xB1, 0xf, 0xf, true));
    v += __builtin_bit_cast(float, __builtin_amdgcn_update_dpp(0, __builtin_bit_cast(int, v), 0x4E, 0xf, 0xf, true));
    v += __builtin_bit_cast(float, __builtin_amdgcn_update_dpp(0, __builtin_bit_cast(int, v), 0x141, 0xf, 0xf, true));
    v += __builtin_bit_cast(float, __builtin_amdgcn_update_dpp(0, __builtin_bit_cast(int, v), 0x140, 0xf, 0xf, true));
    const int b = __builtin_bit_cast(int, v);
    return (__builtin_bit_cast(float, __builtin_amdgcn_readlane(b, 0)) + __builtin_bit_cast(float, __builtin_amdgcn_readlane(b, 16))) + (__builtin_bit_cast(float, __builtin_amdgcn_readlane(b, 32)) + __builtin_bit_cast(float, __builtin_amdgcn_readlane(b, 48)));
}
__device__ __forceinline__ float clamp8(float v) { return __builtin_amdgcn_fmed3f(v, -440.f, 440.f); }
#define LDS_WAIT() asm volatile("s_waitcnt lgkmcnt(0)" ::: "memory")
__device__ __forceinline__ int lane_id() { return (int)__builtin_amdgcn_mbcnt_hi(~0u, __builtin_amdgcn_mbcnt_lo(~0u, 0u)); }

#define XB_TMO      128
#define XB_XCNT(j)  (256  + 64 * (j))
#define XB_XSUB(j)  (1280 + 64 * (j))
#define XB_XGEN(j)  (2304 + 64 * (j))
#define XB_TOP      3328
#define XB_TOPGEN   3392
#define XCD_BAR_WORDS 3456
#define XB_SPIN_CAP (1u << 23)
__device__ __forceinline__ unsigned xb_ld(unsigned* p)              { return __hip_atomic_load(p, __ATOMIC_RELAXED, __HIP_MEMORY_SCOPE_AGENT); }
__device__ __forceinline__ unsigned xb_add(unsigned* p, unsigned v) { return __hip_atomic_fetch_add(p, v, __ATOMIC_RELAXED, __HIP_MEMORY_SCOPE_AGENT); }
__device__ __forceinline__ unsigned xb_xcc_id() { return (unsigned)__builtin_amdgcn_s_getreg((3 << 11) | 20) & 0xFu; }
#define XB_SPIN(cond, bar) do { unsigned _sp = 0; while (cond) { __builtin_amdgcn_s_sleep(1); \
    if ((++_sp & 255u) == 0u) { if (xb_ld(&(bar)[XB_TMO])) break; if (_sp > XB_SPIN_CAP) { atomicAdd(&(bar)[XB_TMO], 1u); break; } } } } while (0)
struct XcdBarrier { unsigned* bar; unsigned x; volatile LAS unsigned* st; };
__device__ __forceinline__ XcdBarrier xcd_barrier_post(unsigned* bar, volatile LAS unsigned* st, bool leader) {
    XcdBarrier b; b.bar = bar; b.x = xb_xcc_id(); b.st = st;
    if (leader) (void)xb_add(&bar[XB_XCNT(b.x)], 1u);
    return b;
}
__device__ __forceinline__ void xcd_barrier_complete(unsigned* bar, unsigned x, unsigned& nloc, unsigned& nx) {
    const unsigned G = gridDim.x * gridDim.y * gridDim.z;
    unsigned sum, cnt, mine, sp = 0u;
    for (;;) {
        sum = 0u; cnt = 0u; mine = 0u;
#pragma unroll
        for (unsigned j = 0; j < 16; ++j) { const unsigned c = xb_ld(&bar[XB_XCNT(j)]); sum += c; cnt += (c > 0u) ? 1u : 0u; mine = (j == x) ? c : mine; }
        if (sum == G) break;
        __builtin_amdgcn_s_sleep(1);
        if ((++sp & 255u) == 0u) { if (xb_ld(&bar[XB_TMO])) break; if (sp > XB_SPIN_CAP) { atomicAdd(&bar[XB_TMO], 1u); break; } }
    }
    nloc = mine > 0u ? mine : 1u; nx = cnt > 0u ? cnt : 1u;
}
__device__ __forceinline__ void xcd_barrier(const XcdBarrier& b, bool leader) {
    asm volatile("s_waitcnt vmcnt(0)" ::: "memory");
    __syncthreads();
    if (leader) {
        unsigned* bar = b.bar;
        __builtin_amdgcn_s_waitcnt(0);
        unsigned nloc = b.st[0], nx = b.st[1];
        if (nloc == 0u) { xcd_barrier_complete(bar, b.x, nloc, nx); b.st[0] = nloc; b.st[1] = nx; }
        const unsigned old = xb_add(&bar[XB_XSUB(b.x)], 1u);
        const unsigned gen = old / nloc;
        if (old + 1u == (gen + 1u) * nloc) {
            __builtin_amdgcn_fence(__ATOMIC_RELEASE, "agent");
            asm volatile("s_waitcnt vmcnt(0)" ::: "memory");
            const unsigned og = xb_add(&bar[XB_TOP], 1u);
            const unsigned tg = og / nx;
            if (og + 1u == (tg + 1u) * nx) xb_add(&bar[XB_TOPGEN], 1u);
            else XB_SPIN(xb_ld(&bar[XB_TOPGEN]) == tg, bar);
            __builtin_amdgcn_fence(__ATOMIC_ACQUIRE, "agent");
            xb_add(&bar[XB_XGEN(b.x)], 1u);
            asm volatile("s_waitcnt vmcnt(0)" ::: "memory");
        } else {
            XB_SPIN(xb_ld(&bar[XB_XGEN(b.x)]) == gen, bar);
            __builtin_amdgcn_fence(__ATOMIC_ACQUIRE, "agent");
            asm volatile("s_waitcnt vmcnt(0)" ::: "memory");
        }
    }
    __syncthreads();
}

namespace pg8 {
constexpr int BM = 256, BK = 64, HALF = 128, HTB = HALF * BK * 2, STAGE_BYTES = 8 * HTB;
__device__ __forceinline__ int lds_byte(int r, int c) { const int st = (r >> 4) * 2 + (c >> 5), rr = r & 15, cc = c & 31, ob = rr * 64 + cc * 2; return st * 1024 + (ob ^ (((ob >> 9) & 1) << 5)); }
__device__ __forceinline__ void stage_rc(int b, int& R, int& C) { const int st = b / 1024, sb = b % 1024, swz = sb ^ (((sb >> 9) & 1) << 5); R = (st >> 1) * 16 + swz / 64; C = (st & 1) * 32 + (swz % 64) / 2; }
__device__ __forceinline__ int perm32(int rho) { const int n = rho >> 4, i = rho & 15; return 8 * (i >> 2) + 4 * n + (i & 3); }

typedef int i32x8 __attribute__((ext_vector_type(8)));
__device__ __forceinline__ i32x8 cat8(const bf16x8 lo, const bf16x8 hi) { const u32x4 a = __builtin_bit_cast(u32x4, lo), b = __builtin_bit_cast(u32x4, hi); return (i32x8){(int)a.x, (int)a.y, (int)a.z, (int)a.w, (int)b.x, (int)b.y, (int)b.z, (int)b.w}; }
struct Unit { int pm, pn; const char* B; int e, cnt, off; };

template <int ESZ = 2, bool AREUSE = false, class Epi, class Sched>
__device__ __forceinline__ void gemm_phase(LAS unsigned char* lds, const char* Abase, const int K, const Sched& S, const Epi& E, const int tid_in) {
    int tid_ = tid_in; asm volatile("" : "+v"(tid_));
    const int tid = tid_, wid = __builtin_amdgcn_readfirstlane(tid >> 6), lane = tid & 63, wr = wid >> 2, wc = wid & 3, fr = lane & 15, fq = lane >> 4;
    const int rowbytes = K * ESZ, nt = rowbytes / 128;
    int Rr[2], Cc[2]; unsigned voffB[2], voffA[2];
#pragma unroll
    for (int i = 0; i < 2; ++i) { int R, C; stage_rc(tid * 16 + i * 8192, R, C); Rr[i] = R; Cc[i] = C; const int Rb = Epi::PERM ? (64 * (R >> 5) + 16 * ((R >> 2) & 3) + 4 * ((R >> 4) & 1) + (R & 3)) : R; voffB[i] = (unsigned)(Rb * rowbytes + C * 2); voffA[i] = (unsigned)(R * rowbytes + C * 2); }
    constexpr bool GATHER = Sched::GATHER;
    const size_t kstep = (size_t)128;
    const size_t hstep = (size_t)HALF * rowbytes;
    const size_t bhstep = (size_t)(Epi::PERM ? 8 : HALF) * rowbytes;
    const unsigned ldsw = (unsigned)wid * 1024u;
    const int aoff = lds_byte(wr * 64 + fr, fq * 8);
    const int boff = lds_byte(wc * 32 + fr, fq * 8);
#define PG8_SA(b, h) (((b) * 2 + (h)) * HTB)
#define PG8_SB(b, h) ((4 + (b) * 2 + (h)) * HTB)
#define PG8_STAGE(bufoff, gbase, voff) do { _Pragma("unroll") for (int _i = 0; _i < 2; ++_i) \
        __builtin_amdgcn_global_load_lds((const unsigned*)((const char*)(gbase) + (voff)[_i]), (LAS unsigned*)(lds + (bufoff) + ldsw + _i * 8192), 16, 0, 0); } while (0)
#define PG8_STAGEA(bufoff, uptr, koff, NEXT, h) do { if constexpr (GATHER) { if (NEXT) { const u32x2 _t = *(const LAS u32x2*)(vnslot + 2 * (h)); unsigned _v[2] = {_t.x, _t.y}; PG8_STAGE(bufoff, Abase + (koff), _v); } else { PG8_STAGE(bufoff, Abase + (koff), vc[h]); } } \
        else { PG8_STAGE(bufoff, (uptr) + (size_t)(h) * hstep + (koff), voffA); } } while (0)
#define PG8_LDA(dst, b, h) do { _Pragma("unroll") for (int m = 0; m < 4; ++m) { if constexpr (ESZ == 2) { _Pragma("unroll") for (int k = 0; k < 2; ++k) dst[m].q[k] = *(const LAS bf16x8*)(lds + PG8_SA(b, h) + aoff + m * 2048 + k * 1024); } \
        else dst[m].w = cat8(*(const LAS bf16x8*)(lds + PG8_SA(b, h) + aoff + m * 2048), *(const LAS bf16x8*)(lds + PG8_SA(b, h) + aoff + m * 2048 + 1024)); } } while (0)
#define PG8_LDB(dst, b, h) do { _Pragma("unroll") for (int n = 0; n < 2; ++n) { if constexpr (ESZ == 2) { _Pragma("unroll") for (int k = 0; k < 2; ++k) dst[n].q[k] = *(const LAS bf16x8*)(lds + PG8_SB(b, h) + boff + n * 2048 + k * 1024); } \
        else dst[n].w = cat8(*(const LAS bf16x8*)(lds + PG8_SB(b, h) + boff + n * 2048), *(const LAS bf16x8*)(lds + PG8_SB(b, h) + boff + n * 2048 + 1024)); } } while (0)
#define PG8_MMA(ai, bj, At, Bt) do { __builtin_amdgcn_s_setprio(1); _Pragma("unroll") for (int m = 0; m < 4; ++m) _Pragma("unroll") for (int n = 0; n < 2; ++n) { \
        if constexpr (ESZ == 2) { _Pragma("unroll") for (int k = 0; k < 2; ++k) acc[ai][bj][m][n] = __builtin_amdgcn_mfma_f32_16x16x32_bf16(Bt[n].q[k], At[m].q[k], acc[ai][bj][m][n], 0, 0, 0); } \
        else { asm volatile("v_mfma_f32_16x16x128_f8f6f4 %0, %1, %2, %0" : "+v"(acc[ai][bj][m][n]) : "v"(Bt[n].w), "v"(At[m].w)); } } \
        __builtin_amdgcn_s_setprio(0); } while (0)
#define PG8_WAIT_V(n) asm volatile("s_waitcnt vmcnt(" #n ")" ::: "memory")
#define PG8_WAIT_L(n) asm volatile("s_waitcnt lgkmcnt(" #n ")" ::: "memory")
#define PG8_BAR __builtin_amdgcn_s_barrier()
#define PG8_SCHED __builtin_amdgcn_sched_barrier(0)
    Unit cur, nxt; int ui = 0; bool fresh_cur = true;
    if (!S.next(0, cur)) return;
    f32x4 acc[2][2][4][2];
    union Frag { bf16x8 q[2]; i32x8 w; };
    Frag At[4], B0[2], B1[2];
    unsigned vc[2][2];
    LAS unsigned* vnslot = (LAS unsigned*)(lds + (VN_OFF - 0)) + tid * 4;
    if constexpr (GATHER) S.avoff(cur, Rr, Cc, vc, tid);
    LAS unsigned* rowtab = (LAS unsigned*)(lds + ROWTAB_OFF);
    if constexpr (GATHER) S.rowtab(cur, rowtab, tid);
    const char* cB = cur.B; const char* cA = Abase + S.aoff(cur);
    PG8_STAGE(PG8_SB(0, 0), cB, voffB); PG8_STAGE(PG8_SB(0, 1), cB + bhstep, voffB); PG8_STAGEA(PG8_SA(0, 0), cA, 0, false, 0); PG8_STAGEA(PG8_SA(0, 1), cA, 0, false, 1);
    if (wr == 1) PG8_BAR;
    PG8_WAIT_V(2); PG8_BAR;
    PG8_STAGE(PG8_SB(1, 0), cB + kstep, voffB); PG8_STAGEA(PG8_SA(1, 0), cA, kstep, false, 0); PG8_STAGE(PG8_SB(1, 1), cB + bhstep + kstep, voffB);
    PG8_WAIT_V(6); PG8_BAR;
    asm volatile("" ::: "memory");
#pragma unroll
    for (int a = 0; a < 2; ++a)
#pragma unroll
        for (int b = 0; b < 2; ++b)
#pragma unroll
            for (int m = 0; m < 4; ++m)
#pragma unroll
                for (int n = 0; n < 2; ++n) { acc[a][b][m][n] = (f32x4){0.f, 0.f, 0.f, 0.f}; asm volatile("" : "+v"(acc[a][b][m][n])); }
    asm volatile("s_nop 4" ::: "memory");
    for (;;) {
        const bool has_next = S.next(ui + 1, nxt);
        if constexpr (GATHER) {
            unsigned vn[2][2];
            if (has_next) S.avoff(nxt, Rr, Cc, vn, tid);
            else {
#pragma unroll
                for (int h = 0; h < 2; ++h)
#pragma unroll
                    for (int i = 0; i < 2; ++i) vn[h][i] = vc[h][i];
            }
            *(LAS u32x4*)vnslot = (u32x4){vn[0][0], vn[0][1], vn[1][0], vn[1][1]};
            if (has_next) S.rowtab(nxt, rowtab + 512 * ((ui + 1) % 3), tid);
        }
        const char* nB = has_next ? nxt.B : cB; const char* nA = has_next ? Abase + S.aoff(nxt) : cA;
        const bool fresh_nxt = !(AREUSE && has_next && nxt.e == cur.e && nxt.pm == cur.pm);
        const bool ff = fresh_cur && fresh_nxt;
#define PG8_WAITX do { if (!AREUSE || ff) PG8_WAIT_V(8); else PG8_WAIT_V(4); } while (0)
        for (int t = 0; t < nt; t += 2) {
            const bool last = (t == nt - 2);
            const size_t k1 = (size_t)(t + 1) * kstep;
            const size_t k2 = last ? (size_t)0 : (size_t)(t + 2) * kstep, k3 = k2 + kstep;
            const char* u2 = last ? nA : cA; const char* b2 = last ? nB : cB + (size_t)(t + 2) * kstep;
            const char* b3 = b2 + kstep;
            PG8_LDB(B0, 0, 0); PG8_LDB(B1, 0, 1); PG8_SCHED; PG8_LDA(At, 0, 0); if (!AREUSE || fresh_cur) PG8_STAGEA(PG8_SA(1, 1), cA, k1, false, 1);
            PG8_WAITX; PG8_WAIT_L(0); PG8_BAR; PG8_MMA(0, 0, At, B0); PG8_MMA(0, 1, At, B1); PG8_BAR; PG8_SCHED;
            PG8_LDA(At, 0, 1); PG8_STAGE(PG8_SB(0, 0), b2, voffB); PG8_STAGE(PG8_SB(0, 1), b2 + bhstep, voffB); if (!AREUSE || fresh_nxt) PG8_STAGEA(PG8_SA(0, 0), u2, k2, last, 0);
            PG8_WAITX; PG8_WAIT_L(0); PG8_BAR; PG8_MMA(1, 0, At, B0); PG8_MMA(1, 1, At, B1); PG8_BAR; PG8_SCHED;
            PG8_LDB(B0, 1, 0); PG8_LDB(B1, 1, 1); PG8_SCHED; PG8_LDA(At, 1, 0); if (!AREUSE || fresh_nxt) PG8_STAGEA(PG8_SA(0, 1), u2, k2, last, 1);
            PG8_WAITX; PG8_WAIT_L(0); PG8_BAR; PG8_MMA(0, 0, At, B0); PG8_MMA(0, 1, At, B1); PG8_BAR; PG8_SCHED;
            PG8_LDA(At, 1, 1); PG8_STAGE(PG8_SB(1, 0), b3, voffB); PG8_STAGE(PG8_SB(1, 1), b3 + bhstep, voffB); if (!AREUSE || fresh_nxt) PG8_STAGEA(PG8_SA(1, 0), u2, k3, last, 0);
            PG8_WAITX; PG8_WAIT_L(0); PG8_BAR; PG8_MMA(1, 0, At, B0); PG8_MMA(1, 1, At, B1); PG8_BAR; PG8_SCHED;
        }
#undef PG8_WAITX
        if (wr == 0) PG8_BAR;
        if constexpr (ESZ == 1) {
            asm volatile("s_nop 15\n\ts_nop 15" ::: "memory");
#pragma unroll
            for (int a = 0; a < 2; ++a)
#pragma unroll
                for (int b = 0; b < 2; ++b)
#pragma unroll
                    for (int m = 0; m < 4; ++m) asm volatile("" : "+v"(acc[a][b][m][0]), "+v"(acc[a][b][m][1]));
        }
        { const int l2 = lane_id(); E(acc, cur, wr, wc, l2 & 15, l2 >> 4, rowtab + 512 * (ui % 3)); }
        if (!has_next) break;
#pragma unroll
        for (int a = 0; a < 2; ++a)
#pragma unroll
            for (int b = 0; b < 2; ++b)
#pragma unroll
                for (int m = 0; m < 4; ++m)
#pragma unroll
                    for (int n = 0; n < 2; ++n) acc[a][b][m][n] = (f32x4){0.f, 0.f, 0.f, 0.f};
        cur = nxt; cB = nB; cA = nA; ++ui; fresh_cur = fresh_nxt;
        if constexpr (GATHER) { const u32x4 _t = *(const LAS u32x4*)vnslot; vc[0][0] = _t.x; vc[0][1] = _t.y; vc[1][0] = _t.z; vc[1][1] = _t.w; }
        if (wr == 1) PG8_BAR;
    }
    PG8_WAIT_V(0);
    PG8_BAR;
#undef PG8_SA
#undef PG8_SB
#undef PG8_STAGE
#undef PG8_STAGEA
#undef PG8_LDA
#undef PG8_LDB
#undef PG8_MMA
#undef PG8_WAIT_V
#undef PG8_WAIT_L
#undef PG8_BAR
#undef PG8_SCHED
}

struct DenseOrder {
    int nM, nN, nwg, G, c, K; const char* Bt;
    __device__ __forceinline__ void init(int Mrows, int N, int K_, const void* Bt_, int G_, int c_) { nM = Mrows / BM; nN = N / BM; nwg = nM * nN; G = G_; c = c_; K = K_; Bt = (const char*)Bt_; }
    __device__ __forceinline__ bool next(int i, Unit& u) const {
        const long L = (long)i * G + c; if (L >= nwg) return false;
        int wgid = (int)L; { const int q = nwg / 8, r = nwg % 8, xcd = wgid % 8, off = wgid / 8; wgid = (xcd < r ? xcd * (q + 1) : r * (q + 1) + (xcd - r) * q) + off; }
        const int nig = 8 * nN, gid = wgid / nig, fm = gid * 8, gsz = (nM - fm) < 8 ? (nM - fm) : 8;
        u.pm = fm + ((wgid % nig) % gsz); u.pn = (wgid % nig) / gsz; u.B = Bt + (size_t)u.pn * BM * K * 2; u.e = 0; u.cnt = 0; u.off = 0; return true;
    }
    static constexpr bool GATHER = false;
    __device__ __forceinline__ size_t aoff(const Unit& u) const { return (size_t)u.pm * BM * K * 2; }
    __device__ __forceinline__ void avoff(const Unit&, const int (&)[2], const int (&)[2], unsigned (&)[2][2], int) const {}
};
struct RowOrder {
    int pm, ncol, K; const char* Bt;
    static constexpr bool GATHER = false;
    __device__ __forceinline__ bool next(int i, Unit& u) const { if (i >= ncol) return false; u.pm = pm; u.pn = i; u.B = Bt + (size_t)i * BM * K * 2; u.e = 0; u.cnt = 0; u.off = 0; return true; }
    __device__ __forceinline__ size_t aoff(const Unit& u) const { return (size_t)u.pm * BM * K * 2; }
    __device__ __forceinline__ void avoff(const Unit&, const int (&)[2], const int (&)[2], unsigned (&)[2][2], int) const {}
};
template <int NCOL, bool TOKROWS, bool TILEMAJOR = false> struct ExpertOrder {
    static constexpr bool GATHER = true;
    __device__ __forceinline__ size_t aoff(const Unit&) const { return 0; }
    const LAS unsigned* tab; int per, c, K  ; const char* W; size_t wstride; const int* slot_ent; const float* slot_w;
    mutable int ehint = 0;
    int xbase, xend, xstride, xlb;
    __device__ __forceinline__ void init(const LAS unsigned* tab_, int K_, const void* W_, size_t wstride_, const int* slot_ent_, const float* slot_w_, int G, int c_) {
        tab = tab_; K = K_; W = (const char*)W_; wstride = wstride_; slot_ent = slot_ent_; slot_w = slot_w_; c = c_;
        const int U = (int)tab[T_TILE + NE] * (TILEMAJOR ? 1 : NCOL); per = (U + G - 1) / G;
        if (G % 8 == 0) { const int x = c_ % 8; const int q = U / 8, r = U % 8; xbase = x * q + (x < r ? x : r); xend = xbase + q + (x < r ? 1 : 0); xstride = G / 8; xlb = c_ / 8; }
        else { xbase = 0; xend = U; xstride = G; xlb = c_; }
    }
    __device__ __forceinline__ bool next(int i, Unit& u) const {
        const int L = TILEMAJOR ? xbase + (i / NCOL) * xstride + xlb : xbase + i * xstride + xlb;
        if (L >= xend) return false;
        const int tile = TILEMAJOR ? L : L / NCOL; u.pn = TILEMAJOR ? i % NCOL : L % NCOL;
        int lo = ehint;
        if (i == 0) { lo = 0; int hi = NE - 1; while (lo < hi) { const int mid = (lo + hi + 1) >> 1; if ((int)tab[T_TILE + mid] <= tile) lo = mid; else hi = mid - 1; } }
        else { while (lo < NE - 1 && (int)tab[T_TILE + lo + 1] <= tile) ++lo; }
        ehint = lo;
        u.e = lo; u.pm = tile - (int)tab[T_TILE + lo]; u.cnt = (int)tab[T_CNT + lo]; u.off = (int)tab[T_OFF + lo];
        u.B = W + (size_t)lo * wstride + (size_t)u.pn * BM * K; return true;
    }
    __device__ __forceinline__ void rowtab(const Unit& u, LAS unsigned* t, int tid) const {
        if (tid < BM) { int r = u.pm * BM + tid; if (r >= u.cnt) r = u.cnt - 1; t[tid] = (unsigned)slot_ent[u.off + r]; t[BM + tid] = __float_as_uint(slot_w[u.off + r]); }
    }
    __device__ __forceinline__ void avoff(const Unit& u, const int (&)[2], const int (&)[2], unsigned (&v)[2][2], int tidq) const {
        int R[2], C[2]; asm volatile("" : "+v"(tidq));
#pragma unroll
        for (int i = 0; i < 2; ++i) stage_rc(tidq * 16 + i * 8192, R[i], C[i]);
#pragma unroll
        for (int h = 0; h < 2; ++h)
#pragma unroll
            for (int i = 0; i < 2; ++i) {
                int r = u.pm * BM + h * HALF + R[i]; if (r >= u.cnt) r = u.cnt - 1;
                const int slot = u.off + r;
                const int row = TOKROWS ? (slot_ent[slot] >> 3) : slot;
                v[h][i] = (unsigned)(row * K + C[i] * 2);
            }
    }
};

struct EpiInProj {
    static constexpr bool PERM = true; bf16_t* O;
    __device__ __forceinline__ void operator()(const f32x4 (&acc)[2][2][4][2], const Unit& u, int wr, int wc, int fr, int fq, const LAS unsigned* rt) const {
        const float sc = INV_IN8 * ((u.pn < 2) ? 0.125f : ((u.pn == 8 || u.pn == 9) ? 0.08838834764831845f : 1.f));
        const int row0 = u.pm * BM + wr * 64 + fr, col0 = u.pn * BM + wc * 64 + 16 * fq;
#pragma unroll
        for (int ai = 0; ai < 2; ++ai)
#pragma unroll
            for (int m = 0; m < 4; ++m) { bf16_t* rowp = O + (size_t)(row0 + ai * HALF + m * 16) * DIN + col0;
#pragma unroll
                for (int bj = 0; bj < 2; ++bj) { const f32x4 v0 = acc[ai][bj][m][0] * sc, v1 = acc[ai][bj][m][1] * sc;
                    u32x4 w; w.x = cvt_pk_bf16(v0[0], v0[1]); w.y = cvt_pk_bf16(v0[2], v0[3]); w.z = cvt_pk_bf16(v1[0], v1[1]); w.w = cvt_pk_bf16(v1[2], v1[3]);
                    *(u32x4*)(rowp + 8 * bj) = w; } }
    }
};
struct EpiOutProj {
    static constexpr bool PERM = true; const float* x; const float* mod; bf16_t* tb;
    __device__ __forceinline__ void operator()(const f32x4 (&acc)[2][2][4][2], const Unit& u, int wr, int wc, int fr, int fq, const LAS unsigned* rt) const {
        const int b = (u.pm * BM) >> 11; const int col0 = u.pn * BM + wc * 64 + 16 * fq;
        f32x4 g[2][2];
#pragma unroll
        for (int bj = 0; bj < 2; ++bj)
#pragma unroll
            for (int n = 0; n < 2; ++n) g[bj][n] = *(const f32x4*)(mod + b * 6144 + MOD_GATE_A + col0 + 8 * bj + 4 * n) * INV_IN8;
#pragma unroll
        for (int ai = 0; ai < 2; ++ai)
#pragma unroll
            for (int m = 0; m < 4; ++m) { const size_t o = (size_t)(u.pm * BM + ai * HALF + wr * 64 + m * 16 + fr) * D + col0;
#pragma unroll
                for (int bj = 0; bj < 2; ++bj) {
                    const f32x4 t0 = *(const f32x4*)(x + o + 8 * bj) * ALPHA + g[bj][0] * acc[ai][bj][m][0], t1 = *(const f32x4*)(x + o + 8 * bj + 4) * ALPHA + g[bj][1] * acc[ai][bj][m][1];
                    u32x4 w; w.x = cvt_pk_bf16(t0[0], t0[1]); w.y = cvt_pk_bf16(t0[2], t0[3]); w.z = cvt_pk_bf16(t1[0], t1[1]); w.w = cvt_pk_bf16(t1[2], t1[3]);
                    *(u32x4*)(tb + o + 8 * bj) = w; } }
    }
};
struct EpiRouter {
    static constexpr bool PERM = false; float* out;
    __device__ __forceinline__ void operator()(const f32x4 (&acc)[2][2][4][2], const Unit& u, int wr, int wc, int fr, int fq, const LAS unsigned* rt) const {
        const int col0 = wc * 32 + 4 * fq;
#pragma unroll
        for (int ai = 0; ai < 2; ++ai)
#pragma unroll
            for (int m = 0; m < 4; ++m) { float* rowp = out + (size_t)(u.pm * BM + ai * HALF + wr * 64 + m * 16 + fr) * NE + col0;
#pragma unroll
                for (int bj = 0; bj < 2; ++bj)
#pragma unroll
                    for (int n = 0; n < 2; ++n) *(f32x4*)(rowp + bj * HALF + n * 16) = acc[ai][bj][m][n]; }
    }
};
template <bool EXPERT, bool F8IN = EXPERT> struct EpiGU {
    static constexpr bool PERM = true; void* Ov;
    __device__ __forceinline__ void operator()(const f32x4 (&acc)[2][2][4][2], const Unit& u, int wr, int wc, int fr, int fq, const LAS unsigned* rt) const {
        const int h0 = u.pn * HALF + wc * 32 + 8 * fq;
#pragma unroll
        for (int ai = 0; ai < 2; ++ai)
#pragma unroll
            for (int m = 0; m < 4; ++m) {
                const int rtw = u.pm * BM + ai * HALF + wr * 64 + m * 16 + fr;
                if (EXPERT) { if (rtw >= u.cnt) continue; }
                const float w = EXPERT ? __uint_as_float(rt[BM + ai * HALF + wr * 64 + m * 16 + fr]) * (S_ACT8 * INV_GU8) : (F8IN ? INV_GU8 : 1.f);
                const float gs = F8IN ? INV_GU8 : 1.f;
                const f32x4 g0 = acc[ai][0][m][0] * gs, g1 = acc[ai][0][m][1] * gs, u0 = acc[ai][1][m][0], u1 = acc[ai][1][m][1];
                const float h[8] = {w * silu_f(g0[0]) * u0[0], w * silu_f(g0[1]) * u0[1], w * silu_f(g0[2]) * u0[2], w * silu_f(g0[3]) * u0[3],
                                    w * silu_f(g1[0]) * u1[0], w * silu_f(g1[1]) * u1[1], w * silu_f(g1[2]) * u1[2], w * silu_f(g1[3]) * u1[3]};
                if (EXPERT) {
                    int w0 = __builtin_amdgcn_cvt_pk_fp8_f32(clamp8(h[0]), clamp8(h[1]), 0, false); w0 = __builtin_amdgcn_cvt_pk_fp8_f32(clamp8(h[2]), clamp8(h[3]), w0, true);
                    int w1 = __builtin_amdgcn_cvt_pk_fp8_f32(clamp8(h[4]), clamp8(h[5]), 0, false); w1 = __builtin_amdgcn_cvt_pk_fp8_f32(clamp8(h[6]), clamp8(h[7]), w1, true);
                    u32x2 o; o.x = (unsigned)w0; o.y = (unsigned)w1; *(u32x2*)((unsigned char*)Ov + (size_t)(u.off + rtw) * DE + h0) = o;
                    asm volatile("" ::: "memory");
                } else {
                    u32x4 o; o.x = cvt_pk_bf16(h[0], h[1]); o.y = cvt_pk_bf16(h[2], h[3]); o.z = cvt_pk_bf16(h[4], h[5]); o.w = cvt_pk_bf16(h[6], h[7]);
                    *(u32x4*)((bf16_t*)Ov + (size_t)rtw * DE + h0) = o;
                }
            }
    }
};
struct EpiSharedDown {
    static constexpr bool PERM = true; unsigned char* ysh;
    __device__ __forceinline__ void operator()(const f32x4 (&acc)[2][2][4][2], const Unit& u, int wr, int wc, int fr, int fq, const LAS unsigned* rt) const {
        const int col0 = u.pn * BM + wc * 64 + 16 * fq;
#pragma unroll
        for (int ai = 0; ai < 2; ++ai)
#pragma unroll
            for (int m = 0; m < 4; ++m) {
                u32x4 o;
#pragma unroll
                for (int bj = 0; bj < 2; ++bj) { const f32x4 v0 = acc[ai][bj][m][0] * YSCALE, v1 = acc[ai][bj][m][1] * YSCALE;
                    int w0 = __builtin_amdgcn_cvt_pk_fp8_f32(clamp8(v0[0]), clamp8(v0[1]), 0, false); w0 = __builtin_amdgcn_cvt_pk_fp8_f32(clamp8(v0[2]), clamp8(v0[3]), w0, true);
                    int w1 = __builtin_amdgcn_cvt_pk_fp8_f32(clamp8(v1[0]), clamp8(v1[1]), 0, false); w1 = __builtin_amdgcn_cvt_pk_fp8_f32(clamp8(v1[2]), clamp8(v1[3]), w1, true);
                    if (bj == 0) { o.x = (unsigned)w0; o.y = (unsigned)w1; } else { o.z = (unsigned)w0; o.w = (unsigned)w1; } }
                *(u32x4*)(ysh + (size_t)(u.pm * BM + ai * HALF + wr * 64 + m * 16 + fr) * D + col0) = o;
            }
    }
};
struct EpiExpDown {
    static constexpr bool PERM = true; unsigned char* ybuf; const int* slot_ent;
    __device__ __forceinline__ void operator()(const f32x4 (&acc)[2][2][4][2], const Unit& u, int wr, int wc, int fr, int fq, const LAS unsigned* rt) const {
        const int col0 = u.pn * BM + wc * 64 + 16 * fq;
#pragma unroll
        for (int ai = 0; ai < 2; ++ai)
#pragma unroll
            for (int m = 0; m < 4; ++m) {
                const int rtw = u.pm * BM + ai * HALF + wr * 64 + m * 16 + fr; if (rtw >= u.cnt) continue;
                u32x4 o;
#pragma unroll
                for (int bj = 0; bj < 2; ++bj) { const f32x4 v0 = acc[ai][bj][m][0] * (YSCALE * INV_DN8), v1 = acc[ai][bj][m][1] * (YSCALE * INV_DN8);
                    int w0 = __builtin_amdgcn_cvt_pk_fp8_f32(clamp8(v0[0]), clamp8(v0[1]), 0, false); w0 = __builtin_amdgcn_cvt_pk_fp8_f32(clamp8(v0[2]), clamp8(v0[3]), w0, true);
                    int w1 = __builtin_amdgcn_cvt_pk_fp8_f32(clamp8(v1[0]), clamp8(v1[1]), 0, false); w1 = __builtin_amdgcn_cvt_pk_fp8_f32(clamp8(v1[2]), clamp8(v1[3]), w1, true);
                    if (bj == 0) { o.x = (unsigned)w0; o.y = (unsigned)w1; } else { o.z = (unsigned)w0; o.w = (unsigned)w1; } }
                *(u32x4*)(ybuf + (size_t)rt[ai * HALF + wr * 64 + m * 16 + fr] * D + col0) = o;
                asm volatile("" ::: "memory");
            }
    }
};

template <int PMODE = 0, class Sched> __device__ __forceinline__ void down_phase(LAS unsigned char* lds, const char* act8, const Sched& S, unsigned char* ybuf, const int tid_in) {
    int tid_ = tid_in; asm volatile("" : "+v"(tid_));
    const int tid = tid_, wid = __builtin_amdgcn_readfirstlane(tid >> 6), lane = tid & 63, wr = wid >> 2, wc = wid & 3, fr = lane & 15, fq = lane >> 4;
    constexpr int RB = DE;
    int Rr[2]; unsigned voffB[2], cc2[2];
#pragma unroll
    for (int i = 0; i < 2; ++i) { int R, C; stage_rc(tid * 16 + i * 8192, R, C); Rr[i] = R; cc2[i] = (unsigned)(C * 2); const int Rb = (R & ~31) + perm32(R & 31); voffB[i] = (unsigned)(Rb * RB + C * 2); }
    const unsigned ldsw = (unsigned)wid * 1024u;
    const int aoff = lds_byte(wr * 64 + fr, fq * 8), boff = lds_byte(wc * 32 + fr, fq * 8);
#define DN_SA(k, h) (((k) * 2 + (h)) * HTB)
#define DN_SB(z, k) (65536 + ((z) * 2 + (k)) * HTB)
#define DN_STAGE(bufoff, gbase, voff) do { _Pragma("unroll") for (int _i = 0; _i < 2; ++_i) \
        __builtin_amdgcn_global_load_lds((const unsigned*)((const char*)(gbase) + (voff)[_i]), (LAS unsigned*)(lds + (bufoff) + ldsw + _i * 8192), 16, 0, 0); } while (0)
    LAS unsigned* rowtab = (LAS unsigned*)(lds + ROWTAB_OFF);
    Unit cur, nxt; int ti = 0;
    if (!S.next(0, cur)) return;
#define DN_STAGE_A(u) do { unsigned _va[2][2]; _Pragma("unroll") for (int _h = 0; _h < 2; ++_h) _Pragma("unroll") for (int _i = 0; _i < 2; ++_i) { int _r = (u).pm * BM + _h * HALF + Rr[_i]; if (_r >= (u).cnt) _r = (u).cnt - 1; _va[_h][_i] = (unsigned)(((u).off + _r) * RB) + cc2[_i]; } \
        _Pragma("unroll") for (int _k = 0; _k < 2; ++_k) _Pragma("unroll") for (int _h = 0; _h < 2; ++_h) DN_STAGE(DN_SA(_k, _h), act8 + _k * 128, _va[_h]); } while (0)
#define DN_STAGE_B(u, s_, z_) do { const char* _b = (u).B + (size_t)(s_) * (HALF * RB); _Pragma("unroll") for (int _k = 0; _k < 2; ++_k) DN_STAGE(DN_SB(z_, _k), _b + _k * 128, voffB); } while (0)
#define DN_ROWTAB(u, par) do { if (tid < BM) { int _r = (u).pm * BM + tid; if (_r >= (u).cnt) _r = (u).cnt - 1; rowtab[(par) * BM + tid] = (PMODE == 1) ? (unsigned)((u).off + _r) : (unsigned)S.slot_ent[(u).off + _r]; } } while (0)
    DN_STAGE_A(cur); DN_ROWTAB(cur, 0); DN_STAGE_B(cur, 0, 0);
    f32x4 acc[2][2][4][2];
    union Frag { bf16x8 q[2]; i32x8 w; };
    int gs = 0;
    Unit prev = cur; int prev_s = -1, prev_par = 0;
#define DN_EPILOGUE(set, u, s_, par) do { const int _col0 = (s_) * HALF + wc * 32 + 8 * fq; \
        _Pragma("unroll") for (int _ai = 0; _ai < 2; ++_ai) _Pragma("unroll") for (int _m = 0; _m < 4; ++_m) { const int _rt = _ai * HALF + wr * 64 + _m * 16 + fr; \
            { const f32x4 _v0 = acc[set][_ai][_m][0] * (YSCALE * INV_DN8), _v1 = acc[set][_ai][_m][1] * (YSCALE * INV_DN8);   \
                int _w0 = __builtin_amdgcn_cvt_pk_fp8_f32(clamp8(_v0[0]), clamp8(_v0[1]), 0, false); _w0 = __builtin_amdgcn_cvt_pk_fp8_f32(clamp8(_v0[2]), clamp8(_v0[3]), _w0, true); \
                int _w1 = __builtin_amdgcn_cvt_pk_fp8_f32(clamp8(_v1[0]), clamp8(_v1[1]), 0, false); _w1 = __builtin_amdgcn_cvt_pk_fp8_f32(clamp8(_v1[2]), clamp8(_v1[3]), _w1, true); \
                u32x2 _o; _o.x = (unsigned)_w0; _o.y = (unsigned)_w1; if (PMODE != 2 || (_w0 == 0x12345678 && _w1 == 0x31415926)) *(u32x2*)(ybuf + (size_t)rowtab[(par) * BM + _rt] * D + _col0) = _o; } } } while (0)
    for (;;) {
        const bool has_next = S.next(ti + 1, nxt);
        const int par = ti & 1;
#pragma unroll 1
        for (int s2 = 0; s2 < 8; s2 += 2) {
#pragma unroll
            for (int sb = 0; sb < 2; ++sb) {
                const int s = s2 + sb; const int z = sb;
                if (s == 0) asm volatile("s_waitcnt vmcnt(0)" ::: "memory");
                else if (PMODE == 2) asm volatile("s_waitcnt vmcnt(0)" ::: "memory");
                else asm volatile("s_waitcnt vmcnt(8)" ::: "memory");
                __builtin_amdgcn_s_barrier();
                asm volatile("" ::: "memory");
                if (s < 7) DN_STAGE_B(cur, s + 1, z ^ 1); else if (has_next) DN_STAGE_B(nxt, 0, z ^ 1);
                if (wr == 1 && prev_s >= 0) { asm volatile("s_nop 15" ::: "memory"); DN_EPILOGUE(sb ^ 1, prev, prev_s, prev_par); }
#pragma unroll
                for (int ai = 0; ai < 2; ++ai)
#pragma unroll
                    for (int m = 0; m < 4; ++m)
#pragma unroll
                        for (int n = 0; n < 2; ++n) acc[sb][ai][m][n] = (f32x4){0.f, 0.f, 0.f, 0.f};
                asm volatile("s_nop 4" ::: "memory");
#pragma unroll
                for (int k = 0; k < 2; ++k) {
                    Frag Bf[2];
#pragma unroll
                    for (int n = 0; n < 2; ++n) Bf[n].w = cat8(*(const LAS bf16x8*)(lds + DN_SB(z, k) + boff + n * 2048), *(const LAS bf16x8*)(lds + DN_SB(z, k) + boff + n * 2048 + 1024));
#pragma unroll
                    for (int ai = 0; ai < 2; ++ai) {
                        Frag Af[4];
#pragma unroll
                        for (int m = 0; m < 4; ++m) Af[m].w = cat8(*(const LAS bf16x8*)(lds + DN_SA(k, ai) + aoff + m * 2048), *(const LAS bf16x8*)(lds + DN_SA(k, ai) + aoff + m * 2048 + 1024));
#pragma unroll
                        for (int m = 0; m < 4; ++m)
#pragma unroll
                            for (int n = 0; n < 2; ++n) asm volatile("v_mfma_f32_16x16x128_f8f6f4 %0, %1, %2, %0" : "+v"(acc[sb][ai][m][n]) : "v"(Bf[n].w), "v"(Af[m].w));
                    }
                }
                if (wr == 0 && prev_s >= 0) DN_EPILOGUE(sb ^ 1, prev, prev_s, prev_par);
                prev = cur; prev_s = s; prev_par = par;
            }
        }
        if (!has_next) break;
        asm volatile("s_waitcnt lgkmcnt(0)" ::: "memory");
        __builtin_amdgcn_s_barrier();
        DN_STAGE_A(nxt); DN_ROWTAB(nxt, par ^ 1);
        cur = nxt; ++ti;
    }
    asm volatile("s_nop 15\n\ts_nop 15" ::: "memory");
    DN_EPILOGUE(1, prev, prev_s, prev_par);
    asm volatile("s_waitcnt vmcnt(0) lgkmcnt(0)" ::: "memory");
    __builtin_amdgcn_s_barrier();
#undef DN_SA
#undef DN_SB
#undef DN_STAGE
#undef DN_STAGE_A
#undef DN_STAGE_B
#undef DN_ROWTAB
#undef DN_EPILOGUE
}
constexpr int T_P64 = T_HIST;
template <int PMODE = 0> __device__ __forceinline__ void down2_phase(LAS unsigned char* lds, LAS unsigned* tab, const char* act8, const char* wd, const int* slot_ent, unsigned char* ybuf, const int G, const int bx, const int tid_in) {
    int tid_ = tid_in; asm volatile("" : "+v"(tid_));
    const int tid = tid_, wid = __builtin_amdgcn_readfirstlane(tid >> 6), lane = tid & 63, wr = wid >> 2, wc = wid & 3, fr = lane & 15, fq = lane >> 4;
    constexpr int NS = 8, PD = 7, PB = 16384;
    if (tid < 64) {
        unsigned c[4], sp = 0;
#pragma unroll
        for (int j = 0; j < 4; ++j) { c[j] = (tab[T_CNT + lane * 4 + j] + 63u) >> 6; sp += c[j]; }
        unsigned ip = sp;
#pragma unroll
        for (int o = 1; o < 64; o <<= 1) { const unsigned a = __shfl_up(ip, o); if (lane >= o) ip += a; }
        unsigned ep = ip - sp;
#pragma unroll
        for (int j = 0; j < 4; ++j) { tab[T_P64 + lane * 4 + j] = ep; ep += c[j]; }
        if (lane == 63) tab[T_P64 + NE] = ep;
    }
    __syncthreads();
    int g, q; const int NG = G >> 2;
    if (G % 32 == 0) { const int x = bx % 8, i = bx / 8; g = x * (G / 32) + (i >> 2); q = i & 3; } else { g = bx >> 2; q = bx & 3; }
    const int NP = (int)tab[T_P64 + NE];
    const int p_lo = g < NG ? (int)((long long)g * NP / NG) : 0, p_hi = g < NG ? (int)((long long)(g + 1) * NP / NG) : 0;
    if (p_lo < p_hi) {
    int R0, C0; stage_rc(tid * 16, R0, C0);
    const unsigned ldsw = (unsigned)wid * 1024u;
    const int aoff = lds_byte(wr * 32 + fr, fq * 8);
    LAS unsigned* rowtab = (LAS unsigned*)(lds + VN_OFF);
    int e0 = 0; { int hi = NE - 1; while (e0 < hi) { const int mid = (e0 + hi + 1) >> 1; if ((int)tab[T_P64 + mid] <= p_lo) e0 = mid; else hi = mid - 1; } }
    int e2 = e0, nb2 = (int)tab[T_P64 + e0 + 1];
    int e = -1, nb = p_lo;
#define D2_STAGE(pp_, it_) do { const int _pp = (pp_) < p_hi ? (pp_) : p_hi - 1; \
        while (_pp >= nb2) { ++e2; nb2 = (int)tab[T_P64 + e2 + 1]; } \
        const int _off = (int)tab[T_OFF + e2], _cnt = (int)tab[T_CNT + e2], _r0 = (_pp - (int)tab[T_P64 + e2]) * 64; \
        int _r = _r0 + R0; if (_r >= _cnt) _r = _cnt - 1; int _rr = _r0 + lane; if (_rr >= _cnt) _rr = _cnt - 1; \
        const char* _a = act8 + (size_t)(unsigned)((_off + _r) * DE + C0 * 2); const unsigned _zb = (unsigned)((it_) & (NS - 1)) * PB; \
        __builtin_amdgcn_global_load_lds((const unsigned*)_a, (LAS unsigned*)(lds + _zb + ldsw), 16, 0, 0); \
        __builtin_amdgcn_global_load_lds((const unsigned*)(_a + 128), (LAS unsigned*)(lds + _zb + 8192 + ldsw), 16, 0, 0); \
        __builtin_amdgcn_global_load_lds((const unsigned*)(slot_ent + _off + _rr), rowtab + ((it_) & 15) * 64, 4, 0, 0); } while (0)
    union Frag { bf16x8 q2[2]; i32x8 w; };
    Frag Bf[2][4], Af[2][2][2];
    f32x4 acc[2][2][4];
#define D2_CVT(v_) ({ const f32x4 _v = (v_) * (YSCALE * INV_DN8); int _w = __builtin_amdgcn_cvt_pk_fp8_f32(clamp8(_v[0]), clamp8(_v[1]), 0, false); (unsigned)__builtin_amdgcn_cvt_pk_fp8_f32(clamp8(_v[2]), clamp8(_v[3]), _w, true); })
#define D2_OUT(dst_, o_) do { if (PMODE == 0 || ((o_).x == 0x12345678u && (o_).y == 0x31415926u && (dst_) < (unsigned)NSLOT)) *(u32x4*)(ybuf + (size_t)(dst_) * D + (q * 256 + wc * 64 + 16 * fq)) = (o_); } while (0)
#define D2_EPILOGUE(set, ip_) do { _Pragma("unroll") for (int _m = 0; _m < 2; ++_m) { \
            const unsigned _dst = rowtab[((ip_) & 15) * 64 + wr * 32 + _m * 16 + fr]; u32x4 _o; \
            _Pragma("unroll") for (int _n = 0; _n < 4; ++_n) _o[_n] = D2_CVT(acc[set][_m][_n]); \
            D2_OUT(_dst, _o); } } while (0)
#define D2_READA(par, it_) do { const unsigned _zb = (unsigned)((it_) & (NS - 1)) * PB; _Pragma("unroll") for (int _k = 0; _k < 2; ++_k) _Pragma("unroll") for (int _m = 0; _m < 2; ++_m) \
        Af[par][_k][_m].w = cat8(*(const LAS bf16x8*)(lds + _zb + _k * 8192 + aoff + _m * 2048), *(const LAS bf16x8*)(lds + _zb + _k * 8192 + aoff + _m * 2048 + 1024)); } while (0)
#define D2_MFMA0(sb, m, n) asm volatile("v_mfma_f32_16x16x128_f8f6f4 %0, %1, %2, 0" : "=&v"(acc[sb][m][n]) : "v"(Bf[0][n].w), "v"(Af[sb][0][m].w))
#define D2_MFMA1(sb, m, n) asm volatile("v_mfma_f32_16x16x128_f8f6f4 %0, %1, %2, %0" : "+v"(acc[sb][m][n]) : "v"(Bf[1][n].w), "v"(Af[sb][1][m].w))
#define D2_PAIR(MF, sb, m, n0, EPI, om, on, ov) do { MF(sb, m, n0); MF(sb, m, n0 + 1); if (EPI && PMODE < 5) (ov)[on] = D2_CVT(acc[(sb) ^ 1][om][on]); __builtin_amdgcn_sched_barrier(0); } while (0)
#define D2_PIECE(sb, i_, EPI) do { const int _i = (i_); \
        if (_i < PD - 1 || PMODE != 0) asm volatile("s_waitcnt vmcnt(15)" ::: "memory");        \
        else asm volatile("s_waitcnt vmcnt(25)" ::: "memory");                                    \
        if (PMODE != 5) __builtin_amdgcn_s_barrier();                      \
        asm volatile("" ::: "memory"); \
        if (PMODE != 3 && PMODE != 5 && PMODE != 6) D2_STAGE(p_lo + _i + PD, _i + PD);                 \
        if (p_lo + _i >= nb) {                                             \
            do { ++e; nb = (int)tab[T_P64 + e + 1]; } while (p_lo + _i >= nb); \
            const __attribute__((address_space(1))) char* wb = (const __attribute__((address_space(1))) char*)(wd + ((size_t)e * D + q * 256 + wc * 64 + 16 * (fr >> 2) + (fr & 3)) * DE + 16 * fq); \
            _Pragma("unroll") for (int _k = 0; _k < 2; ++_k) _Pragma("unroll") for (int _n = 0; _n < 4; ++_n) \
                Bf[_k][_n].w = cat8(*(const __attribute__((address_space(1))) bf16x8*)(wb + _n * 4 * DE + _k * 128), *(const __attribute__((address_space(1))) bf16x8*)(wb + _n * 4 * DE + _k * 128 + 64)); \
            _Pragma("unroll") for (int _k = 0; _k < 2; ++_k) _Pragma("unroll") for (int _n = 0; _n < 4; ++_n) asm volatile("" : "+v"(Bf[_k][_n].w));     \
        } \
        if (PMODE != 5) D2_READA((sb) ^ 1, _i + 1); \
        unsigned _d0 = 0, _d1 = 0; u32x4 _o0, _o1; \
        __builtin_amdgcn_sched_barrier(0); \
        D2_PAIR(D2_MFMA0, sb, 0, 0, EPI, 0, 0, _o0); D2_PAIR(D2_MFMA0, sb, 0, 2, EPI, 0, 1, _o0); \
        if (EPI && PMODE < 5) { _d0 = rowtab[((_i - 1) & 15) * 64 + wr * 32 + fr]; _d1 = rowtab[((_i - 1) & 15) * 64 + wr * 32 + 16 + fr]; }     \
        __builtin_amdgcn_sched_barrier(0); \
        D2_PAIR(D2_MFMA0, sb, 1, 0, EPI, 0, 2, _o0); D2_PAIR(D2_MFMA0, sb, 1, 2, EPI, 0, 3, _o0); \
        if (EPI && PMODE < 5) D2_OUT(_d0, _o0); \
        D2_PAIR(D2_MFMA1, sb, 0, 0, EPI, 1, 0, _o1); D2_PAIR(D2_MFMA1, sb, 0, 2, EPI, 1, 1, _o1); D2_PAIR(D2_MFMA1, sb, 1, 0, EPI, 1, 2, _o1); D2_PAIR(D2_MFMA1, sb, 1, 2, EPI, 1, 3, _o1); \
        if (EPI && PMODE < 5) D2_OUT(_d1, _o1); \
    } while (0)
#pragma unroll 1
    for (int j = 0; j < PD; ++j) D2_STAGE(p_lo + j, j);
    const int n_it = p_hi - p_lo;
    asm volatile("s_waitcnt vmcnt(18)" ::: "memory");
    __builtin_amdgcn_s_barrier();
    asm volatile("" ::: "memory");
    D2_READA(0, 0);
    D2_PIECE(0, 0, false);
#pragma unroll 1
    for (int i2 = 1; i2 < n_it; i2 += 2) {
        D2_PIECE(1, i2, true);
        if (i2 + 1 < n_it) D2_PIECE(0, i2 + 1, true);
    }
    asm volatile("s_nop 15\n\ts_nop 15" ::: "memory");
    if (n_it & 1) D2_EPILOGUE(0, n_it - 1); else D2_EPILOGUE(1, n_it - 1);
#undef D2_CVT
#undef D2_OUT
#undef D2_READA
#undef D2_MFMA0
#undef D2_MFMA1
#undef D2_PAIR
#undef D2_PIECE
#undef D2_STAGE
#undef D2_EPILOGUE
    }
    asm volatile("s_waitcnt vmcnt(0) lgkmcnt(0)" ::: "memory");
    __builtin_amdgcn_s_barrier();
}
struct EpiProbeSum {
    static constexpr bool PERM = true; float* o;
    __device__ __forceinline__ void operator()(const f32x4 (&acc)[2][2][4][2], const Unit& u, int wr, int wc, int fr, int fq, const LAS unsigned* rt) const {
        f32x4 s = (f32x4){0.f, 0.f, 0.f, 0.f};
#pragma unroll
        for (int a = 0; a < 2; ++a)
#pragma unroll
            for (int b = 0; b < 2; ++b)
#pragma unroll
                for (int m = 0; m < 4; ++m) s += acc[a][b][m][0] + acc[a][b][m][1];
        if (s.x == 123.456f) *(f32x4*)(o + (size_t)(blockIdx.x * 512 + wr * 256 + wc * 64 + fq * 16 + fr) * 4) = s;
    }
};
}

struct Ctx {
    const float *x, *c, *w_ada, *b_ada, *w_in, *w_out, *na_rpb, *ret_ld, *ret_gn, *ln1_g, *ln1_b, *ln2_g, *ln2_b, *w_router, *rbias, *w_gate, *w_up, *w_down, *ws_gate, *ws_up, *ws_down;
    float* out; unsigned char* ws;
};
constexpr int NW = 8;

__device__ __forceinline__ void transpose_item(const float* W, int K, int N, bf16_t* WT, int G, int which, LAS float* scr, int item, int lane) {
    const int nblk = N / 32, kb = item / nblk, nb = item % nblk, k0 = 64 * kb, n0 = 32 * nb;
    float v[32];
#pragma unroll
    for (int i = 0; i < 32; ++i) { const int kk = 2 * i + (lane >> 5); v[i] = __builtin_nontemporal_load(W + (size_t)(k0 + kk) * N + n0 + (lane & 31)); }
#pragma unroll
    for (int i = 0; i < 32; ++i) { const int kk = 2 * i + (lane >> 5); scr[kk * 33 + (lane & 31)] = v[i]; }
    LDS_WAIT(); asm volatile("" ::: "memory");
    const int c = lane & 7;
#pragma unroll
    for (int j = 0; j < 4; ++j) { const int n = (lane >> 3) + 8 * j; const LAS float* s = scr + (8 * c) * 33 + n;
        u32x4 o; o.x = pk2(s[0 * 33], s[1 * 33]); o.y = pk2(s[2 * 33], s[3 * 33]); o.z = pk2(s[4 * 33], s[5 * 33]); o.w = pk2(s[6 * 33], s[7 * 33]);
        const int ng = n0 + n; const int drow = (G == 0) ? ng : ((ng / G) * 2 * G + which * G + (ng % G));
        *(u32x4*)(WT + (size_t)drow * K + k0 + 8 * c) = o; }
    LDS_WAIT(); asm volatile("" ::: "memory");
}
__device__ __forceinline__ void transpose_item_fp8(const float* W, int K, int N, unsigned char* WT, int G, int which, float scale, LAS float* scr, int item, int lane) {
    const int nblk = N / 32, kb = item / nblk, nb = item % nblk, k0 = 64 * kb, n0 = 32 * nb;
    float v[32];
#pragma unroll
    for (int i = 0; i < 32; ++i) { const int kk = 2 * i + (lane >> 5); v[i] = __builtin_nontemporal_load(W + (size_t)(k0 + kk) * N + n0 + (lane & 31)); }
#pragma unroll
    for (int i = 0; i < 32; ++i) { const int kk = 2 * i + (lane >> 5); scr[kk * 33 + (lane & 31)] = v[i] * scale; }
    LDS_WAIT(); asm volatile("" ::: "memory");
    const int c = lane & 7;
#pragma unroll
    for (int j = 0; j < 4; ++j) { const int n = (lane >> 3) + 8 * j; const LAS float* sp = scr + (8 * c) * 33 + n;
        int w0 = __builtin_amdgcn_cvt_pk_fp8_f32(clamp8(sp[0 * 33]), clamp8(sp[1 * 33]), 0, false); w0 = __builtin_amdgcn_cvt_pk_fp8_f32(clamp8(sp[2 * 33]), clamp8(sp[3 * 33]), w0, true);
        int w1 = __builtin_amdgcn_cvt_pk_fp8_f32(clamp8(sp[4 * 33]), clamp8(sp[5 * 33]), 0, false); w1 = __builtin_amdgcn_cvt_pk_fp8_f32(clamp8(sp[6 * 33]), clamp8(sp[7 * 33]), w1, true);
        const int ng = n0 + n; const int drow = (G == 0) ? ng : ((ng / G) * 2 * G + which * G + (ng % G));
        u32x2 o; o.x = (unsigned)w0; o.y = (unsigned)w1; *(u32x2*)(WT + (size_t)drow * K + k0 + 8 * c) = o; }
    LDS_WAIT(); asm volatile("" ::: "memory");
}
__device__ __forceinline__ void rope_entry(float* tab, int idx) {
    const int t = idx >> 6, i = idx & 63;
    const float inv_freq = powf(10000.f, -(float)(2 * i) / 128.f);
    const float ang = (float)t * inv_freq;
    const double a = (double)ang; const double two_pi = 6.283185307179586476925286766559;
    const double kf = rint(a / two_pi); double r = a - kf * two_pi;
    double sgn = 1.0; if (r > 1.5707963267948966) { r = 3.141592653589793 - r; sgn = -1.0; } else if (r < -1.5707963267948966) { r = -3.141592653589793 - r; sgn = -1.0; }
    const double r2 = r * r;
    const double s = r * (1.0 + r2 * (-1.0 / 6 + r2 * (1.0 / 120 + r2 * (-1.0 / 5040 + r2 * (1.0 / 362880 + r2 * (-1.0 / 39916800 + r2 * (1.0 / 6227020800.0 + r2 * (-1.0 / 1307674368000.0))))))));
    const double c = 1.0 + r2 * (-0.5 + r2 * (1.0 / 24 + r2 * (-1.0 / 720 + r2 * (1.0 / 40320 + r2 * (-1.0 / 3628800 + r2 * (1.0 / 479001600.0 + r2 * (-1.0 / 87178291200.0 + r2 * (1.0 / 20922789888000.0))))))));
    tab[idx] = (float)(sgn * c); tab[SEQ * 64 + idx] = (float)s;
}
__device__ __forceinline__ void mod_task(const float* __restrict__ cin, const float* __restrict__ w_ada, float* __restrict__ modp, int task, int lane) {
    const int cbk = task % 96, kc = task / 96, j = cbk * 64 + lane, k0 = kc * 64;
    float acc[32], cv[32];
#pragma unroll
    for (int b = 0; b < 32; ++b) { acc[b] = 0.f; cv[b] = silu_f(cin[b * D + k0 + lane]); }
#pragma unroll
    for (int kb = 0; kb < 4; ++kb) {
        float w[16];
#pragma unroll
        for (int i = 0; i < 16; ++i) w[i] = w_ada[(size_t)(k0 + kb * 16 + i) * 6144 + j];
#pragma unroll
        for (int i = 0; i < 16; ++i)
#pragma unroll
            for (int b = 0; b < 32; ++b) acc[b] += __builtin_bit_cast(float, __builtin_amdgcn_readlane(__builtin_bit_cast(int, cv[b]), kb * 16 + i)) * w[i];
    }
#pragma unroll
    for (int b = 0; b < 32; ++b) modp[((size_t)kc * 32 + b) * 6144 + j] = acc[b];
}
__device__ __forceinline__ float mod_sum(const float* __restrict__ modp, const float* __restrict__ b_ada, int b, int j) {
    float s = 0.f;
#pragma unroll
    for (int kc = 0; kc < 16; ++kc) s += modp[((size_t)kc * 32 + b) * 6144 + j];
    return s + b_ada[j];
}

#ifndef RET_PROBE
#define RET_PROBE 0
#endif
namespace ret {
typedef short s16x4 __attribute__((ext_vector_type(4)));
typedef __bf16 bfx2 __attribute__((ext_vector_type(2)));
constexpr unsigned RS = 288, TILE = 128 * RS, LK = 0, LV = TILE, LRF = 2 * TILE, LRB = 3 * TILE;
constexpr float LOG2E = 1.4426950408889634f;
__device__ __forceinline__ unsigned offb(unsigned row, unsigned ch) { return RS * row + 16u * ch; }
__device__ __forceinline__ unsigned cvtpk(float lo, float hi) { const f32x2 v = {lo, hi}; return __builtin_bit_cast(unsigned, __builtin_convertvector(v, bfx2)); }
__device__ __forceinline__ bf16x8 pack8(const float (&f)[8]) { u32x4 u; u.x = cvtpk(f[0], f[1]); u.y = cvtpk(f[2], f[3]); u.z = cvtpk(f[4], f[5]); u.w = cvtpk(f[6], f[7]); return __builtin_bit_cast(bf16x8, u); }
__device__ __forceinline__ void unpack8(const bf16x8 v, float (&f)[8]) { const u32x4 u = __builtin_bit_cast(u32x4, v);
    f[0] = __uint_as_float(u.x << 16); f[1] = __uint_as_float(u.x & 0xffff0000u); f[2] = __uint_as_float(u.y << 16); f[3] = __uint_as_float(u.y & 0xffff0000u);
    f[4] = __uint_as_float(u.z << 16); f[5] = __uint_as_float(u.z & 0xffff0000u); f[6] = __uint_as_float(u.w << 16); f[7] = __uint_as_float(u.w & 0xffff0000u); }
__device__ __forceinline__ bf16x8 trfrag(LAS unsigned char* base, unsigned row0, unsigned row1, unsigned cblk, unsigned qp, unsigned p) {
    const unsigned ch = 2u * cblk + (p >> 1), bo = 8u * (p & 1u);
    const s16x4 lo = __builtin_amdgcn_ds_read_tr16_b64_v4i16((LAS s16x4*)(base + offb(row0 + qp, ch) + bo));
    const s16x4 hi = __builtin_amdgcn_ds_read_tr16_b64_v4i16((LAS s16x4*)(base + offb(row1 + qp, ch) + bo));
    return __builtin_shufflevector(lo, hi, 0, 1, 2, 3, 4, 5, 6, 7);
}
struct KVRaw { bf16x8 ka[2], kb[2], v[4]; f32x4 c0[2], c1[2], s0[2], s1[2]; };
__device__ __forceinline__ void kv_load(KVRaw& R, const bf16_t* __restrict__ proj, const float* __restrict__ rope, int b, int h, int n, int tid) {
#pragma unroll
    for (int i = 0; i < 2; ++i) {
        const int q2 = tid + 512 * i, row = q2 >> 3, pc = q2 & 7, t = n * 128 + row;
        const bf16_t* rp = proj + (size_t)(b * SEQ + t) * DIN + OFF_KR + h * 128;
        R.ka[i] = *(const bf16x8*)(rp + pc * 8); R.kb[i] = *(const bf16x8*)(rp + 64 + pc * 8);
        R.c0[i] = *(const f32x4*)(rope + t * 64 + pc * 8); R.c1[i] = *(const f32x4*)(rope + t * 64 + pc * 8 + 4);
        R.s0[i] = *(const f32x4*)(rope + SEQ * 64 + t * 64 + pc * 8); R.s1[i] = *(const f32x4*)(rope + SEQ * 64 + t * 64 + pc * 8 + 4);
    }
#pragma unroll
    for (int i = 0; i < 4; ++i) { const int q4 = tid + 512 * i, row = q4 >> 4, ch = q4 & 15, t = n * 128 + row;
        R.v[i] = *(const bf16x8*)(proj + (size_t)(b * SEQ + t) * DIN + OFF_VR + h * 128 + ch * 8); }
}
__device__ __forceinline__ void kv_store(LAS unsigned char* lds, const KVRaw& R, int tid) {
#pragma unroll
    for (int i = 0; i < 2; ++i) {
        const int q2 = tid + 512 * i, row = q2 >> 3, pc = q2 & 7;
        float fa[8], fb[8], o1[8], o2[8];
        unpack8(R.ka[i], fa); unpack8(R.kb[i], fb);
        const float cs[8] = {R.c0[i].x, R.c0[i].y, R.c0[i].z, R.c0[i].w, R.c1[i].x, R.c1[i].y, R.c1[i].z, R.c1[i].w}, sn[8] = {R.s0[i].x, R.s0[i].y, R.s0[i].z, R.s0[i].w, R.s1[i].x, R.s1[i].y, R.s1[i].z, R.s1[i].w};
#pragma unroll
        for (int e = 0; e < 8; ++e) { o1[e] = fa[e] * cs[e] - fb[e] * sn[e]; o2[e] = fb[e] * cs[e] + fa[e] * sn[e]; }
        *(LAS bf16x8*)(lds + LK + offb(row, pc)) = pack8(o1); *(LAS bf16x8*)(lds + LK + offb(row, pc + 8)) = pack8(o2);
    }
#pragma unroll
    for (int i = 0; i < 4; ++i) { const int q4 = tid + 512 * i, row = q4 >> 4, ch = q4 & 15; *(LAS bf16x8*)(lds + LV + offb(row, ch)) = R.v[i]; }
}
__device__ __forceinline__ void rb_dma(LAS unsigned char* lds, const unsigned char* img, int w, int lane) {
#pragma unroll
    for (int i = 0; i < 5; ++i) { const int o = w + 8 * i; if (o < (int)TILE / 1024)
        __builtin_amdgcn_global_load_lds((const unsigned*)(img + o * 1024 + lane * 16), (LAS unsigned*)(lds + LRB + o * 1024), 16, 0, 0); }
}
template <bool FWD> __device__ __forceinline__ void state_update_1(LAS unsigned char* lds, f32x4 (&racc)[8], float l2, int w, int g, unsigned qp, unsigned p);
template <bool FWD> __device__ __forceinline__ void state_update(LAS unsigned char* lds, f32x4 (&racc)[8], float l2, int w, int g, unsigned qp, unsigned p) {
    if (RET_PROBE == 2) {
        f32x4 r2[8];
#pragma unroll
        for (int i = 0; i < 8; ++i) r2[i] = racc[i];
        unsigned zo = 0; asm volatile("" : "+v"(zo));
        state_update_1<FWD>(lds + zo, r2, l2, w, g, qp, p);
        state_update_1<FWD>(lds, racc, l2, w, g, qp, p);
#pragma unroll
        for (int i = 0; i < 8; ++i) racc[i] = (racc[i] + r2[i]) * 0.5f;
    } else state_update_1<FWD>(lds, racc, l2, w, g, qp, p);
}
template <bool FWD> __device__ __forceinline__ void state_update_1(LAS unsigned char* lds, f32x4 (&racc)[8], float l2, int w, int g, unsigned qp, unsigned p) {
    const float dec = __builtin_amdgcn_exp2f(128.f * l2);
    bf16x8 vs[4];
#pragma unroll
    for (int ks = 0; ks < 4; ++ks) {
        float f[8]; unpack8(trfrag(lds + LV, 32 * ks + 4 * g, 32 * ks + 16 + 4 * g, w, qp, p), f);
#pragma unroll
        for (int e = 0; e < 8; ++e) { const int key = 32 * ks + 16 * (e >> 2) + 4 * g + (e & 3); f[e] *= __builtin_amdgcn_exp2f((FWD ? (float)(127 - key) : (float)key) * l2); }
        vs[ks] = pack8(f);
    }
#pragma unroll
    for (int nb = 0; nb < 8; ++nb) {
        racc[nb] = racc[nb] * dec;
#pragma unroll
        for (int ks = 0; ks < 4; ++ks) racc[nb] = __builtin_amdgcn_mfma_f32_16x16x32_bf16(vs[ks], trfrag(lds + LK, 32 * ks + 4 * g, 32 * ks + 16 + 4 * g, nb, qp, p), racc[nb], 0, 0, 0);
    }
}
__device__ __forceinline__ void unit(const bf16_t* __restrict__ proj, const float* __restrict__ rope, const float* __restrict__ log_decay, const float* __restrict__ gn_g, bf16_t* __restrict__ ymix,
                                     unsigned char* __restrict__ scratch  , LAS unsigned char* lds, int hu, const int tid_in) {
    const int u = hu >> 1, n0 = (hu & 1) * 8, n1 = n0 + 8;
    const int b = u >> 2, h = u & 3;
    int tid_ = tid_in; asm volatile("" : "+v"(tid_));
    const int tid0 = tid_, w = __builtin_amdgcn_readfirstlane(tid0 >> 6);
#define RET_LANE int tid = tid0; asm volatile("" : "+v"(tid)); const int lane = tid & 63, r = lane & 15, g = lane >> 4; const unsigned qp = (unsigned)r >> 2, p = (unsigned)lane & 3u;
    const float lf2_ = log_decay[h] * LOG2E, lb2_ = log_decay[4 + h] * LOG2E;
    f32x4 racc[8];
    KVRaw raw;
    for (int rep7 = 0; rep7 < (RET_PROBE == 7 ? 2 : 1); ++rep7) {
#pragma unroll
    for (int nb = 0; nb < 8; ++nb) racc[nb] = (f32x4){0.f, 0.f, 0.f, 0.f};
    kv_load(raw, proj, rope, b, h, 15, tid0);
    for (int n = 15; n >= n0; --n) {
        RET_LANE
        if (n < n1) {
            unsigned char* img = scratch + (size_t)(n - n0) * TILE;
#pragma unroll
            for (int nb = 0; nb < 8; ++nb) { u32x2 o; o.x = cvtpk(racc[nb][0], racc[nb][1]); o.y = cvtpk(racc[nb][2], racc[nb][3]);
                *(u32x2*)(img + offb(16 * nb + r, 2 * w + (g >> 1)) + 8 * (g & 1)) = o; }
        }
        if (n == n0) break;
        float lb2 = lb2_; asm volatile("" : "+v"(lb2));
        __syncthreads();
        kv_store(lds, raw, tid);
        __syncthreads();
        kv_load(raw, proj, rope, b, h, n - 1 > n0 ? n - 1 : 0, tid);
        state_update<false>(lds, racc, lb2, w, g, qp, p);
    }
    }
    asm volatile("s_waitcnt vmcnt(0)" ::: "memory");
    __syncthreads();
    __builtin_amdgcn_fence(__ATOMIC_ACQUIRE, "agent");
    asm volatile("s_waitcnt vmcnt(0)" ::: "memory");
    for (int rep8 = 0; rep8 < (RET_PROBE == 8 ? 2 : 1); ++rep8) {
    if (RET_PROBE == 8 && rep8 == 1) { __syncthreads(); kv_load(raw, proj, rope, b, h, 0, tid0); }
#pragma unroll
    for (int nb = 0; nb < 8; ++nb) racc[nb] = (f32x4){0.f, 0.f, 0.f, 0.f};
    for (int n = 0; n < n0; ++n) {
        RET_LANE
        float lf2 = lf2_; asm volatile("" : "+v"(lf2));
        __syncthreads();
        kv_store(lds, raw, tid);
        __syncthreads();
        kv_load(raw, proj, rope, b, h, n + 1, tid);
        state_update<true>(lds, racc, lf2, w, g, qp, p);
    }
    rb_dma(lds, scratch, w, tid0 & 63);
    for (int n = n0; n < n1; ++n) {
        RET_LANE
        float lf2 = lf2_, lb2 = lb2_; asm volatile("" : "+v"(lf2), "+v"(lb2));
        const __attribute__((address_space(1))) float* gnp = (const __attribute__((address_space(1))) float*)gn_g; asm volatile("" : "+s"(gnp));
        __syncthreads();
        kv_store(lds, raw, tid);
#pragma unroll
        for (int nb = 0; nb < 8; ++nb) { u32x2 o; o.x = cvtpk(racc[nb][0], racc[nb][1]); o.y = cvtpk(racc[nb][2], racc[nb][3]);
            *(LAS u32x2*)(lds + LRF + offb(16 * nb + r, 2 * w + (g >> 1)) + 8 * (g & 1)) = o; }
        const int cq = 16 * w + r, tq = n * 128 + cq;
        bf16x8 qn[4], qf[4], qb[4];
        { const bf16_t* rp = proj + (size_t)(b * SEQ + tq) * DIN + OFF_QR + h * 128 + 4 * g;
          const float sf = __builtin_amdgcn_exp2f((float)(cq + 1) * lf2), sb = __builtin_amdgcn_exp2f((float)(128 - cq) * lb2);
#pragma unroll
          for (int ks = 0; ks < 2; ++ks) {
              float fa[8], fb[8], o1[8], o2[8], t1[8], t2[8];
              { const u32x2 a0 = *(const u32x2*)(rp + 32 * ks), a1 = *(const u32x2*)(rp + 32 * ks + 16), b0 = *(const u32x2*)(rp + 32 * ks + 64), b1 = *(const u32x2*)(rp + 32 * ks + 80);
                unpack8(__builtin_bit_cast(bf16x8, (u32x4){a0.x, a0.y, a1.x, a1.y}), fa); unpack8(__builtin_bit_cast(bf16x8, (u32x4){b0.x, b0.y, b1.x, b1.y}), fb); }
              const float* cp = rope + tq * 64 + 32 * ks + 4 * g; const float* sp = cp + SEQ * 64;
              const f32x4 c0 = *(const f32x4*)cp, c1 = *(const f32x4*)(cp + 16), s0 = *(const f32x4*)sp, s1 = *(const f32x4*)(sp + 16);
              const float cs[8] = {c0.x, c0.y, c0.z, c0.w, c1.x, c1.y, c1.z, c1.w}, sn[8] = {s0.x, s0.y, s0.z, s0.w, s1.x, s1.y, s1.z, s1.w};
#pragma unroll
              for (int e = 0; e < 8; ++e) { o1[e] = fa[e] * cs[e] - fb[e] * sn[e]; o2[e] = fb[e] * cs[e] + fa[e] * sn[e]; }
              qn[ks] = pack8(o1); qn[ks + 2] = pack8(o2);
#pragma unroll
              for (int e = 0; e < 8; ++e) { t1[e] = o1[e] * sf; t2[e] = o2[e] * sf; }
              qf[ks] = pack8(t1); qf[ks + 2] = pack8(t2);
#pragma unroll
              for (int e = 0; e < 8; ++e) { t1[e] = o1[e] * sb; t2[e] = o2[e] * sb; }
              qb[ks] = pack8(t1); qb[ks + 2] = pack8(t2);
          } }
        asm volatile("s_waitcnt vmcnt(0)" ::: "memory");
        __syncthreads();
        kv_load(raw, proj, rope, b, h, n + 1 < n1 ? n + 1 : n, tid);
        u32x2 gv[8];
        { const bf16_t* gp = proj + (size_t)(b * SEQ + tq) * DIN + OFF_GR + h * 128 + 4 * g;
#pragma unroll
          for (int mbv = 0; mbv < 8; ++mbv) gv[mbv] = *(const u32x2*)(gp + 16 * mbv); }
        bf16x8 pt[4];
#pragma unroll
        for (int rep3 = 0; rep3 < (RET_PROBE == 3 ? 2 : 1); ++rep3) {
        unsigned zo3 = 0; if (RET_PROBE == 3) asm volatile("" : "+v"(zo3));
#pragma unroll
        for (int ks2 = 0; ks2 < 4; ++ks2) {
            float pv[8];
#pragma unroll
            for (int hb = 0; hb < 2; ++hb) {
                const int mb = 2 * ks2 + hb;
                f32x4 st = (f32x4){0.f, 0.f, 0.f, 0.f};
#pragma unroll
                for (int ks = 0; ks < 4; ++ks) { const LAS unsigned char* kp = lds + LK + zo3 + RS * (16 * mb + r) + 64 * ks + 8 * g; const u32x2 k0 = *(const LAS u32x2*)kp, k1 = *(const LAS u32x2*)(kp + 32);
                    st = __builtin_amdgcn_mfma_f32_16x16x32_bf16(__builtin_bit_cast(bf16x8, (u32x4){k0.x, k0.y, k1.x, k1.y}), qn[ks], st, 0, 0, 0); }
#pragma unroll
                for (int j = 0; j < 4; ++j) { const int diff = cq - (16 * mb + 4 * g + j); pv[4 * hb + j] = st[j] * __builtin_amdgcn_exp2f(diff >= 0 ? (float)diff * lf2 : (float)(-diff) * lb2); }
            }
            pt[ks2] = pack8(pv);
        }
        }
        f32x4 yacc[8];
#pragma unroll
        for (int mbv = 0; mbv < 8; ++mbv) {
            f32x4 y = (f32x4){0.f, 0.f, 0.f, 0.f};
#pragma unroll
            for (int rep = 0; rep < (RET_PROBE == 1 ? 2 : 1); ++rep) {
            unsigned zo = 0; if (RET_PROBE == 1) asm volatile("" : "+v"(zo));
#pragma unroll
            for (int ks2 = 0; ks2 < 4; ++ks2) y = __builtin_amdgcn_mfma_f32_16x16x32_bf16(trfrag(lds + LV + zo, 32 * ks2 + 4 * g, 32 * ks2 + 16 + 4 * g, mbv, qp, p), pt[ks2], y, 0, 0, 0);
#pragma unroll
            for (int ks = 0; ks < 4; ++ks) {
                y = __builtin_amdgcn_mfma_f32_16x16x32_bf16(trfrag(lds + LRF + zo, 32 * ks + 4 * g, 32 * ks + 16 + 4 * g, mbv, qp, p), qf[ks], y, 0, 0, 0);
                y = __builtin_amdgcn_mfma_f32_16x16x32_bf16(trfrag(lds + LRB + zo, 32 * ks + 4 * g, 32 * ks + 16 + 4 * g, mbv, qp, p), qb[ks], y, 0, 0, 0);
            }
            }
            yacc[mbv] = (RET_PROBE == 1) ? y * 0.5f : y;
        }
        __syncthreads();
        if (n + 1 < n1) rb_dma(lds, scratch + (size_t)(n + 1 - n0) * TILE, w, lane);
        { float s = 0.f;
#pragma unroll
          for (int mbv = 0; mbv < 8; ++mbv) s += (yacc[mbv][0] + yacc[mbv][1]) + (yacc[mbv][2] + yacc[mbv][3]);
          s += __shfl_xor(s, 16); s += __shfl_xor(s, 32);
          const float mu = s * (1.f / 128.f); float s2 = 0.f;
#pragma unroll
          for (int mbv = 0; mbv < 8; ++mbv) { yacc[mbv] = yacc[mbv] - mu; s2 += (yacc[mbv][0] * yacc[mbv][0] + yacc[mbv][1] * yacc[mbv][1]) + (yacc[mbv][2] * yacc[mbv][2] + yacc[mbv][3] * yacc[mbv][3]); }
          s2 += __shfl_xor(s2, 16); s2 += __shfl_xor(s2, 32);
          const float rstd = 1.f / sqrtf(s2 * (1.f / 128.f) + GN_EPS);
          unsigned char* op = (unsigned char*)ymix + (size_t)(b * SEQ + tq) * D + 512 + h * 128 + 4 * g;
#pragma unroll
          for (int rep4 = 0; rep4 < (RET_PROBE == 4 ? 2 : 1); ++rep4) {
          if (RET_PROBE == 4) { asm volatile("" : "+v"(op)); asm volatile("" : "+v"(gv[0]), "+v"(gv[1]), "+v"(gv[2]), "+v"(gv[3]), "+v"(gv[4]), "+v"(gv[5]), "+v"(gv[6]), "+v"(gv[7])); }
#pragma unroll
          for (int mbv = 0; mbv < 8; ++mbv) {
              const f32x4 gn = *(const __attribute__((address_space(1))) f32x4*)(gnp + h * 128 + 16 * mbv + 4 * g);
              const float g0 = __uint_as_float(gv[mbv].x << 16), g1 = __uint_as_float(gv[mbv].x & 0xffff0000u), g2 = __uint_as_float(gv[mbv].y << 16), g3 = __uint_as_float(gv[mbv].y & 0xffff0000u);
              int o = __builtin_amdgcn_cvt_pk_fp8_f32(clamp8(S_H8 * silu_f(g0) * (yacc[mbv][0] * rstd * gn.x)), clamp8(S_H8 * silu_f(g1) * (yacc[mbv][1] * rstd * gn.y)), 0, false);
              o = __builtin_amdgcn_cvt_pk_fp8_f32(clamp8(S_H8 * silu_f(g2) * (yacc[mbv][2] * rstd * gn.z)), clamp8(S_H8 * silu_f(g3) * (yacc[mbv][3] * rstd * gn.w)), o, true);
              *(unsigned*)(op + 16 * mbv) = (unsigned)o;
          } } }
        state_update<true>(lds, racc, lf2, w, g, qp, p);
    }
    }
    __syncthreads();
#undef RET_LANE
}
}


namespace na {
constexpr unsigned LKR = 0, LVR = 73728, LRPB = 147456;
__device__ __forceinline__ void load_row(LAS unsigned char* lds, const bf16_t* __restrict__ proj, int b, int head, int krow, int tid) {
    const int key = tid >> 3, ch = tid & 7, slot = krow % 9;
    const bf16_t* rp = proj + (size_t)(b * SEQ + krow * 64 + key) * DIN + head * 64 + ch * 8;
    const unsigned o = (unsigned)slot * 8192u + 128u * key + 16u * (ch ^ (key & 7));
    *(LAS u32x4*)(lds + LKR + o) = *(const u32x4*)(rp + OFF_KNA);
    *(LAS u32x4*)(lds + LVR + o) = *(const u32x4*)(rp + OFF_VNA);
}
__device__ __forceinline__ void unit(const bf16_t* __restrict__ proj, const float* __restrict__ rpb, bf16_t* __restrict__ ymix, LAS unsigned char* lds, int u, const int tid_in) {
    const int b = u >> 3, head = u & 7;
    int tid_ = tid_in; asm volatile("" : "+v"(tid_));
    const int tid0 = tid_, w = __builtin_amdgcn_readfirstlane(tid0 >> 6);
    __syncthreads();
    if (tid0 < 465) ((LAS float*)(lds + LRPB))[tid0] = rpb[head * 465 + tid0];
    const int ct = w & 3, cb = (ct == 0) ? 0 : (ct == 1 ? 8 : (ct == 2 ? 24 : 32));
    u32x4 pk[2], pv2[2]; int pre_lo = 0, pre_n = 0;
    for (int st = 0; st < 16; ++st) {
        int tid = tid0; asm volatile("" : "+v"(tid));
        const int lane = tid & 63, qi = lane & 15, g = lane >> 4; const unsigned qp = (unsigned)qi >> 2, p = (unsigned)lane & 3u;
        const int r = 2 * st + (w >> 2);
        const int rs = min(max(r - 4, 0), 24);
        const int need_hi = min(max(2 * st + 1 - 4, 0), 24) + 7;
        __syncthreads();
        if (st == 0) { for (int kr = 0; kr <= need_hi; ++kr) load_row(lds, proj, b, head, kr, tid); }
        else {
#pragma unroll
            for (int i = 0; i < 2; ++i) if (i < pre_n) { const int key = tid >> 3, ch = tid & 7; const unsigned o = (unsigned)((pre_lo + i) % 9) * 8192u + 128u * key + 16u * (ch ^ (key & 7));
                *(LAS u32x4*)(lds + LKR + o) = pk[i]; *(LAS u32x4*)(lds + LVR + o) = pv2[i]; }
        }
        const int cq = 16 * ct + qi, tq = b * SEQ + r * 64 + cq;
        bf16x8 qn[2];
        { const bf16_t* qptr = proj + (size_t)tq * DIN + OFF_QNA + head * 64 + 8 * g; qn[0] = *(const bf16x8*)qptr; qn[1] = *(const bf16x8*)(qptr + 32); }
        __syncthreads();
        { const int nh = (st < 15) ? min(max(2 * st + 3 - 4, 0), 24) + 7 : need_hi; pre_lo = need_hi + 1; pre_n = nh - need_hi;
#pragma unroll
          for (int i = 0; i < 2; ++i) if (i < pre_n) { const int key = tid >> 3, ch = tid & 7; const bf16_t* rp = proj + (size_t)(b * SEQ + (pre_lo + i) * 64 + key) * DIN + head * 64 + ch * 8;
              pk[i] = *(const u32x4*)(rp + OFF_KNA); pv2[i] = *(const u32x4*)(rp + OFF_VNA); } }
        const int cs = min(max(cq - 8, 0), 48);
        const unsigned kb0 = 128u * qi + 16u * ((unsigned)g ^ ((unsigned)qi & 7u)), kb1 = 128u * qi + 16u * ((4u + (unsigned)g) ^ ((unsigned)qi & 7u));
        const LAS float* bias = (const LAS float*)(lds + LRPB);
        f32x4 sc[16]; float mx = -3.0e38f;
#pragma unroll
        for (int kr = 0; kr < 8; ++kr) {
            const int krow = rs + kr; const unsigned so = (unsigned)(krow % 9) * 8192u + 128u * (unsigned)cb;
            const int dr = krow - r + 7;
#pragma unroll
            for (int h2 = 0; h2 < 2; ++h2) {
                f32x4 a = (f32x4){0.f, 0.f, 0.f, 0.f};
                a = __builtin_amdgcn_mfma_f32_16x16x32_bf16(*(const LAS bf16x8*)(lds + LKR + so + 2048u * h2 + kb0), qn[0], a, 0, 0, 0);
                a = __builtin_amdgcn_mfma_f32_16x16x32_bf16(*(const LAS bf16x8*)(lds + LKR + so + 2048u * h2 + kb1), qn[1], a, 0, 0, 0);
#pragma unroll
                for (int j = 0; j < 4; ++j) {
                    const int kcol = cb + 16 * h2 + 4 * g + j;
                    const int dc = min(max(kcol - cq + 15, 0), 30);
                    const float v = a[j] + bias[dr * 31 + dc];
                    const bool in = (kcol >= cs) && (kcol < cs + 16);
                    a[j] = in ? v : -3.0e38f; mx = fmaxf(mx, a[j]);
                }
                sc[2 * kr + h2] = a;
            }
        }
        mx = fmaxf(mx, __shfl_xor(mx, 16)); mx = fmaxf(mx, __shfl_xor(mx, 32));
        float sum = 0.f; bf16x8 pt[8];
#pragma unroll
        for (int kk = 0; kk < 8; ++kk) {
            float pv[8];
#pragma unroll
            for (int h2 = 0; h2 < 2; ++h2)
#pragma unroll
                for (int j = 0; j < 4; ++j) { const float e = __builtin_amdgcn_exp2f((sc[2 * kk + h2][j] - mx) * 1.4426950408889634f); pv[4 * h2 + j] = e; sum += e; }
            pt[kk] = ret::pack8(pv);
        }
        sum += __shfl_xor(sum, 16); sum += __shfl_xor(sum, 32);
        const float inv = 1.f / sum;
        const unsigned sl = (((unsigned)g & 1u) << 2) | qp;
        unsigned char* op = (unsigned char*)ymix + (size_t)tq * D + head * 64 + 4 * g;
#pragma unroll
        for (int db = 0; db < 4; ++db) {
            const unsigned vb = 128u * (4u * (unsigned)g + qp) + 16u * ((2u * db + (p >> 1)) ^ sl) + 8u * (p & 1u);
            f32x4 y = (f32x4){0.f, 0.f, 0.f, 0.f};
#pragma unroll
            for (int kk = 0; kk < 8; ++kk) {
                const unsigned so = (unsigned)((rs + kk) % 9) * 8192u + 128u * (unsigned)cb;
                const ret::s16x4 lo = __builtin_amdgcn_ds_read_tr16_b64_v4i16((LAS ret::s16x4*)(lds + LVR + so + vb));
                const ret::s16x4 hi = __builtin_amdgcn_ds_read_tr16_b64_v4i16((LAS ret::s16x4*)(lds + LVR + so + 2048u + vb));
                y = __builtin_amdgcn_mfma_f32_16x16x32_bf16(__builtin_shufflevector(lo, hi, 0, 1, 2, 3, 4, 5, 6, 7), pt[kk], y, 0, 0, 0);
            }
            const float inv16 = inv * S_H8;
            int o = __builtin_amdgcn_cvt_pk_fp8_f32(clamp8(y[0] * inv16), clamp8(y[1] * inv16), 0, false); o = __builtin_amdgcn_cvt_pk_fp8_f32(clamp8(y[2] * inv16), clamp8(y[3] * inv16), o, true);
            *(unsigned*)(op + 16 * db) = (unsigned)o;
        }
    }
    __syncthreads();
}
}

__device__ __forceinline__ void unpack_t16r(const u32x4 a, const u32x4 b, f32x4 (&v)[4]) {
    v[0] = (f32x4){__uint_as_float(a.x << 16), __uint_as_float(a.x & 0xffff0000u), __uint_as_float(a.y << 16), __uint_as_float(a.y & 0xffff0000u)};
    v[1] = (f32x4){__uint_as_float(a.z << 16), __uint_as_float(a.z & 0xffff0000u), __uint_as_float(a.w << 16), __uint_as_float(a.w & 0xffff0000u)};
    v[2] = (f32x4){__uint_as_float(b.x << 16), __uint_as_float(b.x & 0xffff0000u), __uint_as_float(b.y << 16), __uint_as_float(b.y & 0xffff0000u)};
    v[3] = (f32x4){__uint_as_float(b.z << 16), __uint_as_float(b.z & 0xffff0000u), __uint_as_float(b.w << 16), __uint_as_float(b.w & 0xffff0000u)};
}
__device__ __forceinline__ void ln1_row(const u32x4 ra, const u32x4 rb, const LAS float* cv  , bf16_t* __restrict__ hf, unsigned char* __restrict__ hf8, float* __restrict__ stats, int row, int lane) {
    asm volatile("" : "+v"(cv));
    const int c0 = lane * 16;
    f32x4 v[4]; float s = 0.f;
    unpack_t16r(ra, rb, v);
#pragma unroll
    for (int j = 0; j < 4; ++j) s += (v[j].x + v[j].y) + (v[j].z + v[j].w);
    const float mean = wave_sum(s) * (1.f / D); float s2 = 0.f;
#pragma unroll
    for (int j = 0; j < 4; ++j) { v[j] = v[j] - mean; s2 += (v[j].x * v[j].x + v[j].y * v[j].y) + (v[j].z * v[j].z + v[j].w * v[j].w); }
    const float rstd = 1.f / sqrtf(wave_sum(s2) * (1.f / D) + LN_EPS);
    if (lane == 0) *(f32x2*)(stats + 2 * (size_t)row) = (f32x2){mean, rstd};
    u32x4 ob[2], o8;
#pragma unroll
    for (int j = 0; j < 4; ++j) { const int col = c0 + 4 * j;
        const f32x4 gg = *(const LAS f32x4*)(cv + col), bv = *(const LAS f32x4*)(cv + 1024 + col), sc1 = *(const LAS f32x4*)(cv + 2048 + col), sh = *(const LAS f32x4*)(cv + 3072 + col);
        const f32x4 h4 = (v[j] * rstd * gg + bv) * sc1 + sh;
        const unsigned p0 = pk2(h4.x, h4.y), p1 = pk2(h4.z, h4.w);
        if (j == 0) { ob[0].x = p0; ob[0].y = p1; } else if (j == 1) { ob[0].z = p0; ob[0].w = p1; } else if (j == 2) { ob[1].x = p0; ob[1].y = p1; } else { ob[1].z = p0; ob[1].w = p1; }
        const f32x4 h8 = h4 * S_HF8;
        int w0 = __builtin_amdgcn_cvt_pk_fp8_f32(clamp8(h8.x), clamp8(h8.y), 0, false); w0 = __builtin_amdgcn_cvt_pk_fp8_f32(clamp8(h8.z), clamp8(h8.w), w0, true);
        if (j == 0) o8.x = (unsigned)w0; else if (j == 1) o8.y = (unsigned)w0; else if (j == 2) o8.z = (unsigned)w0; else o8.w = (unsigned)w0; }
    *(u32x4*)(hf + (size_t)row * D + c0) = ob[0]; *(u32x4*)(hf + (size_t)row * D + c0 + 8) = ob[1];
    *(u32x4*)(hf8 + (size_t)row * D + c0) = o8;
}
__device__ __forceinline__ void top2_merge(float& a1, float& a2, float b1, float b2) { const float n1 = fmaxf(a1, b1); const float n2 = fmaxf(fminf(a1, b1), fmaxf(a2, b2)); a1 = n1; a2 = n2; }
__device__ __forceinline__ float sigm(float x) { return 1.f / (1.f + __expf(-x)); }
__device__ __forceinline__ void route_lane(const float* __restrict__ logits, const float* __restrict__ rbias, int* __restrict__ topk_e, float* __restrict__ topk_w, LAS unsigned* hist, int tok) {
    const float NEG = -3.0e38f;
    const float* row = logits + (size_t)tok * NE;
    float gs[8];
#pragma unroll
    for (int g = 0; g < 8; ++g) {
        float m1 = NEG, m2 = NEG;
#pragma unroll
        for (int q = 0; q < 8; ++q) {
            const f32x4 lg = *(const f32x4*)(row + g * 32 + q * 4), b4 = *(const f32x4*)(rbias + g * 32 + q * 4);
            const float v[4] = {sigm(lg.x) + b4.x, sigm(lg.y) + b4.y, sigm(lg.z) + b4.z, sigm(lg.w) + b4.w};
#pragma unroll
            for (int j = 0; j < 4; ++j) { m2 = fmaxf(m2, fminf(m1, v[j])); m1 = fmaxf(m1, v[j]); }
        }
        gs[g] = m1 + m2;
        if (g & 1) asm volatile("" ::: "memory");
    }
    int pc[8];
    { int run = 0;
#pragma unroll
      for (int g = 0; g < 8; ++g) { int rank = 0;
#pragma unroll
          for (int h = 0; h < 8; ++h) if (h != g) rank += (gs[h] > gs[g] || (gs[h] == gs[g] && h < g)) ? 1 : 0;
          run += (rank < 4) ? 1 : 0; pc[g] = run; } }
    float L[8]; int I[8];
#pragma unroll
    for (int i = 0; i < 8; ++i) { L[i] = NEG; I[i] = 0; }
#pragma unroll 1
    for (int k = 0; k < 4; ++k) {
        int gk = 0;
#pragma unroll
        for (int g = 0; g < 8; ++g) gk += (pc[g] <= k) ? 1 : 0;
        const int base = gk * 32;
#pragma unroll
        for (int q = 0; q < 8; ++q) {
            const f32x4 lg = *(const f32x4*)(row + base + q * 4), b4 = *(const f32x4*)(rbias + base + q * 4);
            const float cv[4] = {sigm(lg.x) + b4.x, sigm(lg.y) + b4.y, sigm(lg.z) + b4.z, sigm(lg.w) + b4.w};
#pragma unroll
            for (int j = 0; j < 4; ++j) { float v = cv[j]; int idx = base + q * 4 + j;
#pragma unroll
                for (int i = 0; i < 8; ++i) { const bool gt = v > L[i]; const float tv = gt ? L[i] : v; const int ti = gt ? I[i] : idx; L[i] = gt ? v : L[i]; I[i] = gt ? idx : I[i]; v = tv; idx = ti; } }
        }
    }
    float w[8], wsum = 0.f;
#pragma unroll
    for (int i = 0; i < 8; ++i) { w[i] = sigm(row[I[i]]); wsum += w[i]; }
    const float sc = 2.5f / wsum;
    *(u32x4*)(topk_e + tok * TOPK) = (u32x4){(unsigned)I[0], (unsigned)I[1], (unsigned)I[2], (unsigned)I[3]}; *(u32x4*)(topk_e + tok * TOPK + 4) = (u32x4){(unsigned)I[4], (unsigned)I[5], (unsigned)I[6], (unsigned)I[7]};
    *(f32x4*)(topk_w + tok * TOPK) = (f32x4){w[0] * sc, w[1] * sc, w[2] * sc, w[3] * sc}; *(f32x4*)(topk_w + tok * TOPK + 4) = (f32x4){w[4] * sc, w[5] * sc, w[6] * sc, w[7] * sc};
#pragma unroll
    for (int i = 0; i < 8; ++i) __hip_atomic_fetch_add(&hist[I[i]], 1u, __ATOMIC_RELAXED, __HIP_MEMORY_SCOPE_WORKGROUP);
}
__device__ __forceinline__ void build_tables(const unsigned* ctl, LAS unsigned* tab, const int tid) {
    if (tid < 64) {
        const int lane = tid;
        unsigned c[4], so = 0, st = 0;
#pragma unroll
        for (int j = 0; j < 4; ++j) { c[j] = __hip_atomic_load(ctl + CW_COUNT + lane * 4 + j, __ATOMIC_RELAXED, __HIP_MEMORY_SCOPE_AGENT); so += c[j]; st += (c[j] + 255u) >> 8; }
        unsigned io = so, it = st;
#pragma unroll
        for (int o = 1; o < 64; o <<= 1) { const unsigned a = __shfl_up(io, o), b = __shfl_up(it, o); if (lane >= o) { io += a; it += b; } }
        unsigned eo = io - so, et = it - st;
#pragma unroll
        for (int j = 0; j < 4; ++j) { tab[T_CNT + lane * 4 + j] = c[j]; tab[T_OFF + lane * 4 + j] = eo; tab[T_TILE + lane * 4 + j] = et; eo += c[j]; et += (c[j] + 255u) >> 8; }
        if (lane == 63) { tab[T_OFF + NE] = eo; tab[T_TILE + NE] = et; }
    }
    __syncthreads();
}
struct RowRaw { u32x4 y[9]; u32x4 t[2]; f32x2 st; };
__device__ __forceinline__ void final_load(RowRaw& R, const bf16_t* __restrict__ tb, const unsigned char* __restrict__ ybuf, const unsigned char* __restrict__ ysh, const float* __restrict__ stats, int row, int lane) {
    const int c0 = lane * 16;
#pragma unroll
    for (int k = 0; k < TOPK; ++k) R.y[k] = *(const u32x4*)(ybuf + ((size_t)row * TOPK + k) * D + c0);
    R.y[8] = *(const u32x4*)(ysh + (size_t)row * D + c0);
    R.t[0] = *(const u32x4*)(tb + (size_t)row * D + c0); R.t[1] = *(const u32x4*)(tb + (size_t)row * D + c0 + 8);
    R.st = *(const f32x2*)(stats + 2 * (size_t)row);
}
__device__ __forceinline__ void final_row(float* __restrict__ out, const RowRaw& R, const LAS float* cv  , int row, int lane) {
    asm volatile("" : "+v"(cv));
    const int c0 = lane * 16;
    f32x4 a[4], t[4], v[4]; float s = 0.f;
#pragma unroll
    for (int j = 0; j < 4; ++j) a[j] = (f32x4){0.f, 0.f, 0.f, 0.f};
#pragma unroll
    for (int k = 0; k < 9; ++k) { const unsigned w[4] = {R.y[k].x, R.y[k].y, R.y[k].z, R.y[k].w};
#pragma unroll
        for (int j = 0; j < 4; ++j) { const f32x2 lo = __builtin_amdgcn_cvt_pk_f32_fp8((int)w[j], false), hi = __builtin_amdgcn_cvt_pk_f32_fp8((int)w[j], true); a[j].x += lo.x; a[j].y += lo.y; a[j].z += hi.x; a[j].w += hi.y; } }
    unpack_t16r(R.t[0], R.t[1], t);
#pragma unroll
    for (int j = 0; j < 4; ++j) { const int col = c0 + 4 * j;
        const f32x4 x1 = (t[j] - R.st.x) * R.st.y * *(const LAS f32x4*)(cv + col) + *(const LAS f32x4*)(cv + 1024 + col);
        v[j] = x1 * ALPHA + *(const LAS f32x4*)(cv + 4096 + col) * a[j] * YINV;
        s += (v[j].x + v[j].y) + (v[j].z + v[j].w); }
    const float mean = wave_sum(s) * (1.f / D); float s2 = 0.f;
#pragma unroll
    for (int j = 0; j < 4; ++j) { v[j] = v[j] - mean; s2 += (v[j].x * v[j].x + v[j].y * v[j].y) + (v[j].z * v[j].z + v[j].w * v[j].w); }
    const float rstd = 1.f / sqrtf(wave_sum(s2) * (1.f / D) + LN_EPS);
#pragma unroll
    for (int j = 0; j < 4; ++j) { const int col = c0 + 4 * j;
        *(f32x4*)(out + (size_t)row * D + col) = v[j] * rstd * *(const LAS f32x4*)(cv + 2048 + col) + *(const LAS f32x4*)(cv + 3072 + col); }
}

#ifndef MK_PER_PHASE
#define MK_PER_PHASE 0
#endif
constexpr int N_PHASES = 13;
struct Args { Ctx X; int ph_lo, ph_hi; };
typedef __attribute__((address_space(4))) const Ctx* CtxCP;
__device__ __forceinline__ CtxCP ctx_ptr() { CtxCP p = (CtxCP)__builtin_amdgcn_kernarg_segment_ptr(); asm volatile("" : "+s"(p)); return p; }

__global__ void __launch_bounds__(NW * 64, 2) mk_fwd(Args args) {
    extern __shared__ __attribute__((aligned(16))) unsigned char lds_raw[];
    LAS unsigned char* lds = (LAS unsigned char*)lds_raw;
    LAS unsigned* tab = (LAS unsigned*)(lds + TAB_OFF);
    volatile LAS unsigned* MISC = (volatile LAS unsigned*)(lds + MISC_OFF);
#define PH_BEGIN \
    const __attribute__((address_space(4))) Ctx& X = *ctx_ptr(); unsigned char* ws = X.ws; (void)ws; \
    const int lane = lane_id(), wave = wave0, tid = wave0 * 64 + lane; (void)lane; (void)wave; (void)tid; \
    const int G = gridDim.x, bx = blockIdx.x; (void)G; (void)bx; \
    const int gw = bx * NW + wave, NGW = G * NW; (void)gw; (void)NGW; \
    const int gt = bx * (NW * 64) + tid, NGT = G * NW * 64; (void)gt; (void)NGT; \
    unsigned* ctl = (unsigned*)(ws + WS_CTL); float* mod = (float*)(ws + WS_MOD); float* rope = (float*)(ws + WS_ROPE); (void)ctl; (void)mod; (void)rope; \
    bf16_t* win_t = (bf16_t*)(ws + WS_WIN_T); bf16_t* wout_t = (bf16_t*)(ws + WS_WOUT_T); bf16_t* wr_t = (bf16_t*)(ws + WS_WR_T); (void)win_t; (void)wout_t; (void)wr_t; \
    bf16_t* wsgu_t = (bf16_t*)(ws + WS_WSGU_T); bf16_t* wsd_t = (bf16_t*)(ws + WS_WSD_T); bf16_t* wd_t = (bf16_t*)(ws + WS_WD_T); bf16_t* wgu_t = (bf16_t*)(ws + WS_WGU_T); (void)wsgu_t; (void)wsd_t; (void)wd_t; (void)wgu_t; \
    int* slot_ent = (int*)(ws + WS_SLOT_ENT); float* slot_w = (float*)(ws + WS_SLOT_W); int* topk_e = (int*)(ws + WS_TOPK_E); float* topk_w = (float*)(ws + WS_TOPK_W); (void)slot_ent; (void)slot_w; (void)topk_e; (void)topk_w; \
    bf16_t* ymix = (bf16_t*)(ws + WS_YMIX); bf16_t* proj = (bf16_t*)(ws + WS_PROJ); bf16_t* hbuf = (bf16_t*)(ws + WS_YMIX); (void)ymix; (void)proj; (void)hbuf; \
    float* logits = (float*)(ws + WS_LOGITS); bf16_t* shh = (bf16_t*)(ws + WS_SHH); bf16_t* hf = (bf16_t*)(ws + WS_HF); bf16_t* act = (bf16_t*)(ws + WS_ACT); (void)logits; (void)shh; (void)hf; (void)act; \
    unsigned char* ybuf = ws + WS_YBUF; float* out = X.out; (void)ybuf; (void)out;

    const int wave0 = __builtin_amdgcn_readfirstlane((int)threadIdx.x >> 6);
    for (int u = threadIdx.x; u < (LDS_BYTES - MISC_OFF) / 4; u += NW * 64) ((LAS unsigned*)(lds + MISC_OFF))[u] = 0u;
    __syncthreads();
    if (!MK_PER_PHASE) { unsigned* ctl0 = (unsigned*)(args.X.ws + WS_CTL); (void)xcd_barrier_post(ctl0 + CW_BAR, MISC + 8, wave0 == 0 && lane_id() == 0); }
    const int lo = args.ph_lo, hi = args.ph_hi;
#ifndef MK_DUP
#define MK_DUP -1
#endif
#define REPS(k) for (int _rep = 0; _rep < ((MK_DUP == (k)) ? 2 : 1); ++_rep)
#ifdef MK_ONLY
#define IN(k) ((k) == MK_ONLY)
#else
#define IN(k) (lo <= (k) && (k) < hi)
#endif
#define SEAM(k) SEAM2(k, (k) + 1)
#define SEAM2(k, k2) do { if (IN(k) && IN(k2)) { XcdBarrier _b; _b.bar = (unsigned*)(ctx_ptr()->ws + WS_CTL) + CW_BAR; _b.x = xb_xcc_id(); _b.st = (volatile LAS unsigned*)(lds + MISC_OFF) + 8; xcd_barrier(_b, wave0 == 0 && lane_id() == 0); } } while (0)

    REPS(0) if (IN(0)) { PH_BEGIN
        LAS float* scr = (LAS float*)(lds + wave * 16384);
        float* modp = (float*)(ws + WS_PROJ);
        for (int t = gw; t < 96 * 16; t += NGW) mod_task(X.c, X.w_ada, modp, t, lane);
        constexpr int I_IN = (D / 64) * (DIN / 32), I_OUT = (D / 64) * (D / 32), I_R = (D / 64) * (NE / 32), I_SG = (D / 64) * (DE / 32), I_SD = (DE / 64) * (D / 32);
        constexpr int I_EG = I_SG, I_ED = I_SD;
        constexpr int N_SMALL = I_IN + I_OUT + I_R + 2 * I_SG + I_SD;
        constexpr int N_ITEMS = N_SMALL + NE * (2 * I_EG + I_ED);
        for (int it = gw; it < N_ITEMS; it += NGW) {
            int r = it;
            if (r < I_IN) { transpose_item_fp8(X.w_in, D, DIN, (unsigned char*)win_t, 0, 0, S_WIN8, scr, r, lane); continue; } r -= I_IN;
            if (r < I_OUT) { transpose_item_fp8(X.w_out, D, D, (unsigned char*)wout_t, 0, 0, S_WIN8, scr, r, lane); continue; } r -= I_OUT;
            if (r < I_R) { transpose_item(X.w_router, D, NE, wr_t, 0, 0, scr, r, lane); continue; } r -= I_R;
            if (r < I_SG) { transpose_item_fp8(X.ws_gate, D, DE, (unsigned char*)wsgu_t, 8, 0, S_WGU8, scr, r, lane); continue; } r -= I_SG;
            if (r < I_SG) { transpose_item_fp8(X.ws_up, D, DE, (unsigned char*)wsgu_t, 8, 1, S_WGU8, scr, r, lane); continue; } r -= I_SG;
            if (r < I_SD) { transpose_item(X.ws_down, DE, D, wsd_t, 0, 0, scr, r, lane); continue; } r -= I_SD;
            const int e = r / (2 * I_EG + I_ED); r -= e * (2 * I_EG + I_ED);
            if (r < I_EG) { transpose_item_fp8(X.w_gate + (size_t)e * D * DE, D, DE, (unsigned char*)wgu_t + (size_t)e * 512 * D, 8, 0, S_WGU8, scr, r, lane); continue; } r -= I_EG;
            if (r < I_EG) { transpose_item_fp8(X.w_up + (size_t)e * D * DE, D, DE, (unsigned char*)wgu_t + (size_t)e * 512 * D, 8, 1, S_WGU8, scr, r, lane); continue; } r -= I_EG;
            transpose_item_fp8(X.w_down + (size_t)e * DE * D, DE, D, (unsigned char*)wd_t + (size_t)e * D * DE, 0, 0, S_WD8, scr, r, lane);
        }
        for (int i = gt; i < SEQ * 64; i += NGT) rope_entry(rope, i);
    }
    SEAM(0);
    REPS(1) if (IN(1)) { PH_BEGIN
        const float* modp = (const float*)(ws + WS_PROJ);
        for (int i = gt; i < 32 * 6144; i += NGT) mod[i] = mod_sum(modp, X.b_ada, i / 6144, i % 6144);
        LAS float* ssc = (LAS float*)lds; LAS float* ssh = ssc + 1024;
        int curb = -1;
        for (int c = bx; c < M / 256; c += G) {
            const int b = c >> 3;
            if (b != curb) {
                __syncthreads();
                for (int i = tid; i < 1024; i += NW * 64) { ssc[i] = 1.f + mod_sum(modp, X.b_ada, b, MOD_SCALE_A + i); ssh[i] = mod_sum(modp, X.b_ada, b, MOD_SHIFT_A + i); }
                __syncthreads();
                curb = b;
            }
            const f32x4 sc = *(const LAS f32x4*)(ssc + (tid & 255) * 4), sh = *(const LAS f32x4*)(ssh + (tid & 255) * 4);
            const float* xp = X.x + (size_t)c * 256 * D + (size_t)(tid >> 8) * D + (tid & 255) * 4;
            unsigned char* hp = (unsigned char*)hbuf + (size_t)c * 256 * D + (size_t)(tid >> 8) * D + (tid & 255) * 4;
            for (int i0 = 0; i0 < 128; i0 += 8) {
                f32x4 v[8];
#pragma unroll
                for (int i = 0; i < 8; ++i) v[i] = __builtin_nontemporal_load((const f32x4*)(xp + (size_t)(i0 + i) * 2 * D));
#pragma unroll
                for (int i = 0; i < 8; ++i) { int w = __builtin_amdgcn_cvt_pk_fp8_f32(clamp8((v[i].x * sc.x + sh.x) * S_H8), clamp8((v[i].y * sc.y + sh.y) * S_H8), 0, false);
                    w = __builtin_amdgcn_cvt_pk_fp8_f32(clamp8((v[i].z * sc.z + sh.z) * S_H8), clamp8((v[i].w * sc.w + sh.w) * S_H8), w, true); *(unsigned*)(hp + (size_t)(i0 + i) * 2 * D) = (unsigned)w; }
            }
        }
        __syncthreads();
    }
    SEAM(1);
    REPS(2) if (IN(2)) { PH_BEGIN
        pg8::DenseOrder S; S.init(M, DIN, D / 2, win_t, G, bx);
        pg8::EpiInProj E{proj};
        pg8::gemm_phase<1>(lds, (const char*)hbuf, D, S, E, tid);
    }
    SEAM(2);
    REPS(3) if (IN(3)) { PH_BEGIN
        REPS(31) for (int hu = bx; hu < BATCH * 4 * 2; hu += G) ret::unit(proj, rope, X.ret_ld, X.ret_gn, ymix, (unsigned char*)out + (size_t)hu * (8 * ret::TILE), lds, hu, tid);
        REPS(32) for (int u = bx; u < BATCH * 8; u += G) na::unit(proj, X.na_rpb, ymix, lds, u, tid);
    }
    SEAM2(3, 5);
    if (IN(5)) { PH_BEGIN
        LAS float* cv = (LAS float*)lds; LAS unsigned* hist = tab + T_HIST;
        if (tid < NE) hist[tid] = 0u;
        __syncthreads();
        for (int c = bx; c < M / 256; c += G) {
            const int b = c >> 3;
            { pg8::RowOrder S{c, 4, D / 2, (const char*)wout_t}; pg8::EpiOutProj E{X.x, mod, (bf16_t*)(ws + WS_TB)}; pg8::gemm_phase<1>(lds, (const char*)ymix, D, S, E, tid); }
            asm volatile("s_waitcnt vmcnt(0)" ::: "memory"); __syncthreads();
            int lane2 = lane; asm volatile("" : "+v"(lane2));
            const int tid2 = wave * 64 + lane2;
            if (tid2 < 256) { const int i = tid2 * 4; *(LAS f32x4*)(cv + i) = *(const f32x4*)(X.ln1_g + i); *(LAS f32x4*)(cv + 1024 + i) = *(const f32x4*)(X.ln1_b + i);
                *(LAS f32x4*)(cv + 2048 + i) = *(const f32x4*)(mod + b * 6144 + MOD_SCALE_F + i) + 1.f; *(LAS f32x4*)(cv + 3072 + i) = *(const f32x4*)(mod + b * 6144 + MOD_SHIFT_F + i); }
            __syncthreads();
            { const bf16_t* tp = (const bf16_t*)(ws + WS_TB) + (size_t)(c * 256 + wave * 32) * D + lane2 * 16;
              u32x4 ra = *(const u32x4*)tp, rb = *(const u32x4*)(tp + 8);
#pragma unroll 1
              for (int i = 0; i < 32; ++i) {
                  const u32x4 ca = ra, cb = rb; const int nx = i < 31 ? i + 1 : i;
                  ra = *(const u32x4*)(tp + (size_t)nx * D); rb = *(const u32x4*)(tp + (size_t)nx * D + 8);
                  ln1_row(ca, cb, cv, hf, ws + WS_HF8, (float*)(ws + WS_STATS), c * 256 + wave * 32 + i, lane2);
              } }
            asm volatile("s_waitcnt vmcnt(0)" ::: "memory"); __syncthreads();
            { pg8::RowOrder S{c, 1, D, (const char*)wr_t}; pg8::EpiRouter E{logits}; pg8::gemm_phase(lds, (const char*)hf, D, S, E, tid); }
            { pg8::RowOrder S{c, 2, D / 2, (const char*)wsgu_t}; pg8::EpiGU<false, true> E{(void*)shh}; pg8::gemm_phase<1>(lds, (const char*)(ws + WS_HF8), D, S, E, tid); }
            asm volatile("s_waitcnt vmcnt(0)" ::: "memory"); __syncthreads();
            { int lane3 = lane; asm volatile("" : "+v"(lane3)); const int tid3 = wave * 64 + lane3;
              if (tid3 < 256) route_lane(logits, X.rbias, topk_e, topk_w, hist, c * 256 + tid3); }
        }
        __syncthreads();
        if (tid < NE && hist[tid]) atomicAdd(&ctl[CW_COUNT + tid], hist[tid]);
    }
    SEAM2(5, 9);
    if (IN(9)) { PH_BEGIN
        build_tables(ctl, tab, tid);
        LAS unsigned* hist = tab + T_HIST; LAS unsigned* base = tab + T_BASE;
        for (int c0 = bx * 2048; c0 < NSLOT; c0 += G * 2048) {
            __syncthreads();
            if (tid < NE) hist[tid] = 0u;
            __syncthreads();
            int e[4]; unsigned loc[4];
#pragma unroll
            for (int i = 0; i < 4; ++i) { const int idx = c0 + i * 512 + tid; e[i] = topk_e[idx]; loc[i] = __hip_atomic_fetch_add(&hist[e[i]], 1u, __ATOMIC_RELAXED, __HIP_MEMORY_SCOPE_WORKGROUP); }
            __syncthreads();
            if (tid < NE && hist[tid]) base[tid] = atomicAdd(&ctl[CW_CURSOR + tid], hist[tid]);
            __syncthreads();
#pragma unroll
            for (int i = 0; i < 4; ++i) { const int idx = c0 + i * 512 + tid; const unsigned pos = tab[T_OFF + e[i]] + base[e[i]] + loc[i]; slot_ent[pos] = idx; slot_w[pos] = topk_w[idx]; }
        }
    }
    SEAM(9);
    if (IN(10)) { PH_BEGIN
        build_tables(ctl, tab, tid);
        REPS(10) { pg8::ExpertOrder<2, true> S; S.init(tab, D, wgu_t, (size_t)512 * D, slot_ent, slot_w, G, bx); pg8::EpiGU<true> E{(void*)act}; pg8::gemm_phase<1>(lds, (const char*)(ws + WS_HF8), D, S, E, tid); }
        { pg8::DenseOrder S; S.init(M, D, DE, wsd_t, G, bx); pg8::EpiSharedDown E{ws + WS_YSH}; pg8::gemm_phase(lds, (const char*)shh, DE, S, E, tid); }
    }
    SEAM(10);
    REPS(11) if (IN(11)) { PH_BEGIN
        build_tables(ctl, tab, tid);
#if MK_DUP >= 113 && MK_DUP <= 118
        pg8::down2_phase<MK_DUP - 112>(lds, tab, (const char*)act, (const char*)wd_t, slot_ent, ybuf, G, bx, tid);
#endif
        pg8::down2_phase(lds, tab, (const char*)act, (const char*)wd_t, slot_ent, ybuf, G, bx, tid);
#if MK_DUP == 111
        { pg8::ExpertOrder<4, false> S2; S2.init(tab, DE, wd_t, (size_t)D * DE, slot_ent, slot_w, G, bx); pg8::EpiProbeSum E2{(float*)(ws + WS_STATS)}; pg8::gemm_phase<1>(lds, (const char*)act, DE, S2, E2, tid); }
#endif
    }
    SEAM(11);
    REPS(12) if (IN(12)) { PH_BEGIN
        LAS float* cv = (LAS float*)lds; int curb = -1;
        for (int c = bx; c < M / 256; c += G) {
            const int b = c >> 3;
            if (b != curb) {
                __syncthreads();
                if (tid < 256) { const int i = tid * 4; *(LAS f32x4*)(cv + i) = *(const f32x4*)(X.ln1_g + i); *(LAS f32x4*)(cv + 1024 + i) = *(const f32x4*)(X.ln1_b + i);
                    *(LAS f32x4*)(cv + 2048 + i) = *(const f32x4*)(X.ln2_g + i); *(LAS f32x4*)(cv + 3072 + i) = *(const f32x4*)(X.ln2_b + i); *(LAS f32x4*)(cv + 4096 + i) = *(const f32x4*)(mod + b * 6144 + MOD_GATE_F + i); }
                __syncthreads(); curb = b;
            }
            const int r0 = c * 256 + wave * 32;
            RowRaw nx; final_load(nx, (const bf16_t*)(ws + WS_TB), ybuf, ws + WS_YSH, (const float*)(ws + WS_STATS), r0, lane);
#pragma unroll 1
            for (int i = 0; i < 32; ++i) {
                const RowRaw cur = nx;
                final_load(nx, (const bf16_t*)(ws + WS_TB), ybuf, ws + WS_YSH, (const float*)(ws + WS_STATS), r0 + (i < 31 ? i + 1 : i), lane);
                final_row(out, cur, cv, r0 + i, lane);
            }
        }
    }
#undef IN
#undef SEAM
}

extern "C" void kernel_launch(void* const* d_in, const int* in_sizes, int n_in, void* d_out, int out_size, void* d_ws, size_t ws_size, hipStream_t stream) {
    static int grid = 0;
    if (grid == 0) {
        if (n_in != 21 || in_sizes[0] != M * D || out_size != M * D || ws_size < WS_END) { fprintf(stderr, "kernel_launch: unexpected shapes (n_in %d, ws %zu)\n", n_in, ws_size); grid = -1; return; }
        int dev = 0, cus = 0, per_cu = 0;
        if (hipGetDevice(&dev) != hipSuccess || hipDeviceGetAttribute(&cus, hipDeviceAttributeMultiprocessorCount, dev) != hipSuccess) { grid = -1; return; }
        if (hipFuncSetAttribute((const void*)mk_fwd, hipFuncAttributeMaxDynamicSharedMemorySize, LDS_BYTES) != hipSuccess) { fprintf(stderr, "kernel_launch: hipFuncSetAttribute failed\n"); grid = -1; return; }
        if (hipOccupancyMaxActiveBlocksPerMultiprocessor(&per_cu, (const void*)mk_fwd, NW * 64, LDS_BYTES) != hipSuccess || per_cu < 1) { fprintf(stderr, "kernel_launch: occupancy query says %d\n", per_cu); }
        (void)hipGetLastError();
        grid = cus;
    }
    if (grid < 0) return;
    (void)hipMemsetAsync((char*)d_ws + WS_CTL, 0, 1 * MiB, stream);
    Args a{};
    const float** p = (const float**)&a.X;
    for (int i = 0; i < 21; ++i) p[i] = (const float*)d_in[i];
    a.X.out = (float*)d_out; a.X.ws = (unsigned char*)d_ws;
#if MK_PER_PHASE
    for (int ph = 0; ph < N_PHASES; ++ph) { a.ph_lo = ph; a.ph_hi = ph + 1; hipLaunchKernelGGL(mk_fwd, dim3(grid), dim3(NW * 64), LDS_BYTES, stream, a); }
#else
    a.ph_lo = 0; a.ph_hi = N_PHASES;
    hipLaunchKernelGGL(mk_fwd, dim3(grid), dim3(NW * 64), LDS_BYTES, stream, a);
#endif
}
```

```cpp
#include <hip/hip_runtime.h>
#include <cstdio>
#include <cstdint>

typedef unsigned short bf16_t;
typedef short bf16x8 __attribute__((ext_vector_type(8)));
typedef float f32x4 __attribute__((ext_vector_type(4)));
typedef float f32x2 __attribute__((ext_vector_type(2)));
typedef unsigned u32x4 __attribute__((ext_vector_type(4)));
typedef unsigned u32x2 __attribute__((ext_vector_type(2)));
#define LAS __attribute__((address_space(3)))

constexpr int D = 1024, BATCH = 32, SEQ = 2048, M = BATCH * SEQ;
constexpr int DIN = 3584;
constexpr int OFF_QNA = 0, OFF_KNA = 512, OFF_VNA = 1024, OFF_QR = 1536, OFF_KR = 2048, OFF_VR = 2560, OFF_GR = 3072;
constexpr int NE = 256, TOPK = 8, DE = 256;
constexpr int NSLOT = M * TOPK;
constexpr float LN_EPS = 1e-5f, GN_EPS = 1e-6f;
constexpr float ALPHA = 1.189207115002721f;
constexpr float YSCALE = 64.f, YINV = 1.f / 64.f;
constexpr float S_HF8 = 16.f, S_WGU8 = 256.f, S_ACT8 = 8.f, S_WD8 = 8.f;
constexpr float INV_GU8 = 1.f / (16.f * 256.f), INV_DN8 = 1.f / (8.f * 8.f);
static_assert(YSCALE * INV_DN8 == 1.f, "down-projection epilogue assumes no rescale");
constexpr float S_H8 = 16.f, S_WIN8 = 128.f, INV_IN8 = 1.f / (16.f * 128.f);
constexpr int MOD_SHIFT_A = 0, MOD_SCALE_A = 1024, MOD_GATE_A = 2048, MOD_SHIFT_F = 3072, MOD_SCALE_F = 4096, MOD_GATE_F = 5120;

constexpr size_t MiB = 1u << 20;
constexpr size_t WS_CTL = 0;
constexpr size_t WS_MOD = 1 * MiB;
constexpr size_t WS_ROPE = 2 * MiB;
constexpr size_t WS_WIN_T = 4 * MiB;
constexpr size_t WS_WOUT_T = 11 * MiB;
constexpr size_t WS_WR_T = 13 * MiB;
constexpr size_t WS_WSGU_T = 14 * MiB;
constexpr size_t WS_WSD_T = 15 * MiB;
constexpr size_t WS_SLOT_ENT = 16 * MiB;
constexpr size_t WS_SLOT_W = 18 * MiB;
constexpr size_t WS_TOPK_E = 20 * MiB;
constexpr size_t WS_TOPK_W = 22 * MiB;
constexpr size_t WS_STATS = 24 * MiB;
constexpr size_t WS_WD_T = 32 * MiB;
constexpr size_t WS_WGU_T = 160 * MiB;
constexpr size_t WS_HF8 = 288 * MiB;
constexpr size_t WS_YMIX = 416 * MiB;
constexpr size_t WS_PROJ = 544 * MiB;
constexpr size_t WS_LOGITS = WS_PROJ + 384 * MiB;
constexpr size_t WS_SHH = 352 * MiB;
constexpr size_t WS_HF = WS_PROJ, WS_ACT = WS_PROJ + 128 * MiB;
constexpr size_t WS_YBUF = WS_WGU_T;
constexpr size_t WS_TB = WS_PROJ + 256 * MiB;
constexpr size_t WS_YSH = WS_PROJ + 384 * MiB;
constexpr size_t WS_END = 992 * MiB;
constexpr int CW_COUNT = 1024, CW_CURSOR = 1536, CW_BAR = 8192;

constexpr int RING_BYTES = 131072;
constexpr int TAB_OFF = RING_BYTES;
constexpr int T_OFF = 0, T_TILE = 260, T_CNT = 520, T_HIST = 776, T_BASE = 1032, TAB_WORDS = 1288;
constexpr int VN_OFF = TAB_OFF + 6144;
constexpr int ROWTAB_OFF = VN_OFF + 8192;
constexpr int PHASE_BYTES = 155648;
constexpr int MISC_OFF = PHASE_BYTES;
constexpr int LDS_BYTES = PHASE_BYTES + 256;
static_assert(TAB_WORDS * 4 <= 6144 && ROWTAB_OFF + 6144 <= PHASE_BYTES && LDS_BYTES <= 163840, "LDS map");

__device__ __forceinline__ unsigned f2bf(float f) { unsigned u = __float_as_uint(f); return (u + 0x7fffu + ((u >> 16) & 1u)) >> 16; }
__device__ __forceinline__ float bf2f(unsigned short h) { return __uint_as_float(((unsigned)h) << 16); }
__device__ __forceinline__ unsigned pk2(float lo, float hi) { return f2bf(lo) | (f2bf(hi) << 16); }
__device__ __forceinline__ unsigned cvt_pk_bf16(float lo, float hi) { unsigned r; asm volatile("v_cvt_pk_bf16_f32 %0, %1, %2" : "=v"(r) : "v"(lo), "v"(hi)); return r; }
__device__ __forceinline__ float silu_f(float v) { return v * __builtin_amdgcn_rcpf(1.f + __expf(-v)); }
__device__ __forceinline__ float wave_sum(float v) {
    v += __builtin_bit_cast(float, __builtin_amdgcn_update_dpp(0, __builtin_bit_cast(int, v), 0xB1, 0xf, 0xf, true));
    v += __builtin_bit_cast(float, __builtin_amdgcn_update_dpp(0, __builtin_bit_cast(int, v), 0x4E, 0xf, 0xf, true));
    v += __builtin_bit_cast(float, __builtin_amdgcn_update_dpp(0, __builtin_bit_cast(int, v), 0x141, 0xf, 0xf, true));
    v += __builtin_bit_cast(float, __builtin_amdgcn_update_dpp(0, __builtin_bit_cast(int, v), 0x140, 0xf, 0xf, true));
    const int b = __builtin_bit_cast(int, v);
    return (__builtin_bit_cast(float, __builtin_amdgcn_readlane(b, 0)) + __builtin_bit_cast(float, __builtin_amdgcn_readlane(b, 16))) + (__builtin_bit_cast(float, __builtin_amdgcn_readlane(b, 32)) + __builtin_bit_cast(float, __builtin_amdgcn_readlane(b, 48)));
}
__device__ __forceinline__ float clamp8(float v) { return __builtin_amdgcn_fmed3f(v, -440.f, 440.f); }
#define LDS_WAIT() asm volatile("s_waitcnt lgkmcnt(0)" ::: "memory")
__device__ __forceinline__ int lane_id() { return (int)__builtin_amdgcn_mbcnt_hi(~0u, __builtin_amdgcn_mbcnt_lo(~0u, 0u)); }

#define XB_TMO      128
#define XB_XCNT(j)  (256  + 64 * (j))
#define XB_XSUB(j)  (1280 + 64 * (j))
#define XB_XGEN(j)  (2304 + 64 * (j))
#define XB_TOP      3328
#define XB_TOPGEN   3392
#define XCD_BAR_WORDS 3456
#define XB_SPIN_CAP (1u << 23)
__device__ __forceinline__ unsigned xb_ld(unsigned* p)              { return __hip_atomic_load(p, __ATOMIC_RELAXED, __HIP_MEMORY_SCOPE_AGENT); }
__device__ __forceinline__ unsigned xb_add(unsigned* p, unsigned v) { return __hip_atomic_fetch_add(p, v, __ATOMIC_RELAXED, __HIP_MEMORY_SCOPE_AGENT); }
__device__ __forceinline__ unsigned xb_xcc_id() { return (unsigned)__builtin_amdgcn_s_getreg((3 << 11) | 20) & 0xFu; }
#define XB_SPIN(cond, bar) do { unsigned _sp = 0; while (cond) { __builtin_amdgcn_s_sleep(1); \
    if ((++_sp & 255u) == 0u) { if (xb_ld(&(bar)[XB_TMO])) break; if (_sp > XB_SPIN_CAP) { atomicAdd(&(bar)[XB_TMO], 1u); break; } } } } while (0)
struct XcdBarrier { unsigned* bar; unsigned x; volatile LAS unsigned* st; };
__device__ __forceinline__ XcdBarrier xcd_barrier_post(unsigned* bar, volatile LAS unsigned* st, bool leader) {
    XcdBarrier b; b.bar = bar; b.x = xb_xcc_id(); b.st = st;
    if (leader) (void)xb_add(&bar[XB_XCNT(b.x)], 1u);
    return b;
}
__device__ __forceinline__ void xcd_barrier_complete(unsigned* bar, unsigned x, unsigned& nloc, unsigned& nx) {
    const unsigned G = gridDim.x * gridDim.y * gridDim.z;
    unsigned sum, cnt, mine, sp = 0u;
    for (;;) {
        sum = 0u; cnt = 0u; mine = 0u;
#pragma unroll
        for (unsigned j = 0; j < 16; ++j) { const unsigned c = xb_ld(&bar[XB_XCNT(j)]); sum += c; cnt += (c > 0u) ? 1u : 0u; mine = (j == x) ? c : mine; }
        if (sum == G) break;
        __builtin_amdgcn_s_sleep(1);
        if ((++sp & 255u) == 0u) { if (xb_ld(&bar[XB_TMO])) break; if (sp > XB_SPIN_CAP) { atomicAdd(&bar[XB_TMO], 1u); break; } }
    }
    nloc = mine > 0u ? mine : 1u; nx = cnt > 0u ? cnt : 1u;
}
__device__ __forceinline__ void xcd_barrier(const XcdBarrier& b, bool leader) {
    asm volatile("s_waitcnt vmcnt(0)" ::: "memory");
    __syncthreads();
    if (leader) {
        unsigned* bar = b.bar;
        __builtin_amdgcn_s_waitcnt(0);
        unsigned nloc = b.st[0], nx = b.st[1];
        if (nloc == 0u) { xcd_barrier_complete(bar, b.x, nloc, nx); b.st[0] = nloc; b.st[1] = nx; }
        const unsigned old = xb_add(&bar[XB_XSUB(b.x)], 1u);
        const unsigned gen = old / nloc;
        if (old + 1u == (gen + 1u) * nloc) {
            __builtin_amdgcn_fence(__ATOMIC_RELEASE, "agent");
            asm volatile("s_waitcnt vmcnt(0)" ::: "memory");
            const unsigned og = xb_add(&bar[XB_TOP], 1u);
            const unsigned tg = og / nx;
            if (og + 1u == (tg + 1u) * nx) xb_add(&bar[XB_TOPGEN], 1u);
            else XB_SPIN(xb_ld(&bar[XB_TOPGEN]) == tg, bar);
            __builtin_amdgcn_fence(__ATOMIC_ACQUIRE, "agent");
            xb_add(&bar[XB_XGEN(b.x)], 1u);
            asm volatile("s_waitcnt vmcnt(0)" ::: "memory");
        } else {
            XB_SPIN(xb_ld(&bar[XB_XGEN(b.x)]) == gen, bar);
            __builtin_amdgcn_fence(__ATOMIC_ACQUIRE, "agent");
            asm volatile("s_waitcnt vmcnt(0)" ::: "memory");
        }
    }
    __syncthreads();
}

namespace pg8 {
constexpr int BM = 256, BK = 64, HALF = 128, HTB = HALF * BK * 2, STAGE_BYTES = 8 * HTB;
__device__ __forceinline__ int lds_byte(int r, int c) { const int st = (r >> 4) * 2 + (c >> 5), rr = r & 15, cc = c & 31, ob = rr * 64 + cc * 2; return st * 1024 + (ob ^ (((ob >> 9) & 1) << 5)); }
__device__ __forceinline__ void stage_rc(int b, int& R, int& C) { const int st = b / 1024, sb = b % 1024, swz = sb ^ (((sb >> 9) & 1) << 5); R = (st >> 1) * 16 + swz / 64; C = (st & 1) * 32 + (swz % 64) / 2; }
__device__ __forceinline__ int perm32(int rho) { const int n = rho >> 4, i = rho & 15; return 8 * (i >> 2) + 4 * n + (i & 3); }

typedef int i32x8 __attribute__((ext_vector_type(8)));
__device__ __forceinline__ i32x8 cat8(const bf16x8 lo, const bf16x8 hi) { const u32x4 a = __builtin_bit_cast(u32x4, lo), b = __builtin_bit_cast(u32x4, hi); return (i32x8){(int)a.x, (int)a.y, (int)a.z, (int)a.w, (int)b.x, (int)b.y, (int)b.z, (int)b.w}; }
struct Unit { int pm, pn; const char* B; int e, cnt, off; };

template <int ESZ = 2, bool AREUSE = false, class Epi, class Sched>
__device__ __forceinline__ void gemm_phase(LAS unsigned char* lds, const char* Abase, const int K, const Sched& S, const Epi& E, const int tid_in) {
    int tid_ = tid_in; asm volatile("" : "+v"(tid_));
    const int tid = tid_, wid = __builtin_amdgcn_readfirstlane(tid >> 6), lane = tid & 63, wr = wid >> 2, wc = wid & 3, fr = lane & 15, fq = lane >> 4;
    const int rowbytes = K * ESZ, nt = rowbytes / 128;
    int Rr[2], Cc[2]; unsigned voffB[2], voffA[2];
#pragma unroll
    for (int i = 0; i < 2; ++i) { int R, C; stage_rc(tid * 16 + i * 8192, R, C); Rr[i] = R; Cc[i] = C; const int Rb = Epi::PERM ? (64 * (R >> 5) + 16 * ((R >> 2) & 3) + 4 * ((R >> 4) & 1) + (R & 3)) : R; voffB[i] = (unsigned)(Rb * rowbytes + C * 2); voffA[i] = (unsigned)(R * rowbytes + C * 2); }
    constexpr bool GATHER = Sched::GATHER;
    const size_t kstep = (size_t)128;
    const size_t hstep = (size_t)HALF * rowbytes;
    const size_t bhstep = (size_t)(Epi::PERM ? 8 : HALF) * rowbytes;
    const unsigned ldsw = (unsigned)wid * 1024u;
    const int aoff = lds_byte(wr * 64 + fr, fq * 8);
    const int boff = lds_byte(wc * 32 + fr, fq * 8);
#define PG8_SA(b, h) (((b) * 2 + (h)) * HTB)
#define PG8_SB(b, h) ((4 + (b) * 2 + (h)) * HTB)
#define PG8_STAGE(bufoff, gbase, voff) do { _Pragma("unroll") for (int _i = 0; _i < 2; ++_i) \
        __builtin_amdgcn_global_load_lds((const unsigned*)((const char*)(gbase) + (voff)[_i]), (LAS unsigned*)(lds + (bufoff) + ldsw + _i * 8192), 16, 0, 0); } while (0)
#define PG8_STAGEA(bufoff, uptr, koff, NEXT, h) do { if constexpr (GATHER) { if (NEXT) { const u32x2 _t = *(const LAS u32x2*)(vnslot + 2 * (h)); unsigned _v[2] = {_t.x, _t.y}; PG8_STAGE(bufoff, Abase + (koff), _v); } else { PG8_STAGE(bufoff, Abase + (koff), vc[h]); } } \
        else { PG8_STAGE(bufoff, (uptr) + (size_t)(h) * hstep + (koff), voffA); } } while (0)
#define PG8_LDA(dst, b, h) do { _Pragma("unroll") for (int m = 0; m < 4; ++m) { if constexpr (ESZ == 2) { _Pragma("unroll") for (int k = 0; k < 2; ++k) dst[m].q[k] = *(const LAS bf16x8*)(lds + PG8_SA(b, h) + aoff + m * 2048 + k * 1024); } \
        else dst[m].w = cat8(*(const LAS bf16x8*)(lds + PG8_SA(b, h) + aoff + m * 2048), *(const LAS bf16x8*)(lds + PG8_SA(b, h) + aoff + m * 2048 + 1024)); } } while (0)
#define PG8_LDB(dst, b, h) do { _Pragma("unroll") for (int n = 0; n < 2; ++n) { if constexpr (ESZ == 2) { _Pragma("unroll") for (int k = 0; k < 2; ++k) dst[n].q[k] = *(const LAS bf16x8*)(lds + PG8_SB(b, h) + boff + n * 2048 + k * 1024); } \
        else dst[n].w = cat8(*(const LAS bf16x8*)(lds + PG8_SB(b, h) + boff + n * 2048), *(const LAS bf16x8*)(lds + PG8_SB(b, h) + boff + n * 2048 + 1024)); } } while (0)
#define PG8_MMA(ai, bj, At, Bt) do { __builtin_amdgcn_s_setprio(1); _Pragma("unroll") for (int m = 0; m < 4; ++m) _Pragma("unroll") for (int n = 0; n < 2; ++n) { \
        if constexpr (ESZ == 2) { _Pragma("unroll") for (int k = 0; k < 2; ++k) acc[ai][bj][m][n] = __builtin_amdgcn_mfma_f32_16x16x32_bf16(Bt[n].q[k], At[m].q[k], acc[ai][bj][m][n], 0, 0, 0); } \
        else { asm volatile("v_mfma_f32_16x16x128_f8f6f4 %0, %1, %2, %0" : "+v"(acc[ai][bj][m][n]) : "v"(Bt[n].w), "v"(At[m].w)); } } \
        __builtin_amdgcn_s_setprio(0); } while (0)
#define PG8_WAIT_V(n) asm volatile("s_waitcnt vmcnt(" #n ")" ::: "memory")
#define PG8_WAIT_L(n) asm volatile("s_waitcnt lgkmcnt(" #n ")" ::: "memory")
#define PG8_BAR __builtin_amdgcn_s_barrier()
#define PG8_SCHED __builtin_amdgcn_sched_barrier(0)
    Unit cur, nxt; int ui = 0; bool fresh_cur = true;
    if (!S.next(0, cur)) return;
    f32x4 acc[2][2][4][2];
    union Frag { bf16x8 q[2]; i32x8 w; };
    Frag At[4], B0[2], B1[2];
    unsigned vc[2][2];
    LAS unsigned* vnslot = (LAS unsigned*)(lds + (VN_OFF - 0)) + tid * 4;
    if constexpr (GATHER) S.avoff(cur, Rr, Cc, vc, tid);
    LAS unsigned* rowtab = (LAS unsigned*)(lds + ROWTAB_OFF);
    if constexpr (GATHER) S.rowtab(cur, rowtab, tid);
    const char* cB = cur.B; const char* cA = Abase + S.aoff(cur);
    PG8_STAGE(PG8_SB(0, 0), cB, voffB); PG8_STAGE(PG8_SB(0, 1), cB + bhstep, voffB); PG8_STAGEA(PG8_SA(0, 0), cA, 0, false, 0); PG8_STAGEA(PG8_SA(0, 1), cA, 0, false, 1);
    if (wr == 1) PG8_BAR;
    PG8_WAIT_V(2); PG8_BAR;
    PG8_STAGE(PG8_SB(1, 0), cB + kstep, voffB); PG8_STAGEA(PG8_SA(1, 0), cA, kstep, false, 0); PG8_STAGE(PG8_SB(1, 1), cB + bhstep + kstep, voffB);
    PG8_WAIT_V(6); PG8_BAR;
    asm volatile("" ::: "memory");
#pragma unroll
    for (int a = 0; a < 2; ++a)
#pragma unroll
        for (int b = 0; b < 2; ++b)
#pragma unroll
            for (int m = 0; m < 4; ++m)
#pragma unroll
                for (int n = 0; n < 2; ++n) { acc[a][b][m][n] = (f32x4){0.f, 0.f, 0.f, 0.f}; asm volatile("" : "+v"(acc[a][b][m][n])); }
    asm volatile("s_nop 4" ::: "memory");
    for (;;) {
        const bool has_next = S.next(ui + 1, nxt);
        if constexpr (GATHER) {
            unsigned vn[2][2];
            if (has_next) S.avoff(nxt, Rr, Cc, vn, tid);
            else {
#pragma unroll
                for (int h = 0; h < 2; ++h)
#pragma unroll
                    for (int i = 0; i < 2; ++i) vn[h][i] = vc[h][i];
            }
            *(LAS u32x4*)vnslot = (u32x4){vn[0][0], vn[0][1], vn[1][0], vn[1][1]};
            if (has_next) S.rowtab(nxt, rowtab + 512 * ((ui + 1) % 3), tid);
        }
        const char* nB = has_next ? nxt.B : cB; const char* nA = has_next ? Abase + S.aoff(nxt) : cA;
        const bool fresh_nxt = !(AREUSE && has_next && nxt.e == cur.e && nxt.pm == cur.pm);
        const bool ff = fresh_cur && fresh_nxt;
#define PG8_WAITX do { if (!AREUSE || ff) PG8_WAIT_V(8); else PG8_WAIT_V(4); } while (0)
        for (int t = 0; t < nt; t += 2) {
            const bool last = (t == nt - 2);
            const size_t k1 = (size_t)(t + 1) * kstep;
            const size_t k2 = last ? (size_t)0 : (size_t)(t + 2) * kstep, k3 = k2 + kstep;
            const char* u2 = last ? nA : cA; const char* b2 = last ? nB : cB + (size_t)(t + 2) * kstep;
            const char* b3 = b2 + kstep;
            PG8_LDB(B0, 0, 0); PG8_LDB(B1, 0, 1); PG8_SCHED; PG8_LDA(At, 0, 0); if (!AREUSE || fresh_cur) PG8_STAGEA(PG8_SA(1, 1), cA, k1, false, 1);
            PG8_WAITX; PG8_WAIT_L(0); PG8_BAR; PG8_MMA(0, 0, At, B0); PG8_MMA(0, 1, At, B1); PG8_BAR; PG8_SCHED;
            PG8_LDA(At, 0, 1); PG8_STAGE(PG8_SB(0, 0), b2, voffB); PG8_STAGE(PG8_SB(0, 1), b2 + bhstep, voffB); if (!AREUSE || fresh_nxt) PG8_STAGEA(PG8_SA(0, 0), u2, k2, last, 0);
            PG8_WAITX; PG8_WAIT_L(0); PG8_BAR; PG8_MMA(1, 0, At, B0); PG8_MMA(1, 1, At, B1); PG8_BAR; PG8_SCHED;
            PG8_LDB(B0, 1, 0); PG8_LDB(B1, 1, 1); PG8_SCHED; PG8_LDA(At, 1, 0); if (!AREUSE || fresh_nxt) PG8_STAGEA(PG8_SA(0, 1), u2, k2, last, 1);
            PG8_WAITX; PG8_WAIT_L(0); PG8_BAR; PG8_MMA(0, 0, At, B0); PG8_MMA(0, 1, At, B1); PG8_BAR; PG8_SCHED;
            PG8_LDA(At, 1, 1); PG8_STAGE(PG8_SB(1, 0), b3, voffB); PG8_STAGE(PG8_SB(1, 1), b3 + bhstep, voffB); if (!AREUSE || fresh_nxt) PG8_STAGEA(PG8_SA(1, 0), u2, k3, last, 0);
            PG8_WAITX; PG8_WAIT_L(0); PG8_BAR; PG8_MMA(1, 0, At, B0); PG8_MMA(1, 1, At, B1); PG8_BAR; PG8_SCHED;
        }
#undef PG8_WAITX
        if (wr == 0) PG8_BAR;
        if constexpr (ESZ == 1) {
            asm volatile("s_nop 15\n\ts_nop 15" ::: "memory");
#pragma unroll
            for (int a = 0; a < 2; ++a)
#pragma unroll
                for (int b = 0; b < 2; ++b)
#pragma unroll
                    for (int m = 0; m < 4; ++m) asm volatile("" : "+v"(acc[a][b][m][0]), "+v"(acc[a][b][m][1]));
        }
        { const int l2 = lane_id(); E(acc, cur, wr, wc, l2 & 15, l2 >> 4, rowtab + 512 * (ui % 3)); }
        if (!has_next) break;
#pragma unroll
        for (int a = 0; a < 2; ++a)
#pragma unroll
            for (int b = 0; b < 2; ++b)
#pragma unroll
                for (int m = 0; m < 4; ++m)
#pragma unroll
                    for (int n = 0; n < 2; ++n) acc[a][b][m][n] = (f32x4){0.f, 0.f, 0.f, 0.f};
        cur = nxt; cB = nB; cA = nA; ++ui; fresh_cur = fresh_nxt;
        if constexpr (GATHER) { const u32x4 _t = *(const LAS u32x4*)vnslot; vc[0][0] = _t.x; vc[0][1] = _t.y; vc[1][0] = _t.z; vc[1][1] = _t.w; }
        if (wr == 1) PG8_BAR;
    }
    PG8_WAIT_V(0);
    PG8_BAR;
#undef PG8_SA
#undef PG8_SB
#undef PG8_STAGE
#undef PG8_STAGEA
#undef PG8_LDA
#undef PG8_LDB
#undef PG8_MMA
#undef PG8_WAIT_V
#undef PG8_WAIT_L
#undef PG8_BAR
#undef PG8_SCHED
}

struct DenseOrder {
    int nM, nN, nwg, G, c, K; const char* Bt;
    __device__ __forceinline__ void init(int Mrows, int N, int K_, const void* Bt_, int G_, int c_) { nM = Mrows / BM; nN = N / BM; nwg = nM * nN; G = G_; c = c_; K = K_; Bt = (const char*)Bt_; }
    __device__ __forceinline__ bool next(int i, Unit& u) const {
        const long L = (long)i * G + c; if (L >= nwg) return false;
        int wgid = (int)L; { const int q = nwg / 8, r = nwg % 8, xcd = wgid % 8, off = wgid / 8; wgid = (xcd < r ? xcd * (q + 1) : r * (q + 1) + (xcd - r) * q) + off; }
        const int nig = 8 * nN, gid = wgid / nig, fm = gid * 8, gsz = (nM - fm) < 8 ? (nM - fm) : 8;
        u.pm = fm + ((wgid % nig) % gsz); u.pn = (wgid % nig) / gsz; u.B = Bt + (size_t)u.pn * BM * K * 2; u.e = 0; u.cnt = 0; u.off = 0; return true;
    }
    static constexpr bool GATHER = false;
    __device__ __forceinline__ size_t aoff(const Unit& u) const { return (size_t)u.pm * BM * K * 2; }
    __device__ __forceinline__ void avoff(const Unit&, const int (&)[2], const int (&)[2], unsigned (&)[2][2], int) const {}
};
struct RowOrder {
    int pm, ncol, K; const char* Bt;
    static constexpr bool GATHER = false;
    __device__ __forceinline__ bool next(int i, Unit& u) const { if (i >= ncol) return false; u.pm = pm; u.pn = i; u.B = Bt + (size_t)i * BM * K * 2; u.e = 0; u.cnt = 0; u.off = 0; return true; }
    __device__ __forceinline__ size_t aoff(const Unit& u) const { return (size_t)u.pm * BM * K * 2; }
    __device__ __forceinline__ void avoff(const Unit&, const int (&)[2], const int (&)[2], unsigned (&)[2][2], int) const {}
};
template <int NCOL, bool TOKROWS, bool TILEMAJOR = false> struct ExpertOrder {
    static constexpr bool GATHER = true;
    __device__ __forceinline__ size_t aoff(const Unit&) const { return 0; }
    const LAS unsigned* tab; int per, c, K  ; const char* W; size_t wstride; const int* slot_ent; const float* slot_w;
    mutable int ehint = 0;
    int xbase, xend, xstride, xlb;
    __device__ __forceinline__ void init(const LAS unsigned* tab_, int K_, const void* W_, size_t wstride_, const int* slot_ent_, const float* slot_w_, int G, int c_) {
        tab = tab_; K = K_; W = (const char*)W_; wstride = wstride_; slot_ent = slot_ent_; slot_w = slot_w_; c = c_;
        const int U = (int)tab[T_TILE + NE] * (TILEMAJOR ? 1 : NCOL); per = (U + G - 1) / G;
        if (G % 8 == 0) { const int x = c_ % 8; const int q = U / 8, r = U % 8; xbase = x * q + (x < r ? x : r); xend = xbase + q + (x < r ? 1 : 0); xstride = G / 8; xlb = c_ / 8; }
        else { xbase = 0; xend = U; xstride = G; xlb = c_; }
    }
    __device__ __forceinline__ bool next(int i, Unit& u) const {
        const int L = TILEMAJOR ? xbase + (i / NCOL) * xstride + xlb : xbase + i * xstride + xlb;
        if (L >= xend) return false;
        const int tile = TILEMAJOR ? L : L / NCOL; u.pn = TILEMAJOR ? i % NCOL : L % NCOL;
        int lo = ehint;
        if (i == 0) { lo = 0; int hi = NE - 1; while (lo < hi) { const int mid = (lo + hi + 1) >> 1; if ((int)tab[T_TILE + mid] <= tile) lo = mid; else hi = mid - 1; } }
        else { while (lo < NE - 1 && (int)tab[T_TILE + lo + 1] <= tile) ++lo; }
        ehint = lo;
        u.e = lo; u.pm = tile - (int)tab[T_TILE + lo]; u.cnt = (int)tab[T_CNT + lo]; u.off = (int)tab[T_OFF + lo];
        u.B = W + (size_t)lo * wstride + (size_t)u.pn * BM * K; return true;
    }
    __device__ __forceinline__ void rowtab(const Unit& u, LAS unsigned* t, int tid) const {
        if (tid < BM) { int r = u.pm * BM + tid; if (r >= u.cnt) r = u.cnt - 1; t[tid] = (unsigned)slot_ent[u.off + r]; t[BM + tid] = __float_as_uint(slot_w[u.off + r]); }
    }
    __device__ __forceinline__ void avoff(const Unit& u, const int (&)[2], const int (&)[2], unsigned (&v)[2][2], int tidq) const {
        int R[2], C[2]; asm volatile("" : "+v"(tidq));
#pragma unroll
        for (int i = 0; i < 2; ++i) stage_rc(tidq * 16 + i * 8192, R[i], C[i]);
#pragma unroll
        for (int h = 0; h < 2; ++h)
#pragma unroll
            for (int i = 0; i < 2; ++i) {
                int r = u.pm * BM + h * HALF + R[i]; if (r >= u.cnt) r = u.cnt - 1;
                const int slot = u.off + r;
                const int row = TOKROWS ? (slot_ent[slot] >> 3) : slot;
                v[h][i] = (unsigned)(row * K + C[i] * 2);
            }
    }
};

struct EpiInProj {
    static constexpr bool PERM = true; bf16_t* O;
    __device__ __forceinline__ void operator()(const f32x4 (&acc)[2][2][4][2], const Unit& u, int wr, int wc, int fr, int fq, const LAS unsigned* rt) const {
        const float sc = INV_IN8 * ((u.pn < 2) ? 0.125f : ((u.pn == 8 || u.pn == 9) ? 0.08838834764831845f : 1.f));
        const int row0 = u.pm * BM + wr * 64 + fr, col0 = u.pn * BM + wc * 64 + 16 * fq;
#pragma unroll
        for (int ai = 0; ai < 2; ++ai)
#pragma unroll
            for (int m = 0; m < 4; ++m) { bf16_t* rowp = O + (size_t)(row0 + ai * HALF + m * 16) * DIN + col0;
#pragma unroll
                for (int bj = 0; bj < 2; ++bj) { const f32x4 v0 = acc[ai][bj][m][0] * sc, v1 = acc[ai][bj][m][1] * sc;
                    u32x4 w; w.x = cvt_pk_bf16(v0[0], v0[1]); w.y = cvt_pk_bf16(v0[2], v0[3]); w.z = cvt_pk_bf16(v1[0], v1[1]); w.w = cvt_pk_bf16(v1[2], v1[3]);
                    *(u32x4*)(rowp + 8 * bj) = w; } }
    }
};
struct EpiOutProj {
    static constexpr bool PERM = true; const float* x; const float* mod; bf16_t* tb;
    __device__ __forceinline__ void operator()(const f32x4 (&acc)[2][2][4][2], const Unit& u, int wr, int wc, int fr, int fq, const LAS unsigned* rt) const {
        const int b = (u.pm * BM) >> 11; const int col0 = u.pn * BM + wc * 64 + 16 * fq;
        f32x4 g[2][2];
#pragma unroll
        for (int bj = 0; bj < 2; ++bj)
#pragma unroll
            for (int n = 0; n < 2; ++n) g[bj][n] = *(const f32x4*)(mod + b * 6144 + MOD_GATE_A + col0 + 8 * bj + 4 * n) * INV_IN8;
#pragma unroll
        for (int ai = 0; ai < 2; ++ai)
#pragma unroll
            for (int m = 0; m < 4; ++m) { const size_t o = (size_t)(u.pm * BM + ai * HALF + wr * 64 + m * 16 + fr) * D + col0;
#pragma unroll
                for (int bj = 0; bj < 2; ++bj) {
                    const f32x4 t0 = *(const f32x4*)(x + o + 8 * bj) * ALPHA + g[bj][0] * acc[ai][bj][m][0], t1 = *(const f32x4*)(x + o + 8 * bj + 4) * ALPHA + g[bj][1] * acc[ai][bj][m][1];
                    u32x4 w; w.x = cvt_pk_bf16(t0[0], t0[1]); w.y = cvt_pk_bf16(t0[2], t0[3]); w.z = cvt_pk_bf16(t1[0], t1[1]); w.w = cvt_pk_bf16(t1[2], t1[3]);
                    *(u32x4*)(tb + o + 8 * bj) = w; } }
    }
};
struct EpiRouter {
    static constexpr bool PERM = false; float* out;
    __device__ __forceinline__ void operator()(const f32x4 (&acc)[2][2][4][2], const Unit& u, int wr, int wc, int fr, int fq, const LAS unsigned* rt) const {
        const int col0 = wc * 32 + 4 * fq;
#pragma unroll
        for (int ai = 0; ai < 2; ++ai)
#pragma unroll
            for (int m = 0; m < 4; ++m) { float* rowp = out + (size_t)(u.pm * BM + ai * HALF + wr * 64 + m * 16 + fr) * NE + col0;
#pragma unroll
                for (int bj = 0; bj < 2; ++bj)
#pragma unroll
                    for (int n = 0; n < 2; ++n) *(f32x4*)(rowp + bj * HALF + n * 16) = acc[ai][bj][m][n]; }
    }
};
template <bool EXPERT, bool F8IN = EXPERT> struct EpiGU {
    static constexpr bool PERM = true; void* Ov;
    __device__ __forceinline__ void operator()(const f32x4 (&acc)[2][2][4][2], const Unit& u, int wr, int wc, int fr, int fq, const LAS unsigned* rt) const {
        const int h0 = u.pn * HALF + wc * 32 + 8 * fq;
#pragma unroll
        for (int ai = 0; ai < 2; ++ai)
#pragma unroll
            for (int m = 0; m < 4; ++m) {
                const int rtw = u.pm * BM + ai * HALF + wr * 64 + m * 16 + fr;
                if (EXPERT) { if (rtw >= u.cnt) continue; }
                const float w = EXPERT ? __uint_as_float(rt[BM + ai * HALF + wr * 64 + m * 16 + fr]) * (S_ACT8 * INV_GU8) : (F8IN ? INV_GU8 : 1.f);
                const float gs = F8IN ? INV_GU8 : 1.f;
                const f32x4 g0 = acc[ai][0][m][0] * gs, g1 = acc[ai][0][m][1] * gs, u0 = acc[ai][1][m][0], u1 = acc[ai][1][m][1];
                const float h[8] = {w * silu_f(g0[0]) * u0[0], w * silu_f(g0[1]) * u0[1], w * silu_f(g0[2]) * u0[2], w * silu_f(g0[3]) * u0[3],
                                    w * silu_f(g1[0]) * u1[0], w * silu_f(g1[1]) * u1[1], w * silu_f(g1[2]) * u1[2], w * silu_f(g1[3]) * u1[3]};
                if (EXPERT) {
                    int w0 = __builtin_amdgcn_cvt_pk_fp8_f32(clamp8(h[0]), clamp8(h[1]), 0, false); w0 = __builtin_amdgcn_cvt_pk_fp8_f32(clamp8(h[2]), clamp8(h[3]), w0, true);
                    int w1 = __builtin_amdgcn_cvt_pk_fp8_f32(clamp8(h[4]), clamp8(h[5]), 0, false); w1 = __builtin_amdgcn_cvt_pk_fp8_f32(clamp8(h[6]), clamp8(h[7]), w1, true);
                    u32x2 o; o.x = (unsigned)w0; o.y = (unsigned)w1; *(u32x2*)((unsigned char*)Ov + (size_t)(u.off + rtw) * DE + h0) = o;
                    asm volatile("" ::: "memory");
                } else {
                    u32x4 o; o.x = cvt_pk_bf16(h[0], h[1]); o.y = cvt_pk_bf16(h[2], h[3]); o.z = cvt_pk_bf16(h[4], h[5]); o.w = cvt_pk_bf16(h[6], h[7]);
                    *(u32x4*)((bf16_t*)Ov + (size_t)rtw * DE + h0) = o;
                }
            }
    }
};
struct EpiSharedDown {
    static constexpr bool PERM = true; unsigned char* ysh;
    __device__ __forceinline__ void operator()(const f32x4 (&acc)[2][2][4][2], const Unit& u, int wr, int wc, int fr, int fq, const LAS unsigned* rt) const {
        const int col0 = u.pn * BM + wc * 64 + 16 * fq;
#pragma unroll
        for (int ai = 0; ai < 2; ++ai)
#pragma unroll
            for (int m = 0; m < 4; ++m) {
                u32x4 o;
#pragma unroll
                for (int bj = 0; bj < 2; ++bj) { const f32x4 v0 = acc[ai][bj][m][0] * YSCALE, v1 = acc[ai][bj][m][1] * YSCALE;
                    int w0 = __builtin_amdgcn_cvt_pk_fp8_f32(clamp8(v0[0]), clamp8(v0[1]), 0, false); w0 = __builtin_amdgcn_cvt_pk_fp8_f32(clamp8(v0[2]), clamp8(v0[3]), w0, true);
                    int w1 = __builtin_amdgcn_cvt_pk_fp8_f32(clamp8(v1[0]), clamp8(v1[1]), 0, false); w1 = __builtin_amdgcn_cvt_pk_fp8_f32(clamp8(v1[2]), clamp8(v1[3]), w1, true);
                    if (bj == 0) { o.x = (unsigned)w0; o.y = (unsigned)w1; } else { o.z = (unsigned)w0; o.w = (unsigned)w1; } }
                *(u32x4*)(ysh + (size_t)(u.pm * BM + ai * HALF + wr * 64 + m * 16 + fr) * D + col0) = o;
            }
    }
};
struct EpiExpDown {
    static constexpr bool PERM = true; unsigned char* ybuf; const int* slot_ent;
    __device__ __forceinline__ void operator()(const f32x4 (&acc)[2][2][4][2], const Unit& u, int wr, int wc, int fr, int fq, const LAS unsigned* rt) const {
        const int col0 = u.pn * BM + wc * 64 + 16 * fq;
#pragma unroll
        for (int ai = 0; ai < 2; ++ai)
#pragma unroll
            for (int m = 0; m < 4; ++m) {
                const int rtw = u.pm * BM + ai * HALF + wr * 64 + m * 16 + fr; if (rtw >= u.cnt) continue;
                u32x4 o;
#pragma unroll
                for (int bj = 0; bj < 2; ++bj) { const f32x4 v0 = acc[ai][bj][m][0] * (YSCALE * INV_DN8), v1 = acc[ai][bj][m][1] * (YSCALE * INV_DN8);
                    int w0 = __builtin_amdgcn_cvt_pk_fp8_f32(clamp8(v0[0]), clamp8(v0[1]), 0, false); w0 = __builtin_amdgcn_cvt_pk_fp8_f32(clamp8(v0[2]), clamp8(v0[3]), w0, true);
                    int w1 = __builtin_amdgcn_cvt_pk_fp8_f32(clamp8(v1[0]), clamp8(v1[1]), 0, false); w1 = __builtin_amdgcn_cvt_pk_fp8_f32(clamp8(v1[2]), clamp8(v1[3]), w1, true);
                    if (bj == 0) { o.x = (unsigned)w0; o.y = (unsigned)w1; } else { o.z = (unsigned)w0; o.w = (unsigned)w1; } }
                *(u32x4*)(ybuf + (size_t)rt[ai * HALF + wr * 64 + m * 16 + fr] * D + col0) = o;
                asm volatile("" ::: "memory");
            }
    }
};

template <int PMODE = 0, class Sched> __device__ __forceinline__ void down_phase(LAS unsigned char* lds, const char* act8, const Sched& S, unsigned char* ybuf, const int tid_in) {
    int tid_ = tid_in; asm volatile("" : "+v"(tid_));
    const int tid = tid_, wid = __builtin_amdgcn_readfirstlane(tid >> 6), lane = tid & 63, wr = wid >> 2, wc = wid & 3, fr = lane & 15, fq = lane >> 4;
    constexpr int RB = DE;
    int Rr[2]; unsigned voffB[2], cc2[2];
#pragma unroll
    for (int i = 0; i < 2; ++i) { int R, C; stage_rc(tid * 16 + i * 8192, R, C); Rr[i] = R; cc2[i] = (unsigned)(C * 2); const int Rb = (R & ~31) + perm32(R & 31); voffB[i] = (unsigned)(Rb * RB + C * 2); }
    const unsigned ldsw = (unsigned)wid * 1024u;
    const int aoff = lds_byte(wr * 64 + fr, fq * 8), boff = lds_byte(wc * 32 + fr, fq * 8);
#define DN_SA(k, h) (((k) * 2 + (h)) * HTB)
#define DN_SB(z, k) (65536 + ((z) * 2 + (k)) * HTB)
#define DN_STAGE(bufoff, gbase, voff) do { _Pragma("unroll") for (int _i = 0; _i < 2; ++_i) \
        __builtin_amdgcn_global_load_lds((const unsigned*)((const char*)(gbase) + (voff)[_i]), (LAS unsigned*)(lds + (bufoff) + ldsw + _i * 8192), 16, 0, 0); } while (0)
    LAS unsigned* rowtab = (LAS unsigned*)(lds + ROWTAB_OFF);
    Unit cur, nxt; int ti = 0;
    if (!S.next(0, cur)) return;
#define DN_STAGE_A(u) do { unsigned _va[2][2]; _Pragma("unroll") for (int _h = 0; _h < 2; ++_h) _Pragma("unroll") for (int _i = 0; _i < 2; ++_i) { int _r = (u).pm * BM + _h * HALF + Rr[_i]; if (_r >= (u).cnt) _r = (u).cnt - 1; _va[_h][_i] = (unsigned)(((u).off + _r) * RB) + cc2[_i]; } \
        _Pragma("unroll") for (int _k = 0; _k < 2; ++_k) _Pragma("unroll") for (int _h = 0; _h < 2; ++_h) DN_STAGE(DN_SA(_k, _h), act8 + _k * 128, _va[_h]); } while (0)
#define DN_STAGE_B(u, s_, z_) do { const char* _b = (u).B + (size_t)(s_) * (HALF * RB); _Pragma("unroll") for (int _k = 0; _k < 2; ++_k) DN_STAGE(DN_SB(z_, _k), _b + _k * 128, voffB); } while (0)
#define DN_ROWTAB(u, par) do { if (tid < BM) { int _r = (u).pm * BM + tid; if (_r >= (u).cnt) _r = (u).cnt - 1; rowtab[(par) * BM + tid] = (PMODE == 1) ? (unsigned)((u).off + _r) : (unsigned)S.slot_ent[(u).off + _r]; } } while (0)
    DN_STAGE_A(cur); DN_ROWTAB(cur, 0); DN_STAGE_B(cur, 0, 0);
    f32x4 acc[2][2][4][2];
    union Frag { bf16x8 q[2]; i32x8 w; };
    int gs = 0;
    Unit prev = cur; int prev_s = -1, prev_par = 0;
#define DN_EPILOGUE(set, u, s_, par) do { const int _col0 = (s_) * HALF + wc * 32 + 8 * fq; \
        _Pragma("unroll") for (int _ai = 0; _ai < 2; ++_ai) _Pragma("unroll") for (int _m = 0; _m < 4; ++_m) { const int _rt = _ai * HALF + wr * 64 + _m * 16 + fr; \
            { const f32x4 _v0 = acc[set][_ai][_m][0] * (YSCALE * INV_DN8), _v1 = acc[set][_ai][_m][1] * (YSCALE * INV_DN8);   \
                int _w0 = __builtin_amdgcn_cvt_pk_fp8_f32(clamp8(_v0[0]), clamp8(_v0[1]), 0, false); _w0 = __builtin_amdgcn_cvt_pk_fp8_f32(clamp8(_v0[2]), clamp8(_v0[3]), _w0, true); \
                int _w1 = __builtin_amdgcn_cvt_pk_fp8_f32(clamp8(_v1[0]), clamp8(_v1[1]), 0, false); _w1 = __builtin_amdgcn_cvt_pk_fp8_f32(clamp8(_v1[2]), clamp8(_v1[3]), _w1, true); \
                u32x2 _o; _o.x = (unsigned)_w0; _o.y = (unsigned)_w1; if (PMODE != 2 || (_w0 == 0x12345678 && _w1 == 0x31415926)) *(u32x2*)(ybuf + (size_t)rowtab[(par) * BM + _rt] * D + _col0) = _o; } } } while (0)
    for (;;) {
        const bool has_next = S.next(ti + 1, nxt);
        const int par = ti & 1;
#pragma unroll 1
        for (int s2 = 0; s2 < 8; s2 += 2) {
#pragma unroll
            for (int sb = 0; sb < 2; ++sb) {
                const int s = s2 + sb; const int z = sb;
                if (s == 0) asm volatile("s_waitcnt vmcnt(0)" ::: "memory");
                else if (PMODE == 2) asm volatile("s_waitcnt vmcnt(0)" ::: "memory");
                else asm volatile("s_waitcnt vmcnt(8)" ::: "memory");
                __builtin_amdgcn_s_barrier();
                asm volatile("" ::: "memory");
                if (s < 7) DN_STAGE_B(cur, s + 1, z ^ 1); else if (has_next) DN_STAGE_B(nxt, 0, z ^ 1);
                if (wr == 1 && prev_s >= 0) { asm volatile("s_nop 15" ::: "memory"); DN_EPILOGUE(sb ^ 1, prev, prev_s, prev_par); }
#pragma unroll
                for (int ai = 0; ai < 2; ++ai)
#pragma unroll
                    for (int m = 0; m < 4; ++m)
#pragma unroll
                        for (int n = 0; n < 2; ++n) acc[sb][ai][m][n] = (f32x4){0.f, 0.f, 0.f, 0.f};
                asm volatile("s_nop 4" ::: "memory");
#pragma unroll
                for (int k = 0; k < 2; ++k) {
                    Frag Bf[2];
#pragma unroll
                    for (int n = 0; n < 2; ++n) Bf[n].w = cat8(*(const LAS bf16x8*)(lds + DN_SB(z, k) + boff + n * 2048), *(const LAS bf16x8*)(lds + DN_SB(z, k) + boff + n * 2048 + 1024));
#pragma unroll
                    for (int ai = 0; ai < 2; ++ai) {
                        Frag Af[4];
#pragma unroll
                        for (int m = 0; m < 4; ++m) Af[m].w = cat8(*(const LAS bf16x8*)(lds + DN_SA(k, ai) + aoff + m * 2048), *(const LAS bf16x8*)(lds + DN_SA(k, ai) + aoff + m * 2048 + 1024));
#pragma unroll
                        for (int m = 0; m < 4; ++m)
#pragma unroll
                            for (int n = 0; n < 2; ++n) asm volatile("v_mfma_f32_16x16x128_f8f6f4 %0, %1, %2, %0" : "+v"(acc[sb][ai][m][n]) : "v"(Bf[n].w), "v"(Af[m].w));
                    }
                }
                if (wr == 0 && prev_s >= 0) DN_EPILOGUE(sb ^ 1, prev, prev_s, prev_par);
                prev = cur; prev_s = s; prev_par = par;
            }
        }
        if (!has_next) break;
        asm volatile("s_waitcnt lgkmcnt(0)" ::: "memory");
        __builtin_amdgcn_s_barrier();
        DN_STAGE_A(nxt); DN_ROWTAB(nxt, par ^ 1);
        cur = nxt; ++ti;
    }
    asm volatile("s_nop 15\n\ts_nop 15" ::: "memory");
    DN_EPILOGUE(1, prev, prev_s, prev_par);
    asm volatile("s_waitcnt vmcnt(0) lgkmcnt(0)" ::: "memory");
    __builtin_amdgcn_s_barrier();
#undef DN_SA
#undef DN_SB
#undef DN_STAGE
#undef DN_STAGE_A
#undef DN_STAGE_B
#undef DN_ROWTAB
#undef DN_EPILOGUE
}
constexpr int T_P64 = T_HIST;
template <int PMODE = 0> __device__ __forceinline__ void down2_phase(LAS unsigned char* lds, LAS unsigned* tab, const char* act8, const char* wd, const int* slot_ent, unsigned char* ybuf, const int G, const int bx, const int tid_in) {
    int tid_ = tid_in; asm volatile("" : "+v"(tid_));
    const int tid = tid_, wid = __builtin_amdgcn_readfirstlane(tid >> 6), lane = tid & 63, wr = wid >> 2, wc = wid & 3, fr = lane & 15, fq = lane >> 4;
    constexpr int NS = 8, PD = 7, PB = 16384;
    if (tid < 64) {
        unsigned c[4], sp = 0;
#pragma unroll
        for (int j = 0; j < 4; ++j) { c[j] = (tab[T_CNT + lane * 4 + j] + 63u) >> 6; sp += c[j]; }
        unsigned ip = sp;
#pragma unroll
        for (int o = 1; o < 64; o <<= 1) { const unsigned a = __shfl_up(ip, o); if (lane >= o) ip += a; }
        unsigned ep = ip - sp;
#pragma unroll
        for (int j = 0; j < 4; ++j) { tab[T_P64 + lane * 4 + j] = ep; ep += c[j]; }
        if (lane == 63) tab[T_P64 + NE] = ep;
    }
    __syncthreads();
    int g, q; const int NG = G >> 2;
    if (G % 32 == 0) { const int x = bx % 8, i = bx / 8; g = x * (G / 32) + (i >> 2); q = i & 3; } else { g = bx >> 2; q = bx & 3; }
    const int NP = (int)tab[T_P64 + NE];
    const int p_lo = g < NG ? (int)((long long)g * NP / NG) : 0, p_hi = g < NG ? (int)((long long)(g + 1) * NP / NG) : 0;
    if (p_lo < p_hi) {
    int R0, C0; stage_rc(tid * 16, R0, C0);
    const unsigned ldsw = (unsigned)wid * 1024u;
    const int aoff = lds_byte(wr * 32 + fr, fq * 8);
    LAS unsigned* rowtab = (LAS unsigned*)(lds + VN_OFF);
    int e0 = 0; { int hi = NE - 1; while (e0 < hi) { const int mid = (e0 + hi + 1) >> 1; if ((int)tab[T_P64 + mid] <= p_lo) e0 = mid; else hi = mid - 1; } }
    int e2 = e0, nb2 = (int)tab[T_P64 + e0 + 1];
    int e = -1, nb = p_lo;
#define D2_STAGE(pp_, it_) do { const int _pp = (pp_) < p_hi ? (pp_) : p_hi - 1; \
        while (_pp >= nb2) { ++e2; nb2 = (int)tab[T_P64 + e2 + 1]; } \
        const int _off = (int)tab[T_OFF + e2], _cnt = (int)tab[T_CNT + e2], _r0 = (_pp - (int)tab[T_P64 + e2]) * 64; \
        int _r = _r0 + R0; if (_r >= _cnt) _r = _cnt - 1; int _rr = _r0 + lane; if (_rr >= _cnt) _rr = _cnt - 1; \
        const char* _a = act8 + (size_t)(unsigned)((_off + _r) * DE + C0 * 2); const unsigned _zb = (unsigned)((it_) & (NS - 1)) * PB; \
        __builtin_amdgcn_global_load_lds((const unsigned*)_a, (LAS unsigned*)(lds + _zb + ldsw), 16, 0, 0); \
        __builtin_amdgcn_global_load_lds((const unsigned*)(_a + 128), (LAS unsigned*)(lds + _zb + 8192 + ldsw), 16, 0, 0); \
        if (wid == 0) __builtin_amdgcn_global_load_lds((const unsigned*)(slot_ent + _off + _rr), rowtab + ((it_) & 15) * 64, 4, 0, 0); } while (0)
    union Frag { bf16x8 q2[2]; i32x8 w; };
    Frag Bf[2][4], Af[2][2][2];
    f32x4 acc[2][2][4];
#define D2_CVT(v_) ({ const f32x4 _v = (v_); const float _c0 = clamp8(_v[0]); int _w = __builtin_amdgcn_cvt_pk_fp8_f32(_c0, clamp8(_v[1]), __float_as_int(_c0), false); (unsigned)__builtin_amdgcn_cvt_pk_fp8_f32(clamp8(_v[2]), clamp8(_v[3]), _w, true); })
#define D2_OUT(dst_, o_) do { if (PMODE == 0 || ((o_).x == 0x12345678u && (o_).y == 0x31415926u && (dst_) < (unsigned)NSLOT)) *(u32x4*)(ybuf + (size_t)(dst_) * D + (q * 256 + wc * 64 + 16 * fq)) = (o_); } while (0)
#define D2_EPILOGUE(set, ip_) do { _Pragma("unroll") for (int _m = 0; _m < 2; ++_m) { \
            const unsigned _dst = rowtab[((ip_) & 15) * 64 + wr * 32 + _m * 16 + fr]; u32x4 _o; \
            _Pragma("unroll") for (int _n = 0; _n < 4; ++_n) _o[_n] = D2_CVT(acc[set][_m][_n]); \
            D2_OUT(_dst, _o); } } while (0)
#define D2_READA(par, it_) do { const unsigned _zb = (unsigned)((it_) & (NS - 1)) * PB; _Pragma("unroll") for (int _k = 0; _k < 2; ++_k) _Pragma("unroll") for (int _m = 0; _m < 2; ++_m) \
        Af[par][_k][_m].w = cat8(*(const LAS bf16x8*)(lds + _zb + _k * 8192 + aoff + _m * 2048), *(const LAS bf16x8*)(lds + _zb + _k * 8192 + aoff + _m * 2048 + 1024)); } while (0)
#define D2_MFMA0(sb, m, n) asm volatile("v_mfma_f32_16x16x128_f8f6f4 %0, %1, %2, 0" : "=&v"(acc[sb][m][n]) : "v"(Bf[0][n].w), "v"(Af[sb][0][m].w))
#define D2_MFMA1(sb, m, n) asm volatile("v_mfma_f32_16x16x128_f8f6f4 %0, %1, %2, %0" : "+v"(acc[sb][m][n]) : "v"(Bf[1][n].w), "v"(Af[sb][1][m].w))
#define D2_PAIR(MF, sb, m, n0, EPI, om, on, ov) do { MF(sb, m, n0); MF(sb, m, n0 + 1); if (EPI && PMODE < 5) (ov)[on] = D2_CVT(acc[(sb) ^ 1][om][on]); __builtin_amdgcn_sched_barrier(0); } while (0)
#define D2_PIECE(sb, i_, EPI) do { const int _i = (i_); \
        if (_i < PD - 1 || PMODE != 0) { if (wid == 0) asm volatile("s_waitcnt vmcnt(15)" ::: "memory"); else asm volatile("s_waitcnt vmcnt(10)" ::: "memory"); }     \
        else { if (wid == 0) asm volatile("s_waitcnt vmcnt(25)" ::: "memory"); else asm volatile("s_waitcnt vmcnt(20)" ::: "memory"); }                                    \
        if (PMODE != 5) __builtin_amdgcn_s_barrier();                      \
        asm volatile("" ::: "memory"); \
        if (PMODE != 3 && PMODE != 5 && PMODE != 6) D2_STAGE(p_lo + _i + PD, _i + PD);                 \
        if (p_lo + _i >= nb) {                                             \
            do { ++e; nb = (int)tab[T_P64 + e + 1]; } while (p_lo + _i >= nb); \
            const __attribute__((address_space(1))) char* wb = (const __attribute__((address_space(1))) char*)(wd + ((size_t)e * D + q * 256 + wc * 64 + 16 * (fr >> 2) + (fr & 3)) * DE + 16 * fq); \
            _Pragma("unroll") for (int _k = 0; _k < 2; ++_k) _Pragma("unroll") for (int _n = 0; _n < 4; ++_n) \
                Bf[_k][_n].w = cat8(*(const __attribute__((address_space(1))) bf16x8*)(wb + _n * 4 * DE + _k * 128), *(const __attribute__((address_space(1))) bf16x8*)(wb + _n * 4 * DE + _k * 128 + 64)); \
            _Pragma("unroll") for (int _k = 0; _k < 2; ++_k) _Pragma("unroll") for (int _n = 0; _n < 4; ++_n) asm volatile("" : "+v"(Bf[_k][_n].w));     \
        } \
        if (PMODE != 5) D2_READA((sb) ^ 1, _i + 1); \
        unsigned _d0 = 0, _d1 = 0; u32x4 _o0, _o1; \
        __builtin_amdgcn_sched_barrier(0); \
        D2_PAIR(D2_MFMA0, sb, 0, 0, EPI, 0, 0, _o0); D2_PAIR(D2_MFMA0, sb, 0, 2, EPI, 0, 1, _o0); \
        if (EPI && PMODE < 5) { _d0 = rowtab[((_i - 1) & 15) * 64 + wr * 32 + fr]; _d1 = rowtab[((_i - 1) & 15) * 64 + wr * 32 + 16 + fr]; }     \
        __builtin_amdgcn_sched_barrier(0); \
        D2_PAIR(D2_MFMA0, sb, 1, 0, EPI, 0, 2, _o0); D2_PAIR(D2_MFMA0, sb, 1, 2, EPI, 0, 3, _o0); \
        if (EPI && PMODE < 5) D2_OUT(_d0, _o0); \
        D2_PAIR(D2_MFMA1, sb, 0, 0, EPI, 1, 0, _o1); D2_PAIR(D2_MFMA1, sb, 0, 2, EPI, 1, 1, _o1); D2_PAIR(D2_MFMA1, sb, 1, 0, EPI, 1, 2, _o1); D2_PAIR(D2_MFMA1, sb, 1, 2, EPI, 1, 3, _o1); \
        if (EPI && PMODE < 5) D2_OUT(_d1, _o1); \
    } while (0)
#pragma unroll 1
    for (int j = 0; j < PD; ++j) D2_STAGE(p_lo + j, j);
    const int n_it = p_hi - p_lo;
    asm volatile("s_waitcnt vmcnt(12)" ::: "memory");
    __builtin_amdgcn_s_barrier();
    asm volatile("" ::: "memory");
    D2_READA(0, 0);
    D2_PIECE(0, 0, false);
#pragma unroll 1
    for (int i2 = 1; i2 < n_it; i2 += 2) {
        D2_PIECE(1, i2, true);
        if (i2 + 1 < n_it) D2_PIECE(0, i2 + 1, true);
    }
    asm volatile("s_nop 15\n\ts_nop 15" ::: "memory");
    if (n_it & 1) D2_EPILOGUE(0, n_it - 1); else D2_EPILOGUE(1, n_it - 1);
#undef D2_CVT
#undef D2_OUT
#undef D2_READA
#undef D2_MFMA0
#undef D2_MFMA1
#undef D2_PAIR
#undef D2_PIECE
#undef D2_STAGE
#undef D2_EPILOGUE
    }
    asm volatile("s_waitcnt vmcnt(0) lgkmcnt(0)" ::: "memory");
    __builtin_amdgcn_s_barrier();
}
struct EpiProbeSum {
    static constexpr bool PERM = true; float* o;
    __device__ __forceinline__ void operator()(const f32x4 (&acc)[2][2][4][2], const Unit& u, int wr, int wc, int fr, int fq, const LAS unsigned* rt) const {
        f32x4 s = (f32x4){0.f, 0.f, 0.f, 0.f};
#pragma unroll
        for (int a = 0; a < 2; ++a)
#pragma unroll
            for (int b = 0; b < 2; ++b)
#pragma unroll
                for (int m = 0; m < 4; ++m) s += acc[a][b][m][0] + acc[a][b][m][1];
        if (s.x == 123.456f) *(f32x4*)(o + (size_t)(blockIdx.x * 512 + wr * 256 + wc * 64 + fq * 16 + fr) * 4) = s;
    }
};
}

struct Ctx {
    const float *x, *c, *w_ada, *b_ada, *w_in, *w_out, *na_rpb, *ret_ld, *ret_gn, *ln1_g, *ln1_b, *ln2_g, *ln2_b, *w_router, *rbias, *w_gate, *w_up, *w_down, *ws_gate, *ws_up, *ws_down;
    float* out; unsigned char* ws;
};
constexpr int NW = 8;

__device__ __forceinline__ void transpose_item(const float* W, int K, int N, bf16_t* WT, int G, int which, LAS float* scr, int item, int lane) {
    const int nblk = N / 32, kb = item / nblk, nb = item % nblk, k0 = 64 * kb, n0 = 32 * nb;
    float v[32];
#pragma unroll
    for (int i = 0; i < 32; ++i) { const int kk = 2 * i + (lane >> 5); v[i] = __builtin_nontemporal_load(W + (size_t)(k0 + kk) * N + n0 + (lane & 31)); }
#pragma unroll
    for (int i = 0; i < 32; ++i) { const int kk = 2 * i + (lane >> 5); scr[kk * 33 + (lane & 31)] = v[i]; }
    LDS_WAIT(); asm volatile("" ::: "memory");
    const int c = lane & 7;
#pragma unroll
    for (int j = 0; j < 4; ++j) { const int n = (lane >> 3) + 8 * j; const LAS float* s = scr + (8 * c) * 33 + n;
        u32x4 o; o.x = pk2(s[0 * 33], s[1 * 33]); o.y = pk2(s[2 * 33], s[3 * 33]); o.z = pk2(s[4 * 33], s[5 * 33]); o.w = pk2(s[6 * 33], s[7 * 33]);
        const int ng = n0 + n; const int drow = (G == 0) ? ng : ((ng / G) * 2 * G + which * G + (ng % G));
        *(u32x4*)(WT + (size_t)drow * K + k0 + 8 * c) = o; }
    LDS_WAIT(); asm volatile("" ::: "memory");
}
__device__ __forceinline__ void transpose_item_fp8(const float* W, int K, int N, unsigned char* WT, int G, int which, float scale, LAS float* scr, int item, int lane) {
    const int nblk = N / 32, kb = item / nblk, nb = item % nblk, k0 = 64 * kb, n0 = 32 * nb;
    float v[32];
#pragma unroll
    for (int i = 0; i < 32; ++i) { const int kk = 2 * i + (lane >> 5); v[i] = __builtin_nontemporal_load(W + (size_t)(k0 + kk) * N + n0 + (lane & 31)); }
#pragma unroll
    for (int i = 0; i < 32; ++i) { const int kk = 2 * i + (lane >> 5); scr[kk * 33 + (lane & 31)] = v[i] * scale; }
    LDS_WAIT(); asm volatile("" ::: "memory");
    const int c = lane & 7;
#pragma unroll
    for (int j = 0; j < 4; ++j) { const int n = (lane >> 3) + 8 * j; const LAS float* sp = scr + (8 * c) * 33 + n;
        int w0 = __builtin_amdgcn_cvt_pk_fp8_f32(clamp8(sp[0 * 33]), clamp8(sp[1 * 33]), 0, false); w0 = __builtin_amdgcn_cvt_pk_fp8_f32(clamp8(sp[2 * 33]), clamp8(sp[3 * 33]), w0, true);
        int w1 = __builtin_amdgcn_cvt_pk_fp8_f32(clamp8(sp[4 * 33]), clamp8(sp[5 * 33]), 0, false); w1 = __builtin_amdgcn_cvt_pk_fp8_f32(clamp8(sp[6 * 33]), clamp8(sp[7 * 33]), w1, true);
        const int ng = n0 + n; const int drow = (G == 0) ? ng : ((ng / G) * 2 * G + which * G + (ng % G));
        u32x2 o; o.x = (unsigned)w0; o.y = (unsigned)w1; *(u32x2*)(WT + (size_t)drow * K + k0 + 8 * c) = o; }
    LDS_WAIT(); asm volatile("" ::: "memory");
}
__device__ __forceinline__ void rope_entry(float* tab, int idx) {
    const int t = idx >> 6, i = idx & 63;
    const float inv_freq = powf(10000.f, -(float)(2 * i) / 128.f);
    const float ang = (float)t * inv_freq;
    const double a = (double)ang; const double two_pi = 6.283185307179586476925286766559;
    const double kf = rint(a / two_pi); double r = a - kf * two_pi;
    double sgn = 1.0; if (r > 1.5707963267948966) { r = 3.141592653589793 - r; sgn = -1.0; } else if (r < -1.5707963267948966) { r = -3.141592653589793 - r; sgn = -1.0; }
    const double r2 = r * r;
    const double s = r * (1.0 + r2 * (-1.0 / 6 + r2 * (1.0 / 120 + r2 * (-1.0 / 5040 + r2 * (1.0 / 362880 + r2 * (-1.0 / 39916800 + r2 * (1.0 / 6227020800.0 + r2 * (-1.0 / 1307674368000.0))))))));
    const double c = 1.0 + r2 * (-0.5 + r2 * (1.0 / 24 + r2 * (-1.0 / 720 + r2 * (1.0 / 40320 + r2 * (-1.0 / 3628800 + r2 * (1.0 / 479001600.0 + r2 * (-1.0 / 87178291200.0 + r2 * (1.0 / 20922789888000.0))))))));
    tab[idx] = (float)(sgn * c); tab[SEQ * 64 + idx] = (float)s;
}
__device__ __forceinline__ void mod_task(const float* __restrict__ cin, const float* __restrict__ w_ada, float* __restrict__ modp, int task, int lane) {
    const int cbk = task % 96, kc = task / 96, j = cbk * 64 + lane, k0 = kc * 64;
    float acc[32], cv[32];
#pragma unroll
    for (int b = 0; b < 32; ++b) { acc[b] = 0.f; cv[b] = silu_f(cin[b * D + k0 + lane]); }
#pragma unroll
    for (int kb = 0; kb < 4; ++kb) {
        float w[16];
#pragma unroll
        for (int i = 0; i < 16; ++i) w[i] = w_ada[(size_t)(k0 + kb * 16 + i) * 6144 + j];
#pragma unroll
        for (int i = 0; i < 16; ++i)
#pragma unroll
            for (int b = 0; b < 32; ++b) acc[b] += __builtin_bit_cast(float, __builtin_amdgcn_readlane(__builtin_bit_cast(int, cv[b]), kb * 16 + i)) * w[i];
    }
#pragma unroll
    for (int b = 0; b < 32; ++b) modp[((size_t)kc * 32 + b) * 6144 + j] = acc[b];
}
__device__ __forceinline__ float mod_sum(const float* __restrict__ modp, const float* __restrict__ b_ada, int b, int j) {
    float s = 0.f;
#pragma unroll
    for (int kc = 0; kc < 16; ++kc) s += modp[((size_t)kc * 32 + b) * 6144 + j];
    return s + b_ada[j];
}

#ifndef RET_PROBE
#define RET_PROBE 0
#endif
namespace ret {
typedef short s16x4 __attribute__((ext_vector_type(4)));
typedef __bf16 bfx2 __attribute__((ext_vector_type(2)));
constexpr unsigned RS = 288, TILE = 128 * RS, LK = 0, LV = TILE, LRF = 2 * TILE, LRB = 3 * TILE;
constexpr float LOG2E = 1.4426950408889634f;
__device__ __forceinline__ unsigned offb(unsigned row, unsigned ch) { return RS * row + 16u * ch; }
__device__ __forceinline__ unsigned cvtpk(float lo, float hi) { const f32x2 v = {lo, hi}; return __builtin_bit_cast(unsigned, __builtin_convertvector(v, bfx2)); }
__device__ __forceinline__ bf16x8 pack8(const float (&f)[8]) { u32x4 u; u.x = cvtpk(f[0], f[1]); u.y = cvtpk(f[2], f[3]); u.z = cvtpk(f[4], f[5]); u.w = cvtpk(f[6], f[7]); return __builtin_bit_cast(bf16x8, u); }
__device__ __forceinline__ void unpack8(const bf16x8 v, float (&f)[8]) { const u32x4 u = __builtin_bit_cast(u32x4, v);
    f[0] = __uint_as_float(u.x << 16); f[1] = __uint_as_float(u.x & 0xffff0000u); f[2] = __uint_as_float(u.y << 16); f[3] = __uint_as_float(u.y & 0xffff0000u);
    f[4] = __uint_as_float(u.z << 16); f[5] = __uint_as_float(u.z & 0xffff0000u); f[6] = __uint_as_float(u.w << 16); f[7] = __uint_as_float(u.w & 0xffff0000u); }
__device__ __forceinline__ bf16x8 trfrag(LAS unsigned char* base, unsigned row0, unsigned row1, unsigned cblk, unsigned qp, unsigned p) {
    const unsigned ch = 2u * cblk + (p >> 1), bo = 8u * (p & 1u);
    const s16x4 lo = __builtin_amdgcn_ds_read_tr16_b64_v4i16((LAS s16x4*)(base + offb(row0 + qp, ch) + bo));
    const s16x4 hi = __builtin_amdgcn_ds_read_tr16_b64_v4i16((LAS s16x4*)(base + offb(row1 + qp, ch) + bo));
    return __builtin_shufflevector(lo, hi, 0, 1, 2, 3, 4, 5, 6, 7);
}
struct KVRaw { bf16x8 ka[2], kb[2], v[4]; f32x4 c0[2], c1[2], s0[2], s1[2]; };
__device__ __forceinline__ void kv_load(KVRaw& R, const bf16_t* __restrict__ proj, const float* __restrict__ rope, int b, int h, int n, int tid) {
#pragma unroll
    for (int i = 0; i < 2; ++i) {
        const int q2 = tid + 512 * i, row = q2 >> 3, pc = q2 & 7, t = n * 128 + row;
        const bf16_t* rp = proj + (size_t)(b * SEQ + t) * DIN + OFF_KR + h * 128;
        R.ka[i] = *(const bf16x8*)(rp + pc * 8); R.kb[i] = *(const bf16x8*)(rp + 64 + pc * 8);
        R.c0[i] = *(const f32x4*)(rope + t * 64 + pc * 8); R.c1[i] = *(const f32x4*)(rope + t * 64 + pc * 8 + 4);
        R.s0[i] = *(const f32x4*)(rope + SEQ * 64 + t * 64 + pc * 8); R.s1[i] = *(const f32x4*)(rope + SEQ * 64 + t * 64 + pc * 8 + 4);
    }
#pragma unroll
    for (int i = 0; i < 4; ++i) { const int q4 = tid + 512 * i, row = q4 >> 4, ch = q4 & 15, t = n * 128 + row;
        R.v[i] = *(const bf16x8*)(proj + (size_t)(b * SEQ + t) * DIN + OFF_VR + h * 128 + ch * 8); }
}
__device__ __forceinline__ void kv_store(LAS unsigned char* lds, const KVRaw& R, int tid) {
#pragma unroll
    for (int i = 0; i < 2; ++i) {
        const int q2 = tid + 512 * i, row = q2 >> 3, pc = q2 & 7;
        float fa[8], fb[8], o1[8], o2[8];
        unpack8(R.ka[i], fa); unpack8(R.kb[i], fb);
        const float cs[8] = {R.c0[i].x, R.c0[i].y, R.c0[i].z, R.c0[i].w, R.c1[i].x, R.c1[i].y, R.c1[i].z, R.c1[i].w}, sn[8] = {R.s0[i].x, R.s0[i].y, R.s0[i].z, R.s0[i].w, R.s1[i].x, R.s1[i].y, R.s1[i].z, R.s1[i].w};
#pragma unroll
        for (int e = 0; e < 8; ++e) { o1[e] = fa[e] * cs[e] - fb[e] * sn[e]; o2[e] = fb[e] * cs[e] + fa[e] * sn[e]; }
        *(LAS bf16x8*)(lds + LK + offb(row, pc)) = pack8(o1); *(LAS bf16x8*)(lds + LK + offb(row, pc + 8)) = pack8(o2);
    }
#pragma unroll
    for (int i = 0; i < 4; ++i) { const int q4 = tid + 512 * i, row = q4 >> 4, ch = q4 & 15; *(LAS bf16x8*)(lds + LV + offb(row, ch)) = R.v[i]; }
}
__device__ __forceinline__ void rb_dma(LAS unsigned char* lds, const unsigned char* img, int w, int lane) {
#pragma unroll
    for (int i = 0; i < 5; ++i) { const int o = w + 8 * i; if (o < (int)TILE / 1024)
        __builtin_amdgcn_global_load_lds((const unsigned*)(img + o * 1024 + lane * 16), (LAS unsigned*)(lds + LRB + o * 1024), 16, 0, 0); }
}
template <bool FWD> __device__ __forceinline__ void state_update_1(LAS unsigned char* lds, f32x4 (&racc)[8], float l2, int w, int g, unsigned qp, unsigned p);
template <bool FWD> __device__ __forceinline__ void state_update(LAS unsigned char* lds, f32x4 (&racc)[8], float l2, int w, int g, unsigned qp, unsigned p) {
    if (RET_PROBE == 2) {
        f32x4 r2[8];
#pragma unroll
        for (int i = 0; i < 8; ++i) r2[i] = racc[i];
        unsigned zo = 0; asm volatile("" : "+v"(zo));
        state_update_1<FWD>(lds + zo, r2, l2, w, g, qp, p);
        state_update_1<FWD>(lds, racc, l2, w, g, qp, p);
#pragma unroll
        for (int i = 0; i < 8; ++i) racc[i] = (racc[i] + r2[i]) * 0.5f;
    } else state_update_1<FWD>(lds, racc, l2, w, g, qp, p);
}
template <bool FWD> __device__ __forceinline__ void state_update_1(LAS unsigned char* lds, f32x4 (&racc)[8], float l2, int w, int g, unsigned qp, unsigned p) {
    const float dec = __builtin_amdgcn_exp2f(128.f * l2);
    bf16x8 vs[4];
#pragma unroll
    for (int ks = 0; ks < 4; ++ks) {
        float f[8]; unpack8(trfrag(lds + LV, 32 * ks + 4 * g, 32 * ks + 16 + 4 * g, w, qp, p), f);
#pragma unroll
        for (int e = 0; e < 8; ++e) { const int key = 32 * ks + 16 * (e >> 2) + 4 * g + (e & 3); f[e] *= __builtin_amdgcn_exp2f((FWD ? (float)(127 - key) : (float)key) * l2); }
        vs[ks] = pack8(f);
    }
#pragma unroll
    for (int nb = 0; nb < 8; ++nb) {
        racc[nb] = racc[nb] * dec;
#pragma unroll
        for (int ks = 0; ks < 4; ++ks) racc[nb] = __builtin_amdgcn_mfma_f32_16x16x32_bf16(vs[ks], trfrag(lds + LK, 32 * ks + 4 * g, 32 * ks + 16 + 4 * g, nb, qp, p), racc[nb], 0, 0, 0);
    }
}
__device__ __forceinline__ void unit(const bf16_t* __restrict__ proj, const float* __restrict__ rope, const float* __restrict__ log_decay, const float* __restrict__ gn_g, bf16_t* __restrict__ ymix,
                                     unsigned char* __restrict__ scratch  , LAS unsigned char* lds, int hu, const int tid_in) {
    const int u = hu >> 1, n0 = (hu & 1) * 8, n1 = n0 + 8;
    const int b = u >> 2, h = u & 3;
    int tid_ = tid_in; asm volatile("" : "+v"(tid_));
    const int tid0 = tid_, w = __builtin_amdgcn_readfirstlane(tid0 >> 6);
#define RET_LANE int tid = tid0; asm volatile("" : "+v"(tid)); const int lane = tid & 63, r = lane & 15, g = lane >> 4; const unsigned qp = (unsigned)r >> 2, p = (unsigned)lane & 3u;
    const float lf2_ = log_decay[h] * LOG2E, lb2_ = log_decay[4 + h] * LOG2E;
    f32x4 racc[8];
    KVRaw raw;
    for (int rep7 = 0; rep7 < (RET_PROBE == 7 ? 2 : 1); ++rep7) {
#pragma unroll
    for (int nb = 0; nb < 8; ++nb) racc[nb] = (f32x4){0.f, 0.f, 0.f, 0.f};
    kv_load(raw, proj, rope, b, h, 15, tid0);
    for (int n = 15; n >= n0; --n) {
        RET_LANE
        if (n < n1) {
            unsigned char* img = scratch + (size_t)(n - n0) * TILE;
#pragma unroll
            for (int nb = 0; nb < 8; ++nb) { u32x2 o; o.x = cvtpk(racc[nb][0], racc[nb][1]); o.y = cvtpk(racc[nb][2], racc[nb][3]);
                *(u32x2*)(img + offb(16 * nb + r, 2 * w + (g >> 1)) + 8 * (g & 1)) = o; }
        }
        if (n == n0) break;
        float lb2 = lb2_; asm volatile("" : "+v"(lb2));
        __syncthreads();
        kv_store(lds, raw, tid);
        __syncthreads();
        kv_load(raw, proj, rope, b, h, n - 1 > n0 ? n - 1 : 0, tid);
        state_update<false>(lds, racc, lb2, w, g, qp, p);
    }
    }
    asm volatile("s_waitcnt vmcnt(0)" ::: "memory");
    __syncthreads();
    __builtin_amdgcn_fence(__ATOMIC_ACQUIRE, "agent");
    asm volatile("s_waitcnt vmcnt(0)" ::: "memory");
    for (int rep8 = 0; rep8 < (RET_PROBE == 8 ? 2 : 1); ++rep8) {
    if (RET_PROBE == 8 && rep8 == 1) { __syncthreads(); kv_load(raw, proj, rope, b, h, 0, tid0); }
#pragma unroll
    for (int nb = 0; nb < 8; ++nb) racc[nb] = (f32x4){0.f, 0.f, 0.f, 0.f};
    for (int n = 0; n < n0; ++n) {
        RET_LANE
        float lf2 = lf2_; asm volatile("" : "+v"(lf2));
        __syncthreads();
        kv_store(lds, raw, tid);
        __syncthreads();
        kv_load(raw, proj, rope, b, h, n + 1, tid);
        state_update<true>(lds, racc, lf2, w, g, qp, p);
    }
    rb_dma(lds, scratch, w, tid0 & 63);
    for (int n = n0; n < n1; ++n) {
        RET_LANE
        float lf2 = lf2_, lb2 = lb2_; asm volatile("" : "+v"(lf2), "+v"(lb2));
        const __attribute__((address_space(1))) float* gnp = (const __attribute__((address_space(1))) float*)gn_g; asm volatile("" : "+s"(gnp));
        __syncthreads();
        kv_store(lds, raw, tid);
#pragma unroll
        for (int nb = 0; nb < 8; ++nb) { u32x2 o; o.x = cvtpk(racc[nb][0], racc[nb][1]); o.y = cvtpk(racc[nb][2], racc[nb][3]);
            *(LAS u32x2*)(lds + LRF + offb(16 * nb + r, 2 * w + (g >> 1)) + 8 * (g & 1)) = o; }
        const int cq = 16 * w + r, tq = n * 128 + cq;
        bf16x8 qn[4], qf[4], qb[4];
        { const bf16_t* rp = proj + (size_t)(b * SEQ + tq) * DIN + OFF_QR + h * 128 + 4 * g;
          const float sf = __builtin_amdgcn_exp2f((float)(cq + 1) * lf2), sb = __builtin_amdgcn_exp2f((float)(128 - cq) * lb2);
#pragma unroll
          for (int ks = 0; ks < 2; ++ks) {
              float fa[8], fb[8], o1[8], o2[8], t1[8], t2[8];
              { const u32x2 a0 = *(const u32x2*)(rp + 32 * ks), a1 = *(const u32x2*)(rp + 32 * ks + 16), b0 = *(const u32x2*)(rp + 32 * ks + 64), b1 = *(const u32x2*)(rp + 32 * ks + 80);
                unpack8(__builtin_bit_cast(bf16x8, (u32x4){a0.x, a0.y, a1.x, a1.y}), fa); unpack8(__builtin_bit_cast(bf16x8, (u32x4){b0.x, b0.y, b1.x, b1.y}), fb); }
              const float* cp = rope + tq * 64 + 32 * ks + 4 * g; const float* sp = cp + SEQ * 64;
              const f32x4 c0 = *(const f32x4*)cp, c1 = *(const f32x4*)(cp + 16), s0 = *(const f32x4*)sp, s1 = *(const f32x4*)(sp + 16);
              const float cs[8] = {c0.x, c0.y, c0.z, c0.w, c1.x, c1.y, c1.z, c1.w}, sn[8] = {s0.x, s0.y, s0.z, s0.w, s1.x, s1.y, s1.z, s1.w};
#pragma unroll
              for (int e = 0; e < 8; ++e) { o1[e] = fa[e] * cs[e] - fb[e] * sn[e]; o2[e] = fb[e] * cs[e] + fa[e] * sn[e]; }
              qn[ks] = pack8(o1); qn[ks + 2] = pack8(o2);
#pragma unroll
              for (int e = 0; e < 8; ++e) { t1[e] = o1[e] * sf; t2[e] = o2[e] * sf; }
              qf[ks] = pack8(t1); qf[ks + 2] = pack8(t2);
#pragma unroll
              for (int e = 0; e < 8; ++e) { t1[e] = o1[e] * sb; t2[e] = o2[e] * sb; }
              qb[ks] = pack8(t1); qb[ks + 2] = pack8(t2);
          } }
        asm volatile("s_waitcnt vmcnt(0)" ::: "memory");
        __syncthreads();
        kv_load(raw, proj, rope, b, h, n + 1 < n1 ? n + 1 : n, tid);
        u32x2 gv[8];
        { const bf16_t* gp = proj + (size_t)(b * SEQ + tq) * DIN + OFF_GR + h * 128 + 4 * g;
#pragma unroll
          for (int mbv = 0; mbv < 8; ++mbv) gv[mbv] = *(const u32x2*)(gp + 16 * mbv); }
        bf16x8 pt[4];
#pragma unroll
        for (int rep3 = 0; rep3 < (RET_PROBE == 3 ? 2 : 1); ++rep3) {
        unsigned zo3 = 0; if (RET_PROBE == 3) asm volatile("" : "+v"(zo3));
#pragma unroll
        for (int ks2 = 0; ks2 < 4; ++ks2) {
            float pv[8];
#pragma unroll
            for (int hb = 0; hb < 2; ++hb) {
                const int mb = 2 * ks2 + hb;
                f32x4 st = (f32x4){0.f, 0.f, 0.f, 0.f};
#pragma unroll
                for (int ks = 0; ks < 4; ++ks) { const LAS unsigned char* kp = lds + LK + zo3 + RS * (16 * mb + r) + 64 * ks + 8 * g; const u32x2 k0 = *(const LAS u32x2*)kp, k1 = *(const LAS u32x2*)(kp + 32);
                    st = __builtin_amdgcn_mfma_f32_16x16x32_bf16(__builtin_bit_cast(bf16x8, (u32x4){k0.x, k0.y, k1.x, k1.y}), qn[ks], st, 0, 0, 0); }
#pragma unroll
                for (int j = 0; j < 4; ++j) { const int diff = cq - (16 * mb + 4 * g + j); pv[4 * hb + j] = st[j] * __builtin_amdgcn_exp2f(diff >= 0 ? (float)diff * lf2 : (float)(-diff) * lb2); }
            }
            pt[ks2] = pack8(pv);
        }
        }
        f32x4 yacc[8];
#pragma unroll
        for (int mbv = 0; mbv < 8; ++mbv) {
            f32x4 y = (f32x4){0.f, 0.f, 0.f, 0.f};
#pragma unroll
            for (int rep = 0; rep < (RET_PROBE == 1 ? 2 : 1); ++rep) {
            unsigned zo = 0; if (RET_PROBE == 1) asm volatile("" : "+v"(zo));
#pragma unroll
            for (int ks2 = 0; ks2 < 4; ++ks2) y = __builtin_amdgcn_mfma_f32_16x16x32_bf16(trfrag(lds + LV + zo, 32 * ks2 + 4 * g, 32 * ks2 + 16 + 4 * g, mbv, qp, p), pt[ks2], y, 0, 0, 0);
#pragma unroll
            for (int ks = 0; ks < 4; ++ks) {
                y = __builtin_amdgcn_mfma_f32_16x16x32_bf16(trfrag(lds + LRF + zo, 32 * ks + 4 * g, 32 * ks + 16 + 4 * g, mbv, qp, p), qf[ks], y, 0, 0, 0);
                y = __builtin_amdgcn_mfma_f32_16x16x32_bf16(trfrag(lds + LRB + zo, 32 * ks + 4 * g, 32 * ks + 16 + 4 * g, mbv, qp, p), qb[ks], y, 0, 0, 0);
            }
            }
            yacc[mbv] = (RET_PROBE == 1) ? y * 0.5f : y;
        }
        __syncthreads();
        if (n + 1 < n1) rb_dma(lds, scratch + (size_t)(n + 1 - n0) * TILE, w, lane);
        { float s = 0.f;
#pragma unroll
          for (int mbv = 0; mbv < 8; ++mbv) s += (yacc[mbv][0] + yacc[mbv][1]) + (yacc[mbv][2] + yacc[mbv][3]);
          s += __shfl_xor(s, 16); s += __shfl_xor(s, 32);
          const float mu = s * (1.f / 128.f); float s2 = 0.f;
#pragma unroll
          for (int mbv = 0; mbv < 8; ++mbv) { yacc[mbv] = yacc[mbv] - mu; s2 += (yacc[mbv][0] * yacc[mbv][0] + yacc[mbv][1] * yacc[mbv][1]) + (yacc[mbv][2] * yacc[mbv][2] + yacc[mbv][3] * yacc[mbv][3]); }
          s2 += __shfl_xor(s2, 16); s2 += __shfl_xor(s2, 32);
          const float rstd = 1.f / sqrtf(s2 * (1.f / 128.f) + GN_EPS);
          unsigned char* op = (unsigned char*)ymix + (size_t)(b * SEQ + tq) * D + 512 + h * 128 + 4 * g;
#pragma unroll
          for (int rep4 = 0; rep4 < (RET_PROBE == 4 ? 2 : 1); ++rep4) {
          if (RET_PROBE == 4) { asm volatile("" : "+v"(op)); asm volatile("" : "+v"(gv[0]), "+v"(gv[1]), "+v"(gv[2]), "+v"(gv[3]), "+v"(gv[4]), "+v"(gv[5]), "+v"(gv[6]), "+v"(gv[7])); }
#pragma unroll
          for (int mbv = 0; mbv < 8; ++mbv) {
              const f32x4 gn = *(const __attribute__((address_space(1))) f32x4*)(gnp + h * 128 + 16 * mbv + 4 * g);
              const float g0 = __uint_as_float(gv[mbv].x << 16), g1 = __uint_as_float(gv[mbv].x & 0xffff0000u), g2 = __uint_as_float(gv[mbv].y << 16), g3 = __uint_as_float(gv[mbv].y & 0xffff0000u);
              int o = __builtin_amdgcn_cvt_pk_fp8_f32(clamp8(S_H8 * silu_f(g0) * (yacc[mbv][0] * rstd * gn.x)), clamp8(S_H8 * silu_f(g1) * (yacc[mbv][1] * rstd * gn.y)), 0, false);
              o = __builtin_amdgcn_cvt_pk_fp8_f32(clamp8(S_H8 * silu_f(g2) * (yacc[mbv][2] * rstd * gn.z)), clamp8(S_H8 * silu_f(g3) * (yacc[mbv][3] * rstd * gn.w)), o, true);
              *(unsigned*)(op + 16 * mbv) = (unsigned)o;
          } } }
        state_update<true>(lds, racc, lf2, w, g, qp, p);
    }
    }
    __syncthreads();
#undef RET_LANE
}
}


namespace na {
constexpr unsigned LKR = 0, LVR = 73728, LRPB = 147456;
__device__ __forceinline__ void load_row(LAS unsigned char* lds, const bf16_t* __restrict__ proj, int b, int head, int krow, int tid) {
    const int key = tid >> 3, ch = tid & 7, slot = krow % 9;
    const bf16_t* rp = proj + (size_t)(b * SEQ + krow * 64 + key) * DIN + head * 64 + ch * 8;
    const unsigned o = (unsigned)slot * 8192u + 128u * key + 16u * (ch ^ (key & 7));
    *(LAS u32x4*)(lds + LKR + o) = *(const u32x4*)(rp + OFF_KNA);
    *(LAS u32x4*)(lds + LVR + o) = *(const u32x4*)(rp + OFF_VNA);
}
__device__ __forceinline__ void unit(const bf16_t* __restrict__ proj, const float* __restrict__ rpb, bf16_t* __restrict__ ymix, LAS unsigned char* lds, int u, const int tid_in) {
    const int b = u >> 3, head = u & 7;
    int tid_ = tid_in; asm volatile("" : "+v"(tid_));
    const int tid0 = tid_, w = __builtin_amdgcn_readfirstlane(tid0 >> 6);
    __syncthreads();
    if (tid0 < 465) ((LAS float*)(lds + LRPB))[tid0] = rpb[head * 465 + tid0];
    const int ct = w & 3, cb = (ct == 0) ? 0 : (ct == 1 ? 8 : (ct == 2 ? 24 : 32));
    u32x4 pk[2], pv2[2]; int pre_lo = 0, pre_n = 0;
    for (int st = 0; st < 16; ++st) {
        int tid = tid0; asm volatile("" : "+v"(tid));
        const int lane = tid & 63, qi = lane & 15, g = lane >> 4; const unsigned qp = (unsigned)qi >> 2, p = (unsigned)lane & 3u;
        const int r = 2 * st + (w >> 2);
        const int rs = min(max(r - 4, 0), 24);
        const int need_hi = min(max(2 * st + 1 - 4, 0), 24) + 7;
        __syncthreads();
        if (st == 0) { for (int kr = 0; kr <= need_hi; ++kr) load_row(lds, proj, b, head, kr, tid); }
        else {
#pragma unroll
            for (int i = 0; i < 2; ++i) if (i < pre_n) { const int key = tid >> 3, ch = tid & 7; const unsigned o = (unsigned)((pre_lo + i) % 9) * 8192u + 128u * key + 16u * (ch ^ (key & 7));
                *(LAS u32x4*)(lds + LKR + o) = pk[i]; *(LAS u32x4*)(lds + LVR + o) = pv2[i]; }
        }
        const int cq = 16 * ct + qi, tq = b * SEQ + r * 64 + cq;
        bf16x8 qn[2];
        { const bf16_t* qptr = proj + (size_t)tq * DIN + OFF_QNA + head * 64 + 8 * g; qn[0] = *(const bf16x8*)qptr; qn[1] = *(const bf16x8*)(qptr + 32); }
        __syncthreads();
        { const int nh = (st < 15) ? min(max(2 * st + 3 - 4, 0), 24) + 7 : need_hi; pre_lo = need_hi + 1; pre_n = nh - need_hi;
#pragma unroll
          for (int i = 0; i < 2; ++i) if (i < pre_n) { const int key = tid >> 3, ch = tid & 7; const bf16_t* rp = proj + (size_t)(b * SEQ + (pre_lo + i) * 64 + key) * DIN + head * 64 + ch * 8;
              pk[i] = *(const u32x4*)(rp + OFF_KNA); pv2[i] = *(const u32x4*)(rp + OFF_VNA); } }
        const int cs = min(max(cq - 8, 0), 48);
        const unsigned kb0 = 128u * qi + 16u * ((unsigned)g ^ ((unsigned)qi & 7u)), kb1 = 128u * qi + 16u * ((4u + (unsigned)g) ^ ((unsigned)qi & 7u));
        const LAS float* bias = (const LAS float*)(lds + LRPB);
        f32x4 sc[16]; float mx = -3.0e38f;
#pragma unroll
        for (int kr = 0; kr < 8; ++kr) {
            const int krow = rs + kr; const unsigned so = (unsigned)(krow % 9) * 8192u + 128u * (unsigned)cb;
            const int dr = krow - r + 7;
#pragma unroll
            for (int h2 = 0; h2 < 2; ++h2) {
                f32x4 a = (f32x4){0.f, 0.f, 0.f, 0.f};
                a = __builtin_amdgcn_mfma_f32_16x16x32_bf16(*(const LAS bf16x8*)(lds + LKR + so + 2048u * h2 + kb0), qn[0], a, 0, 0, 0);
                a = __builtin_amdgcn_mfma_f32_16x16x32_bf16(*(const LAS bf16x8*)(lds + LKR + so + 2048u * h2 + kb1), qn[1], a, 0, 0, 0);
#pragma unroll
                for (int j = 0; j < 4; ++j) {
                    const int kcol = cb + 16 * h2 + 4 * g + j;
                    const int dc = min(max(kcol - cq + 15, 0), 30);
                    const float v = a[j] + bias[dr * 31 + dc];
                    const bool in = (kcol >= cs) && (kcol < cs + 16);
                    a[j] = in ? v : -3.0e38f; mx = fmaxf(mx, a[j]);
                }
                sc[2 * kr + h2] = a;
            }
        }
        mx = fmaxf(mx, __shfl_xor(mx, 16)); mx = fmaxf(mx, __shfl_xor(mx, 32));
        float sum = 0.f; bf16x8 pt[8];
#pragma unroll
        for (int kk = 0; kk < 8; ++kk) {
            float pv[8];
#pragma unroll
            for (int h2 = 0; h2 < 2; ++h2)
#pragma unroll
                for (int j = 0; j < 4; ++j) { const float e = __builtin_amdgcn_exp2f((sc[2 * kk + h2][j] - mx) * 1.4426950408889634f); pv[4 * h2 + j] = e; sum += e; }
            pt[kk] = ret::pack8(pv);
        }
        sum += __shfl_xor(sum, 16); sum += __shfl_xor(sum, 32);
        const float inv = 1.f / sum;
        const unsigned sl = (((unsigned)g & 1u) << 2) | qp;
        unsigned char* op = (unsigned char*)ymix + (size_t)tq * D + head * 64 + 4 * g;
#pragma unroll
        for (int db = 0; db < 4; ++db) {
            const unsigned vb = 128u * (4u * (unsigned)g + qp) + 16u * ((2u * db + (p >> 1)) ^ sl) + 8u * (p & 1u);
            f32x4 y = (f32x4){0.f, 0.f, 0.f, 0.f};
#pragma unroll
            for (int kk = 0; kk < 8; ++kk) {
                const unsigned so = (unsigned)((rs + kk) % 9) * 8192u + 128u * (unsigned)cb;
                const ret::s16x4 lo = __builtin_amdgcn_ds_read_tr16_b64_v4i16((LAS ret::s16x4*)(lds + LVR + so + vb));
                const ret::s16x4 hi = __builtin_amdgcn_ds_read_tr16_b64_v4i16((LAS ret::s16x4*)(lds + LVR + so + 2048u + vb));
                y = __builtin_amdgcn_mfma_f32_16x16x32_bf16(__builtin_shufflevector(lo, hi, 0, 1, 2, 3, 4, 5, 6, 7), pt[kk], y, 0, 0, 0);
            }
            const float inv16 = inv * S_H8;
            int o = __builtin_amdgcn_cvt_pk_fp8_f32(clamp8(y[0] * inv16), clamp8(y[1] * inv16), 0, false); o = __builtin_amdgcn_cvt_pk_fp8_f32(clamp8(y[2] * inv16), clamp8(y[3] * inv16), o, true);
            *(unsigned*)(op + 16 * db) = (unsigned)o;
        }
    }
    __syncthreads();
}
}

__device__ __forceinline__ void unpack_t16r(const u32x4 a, const u32x4 b, f32x4 (&v)[4]) {
    v[0] = (f32x4){__uint_as_float(a.x << 16), __uint_as_float(a.x & 0xffff0000u), __uint_as_float(a.y << 16), __uint_as_float(a.y & 0xffff0000u)};
    v[1] = (f32x4){__uint_as_float(a.z << 16), __uint_as_float(a.z & 0xffff0000u), __uint_as_float(a.w << 16), __uint_as_float(a.w & 0xffff0000u)};
    v[2] = (f32x4){__uint_as_float(b.x << 16), __uint_as_float(b.x & 0xffff0000u), __uint_as_float(b.y << 16), __uint_as_float(b.y & 0xffff0000u)};
    v[3] = (f32x4){__uint_as_float(b.z << 16), __uint_as_float(b.z & 0xffff0000u), __uint_as_float(b.w << 16), __uint_as_float(b.w & 0xffff0000u)};
}
__device__ __forceinline__ void ln1_row(const u32x4 ra, const u32x4 rb, const LAS float* cv  , bf16_t* __restrict__ hf, unsigned char* __restrict__ hf8, float* __restrict__ stats, int row, int lane) {
    asm volatile("" : "+v"(cv));
    const int c0 = lane * 16;
    f32x4 v[4]; float s = 0.f;
    unpack_t16r(ra, rb, v);
#pragma unroll
    for (int j = 0; j < 4; ++j) s += (v[j].x + v[j].y) + (v[j].z + v[j].w);
    const float mean = wave_sum(s) * (1.f / D); float s2 = 0.f;
#pragma unroll
    for (int j = 0; j < 4; ++j) { v[j] = v[j] - mean; s2 += (v[j].x * v[j].x + v[j].y * v[j].y) + (v[j].z * v[j].z + v[j].w * v[j].w); }
    const float rstd = 1.f / sqrtf(wave_sum(s2) * (1.f / D) + LN_EPS);
    if (lane == 0) *(f32x2*)(stats + 2 * (size_t)row) = (f32x2){mean, rstd};
    u32x4 ob[2], o8;
#pragma unroll
    for (int j = 0; j < 4; ++j) { const int col = c0 + 4 * j;
        const f32x4 gg = *(const LAS f32x4*)(cv + col), bv = *(const LAS f32x4*)(cv + 1024 + col), sc1 = *(const LAS f32x4*)(cv + 2048 + col), sh = *(const LAS f32x4*)(cv + 3072 + col);
        const f32x4 h4 = (v[j] * rstd * gg + bv) * sc1 + sh;
        const unsigned p0 = pk2(h4.x, h4.y), p1 = pk2(h4.z, h4.w);
        if (j == 0) { ob[0].x = p0; ob[0].y = p1; } else if (j == 1) { ob[0].z = p0; ob[0].w = p1; } else if (j == 2) { ob[1].x = p0; ob[1].y = p1; } else { ob[1].z = p0; ob[1].w = p1; }
        const f32x4 h8 = h4 * S_HF8;
        int w0 = __builtin_amdgcn_cvt_pk_fp8_f32(clamp8(h8.x), clamp8(h8.y), 0, false); w0 = __builtin_amdgcn_cvt_pk_fp8_f32(clamp8(h8.z), clamp8(h8.w), w0, true);
        if (j == 0) o8.x = (unsigned)w0; else if (j == 1) o8.y = (unsigned)w0; else if (j == 2) o8.z = (unsigned)w0; else o8.w = (unsigned)w0; }
    *(u32x4*)(hf + (size_t)row * D + c0) = ob[0]; *(u32x4*)(hf + (size_t)row * D + c0 + 8) = ob[1];
    *(u32x4*)(hf8 + (size_t)row * D + c0) = o8;
}
__device__ __forceinline__ void top2_merge(float& a1, float& a2, float b1, float b2) { const float n1 = fmaxf(a1, b1); const float n2 = fmaxf(fminf(a1, b1), fmaxf(a2, b2)); a1 = n1; a2 = n2; }
__device__ __forceinline__ float sigm(float x) { return 1.f / (1.f + __expf(-x)); }
__device__ __forceinline__ void route_lane(const float* __restrict__ logits, const float* __restrict__ rbias, int* __restrict__ topk_e, float* __restrict__ topk_w, LAS unsigned* hist, int tok) {
    const float NEG = -3.0e38f;
    const float* row = logits + (size_t)tok * NE;
    float gs[8];
#pragma unroll
    for (int g = 0; g < 8; ++g) {
        float m1 = NEG, m2 = NEG;
#pragma unroll
        for (int q = 0; q < 8; ++q) {
            const f32x4 lg = *(const f32x4*)(row + g * 32 + q * 4), b4 = *(const f32x4*)(rbias + g * 32 + q * 4);
            const float v[4] = {sigm(lg.x) + b4.x, sigm(lg.y) + b4.y, sigm(lg.z) + b4.z, sigm(lg.w) + b4.w};
#pragma unroll
            for (int j = 0; j < 4; ++j) { m2 = fmaxf(m2, fminf(m1, v[j])); m1 = fmaxf(m1, v[j]); }
        }
        gs[g] = m1 + m2;
        if (g & 1) asm volatile("" ::: "memory");
    }
    int pc[8];
    { int run = 0;
#pragma unroll
      for (int g = 0; g < 8; ++g) { int rank = 0;
#pragma unroll
          for (int h = 0; h < 8; ++h) if (h != g) rank += (gs[h] > gs[g] || (gs[h] == gs[g] && h < g)) ? 1 : 0;
          run += (rank < 4) ? 1 : 0; pc[g] = run; } }
    float L[8]; int I[8];
#pragma unroll
    for (int i = 0; i < 8; ++i) { L[i] = NEG; I[i] = 0; }
#pragma unroll 1
    for (int k = 0; k < 4; ++k) {
        int gk = 0;
#pragma unroll
        for (int g = 0; g < 8; ++g) gk += (pc[g] <= k) ? 1 : 0;
        const int base = gk * 32;
#pragma unroll
        for (int q = 0; q < 8; ++q) {
            const f32x4 lg = *(const f32x4*)(row + base + q * 4), b4 = *(const f32x4*)(rbias + base + q * 4);
            const float cv[4] = {sigm(lg.x) + b4.x, sigm(lg.y) + b4.y, sigm(lg.z) + b4.z, sigm(lg.w) + b4.w};
#pragma unroll
            for (int j = 0; j < 4; ++j) { float v = cv[j]; int idx = base + q * 4 + j;
#pragma unroll
                for (int i = 0; i < 8; ++i) { const bool gt = v > L[i]; const float tv = gt ? L[i] : v; const int ti = gt ? I[i] : idx; L[i] = gt ? v : L[i]; I[i] = gt ? idx : I[i]; v = tv; idx = ti; } }
        }
    }
    float w[8], wsum = 0.f;
#pragma unroll
    for (int i = 0; i < 8; ++i) { w[i] = sigm(row[I[i]]); wsum += w[i]; }
    const float sc = 2.5f / wsum;
    *(u32x4*)(topk_e + tok * TOPK) = (u32x4){(unsigned)I[0], (unsigned)I[1], (unsigned)I[2], (unsigned)I[3]}; *(u32x4*)(topk_e + tok * TOPK + 4) = (u32x4){(unsigned)I[4], (unsigned)I[5], (unsigned)I[6], (unsigned)I[7]};
    *(f32x4*)(topk_w + tok * TOPK) = (f32x4){w[0] * sc, w[1] * sc, w[2] * sc, w[3] * sc}; *(f32x4*)(topk_w + tok * TOPK + 4) = (f32x4){w[4] * sc, w[5] * sc, w[6] * sc, w[7] * sc};
#pragma unroll
    for (int i = 0; i < 8; ++i) __hip_atomic_fetch_add(&hist[I[i]], 1u, __ATOMIC_RELAXED, __HIP_MEMORY_SCOPE_WORKGROUP);
}
__device__ __forceinline__ void build_tables(const unsigned* ctl, LAS unsigned* tab, const int tid) {
    if (tid < 64) {
        const int lane = tid;
        unsigned c[4], so = 0, st = 0;
#pragma unroll
        for (int j = 0; j < 4; ++j) { c[j] = __hip_atomic_load(ctl + CW_COUNT + lane * 4 + j, __ATOMIC_RELAXED, __HIP_MEMORY_SCOPE_AGENT); so += c[j]; st += (c[j] + 255u) >> 8; }
        unsigned io = so, it = st;
#pragma unroll
        for (int o = 1; o < 64; o <<= 1) { const unsigned a = __shfl_up(io, o), b = __shfl_up(it, o); if (lane >= o) { io += a; it += b; } }
        unsigned eo = io - so, et = it - st;
#pragma unroll
        for (int j = 0; j < 4; ++j) { tab[T_CNT + lane * 4 + j] = c[j]; tab[T_OFF + lane * 4 + j] = eo; tab[T_TILE + lane * 4 + j] = et; eo += c[j]; et += (c[j] + 255u) >> 8; }
        if (lane == 63) { tab[T_OFF + NE] = eo; tab[T_TILE + NE] = et; }
    }
    __syncthreads();
}
struct RowRaw { u32x4 y[9]; u32x4 t[2]; f32x2 st; };
__device__ __forceinline__ void final_load(RowRaw& R, const bf16_t* __restrict__ tb, const unsigned char* __restrict__ ybuf, const unsigned char* __restrict__ ysh, const float* __restrict__ stats, int row, int lane) {
    const int c0 = lane * 16;
#pragma unroll
    for (int k = 0; k < TOPK; ++k) R.y[k] = *(const u32x4*)(ybuf + ((size_t)row * TOPK + k) * D + c0);
    R.y[8] = *(const u32x4*)(ysh + (size_t)row * D + c0);
    R.t[0] = *(const u32x4*)(tb + (size_t)row * D + c0); R.t[1] = *(const u32x4*)(tb + (size_t)row * D + c0 + 8);
    R.st = *(const f32x2*)(stats + 2 * (size_t)row);
}
__device__ __forceinline__ void final_row(float* __restrict__ out, const RowRaw& R, const LAS float* cv  , int row, int lane) {
    asm volatile("" : "+v"(cv));
    const int c0 = lane * 16;
    f32x4 a[4], t[4], v[4]; float s = 0.f;
#pragma unroll
    for (int j = 0; j < 4; ++j) a[j] = (f32x4){0.f, 0.f, 0.f, 0.f};
#pragma unroll
    for (int k = 0; k < 9; ++k) { const unsigned w[4] = {R.y[k].x, R.y[k].y, R.y[k].z, R.y[k].w};
#pragma unroll
        for (int j = 0; j < 4; ++j) { const f32x2 lo = __builtin_amdgcn_cvt_pk_f32_fp8((int)w[j], false), hi = __builtin_amdgcn_cvt_pk_f32_fp8((int)w[j], true); a[j].x += lo.x; a[j].y += lo.y; a[j].z += hi.x; a[j].w += hi.y; } }
    unpack_t16r(R.t[0], R.t[1], t);
#pragma unroll
    for (int j = 0; j < 4; ++j) { const int col = c0 + 4 * j;
        const f32x4 x1 = (t[j] - R.st.x) * R.st.y * *(const LAS f32x4*)(cv + col) + *(const LAS f32x4*)(cv + 1024 + col);
        v[j] = x1 * ALPHA + *(const LAS f32x4*)(cv + 4096 + col) * a[j] * YINV;
        s += (v[j].x + v[j].y) + (v[j].z + v[j].w); }
    const float mean = wave_sum(s) * (1.f / D); float s2 = 0.f;
#pragma unroll
    for (int j = 0; j < 4; ++j) { v[j] = v[j] - mean; s2 += (v[j].x * v[j].x + v[j].y * v[j].y) + (v[j].z * v[j].z + v[j].w * v[j].w); }
    const float rstd = 1.f / sqrtf(wave_sum(s2) * (1.f / D) + LN_EPS);
#pragma unroll
    for (int j = 0; j < 4; ++j) { const int col = c0 + 4 * j;
        *(f32x4*)(out + (size_t)row * D + col) = v[j] * rstd * *(const LAS f32x4*)(cv + 2048 + col) + *(const LAS f32x4*)(cv + 3072 + col); }
}

#ifndef MK_PER_PHASE
#define MK_PER_PHASE 0
#endif
constexpr int N_PHASES = 13;
struct Args { Ctx X; int ph_lo, ph_hi; };
typedef __attribute__((address_space(4))) const Ctx* CtxCP;
__device__ __forceinline__ CtxCP ctx_ptr() { CtxCP p = (CtxCP)__builtin_amdgcn_kernarg_segment_ptr(); asm volatile("" : "+s"(p)); return p; }

__global__ void __launch_bounds__(NW * 64, 2) mk_fwd(Args args) {
    extern __shared__ __attribute__((aligned(16))) unsigned char lds_raw[];
    LAS unsigned char* lds = (LAS unsigned char*)lds_raw;
    LAS unsigned* tab = (LAS unsigned*)(lds + TAB_OFF);
    volatile LAS unsigned* MISC = (volatile LAS unsigned*)(lds + MISC_OFF);
#define PH_BEGIN \
    const __attribute__((address_space(4))) Ctx& X = *ctx_ptr(); unsigned char* ws = X.ws; (void)ws; \
    const int lane = lane_id(), wave = wave0, tid = wave0 * 64 + lane; (void)lane; (void)wave; (void)tid; \
    const int G = gridDim.x, bx = blockIdx.x; (void)G; (void)bx; \
    const int gw = bx * NW + wave, NGW = G * NW; (void)gw; (void)NGW; \
    const int gt = bx * (NW * 64) + tid, NGT = G * NW * 64; (void)gt; (void)NGT; \
    unsigned* ctl = (unsigned*)(ws + WS_CTL); float* mod = (float*)(ws + WS_MOD); float* rope = (float*)(ws + WS_ROPE); (void)ctl; (void)mod; (void)rope; \
    bf16_t* win_t = (bf16_t*)(ws + WS_WIN_T); bf16_t* wout_t = (bf16_t*)(ws + WS_WOUT_T); bf16_t* wr_t = (bf16_t*)(ws + WS_WR_T); (void)win_t; (void)wout_t; (void)wr_t; \
    bf16_t* wsgu_t = (bf16_t*)(ws + WS_WSGU_T); bf16_t* wsd_t = (bf16_t*)(ws + WS_WSD_T); bf16_t* wd_t = (bf16_t*)(ws + WS_WD_T); bf16_t* wgu_t = (bf16_t*)(ws + WS_WGU_T); (void)wsgu_t; (void)wsd_t; (void)wd_t; (void)wgu_t; \
    int* slot_ent = (int*)(ws + WS_SLOT_ENT); float* slot_w = (float*)(ws + WS_SLOT_W); int* topk_e = (int*)(ws + WS_TOPK_E); float* topk_w = (float*)(ws + WS_TOPK_W); (void)slot_ent; (void)slot_w; (void)topk_e; (void)topk_w; \
    bf16_t* ymix = (bf16_t*)(ws + WS_YMIX); bf16_t* proj = (bf16_t*)(ws + WS_PROJ); bf16_t* hbuf = (bf16_t*)(ws + WS_YMIX); (void)ymix; (void)proj; (void)hbuf; \
    float* logits = (float*)(ws + WS_LOGITS); bf16_t* shh = (bf16_t*)(ws + WS_SHH); bf16_t* hf = (bf16_t*)(ws + WS_HF); bf16_t* act = (bf16_t*)(ws + WS_ACT); (void)logits; (void)shh; (void)hf; (void)act; \
    unsigned char* ybuf = ws + WS_YBUF; float* out = X.out; (void)ybuf; (void)out;

    const int wave0 = __builtin_amdgcn_readfirstlane((int)threadIdx.x >> 6);
    for (int u = threadIdx.x; u < (LDS_BYTES - MISC_OFF) / 4; u += NW * 64) ((LAS unsigned*)(lds + MISC_OFF))[u] = 0u;
    __syncthreads();
    if (!MK_PER_PHASE) { unsigned* ctl0 = (unsigned*)(args.X.ws + WS_CTL); (void)xcd_barrier_post(ctl0 + CW_BAR, MISC + 8, wave0 == 0 && lane_id() == 0); }
    const int lo = args.ph_lo, hi = args.ph_hi;
#ifndef MK_DUP
#define MK_DUP -1
#endif
#define REPS(k) for (int _rep = 0; _rep < ((MK_DUP == (k) || (MK_DUP == 202 && (k) == 0)) ? 2 : 1); ++_rep)
#ifdef MK_ONLY
#define IN(k) ((k) == MK_ONLY)
#else
#define IN(k) (lo <= (k) && (k) < hi)
#endif
#define SEAM(k) SEAM2(k, (k) + 1)
#define SEAM2(k, k2) do { if (IN(k) && IN(k2)) { XcdBarrier _b; _b.bar = (unsigned*)(ctx_ptr()->ws + WS_CTL) + CW_BAR; _b.x = xb_xcc_id(); _b.st = (volatile LAS unsigned*)(lds + MISC_OFF) + 8; xcd_barrier(_b, wave0 == 0 && lane_id() == 0); } } while (0)

    REPS(0) if (IN(0)) { PH_BEGIN
        LAS float* scr = (LAS float*)(lds + wave * 16384);
        float* modp = (float*)(ws + WS_PROJ);
        for (int t = gw; t < 96 * 16; t += NGW) mod_task(X.c, X.w_ada, modp, t, lane);
        constexpr int I_IN = (D / 64) * (DIN / 32), I_OUT = (D / 64) * (D / 32), I_R = (D / 64) * (NE / 32), I_SG = (D / 64) * (DE / 32), I_SD = (DE / 64) * (D / 32);
        constexpr int I_EG = I_SG, I_ED = I_SD;
        constexpr int N_SMALL = I_IN + I_OUT + I_R + 2 * I_SG + I_SD;
        constexpr int N_ITEMS = N_SMALL + NE * (2 * I_EG + I_ED);
#if MK_DUP == 200 || MK_DUP == 201
        for (int it = gw; it < NE * (2 * I_EG + I_ED); it += NGW) {
            int r = it; const int e = r / (2 * I_EG + I_ED); r -= e * (2 * I_EG + I_ED);
            const float* W; int K, N;
            if (r < I_EG) { W = X.w_gate + (size_t)e * D * DE; K = D; N = DE; } else if (r < 2 * I_EG) { r -= I_EG; W = X.w_up + (size_t)e * D * DE; K = D; N = DE; } else { r -= 2 * I_EG; W = X.w_down + (size_t)e * DE * D; K = DE; N = D; }
            const int nblk = N / 32, kb = r / nblk, nb = r % nblk, k0 = 64 * kb, n0 = 32 * nb; float sum = 0.f;
#if MK_DUP == 200
            float v[32];
#pragma unroll
            for (int i = 0; i < 32; ++i) { const int kk = 2 * i + (lane >> 5); v[i] = __builtin_nontemporal_load(W + (size_t)(k0 + kk) * N + n0 + (lane & 31)); }
#pragma unroll
            for (int i = 0; i < 32; ++i) sum += v[i];
#else
            f32x4 v[8];
#pragma unroll
            for (int i = 0; i < 8; ++i) { const int kk = 8 * i + (lane >> 3); v[i] = __builtin_nontemporal_load((const f32x4*)(W + (size_t)(k0 + kk) * N + n0 + 4 * (lane & 7))); }
#pragma unroll
            for (int i = 0; i < 8; ++i) sum += (v[i].x + v[i].y) + (v[i].z + v[i].w);
#endif
            if (sum == 123.456f) modp[it] = sum;
        }
#endif
        for (int it = gw; it < N_SMALL; it += NGW) {
            int r = it;
            if (r < I_IN) { transpose_item_fp8(X.w_in, D, DIN, (unsigned char*)win_t, 0, 0, S_WIN8, scr, r, lane); continue; } r -= I_IN;
            if (r < I_OUT) { transpose_item_fp8(X.w_out, D, D, (unsigned char*)wout_t, 0, 0, S_WIN8, scr, r, lane); continue; } r -= I_OUT;
            if (r < I_R) { transpose_item(X.w_router, D, NE, wr_t, 0, 0, scr, r, lane); continue; } r -= I_R;
            if (r < I_SG) { transpose_item_fp8(X.ws_gate, D, DE, (unsigned char*)wsgu_t, 8, 0, S_WGU8, scr, r, lane); continue; } r -= I_SG;
            if (r < I_SG) { transpose_item_fp8(X.ws_up, D, DE, (unsigned char*)wsgu_t, 8, 1, S_WGU8, scr, r, lane); continue; } r -= I_SG;
            transpose_item(X.ws_down, DE, D, wsd_t, 0, 0, scr, r, lane);
        }
        {
            constexpr int I_E = (D / 128) * (DE / 32), PER_E = 3 * I_E, N_EXP = NE * PER_E;
            static_assert((DE / 128) * (D / 32) == I_E, "item count");
            f32x4 v[16];
            const float* W = X.w_gate; unsigned char* WT = (unsigned char*)wgu_t; int K = D, N = DE, G8 = 8, which = 0, k0 = 0, n0 = 0; float scale = S_WGU8;
            const int kq = lane >> 3, nq = lane & 7;
            LAS unsigned char* sb = (LAS unsigned char*)scr;
#define P0_DECODE(it_) do { int _r = (it_); const int _e = _r / PER_E; _r -= _e * PER_E; const int _t = _r / I_E; _r -= _t * I_E; \
                if (_t < 2) { which = _t; W = (_t ? X.w_up : X.w_gate) + (size_t)_e * D * DE; K = D; N = DE; WT = (unsigned char*)wgu_t + (size_t)_e * 512 * D; G8 = 8; scale = S_WGU8; } \
                else { W = X.w_down + (size_t)_e * DE * D; K = DE; N = D; WT = (unsigned char*)wd_t + (size_t)_e * D * DE; G8 = 0; which = 0; scale = S_WD8; } \
                const int _nblk = N / 32; k0 = 128 * (_r / _nblk); n0 = 32 * (_r % _nblk); } while (0)
#define P0_LOAD() do { _Pragma("unroll") for (int _j = 0; _j < 4; ++_j) _Pragma("unroll") for (int _t = 0; _t < 4; ++_t) \
                v[4 * _j + _t] = __builtin_nontemporal_load((const f32x4*)(W + (size_t)(k0 + 4 * (8 * _j + kq) + _t) * N + n0 + 4 * nq)); } while (0)
#define P0_CVT4(x_) ({ const f32x4 _x = (x_) * cs; const float _c0 = clamp8(_x.x); int _w = __builtin_amdgcn_cvt_pk_fp8_f32(_c0, clamp8(_x.y), __float_as_int(_c0), false); (unsigned)__builtin_amdgcn_cvt_pk_fp8_f32(clamp8(_x.z), clamp8(_x.w), _w, true); })
            int it = gw;
            if (it < N_EXP) { P0_DECODE(it); P0_LOAD(); }
#pragma unroll 1
            while (it < N_EXP) {
                unsigned char* cWT = WT; const int cK = K, cG = G8, cwhich = which, ck0 = k0, cn0 = n0; const float cs = scale;
#pragma unroll
                for (int j = 0; j < 4; ++j) {
                    const unsigned d0 = P0_CVT4(v[4 * j + 0]), d1 = P0_CVT4(v[4 * j + 1]), d2 = P0_CVT4(v[4 * j + 2]), d3 = P0_CVT4(v[4 * j + 3]);
                    const unsigned x0 = __builtin_amdgcn_perm(d1, d0, 0x05010400u), x1 = __builtin_amdgcn_perm(d1, d0, 0x07030602u), y0 = __builtin_amdgcn_perm(d3, d2, 0x05010400u), y1 = __builtin_amdgcn_perm(d3, d2, 0x07030602u);
                    const unsigned e0 = __builtin_amdgcn_perm(y0, x0, 0x05040100u), e1 = __builtin_amdgcn_perm(y0, x0, 0x07060302u), e2 = __builtin_amdgcn_perm(y1, x1, 0x05040100u), e3 = __builtin_amdgcn_perm(y1, x1, 0x07060302u);
                    LAS unsigned char* wp = sb + (4 * nq) * 144 + 4 * (8 * j + kq);
                    *(LAS unsigned*)(wp) = e0; *(LAS unsigned*)(wp + 144) = e1; *(LAS unsigned*)(wp + 288) = e2; *(LAS unsigned*)(wp + 432) = e3;
                }
                const int itn = it + NGW;
                if (itn < N_EXP) { P0_DECODE(itn); P0_LOAD(); }
                LDS_WAIT(); asm volatile("" ::: "memory");
#pragma unroll
                for (int j2 = 0; j2 < 4; ++j2) { const int n = (lane >> 3) + 8 * j2; const u32x4 o = *(const LAS u32x4*)(sb + n * 144 + 16 * (lane & 7));
                    const int ng = cn0 + n; const int drow = cG ? ((ng >> 3) * 16 + cwhich * 8 + (ng & 7)) : ng;
                    *(u32x4*)(cWT + (size_t)drow * cK + ck0 + 16 * (lane & 7)) = o; }
                LDS_WAIT(); asm volatile("" ::: "memory");
                it = itn;
            }
#undef P0_DECODE
#undef P0_LOAD
#undef P0_CVT4
        }
        for (int i = gt; i < SEQ * 64; i += NGT) rope_entry(rope, i);
    }
    SEAM(0);
    REPS(1) if (IN(1)) { PH_BEGIN
        const float* modp = (const float*)(ws + WS_PROJ);
        for (int i = gt; i < 32 * 6144; i += NGT) mod[i] = mod_sum(modp, X.b_ada, i / 6144, i % 6144);
        LAS float* ssc = (LAS float*)lds; LAS float* ssh = ssc + 1024;
        int curb = -1;
        for (int c = bx; c < M / 256; c += G) {
            const int b = c >> 3;
            if (b != curb) {
                __syncthreads();
                for (int i = tid; i < 1024; i += NW * 64) { ssc[i] = 1.f + mod_sum(modp, X.b_ada, b, MOD_SCALE_A + i); ssh[i] = mod_sum(modp, X.b_ada, b, MOD_SHIFT_A + i); }
                __syncthreads();
                curb = b;
            }
            const f32x4 sc = *(const LAS f32x4*)(ssc + (tid & 255) * 4), sh = *(const LAS f32x4*)(ssh + (tid & 255) * 4);
            const float* xp = X.x + (size_t)c * 256 * D + (size_t)(tid >> 8) * D + (tid & 255) * 4;
            unsigned char* hp = (unsigned char*)hbuf + (size_t)c * 256 * D + (size_t)(tid >> 8) * D + (tid & 255) * 4;
            for (int i0 = 0; i0 < 128; i0 += 8) {
                f32x4 v[8];
#pragma unroll
                for (int i = 0; i < 8; ++i) v[i] = __builtin_nontemporal_load((const f32x4*)(xp + (size_t)(i0 + i) * 2 * D));
#pragma unroll
                for (int i = 0; i < 8; ++i) { int w = __builtin_amdgcn_cvt_pk_fp8_f32(clamp8((v[i].x * sc.x + sh.x) * S_H8), clamp8((v[i].y * sc.y + sh.y) * S_H8), 0, false);
                    w = __builtin_amdgcn_cvt_pk_fp8_f32(clamp8((v[i].z * sc.z + sh.z) * S_H8), clamp8((v[i].w * sc.w + sh.w) * S_H8), w, true); *(unsigned*)(hp + (size_t)(i0 + i) * 2 * D) = (unsigned)w; }
            }
        }
        __syncthreads();
    }
    SEAM(1);
    REPS(2) if (IN(2)) { PH_BEGIN
        pg8::DenseOrder S; S.init(M, DIN, D / 2, win_t, G, bx);
        pg8::EpiInProj E{proj};
        pg8::gemm_phase<1>(lds, (const char*)hbuf, D, S, E, tid);
    }
    SEAM(2);
    REPS(3) if (IN(3)) { PH_BEGIN
        REPS(31) for (int hu = bx; hu < BATCH * 4 * 2; hu += G) ret::unit(proj, rope, X.ret_ld, X.ret_gn, ymix, (unsigned char*)out + (size_t)hu * (8 * ret::TILE), lds, hu, tid);
        REPS(32) for (int u = bx; u < BATCH * 8; u += G) na::unit(proj, X.na_rpb, ymix, lds, u, tid);
    }
    SEAM2(3, 5);
    if (IN(5)) { PH_BEGIN
        LAS float* cv = (LAS float*)lds; LAS unsigned* hist = tab + T_HIST;
        if (tid < NE) hist[tid] = 0u;
        __syncthreads();
        for (int c = bx; c < M / 256; c += G) {
            const int b = c >> 3;
            { pg8::RowOrder S{c, 4, D / 2, (const char*)wout_t}; pg8::EpiOutProj E{X.x, mod, (bf16_t*)(ws + WS_TB)}; pg8::gemm_phase<1>(lds, (const char*)ymix, D, S, E, tid); }
            asm volatile("s_waitcnt vmcnt(0)" ::: "memory"); __syncthreads();
            int lane2 = lane; asm volatile("" : "+v"(lane2));
            const int tid2 = wave * 64 + lane2;
            if (tid2 < 256) { const int i = tid2 * 4; *(LAS f32x4*)(cv + i) = *(const f32x4*)(X.ln1_g + i); *(LAS f32x4*)(cv + 1024 + i) = *(const f32x4*)(X.ln1_b + i);
                *(LAS f32x4*)(cv + 2048 + i) = *(const f32x4*)(mod + b * 6144 + MOD_SCALE_F + i) + 1.f; *(LAS f32x4*)(cv + 3072 + i) = *(const f32x4*)(mod + b * 6144 + MOD_SHIFT_F + i); }
            __syncthreads();
            { const bf16_t* tp = (const bf16_t*)(ws + WS_TB) + (size_t)(c * 256 + wave * 32) * D + lane2 * 16;
              u32x4 ra = *(const u32x4*)tp, rb = *(const u32x4*)(tp + 8);
#pragma unroll 1
              for (int i = 0; i < 32; ++i) {
                  const u32x4 ca = ra, cb = rb; const int nx = i < 31 ? i + 1 : i;
                  ra = *(const u32x4*)(tp + (size_t)nx * D); rb = *(const u32x4*)(tp + (size_t)nx * D + 8);
                  ln1_row(ca, cb, cv, hf, ws + WS_HF8, (float*)(ws + WS_STATS), c * 256 + wave * 32 + i, lane2);
              } }
            asm volatile("s_waitcnt vmcnt(0)" ::: "memory"); __syncthreads();
            { pg8::RowOrder S{c, 1, D, (const char*)wr_t}; pg8::EpiRouter E{logits}; pg8::gemm_phase(lds, (const char*)hf, D, S, E, tid); }
            { pg8::RowOrder S{c, 2, D / 2, (const char*)wsgu_t}; pg8::EpiGU<false, true> E{(void*)shh}; pg8::gemm_phase<1>(lds, (const char*)(ws + WS_HF8), D, S, E, tid); }
            asm volatile("s_waitcnt vmcnt(0)" ::: "memory"); __syncthreads();
            { int lane3 = lane; asm volatile("" : "+v"(lane3)); const int tid3 = wave * 64 + lane3;
              if (tid3 < 256) route_lane(logits, X.rbias, topk_e, topk_w, hist, c * 256 + tid3); }
        }
        __syncthreads();
        if (tid < NE && hist[tid]) atomicAdd(&ctl[CW_COUNT + tid], hist[tid]);
    }
    SEAM2(5, 9);
    if (IN(9)) { PH_BEGIN
        build_tables(ctl, tab, tid);
        LAS unsigned* hist = tab + T_HIST; LAS unsigned* base = tab + T_BASE;
        for (int c0 = bx * 2048; c0 < NSLOT; c0 += G * 2048) {
            __syncthreads();
            if (tid < NE) hist[tid] = 0u;
            __syncthreads();
            int e[4]; unsigned loc[4];
#pragma unroll
            for (int i = 0; i < 4; ++i) { const int idx = c0 + i * 512 + tid; e[i] = topk_e[idx]; loc[i] = __hip_atomic_fetch_add(&hist[e[i]], 1u, __ATOMIC_RELAXED, __HIP_MEMORY_SCOPE_WORKGROUP); }
            __syncthreads();
            if (tid < NE && hist[tid]) base[tid] = atomicAdd(&ctl[CW_CURSOR + tid], hist[tid]);
            __syncthreads();
#pragma unroll
            for (int i = 0; i < 4; ++i) { const int idx = c0 + i * 512 + tid; const unsigned pos = tab[T_OFF + e[i]] + base[e[i]] + loc[i]; slot_ent[pos] = idx; slot_w[pos] = topk_w[idx]; }
        }
    }
    SEAM(9);
    if (IN(10)) { PH_BEGIN
        build_tables(ctl, tab, tid);
        REPS(10) { pg8::ExpertOrder<2, true> S; S.init(tab, D, wgu_t, (size_t)512 * D, slot_ent, slot_w, G, bx); pg8::EpiGU<true> E{(void*)act}; pg8::gemm_phase<1>(lds, (const char*)(ws + WS_HF8), D, S, E, tid); }
        { pg8::DenseOrder S; S.init(M, D, DE, wsd_t, G, bx); pg8::EpiSharedDown E{ws + WS_YSH}; pg8::gemm_phase(lds, (const char*)shh, DE, S, E, tid); }
    }
    SEAM(10);
    REPS(11) if (IN(11)) { PH_BEGIN
        build_tables(ctl, tab, tid);
#if MK_DUP >= 113 && MK_DUP <= 118
        pg8::down2_phase<MK_DUP - 112>(lds, tab, (const char*)act, (const char*)wd_t, slot_ent, ybuf, G, bx, tid);
#endif
        pg8::down2_phase(lds, tab, (const char*)act, (const char*)wd_t, slot_ent, ybuf, G, bx, tid);
#if MK_DUP == 111
        { pg8::ExpertOrder<4, false> S2; S2.init(tab, DE, wd_t, (size_t)D * DE, slot_ent, slot_w, G, bx); pg8::EpiProbeSum E2{(float*)(ws + WS_STATS)}; pg8::gemm_phase<1>(lds, (const char*)act, DE, S2, E2, tid); }
#endif
    }
    SEAM(11);
    REPS(12) if (IN(12)) { PH_BEGIN
        LAS float* cv = (LAS float*)lds; int curb = -1;
        for (int c = bx; c < M / 256; c += G) {
            const int b = c >> 3;
            if (b != curb) {
                __syncthreads();
                if (tid < 256) { const int i = tid * 4; *(LAS f32x4*)(cv + i) = *(const f32x4*)(X.ln1_g + i); *(LAS f32x4*)(cv + 1024 + i) = *(const f32x4*)(X.ln1_b + i);
                    *(LAS f32x4*)(cv + 2048 + i) = *(const f32x4*)(X.ln2_g + i); *(LAS f32x4*)(cv + 3072 + i) = *(const f32x4*)(X.ln2_b + i); *(LAS f32x4*)(cv + 4096 + i) = *(const f32x4*)(mod + b * 6144 + MOD_GATE_F + i); }
                __syncthreads(); curb = b;
            }
            const int r0 = c * 256 + wave * 32;
            RowRaw nx; final_load(nx, (const bf16_t*)(ws + WS_TB), ybuf, ws + WS_YSH, (const float*)(ws + WS_STATS), r0, lane);
#pragma unroll 1
            for (int i = 0; i < 32; ++i) {
                const RowRaw cur = nx;
                final_load(nx, (const bf16_t*)(ws + WS_TB), ybuf, ws + WS_YSH, (const float*)(ws + WS_STATS), r0 + (i < 31 ? i + 1 : i), lane);
                final_row(out, cur, cv, r0 + i, lane);
            }
        }
    }
#undef IN
#undef SEAM
}

extern "C" void kernel_launch(void* const* d_in, const int* in_sizes, int n_in, void* d_out, int out_size, void* d_ws, size_t ws_size, hipStream_t stream) {
    static int grid = 0;
    if (grid == 0) {
        if (n_in != 21 || in_sizes[0] != M * D || out_size != M * D || ws_size < WS_END) { fprintf(stderr, "kernel_launch: unexpected shapes (n_in %d, ws %zu)\n", n_in, ws_size); grid = -1; return; }
        int dev = 0, cus = 0, per_cu = 0;
        if (hipGetDevice(&dev) != hipSuccess || hipDeviceGetAttribute(&cus, hipDeviceAttributeMultiprocessorCount, dev) != hipSuccess) { grid = -1; return; }
        if (hipFuncSetAttribute((const void*)mk_fwd, hipFuncAttributeMaxDynamicSharedMemorySize, LDS_BYTES) != hipSuccess) { fprintf(stderr, "kernel_launch: hipFuncSetAttribute failed\n"); grid = -1; return; }
        if (hipOccupancyMaxActiveBlocksPerMultiprocessor(&per_cu, (const void*)mk_fwd, NW * 64, LDS_BYTES) != hipSuccess || per_cu < 1) { fprintf(stderr, "kernel_launch: occupancy query says %d\n", per_cu); }
        (void)hipGetLastError();
        grid = cus;
    }
    if (grid < 0) return;
    (void)hipMemsetAsync((char*)d_ws + WS_CTL, 0, 1 * MiB, stream);
    Args a{};
    const float** p = (const float**)&a.X;
    for (int i = 0; i < 21; ++i) p[i] = (const float*)d_in[i];
    a.X.out = (float*)d_out; a.X.ws = (unsigned char*)d_ws;
#if MK_PER_PHASE
    for (int ph = 0; ph < N_PHASES; ++ph) { a.ph_lo = ph; a.ph_hi = ph + 1; hipLaunchKernelGGL(mk_fwd, dim3(grid), dim3(NW * 64), LDS_BYTES, stream, a); }
#else
    a.ph_lo = 0; a.ph_hi = N_PHASES;
    hipLaunchKernelGGL(mk_fwd, dim3(grid), dim3(NW * 64), LDS_BYTES, stream, a);
#endif
}
```

```cpp
#include <hip/hip_runtime.h>
#include <cstdio>
#include <cstdint>

typedef unsigned short bf16_t;
typedef short bf16x8 __attribute__((ext_vector_type(8)));
typedef float f32x4 __attribute__((ext_vector_type(4)));
typedef float f32x2 __attribute__((ext_vector_type(2)));
typedef unsigned u32x4 __attribute__((ext_vector_type(4)));
typedef unsigned u32x2 __attribute__((ext_vector_type(2)));
#define LAS __attribute__((address_space(3)))

constexpr int D = 1024, BATCH = 32, SEQ = 2048, M = BATCH * SEQ;
constexpr int DIN = 3584;
constexpr int OFF_QNA = 0, OFF_KNA = 512, OFF_VNA = 1024, OFF_QR = 1536, OFF_KR = 2048, OFF_VR = 2560, OFF_GR = 3072;
constexpr int NE = 256, TOPK = 8, DE = 256;
constexpr int NSLOT = M * TOPK;
constexpr float LN_EPS = 1e-5f, GN_EPS = 1e-6f;
constexpr float ALPHA = 1.189207115002721f;
constexpr float YSCALE = 64.f, YINV = 1.f / 64.f;
constexpr float S_HF8 = 16.f, S_WGU8 = 256.f, S_ACT8 = 8.f, S_WD8 = 8.f;
constexpr float INV_GU8 = 1.f / (16.f * 256.f), INV_DN8 = 1.f / (8.f * 8.f);
static_assert(YSCALE * INV_DN8 == 1.f, "down-projection epilogue assumes no rescale");
constexpr float S_H8 = 16.f, S_WIN8 = 128.f, INV_IN8 = 1.f / (16.f * 128.f);
constexpr int MOD_SHIFT_A = 0, MOD_SCALE_A = 1024, MOD_GATE_A = 2048, MOD_SHIFT_F = 3072, MOD_SCALE_F = 4096, MOD_GATE_F = 5120;

constexpr size_t MiB = 1u << 20;
constexpr size_t WS_CTL = 0;
constexpr size_t WS_MOD = 1 * MiB;
constexpr size_t WS_ROPE = 2 * MiB;
constexpr size_t WS_WIN_T = 4 * MiB;
constexpr size_t WS_WOUT_T = 11 * MiB;
constexpr size_t WS_WR_T = 13 * MiB;
constexpr size_t WS_WSGU_T = 14 * MiB;
constexpr size_t WS_WSD_T = 15 * MiB;
constexpr size_t WS_SLOT_ENT = 16 * MiB;
constexpr size_t WS_SLOT_W = 18 * MiB;
constexpr size_t WS_TOPK_E = 20 * MiB;
constexpr size_t WS_TOPK_W = 22 * MiB;
constexpr size_t WS_STATS = 24 * MiB;
constexpr size_t WS_WD_T = 32 * MiB;
constexpr size_t WS_WGU_T = 160 * MiB;
constexpr size_t WS_HF8 = 288 * MiB;
constexpr size_t WS_YMIX = 416 * MiB;
constexpr size_t WS_PROJ = 544 * MiB;
constexpr size_t WS_LOGITS = WS_PROJ + 384 * MiB;
constexpr size_t WS_SHH = 352 * MiB;
constexpr size_t WS_HF = WS_PROJ, WS_ACT = WS_PROJ + 128 * MiB;
constexpr size_t WS_YBUF = WS_WGU_T;
constexpr size_t WS_TB = WS_PROJ + 256 * MiB;
constexpr size_t WS_YSH = WS_PROJ + 384 * MiB;
constexpr size_t WS_END = 992 * MiB;
constexpr int CW_COUNT = 1024, CW_CURSOR = 1536, CW_BAR = 8192;

constexpr int RING_BYTES = 131072;
constexpr int TAB_OFF = RING_BYTES;
constexpr int T_OFF = 0, T_TILE = 260, T_CNT = 520, T_HIST = 776, T_BASE = 1032, TAB_WORDS = 1288;
constexpr int VN_OFF = TAB_OFF + 6144;
constexpr int ROWTAB_OFF = VN_OFF + 8192;
constexpr int PHASE_BYTES = 155648;
constexpr int MISC_OFF = PHASE_BYTES;
constexpr int LDS_BYTES = PHASE_BYTES + 256;
static_assert(TAB_WORDS * 4 <= 6144 && ROWTAB_OFF + 6144 <= PHASE_BYTES && LDS_BYTES <= 163840, "LDS map");

__device__ __forceinline__ unsigned f2bf(float f) { unsigned u = __float_as_uint(f); return (u + 0x7fffu + ((u >> 16) & 1u)) >> 16; }
__device__ __forceinline__ float bf2f(unsigned short h) { return __uint_as_float(((unsigned)h) << 16); }
__device__ __forceinline__ unsigned pk2(float lo, float hi) { return f2bf(lo) | (f2bf(hi) << 16); }
__device__ __forceinline__ unsigned cvt_pk_bf16(float lo, float hi) { unsigned r; asm volatile("v_cvt_pk_bf16_f32 %0, %1, %2" : "=v"(r) : "v"(lo), "v"(hi)); return r; }
__device__ __forceinline__ float silu_f(float v) { return v * __builtin_amdgcn_rcpf(1.f + __expf(-v)); }
__device__ __forceinline__ float wave_sum(float v) {
    v += __builtin_bit_cast(float, __builtin_amdgcn_update_dpp(0, __builtin_bit_cast(int, v), 0xB1, 0xf, 0xf, true));
    v += __builtin_bit_cast(float, __builtin_amdgcn_update_dpp(0, __builtin_bit_cast(int, v), 0x4E, 0xf, 0xf, true));
    v += __builtin_bit_cast(float, __builtin_amdgcn_update_dpp(0, __builtin_bit_cast(int, v), 0x141, 0xf, 0xf, true));
    v += __builtin_bit_cast(float, __builtin_amdgcn_update_dpp(0, __builtin_bit_cast(int, v), 0x140, 0xf, 0xf, true));
    const int b = __builtin_bit_cast(int, v);
    return (__builtin_bit_cast(float, __builtin_amdgcn_readlane(b, 0)) + __builtin_bit_cast(float, __builtin_amdgcn_readlane(b, 16))) + (__builtin_bit_cast(float, __builtin_amdgcn_readlane(b, 32)) + __builtin_bit_cast(float, __builtin_amdgcn_readlane(b, 48)));
}
__device__ __forceinline__ float clamp8(float v) { return __builtin_amdgcn_fmed3f(v, -440.f, 440.f); }
#define LDS_WAIT() asm volatile("s_waitcnt lgkmcnt(0)" ::: "memory")
__device__ __forceinline__ int lane_id() { return (int)__builtin_amdgcn_mbcnt_hi(~0u, __builtin_amdgcn_mbcnt_lo(~0u, 0u)); }

#define XB_TMO      128
#define XB_XCNT(j)  (256  + 64 * (j))
#define XB_XSUB(j)  (1280 + 64 * (j))
#define XB_XGEN(j)  (2304 + 64 * (j))
#define XB_TOP      3328
#define XB_TOPGEN   3392
#define XCD_BAR_WORDS 3456
#define XB_SPIN_CAP (1u << 23)
__device__ __forceinline__ unsigned xb_ld(unsigned* p)              { return __hip_atomic_load(p, __ATOMIC_RELAXED, __HIP_MEMORY_SCOPE_AGENT); }
__device__ __forceinline__ unsigned xb_add(unsigned* p, unsigned v) { return __hip_atomic_fetch_add(p, v, __ATOMIC_RELAXED, __HIP_MEMORY_SCOPE_AGENT); }
__device__ __forceinline__ unsigned xb_xcc_id() { return (unsigned)__builtin_amdgcn_s_getreg((3 << 11) | 20) & 0xFu; }
#define XB_SPIN(cond, bar) do { unsigned _sp = 0; while (cond) { __builtin_amdgcn_s_sleep(1); \
    if ((++_sp & 255u) == 0u) { if (xb_ld(&(bar)[XB_TMO])) break; if (_sp > XB_SPIN_CAP) { atomicAdd(&(bar)[XB_TMO], 1u); break; } } } } while (0)
struct XcdBarrier { unsigned* bar; unsigned x; volatile LAS unsigned* st; };
__device__ __forceinline__ XcdBarrier xcd_barrier_post(unsigned* bar, volatile LAS unsigned* st, bool leader) {
    XcdBarrier b; b.bar = bar; b.x = xb_xcc_id(); b.st = st;
    if (leader) (void)xb_add(&bar[XB_XCNT(b.x)], 1u);
    return b;
}
__device__ __forceinline__ void xcd_barrier_complete(unsigned* bar, unsigned x, unsigned& nloc, unsigned& nx) {
    const unsigned G = gridDim.x * gridDim.y * gridDim.z;
    unsigned sum, cnt, mine, sp = 0u;
    for (;;) {
        sum = 0u; cnt = 0u; mine = 0u;
#pragma unroll
        for (unsigned j = 0; j < 16; ++j) { const unsigned c = xb_ld(&bar[XB_XCNT(j)]); sum += c; cnt += (c > 0u) ? 1u : 0u; mine = (j == x) ? c : mine; }
        if (sum == G) break;
        __builtin_amdgcn_s_sleep(1);
        if ((++sp & 255u) == 0u) { if (xb_ld(&bar[XB_TMO])) break; if (sp > XB_SPIN_CAP) { atomicAdd(&bar[XB_TMO], 1u); break; } }
    }
    nloc = mine > 0u ? mine : 1u; nx = cnt > 0u ? cnt : 1u;
}
__device__ __forceinline__ void xcd_barrier(const XcdBarrier& b, bool leader) {
    asm volatile("s_waitcnt vmcnt(0)" ::: "memory");
    __syncthreads();
    if (leader) {
        unsigned* bar = b.bar;
        __builtin_amdgcn_s_waitcnt(0);
        unsigned nloc = b.st[0], nx = b.st[1];
        if (nloc == 0u) { xcd_barrier_complete(bar, b.x, nloc, nx); b.st[0] = nloc; b.st[1] = nx; }
        const unsigned old = xb_add(&bar[XB_XSUB(b.x)], 1u);
        const unsigned gen = old / nloc;
        if (old + 1u == (gen + 1u) * nloc) {
            __builtin_amdgcn_fence(__ATOMIC_RELEASE, "agent");
            asm volatile("s_waitcnt vmcnt(0)" ::: "memory");
            const unsigned og = xb_add(&bar[XB_TOP], 1u);
            const unsigned tg = og / nx;
            if (og + 1u == (tg + 1u) * nx) xb_add(&bar[XB_TOPGEN], 1u);
            else XB_SPIN(xb_ld(&bar[XB_TOPGEN]) == tg, bar);
            __builtin_amdgcn_fence(__ATOMIC_ACQUIRE, "agent");
            xb_add(&bar[XB_XGEN(b.x)], 1u);
            asm volatile("s_waitcnt vmcnt(0)" ::: "memory");
        } else {
            XB_SPIN(xb_ld(&bar[XB_XGEN(b.x)]) == gen, bar);
            __builtin_amdgcn_fence(__ATOMIC_ACQUIRE, "agent");
            asm volatile("s_waitcnt vmcnt(0)" ::: "memory");
        }
    }
    __syncthreads();
}

namespace pg8 {
constexpr int BM = 256, BK = 64, HALF = 128, HTB = HALF * BK * 2, STAGE_BYTES = 8 * HTB;
__device__ __forceinline__ int lds_byte(int r, int c) { const int st = (r >> 4) * 2 + (c >> 5), rr = r & 15, cc = c & 31, ob = rr * 64 + cc * 2; return st * 1024 + (ob ^ (((ob >> 9) & 1) << 5)); }
__device__ __forceinline__ void stage_rc(int b, int& R, int& C) { const int st = b / 1024, sb = b % 1024, swz = sb ^ (((sb >> 9) & 1) << 5); R = (st >> 1) * 16 + swz / 64; C = (st & 1) * 32 + (swz % 64) / 2; }
__device__ __forceinline__ int perm32(int rho) { const int n = rho >> 4, i = rho & 15; return 8 * (i >> 2) + 4 * n + (i & 3); }

typedef int i32x8 __attribute__((ext_vector_type(8)));
__device__ __forceinline__ i32x8 cat8(const bf16x8 lo, const bf16x8 hi) { const u32x4 a = __builtin_bit_cast(u32x4, lo), b = __builtin_bit_cast(u32x4, hi); return (i32x8){(int)a.x, (int)a.y, (int)a.z, (int)a.w, (int)b.x, (int)b.y, (int)b.z, (int)b.w}; }
struct Unit { int pm, pn; const char* B; int e, cnt, off; };

template <int ESZ = 2, bool AREUSE = false, class Epi, class Sched>
__device__ __forceinline__ void gemm_phase(LAS unsigned char* lds, const char* Abase, const int K, const Sched& S, const Epi& E, const int tid_in) {
    int tid_ = tid_in; asm volatile("" : "+v"(tid_));
    const int tid = tid_, wid = __builtin_amdgcn_readfirstlane(tid >> 6), lane = tid & 63, wr = wid >> 2, wc = wid & 3, fr = lane & 15, fq = lane >> 4;
    const int rowbytes = K * ESZ, nt = rowbytes / 128;
    int Rr[2], Cc[2]; unsigned voffB[2], voffA[2];
#pragma unroll
    for (int i = 0; i < 2; ++i) { int R, C; stage_rc(tid * 16 + i * 8192, R, C); Rr[i] = R; Cc[i] = C; const int Rb = Epi::PERM ? (64 * (R >> 5) + 16 * ((R >> 2) & 3) + 4 * ((R >> 4) & 1) + (R & 3)) : R; voffB[i] = (unsigned)(Rb * rowbytes + C * 2); voffA[i] = (unsigned)(R * rowbytes + C * 2); }
    constexpr bool GATHER = Sched::GATHER;
    const size_t kstep = (size_t)128;
    const size_t hstep = (size_t)HALF * rowbytes;
    const size_t bhstep = (size_t)(Epi::PERM ? 8 : HALF) * rowbytes;
    const unsigned ldsw = (unsigned)wid * 1024u;
    const int aoff = lds_byte(wr * 64 + fr, fq * 8);
    const int boff = lds_byte(wc * 32 + fr, fq * 8);
#define PG8_SA(b, h) (((b) * 2 + (h)) * HTB)
#define PG8_SB(b, h) ((4 + (b) * 2 + (h)) * HTB)
#define PG8_STAGE(bufoff, gbase, voff) do { _Pragma("unroll") for (int _i = 0; _i < 2; ++_i) \
        __builtin_amdgcn_global_load_lds((const unsigned*)((const char*)(gbase) + (voff)[_i]), (LAS unsigned*)(lds + (bufoff) + ldsw + _i * 8192), 16, 0, 0); } while (0)
#define PG8_STAGEA(bufoff, uptr, koff, NEXT, h) do { if constexpr (GATHER) { if (NEXT) { const u32x2 _t = *(const LAS u32x2*)(vnslot + 2 * (h)); unsigned _v[2] = {_t.x, _t.y}; PG8_STAGE(bufoff, Abase + (koff), _v); } else { PG8_STAGE(bufoff, Abase + (koff), vc[h]); } } \
        else { PG8_STAGE(bufoff, (uptr) + (size_t)(h) * hstep + (koff), voffA); } } while (0)
#define PG8_LDA(dst, b, h) do { _Pragma("unroll") for (int m = 0; m < 4; ++m) { if constexpr (ESZ == 2) { _Pragma("unroll") for (int k = 0; k < 2; ++k) dst[m].q[k] = *(const LAS bf16x8*)(lds + PG8_SA(b, h) + aoff + m * 2048 + k * 1024); } \
        else dst[m].w = cat8(*(const LAS bf16x8*)(lds + PG8_SA(b, h) + aoff + m * 2048), *(const LAS bf16x8*)(lds + PG8_SA(b, h) + aoff + m * 2048 + 1024)); } } while (0)
#define PG8_LDB(dst, b, h) do { _Pragma("unroll") for (int n = 0; n < 2; ++n) { if constexpr (ESZ == 2) { _Pragma("unroll") for (int k = 0; k < 2; ++k) dst[n].q[k] = *(const LAS bf16x8*)(lds + PG8_SB(b, h) + boff + n * 2048 + k * 1024); } \
        else dst[n].w = cat8(*(const LAS bf16x8*)(lds + PG8_SB(b, h) + boff + n * 2048), *(const LAS bf16x8*)(lds + PG8_SB(b, h) + boff + n * 2048 + 1024)); } } while (0)
#define PG8_MMA(ai, bj, At, Bt) do { __builtin_amdgcn_s_setprio(1); _Pragma("unroll") for (int m = 0; m < 4; ++m) _Pragma("unroll") for (int n = 0; n < 2; ++n) { \
        if constexpr (ESZ == 2) { _Pragma("unroll") for (int k = 0; k < 2; ++k) acc[ai][bj][m][n] = __builtin_amdgcn_mfma_f32_16x16x32_bf16(Bt[n].q[k], At[m].q[k], acc[ai][bj][m][n], 0, 0, 0); } \
        else { asm volatile("v_mfma_f32_16x16x128_f8f6f4 %0, %1, %2, %0" : "+v"(acc[ai][bj][m][n]) : "v"(Bt[n].w), "v"(At[m].w)); } } \
        __builtin_amdgcn_s_setprio(0); } while (0)
#define PG8_WAIT_V(n) asm volatile("s_waitcnt vmcnt(" #n ")" ::: "memory")
#define PG8_WAIT_L(n) asm volatile("s_waitcnt lgkmcnt(" #n ")" ::: "memory")
#define PG8_BAR __builtin_amdgcn_s_barrier()
#define PG8_SCHED __builtin_amdgcn_sched_barrier(0)
    Unit cur, nxt; int ui = 0; bool fresh_cur = true;
    if (!S.next(0, cur)) return;
    f32x4 acc[2][2][4][2];
    union Frag { bf16x8 q[2]; i32x8 w; };
    Frag At[4], B0[2], B1[2];
    unsigned vc[2][2];
    LAS unsigned* vnslot = (LAS unsigned*)(lds + (VN_OFF - 0)) + tid * 4;
    if constexpr (GATHER) S.avoff(cur, Rr, Cc, vc, tid);
    LAS unsigned* rowtab = (LAS unsigned*)(lds + ROWTAB_OFF);
    if constexpr (GATHER) S.rowtab(cur, rowtab, tid);
    const char* cB = cur.B; const char* cA = Abase + S.aoff(cur);
    PG8_STAGE(PG8_SB(0, 0), cB, voffB); PG8_STAGE(PG8_SB(0, 1), cB + bhstep, voffB); PG8_STAGEA(PG8_SA(0, 0), cA, 0, false, 0); PG8_STAGEA(PG8_SA(0, 1), cA, 0, false, 1);
    if (wr == 1) PG8_BAR;
    PG8_WAIT_V(2); PG8_BAR;
    PG8_STAGE(PG8_SB(1, 0), cB + kstep, voffB); PG8_STAGEA(PG8_SA(1, 0), cA, kstep, false, 0); PG8_STAGE(PG8_SB(1, 1), cB + bhstep + kstep, voffB);
    PG8_WAIT_V(6); PG8_BAR;
    asm volatile("" ::: "memory");
#pragma unroll
    for (int a = 0; a < 2; ++a)
#pragma unroll
        for (int b = 0; b < 2; ++b)
#pragma unroll
            for (int m = 0; m < 4; ++m)
#pragma unroll
                for (int n = 0; n < 2; ++n) { acc[a][b][m][n] = (f32x4){0.f, 0.f, 0.f, 0.f}; asm volatile("" : "+v"(acc[a][b][m][n])); }
    asm volatile("s_nop 4" ::: "memory");
    for (;;) {
        const bool has_next = S.next(ui + 1, nxt);
        if constexpr (GATHER) {
            unsigned vn[2][2];
            if (has_next) S.avoff(nxt, Rr, Cc, vn, tid);
            else {
#pragma unroll
                for (int h = 0; h < 2; ++h)
#pragma unroll
                    for (int i = 0; i < 2; ++i) vn[h][i] = vc[h][i];
            }
            *(LAS u32x4*)vnslot = (u32x4){vn[0][0], vn[0][1], vn[1][0], vn[1][1]};
            if (has_next) S.rowtab(nxt, rowtab + 512 * ((ui + 1) % 3), tid);
        }
        const char* nB = has_next ? nxt.B : cB; const char* nA = has_next ? Abase + S.aoff(nxt) : cA;
        const bool fresh_nxt = !(AREUSE && has_next && nxt.e == cur.e && nxt.pm == cur.pm);
        const bool ff = fresh_cur && fresh_nxt;
#define PG8_WAITX do { if (!AREUSE || ff) PG8_WAIT_V(8); else PG8_WAIT_V(4); } while (0)
        for (int t = 0; t < nt; t += 2) {
            const bool last = (t == nt - 2);
            const size_t k1 = (size_t)(t + 1) * kstep;
            const size_t k2 = last ? (size_t)0 : (size_t)(t + 2) * kstep, k3 = k2 + kstep;
            const char* u2 = last ? nA : cA; const char* b2 = last ? nB : cB + (size_t)(t + 2) * kstep;
            const char* b3 = b2 + kstep;
            PG8_LDB(B0, 0, 0); PG8_LDB(B1, 0, 1); PG8_SCHED; PG8_LDA(At, 0, 0); if (!AREUSE || fresh_cur) PG8_STAGEA(PG8_SA(1, 1), cA, k1, false, 1);
            PG8_WAITX; PG8_WAIT_L(0); PG8_BAR; PG8_MMA(0, 0, At, B0); PG8_MMA(0, 1, At, B1); PG8_BAR; PG8_SCHED;
            PG8_LDA(At, 0, 1); PG8_STAGE(PG8_SB(0, 0), b2, voffB); PG8_STAGE(PG8_SB(0, 1), b2 + bhstep, voffB); if (!AREUSE || fresh_nxt) PG8_STAGEA(PG8_SA(0, 0), u2, k2, last, 0);
            PG8_WAITX; PG8_WAIT_L(0); PG8_BAR; PG8_MMA(1, 0, At, B0); PG8_MMA(1, 1, At, B1); PG8_BAR; PG8_SCHED;
            PG8_LDB(B0, 1, 0); PG8_LDB(B1, 1, 1); PG8_SCHED; PG8_LDA(At, 1, 0); if (!AREUSE || fresh_nxt) PG8_STAGEA(PG8_SA(0, 1), u2, k2, last, 1);
            PG8_WAITX; PG8_WAIT_L(0); PG8_BAR; PG8_MMA(0, 0, At, B0); PG8_MMA(0, 1, At, B1); PG8_BAR; PG8_SCHED;
            PG8_LDA(At, 1, 1); PG8_STAGE(PG8_SB(1, 0), b3, voffB); PG8_STAGE(PG8_SB(1, 1), b3 + bhstep, voffB); if (!AREUSE || fresh_nxt) PG8_STAGEA(PG8_SA(1, 0), u2, k3, last, 0);
            PG8_WAITX; PG8_WAIT_L(0); PG8_BAR; PG8_MMA(1, 0, At, B0); PG8_MMA(1, 1, At, B1); PG8_BAR; PG8_SCHED;
        }
#undef PG8_WAITX
        if (wr == 0) PG8_BAR;
        if constexpr (ESZ == 1) {
            asm volatile("s_nop 15\n\ts_nop 15" ::: "memory");
#pragma unroll
            for (int a = 0; a < 2; ++a)
#pragma unroll
                for (int b = 0; b < 2; ++b)
#pragma unroll
                    for (int m = 0; m < 4; ++m) asm volatile("" : "+v"(acc[a][b][m][0]), "+v"(acc[a][b][m][1]));
        }
        { const int l2 = lane_id(); E(acc, cur, wr, wc, l2 & 15, l2 >> 4, rowtab + 512 * (ui % 3)); }
        if (!has_next) break;
#pragma unroll
        for (int a = 0; a < 2; ++a)
#pragma unroll
            for (int b = 0; b < 2; ++b)
#pragma unroll
                for (int m = 0; m < 4; ++m)
#pragma unroll
                    for (int n = 0; n < 2; ++n) acc[a][b][m][n] = (f32x4){0.f, 0.f, 0.f, 0.f};
        cur = nxt; cB = nB; cA = nA; ++ui; fresh_cur = fresh_nxt;
        if constexpr (GATHER) { const u32x4 _t = *(const LAS u32x4*)vnslot; vc[0][0] = _t.x; vc[0][1] = _t.y; vc[1][0] = _t.z; vc[1][1] = _t.w; }
        if (wr == 1) PG8_BAR;
    }
    PG8_WAIT_V(0);
    PG8_BAR;
#undef PG8_SA
#undef PG8_SB
#undef PG8_STAGE
#undef PG8_STAGEA
#undef PG8_LDA
#undef PG8_LDB
#undef PG8_MMA
#undef PG8_WAIT_V
#undef PG8_WAIT_L
#undef PG8_BAR
#undef PG8_SCHED
}

struct DenseOrder {
    int nM, nN, nwg, G, c, K; const char* Bt;
    __device__ __forceinline__ void init(int Mrows, int N, int K_, const void* Bt_, int G_, int c_) { nM = Mrows / BM; nN = N / BM; nwg = nM * nN; G = G_; c = c_; K = K_; Bt = (const char*)Bt_; }
    __device__ __forceinline__ bool next(int i, Unit& u) const {
        const long L = (long)i * G + c; if (L >= nwg) return false;
        int wgid = (int)L; { const int q = nwg / 8, r = nwg % 8, xcd = wgid % 8, off = wgid / 8; wgid = (xcd < r ? xcd * (q + 1) : r * (q + 1) + (xcd - r) * q) + off; }
        const int nig = 8 * nN, gid = wgid / nig, fm = gid * 8, gsz = (nM - fm) < 8 ? (nM - fm) : 8;
        u.pm = fm + ((wgid % nig) % gsz); u.pn = (wgid % nig) / gsz; u.B = Bt + (size_t)u.pn * BM * K * 2; u.e = 0; u.cnt = 0; u.off = 0; return true;
    }
    static constexpr bool GATHER = false;
    __device__ __forceinline__ size_t aoff(const Unit& u) const { return (size_t)u.pm * BM * K * 2; }
    __device__ __forceinline__ void avoff(const Unit&, const int (&)[2], const int (&)[2], unsigned (&)[2][2], int) const {}
};
struct RowOrder {
    int pm, ncol, K; const char* Bt;
    static constexpr bool GATHER = false;
    __device__ __forceinline__ bool next(int i, Unit& u) const { if (i >= ncol) return false; u.pm = pm; u.pn = i; u.B = Bt + (size_t)i * BM * K * 2; u.e = 0; u.cnt = 0; u.off = 0; return true; }
    __device__ __forceinline__ size_t aoff(const Unit& u) const { return (size_t)u.pm * BM * K * 2; }
    __device__ __forceinline__ void avoff(const Unit&, const int (&)[2], const int (&)[2], unsigned (&)[2][2], int) const {}
};
template <int NCOL, bool TOKROWS, bool TILEMAJOR = false> struct ExpertOrder {
    static constexpr bool GATHER = true;
    __device__ __forceinline__ size_t aoff(const Unit&) const { return 0; }
    const LAS unsigned* tab; int per, c, K  ; const char* W; size_t wstride; const int* slot_ent; const float* slot_w;
    mutable int ehint = 0;
    int xbase, xend, xstride, xlb;
    __device__ __forceinline__ void init(const LAS unsigned* tab_, int K_, const void* W_, size_t wstride_, const int* slot_ent_, const float* slot_w_, int G, int c_) {
        tab = tab_; K = K_; W = (const char*)W_; wstride = wstride_; slot_ent = slot_ent_; slot_w = slot_w_; c = c_;
        const int U = (int)tab[T_TILE + NE] * (TILEMAJOR ? 1 : NCOL); per = (U + G - 1) / G;
        if (G % 8 == 0) { const int x = c_ % 8; const int q = U / 8, r = U % 8; xbase = x * q + (x < r ? x : r); xend = xbase + q + (x < r ? 1 : 0); xstride = G / 8; xlb = c_ / 8; }
        else { xbase = 0; xend = U; xstride = G; xlb = c_; }
    }
    __device__ __forceinline__ bool next(int i, Unit& u) const {
        const int L = TILEMAJOR ? xbase + (i / NCOL) * xstride + xlb : xbase + i * xstride + xlb;
        if (L >= xend) return false;
        const int tile = TILEMAJOR ? L : L / NCOL; u.pn = TILEMAJOR ? i % NCOL : L % NCOL;
        int lo = ehint;
        if (i == 0) { lo = 0; int hi = NE - 1; while (lo < hi) { const int mid = (lo + hi + 1) >> 1; if ((int)tab[T_TILE + mid] <= tile) lo = mid; else hi = mid - 1; } }
        else { while (lo < NE - 1 && (int)tab[T_TILE + lo + 1] <= tile) ++lo; }
        ehint = lo;
        u.e = lo; u.pm = tile - (int)tab[T_TILE + lo]; u.cnt = (int)tab[T_CNT + lo]; u.off = (int)tab[T_OFF + lo];
        u.B = W + (size_t)lo * wstride + (size_t)u.pn * BM * K; return true;
    }
    __device__ __forceinline__ void rowtab(const Unit& u, LAS unsigned* t, int tid) const {
        if (tid < BM) { int r = u.pm * BM + tid; if (r >= u.cnt) r = u.cnt - 1; t[tid] = (unsigned)slot_ent[u.off + r]; t[BM + tid] = __float_as_uint(slot_w[u.off + r]); }
    }
    __device__ __forceinline__ void avoff(const Unit& u, const int (&)[2], const int (&)[2], unsigned (&v)[2][2], int tidq) const {
        int R[2], C[2]; asm volatile("" : "+v"(tidq));
#pragma unroll
        for (int i = 0; i < 2; ++i) stage_rc(tidq * 16 + i * 8192, R[i], C[i]);
#pragma unroll
        for (int h = 0; h < 2; ++h)
#pragma unroll
            for (int i = 0; i < 2; ++i) {
                int r = u.pm * BM + h * HALF + R[i]; if (r >= u.cnt) r = u.cnt - 1;
                const int slot = u.off + r;
                const int row = TOKROWS ? (slot_ent[slot] >> 3) : slot;
                v[h][i] = (unsigned)(row * K + C[i] * 2);
            }
    }
};

struct EpiInProj {
    static constexpr bool PERM = true; bf16_t* O;
    __device__ __forceinline__ void operator()(const f32x4 (&acc)[2][2][4][2], const Unit& u, int wr, int wc, int fr, int fq, const LAS unsigned* rt) const {
        const float sc = INV_IN8 * ((u.pn < 2) ? 0.125f : ((u.pn == 8 || u.pn == 9) ? 0.08838834764831845f : 1.f));
        const int row0 = u.pm * BM + wr * 64 + fr, col0 = u.pn * BM + wc * 64 + 16 * fq;
#pragma unroll
        for (int ai = 0; ai < 2; ++ai)
#pragma unroll
            for (int m = 0; m < 4; ++m) { bf16_t* rowp = O + (size_t)(row0 + ai * HALF + m * 16) * DIN + col0;
#pragma unroll
                for (int bj = 0; bj < 2; ++bj) { const f32x4 v0 = acc[ai][bj][m][0] * sc, v1 = acc[ai][bj][m][1] * sc;
                    u32x4 w; w.x = cvt_pk_bf16(v0[0], v0[1]); w.y = cvt_pk_bf16(v0[2], v0[3]); w.z = cvt_pk_bf16(v1[0], v1[1]); w.w = cvt_pk_bf16(v1[2], v1[3]);
                    *(u32x4*)(rowp + 8 * bj) = w; } }
    }
};
struct EpiOutProj {
    static constexpr bool PERM = true; const float* x; const float* mod; bf16_t* tb;
    __device__ __forceinline__ void operator()(const f32x4 (&acc)[2][2][4][2], const Unit& u, int wr, int wc, int fr, int fq, const LAS unsigned* rt) const {
        const int b = (u.pm * BM) >> 11; const int col0 = u.pn * BM + wc * 64 + 16 * fq;
        f32x4 g[2][2];
#pragma unroll
        for (int bj = 0; bj < 2; ++bj)
#pragma unroll
            for (int n = 0; n < 2; ++n) g[bj][n] = *(const f32x4*)(mod + b * 6144 + MOD_GATE_A + col0 + 8 * bj + 4 * n) * INV_IN8;
#pragma unroll
        for (int ai = 0; ai < 2; ++ai)
#pragma unroll
            for (int m = 0; m < 4; ++m) { const size_t o = (size_t)(u.pm * BM + ai * HALF + wr * 64 + m * 16 + fr) * D + col0;
                const f32x4 x0 = *(const f32x4*)(x + o), x1 = *(const f32x4*)(x + o + 4), x2 = *(const f32x4*)(x + o + 8), x3 = *(const f32x4*)(x + o + 12);
                const f32x4 xs[2][2] = {{x0, x1}, {x2, x3}};
#pragma unroll
                for (int bj = 0; bj < 2; ++bj) {
                    const f32x4 t0 = xs[bj][0] * ALPHA + g[bj][0] * acc[ai][bj][m][0], t1 = xs[bj][1] * ALPHA + g[bj][1] * acc[ai][bj][m][1];
                    u32x4 w; w.x = cvt_pk_bf16(t0[0], t0[1]); w.y = cvt_pk_bf16(t0[2], t0[3]); w.z = cvt_pk_bf16(t1[0], t1[1]); w.w = cvt_pk_bf16(t1[2], t1[3]);
                    *(u32x4*)(tb + o + 8 * bj) = w; } }
    }
};
struct EpiRouter {
    static constexpr bool PERM = false; float* out;
    __device__ __forceinline__ void operator()(const f32x4 (&acc)[2][2][4][2], const Unit& u, int wr, int wc, int fr, int fq, const LAS unsigned* rt) const {
        const int col0 = wc * 32 + 4 * fq;
        float* tp = out + (size_t)u.pm * (BM * NE);
#pragma unroll
        for (int ai = 0; ai < 2; ++ai)
#pragma unroll
            for (int m = 0; m < 4; ++m) { const int rl = ai * HALF + wr * 64 + m * 16 + fr;
#pragma unroll
                for (int bj = 0; bj < 2; ++bj)
#pragma unroll
                    for (int n = 0; n < 2; ++n)
#pragma unroll
                        for (int j = 0; j < 4; ++j) tp[(size_t)(col0 + bj * HALF + n * 16 + j) * BM + rl] = 1.f / (1.f + __expf(-acc[ai][bj][m][n][j])); }
    }
};
template <bool EXPERT, bool F8IN = EXPERT> struct EpiGU {
    static constexpr bool PERM = true; void* Ov;
    __device__ __forceinline__ void operator()(const f32x4 (&acc)[2][2][4][2], const Unit& u, int wr, int wc, int fr, int fq, const LAS unsigned* rt) const {
        const int h0 = u.pn * HALF + wc * 32 + 8 * fq;
#pragma unroll
        for (int ai = 0; ai < 2; ++ai)
#pragma unroll
            for (int m = 0; m < 4; ++m) {
                const int rtw = u.pm * BM + ai * HALF + wr * 64 + m * 16 + fr;
                if (EXPERT) { if (rtw >= u.cnt) continue; }
                const float w = EXPERT ? __uint_as_float(rt[BM + ai * HALF + wr * 64 + m * 16 + fr]) * (S_ACT8 * INV_GU8) : (F8IN ? INV_GU8 : 1.f);
                const float gs = F8IN ? INV_GU8 : 1.f;
                const f32x4 g0 = acc[ai][0][m][0] * gs, g1 = acc[ai][0][m][1] * gs, u0 = acc[ai][1][m][0], u1 = acc[ai][1][m][1];
                const float h[8] = {w * silu_f(g0[0]) * u0[0], w * silu_f(g0[1]) * u0[1], w * silu_f(g0[2]) * u0[2], w * silu_f(g0[3]) * u0[3],
                                    w * silu_f(g1[0]) * u1[0], w * silu_f(g1[1]) * u1[1], w * silu_f(g1[2]) * u1[2], w * silu_f(g1[3]) * u1[3]};
                if (EXPERT) {
                    int w0 = __builtin_amdgcn_cvt_pk_fp8_f32(clamp8(h[0]), clamp8(h[1]), 0, false); w0 = __builtin_amdgcn_cvt_pk_fp8_f32(clamp8(h[2]), clamp8(h[3]), w0, true);
                    int w1 = __builtin_amdgcn_cvt_pk_fp8_f32(clamp8(h[4]), clamp8(h[5]), 0, false); w1 = __builtin_amdgcn_cvt_pk_fp8_f32(clamp8(h[6]), clamp8(h[7]), w1, true);
                    u32x2 o; o.x = (unsigned)w0; o.y = (unsigned)w1; *(u32x2*)((unsigned char*)Ov + (size_t)(u.off + rtw) * DE + h0) = o;
                    asm volatile("" ::: "memory");
                } else {
                    u32x4 o; o.x = cvt_pk_bf16(h[0], h[1]); o.y = cvt_pk_bf16(h[2], h[3]); o.z = cvt_pk_bf16(h[4], h[5]); o.w = cvt_pk_bf16(h[6], h[7]);
                    *(u32x4*)((bf16_t*)Ov + (size_t)rtw * DE + h0) = o;
                }
            }
    }
};
struct EpiSharedDown {
    static constexpr bool PERM = true; unsigned char* ysh;
    __device__ __forceinline__ void operator()(const f32x4 (&acc)[2][2][4][2], const Unit& u, int wr, int wc, int fr, int fq, const LAS unsigned* rt) const {
        const int col0 = u.pn * BM + wc * 64 + 16 * fq;
#pragma unroll
        for (int ai = 0; ai < 2; ++ai)
#pragma unroll
            for (int m = 0; m < 4; ++m) {
                u32x4 o;
#pragma unroll
                for (int bj = 0; bj < 2; ++bj) { const f32x4 v0 = acc[ai][bj][m][0] * YSCALE, v1 = acc[ai][bj][m][1] * YSCALE;
                    int w0 = __builtin_amdgcn_cvt_pk_fp8_f32(clamp8(v0[0]), clamp8(v0[1]), 0, false); w0 = __builtin_amdgcn_cvt_pk_fp8_f32(clamp8(v0[2]), clamp8(v0[3]), w0, true);
                    int w1 = __builtin_amdgcn_cvt_pk_fp8_f32(clamp8(v1[0]), clamp8(v1[1]), 0, false); w1 = __builtin_amdgcn_cvt_pk_fp8_f32(clamp8(v1[2]), clamp8(v1[3]), w1, true);
                    if (bj == 0) { o.x = (unsigned)w0; o.y = (unsigned)w1; } else { o.z = (unsigned)w0; o.w = (unsigned)w1; } }
                *(u32x4*)(ysh + (size_t)(u.pm * BM + ai * HALF + wr * 64 + m * 16 + fr) * D + col0) = o;
            }
    }
};
struct EpiExpDown {
    static constexpr bool PERM = true; unsigned char* ybuf; const int* slot_ent;
    __device__ __forceinline__ void operator()(const f32x4 (&acc)[2][2][4][2], const Unit& u, int wr, int wc, int fr, int fq, const LAS unsigned* rt) const {
        const int col0 = u.pn * BM + wc * 64 + 16 * fq;
#pragma unroll
        for (int ai = 0; ai < 2; ++ai)
#pragma unroll
            for (int m = 0; m < 4; ++m) {
                const int rtw = u.pm * BM + ai * HALF + wr * 64 + m * 16 + fr; if (rtw >= u.cnt) continue;
                u32x4 o;
#pragma unroll
                for (int bj = 0; bj < 2; ++bj) { const f32x4 v0 = acc[ai][bj][m][0] * (YSCALE * INV_DN8), v1 = acc[ai][bj][m][1] * (YSCALE * INV_DN8);
                    int w0 = __builtin_amdgcn_cvt_pk_fp8_f32(clamp8(v0[0]), clamp8(v0[1]), 0, false); w0 = __builtin_amdgcn_cvt_pk_fp8_f32(clamp8(v0[2]), clamp8(v0[3]), w0, true);
                    int w1 = __builtin_amdgcn_cvt_pk_fp8_f32(clamp8(v1[0]), clamp8(v1[1]), 0, false); w1 = __builtin_amdgcn_cvt_pk_fp8_f32(clamp8(v1[2]), clamp8(v1[3]), w1, true);
                    if (bj == 0) { o.x = (unsigned)w0; o.y = (unsigned)w1; } else { o.z = (unsigned)w0; o.w = (unsigned)w1; } }
                *(u32x4*)(ybuf + (size_t)rt[ai * HALF + wr * 64 + m * 16 + fr] * D + col0) = o;
                asm volatile("" ::: "memory");
            }
    }
};

template <int PMODE = 0, class Sched> __device__ __forceinline__ void down_phase(LAS unsigned char* lds, const char* act8, const Sched& S, unsigned char* ybuf, const int tid_in) {
    int tid_ = tid_in; asm volatile("" : "+v"(tid_));
    const int tid = tid_, wid = __builtin_amdgcn_readfirstlane(tid >> 6), lane = tid & 63, wr = wid >> 2, wc = wid & 3, fr = lane & 15, fq = lane >> 4;
    constexpr int RB = DE;
    int Rr[2]; unsigned voffB[2], cc2[2];
#pragma unroll
    for (int i = 0; i < 2; ++i) { int R, C; stage_rc(tid * 16 + i * 8192, R, C); Rr[i] = R; cc2[i] = (unsigned)(C * 2); const int Rb = (R & ~31) + perm32(R & 31); voffB[i] = (unsigned)(Rb * RB + C * 2); }
    const unsigned ldsw = (unsigned)wid * 1024u;
    const int aoff = lds_byte(wr * 64 + fr, fq * 8), boff = lds_byte(wc * 32 + fr, fq * 8);
#define DN_SA(k, h) (((k) * 2 + (h)) * HTB)
#define DN_SB(z, k) (65536 + ((z) * 2 + (k)) * HTB)
#define DN_STAGE(bufoff, gbase, voff) do { _Pragma("unroll") for (int _i = 0; _i < 2; ++_i) \
        __builtin_amdgcn_global_load_lds((const unsigned*)((const char*)(gbase) + (voff)[_i]), (LAS unsigned*)(lds + (bufoff) + ldsw + _i * 8192), 16, 0, 0); } while (0)
    LAS unsigned* rowtab = (LAS unsigned*)(lds + ROWTAB_OFF);
    Unit cur, nxt; int ti = 0;
    if (!S.next(0, cur)) return;
#define DN_STAGE_A(u) do { unsigned _va[2][2]; _Pragma("unroll") for (int _h = 0; _h < 2; ++_h) _Pragma("unroll") for (int _i = 0; _i < 2; ++_i) { int _r = (u).pm * BM + _h * HALF + Rr[_i]; if (_r >= (u).cnt) _r = (u).cnt - 1; _va[_h][_i] = (unsigned)(((u).off + _r) * RB) + cc2[_i]; } \
        _Pragma("unroll") for (int _k = 0; _k < 2; ++_k) _Pragma("unroll") for (int _h = 0; _h < 2; ++_h) DN_STAGE(DN_SA(_k, _h), act8 + _k * 128, _va[_h]); } while (0)
#define DN_STAGE_B(u, s_, z_) do { const char* _b = (u).B + (size_t)(s_) * (HALF * RB); _Pragma("unroll") for (int _k = 0; _k < 2; ++_k) DN_STAGE(DN_SB(z_, _k), _b + _k * 128, voffB); } while (0)
#define DN_ROWTAB(u, par) do { if (tid < BM) { int _r = (u).pm * BM + tid; if (_r >= (u).cnt) _r = (u).cnt - 1; rowtab[(par) * BM + tid] = (PMODE == 1) ? (unsigned)((u).off + _r) : (unsigned)S.slot_ent[(u).off + _r]; } } while (0)
    DN_STAGE_A(cur); DN_ROWTAB(cur, 0); DN_STAGE_B(cur, 0, 0);
    f32x4 acc[2][2][4][2];
    union Frag { bf16x8 q[2]; i32x8 w; };
    int gs = 0;
    Unit prev = cur; int prev_s = -1, prev_par = 0;
#define DN_EPILOGUE(set, u, s_, par) do { const int _col0 = (s_) * HALF + wc * 32 + 8 * fq; \
        _Pragma("unroll") for (int _ai = 0; _ai < 2; ++_ai) _Pragma("unroll") for (int _m = 0; _m < 4; ++_m) { const int _rt = _ai * HALF + wr * 64 + _m * 16 + fr; \
            { const f32x4 _v0 = acc[set][_ai][_m][0] * (YSCALE * INV_DN8), _v1 = acc[set][_ai][_m][1] * (YSCALE * INV_DN8);   \
                int _w0 = __builtin_amdgcn_cvt_pk_fp8_f32(clamp8(_v0[0]), clamp8(_v0[1]), 0, false); _w0 = __builtin_amdgcn_cvt_pk_fp8_f32(clamp8(_v0[2]), clamp8(_v0[3]), _w0, true); \
                int _w1 = __builtin_amdgcn_cvt_pk_fp8_f32(clamp8(_v1[0]), clamp8(_v1[1]), 0, false); _w1 = __builtin_amdgcn_cvt_pk_fp8_f32(clamp8(_v1[2]), clamp8(_v1[3]), _w1, true); \
                u32x2 _o; _o.x = (unsigned)_w0; _o.y = (unsigned)_w1; if (PMODE != 2 || (_w0 == 0x12345678 && _w1 == 0x31415926)) *(u32x2*)(ybuf + (size_t)rowtab[(par) * BM + _rt] * D + _col0) = _o; } } } while (0)
    for (;;) {
        const bool has_next = S.next(ti + 1, nxt);
        const int par = ti & 1;
#pragma unroll 1
        for (int s2 = 0; s2 < 8; s2 += 2) {
#pragma unroll
            for (int sb = 0; sb < 2; ++sb) {
                const int s = s2 + sb; const int z = sb;
                if (s == 0) asm volatile("s_waitcnt vmcnt(0)" ::: "memory");
                else if (PMODE == 2) asm volatile("s_waitcnt vmcnt(0)" ::: "memory");
                else asm volatile("s_waitcnt vmcnt(8)" ::: "memory");
                __builtin_amdgcn_s_barrier();
                asm volatile("" ::: "memory");
                if (s < 7) DN_STAGE_B(cur, s + 1, z ^ 1); else if (has_next) DN_STAGE_B(nxt, 0, z ^ 1);
                if (wr == 1 && prev_s >= 0) { asm volatile("s_nop 15" ::: "memory"); DN_EPILOGUE(sb ^ 1, prev, prev_s, prev_par); }
#pragma unroll
                for (int ai = 0; ai < 2; ++ai)
#pragma unroll
                    for (int m = 0; m < 4; ++m)
#pragma unroll
                        for (int n = 0; n < 2; ++n) acc[sb][ai][m][n] = (f32x4){0.f, 0.f, 0.f, 0.f};
                asm volatile("s_nop 4" ::: "memory");
#pragma unroll
                for (int k = 0; k < 2; ++k) {
                    Frag Bf[2];
#pragma unroll
                    for (int n = 0; n < 2; ++n) Bf[n].w = cat8(*(const LAS bf16x8*)(lds + DN_SB(z, k) + boff + n * 2048), *(const LAS bf16x8*)(lds + DN_SB(z, k) + boff + n * 2048 + 1024));
#pragma unroll
                    for (int ai = 0; ai < 2; ++ai) {
                        Frag Af[4];
#pragma unroll
                        for (int m = 0; m < 4; ++m) Af[m].w = cat8(*(const LAS bf16x8*)(lds + DN_SA(k, ai) + aoff + m * 2048), *(const LAS bf16x8*)(lds + DN_SA(k, ai) + aoff + m * 2048 + 1024));
#pragma unroll
                        for (int m = 0; m < 4; ++m)
#pragma unroll
                            for (int n = 0; n < 2; ++n) asm volatile("v_mfma_f32_16x16x128_f8f6f4 %0, %1, %2, %0" : "+v"(acc[sb][ai][m][n]) : "v"(Bf[n].w), "v"(Af[m].w));
                    }
                }
                if (wr == 0 && prev_s >= 0) DN_EPILOGUE(sb ^ 1, prev, prev_s, prev_par);
                prev = cur; prev_s = s; prev_par = par;
            }
        }
        if (!has_next) break;
        asm volatile("s_waitcnt lgkmcnt(0)" ::: "memory");
        __builtin_amdgcn_s_barrier();
        DN_STAGE_A(nxt); DN_ROWTAB(nxt, par ^ 1);
        cur = nxt; ++ti;
    }
    asm volatile("s_nop 15\n\ts_nop 15" ::: "memory");
    DN_EPILOGUE(1, prev, prev_s, prev_par);
    asm volatile("s_waitcnt vmcnt(0) lgkmcnt(0)" ::: "memory");
    __builtin_amdgcn_s_barrier();
#undef DN_SA
#undef DN_SB
#undef DN_STAGE
#undef DN_STAGE_A
#undef DN_STAGE_B
#undef DN_ROWTAB
#undef DN_EPILOGUE
}
constexpr int T_P64 = T_HIST;
template <int PMODE = 0> __device__ __forceinline__ void down2_phase(LAS unsigned char* lds, LAS unsigned* tab, const char* act8, const char* wd, const int* slot_ent, unsigned char* ybuf, const int G, const int bx, const int tid_in) {
    int tid_ = tid_in; asm volatile("" : "+v"(tid_));
    const int tid = tid_, wid = __builtin_amdgcn_readfirstlane(tid >> 6), lane = tid & 63, wr = wid >> 2, wc = wid & 3, fr = lane & 15, fq = lane >> 4;
    constexpr int NS = 8, PB = 16384;
    if (tid < 64) {
        unsigned c[4], sp = 0;
#pragma unroll
        for (int j = 0; j < 4; ++j) { c[j] = (tab[T_CNT + lane * 4 + j] + 63u) >> 6; sp += c[j]; }
        unsigned ip = sp;
#pragma unroll
        for (int o = 1; o < 64; o <<= 1) { const unsigned a = __shfl_up(ip, o); if (lane >= o) ip += a; }
        unsigned ep = ip - sp;
#pragma unroll
        for (int j = 0; j < 4; ++j) { tab[T_P64 + lane * 4 + j] = ep; ep += c[j]; }
        if (lane == 63) tab[T_P64 + NE] = ep;
    }
    __syncthreads();
    int g, q; const int NG = G >> 2;
    if (G % 32 == 0) { const int x = bx % 8, i = bx / 8; g = x * (G / 32) + (i >> 2); q = i & 3; } else { g = bx >> 2; q = bx & 3; }
    const int NP = (int)tab[T_P64 + NE];
    const int p_lo = g < NG ? (int)((long long)g * NP / NG) : 0, p_hi = g < NG ? (int)((long long)(g + 1) * NP / NG) : 0;
    if (p_lo < p_hi) {
    int R0, C0; stage_rc(tid * 16, R0, C0);
    const unsigned ldsw = (unsigned)wid * 1024u;
    const int aoff = lds_byte(wr * 32 + fr, fq * 8);
    LAS unsigned* rowtab = (LAS unsigned*)(lds + VN_OFF);
    int e0 = 0; { int hi = NE - 1; while (e0 < hi) { const int mid = (e0 + hi + 1) >> 1; if ((int)tab[T_P64 + mid] <= p_lo) e0 = mid; else hi = mid - 1; } }
    int e2 = e0, nb2 = (int)tab[T_P64 + e0 + 1];
    int e = -1, nb = p_lo;
#define D2_STAGE(pp_, it_) do { const int _pp = (pp_) < p_hi ? (pp_) : p_hi - 1; \
        while (_pp >= nb2) { ++e2; nb2 = (int)tab[T_P64 + e2 + 1]; } \
        const int _off = (int)tab[T_OFF + e2], _cnt = (int)tab[T_CNT + e2], _r0 = (_pp - (int)tab[T_P64 + e2]) * 64; \
        int _r = _r0 + R0; if (_r >= _cnt) _r = _cnt - 1; int _rr = _r0 + lane; if (_rr >= _cnt) _rr = _cnt - 1; \
        const char* _a = act8 + (size_t)(unsigned)((_off + _r) * DE + C0 * 2); const unsigned _zb = (unsigned)((it_) & (NS - 1)) * PB; \
        __builtin_amdgcn_global_load_lds((const unsigned*)_a, (LAS unsigned*)(lds + _zb + ldsw), 16, 0, 0); \
        __builtin_amdgcn_global_load_lds((const unsigned*)(_a + 128), (LAS unsigned*)(lds + _zb + 8192 + ldsw), 16, 0, 0); \
        if (wid == 0) __builtin_amdgcn_global_load_lds((const unsigned*)(slot_ent + _off + _rr), rowtab + ((it_) & 15) * 64, 4, 0, 0); } while (0)
    union Frag { bf16x8 q2[2]; i32x8 w; };
    Frag Bf[2][4], Af[2][2][2];
    f32x4 acc[2][2][4];
#define D2_CVT(v_) ({ const f32x4 _v = (v_); const float _c0 = clamp8(_v[0]); int _w = __builtin_amdgcn_cvt_pk_fp8_f32(_c0, clamp8(_v[1]), __float_as_int(_c0), false); (unsigned)__builtin_amdgcn_cvt_pk_fp8_f32(clamp8(_v[2]), clamp8(_v[3]), _w, true); })
#define D2_OUT(dst_, o_) do { if (PMODE == 0 || ((o_).x == 0x12345678u && (o_).y == 0x31415926u && (dst_) < (unsigned)NSLOT)) *(u32x4*)(ybuf + (size_t)(dst_) * D + (q * 256 + wc * 64 + 16 * fq)) = (o_); } while (0)
#define D2_EPILOGUE(set, ip_) do { _Pragma("unroll") for (int _m = 0; _m < 2; ++_m) { \
            const unsigned _dst = rowtab[((ip_) & 15) * 64 + wr * 32 + _m * 16 + fr]; u32x4 _o; \
            _Pragma("unroll") for (int _n = 0; _n < 4; ++_n) _o[_n] = D2_CVT(acc[set][_m][_n]); \
            D2_OUT(_dst, _o); } } while (0)
#define D2_READA(par, it_) do { const unsigned _zb = (unsigned)((it_) & (NS - 1)) * PB; _Pragma("unroll") for (int _k = 0; _k < 2; ++_k) _Pragma("unroll") for (int _m = 0; _m < 2; ++_m) \
        Af[par][_k][_m].w = cat8(*(const LAS bf16x8*)(lds + _zb + _k * 8192 + aoff + _m * 2048), *(const LAS bf16x8*)(lds + _zb + _k * 8192 + aoff + _m * 2048 + 1024)); } while (0)
#define D2_MFMA0(sb, m, n) asm volatile("v_mfma_f32_16x16x128_f8f6f4 %0, %1, %2, 0" : "=&v"(acc[sb][m][n]) : "v"(Bf[0][n].w), "v"(Af[sb][0][m].w))
#define D2_MFMA1(sb, m, n) asm volatile("v_mfma_f32_16x16x128_f8f6f4 %0, %1, %2, %0" : "+v"(acc[sb][m][n]) : "v"(Bf[1][n].w), "v"(Af[sb][1][m].w))
#define D2_PAIR(MF, sb, m, n0, EPI, om, on, ov) do { MF(sb, m, n0); MF(sb, m, n0 + 1); if (EPI && PMODE < 5) (ov)[on] = D2_CVT(acc[(sb) ^ 1][om][on]); __builtin_amdgcn_sched_barrier(0); } while (0)
#define D2_PIECE(sb, i_, EPI) do { const int _i = (i_); \
        if ((_i & 3) == 0) {                                               \
            if (_i == 0) asm volatile("s_waitcnt vmcnt(0)" ::: "memory"); else asm volatile("s_waitcnt vmcnt(6)" ::: "memory");     \
            asm volatile("s_waitcnt lgkmcnt(0)" ::: "memory"); \
            if (PMODE != 5) __builtin_amdgcn_s_barrier();                  \
            asm volatile("" ::: "memory"); \
            if (PMODE != 3 && PMODE != 5 && PMODE != 6) { _Pragma("unroll 1") for (int _t = 5; _t < 9; ++_t) D2_STAGE(p_lo + _i + _t, _i + _t); } \
        } \
        if (p_lo + _i >= nb) {                                             \
            do { ++e; nb = (int)tab[T_P64 + e + 1]; } while (p_lo + _i >= nb); \
            const __attribute__((address_space(1))) char* wb = (const __attribute__((address_space(1))) char*)(wd + ((size_t)e * D + q * 256 + wc * 64 + 16 * (fr >> 2) + (fr & 3)) * DE + 16 * fq); \
            _Pragma("unroll") for (int _k = 0; _k < 2; ++_k) _Pragma("unroll") for (int _n = 0; _n < 4; ++_n) \
                Bf[_k][_n].w = cat8(*(const __attribute__((address_space(1))) bf16x8*)(wb + _n * 4 * DE + _k * 128), *(const __attribute__((address_space(1))) bf16x8*)(wb + _n * 4 * DE + _k * 128 + 64)); \
            _Pragma("unroll") for (int _k = 0; _k < 2; ++_k) _Pragma("unroll") for (int _n = 0; _n < 4; ++_n) asm volatile("" : "+v"(Bf[_k][_n].w));     \
        } \
        if (PMODE != 5) D2_READA((sb) ^ 1, _i + 1); \
        unsigned _d0 = 0, _d1 = 0; u32x4 _o0, _o1; \
        __builtin_amdgcn_sched_barrier(0); \
        D2_PAIR(D2_MFMA0, sb, 0, 0, EPI, 0, 0, _o0); D2_PAIR(D2_MFMA0, sb, 0, 2, EPI, 0, 1, _o0); \
        if (EPI && PMODE < 5) { _d0 = rowtab[((_i - 1) & 15) * 64 + wr * 32 + fr]; _d1 = rowtab[((_i - 1) & 15) * 64 + wr * 32 + 16 + fr]; }     \
        __builtin_amdgcn_sched_barrier(0); \
        D2_PAIR(D2_MFMA0, sb, 1, 0, EPI, 0, 2, _o0); D2_PAIR(D2_MFMA0, sb, 1, 2, EPI, 0, 3, _o0); \
        if (EPI && PMODE < 5) D2_OUT(_d0, _o0); \
        D2_PAIR(D2_MFMA1, sb, 0, 0, EPI, 1, 0, _o1); D2_PAIR(D2_MFMA1, sb, 0, 2, EPI, 1, 1, _o1); D2_PAIR(D2_MFMA1, sb, 1, 0, EPI, 1, 2, _o1); D2_PAIR(D2_MFMA1, sb, 1, 2, EPI, 1, 3, _o1); \
        if (EPI && PMODE < 5) D2_OUT(_d1, _o1); \
    } while (0)
#pragma unroll 1
    for (int j = 0; j < 5; ++j) D2_STAGE(p_lo + j, j);
    const int n_it = p_hi - p_lo;
    asm volatile("s_waitcnt vmcnt(0)" ::: "memory");
    __builtin_amdgcn_s_barrier();
    asm volatile("" ::: "memory");
    D2_READA(0, 0);
    D2_PIECE(0, 0, false);
#pragma unroll 1
    for (int i2 = 1; i2 < n_it; i2 += 2) {
        D2_PIECE(1, i2, true);
        if (i2 + 1 < n_it) D2_PIECE(0, i2 + 1, true);
    }
    asm volatile("s_nop 15\n\ts_nop 15" ::: "memory");
    if (n_it & 1) D2_EPILOGUE(0, n_it - 1); else D2_EPILOGUE(1, n_it - 1);
#undef D2_CVT
#undef D2_OUT
#undef D2_READA
#undef D2_MFMA0
#undef D2_MFMA1
#undef D2_PAIR
#undef D2_PIECE
#undef D2_STAGE
#undef D2_EPILOGUE
    }
    asm volatile("s_waitcnt vmcnt(0) lgkmcnt(0)" ::: "memory");
    __builtin_amdgcn_s_barrier();
}
struct EpiProbeSum {
    static constexpr bool PERM = true; float* o;
    __device__ __forceinline__ void operator()(const f32x4 (&acc)[2][2][4][2], const Unit& u, int wr, int wc, int fr, int fq, const LAS unsigned* rt) const {
        f32x4 s = (f32x4){0.f, 0.f, 0.f, 0.f};
#pragma unroll
        for (int a = 0; a < 2; ++a)
#pragma unroll
            for (int b = 0; b < 2; ++b)
#pragma unroll
                for (int m = 0; m < 4; ++m) s += acc[a][b][m][0] + acc[a][b][m][1];
        if (s.x == 123.456f) *(f32x4*)(o + (size_t)(blockIdx.x * 512 + wr * 256 + wc * 64 + fq * 16 + fr) * 4) = s;
    }
};
}

struct Ctx {
    const float *x, *c, *w_ada, *b_ada, *w_in, *w_out, *na_rpb, *ret_ld, *ret_gn, *ln1_g, *ln1_b, *ln2_g, *ln2_b, *w_router, *rbias, *w_gate, *w_up, *w_down, *ws_gate, *ws_up, *ws_down;
    float* out; unsigned char* ws;
};
constexpr int NW = 8;

__device__ __forceinline__ void transpose_item(const float* W, int K, int N, bf16_t* WT, int G, int which, LAS float* scr, int item, int lane) {
    const int nblk = N / 32, kb = item / nblk, nb = item % nblk, k0 = 64 * kb, n0 = 32 * nb;
    float v[32];
#pragma unroll
    for (int i = 0; i < 32; ++i) { const int kk = 2 * i + (lane >> 5); v[i] = __builtin_nontemporal_load(W + (size_t)(k0 + kk) * N + n0 + (lane & 31)); }
#pragma unroll
    for (int i = 0; i < 32; ++i) { const int kk = 2 * i + (lane >> 5); scr[kk * 33 + (lane & 31)] = v[i]; }
    LDS_WAIT(); asm volatile("" ::: "memory");
    const int c = lane & 7;
#pragma unroll
    for (int j = 0; j < 4; ++j) { const int n = (lane >> 3) + 8 * j; const LAS float* s = scr + (8 * c) * 33 + n;
        u32x4 o; o.x = pk2(s[0 * 33], s[1 * 33]); o.y = pk2(s[2 * 33], s[3 * 33]); o.z = pk2(s[4 * 33], s[5 * 33]); o.w = pk2(s[6 * 33], s[7 * 33]);
        const int ng = n0 + n; const int drow = (G == 0) ? ng : ((ng / G) * 2 * G + which * G + (ng % G));
        *(u32x4*)(WT + (size_t)drow * K + k0 + 8 * c) = o; }
    LDS_WAIT(); asm volatile("" ::: "memory");
}
__device__ __forceinline__ void transpose_item_fp8(const float* W, int K, int N, unsigned char* WT, int G, int which, float scale, LAS float* scr, int item, int lane) {
    const int nblk = N / 32, kb = item / nblk, nb = item % nblk, k0 = 64 * kb, n0 = 32 * nb;
    float v[32];
#pragma unroll
    for (int i = 0; i < 32; ++i) { const int kk = 2 * i + (lane >> 5); v[i] = __builtin_nontemporal_load(W + (size_t)(k0 + kk) * N + n0 + (lane & 31)); }
#pragma unroll
    for (int i = 0; i < 32; ++i) { const int kk = 2 * i + (lane >> 5); scr[kk * 33 + (lane & 31)] = v[i] * scale; }
    LDS_WAIT(); asm volatile("" ::: "memory");
    const int c = lane & 7;
#pragma unroll
    for (int j = 0; j < 4; ++j) { const int n = (lane >> 3) + 8 * j; const LAS float* sp = scr + (8 * c) * 33 + n;
        int w0 = __builtin_amdgcn_cvt_pk_fp8_f32(clamp8(sp[0 * 33]), clamp8(sp[1 * 33]), 0, false); w0 = __builtin_amdgcn_cvt_pk_fp8_f32(clamp8(sp[2 * 33]), clamp8(sp[3 * 33]), w0, true);
        int w1 = __builtin_amdgcn_cvt_pk_fp8_f32(clamp8(sp[4 * 33]), clamp8(sp[5 * 33]), 0, false); w1 = __builtin_amdgcn_cvt_pk_fp8_f32(clamp8(sp[6 * 33]), clamp8(sp[7 * 33]), w1, true);
        const int ng = n0 + n; const int drow = (G == 0) ? ng : ((ng / G) * 2 * G + which * G + (ng % G));
        u32x2 o; o.x = (unsigned)w0; o.y = (unsigned)w1; *(u32x2*)(WT + (size_t)drow * K + k0 + 8 * c) = o; }
    LDS_WAIT(); asm volatile("" ::: "memory");
}
__device__ __forceinline__ void rope_entry(float* tab, int idx) {
    const int t = idx >> 6, i = idx & 63;
    const float inv_freq = powf(10000.f, -(float)(2 * i) / 128.f);
    const float ang = (float)t * inv_freq;
    const double a = (double)ang; const double two_pi = 6.283185307179586476925286766559;
    const double kf = rint(a / two_pi); double r = a - kf * two_pi;
    double sgn = 1.0; if (r > 1.5707963267948966) { r = 3.141592653589793 - r; sgn = -1.0; } else if (r < -1.5707963267948966) { r = -3.141592653589793 - r; sgn = -1.0; }
    const double r2 = r * r;
    const double s = r * (1.0 + r2 * (-1.0 / 6 + r2 * (1.0 / 120 + r2 * (-1.0 / 5040 + r2 * (1.0 / 362880 + r2 * (-1.0 / 39916800 + r2 * (1.0 / 6227020800.0 + r2 * (-1.0 / 1307674368000.0))))))));
    const double c = 1.0 + r2 * (-0.5 + r2 * (1.0 / 24 + r2 * (-1.0 / 720 + r2 * (1.0 / 40320 + r2 * (-1.0 / 3628800 + r2 * (1.0 / 479001600.0 + r2 * (-1.0 / 87178291200.0 + r2 * (1.0 / 20922789888000.0))))))));
    tab[idx] = (float)(sgn * c); tab[SEQ * 64 + idx] = (float)s;
}
__device__ __forceinline__ void mod_task(const float* __restrict__ cin, const float* __restrict__ w_ada, float* __restrict__ modp, int task, int lane) {
    const int cbk = task % 96, kc = task / 96, j = cbk * 64 + lane, k0 = kc * 64;
    float acc[32], cv[32];
#pragma unroll
    for (int b = 0; b < 32; ++b) { acc[b] = 0.f; cv[b] = silu_f(cin[b * D + k0 + lane]); }
#pragma unroll
    for (int kb = 0; kb < 4; ++kb) {
        float w[16];
#pragma unroll
        for (int i = 0; i < 16; ++i) w[i] = w_ada[(size_t)(k0 + kb * 16 + i) * 6144 + j];
#pragma unroll
        for (int i = 0; i < 16; ++i)
#pragma unroll
            for (int b = 0; b < 32; ++b) acc[b] += __builtin_bit_cast(float, __builtin_amdgcn_readlane(__builtin_bit_cast(int, cv[b]), kb * 16 + i)) * w[i];
    }
#pragma unroll
    for (int b = 0; b < 32; ++b) modp[((size_t)kc * 32 + b) * 6144 + j] = acc[b];
}
__device__ __forceinline__ float mod_sum(const float* __restrict__ modp, const float* __restrict__ b_ada, int b, int j) {
    float s = 0.f;
#pragma unroll
    for (int kc = 0; kc < 16; ++kc) s += modp[((size_t)kc * 32 + b) * 6144 + j];
    return s + b_ada[j];
}

#ifndef RET_PROBE
#define RET_PROBE 0
#endif
namespace ret {
typedef short s16x4 __attribute__((ext_vector_type(4)));
typedef __bf16 bfx2 __attribute__((ext_vector_type(2)));
constexpr unsigned RS = 288, TILE = 128 * RS, LK = 0, LV = TILE, LRF = 2 * TILE, LRB = 3 * TILE;
constexpr float LOG2E = 1.4426950408889634f;
__device__ __forceinline__ unsigned offb(unsigned row, unsigned ch) { return RS * row + 16u * ch; }
__device__ __forceinline__ unsigned cvtpk(float lo, float hi) { const f32x2 v = {lo, hi}; return __builtin_bit_cast(unsigned, __builtin_convertvector(v, bfx2)); }
__device__ __forceinline__ bf16x8 pack8(const float (&f)[8]) { u32x4 u; u.x = cvtpk(f[0], f[1]); u.y = cvtpk(f[2], f[3]); u.z = cvtpk(f[4], f[5]); u.w = cvtpk(f[6], f[7]); return __builtin_bit_cast(bf16x8, u); }
__device__ __forceinline__ void unpack8(const bf16x8 v, float (&f)[8]) { const u32x4 u = __builtin_bit_cast(u32x4, v);
    f[0] = __uint_as_float(u.x << 16); f[1] = __uint_as_float(u.x & 0xffff0000u); f[2] = __uint_as_float(u.y << 16); f[3] = __uint_as_float(u.y & 0xffff0000u);
    f[4] = __uint_as_float(u.z << 16); f[5] = __uint_as_float(u.z & 0xffff0000u); f[6] = __uint_as_float(u.w << 16); f[7] = __uint_as_float(u.w & 0xffff0000u); }
__device__ __forceinline__ bf16x8 trfrag(LAS unsigned char* base, unsigned row0, unsigned row1, unsigned cblk, unsigned qp, unsigned p) {
    const unsigned ch = 2u * cblk + (p >> 1), bo = 8u * (p & 1u);
    const s16x4 lo = __builtin_amdgcn_ds_read_tr16_b64_v4i16((LAS s16x4*)(base + offb(row0 + qp, ch) + bo));
    const s16x4 hi = __builtin_amdgcn_ds_read_tr16_b64_v4i16((LAS s16x4*)(base + offb(row1 + qp, ch) + bo));
    return __builtin_shufflevector(lo, hi, 0, 1, 2, 3, 4, 5, 6, 7);
}
struct KVRaw { bf16x8 ka[2], kb[2], v[4]; f32x4 c0[2], c1[2], s0[2], s1[2]; };
__device__ __forceinline__ void kv_load(KVRaw& R, const bf16_t* __restrict__ proj, const float* __restrict__ rope, int b, int h, int n, int tid) {
#pragma unroll
    for (int i = 0; i < 2; ++i) {
        const int q2 = tid + 512 * i, row = q2 >> 3, pc = q2 & 7, t = n * 128 + row;
        const bf16_t* rp = proj + (size_t)(b * SEQ + t) * DIN + OFF_KR + h * 128;
        R.ka[i] = *(const bf16x8*)(rp + pc * 8); R.kb[i] = *(const bf16x8*)(rp + 64 + pc * 8);
        R.c0[i] = *(const f32x4*)(rope + t * 64 + pc * 8); R.c1[i] = *(const f32x4*)(rope + t * 64 + pc * 8 + 4);
        R.s0[i] = *(const f32x4*)(rope + SEQ * 64 + t * 64 + pc * 8); R.s1[i] = *(const f32x4*)(rope + SEQ * 64 + t * 64 + pc * 8 + 4);
    }
#pragma unroll
    for (int i = 0; i < 4; ++i) { const int q4 = tid + 512 * i, row = q4 >> 4, ch = q4 & 15, t = n * 128 + row;
        R.v[i] = *(const bf16x8*)(proj + (size_t)(b * SEQ + t) * DIN + OFF_VR + h * 128 + ch * 8); }
}
__device__ __forceinline__ void kv_store(LAS unsigned char* lds, const KVRaw& R, int tid) {
#pragma unroll
    for (int i = 0; i < 2; ++i) {
        const int q2 = tid + 512 * i, row = q2 >> 3, pc = q2 & 7;
        float fa[8], fb[8], o1[8], o2[8];
        unpack8(R.ka[i], fa); unpack8(R.kb[i], fb);
        const float cs[8] = {R.c0[i].x, R.c0[i].y, R.c0[i].z, R.c0[i].w, R.c1[i].x, R.c1[i].y, R.c1[i].z, R.c1[i].w}, sn[8] = {R.s0[i].x, R.s0[i].y, R.s0[i].z, R.s0[i].w, R.s1[i].x, R.s1[i].y, R.s1[i].z, R.s1[i].w};
#pragma unroll
        for (int e = 0; e < 8; ++e) { o1[e] = fa[e] * cs[e] - fb[e] * sn[e]; o2[e] = fb[e] * cs[e] + fa[e] * sn[e]; }
        *(LAS bf16x8*)(lds + LK + offb(row, pc)) = pack8(o1); *(LAS bf16x8*)(lds + LK + offb(row, pc + 8)) = pack8(o2);
    }
#pragma unroll
    for (int i = 0; i < 4; ++i) { const int q4 = tid + 512 * i, row = q4 >> 4, ch = q4 & 15; *(LAS bf16x8*)(lds + LV + offb(row, ch)) = R.v[i]; }
}
__device__ __forceinline__ void rb_dma(LAS unsigned char* lds, const unsigned char* img, int w, int lane) {
#pragma unroll
    for (int i = 0; i < 5; ++i) { const int o = w + 8 * i; if (o < (int)TILE / 1024)
        __builtin_amdgcn_global_load_lds((const unsigned*)(img + o * 1024 + lane * 16), (LAS unsigned*)(lds + LRB + o * 1024), 16, 0, 0); }
}
template <bool FWD> __device__ __forceinline__ void state_update_1(LAS unsigned char* lds, f32x4 (&racc)[8], float l2, int w, int g, unsigned qp, unsigned p);
template <bool FWD> __device__ __forceinline__ void state_update(LAS unsigned char* lds, f32x4 (&racc)[8], float l2, int w, int g, unsigned qp, unsigned p) {
    if (RET_PROBE == 2) {
        f32x4 r2[8];
#pragma unroll
        for (int i = 0; i < 8; ++i) r2[i] = racc[i];
        unsigned zo = 0; asm volatile("" : "+v"(zo));
        state_update_1<FWD>(lds + zo, r2, l2, w, g, qp, p);
        state_update_1<FWD>(lds, racc, l2, w, g, qp, p);
#pragma unroll
        for (int i = 0; i < 8; ++i) racc[i] = (racc[i] + r2[i]) * 0.5f;
    } else state_update_1<FWD>(lds, racc, l2, w, g, qp, p);
}
template <bool FWD> __device__ __forceinline__ void state_update_1(LAS unsigned char* lds, f32x4 (&racc)[8], float l2, int w, int g, unsigned qp, unsigned p) {
    const float dec = __builtin_amdgcn_exp2f(128.f * l2);
    bf16x8 vs[4];
#pragma unroll
    for (int ks = 0; ks < 4; ++ks) {
        float f[8]; unpack8(trfrag(lds + LV, 32 * ks + 4 * g, 32 * ks + 16 + 4 * g, w, qp, p), f);
#pragma unroll
        for (int e = 0; e < 8; ++e) { const int key = 32 * ks + 16 * (e >> 2) + 4 * g + (e & 3); f[e] *= __builtin_amdgcn_exp2f((FWD ? (float)(127 - key) : (float)key) * l2); }
        vs[ks] = pack8(f);
    }
#pragma unroll
    for (int nb = 0; nb < 8; ++nb) {
        racc[nb] = racc[nb] * dec;
#pragma unroll
        for (int ks = 0; ks < 4; ++ks) racc[nb] = __builtin_amdgcn_mfma_f32_16x16x32_bf16(vs[ks], trfrag(lds + LK, 32 * ks + 4 * g, 32 * ks + 16 + 4 * g, nb, qp, p), racc[nb], 0, 0, 0);
    }
}
__device__ __forceinline__ void unit(const bf16_t* __restrict__ proj, const float* __restrict__ rope, const float* __restrict__ log_decay, const float* __restrict__ gn_g, bf16_t* __restrict__ ymix,
                                     unsigned char* __restrict__ scratch  , LAS unsigned char* lds, int hu, const int tid_in) {
    const int u = hu >> 1, n0 = (hu & 1) * 8, n1 = n0 + 8;
    const int b = u >> 2, h = u & 3;
    int tid_ = tid_in; asm volatile("" : "+v"(tid_));
    const int tid0 = tid_, w = __builtin_amdgcn_readfirstlane(tid0 >> 6);
#define RET_LANE int tid = tid0; asm volatile("" : "+v"(tid)); const int lane = tid & 63, r = lane & 15, g = lane >> 4; const unsigned qp = (unsigned)r >> 2, p = (unsigned)lane & 3u;
    const float lf2_ = log_decay[h] * LOG2E, lb2_ = log_decay[4 + h] * LOG2E;
    if (tid0 < 128) ((LAS float*)(lds + 4 * TILE))[tid0] = gn_g[h * 128 + tid0];
    f32x4 racc[8];
    KVRaw raw;
    for (int rep7 = 0; rep7 < (RET_PROBE == 7 ? 2 : 1); ++rep7) {
#pragma unroll
    for (int nb = 0; nb < 8; ++nb) racc[nb] = (f32x4){0.f, 0.f, 0.f, 0.f};
    kv_load(raw, proj, rope, b, h, 15, tid0);
    for (int n = 15; n >= n0; --n) {
        RET_LANE
        if (n < n1) {
            unsigned char* img = scratch + (size_t)(n - n0) * TILE;
#pragma unroll
            for (int nb = 0; nb < 8; ++nb) { u32x2 o; o.x = cvtpk(racc[nb][0], racc[nb][1]); o.y = cvtpk(racc[nb][2], racc[nb][3]);
                *(u32x2*)(img + offb(16 * nb + r, 2 * w + (g >> 1)) + 8 * (g & 1)) = o; }
        }
        if (n == n0) break;
        float lb2 = lb2_; asm volatile("" : "+v"(lb2));
        __syncthreads();
        kv_store(lds, raw, tid);
        __syncthreads();
        kv_load(raw, proj, rope, b, h, n - 1 > n0 ? n - 1 : 0, tid);
        state_update<false>(lds, racc, lb2, w, g, qp, p);
    }
    }
    asm volatile("s_waitcnt vmcnt(0)" ::: "memory");
    __syncthreads();
    __builtin_amdgcn_fence(__ATOMIC_ACQUIRE, "agent");
    asm volatile("s_waitcnt vmcnt(0)" ::: "memory");
    for (int rep8 = 0; rep8 < (RET_PROBE == 8 ? 2 : 1); ++rep8) {
    if (RET_PROBE == 8 && rep8 == 1) { __syncthreads(); kv_load(raw, proj, rope, b, h, 0, tid0); }
#pragma unroll
    for (int nb = 0; nb < 8; ++nb) racc[nb] = (f32x4){0.f, 0.f, 0.f, 0.f};
    for (int n = 0; n < n0; ++n) {
        RET_LANE
        float lf2 = lf2_; asm volatile("" : "+v"(lf2));
        __syncthreads();
        kv_store(lds, raw, tid);
        __syncthreads();
        kv_load(raw, proj, rope, b, h, n + 1, tid);
        state_update<true>(lds, racc, lf2, w, g, qp, p);
    }
    rb_dma(lds, scratch, w, tid0 & 63);
    for (int n = n0; n < n1; ++n) {
        RET_LANE
        float lf2 = lf2_, lb2 = lb2_; asm volatile("" : "+v"(lf2), "+v"(lb2));
        const LAS float* gnp = (const LAS float*)(lds + 4 * TILE); asm volatile("" : "+v"(gnp));
        const int cq = 16 * w + r, tq = n * 128 + cq;
        u32x2 qraw[2][4];
        { const bf16_t* rp = proj + (size_t)(b * SEQ + tq) * DIN + OFF_QR + h * 128 + 4 * g;
#pragma unroll
          for (int ks = 0; ks < 2; ++ks) { qraw[ks][0] = *(const u32x2*)(rp + 32 * ks); qraw[ks][1] = *(const u32x2*)(rp + 32 * ks + 16); qraw[ks][2] = *(const u32x2*)(rp + 32 * ks + 64); qraw[ks][3] = *(const u32x2*)(rp + 32 * ks + 80); } }
        __syncthreads();
        kv_store(lds, raw, tid);
#pragma unroll
        for (int nb = 0; nb < 8; ++nb) { u32x2 o; o.x = cvtpk(racc[nb][0], racc[nb][1]); o.y = cvtpk(racc[nb][2], racc[nb][3]);
            *(LAS u32x2*)(lds + LRF + offb(16 * nb + r, 2 * w + (g >> 1)) + 8 * (g & 1)) = o; }
        bf16x8 qn[4], qf[4], qb[4];
        { const float sf = __builtin_amdgcn_exp2f((float)(cq + 1) * lf2), sb = __builtin_amdgcn_exp2f((float)(128 - cq) * lb2);
#pragma unroll
          for (int ks = 0; ks < 2; ++ks) {
              float fa[8], fb[8], o1[8], o2[8], t1[8], t2[8];
              { const u32x2 a0 = qraw[ks][0], a1 = qraw[ks][1], b0 = qraw[ks][2], b1 = qraw[ks][3];
                unpack8(__builtin_bit_cast(bf16x8, (u32x4){a0.x, a0.y, a1.x, a1.y}), fa); unpack8(__builtin_bit_cast(bf16x8, (u32x4){b0.x, b0.y, b1.x, b1.y}), fb); }
              const float* cp = rope + tq * 64 + 32 * ks + 4 * g; const float* sp = cp + SEQ * 64;
              const f32x4 c0 = *(const f32x4*)cp, c1 = *(const f32x4*)(cp + 16), s0 = *(const f32x4*)sp, s1 = *(const f32x4*)(sp + 16);
              const float cs[8] = {c0.x, c0.y, c0.z, c0.w, c1.x, c1.y, c1.z, c1.w}, sn[8] = {s0.x, s0.y, s0.z, s0.w, s1.x, s1.y, s1.z, s1.w};
#pragma unroll
              for (int e = 0; e < 8; ++e) { o1[e] = fa[e] * cs[e] - fb[e] * sn[e]; o2[e] = fb[e] * cs[e] + fa[e] * sn[e]; }
              qn[ks] = pack8(o1); qn[ks + 2] = pack8(o2);
#pragma unroll
              for (int e = 0; e < 8; ++e) { t1[e] = o1[e] * sf; t2[e] = o2[e] * sf; }
              qf[ks] = pack8(t1); qf[ks + 2] = pack8(t2);
#pragma unroll
              for (int e = 0; e < 8; ++e) { t1[e] = o1[e] * sb; t2[e] = o2[e] * sb; }
              qb[ks] = pack8(t1); qb[ks + 2] = pack8(t2);
          } }
        asm volatile("s_waitcnt vmcnt(0)" ::: "memory");
        __syncthreads();
        kv_load(raw, proj, rope, b, h, n + 1 < n1 ? n + 1 : n, tid);
        u32x2 gv[8];
        { const bf16_t* gp = proj + (size_t)(b * SEQ + tq) * DIN + OFF_GR + h * 128 + 4 * g;
#pragma unroll
          for (int mbv = 0; mbv < 8; ++mbv) gv[mbv] = *(const u32x2*)(gp + 16 * mbv); }
        bf16x8 pt[4];
#pragma unroll
        for (int rep3 = 0; rep3 < (RET_PROBE == 3 ? 2 : 1); ++rep3) {
        unsigned zo3 = 0; if (RET_PROBE == 3) asm volatile("" : "+v"(zo3));
#pragma unroll
        for (int ks2 = 0; ks2 < 4; ++ks2) {
            float pv[8];
#pragma unroll
            for (int hb = 0; hb < 2; ++hb) {
                const int mb = 2 * ks2 + hb;
                f32x4 st = (f32x4){0.f, 0.f, 0.f, 0.f};
#pragma unroll
                for (int ks = 0; ks < 4; ++ks) { const LAS unsigned char* kp = lds + LK + zo3 + RS * (16 * mb + r) + 64 * ks + 8 * g; const u32x2 k0 = *(const LAS u32x2*)kp, k1 = *(const LAS u32x2*)(kp + 32);
                    st = __builtin_amdgcn_mfma_f32_16x16x32_bf16(__builtin_bit_cast(bf16x8, (u32x4){k0.x, k0.y, k1.x, k1.y}), qn[ks], st, 0, 0, 0); }
#pragma unroll
                for (int j = 0; j < 4; ++j) { const int diff = cq - (16 * mb + 4 * g + j); pv[4 * hb + j] = st[j] * __builtin_amdgcn_exp2f(diff >= 0 ? (float)diff * lf2 : (float)(-diff) * lb2); }
            }
            pt[ks2] = pack8(pv);
        }
        }
        f32x4 yacc[8];
#pragma unroll
        for (int mbv = 0; mbv < 8; ++mbv) {
            f32x4 y = (f32x4){0.f, 0.f, 0.f, 0.f};
#pragma unroll
            for (int rep = 0; rep < (RET_PROBE == 1 ? 2 : 1); ++rep) {
            unsigned zo = 0; if (RET_PROBE == 1) asm volatile("" : "+v"(zo));
#pragma unroll
            for (int ks2 = 0; ks2 < 4; ++ks2) y = __builtin_amdgcn_mfma_f32_16x16x32_bf16(trfrag(lds + LV + zo, 32 * ks2 + 4 * g, 32 * ks2 + 16 + 4 * g, mbv, qp, p), pt[ks2], y, 0, 0, 0);
#pragma unroll
            for (int ks = 0; ks < 4; ++ks) {
                y = __builtin_amdgcn_mfma_f32_16x16x32_bf16(trfrag(lds + LRF + zo, 32 * ks + 4 * g, 32 * ks + 16 + 4 * g, mbv, qp, p), qf[ks], y, 0, 0, 0);
                y = __builtin_amdgcn_mfma_f32_16x16x32_bf16(trfrag(lds + LRB + zo, 32 * ks + 4 * g, 32 * ks + 16 + 4 * g, mbv, qp, p), qb[ks], y, 0, 0, 0);
            }
            }
            yacc[mbv] = (RET_PROBE == 1) ? y * 0.5f : y;
        }
        __syncthreads();
        if (n + 1 < n1) rb_dma(lds, scratch + (size_t)(n + 1 - n0) * TILE, w, lane);
        { float s = 0.f;
#pragma unroll
          for (int mbv = 0; mbv < 8; ++mbv) s += (yacc[mbv][0] + yacc[mbv][1]) + (yacc[mbv][2] + yacc[mbv][3]);
          s += __shfl_xor(s, 16); s += __shfl_xor(s, 32);
          const float mu = s * (1.f / 128.f); float s2 = 0.f;
#pragma unroll
          for (int mbv = 0; mbv < 8; ++mbv) { yacc[mbv] = yacc[mbv] - mu; s2 += (yacc[mbv][0] * yacc[mbv][0] + yacc[mbv][1] * yacc[mbv][1]) + (yacc[mbv][2] * yacc[mbv][2] + yacc[mbv][3] * yacc[mbv][3]); }
          s2 += __shfl_xor(s2, 16); s2 += __shfl_xor(s2, 32);
          const float rstd = 1.f / sqrtf(s2 * (1.f / 128.f) + GN_EPS);
          unsigned char* op = (unsigned char*)ymix + (size_t)(b * SEQ + tq) * D + 512 + h * 128 + 4 * g;
#pragma unroll
          for (int rep4 = 0; rep4 < (RET_PROBE == 4 ? 2 : 1); ++rep4) {
          if (RET_PROBE == 4) { asm volatile("" : "+v"(op)); asm volatile("" : "+v"(gv[0]), "+v"(gv[1]), "+v"(gv[2]), "+v"(gv[3]), "+v"(gv[4]), "+v"(gv[5]), "+v"(gv[6]), "+v"(gv[7])); }
#pragma unroll
          for (int mbv = 0; mbv < 8; ++mbv) {
              const f32x4 gn = *(const LAS f32x4*)(gnp + 16 * mbv + 4 * g);
              const float g0 = __uint_as_float(gv[mbv].x << 16), g1 = __uint_as_float(gv[mbv].x & 0xffff0000u), g2 = __uint_as_float(gv[mbv].y << 16), g3 = __uint_as_float(gv[mbv].y & 0xffff0000u);
              int o = __builtin_amdgcn_cvt_pk_fp8_f32(clamp8(S_H8 * silu_f(g0) * (yacc[mbv][0] * rstd * gn.x)), clamp8(S_H8 * silu_f(g1) * (yacc[mbv][1] * rstd * gn.y)), 0, false);
              o = __builtin_amdgcn_cvt_pk_fp8_f32(clamp8(S_H8 * silu_f(g2) * (yacc[mbv][2] * rstd * gn.z)), clamp8(S_H8 * silu_f(g3) * (yacc[mbv][3] * rstd * gn.w)), o, true);
              *(unsigned*)(op + 16 * mbv) = (unsigned)o;
          } } }
        state_update<true>(lds, racc, lf2, w, g, qp, p);
    }
    }
    __syncthreads();
#undef RET_LANE
}
}


namespace na {
constexpr unsigned LKR = 0, LVR = 73728, LRPB = 147456;
__device__ __forceinline__ void load_row(LAS unsigned char* lds, const bf16_t* __restrict__ proj, int b, int head, int krow, int tid) {
    const int key = tid >> 3, ch = tid & 7, slot = krow % 9;
    const bf16_t* rp = proj + (size_t)(b * SEQ + krow * 64 + key) * DIN + head * 64 + ch * 8;
    const unsigned o = (unsigned)slot * 8192u + 128u * key + 16u * (ch ^ (key & 7));
    *(LAS u32x4*)(lds + LKR + o) = *(const u32x4*)(rp + OFF_KNA);
    *(LAS u32x4*)(lds + LVR + o) = *(const u32x4*)(rp + OFF_VNA);
}
__device__ __forceinline__ void unit(const bf16_t* __restrict__ proj, const float* __restrict__ rpb, bf16_t* __restrict__ ymix, LAS unsigned char* lds, int u, const int tid_in) {
    const int b = u >> 3, head = u & 7;
    int tid_ = tid_in; asm volatile("" : "+v"(tid_));
    const int tid0 = tid_, w = __builtin_amdgcn_readfirstlane(tid0 >> 6);
    __syncthreads();
    if (tid0 < 465) ((LAS float*)(lds + LRPB))[tid0] = rpb[head * 465 + tid0];
    const int ct = w & 3, cb = (ct == 0) ? 0 : (ct == 1 ? 8 : (ct == 2 ? 24 : 32));
    u32x4 pk[2], pv2[2]; int pre_lo = 0, pre_n = 0;
    bf16x8 qnx[2];
    { const int lane0 = tid0 & 63; const bf16_t* qptr = proj + (size_t)(b * SEQ + (w >> 2) * 64 + 16 * ct + (lane0 & 15)) * DIN + OFF_QNA + head * 64 + 8 * (lane0 >> 4); qnx[0] = *(const bf16x8*)qptr; qnx[1] = *(const bf16x8*)(qptr + 32); }
    for (int st = 0; st < 16; ++st) {
        int tid = tid0; asm volatile("" : "+v"(tid));
        const int lane = tid & 63, qi = lane & 15, g = lane >> 4; const unsigned qp = (unsigned)qi >> 2, p = (unsigned)lane & 3u;
        const int r = 2 * st + (w >> 2);
        const int rs = min(max(r - 4, 0), 24);
        const int need_hi = min(max(2 * st + 1 - 4, 0), 24) + 7;
        __syncthreads();
        if (st == 0) { for (int kr = 0; kr <= need_hi; ++kr) load_row(lds, proj, b, head, kr, tid); }
        else {
#pragma unroll
            for (int i = 0; i < 2; ++i) if (i < pre_n) { const int key = tid >> 3, ch = tid & 7; const unsigned o = (unsigned)((pre_lo + i) % 9) * 8192u + 128u * key + 16u * (ch ^ (key & 7));
                *(LAS u32x4*)(lds + LKR + o) = pk[i]; *(LAS u32x4*)(lds + LVR + o) = pv2[i]; }
        }
        const int cq = 16 * ct + qi, tq = b * SEQ + r * 64 + cq;
        bf16x8 qn[2];
        qn[0] = qnx[0]; qn[1] = qnx[1];
        __syncthreads();
        if (st < 15) { const bf16_t* qptr = proj + (size_t)(tq + 128) * DIN + OFF_QNA + head * 64 + 8 * g; qnx[0] = *(const bf16x8*)qptr; qnx[1] = *(const bf16x8*)(qptr + 32); }
        { const int nh = (st < 15) ? min(max(2 * st + 3 - 4, 0), 24) + 7 : need_hi; pre_lo = need_hi + 1; pre_n = nh - need_hi;
#pragma unroll
          for (int i = 0; i < 2; ++i) if (i < pre_n) { const int key = tid >> 3, ch = tid & 7; const bf16_t* rp = proj + (size_t)(b * SEQ + (pre_lo + i) * 64 + key) * DIN + head * 64 + ch * 8;
              pk[i] = *(const u32x4*)(rp + OFF_KNA); pv2[i] = *(const u32x4*)(rp + OFF_VNA); } }
        const int cs = min(max(cq - 8, 0), 48);
        const unsigned kb0 = 128u * qi + 16u * ((unsigned)g ^ ((unsigned)qi & 7u)), kb1 = 128u * qi + 16u * ((4u + (unsigned)g) ^ ((unsigned)qi & 7u));
        const LAS float* bias = (const LAS float*)(lds + LRPB);
        f32x4 sc[16]; float mx = -3.0e38f;
#pragma unroll
        for (int kr = 0; kr < 8; ++kr) {
            const int krow = rs + kr; const unsigned so = (unsigned)(krow % 9) * 8192u + 128u * (unsigned)cb;
            const int dr = krow - r + 7;
#pragma unroll
            for (int h2 = 0; h2 < 2; ++h2) {
                f32x4 a = (f32x4){0.f, 0.f, 0.f, 0.f};
                a = __builtin_amdgcn_mfma_f32_16x16x32_bf16(*(const LAS bf16x8*)(lds + LKR + so + 2048u * h2 + kb0), qn[0], a, 0, 0, 0);
                a = __builtin_amdgcn_mfma_f32_16x16x32_bf16(*(const LAS bf16x8*)(lds + LKR + so + 2048u * h2 + kb1), qn[1], a, 0, 0, 0);
#pragma unroll
                for (int j = 0; j < 4; ++j) {
                    const int kcol = cb + 16 * h2 + 4 * g + j;
                    const int dc = min(max(kcol - cq + 15, 0), 30);
                    const float v = a[j] + bias[dr * 31 + dc];
                    const bool in = (kcol >= cs) && (kcol < cs + 16);
                    a[j] = in ? v : -3.0e38f; mx = fmaxf(mx, a[j]);
                }
                sc[2 * kr + h2] = a;
            }
        }
        mx = fmaxf(mx, __shfl_xor(mx, 16)); mx = fmaxf(mx, __shfl_xor(mx, 32));
        float sum = 0.f; bf16x8 pt[8];
#pragma unroll
        for (int kk = 0; kk < 8; ++kk) {
            float pv[8];
#pragma unroll
            for (int h2 = 0; h2 < 2; ++h2)
#pragma unroll
                for (int j = 0; j < 4; ++j) { const float e = __builtin_amdgcn_exp2f((sc[2 * kk + h2][j] - mx) * 1.4426950408889634f); pv[4 * h2 + j] = e; sum += e; }
            pt[kk] = ret::pack8(pv);
        }
        sum += __shfl_xor(sum, 16); sum += __shfl_xor(sum, 32);
        const float inv = 1.f / sum;
        const unsigned sl = (((unsigned)g & 1u) << 2) | qp;
        unsigned char* op = (unsigned char*)ymix + (size_t)tq * D + head * 64 + 4 * g;
#pragma unroll
        for (int db = 0; db < 4; ++db) {
            const unsigned vb = 128u * (4u * (unsigned)g + qp) + 16u * ((2u * db + (p >> 1)) ^ sl) + 8u * (p & 1u);
            f32x4 y = (f32x4){0.f, 0.f, 0.f, 0.f};
#pragma unroll
            for (int kk = 0; kk < 8; ++kk) {
                const unsigned so = (unsigned)((rs + kk) % 9) * 8192u + 128u * (unsigned)cb;
                const ret::s16x4 lo = __builtin_amdgcn_ds_read_tr16_b64_v4i16((LAS ret::s16x4*)(lds + LVR + so + vb));
                const ret::s16x4 hi = __builtin_amdgcn_ds_read_tr16_b64_v4i16((LAS ret::s16x4*)(lds + LVR + so + 2048u + vb));
                y = __builtin_amdgcn_mfma_f32_16x16x32_bf16(__builtin_shufflevector(lo, hi, 0, 1, 2, 3, 4, 5, 6, 7), pt[kk], y, 0, 0, 0);
            }
            const float inv16 = inv * S_H8;
            int o = __builtin_amdgcn_cvt_pk_fp8_f32(clamp8(y[0] * inv16), clamp8(y[1] * inv16), 0, false); o = __builtin_amdgcn_cvt_pk_fp8_f32(clamp8(y[2] * inv16), clamp8(y[3] * inv16), o, true);
            *(unsigned*)(op + 16 * db) = (unsigned)o;
        }
    }
    __syncthreads();
}
}

__device__ __forceinline__ void unpack_t16r(const u32x4 a, const u32x4 b, f32x4 (&v)[4]) {
    v[0] = (f32x4){__uint_as_float(a.x << 16), __uint_as_float(a.x & 0xffff0000u), __uint_as_float(a.y << 16), __uint_as_float(a.y & 0xffff0000u)};
    v[1] = (f32x4){__uint_as_float(a.z << 16), __uint_as_float(a.z & 0xffff0000u), __uint_as_float(a.w << 16), __uint_as_float(a.w & 0xffff0000u)};
    v[2] = (f32x4){__uint_as_float(b.x << 16), __uint_as_float(b.x & 0xffff0000u), __uint_as_float(b.y << 16), __uint_as_float(b.y & 0xffff0000u)};
    v[3] = (f32x4){__uint_as_float(b.z << 16), __uint_as_float(b.z & 0xffff0000u), __uint_as_float(b.w << 16), __uint_as_float(b.w & 0xffff0000u)};
}
__device__ __forceinline__ void ln1_row(const u32x4 ra, const u32x4 rb, const LAS float* cv  , bf16_t* __restrict__ hf, unsigned char* __restrict__ hf8, float* __restrict__ stats, int row, int lane) {
    asm volatile("" : "+v"(cv));
    const int c0 = lane * 16;
    f32x4 v[4]; float s = 0.f;
    unpack_t16r(ra, rb, v);
#pragma unroll
    for (int j = 0; j < 4; ++j) s += (v[j].x + v[j].y) + (v[j].z + v[j].w);
    const float mean = wave_sum(s) * (1.f / D); float s2 = 0.f;
#pragma unroll
    for (int j = 0; j < 4; ++j) { v[j] = v[j] - mean; s2 += (v[j].x * v[j].x + v[j].y * v[j].y) + (v[j].z * v[j].z + v[j].w * v[j].w); }
    const float rstd = 1.f / sqrtf(wave_sum(s2) * (1.f / D) + LN_EPS);
    if (lane == 0) *(f32x2*)(stats + 2 * (size_t)row) = (f32x2){mean, rstd};
    u32x4 ob[2], o8;
#pragma unroll
    for (int j = 0; j < 4; ++j) { const int col = c0 + 4 * j;
        const f32x4 gg = *(const LAS f32x4*)(cv + col), bv = *(const LAS f32x4*)(cv + 1024 + col), sc1 = *(const LAS f32x4*)(cv + 2048 + col), sh = *(const LAS f32x4*)(cv + 3072 + col);
        const f32x4 h4 = (v[j] * rstd * gg + bv) * sc1 + sh;
        const unsigned p0 = pk2(h4.x, h4.y), p1 = pk2(h4.z, h4.w);
        if (j == 0) { ob[0].x = p0; ob[0].y = p1; } else if (j == 1) { ob[0].z = p0; ob[0].w = p1; } else if (j == 2) { ob[1].x = p0; ob[1].y = p1; } else { ob[1].z = p0; ob[1].w = p1; }
        const f32x4 h8 = h4 * S_HF8;
        int w0 = __builtin_amdgcn_cvt_pk_fp8_f32(clamp8(h8.x), clamp8(h8.y), 0, false); w0 = __builtin_amdgcn_cvt_pk_fp8_f32(clamp8(h8.z), clamp8(h8.w), w0, true);
        if (j == 0) o8.x = (unsigned)w0; else if (j == 1) o8.y = (unsigned)w0; else if (j == 2) o8.z = (unsigned)w0; else o8.w = (unsigned)w0; }
    *(u32x4*)(hf + (size_t)row * D + c0) = ob[0]; *(u32x4*)(hf + (size_t)row * D + c0 + 8) = ob[1];
    *(u32x4*)(hf8 + (size_t)row * D + c0) = o8;
}
__device__ __forceinline__ void top2_merge(float& a1, float& a2, float b1, float b2) { const float n1 = fmaxf(a1, b1); const float n2 = fmaxf(fminf(a1, b1), fmaxf(a2, b2)); a1 = n1; a2 = n2; }
__device__ __forceinline__ float sigm(float x) { return 1.f / (1.f + __expf(-x)); }
__device__ __forceinline__ void route_lane(const float* __restrict__ logits, const float* __restrict__ rbias, int* __restrict__ topk_e, float* __restrict__ topk_w, LAS unsigned* hist, int tok) {
    const float NEG = -3.0e38f;
    const float* row = logits + (size_t)(tok >> 8) * (256 * NE) + (tok & 255);
    float gs[8];
#pragma unroll
    for (int g = 0; g < 8; ++g) {
        float m1 = NEG, m2 = NEG;
        float sv[32];
#pragma unroll
        for (int i = 0; i < 32; ++i) sv[i] = row[(g * 32 + i) * 256];
#pragma unroll
        for (int q = 0; q < 8; ++q) {
            const f32x4 b4 = *(const f32x4*)(rbias + g * 32 + q * 4);
            const float v[4] = {sv[4 * q] + b4.x, sv[4 * q + 1] + b4.y, sv[4 * q + 2] + b4.z, sv[4 * q + 3] + b4.w};
#pragma unroll
            for (int j = 0; j < 4; ++j) { m2 = fmaxf(m2, fminf(m1, v[j])); m1 = fmaxf(m1, v[j]); }
        }
        gs[g] = m1 + m2;
        asm volatile("" ::: "memory");
    }
    int pc[8];
    { int run = 0;
#pragma unroll
      for (int g = 0; g < 8; ++g) { int rank = 0;
#pragma unroll
          for (int h = 0; h < 8; ++h) if (h != g) rank += (gs[h] > gs[g] || (gs[h] == gs[g] && h < g)) ? 1 : 0;
          run += (rank < 4) ? 1 : 0; pc[g] = run; } }
    float L[8]; int I[8];
#pragma unroll
    for (int i = 0; i < 8; ++i) { L[i] = NEG; I[i] = 0; }
#pragma unroll 1
    for (int k = 0; k < 4; ++k) {
        int gk = 0;
#pragma unroll
        for (int g = 0; g < 8; ++g) gk += (pc[g] <= k) ? 1 : 0;
        const int base = gk * 32;
        float sv[32];
#pragma unroll
        for (int i = 0; i < 32; ++i) sv[i] = row[(base + i) * 256];
#pragma unroll
        for (int q = 0; q < 8; ++q) {
            const f32x4 b4 = *(const f32x4*)(rbias + base + q * 4);
            const float cv[4] = {sv[4 * q] + b4.x, sv[4 * q + 1] + b4.y, sv[4 * q + 2] + b4.z, sv[4 * q + 3] + b4.w};
#pragma unroll
            for (int j = 0; j < 4; ++j) { float v = cv[j]; int idx = base + q * 4 + j;
#pragma unroll
                for (int i = 0; i < 8; ++i) { const bool gt = v > L[i]; const float tv = gt ? L[i] : v; const int ti = gt ? I[i] : idx; L[i] = gt ? v : L[i]; I[i] = gt ? idx : I[i]; v = tv; idx = ti; } }
        }
    }
    float w[8], wsum = 0.f;
#pragma unroll
    for (int i = 0; i < 8; ++i) { w[i] = row[I[i] * 256]; wsum += w[i]; }
    const float sc = 2.5f / wsum;
    *(u32x4*)(topk_e + tok * TOPK) = (u32x4){(unsigned)I[0], (unsigned)I[1], (unsigned)I[2], (unsigned)I[3]}; *(u32x4*)(topk_e + tok * TOPK + 4) = (u32x4){(unsigned)I[4], (unsigned)I[5], (unsigned)I[6], (unsigned)I[7]};
    *(f32x4*)(topk_w + tok * TOPK) = (f32x4){w[0] * sc, w[1] * sc, w[2] * sc, w[3] * sc}; *(f32x4*)(topk_w + tok * TOPK + 4) = (f32x4){w[4] * sc, w[5] * sc, w[6] * sc, w[7] * sc};
#pragma unroll
    for (int i = 0; i < 8; ++i) __hip_atomic_fetch_add(&hist[I[i]], 1u, __ATOMIC_RELAXED, __HIP_MEMORY_SCOPE_WORKGROUP);
}
__device__ __forceinline__ void build_tables(const unsigned* ctl, LAS unsigned* tab, const int tid) {
    if (tid < 64) {
        const int lane = tid;
        unsigned c[4], so = 0, st = 0;
#pragma unroll
        for (int j = 0; j < 4; ++j) { c[j] = __hip_atomic_load(ctl + CW_COUNT + lane * 4 + j, __ATOMIC_RELAXED, __HIP_MEMORY_SCOPE_AGENT); so += c[j]; st += (c[j] + 255u) >> 8; }
        unsigned io = so, it = st;
#pragma unroll
        for (int o = 1; o < 64; o <<= 1) { const unsigned a = __shfl_up(io, o), b = __shfl_up(it, o); if (lane >= o) { io += a; it += b; } }
        unsigned eo = io - so, et = it - st;
#pragma unroll
        for (int j = 0; j < 4; ++j) { tab[T_CNT + lane * 4 + j] = c[j]; tab[T_OFF + lane * 4 + j] = eo; tab[T_TILE + lane * 4 + j] = et; eo += c[j]; et += (c[j] + 255u) >> 8; }
        if (lane == 63) { tab[T_OFF + NE] = eo; tab[T_TILE + NE] = et; }
    }
    __syncthreads();
}
struct RowRaw { u32x4 y[9]; u32x4 t[2]; f32x2 st; };
__device__ __forceinline__ void final_load(RowRaw& R, const bf16_t* __restrict__ tb, const unsigned char* __restrict__ ybuf, const unsigned char* __restrict__ ysh, const float* __restrict__ stats, int row, int lane) {
    const int c0 = lane * 16;
#pragma unroll
    for (int k = 0; k < TOPK; ++k) R.y[k] = *(const u32x4*)(ybuf + ((size_t)row * TOPK + k) * D + c0);
    R.y[8] = *(const u32x4*)(ysh + (size_t)row * D + c0);
    R.t[0] = *(const u32x4*)(tb + (size_t)row * D + c0); R.t[1] = *(const u32x4*)(tb + (size_t)row * D + c0 + 8);
    R.st = *(const f32x2*)(stats + 2 * (size_t)row);
}
__device__ __forceinline__ void final_row(float* __restrict__ out, const RowRaw& R, const LAS float* cv  , int row, int lane) {
    asm volatile("" : "+v"(cv));
    const int c0 = lane * 16;
    f32x4 a[4], t[4], v[4]; float s = 0.f;
#pragma unroll
    for (int j = 0; j < 4; ++j) a[j] = (f32x4){0.f, 0.f, 0.f, 0.f};
#pragma unroll
    for (int k = 0; k < 9; ++k) { const unsigned w[4] = {R.y[k].x, R.y[k].y, R.y[k].z, R.y[k].w};
#pragma unroll
        for (int j = 0; j < 4; ++j) { const f32x2 lo = __builtin_amdgcn_cvt_pk_f32_fp8((int)w[j], false), hi = __builtin_amdgcn_cvt_pk_f32_fp8((int)w[j], true); a[j].x += lo.x; a[j].y += lo.y; a[j].z += hi.x; a[j].w += hi.y; } }
    unpack_t16r(R.t[0], R.t[1], t);
#pragma unroll
    for (int j = 0; j < 4; ++j) { const int col = c0 + 4 * j;
        const f32x4 x1 = (t[j] - R.st.x) * R.st.y * *(const LAS f32x4*)(cv + col) + *(const LAS f32x4*)(cv + 1024 + col);
        v[j] = x1 * ALPHA + *(const LAS f32x4*)(cv + 4096 + col) * a[j] * YINV;
        s += (v[j].x + v[j].y) + (v[j].z + v[j].w); }
    const float mean = wave_sum(s) * (1.f / D); float s2 = 0.f;
#pragma unroll
    for (int j = 0; j < 4; ++j) { v[j] = v[j] - mean; s2 += (v[j].x * v[j].x + v[j].y * v[j].y) + (v[j].z * v[j].z + v[j].w * v[j].w); }
    const float rstd = 1.f / sqrtf(wave_sum(s2) * (1.f / D) + LN_EPS);
#pragma unroll
    for (int j = 0; j < 4; ++j) { const int col = c0 + 4 * j;
        *(f32x4*)(out + (size_t)row * D + col) = v[j] * rstd * *(const LAS f32x4*)(cv + 2048 + col) + *(const LAS f32x4*)(cv + 3072 + col); }
}

#ifndef MK_PER_PHASE
#define MK_PER_PHASE 0
#endif
constexpr int N_PHASES = 13;
struct Args { Ctx X; int ph_lo, ph_hi; };
typedef __attribute__((address_space(4))) const Ctx* CtxCP;
__device__ __forceinline__ CtxCP ctx_ptr() { CtxCP p = (CtxCP)__builtin_amdgcn_kernarg_segment_ptr(); asm volatile("" : "+s"(p)); return p; }

__global__ void __launch_bounds__(NW * 64, 2) mk_fwd(Args args) {
    extern __shared__ __attribute__((aligned(16))) unsigned char lds_raw[];
    LAS unsigned char* lds = (LAS unsigned char*)lds_raw;
    LAS unsigned* tab = (LAS unsigned*)(lds + TAB_OFF);
    volatile LAS unsigned* MISC = (volatile LAS unsigned*)(lds + MISC_OFF);
#define PH_BEGIN \
    const __attribute__((address_space(4))) Ctx& X = *ctx_ptr(); unsigned char* ws = X.ws; (void)ws; \
    const int lane = lane_id(), wave = wave0, tid = wave0 * 64 + lane; (void)lane; (void)wave; (void)tid; \
    const int G = gridDim.x, bx = blockIdx.x; (void)G; (void)bx; \
    const int gw = bx * NW + wave, NGW = G * NW; (void)gw; (void)NGW; \
    const int gt = bx * (NW * 64) + tid, NGT = G * NW * 64; (void)gt; (void)NGT; \
    unsigned* ctl = (unsigned*)(ws + WS_CTL); float* mod = (float*)(ws + WS_MOD); float* rope = (float*)(ws + WS_ROPE); (void)ctl; (void)mod; (void)rope; \
    bf16_t* win_t = (bf16_t*)(ws + WS_WIN_T); bf16_t* wout_t = (bf16_t*)(ws + WS_WOUT_T); bf16_t* wr_t = (bf16_t*)(ws + WS_WR_T); (void)win_t; (void)wout_t; (void)wr_t; \
    bf16_t* wsgu_t = (bf16_t*)(ws + WS_WSGU_T); bf16_t* wsd_t = (bf16_t*)(ws + WS_WSD_T); bf16_t* wd_t = (bf16_t*)(ws + WS_WD_T); bf16_t* wgu_t = (bf16_t*)(ws + WS_WGU_T); (void)wsgu_t; (void)wsd_t; (void)wd_t; (void)wgu_t; \
    int* slot_ent = (int*)(ws + WS_SLOT_ENT); float* slot_w = (float*)(ws + WS_SLOT_W); int* topk_e = (int*)(ws + WS_TOPK_E); float* topk_w = (float*)(ws + WS_TOPK_W); (void)slot_ent; (void)slot_w; (void)topk_e; (void)topk_w; \
    bf16_t* ymix = (bf16_t*)(ws + WS_YMIX); bf16_t* proj = (bf16_t*)(ws + WS_PROJ); bf16_t* hbuf = (bf16_t*)(ws + WS_YMIX); (void)ymix; (void)proj; (void)hbuf; \
    float* logits = (float*)(ws + WS_LOGITS); bf16_t* shh = (bf16_t*)(ws + WS_SHH); bf16_t* hf = (bf16_t*)(ws + WS_HF); bf16_t* act = (bf16_t*)(ws + WS_ACT); (void)logits; (void)shh; (void)hf; (void)act; \
    unsigned char* ybuf = ws + WS_YBUF; float* out = X.out; (void)ybuf; (void)out;

    const int wave0 = __builtin_amdgcn_readfirstlane((int)threadIdx.x >> 6);
    for (int u = threadIdx.x; u < (LDS_BYTES - MISC_OFF) / 4; u += NW * 64) ((LAS unsigned*)(lds + MISC_OFF))[u] = 0u;
    __syncthreads();
    if (!MK_PER_PHASE) { unsigned* ctl0 = (unsigned*)(args.X.ws + WS_CTL); (void)xcd_barrier_post(ctl0 + CW_BAR, MISC + 8, wave0 == 0 && lane_id() == 0); }
    const int lo = args.ph_lo, hi = args.ph_hi;
#ifndef MK_DUP
#define MK_DUP -1
#endif
#define REPS(k) for (int _rep = 0; _rep < ((MK_DUP == (k) || (MK_DUP == 202 && (k) == 0)) ? 2 : 1); ++_rep)
#ifdef MK_ONLY
#define IN(k) ((k) == MK_ONLY)
#else
#define IN(k) (lo <= (k) && (k) < hi)
#endif
#define SEAM(k) SEAM2(k, (k) + 1)
#define SEAM2(k, k2) do { if (IN(k) && IN(k2)) { XcdBarrier _b; _b.bar = (unsigned*)(ctx_ptr()->ws + WS_CTL) + CW_BAR; _b.x = xb_xcc_id(); _b.st = (volatile LAS unsigned*)(lds + MISC_OFF) + 8; xcd_barrier(_b, wave0 == 0 && lane_id() == 0); } } while (0)

    REPS(0) if (IN(0)) { PH_BEGIN
        LAS float* scr = (LAS float*)(lds + wave * 16384);
        float* modp = (float*)(ws + WS_PROJ);
        for (int t = gw; t < 96 * 16; t += NGW) mod_task(X.c, X.w_ada, modp, t, lane);
        constexpr int I_IN = (D / 64) * (DIN / 32), I_OUT = (D / 64) * (D / 32), I_R = (D / 64) * (NE / 32), I_SG = (D / 64) * (DE / 32), I_SD = (DE / 64) * (D / 32);
        constexpr int I_EG = I_SG, I_ED = I_SD;
        constexpr int N_SMALL = I_IN + I_OUT + I_R + 2 * I_SG + I_SD;
        constexpr int N_ITEMS = N_SMALL + NE * (2 * I_EG + I_ED);
#if MK_DUP == 200 || MK_DUP == 201
        for (int it = gw; it < NE * (2 * I_EG + I_ED); it += NGW) {
            int r = it; const int e = r / (2 * I_EG + I_ED); r -= e * (2 * I_EG + I_ED);
            const float* W; int K, N;
            if (r < I_EG) { W = X.w_gate + (size_t)e * D * DE; K = D; N = DE; } else if (r < 2 * I_EG) { r -= I_EG; W = X.w_up + (size_t)e * D * DE; K = D; N = DE; } else { r -= 2 * I_EG; W = X.w_down + (size_t)e * DE * D; K = DE; N = D; }
            const int nblk = N / 32, kb = r / nblk, nb = r % nblk, k0 = 64 * kb, n0 = 32 * nb; float sum = 0.f;
#if MK_DUP == 200
            float v[32];
#pragma unroll
            for (int i = 0; i < 32; ++i) { const int kk = 2 * i + (lane >> 5); v[i] = __builtin_nontemporal_load(W + (size_t)(k0 + kk) * N + n0 + (lane & 31)); }
#pragma unroll
            for (int i = 0; i < 32; ++i) sum += v[i];
#else
            f32x4 v[8];
#pragma unroll
            for (int i = 0; i < 8; ++i) { const int kk = 8 * i + (lane >> 3); v[i] = __builtin_nontemporal_load((const f32x4*)(W + (size_t)(k0 + kk) * N + n0 + 4 * (lane & 7))); }
#pragma unroll
            for (int i = 0; i < 8; ++i) sum += (v[i].x + v[i].y) + (v[i].z + v[i].w);
#endif
            if (sum == 123.456f) modp[it] = sum;
        }
#endif
        for (int it = gw; it < N_SMALL; it += NGW) {
            int r = it;
            if (r < I_IN) { transpose_item_fp8(X.w_in, D, DIN, (unsigned char*)win_t, 0, 0, S_WIN8, scr, r, lane); continue; } r -= I_IN;
            if (r < I_OUT) { transpose_item_fp8(X.w_out, D, D, (unsigned char*)wout_t, 0, 0, S_WIN8, scr, r, lane); continue; } r -= I_OUT;
            if (r < I_R) { transpose_item(X.w_router, D, NE, wr_t, 0, 0, scr, r, lane); continue; } r -= I_R;
            if (r < I_SG) { transpose_item_fp8(X.ws_gate, D, DE, (unsigned char*)wsgu_t, 8, 0, S_WGU8, scr, r, lane); continue; } r -= I_SG;
            if (r < I_SG) { transpose_item_fp8(X.ws_up, D, DE, (unsigned char*)wsgu_t, 8, 1, S_WGU8, scr, r, lane); continue; } r -= I_SG;
            transpose_item(X.ws_down, DE, D, wsd_t, 0, 0, scr, r, lane);
        }
        {
            constexpr int I_E = (D / 128) * (DE / 32), PER_E = 3 * I_E, N_EXP = NE * PER_E;
            static_assert((DE / 128) * (D / 32) == I_E, "item count");
            f32x4 v[16];
            const float* W = X.w_gate; unsigned char* WT = (unsigned char*)wgu_t; int K = D, N = DE, G8 = 8, which = 0, k0 = 0, n0 = 0; float scale = S_WGU8;
            const int kq = lane >> 3, nq = lane & 7;
            LAS unsigned char* sb = (LAS unsigned char*)scr;
#define P0_DECODE(it_) do { int _r = (it_); const int _e = _r / PER_E; _r -= _e * PER_E; const int _t = _r / I_E; _r -= _t * I_E; \
                if (_t < 2) { which = _t; W = (_t ? X.w_up : X.w_gate) + (size_t)_e * D * DE; K = D; N = DE; WT = (unsigned char*)wgu_t + (size_t)_e * 512 * D; G8 = 8; scale = S_WGU8; } \
                else { W = X.w_down + (size_t)_e * DE * D; K = DE; N = D; WT = (unsigned char*)wd_t + (size_t)_e * D * DE; G8 = 0; which = 0; scale = S_WD8; } \
                const int _nblk = N / 32; k0 = 128 * (_r / _nblk); n0 = 32 * (_r % _nblk); } while (0)
#define P0_LOAD() do { _Pragma("unroll") for (int _j = 0; _j < 4; ++_j) _Pragma("unroll") for (int _t = 0; _t < 4; ++_t) \
                v[4 * _j + _t] = __builtin_nontemporal_load((const f32x4*)(W + (size_t)(k0 + 4 * (8 * _j + kq) + _t) * N + n0 + 4 * nq)); } while (0)
#define P0_CVT4(x_) ({ const f32x4 _x = (x_) * cs; const float _c0 = clamp8(_x.x); int _w = __builtin_amdgcn_cvt_pk_fp8_f32(_c0, clamp8(_x.y), __float_as_int(_c0), false); (unsigned)__builtin_amdgcn_cvt_pk_fp8_f32(clamp8(_x.z), clamp8(_x.w), _w, true); })
            int it = gw;
            if (it < N_EXP) { P0_DECODE(it); P0_LOAD(); }
#pragma unroll 1
            while (it < N_EXP) {
                unsigned char* cWT = WT; const int cK = K, cG = G8, cwhich = which, ck0 = k0, cn0 = n0; const float cs = scale;
#pragma unroll
                for (int j = 0; j < 4; ++j) {
                    const unsigned d0 = P0_CVT4(v[4 * j + 0]), d1 = P0_CVT4(v[4 * j + 1]), d2 = P0_CVT4(v[4 * j + 2]), d3 = P0_CVT4(v[4 * j + 3]);
                    const unsigned x0 = __builtin_amdgcn_perm(d1, d0, 0x05010400u), x1 = __builtin_amdgcn_perm(d1, d0, 0x07030602u), y0 = __builtin_amdgcn_perm(d3, d2, 0x05010400u), y1 = __builtin_amdgcn_perm(d3, d2, 0x07030602u);
                    const unsigned e0 = __builtin_amdgcn_perm(y0, x0, 0x05040100u), e1 = __builtin_amdgcn_perm(y0, x0, 0x07060302u), e2 = __builtin_amdgcn_perm(y1, x1, 0x05040100u), e3 = __builtin_amdgcn_perm(y1, x1, 0x07060302u);
                    LAS unsigned char* wp = sb + (4 * nq) * 144 + 4 * (8 * j + kq);
                    *(LAS unsigned*)(wp) = e0; *(LAS unsigned*)(wp + 144) = e1; *(LAS unsigned*)(wp + 288) = e2; *(LAS unsigned*)(wp + 432) = e3;
                }
                const int itn = it + NGW;
                if (itn < N_EXP) { P0_DECODE(itn); P0_LOAD(); }
                LDS_WAIT(); asm volatile("" ::: "memory");
#pragma unroll
                for (int j2 = 0; j2 < 4; ++j2) { const int n = (lane >> 3) + 8 * j2; const u32x4 o = *(const LAS u32x4*)(sb + n * 144 + 16 * (lane & 7));
                    const int ng = cn0 + n; const int drow = cG ? ((ng >> 3) * 16 + cwhich * 8 + (ng & 7)) : ng;
                    *(u32x4*)(cWT + (size_t)drow * cK + ck0 + 16 * (lane & 7)) = o; }
                LDS_WAIT(); asm volatile("" ::: "memory");
                it = itn;
            }
#undef P0_DECODE
#undef P0_LOAD
#undef P0_CVT4
        }
        for (int i = gt; i < SEQ * 64; i += NGT) rope_entry(rope, i);
    }
    SEAM(0);
    REPS(1) if (IN(1)) { PH_BEGIN
        const float* modp = (const float*)(ws + WS_PROJ);
        for (int i = gt; i < 32 * 6144; i += NGT) mod[i] = mod_sum(modp, X.b_ada, i / 6144, i % 6144);
        LAS float* ssc = (LAS float*)lds; LAS float* ssh = ssc + 1024;
        int curb = -1;
        for (int c = bx; c < M / 256; c += G) {
            const int b = c >> 3;
            if (b != curb) {
                __syncthreads();
                for (int i = tid; i < 1024; i += NW * 64) { ssc[i] = 1.f + mod_sum(modp, X.b_ada, b, MOD_SCALE_A + i); ssh[i] = mod_sum(modp, X.b_ada, b, MOD_SHIFT_A + i); }
                __syncthreads();
                curb = b;
            }
            const f32x4 sc = *(const LAS f32x4*)(ssc + (tid & 255) * 4), sh = *(const LAS f32x4*)(ssh + (tid & 255) * 4);
            const float* xp = X.x + (size_t)c * 256 * D + (size_t)(tid >> 8) * D + (tid & 255) * 4;
            unsigned char* hp = (unsigned char*)hbuf + (size_t)c * 256 * D + (size_t)(tid >> 8) * D + (tid & 255) * 4;
            for (int i0 = 0; i0 < 128; i0 += 8) {
                f32x4 v[8];
#pragma unroll
                for (int i = 0; i < 8; ++i) v[i] = __builtin_nontemporal_load((const f32x4*)(xp + (size_t)(i0 + i) * 2 * D));
#pragma unroll
                for (int i = 0; i < 8; ++i) { int w = __builtin_amdgcn_cvt_pk_fp8_f32(clamp8((v[i].x * sc.x + sh.x) * S_H8), clamp8((v[i].y * sc.y + sh.y) * S_H8), 0, false);
                    w = __builtin_amdgcn_cvt_pk_fp8_f32(clamp8((v[i].z * sc.z + sh.z) * S_H8), clamp8((v[i].w * sc.w + sh.w) * S_H8), w, true); *(unsigned*)(hp + (size_t)(i0 + i) * 2 * D) = (unsigned)w; }
            }
        }
        __syncthreads();
    }
    SEAM(1);
    REPS(2) if (IN(2)) { PH_BEGIN
        pg8::DenseOrder S; S.init(M, DIN, D / 2, win_t, G, bx);
        pg8::EpiInProj E{proj};
        pg8::gemm_phase<1>(lds, (const char*)hbuf, D, S, E, tid);
    }
    SEAM(2);
    REPS(3) if (IN(3)) { PH_BEGIN
        REPS(31) for (int hu = bx; hu < BATCH * 4 * 2; hu += G) ret::unit(proj, rope, X.ret_ld, X.ret_gn, ymix, (unsigned char*)out + (size_t)hu * (8 * ret::TILE), lds, hu, tid);
        REPS(32) for (int u = bx; u < BATCH * 8; u += G) na::unit(proj, X.na_rpb, ymix, lds, u, tid);
    }
    SEAM2(3, 5);
    if (IN(5)) { PH_BEGIN
        LAS float* cv = (LAS float*)lds; LAS unsigned* hist = tab + T_HIST;
        if (tid < NE) hist[tid] = 0u;
        __syncthreads();
        for (int c = bx; c < M / 256; c += G) {
            const int b = c >> 3;
            { pg8::RowOrder S{c, 4, D / 2, (const char*)wout_t}; pg8::EpiOutProj E{X.x, mod, (bf16_t*)(ws + WS_TB)}; pg8::gemm_phase<1>(lds, (const char*)ymix, D, S, E, tid); }
            asm volatile("s_waitcnt vmcnt(0)" ::: "memory"); __syncthreads();
            int lane2 = lane; asm volatile("" : "+v"(lane2));
            const int tid2 = wave * 64 + lane2;
            if (tid2 < 256) { const int i = tid2 * 4; *(LAS f32x4*)(cv + i) = *(const f32x4*)(X.ln1_g + i); *(LAS f32x4*)(cv + 1024 + i) = *(const f32x4*)(X.ln1_b + i);
                *(LAS f32x4*)(cv + 2048 + i) = *(const f32x4*)(mod + b * 6144 + MOD_SCALE_F + i) + 1.f; *(LAS f32x4*)(cv + 3072 + i) = *(const f32x4*)(mod + b * 6144 + MOD_SHIFT_F + i); }
            __syncthreads();
            { const bf16_t* tp = (const bf16_t*)(ws + WS_TB) + (size_t)(c * 256 + wave * 32) * D + lane2 * 16;
              u32x4 ra = *(const u32x4*)tp, rb = *(const u32x4*)(tp + 8);
#pragma unroll 1
              for (int i = 0; i < 32; ++i) {
                  const u32x4 ca = ra, cb = rb; const int nx = i < 31 ? i + 1 : i;
                  ra = *(const u32x4*)(tp + (size_t)nx * D); rb = *(const u32x4*)(tp + (size_t)nx * D + 8);
                  ln1_row(ca, cb, cv, hf, ws + WS_HF8, (float*)(ws + WS_STATS), c * 256 + wave * 32 + i, lane2);
              } }
            asm volatile("s_waitcnt vmcnt(0)" ::: "memory"); __syncthreads();
            { pg8::RowOrder S{c, 1, D, (const char*)wr_t}; pg8::EpiRouter E{logits}; pg8::gemm_phase(lds, (const char*)hf, D, S, E, tid); }
            { pg8::RowOrder S{c, 2, D / 2, (const char*)wsgu_t}; pg8::EpiGU<false, true> E{(void*)shh}; pg8::gemm_phase<1>(lds, (const char*)(ws + WS_HF8), D, S, E, tid); }
            asm volatile("s_waitcnt vmcnt(0)" ::: "memory"); __syncthreads();
            { int lane3 = lane; asm volatile("" : "+v"(lane3)); const int tid3 = wave * 64 + lane3;
              if (tid3 < 256) route_lane(logits, X.rbias, topk_e, topk_w, hist, c * 256 + tid3); }
        }
        __syncthreads();
        if (tid < NE && hist[tid]) atomicAdd(&ctl[CW_COUNT + tid], hist[tid]);
    }
    SEAM2(5, 9);
    if (IN(9)) { PH_BEGIN
        build_tables(ctl, tab, tid);
        LAS unsigned* hist = tab + T_HIST; LAS unsigned* base = tab + T_BASE;
        for (int c0 = bx * 2048; c0 < NSLOT; c0 += G * 2048) {
            __syncthreads();
            if (tid < NE) hist[tid] = 0u;
            __syncthreads();
            int e[4]; unsigned loc[4];
#pragma unroll
            for (int i = 0; i < 4; ++i) { const int idx = c0 + i * 512 + tid; e[i] = topk_e[idx]; loc[i] = __hip_atomic_fetch_add(&hist[e[i]], 1u, __ATOMIC_RELAXED, __HIP_MEMORY_SCOPE_WORKGROUP); }
            __syncthreads();
            if (tid < NE && hist[tid]) base[tid] = atomicAdd(&ctl[CW_CURSOR + tid], hist[tid]);
            __syncthreads();
#pragma unroll
            for (int i = 0; i < 4; ++i) { const int idx = c0 + i * 512 + tid; const unsigned pos = tab[T_OFF + e[i]] + base[e[i]] + loc[i]; slot_ent[pos] = idx; slot_w[pos] = topk_w[idx]; }
        }
    }
    SEAM(9);
    if (IN(10)) { PH_BEGIN
        build_tables(ctl, tab, tid);
        REPS(10) { pg8::ExpertOrder<2, true> S; S.init(tab, D, wgu_t, (size_t)512 * D, slot_ent, slot_w, G, bx); pg8::EpiGU<true> E{(void*)act}; pg8::gemm_phase<1>(lds, (const char*)(ws + WS_HF8), D, S, E, tid); }
        { pg8::DenseOrder S; S.init(M, D, DE, wsd_t, G, bx); pg8::EpiSharedDown E{ws + WS_YSH}; pg8::gemm_phase(lds, (const char*)shh, DE, S, E, tid); }
    }
    SEAM(10);
    REPS(11) if (IN(11)) { PH_BEGIN
        build_tables(ctl, tab, tid);
#if MK_DUP >= 113 && MK_DUP <= 118
        pg8::down2_phase<MK_DUP - 112>(lds, tab, (const char*)act, (const char*)wd_t, slot_ent, ybuf, G, bx, tid);
#endif
        pg8::down2_phase(lds, tab, (const char*)act, (const char*)wd_t, slot_ent, ybuf, G, bx, tid);
#if MK_DUP == 111
        { pg8::ExpertOrder<4, false> S2; S2.init(tab, DE, wd_t, (size_t)D * DE, slot_ent, slot_w, G, bx); pg8::EpiProbeSum E2{(float*)(ws + WS_STATS)}; pg8::gemm_phase<1>(lds, (const char*)act, DE, S2, E2, tid); }
#endif
    }
    SEAM(11);
    REPS(12) if (IN(12)) { PH_BEGIN
        LAS float* cv = (LAS float*)lds; int curb = -1;
        for (int c = bx; c < M / 256; c += G) {
            const int b = c >> 3;
            if (b != curb) {
                __syncthreads();
                if (tid < 256) { const int i = tid * 4; *(LAS f32x4*)(cv + i) = *(const f32x4*)(X.ln1_g + i); *(LAS f32x4*)(cv + 1024 + i) = *(const f32x4*)(X.ln1_b + i);
                    *(LAS f32x4*)(cv + 2048 + i) = *(const f32x4*)(X.ln2_g + i); *(LAS f32x4*)(cv + 3072 + i) = *(const f32x4*)(X.ln2_b + i); *(LAS f32x4*)(cv + 4096 + i) = *(const f32x4*)(mod + b * 6144 + MOD_GATE_F + i); }
                __syncthreads(); curb = b;
            }
            const int r0 = c * 256 + wave * 32;
            RowRaw nx; final_load(nx, (const bf16_t*)(ws + WS_TB), ybuf, ws + WS_YSH, (const float*)(ws + WS_STATS), r0, lane);
#pragma unroll 1
            for (int i = 0; i < 32; ++i) {
                const RowRaw cur = nx;
                final_load(nx, (const bf16_t*)(ws + WS_TB), ybuf, ws + WS_YSH, (const float*)(ws + WS_STATS), r0 + (i < 31 ? i + 1 : i), lane);
                final_row(out, cur, cv, r0 + i, lane);
            }
        }
    }
#undef IN
#undef SEAM
}

extern "C" void kernel_launch(void* const* d_in, const int* in_sizes, int n_in, void* d_out, int out_size, void* d_ws, size_t ws_size, hipStream_t stream) {
    static int grid = 0;
    if (grid == 0) {
        if (n_in != 21 || in_sizes[0] != M * D || out_size != M * D || ws_size < WS_END) { fprintf(stderr, "kernel_launch: unexpected shapes (n_in %d, ws %zu)\n", n_in, ws_size); grid = -1; return; }
        int dev = 0, cus = 0, per_cu = 0;
        if (hipGetDevice(&dev) != hipSuccess || hipDeviceGetAttribute(&cus, hipDeviceAttributeMultiprocessorCount, dev) != hipSuccess) { grid = -1; return; }
        if (hipFuncSetAttribute((const void*)mk_fwd, hipFuncAttributeMaxDynamicSharedMemorySize, LDS_BYTES) != hipSuccess) { fprintf(stderr, "kernel_launch: hipFuncSetAttribute failed\n"); grid = -1; return; }
        if (hipOccupancyMaxActiveBlocksPerMultiprocessor(&per_cu, (const void*)mk_fwd, NW * 64, LDS_BYTES) != hipSuccess || per_cu < 1) { fprintf(stderr, "kernel_launch: occupancy query says %d\n", per_cu); }
        (void)hipGetLastError();
        grid = cus;
    }
    if (grid < 0) return;
    (void)hipMemsetAsync((char*)d_ws + WS_CTL, 0, 1 * MiB, stream);
    Args a{};
    const float** p = (const float**)&a.X;
    for (int i = 0; i < 21; ++i) p[i] = (const float*)d_in[i];
    a.X.out = (float*)d_out; a.X.ws = (unsigned char*)d_ws;
#if MK_PER_PHASE
    for (int ph = 0; ph < N_PHASES; ++ph) { a.ph_lo = ph; a.ph_hi = ph + 1; hipLaunchKernelGGL(mk_fwd, dim3(grid), dim3(NW * 64), LDS_BYTES, stream, a); }
#else
    a.ph_lo = 0; a.ph_hi = N_PHASES;
    hipLaunchKernelGGL(mk_fwd, dim3(grid), dim3(NW * 64), LDS_BYTES, stream, a);
#endif
}
```

```cpp
#include <hip/hip_runtime.h>
#include <cstdio>
#include <cstdint>

typedef unsigned short bf16_t;
typedef short bf16x8 __attribute__((ext_vector_type(8)));
typedef float f32x4 __attribute__((ext_vector_type(4)));
typedef float f32x2 __attribute__((ext_vector_type(2)));
typedef unsigned u32x4 __attribute__((ext_vector_type(4)));
typedef unsigned u32x2 __attribute__((ext_vector_type(2)));
#define LAS __attribute__((address_space(3)))

constexpr int D = 1024, BATCH = 32, SEQ = 2048, M = BATCH * SEQ;
constexpr int DIN = 3584;
constexpr int OFF_QNA = 0, OFF_KNA = 512, OFF_VNA = 1024, OFF_QR = 1536, OFF_KR = 2048, OFF_VR = 2560, OFF_GR = 3072;
constexpr int NE = 256, TOPK = 8, DE = 256;
constexpr int NSLOT = M * TOPK;
constexpr float LN_EPS = 1e-5f, GN_EPS = 1e-6f;
constexpr float ALPHA = 1.189207115002721f;
constexpr float YSCALE = 64.f, YINV = 1.f / 64.f;
constexpr float S_HF8 = 16.f, S_WGU8 = 256.f, S_ACT8 = 8.f, S_WD8 = 8.f;
constexpr float INV_GU8 = 1.f / (16.f * 256.f), INV_DN8 = 1.f / (8.f * 8.f);
static_assert(YSCALE * INV_DN8 == 1.f, "down-projection epilogue assumes no rescale");
constexpr float S_H8 = 16.f, S_WIN8 = 128.f, INV_IN8 = 1.f / (16.f * 128.f);
constexpr int MOD_SHIFT_A = 0, MOD_SCALE_A = 1024, MOD_GATE_A = 2048, MOD_SHIFT_F = 3072, MOD_SCALE_F = 4096, MOD_GATE_F = 5120;

constexpr size_t MiB = 1u << 20;
constexpr size_t WS_CTL = 0;
constexpr size_t WS_MOD = 1 * MiB;
constexpr size_t WS_ROPE = 2 * MiB;
constexpr size_t WS_WIN_T = 4 * MiB;
constexpr size_t WS_WOUT_T = 11 * MiB;
constexpr size_t WS_WR_T = 13 * MiB;
constexpr size_t WS_WSGU_T = 14 * MiB;
constexpr size_t WS_WSD_T = 15 * MiB;
constexpr size_t WS_SLOT_ENT = 16 * MiB;
constexpr size_t WS_SLOT_W = 18 * MiB;
constexpr size_t WS_TOPK_E = 20 * MiB;
constexpr size_t WS_TOPK_W = 22 * MiB;
constexpr size_t WS_STATS = 24 * MiB;
constexpr size_t WS_WD_T = 32 * MiB;
constexpr size_t WS_WGU_T = 160 * MiB;
constexpr size_t WS_HF8 = 288 * MiB;
constexpr size_t WS_YMIX = 416 * MiB;
constexpr size_t WS_PROJ = 544 * MiB;
constexpr size_t WS_LOGITS = WS_PROJ + 384 * MiB;
constexpr size_t WS_SHH = 352 * MiB;
constexpr size_t WS_HF = WS_PROJ, WS_ACT = WS_PROJ + 128 * MiB;
constexpr size_t WS_YBUF = WS_WGU_T;
constexpr size_t WS_TB = WS_PROJ + 256 * MiB;
constexpr size_t WS_YSH = WS_PROJ + 384 * MiB;
constexpr size_t WS_END = 992 * MiB;
constexpr int CW_COUNT = 1024, CW_CURSOR = 1536, CW_BAR = 8192;

constexpr int RING_BYTES = 131072;
constexpr int TAB_OFF = RING_BYTES;
constexpr int T_OFF = 0, T_TILE = 260, T_CNT = 520, T_HIST = 776, T_BASE = 1032, TAB_WORDS = 1288;
constexpr int VN_OFF = TAB_OFF + 6144;
constexpr int ROWTAB_OFF = VN_OFF + 8192;
constexpr int PHASE_BYTES = 155648;
constexpr int MISC_OFF = PHASE_BYTES;
constexpr int LDS_BYTES = PHASE_BYTES + 256;
static_assert(TAB_WORDS * 4 <= 6144 && ROWTAB_OFF + 6144 <= PHASE_BYTES && LDS_BYTES <= 163840, "LDS map");

__device__ __forceinline__ unsigned f2bf(float f) { unsigned u = __float_as_uint(f); return (u + 0x7fffu + ((u >> 16) & 1u)) >> 16; }
__device__ __forceinline__ float bf2f(unsigned short h) { return __uint_as_float(((unsigned)h) << 16); }
__device__ __forceinline__ unsigned pk2(float lo, float hi) { return f2bf(lo) | (f2bf(hi) << 16); }
__device__ __forceinline__ unsigned cvt_pk_bf16(float lo, float hi) { unsigned r; asm volatile("v_cvt_pk_bf16_f32 %0, %1, %2" : "=v"(r) : "v"(lo), "v"(hi)); return r; }
__device__ __forceinline__ float silu_f(float v) { return v * __builtin_amdgcn_rcpf(1.f + __expf(-v)); }
__device__ __forceinline__ float wave_sum(float v) {
    v += __builtin_bit_cast(float, __builtin_amdgcn_update_dpp(0, __builtin_bit_cast(int, v), 0xB1, 0xf, 0xf, true));
    v += __builtin_bit_cast(float, __builtin_amdgcn_update_dpp(0, __builtin_bit_cast(int, v), 0x4E, 0xf, 0xf, true));
    v += __builtin_bit_cast(float, __builtin_amdgcn_update_dpp(0, __builtin_bit_cast(int, v), 0x141, 0xf, 0xf, true));
    v += __builtin_bit_cast(float, __builtin_amdgcn_update_dpp(0, __builtin_bit_cast(int, v), 0x140, 0xf, 0xf, true));
    const int b = __builtin_bit_cast(int, v);
    return (__builtin_bit_cast(float, __builtin_amdgcn_readlane(b, 0)) + __builtin_bit_cast(float, __builtin_amdgcn_readlane(b, 16))) + (__builtin_bit_cast(float, __builtin_amdgcn_readlane(b, 32)) + __builtin_bit_cast(float, __builtin_amdgcn_readlane(b, 48)));
}
__device__ __forceinline__ float clamp8(float v) { return __builtin_amdgcn_fmed3f(v, -440.f, 440.f); }
#define LDS_WAIT() asm volatile("s_waitcnt lgkmcnt(0)" ::: "memory")
__device__ __forceinline__ int lane_id() { return (int)__builtin_amdgcn_mbcnt_hi(~0u, __builtin_amdgcn_mbcnt_lo(~0u, 0u)); }

#define XB_TMO      128
#define XB_XCNT(j)  (256  + 64 * (j))
#define XB_XSUB(j)  (1280 + 64 * (j))
#define XB_XGEN(j)  (2304 + 64 * (j))
#define XB_TOP      3328
#define XB_TOPGEN   3392
#define XCD_BAR_WORDS 3456
#define XB_SPIN_CAP (1u << 23)
__device__ __forceinline__ unsigned xb_ld(unsigned* p)              { return __hip_atomic_load(p, __ATOMIC_RELAXED, __HIP_MEMORY_SCOPE_AGENT); }
__device__ __forceinline__ unsigned xb_add(unsigned* p, unsigned v) { return __hip_atomic_fetch_add(p, v, __ATOMIC_RELAXED, __HIP_MEMORY_SCOPE_AGENT); }
__device__ __forceinline__ unsigned xb_xcc_id() { return (unsigned)__builtin_amdgcn_s_getreg((3 << 11) | 20) & 0xFu; }
#define XB_SPIN(cond, bar) do { unsigned _sp = 0; while (cond) { __builtin_amdgcn_s_sleep(1); \
    if ((++_sp & 255u) == 0u) { if (xb_ld(&(bar)[XB_TMO])) break; if (_sp > XB_SPIN_CAP) { atomicAdd(&(bar)[XB_TMO], 1u); break; } } } } while (0)
struct XcdBarrier { unsigned* bar; unsigned x; volatile LAS unsigned* st; };
__device__ __forceinline__ XcdBarrier xcd_barrier_post(unsigned* bar, volatile LAS unsigned* st, bool leader) {
    XcdBarrier b; b.bar = bar; b.x = xb_xcc_id(); b.st = st;
    if (leader) (void)xb_add(&bar[XB_XCNT(b.x)], 1u);
    return b;
}
__device__ __forceinline__ void xcd_barrier_complete(unsigned* bar, unsigned x, unsigned& nloc, unsigned& nx) {
    const unsigned G = gridDim.x * gridDim.y * gridDim.z;
    unsigned sum, cnt, mine, sp = 0u;
    for (;;) {
        sum = 0u; cnt = 0u; mine = 0u;
#pragma unroll
        for (unsigned j = 0; j < 16; ++j) { const unsigned c = xb_ld(&bar[XB_XCNT(j)]); sum += c; cnt += (c > 0u) ? 1u : 0u; mine = (j == x) ? c : mine; }
        if (sum == G) break;
        __builtin_amdgcn_s_sleep(1);
        if ((++sp & 255u) == 0u) { if (xb_ld(&bar[XB_TMO])) break; if (sp > XB_SPIN_CAP) { atomicAdd(&bar[XB_TMO], 1u); break; } }
    }
    nloc = mine > 0u ? mine : 1u; nx = cnt > 0u ? cnt : 1u;
}
__device__ __forceinline__ void xcd_barrier(const XcdBarrier& b, bool leader) {
    asm volatile("s_waitcnt vmcnt(0)" ::: "memory");
    __syncthreads();
    if (leader) {
        unsigned* bar = b.bar;
        __builtin_amdgcn_s_waitcnt(0);
        unsigned nloc = b.st[0], nx = b.st[1];
        if (nloc == 0u) { xcd_barrier_complete(bar, b.x, nloc, nx); b.st[0] = nloc; b.st[1] = nx; }
        const unsigned old = xb_add(&bar[XB_XSUB(b.x)], 1u);
        const unsigned gen = old / nloc;
        if (old + 1u == (gen + 1u) * nloc) {
            __builtin_amdgcn_fence(__ATOMIC_RELEASE, "agent");
            asm volatile("s_waitcnt vmcnt(0)" ::: "memory");
            const unsigned og = xb_add(&bar[XB_TOP], 1u);
            const unsigned tg = og / nx;
            if (og + 1u == (tg + 1u) * nx) xb_add(&bar[XB_TOPGEN], 1u);
            else XB_SPIN(xb_ld(&bar[XB_TOPGEN]) == tg, bar);
            __builtin_amdgcn_fence(__ATOMIC_ACQUIRE, "agent");
            xb_add(&bar[XB_XGEN(b.x)], 1u);
            asm volatile("s_waitcnt vmcnt(0)" ::: "memory");
        } else {
            XB_SPIN(xb_ld(&bar[XB_XGEN(b.x)]) == gen, bar);
            __builtin_amdgcn_fence(__ATOMIC_ACQUIRE, "agent");
            asm volatile("s_waitcnt vmcnt(0)" ::: "memory");
        }
    }
    __syncthreads();
}

namespace pg8 {
constexpr int BM = 256, BK = 64, HALF = 128, HTB = HALF * BK * 2, STAGE_BYTES = 8 * HTB;
__device__ __forceinline__ int lds_byte(int r, int c) { const int st = (r >> 4) * 2 + (c >> 5), rr = r & 15, cc = c & 31, ob = rr * 64 + cc * 2; return st * 1024 + (ob ^ (((ob >> 9) & 1) << 5)); }
__device__ __forceinline__ void stage_rc(int b, int& R, int& C) { const int st = b / 1024, sb = b % 1024, swz = sb ^ (((sb >> 9) & 1) << 5); R = (st >> 1) * 16 + swz / 64; C = (st & 1) * 32 + (swz % 64) / 2; }
__device__ __forceinline__ int perm32(int rho) { const int n = rho >> 4, i = rho & 15; return 8 * (i >> 2) + 4 * n + (i & 3); }

typedef int i32x8 __attribute__((ext_vector_type(8)));
__device__ __forceinline__ i32x8 cat8(const bf16x8 lo, const bf16x8 hi) { const u32x4 a = __builtin_bit_cast(u32x4, lo), b = __builtin_bit_cast(u32x4, hi); return (i32x8){(int)a.x, (int)a.y, (int)a.z, (int)a.w, (int)b.x, (int)b.y, (int)b.z, (int)b.w}; }
struct Unit { int pm, pn; const char* B; int e, cnt, off; };

template <int ESZ = 2, bool AREUSE = false, class Epi, class Sched>
__device__ __forceinline__ void gemm_phase(LAS unsigned char* lds, const char* Abase, const int K, const Sched& S, const Epi& E, const int tid_in) {
    int tid_ = tid_in; asm volatile("" : "+v"(tid_));
    const int tid = tid_, wid = __builtin_amdgcn_readfirstlane(tid >> 6), lane = tid & 63, wr = wid >> 2, wc = wid & 3, fr = lane & 15, fq = lane >> 4;
    const int rowbytes = K * ESZ, nt = rowbytes / 128;
    int Rr[2], Cc[2]; unsigned voffB[2], voffA[2];
#pragma unroll
    for (int i = 0; i < 2; ++i) { int R, C; stage_rc(tid * 16 + i * 8192, R, C); Rr[i] = R; Cc[i] = C; const int Rb = Epi::PERM ? (64 * (R >> 5) + 16 * ((R >> 2) & 3) + 4 * ((R >> 4) & 1) + (R & 3)) : R; voffB[i] = (unsigned)(Rb * rowbytes + C * 2); voffA[i] = (unsigned)(R * rowbytes + C * 2); }
    constexpr bool GATHER = Sched::GATHER;
    const size_t kstep = (size_t)128;
    const size_t hstep = (size_t)HALF * rowbytes;
    const size_t bhstep = (size_t)(Epi::PERM ? 8 : HALF) * rowbytes;
    const unsigned ldsw = (unsigned)wid * 1024u;
    const int aoff = lds_byte(wr * 64 + fr, fq * 8);
    const int boff = lds_byte(wc * 32 + fr, fq * 8);
#define PG8_SA(b, h) (((b) * 2 + (h)) * HTB)
#define PG8_SB(b, h) ((4 + (b) * 2 + (h)) * HTB)
#define PG8_STAGE(bufoff, gbase, voff) do { _Pragma("unroll") for (int _i = 0; _i < 2; ++_i) \
        __builtin_amdgcn_global_load_lds((const unsigned*)((const char*)(gbase) + (voff)[_i]), (LAS unsigned*)(lds + (bufoff) + ldsw + _i * 8192), 16, 0, 0); } while (0)
#define PG8_STAGEA(bufoff, uptr, koff, NEXT, h) do { if constexpr (GATHER) { if (NEXT) { const u32x2 _t = *(const LAS u32x2*)(vnslot + 2 * (h)); unsigned _v[2] = {_t.x, _t.y}; PG8_STAGE(bufoff, Abase + (koff), _v); } else { PG8_STAGE(bufoff, Abase + (koff), vc[h]); } } \
        else { PG8_STAGE(bufoff, (uptr) + (size_t)(h) * hstep + (koff), voffA); } } while (0)
#define PG8_LDA(dst, b, h) do { _Pragma("unroll") for (int m = 0; m < 4; ++m) { if constexpr (ESZ == 2) { _Pragma("unroll") for (int k = 0; k < 2; ++k) dst[m].q[k] = *(const LAS bf16x8*)(lds + PG8_SA(b, h) + aoff + m * 2048 + k * 1024); } \
        else dst[m].w = cat8(*(const LAS bf16x8*)(lds + PG8_SA(b, h) + aoff + m * 2048), *(const LAS bf16x8*)(lds + PG8_SA(b, h) + aoff + m * 2048 + 1024)); } } while (0)
#define PG8_LDB(dst, b, h) do { _Pragma("unroll") for (int n = 0; n < 2; ++n) { if constexpr (ESZ == 2) { _Pragma("unroll") for (int k = 0; k < 2; ++k) dst[n].q[k] = *(const LAS bf16x8*)(lds + PG8_SB(b, h) + boff + n * 2048 + k * 1024); } \
        else dst[n].w = cat8(*(const LAS bf16x8*)(lds + PG8_SB(b, h) + boff + n * 2048), *(const LAS bf16x8*)(lds + PG8_SB(b, h) + boff + n * 2048 + 1024)); } } while (0)
#define PG8_MMA(ai, bj, At, Bt) do { __builtin_amdgcn_s_setprio(1); _Pragma("unroll") for (int m = 0; m < 4; ++m) _Pragma("unroll") for (int n = 0; n < 2; ++n) { \
        if constexpr (ESZ == 2) { _Pragma("unroll") for (int k = 0; k < 2; ++k) acc[ai][bj][m][n] = __builtin_amdgcn_mfma_f32_16x16x32_bf16(Bt[n].q[k], At[m].q[k], acc[ai][bj][m][n], 0, 0, 0); } \
        else { asm volatile("v_mfma_f32_16x16x128_f8f6f4 %0, %1, %2, %0" : "+v"(acc[ai][bj][m][n]) : "v"(Bt[n].w), "v"(At[m].w)); } } \
        __builtin_amdgcn_s_setprio(0); } while (0)
#define PG8_WAIT_V(n) asm volatile("s_waitcnt vmcnt(" #n ")" ::: "memory")
#define PG8_WAIT_L(n) asm volatile("s_waitcnt lgkmcnt(" #n ")" ::: "memory")
#define PG8_BAR __builtin_amdgcn_s_barrier()
#define PG8_SCHED __builtin_amdgcn_sched_barrier(0)
    Unit cur, nxt; int ui = 0; bool fresh_cur = true;
    if (!S.next(0, cur)) return;
    f32x4 acc[2][2][4][2];
    union Frag { bf16x8 q[2]; i32x8 w; };
    Frag At[4], B0[2], B1[2];
    unsigned vc[2][2];
    LAS unsigned* vnslot = (LAS unsigned*)(lds + (VN_OFF - 0)) + tid * 4;
    if constexpr (GATHER) S.avoff(cur, Rr, Cc, vc, tid);
    LAS unsigned* rowtab = (LAS unsigned*)(lds + ROWTAB_OFF);
    if constexpr (GATHER) S.rowtab(cur, rowtab, tid);
    const char* cB = cur.B; const char* cA = Abase + S.aoff(cur);
    PG8_STAGE(PG8_SB(0, 0), cB, voffB); PG8_STAGE(PG8_SB(0, 1), cB + bhstep, voffB); PG8_STAGEA(PG8_SA(0, 0), cA, 0, false, 0); PG8_STAGEA(PG8_SA(0, 1), cA, 0, false, 1);
    if (wr == 1) PG8_BAR;
    PG8_WAIT_V(2); PG8_BAR;
    PG8_STAGE(PG8_SB(1, 0), cB + kstep, voffB); PG8_STAGEA(PG8_SA(1, 0), cA, kstep, false, 0); PG8_STAGE(PG8_SB(1, 1), cB + bhstep + kstep, voffB);
    PG8_WAIT_V(6); PG8_BAR;
    asm volatile("" ::: "memory");
#pragma unroll
    for (int a = 0; a < 2; ++a)
#pragma unroll
        for (int b = 0; b < 2; ++b)
#pragma unroll
            for (int m = 0; m < 4; ++m)
#pragma unroll
                for (int n = 0; n < 2; ++n) { acc[a][b][m][n] = (f32x4){0.f, 0.f, 0.f, 0.f}; asm volatile("" : "+v"(acc[a][b][m][n])); }
    asm volatile("s_nop 4" ::: "memory");
    for (;;) {
        const bool has_next = S.next(ui + 1, nxt);
        if constexpr (GATHER) {
            unsigned vn[2][2];
            if (has_next) S.avoff(nxt, Rr, Cc, vn, tid);
            else {
#pragma unroll
                for (int h = 0; h < 2; ++h)
#pragma unroll
                    for (int i = 0; i < 2; ++i) vn[h][i] = vc[h][i];
            }
            *(LAS u32x4*)vnslot = (u32x4){vn[0][0], vn[0][1], vn[1][0], vn[1][1]};
            if (has_next) S.rowtab(nxt, rowtab + 512 * ((ui + 1) % 3), tid);
        }
        const char* nB = has_next ? nxt.B : cB; const char* nA = has_next ? Abase + S.aoff(nxt) : cA;
        const bool fresh_nxt = !(AREUSE && has_next && nxt.e == cur.e && nxt.pm == cur.pm);
        const bool ff = fresh_cur && fresh_nxt;
#define PG8_WAITX do { if (!AREUSE || ff) PG8_WAIT_V(8); else PG8_WAIT_V(4); } while (0)
        for (int t = 0; t < nt; t += 2) {
            const bool last = (t == nt - 2);
            const size_t k1 = (size_t)(t + 1) * kstep;
            const size_t k2 = last ? (size_t)0 : (size_t)(t + 2) * kstep, k3 = k2 + kstep;
            const char* u2 = last ? nA : cA; const char* b2 = last ? nB : cB + (size_t)(t + 2) * kstep;
            const char* b3 = b2 + kstep;
            PG8_LDB(B0, 0, 0); PG8_LDB(B1, 0, 1); PG8_SCHED; PG8_LDA(At, 0, 0); if (!AREUSE || fresh_cur) PG8_STAGEA(PG8_SA(1, 1), cA, k1, false, 1);
            PG8_WAITX; PG8_WAIT_L(0); PG8_BAR; PG8_MMA(0, 0, At, B0); PG8_MMA(0, 1, At, B1); PG8_BAR; PG8_SCHED;
            PG8_LDA(At, 0, 1); PG8_STAGE(PG8_SB(0, 0), b2, voffB); PG8_STAGE(PG8_SB(0, 1), b2 + bhstep, voffB); if (!AREUSE || fresh_nxt) PG8_STAGEA(PG8_SA(0, 0), u2, k2, last, 0);
            PG8_WAITX; PG8_WAIT_L(0); PG8_BAR; PG8_MMA(1, 0, At, B0); PG8_MMA(1, 1, At, B1); PG8_BAR; PG8_SCHED;
            PG8_LDB(B0, 1, 0); PG8_LDB(B1, 1, 1); PG8_SCHED; PG8_LDA(At, 1, 0); if (!AREUSE || fresh_nxt) PG8_STAGEA(PG8_SA(0, 1), u2, k2, last, 1);
            PG8_WAITX; PG8_WAIT_L(0); PG8_BAR; PG8_MMA(0, 0, At, B0); PG8_MMA(0, 1, At, B1); PG8_BAR; PG8_SCHED;
            PG8_LDA(At, 1, 1); PG8_STAGE(PG8_SB(1, 0), b3, voffB); PG8_STAGE(PG8_SB(1, 1), b3 + bhstep, voffB); if (!AREUSE || fresh_nxt) PG8_STAGEA(PG8_SA(1, 0), u2, k3, last, 0);
            PG8_WAITX; PG8_WAIT_L(0); PG8_BAR; PG8_MMA(1, 0, At, B0); PG8_MMA(1, 1, At, B1); PG8_BAR; PG8_SCHED;
        }
#undef PG8_WAITX
        if (wr == 0) PG8_BAR;
        if constexpr (ESZ == 1) {
            asm volatile("s_nop 15\n\ts_nop 15" ::: "memory");
#pragma unroll
            for (int a = 0; a < 2; ++a)
#pragma unroll
                for (int b = 0; b < 2; ++b)
#pragma unroll
                    for (int m = 0; m < 4; ++m) asm volatile("" : "+v"(acc[a][b][m][0]), "+v"(acc[a][b][m][1]));
        }
        { const int l2 = lane_id(); E(acc, cur, wr, wc, l2 & 15, l2 >> 4, rowtab + 512 * (ui % 3)); }
        if (!has_next) break;
#pragma unroll
        for (int a = 0; a < 2; ++a)
#pragma unroll
            for (int b = 0; b < 2; ++b)
#pragma unroll
                for (int m = 0; m < 4; ++m)
#pragma unroll
                    for (int n = 0; n < 2; ++n) acc[a][b][m][n] = (f32x4){0.f, 0.f, 0.f, 0.f};
        cur = nxt; cB = nB; cA = nA; ++ui; fresh_cur = fresh_nxt;
        if constexpr (GATHER) { const u32x4 _t = *(const LAS u32x4*)vnslot; vc[0][0] = _t.x; vc[0][1] = _t.y; vc[1][0] = _t.z; vc[1][1] = _t.w; }
        if (wr == 1) PG8_BAR;
    }
    PG8_WAIT_V(0);
    PG8_BAR;
#undef PG8_SA
#undef PG8_SB
#undef PG8_STAGE
#undef PG8_STAGEA
#undef PG8_LDA
#undef PG8_LDB
#undef PG8_MMA
#undef PG8_WAIT_V
#undef PG8_WAIT_L
#undef PG8_BAR
#undef PG8_SCHED
}

struct DenseOrder {
    int nM, nN, nwg, G, c, K; const char* Bt;
    __device__ __forceinline__ void init(int Mrows, int N, int K_, const void* Bt_, int G_, int c_) { nM = Mrows / BM; nN = N / BM; nwg = nM * nN; G = G_; c = c_; K = K_; Bt = (const char*)Bt_; }
    __device__ __forceinline__ bool next(int i, Unit& u) const {
        const long L = (long)i * G + c; if (L >= nwg) return false;
        int wgid = (int)L; { const int q = nwg / 8, r = nwg % 8, xcd = wgid % 8, off = wgid / 8; wgid = (xcd < r ? xcd * (q + 1) : r * (q + 1) + (xcd - r) * q) + off; }
        const int nig = 8 * nN, gid = wgid / nig, fm = gid * 8, gsz = (nM - fm) < 8 ? (nM - fm) : 8;
        u.pm = fm + ((wgid % nig) % gsz); u.pn = (wgid % nig) / gsz; u.B = Bt + (size_t)u.pn * BM * K * 2; u.e = 0; u.cnt = 0; u.off = 0; return true;
    }
    static constexpr bool GATHER = false;
    __device__ __forceinline__ size_t aoff(const Unit& u) const { return (size_t)u.pm * BM * K * 2; }
    __device__ __forceinline__ void avoff(const Unit&, const int (&)[2], const int (&)[2], unsigned (&)[2][2], int) const {}
};
struct RowOrder {
    int pm, ncol, K; const char* Bt;
    static constexpr bool GATHER = false;
    __device__ __forceinline__ bool next(int i, Unit& u) const { if (i >= ncol) return false; u.pm = pm; u.pn = i; u.B = Bt + (size_t)i * BM * K * 2; u.e = 0; u.cnt = 0; u.off = 0; return true; }
    __device__ __forceinline__ size_t aoff(const Unit& u) const { return (size_t)u.pm * BM * K * 2; }
    __device__ __forceinline__ void avoff(const Unit&, const int (&)[2], const int (&)[2], unsigned (&)[2][2], int) const {}
};
template <int NCOL, bool TOKROWS, bool TILEMAJOR = false> struct ExpertOrder {
    static constexpr bool GATHER = true;
    __device__ __forceinline__ size_t aoff(const Unit&) const { return 0; }
    const LAS unsigned* tab; int per, c, K  ; const char* W; size_t wstride; const int* slot_ent; const float* slot_w;
    mutable int ehint = 0;
    int xbase, xend, xstride, xlb;
    __device__ __forceinline__ void init(const LAS unsigned* tab_, int K_, const void* W_, size_t wstride_, const int* slot_ent_, const float* slot_w_, int G, int c_) {
        tab = tab_; K = K_; W = (const char*)W_; wstride = wstride_; slot_ent = slot_ent_; slot_w = slot_w_; c = c_;
        const int U = (int)tab[T_TILE + NE] * (TILEMAJOR ? 1 : NCOL); per = (U + G - 1) / G;
        if (G % 8 == 0) { const int x = c_ % 8; const int q = U / 8, r = U % 8; xbase = x * q + (x < r ? x : r); xend = xbase + q + (x < r ? 1 : 0); xstride = G / 8; xlb = c_ / 8; }
        else { xbase = 0; xend = U; xstride = G; xlb = c_; }
    }
    __device__ __forceinline__ bool next(int i, Unit& u) const {
        const int L = TILEMAJOR ? xbase + (i / NCOL) * xstride + xlb : xbase + i * xstride + xlb;
        if (L >= xend) return false;
        const int tile = TILEMAJOR ? L : L / NCOL; u.pn = TILEMAJOR ? i % NCOL : L % NCOL;
        int lo = ehint;
        if (i == 0) { lo = 0; int hi = NE - 1; while (lo < hi) { const int mid = (lo + hi + 1) >> 1; if ((int)tab[T_TILE + mid] <= tile) lo = mid; else hi = mid - 1; } }
        else { while (lo < NE - 1 && (int)tab[T_TILE + lo + 1] <= tile) ++lo; }
        ehint = lo;
        u.e = lo; u.pm = tile - (int)tab[T_TILE + lo]; u.cnt = (int)tab[T_CNT + lo]; u.off = (int)tab[T_OFF + lo];
        u.B = W + (size_t)lo * wstride + (size_t)u.pn * BM * K; return true;
    }
    __device__ __forceinline__ void rowtab(const Unit& u, LAS unsigned* t, int tid) const {
        if (tid < BM) { int r = u.pm * BM + tid; if (r >= u.cnt) r = u.cnt - 1; t[tid] = (unsigned)slot_ent[u.off + r]; t[BM + tid] = __float_as_uint(slot_w[u.off + r]); }
    }
    __device__ __forceinline__ void avoff(const Unit& u, const int (&)[2], const int (&)[2], unsigned (&v)[2][2], int tidq) const {
        int R[2], C[2]; asm volatile("" : "+v"(tidq));
#pragma unroll
        for (int i = 0; i < 2; ++i) stage_rc(tidq * 16 + i * 8192, R[i], C[i]);
#pragma unroll
        for (int h = 0; h < 2; ++h)
#pragma unroll
            for (int i = 0; i < 2; ++i) {
                int r = u.pm * BM + h * HALF + R[i]; if (r >= u.cnt) r = u.cnt - 1;
                const int slot = u.off + r;
                const int row = TOKROWS ? (slot_ent[slot] >> 3) : slot;
                v[h][i] = (unsigned)(row * K + C[i] * 2);
            }
    }
};

struct EpiInProj {
    static constexpr bool PERM = true; bf16_t* O;
    __device__ __forceinline__ void operator()(const f32x4 (&acc)[2][2][4][2], const Unit& u, int wr, int wc, int fr, int fq, const LAS unsigned* rt) const {
        const float sc = INV_IN8 * ((u.pn < 2) ? 0.125f : ((u.pn == 8 || u.pn == 9) ? 0.08838834764831845f : 1.f));
        const int row0 = u.pm * BM + wr * 64 + fr, col0 = u.pn * BM + wc * 64 + 16 * fq;
#pragma unroll
        for (int ai = 0; ai < 2; ++ai)
#pragma unroll
            for (int m = 0; m < 4; ++m) { bf16_t* rowp = O + (size_t)(row0 + ai * HALF + m * 16) * DIN + col0;
#pragma unroll
                for (int bj = 0; bj < 2; ++bj) { const f32x4 v0 = acc[ai][bj][m][0] * sc, v1 = acc[ai][bj][m][1] * sc;
                    u32x4 w; w.x = cvt_pk_bf16(v0[0], v0[1]); w.y = cvt_pk_bf16(v0[2], v0[3]); w.z = cvt_pk_bf16(v1[0], v1[1]); w.w = cvt_pk_bf16(v1[2], v1[3]);
                    *(u32x4*)(rowp + 8 * bj) = w; } }
    }
};
struct EpiOutProj {
    static constexpr bool PERM = true; const float* x; const float* mod; bf16_t* tb;
    __device__ __forceinline__ void operator()(const f32x4 (&acc)[2][2][4][2], const Unit& u, int wr, int wc, int fr, int fq, const LAS unsigned* rt) const {
        const int b = (u.pm * BM) >> 11; const int col0 = u.pn * BM + wc * 64 + 16 * fq;
        f32x4 g[2][2];
#pragma unroll
        for (int bj = 0; bj < 2; ++bj)
#pragma unroll
            for (int n = 0; n < 2; ++n) g[bj][n] = *(const f32x4*)(mod + b * 6144 + MOD_GATE_A + col0 + 8 * bj + 4 * n) * INV_IN8;
#pragma unroll
        for (int ai = 0; ai < 2; ++ai)
#pragma unroll
            for (int m = 0; m < 4; ++m) { const size_t o = (size_t)(u.pm * BM + ai * HALF + wr * 64 + m * 16 + fr) * D + col0;
                const f32x4 x0 = *(const f32x4*)(x + o), x1 = *(const f32x4*)(x + o + 4), x2 = *(const f32x4*)(x + o + 8), x3 = *(const f32x4*)(x + o + 12);
                const f32x4 xs[2][2] = {{x0, x1}, {x2, x3}};
#pragma unroll
                for (int bj = 0; bj < 2; ++bj) {
                    const f32x4 t0 = xs[bj][0] * ALPHA + g[bj][0] * acc[ai][bj][m][0], t1 = xs[bj][1] * ALPHA + g[bj][1] * acc[ai][bj][m][1];
                    u32x4 w; w.x = cvt_pk_bf16(t0[0], t0[1]); w.y = cvt_pk_bf16(t0[2], t0[3]); w.z = cvt_pk_bf16(t1[0], t1[1]); w.w = cvt_pk_bf16(t1[2], t1[3]);
                    *(u32x4*)(tb + o + 8 * bj) = w; } }
    }
};
struct EpiRouter {
    static constexpr bool PERM = false; float* out;
    __device__ __forceinline__ void operator()(const f32x4 (&acc)[2][2][4][2], const Unit& u, int wr, int wc, int fr, int fq, const LAS unsigned* rt) const {
        const int col0 = wc * 32 + 4 * fq;
        float* tp = out + (size_t)u.pm * (BM * NE);
#pragma unroll
        for (int ai = 0; ai < 2; ++ai)
#pragma unroll
            for (int m = 0; m < 4; ++m) { const int rl = ai * HALF + wr * 64 + m * 16 + fr;
#pragma unroll
                for (int bj = 0; bj < 2; ++bj)
#pragma unroll
                    for (int n = 0; n < 2; ++n)
#pragma unroll
                        for (int j = 0; j < 4; ++j) tp[(size_t)(col0 + bj * HALF + n * 16 + j) * BM + rl] = 1.f / (1.f + __expf(-acc[ai][bj][m][n][j])); }
    }
};
template <bool EXPERT, bool F8IN = EXPERT> struct EpiGU {
    static constexpr bool PERM = true; void* Ov;
    __device__ __forceinline__ void operator()(const f32x4 (&acc)[2][2][4][2], const Unit& u, int wr, int wc, int fr, int fq, const LAS unsigned* rt) const {
        const int h0 = u.pn * HALF + wc * 32 + 8 * fq;
#pragma unroll
        for (int ai = 0; ai < 2; ++ai)
#pragma unroll
            for (int m = 0; m < 4; ++m) {
                const int rtw = u.pm * BM + ai * HALF + wr * 64 + m * 16 + fr;
                if (EXPERT) { if (rtw >= u.cnt) continue; }
                const float w = EXPERT ? __uint_as_float(rt[BM + ai * HALF + wr * 64 + m * 16 + fr]) * (S_ACT8 * INV_GU8) : (F8IN ? INV_GU8 : 1.f);
                const float gs = F8IN ? INV_GU8 : 1.f;
                const f32x4 g0 = acc[ai][0][m][0] * gs, g1 = acc[ai][0][m][1] * gs, u0 = acc[ai][1][m][0], u1 = acc[ai][1][m][1];
                const float h[8] = {w * silu_f(g0[0]) * u0[0], w * silu_f(g0[1]) * u0[1], w * silu_f(g0[2]) * u0[2], w * silu_f(g0[3]) * u0[3],
                                    w * silu_f(g1[0]) * u1[0], w * silu_f(g1[1]) * u1[1], w * silu_f(g1[2]) * u1[2], w * silu_f(g1[3]) * u1[3]};
                if (EXPERT) {
                    int w0 = __builtin_amdgcn_cvt_pk_fp8_f32(clamp8(h[0]), clamp8(h[1]), 0, false); w0 = __builtin_amdgcn_cvt_pk_fp8_f32(clamp8(h[2]), clamp8(h[3]), w0, true);
                    int w1 = __builtin_amdgcn_cvt_pk_fp8_f32(clamp8(h[4]), clamp8(h[5]), 0, false); w1 = __builtin_amdgcn_cvt_pk_fp8_f32(clamp8(h[6]), clamp8(h[7]), w1, true);
                    u32x2 o; o.x = (unsigned)w0; o.y = (unsigned)w1; *(u32x2*)((unsigned char*)Ov + (size_t)(u.off + rtw) * DE + h0) = o;
                    asm volatile("" ::: "memory");
                } else {
                    u32x4 o; o.x = cvt_pk_bf16(h[0], h[1]); o.y = cvt_pk_bf16(h[2], h[3]); o.z = cvt_pk_bf16(h[4], h[5]); o.w = cvt_pk_bf16(h[6], h[7]);
                    *(u32x4*)((bf16_t*)Ov + (size_t)rtw * DE + h0) = o;
                }
            }
    }
};
struct EpiSharedDown {
    static constexpr bool PERM = true; unsigned char* ysh;
    __device__ __forceinline__ void operator()(const f32x4 (&acc)[2][2][4][2], const Unit& u, int wr, int wc, int fr, int fq, const LAS unsigned* rt) const {
        const int col0 = u.pn * BM + wc * 64 + 16 * fq;
#pragma unroll
        for (int ai = 0; ai < 2; ++ai)
#pragma unroll
            for (int m = 0; m < 4; ++m) {
                u32x4 o;
#pragma unroll
                for (int bj = 0; bj < 2; ++bj) { const f32x4 v0 = acc[ai][bj][m][0] * YSCALE, v1 = acc[ai][bj][m][1] * YSCALE;
                    int w0 = __builtin_amdgcn_cvt_pk_fp8_f32(clamp8(v0[0]), clamp8(v0[1]), 0, false); w0 = __builtin_amdgcn_cvt_pk_fp8_f32(clamp8(v0[2]), clamp8(v0[3]), w0, true);
                    int w1 = __builtin_amdgcn_cvt_pk_fp8_f32(clamp8(v1[0]), clamp8(v1[1]), 0, false); w1 = __builtin_amdgcn_cvt_pk_fp8_f32(clamp8(v1[2]), clamp8(v1[3]), w1, true);
                    if (bj == 0) { o.x = (unsigned)w0; o.y = (unsigned)w1; } else { o.z = (unsigned)w0; o.w = (unsigned)w1; } }
                *(u32x4*)(ysh + (size_t)(u.pm * BM + ai * HALF + wr * 64 + m * 16 + fr) * D + col0) = o;
            }
    }
};
struct EpiExpDown {
    static constexpr bool PERM = true; unsigned char* ybuf; const int* slot_ent;
    __device__ __forceinline__ void operator()(const f32x4 (&acc)[2][2][4][2], const Unit& u, int wr, int wc, int fr, int fq, const LAS unsigned* rt) const {
        const int col0 = u.pn * BM + wc * 64 + 16 * fq;
#pragma unroll
        for (int ai = 0; ai < 2; ++ai)
#pragma unroll
            for (int m = 0; m < 4; ++m) {
                const int rtw = u.pm * BM + ai * HALF + wr * 64 + m * 16 + fr; if (rtw >= u.cnt) continue;
                u32x4 o;
#pragma unroll
                for (int bj = 0; bj < 2; ++bj) { const f32x4 v0 = acc[ai][bj][m][0] * (YSCALE * INV_DN8), v1 = acc[ai][bj][m][1] * (YSCALE * INV_DN8);
                    int w0 = __builtin_amdgcn_cvt_pk_fp8_f32(clamp8(v0[0]), clamp8(v0[1]), 0, false); w0 = __builtin_amdgcn_cvt_pk_fp8_f32(clamp8(v0[2]), clamp8(v0[3]), w0, true);
                    int w1 = __builtin_amdgcn_cvt_pk_fp8_f32(clamp8(v1[0]), clamp8(v1[1]), 0, false); w1 = __builtin_amdgcn_cvt_pk_fp8_f32(clamp8(v1[2]), clamp8(v1[3]), w1, true);
                    if (bj == 0) { o.x = (unsigned)w0; o.y = (unsigned)w1; } else { o.z = (unsigned)w0; o.w = (unsigned)w1; } }
                *(u32x4*)(ybuf + (size_t)rt[ai * HALF + wr * 64 + m * 16 + fr] * D + col0) = o;
                asm volatile("" ::: "memory");
            }
    }
};

template <int PMODE = 0, class Sched> __device__ __forceinline__ void down_phase(LAS unsigned char* lds, const char* act8, const Sched& S, unsigned char* ybuf, const int tid_in) {
    int tid_ = tid_in; asm volatile("" : "+v"(tid_));
    const int tid = tid_, wid = __builtin_amdgcn_readfirstlane(tid >> 6), lane = tid & 63, wr = wid >> 2, wc = wid & 3, fr = lane & 15, fq = lane >> 4;
    constexpr int RB = DE;
    int Rr[2]; unsigned voffB[2], cc2[2];
#pragma unroll
    for (int i = 0; i < 2; ++i) { int R, C; stage_rc(tid * 16 + i * 8192, R, C); Rr[i] = R; cc2[i] = (unsigned)(C * 2); const int Rb = (R & ~31) + perm32(R & 31); voffB[i] = (unsigned)(Rb * RB + C * 2); }
    const unsigned ldsw = (unsigned)wid * 1024u;
    const int aoff = lds_byte(wr * 64 + fr, fq * 8), boff = lds_byte(wc * 32 + fr, fq * 8);
#define DN_SA(k, h) (((k) * 2 + (h)) * HTB)
#define DN_SB(z, k) (65536 + ((z) * 2 + (k)) * HTB)
#define DN_STAGE(bufoff, gbase, voff) do { _Pragma("unroll") for (int _i = 0; _i < 2; ++_i) \
        __builtin_amdgcn_global_load_lds((const unsigned*)((const char*)(gbase) + (voff)[_i]), (LAS unsigned*)(lds + (bufoff) + ldsw + _i * 8192), 16, 0, 0); } while (0)
    LAS unsigned* rowtab = (LAS unsigned*)(lds + ROWTAB_OFF);
    Unit cur, nxt; int ti = 0;
    if (!S.next(0, cur)) return;
#define DN_STAGE_A(u) do { unsigned _va[2][2]; _Pragma("unroll") for (int _h = 0; _h < 2; ++_h) _Pragma("unroll") for (int _i = 0; _i < 2; ++_i) { int _r = (u).pm * BM + _h * HALF + Rr[_i]; if (_r >= (u).cnt) _r = (u).cnt - 1; _va[_h][_i] = (unsigned)(((u).off + _r) * RB) + cc2[_i]; } \
        _Pragma("unroll") for (int _k = 0; _k < 2; ++_k) _Pragma("unroll") for (int _h = 0; _h < 2; ++_h) DN_STAGE(DN_SA(_k, _h), act8 + _k * 128, _va[_h]); } while (0)
#define DN_STAGE_B(u, s_, z_) do { const char* _b = (u).B + (size_t)(s_) * (HALF * RB); _Pragma("unroll") for (int _k = 0; _k < 2; ++_k) DN_STAGE(DN_SB(z_, _k), _b + _k * 128, voffB); } while (0)
#define DN_ROWTAB(u, par) do { if (tid < BM) { int _r = (u).pm * BM + tid; if (_r >= (u).cnt) _r = (u).cnt - 1; rowtab[(par) * BM + tid] = (PMODE == 1) ? (unsigned)((u).off + _r) : (unsigned)S.slot_ent[(u).off + _r]; } } while (0)
    DN_STAGE_A(cur); DN_ROWTAB(cur, 0); DN_STAGE_B(cur, 0, 0);
    f32x4 acc[2][2][4][2];
    union Frag { bf16x8 q[2]; i32x8 w; };
    int gs = 0;
    Unit prev = cur; int prev_s = -1, prev_par = 0;
#define DN_EPILOGUE(set, u, s_, par) do { const int _col0 = (s_) * HALF + wc * 32 + 8 * fq; \
        _Pragma("unroll") for (int _ai = 0; _ai < 2; ++_ai) _Pragma("unroll") for (int _m = 0; _m < 4; ++_m) { const int _rt = _ai * HALF + wr * 64 + _m * 16 + fr; \
            { const f32x4 _v0 = acc[set][_ai][_m][0] * (YSCALE * INV_DN8), _v1 = acc[set][_ai][_m][1] * (YSCALE * INV_DN8);   \
                int _w0 = __builtin_amdgcn_cvt_pk_fp8_f32(clamp8(_v0[0]), clamp8(_v0[1]), 0, false); _w0 = __builtin_amdgcn_cvt_pk_fp8_f32(clamp8(_v0[2]), clamp8(_v0[3]), _w0, true); \
                int _w1 = __builtin_amdgcn_cvt_pk_fp8_f32(clamp8(_v1[0]), clamp8(_v1[1]), 0, false); _w1 = __builtin_amdgcn_cvt_pk_fp8_f32(clamp8(_v1[2]), clamp8(_v1[3]), _w1, true); \
                u32x2 _o; _o.x = (unsigned)_w0; _o.y = (unsigned)_w1; if (PMODE != 2 || (_w0 == 0x12345678 && _w1 == 0x31415926)) *(u32x2*)(ybuf + (size_t)rowtab[(par) * BM + _rt] * D + _col0) = _o; } } } while (0)
    for (;;) {
        const bool has_next = S.next(ti + 1, nxt);
        const int par = ti & 1;
#pragma unroll 1
        for (int s2 = 0; s2 < 8; s2 += 2) {
#pragma unroll
            for (int sb = 0; sb < 2; ++sb) {
                const int s = s2 + sb; const int z = sb;
                if (s == 0) asm volatile("s_waitcnt vmcnt(0)" ::: "memory");
                else if (PMODE == 2) asm volatile("s_waitcnt vmcnt(0)" ::: "memory");
                else asm volatile("s_waitcnt vmcnt(8)" ::: "memory");
                __builtin_amdgcn_s_barrier();
                asm volatile("" ::: "memory");
                if (s < 7) DN_STAGE_B(cur, s + 1, z ^ 1); else if (has_next) DN_STAGE_B(nxt, 0, z ^ 1);
                if (wr == 1 && prev_s >= 0) { asm volatile("s_nop 15" ::: "memory"); DN_EPILOGUE(sb ^ 1, prev, prev_s, prev_par); }
#pragma unroll
                for (int ai = 0; ai < 2; ++ai)
#pragma unroll
                    for (int m = 0; m < 4; ++m)
#pragma unroll
                        for (int n = 0; n < 2; ++n) acc[sb][ai][m][n] = (f32x4){0.f, 0.f, 0.f, 0.f};
                asm volatile("s_nop 4" ::: "memory");
#pragma unroll
                for (int k = 0; k < 2; ++k) {
                    Frag Bf[2];
#pragma unroll
                    for (int n = 0; n < 2; ++n) Bf[n].w = cat8(*(const LAS bf16x8*)(lds + DN_SB(z, k) + boff + n * 2048), *(const LAS bf16x8*)(lds + DN_SB(z, k) + boff + n * 2048 + 1024));
#pragma unroll
                    for (int ai = 0; ai < 2; ++ai) {
                        Frag Af[4];
#pragma unroll
                        for (int m = 0; m < 4; ++m) Af[m].w = cat8(*(const LAS bf16x8*)(lds + DN_SA(k, ai) + aoff + m * 2048), *(const LAS bf16x8*)(lds + DN_SA(k, ai) + aoff + m * 2048 + 1024));
#pragma unroll
                        for (int m = 0; m < 4; ++m)
#pragma unroll
                            for (int n = 0; n < 2; ++n) asm volatile("v_mfma_f32_16x16x128_f8f6f4 %0, %1, %2, %0" : "+v"(acc[sb][ai][m][n]) : "v"(Bf[n].w), "v"(Af[m].w));
                    }
                }
                if (wr == 0 && prev_s >= 0) DN_EPILOGUE(sb ^ 1, prev, prev_s, prev_par);
                prev = cur; prev_s = s; prev_par = par;
            }
        }
        if (!has_next) break;
        asm volatile("s_waitcnt lgkmcnt(0)" ::: "memory");
        __builtin_amdgcn_s_barrier();
        DN_STAGE_A(nxt); DN_ROWTAB(nxt, par ^ 1);
        cur = nxt; ++ti;
    }
    asm volatile("s_nop 15\n\ts_nop 15" ::: "memory");
    DN_EPILOGUE(1, prev, prev_s, prev_par);
    asm volatile("s_waitcnt vmcnt(0) lgkmcnt(0)" ::: "memory");
    __builtin_amdgcn_s_barrier();
#undef DN_SA
#undef DN_SB
#undef DN_STAGE
#undef DN_STAGE_A
#undef DN_STAGE_B
#undef DN_ROWTAB
#undef DN_EPILOGUE
}
constexpr int T_P64 = T_HIST;
template <int PMODE = 0> __device__ __forceinline__ void down2_phase(LAS unsigned char* lds, LAS unsigned* tab, const char* act8, const char* wd, const int* slot_ent, unsigned char* ybuf, const int G, const int bx, const int tid_in) {
    int tid_ = tid_in; asm volatile("" : "+v"(tid_));
    const int tid = tid_, wid = __builtin_amdgcn_readfirstlane(tid >> 6), lane = tid & 63, wr = wid >> 2, wc = wid & 3, fr = lane & 15, fq = lane >> 4;
    constexpr int NS = 8, PB = 16384;
    if (tid < 64) {
        unsigned c[4], sp = 0;
#pragma unroll
        for (int j = 0; j < 4; ++j) { c[j] = (tab[T_CNT + lane * 4 + j] + 63u) >> 6; sp += c[j]; }
        unsigned ip = sp;
#pragma unroll
        for (int o = 1; o < 64; o <<= 1) { const unsigned a = __shfl_up(ip, o); if (lane >= o) ip += a; }
        unsigned ep = ip - sp;
#pragma unroll
        for (int j = 0; j < 4; ++j) { tab[T_P64 + lane * 4 + j] = ep; ep += c[j]; }
        if (lane == 63) tab[T_P64 + NE] = ep;
    }
    __syncthreads();
    int g, q; const int NG = G >> 2;
    if (G % 32 == 0) { const int x = bx % 8, i = bx / 8; g = x * (G / 32) + (i >> 2); q = i & 3; } else { g = bx >> 2; q = bx & 3; }
    const int NP = (int)tab[T_P64 + NE];
    const int p_lo = g < NG ? (int)((long long)g * NP / NG) : 0, p_hi = g < NG ? (int)((long long)(g + 1) * NP / NG) : 0;
    if (p_lo < p_hi) {
    int R0, C0; stage_rc(tid * 16, R0, C0);
    const unsigned ldsw = (unsigned)wid * 1024u;
    const int aoff = lds_byte(wr * 32 + fr, fq * 8);
    LAS unsigned* rowtab = (LAS unsigned*)(lds + VN_OFF);
    int e0 = 0; { int hi = NE - 1; while (e0 < hi) { const int mid = (e0 + hi + 1) >> 1; if ((int)tab[T_P64 + mid] <= p_lo) e0 = mid; else hi = mid - 1; } }
    int e2 = e0, nb2 = (int)tab[T_P64 + e0 + 1];
    int e = -1, nb = p_lo;
#define D2_STAGE(pp_, it_) do { const int _pp = (pp_) < p_hi ? (pp_) : p_hi - 1; \
        while (_pp >= nb2) { ++e2; nb2 = (int)tab[T_P64 + e2 + 1]; } \
        const int _off = (int)tab[T_OFF + e2], _cnt = (int)tab[T_CNT + e2], _r0 = (_pp - (int)tab[T_P64 + e2]) * 64; \
        int _r = _r0 + R0; if (_r >= _cnt) _r = _cnt - 1; int _rr = _r0 + lane; if (_rr >= _cnt) _rr = _cnt - 1; \
        const char* _a = act8 + (size_t)(unsigned)((_off + _r) * DE + C0 * 2); const unsigned _zb = (unsigned)((it_) & (NS - 1)) * PB; \
        __builtin_amdgcn_global_load_lds((const unsigned*)_a, (LAS unsigned*)(lds + _zb + ldsw), 16, 0, 0); \
        __builtin_amdgcn_global_load_lds((const unsigned*)(_a + 128), (LAS unsigned*)(lds + _zb + 8192 + ldsw), 16, 0, 0); \
        if (wid == 0) __builtin_amdgcn_global_load_lds((const unsigned*)(slot_ent + _off + _rr), rowtab + ((it_) & 15) * 64, 4, 0, 0); } while (0)
    union Frag { bf16x8 q2[2]; i32x8 w; };
    Frag Bf[2][4], Af[2][2][2];
    f32x4 acc[2][2][4];
#define D2_CVT(v_) ({ const f32x4 _v = (v_); const float _c0 = clamp8(_v[0]); int _w = __builtin_amdgcn_cvt_pk_fp8_f32(_c0, clamp8(_v[1]), __float_as_int(_c0), false); (unsigned)__builtin_amdgcn_cvt_pk_fp8_f32(clamp8(_v[2]), clamp8(_v[3]), _w, true); })
#define D2_OUT(dst_, o_) do { if (PMODE == 0 || ((o_).x == 0x12345678u && (o_).y == 0x31415926u && (dst_) < (unsigned)NSLOT)) *(u32x4*)(ybuf + (size_t)(dst_) * D + (q * 256 + wc * 64 + 16 * fq)) = (o_); } while (0)
#define D2_EPILOGUE(set, ip_) do { _Pragma("unroll") for (int _m = 0; _m < 2; ++_m) { \
            const unsigned _dst = rowtab[((ip_) & 15) * 64 + wr * 32 + _m * 16 + fr]; u32x4 _o; \
            _Pragma("unroll") for (int _n = 0; _n < 4; ++_n) _o[_n] = D2_CVT(acc[set][_m][_n]); \
            D2_OUT(_dst, _o); } } while (0)
#define D2_READA(par, it_) do { const unsigned _zb = (unsigned)((it_) & (NS - 1)) * PB; _Pragma("unroll") for (int _k = 0; _k < 2; ++_k) _Pragma("unroll") for (int _m = 0; _m < 2; ++_m) \
        Af[par][_k][_m].w = cat8(*(const LAS bf16x8*)(lds + _zb + _k * 8192 + aoff + _m * 2048), *(const LAS bf16x8*)(lds + _zb + _k * 8192 + aoff + _m * 2048 + 1024)); } while (0)
#define D2_MFMA0(sb, m, n) asm volatile("v_mfma_f32_16x16x128_f8f6f4 %0, %1, %2, 0" : "=&v"(acc[sb][m][n]) : "v"(Bf[0][n].w), "v"(Af[sb][0][m].w))
#define D2_MFMA1(sb, m, n) asm volatile("v_mfma_f32_16x16x128_f8f6f4 %0, %1, %2, %0" : "+v"(acc[sb][m][n]) : "v"(Bf[1][n].w), "v"(Af[sb][1][m].w))
#define D2_PAIR(MF, sb, m, n0, EPI, om, on, ov) do { MF(sb, m, n0); MF(sb, m, n0 + 1); if (EPI && PMODE < 5) (ov)[on] = D2_CVT(acc[(sb) ^ 1][om][on]); __builtin_amdgcn_sched_barrier(0); } while (0)
#define D2_PIECE(sb, i_, EPI) do { const int _i = (i_); \
        if ((_i & 3) == 0) {                                               \
            if (_i == 0) asm volatile("s_waitcnt vmcnt(0)" ::: "memory"); else asm volatile("s_waitcnt vmcnt(6)" ::: "memory");     \
            asm volatile("s_waitcnt lgkmcnt(0)" ::: "memory"); \
            if (PMODE != 5) __builtin_amdgcn_s_barrier();                  \
            asm volatile("" ::: "memory"); \
            if (PMODE != 3 && PMODE != 5 && PMODE != 6) { _Pragma("unroll 1") for (int _t = 5; _t < 9; ++_t) D2_STAGE(p_lo + _i + _t, _i + _t); } \
        } \
        if (p_lo + _i >= nb) {                                             \
            do { ++e; nb = (int)tab[T_P64 + e + 1]; } while (p_lo + _i >= nb); \
            const __attribute__((address_space(1))) char* wb = (const __attribute__((address_space(1))) char*)(wd + ((size_t)e * D + q * 256 + wc * 64 + 16 * (fr >> 2) + (fr & 3)) * DE + 16 * fq); \
            _Pragma("unroll") for (int _k = 0; _k < 2; ++_k) _Pragma("unroll") for (int _n = 0; _n < 4; ++_n) \
                Bf[_k][_n].w = cat8(*(const __attribute__((address_space(1))) bf16x8*)(wb + _n * 4 * DE + _k * 128), *(const __attribute__((address_space(1))) bf16x8*)(wb + _n * 4 * DE + _k * 128 + 64)); \
            _Pragma("unroll") for (int _k = 0; _k < 2; ++_k) _Pragma("unroll") for (int _n = 0; _n < 4; ++_n) asm volatile("" : "+v"(Bf[_k][_n].w));     \
        } \
        if (PMODE != 5) D2_READA((sb) ^ 1, _i + 1); \
        unsigned _d0 = 0, _d1 = 0; u32x4 _o0, _o1; \
        __builtin_amdgcn_sched_barrier(0); \
        D2_PAIR(D2_MFMA0, sb, 0, 0, EPI, 0, 0, _o0); D2_PAIR(D2_MFMA0, sb, 0, 2, EPI, 0, 1, _o0); \
        if (EPI && PMODE < 5) { _d0 = rowtab[((_i - 1) & 15) * 64 + wr * 32 + fr]; _d1 = rowtab[((_i - 1) & 15) * 64 + wr * 32 + 16 + fr]; }     \
        __builtin_amdgcn_sched_barrier(0); \
        D2_PAIR(D2_MFMA0, sb, 1, 0, EPI, 0, 2, _o0); D2_PAIR(D2_MFMA0, sb, 1, 2, EPI, 0, 3, _o0); \
        if (EPI && PMODE < 5) D2_OUT(_d0, _o0); \
        D2_PAIR(D2_MFMA1, sb, 0, 0, EPI, 1, 0, _o1); D2_PAIR(D2_MFMA1, sb, 0, 2, EPI, 1, 1, _o1); D2_PAIR(D2_MFMA1, sb, 1, 0, EPI, 1, 2, _o1); D2_PAIR(D2_MFMA1, sb, 1, 2, EPI, 1, 3, _o1); \
        if (EPI && PMODE < 5) D2_OUT(_d1, _o1); \
    } while (0)
#pragma unroll 1
    for (int j = 0; j < 5; ++j) D2_STAGE(p_lo + j, j);
    const int n_it = p_hi - p_lo;
    asm volatile("s_waitcnt vmcnt(0)" ::: "memory");
    __builtin_amdgcn_s_barrier();
    asm volatile("" ::: "memory");
    D2_READA(0, 0);
    D2_PIECE(0, 0, false);
#pragma unroll 1
    for (int i2 = 1; i2 < n_it; i2 += 2) {
        D2_PIECE(1, i2, true);
        if (i2 + 1 < n_it) D2_PIECE(0, i2 + 1, true);
    }
    asm volatile("s_nop 15\n\ts_nop 15" ::: "memory");
    if (n_it & 1) D2_EPILOGUE(0, n_it - 1); else D2_EPILOGUE(1, n_it - 1);
#undef D2_CVT
#undef D2_OUT
#undef D2_READA
#undef D2_MFMA0
#undef D2_MFMA1
#undef D2_PAIR
#undef D2_PIECE
#undef D2_STAGE
#undef D2_EPILOGUE
    }
    asm volatile("s_waitcnt vmcnt(0) lgkmcnt(0)" ::: "memory");
    __builtin_amdgcn_s_barrier();
}
struct EpiProbeSum {
    static constexpr bool PERM = true; float* o;
    __device__ __forceinline__ void operator()(const f32x4 (&acc)[2][2][4][2], const Unit& u, int wr, int wc, int fr, int fq, const LAS unsigned* rt) const {
        f32x4 s = (f32x4){0.f, 0.f, 0.f, 0.f};
#pragma unroll
        for (int a = 0; a < 2; ++a)
#pragma unroll
            for (int b = 0; b < 2; ++b)
#pragma unroll
                for (int m = 0; m < 4; ++m) s += acc[a][b][m][0] + acc[a][b][m][1];
        if (s.x == 123.456f) *(f32x4*)(o + (size_t)(blockIdx.x * 512 + wr * 256 + wc * 64 + fq * 16 + fr) * 4) = s;
    }
};
}

struct Ctx {
    const float *x, *c, *w_ada, *b_ada, *w_in, *w_out, *na_rpb, *ret_ld, *ret_gn, *ln1_g, *ln1_b, *ln2_g, *ln2_b, *w_router, *rbias, *w_gate, *w_up, *w_down, *ws_gate, *ws_up, *ws_down;
    float* out; unsigned char* ws;
};
constexpr int NW = 8;

__device__ __forceinline__ void transpose_item(const float* W, int K, int N, bf16_t* WT, int G, int which, LAS float* scr, int item, int lane) {
    const int nblk = N / 32, kb = item / nblk, nb = item % nblk, k0 = 64 * kb, n0 = 32 * nb;
    float v[32];
#pragma unroll
    for (int i = 0; i < 32; ++i) { const int kk = 2 * i + (lane >> 5); v[i] = __builtin_nontemporal_load(W + (size_t)(k0 + kk) * N + n0 + (lane & 31)); }
#pragma unroll
    for (int i = 0; i < 32; ++i) { const int kk = 2 * i + (lane >> 5); scr[kk * 33 + (lane & 31)] = v[i]; }
    LDS_WAIT(); asm volatile("" ::: "memory");
    const int c = lane & 7;
#pragma unroll
    for (int j = 0; j < 4; ++j) { const int n = (lane >> 3) + 8 * j; const LAS float* s = scr + (8 * c) * 33 + n;
        u32x4 o; o.x = pk2(s[0 * 33], s[1 * 33]); o.y = pk2(s[2 * 33], s[3 * 33]); o.z = pk2(s[4 * 33], s[5 * 33]); o.w = pk2(s[6 * 33], s[7 * 33]);
        const int ng = n0 + n; const int drow = (G == 0) ? ng : ((ng / G) * 2 * G + which * G + (ng % G));
        *(u32x4*)(WT + (size_t)drow * K + k0 + 8 * c) = o; }
    LDS_WAIT(); asm volatile("" ::: "memory");
}
__device__ __forceinline__ void transpose_item_fp8(const float* W, int K, int N, unsigned char* WT, int G, int which, float scale, LAS float* scr, int item, int lane) {
    const int nblk = N / 32, kb = item / nblk, nb = item % nblk, k0 = 64 * kb, n0 = 32 * nb;
    float v[32];
#pragma unroll
    for (int i = 0; i < 32; ++i) { const int kk = 2 * i + (lane >> 5); v[i] = __builtin_nontemporal_load(W + (size_t)(k0 + kk) * N + n0 + (lane & 31)); }
#pragma unroll
    for (int i = 0; i < 32; ++i) { const int kk = 2 * i + (lane >> 5); scr[kk * 33 + (lane & 31)] = v[i] * scale; }
    LDS_WAIT(); asm volatile("" ::: "memory");
    const int c = lane & 7;
#pragma unroll
    for (int j = 0; j < 4; ++j) { const int n = (lane >> 3) + 8 * j; const LAS float* sp = scr + (8 * c) * 33 + n;
        int w0 = __builtin_amdgcn_cvt_pk_fp8_f32(clamp8(sp[0 * 33]), clamp8(sp[1 * 33]), 0, false); w0 = __builtin_amdgcn_cvt_pk_fp8_f32(clamp8(sp[2 * 33]), clamp8(sp[3 * 33]), w0, true);
        int w1 = __builtin_amdgcn_cvt_pk_fp8_f32(clamp8(sp[4 * 33]), clamp8(sp[5 * 33]), 0, false); w1 = __builtin_amdgcn_cvt_pk_fp8_f32(clamp8(sp[6 * 33]), clamp8(sp[7 * 33]), w1, true);
        const int ng = n0 + n; const int drow = (G == 0) ? ng : ((ng / G) * 2 * G + which * G + (ng % G));
        u32x2 o; o.x = (unsigned)w0; o.y = (unsigned)w1; *(u32x2*)(WT + (size_t)drow * K + k0 + 8 * c) = o; }
    LDS_WAIT(); asm volatile("" ::: "memory");
}
__device__ __forceinline__ void rope_entry(float* tab, int idx) {
    const int t = idx >> 6, i = idx & 63;
    const float inv_freq = powf(10000.f, -(float)(2 * i) / 128.f);
    const float ang = (float)t * inv_freq;
    const double a = (double)ang; const double two_pi = 6.283185307179586476925286766559;
    const double kf = rint(a / two_pi); double r = a - kf * two_pi;
    double sgn = 1.0; if (r > 1.5707963267948966) { r = 3.141592653589793 - r; sgn = -1.0; } else if (r < -1.5707963267948966) { r = -3.141592653589793 - r; sgn = -1.0; }
    const double r2 = r * r;
    const double s = r * (1.0 + r2 * (-1.0 / 6 + r2 * (1.0 / 120 + r2 * (-1.0 / 5040 + r2 * (1.0 / 362880 + r2 * (-1.0 / 39916800 + r2 * (1.0 / 6227020800.0 + r2 * (-1.0 / 1307674368000.0))))))));
    const double c = 1.0 + r2 * (-0.5 + r2 * (1.0 / 24 + r2 * (-1.0 / 720 + r2 * (1.0 / 40320 + r2 * (-1.0 / 3628800 + r2 * (1.0 / 479001600.0 + r2 * (-1.0 / 87178291200.0 + r2 * (1.0 / 20922789888000.0))))))));
    tab[idx] = (float)(sgn * c); tab[SEQ * 64 + idx] = (float)s;
}
__device__ __forceinline__ void mod_task(const float* __restrict__ cin, const float* __restrict__ w_ada, float* __restrict__ modp, int task, int lane) {
    const int cbk = task % 96, kc = task / 96, j = cbk * 64 + lane, k0 = kc * 64;
    float acc[32], cv[32];
#pragma unroll
    for (int b = 0; b < 32; ++b) { acc[b] = 0.f; cv[b] = silu_f(cin[b * D + k0 + lane]); }
#pragma unroll
    for (int kb = 0; kb < 4; ++kb) {
        float w[16];
#pragma unroll
        for (int i = 0; i < 16; ++i) w[i] = w_ada[(size_t)(k0 + kb * 16 + i) * 6144 + j];
#pragma unroll
        for (int i = 0; i < 16; ++i)
#pragma unroll
            for (int b = 0; b < 32; ++b) acc[b] += __builtin_bit_cast(float, __builtin_amdgcn_readlane(__builtin_bit_cast(int, cv[b]), kb * 16 + i)) * w[i];
    }
#pragma unroll
    for (int b = 0; b < 32; ++b) modp[((size_t)kc * 32 + b) * 6144 + j] = acc[b];
}
__device__ __forceinline__ float mod_sum(const float* __restrict__ modp, const float* __restrict__ b_ada, int b, int j) {
    float s = 0.f;
#pragma unroll
    for (int kc = 0; kc < 16; ++kc) s += modp[((size_t)kc * 32 + b) * 6144 + j];
    return s + b_ada[j];
}

#ifndef RET_PROBE
#define RET_PROBE 0
#endif
namespace ret {
typedef short s16x4 __attribute__((ext_vector_type(4)));
typedef __bf16 bfx2 __attribute__((ext_vector_type(2)));
constexpr unsigned RS = 288, TILE = 128 * RS, LK = 0, LV = TILE, LRF = 2 * TILE, LRB = 3 * TILE;
constexpr float LOG2E = 1.4426950408889634f;
__device__ __forceinline__ unsigned offb(unsigned row, unsigned ch) { return RS * row + 16u * ch; }
__device__ __forceinline__ unsigned cvtpk(float lo, float hi) { const f32x2 v = {lo, hi}; return __builtin_bit_cast(unsigned, __builtin_convertvector(v, bfx2)); }
__device__ __forceinline__ bf16x8 pack8(const float (&f)[8]) { u32x4 u; u.x = cvtpk(f[0], f[1]); u.y = cvtpk(f[2], f[3]); u.z = cvtpk(f[4], f[5]); u.w = cvtpk(f[6], f[7]); return __builtin_bit_cast(bf16x8, u); }
__device__ __forceinline__ void unpack8(const bf16x8 v, float (&f)[8]) { const u32x4 u = __builtin_bit_cast(u32x4, v);
    f[0] = __uint_as_float(u.x << 16); f[1] = __uint_as_float(u.x & 0xffff0000u); f[2] = __uint_as_float(u.y << 16); f[3] = __uint_as_float(u.y & 0xffff0000u);
    f[4] = __uint_as_float(u.z << 16); f[5] = __uint_as_float(u.z & 0xffff0000u); f[6] = __uint_as_float(u.w << 16); f[7] = __uint_as_float(u.w & 0xffff0000u); }
__device__ __forceinline__ bf16x8 trfrag(LAS unsigned char* base, unsigned row0, unsigned row1, unsigned cblk, unsigned qp, unsigned p) {
    const unsigned ch = 2u * cblk + (p >> 1), bo = 8u * (p & 1u);
    const s16x4 lo = __builtin_amdgcn_ds_read_tr16_b64_v4i16((LAS s16x4*)(base + offb(row0 + qp, ch) + bo));
    const s16x4 hi = __builtin_amdgcn_ds_read_tr16_b64_v4i16((LAS s16x4*)(base + offb(row1 + qp, ch) + bo));
    return __builtin_shufflevector(lo, hi, 0, 1, 2, 3, 4, 5, 6, 7);
}
struct KVRaw { bf16x8 ka[2], kb[2], v[4]; f32x4 c0[2], c1[2], s0[2], s1[2]; };
__device__ __forceinline__ void kv_load(KVRaw& R, const bf16_t* __restrict__ proj, const float* __restrict__ rope, int b, int h, int n, int tid) {
#pragma unroll
    for (int i = 0; i < 2; ++i) {
        const int q2 = tid + 512 * i, row = q2 >> 3, pc = q2 & 7, t = n * 128 + row;
        const bf16_t* rp = proj + (size_t)(b * SEQ + t) * DIN + OFF_KR + h * 128;
        R.ka[i] = *(const bf16x8*)(rp + pc * 8); R.kb[i] = *(const bf16x8*)(rp + 64 + pc * 8);
        R.c0[i] = *(const f32x4*)(rope + t * 64 + pc * 8); R.c1[i] = *(const f32x4*)(rope + t * 64 + pc * 8 + 4);
        R.s0[i] = *(const f32x4*)(rope + SEQ * 64 + t * 64 + pc * 8); R.s1[i] = *(const f32x4*)(rope + SEQ * 64 + t * 64 + pc * 8 + 4);
    }
#pragma unroll
    for (int i = 0; i < 4; ++i) { const int q4 = tid + 512 * i, row = q4 >> 4, ch = q4 & 15, t = n * 128 + row;
        R.v[i] = *(const bf16x8*)(proj + (size_t)(b * SEQ + t) * DIN + OFF_VR + h * 128 + ch * 8); }
}
__device__ __forceinline__ void kv_store(LAS unsigned char* lds, const KVRaw& R, int tid) {
#pragma unroll
    for (int i = 0; i < 2; ++i) {
        const int q2 = tid + 512 * i, row = q2 >> 3, pc = q2 & 7;
        float fa[8], fb[8], o1[8], o2[8];
        unpack8(R.ka[i], fa); unpack8(R.kb[i], fb);
        const float cs[8] = {R.c0[i].x, R.c0[i].y, R.c0[i].z, R.c0[i].w, R.c1[i].x, R.c1[i].y, R.c1[i].z, R.c1[i].w}, sn[8] = {R.s0[i].x, R.s0[i].y, R.s0[i].z, R.s0[i].w, R.s1[i].x, R.s1[i].y, R.s1[i].z, R.s1[i].w};
#pragma unroll
        for (int e = 0; e < 8; ++e) { o1[e] = fa[e] * cs[e] - fb[e] * sn[e]; o2[e] = fb[e] * cs[e] + fa[e] * sn[e]; }
        *(LAS bf16x8*)(lds + LK + offb(row, pc)) = pack8(o1); *(LAS bf16x8*)(lds + LK + offb(row, pc + 8)) = pack8(o2);
    }
#pragma unroll
    for (int i = 0; i < 4; ++i) { const int q4 = tid + 512 * i, row = q4 >> 4, ch = q4 & 15; *(LAS bf16x8*)(lds + LV + offb(row, ch)) = R.v[i]; }
}
__device__ __forceinline__ void rb_dma(LAS unsigned char* lds, const unsigned char* img, int w, int lane) {
#pragma unroll
    for (int i = 0; i < 5; ++i) { const int o = w + 8 * i; if (o < (int)TILE / 1024)
        __builtin_amdgcn_global_load_lds((const unsigned*)(img + o * 1024 + lane * 16), (LAS unsigned*)(lds + LRB + o * 1024), 16, 0, 0); }
}
template <bool FWD> __device__ __forceinline__ void state_update_1(LAS unsigned char* lds, f32x4 (&racc)[8], float l2, int w, int g, unsigned qp, unsigned p);
template <bool FWD> __device__ __forceinline__ void state_update(LAS unsigned char* lds, f32x4 (&racc)[8], float l2, int w, int g, unsigned qp, unsigned p) {
    if (RET_PROBE == 2) {
        f32x4 r2[8];
#pragma unroll
        for (int i = 0; i < 8; ++i) r2[i] = racc[i];
        unsigned zo = 0; asm volatile("" : "+v"(zo));
        state_update_1<FWD>(lds + zo, r2, l2, w, g, qp, p);
        state_update_1<FWD>(lds, racc, l2, w, g, qp, p);
#pragma unroll
        for (int i = 0; i < 8; ++i) racc[i] = (racc[i] + r2[i]) * 0.5f;
    } else state_update_1<FWD>(lds, racc, l2, w, g, qp, p);
}
template <bool FWD> __device__ __forceinline__ void state_update_1(LAS unsigned char* lds, f32x4 (&racc)[8], float l2, int w, int g, unsigned qp, unsigned p) {
    const float dec = __builtin_amdgcn_exp2f(128.f * l2);
    bf16x8 vs[4];
#pragma unroll
    for (int ks = 0; ks < 4; ++ks) {
        float f[8]; unpack8(trfrag(lds + LV, 32 * ks + 4 * g, 32 * ks + 16 + 4 * g, w, qp, p), f);
#pragma unroll
        for (int e = 0; e < 8; ++e) { const int key = 32 * ks + 16 * (e >> 2) + 4 * g + (e & 3); f[e] *= __builtin_amdgcn_exp2f((FWD ? (float)(127 - key) : (float)key) * l2); }
        vs[ks] = pack8(f);
    }
#pragma unroll
    for (int nb = 0; nb < 8; ++nb) {
        racc[nb] = racc[nb] * dec;
#pragma unroll
        for (int ks = 0; ks < 4; ++ks) racc[nb] = __builtin_amdgcn_mfma_f32_16x16x32_bf16(vs[ks], trfrag(lds + LK, 32 * ks + 4 * g, 32 * ks + 16 + 4 * g, nb, qp, p), racc[nb], 0, 0, 0);
    }
}
__device__ __forceinline__ void unit(const bf16_t* __restrict__ proj, const float* __restrict__ rope, const float* __restrict__ log_decay, const float* __restrict__ gn_g, bf16_t* __restrict__ ymix,
                                     unsigned char* __restrict__ scratch  , LAS unsigned char* lds, int hu, const int tid_in) {
    const int u = hu >> 1, n0 = (hu & 1) * 8, n1 = n0 + 8;
    const int b = u >> 2, h = u & 3;
    int tid_ = tid_in; asm volatile("" : "+v"(tid_));
    const int tid0 = tid_, w = __builtin_amdgcn_readfirstlane(tid0 >> 6);
#define RET_LANE int tid = tid0; asm volatile("" : "+v"(tid)); const int lane = tid & 63, r = lane & 15, g = lane >> 4; const unsigned qp = (unsigned)r >> 2, p = (unsigned)lane & 3u;
    const float lf2_ = log_decay[h] * LOG2E, lb2_ = log_decay[4 + h] * LOG2E;
    if (tid0 < 128) ((LAS float*)(lds + 4 * TILE))[tid0] = gn_g[h * 128 + tid0];
    f32x4 racc[8];
    KVRaw raw;
    for (int rep7 = 0; rep7 < (RET_PROBE == 7 ? 2 : 1); ++rep7) {
#pragma unroll
    for (int nb = 0; nb < 8; ++nb) racc[nb] = (f32x4){0.f, 0.f, 0.f, 0.f};
    kv_load(raw, proj, rope, b, h, 15, tid0);
    for (int n = 15; n >= n0; --n) {
        RET_LANE
        if (n < n1) {
            unsigned char* img = scratch + (size_t)(n - n0) * TILE;
#pragma unroll
            for (int nb = 0; nb < 8; ++nb) { u32x2 o; o.x = cvtpk(racc[nb][0], racc[nb][1]); o.y = cvtpk(racc[nb][2], racc[nb][3]);
                *(u32x2*)(img + offb(16 * nb + r, 2 * w + (g >> 1)) + 8 * (g & 1)) = o; }
        }
        if (n == n0) break;
        float lb2 = lb2_; asm volatile("" : "+v"(lb2));
        __syncthreads();
        kv_store(lds, raw, tid);
        __syncthreads();
        kv_load(raw, proj, rope, b, h, n - 1 > n0 ? n - 1 : 0, tid);
        state_update<false>(lds, racc, lb2, w, g, qp, p);
    }
    }
    asm volatile("s_waitcnt vmcnt(0)" ::: "memory");
    __syncthreads();
    __builtin_amdgcn_fence(__ATOMIC_ACQUIRE, "agent");
    asm volatile("s_waitcnt vmcnt(0)" ::: "memory");
    for (int rep8 = 0; rep8 < (RET_PROBE == 8 ? 2 : 1); ++rep8) {
    if (RET_PROBE == 8 && rep8 == 1) { __syncthreads(); kv_load(raw, proj, rope, b, h, 0, tid0); }
#pragma unroll
    for (int nb = 0; nb < 8; ++nb) racc[nb] = (f32x4){0.f, 0.f, 0.f, 0.f};
    for (int n = 0; n < n0; ++n) {
        RET_LANE
        float lf2 = lf2_; asm volatile("" : "+v"(lf2));
        __syncthreads();
        kv_store(lds, raw, tid);
        __syncthreads();
        kv_load(raw, proj, rope, b, h, n + 1, tid);
        state_update<true>(lds, racc, lf2, w, g, qp, p);
    }
    rb_dma(lds, scratch, w, tid0 & 63);
    for (int n = n0; n < n1; ++n) {
        RET_LANE
        float lf2 = lf2_, lb2 = lb2_; asm volatile("" : "+v"(lf2), "+v"(lb2));
        const LAS float* gnp = (const LAS float*)(lds + 4 * TILE); asm volatile("" : "+v"(gnp));
        const int cq = 16 * w + r, tq = n * 128 + cq;
        u32x2 qraw[2][4];
        { const bf16_t* rp = proj + (size_t)(b * SEQ + tq) * DIN + OFF_QR + h * 128 + 4 * g;
#pragma unroll
          for (int ks = 0; ks < 2; ++ks) { qraw[ks][0] = *(const u32x2*)(rp + 32 * ks); qraw[ks][1] = *(const u32x2*)(rp + 32 * ks + 16); qraw[ks][2] = *(const u32x2*)(rp + 32 * ks + 64); qraw[ks][3] = *(const u32x2*)(rp + 32 * ks + 80); } }
        __syncthreads();
        kv_store(lds, raw, tid);
#pragma unroll
        for (int nb = 0; nb < 8; ++nb) { u32x2 o; o.x = cvtpk(racc[nb][0], racc[nb][1]); o.y = cvtpk(racc[nb][2], racc[nb][3]);
            *(LAS u32x2*)(lds + LRF + offb(16 * nb + r, 2 * w + (g >> 1)) + 8 * (g & 1)) = o; }
        bf16x8 qn[4], qf[4], qb[4];
        { const float sf = __builtin_amdgcn_exp2f((float)(cq + 1) * lf2), sb = __builtin_amdgcn_exp2f((float)(128 - cq) * lb2);
#pragma unroll
          for (int ks = 0; ks < 2; ++ks) {
              float fa[8], fb[8], o1[8], o2[8], t1[8], t2[8];
              { const u32x2 a0 = qraw[ks][0], a1 = qraw[ks][1], b0 = qraw[ks][2], b1 = qraw[ks][3];
                unpack8(__builtin_bit_cast(bf16x8, (u32x4){a0.x, a0.y, a1.x, a1.y}), fa); unpack8(__builtin_bit_cast(bf16x8, (u32x4){b0.x, b0.y, b1.x, b1.y}), fb); }
              const float* cp = rope + tq * 64 + 32 * ks + 4 * g; const float* sp = cp + SEQ * 64;
              const f32x4 c0 = *(const f32x4*)cp, c1 = *(const f32x4*)(cp + 16), s0 = *(const f32x4*)sp, s1 = *(const f32x4*)(sp + 16);
              const float cs[8] = {c0.x, c0.y, c0.z, c0.w, c1.x, c1.y, c1.z, c1.w}, sn[8] = {s0.x, s0.y, s0.z, s0.w, s1.x, s1.y, s1.z, s1.w};
#pragma unroll
              for (int e = 0; e < 8; ++e) { o1[e] = fa[e] * cs[e] - fb[e] * sn[e]; o2[e] = fb[e] * cs[e] + fa[e] * sn[e]; }
              qn[ks] = pack8(o1); qn[ks + 2] = pack8(o2);
#pragma unroll
              for (int e = 0; e < 8; ++e) { t1[e] = o1[e] * sf; t2[e] = o2[e] * sf; }
              qf[ks] = pack8(t1); qf[ks + 2] = pack8(t2);
#pragma unroll
              for (int e = 0; e < 8; ++e) { t1[e] = o1[e] * sb; t2[e] = o2[e] * sb; }
              qb[ks] = pack8(t1); qb[ks + 2] = pack8(t2);
          } }
        asm volatile("s_waitcnt vmcnt(0)" ::: "memory");
        __syncthreads();
        kv_load(raw, proj, rope, b, h, n + 1 < n1 ? n + 1 : n, tid);
        u32x2 gv[8];
        { const bf16_t* gp = proj + (size_t)(b * SEQ + tq) * DIN + OFF_GR + h * 128 + 4 * g;
#pragma unroll
          for (int mbv = 0; mbv < 8; ++mbv) gv[mbv] = *(const u32x2*)(gp + 16 * mbv); }
        bf16x8 pt[4];
#pragma unroll
        for (int rep3 = 0; rep3 < (RET_PROBE == 3 ? 2 : 1); ++rep3) {
        unsigned zo3 = 0; if (RET_PROBE == 3) asm volatile("" : "+v"(zo3));
#pragma unroll
        for (int ks2 = 0; ks2 < 4; ++ks2) {
            float pv[8];
#pragma unroll
            for (int hb = 0; hb < 2; ++hb) {
                const int mb = 2 * ks2 + hb;
                f32x4 st = (f32x4){0.f, 0.f, 0.f, 0.f};
#pragma unroll
                for (int ks = 0; ks < 4; ++ks) { const LAS unsigned char* kp = lds + LK + zo3 + RS * (16 * mb + r) + 64 * ks + 8 * g; const u32x2 k0 = *(const LAS u32x2*)kp, k1 = *(const LAS u32x2*)(kp + 32);
                    st = __builtin_amdgcn_mfma_f32_16x16x32_bf16(__builtin_bit_cast(bf16x8, (u32x4){k0.x, k0.y, k1.x, k1.y}), qn[ks], st, 0, 0, 0); }
#pragma unroll
                for (int j = 0; j < 4; ++j) { const int diff = cq - (16 * mb + 4 * g + j); pv[4 * hb + j] = st[j] * __builtin_amdgcn_exp2f(diff >= 0 ? (float)diff * lf2 : (float)(-diff) * lb2); }
            }
            pt[ks2] = pack8(pv);
        }
        }
        f32x4 yacc[8];
#pragma unroll
        for (int mbv = 0; mbv < 8; ++mbv) {
            f32x4 y = (f32x4){0.f, 0.f, 0.f, 0.f};
#pragma unroll
            for (int rep = 0; rep < (RET_PROBE == 1 ? 2 : 1); ++rep) {
            unsigned zo = 0; if (RET_PROBE == 1) asm volatile("" : "+v"(zo));
#pragma unroll
            for (int ks2 = 0; ks2 < 4; ++ks2) y = __builtin_amdgcn_mfma_f32_16x16x32_bf16(trfrag(lds + LV + zo, 32 * ks2 + 4 * g, 32 * ks2 + 16 + 4 * g, mbv, qp, p), pt[ks2], y, 0, 0, 0);
#pragma unroll
            for (int ks = 0; ks < 4; ++ks) {
                y = __builtin_amdgcn_mfma_f32_16x16x32_bf16(trfrag(lds + LRF + zo, 32 * ks + 4 * g, 32 * ks + 16 + 4 * g, mbv, qp, p), qf[ks], y, 0, 0, 0);
                y = __builtin_amdgcn_mfma_f32_16x16x32_bf16(trfrag(lds + LRB + zo, 32 * ks + 4 * g, 32 * ks + 16 + 4 * g, mbv, qp, p), qb[ks], y, 0, 0, 0);
            }
            }
            yacc[mbv] = (RET_PROBE == 1) ? y * 0.5f : y;
        }
        __syncthreads();
        if (n + 1 < n1) rb_dma(lds, scratch + (size_t)(n + 1 - n0) * TILE, w, lane);
        { float s = 0.f;
#pragma unroll
          for (int mbv = 0; mbv < 8; ++mbv) s += (yacc[mbv][0] + yacc[mbv][1]) + (yacc[mbv][2] + yacc[mbv][3]);
          s += __shfl_xor(s, 16); s += __shfl_xor(s, 32);
          const float mu = s * (1.f / 128.f); float s2 = 0.f;
#pragma unroll
          for (int mbv = 0; mbv < 8; ++mbv) { yacc[mbv] = yacc[mbv] - mu; s2 += (yacc[mbv][0] * yacc[mbv][0] + yacc[mbv][1] * yacc[mbv][1]) + (yacc[mbv][2] * yacc[mbv][2] + yacc[mbv][3] * yacc[mbv][3]); }
          s2 += __shfl_xor(s2, 16); s2 += __shfl_xor(s2, 32);
          const float rstd = 1.f / sqrtf(s2 * (1.f / 128.f) + GN_EPS);
          unsigned char* op = (unsigned char*)ymix + (size_t)(b * SEQ + tq) * D + 512 + h * 128 + 4 * g;
#pragma unroll
          for (int rep4 = 0; rep4 < (RET_PROBE == 4 ? 2 : 1); ++rep4) {
          if (RET_PROBE == 4) { asm volatile("" : "+v"(op)); asm volatile("" : "+v"(gv[0]), "+v"(gv[1]), "+v"(gv[2]), "+v"(gv[3]), "+v"(gv[4]), "+v"(gv[5]), "+v"(gv[6]), "+v"(gv[7])); }
#pragma unroll
          for (int mbv = 0; mbv < 8; ++mbv) {
              const f32x4 gn = *(const LAS f32x4*)(gnp + 16 * mbv + 4 * g);
              const float g0 = __uint_as_float(gv[mbv].x << 16), g1 = __uint_as_float(gv[mbv].x & 0xffff0000u), g2 = __uint_as_float(gv[mbv].y << 16), g3 = __uint_as_float(gv[mbv].y & 0xffff0000u);
              int o = __builtin_amdgcn_cvt_pk_fp8_f32(clamp8(S_H8 * silu_f(g0) * (yacc[mbv][0] * rstd * gn.x)), clamp8(S_H8 * silu_f(g1) * (yacc[mbv][1] * rstd * gn.y)), 0, false);
              o = __builtin_amdgcn_cvt_pk_fp8_f32(clamp8(S_H8 * silu_f(g2) * (yacc[mbv][2] * rstd * gn.z)), clamp8(S_H8 * silu_f(g3) * (yacc[mbv][3] * rstd * gn.w)), o, true);
              *(unsigned*)(op + 16 * mbv) = (unsigned)o;
          } } }
        state_update<true>(lds, racc, lf2, w, g, qp, p);
    }
    }
    __syncthreads();
#undef RET_LANE
}
}


namespace na {
constexpr unsigned LKR = 0, LVR = 73728, LRPB = 147456;
__device__ __forceinline__ void load_row(LAS unsigned char* lds, const bf16_t* __restrict__ proj, int b, int head, int krow, int tid) {
    const int key = tid >> 3, ch = tid & 7, slot = krow % 9;
    const bf16_t* rp = proj + (size_t)(b * SEQ + krow * 64 + key) * DIN + head * 64 + ch * 8;
    const unsigned o = (unsigned)slot * 8192u + 128u * key + 16u * (ch ^ (key & 7));
    *(LAS u32x4*)(lds + LKR + o) = *(const u32x4*)(rp + OFF_KNA);
    *(LAS u32x4*)(lds + LVR + o) = *(const u32x4*)(rp + OFF_VNA);
}
__device__ __forceinline__ void unit(const bf16_t* __restrict__ proj, const float* __restrict__ rpb, bf16_t* __restrict__ ymix, LAS unsigned char* lds, int u, const int tid_in) {
    const int b = u >> 3, head = u & 7;
    int tid_ = tid_in; asm volatile("" : "+v"(tid_));
    const int tid0 = tid_, w = __builtin_amdgcn_readfirstlane(tid0 >> 6);
    __syncthreads();
    if (tid0 < 465) ((LAS float*)(lds + LRPB))[tid0] = rpb[head * 465 + tid0];
    const int ct = w & 3, cb = (ct == 0) ? 0 : (ct == 1 ? 8 : (ct == 2 ? 24 : 32));
    u32x4 pk[2], pv2[2]; int pre_lo = 0, pre_n = 0;
    bf16x8 qnx[2];
    { const int lane0 = tid0 & 63; const bf16_t* qptr = proj + (size_t)(b * SEQ + (w >> 2) * 64 + 16 * ct + (lane0 & 15)) * DIN + OFF_QNA + head * 64 + 8 * (lane0 >> 4); qnx[0] = *(const bf16x8*)qptr; qnx[1] = *(const bf16x8*)(qptr + 32); }
    for (int st = 0; st < 16; ++st) {
        int tid = tid0; asm volatile("" : "+v"(tid));
        const int lane = tid & 63, qi = lane & 15, g = lane >> 4; const unsigned qp = (unsigned)qi >> 2, p = (unsigned)lane & 3u;
        const int r = 2 * st + (w >> 2);
        const int rs = min(max(r - 4, 0), 24);
        const int need_hi = min(max(2 * st + 1 - 4, 0), 24) + 7;
        __syncthreads();
        if (st == 0) { for (int kr = 0; kr <= need_hi; ++kr) load_row(lds, proj, b, head, kr, tid); }
        else {
#pragma unroll
            for (int i = 0; i < 2; ++i) if (i < pre_n) { const int key = tid >> 3, ch = tid & 7; const unsigned o = (unsigned)((pre_lo + i) % 9) * 8192u + 128u * key + 16u * (ch ^ (key & 7));
                *(LAS u32x4*)(lds + LKR + o) = pk[i]; *(LAS u32x4*)(lds + LVR + o) = pv2[i]; }
        }
        const int cq = 16 * ct + qi, tq = b * SEQ + r * 64 + cq;
        bf16x8 qn[2];
        qn[0] = qnx[0]; qn[1] = qnx[1];
        __syncthreads();
        if (st < 15) { const bf16_t* qptr = proj + (size_t)(tq + 128) * DIN + OFF_QNA + head * 64 + 8 * g; qnx[0] = *(const bf16x8*)qptr; qnx[1] = *(const bf16x8*)(qptr + 32); }
        { const int nh = (st < 15) ? min(max(2 * st + 3 - 4, 0), 24) + 7 : need_hi; pre_lo = need_hi + 1; pre_n = nh - need_hi;
#pragma unroll
          for (int i = 0; i < 2; ++i) if (i < pre_n) { const int key = tid >> 3, ch = tid & 7; const bf16_t* rp = proj + (size_t)(b * SEQ + (pre_lo + i) * 64 + key) * DIN + head * 64 + ch * 8;
              pk[i] = *(const u32x4*)(rp + OFF_KNA); pv2[i] = *(const u32x4*)(rp + OFF_VNA); } }
        const int cs = min(max(cq - 8, 0), 48);
        const unsigned kb0 = 128u * qi + 16u * ((unsigned)g ^ ((unsigned)qi & 7u)), kb1 = 128u * qi + 16u * ((4u + (unsigned)g) ^ ((unsigned)qi & 7u));
        const LAS float* bias = (const LAS float*)(lds + LRPB);
        f32x4 sc[16]; float mx = -3.0e38f;
#pragma unroll
        for (int kr = 0; kr < 8; ++kr) {
            const int krow = rs + kr; const unsigned so = (unsigned)(krow % 9) * 8192u + 128u * (unsigned)cb;
            const int dr = krow - r + 7;
#pragma unroll
            for (int h2 = 0; h2 < 2; ++h2) {
                f32x4 a = (f32x4){0.f, 0.f, 0.f, 0.f};
                a = __builtin_amdgcn_mfma_f32_16x16x32_bf16(*(const LAS bf16x8*)(lds + LKR + so + 2048u * h2 + kb0), qn[0], a, 0, 0, 0);
                a = __builtin_amdgcn_mfma_f32_16x16x32_bf16(*(const LAS bf16x8*)(lds + LKR + so + 2048u * h2 + kb1), qn[1], a, 0, 0, 0);
#pragma unroll
                for (int j = 0; j < 4; ++j) {
                    const int kcol = cb + 16 * h2 + 4 * g + j;
                    const int dc = min(max(kcol - cq + 15, 0), 30);
                    const float v = a[j] + bias[dr * 31 + dc];
                    const bool in = (kcol >= cs) && (kcol < cs + 16);
                    a[j] = in ? v : -3.0e38f; mx = fmaxf(mx, a[j]);
                }
                sc[2 * kr + h2] = a;
            }
        }
        mx = fmaxf(mx, __shfl_xor(mx, 16)); mx = fmaxf(mx, __shfl_xor(mx, 32));
        float sum = 0.f; bf16x8 pt[8];
#pragma unroll
        for (int kk = 0; kk < 8; ++kk) {
            float pv[8];
#pragma unroll
            for (int h2 = 0; h2 < 2; ++h2)
#pragma unroll
                for (int j = 0; j < 4; ++j) { const float e = __builtin_amdgcn_exp2f((sc[2 * kk + h2][j] - mx) * 1.4426950408889634f); pv[4 * h2 + j] = e; sum += e; }
            pt[kk] = ret::pack8(pv);
        }
        sum += __shfl_xor(sum, 16); sum += __shfl_xor(sum, 32);
        const float inv = 1.f / sum;
        const unsigned sl = (((unsigned)g & 1u) << 2) | qp;
        unsigned char* op = (unsigned char*)ymix + (size_t)tq * D + head * 64 + 4 * g;
#pragma unroll
        for (int db = 0; db < 4; ++db) {
            const unsigned vb = 128u * (4u * (unsigned)g + qp) + 16u * ((2u * db + (p >> 1)) ^ sl) + 8u * (p & 1u);
            f32x4 y = (f32x4){0.f, 0.f, 0.f, 0.f};
#pragma unroll
            for (int kk = 0; kk < 8; ++kk) {
                const unsigned so = (unsigned)((rs + kk) % 9) * 8192u + 128u * (unsigned)cb;
                const ret::s16x4 lo = __builtin_amdgcn_ds_read_tr16_b64_v4i16((LAS ret::s16x4*)(lds + LVR + so + vb));
                const ret::s16x4 hi = __builtin_amdgcn_ds_read_tr16_b64_v4i16((LAS ret::s16x4*)(lds + LVR + so + 2048u + vb));
                y = __builtin_amdgcn_mfma_f32_16x16x32_bf16(__builtin_shufflevector(lo, hi, 0, 1, 2, 3, 4, 5, 6, 7), pt[kk], y, 0, 0, 0);
            }
            const float inv16 = inv * S_H8;
            int o = __builtin_amdgcn_cvt_pk_fp8_f32(clamp8(y[0] * inv16), clamp8(y[1] * inv16), 0, false); o = __builtin_amdgcn_cvt_pk_fp8_f32(clamp8(y[2] * inv16), clamp8(y[3] * inv16), o, true);
            *(unsigned*)(op + 16 * db) = (unsigned)o;
        }
    }
    __syncthreads();
}
}

__device__ __forceinline__ void unpack_t16r(const u32x4 a, const u32x4 b, f32x4 (&v)[4]) {
    v[0] = (f32x4){__uint_as_float(a.x << 16), __uint_as_float(a.x & 0xffff0000u), __uint_as_float(a.y << 16), __uint_as_float(a.y & 0xffff0000u)};
    v[1] = (f32x4){__uint_as_float(a.z << 16), __uint_as_float(a.z & 0xffff0000u), __uint_as_float(a.w << 16), __uint_as_float(a.w & 0xffff0000u)};
    v[2] = (f32x4){__uint_as_float(b.x << 16), __uint_as_float(b.x & 0xffff0000u), __uint_as_float(b.y << 16), __uint_as_float(b.y & 0xffff0000u)};
    v[3] = (f32x4){__uint_as_float(b.z << 16), __uint_as_float(b.z & 0xffff0000u), __uint_as_float(b.w << 16), __uint_as_float(b.w & 0xffff0000u)};
}
__device__ __forceinline__ void ln1_row(const u32x4 ra, const u32x4 rb, const LAS float* cv  , bf16_t* __restrict__ hf, unsigned char* __restrict__ hf8, float* __restrict__ stats, int row, int lane) {
    asm volatile("" : "+v"(cv));
    const int c0 = lane * 16;
    f32x4 v[4]; float s = 0.f;
    unpack_t16r(ra, rb, v);
#pragma unroll
    for (int j = 0; j < 4; ++j) s += (v[j].x + v[j].y) + (v[j].z + v[j].w);
    const float mean = wave_sum(s) * (1.f / D); float s2 = 0.f;
#pragma unroll
    for (int j = 0; j < 4; ++j) { v[j] = v[j] - mean; s2 += (v[j].x * v[j].x + v[j].y * v[j].y) + (v[j].z * v[j].z + v[j].w * v[j].w); }
    const float rstd = 1.f / sqrtf(wave_sum(s2) * (1.f / D) + LN_EPS);
    if (lane == 0) *(f32x2*)(stats + 2 * (size_t)row) = (f32x2){mean, rstd};
    u32x4 ob[2], o8;
#pragma unroll
    for (int j = 0; j < 4; ++j) { const int col = c0 + 4 * j;
        const f32x4 gg = *(const LAS f32x4*)(cv + col), bv = *(const LAS f32x4*)(cv + 1024 + col), sc1 = *(const LAS f32x4*)(cv + 2048 + col), sh = *(const LAS f32x4*)(cv + 3072 + col);
        const f32x4 h4 = (v[j] * rstd * gg + bv) * sc1 + sh;
        const unsigned p0 = pk2(h4.x, h4.y), p1 = pk2(h4.z, h4.w);
        if (j == 0) { ob[0].x = p0; ob[0].y = p1; } else if (j == 1) { ob[0].z = p0; ob[0].w = p1; } else if (j == 2) { ob[1].x = p0; ob[1].y = p1; } else { ob[1].z = p0; ob[1].w = p1; }
        const f32x4 h8 = h4 * S_HF8;
        int w0 = __builtin_amdgcn_cvt_pk_fp8_f32(clamp8(h8.x), clamp8(h8.y), 0, false); w0 = __builtin_amdgcn_cvt_pk_fp8_f32(clamp8(h8.z), clamp8(h8.w), w0, true);
        if (j == 0) o8.x = (unsigned)w0; else if (j == 1) o8.y = (unsigned)w0; else if (j == 2) o8.z = (unsigned)w0; else o8.w = (unsigned)w0; }
    *(u32x4*)(hf + (size_t)row * D + c0) = ob[0]; *(u32x4*)(hf + (size_t)row * D + c0 + 8) = ob[1];
    *(u32x4*)(hf8 + (size_t)row * D + c0) = o8;
}
__device__ __forceinline__ void top2_merge(float& a1, float& a2, float b1, float b2) { const float n1 = fmaxf(a1, b1); const float n2 = fmaxf(fminf(a1, b1), fmaxf(a2, b2)); a1 = n1; a2 = n2; }
__device__ __forceinline__ float sigm(float x) { return 1.f / (1.f + __expf(-x)); }
__device__ __forceinline__ void route_lane(const float* __restrict__ logits, const float* __restrict__ rbias, int* __restrict__ topk_e, float* __restrict__ topk_w, LAS unsigned* hist, int tok) {
    const float NEG = -3.0e38f;
    const float* row = logits + (size_t)(tok >> 8) * (256 * NE) + (tok & 255);
    float gs[8];
#pragma unroll
    for (int g = 0; g < 8; ++g) {
        float m1 = NEG, m2 = NEG;
        float sv[32];
#pragma unroll
        for (int i = 0; i < 32; ++i) sv[i] = row[(g * 32 + i) * 256];
#pragma unroll
        for (int q = 0; q < 8; ++q) {
            const f32x4 b4 = *(const f32x4*)(rbias + g * 32 + q * 4);
            const float v[4] = {sv[4 * q] + b4.x, sv[4 * q + 1] + b4.y, sv[4 * q + 2] + b4.z, sv[4 * q + 3] + b4.w};
#pragma unroll
            for (int j = 0; j < 4; ++j) { m2 = fmaxf(m2, fminf(m1, v[j])); m1 = fmaxf(m1, v[j]); }
        }
        gs[g] = m1 + m2;
        asm volatile("" ::: "memory");
    }
    int pc[8];
    { int run = 0;
#pragma unroll
      for (int g = 0; g < 8; ++g) { int rank = 0;
#pragma unroll
          for (int h = 0; h < 8; ++h) if (h != g) rank += (gs[h] > gs[g] || (gs[h] == gs[g] && h < g)) ? 1 : 0;
          run += (rank < 4) ? 1 : 0; pc[g] = run; } }
    float L[8]; int I[8];
#pragma unroll
    for (int i = 0; i < 8; ++i) { L[i] = NEG; I[i] = 0; }
#pragma unroll 1
    for (int k = 0; k < 4; ++k) {
        int gk = 0;
#pragma unroll
        for (int g = 0; g < 8; ++g) gk += (pc[g] <= k) ? 1 : 0;
        const int base = gk * 32;
        float sv[32];
#pragma unroll
        for (int i = 0; i < 32; ++i) sv[i] = row[(base + i) * 256];
#pragma unroll
        for (int q = 0; q < 8; ++q) {
            const f32x4 b4 = *(const f32x4*)(rbias + base + q * 4);
            const float cv[4] = {sv[4 * q] + b4.x, sv[4 * q + 1] + b4.y, sv[4 * q + 2] + b4.z, sv[4 * q + 3] + b4.w};
#pragma unroll
            for (int j = 0; j < 4; ++j) { float v = cv[j]; int idx = base + q * 4 + j;
#pragma unroll
                for (int i = 0; i < 8; ++i) { const bool gt = v > L[i]; const float tv = gt ? L[i] : v; const int ti = gt ? I[i] : idx; L[i] = gt ? v : L[i]; I[i] = gt ? idx : I[i]; v = tv; idx = ti; } }
        }
    }
    float w[8], wsum = 0.f;
#pragma unroll
    for (int i = 0; i < 8; ++i) { w[i] = row[I[i] * 256]; wsum += w[i]; }
    const float sc = 2.5f / wsum;
    *(u32x4*)(topk_e + tok * TOPK) = (u32x4){(unsigned)I[0], (unsigned)I[1], (unsigned)I[2], (unsigned)I[3]}; *(u32x4*)(topk_e + tok * TOPK + 4) = (u32x4){(unsigned)I[4], (unsigned)I[5], (unsigned)I[6], (unsigned)I[7]};
    *(f32x4*)(topk_w + tok * TOPK) = (f32x4){w[0] * sc, w[1] * sc, w[2] * sc, w[3] * sc}; *(f32x4*)(topk_w + tok * TOPK + 4) = (f32x4){w[4] * sc, w[5] * sc, w[6] * sc, w[7] * sc};
#pragma unroll
    for (int i = 0; i < 8; ++i) __hip_atomic_fetch_add(&hist[I[i]], 1u, __ATOMIC_RELAXED, __HIP_MEMORY_SCOPE_WORKGROUP);
}
__device__ __forceinline__ void build_tables(const unsigned* ctl, LAS unsigned* tab, const int tid) {
    if (tid < 64) {
        const int lane = tid;
        unsigned c[4], so = 0, st = 0;
#pragma unroll
        for (int j = 0; j < 4; ++j) { c[j] = __hip_atomic_load(ctl + CW_COUNT + lane * 4 + j, __ATOMIC_RELAXED, __HIP_MEMORY_SCOPE_AGENT); so += c[j]; st += (c[j] + 255u) >> 8; }
        unsigned io = so, it = st;
#pragma unroll
        for (int o = 1; o < 64; o <<= 1) { const unsigned a = __shfl_up(io, o), b = __shfl_up(it, o); if (lane >= o) { io += a; it += b; } }
        unsigned eo = io - so, et = it - st;
#pragma unroll
        for (int j = 0; j < 4; ++j) { tab[T_CNT + lane * 4 + j] = c[j]; tab[T_OFF + lane * 4 + j] = eo; tab[T_TILE + lane * 4 + j] = et; eo += c[j]; et += (c[j] + 255u) >> 8; }
        if (lane == 63) { tab[T_OFF + NE] = eo; tab[T_TILE + NE] = et; }
    }
    __syncthreads();
}
struct RowRaw { u32x4 y[9]; u32x4 t[2]; f32x2 st; };
__device__ __forceinline__ void final_load(RowRaw& R, const bf16_t* __restrict__ tb, const unsigned char* __restrict__ ybuf, const unsigned char* __restrict__ ysh, const float* __restrict__ stats, int row, int lane) {
    const int c0 = lane * 16;
#pragma unroll
    for (int k = 0; k < TOPK; ++k) R.y[k] = __builtin_nontemporal_load((const u32x4*)(ybuf + ((size_t)row * TOPK + k) * D + c0));
    R.y[8] = __builtin_nontemporal_load((const u32x4*)(ysh + (size_t)row * D + c0));
    R.t[0] = __builtin_nontemporal_load((const u32x4*)(tb + (size_t)row * D + c0)); R.t[1] = __builtin_nontemporal_load((const u32x4*)(tb + (size_t)row * D + c0 + 8));
    R.st = *(const f32x2*)(stats + 2 * (size_t)row);
}
__device__ __forceinline__ void final_row(float* __restrict__ out, const RowRaw& R, const LAS float* cv  , int row, int lane) {
    asm volatile("" : "+v"(cv));
    const int c0 = lane * 16;
    f32x4 a[4], t[4], v[4]; float s = 0.f;
#pragma unroll
    for (int j = 0; j < 4; ++j) a[j] = (f32x4){0.f, 0.f, 0.f, 0.f};
#pragma unroll
    for (int k = 0; k < 9; ++k) { const unsigned w[4] = {R.y[k].x, R.y[k].y, R.y[k].z, R.y[k].w};
#pragma unroll
        for (int j = 0; j < 4; ++j) { const f32x2 lo = __builtin_amdgcn_cvt_pk_f32_fp8((int)w[j], false), hi = __builtin_amdgcn_cvt_pk_f32_fp8((int)w[j], true); a[j].x += lo.x; a[j].y += lo.y; a[j].z += hi.x; a[j].w += hi.y; } }
    unpack_t16r(R.t[0], R.t[1], t);
#pragma unroll
    for (int j = 0; j < 4; ++j) { const int col = c0 + 4 * j;
        const f32x4 x1 = (t[j] - R.st.x) * R.st.y * *(const LAS f32x4*)(cv + col) + *(const LAS f32x4*)(cv + 1024 + col);
        v[j] = x1 * ALPHA + *(const LAS f32x4*)(cv + 4096 + col) * a[j] * YINV;
        s += (v[j].x + v[j].y) + (v[j].z + v[j].w); }
    const float mean = wave_sum(s) * (1.f / D); float s2 = 0.f;
#pragma unroll
    for (int j = 0; j < 4; ++j) { v[j] = v[j] - mean; s2 += (v[j].x * v[j].x + v[j].y * v[j].y) + (v[j].z * v[j].z + v[j].w * v[j].w); }
    const float rstd = 1.f / sqrtf(wave_sum(s2) * (1.f / D) + LN_EPS);
#pragma unroll
    for (int j = 0; j < 4; ++j) { const int col = c0 + 4 * j;
        *(f32x4*)(out + (size_t)row * D + col) = v[j] * rstd * *(const LAS f32x4*)(cv + 2048 + col) + *(const LAS f32x4*)(cv + 3072 + col); }
}

#ifndef MK_PER_PHASE
#define MK_PER_PHASE 0
#endif
constexpr int N_PHASES = 13;
struct Args { Ctx X; int ph_lo, ph_hi; };
typedef __attribute__((address_space(4))) const Ctx* CtxCP;
__device__ __forceinline__ CtxCP ctx_ptr() { CtxCP p = (CtxCP)__builtin_amdgcn_kernarg_segment_ptr(); asm volatile("" : "+s"(p)); return p; }

__global__ void __launch_bounds__(NW * 64, 2) mk_fwd(Args args) {
    extern __shared__ __attribute__((aligned(16))) unsigned char lds_raw[];
    LAS unsigned char* lds = (LAS unsigned char*)lds_raw;
    LAS unsigned* tab = (LAS unsigned*)(lds + TAB_OFF);
    volatile LAS unsigned* MISC = (volatile LAS unsigned*)(lds + MISC_OFF);
#define PH_BEGIN \
    const __attribute__((address_space(4))) Ctx& X = *ctx_ptr(); unsigned char* ws = X.ws; (void)ws; \
    const int lane = lane_id(), wave = wave0, tid = wave0 * 64 + lane; (void)lane; (void)wave; (void)tid; \
    const int G = gridDim.x, bx = blockIdx.x; (void)G; (void)bx; \
    const int gw = bx * NW + wave, NGW = G * NW; (void)gw; (void)NGW; \
    const int gt = bx * (NW * 64) + tid, NGT = G * NW * 64; (void)gt; (void)NGT; \
    unsigned* ctl = (unsigned*)(ws + WS_CTL); float* mod = (float*)(ws + WS_MOD); float* rope = (float*)(ws + WS_ROPE); (void)ctl; (void)mod; (void)rope; \
    bf16_t* win_t = (bf16_t*)(ws + WS_WIN_T); bf16_t* wout_t = (bf16_t*)(ws + WS_WOUT_T); bf16_t* wr_t = (bf16_t*)(ws + WS_WR_T); (void)win_t; (void)wout_t; (void)wr_t; \
    bf16_t* wsgu_t = (bf16_t*)(ws + WS_WSGU_T); bf16_t* wsd_t = (bf16_t*)(ws + WS_WSD_T); bf16_t* wd_t = (bf16_t*)(ws + WS_WD_T); bf16_t* wgu_t = (bf16_t*)(ws + WS_WGU_T); (void)wsgu_t; (void)wsd_t; (void)wd_t; (void)wgu_t; \
    int* slot_ent = (int*)(ws + WS_SLOT_ENT); float* slot_w = (float*)(ws + WS_SLOT_W); int* topk_e = (int*)(ws + WS_TOPK_E); float* topk_w = (float*)(ws + WS_TOPK_W); (void)slot_ent; (void)slot_w; (void)topk_e; (void)topk_w; \
    bf16_t* ymix = (bf16_t*)(ws + WS_YMIX); bf16_t* proj = (bf16_t*)(ws + WS_PROJ); bf16_t* hbuf = (bf16_t*)(ws + WS_YMIX); (void)ymix; (void)proj; (void)hbuf; \
    float* logits = (float*)(ws + WS_LOGITS); bf16_t* shh = (bf16_t*)(ws + WS_SHH); bf16_t* hf = (bf16_t*)(ws + WS_HF); bf16_t* act = (bf16_t*)(ws + WS_ACT); (void)logits; (void)shh; (void)hf; (void)act; \
    unsigned char* ybuf = ws + WS_YBUF; float* out = X.out; (void)ybuf; (void)out;

    const int wave0 = __builtin_amdgcn_readfirstlane((int)threadIdx.x >> 6);
    for (int u = threadIdx.x; u < (LDS_BYTES - MISC_OFF) / 4; u += NW * 64) ((LAS unsigned*)(lds + MISC_OFF))[u] = 0u;
    __syncthreads();
    if (!MK_PER_PHASE) { unsigned* ctl0 = (unsigned*)(args.X.ws + WS_CTL); (void)xcd_barrier_post(ctl0 + CW_BAR, MISC + 8, wave0 == 0 && lane_id() == 0); }
    const int lo = args.ph_lo, hi = args.ph_hi;
#ifndef MK_DUP
#define MK_DUP -1
#endif
#define REPS(k) for (int _rep = 0; _rep < ((MK_DUP == (k) || (MK_DUP == 202 && (k) == 0)) ? 2 : 1); ++_rep)
#ifdef MK_ONLY
#define IN(k) ((k) == MK_ONLY)
#else
#define IN(k) (lo <= (k) && (k) < hi)
#endif
#define SEAM(k) SEAM2(k, (k) + 1)
#define SEAM2(k, k2) do { if (IN(k) && IN(k2)) { XcdBarrier _b; _b.bar = (unsigned*)(ctx_ptr()->ws + WS_CTL) + CW_BAR; _b.x = xb_xcc_id(); _b.st = (volatile LAS unsigned*)(lds + MISC_OFF) + 8; xcd_barrier(_b, wave0 == 0 && lane_id() == 0); } } while (0)

    REPS(0) if (IN(0)) { PH_BEGIN
        LAS float* scr = (LAS float*)(lds + wave * 16384);
        float* modp = (float*)(ws + WS_PROJ);
        for (int t = gw; t < 96 * 16; t += NGW) mod_task(X.c, X.w_ada, modp, t, lane);
        constexpr int I_IN = (D / 64) * (DIN / 32), I_OUT = (D / 64) * (D / 32), I_R = (D / 64) * (NE / 32), I_SG = (D / 64) * (DE / 32), I_SD = (DE / 64) * (D / 32);
        constexpr int I_EG = I_SG, I_ED = I_SD;
        constexpr int N_SMALL = I_IN + I_OUT + I_R + 2 * I_SG + I_SD;
        constexpr int N_ITEMS = N_SMALL + NE * (2 * I_EG + I_ED);
#if MK_DUP == 200 || MK_DUP == 201
        for (int it = gw; it < NE * (2 * I_EG + I_ED); it += NGW) {
            int r = it; const int e = r / (2 * I_EG + I_ED); r -= e * (2 * I_EG + I_ED);
            const float* W; int K, N;
            if (r < I_EG) { W = X.w_gate + (size_t)e * D * DE; K = D; N = DE; } else if (r < 2 * I_EG) { r -= I_EG; W = X.w_up + (size_t)e * D * DE; K = D; N = DE; } else { r -= 2 * I_EG; W = X.w_down + (size_t)e * DE * D; K = DE; N = D; }
            const int nblk = N / 32, kb = r / nblk, nb = r % nblk, k0 = 64 * kb, n0 = 32 * nb; float sum = 0.f;
#if MK_DUP == 200
            float v[32];
#pragma unroll
            for (int i = 0; i < 32; ++i) { const int kk = 2 * i + (lane >> 5); v[i] = __builtin_nontemporal_load(W + (size_t)(k0 + kk) * N + n0 + (lane & 31)); }
#pragma unroll
            for (int i = 0; i < 32; ++i) sum += v[i];
#else
            f32x4 v[8];
#pragma unroll
            for (int i = 0; i < 8; ++i) { const int kk = 8 * i + (lane >> 3); v[i] = __builtin_nontemporal_load((const f32x4*)(W + (size_t)(k0 + kk) * N + n0 + 4 * (lane & 7))); }
#pragma unroll
            for (int i = 0; i < 8; ++i) sum += (v[i].x + v[i].y) + (v[i].z + v[i].w);
#endif
            if (sum == 123.456f) modp[it] = sum;
        }
#endif
        for (int it = gw; it < N_SMALL; it += NGW) {
            int r = it;
            if (r < I_IN) { transpose_item_fp8(X.w_in, D, DIN, (unsigned char*)win_t, 0, 0, S_WIN8, scr, r, lane); continue; } r -= I_IN;
            if (r < I_OUT) { transpose_item_fp8(X.w_out, D, D, (unsigned char*)wout_t, 0, 0, S_WIN8, scr, r, lane); continue; } r -= I_OUT;
            if (r < I_R) { transpose_item(X.w_router, D, NE, wr_t, 0, 0, scr, r, lane); continue; } r -= I_R;
            if (r < I_SG) { transpose_item_fp8(X.ws_gate, D, DE, (unsigned char*)wsgu_t, 8, 0, S_WGU8, scr, r, lane); continue; } r -= I_SG;
            if (r < I_SG) { transpose_item_fp8(X.ws_up, D, DE, (unsigned char*)wsgu_t, 8, 1, S_WGU8, scr, r, lane); continue; } r -= I_SG;
            transpose_item(X.ws_down, DE, D, wsd_t, 0, 0, scr, r, lane);
        }
        {
            constexpr int I_E = (D / 128) * (DE / 32), PER_E = 3 * I_E, N_EXP = NE * PER_E;
            static_assert((DE / 128) * (D / 32) == I_E, "item count");
            f32x4 v[16];
            const float* W = X.w_gate; unsigned char* WT = (unsigned char*)wgu_t; int K = D, N = DE, G8 = 8, which = 0, k0 = 0, n0 = 0; float scale = S_WGU8;
            const int kq = lane >> 3, nq = lane & 7;
            LAS unsigned char* sb = (LAS unsigned char*)scr;
#define P0_DECODE(it_) do { int _r = (it_); const int _e = _r / PER_E; _r -= _e * PER_E; const int _t = _r / I_E; _r -= _t * I_E; \
                if (_t < 2) { which = _t; W = (_t ? X.w_up : X.w_gate) + (size_t)_e * D * DE; K = D; N = DE; WT = (unsigned char*)wgu_t + (size_t)_e * 512 * D; G8 = 8; scale = S_WGU8; } \
                else { W = X.w_down + (size_t)_e * DE * D; K = DE; N = D; WT = (unsigned char*)wd_t + (size_t)_e * D * DE; G8 = 0; which = 0; scale = S_WD8; } \
                const int _nblk = N / 32; k0 = 128 * (_r / _nblk); n0 = 32 * (_r % _nblk); } while (0)
#define P0_LOAD() do { _Pragma("unroll") for (int _j = 0; _j < 4; ++_j) _Pragma("unroll") for (int _t = 0; _t < 4; ++_t) \
                v[4 * _j + _t] = __builtin_nontemporal_load((const f32x4*)(W + (size_t)(k0 + 4 * (8 * _j + kq) + _t) * N + n0 + 4 * nq)); } while (0)
#define P0_CVT4(x_) ({ const f32x4 _x = (x_) * cs; const float _c0 = clamp8(_x.x); int _w = __builtin_amdgcn_cvt_pk_fp8_f32(_c0, clamp8(_x.y), __float_as_int(_c0), false); (unsigned)__builtin_amdgcn_cvt_pk_fp8_f32(clamp8(_x.z), clamp8(_x.w), _w, true); })
            int it = gw;
            if (it < N_EXP) { P0_DECODE(it); P0_LOAD(); }
#pragma unroll 1
            while (it < N_EXP) {
                unsigned char* cWT = WT; const int cK = K, cG = G8, cwhich = which, ck0 = k0, cn0 = n0; const float cs = scale;
#pragma unroll
                for (int j = 0; j < 4; ++j) {
                    const unsigned d0 = P0_CVT4(v[4 * j + 0]), d1 = P0_CVT4(v[4 * j + 1]), d2 = P0_CVT4(v[4 * j + 2]), d3 = P0_CVT4(v[4 * j + 3]);
                    const unsigned x0 = __builtin_amdgcn_perm(d1, d0, 0x05010400u), x1 = __builtin_amdgcn_perm(d1, d0, 0x07030602u), y0 = __builtin_amdgcn_perm(d3, d2, 0x05010400u), y1 = __builtin_amdgcn_perm(d3, d2, 0x07030602u);
                    const unsigned e0 = __builtin_amdgcn_perm(y0, x0, 0x05040100u), e1 = __builtin_amdgcn_perm(y0, x0, 0x07060302u), e2 = __builtin_amdgcn_perm(y1, x1, 0x05040100u), e3 = __builtin_amdgcn_perm(y1, x1, 0x07060302u);
                    LAS unsigned char* wp = sb + (4 * nq) * 144 + 4 * (8 * j + kq);
                    *(LAS unsigned*)(wp) = e0; *(LAS unsigned*)(wp + 144) = e1; *(LAS unsigned*)(wp + 288) = e2; *(LAS unsigned*)(wp + 432) = e3;
                }
                const int itn = it + NGW;
                if (itn < N_EXP) { P0_DECODE(itn); P0_LOAD(); }
                LDS_WAIT(); asm volatile("" ::: "memory");
#pragma unroll
                for (int j2 = 0; j2 < 4; ++j2) { const int n = (lane >> 3) + 8 * j2; const u32x4 o = *(const LAS u32x4*)(sb + n * 144 + 16 * (lane & 7));
                    const int ng = cn0 + n; const int drow = cG ? ((ng >> 3) * 16 + cwhich * 8 + (ng & 7)) : ng;
                    *(u32x4*)(cWT + (size_t)drow * cK + ck0 + 16 * (lane & 7)) = o; }
                LDS_WAIT(); asm volatile("" ::: "memory");
                it = itn;
            }
#undef P0_DECODE
#undef P0_LOAD
#undef P0_CVT4
        }
        for (int i = gt; i < SEQ * 64; i += NGT) rope_entry(rope, i);
    }
    SEAM(0);
    REPS(1) if (IN(1)) { PH_BEGIN
        const float* modp = (const float*)(ws + WS_PROJ);
        for (int i = gt; i < 32 * 6144; i += NGT) mod[i] = mod_sum(modp, X.b_ada, i / 6144, i % 6144);
        LAS float* ssc = (LAS float*)lds; LAS float* ssh = ssc + 1024;
        int curb = -1;
        for (int c = bx; c < M / 256; c += G) {
            const int b = c >> 3;
            if (b != curb) {
                __syncthreads();
                for (int i = tid; i < 1024; i += NW * 64) { ssc[i] = 1.f + mod_sum(modp, X.b_ada, b, MOD_SCALE_A + i); ssh[i] = mod_sum(modp, X.b_ada, b, MOD_SHIFT_A + i); }
                __syncthreads();
                curb = b;
            }
            const f32x4 sc = *(const LAS f32x4*)(ssc + (tid & 255) * 4), sh = *(const LAS f32x4*)(ssh + (tid & 255) * 4);
            const float* xp = X.x + (size_t)c * 256 * D + (size_t)(tid >> 8) * D + (tid & 255) * 4;
            unsigned char* hp = (unsigned char*)hbuf + (size_t)c * 256 * D + (size_t)(tid >> 8) * D + (tid & 255) * 4;
            for (int i0 = 0; i0 < 128; i0 += 8) {
                f32x4 v[8];
#pragma unroll
                for (int i = 0; i < 8; ++i) v[i] = __builtin_nontemporal_load((const f32x4*)(xp + (size_t)(i0 + i) * 2 * D));
#pragma unroll
                for (int i = 0; i < 8; ++i) { int w = __builtin_amdgcn_cvt_pk_fp8_f32(clamp8((v[i].x * sc.x + sh.x) * S_H8), clamp8((v[i].y * sc.y + sh.y) * S_H8), 0, false);
                    w = __builtin_amdgcn_cvt_pk_fp8_f32(clamp8((v[i].z * sc.z + sh.z) * S_H8), clamp8((v[i].w * sc.w + sh.w) * S_H8), w, true); *(unsigned*)(hp + (size_t)(i0 + i) * 2 * D) = (unsigned)w; }
            }
        }
        __syncthreads();
    }
    SEAM(1);
    REPS(2) if (IN(2)) { PH_BEGIN
        pg8::DenseOrder S; S.init(M, DIN, D / 2, win_t, G, bx);
        pg8::EpiInProj E{proj};
        pg8::gemm_phase<1>(lds, (const char*)hbuf, D, S, E, tid);
    }
    SEAM(2);
    REPS(3) if (IN(3)) { PH_BEGIN
        REPS(31) for (int hu = bx; hu < BATCH * 4 * 2; hu += G) ret::unit(proj, rope, X.ret_ld, X.ret_gn, ymix, (unsigned char*)out + (size_t)hu * (8 * ret::TILE), lds, hu, tid);
        REPS(32) for (int u = bx; u < BATCH * 8; u += G) na::unit(proj, X.na_rpb, ymix, lds, u, tid);
    }
    SEAM2(3, 5);
    if (IN(5)) { PH_BEGIN
        LAS float* cv = (LAS float*)lds; LAS unsigned* hist = tab + T_HIST;
        if (tid < NE) hist[tid] = 0u;
        __syncthreads();
        for (int c = bx; c < M / 256; c += G) {
            const int b = c >> 3;
            { pg8::RowOrder S{c, 4, D / 2, (const char*)wout_t}; pg8::EpiOutProj E{X.x, mod, (bf16_t*)(ws + WS_TB)}; pg8::gemm_phase<1>(lds, (const char*)ymix, D, S, E, tid); }
            asm volatile("s_waitcnt vmcnt(0)" ::: "memory"); __syncthreads();
            int lane2 = lane; asm volatile("" : "+v"(lane2));
            const int tid2 = wave * 64 + lane2;
            if (tid2 < 256) { const int i = tid2 * 4; *(LAS f32x4*)(cv + i) = *(const f32x4*)(X.ln1_g + i); *(LAS f32x4*)(cv + 1024 + i) = *(const f32x4*)(X.ln1_b + i);
                *(LAS f32x4*)(cv + 2048 + i) = *(const f32x4*)(mod + b * 6144 + MOD_SCALE_F + i) + 1.f; *(LAS f32x4*)(cv + 3072 + i) = *(const f32x4*)(mod + b * 6144 + MOD_SHIFT_F + i); }
            __syncthreads();
            { const bf16_t* tp = (const bf16_t*)(ws + WS_TB) + (size_t)(c * 256 + wave * 32) * D + lane2 * 16;
              u32x4 ra = *(const u32x4*)tp, rb = *(const u32x4*)(tp + 8);
#pragma unroll 1
              for (int i = 0; i < 32; ++i) {
                  const u32x4 ca = ra, cb = rb; const int nx = i < 31 ? i + 1 : i;
                  ra = *(const u32x4*)(tp + (size_t)nx * D); rb = *(const u32x4*)(tp + (size_t)nx * D + 8);
                  ln1_row(ca, cb, cv, hf, ws + WS_HF8, (float*)(ws + WS_STATS), c * 256 + wave * 32 + i, lane2);
              } }
            asm volatile("s_waitcnt vmcnt(0)" ::: "memory"); __syncthreads();
            { pg8::RowOrder S{c, 1, D, (const char*)wr_t}; pg8::EpiRouter E{logits}; pg8::gemm_phase(lds, (const char*)hf, D, S, E, tid); }
            { pg8::RowOrder S{c, 2, D / 2, (const char*)wsgu_t}; pg8::EpiGU<false, true> E{(void*)shh}; pg8::gemm_phase<1>(lds, (const char*)(ws + WS_HF8), D, S, E, tid); }
            asm volatile("s_waitcnt vmcnt(0)" ::: "memory"); __syncthreads();
            { int lane3 = lane; asm volatile("" : "+v"(lane3)); const int tid3 = wave * 64 + lane3;
              if (tid3 < 256) route_lane(logits, X.rbias, topk_e, topk_w, hist, c * 256 + tid3); }
        }
        __syncthreads();
        if (tid < NE && hist[tid]) atomicAdd(&ctl[CW_COUNT + tid], hist[tid]);
    }
    SEAM2(5, 9);
    if (IN(9)) { PH_BEGIN
        build_tables(ctl, tab, tid);
        LAS unsigned* hist = tab + T_HIST; LAS unsigned* base = tab + T_BASE;
        for (int c0 = bx * 2048; c0 < NSLOT; c0 += G * 2048) {
            __syncthreads();
            if (tid < NE) hist[tid] = 0u;
            __syncthreads();
            int e[4]; unsigned loc[4];
#pragma unroll
            for (int i = 0; i < 4; ++i) { const int idx = c0 + i * 512 + tid; e[i] = topk_e[idx]; loc[i] = __hip_atomic_fetch_add(&hist[e[i]], 1u, __ATOMIC_RELAXED, __HIP_MEMORY_SCOPE_WORKGROUP); }
            __syncthreads();
            if (tid < NE && hist[tid]) base[tid] = atomicAdd(&ctl[CW_CURSOR + tid], hist[tid]);
            __syncthreads();
#pragma unroll
            for (int i = 0; i < 4; ++i) { const int idx = c0 + i * 512 + tid; const unsigned pos = tab[T_OFF + e[i]] + base[e[i]] + loc[i]; slot_ent[pos] = idx; slot_w[pos] = topk_w[idx]; }
        }
    }
    SEAM(9);
    if (IN(10)) { PH_BEGIN
        build_tables(ctl, tab, tid);
        REPS(10) { pg8::ExpertOrder<2, true> S; S.init(tab, D, wgu_t, (size_t)512 * D, slot_ent, slot_w, G, bx); pg8::EpiGU<true> E{(void*)act}; pg8::gemm_phase<1>(lds, (const char*)(ws + WS_HF8), D, S, E, tid); }
        { pg8::DenseOrder S; S.init(M, D, DE, wsd_t, G, bx); pg8::EpiSharedDown E{ws + WS_YSH}; pg8::gemm_phase(lds, (const char*)shh, DE, S, E, tid); }
    }
    SEAM(10);
    REPS(11) if (IN(11)) { PH_BEGIN
        build_tables(ctl, tab, tid);
#if MK_DUP >= 113 && MK_DUP <= 118
        pg8::down2_phase<MK_DUP - 112>(lds, tab, (const char*)act, (const char*)wd_t, slot_ent, ybuf, G, bx, tid);
#endif
        pg8::down2_phase(lds, tab, (const char*)act, (const char*)wd_t, slot_ent, ybuf, G, bx, tid);
#if MK_DUP == 111
        { pg8::ExpertOrder<4, false> S2; S2.init(tab, DE, wd_t, (size_t)D * DE, slot_ent, slot_w, G, bx); pg8::EpiProbeSum E2{(float*)(ws + WS_STATS)}; pg8::gemm_phase<1>(lds, (const char*)act, DE, S2, E2, tid); }
#endif
    }
    SEAM(11);
    REPS(12) if (IN(12)) { PH_BEGIN
        LAS float* cv = (LAS float*)lds; int curb = -1;
        for (int c = bx; c < M / 256; c += G) {
            const int b = c >> 3;
            if (b != curb) {
                __syncthreads();
                if (tid < 256) { const int i = tid * 4; *(LAS f32x4*)(cv + i) = *(const f32x4*)(X.ln1_g + i); *(LAS f32x4*)(cv + 1024 + i) = *(const f32x4*)(X.ln1_b + i);
                    *(LAS f32x4*)(cv + 2048 + i) = *(const f32x4*)(X.ln2_g + i); *(LAS f32x4*)(cv + 3072 + i) = *(const f32x4*)(X.ln2_b + i); *(LAS f32x4*)(cv + 4096 + i) = *(const f32x4*)(mod + b * 6144 + MOD_GATE_F + i); }
                __syncthreads(); curb = b;
            }
            const int r0 = c * 256 + wave * 32;
            RowRaw nx; final_load(nx, (const bf16_t*)(ws + WS_TB), ybuf, ws + WS_YSH, (const float*)(ws + WS_STATS), r0, lane);
#pragma unroll 1
            for (int i = 0; i < 32; ++i) {
                const RowRaw cur = nx;
                final_load(nx, (const bf16_t*)(ws + WS_TB), ybuf, ws + WS_YSH, (const float*)(ws + WS_STATS), r0 + (i < 31 ? i + 1 : i), lane);
                final_row(out, cur, cv, r0 + i, lane);
            }
        }
    }
#undef IN
#undef SEAM
}

extern "C" void kernel_launch(void* const* d_in, const int* in_sizes, int n_in, void* d_out, int out_size, void* d_ws, size_t ws_size, hipStream_t stream) {
    static int grid = 0;
    if (grid == 0) {
        if (n_in != 21 || in_sizes[0] != M * D || out_size != M * D || ws_size < WS_END) { fprintf(stderr, "kernel_launch: unexpected shapes (n_in %d, ws %zu)\n", n_in, ws_size); grid = -1; return; }
        int dev = 0, cus = 0, per_cu = 0;
        if (hipGetDevice(&dev) != hipSuccess || hipDeviceGetAttribute(&cus, hipDeviceAttributeMultiprocessorCount, dev) != hipSuccess) { grid = -1; return; }
        if (hipFuncSetAttribute((const void*)mk_fwd, hipFuncAttributeMaxDynamicSharedMemorySize, LDS_BYTES) != hipSuccess) { fprintf(stderr, "kernel_launch: hipFuncSetAttribute failed\n"); grid = -1; return; }
        if (hipOccupancyMaxActiveBlocksPerMultiprocessor(&per_cu, (const void*)mk_fwd, NW * 64, LDS_BYTES) != hipSuccess || per_cu < 1) { fprintf(stderr, "kernel_launch: occupancy query says %d\n", per_cu); }
        (void)hipGetLastError();
        grid = cus;
    }
    if (grid < 0) return;
    (void)hipMemsetAsync((char*)d_ws + WS_CTL, 0, 1 * MiB, stream);
    Args a{};
    const float** p = (const float**)&a.X;
    for (int i = 0; i < 21; ++i) p[i] = (const float*)d_in[i];
    a.X.out = (float*)d_out; a.X.ws = (unsigned char*)d_ws;
#if MK_PER_PHASE
    for (int ph = 0; ph < N_PHASES; ++ph) { a.ph_lo = ph; a.ph_hi = ph + 1; hipLaunchKernelGGL(mk_fwd, dim3(grid), dim3(NW * 64), LDS_BYTES, stream, a); }
#else
    a.ph_lo = 0; a.ph_hi = N_PHASES;
    hipLaunchKernelGGL(mk_fwd, dim3(grid), dim3(NW * 64), LDS_BYTES, stream, a);
#endif
}
```
